# Optimizing an MI355X kernel written in HIP

```python
import math
import jax, jax.numpy as jnp
from jax import lax
import numpy as np

D_MODEL = 1024
BATCH = 8
SEQ = 8192
DEPTH = 2
DEC_BATCH = 8
DEC_SEQ = 16
PAST_LEN = 2048

CHUNK = 64
PLE_DIM = 256
MIX_WIDTH = D_MODEL
D_FF = 4 * D_MODEL
ROPE_THETA = 10000.0
NORM_EPS = 1e-6
L2_EPS = 1e-6
Q_BLOCK = 128

A_HEADS = 4
A_DK = MIX_WIDTH // 4 // A_HEADS
A_DV = A_DK
A_QK = A_HEADS * A_DK
CONV_W = 4
A_CONV_CH = 2 * A_QK + A_HEADS * A_DV

B_HEADS = 4
B_DV = MIX_WIDTH // 2 // B_HEADS
B_DQK = B_DV // 2

C_HEADS = 4
C_HD = MIX_WIDTH // 4 // C_HEADS
C_WIDTH = C_HEADS * C_HD
C_W_RANK = 64
C_A_RANK = 64
C_G_RANK = 128
C_PROJ = 3 * C_WIDTH + C_W_RANK + C_A_RANK + C_G_RANK
C_LN_EPS = 64e-5
RWKV_DECAY_OFFSET = 0.5

PROJ_SIZES = (A_CONV_CH, A_HEADS * A_DV, A_HEADS, A_HEADS,
              B_HEADS * 2 * B_DQK, B_HEADS * 2 * B_DQK, B_HEADS * B_DV, C_PROJ)
IN_WIDTH = (A_CONV_CH + A_HEADS * A_DV + 2 * A_HEADS
            + 2 * B_HEADS * 2 * B_DQK + B_HEADS * B_DV + C_PROJ)

kernel_name = 'hybrid_streaming_encoder_step'

F32 = jnp.float32


def rmsnorm(x, g):
    xf = x.astype(F32)
    y = xf * lax.rsqrt(jnp.mean(xf * xf, axis=-1, keepdims=True) + NORM_EPS)
    return (y * g.astype(F32)).astype(x.dtype)


def l2norm(x):
    xf = x.astype(F32)
    return (xf * lax.rsqrt(jnp.sum(xf * xf, axis=-1, keepdims=True) + L2_EPS)).astype(x.dtype)


def rope(x, pos):
    d = x.shape[-1]
    half = d // 2
    inv = ROPE_THETA ** (-2.0 * jnp.arange(half, dtype=F32) / d)
    ang = pos.astype(F32)[:, None] * inv[None, :]
    shape = (1, pos.shape[0]) + (1,) * (x.ndim - 3) + (half,)
    cos = jnp.cos(ang).reshape(shape)
    sin = jnp.sin(ang).reshape(shape)
    xf = x.astype(F32)
    x1, x2 = xf[..., :half], xf[..., half:]
    return jnp.concatenate([x1 * cos - x2 * sin, x2 * cos + x1 * sin], axis=-1).astype(x.dtype)


def causal_conv(x, buf, w):
    L = x.shape[1]
    xp = jnp.concatenate([buf.astype(x.dtype), x], axis=1)
    y = xp[:, 0:L] * w[0]
    for j in range(1, CONV_W):
        y = y + xp[:, j:j + L] * w[j]
    return y, xp[:, L:]


def split_proj(proj):
    idx, acc = [], 0
    for s in PROJ_SIZES[:-1]:
        acc += s
        idx.append(acc)
    return jnp.split(proj, idx, axis=-1)


def gated_delta_chunked(q, k, v, g, beta, s0):
    bn, L, nh, dk = q.shape
    dv = v.shape[-1]
    C = min(CHUNK, L)
    N = L // C

    def blk(t):
        t = t.astype(F32).reshape((bn, N, C, nh) + t.shape[3:])
        return jnp.moveaxis(t, 3, 1)

    q, k, v, g, beta = blk(q), blk(k), blk(v), blk(g), blk(beta)
    q = q * (dk ** -0.5)
    g = jnp.cumsum(g, axis=-1)
    idx = jnp.arange(C)
    lower = idx[:, None] >= idx[None, :]
    strict = idx[:, None] > idx[None, :]
    diff = g[..., :, None] - g[..., None, :]
    decay = jnp.where(lower, jnp.exp(jnp.where(lower, diff, 0.0)), 0.0)
    kk = jnp.einsum('bhnid,bhnjd->bhnij', k, k)
    a_mat = jnp.where(strict, beta[..., :, None] * kk * decay, 0.0)
    eye = jnp.eye(C, dtype=F32)
    rhs = jnp.concatenate([v * beta[..., None], k * (beta * jnp.exp(g))[..., None]], axis=-1)
    sol = lax.linalg.triangular_solve(jnp.broadcast_to(eye, a_mat.shape) + a_mat, rhs,
                                      left_side=True, lower=True)
    u_val, w_k = sol[..., :dv], sol[..., dv:]
    qk = jnp.where(lower, jnp.einsum('bhnid,bhnjd->bhnij', q, k) * decay, 0.0)
    q_dec = q * jnp.exp(g)[..., None]
    k_tail = k * jnp.exp(g[..., -1:] - g)[..., None]
    g_last = jnp.exp(g[..., -1])

    def step(s, xs):
        u_c, w_c, qk_c, qd_c, kt_c, gl_c = xs
        u_new = u_c - jnp.einsum('bhcd,bhde->bhce', w_c, s)
        o = jnp.einsum('bhcd,bhde->bhce', qd_c, s) + jnp.einsum('bhij,bhje->bhie', qk_c, u_new)
        s = s * gl_c[..., None, None] + jnp.einsum('bhcd,bhce->bhde', kt_c, u_new)
        return s, o

    xs = (jnp.moveaxis(u_val, 2, 0), jnp.moveaxis(w_k, 2, 0), jnp.moveaxis(qk, 2, 0),
          jnp.moveaxis(q_dec, 2, 0), jnp.moveaxis(k_tail, 2, 0), jnp.moveaxis(g_last, 2, 0))
    s_fin, o = lax.scan(step, s0.astype(F32), xs)
    o = jnp.transpose(o, (1, 0, 3, 2, 4)).reshape(bn, L, nh, dv)
    return o, s_fin


def rwkv7_scan(r, w_log, k, v, kk, a, s0):
    def step(s, xs):
        r_t, w_t, k_t, v_t, kk_t, a_t = xs
        sa = jnp.einsum('bhvk,bhk->bhv', s, -kk_t)
        s = (s * jnp.exp(w_t)[:, :, None, :] + sa[..., :, None] * (kk_t * a_t)[..., None, :]
             + v_t[..., :, None] * k_t[..., None, :])
        return s, jnp.einsum('bhvk,bhk->bhv', s, r_t)

    xs = (jnp.moveaxis(r.astype(F32), 1, 0), jnp.moveaxis(w_log.astype(F32), 1, 0),
          jnp.moveaxis(k.astype(F32), 1, 0), jnp.moveaxis(v.astype(F32), 1, 0),
          jnp.moveaxis(kk.astype(F32), 1, 0), jnp.moveaxis(a.astype(F32), 1, 0))
    s_fin, y = lax.scan(step, s0.astype(F32), xs)
    return jnp.moveaxis(y, 0, 1), s_fin


def diff_attention(q, k, v, q_pos, k_pos, lam):
    bn, lq, nh, _, d = q.shape
    dv = v.shape[-1]
    blk = min(Q_BLOCK, lq)
    nb = lq // blk
    kf = k.astype(F32)
    vf = v.astype(F32)
    k_chunk = k_pos // CHUNK
    neg = jnp.finfo(F32).min

    def one_block(args):
        qb, qp = args
        s = jnp.einsum('bqhmd,bkhmd->bhmqk', qb.astype(F32) * (d ** -0.5), kf)
        visible = k_chunk[None, :] <= (qp // CHUNK)[:, None]
        p = jax.nn.softmax(jnp.where(visible, s, neg), axis=-1)
        pd = p[:, :, 0] - lam * p[:, :, 1]
        return jnp.einsum('bhqk,bkhe->bqhe', pd, vf)

    qb = jnp.moveaxis(q.reshape(bn, nb, blk, nh, 2, d), 1, 0)
    o = lax.map(one_block, (qb, q_pos.reshape(nb, blk)))
    return jnp.moveaxis(o, 0, 1).reshape(bn, lq, nh, dv)


def trunk_layer(h, p_l, past_len, cache_k, cache_v, conv_buf, delta_s, shift_prev, wkv_s,
                norm_mix, w_in, a_conv_w, a_A_log, a_dt_bias, a_norm,
                b_lam_q1, b_lam_k1, b_lam_q2, b_lam_k2, b_norm,
                c_mu, c_w0, c_w_up, c_a0, c_a_up, c_g_up, c_k_k, c_k_a, c_r_k, c_ln_w, c_ln_b,
                w_out, norm_ffn, w_ff1, w_ff2, norm_ple, w_ple_gate, w_ple_proj, layer_idx):
    dt = h.dtype
    bn, L, _ = h.shape
    x = rmsnorm(h, norm_mix)
    a_qkv, a_z, a_a, a_b, b_q, b_k, b_v, c_raw = split_proj(x @ w_in)

    a_c, new_conv = causal_conv(a_qkv, conv_buf, a_conv_w)
    a_c = jax.nn.silu(a_c)
    aq, ak, av = jnp.split(a_c, [A_QK, 2 * A_QK], axis=-1)
    aq = l2norm(aq.reshape(bn, L, A_HEADS, A_DK))
    ak = l2norm(ak.reshape(bn, L, A_HEADS, A_DK))
    av = av.reshape(bn, L, A_HEADS, A_DV)
    a_logdecay = -jnp.exp(a_A_log.astype(F32)) * jax.nn.softplus(a_a.astype(F32) + a_dt_bias)
    a_beta = jax.nn.sigmoid(a_b.astype(F32))
    ao, new_delta = gated_delta_chunked(aq, ak, av, a_logdecay, a_beta, delta_s)
    ao = rmsnorm(ao, a_norm) * jax.nn.silu(a_z.astype(F32)).reshape(bn, L, A_HEADS, A_DV)

    q_pos = past_len + jnp.arange(L, dtype=jnp.int32)
    k_pos = jnp.arange(past_len + L, dtype=jnp.int32)
    bq = rope(b_q.reshape(bn, L, B_HEADS, 2, B_DQK), q_pos)
    bk = rope(b_k.reshape(bn, L, B_HEADS, 2, B_DQK), q_pos)
    bv = b_v.reshape(bn, L, B_HEADS, B_DV)
    new_k = bk.reshape(bn, L, B_HEADS, 2 * B_DQK)
    k_all = jnp.concatenate([cache_k.astype(dt), new_k], axis=1).reshape(bn, past_len + L, B_HEADS, 2, B_DQK)
    v_all = jnp.concatenate([cache_v.astype(dt), bv], axis=1)
    lam_init = 0.8 - 0.6 * math.exp(-0.3 * layer_idx)
    lam = (jnp.exp(jnp.sum(b_lam_q1.astype(F32) * b_lam_k1.astype(F32)))
           - jnp.exp(jnp.sum(b_lam_q2.astype(F32) * b_lam_k2.astype(F32))) + lam_init)
    bo = diff_attention(bq, k_all, v_all, q_pos, k_pos, lam)
    bo = rmsnorm(bo, b_norm) * (1.0 - lam_init)

    prev = jnp.concatenate([shift_prev[:, None, :].astype(dt), c_raw[:, :-1]], axis=1)
    c = c_raw + (prev - c_raw) * c_mu
    new_shift = c_raw[:, -1]
    cr, ck, cv, cwd, cad, cgd = jnp.split(
        c, [C_WIDTH, 2 * C_WIDTH, 3 * C_WIDTH, 3 * C_WIDTH + C_W_RANK,
            3 * C_WIDTH + C_W_RANK + C_A_RANK], axis=-1)
    hd = (bn, L, C_HEADS, C_HD)
    w_log = -jnp.exp(-jax.nn.softplus(-(c_w0 + jnp.tanh(cwd.astype(F32)) @ c_w_up)) - RWKV_DECAY_OFFSET)
    ca = jax.nn.sigmoid(c_a0 + cad.astype(F32) @ c_a_up).reshape(hd)
    cg = jax.nn.sigmoid(cgd.astype(F32)) @ c_g_up
    cr = cr.astype(F32).reshape(hd)
    cv = cv.astype(F32).reshape(hd)
    ck = ck.astype(F32).reshape(hd)
    kk = l2norm(ck * c_k_k.reshape(C_HEADS, C_HD))
    ck = ck * (1.0 + (ca - 1.0) * c_k_a.reshape(C_HEADS, C_HD))
    cy, new_wkv = rwkv7_scan(cr, w_log.reshape(hd), ck, cv, kk, ca, wkv_s)
    mu = jnp.mean(cy, axis=-1, keepdims=True)
    var = jnp.mean(jnp.square(cy - mu), axis=-1, keepdims=True)
    cy = ((cy - mu) * lax.rsqrt(var + C_LN_EPS)).reshape(bn, L, C_WIDTH) * c_ln_w + c_ln_b
    bonus = jnp.sum(cr * ck * c_r_k, axis=-1, keepdims=True) * cv
    co = (cy + bonus.reshape(bn, L, C_WIDTH)) * cg

    mix = jnp.concatenate([ao.reshape(bn, L, -1).astype(dt), bo.reshape(bn, L, -1).astype(dt),
                           co.astype(dt)], axis=-1)
    h = h + mix @ w_out

    u = jax.nn.relu(rmsnorm(h, norm_ffn) @ w_ff1)
    h = h + (u * u) @ w_ff2

    gate = jax.nn.sigmoid(rmsnorm(h, norm_ple) @ w_ple_gate)
    h = h + gate * (p_l @ w_ple_proj)

    return h, (new_conv, new_delta.astype(dt), new_k, bv, new_shift, new_wkv.astype(dt))


def run_trunk(x, p, cache_k, cache_v, conv_buf, delta_s, shift_prev, wkv_s, layer_params, norm_final):
    past_len = cache_k.shape[2]
    h = x
    states = []
    for i in range(DEPTH):
        lp = [t[i] for t in layer_params]
        h, st = trunk_layer(h, p[i], past_len, cache_k[i], cache_v[i], conv_buf[i], delta_s[i],
                            shift_prev[i], wkv_s[i], *lp, layer_idx=i)
        states.append(st)
    new_state = [jnp.stack([st[j] for st in states], axis=0) for j in range(6)]
    return rmsnorm(h, norm_final), new_state


def setup_inputs(seed: int = 0) -> dict:
    key = jax.random.key(seed)
    ks = iter(jax.random.split(key, 48))

    def nrm(shape, s):
        return jax.random.normal(next(ks), shape, F32) * s

    def gain(shape):
        return 1.0 + nrm(shape, 0.01)

    dt0 = jnp.exp(jax.random.uniform(next(ks), (DEPTH, A_HEADS), F32,
                                     minval=math.log(1e-3), maxval=math.log(1e-1)))
    return {
        'x_prompt': nrm((BATCH, SEQ, D_MODEL), 1.0),
        'x_sample': nrm((DEC_BATCH, DEC_SEQ, D_MODEL), 1.0),
        'cache_b_k': nrm((DEPTH, DEC_BATCH, PAST_LEN, B_HEADS, 2 * B_DQK), 1.0),
        'cache_b_v': nrm((DEPTH, DEC_BATCH, PAST_LEN, B_HEADS, B_DV), 1.0),
        'state_a_conv': nrm((DEPTH, DEC_BATCH, CONV_W - 1, A_CONV_CH), 1.0),
        'state_a_delta': nrm((DEPTH, DEC_BATCH, A_HEADS, A_DK, A_DV), 0.1),
        'state_c_shift': nrm((DEPTH, DEC_BATCH, C_PROJ), 1.0),
        'state_c_wkv': nrm((DEPTH, DEC_BATCH, C_HEADS, C_HD, C_HD), 0.5),
        'p_prompt': nrm((DEPTH, BATCH, SEQ, PLE_DIM), 1.0),
        'p_sample': nrm((DEPTH, DEC_BATCH, DEC_SEQ, PLE_DIM), 1.0),
        'norm_mix': gain((DEPTH, D_MODEL)),
        'w_in': nrm((DEPTH, D_MODEL, IN_WIDTH), D_MODEL ** -0.5),
        'a_conv_w': nrm((DEPTH, CONV_W, A_CONV_CH), CONV_W ** -0.5),
        'a_A_log': jnp.log(jax.random.uniform(next(ks), (DEPTH, A_HEADS), F32, minval=1.0, maxval=16.0)),
        'a_dt_bias': dt0 + jnp.log(-jnp.expm1(-dt0)),
        'a_norm': gain((DEPTH, A_DV)),
        'b_lam_q1': nrm((DEPTH, B_DQK), 0.1),
        'b_lam_k1': nrm((DEPTH, B_DQK), 0.1),
        'b_lam_q2': nrm((DEPTH, B_DQK), 0.1),
        'b_lam_k2': nrm((DEPTH, B_DQK), 0.1),
        'b_norm': gain((DEPTH, B_DV)),
        'c_mu': jax.random.uniform(next(ks), (DEPTH, C_PROJ), F32),
        'c_w0': nrm((DEPTH, C_WIDTH), 0.5) - 0.5,
        'c_w_up': nrm((DEPTH, C_W_RANK, C_WIDTH), 0.5 * C_W_RANK ** -0.5),
        'c_a0': nrm((DEPTH, C_WIDTH), 0.1),
        'c_a_up': nrm((DEPTH, C_A_RANK, C_WIDTH), 0.5 * C_A_RANK ** -0.5),
        'c_g_up': nrm((DEPTH, C_G_RANK, C_WIDTH), C_G_RANK ** -0.5),
        'c_k_k': 0.85 + nrm((DEPTH, C_WIDTH), 0.02),
        'c_k_a': 1.0 + nrm((DEPTH, C_WIDTH), 0.02),
        'c_r_k': nrm((DEPTH, C_HEADS, C_HD), 0.1),
        'c_ln_w': gain((DEPTH, C_WIDTH)),
        'c_ln_b': nrm((DEPTH, C_WIDTH), 0.01),
        'w_out': nrm((DEPTH, MIX_WIDTH, D_MODEL), MIX_WIDTH ** -0.5),
        'norm_ffn': gain((DEPTH, D_MODEL)),
        'w_ff1': nrm((DEPTH, D_MODEL, D_FF), D_MODEL ** -0.5),
        'w_ff2': nrm((DEPTH, D_FF, D_MODEL), D_FF ** -0.5),
        'norm_ple': gain((DEPTH, D_MODEL)),
        'w_ple_gate': nrm((DEPTH, D_MODEL, D_MODEL), D_MODEL ** -0.5),
        'w_ple_proj': nrm((DEPTH, PLE_DIM, D_MODEL), PLE_DIM ** -0.5),
        'norm_final': gain((D_MODEL,)),
    }


def reference(x_prompt, x_sample, cache_b_k, cache_b_v, state_a_conv, state_a_delta,
              state_c_shift, state_c_wkv, p_prompt, p_sample,
              norm_mix, w_in, a_conv_w, a_A_log, a_dt_bias, a_norm,
              b_lam_q1, b_lam_k1, b_lam_q2, b_lam_k2, b_norm,
              c_mu, c_w0, c_w_up, c_a0, c_a_up, c_g_up, c_k_k, c_k_a, c_r_k, c_ln_w, c_ln_b,
              w_out, norm_ffn, w_ff1, w_ff2, norm_ple, w_ple_gate, w_ple_proj, norm_final):
    layer_params = (norm_mix, w_in, a_conv_w, a_A_log, a_dt_bias, a_norm,
                    b_lam_q1, b_lam_k1, b_lam_q2, b_lam_k2, b_norm,
                    c_mu, c_w0, c_w_up, c_a0, c_a_up, c_g_up, c_k_k, c_k_a, c_r_k, c_ln_w, c_ln_b,
                    w_out, norm_ffn, w_ff1, w_ff2, norm_ple, w_ple_gate, w_ple_proj)

    bp = x_prompt.shape[0]
    dt = x_prompt.dtype
    zk = jnp.zeros((DEPTH, bp, 0, B_HEADS, 2 * B_DQK), dt)
    zv = jnp.zeros((DEPTH, bp, 0, B_HEADS, B_DV), dt)
    zc = jnp.zeros((DEPTH, bp, CONV_W - 1, A_CONV_CH), dt)
    zd = jnp.zeros((DEPTH, bp, A_HEADS, A_DK, A_DV), dt)
    zs = jnp.zeros((DEPTH, bp, C_PROJ), dt)
    zw = jnp.zeros((DEPTH, bp, C_HEADS, C_HD, C_HD), dt)
    y_prompt, st_p = run_trunk(x_prompt, p_prompt, zk, zv, zc, zd, zs, zw, layer_params, norm_final)
    a_conv_p, a_delta_p, b_k_p, b_v_p, c_shift_p, c_wkv_p = st_p

    y_sample, st_s = run_trunk(x_sample, p_sample, cache_b_k, cache_b_v, state_a_conv, state_a_delta,
                               state_c_shift, state_c_wkv, layer_params, norm_final)
    a_conv_s, a_delta_s, b_k_s, b_v_s, c_shift_s, c_wkv_s = st_s

    return (y_prompt, y_sample,
            a_conv_p, a_delta_p, b_k_p, b_v_p, c_shift_p, c_wkv_p,
            a_conv_s, a_delta_s, b_k_s, b_v_s, c_shift_s, c_wkv_s)
```

```cpp
#include <hip/hip_runtime.h>
#include <hip/hip_cooperative_groups.h>
#include <cstdio>
#include <cstdint>
namespace cg = cooperative_groups;
namespace pg8 {
#define PG8_LAS __attribute__((address_space(3)))
typedef unsigned short bf16_t;
typedef short bf16x8 __attribute__((ext_vector_type(8)));
typedef float f32x4 __attribute__((ext_vector_type(4)));
typedef unsigned u32x4 __attribute__((ext_vector_type(4)));
constexpr int BM = 256, BK = 64, HALF = 128, HTB = HALF * BK * 2  , STAGE_BYTES = 8 * HTB, NXCD = 8, WGM = 8;

__host__ __device__ __forceinline__ int lds_byte(int r, int c) { const int st = (r >> 4) * 2 + (c >> 5), rr = r & 15, cc = c & 31, ob = rr * 64 + cc * 2; return st * 1024 + (ob ^ (((ob >> 9) & 1) << 5)); }
__host__ __device__ __forceinline__ void stage_rc(int b, int& R, int& C) { const int st = b / 1024, sb = b % 1024, swz = sb ^ (((sb >> 9) & 1) << 5); R = (st >> 1) * 16 + swz / 64; C = (st & 1) * 32 + (swz % 64) / 2; }
__host__ __device__ __forceinline__ int perm32(int rho) { const int n = rho >> 4, i = rho & 15; return 8 * (i >> 2) + 4 * n + (i & 3); }

struct Unit { int pm, pn; };
struct Gemm { const bf16_t* A; const bf16_t* Bt; int M, N, K; };

struct StaticOrder {
    int nM, nN, nwg, G, c;
    __host__ __device__ void init(int M, int N, int G_, int c_) { nM = M / BM; nN = N / BM; nwg = nM * nN; G = G_; c = c_; }
    __host__ __device__ bool next(int i, Unit& u) const {
        const long L = (long)i * G + c; if (L >= nwg) return false;
        int wgid = (int)L; { const int q = nwg / NXCD, r = nwg % NXCD, xcd = wgid % NXCD, off = wgid / NXCD; wgid = (xcd < r ? xcd * (q + 1) : r * (q + 1) + (xcd - r) * q) + off; }
        const int nig = WGM * nN, gid = wgid / nig, fm = gid * WGM, gsz = (nM - fm) < WGM ? (nM - fm) : WGM;
        u.pm = fm + ((wgid % nig) % gsz); u.pn = (wgid % nig) / gsz; return true;
    }
    __device__ __forceinline__ void a_ready(const Unit&) const {}
    __device__ __forceinline__ void done(const Unit&) const {}
};

__device__ __forceinline__ unsigned cvt_pk_bf16(float lo, float hi) { unsigned r; asm volatile("v_cvt_pk_bf16_f32 %0, %1, %2" : "=v"(r) : "v"(lo), "v"(hi)); return r; }
typedef float f32x2 __attribute__((ext_vector_type(2)));
__device__ __forceinline__ f32x2 gelu_pk(f32x2 v) {
    const f32x2 av = __builtin_elementwise_abs(v), d = av * 0.2316418882f + 1.0f;
    f32x2 t; t.x = __builtin_amdgcn_rcpf(d.x); t.y = __builtin_amdgcn_rcpf(d.y);
    f32x2 q = t * 0.5307027145f + (-0.7265760135f); q = q * t + 0.7107068705f; q = q * t + (-0.142248368f); q = q * t + 0.127414796f; q = q * t;
    const f32x2 s = (v * v) * (-0.72134752044f);
    f32x2 e; e.x = __builtin_amdgcn_exp2f(s.x); e.y = __builtin_amdgcn_exp2f(s.y);
    const f32x2 m = v * (q * e), r = v - m;
    f32x2 o; o.x = v.x < 0.f ? m.x : r.x; o.y = v.y < 0.f ? m.y : r.y; return o;
}

template <int ACT  > struct EpiBf16 {
    static constexpr bool PERM = true, AFTER_DRAIN = false; static_assert(ACT == 0 || ACT == 1, "EpiBf16: ACT is 0 (none) or 1 (gelu_pk)");
    bf16_t* O; int ldc; const float* bias; int split_cols; size_t split_stride; float scale0;
    __device__ __forceinline__ void operator()(const f32x4 (&acc)[2][2][4][2], const Unit& u, int wr, int wc, int fr, int fq) const {
        const int row0 = u.pm * BM + wr * 64 + fr; int colt = u.pn * BM; bf16_t* base = O;
        float sc = 1.f; if (split_cols) { const int t = colt / split_cols; base += (size_t)t * split_stride; colt -= t * split_cols; if (t == 0) sc = scale0; }
        const int col0 = colt + wc * 32 + 8 * fq, bcol0 = u.pn * BM + wc * 32 + 8 * fq;
        f32x4 bv[2][2];
#pragma unroll
        for (int bj = 0; bj < 2; ++bj)
#pragma unroll
            for (int n = 0; n < 2; ++n) bv[bj][n] = bias ? *(const f32x4*)(bias + bcol0 + bj * HALF + 4 * n) : (f32x4){0.f, 0.f, 0.f, 0.f};
#pragma unroll
        for (int ai = 0; ai < 2; ++ai)
#pragma unroll
            for (int m = 0; m < 4; ++m) { bf16_t* rowp = base + (size_t)(row0 + ai * HALF + m * 16) * ldc + col0;
#pragma unroll
                for (int bj = 0; bj < 2; ++bj) { f32x4 v0 = acc[ai][bj][m][0] + bv[bj][0], v1 = acc[ai][bj][m][1] + bv[bj][1];
                    if (ACT == 1) { f32x2 a = gelu_pk((f32x2){v0[0], v0[1]}), b = gelu_pk((f32x2){v0[2], v0[3]}), c = gelu_pk((f32x2){v1[0], v1[1]}), d = gelu_pk((f32x2){v1[2], v1[3]});
                        v0 = (f32x4){a.x, a.y, b.x, b.y}; v1 = (f32x4){c.x, c.y, d.x, d.y}; }
                    v0 = v0 * sc; v1 = v1 * sc; u32x4 w; w.x = cvt_pk_bf16(v0[0], v0[1]); w.y = cvt_pk_bf16(v0[2], v0[3]); w.z = cvt_pk_bf16(v1[0], v1[1]); w.w = cvt_pk_bf16(v1[2], v1[3]);
                    *(u32x4*)(rowp + bj * HALF) = w; } }
    }
};

struct PanelStats {
    unsigned* xbuf;
    unsigned* cnt;
    unsigned* tmo;
    int ntn; float eps;
    unsigned code;
    __device__ __forceinline__ bool run(const f32x4 (&v)[2][2][4][2], const Unit& u, int wr, int wc, int fr, int fq, PG8_LAS unsigned char* lds, int wid, int lane) const {
        typedef float f32x2v __attribute__((ext_vector_type(2)));
        PG8_LAS f32x2v* P = (PG8_LAS f32x2v*)lds;
        PG8_LAS f32x2v* S = (PG8_LAS f32x2v*)(lds + 8192);
        PG8_LAS unsigned* flag = (PG8_LAS unsigned*)(lds + 8192 + 2048);
#pragma unroll
        for (int ai = 0; ai < 2; ++ai)
#pragma unroll
            for (int m = 0; m < 4; ++m) {
                float s = 0.f;
#pragma unroll
                for (int bj = 0; bj < 2; ++bj)
#pragma unroll
                    for (int n = 0; n < 2; ++n) { const f32x4 x = v[ai][bj][m][n]; s += (x[0] + x[1]) + (x[2] + x[3]); }
                s += __shfl_xor(s, 16); s += __shfl_xor(s, 32);
                const float mw = s * (1.0f / 64.0f); float q = 0.f;
#pragma unroll
                for (int bj = 0; bj < 2; ++bj)
#pragma unroll
                    for (int n = 0; n < 2; ++n) { const f32x4 d = v[ai][bj][m][n] - mw; q += (d[0] * d[0] + d[1] * d[1]) + (d[2] * d[2] + d[3] * d[3]); }
                q += __shfl_xor(q, 16); q += __shfl_xor(q, 32);
                if (fq == 0) P[(ai * HALF + wr * 64 + m * 16 + fr) * 4 + wc] = (f32x2v){mw, q};
            }
        asm volatile("s_waitcnt lgkmcnt(0)" ::: "memory"); __builtin_amdgcn_s_barrier(); asm volatile("" ::: "memory");
#if defined(BROKEN_EXCHANGE_NO_WAIT)
#warning BROKEN CONTROL BUILD: the row-statistics exchange does not wait; results are wrong by design
        if (blockIdx.x >= 64) { const long long t0_ = clock64(); while (clock64() - t0_ < 60000) __builtin_amdgcn_s_sleep(8); }
#endif
        const int row = wid * 32 + (lane & 31);
        if (lane < 32) {
            const f32x2v a = P[row * 4 + 0], b = P[row * 4 + 1], c = P[row * 4 + 2], d = P[row * 4 + 3];
            const float mt = (a.x + b.x + c.x + d.x) * 0.25f;
            const float da = a.x - mt, db = b.x - mt, dc = c.x - mt, dd = d.x - mt;
            const float m2 = (a.y + b.y) + (c.y + d.y) + 64.0f * ((da * da + db * db) + (dc * dc + dd * dd));
            unsigned long long* slot = (unsigned long long*)xbuf + ((size_t)(u.pm * BM + row) * 4 + u.pn);
            __hip_atomic_store(slot, ((unsigned long long)__float_as_uint(m2) << 32) | __float_as_uint(mt), __ATOMIC_RELAXED, __HIP_MEMORY_SCOPE_AGENT);
        }
        asm volatile("s_waitcnt vmcnt(0)" ::: "memory");
        if (lane == 0) __hip_atomic_fetch_add(cnt + 64 * u.pm, 1u, __ATOMIC_RELAXED, __HIP_MEMORY_SCOPE_AGENT);
        if (wid == 0) {
            bool dead = false; const unsigned long long t0 = __builtin_amdgcn_s_memrealtime(); const unsigned want = 8u * (unsigned)ntn;
            for (;;) {
#if defined(BROKEN_EXCHANGE_NO_WAIT)
                break;
#endif
                if ((unsigned)__builtin_amdgcn_readfirstlane(__hip_atomic_load(cnt + 64 * u.pm, __ATOMIC_RELAXED, __HIP_MEMORY_SCOPE_AGENT)) >= want) break;
                if (__builtin_amdgcn_s_memrealtime() - t0 > 2000000ull) {
                    if (lane == 0) { unsigned expect = 0u; __hip_atomic_compare_exchange_strong(tmo + 1, &expect, code | (unsigned)(u.pm & 0xff), __ATOMIC_RELAXED, __ATOMIC_RELAXED, __HIP_MEMORY_SCOPE_AGENT);
                                     __hip_atomic_store(tmo, 1u, __ATOMIC_RELAXED, __HIP_MEMORY_SCOPE_AGENT); }
                    dead = true; break; }
                __builtin_amdgcn_s_sleep(2);
            }
            __builtin_amdgcn_fence(__ATOMIC_ACQUIRE, "agent");
            if (lane == 0) flag[0] = dead ? 1u : 0u;
        }
        asm volatile("s_waitcnt vmcnt(0) lgkmcnt(0)" ::: "memory"); __builtin_amdgcn_s_barrier(); asm volatile("" ::: "memory");
        const bool bad = flag[0] != 0u;
        if (lane < 32) {
            const unsigned long long* slot = (const unsigned long long*)xbuf + (size_t)(u.pm * BM + row) * 4; float mt[4], m2[4]; float ms = 0.f;
#pragma unroll
            for (int t = 0; t < 4; ++t) { if (t < ntn) { const unsigned long long w = __hip_atomic_load(slot + t, __ATOMIC_RELAXED, __HIP_MEMORY_SCOPE_AGENT); mt[t] = __uint_as_float((unsigned)w); m2[t] = __uint_as_float((unsigned)(w >> 32)); } else { mt[t] = 0.f; m2[t] = 0.f; } ms += mt[t]; }
            const float mean = ms / (float)ntn; float q = 0.f;
#pragma unroll
            for (int t = 0; t < 4; ++t) if (t < ntn) { const float dm = mt[t] - mean; q += m2[t] + 256.0f * dm * dm; }
            S[row] = (f32x2v){mean, 1.0f / sqrtf(q / (256.0f * (float)ntn) + eps)};
        }
        asm volatile("s_waitcnt lgkmcnt(0)" ::: "memory"); __builtin_amdgcn_s_barrier(); asm volatile("" ::: "memory");
        return bad;
    }
};
struct EpiLnRes {
    static constexpr bool PERM = false, AFTER_DRAIN = true;
    const float* base; float* out; int ldc; const float* bias; PanelStats st; unsigned poison;
    __device__ __forceinline__ void fused(f32x4 (&acc)[2][2][4][2], const Unit& u, int wr, int wc, int fr, int fq, PG8_LAS unsigned char* lds, int wid, int lane) const {
        typedef float f32x2v __attribute__((ext_vector_type(2)));
        const PG8_LAS f32x2v* S = (const PG8_LAS f32x2v*)(lds + 8192);
        const int col0 = u.pn * BM + wc * 32 + 4 * fq;
#pragma unroll
        for (int bj = 0; bj < 2; ++bj)
#pragma unroll
            for (int n = 0; n < 2; ++n) { const f32x4 bv = bias ? *(const f32x4*)(bias + col0 + bj * HALF + n * 16) : (f32x4){0.f, 0.f, 0.f, 0.f};
#pragma unroll
                for (int ai = 0; ai < 2; ++ai)
#pragma unroll
                    for (int m = 0; m < 4; ++m) acc[ai][bj][m][n] += bv; }
        f32x4 pre[4][2][2];
#pragma unroll
        for (int m = 0; m < 4; ++m) { const size_t off = (size_t)(u.pm * BM + wr * 64 + m * 16 + fr) * ldc + col0;
#pragma unroll
            for (int bj = 0; bj < 2; ++bj)
#pragma unroll
                for (int n = 0; n < 2; ++n) pre[m][bj][n] = *(const f32x4*)(base + off + bj * HALF + n * 16); }
        const bool bad = st.run(acc, u, wr, wc, fr, fq, lds, wid, lane) || poison != 0u;
        const float qnan = __builtin_nanf("");
#pragma unroll
        for (int ai = 0; ai < 2; ++ai)
#pragma unroll
            for (int m = 0; m < 4; ++m) { const int r = ai * HALF + wr * 64 + m * 16 + fr; const f32x2v sr = S[r]; const size_t off = (size_t)(u.pm * BM + r) * ldc + col0;
#pragma unroll
                for (int bj = 0; bj < 2; ++bj)
#pragma unroll
                    for (int n = 0; n < 2; ++n) { const f32x4 bs = ai == 0 ? pre[m][bj][n] : *(const f32x4*)(base + off + bj * HALF + n * 16); f32x4 o = bs + (acc[ai][bj][m][n] - sr.x) * sr.y;
                        if (bad) o = (f32x4){qnan, qnan, qnan, qnan}; *(f32x4*)(out + off + bj * HALF + n * 16) = o; }
                if (m & 1) asm volatile("" ::: "memory"); }
    }
};
struct EpiLnResLn {
    static constexpr bool PERM = false, AFTER_DRAIN = true;
    const float* base; float* out; bf16_t* xn; int ldc; const float* bias; PanelStats st1, st2; unsigned poison;
    __device__ __forceinline__ void fused(f32x4 (&acc)[2][2][4][2], const Unit& u, int wr, int wc, int fr, int fq, PG8_LAS unsigned char* lds, int wid, int lane) const {
        typedef float f32x2v __attribute__((ext_vector_type(2))); typedef unsigned u32x2v __attribute__((ext_vector_type(2)));
        const PG8_LAS f32x2v* S = (const PG8_LAS f32x2v*)(lds + 8192);
        const int col0 = u.pn * BM + wc * 32 + 4 * fq;
#pragma unroll
        for (int bj = 0; bj < 2; ++bj)
#pragma unroll
            for (int n = 0; n < 2; ++n) { const f32x4 bv = bias ? *(const f32x4*)(bias + col0 + bj * HALF + n * 16) : (f32x4){0.f, 0.f, 0.f, 0.f};
#pragma unroll
                for (int ai = 0; ai < 2; ++ai)
#pragma unroll
                    for (int m = 0; m < 4; ++m) acc[ai][bj][m][n] += bv; }
        bool bad = st1.run(acc, u, wr, wc, fr, fq, lds, wid, lane) || poison != 0u;
        const float qnan = __builtin_nanf("");
#pragma unroll
        for (int ai = 0; ai < 2; ++ai)
#pragma unroll
            for (int m = 0; m < 4; ++m) { const int r = ai * HALF + wr * 64 + m * 16 + fr; const f32x2v sr = S[r]; const size_t off = (size_t)(u.pm * BM + r) * ldc + col0;
#pragma unroll
                for (int bj = 0; bj < 2; ++bj)
#pragma unroll
                    for (int n = 0; n < 2; ++n) { const f32x4 bs = *(const f32x4*)(base + off + bj * HALF + n * 16); acc[ai][bj][m][n] = bs + (acc[ai][bj][m][n] - sr.x) * sr.y; }
                asm volatile("" : "+v"(acc[ai][0][m][0]), "+v"(acc[ai][0][m][1]), "+v"(acc[ai][1][m][0]), "+v"(acc[ai][1][m][1]));
                if (m & 1) asm volatile("" ::: "memory"); }
        const bool bad1 = bad;
        bad = st2.run(acc, u, wr, wc, fr, fq, lds, wid, lane) || bad;
#pragma unroll
        for (int ai = 0; ai < 2; ++ai)
#pragma unroll
            for (int m = 0; m < 4; ++m) { const int r = ai * HALF + wr * 64 + m * 16 + fr; const f32x2v sr = S[r]; const size_t off = (size_t)(u.pm * BM + r) * ldc + col0;
#pragma unroll
                for (int bj = 0; bj < 2; ++bj)
#pragma unroll
                    for (int n = 0; n < 2; ++n) { const f32x4 x1 = acc[ai][bj][m][n]; *(f32x4*)(out + off + bj * HALF + n * 16) = bad1 ? (f32x4){qnan, qnan, qnan, qnan} : x1;
                        const f32x4 o = (x1 - sr.x) * sr.y; u32x2v w; w.x = cvt_pk_bf16(o[0], o[1]); w.y = cvt_pk_bf16(o[2], o[3]);
                        if (bad) { w.x = 0x7fc07fc0u; w.y = 0x7fc07fc0u; } *(u32x2v*)(xn + off + bj * HALF + n * 16) = w; }
                asm volatile("" ::: "memory"); }
    }
};

template <class Epi, class Sched, bool ALIGN_EPI = false, bool SP2 = false>
__device__ __forceinline__ void gemm_phase(PG8_LAS unsigned char* lds, const Gemm g, const Sched& S, const Epi& E, const int wv_) {
    int tid_o = wv_ * 64 + (int)__builtin_amdgcn_mbcnt_hi(~0u, __builtin_amdgcn_mbcnt_lo(~0u, 0u)); asm volatile("" : "+v"(tid_o)); tid_o &= 511;
    const int tid = tid_o, wid = __builtin_amdgcn_readfirstlane(tid >> 6), lane = tid & 63, wr = wid >> 2, wc = wid & 3, fr = lane & 15, fq = lane >> 4;
    const int K = g.K, nt = K / BK;
    unsigned voffA[2], voffB[2];
#pragma unroll
    for (int i = 0; i < 2; ++i) { int R, C; stage_rc(tid * 16 + i * 8192, R, C); const int Rb = Epi::PERM ? ((R & ~31) + perm32(R & 31)) : R;
        voffA[i] = (unsigned)(R * K + C) * 2u; voffB[i] = (unsigned)(Rb * K + C) * 2u; }
    const size_t kstep = (size_t)(BK * 2);
    const size_t hstep = (size_t)HALF * K * 2;
    const size_t tstep = 2 * hstep;
    const unsigned ldsw = (unsigned)wid * 1024u;
    const int aoff = lds_byte(wr * 64 + fr, fq * 8), boff = lds_byte(wc * 32 + fr, fq * 8);
#define PG8_SA(b, h) (((b) * 2 + (h)) * HTB)
#define PG8_SB(b, h) ((4 + (b) * 2 + (h)) * HTB)
#define PG8_STAGE(bufoff, gbase, voff) do { _Pragma("unroll") for (int _i = 0; _i < 2; ++_i) \
        __builtin_amdgcn_global_load_lds((const unsigned*)((const char*)(gbase) + (voff)[_i]), (PG8_LAS unsigned*)(lds + (bufoff) + ldsw + _i * 8192), 16, 0, 0); } while (0)
#define PG8_LDA(dst, b, h) do { _Pragma("unroll") for (int m = 0; m < 4; ++m) _Pragma("unroll") for (int k = 0; k < 2; ++k) dst[m][k] = *(const PG8_LAS bf16x8*)(lds + PG8_SA(b, h) + aoff + m * 2048 + k * 1024); } while (0)
#define PG8_LDB(dst, b, h) do { _Pragma("unroll") for (int n = 0; n < 2; ++n) _Pragma("unroll") for (int k = 0; k < 2; ++k) dst[n][k] = *(const PG8_LAS bf16x8*)(lds + PG8_SB(b, h) + boff + n * 2048 + k * 1024); } while (0)
#define PG8_MMA(ai, bj, At, Bt) do { __builtin_amdgcn_s_setprio(1); _Pragma("unroll") for (int m = 0; m < 4; ++m) _Pragma("unroll") for (int n = 0; n < 2; ++n) _Pragma("unroll") for (int k = 0; k < 2; ++k) \
        acc[ai][bj][m][n] = __builtin_amdgcn_mfma_f32_16x16x32_bf16(Bt[n][k], At[m][k], acc[ai][bj][m][n], 0, 0, 0); __builtin_amdgcn_s_setprio(0); } while (0)
#define PG8_WAIT_V(n) asm volatile("s_waitcnt vmcnt(" #n ")" ::: "memory")
#define PG8_WAIT_L(n) asm volatile("s_waitcnt lgkmcnt(" #n ")" ::: "memory")
#define PG8_BAR __builtin_amdgcn_s_barrier()
#define PG8_SCHED __builtin_amdgcn_sched_barrier(0)
    Unit cur, nxt; int ui = 0;
    if (!S.next(0, cur)) return;
    f32x4 acc[2][2][4][2];
#pragma unroll
    for (int a = 0; a < 2; ++a)
#pragma unroll
        for (int b = 0; b < 2; ++b)
#pragma unroll
            for (int m = 0; m < 4; ++m)
#pragma unroll
                for (int n = 0; n < 2; ++n) acc[a][b][m][n] = (f32x4){0.f, 0.f, 0.f, 0.f};
    bf16x8 At[4][2], B0[2][2], B1[2][2];
    const char* cA = (const char*)g.A + (size_t)cur.pm * tstep; const char* cB = (const char*)g.Bt + (size_t)cur.pn * tstep;
    S.a_ready(cur);
    if constexpr (SP2) {
        PG8_STAGE(PG8_SB(0, 0), cB, voffB); PG8_STAGE(PG8_SB(0, 1), cB + hstep, voffB); PG8_STAGE(PG8_SA(0, 0), cA, voffA); PG8_STAGE(PG8_SA(0, 1), cA + hstep, voffA);
        if (wr == 1) PG8_BAR;
        PG8_WAIT_V(2); PG8_BAR;
        PG8_STAGE(PG8_SB(1, 0), cB + kstep, voffB); PG8_STAGE(PG8_SA(1, 0), cA + kstep, voffA); PG8_STAGE(PG8_SB(1, 1), cB + hstep + kstep, voffB);
        PG8_WAIT_V(6); PG8_BAR;
    } else {
        PG8_STAGE(PG8_SB(0, 0), cB, voffB); PG8_STAGE(PG8_SA(0, 0), cA, voffA); PG8_STAGE(PG8_SB(0, 1), cB + hstep, voffB); PG8_STAGE(PG8_SA(0, 1), cA + hstep, voffA);
        if (wr == 1) PG8_BAR;
        PG8_WAIT_V(4); PG8_BAR;
        PG8_STAGE(PG8_SB(1, 0), cB + kstep, voffB); PG8_STAGE(PG8_SA(1, 0), cA + kstep, voffA); PG8_STAGE(PG8_SB(1, 1), cB + hstep + kstep, voffB);
        PG8_WAIT_V(6); PG8_BAR;
    }
    for (;;) {
        const bool has_next = S.next(ui + 1, nxt);
        const char* nA = has_next ? (const char*)g.A + (size_t)nxt.pm * tstep : cA; const char* nB = has_next ? (const char*)g.Bt + (size_t)nxt.pn * tstep : cB;
        for (int t = 0; t < nt; t += 2) {
            const bool last = (t == nt - 2);
            const char* a1 = cA + (size_t)(t + 1) * kstep;
            const char* a2 = last ? nA : cA + (size_t)(t + 2) * kstep; const char* b2 = last ? nB : cB + (size_t)(t + 2) * kstep;
            const char* a3 = a2 + kstep; const char* b3 = b2 + kstep;
            if (last && has_next) S.a_ready(nxt);
            if constexpr (SP2) {
            PG8_LDB(B0, 0, 0); PG8_LDB(B1, 0, 1); PG8_SCHED; PG8_LDA(At, 0, 0); PG8_STAGE(PG8_SA(1, 1), a1 + hstep, voffA);
            PG8_WAIT_V(8); PG8_WAIT_L(0); PG8_BAR; PG8_MMA(0, 0, At, B0); PG8_MMA(0, 1, At, B1); PG8_BAR; PG8_SCHED;
            PG8_LDA(At, 0, 1); PG8_STAGE(PG8_SB(0, 0), b2, voffB); PG8_STAGE(PG8_SB(0, 1), b2 + hstep, voffB); PG8_STAGE(PG8_SA(0, 0), a2, voffA);
            PG8_WAIT_V(8); PG8_WAIT_L(0); PG8_BAR; PG8_MMA(1, 0, At, B0); PG8_MMA(1, 1, At, B1); PG8_BAR; PG8_SCHED;
            PG8_LDB(B0, 1, 0); PG8_LDB(B1, 1, 1); PG8_SCHED; PG8_LDA(At, 1, 0); PG8_STAGE(PG8_SA(0, 1), a2 + hstep, voffA);
            PG8_WAIT_V(8); PG8_WAIT_L(0); PG8_BAR; PG8_MMA(0, 0, At, B0); PG8_MMA(0, 1, At, B1); PG8_BAR; PG8_SCHED;
            PG8_LDA(At, 1, 1); PG8_STAGE(PG8_SB(1, 0), b3, voffB); PG8_STAGE(PG8_SB(1, 1), b3 + hstep, voffB); PG8_STAGE(PG8_SA(1, 0), a3, voffA);
            PG8_WAIT_V(8); PG8_WAIT_L(0); PG8_BAR; PG8_MMA(1, 0, At, B0); PG8_MMA(1, 1, At, B1); PG8_BAR; PG8_SCHED;
            } else {
            PG8_LDB(B0, 0, 0); PG8_SCHED; PG8_LDA(At, 0, 0); PG8_STAGE(PG8_SA(1, 1), a1 + hstep, voffA);
            PG8_WAIT_L(8); PG8_BAR; PG8_WAIT_L(0); PG8_MMA(0, 0, At, B0); PG8_BAR; PG8_SCHED;
            PG8_LDB(B1, 0, 1); PG8_STAGE(PG8_SB(0, 0), b2, voffB);
            PG8_BAR; PG8_WAIT_L(0); PG8_MMA(0, 1, At, B1); PG8_BAR;
            PG8_LDA(At, 0, 1); PG8_STAGE(PG8_SA(0, 0), a2, voffA);
            PG8_BAR; PG8_WAIT_L(0); PG8_MMA(1, 0, At, B0); PG8_BAR; PG8_SCHED;
            PG8_STAGE(PG8_SB(0, 1), b2 + hstep, voffB);
            PG8_WAIT_V(6); PG8_BAR; PG8_MMA(1, 1, At, B1); PG8_BAR;
            PG8_LDB(B0, 1, 0); PG8_SCHED; PG8_LDA(At, 1, 0); PG8_STAGE(PG8_SA(0, 1), a2 + hstep, voffA);
            PG8_WAIT_L(8); PG8_BAR; PG8_WAIT_L(0); PG8_MMA(0, 0, At, B0); PG8_BAR; PG8_SCHED;
            PG8_LDB(B1, 1, 1); PG8_STAGE(PG8_SB(1, 0), b3, voffB);
            PG8_BAR; PG8_WAIT_L(0); PG8_MMA(0, 1, At, B1); PG8_BAR;
            PG8_LDA(At, 1, 1); PG8_STAGE(PG8_SA(1, 0), a3, voffA);
            PG8_BAR; PG8_WAIT_L(0); PG8_MMA(1, 0, At, B0); PG8_BAR; PG8_SCHED;
            PG8_STAGE(PG8_SB(1, 1), b3 + hstep, voffB);
            PG8_WAIT_V(6); PG8_BAR; PG8_MMA(1, 1, At, B1); PG8_BAR;
            }
        }
        if constexpr (ALIGN_EPI) { if (wr == 0) PG8_BAR; }
        if constexpr (!Epi::AFTER_DRAIN) { E(acc, cur, wr, wc, fr, fq); S.done(cur); }
        if (!has_next) break;
#pragma unroll
        for (int a = 0; a < 2; ++a)
#pragma unroll
            for (int b = 0; b < 2; ++b)
#pragma unroll
                for (int m = 0; m < 4; ++m)
#pragma unroll
                    for (int n = 0; n < 2; ++n) acc[a][b][m][n] = (f32x4){0.f, 0.f, 0.f, 0.f};
        cur = nxt; cA = nA; cB = nB; ++ui;
        if constexpr (ALIGN_EPI) { if (wr == 1) PG8_BAR; }
    }
    PG8_WAIT_V(0);
    if constexpr (!ALIGN_EPI) { if (wr == 0) PG8_BAR; }
    PG8_BAR;
    if constexpr (Epi::AFTER_DRAIN) { E.fused(acc, cur, wr, wc, fr, fq, lds, wid, lane); S.done(cur); }
#undef PG8_SA
#undef PG8_SB
#undef PG8_STAGE
#undef PG8_LDA
#undef PG8_LDB
#undef PG8_MMA
#undef PG8_WAIT_V
#undef PG8_WAIT_L
#undef PG8_BAR
#undef PG8_SCHED
}
}
#include <hip/hip_bf16.h>
#include <cmath>
namespace attn_body {
using bf16=__hip_bfloat16;
using bf16x8=__attribute__((ext_vector_type(8)))short;
using s16x4=__attribute__((ext_vector_type(4)))short;
using f32x16=__attribute__((ext_vector_type(16)))float;
using u32x4=__attribute__((ext_vector_type(4)))unsigned;
constexpr int BATCH=8,NHEAD=16,SEQ=8192,D=64,DM=NHEAD*D,DMI=512,DMO=1024;
constexpr int NW=8,QBLK=32,QB=QBLK*NW,KVBLK=64,NQB=SEQ/QB;
constexpr int ATTN_PITCH=DM, ATTN_UNIT_ROWS=QB;
__device__ __forceinline__ int crow(int r,int hi){return (r&3)+8*(r>>2)+4*hi;}
#define SBAR() __builtin_amdgcn_sched_barrier(0)
__device__ __forceinline__ void cmask(f32x16&p0,f32x16&p1,int jb,int qrel,int hi){
  const float NEG=-INFINITY; int kb=64*jb+4*hi;
  #pragma unroll
  for(int r=0;r<16;++r){ if(jb>(qrel>>6)){p0[r]=NEG;p1[r]=NEG;} } (void)kb;
}

constexpr int NSLOT=3, SLOTB=8192;
constexpr int LDS_K=0, LDS_V=NSLOT*SLOTB, LDS_WS=2*NSLOT*SLOTB, LDS_OST=LDS_WS+NW*64*4, LDS_BYTES=LDS_OST+NW*4096;
constexpr float C2=0.125f*1.4426950408889634f;
__device__ __forceinline__ void glds16(const void*gsrc,unsigned lds_dst){unsigned keep;
  asm volatile("s_mov_b32 %0, m0\n\ts_mov_b32 m0, %2\n\ts_nop 0\n\tglobal_load_lds_dwordx4 %1, off\n\ts_mov_b32 m0, %0":"=&s"(keep):"v"(gsrc),"s"(lds_dst):"memory");}
__device__ __forceinline__ float max3f(float a,float b,float c){float r;asm("v_max3_f32 %0, %1, %2, %3":"=v"(r):"v"(a),"v"(b),"v"(c));return r;}
__device__ __forceinline__ float max2f(float a,float b){float r;asm("v_max_f32_e32 %0, %1, %2":"=v"(r):"v"(a),"v"(b));return r;}
__device__ __forceinline__ float fadd_s(float a,float b){float r;asm("v_add_f32_e32 %0, %1, %2":"=v"(r):"v"(a),"v"(b));return r;}
__device__ __forceinline__ float fsub_s(float a,float b){float r;asm("v_sub_f32_e32 %0, %1, %2":"=v"(r):"v"(a),"v"(b));return r;}
typedef float f32x2_t __attribute__((ext_vector_type(2))); typedef __bf16 bf16x2_t __attribute__((ext_vector_type(2)));
__device__ __forceinline__ unsigned cvtpk_s(float lo,float hi){f32x2_t v={lo,hi};bf16x2_t b=__builtin_convertvector(v,bf16x2_t);return __builtin_bit_cast(unsigned,b);}
#define WAIT_BAR(N) asm volatile("s_waitcnt vmcnt(" #N ") lgkmcnt(0)\n\ts_barrier":::"memory")

__device__ __forceinline__ void qkt(f32x16&p0,f32x16&p1,const char*Kslot,const bf16x8*qr,const f32x16&negm,int r32,int hi){
  const char*kb=Kslot+hi*1024+r32*16;
  #pragma unroll
  for(int d0=0;d0<4;++d0){
    const bf16x8 b0=*reinterpret_cast<const bf16x8*>(kb+d0*2048);
    const bf16x8 b1=*reinterpret_cast<const bf16x8*>(kb+d0*2048+512);
    if(d0==0){p0=__builtin_amdgcn_mfma_f32_32x32x16_bf16(b0,qr[0],negm,0,0,0);p1=__builtin_amdgcn_mfma_f32_32x32x16_bf16(b1,qr[0],negm,0,0,0);}
    else{p0=__builtin_amdgcn_mfma_f32_32x32x16_bf16(b0,qr[d0],p0,0,0,0);p1=__builtin_amdgcn_mfma_f32_32x32x16_bf16(b1,qr[d0],p1,0,0,0);}}
}
typedef __attribute__((address_space(3))) const char* lds_cptr;
typedef short v4i16_t __attribute__((ext_vector_type(4)));
__device__ __forceinline__ void kload8(bf16x8*kf,lds_cptr kp){
  kf[0]=*(const __attribute__((address_space(3))) bf16x8*)(kp);      kf[1]=*(const __attribute__((address_space(3))) bf16x8*)(kp+512);
  kf[2]=*(const __attribute__((address_space(3))) bf16x8*)(kp+2048); kf[3]=*(const __attribute__((address_space(3))) bf16x8*)(kp+2560);
  kf[4]=*(const __attribute__((address_space(3))) bf16x8*)(kp+4096); kf[5]=*(const __attribute__((address_space(3))) bf16x8*)(kp+4608);
  kf[6]=*(const __attribute__((address_space(3))) bf16x8*)(kp+6144); kf[7]=*(const __attribute__((address_space(3))) bf16x8*)(kp+6656);
}
__device__ __forceinline__ void kload2(bf16x8*kf,lds_cptr kp,int j){ kf[2*j]=*(const __attribute__((address_space(3))) bf16x8*)(kp+j*2048); kf[2*j+1]=*(const __attribute__((address_space(3))) bf16x8*)(kp+j*2048+512); }
__device__ __forceinline__ s16x4 vtr(lds_cptr p){ return __builtin_bit_cast(s16x4,__builtin_amdgcn_ds_read_tr16_b64_v4i16((__attribute__((address_space(3))) v4i16_t*)p)); }
__device__ __forceinline__ float rowmax(const f32x16&p0,const f32x16&p1){
  float a=max3f(p0[0],p0[1],p1[0]),b=max3f(p0[2],p0[3],p1[1]);a=max3f(a,p1[2],p1[3]);
  #pragma unroll
  for(int r=4;r<16;r+=4){a=max3f(a,p0[r],p0[r+1]);b=max3f(b,p0[r+2],p0[r+3]);a=max3f(a,p1[r],p1[r+1]);b=max3f(b,p1[r+2],p1[r+3]);}
  const float m=max2f(a,b);
  auto rr=__builtin_amdgcn_permlane32_swap(__float_as_uint(m),__float_as_uint(m),false,false);
  return max2f(__uint_as_float(rr[0]),__uint_as_float(rr[1]));
}
__device__ __forceinline__ void pv(f32x16*o,int vb,bf16x8 pa0,bf16x8 pa1,bf16x8 pa2,bf16x8 pa3){
  #pragma unroll
  for(int d0=0;d0<2;++d0){s16x4 lo[4],hi[4];
    #pragma unroll
    for(int ks=0;ks<4;++ks){
      asm volatile("ds_read_b64_tr_b16 %0,%1 offset:%c2":"=&v"(lo[ks]):"v"(vb),"i"(d0*4096+ks*1024):"memory");
      asm volatile("ds_read_b64_tr_b16 %0,%1 offset:%c2":"=&v"(hi[ks]):"v"(vb),"i"(d0*4096+ks*1024+512):"memory");}
    asm volatile("s_waitcnt lgkmcnt(0)":::"memory");SBAR();
    #define PK(k) (bf16x8){lo[k][0],lo[k][1],lo[k][2],lo[k][3],hi[k][0],hi[k][1],hi[k][2],hi[k][3]}
    o[d0]=__builtin_amdgcn_mfma_f32_32x32x16_bf16(pa0,PK(0),o[d0],0,0,0);
    o[d0]=__builtin_amdgcn_mfma_f32_32x32x16_bf16(pa1,PK(1),o[d0],0,0,0);
    o[d0]=__builtin_amdgcn_mfma_f32_32x32x16_bf16(pa2,PK(2),o[d0],0,0,0);
    o[d0]=__builtin_amdgcn_mfma_f32_32x32x16_bf16(pa3,PK(3),o[d0],0,0,0);
    #undef PK
  }
}

#ifndef ATTN_STORE16
#define ATTN_STORE16(p,v) (*(u32x4*)(p)=(v))
#endif
template<int THRL> __device__ __forceinline__ void attn_unit(int b,int h,int qb,const bf16*Q,const bf16*__restrict__ K,const bf16*__restrict__ V,bf16*O,char*shm,const int wv_){
  int tid_o=wv_*64+(int)__builtin_amdgcn_mbcnt_hi(~0u,__builtin_amdgcn_mbcnt_lo(~0u,0u)); asm volatile("":"+v"(tid_o)); tid_o&=511;
  const int tid=tid_o,lane=tid&63,r32=lane&31,hi=lane>>5; const int wid=__builtin_amdgcn_readfirstlane(tid>>6);
  const long rowbase=(long)b*SEQ; const int q0=qb*QB;
  const bf16*Qw=Q+(rowbase+q0+wid*QBLK)*DMI+(h>>1)*D;
  const bf16*Kh=K+rowbase*DMI+(h>>1)*D,*Vh=V+rowbase*DMI+(h>>2)*128+(h&1)*64;
  const unsigned lds0=(unsigned)(uintptr_t)shm;
  float*wsf=(float*)(shm+LDS_WS)+wid*64;
  const bf16*ksrc=Kh+(long)lane*DMI+wid*8;
  const bf16*vsrc=Vh+(long)(16*(wid&3)+(lane>>2))*DMI+(wid>>2)*32+(lane&3)*8;
  const unsigned kdst=lds0+LDS_K+wid*1024, vdst=lds0+LDS_V+wid*1024;
  #define DMA_K(t,slot) glds16(ksrc+(long)(t)*KVBLK*DMI,(unsigned)__builtin_amdgcn_readfirstlane(kdst+(slot)))
  #define DMA_V(t,slot) glds16(vsrc+(long)(t)*KVBLK*DMI,(unsigned)__builtin_amdgcn_readfirstlane(vdst+(slot)))
  const int vb0=(int)(lds0+LDS_V)+((lane>>4)&1)*32+(lane&3)*8+(4*hi+((lane&15)>>2))*64;
  const char*Kbase=shm+LDS_K; bf16x8 kf[8];
  const lds_cptr shm3=(lds_cptr)shm; const lds_cptr kp0=shm3+LDS_K+hi*1024+r32*16; const lds_cptr vp0=shm3+LDS_V+((lane>>4)&1)*32+(lane&3)*8+(4*hi+((lane&15)>>2))*64;
  const int NT=(q0+QB)/KVBLK;
  DMA_K(0,0);DMA_V(0,0);DMA_K(1,SLOTB);
  bf16x8 qr[4];
  #pragma unroll
  for(int d0=0;d0<4;++d0)qr[d0]=*reinterpret_cast<const bf16x8*>(&Qw[(long)r32*DMI+d0*16+hi*8]);
  float mhat=0.f,l_reg=0.f;f32x16 o[2];o[0]=f32x16{};o[1]=f32x16{};f32x16 negm=f32x16{};asm volatile("":"+v"(negm));
  const int qrel=wid*QBLK+r32;
  #define CMASK(P0,P1,t) do{int jb_=(t)-(NT-4); if(jb_>=0)cmask(P0,P1,jb_,qrel,hi);}while(0)
  bool resc=false;
  #define START(P0,P1) do{ const float rm=rowmax(P0,P1); resc=false; \
    { const float dl=rm; mhat=fadd_s(mhat,dl); \
      _Pragma("unroll") for(int r=0;r<16;++r){P0[r]=fsub_s(P0[r],dl);P1[r]=fsub_s(P1[r],dl);} \
      _Pragma("unroll") for(int r=0;r<16;++r)negm[r]=-mhat; asm volatile("":"+v"(negm)); } \
    _Pragma("unroll") for(int r=0;r<16;++r)P0[r]=__builtin_amdgcn_exp2f(P0[r]); }while(0)
  #define RESC() do{ if(resc){ asm volatile("s_waitcnt lgkmcnt(0)":::"memory"); \
      _Pragma("unroll") for(int d_=0;d_<2;++d_) _Pragma("unroll") for(int r=0;r<16;++r)o[d_][r]*=wsf[crow(r,hi)]; } }while(0)
  f32x16 pA0,pA1,pB0,pB1;
  int sl_prev=0,sl_cur=0,sl_next=SLOTB;
  #define ROT() do{sl_prev=sl_cur;sl_cur=sl_next;sl_next=(sl_next==(NSLOT-1)*SLOTB)?0:sl_next+SLOTB;}while(0)
  DMA_K(2,2*SLOTB);
  WAIT_BAR(3);
  qkt(pA0,pA1,Kbase,qr,negm,r32,hi);asm volatile("s_nop 15\n\ts_nop 7":"+v"(pA0),"+v"(pA1));CMASK(pA0,pA1,0);
  START(pA0,pA1);
  _Pragma("unroll") for(int r=0;r<16;++r)pA1[r]=__builtin_amdgcn_exp2f(pA1[r]);
  WAIT_BAR(0);
  DMA_K(3,0);DMA_V(1,SLOTB);
  ROT();
  kload8(kf,kp0+sl_cur);
  WAIT_BAR(2);
  s16x4 vlo[8],vhi[8]; u32x4 pw0,pw1,pw2,pw3;
  #define PKW(P,B) cvtpk_s(P[B],P[B+1])
  #define PAF(k) __builtin_bit_cast(bf16x8,pw##k)
  #define VFR(i) (bf16x8){vlo[i][0],vlo[i][1],vlo[i][2],vlo[i][3],vhi[i][0],vhi[i][1],vhi[i][2],vhi[i][3]}
  #define PIN(x) asm volatile("":"+v"(x))
  #define MX3(a,b,c) __builtin_fmaxf(__builtin_fmaxf((a),(b)),(c))
  #define GAPA(MF,A0,A1,A2,A3,W0,W1,PW) do{ MF; sacc+=A0; sacc+=A1; sacc+=A2; sacc+=A3; PIN(sacc); W0; W1; PIN(PW); SBAR(); }while(0)
  #define EX(v) __builtin_amdgcn_exp2f(v)
  #define GAPB(MF,X,B) do{ MF; X[B]=EX(X[B]); X[B+1]=EX(X[B+1]); X[B+2]=EX(X[B+2]); X[B+3]=EX(X[B+3]); PIN(X); SBAR(); }while(0)
  #define VRD(i) do{ vlo[i]=vtr(vp_+(((i)>>2)*4096+((i)&3)*1024)); vhi[i]=vtr(vp_+(((i)>>2)*4096+((i)&3)*1024+512)); }while(0)
  #define KRD(G,j) do{ if(G){ kload2(kf,kp0+sl_next,j); SBAR(); } }while(0)
  #define STEP(C0,C1,P0,P1,t,GK,GV,GL) do{ SBAR(); \
    const lds_cptr vp_=vp0+sl_prev; \
    VRD(0); SBAR(); float sacc=(P0[0]+P0[1]); \
    GAPA(C0=__builtin_amdgcn_mfma_f32_32x32x16_bf16(kf[0],qr[0],negm,0,0,0), P0[2],P0[3],P0[4],P0[5],     pw0[0]=PKW(P0,0), pw0[1]=PKW(P0,2), pw0); \
    VRD(4); SBAR(); GAPA(C1=__builtin_amdgcn_mfma_f32_32x32x16_bf16(kf[1],qr[0],negm,0,0,0), P0[6],P0[7],P0[8],P0[9],     pw0[2]=PKW(P0,4), pw0[3]=PKW(P0,6), pw0); \
    VRD(1); SBAR(); GAPA(C0=__builtin_amdgcn_mfma_f32_32x32x16_bf16(kf[2],qr[1],C0,0,0,0),   P0[10],P0[11],P0[12],P0[13], pw1[0]=PKW(P0,8), pw1[1]=PKW(P0,10), pw1); \
    VRD(5); SBAR(); GAPA(C1=__builtin_amdgcn_mfma_f32_32x32x16_bf16(kf[3],qr[1],C1,0,0,0),   P0[14],P0[15],P1[0],P1[1],   pw1[2]=PKW(P0,12),pw1[3]=PKW(P0,14), pw1); \
    VRD(2); SBAR(); GAPA(C0=__builtin_amdgcn_mfma_f32_32x32x16_bf16(kf[4],qr[2],C0,0,0,0),   P1[2],P1[3],P1[4],P1[5],     pw2[0]=PKW(P1,0), pw2[1]=PKW(P1,2), pw2); \
    VRD(6); SBAR(); GAPA(C1=__builtin_amdgcn_mfma_f32_32x32x16_bf16(kf[5],qr[2],C1,0,0,0),   P1[6],P1[7],P1[8],P1[9],     pw2[2]=PKW(P1,4), pw2[3]=PKW(P1,6), pw2); \
    VRD(3); SBAR(); GAPA(C0=__builtin_amdgcn_mfma_f32_32x32x16_bf16(kf[6],qr[3],C0,0,0,0),   P1[10],P1[11],P1[12],P1[13], pw3[0]=PKW(P1,8), pw3[1]=PKW(P1,10), pw3); \
    VRD(7); SBAR(); GAPA(C1=__builtin_amdgcn_mfma_f32_32x32x16_bf16(kf[7],qr[3],C1,0,0,0),   P1[14],P1[15],0.f,0.f,       pw3[2]=PKW(P1,12),pw3[3]=PKW(P1,14), pw3); \
    l_reg+=sacc; \
    if(GK){DMA_K((t)+3,sl_cur);} if(GV){DMA_V((t)+1,sl_next);} \
    CMASK(C0,C1,t); \
    { float a=MX3(C0[0],C0[1],C1[0]),b=MX3(C0[2],C0[3],C1[1]); a=MX3(a,C1[2],C1[3]); \
      _Pragma("unroll") for(int r=4;r<16;r+=4){a=MX3(a,C0[r],C0[r+1]);b=MX3(b,C0[r+2],C0[r+3]);a=MX3(a,C1[r],C1[r+1]);b=MX3(b,C1[r+2],C1[r+3]);} \
      float rm=__builtin_fmaxf(a,b); { auto rr=__builtin_amdgcn_permlane32_swap(__float_as_uint(rm),__float_as_uint(rm),false,false); rm=__builtin_fmaxf(__uint_as_float(rr[0]),__uint_as_float(rr[1])); } \
      resc=false; \
      if(__builtin_expect(__any(rm>(float)THRL),0)){ const float dl=__builtin_fmaxf(rm,0.f); mhat+=dl; \
        _Pragma("unroll") for(int r=0;r<16;++r){C0[r]-=dl;C1[r]-=dl;} \
        _Pragma("unroll") for(int r=0;r<16;++r)negm[r]=-mhat; asm volatile("":"+v"(negm)); \
        const float f=__builtin_amdgcn_exp2f(-dl); l_reg*=f; if(hi==0)wsf[r32]=f; resc=true; } } \
    SBAR(); \
    GAPB(o[0]=__builtin_amdgcn_mfma_f32_32x32x16_bf16(PAF(0),VFR(0),o[0],0,0,0), C0,0); \
    GAPB(o[1]=__builtin_amdgcn_mfma_f32_32x32x16_bf16(PAF(0),VFR(4),o[1],0,0,0), C0,4); \
    KRD(GL,0); GAPB(o[0]=__builtin_amdgcn_mfma_f32_32x32x16_bf16(PAF(1),VFR(1),o[0],0,0,0), C0,8); \
    KRD(GL,1); GAPB(o[1]=__builtin_amdgcn_mfma_f32_32x32x16_bf16(PAF(1),VFR(5),o[1],0,0,0), C0,12); \
    KRD(GL,2); GAPB(o[0]=__builtin_amdgcn_mfma_f32_32x32x16_bf16(PAF(2),VFR(2),o[0],0,0,0), C1,0); \
    KRD(GL,3); GAPB(o[1]=__builtin_amdgcn_mfma_f32_32x32x16_bf16(PAF(2),VFR(6),o[1],0,0,0), C1,4); \
    GAPB(o[0]=__builtin_amdgcn_mfma_f32_32x32x16_bf16(PAF(3),VFR(3),o[0],0,0,0), C1,8); \
    GAPB(o[1]=__builtin_amdgcn_mfma_f32_32x32x16_bf16(PAF(3),VFR(7),o[1],0,0,0), C1,12); \
    }while(0)
  int t=1;
  #undef CMASK
  #define CMASK(P0,P1,t) do{}while(0)
  for(;t+5<NT;t+=2){
    STEP(pB0,pB1,pA0,pA1,t,true,true,true);     WAIT_BAR(2); RESC(); ROT();
    STEP(pA0,pA1,pB0,pB1,t+1,true,true,true);   WAIT_BAR(2); RESC(); ROT();
  }
  #undef CMASK
  #define CMASK(P0,P1,t) do{int jb_=(t)-(NT-4); if(jb_>=0)cmask(P0,P1,jb_,qrel,hi);}while(0)
  #define ENDW(tt) do{ if((tt)+3<NT){WAIT_BAR(2);} else if((tt)+2<NT){WAIT_BAR(1);} else {WAIT_BAR(0);} }while(0)
  for(;t+1<NT;t+=2){
    STEP(pB0,pB1,pA0,pA1,t,(t+3<NT),(t+1<NT),(t+1<NT));       ENDW(t);   RESC(); ROT();
    STEP(pA0,pA1,pB0,pB1,t+1,(t+4<NT),(t+2<NT),(t+2<NT));     ENDW(t+1); RESC(); ROT();
  }
  STEP(pB0,pB1,pA0,pA1,NT-1,false,false,false); RESC();
  { float sacc=pB0[0]+pB0[1]; _Pragma("unroll") for(int r=2;r<16;++r)sacc+=pB0[r]; _Pragma("unroll") for(int r=0;r<16;++r)sacc+=pB1[r]; l_reg+=sacc;
    pw0=(u32x4){PKW(pB0,0),PKW(pB0,2),PKW(pB0,4),PKW(pB0,6)};pw1=(u32x4){PKW(pB0,8),PKW(pB0,10),PKW(pB0,12),PKW(pB0,14)};pw2=(u32x4){PKW(pB1,0),PKW(pB1,2),PKW(pB1,4),PKW(pB1,6)};pw3=(u32x4){PKW(pB1,8),PKW(pB1,10),PKW(pB1,12),PKW(pB1,14)};
    SBAR(); pv(o,vb0+sl_cur,PAF(0),PAF(1),PAF(2),PAF(3)); }
  #undef PKW
  #undef PAF
  #undef VFR
  #undef PIN
  #undef MX3
  #undef GAPA
  #undef GAPB
  #undef EX
  #undef VRD
  #undef KRD
  #undef STEP
  #undef ENDW
  {auto rr=__builtin_amdgcn_permlane32_swap(__float_as_uint(l_reg),__float_as_uint(l_reg),false,false);l_reg=__uint_as_float(rr[0])+__uint_as_float(rr[1]);}
  if(hi==0)wsf[32+r32]=l_reg;asm volatile("s_waitcnt lgkmcnt(0)":::"memory");
  float rli[16];
  #pragma unroll
  for(int r=0;r<16;++r)rli[r]=__builtin_amdgcn_rcpf(wsf[32+crow(r,hi)]);
  bf16*Ow=O+(rowbase+q0+wid*QBLK)*DMO+h*D;
  { bf16*stg=(bf16*)(shm+LDS_OST)+wid*2048;
    #pragma unroll
    for(int r=0;r<16;++r){const int orow=crow(r,hi);
      #pragma unroll
      for(int d0=0;d0<2;++d0)stg[orow*64+d0*32+r32]=__float2bfloat16(o[d0][r]*rli[r]);}
    asm volatile("s_waitcnt lgkmcnt(0)":::"memory");
    #pragma unroll
    for(int i=0;i<4;++i){const int row=i*8+(lane>>3),ch=lane&7; const u32x4 v=*(const u32x4*)(stg+row*64+ch*8); ATTN_STORE16(Ow+(long)row*DMO+ch*8,v);} }
  asm volatile("s_waitcnt lgkmcnt(0)\n\ts_barrier":::"memory");
  #undef DMA_K
  #undef DMA_V
  #undef CMASK
  #undef START
  #undef RESC
  #undef ROT
}
constexpr int ATTN_LDS_BYTES=LDS_BYTES;
struct AttnTensors { const bf16* Q; const bf16* K; const bf16* V; bf16* O; };
struct AttnUnit { int bh; int qb; };
struct StaticOrder {
  int vcu;
  __device__ __forceinline__ explicit StaticOrder(int grid,int block):vcu((block%8)*(grid/8)+block/8){}
  __device__ __forceinline__ bool next(int i,AttnUnit&u)const{ if(i>=4)return false; const int s=vcu&7; u.bh=vcu>>3; u.qb=(i==0)?s:(i==1)?15-s:(i==2)?16+s:31-s; return true; }
  __device__ __forceinline__ void a_ready(const AttnUnit&)const{}
  __device__ __forceinline__ void done(const AttnUnit&)const{}
};
template<class Sched,int THRL=8> __device__ __forceinline__ void attn_phase(char*lds,const AttnTensors&T,const Sched&S){
  AttnUnit u;
  for(int i=0;S.next(i,u);++i){ S.a_ready(u); attn_unit<THRL>(u.bh/NHEAD,u.bh%NHEAD,u.qb,T.Q,T.K,T.V,T.O,lds); S.done(u); }
}
#undef SBAR
#undef WAIT_BAR
}

#define LAS __attribute__((address_space(3)))
typedef unsigned short bfu;
typedef unsigned v4u __attribute__((ext_vector_type(4)));
typedef unsigned v2u __attribute__((ext_vector_type(2)));
typedef float f32x4 __attribute__((ext_vector_type(4)));
typedef float f32x8 __attribute__((ext_vector_type(8)));
typedef float f32x16 __attribute__((ext_vector_type(16)));
typedef float f32x2 __attribute__((ext_vector_type(2)));

constexpr int NWAVES = 8, NTHR = 512;
constexpr int MP = 65536, MS = 128, MR = MP + MS, MPAD = 65792;
constexpr int NIN = 3840, FFD = 4096;
constexpr int NPHASE = 24;
#ifndef MK_ONE_LAUNCH
#define MK_ONE_LAUNCH 1
#endif

constexpr size_t O_Y = 0;
constexpr size_t O_YS = (size_t)MP * 1024;
constexpr size_t O_ACP = O_YS + 128 * 1024;
constexpr size_t O_ADP = O_ACP + 2 * 8 * 3 * 768;
constexpr size_t O_BKP = O_ADP + 2 * 8 * 4 * 64 * 64;
constexpr size_t O_BVP = O_BKP + (size_t)2 * 8 * 8192 * 512;
constexpr size_t O_CSP = O_BVP + (size_t)2 * 8 * 8192 * 512;
constexpr size_t O_CWP = O_CSP + 2 * 8 * 1024;
constexpr size_t O_ACS = O_CWP + 2 * 8 * 4 * 64 * 64;
constexpr size_t O_ADS = O_ACS + 2 * 8 * 3 * 768;
constexpr size_t O_BKS = O_ADS + 2 * 8 * 4 * 64 * 64;
constexpr size_t O_BVS = O_BKS + 2 * 8 * 16 * 512;
constexpr size_t O_CSS = O_BVS + 2 * 8 * 16 * 512;
constexpr size_t O_CWS = O_CSS + 2 * 8 * 1024;
constexpr size_t O_END = O_CWS + 2 * 8 * 4 * 64 * 64;
static_assert(O_END == 202874880, "output size");

constexpr size_t MiB = 1u << 20;
constexpr size_t WS_CTL = 0;
constexpr size_t WS_RS = 64 * 1024;
constexpr size_t WS_BONUS = 2 * MiB;
constexpr size_t WS_GAB = 3 * MiB + 512 * 1024;
constexpr size_t WS_AB = 6 * MiB;
constexpr size_t WS_ROPE = 8 * MiB + 512 * 1024;
constexpr size_t WS_GCH = 10 * MiB + 512 * 1024;
constexpr size_t WS_W = 12 * MiB;
constexpr size_t W_IN = 0, W_OUT = W_IN + (size_t)NIN * 1024 * 2, W_FF1 = W_OUT + 1024 * 1024 * 2, W_FF2 = W_FF1 + 4096 * 1024 * 2,
                 W_GATE = W_FF2 + 4096 * 1024 * 2, W_PP = W_GATE + 1024 * 1024 * 2, W_LR = W_PP + 1024 * 256 * 2, W_END = W_LR + 768 * 256 * 2;
constexpr size_t WS_SLOT = 41 * MiB;
constexpr size_t USLOT = (size_t)MPAD * 1024;
static_assert(WS_W + W_END <= WS_SLOT, "weights");
static_assert(WS_SLOT + 15 * USLOT <= (size_t)1024 * MiB, "ws");
static_assert(WS_RS + 7 * (size_t)MPAD * 4 <= WS_BONUS && WS_BONUS + 4 * (size_t)MPAD * 4 <= WS_GAB && WS_GAB + 8 * (size_t)MPAD * 4 <= WS_AB && WS_AB + 8 * (size_t)MPAD * 4 <= WS_ROPE && WS_ROPE + 8192 * 64 * 4 <= WS_GCH && WS_GCH + 4 * 1032 * 64 * 4 <= WS_W, "ctl map");

__device__ __forceinline__ unsigned char* slotp(unsigned char* ws, int l, int s) {
    if (l & 1) { if (s < 2) s += 13; else if (s >= 13) s -= 13; }
    return ws + WS_SLOT + (size_t)s * USLOT;
}
__device__ __forceinline__ unsigned char* slotph(unsigned char* ws, int l, int s) { return slotp(ws, l, s) + USLOT / 2; }

constexpr int RING_BYTES = 131072, MISC_OFF = RING_BYTES + 320, LDS_BYTES = 147456;

#define LDS_WAIT() asm volatile("s_waitcnt lgkmcnt(0)" ::: "memory")
__device__ __forceinline__ float bf2f(unsigned short u) { return __uint_as_float(((unsigned)u) << 16); }
__device__ __forceinline__ unsigned f2bf(float f) { unsigned u = __builtin_bit_cast(unsigned, f); return (u + 0x7fffu + ((u >> 16) & 1u)) >> 16; }
__device__ __forceinline__ unsigned pk2(float lo, float hi) { return f2bf(lo) | (f2bf(hi) << 16); }
__device__ __forceinline__ float wave_sum(float v) {
#pragma unroll
    for (int o = 1; o < 64; o <<= 1) v += __shfl_xor(v, o);
    return v;
}
__device__ __forceinline__ float sigm(float x) { return 1.f / (1.f + __expf(-x)); }
__device__ __forceinline__ float softplusf(float x) { return x > 20.f ? x : log1pf(__expf(x)); }

struct Args { const float* in[40]; float* out; unsigned char* ws; int ph_lo, ph_hi; };
typedef const __attribute__((address_space(4))) Args* KArgs;

constexpr float ATT_C2 = 0.125f * 1.4426950408889634f;
struct EpiG1 {
    static constexpr bool PERM = false, AFTER_DRAIN = false;
    const float* rs; bfu *aqkvz, *qb, *kb, *vb, *craw; float* ab; const float* rope; float *okp, *ovp, *oks, *ovs;
    __device__ __forceinline__ void operator()(const pg8::f32x4 (&acc)[2][2][4][2], const pg8::Unit& u, int wr, int wc, int fr, int fq) const {
        const int pn = u.pn; const int rowb = u.pm * 256 + wr * 64 + fr; const int cl = wc * 32 + 4 * fq;
#pragma unroll
        for (int ai = 0; ai < 2; ++ai)
#pragma unroll
            for (int m = 0; m < 4; ++m) {
                const int row = rowb + ai * 128 + m * 16;
                const float s = rsqrtf(rs[row] * (1.f / 1024.f) + 1e-6f);
                if (pn < 4 || (pn >= 10 && pn < 14)) {
                    bfu* dst = (pn < 4 ? aqkvz + pn * 256 : craw + (pn - 10) * 256) + (size_t)row * 1024 + cl;
#pragma unroll
                    for (int bj = 0; bj < 2; ++bj)
#pragma unroll
                        for (int n = 0; n < 2; ++n) { const pg8::f32x4 v = acc[ai][bj][m][n] * s; v2u w; w.x = pg8::cvt_pk_bf16(v[0], v[1]); w.y = pg8::cvt_pk_bf16(v[2], v[3]); *(v2u*)(dst + bj * 128 + n * 16) = w; }
                } else if (pn < 8) {
                    const bool isk = pn >= 6;
                    const int pos = row < MP ? (row & 8191) : 2048 + ((row - MP) & 15);
                    const int i0 = (wc & 1) * 16 + 4 * fq;
                    const pg8::f32x4 c4 = *(const pg8::f32x4*)(rope + pos * 64 + i0), s4 = *(const pg8::f32x4*)(rope + pos * 64 + 32 + i0);
#pragma unroll
                    for (int bj = 0; bj < 2; ++bj) {
                        const pg8::f32x4 x1 = acc[ai][bj][m][0] * s, x2 = acc[ai][bj][m][1] * s;
                        pg8::f32x4 o1 = x1 * c4 - x2 * s4, o2 = x2 * c4 + x1 * s4;
                        if (!isk) {
                            o1 = o1 * ATT_C2; o2 = o2 * ATT_C2;
                            bfu* d = qb + (size_t)row * 512 + (pn - 4) * 256 + bj * 128 + cl;
                            v2u w; w.x = pg8::cvt_pk_bf16(o1[0], o1[1]); w.y = pg8::cvt_pk_bf16(o1[2], o1[3]); *(v2u*)d = w;
                            w.x = pg8::cvt_pk_bf16(o2[0], o2[1]); w.y = pg8::cvt_pk_bf16(o2[2], o2[3]); *(v2u*)(d + 16) = w;
                        } else {
                            bfu* d = kb + (size_t)row * 512 + (pn - 6) * 256 + bj * 128 + cl;
                            v2u w; w.x = pg8::cvt_pk_bf16(o1[0], o1[1]); w.y = pg8::cvt_pk_bf16(o1[2], o1[3]); *(v2u*)d = w;
                            w.x = pg8::cvt_pk_bf16(o2[0], o2[1]); w.y = pg8::cvt_pk_bf16(o2[2], o2[3]); *(v2u*)(d + 16) = w;
                            if (row < MR) {
                                float* ob = (row < MP ? okp + (size_t)row * 512 : oks + (size_t)(row - MP) * 512) + (pn - 6) * 256 + bj * 128 + (wc >> 1) * 64 + (wc & 1) * 16 + 4 * fq;
                                *(pg8::f32x4*)ob = o1; *(pg8::f32x4*)(ob + 32) = o2;
                            }
                        }
                    }
                } else if (pn < 10) {
#pragma unroll
                    for (int bj = 0; bj < 2; ++bj)
#pragma unroll
                        for (int n = 0; n < 2; ++n) {
                            const pg8::f32x4 v = acc[ai][bj][m][n] * s; const int col = (pn - 8) * 256 + bj * 128 + cl + n * 16;
                            v2u w; w.x = pg8::cvt_pk_bf16(v[0], v[1]); w.y = pg8::cvt_pk_bf16(v[2], v[3]); *(v2u*)(vb + (size_t)row * 512 + col) = w;
                            if (row < MR) { float* ob = (row < MP ? ovp + (size_t)row * 512 : ovs + (size_t)(row - MP) * 512) + col; *(pg8::f32x4*)ob = v; }
                        }
                } else {
                    if (wc == 0 && fq < 2) { const pg8::f32x4 v = acc[ai][0][m][0] * s; *(pg8::f32x4*)(ab + (size_t)row * 8 + 4 * fq) = v; }
                }
            }
    }
};
template <int MODE> struct EpiB {
    static constexpr bool PERM = false, AFTER_DRAIN = false;
    bfu* O; int ldc; const float* rs;
    __device__ __forceinline__ void operator()(const pg8::f32x4 (&acc)[2][2][4][2], const pg8::Unit& u, int wr, int wc, int fr, int fq) const {
        const int rowb = u.pm * 256 + wr * 64 + fr; const int cl = u.pn * 256 + wc * 32 + 4 * fq;
#pragma unroll
        for (int ai = 0; ai < 2; ++ai)
#pragma unroll
            for (int m = 0; m < 4; ++m) {
                const int row = rowb + ai * 128 + m * 16;
                float s = 1.f; if (MODE == 1) s = rsqrtf(rs[row] * (1.f / 1024.f) + 1e-6f);
                bfu* dst = O + (size_t)row * ldc + cl;
#pragma unroll
                for (int bj = 0; bj < 2; ++bj)
#pragma unroll
                    for (int n = 0; n < 2; ++n) {
                        pg8::f32x4 v = acc[ai][bj][m][n];
                        if (MODE == 1) { v = v * s; v[0] = fmaxf(v[0], 0.f); v[1] = fmaxf(v[1], 0.f); v[2] = fmaxf(v[2], 0.f); v[3] = fmaxf(v[3], 0.f); v = v * v; }
                        v2u w; w.x = pg8::cvt_pk_bf16(v[0], v[1]); w.y = pg8::cvt_pk_bf16(v[2], v[3]); *(v2u*)(dst + bj * 128 + n * 16) = w;
                    }
            }
    }
};
template <int MODE> struct EpiH {
    static constexpr bool PERM = false, AFTER_DRAIN = false;
    float* H; bfu* xh; float* rsn; const float* rs; const bfu* pp;
    __device__ __forceinline__ void operator()(const pg8::f32x4 (&acc)[2][2][4][2], const pg8::Unit& u, int wr, int wc, int fr, int fq) const {
        const int rowb = u.pm * 256 + wr * 64 + fr; const int cl = u.pn * 256 + wc * 32 + 4 * fq;
#pragma unroll
        for (int ai = 0; ai < 2; ++ai)
#pragma unroll
            for (int m = 0; m < 4; ++m) {
                const int row = rowb + ai * 128 + m * 16; const bool valid = row < MR; float ss = 0.f;
                if (valid) {
                    float s = 1.f; if (MODE == 3) s = rsqrtf(rs[row] * (1.f / 1024.f) + 1e-6f);
#pragma unroll
                    for (int bj = 0; bj < 2; ++bj)
#pragma unroll
                        for (int n = 0; n < 2; ++n) {
                            const size_t off = (size_t)row * 1024 + cl + bj * 128 + n * 16;
                            pg8::f32x4 h = *(const pg8::f32x4*)(H + off); const pg8::f32x4 a = acc[ai][bj][m][n];
                            if (MODE == 3) { const v2u pw = *(const v2u*)(pp + off);
                                h[0] += sigm(a[0] * s) * __uint_as_float(pw.x << 16); h[1] += sigm(a[1] * s) * __uint_as_float(pw.x & 0xffff0000u);
                                h[2] += sigm(a[2] * s) * __uint_as_float(pw.y << 16); h[3] += sigm(a[3] * s) * __uint_as_float(pw.y & 0xffff0000u);
                            } else h = h + a;
                            *(pg8::f32x4*)(H + off) = h;
                            v2u w; w.x = pg8::cvt_pk_bf16(h[0], h[1]); w.y = pg8::cvt_pk_bf16(h[2], h[3]); *(v2u*)(xh + off) = w;
                            ss += (h[0] * h[0] + h[1] * h[1]) + (h[2] * h[2] + h[3] * h[3]);
                        }
                }
                ss += __shfl_xor(ss, 16); ss += __shfl_xor(ss, 32);
                if (valid && fq == 0) unsafeAtomicAdd(rsn + row, ss);
            }
    }
};

__device__ __forceinline__ int win_src(int nd) {
    if (nd < 1024) return nd;
    if (nd < 2048) { const int c = nd - 1024, p = c & 63, grp = c >> 6; const int s = p >> 5, n_ = (p >> 4) & 1, r = p & 15; return 1032 + grp * 64 + n_ * 32 + s * 16 + r; }
    if (nd < 2560) return 2056 + (nd - 2048);
    if (nd < 3584) return 2568 + (nd - 2560);
    if (nd < 3592) return 1024 + (nd - 3584);
    return -1;
}
template <bool MAP> __device__ __forceinline__ void wt_item(const float* W, int K, int Nsrc, bfu* WT, const float* gain, LAS float* scr, int item, int nblk, int lane) {
    const int kb = item / nblk, nb = item % nblk, k0 = 64 * kb, n0 = 32 * nb;
    const int nd = n0 + (lane & 31); const int src = MAP ? win_src(nd) : nd;
#pragma unroll 8
    for (int i = 0; i < 32; ++i) { const int kk = 2 * i + (lane >> 5); float v = src >= 0 ? W[(size_t)(k0 + kk) * Nsrc + src] : 0.f; if (gain) v *= gain[k0 + kk]; scr[kk * 33 + (lane & 31)] = v; }
    LDS_WAIT(); asm volatile("" ::: "memory");
    const int c = lane & 7;
#pragma unroll
    for (int j = 0; j < 4; ++j) { const int n = (lane >> 3) + 8 * j; const LAS float* s = scr + (8 * c) * 33 + n;
        v4u o; o.x = pk2(s[0 * 33], s[1 * 33]); o.y = pk2(s[2 * 33], s[3 * 33]); o.z = pk2(s[4 * 33], s[5 * 33]); o.w = pk2(s[6 * 33], s[7 * 33]);
        *(v4u*)(WT + (size_t)(n0 + n) * K + k0 + 8 * c) = o; }
    LDS_WAIT(); asm volatile("" ::: "memory");
}
__device__ __forceinline__ void conv_weights(KArgs A, int l, int mask, LAS unsigned char* lds, int gw, int NGW, int lane, int wave) {
    LAS float* scr = (LAS float*)(lds + wave * 16384);
    unsigned char* wb = A->ws + WS_W;
    if (mask & 1) {
        const float* win = A->in[11] + (size_t)l * 1024 * 3592; const float* g = A->in[10] + l * 1024;
        for (int it = gw; it < 16 * 120; it += NGW) wt_item<true>(win, 1024, 3592, (bfu*)(wb + W_IN), g, scr, it, 120, lane);
        const float* wu = A->in[23] + (size_t)l * 64 * 256; const float* au = A->in[25] + (size_t)l * 64 * 256; const float* gu = A->in[26] + (size_t)l * 128 * 256;
        bfu* lr = (bfu*)(wb + W_LR);
        for (int i = gw * 64 + lane; i < 768 * 256; i += NGW * 64) { const int n = i >> 8, k = i & 255; float v = 0.f;
            if (n < 256) { if (k < 64) v = wu[k * 256 + n]; } else if (n < 512) { if (k >= 64 && k < 128) v = au[(k - 64) * 256 + (n - 256)]; } else { if (k >= 128) v = gu[(k - 128) * 256 + (n - 512)]; }
            lr[i] = (bfu)f2bf(v); }
    }
    if (mask & 2) {
        const float* wo = A->in[32] + (size_t)l * 1024 * 1024; const float* f1 = A->in[34] + (size_t)l * 1024 * 4096; const float* f2 = A->in[35] + (size_t)l * 4096 * 1024;
        const float* wg = A->in[37] + (size_t)l * 1024 * 1024; const float* wp = A->in[38] + (size_t)l * 256 * 1024;
        const float* gf = A->in[33] + l * 1024; const float* gp = A->in[36] + l * 1024;
        constexpr int I_O = 16 * 32, I_1 = 16 * 128, I_2 = 64 * 32, I_G = 16 * 32, I_P = 4 * 32;
        for (int it = gw; it < I_O + I_1 + I_2 + I_G + I_P; it += NGW) {
            int r = it;
            if (r < I_O) { wt_item<false>(wo, 1024, 1024, (bfu*)(wb + W_OUT), nullptr, scr, r, 32, lane); continue; } r -= I_O;
            if (r < I_1) { wt_item<false>(f1, 1024, 4096, (bfu*)(wb + W_FF1), gf, scr, r, 128, lane); continue; } r -= I_1;
            if (r < I_2) { wt_item<false>(f2, 4096, 1024, (bfu*)(wb + W_FF2), nullptr, scr, r, 32, lane); continue; } r -= I_2;
            if (r < I_G) { wt_item<false>(wg, 1024, 1024, (bfu*)(wb + W_GATE), gp, scr, r, 32, lane); continue; } r -= I_G;
            wt_item<false>(wp, 256, 1024, (bfu*)(wb + W_PP), nullptr, scr, r, 32, lane);
        }
    }
}
__device__ __forceinline__ void conv_p(KArgs A, int l, bfu* pb, int gtid, int NT) {
    const float* pp = A->in[8] + (size_t)l * MP * 256; const float* ps = A->in[9] + (size_t)l * MS * 256;
    for (int i = gtid; i < MR * 64; i += NT) { const int m = i >> 6, c = (i & 63) * 4;
        const f32x4 v = *(const f32x4*)(m < MP ? pp + (size_t)m * 256 + c : ps + (size_t)(m - MP) * 256 + c);
        v2u w; w.x = pk2(v[0], v[1]); w.y = pk2(v[2], v[3]); *(v2u*)(pb + (size_t)m * 256 + c) = w; }
}
__device__ __forceinline__ void prologue(KArgs A, LAS unsigned char* lds, int gw, int NGW, int lane, int wave, int gtid, int NT) {
    conv_weights(A, 0, 3, lds, gw, NGW, lane, wave);
    unsigned char* ws = A->ws;
    float* rs = (float*)(ws + WS_RS); bfu* xh = (bfu*)slotp(ws, 0, 0); float* H = A->out;
    for (int i = gtid; i < 6 * MPAD; i += NT) rs[MPAD + i] = 0.f;
    for (int m = gw; m < MPAD; m += NGW) {
        if (m < MR) {
            const float* xr = m < MP ? A->in[0] + (size_t)m * 1024 : A->in[1] + (size_t)(m - MP) * 1024; float ss = 0.f;
#pragma unroll
            for (int j = 0; j < 4; ++j) { const f32x4 v = *(const f32x4*)(xr + j * 256 + lane * 4); *(f32x4*)(H + (size_t)m * 1024 + j * 256 + lane * 4) = v;
                v2u w; w.x = pk2(v[0], v[1]); w.y = pk2(v[2], v[3]); *(v2u*)(xh + (size_t)m * 1024 + j * 256 + lane * 4) = w; ss += (v[0] * v[0] + v[1] * v[1]) + (v[2] * v[2] + v[3] * v[3]); }
            ss = wave_sum(ss); if (lane == 0) rs[m] = ss;
        } else {
#pragma unroll
            for (int j = 0; j < 4; ++j) *(v2u*)(xh + (size_t)m * 1024 + j * 256 + lane * 4) = (v2u){0u, 0u};
            if (lane == 0) rs[m] = 1024.f;
        }
    }
    float* rope = (float*)(ws + WS_ROPE);
    for (int i = gtid; i < 8192 * 32; i += NT) { const int pos = i >> 5, k = i & 31;
        const float inv = exp2f(-(float)k * (13.287712379549449f / 32.0f)); const float ang = (float)pos * inv;
        const float nn = rintf(ang * 0.15915494309189535f); const float fr = fmaf(-nn, 1.9353071795864769e-3f, fmaf(-nn, 6.28125f, ang));
        rope[pos * 64 + k] = __cosf(fr); rope[pos * 64 + 32 + k] = __sinf(fr); }
    if (gw == 0) {
        for (int l = 0; l < 2; ++l) {
            const float a = wave_sum(A->in[16][l * 64 + lane] * A->in[17][l * 64 + lane]), b = wave_sum(A->in[18][l * 64 + lane] * A->in[19][l * 64 + lane]);
            const float li = 0.8f - 0.6f * expf(-0.3f * (float)l);
            if (lane == 0) { float* lf = (float*)(ws + WS_CTL + 1024); lf[2 * l] = expf(a) - expf(b) + li; lf[2 * l + 1] = li; }
        }
    }
}

__device__ __forceinline__ void prep_a(KArgs A, int l, int gw, int NGW, int lane) {
    unsigned char* ws = A->ws;
    const bfu* aq = (const bfu*)slotp(ws, l, 2); const float* ab = (const float*)(ws + WS_AB);
    float* sia = (float*)slotp(ws, l, 9); bfu* va = (bfu*)slotp(ws, l, 11); bfu* zs = (bfu*)slotph(ws, l, 11); float* gab = (float*)(ws + WS_GAB);
    const float* cw = A->in[12] + l * 4 * 768; const float* stc = A->in[4] + (size_t)l * 8 * 3 * 768;
    const float* anorm = A->in[15] + l * 64;
    for (int m = gw; m < MR; m += NGW) {
        int t, L, sb = 0; const bool smp = m >= MP; float* aco;
        if (!smp) { t = m & 8191; L = 8192; aco = A->out + O_ACP + ((size_t)(l * 8 + (m >> 13)) * 3) * 768; }
        else { sb = (m - MP) >> 4; t = (m - MP) & 15; L = 16; aco = A->out + O_ACS + ((size_t)(l * 8 + sb) * 3) * 768; }
#pragma unroll 1
        for (int h = 0; h < 4; ++h) {
            float val[3];
#pragma unroll
            for (int g = 0; g < 3; ++g) {
                const int c = g * 256 + h * 64 + lane; float x[4];
#pragma unroll
                for (int d = 0; d < 4; ++d) { const int tt = t - d;
                    x[d] = tt >= 0 ? bf2f(aq[(size_t)(m - d) * 1024 + c]) : (smp ? stc[((size_t)sb * 3 + (3 + tt)) * 768 + c] : 0.f); }
                const float y = x[3] * cw[c] + x[2] * cw[768 + c] + x[1] * cw[1536 + c] + x[0] * cw[2304 + c];
                val[g] = y * sigm(y);
                if (t >= L - 3) aco[(size_t)(t - (L - 3)) * 768 + c] = x[0];
            }
            const float sq = wave_sum(val[0] * val[0]), sk = wave_sum(val[1] * val[1]);
            const float qn = val[0] * rsqrtf(sq + 1e-6f) * 0.125f, kn = val[1] * rsqrtf(sk + 1e-6f);
            float* rec = sia + ((size_t)(h * 8 + (lane >> 3)) * MPAD + m) * 16 + (lane & 7);
            rec[0] = kn; rec[8] = qn;
            va[(size_t)m * 256 + h * 64 + lane] = (bfu)f2bf(val[2]);
            const float z = bf2f(aq[(size_t)m * 1024 + 768 + h * 64 + lane]);
            zs[(size_t)m * 256 + h * 64 + lane] = (bfu)f2bf(z * sigm(z) * anorm[lane]);
        }
        if (lane < 4) { const int h = lane;
            const float g = -__expf(A->in[13][l * 4 + h]) * softplusf(ab[(size_t)m * 8 + h] + A->in[14][l * 4 + h]);
            gab[((size_t)h * MPAD + m) * 2] = __expf(g); gab[((size_t)h * MPAD + m) * 2 + 1] = sigm(ab[(size_t)m * 8 + 4 + h]); }
    }
}
__device__ __forceinline__ void prep_c1(KArgs A, int l, int gw, int NGW, int lane) {
    unsigned char* ws = A->ws;
    const bfu* cr = (const bfu*)slotp(ws, l, 7); bfu* lra = (bfu*)slotp(ws, l, 12);
    const float* mu = A->in[21] + l * 1024; const float* sts = A->in[6] + (size_t)l * 8 * 1024;
    for (int m = gw; m < MR; m += NGW) {
        int t, L, sb = 0; const bool smp = m >= MP; float* cso;
        if (!smp) { t = m & 8191; L = 8192; cso = A->out + O_CSP + (size_t)(l * 8 + (m >> 13)) * 1024; }
        else { sb = (m - MP) >> 4; t = (m - MP) & 15; L = 16; cso = A->out + O_CSS + (size_t)(l * 8 + sb) * 1024; }
#pragma unroll
        for (int i = 0; i < 4; ++i) { const int j = 768 + lane + 64 * i;
            const float cur = bf2f(cr[(size_t)m * 1024 + j]);
            const float prev = t > 0 ? bf2f(cr[(size_t)(m - 1) * 1024 + j]) : (smp ? sts[(size_t)sb * 1024 + j] : 0.f);
            const float c = cur + (prev - cur) * mu[j];
            const float o = i == 0 ? tanhf(c) : (i == 1 ? c : sigm(c));
            lra[(size_t)m * 256 + lane + 64 * i] = (bfu)f2bf(o); }
        if (t == L - 1) {
#pragma unroll
            for (int i = 0; i < 16; ++i) cso[lane + 64 * i] = bf2f(cr[(size_t)m * 1024 + lane + 64 * i]);
        }
    }
}
__device__ __forceinline__ void prep_c2(KArgs A, int l, int bid, int G, int tid) {
    unsigned char* ws = A->ws;
    const bfu* cr = (const bfu*)slotp(ws, l, 7); const bfu* lro = (const bfu*)slotp(ws, l, 13);
    bfu* v2 = (bfu*)slotp(ws, l, 12); bfu* gg = (bfu*)slotph(ws, l, 12);
    float* bonus = (float*)(ws + WS_BONUS); float* gch = (float*)(ws + WS_GCH);
    const float* mu = A->in[21] + l * 1024; const float* sts = A->in[6] + (size_t)l * 8 * 1024;
    const int ch = tid & 255, h = ch >> 6, lane = ch & 63, half = tid >> 8;
    float* sic = (float*)slotp(ws, l, h) + ((size_t)(lane >> 3) * MPAD) * 32 + (lane & 7);
    const float mur = mu[ch], muk = mu[256 + ch], muv = mu[512 + ch];
    const float w0 = A->in[22][l * 256 + ch], a0 = A->in[24][l * 256 + ch], kk_ = A->in[27][l * 256 + ch], ka = A->in[28][l * 256 + ch], rk = A->in[29][l * 256 + ch];
    for (int u = bid * 2 + half; u < 1032; u += G * 2) {
        int m0, n; float pr, pk, pv;
        if (u < 1024) { m0 = u * 64; n = 64;
            if ((u & 127) == 0) { pr = pk = pv = 0.f; } else { pr = bf2f(cr[(size_t)(m0 - 1) * 1024 + ch]); pk = bf2f(cr[(size_t)(m0 - 1) * 1024 + 256 + ch]); pv = bf2f(cr[(size_t)(m0 - 1) * 1024 + 512 + ch]); } }
        else { const int sb = u - 1024; m0 = MP + sb * 16; n = 16; pr = sts[(size_t)sb * 1024 + ch]; pk = sts[(size_t)sb * 1024 + 256 + ch]; pv = sts[(size_t)sb * 1024 + 512 + ch]; }
        float cum = 0.f;
#pragma unroll 4
        for (int tt = 0; tt < n; ++tt) { const int m = m0 + tt;
            const float c_r = bf2f(cr[(size_t)m * 1024 + ch]), c_k = bf2f(cr[(size_t)m * 1024 + 256 + ch]), c_v = bf2f(cr[(size_t)m * 1024 + 512 + ch]);
            const float r = c_r + (pr - c_r) * mur, k = c_k + (pk - c_k) * muk, v = c_v + (pv - c_v) * muv; pr = c_r; pk = c_k; pv = c_v;
            const float lw = bf2f(lro[(size_t)m * 768 + ch]), la = bf2f(lro[(size_t)m * 768 + 256 + ch]); const bfu gb = lro[(size_t)m * 768 + 512 + ch];
            const float wl = -0.6065306597126334f * sigm(w0 + lw); const float a = sigm(a0 + la);
            const float kkr = k * kk_; const float kk = kkr * rsqrtf(wave_sum(kkr * kkr) + 1e-6f);
            const float kp = k * (1.f + (a - 1.f) * ka);
            const float Gp = __expf(cum); cum += wl; const float Gc = __expf(cum), iG = __expf(-cum);
            float* rec = sic + (size_t)m * 32;
            rec[0] = kk * Gp; rec[8] = kk * a * iG; rec[16] = kp * iG; rec[24] = r * Gc;
            const float bo = wave_sum(r * kp * rk); if (lane == 0) bonus[(size_t)h * MPAD + m] = bo;
            v2[(size_t)m * 256 + ch] = (bfu)f2bf(v); gg[(size_t)m * 256 + ch] = gb;
        }
        gch[((size_t)h * 1032 + u) * 64 + lane] = __expf(cum);
    }
}
__device__ __forceinline__ void post_attn(KArgs A, int l, int gw, int NGW, int lane) {
    unsigned char* ws = A->ws;
    const bfu* O = (const bfu*)slotp(ws, l, 13); bfu* mix = (bfu*)slotp(ws, l, 7);
    const float* lf = (const float*)(ws + WS_CTL + 1024); const float lam = lf[2 * l], omli = 1.f - lf[2 * l + 1];
    const int h = lane >> 4, e0 = (lane & 15) * 8; const float* bn = A->in[20] + l * 128 + e0;
    float bnv[8];
#pragma unroll
    for (int i = 0; i < 8; ++i) bnv[i] = bn[i] * omli;
    for (int m = gw; m < MP; m += NGW) {
        const v4u a = *(const v4u*)(O + (size_t)m * 1024 + (4 * h + (e0 >> 6)) * 64 + (e0 & 63));
        const v4u b = *(const v4u*)(O + (size_t)m * 1024 + (4 * h + 2 + (e0 >> 6)) * 64 + (e0 & 63));
        float o[8]; float ss = 0.f;
#pragma unroll
        for (int i = 0; i < 4; ++i) { const unsigned aw = a[i], bw = b[i];
            o[2 * i] = __uint_as_float(aw << 16) - lam * __uint_as_float(bw << 16); o[2 * i + 1] = __uint_as_float(aw & 0xffff0000u) - lam * __uint_as_float(bw & 0xffff0000u);
            ss += o[2 * i] * o[2 * i] + o[2 * i + 1] * o[2 * i + 1]; }
        ss += __shfl_xor(ss, 1); ss += __shfl_xor(ss, 2); ss += __shfl_xor(ss, 4); ss += __shfl_xor(ss, 8);
        const float rn = rsqrtf(ss * (1.f / 128.f) + 1e-6f);
        v4u w; w.x = pk2(o[0] * rn * bnv[0], o[1] * rn * bnv[1]); w.y = pk2(o[2] * rn * bnv[2], o[3] * rn * bnv[3]); w.z = pk2(o[4] * rn * bnv[4], o[5] * rn * bnv[5]); w.w = pk2(o[6] * rn * bnv[6], o[7] * rn * bnv[7]);
        *(v4u*)(mix + (size_t)m * 1024 + 256 + h * 128 + e0) = w;
    }
}
__device__ __forceinline__ void final_norm(KArgs A, int gw, int NGW, int lane) {
    const float* rs = (const float*)(A->ws + WS_RS) + 6 * (size_t)MPAD; const float* g = A->in[39];
    for (int m = gw; m < MR; m += NGW) { const float s = rsqrtf(rs[m] * (1.f / 1024.f) + 1e-6f);
#pragma unroll
        for (int j = 0; j < 4; ++j) { float* p = A->out + (size_t)m * 1024 + j * 256 + lane * 4; f32x4 v = *(f32x4*)p; const f32x4 gv = *(const f32x4*)(g + j * 256 + lane * 4); v = v * s * gv; *(f32x4*)p = v; } }
}

__device__ __forceinline__ f32x8 sload8(const float* p) { f32x8 r; asm volatile("s_load_dwordx8 %0, %1, 0x0" : "=s"(r) : "s"(p)); return r; }
__device__ __forceinline__ f32x16 sload16(const float* p) { f32x16 r; asm volatile("s_load_dwordx16 %0, %1, 0x0" : "=s"(r) : "s"(p)); return r; }
__device__ __forceinline__ f32x2 sload2(const float* p) { f32x2 r; asm volatile("s_load_dwordx2 %0, %1, 0x0" : "=s"(r) : "s"(p)); return r; }
#define SC_BAR() asm volatile("s_waitcnt lgkmcnt(0)\n\ts_barrier" ::: "memory")
constexpr int SC_RED = 0, SC_YRED = 4096, SC_VBUF = 8192, SC_GBUF = 24576, SC_BON = 40960;

__device__ __forceinline__ void scan_rwkv(KArgs A, int l, LAS unsigned char* lds, int h, int m0, int L, int CL, int CLS, int chunk0, const float* st_in, float* st_out, int tid) {
    unsigned char* ws = A->ws;
    const int lane = tid & 63, wid = __builtin_amdgcn_readfirstlane(tid >> 6);
    LAS float* red = (LAS float*)(lds + SC_RED); LAS float* yred = (LAS float*)(lds + SC_YRED);
    LAS bfu* vbuf = (LAS bfu*)(lds + SC_VBUF); LAS bfu* gbuf = (LAS bfu*)(lds + SC_GBUF); LAS float* bon = (LAS float*)(lds + SC_BON);
    const bfu* v2 = (const bfu*)slotp(ws, l, 12); const bfu* gg = (const bfu*)slotph(ws, l, 12);
    const float* bonus = (const float*)(ws + WS_BONUS) + (size_t)h * MPAD;
    const float* gch = (const float*)(ws + WS_GCH) + ((size_t)h * 1032 + chunk0) * 64 + 8 * wid;
    bfu* mix = (bfu*)slotp(ws, l, 7);
    const float* P = (const float*)slotp(ws, l, h) + ((size_t)wid * MPAD + m0) * 32;
    const float lnw = A->in[30][l * 256 + h * 64 + lane], lnb = A->in[31][l * 256 + h * 64 + lane];
    float S[8];
#pragma unroll
    for (int j = 0; j < 8; ++j) S[j] = st_in ? st_in[lane * 64 + 8 * wid + j] : 0.f;
    const int nch = L >> CLS; const int srow = tid >> 3, sc8 = tid & 7; const bool sval = srow < CL;
    v4u sv = {0, 0, 0, 0}, sg = {0, 0, 0, 0}; float sb_ = 0.f;
#define RW_STAGE(c) do { if (sval) { const size_t mm = (size_t)(m0 + (c) * CL + srow) * 256 + h * 64 + sc8 * 8; sv = *(const v4u*)(v2 + mm); sg = *(const v4u*)(gg + mm); } if (tid < CL) sb_ = bonus[m0 + (c) * CL + tid]; } while (0)
#define RW_COMMIT(c) do { if (sval) { *(LAS v4u*)(vbuf + ((c) & 1) * 4096 + srow * 64 + sc8 * 8) = sv; *(LAS v4u*)(gbuf + ((c) & 1) * 4096 + srow * 64 + sc8 * 8) = sg; } if (tid < CL) bon[((c) & 1) * 64 + tid] = sb_; } while (0)
    __syncthreads();
    RW_STAGE(0); RW_COMMIT(0); if (nch > 1) RW_STAGE(1);
    float pfv = 0.f, pfacc = 0.f;
    const float* Pend = P + (size_t)(L - 1) * 32;
    { const float* q0 = P + (size_t)lane * 16; pfv = *(q0 < Pend ? q0 : Pend); pfacc += pfv; }
    f32x8 a1 = sload8(P), a2 = sload8(P + 8), a3 = sload8(P + 16), a4 = sload8(P + 24), b1 = a1, b2 = a1, b3 = a1, b4 = a1, ge = a1;
    asm volatile("s_waitcnt lgkmcnt(0)" : "+s"(a1), "+s"(a2), "+s"(a3), "+s"(a4));
    b1 = a1; b2 = a2; b3 = a3; b4 = a4; ge = a1;
#define RW_FINAL(T) do { const int tf_ = (T); const int cf_ = tf_ >> CLS, ttf_ = tf_ & (CL - 1), bf_ = cf_ & 1; \
        const LAS float* yr_ = yred + (tf_ & 1) * 512 + lane; const float y_ = ((yr_[0] + yr_[64]) + (yr_[128] + yr_[192])) + ((yr_[256] + yr_[320]) + (yr_[384] + yr_[448])); \
        const float mu_ = wave_sum(y_) * (1.f / 64.f); const float d_ = y_ - mu_; const float var_ = wave_sum(d_ * d_) * (1.f / 64.f); \
        const float cy_ = d_ * rsqrtf(var_ + 64e-5f) * lnw + lnb; \
        const float vv_ = bf2f(vbuf[bf_ * 4096 + ttf_ * 64 + lane]), g_ = bf2f(gbuf[bf_ * 4096 + ttf_ * 64 + lane]); \
        mix[(size_t)(m0 + tf_) * 1024 + 768 + h * 64 + lane] = (bfu)f2bf((cy_ + bon[bf_ * 64 + ttf_] * vv_) * g_); } while (0)
#define RW_STEP(C1, C2, C3, C4, N1, N2, N3, N4, T, TT, BUF) do { \
        float d0 = S[0] * C1[0], d1 = S[1] * C1[1]; d0 = fmaf(S[2], C1[2], d0); d1 = fmaf(S[3], C1[3], d1); d0 = fmaf(S[4], C1[4], d0); d1 = fmaf(S[5], C1[5], d1); d0 = fmaf(S[6], C1[6], d0); d1 = fmaf(S[7], C1[7], d1); \
        red[((T) & 1) * 512 + wid * 64 + lane] = d0 + d1; \
        SC_BAR(); \
        if ((T) + 1 < L) { const float* pn_ = P + (size_t)((T) + 1) * 32; N1 = sload8(pn_); N2 = sload8(pn_ + 8); N3 = sload8(pn_ + 16); N4 = sload8(pn_ + 24); } \
        const LAS float* rr_ = red + ((T) & 1) * 512 + lane; const float tot_ = ((rr_[0] + rr_[64]) + (rr_[128] + rr_[192])) + ((rr_[256] + rr_[320]) + (rr_[384] + rr_[448])); \
        const float vv = bf2f(vbuf[(BUF) * 4096 + (TT) * 64 + lane]); const float sa = -tot_; \
        _Pragma("unroll") for (int j = 0; j < 8; ++j) S[j] = fmaf(sa, C2[j], fmaf(vv, C3[j], S[j])); \
        float y0 = S[0] * C4[0], y1 = S[1] * C4[1]; y0 = fmaf(S[2], C4[2], y0); y1 = fmaf(S[3], C4[3], y1); y0 = fmaf(S[4], C4[4], y0); y1 = fmaf(S[5], C4[5], y1); y0 = fmaf(S[6], C4[6], y0); y1 = fmaf(S[7], C4[7], y1); \
        yred[((T) & 1) * 512 + wid * 64 + lane] = y0 + y1; \
        if ((T) > 0 && wid == (((T) - 1) & 7)) RW_FINAL((T) - 1); \
        asm volatile("s_waitcnt lgkmcnt(0)" : "+s"(N1), "+s"(N2), "+s"(N3), "+s"(N4)); } while (0)
    for (int c = 0; c < nch; ++c) {
        ge = sload8(gch + (size_t)c * 64);
        const int buf = c & 1;
        for (int tt = 0; tt < CL; tt += 2) {
            const int t = c * CL + tt;
            if ((t & 15) == 0) { pfacc += pfv; const float* q0 = P + (size_t)(t + 16) * 32 + (size_t)lane * 16; pfv = *(q0 < Pend ? q0 : Pend); }
            RW_STEP(a1, a2, a3, a4, b1, b2, b3, b4, t, tt, buf);
            RW_STEP(b1, b2, b3, b4, a1, a2, a3, a4, t + 1, tt + 1, buf);
        }
        asm volatile("s_waitcnt lgkmcnt(0)" : "+s"(ge));
#pragma unroll
        for (int j = 0; j < 8; ++j) S[j] *= ge[j];
        if (c + 1 < nch) { RW_COMMIT(c + 1); if (c + 2 < nch) RW_STAGE(c + 2); }
    }
    SC_BAR();
    if (wid == ((L - 1) & 7)) RW_FINAL(L - 1);
#pragma unroll
    for (int j = 0; j < 8; ++j) st_out[lane * 64 + 8 * wid + j] = S[j];
    if (pfacc == 1.2345678e33f) st_out[0] = pfacc;
    __syncthreads();
#undef RW_STAGE
#undef RW_COMMIT
#undef RW_FINAL
#undef RW_STEP
}

__device__ __forceinline__ void scan_delta(KArgs A, int l, LAS unsigned char* lds, int h, int m0, int L, int CL, int CLS, const float* st_in, float* st_out, int tid) {
    unsigned char* ws = A->ws;
    const int lane = tid & 63, wid = __builtin_amdgcn_readfirstlane(tid >> 6);
    LAS float* red = (LAS float*)(lds + SC_RED); LAS float* yred = (LAS float*)(lds + SC_YRED);
    LAS bfu* vbuf = (LAS bfu*)(lds + SC_VBUF); LAS bfu* gbuf = (LAS bfu*)(lds + SC_GBUF);
    const bfu* va = (const bfu*)slotp(ws, l, 11); const bfu* zs = (const bfu*)slotph(ws, l, 11);
    bfu* mix = (bfu*)slotp(ws, l, 7);
    const float* P = (const float*)slotp(ws, l, 9) + ((size_t)(h * 8 + wid) * MPAD + m0) * 16;
    const float* PG = (const float*)(ws + WS_GAB) + ((size_t)h * MPAD + m0) * 2;
    float S[8];
#pragma unroll
    for (int j = 0; j < 8; ++j) S[j] = st_in ? st_in[(8 * wid + j) * 64 + lane] : 0.f;
    const int nch = L >> CLS; const int srow = tid >> 3, sc8 = tid & 7; const bool sval = srow < CL;
    v4u sv = {0, 0, 0, 0}, sg = {0, 0, 0, 0};
#define DL_STAGE(c) do { if (sval) { const size_t mm = (size_t)(m0 + (c) * CL + srow) * 256 + h * 64 + sc8 * 8; sv = *(const v4u*)(va + mm); sg = *(const v4u*)(zs + mm); } } while (0)
#define DL_COMMIT(c) do { if (sval) { *(LAS v4u*)(vbuf + ((c) & 1) * 4096 + srow * 64 + sc8 * 8) = sv; *(LAS v4u*)(gbuf + ((c) & 1) * 4096 + srow * 64 + sc8 * 8) = sg; } } while (0)
    __syncthreads();
    DL_STAGE(0); DL_COMMIT(0); if (nch > 1) DL_STAGE(1);
    float pfv = 0.f, pfacc = 0.f;
    const float* Pend = P + (size_t)(L - 1) * 16;
    { const float* q0 = P + (size_t)lane * 16; pfv = *(q0 < Pend ? q0 : Pend); pfacc += pfv; }
    f32x16 ka = sload16(P), kb = ka; f32x2 ga = sload2(PG), gb = ga;
    asm volatile("s_waitcnt lgkmcnt(0)" : "+s"(ka), "+s"(ga));
    kb = ka; gb = ga;
#define DL_FINAL(T) do { const int tf_ = (T); const int cf_ = tf_ >> CLS, ttf_ = tf_ & (CL - 1), bf_ = cf_ & 1; \
        const LAS float* yr_ = yred + (tf_ & 1) * 512 + lane; const float o_ = ((yr_[0] + yr_[64]) + (yr_[128] + yr_[192])) + ((yr_[256] + yr_[320]) + (yr_[384] + yr_[448])); \
        const float ss_ = wave_sum(o_ * o_) * (1.f / 64.f); \
        mix[(size_t)(m0 + tf_) * 1024 + h * 64 + lane] = (bfu)f2bf(o_ * rsqrtf(ss_ + 1e-6f) * bf2f(gbuf[bf_ * 4096 + ttf_ * 64 + lane])); } while (0)
#define DL_STEP(CK, CG, NK, NG, T, TT, BUF) do { \
        float d0 = S[0] * CK[0], d1 = S[1] * CK[1]; d0 = fmaf(S[2], CK[2], d0); d1 = fmaf(S[3], CK[3], d1); d0 = fmaf(S[4], CK[4], d0); d1 = fmaf(S[5], CK[5], d1); d0 = fmaf(S[6], CK[6], d0); d1 = fmaf(S[7], CK[7], d1); \
        red[((T) & 1) * 512 + wid * 64 + lane] = d0 + d1; \
        SC_BAR(); \
        if ((T) + 1 < L) { NK = sload16(P + (size_t)((T) + 1) * 16); NG = sload2(PG + (size_t)((T) + 1) * 2); } \
        const LAS float* rr_ = red + ((T) & 1) * 512 + lane; const float tot_ = ((rr_[0] + rr_[64]) + (rr_[128] + rr_[192])) + ((rr_[256] + rr_[320]) + (rr_[384] + rr_[448])); \
        const float vv = bf2f(vbuf[(BUF) * 4096 + (TT) * 64 + lane]); const float av = CG[0]; const float dl = CG[1] * (vv - av * tot_); \
        _Pragma("unroll") for (int j = 0; j < 8; ++j) S[j] = fmaf(CK[j], dl, av * S[j]); \
        float y0 = S[0] * CK[8], y1 = S[1] * CK[9]; y0 = fmaf(S[2], CK[10], y0); y1 = fmaf(S[3], CK[11], y1); y0 = fmaf(S[4], CK[12], y0); y1 = fmaf(S[5], CK[13], y1); y0 = fmaf(S[6], CK[14], y0); y1 = fmaf(S[7], CK[15], y1); \
        yred[((T) & 1) * 512 + wid * 64 + lane] = y0 + y1; \
        if ((T) > 0 && wid == (((T) - 1) & 7)) DL_FINAL((T) - 1); \
        asm volatile("s_waitcnt lgkmcnt(0)" : "+s"(NK), "+s"(NG)); } while (0)
    for (int c = 0; c < nch; ++c) {
        const int buf = c & 1;
        for (int tt = 0; tt < CL; tt += 2) {
            const int t = c * CL + tt;
            if ((t & 31) == 0) { pfacc += pfv; const float* q0 = P + (size_t)(t + 32) * 16 + (size_t)lane * 16; pfv = *(q0 < Pend ? q0 : Pend); }
            DL_STEP(ka, ga, kb, gb, t, tt, buf);
            DL_STEP(kb, gb, ka, ga, t + 1, tt + 1, buf);
        }
        if (c + 1 < nch) { DL_COMMIT(c + 1); if (c + 2 < nch) DL_STAGE(c + 2); }
    }
    SC_BAR();
    if (wid == ((L - 1) & 7)) DL_FINAL(L - 1);
#pragma unroll
    for (int j = 0; j < 8; ++j) st_out[(8 * wid + j) * 64 + lane] = S[j];
    if (pfacc == 1.2345678e33f) st_out[0] = pfacc;
    __syncthreads();
#undef DL_STAGE
#undef DL_COMMIT
#undef DL_FINAL
#undef DL_STEP
}

__device__ __forceinline__ void sample_attn(KArgs A, int l, LAS unsigned char* lds, int unit, int tid) {
    unsigned char* ws = A->ws;
    const int sb = unit >> 2, h = unit & 3;
    LAS float* qs = (LAS float*)lds;
    LAS float* sc = qs + 2048;
    LAS float* scl = sc + 1024;
    LAS float* ssq = scl + 32;
    LAS float* lsum = ssq + 512;
    const bfu* qb = (const bfu*)slotp(ws, l, 4); bfu* mix = (bfu*)slotp(ws, l, 7);
    const float* ck = A->in[2] + (size_t)(l * 8 + sb) * 2048 * 512 + h * 128; const float* cv = A->in[3] + (size_t)(l * 8 + sb) * 2048 * 512 + h * 128;
    const float* nk = A->out + O_BKS + (size_t)(l * 8 + sb) * 16 * 512 + h * 128; const float* nv = A->out + O_BVS + (size_t)(l * 8 + sb) * 16 * 512 + h * 128;
    const float* lf = (const float*)(ws + WS_CTL + 1024); const float lam = lf[2 * l], omli = 1.f - lf[2 * l + 1];
    __syncthreads();
    for (int i = tid; i < 2048; i += NTHR) { const int map = i >> 10, qi = (i >> 6) & 15, p = i & 63; const int s = p >> 5, n_ = (p >> 4) & 1, r = p & 15;
        qs[(map * 16 + qi) * 64 + n_ * 32 + s * 16 + r] = bf2f(qb[(size_t)(MP + sb * 16 + qi) * 512 + h * 128 + map * 64 + p]); }
    float mrun = -1e30f, lrun = 0.f;
    const int qi = tid & 15, kj = tid >> 4, eg = tid >> 4;
    f32x4 acc0 = {0.f, 0.f, 0.f, 0.f}, acc1 = {0.f, 0.f, 0.f, 0.f};
    __syncthreads();
    for (int tile = 0; tile < 65; ++tile) {
        const int kidx = tile * 32 + kj;
        float s1 = -1e30f, s2 = -1e30f;
        if (kidx < 2064) { const float* kr = kidx < 2048 ? ck + (size_t)kidx * 512 : nk + (size_t)(kidx - 2048) * 512; s1 = 0.f; s2 = 0.f;
#pragma unroll 4
            for (int d = 0; d < 64; d += 4) { const f32x4 k1 = *(const f32x4*)(kr + d), k2 = *(const f32x4*)(kr + 64 + d); const LAS float* q1 = qs + qi * 64 + d; const LAS float* q2 = qs + (16 + qi) * 64 + d;
                s1 += q1[0] * k1[0] + q1[1] * k1[1] + q1[2] * k1[2] + q1[3] * k1[3]; s2 += q2[0] * k2[0] + q2[1] * k2[1] + q2[2] * k2[2] + q2[3] * k2[3]; } }
        sc[qi * 32 + kj] = s1; sc[(16 + qi) * 32 + kj] = s2;
        __syncthreads();
        if (tid < 32) { LAS float* r = sc + tid * 32; float mx = mrun;
#pragma unroll 8
            for (int j = 0; j < 32; ++j) mx = fmaxf(mx, r[j]);
            const float f = exp2f(mrun - mx); float su = 0.f;
#pragma unroll 8
            for (int j = 0; j < 32; ++j) { const float p = exp2f(r[j] - mx); r[j] = p; su += p; }
            lrun = lrun * f + su; mrun = mx; scl[tid] = f; }
        __syncthreads();
        { const float f0 = scl[qi], f1 = scl[16 + qi]; acc0 = acc0 * f0; acc1 = acc1 * f1;
            const int nk_ = tile < 64 ? 32 : 16;
            for (int j = 0; j < nk_; ++j) { const int kx = tile * 32 + j; const float* vr = (kx < 2048 ? cv + (size_t)kx * 512 : nv + (size_t)(kx - 2048) * 512) + eg * 4;
                const f32x4 v = *(const f32x4*)vr; acc0 = acc0 + v * sc[qi * 32 + j]; acc1 = acc1 + v * sc[(16 + qi) * 32 + j]; } }
        __syncthreads();
    }
    if (tid < 32) lsum[tid] = lrun;
    __syncthreads();
    const f32x4 o = acc0 * (1.f / lsum[qi]) - acc1 * (lam / lsum[16 + qi]);
    ssq[qi * 32 + eg] = (o[0] * o[0] + o[1] * o[1]) + (o[2] * o[2] + o[3] * o[3]);
    __syncthreads();
    float ss = 0.f;
#pragma unroll 8
    for (int j = 0; j < 32; ++j) ss += ssq[qi * 32 + j];
    const float rn = rsqrtf(ss * (1.f / 128.f) + 1e-6f) * omli; const float* bn = A->in[20] + l * 128 + eg * 4;
    v2u w; w.x = pk2(o[0] * rn * bn[0], o[1] * rn * bn[1]); w.y = pk2(o[2] * rn * bn[2], o[3] * rn * bn[3]);
    *(v2u*)(mix + (size_t)(MP + sb * 16 + qi) * 1024 + 256 + h * 128 + eg * 4) = w;
    __syncthreads();
}

#define PH_BEGIN \
        KArgs A = (KArgs)__builtin_amdgcn_kernarg_segment_ptr(); \
        int tid = wv * 64 + (int)__builtin_amdgcn_mbcnt_hi(~0u, __builtin_amdgcn_mbcnt_lo(~0u, 0u)); asm volatile("" : "+v"(tid)); tid &= 511; \
        const int bid = blockIdx.x, G = gridDim.x; \
        const int lane = tid & 63, wave = wv; \
        const int gw = bid * NWAVES + wave, NGW = G * NWAVES, gtid = bid * NTHR + tid, NT = G * NTHR; \
        unsigned char* ws = A->ws; float* rsb = (float*)(ws + WS_RS); unsigned char* wb = ws + WS_W; \
        (void)lane; (void)gw; (void)NGW; (void)gtid; (void)NT; (void)rsb; (void)wb;
#define IN(k) (lo <= (k) && (k) < hi)
__device__ __forceinline__ void grid_bar(unsigned* bar, unsigned target, bool leader) {
    asm volatile("s_waitcnt vmcnt(0) lgkmcnt(0)" ::: "memory");
    __syncthreads();
    if (leader) {
        __builtin_amdgcn_fence(__ATOMIC_RELEASE, "agent");
        asm volatile("s_waitcnt vmcnt(0)" ::: "memory");
        __hip_atomic_fetch_add(bar, 1u, __ATOMIC_RELAXED, __HIP_MEMORY_SCOPE_AGENT);
        unsigned spins = 0;
        while (__hip_atomic_load(bar, __ATOMIC_RELAXED, __HIP_MEMORY_SCOPE_AGENT) < target) { __builtin_amdgcn_s_sleep(2); if (++spins > (1u << 27)) break; }
        __builtin_amdgcn_fence(__ATOMIC_ACQUIRE, "agent");
        asm volatile("s_waitcnt vmcnt(0)" ::: "memory");
    }
    __syncthreads();
}
#define SEAM(k) do { if ((k) + 1 < hi) { grid_bar((unsigned*)(ws + WS_CTL + 4096), (unsigned)((k) + 1 - lo) * (unsigned)G, tid == 0); } } while (0)
__global__ void __launch_bounds__(NTHR, 2) hybrid_fwd(Args Aval) {
    extern __shared__ __attribute__((aligned(16))) unsigned char lds_raw[];
    LAS unsigned char* lds = (LAS unsigned char*)lds_raw;
    const int lo = Aval.ph_lo, hi = Aval.ph_hi;
    if (Aval.ph_lo < 0) cg::this_grid().sync();
    const int wv = __builtin_amdgcn_readfirstlane(threadIdx.x >> 6);
    if (IN(0)) { PH_BEGIN prologue(A, lds, gw, NGW, lane, wave, gtid, NT); SEAM(0); }
    { constexpr int l = 0;

        const int p0 = 1 + 11 * l;
        if (IN(p0 + 0)) { PH_BEGIN
            pg8::Gemm g{(const pg8::bf16_t*)slotp(ws, l, 0), (const pg8::bf16_t*)(wb + W_IN), MPAD, NIN, 1024};
            pg8::StaticOrder S; S.init(MPAD, NIN, G, bid);
            EpiG1 E{rsb + (size_t)(3 * l) * MPAD, (bfu*)slotp(ws, l, 2), (bfu*)slotp(ws, l, 4), (bfu*)slotp(ws, l, 5), (bfu*)slotp(ws, l, 6), (bfu*)slotp(ws, l, 7), (float*)(ws + WS_AB), (const float*)(ws + WS_ROPE),
                    A->out + O_BKP + (size_t)l * MP * 512, A->out + O_BVP + (size_t)l * MP * 512, A->out + O_BKS + (size_t)l * MS * 512, A->out + O_BVS + (size_t)l * MS * 512};
            pg8::gemm_phase<EpiG1, pg8::StaticOrder, true, true>((PG8_LAS unsigned char*)lds, g, S, E, wv);
            SEAM(p0 + 0); }
        if (IN(p0 + 1)) { PH_BEGIN
            prep_a(A, l, gw, NGW, lane); prep_c1(A, l, gw, NGW, lane);
            if (l == 1) conv_weights(A, 1, 2, lds, gw, NGW, lane, wave);
            SEAM(p0 + 1); }
        if (IN(p0 + 2)) { PH_BEGIN
            pg8::Gemm g{(const pg8::bf16_t*)slotp(ws, l, 12), (const pg8::bf16_t*)(wb + W_LR), MPAD, 768, 256};
            pg8::StaticOrder S; S.init(MPAD, 768, G, bid);
            EpiB<0> E{(bfu*)slotp(ws, l, 13), 768, nullptr};
            pg8::gemm_phase<EpiB<0>, pg8::StaticOrder, true, true>((PG8_LAS unsigned char*)lds, g, S, E, wv);
            SEAM(p0 + 2); }
        if (IN(p0 + 3)) { PH_BEGIN prep_c2(A, l, bid, G, tid); SEAM(p0 + 3); }
        if (IN(p0 + 4)) { PH_BEGIN
            if (bid < 32) { const int b = bid >> 2, h = bid & 3;
                scan_rwkv(A, l, lds, h, b * 8192, 8192, 64, 6, b * 128, nullptr, A->out + O_CWP + (size_t)((l * 8 + b) * 4 + h) * 4096, tid);
                scan_rwkv(A, l, lds, h, MP + b * 16, 16, 16, 4, 1024 + b, A->in[7] + (size_t)((l * 8 + b) * 4 + h) * 4096, A->out + O_CWS + (size_t)((l * 8 + b) * 4 + h) * 4096, tid);
            } else if (bid < 64) { const int b = (bid - 32) >> 2, h = bid & 3;
                scan_delta(A, l, lds, h, b * 8192, 8192, 64, 6, nullptr, A->out + O_ADP + (size_t)((l * 8 + b) * 4 + h) * 4096, tid);
                scan_delta(A, l, lds, h, MP + b * 16, 16, 16, 4, A->in[5] + (size_t)((l * 8 + b) * 4 + h) * 4096, A->out + O_ADS + (size_t)((l * 8 + b) * 4 + h) * 4096, tid);
            } else if (bid < 96) { sample_attn(A, l, lds, bid - 64, tid); }
            __syncthreads();
            unsigned* ctr = (unsigned*)(ws + WS_CTL) + 16 * l; volatile LAS unsigned* qw = (volatile LAS unsigned*)(lds + MISC_OFF);
            const attn_body::bf16* Q = (const attn_body::bf16*)slotp(ws, l, 4); const attn_body::bf16* K = (const attn_body::bf16*)slotp(ws, l, 5); const attn_body::bf16* V = (const attn_body::bf16*)slotp(ws, l, 6);
            attn_body::bf16* O = (attn_body::bf16*)slotp(ws, l, 13);
            for (;;) {
                if (tid == 0) qw[0] = atomicAdd(ctr, 1u);
                __syncthreads();
                const unsigned u = qw[0];
                __syncthreads();
                if (u >= 4096u) break;
                const int qb = 31 - (int)(u >> 7), bh = (int)(u & 127);
                attn_body::attn_unit<8>(bh >> 4, bh & 15, qb, Q, K, V, O, (char*)lds_raw, wv);
            }
            SEAM(p0 + 4); }
        if (IN(p0 + 5)) { PH_BEGIN
            post_attn(A, l, gw, NGW, lane);
            conv_p(A, l, (bfu*)slotp(ws, l, 10), gtid, NT);
            if (l == 0) conv_weights(A, 1, 1, lds, gw, NGW, lane, wave);
            SEAM(p0 + 5); }
        if (IN(p0 + 6)) { PH_BEGIN
            pg8::Gemm g{(const pg8::bf16_t*)slotp(ws, l, 7), (const pg8::bf16_t*)(wb + W_OUT), MPAD, 1024, 1024};
            pg8::StaticOrder S; S.init(MPAD, 1024, G, bid);
            EpiH<2> E{A->out, (bfu*)slotp(ws, l, 0), rsb + (size_t)(3 * l + 1) * MPAD, nullptr, nullptr};
            pg8::gemm_phase<EpiH<2>, pg8::StaticOrder, true, true>((PG8_LAS unsigned char*)lds, g, S, E, wv);
            SEAM(p0 + 6); }
        if (IN(p0 + 7)) { PH_BEGIN
            pg8::Gemm g{(const pg8::bf16_t*)slotp(ws, l, 0), (const pg8::bf16_t*)(wb + W_FF1), MPAD, FFD, 1024};
            pg8::StaticOrder S; S.init(MPAD, FFD, G, bid);
            EpiB<1> E{(bfu*)slotp(ws, l, 2), FFD, rsb + (size_t)(3 * l + 1) * MPAD};
            pg8::gemm_phase<EpiB<1>, pg8::StaticOrder, true, true>((PG8_LAS unsigned char*)lds, g, S, E, wv);
            SEAM(p0 + 7); }
        if (IN(p0 + 8)) { PH_BEGIN
            pg8::Gemm g{(const pg8::bf16_t*)slotp(ws, l, 2), (const pg8::bf16_t*)(wb + W_FF2), MPAD, 1024, FFD};
            pg8::StaticOrder S; S.init(MPAD, 1024, G, bid);
            EpiH<2> E{A->out, (bfu*)slotp(ws, l, 0), rsb + (size_t)(3 * l + 2) * MPAD, nullptr, nullptr};
            pg8::gemm_phase<EpiH<2>, pg8::StaticOrder, true, true>((PG8_LAS unsigned char*)lds, g, S, E, wv);
            SEAM(p0 + 8); }
        if (IN(p0 + 9)) { PH_BEGIN
            pg8::Gemm g{(const pg8::bf16_t*)slotp(ws, l, 10), (const pg8::bf16_t*)(wb + W_PP), MPAD, 1024, 256};
            pg8::StaticOrder S; S.init(MPAD, 1024, G, bid);
            EpiB<0> E{(bfu*)slotp(ws, l, 11), 1024, nullptr};
            pg8::gemm_phase<EpiB<0>, pg8::StaticOrder, true, true>((PG8_LAS unsigned char*)lds, g, S, E, wv);
            SEAM(p0 + 9); }
        if (IN(p0 + 10)) { PH_BEGIN
            pg8::Gemm g{(const pg8::bf16_t*)slotp(ws, l, 0), (const pg8::bf16_t*)(wb + W_GATE), MPAD, 1024, 1024};
            pg8::StaticOrder S; S.init(MPAD, 1024, G, bid);
            EpiH<3> E{A->out, (bfu*)slotp(ws, l, 13), rsb + (size_t)(3 * l + 3) * MPAD, rsb + (size_t)(3 * l + 2) * MPAD, (const bfu*)slotp(ws, l, 11)};
            pg8::gemm_phase<EpiH<3>, pg8::StaticOrder, true, true>((PG8_LAS unsigned char*)lds, g, S, E, wv);
            SEAM(p0 + 10); }
        }
    { constexpr int l = 1;

        const int p0 = 1 + 11 * l;
        if (IN(p0 + 0)) { PH_BEGIN
            pg8::Gemm g{(const pg8::bf16_t*)slotp(ws, l, 0), (const pg8::bf16_t*)(wb + W_IN), MPAD, NIN, 1024};
            pg8::StaticOrder S; S.init(MPAD, NIN, G, bid);
            EpiG1 E{rsb + (size_t)(3 * l) * MPAD, (bfu*)slotp(ws, l, 2), (bfu*)slotp(ws, l, 4), (bfu*)slotp(ws, l, 5), (bfu*)slotp(ws, l, 6), (bfu*)slotp(ws, l, 7), (float*)(ws + WS_AB), (const float*)(ws + WS_ROPE),
                    A->out + O_BKP + (size_t)l * MP * 512, A->out + O_BVP + (size_t)l * MP * 512, A->out + O_BKS + (size_t)l * MS * 512, A->out + O_BVS + (size_t)l * MS * 512};
            pg8::gemm_phase<EpiG1, pg8::StaticOrder, true, true>((PG8_LAS unsigned char*)lds, g, S, E, wv);
            SEAM(p0 + 0); }
        if (IN(p0 + 1)) { PH_BEGIN
            prep_a(A, l, gw, NGW, lane); prep_c1(A, l, gw, NGW, lane);
            if (l == 1) conv_weights(A, 1, 2, lds, gw, NGW, lane, wave);
            SEAM(p0 + 1); }
        if (IN(p0 + 2)) { PH_BEGIN
            pg8::Gemm g{(const pg8::bf16_t*)slotp(ws, l, 12), (const pg8::bf16_t*)(wb + W_LR), MPAD, 768, 256};
            pg8::StaticOrder S; S.init(MPAD, 768, G, bid);
            EpiB<0> E{(bfu*)slotp(ws, l, 13), 768, nullptr};
            pg8::gemm_phase<EpiB<0>, pg8::StaticOrder, true, true>((PG8_LAS unsigned char*)lds, g, S, E, wv);
            SEAM(p0 + 2); }
        if (IN(p0 + 3)) { PH_BEGIN prep_c2(A, l, bid, G, tid); SEAM(p0 + 3); }
        if (IN(p0 + 4)) { PH_BEGIN
            if (bid < 32) { const int b = bid >> 2, h = bid & 3;
                scan_rwkv(A, l, lds, h, b * 8192, 8192, 64, 6, b * 128, nullptr, A->out + O_CWP + (size_t)((l * 8 + b) * 4 + h) * 4096, tid);
                scan_rwkv(A, l, lds, h, MP + b * 16, 16, 16, 4, 1024 + b, A->in[7] + (size_t)((l * 8 + b) * 4 + h) * 4096, A->out + O_CWS + (size_t)((l * 8 + b) * 4 + h) * 4096, tid);
            } else if (bid < 64) { const int b = (bid - 32) >> 2, h = bid & 3;
                scan_delta(A, l, lds, h, b * 8192, 8192, 64, 6, nullptr, A->out + O_ADP + (size_t)((l * 8 + b) * 4 + h) * 4096, tid);
                scan_delta(A, l, lds, h, MP + b * 16, 16, 16, 4, A->in[5] + (size_t)((l * 8 + b) * 4 + h) * 4096, A->out + O_ADS + (size_t)((l * 8 + b) * 4 + h) * 4096, tid);
            } else if (bid < 96) { sample_attn(A, l, lds, bid - 64, tid); }
            __syncthreads();
            unsigned* ctr = (unsigned*)(ws + WS_CTL) + 16 * l; volatile LAS unsigned* qw = (volatile LAS unsigned*)(lds + MISC_OFF);
            const attn_body::bf16* Q = (const attn_body::bf16*)slotp(ws, l, 4); const attn_body::bf16* K = (const attn_body::bf16*)slotp(ws, l, 5); const attn_body::bf16* V = (const attn_body::bf16*)slotp(ws, l, 6);
            attn_body::bf16* O = (attn_body::bf16*)slotp(ws, l, 13);
            for (;;) {
                if (tid == 0) qw[0] = atomicAdd(ctr, 1u);
                __syncthreads();
                const unsigned u = qw[0];
                __syncthreads();
                if (u >= 4096u) break;
                const int qb = 31 - (int)(u >> 7), bh = (int)(u & 127);
                attn_body::attn_unit<8>(bh >> 4, bh & 15, qb, Q, K, V, O, (char*)lds_raw, wv);
            }
            SEAM(p0 + 4); }
        if (IN(p0 + 5)) { PH_BEGIN
            post_attn(A, l, gw, NGW, lane);
            conv_p(A, l, (bfu*)slotp(ws, l, 10), gtid, NT);
            if (l == 0) conv_weights(A, 1, 1, lds, gw, NGW, lane, wave);
            SEAM(p0 + 5); }
        if (IN(p0 + 6)) { PH_BEGIN
            pg8::Gemm g{(const pg8::bf16_t*)slotp(ws, l, 7), (const pg8::bf16_t*)(wb + W_OUT), MPAD, 1024, 1024};
            pg8::StaticOrder S; S.init(MPAD, 1024, G, bid);
            EpiH<2> E{A->out, (bfu*)slotp(ws, l, 0), rsb + (size_t)(3 * l + 1) * MPAD, nullptr, nullptr};
            pg8::gemm_phase<EpiH<2>, pg8::StaticOrder, true, true>((PG8_LAS unsigned char*)lds, g, S, E, wv);
            SEAM(p0 + 6); }
        if (IN(p0 + 7)) { PH_BEGIN
            pg8::Gemm g{(const pg8::bf16_t*)slotp(ws, l, 0), (const pg8::bf16_t*)(wb + W_FF1), MPAD, FFD, 1024};
            pg8::StaticOrder S; S.init(MPAD, FFD, G, bid);
            EpiB<1> E{(bfu*)slotp(ws, l, 2), FFD, rsb + (size_t)(3 * l + 1) * MPAD};
            pg8::gemm_phase<EpiB<1>, pg8::StaticOrder, true, true>((PG8_LAS unsigned char*)lds, g, S, E, wv);
            SEAM(p0 + 7); }
        if (IN(p0 + 8)) { PH_BEGIN
            pg8::Gemm g{(const pg8::bf16_t*)slotp(ws, l, 2), (const pg8::bf16_t*)(wb + W_FF2), MPAD, 1024, FFD};
            pg8::StaticOrder S; S.init(MPAD, 1024, G, bid);
            EpiH<2> E{A->out, (bfu*)slotp(ws, l, 0), rsb + (size_t)(3 * l + 2) * MPAD, nullptr, nullptr};
            pg8::gemm_phase<EpiH<2>, pg8::StaticOrder, true, true>((PG8_LAS unsigned char*)lds, g, S, E, wv);
            SEAM(p0 + 8); }
        if (IN(p0 + 9)) { PH_BEGIN
            pg8::Gemm g{(const pg8::bf16_t*)slotp(ws, l, 10), (const pg8::bf16_t*)(wb + W_PP), MPAD, 1024, 256};
            pg8::StaticOrder S; S.init(MPAD, 1024, G, bid);
            EpiB<0> E{(bfu*)slotp(ws, l, 11), 1024, nullptr};
            pg8::gemm_phase<EpiB<0>, pg8::StaticOrder, true, true>((PG8_LAS unsigned char*)lds, g, S, E, wv);
            SEAM(p0 + 9); }
        if (IN(p0 + 10)) { PH_BEGIN
            pg8::Gemm g{(const pg8::bf16_t*)slotp(ws, l, 0), (const pg8::bf16_t*)(wb + W_GATE), MPAD, 1024, 1024};
            pg8::StaticOrder S; S.init(MPAD, 1024, G, bid);
            EpiH<3> E{A->out, (bfu*)slotp(ws, l, 13), rsb + (size_t)(3 * l + 3) * MPAD, rsb + (size_t)(3 * l + 2) * MPAD, (const bfu*)slotp(ws, l, 11)};
            pg8::gemm_phase<EpiH<3>, pg8::StaticOrder, true, true>((PG8_LAS unsigned char*)lds, g, S, E, wv);
            SEAM(p0 + 10); }
        }
    if (IN(NPHASE - 1)) { PH_BEGIN final_norm(A, gw, NGW, lane); }
}
#undef PH_BEGIN
#undef IN
#undef SEAM

extern "C" void kernel_launch(void* const* d_in, const int* in_sizes, int n_in, void* d_out, int out_size, void* d_ws, size_t ws_size, hipStream_t stream) {
    static int grid = 0;
    if (grid == 0) {
        if (n_in != 40 || (size_t)out_size != O_END || ws_size < WS_SLOT + 15 * USLOT) { fprintf(stderr, "kernel_launch: unexpected shapes (n_in %d out %d ws %zu)\n", n_in, out_size, ws_size); grid = -1; return; }
        int dev = 0, cus = 0, per_cu = 0;
        if (hipGetDevice(&dev) != hipSuccess || hipDeviceGetAttribute(&cus, hipDeviceAttributeMultiprocessorCount, dev) != hipSuccess) { grid = -1; return; }
        if (hipFuncSetAttribute((const void*)hybrid_fwd, hipFuncAttributeMaxDynamicSharedMemorySize, LDS_BYTES) != hipSuccess) { fprintf(stderr, "kernel_launch: hipFuncSetAttribute failed\n"); grid = -1; return; }
        if (hipOccupancyMaxActiveBlocksPerMultiprocessor(&per_cu, (const void*)hybrid_fwd, NTHR, LDS_BYTES) != hipSuccess || per_cu < 1) { fprintf(stderr, "kernel_launch: occupancy query says %d\n", per_cu); per_cu = 1; }
        (void)hipGetLastError();
        grid = cus;
    }
    if (grid < 0) return;
    if (hipMemsetAsync((char*)d_ws + WS_CTL, 0, 64 * 1024, stream) != hipSuccess) { fprintf(stderr, "kernel_launch: memset failed\n"); return; }
    Args a{};
    for (int i = 0; i < 40; ++i) a.in[i] = (const float*)d_in[i];
    a.out = (float*)d_out; a.ws = (unsigned char*)d_ws;
#if MK_ONE_LAUNCH
    a.ph_lo = 0; a.ph_hi = NPHASE;
    void* args[] = {&a};
    hipError_t e = hipLaunchCooperativeKernel((const void*)hybrid_fwd, dim3(grid), dim3(NTHR), args, LDS_BYTES, stream);
    if (e != hipSuccess) fprintf(stderr, "kernel_launch: cooperative launch failed: %s (grid %d)\n", hipGetErrorString(e), grid);
#else
    for (int ph = 0; ph < NPHASE; ++ph) { a.ph_lo = ph; a.ph_hi = ph + 1; hipLaunchKernelGGL(hybrid_fwd, dim3(grid), dim3(NTHR), LDS_BYTES, stream, a); }
#endif
}
```

```cpp
#include <hip/hip_runtime.h>
#include <hip/hip_cooperative_groups.h>
#include <cstdio>
#include <cstdint>
namespace cg = cooperative_groups;
namespace pg8 {
#define PG8_LAS __attribute__((address_space(3)))
typedef unsigned short bf16_t;
typedef short bf16x8 __attribute__((ext_vector_type(8)));
typedef float f32x4 __attribute__((ext_vector_type(4)));
typedef unsigned u32x4 __attribute__((ext_vector_type(4)));
constexpr int BM = 256, BK = 64, HALF = 128, HTB = HALF * BK * 2  , STAGE_BYTES = 8 * HTB, NXCD = 8, WGM = 8;

__host__ __device__ __forceinline__ int lds_byte(int r, int c) { const int st = (r >> 4) * 2 + (c >> 5), rr = r & 15, cc = c & 31, ob = rr * 64 + cc * 2; return st * 1024 + (ob ^ (((ob >> 9) & 1) << 5)); }
__host__ __device__ __forceinline__ void stage_rc(int b, int& R, int& C) { const int st = b / 1024, sb = b % 1024, swz = sb ^ (((sb >> 9) & 1) << 5); R = (st >> 1) * 16 + swz / 64; C = (st & 1) * 32 + (swz % 64) / 2; }
__host__ __device__ __forceinline__ int perm32(int rho) { const int n = rho >> 4, i = rho & 15; return 8 * (i >> 2) + 4 * n + (i & 3); }

struct Unit { int pm, pn; };
struct Gemm { const bf16_t* A; const bf16_t* Bt; int M, N, K; };

struct StaticOrder {
    int nM, nN, nwg, G, c;
    __host__ __device__ void init(int M, int N, int G_, int c_) { nM = M / BM; nN = N / BM; nwg = nM * nN; G = G_; c = c_; }
    __host__ __device__ bool next(int i, Unit& u) const {
        const long L = (long)i * G + c; if (L >= nwg) return false;
        int wgid = (int)L; { const int q = nwg / NXCD, r = nwg % NXCD, xcd = wgid % NXCD, off = wgid / NXCD; wgid = (xcd < r ? xcd * (q + 1) : r * (q + 1) + (xcd - r) * q) + off; }
        const int nig = WGM * nN, gid = wgid / nig, fm = gid * WGM, gsz = (nM - fm) < WGM ? (nM - fm) : WGM;
        u.pm = fm + ((wgid % nig) % gsz); u.pn = (wgid % nig) / gsz; return true;
    }
    __device__ __forceinline__ void a_ready(const Unit&) const {}
    __device__ __forceinline__ void done(const Unit&) const {}
};

__device__ __forceinline__ unsigned cvt_pk_bf16(float lo, float hi) { unsigned r; asm volatile("v_cvt_pk_bf16_f32 %0, %1, %2" : "=v"(r) : "v"(lo), "v"(hi)); return r; }
typedef float f32x2 __attribute__((ext_vector_type(2)));
__device__ __forceinline__ f32x2 gelu_pk(f32x2 v) {
    const f32x2 av = __builtin_elementwise_abs(v), d = av * 0.2316418882f + 1.0f;
    f32x2 t; t.x = __builtin_amdgcn_rcpf(d.x); t.y = __builtin_amdgcn_rcpf(d.y);
    f32x2 q = t * 0.5307027145f + (-0.7265760135f); q = q * t + 0.7107068705f; q = q * t + (-0.142248368f); q = q * t + 0.127414796f; q = q * t;
    const f32x2 s = (v * v) * (-0.72134752044f);
    f32x2 e; e.x = __builtin_amdgcn_exp2f(s.x); e.y = __builtin_amdgcn_exp2f(s.y);
    const f32x2 m = v * (q * e), r = v - m;
    f32x2 o; o.x = v.x < 0.f ? m.x : r.x; o.y = v.y < 0.f ? m.y : r.y; return o;
}

template <int ACT  > struct EpiBf16 {
    static constexpr bool PERM = true, AFTER_DRAIN = false; static_assert(ACT == 0 || ACT == 1, "EpiBf16: ACT is 0 (none) or 1 (gelu_pk)");
    bf16_t* O; int ldc; const float* bias; int split_cols; size_t split_stride; float scale0;
    __device__ __forceinline__ void operator()(const f32x4 (&acc)[2][2][4][2], const Unit& u, int wr, int wc, int fr, int fq) const {
        const int row0 = u.pm * BM + wr * 64 + fr; int colt = u.pn * BM; bf16_t* base = O;
        float sc = 1.f; if (split_cols) { const int t = colt / split_cols; base += (size_t)t * split_stride; colt -= t * split_cols; if (t == 0) sc = scale0; }
        const int col0 = colt + wc * 32 + 8 * fq, bcol0 = u.pn * BM + wc * 32 + 8 * fq;
        f32x4 bv[2][2];
#pragma unroll
        for (int bj = 0; bj < 2; ++bj)
#pragma unroll
            for (int n = 0; n < 2; ++n) bv[bj][n] = bias ? *(const f32x4*)(bias + bcol0 + bj * HALF + 4 * n) : (f32x4){0.f, 0.f, 0.f, 0.f};
#pragma unroll
        for (int ai = 0; ai < 2; ++ai)
#pragma unroll
            for (int m = 0; m < 4; ++m) { bf16_t* rowp = base + (size_t)(row0 + ai * HALF + m * 16) * ldc + col0;
#pragma unroll
                for (int bj = 0; bj < 2; ++bj) { f32x4 v0 = acc[ai][bj][m][0] + bv[bj][0], v1 = acc[ai][bj][m][1] + bv[bj][1];
                    if (ACT == 1) { f32x2 a = gelu_pk((f32x2){v0[0], v0[1]}), b = gelu_pk((f32x2){v0[2], v0[3]}), c = gelu_pk((f32x2){v1[0], v1[1]}), d = gelu_pk((f32x2){v1[2], v1[3]});
                        v0 = (f32x4){a.x, a.y, b.x, b.y}; v1 = (f32x4){c.x, c.y, d.x, d.y}; }
                    v0 = v0 * sc; v1 = v1 * sc; u32x4 w; w.x = cvt_pk_bf16(v0[0], v0[1]); w.y = cvt_pk_bf16(v0[2], v0[3]); w.z = cvt_pk_bf16(v1[0], v1[1]); w.w = cvt_pk_bf16(v1[2], v1[3]);
                    *(u32x4*)(rowp + bj * HALF) = w; } }
    }
};

struct PanelStats {
    unsigned* xbuf;
    unsigned* cnt;
    unsigned* tmo;
    int ntn; float eps;
    unsigned code;
    __device__ __forceinline__ bool run(const f32x4 (&v)[2][2][4][2], const Unit& u, int wr, int wc, int fr, int fq, PG8_LAS unsigned char* lds, int wid, int lane) const {
        typedef float f32x2v __attribute__((ext_vector_type(2)));
        PG8_LAS f32x2v* P = (PG8_LAS f32x2v*)lds;
        PG8_LAS f32x2v* S = (PG8_LAS f32x2v*)(lds + 8192);
        PG8_LAS unsigned* flag = (PG8_LAS unsigned*)(lds + 8192 + 2048);
#pragma unroll
        for (int ai = 0; ai < 2; ++ai)
#pragma unroll
            for (int m = 0; m < 4; ++m) {
                float s = 0.f;
#pragma unroll
                for (int bj = 0; bj < 2; ++bj)
#pragma unroll
                    for (int n = 0; n < 2; ++n) { const f32x4 x = v[ai][bj][m][n]; s += (x[0] + x[1]) + (x[2] + x[3]); }
                s += __shfl_xor(s, 16); s += __shfl_xor(s, 32);
                const float mw = s * (1.0f / 64.0f); float q = 0.f;
#pragma unroll
                for (int bj = 0; bj < 2; ++bj)
#pragma unroll
                    for (int n = 0; n < 2; ++n) { const f32x4 d = v[ai][bj][m][n] - mw; q += (d[0] * d[0] + d[1] * d[1]) + (d[2] * d[2] + d[3] * d[3]); }
                q += __shfl_xor(q, 16); q += __shfl_xor(q, 32);
                if (fq == 0) P[(ai * HALF + wr * 64 + m * 16 + fr) * 4 + wc] = (f32x2v){mw, q};
            }
        asm volatile("s_waitcnt lgkmcnt(0)" ::: "memory"); __builtin_amdgcn_s_barrier(); asm volatile("" ::: "memory");
#if defined(BROKEN_EXCHANGE_NO_WAIT)
#warning BROKEN CONTROL BUILD: the row-statistics exchange does not wait; results are wrong by design
        if (blockIdx.x >= 64) { const long long t0_ = clock64(); while (clock64() - t0_ < 60000) __builtin_amdgcn_s_sleep(8); }
#endif
        const int row = wid * 32 + (lane & 31);
        if (lane < 32) {
            const f32x2v a = P[row * 4 + 0], b = P[row * 4 + 1], c = P[row * 4 + 2], d = P[row * 4 + 3];
            const float mt = (a.x + b.x + c.x + d.x) * 0.25f;
            const float da = a.x - mt, db = b.x - mt, dc = c.x - mt, dd = d.x - mt;
            const float m2 = (a.y + b.y) + (c.y + d.y) + 64.0f * ((da * da + db * db) + (dc * dc + dd * dd));
            unsigned long long* slot = (unsigned long long*)xbuf + ((size_t)(u.pm * BM + row) * 4 + u.pn);
            __hip_atomic_store(slot, ((unsigned long long)__float_as_uint(m2) << 32) | __float_as_uint(mt), __ATOMIC_RELAXED, __HIP_MEMORY_SCOPE_AGENT);
        }
        asm volatile("s_waitcnt vmcnt(0)" ::: "memory");
        if (lane == 0) __hip_atomic_fetch_add(cnt + 64 * u.pm, 1u, __ATOMIC_RELAXED, __HIP_MEMORY_SCOPE_AGENT);
        if (wid == 0) {
            bool dead = false; const unsigned long long t0 = __builtin_amdgcn_s_memrealtime(); const unsigned want = 8u * (unsigned)ntn;
            for (;;) {
#if defined(BROKEN_EXCHANGE_NO_WAIT)
                break;
#endif
                if ((unsigned)__builtin_amdgcn_readfirstlane(__hip_atomic_load(cnt + 64 * u.pm, __ATOMIC_RELAXED, __HIP_MEMORY_SCOPE_AGENT)) >= want) break;
                if (__builtin_amdgcn_s_memrealtime() - t0 > 2000000ull) {
                    if (lane == 0) { unsigned expect = 0u; __hip_atomic_compare_exchange_strong(tmo + 1, &expect, code | (unsigned)(u.pm & 0xff), __ATOMIC_RELAXED, __ATOMIC_RELAXED, __HIP_MEMORY_SCOPE_AGENT);
                                     __hip_atomic_store(tmo, 1u, __ATOMIC_RELAXED, __HIP_MEMORY_SCOPE_AGENT); }
                    dead = true; break; }
                __builtin_amdgcn_s_sleep(2);
            }
            __builtin_amdgcn_fence(__ATOMIC_ACQUIRE, "agent");
            if (lane == 0) flag[0] = dead ? 1u : 0u;
        }
        asm volatile("s_waitcnt vmcnt(0) lgkmcnt(0)" ::: "memory"); __builtin_amdgcn_s_barrier(); asm volatile("" ::: "memory");
        const bool bad = flag[0] != 0u;
        if (lane < 32) {
            const unsigned long long* slot = (const unsigned long long*)xbuf + (size_t)(u.pm * BM + row) * 4; float mt[4], m2[4]; float ms = 0.f;
#pragma unroll
            for (int t = 0; t < 4; ++t) { if (t < ntn) { const unsigned long long w = __hip_atomic_load(slot + t, __ATOMIC_RELAXED, __HIP_MEMORY_SCOPE_AGENT); mt[t] = __uint_as_float((unsigned)w); m2[t] = __uint_as_float((unsigned)(w >> 32)); } else { mt[t] = 0.f; m2[t] = 0.f; } ms += mt[t]; }
            const float mean = ms / (float)ntn; float q = 0.f;
#pragma unroll
            for (int t = 0; t < 4; ++t) if (t < ntn) { const float dm = mt[t] - mean; q += m2[t] + 256.0f * dm * dm; }
            S[row] = (f32x2v){mean, 1.0f / sqrtf(q / (256.0f * (float)ntn) + eps)};
        }
        asm volatile("s_waitcnt lgkmcnt(0)" ::: "memory"); __builtin_amdgcn_s_barrier(); asm volatile("" ::: "memory");
        return bad;
    }
};
struct EpiLnRes {
    static constexpr bool PERM = false, AFTER_DRAIN = true;
    const float* base; float* out; int ldc; const float* bias; PanelStats st; unsigned poison;
    __device__ __forceinline__ void fused(f32x4 (&acc)[2][2][4][2], const Unit& u, int wr, int wc, int fr, int fq, PG8_LAS unsigned char* lds, int wid, int lane) const {
        typedef float f32x2v __attribute__((ext_vector_type(2)));
        const PG8_LAS f32x2v* S = (const PG8_LAS f32x2v*)(lds + 8192);
        const int col0 = u.pn * BM + wc * 32 + 4 * fq;
#pragma unroll
        for (int bj = 0; bj < 2; ++bj)
#pragma unroll
            for (int n = 0; n < 2; ++n) { const f32x4 bv = bias ? *(const f32x4*)(bias + col0 + bj * HALF + n * 16) : (f32x4){0.f, 0.f, 0.f, 0.f};
#pragma unroll
                for (int ai = 0; ai < 2; ++ai)
#pragma unroll
                    for (int m = 0; m < 4; ++m) acc[ai][bj][m][n] += bv; }
        f32x4 pre[4][2][2];
#pragma unroll
        for (int m = 0; m < 4; ++m) { const size_t off = (size_t)(u.pm * BM + wr * 64 + m * 16 + fr) * ldc + col0;
#pragma unroll
            for (int bj = 0; bj < 2; ++bj)
#pragma unroll
                for (int n = 0; n < 2; ++n) pre[m][bj][n] = *(const f32x4*)(base + off + bj * HALF + n * 16); }
        const bool bad = st.run(acc, u, wr, wc, fr, fq, lds, wid, lane) || poison != 0u;
        const float qnan = __builtin_nanf("");
#pragma unroll
        for (int ai = 0; ai < 2; ++ai)
#pragma unroll
            for (int m = 0; m < 4; ++m) { const int r = ai * HALF + wr * 64 + m * 16 + fr; const f32x2v sr = S[r]; const size_t off = (size_t)(u.pm * BM + r) * ldc + col0;
#pragma unroll
                for (int bj = 0; bj < 2; ++bj)
#pragma unroll
                    for (int n = 0; n < 2; ++n) { const f32x4 bs = ai == 0 ? pre[m][bj][n] : *(const f32x4*)(base + off + bj * HALF + n * 16); f32x4 o = bs + (acc[ai][bj][m][n] - sr.x) * sr.y;
                        if (bad) o = (f32x4){qnan, qnan, qnan, qnan}; *(f32x4*)(out + off + bj * HALF + n * 16) = o; }
                if (m & 1) asm volatile("" ::: "memory"); }
    }
};
struct EpiLnResLn {
    static constexpr bool PERM = false, AFTER_DRAIN = true;
    const float* base; float* out; bf16_t* xn; int ldc; const float* bias; PanelStats st1, st2; unsigned poison;
    __device__ __forceinline__ void fused(f32x4 (&acc)[2][2][4][2], const Unit& u, int wr, int wc, int fr, int fq, PG8_LAS unsigned char* lds, int wid, int lane) const {
        typedef float f32x2v __attribute__((ext_vector_type(2))); typedef unsigned u32x2v __attribute__((ext_vector_type(2)));
        const PG8_LAS f32x2v* S = (const PG8_LAS f32x2v*)(lds + 8192);
        const int col0 = u.pn * BM + wc * 32 + 4 * fq;
#pragma unroll
        for (int bj = 0; bj < 2; ++bj)
#pragma unroll
            for (int n = 0; n < 2; ++n) { const f32x4 bv = bias ? *(const f32x4*)(bias + col0 + bj * HALF + n * 16) : (f32x4){0.f, 0.f, 0.f, 0.f};
#pragma unroll
                for (int ai = 0; ai < 2; ++ai)
#pragma unroll
                    for (int m = 0; m < 4; ++m) acc[ai][bj][m][n] += bv; }
        bool bad = st1.run(acc, u, wr, wc, fr, fq, lds, wid, lane) || poison != 0u;
        const float qnan = __builtin_nanf("");
#pragma unroll
        for (int ai = 0; ai < 2; ++ai)
#pragma unroll
            for (int m = 0; m < 4; ++m) { const int r = ai * HALF + wr * 64 + m * 16 + fr; const f32x2v sr = S[r]; const size_t off = (size_t)(u.pm * BM + r) * ldc + col0;
#pragma unroll
                for (int bj = 0; bj < 2; ++bj)
#pragma unroll
                    for (int n = 0; n < 2; ++n) { const f32x4 bs = *(const f32x4*)(base + off + bj * HALF + n * 16); acc[ai][bj][m][n] = bs + (acc[ai][bj][m][n] - sr.x) * sr.y; }
                asm volatile("" : "+v"(acc[ai][0][m][0]), "+v"(acc[ai][0][m][1]), "+v"(acc[ai][1][m][0]), "+v"(acc[ai][1][m][1]));
                if (m & 1) asm volatile("" ::: "memory"); }
        const bool bad1 = bad;
        bad = st2.run(acc, u, wr, wc, fr, fq, lds, wid, lane) || bad;
#pragma unroll
        for (int ai = 0; ai < 2; ++ai)
#pragma unroll
            for (int m = 0; m < 4; ++m) { const int r = ai * HALF + wr * 64 + m * 16 + fr; const f32x2v sr = S[r]; const size_t off = (size_t)(u.pm * BM + r) * ldc + col0;
#pragma unroll
                for (int bj = 0; bj < 2; ++bj)
#pragma unroll
                    for (int n = 0; n < 2; ++n) { const f32x4 x1 = acc[ai][bj][m][n]; *(f32x4*)(out + off + bj * HALF + n * 16) = bad1 ? (f32x4){qnan, qnan, qnan, qnan} : x1;
                        const f32x4 o = (x1 - sr.x) * sr.y; u32x2v w; w.x = cvt_pk_bf16(o[0], o[1]); w.y = cvt_pk_bf16(o[2], o[3]);
                        if (bad) { w.x = 0x7fc07fc0u; w.y = 0x7fc07fc0u; } *(u32x2v*)(xn + off + bj * HALF + n * 16) = w; }
                asm volatile("" ::: "memory"); }
    }
};

template <class Epi, class Sched, bool ALIGN_EPI = false, bool SP2 = false>
__device__ __forceinline__ void gemm_phase(PG8_LAS unsigned char* lds, const Gemm g, const Sched& S, const Epi& E, const int wv_) {
    int tid_o = wv_ * 64 + (int)__builtin_amdgcn_mbcnt_hi(~0u, __builtin_amdgcn_mbcnt_lo(~0u, 0u)); asm volatile("" : "+v"(tid_o)); tid_o &= 511;
    const int tid = tid_o, wid = __builtin_amdgcn_readfirstlane(tid >> 6), lane = tid & 63, wr = wid >> 2, wc = wid & 3, fr = lane & 15, fq = lane >> 4;
    const int K = g.K, nt = K / BK;
    unsigned voffA[2], voffB[2];
#pragma unroll
    for (int i = 0; i < 2; ++i) { int R, C; stage_rc(tid * 16 + i * 8192, R, C); const int Rb = Epi::PERM ? ((R & ~31) + perm32(R & 31)) : R;
        voffA[i] = (unsigned)(R * K + C) * 2u; voffB[i] = (unsigned)(Rb * K + C) * 2u; }
    const size_t kstep = (size_t)(BK * 2);
    const size_t hstep = (size_t)HALF * K * 2;
    const size_t tstep = 2 * hstep;
    const unsigned ldsw = (unsigned)wid * 1024u;
    const int aoff = lds_byte(wr * 64 + fr, fq * 8), boff = lds_byte(wc * 32 + fr, fq * 8);
#define PG8_SA(b, h) (((b) * 2 + (h)) * HTB)
#define PG8_SB(b, h) ((4 + (b) * 2 + (h)) * HTB)
#define PG8_STAGE(bufoff, gbase, voff) do { _Pragma("unroll") for (int _i = 0; _i < 2; ++_i) \
        __builtin_amdgcn_global_load_lds((const unsigned*)((const char*)(gbase) + (voff)[_i]), (PG8_LAS unsigned*)(lds + (bufoff) + ldsw + _i * 8192), 16, 0, 0); } while (0)
#define PG8_LDA(dst, b, h) do { _Pragma("unroll") for (int m = 0; m < 4; ++m) _Pragma("unroll") for (int k = 0; k < 2; ++k) dst[m][k] = *(const PG8_LAS bf16x8*)(lds + PG8_SA(b, h) + aoff + m * 2048 + k * 1024); } while (0)
#define PG8_LDB(dst, b, h) do { _Pragma("unroll") for (int n = 0; n < 2; ++n) _Pragma("unroll") for (int k = 0; k < 2; ++k) dst[n][k] = *(const PG8_LAS bf16x8*)(lds + PG8_SB(b, h) + boff + n * 2048 + k * 1024); } while (0)
#define PG8_MMA(ai, bj, At, Bt) do { __builtin_amdgcn_s_setprio(1); _Pragma("unroll") for (int m = 0; m < 4; ++m) _Pragma("unroll") for (int n = 0; n < 2; ++n) _Pragma("unroll") for (int k = 0; k < 2; ++k) \
        acc[ai][bj][m][n] = __builtin_amdgcn_mfma_f32_16x16x32_bf16(Bt[n][k], At[m][k], acc[ai][bj][m][n], 0, 0, 0); __builtin_amdgcn_s_setprio(0); } while (0)
#define PG8_WAIT_V(n) asm volatile("s_waitcnt vmcnt(" #n ")" ::: "memory")
#define PG8_WAIT_L(n) asm volatile("s_waitcnt lgkmcnt(" #n ")" ::: "memory")
#define PG8_BAR __builtin_amdgcn_s_barrier()
#define PG8_SCHED __builtin_amdgcn_sched_barrier(0)
    Unit cur, nxt; int ui = 0;
    if (!S.next(0, cur)) return;
    f32x4 acc[2][2][4][2];
#pragma unroll
    for (int a = 0; a < 2; ++a)
#pragma unroll
        for (int b = 0; b < 2; ++b)
#pragma unroll
            for (int m = 0; m < 4; ++m)
#pragma unroll
                for (int n = 0; n < 2; ++n) acc[a][b][m][n] = (f32x4){0.f, 0.f, 0.f, 0.f};
    bf16x8 At[4][2], B0[2][2], B1[2][2];
    const char* cA = (const char*)g.A + (size_t)cur.pm * tstep; const char* cB = (const char*)g.Bt + (size_t)cur.pn * tstep;
    S.a_ready(cur);
    if constexpr (SP2) {
        PG8_STAGE(PG8_SB(0, 0), cB, voffB); PG8_STAGE(PG8_SB(0, 1), cB + hstep, voffB); PG8_STAGE(PG8_SA(0, 0), cA, voffA); PG8_STAGE(PG8_SA(0, 1), cA + hstep, voffA);
        if (wr == 1) PG8_BAR;
        PG8_WAIT_V(2); PG8_BAR;
        PG8_STAGE(PG8_SB(1, 0), cB + kstep, voffB); PG8_STAGE(PG8_SA(1, 0), cA + kstep, voffA); PG8_STAGE(PG8_SB(1, 1), cB + hstep + kstep, voffB);
        PG8_WAIT_V(6); PG8_BAR;
    } else {
        PG8_STAGE(PG8_SB(0, 0), cB, voffB); PG8_STAGE(PG8_SA(0, 0), cA, voffA); PG8_STAGE(PG8_SB(0, 1), cB + hstep, voffB); PG8_STAGE(PG8_SA(0, 1), cA + hstep, voffA);
        if (wr == 1) PG8_BAR;
        PG8_WAIT_V(4); PG8_BAR;
        PG8_STAGE(PG8_SB(1, 0), cB + kstep, voffB); PG8_STAGE(PG8_SA(1, 0), cA + kstep, voffA); PG8_STAGE(PG8_SB(1, 1), cB + hstep + kstep, voffB);
        PG8_WAIT_V(6); PG8_BAR;
    }
    for (;;) {
        const bool has_next = S.next(ui + 1, nxt);
        const char* nA = has_next ? (const char*)g.A + (size_t)nxt.pm * tstep : cA; const char* nB = has_next ? (const char*)g.Bt + (size_t)nxt.pn * tstep : cB;
        for (int t = 0; t < nt; t += 2) {
            const bool last = (t == nt - 2);
            const char* a1 = cA + (size_t)(t + 1) * kstep;
            const char* a2 = last ? nA : cA + (size_t)(t + 2) * kstep; const char* b2 = last ? nB : cB + (size_t)(t + 2) * kstep;
            const char* a3 = a2 + kstep; const char* b3 = b2 + kstep;
            if (last && has_next) S.a_ready(nxt);
            if constexpr (SP2) {
            PG8_LDB(B0, 0, 0); PG8_LDB(B1, 0, 1); PG8_SCHED; PG8_LDA(At, 0, 0); PG8_STAGE(PG8_SA(1, 1), a1 + hstep, voffA);
            PG8_WAIT_V(8); PG8_WAIT_L(0); PG8_BAR; PG8_MMA(0, 0, At, B0); PG8_MMA(0, 1, At, B1); PG8_BAR; PG8_SCHED;
            PG8_LDA(At, 0, 1); PG8_STAGE(PG8_SB(0, 0), b2, voffB); PG8_STAGE(PG8_SB(0, 1), b2 + hstep, voffB); PG8_STAGE(PG8_SA(0, 0), a2, voffA);
            PG8_WAIT_V(8); PG8_WAIT_L(0); PG8_BAR; PG8_MMA(1, 0, At, B0); PG8_MMA(1, 1, At, B1); PG8_BAR; PG8_SCHED;
            PG8_LDB(B0, 1, 0); PG8_LDB(B1, 1, 1); PG8_SCHED; PG8_LDA(At, 1, 0); PG8_STAGE(PG8_SA(0, 1), a2 + hstep, voffA);
            PG8_WAIT_V(8); PG8_WAIT_L(0); PG8_BAR; PG8_MMA(0, 0, At, B0); PG8_MMA(0, 1, At, B1); PG8_BAR; PG8_SCHED;
            PG8_LDA(At, 1, 1); PG8_STAGE(PG8_SB(1, 0), b3, voffB); PG8_STAGE(PG8_SB(1, 1), b3 + hstep, voffB); PG8_STAGE(PG8_SA(1, 0), a3, voffA);
            PG8_WAIT_V(8); PG8_WAIT_L(0); PG8_BAR; PG8_MMA(1, 0, At, B0); PG8_MMA(1, 1, At, B1); PG8_BAR; PG8_SCHED;
            } else {
            PG8_LDB(B0, 0, 0); PG8_SCHED; PG8_LDA(At, 0, 0); PG8_STAGE(PG8_SA(1, 1), a1 + hstep, voffA);
            PG8_WAIT_L(8); PG8_BAR; PG8_WAIT_L(0); PG8_MMA(0, 0, At, B0); PG8_BAR; PG8_SCHED;
            PG8_LDB(B1, 0, 1); PG8_STAGE(PG8_SB(0, 0), b2, voffB);
            PG8_BAR; PG8_WAIT_L(0); PG8_MMA(0, 1, At, B1); PG8_BAR;
            PG8_LDA(At, 0, 1); PG8_STAGE(PG8_SA(0, 0), a2, voffA);
            PG8_BAR; PG8_WAIT_L(0); PG8_MMA(1, 0, At, B0); PG8_BAR; PG8_SCHED;
            PG8_STAGE(PG8_SB(0, 1), b2 + hstep, voffB);
            PG8_WAIT_V(6); PG8_BAR; PG8_MMA(1, 1, At, B1); PG8_BAR;
            PG8_LDB(B0, 1, 0); PG8_SCHED; PG8_LDA(At, 1, 0); PG8_STAGE(PG8_SA(0, 1), a2 + hstep, voffA);
            PG8_WAIT_L(8); PG8_BAR; PG8_WAIT_L(0); PG8_MMA(0, 0, At, B0); PG8_BAR; PG8_SCHED;
            PG8_LDB(B1, 1, 1); PG8_STAGE(PG8_SB(1, 0), b3, voffB);
            PG8_BAR; PG8_WAIT_L(0); PG8_MMA(0, 1, At, B1); PG8_BAR;
            PG8_LDA(At, 1, 1); PG8_STAGE(PG8_SA(1, 0), a3, voffA);
            PG8_BAR; PG8_WAIT_L(0); PG8_MMA(1, 0, At, B0); PG8_BAR; PG8_SCHED;
            PG8_STAGE(PG8_SB(1, 1), b3 + hstep, voffB);
            PG8_WAIT_V(6); PG8_BAR; PG8_MMA(1, 1, At, B1); PG8_BAR;
            }
        }
        if constexpr (ALIGN_EPI) { if (wr == 0) PG8_BAR; }
        if constexpr (!Epi::AFTER_DRAIN) { E(acc, cur, wr, wc, fr, fq); S.done(cur); }
        if (!has_next) break;
#pragma unroll
        for (int a = 0; a < 2; ++a)
#pragma unroll
            for (int b = 0; b < 2; ++b)
#pragma unroll
                for (int m = 0; m < 4; ++m)
#pragma unroll
                    for (int n = 0; n < 2; ++n) acc[a][b][m][n] = (f32x4){0.f, 0.f, 0.f, 0.f};
        cur = nxt; cA = nA; cB = nB; ++ui;
        if constexpr (ALIGN_EPI) { if (wr == 1) PG8_BAR; }
    }
    PG8_WAIT_V(0);
    if constexpr (!ALIGN_EPI) { if (wr == 0) PG8_BAR; }
    PG8_BAR;
    if constexpr (Epi::AFTER_DRAIN) { E.fused(acc, cur, wr, wc, fr, fq, lds, wid, lane); S.done(cur); }
#undef PG8_SA
#undef PG8_SB
#undef PG8_STAGE
#undef PG8_LDA
#undef PG8_LDB
#undef PG8_MMA
#undef PG8_WAIT_V
#undef PG8_WAIT_L
#undef PG8_BAR
#undef PG8_SCHED
}
}
#include <hip/hip_bf16.h>
#include <cmath>
namespace attn_body {
using bf16=__hip_bfloat16;
using bf16x8=__attribute__((ext_vector_type(8)))short;
using s16x4=__attribute__((ext_vector_type(4)))short;
using f32x16=__attribute__((ext_vector_type(16)))float;
using u32x4=__attribute__((ext_vector_type(4)))unsigned;
constexpr int BATCH=8,NHEAD=16,SEQ=8192,D=64,DM=NHEAD*D,DMI=512,DMO=1024;
constexpr int NW=8,QBLK=32,QB=QBLK*NW,KVBLK=64,NQB=SEQ/QB;
constexpr int ATTN_PITCH=DM, ATTN_UNIT_ROWS=QB;
__device__ __forceinline__ int crow(int r,int hi){return (r&3)+8*(r>>2)+4*hi;}
#define SBAR() __builtin_amdgcn_sched_barrier(0)
__device__ __forceinline__ void cmask(f32x16&p0,f32x16&p1,int jb,int qrel,int hi){
  const float NEG=-INFINITY; int kb=64*jb+4*hi;
  #pragma unroll
  for(int r=0;r<16;++r){ if(jb>(qrel>>6)){p0[r]=NEG;p1[r]=NEG;} } (void)kb;
}

constexpr int NSLOT=3, SLOTB=8192;
constexpr int LDS_K=0, LDS_V=NSLOT*SLOTB, LDS_WS=2*NSLOT*SLOTB, LDS_OST=LDS_WS+NW*64*4, LDS_BYTES=LDS_OST+NW*4096;
constexpr float C2=0.125f*1.4426950408889634f;
__device__ __forceinline__ void glds16(const void*gsrc,unsigned lds_dst){unsigned keep;
  asm volatile("s_mov_b32 %0, m0\n\ts_mov_b32 m0, %2\n\ts_nop 0\n\tglobal_load_lds_dwordx4 %1, off\n\ts_mov_b32 m0, %0":"=&s"(keep):"v"(gsrc),"s"(lds_dst):"memory");}
__device__ __forceinline__ float max3f(float a,float b,float c){float r;asm("v_max3_f32 %0, %1, %2, %3":"=v"(r):"v"(a),"v"(b),"v"(c));return r;}
__device__ __forceinline__ float max2f(float a,float b){float r;asm("v_max_f32_e32 %0, %1, %2":"=v"(r):"v"(a),"v"(b));return r;}
__device__ __forceinline__ float fadd_s(float a,float b){float r;asm("v_add_f32_e32 %0, %1, %2":"=v"(r):"v"(a),"v"(b));return r;}
__device__ __forceinline__ float fsub_s(float a,float b){float r;asm("v_sub_f32_e32 %0, %1, %2":"=v"(r):"v"(a),"v"(b));return r;}
typedef float f32x2_t __attribute__((ext_vector_type(2))); typedef __bf16 bf16x2_t __attribute__((ext_vector_type(2)));
__device__ __forceinline__ unsigned cvtpk_s(float lo,float hi){f32x2_t v={lo,hi};bf16x2_t b=__builtin_convertvector(v,bf16x2_t);return __builtin_bit_cast(unsigned,b);}
#define WAIT_BAR(N) asm volatile("s_waitcnt vmcnt(" #N ") lgkmcnt(0)\n\ts_barrier":::"memory")

__device__ __forceinline__ void qkt(f32x16&p0,f32x16&p1,const char*Kslot,const bf16x8*qr,const f32x16&negm,int r32,int hi){
  const char*kb=Kslot+hi*1024+r32*16;
  #pragma unroll
  for(int d0=0;d0<4;++d0){
    const bf16x8 b0=*reinterpret_cast<const bf16x8*>(kb+d0*2048);
    const bf16x8 b1=*reinterpret_cast<const bf16x8*>(kb+d0*2048+512);
    if(d0==0){p0=__builtin_amdgcn_mfma_f32_32x32x16_bf16(b0,qr[0],negm,0,0,0);p1=__builtin_amdgcn_mfma_f32_32x32x16_bf16(b1,qr[0],negm,0,0,0);}
    else{p0=__builtin_amdgcn_mfma_f32_32x32x16_bf16(b0,qr[d0],p0,0,0,0);p1=__builtin_amdgcn_mfma_f32_32x32x16_bf16(b1,qr[d0],p1,0,0,0);}}
}
typedef __attribute__((address_space(3))) const char* lds_cptr;
typedef short v4i16_t __attribute__((ext_vector_type(4)));
__device__ __forceinline__ void kload8(bf16x8*kf,lds_cptr kp){
  kf[0]=*(const __attribute__((address_space(3))) bf16x8*)(kp);      kf[1]=*(const __attribute__((address_space(3))) bf16x8*)(kp+512);
  kf[2]=*(const __attribute__((address_space(3))) bf16x8*)(kp+2048); kf[3]=*(const __attribute__((address_space(3))) bf16x8*)(kp+2560);
  kf[4]=*(const __attribute__((address_space(3))) bf16x8*)(kp+4096); kf[5]=*(const __attribute__((address_space(3))) bf16x8*)(kp+4608);
  kf[6]=*(const __attribute__((address_space(3))) bf16x8*)(kp+6144); kf[7]=*(const __attribute__((address_space(3))) bf16x8*)(kp+6656);
}
__device__ __forceinline__ void kload2(bf16x8*kf,lds_cptr kp,int j){ kf[2*j]=*(const __attribute__((address_space(3))) bf16x8*)(kp+j*2048); kf[2*j+1]=*(const __attribute__((address_space(3))) bf16x8*)(kp+j*2048+512); }
__device__ __forceinline__ s16x4 vtr(lds_cptr p){ return __builtin_bit_cast(s16x4,__builtin_amdgcn_ds_read_tr16_b64_v4i16((__attribute__((address_space(3))) v4i16_t*)p)); }
__device__ __forceinline__ float rowmax(const f32x16&p0,const f32x16&p1){
  float a=max3f(p0[0],p0[1],p1[0]),b=max3f(p0[2],p0[3],p1[1]);a=max3f(a,p1[2],p1[3]);
  #pragma unroll
  for(int r=4;r<16;r+=4){a=max3f(a,p0[r],p0[r+1]);b=max3f(b,p0[r+2],p0[r+3]);a=max3f(a,p1[r],p1[r+1]);b=max3f(b,p1[r+2],p1[r+3]);}
  const float m=max2f(a,b);
  auto rr=__builtin_amdgcn_permlane32_swap(__float_as_uint(m),__float_as_uint(m),false,false);
  return max2f(__uint_as_float(rr[0]),__uint_as_float(rr[1]));
}
__device__ __forceinline__ void pv(f32x16*o,int vb,bf16x8 pa0,bf16x8 pa1,bf16x8 pa2,bf16x8 pa3){
  #pragma unroll
  for(int d0=0;d0<2;++d0){s16x4 lo[4],hi[4];
    #pragma unroll
    for(int ks=0;ks<4;++ks){
      asm volatile("ds_read_b64_tr_b16 %0,%1 offset:%c2":"=&v"(lo[ks]):"v"(vb),"i"(d0*4096+ks*1024):"memory");
      asm volatile("ds_read_b64_tr_b16 %0,%1 offset:%c2":"=&v"(hi[ks]):"v"(vb),"i"(d0*4096+ks*1024+512):"memory");}
    asm volatile("s_waitcnt lgkmcnt(0)":::"memory");SBAR();
    #define PK(k) (bf16x8){lo[k][0],lo[k][1],lo[k][2],lo[k][3],hi[k][0],hi[k][1],hi[k][2],hi[k][3]}
    o[d0]=__builtin_amdgcn_mfma_f32_32x32x16_bf16(pa0,PK(0),o[d0],0,0,0);
    o[d0]=__builtin_amdgcn_mfma_f32_32x32x16_bf16(pa1,PK(1),o[d0],0,0,0);
    o[d0]=__builtin_amdgcn_mfma_f32_32x32x16_bf16(pa2,PK(2),o[d0],0,0,0);
    o[d0]=__builtin_amdgcn_mfma_f32_32x32x16_bf16(pa3,PK(3),o[d0],0,0,0);
    #undef PK
  }
}

#ifndef ATTN_STORE16
#define ATTN_STORE16(p,v) (*(u32x4*)(p)=(v))
#endif
template<int THRL> __device__ __forceinline__ void attn_unit(int b,int h,int qb,const bf16*Q,const bf16*__restrict__ K,const bf16*__restrict__ V,bf16*O,char*shm,const int wv_){
  int tid_o=wv_*64+(int)__builtin_amdgcn_mbcnt_hi(~0u,__builtin_amdgcn_mbcnt_lo(~0u,0u)); asm volatile("":"+v"(tid_o)); tid_o&=511;
  const int tid=tid_o,lane=tid&63,r32=lane&31,hi=lane>>5; const int wid=__builtin_amdgcn_readfirstlane(tid>>6);
  const long rowbase=(long)b*SEQ; const int q0=qb*QB;
  const bf16*Qw=Q+(rowbase+q0+wid*QBLK)*DMI+(h>>1)*D;
  const bf16*Kh=K+rowbase*DMI+(h>>1)*D,*Vh=V+rowbase*DMI+(h>>2)*128+(h&1)*64;
  const unsigned lds0=(unsigned)(uintptr_t)shm;
  float*wsf=(float*)(shm+LDS_WS)+wid*64;
  const bf16*ksrc=Kh+(long)lane*DMI+wid*8;
  const bf16*vsrc=Vh+(long)(16*(wid&3)+(lane>>2))*DMI+(wid>>2)*32+(lane&3)*8;
  const unsigned kdst=lds0+LDS_K+wid*1024, vdst=lds0+LDS_V+wid*1024;
  #define DMA_K(t,slot) glds16(ksrc+(long)(t)*KVBLK*DMI,(unsigned)__builtin_amdgcn_readfirstlane(kdst+(slot)))
  #define DMA_V(t,slot) glds16(vsrc+(long)(t)*KVBLK*DMI,(unsigned)__builtin_amdgcn_readfirstlane(vdst+(slot)))
  const int vb0=(int)(lds0+LDS_V)+((lane>>4)&1)*32+(lane&3)*8+(4*hi+((lane&15)>>2))*64;
  const char*Kbase=shm+LDS_K; bf16x8 kf[8];
  const lds_cptr shm3=(lds_cptr)shm; const lds_cptr kp0=shm3+LDS_K+hi*1024+r32*16; const lds_cptr vp0=shm3+LDS_V+((lane>>4)&1)*32+(lane&3)*8+(4*hi+((lane&15)>>2))*64;
  const int NT=(q0+QB)/KVBLK;
  DMA_K(0,0);DMA_V(0,0);DMA_K(1,SLOTB);
  bf16x8 qr[4];
  #pragma unroll
  for(int d0=0;d0<4;++d0)qr[d0]=*reinterpret_cast<const bf16x8*>(&Qw[(long)r32*DMI+d0*16+hi*8]);
  float mhat=0.f,l_reg=0.f;f32x16 o[2];o[0]=f32x16{};o[1]=f32x16{};f32x16 negm=f32x16{};asm volatile("":"+v"(negm));
  const int qrel=wid*QBLK+r32;
  #define CMASK(P0,P1,t) do{int jb_=(t)-(NT-4); if(jb_>=0)cmask(P0,P1,jb_,qrel,hi);}while(0)
  bool resc=false;
  #define START(P0,P1) do{ const float rm=rowmax(P0,P1); resc=false; \
    { const float dl=rm; mhat=fadd_s(mhat,dl); \
      _Pragma("unroll") for(int r=0;r<16;++r){P0[r]=fsub_s(P0[r],dl);P1[r]=fsub_s(P1[r],dl);} \
      _Pragma("unroll") for(int r=0;r<16;++r)negm[r]=-mhat; asm volatile("":"+v"(negm)); } \
    _Pragma("unroll") for(int r=0;r<16;++r)P0[r]=__builtin_amdgcn_exp2f(P0[r]); }while(0)
  #define RESC() do{ if(resc){ asm volatile("s_waitcnt lgkmcnt(0)":::"memory"); \
      _Pragma("unroll") for(int d_=0;d_<2;++d_) _Pragma("unroll") for(int r=0;r<16;++r)o[d_][r]*=wsf[crow(r,hi)]; } }while(0)
  f32x16 pA0,pA1,pB0,pB1;
  int sl_prev=0,sl_cur=0,sl_next=SLOTB;
  #define ROT() do{sl_prev=sl_cur;sl_cur=sl_next;sl_next=(sl_next==(NSLOT-1)*SLOTB)?0:sl_next+SLOTB;}while(0)
  DMA_K(2,2*SLOTB);
  WAIT_BAR(3);
  qkt(pA0,pA1,Kbase,qr,negm,r32,hi);asm volatile("s_nop 15\n\ts_nop 7":"+v"(pA0),"+v"(pA1));CMASK(pA0,pA1,0);
  START(pA0,pA1);
  _Pragma("unroll") for(int r=0;r<16;++r)pA1[r]=__builtin_amdgcn_exp2f(pA1[r]);
  WAIT_BAR(0);
  DMA_K(3,0);DMA_V(1,SLOTB);
  ROT();
  kload8(kf,kp0+sl_cur);
  WAIT_BAR(2);
  s16x4 vlo[8],vhi[8]; u32x4 pw0,pw1,pw2,pw3;
  #define PKW(P,B) cvtpk_s(P[B],P[B+1])
  #define PAF(k) __builtin_bit_cast(bf16x8,pw##k)
  #define VFR(i) (bf16x8){vlo[i][0],vlo[i][1],vlo[i][2],vlo[i][3],vhi[i][0],vhi[i][1],vhi[i][2],vhi[i][3]}
  #define PIN(x) asm volatile("":"+v"(x))
  #define MX3(a,b,c) __builtin_fmaxf(__builtin_fmaxf((a),(b)),(c))
  #define GAPA(MF,A0,A1,A2,A3,W0,W1,PW) do{ MF; sacc+=A0; sacc+=A1; sacc+=A2; sacc+=A3; PIN(sacc); W0; W1; PIN(PW); SBAR(); }while(0)
  #define EX(v) __builtin_amdgcn_exp2f(v)
  #define GAPB(MF,X,B) do{ MF; X[B]=EX(X[B]); X[B+1]=EX(X[B+1]); X[B+2]=EX(X[B+2]); X[B+3]=EX(X[B+3]); PIN(X); SBAR(); }while(0)
  #define VRD(i) do{ vlo[i]=vtr(vp_+(((i)>>2)*4096+((i)&3)*1024)); vhi[i]=vtr(vp_+(((i)>>2)*4096+((i)&3)*1024+512)); }while(0)
  #define KRD(G,j) do{ if(G){ kload2(kf,kp0+sl_next,j); SBAR(); } }while(0)
  #define STEP(C0,C1,P0,P1,t,GK,GV,GL) do{ SBAR(); \
    const lds_cptr vp_=vp0+sl_prev; \
    VRD(0); SBAR(); float sacc=(P0[0]+P0[1]); \
    GAPA(C0=__builtin_amdgcn_mfma_f32_32x32x16_bf16(kf[0],qr[0],negm,0,0,0), P0[2],P0[3],P0[4],P0[5],     pw0[0]=PKW(P0,0), pw0[1]=PKW(P0,2), pw0); \
    VRD(4); SBAR(); GAPA(C1=__builtin_amdgcn_mfma_f32_32x32x16_bf16(kf[1],qr[0],negm,0,0,0), P0[6],P0[7],P0[8],P0[9],     pw0[2]=PKW(P0,4), pw0[3]=PKW(P0,6), pw0); \
    VRD(1); SBAR(); GAPA(C0=__builtin_amdgcn_mfma_f32_32x32x16_bf16(kf[2],qr[1],C0,0,0,0),   P0[10],P0[11],P0[12],P0[13], pw1[0]=PKW(P0,8), pw1[1]=PKW(P0,10), pw1); \
    VRD(5); SBAR(); GAPA(C1=__builtin_amdgcn_mfma_f32_32x32x16_bf16(kf[3],qr[1],C1,0,0,0),   P0[14],P0[15],P1[0],P1[1],   pw1[2]=PKW(P0,12),pw1[3]=PKW(P0,14), pw1); \
    VRD(2); SBAR(); GAPA(C0=__builtin_amdgcn_mfma_f32_32x32x16_bf16(kf[4],qr[2],C0,0,0,0),   P1[2],P1[3],P1[4],P1[5],     pw2[0]=PKW(P1,0), pw2[1]=PKW(P1,2), pw2); \
    VRD(6); SBAR(); GAPA(C1=__builtin_amdgcn_mfma_f32_32x32x16_bf16(kf[5],qr[2],C1,0,0,0),   P1[6],P1[7],P1[8],P1[9],     pw2[2]=PKW(P1,4), pw2[3]=PKW(P1,6), pw2); \
    VRD(3); SBAR(); GAPA(C0=__builtin_amdgcn_mfma_f32_32x32x16_bf16(kf[6],qr[3],C0,0,0,0),   P1[10],P1[11],P1[12],P1[13], pw3[0]=PKW(P1,8), pw3[1]=PKW(P1,10), pw3); \
    VRD(7); SBAR(); GAPA(C1=__builtin_amdgcn_mfma_f32_32x32x16_bf16(kf[7],qr[3],C1,0,0,0),   P1[14],P1[15],0.f,0.f,       pw3[2]=PKW(P1,12),pw3[3]=PKW(P1,14), pw3); \
    l_reg+=sacc; \
    if(GK){DMA_K((t)+3,sl_cur);} if(GV){DMA_V((t)+1,sl_next);} \
    CMASK(C0,C1,t); \
    { float a=MX3(C0[0],C0[1],C1[0]),b=MX3(C0[2],C0[3],C1[1]); a=MX3(a,C1[2],C1[3]); \
      _Pragma("unroll") for(int r=4;r<16;r+=4){a=MX3(a,C0[r],C0[r+1]);b=MX3(b,C0[r+2],C0[r+3]);a=MX3(a,C1[r],C1[r+1]);b=MX3(b,C1[r+2],C1[r+3]);} \
      float rm=__builtin_fmaxf(a,b); { auto rr=__builtin_amdgcn_permlane32_swap(__float_as_uint(rm),__float_as_uint(rm),false,false); rm=__builtin_fmaxf(__uint_as_float(rr[0]),__uint_as_float(rr[1])); } \
      resc=false; \
      if(__builtin_expect(__any(rm>(float)THRL),0)){ const float dl=__builtin_fmaxf(rm,0.f); mhat+=dl; \
        _Pragma("unroll") for(int r=0;r<16;++r){C0[r]-=dl;C1[r]-=dl;} \
        _Pragma("unroll") for(int r=0;r<16;++r)negm[r]=-mhat; asm volatile("":"+v"(negm)); \
        const float f=__builtin_amdgcn_exp2f(-dl); l_reg*=f; if(hi==0)wsf[r32]=f; resc=true; } } \
    SBAR(); \
    GAPB(o[0]=__builtin_amdgcn_mfma_f32_32x32x16_bf16(PAF(0),VFR(0),o[0],0,0,0), C0,0); \
    GAPB(o[1]=__builtin_amdgcn_mfma_f32_32x32x16_bf16(PAF(0),VFR(4),o[1],0,0,0), C0,4); \
    KRD(GL,0); GAPB(o[0]=__builtin_amdgcn_mfma_f32_32x32x16_bf16(PAF(1),VFR(1),o[0],0,0,0), C0,8); \
    KRD(GL,1); GAPB(o[1]=__builtin_amdgcn_mfma_f32_32x32x16_bf16(PAF(1),VFR(5),o[1],0,0,0), C0,12); \
    KRD(GL,2); GAPB(o[0]=__builtin_amdgcn_mfma_f32_32x32x16_bf16(PAF(2),VFR(2),o[0],0,0,0), C1,0); \
    KRD(GL,3); GAPB(o[1]=__builtin_amdgcn_mfma_f32_32x32x16_bf16(PAF(2),VFR(6),o[1],0,0,0), C1,4); \
    GAPB(o[0]=__builtin_amdgcn_mfma_f32_32x32x16_bf16(PAF(3),VFR(3),o[0],0,0,0), C1,8); \
    GAPB(o[1]=__builtin_amdgcn_mfma_f32_32x32x16_bf16(PAF(3),VFR(7),o[1],0,0,0), C1,12); \
    }while(0)
  int t=1;
  #undef CMASK
  #define CMASK(P0,P1,t) do{}while(0)
  for(;t+5<NT;t+=2){
    STEP(pB0,pB1,pA0,pA1,t,true,true,true);     WAIT_BAR(2); RESC(); ROT();
    STEP(pA0,pA1,pB0,pB1,t+1,true,true,true);   WAIT_BAR(2); RESC(); ROT();
  }
  #undef CMASK
  #define CMASK(P0,P1,t) do{int jb_=(t)-(NT-4); if(jb_>=0)cmask(P0,P1,jb_,qrel,hi);}while(0)
  #define ENDW(tt) do{ if((tt)+3<NT){WAIT_BAR(2);} else if((tt)+2<NT){WAIT_BAR(1);} else {WAIT_BAR(0);} }while(0)
  for(;t+1<NT;t+=2){
    STEP(pB0,pB1,pA0,pA1,t,(t+3<NT),(t+1<NT),(t+1<NT));       ENDW(t);   RESC(); ROT();
    STEP(pA0,pA1,pB0,pB1,t+1,(t+4<NT),(t+2<NT),(t+2<NT));     ENDW(t+1); RESC(); ROT();
  }
  STEP(pB0,pB1,pA0,pA1,NT-1,false,false,false); RESC();
  { float sacc=pB0[0]+pB0[1]; _Pragma("unroll") for(int r=2;r<16;++r)sacc+=pB0[r]; _Pragma("unroll") for(int r=0;r<16;++r)sacc+=pB1[r]; l_reg+=sacc;
    pw0=(u32x4){PKW(pB0,0),PKW(pB0,2),PKW(pB0,4),PKW(pB0,6)};pw1=(u32x4){PKW(pB0,8),PKW(pB0,10),PKW(pB0,12),PKW(pB0,14)};pw2=(u32x4){PKW(pB1,0),PKW(pB1,2),PKW(pB1,4),PKW(pB1,6)};pw3=(u32x4){PKW(pB1,8),PKW(pB1,10),PKW(pB1,12),PKW(pB1,14)};
    SBAR(); pv(o,vb0+sl_cur,PAF(0),PAF(1),PAF(2),PAF(3)); }
  #undef PKW
  #undef PAF
  #undef VFR
  #undef PIN
  #undef MX3
  #undef GAPA
  #undef GAPB
  #undef EX
  #undef VRD
  #undef KRD
  #undef STEP
  #undef ENDW
  {auto rr=__builtin_amdgcn_permlane32_swap(__float_as_uint(l_reg),__float_as_uint(l_reg),false,false);l_reg=__uint_as_float(rr[0])+__uint_as_float(rr[1]);}
  if(hi==0)wsf[32+r32]=l_reg;asm volatile("s_waitcnt lgkmcnt(0)":::"memory");
  float rli[16];
  #pragma unroll
  for(int r=0;r<16;++r)rli[r]=__builtin_amdgcn_rcpf(wsf[32+crow(r,hi)]);
  bf16*Ow=O+(rowbase+q0+wid*QBLK)*DMO+h*D;
  { bf16*stg=(bf16*)(shm+LDS_OST)+wid*2048;
    #pragma unroll
    for(int r=0;r<16;++r){const int orow=crow(r,hi);
      #pragma unroll
      for(int d0=0;d0<2;++d0)stg[orow*64+d0*32+r32]=__float2bfloat16(o[d0][r]*rli[r]);}
    asm volatile("s_waitcnt lgkmcnt(0)":::"memory");
    #pragma unroll
    for(int i=0;i<4;++i){const int row=i*8+(lane>>3),ch=lane&7; const u32x4 v=*(const u32x4*)(stg+row*64+ch*8); ATTN_STORE16(Ow+(long)row*DMO+ch*8,v);} }
  asm volatile("s_waitcnt lgkmcnt(0)\n\ts_barrier":::"memory");
  #undef DMA_K
  #undef DMA_V
  #undef CMASK
  #undef START
  #undef RESC
  #undef ROT
}
constexpr int ATTN_LDS_BYTES=LDS_BYTES;
struct AttnTensors { const bf16* Q; const bf16* K; const bf16* V; bf16* O; };
struct AttnUnit { int bh; int qb; };
struct StaticOrder {
  int vcu;
  __device__ __forceinline__ explicit StaticOrder(int grid,int block):vcu((block%8)*(grid/8)+block/8){}
  __device__ __forceinline__ bool next(int i,AttnUnit&u)const{ if(i>=4)return false; const int s=vcu&7; u.bh=vcu>>3; u.qb=(i==0)?s:(i==1)?15-s:(i==2)?16+s:31-s; return true; }
  __device__ __forceinline__ void a_ready(const AttnUnit&)const{}
  __device__ __forceinline__ void done(const AttnUnit&)const{}
};
template<class Sched,int THRL=8> __device__ __forceinline__ void attn_phase(char*lds,const AttnTensors&T,const Sched&S){
  AttnUnit u;
  for(int i=0;S.next(i,u);++i){ S.a_ready(u); attn_unit<THRL>(u.bh/NHEAD,u.bh%NHEAD,u.qb,T.Q,T.K,T.V,T.O,lds); S.done(u); }
}
#undef SBAR
#undef WAIT_BAR
}

#define LAS __attribute__((address_space(3)))
typedef unsigned short bfu;
typedef unsigned v4u __attribute__((ext_vector_type(4)));
typedef unsigned v2u __attribute__((ext_vector_type(2)));
typedef float f32x4 __attribute__((ext_vector_type(4)));
typedef float f32x8 __attribute__((ext_vector_type(8)));
typedef float f32x16 __attribute__((ext_vector_type(16)));
typedef float f32x2 __attribute__((ext_vector_type(2)));

constexpr int NWAVES = 8, NTHR = 512;
constexpr int MP = 65536, MS = 128, MR = MP + MS, MPAD = 65792;
constexpr int NIN = 3840, FFD = 4096;
constexpr int NPHASE = 24;
#ifndef MK_ONE_LAUNCH
#define MK_ONE_LAUNCH 1
#endif

constexpr size_t O_Y = 0;
constexpr size_t O_YS = (size_t)MP * 1024;
constexpr size_t O_ACP = O_YS + 128 * 1024;
constexpr size_t O_ADP = O_ACP + 2 * 8 * 3 * 768;
constexpr size_t O_BKP = O_ADP + 2 * 8 * 4 * 64 * 64;
constexpr size_t O_BVP = O_BKP + (size_t)2 * 8 * 8192 * 512;
constexpr size_t O_CSP = O_BVP + (size_t)2 * 8 * 8192 * 512;
constexpr size_t O_CWP = O_CSP + 2 * 8 * 1024;
constexpr size_t O_ACS = O_CWP + 2 * 8 * 4 * 64 * 64;
constexpr size_t O_ADS = O_ACS + 2 * 8 * 3 * 768;
constexpr size_t O_BKS = O_ADS + 2 * 8 * 4 * 64 * 64;
constexpr size_t O_BVS = O_BKS + 2 * 8 * 16 * 512;
constexpr size_t O_CSS = O_BVS + 2 * 8 * 16 * 512;
constexpr size_t O_CWS = O_CSS + 2 * 8 * 1024;
constexpr size_t O_END = O_CWS + 2 * 8 * 4 * 64 * 64;
static_assert(O_END == 202874880, "output size");

constexpr size_t MiB = 1u << 20;
constexpr size_t WS_CTL = 0;
constexpr size_t WS_RS = 64 * 1024;
constexpr size_t WS_BONUS = 2 * MiB;
constexpr size_t WS_GAB = 3 * MiB + 512 * 1024;
constexpr size_t WS_AB = 6 * MiB;
constexpr size_t WS_ROPE = 8 * MiB + 512 * 1024;
constexpr size_t WS_GCH = 10 * MiB + 512 * 1024;
constexpr size_t WS_W = 12 * MiB;
constexpr size_t W_IN = 0, W_OUT = W_IN + (size_t)NIN * 1024 * 2, W_FF1 = W_OUT + 1024 * 1024 * 2, W_FF2 = W_FF1 + 4096 * 1024 * 2,
                 W_GATE = W_FF2 + 4096 * 1024 * 2, W_PP = W_GATE + 1024 * 1024 * 2, W_LR = W_PP + 1024 * 256 * 2, W_END = W_LR + 768 * 256 * 2;
constexpr size_t WS_SLOT = 41 * MiB;
constexpr size_t USLOT = (size_t)MPAD * 1024;
static_assert(WS_W + W_END <= WS_SLOT, "weights");
static_assert(WS_SLOT + 15 * USLOT <= (size_t)1024 * MiB, "ws");
static_assert(WS_RS + 7 * (size_t)MPAD * 4 <= WS_BONUS && WS_BONUS + 4 * (size_t)MPAD * 4 <= WS_GAB && WS_GAB + 8 * (size_t)MPAD * 4 <= WS_AB && WS_AB + 8 * (size_t)MPAD * 4 <= WS_ROPE && WS_ROPE + 8192 * 64 * 4 <= WS_GCH && WS_GCH + 4 * 1032 * 64 * 4 <= WS_W, "ctl map");

__device__ __forceinline__ unsigned char* slotp(unsigned char* ws, int l, int s) {
    if (l & 1) { if (s < 2) s += 13; else if (s >= 13) s -= 13; }
    return ws + WS_SLOT + (size_t)s * USLOT;
}
__device__ __forceinline__ unsigned char* slotph(unsigned char* ws, int l, int s) { return slotp(ws, l, s) + USLOT / 2; }

constexpr int RING_BYTES = 131072, MISC_OFF = RING_BYTES + 320, LDS_BYTES = 147456;

#define LDS_WAIT() asm volatile("s_waitcnt lgkmcnt(0)" ::: "memory")
__device__ __forceinline__ float bf2f(unsigned short u) { return __uint_as_float(((unsigned)u) << 16); }
__device__ __forceinline__ unsigned f2bf(float f) { unsigned u = __builtin_bit_cast(unsigned, f); return (u + 0x7fffu + ((u >> 16) & 1u)) >> 16; }
__device__ __forceinline__ unsigned pk2(float lo, float hi) { return f2bf(lo) | (f2bf(hi) << 16); }
#define DPP_ROR_ADD(v, ctrl) ((v) + __builtin_bit_cast(float, __builtin_amdgcn_update_dpp(0, __builtin_bit_cast(int, (v)), (ctrl), 0xf, 0xf, false)))
__device__ __forceinline__ float wave_sum(float v) {
    v = DPP_ROR_ADD(v, 0x128); v = DPP_ROR_ADD(v, 0x124); v = DPP_ROR_ADD(v, 0x122); v = DPP_ROR_ADD(v, 0x121);
    v += __shfl_xor(v, 16);
    const unsigned u = __float_as_uint(v); auto rr = __builtin_amdgcn_permlane32_swap(u, u, false, false);
    return __uint_as_float(rr[0]) + __uint_as_float(rr[1]);
}
__device__ __forceinline__ float sigm(float x) { return 1.f / (1.f + __expf(-x)); }
__device__ __forceinline__ float softplusf(float x) { return x > 20.f ? x : log1pf(__expf(x)); }

struct Args { const float* in[40]; float* out; unsigned char* ws; int ph_lo, ph_hi; };
typedef const __attribute__((address_space(4))) Args* KArgs;

constexpr float ATT_C2 = 0.125f * 1.4426950408889634f;
struct EpiG1 {
    static constexpr bool PERM = false, AFTER_DRAIN = false;
    const float* rs; bfu *aqkvz, *qb, *kb, *vb, *craw; float* ab; const float* rope; float *okp, *ovp, *oks, *ovs;
    __device__ __forceinline__ void operator()(const pg8::f32x4 (&acc)[2][2][4][2], const pg8::Unit& u, int wr, int wc, int fr, int fq) const {
        const int pn = u.pn; const int rowb = u.pm * 256 + wr * 64 + fr; const int cl = wc * 32 + 4 * fq;
#pragma unroll
        for (int ai = 0; ai < 2; ++ai)
#pragma unroll
            for (int m = 0; m < 4; ++m) {
                const int row = rowb + ai * 128 + m * 16;
                const float s = rsqrtf(rs[row] * (1.f / 1024.f) + 1e-6f);
                if (pn < 4 || (pn >= 10 && pn < 14)) {
                    bfu* dst = (pn < 4 ? aqkvz + pn * 256 : craw + (pn - 10) * 256) + (size_t)row * 1024 + cl;
#pragma unroll
                    for (int bj = 0; bj < 2; ++bj)
#pragma unroll
                        for (int n = 0; n < 2; ++n) { const pg8::f32x4 v = acc[ai][bj][m][n] * s; v2u w; w.x = pg8::cvt_pk_bf16(v[0], v[1]); w.y = pg8::cvt_pk_bf16(v[2], v[3]); *(v2u*)(dst + bj * 128 + n * 16) = w; }
                } else if (pn < 8) {
                    const bool isk = pn >= 6;
                    const int pos = row < MP ? (row & 8191) : 2048 + ((row - MP) & 15);
                    const int i0 = (wc & 1) * 16 + 4 * fq;
                    const pg8::f32x4 c4 = *(const pg8::f32x4*)(rope + pos * 64 + i0), s4 = *(const pg8::f32x4*)(rope + pos * 64 + 32 + i0);
#pragma unroll
                    for (int bj = 0; bj < 2; ++bj) {
                        const pg8::f32x4 x1 = acc[ai][bj][m][0] * s, x2 = acc[ai][bj][m][1] * s;
                        pg8::f32x4 o1 = x1 * c4 - x2 * s4, o2 = x2 * c4 + x1 * s4;
                        if (!isk) {
                            o1 = o1 * ATT_C2; o2 = o2 * ATT_C2;
                            bfu* d = qb + (size_t)row * 512 + (pn - 4) * 256 + bj * 128 + cl;
                            v2u w; w.x = pg8::cvt_pk_bf16(o1[0], o1[1]); w.y = pg8::cvt_pk_bf16(o1[2], o1[3]); *(v2u*)d = w;
                            w.x = pg8::cvt_pk_bf16(o2[0], o2[1]); w.y = pg8::cvt_pk_bf16(o2[2], o2[3]); *(v2u*)(d + 16) = w;
                        } else {
                            bfu* d = kb + (size_t)row * 512 + (pn - 6) * 256 + bj * 128 + cl;
                            v2u w; w.x = pg8::cvt_pk_bf16(o1[0], o1[1]); w.y = pg8::cvt_pk_bf16(o1[2], o1[3]); *(v2u*)d = w;
                            w.x = pg8::cvt_pk_bf16(o2[0], o2[1]); w.y = pg8::cvt_pk_bf16(o2[2], o2[3]); *(v2u*)(d + 16) = w;
                            if (row < MR) {
                                float* ob = (row < MP ? okp + (size_t)row * 512 : oks + (size_t)(row - MP) * 512) + (pn - 6) * 256 + bj * 128 + (wc >> 1) * 64 + (wc & 1) * 16 + 4 * fq;
                                *(pg8::f32x4*)ob = o1; *(pg8::f32x4*)(ob + 32) = o2;
                            }
                        }
                    }
                } else if (pn < 10) {
#pragma unroll
                    for (int bj = 0; bj < 2; ++bj)
#pragma unroll
                        for (int n = 0; n < 2; ++n) {
                            const pg8::f32x4 v = acc[ai][bj][m][n] * s; const int col = (pn - 8) * 256 + bj * 128 + cl + n * 16;
                            v2u w; w.x = pg8::cvt_pk_bf16(v[0], v[1]); w.y = pg8::cvt_pk_bf16(v[2], v[3]); *(v2u*)(vb + (size_t)row * 512 + col) = w;
                            if (row < MR) { float* ob = (row < MP ? ovp + (size_t)row * 512 : ovs + (size_t)(row - MP) * 512) + col; *(pg8::f32x4*)ob = v; }
                        }
                } else {
                    if (wc == 0 && fq < 2) { const pg8::f32x4 v = acc[ai][0][m][0] * s; *(pg8::f32x4*)(ab + (size_t)row * 8 + 4 * fq) = v; }
                }
            }
    }
};
template <int MODE> struct EpiB {
    static constexpr bool PERM = false, AFTER_DRAIN = false;
    bfu* O; int ldc; const float* rs;
    __device__ __forceinline__ void operator()(const pg8::f32x4 (&acc)[2][2][4][2], const pg8::Unit& u, int wr, int wc, int fr, int fq) const {
        const int rowb = u.pm * 256 + wr * 64 + fr; const int cl = u.pn * 256 + wc * 32 + 4 * fq;
#pragma unroll
        for (int ai = 0; ai < 2; ++ai)
#pragma unroll
            for (int m = 0; m < 4; ++m) {
                const int row = rowb + ai * 128 + m * 16;
                float s = 1.f; if (MODE == 1) s = rsqrtf(rs[row] * (1.f / 1024.f) + 1e-6f);
                bfu* dst = O + (size_t)row * ldc + cl;
#pragma unroll
                for (int bj = 0; bj < 2; ++bj)
#pragma unroll
                    for (int n = 0; n < 2; ++n) {
                        pg8::f32x4 v = acc[ai][bj][m][n];
                        if (MODE == 1) { v = v * s; v[0] = fmaxf(v[0], 0.f); v[1] = fmaxf(v[1], 0.f); v[2] = fmaxf(v[2], 0.f); v[3] = fmaxf(v[3], 0.f); v = v * v; }
                        v2u w; w.x = pg8::cvt_pk_bf16(v[0], v[1]); w.y = pg8::cvt_pk_bf16(v[2], v[3]); *(v2u*)(dst + bj * 128 + n * 16) = w;
                    }
            }
    }
};
template <int MODE> struct EpiH {
    static constexpr bool PERM = false, AFTER_DRAIN = false;
    float* H; bfu* xh; float* rsn; const float* rs; const bfu* pp;
    __device__ __forceinline__ void operator()(const pg8::f32x4 (&acc)[2][2][4][2], const pg8::Unit& u, int wr, int wc, int fr, int fq) const {
        const int rowb = u.pm * 256 + wr * 64 + fr; const int cl = u.pn * 256 + wc * 32 + 4 * fq;
#pragma unroll
        for (int ai = 0; ai < 2; ++ai)
#pragma unroll
            for (int m = 0; m < 4; ++m) {
                const int row = rowb + ai * 128 + m * 16; const bool valid = row < MR; float ss = 0.f;
                if (valid) {
                    float s = 1.f; if (MODE == 3) s = rsqrtf(rs[row] * (1.f / 1024.f) + 1e-6f);
#pragma unroll
                    for (int bj = 0; bj < 2; ++bj)
#pragma unroll
                        for (int n = 0; n < 2; ++n) {
                            const size_t off = (size_t)row * 1024 + cl + bj * 128 + n * 16;
                            pg8::f32x4 h = *(const pg8::f32x4*)(H + off); const pg8::f32x4 a = acc[ai][bj][m][n];
                            if (MODE == 3) { const v2u pw = *(const v2u*)(pp + off);
                                h[0] += sigm(a[0] * s) * __uint_as_float(pw.x << 16); h[1] += sigm(a[1] * s) * __uint_as_float(pw.x & 0xffff0000u);
                                h[2] += sigm(a[2] * s) * __uint_as_float(pw.y << 16); h[3] += sigm(a[3] * s) * __uint_as_float(pw.y & 0xffff0000u);
                            } else h = h + a;
                            *(pg8::f32x4*)(H + off) = h;
                            v2u w; w.x = pg8::cvt_pk_bf16(h[0], h[1]); w.y = pg8::cvt_pk_bf16(h[2], h[3]); *(v2u*)(xh + off) = w;
                            ss += (h[0] * h[0] + h[1] * h[1]) + (h[2] * h[2] + h[3] * h[3]);
                        }
                }
                ss += __shfl_xor(ss, 16); ss += __shfl_xor(ss, 32);
                if (valid && fq == 0) unsafeAtomicAdd(rsn + row, ss);
            }
    }
};

__device__ __forceinline__ int win_src(int nd) {
    if (nd < 1024) return nd;
    if (nd < 2048) { const int c = nd - 1024, p = c & 63, grp = c >> 6; const int s = p >> 5, n_ = (p >> 4) & 1, r = p & 15; return 1032 + grp * 64 + n_ * 32 + s * 16 + r; }
    if (nd < 2560) return 2056 + (nd - 2048);
    if (nd < 3584) return 2568 + (nd - 2560);
    if (nd < 3592) return 1024 + (nd - 3584);
    return -1;
}
template <bool MAP> __device__ __forceinline__ void wt_item(const float* W, int K, int Nsrc, bfu* WT, const float* gain, LAS float* scr, int item, int nblk, int lane) {
    const int kb = item / nblk, nb = item % nblk, k0 = 64 * kb, n0 = 32 * nb;
    const int nd = n0 + (lane & 31); const int src = MAP ? win_src(nd) : nd;
#pragma unroll 8
    for (int i = 0; i < 32; ++i) { const int kk = 2 * i + (lane >> 5); float v = src >= 0 ? W[(size_t)(k0 + kk) * Nsrc + src] : 0.f; if (gain) v *= gain[k0 + kk]; scr[kk * 33 + (lane & 31)] = v; }
    LDS_WAIT(); asm volatile("" ::: "memory");
    const int c = lane & 7;
#pragma unroll
    for (int j = 0; j < 4; ++j) { const int n = (lane >> 3) + 8 * j; const LAS float* s = scr + (8 * c) * 33 + n;
        v4u o; o.x = pk2(s[0 * 33], s[1 * 33]); o.y = pk2(s[2 * 33], s[3 * 33]); o.z = pk2(s[4 * 33], s[5 * 33]); o.w = pk2(s[6 * 33], s[7 * 33]);
        *(v4u*)(WT + (size_t)(n0 + n) * K + k0 + 8 * c) = o; }
    LDS_WAIT(); asm volatile("" ::: "memory");
}
__device__ __forceinline__ void conv_weights(KArgs A, int l, int mask, LAS unsigned char* lds, int gw, int NGW, int lane, int wave) {
    LAS float* scr = (LAS float*)(lds + wave * 16384);
    unsigned char* wb = A->ws + WS_W;
    if (mask & 1) {
        const float* win = A->in[11] + (size_t)l * 1024 * 3592; const float* g = A->in[10] + l * 1024;
        for (int it = gw; it < 16 * 120; it += NGW) wt_item<true>(win, 1024, 3592, (bfu*)(wb + W_IN), g, scr, it, 120, lane);
        const float* wu = A->in[23] + (size_t)l * 64 * 256; const float* au = A->in[25] + (size_t)l * 64 * 256; const float* gu = A->in[26] + (size_t)l * 128 * 256;
        bfu* lr = (bfu*)(wb + W_LR);
        for (int i = gw * 64 + lane; i < 768 * 256; i += NGW * 64) { const int n = i >> 8, k = i & 255; float v = 0.f;
            if (n < 256) { if (k < 64) v = wu[k * 256 + n]; } else if (n < 512) { if (k >= 64 && k < 128) v = au[(k - 64) * 256 + (n - 256)]; } else { if (k >= 128) v = gu[(k - 128) * 256 + (n - 512)]; }
            lr[i] = (bfu)f2bf(v); }
    }
    if (mask & 2) {
        const float* wo = A->in[32] + (size_t)l * 1024 * 1024; const float* f1 = A->in[34] + (size_t)l * 1024 * 4096; const float* f2 = A->in[35] + (size_t)l * 4096 * 1024;
        const float* wg = A->in[37] + (size_t)l * 1024 * 1024; const float* wp = A->in[38] + (size_t)l * 256 * 1024;
        const float* gf = A->in[33] + l * 1024; const float* gp = A->in[36] + l * 1024;
        constexpr int I_O = 16 * 32, I_1 = 16 * 128, I_2 = 64 * 32, I_G = 16 * 32, I_P = 4 * 32;
        for (int it = gw; it < I_O + I_1 + I_2 + I_G + I_P; it += NGW) {
            int r = it;
            if (r < I_O) { wt_item<false>(wo, 1024, 1024, (bfu*)(wb + W_OUT), nullptr, scr, r, 32, lane); continue; } r -= I_O;
            if (r < I_1) { wt_item<false>(f1, 1024, 4096, (bfu*)(wb + W_FF1), gf, scr, r, 128, lane); continue; } r -= I_1;
            if (r < I_2) { wt_item<false>(f2, 4096, 1024, (bfu*)(wb + W_FF2), nullptr, scr, r, 32, lane); continue; } r -= I_2;
            if (r < I_G) { wt_item<false>(wg, 1024, 1024, (bfu*)(wb + W_GATE), gp, scr, r, 32, lane); continue; } r -= I_G;
            wt_item<false>(wp, 256, 1024, (bfu*)(wb + W_PP), nullptr, scr, r, 32, lane);
        }
    }
}
__device__ __forceinline__ void conv_p(KArgs A, int l, bfu* pb, int gtid, int NT) {
    const float* pp = A->in[8] + (size_t)l * MP * 256; const float* ps = A->in[9] + (size_t)l * MS * 256;
    for (int i = gtid; i < MR * 64; i += NT) { const int m = i >> 6, c = (i & 63) * 4;
        const f32x4 v = *(const f32x4*)(m < MP ? pp + (size_t)m * 256 + c : ps + (size_t)(m - MP) * 256 + c);
        v2u w; w.x = pk2(v[0], v[1]); w.y = pk2(v[2], v[3]); *(v2u*)(pb + (size_t)m * 256 + c) = w; }
}
__device__ __forceinline__ void prologue(KArgs A, LAS unsigned char* lds, int gw, int NGW, int lane, int wave, int gtid, int NT) {
    conv_weights(A, 0, 3, lds, gw, NGW, lane, wave);
    unsigned char* ws = A->ws;
    float* rs = (float*)(ws + WS_RS); bfu* xh = (bfu*)slotp(ws, 0, 0); float* H = A->out;
    for (int i = gtid; i < 6 * MPAD; i += NT) rs[MPAD + i] = 0.f;
    for (int m = gw; m < MPAD; m += NGW) {
        if (m < MR) {
            const float* xr = m < MP ? A->in[0] + (size_t)m * 1024 : A->in[1] + (size_t)(m - MP) * 1024; float ss = 0.f;
#pragma unroll
            for (int j = 0; j < 4; ++j) { const f32x4 v = *(const f32x4*)(xr + j * 256 + lane * 4); *(f32x4*)(H + (size_t)m * 1024 + j * 256 + lane * 4) = v;
                v2u w; w.x = pk2(v[0], v[1]); w.y = pk2(v[2], v[3]); *(v2u*)(xh + (size_t)m * 1024 + j * 256 + lane * 4) = w; ss += (v[0] * v[0] + v[1] * v[1]) + (v[2] * v[2] + v[3] * v[3]); }
            ss = wave_sum(ss); if (lane == 0) rs[m] = ss;
        } else {
#pragma unroll
            for (int j = 0; j < 4; ++j) *(v2u*)(xh + (size_t)m * 1024 + j * 256 + lane * 4) = (v2u){0u, 0u};
            if (lane == 0) rs[m] = 1024.f;
        }
    }
    float* rope = (float*)(ws + WS_ROPE);
    for (int i = gtid; i < 8192 * 32; i += NT) { const int pos = i >> 5, k = i & 31;
        const float inv = exp2f(-(float)k * (13.287712379549449f / 32.0f)); const float ang = (float)pos * inv;
        const float nn = rintf(ang * 0.15915494309189535f); const float fr = fmaf(-nn, 1.9353071795864769e-3f, fmaf(-nn, 6.28125f, ang));
        rope[pos * 64 + k] = __cosf(fr); rope[pos * 64 + 32 + k] = __sinf(fr); }
    if (gw == 0) {
        for (int l = 0; l < 2; ++l) {
            const float a = wave_sum(A->in[16][l * 64 + lane] * A->in[17][l * 64 + lane]), b = wave_sum(A->in[18][l * 64 + lane] * A->in[19][l * 64 + lane]);
            const float li = 0.8f - 0.6f * expf(-0.3f * (float)l);
            if (lane == 0) { float* lf = (float*)(ws + WS_CTL + 1024); lf[2 * l] = expf(a) - expf(b) + li; lf[2 * l + 1] = li; }
        }
    }
}

__device__ __forceinline__ void prep_a(KArgs A, int l, int gw, int NGW, int lane) {
    unsigned char* ws = A->ws;
    const bfu* aq = (const bfu*)slotp(ws, l, 2); const float* ab = (const float*)(ws + WS_AB);
    float* sia = (float*)slotp(ws, l, 9); bfu* va = (bfu*)slotp(ws, l, 11); bfu* zs = (bfu*)slotph(ws, l, 11); float* gab = (float*)(ws + WS_GAB);
    const float* cw = A->in[12] + l * 4 * 768; const float* stc = A->in[4] + (size_t)l * 8 * 3 * 768;
    const float* anorm = A->in[15] + l * 64;
    for (int m = gw; m < MR; m += NGW) {
        int t, L, sb = 0; const bool smp = m >= MP; float* aco;
        if (!smp) { t = m & 8191; L = 8192; aco = A->out + O_ACP + ((size_t)(l * 8 + (m >> 13)) * 3) * 768; }
        else { sb = (m - MP) >> 4; t = (m - MP) & 15; L = 16; aco = A->out + O_ACS + ((size_t)(l * 8 + sb) * 3) * 768; }
#pragma unroll 1
        for (int h = 0; h < 4; ++h) {
            float val[3];
#pragma unroll
            for (int g = 0; g < 3; ++g) {
                const int c = g * 256 + h * 64 + lane; float x[4];
#pragma unroll
                for (int d = 0; d < 4; ++d) { const int tt = t - d;
                    x[d] = tt >= 0 ? bf2f(aq[(size_t)(m - d) * 1024 + c]) : (smp ? stc[((size_t)sb * 3 + (3 + tt)) * 768 + c] : 0.f); }
                const float y = x[3] * cw[c] + x[2] * cw[768 + c] + x[1] * cw[1536 + c] + x[0] * cw[2304 + c];
                val[g] = y * sigm(y);
                if (t >= L - 3) aco[(size_t)(t - (L - 3)) * 768 + c] = x[0];
            }
            const float sq = wave_sum(val[0] * val[0]), sk = wave_sum(val[1] * val[1]);
            const float qn = val[0] * rsqrtf(sq + 1e-6f) * 0.125f, kn = val[1] * rsqrtf(sk + 1e-6f);
            float* rec = sia + ((size_t)(h * 8 + (lane >> 3)) * MPAD + m) * 16 + (lane & 7);
            rec[0] = kn; rec[8] = qn;
            va[(size_t)m * 256 + h * 64 + lane] = (bfu)f2bf(val[2]);
            const float z = bf2f(aq[(size_t)m * 1024 + 768 + h * 64 + lane]);
            zs[(size_t)m * 256 + h * 64 + lane] = (bfu)f2bf(z * sigm(z) * anorm[lane]);
        }
        if (lane < 4) { const int h = lane;
            const float g = -__expf(A->in[13][l * 4 + h]) * softplusf(ab[(size_t)m * 8 + h] + A->in[14][l * 4 + h]);
            gab[((size_t)h * MPAD + m) * 2] = __expf(g); gab[((size_t)h * MPAD + m) * 2 + 1] = sigm(ab[(size_t)m * 8 + 4 + h]); }
    }
}
__device__ __forceinline__ void prep_c1(KArgs A, int l, int gw, int NGW, int lane) {
    unsigned char* ws = A->ws;
    const bfu* cr = (const bfu*)slotp(ws, l, 7); bfu* lra = (bfu*)slotp(ws, l, 12);
    const float* mu = A->in[21] + l * 1024; const float* sts = A->in[6] + (size_t)l * 8 * 1024;
    for (int m = gw; m < MR; m += NGW) {
        int t, L, sb = 0; const bool smp = m >= MP; float* cso;
        if (!smp) { t = m & 8191; L = 8192; cso = A->out + O_CSP + (size_t)(l * 8 + (m >> 13)) * 1024; }
        else { sb = (m - MP) >> 4; t = (m - MP) & 15; L = 16; cso = A->out + O_CSS + (size_t)(l * 8 + sb) * 1024; }
#pragma unroll
        for (int i = 0; i < 4; ++i) { const int j = 768 + lane + 64 * i;
            const float cur = bf2f(cr[(size_t)m * 1024 + j]);
            const float prev = t > 0 ? bf2f(cr[(size_t)(m - 1) * 1024 + j]) : (smp ? sts[(size_t)sb * 1024 + j] : 0.f);
            const float c = cur + (prev - cur) * mu[j];
            const float o = i == 0 ? tanhf(c) : (i == 1 ? c : sigm(c));
            lra[(size_t)m * 256 + lane + 64 * i] = (bfu)f2bf(o); }
        if (t == L - 1) {
#pragma unroll
            for (int i = 0; i < 16; ++i) cso[lane + 64 * i] = bf2f(cr[(size_t)m * 1024 + lane + 64 * i]);
        }
    }
}
__device__ __forceinline__ void prep_c2(KArgs A, int l, int bid, int G, int tid) {
    unsigned char* ws = A->ws;
    const bfu* cr = (const bfu*)slotp(ws, l, 7); const bfu* lro = (const bfu*)slotp(ws, l, 13);
    bfu* v2 = (bfu*)slotp(ws, l, 12); bfu* gg = (bfu*)slotph(ws, l, 12);
    float* bonus = (float*)(ws + WS_BONUS); float* gch = (float*)(ws + WS_GCH);
    const float* mu = A->in[21] + l * 1024; const float* sts = A->in[6] + (size_t)l * 8 * 1024;
    const int ch = tid & 255, h = ch >> 6, lane = ch & 63, half = tid >> 8;
    float* sic = (float*)slotp(ws, l, h) + ((size_t)(lane >> 3) * MPAD) * 32 + (lane & 7);
    const float mur = mu[ch], muk = mu[256 + ch], muv = mu[512 + ch];
    const float w0 = A->in[22][l * 256 + ch], a0 = A->in[24][l * 256 + ch], kk_ = A->in[27][l * 256 + ch], ka = A->in[28][l * 256 + ch], rk = A->in[29][l * 256 + ch];
    for (int u = bid * 2 + half; u < 1032; u += G * 2) {
        int m0, n; float pr, pk, pv;
        if (u < 1024) { m0 = u * 64; n = 64;
            if ((u & 127) == 0) { pr = pk = pv = 0.f; } else { pr = bf2f(cr[(size_t)(m0 - 1) * 1024 + ch]); pk = bf2f(cr[(size_t)(m0 - 1) * 1024 + 256 + ch]); pv = bf2f(cr[(size_t)(m0 - 1) * 1024 + 512 + ch]); } }
        else { const int sb = u - 1024; m0 = MP + sb * 16; n = 16; pr = sts[(size_t)sb * 1024 + ch]; pk = sts[(size_t)sb * 1024 + 256 + ch]; pv = sts[(size_t)sb * 1024 + 512 + ch]; }
        float cum = 0.f;
#pragma unroll 4
        for (int tt = 0; tt < n; ++tt) { const int m = m0 + tt;
            const float c_r = bf2f(cr[(size_t)m * 1024 + ch]), c_k = bf2f(cr[(size_t)m * 1024 + 256 + ch]), c_v = bf2f(cr[(size_t)m * 1024 + 512 + ch]);
            const float r = c_r + (pr - c_r) * mur, k = c_k + (pk - c_k) * muk, v = c_v + (pv - c_v) * muv; pr = c_r; pk = c_k; pv = c_v;
            const float lw = bf2f(lro[(size_t)m * 768 + ch]), la = bf2f(lro[(size_t)m * 768 + 256 + ch]); const bfu gb = lro[(size_t)m * 768 + 512 + ch];
            const float wl = -0.6065306597126334f * sigm(w0 + lw); const float a = sigm(a0 + la);
            const float kkr = k * kk_; const float kk = kkr * rsqrtf(wave_sum(kkr * kkr) + 1e-6f);
            const float kp = k * (1.f + (a - 1.f) * ka);
            const float Gp = __expf(cum); cum += wl; const float Gc = __expf(cum), iG = __expf(-cum);
            float* rec = sic + (size_t)m * 32;
            rec[0] = kk * Gp; rec[8] = kk * a * iG; rec[16] = kp * iG; rec[24] = r * Gc;
            const float bo = wave_sum(r * kp * rk); if (lane == 0) bonus[(size_t)h * MPAD + m] = bo;
            v2[(size_t)m * 256 + ch] = (bfu)f2bf(v); gg[(size_t)m * 256 + ch] = gb;
        }
        gch[((size_t)h * 1032 + u) * 64 + lane] = __expf(cum);
    }
}
__device__ __forceinline__ void post_attn(KArgs A, int l, int gw, int NGW, int lane) {
    unsigned char* ws = A->ws;
    const bfu* O = (const bfu*)slotp(ws, l, 13); bfu* mix = (bfu*)slotp(ws, l, 7);
    const float* lf = (const float*)(ws + WS_CTL + 1024); const float lam = lf[2 * l], omli = 1.f - lf[2 * l + 1];
    const int h = lane >> 4, e0 = (lane & 15) * 8; const float* bn = A->in[20] + l * 128 + e0;
    float bnv[8];
#pragma unroll
    for (int i = 0; i < 8; ++i) bnv[i] = bn[i] * omli;
    for (int m = gw; m < MP; m += NGW) {
        const v4u a = *(const v4u*)(O + (size_t)m * 1024 + (4 * h + (e0 >> 6)) * 64 + (e0 & 63));
        const v4u b = *(const v4u*)(O + (size_t)m * 1024 + (4 * h + 2 + (e0 >> 6)) * 64 + (e0 & 63));
        float o[8]; float ss = 0.f;
#pragma unroll
        for (int i = 0; i < 4; ++i) { const unsigned aw = a[i], bw = b[i];
            o[2 * i] = __uint_as_float(aw << 16) - lam * __uint_as_float(bw << 16); o[2 * i + 1] = __uint_as_float(aw & 0xffff0000u) - lam * __uint_as_float(bw & 0xffff0000u);
            ss += o[2 * i] * o[2 * i] + o[2 * i + 1] * o[2 * i + 1]; }
        ss += __shfl_xor(ss, 1); ss += __shfl_xor(ss, 2); ss += __shfl_xor(ss, 4); ss += __shfl_xor(ss, 8);
        const float rn = rsqrtf(ss * (1.f / 128.f) + 1e-6f);
        v4u w; w.x = pk2(o[0] * rn * bnv[0], o[1] * rn * bnv[1]); w.y = pk2(o[2] * rn * bnv[2], o[3] * rn * bnv[3]); w.z = pk2(o[4] * rn * bnv[4], o[5] * rn * bnv[5]); w.w = pk2(o[6] * rn * bnv[6], o[7] * rn * bnv[7]);
        *(v4u*)(mix + (size_t)m * 1024 + 256 + h * 128 + e0) = w;
    }
}
__device__ __forceinline__ void final_norm(KArgs A, int gw, int NGW, int lane) {
    const float* rs = (const float*)(A->ws + WS_RS) + 6 * (size_t)MPAD; const float* g = A->in[39];
    for (int m = gw; m < MR; m += NGW) { const float s = rsqrtf(rs[m] * (1.f / 1024.f) + 1e-6f);
#pragma unroll
        for (int j = 0; j < 4; ++j) { float* p = A->out + (size_t)m * 1024 + j * 256 + lane * 4; f32x4 v = *(f32x4*)p; const f32x4 gv = *(const f32x4*)(g + j * 256 + lane * 4); v = v * s * gv; *(f32x4*)p = v; } }
}

#define SC_BAR() asm volatile("s_waitcnt lgkmcnt(0)\n\ts_barrier" ::: "memory")
constexpr int SC_RED = 0, SC_SI = 8192, SC_VBUF = 73728, SC_GBUF = 81920, SC_BON = 90112, SC_YP = 90624;

__device__ __forceinline__ void scan_rwkv(KArgs A, int l, LAS unsigned char* lds, int h, int m0, int L, int BL, int BLS, int chunk0, const float* st_in, float* st_out, int tid) {
    unsigned char* ws = A->ws;
    const int lane = tid & 63, wid = __builtin_amdgcn_readfirstlane(tid >> 6);
    LAS float* red = (LAS float*)(lds + SC_RED); LAS float* yred = (LAS float*)(lds + SC_YP);
    LAS float* sib = (LAS float*)(lds + SC_SI) + wid * 1024;
    LAS bfu* vbuf = (LAS bfu*)(lds + SC_VBUF); LAS bfu* gbuf = (LAS bfu*)(lds + SC_GBUF); LAS float* bon = (LAS float*)(lds + SC_BON);
    const bfu* v2 = (const bfu*)slotp(ws, l, 12); const bfu* gg = (const bfu*)slotph(ws, l, 12);
    const float* bonus = (const float*)(ws + WS_BONUS) + (size_t)h * MPAD;
    const float* gch = (const float*)(ws + WS_GCH) + ((size_t)h * 1032 + chunk0) * 64 + 8 * wid;
    bfu* mix = (bfu*)slotp(ws, l, 7);
    const float* P = (const float*)slotp(ws, l, h) + ((size_t)wid * MPAD + m0) * 32;
    const float lnw = A->in[30][l * 256 + h * 64 + lane], lnb = A->in[31][l * 256 + h * 64 + lane];
    float S[8];
#pragma unroll
    for (int j = 0; j < 8; ++j) S[j] = st_in ? st_in[lane * 64 + 8 * wid + j] : 0.f;
    const int nblk = L >> BLS; const int srow = tid >> 4, sc4 = tid & 15; const bool sval = srow < BL;
    const int nsi = BL >> 3;
    f32x4 ssi[4]; v2u sv = {0, 0}, sg = {0, 0}; float sb_ = 0.f;
#define RW_STAGE(c) do { const float* ps_ = P + (size_t)(c) * BL * 32 + lane * 4; \
        _Pragma("unroll") for (int i_ = 0; i_ < 4; ++i_) if (i_ < nsi) ssi[i_] = *(const f32x4*)(ps_ + i_ * 256); \
        if (sval) { const size_t mm = (size_t)(m0 + (c) * BL + srow) * 256 + h * 64 + sc4 * 4; sv = *(const v2u*)(v2 + mm); sg = *(const v2u*)(gg + mm); } if (tid < BL) sb_ = bonus[m0 + (c) * BL + tid]; } while (0)
#define RW_COMMIT(c) do { LAS float* pd_ = sib + ((c) & 1) * 8192 + lane * 4; \
        _Pragma("unroll") for (int i_ = 0; i_ < 4; ++i_) if (i_ < nsi) *(LAS f32x4*)(pd_ + i_ * 256) = ssi[i_]; \
        if (sval) { *(LAS v2u*)(vbuf + ((c) & 1) * 2048 + srow * 64 + sc4 * 4) = sv; *(LAS v2u*)(gbuf + ((c) & 1) * 2048 + srow * 64 + sc4 * 4) = sg; } if (tid < BL) bon[((c) & 1) * 32 + tid] = sb_; } while (0)
    __syncthreads();
    RW_STAGE(0); RW_COMMIT(0); if (nblk > 1) RW_STAGE(1);
    f32x4 ca[8], cb[8];
#define RW_LOADOPS(D, T) do { const LAS f32x4* po_ = (const LAS f32x4*)(sib + ((((T) >> BLS) & 1) * 8192) + ((T) & (BL - 1)) * 32); \
        _Pragma("unroll") for (int i_ = 0; i_ < 8; ++i_) D[i_] = po_[i_]; } while (0)
    RW_LOADOPS(ca, 0);
#define RW_FINAL(T) do { const int tf_ = (T); const int ttf_ = tf_ & (BL - 1), bf_ = (tf_ >> BLS) & 1; \
        const LAS float* yr_ = yred + (tf_ & 15) * 512 + lane; const float y_ = ((yr_[0] + yr_[64]) + (yr_[128] + yr_[192])) + ((yr_[256] + yr_[320]) + (yr_[384] + yr_[448])); \
        const float mu_ = wave_sum(y_) * (1.f / 64.f); const float d_ = y_ - mu_; const float var_ = wave_sum(d_ * d_) * (1.f / 64.f); \
        const float cy_ = d_ * rsqrtf(var_ + 64e-5f) * lnw + lnb; \
        const float vv_ = bf2f(vbuf[bf_ * 2048 + ttf_ * 64 + lane]), g_ = bf2f(gbuf[bf_ * 2048 + ttf_ * 64 + lane]); \
        mix[(size_t)(m0 + tf_) * 1024 + 768 + h * 64 + lane] = (bfu)f2bf((cy_ + bon[bf_ * 32 + ttf_] * vv_) * g_); } while (0)
#define RW_STEP(C, N, T) do { \
        float d0 = S[0] * C[0][0], d1 = S[1] * C[0][1]; d0 = fmaf(S[2], C[0][2], d0); d1 = fmaf(S[3], C[0][3], d1); d0 = fmaf(S[4], C[1][0], d0); d1 = fmaf(S[5], C[1][1], d1); d0 = fmaf(S[6], C[1][2], d0); d1 = fmaf(S[7], C[1][3], d1); \
        red[((T) & 1) * 512 + wid * 64 + lane] = d0 + d1; \
        SC_BAR(); \
        const LAS float* rr_ = red + ((T) & 1) * 512 + lane; const float r0_ = rr_[0], r1_ = rr_[64], r2_ = rr_[128], r3_ = rr_[192], r4_ = rr_[256], r5_ = rr_[320], r6_ = rr_[384], r7_ = rr_[448]; \
        const float vv = bf2f(vbuf[(((T) >> BLS) & 1) * 2048 + ((T) & (BL - 1)) * 64 + lane]); \
        asm volatile("" ::: "memory"); \
        if ((T) + 1 < L) RW_LOADOPS(N, (T) + 1); \
        const float tot_ = ((r0_ + r1_) + (r2_ + r3_)) + ((r4_ + r5_) + (r6_ + r7_)); const float sa = -tot_; \
        _Pragma("unroll") for (int j = 0; j < 8; ++j) S[j] = fmaf(sa, C[2 + (j >> 2)][j & 3], fmaf(vv, C[4 + (j >> 2)][j & 3], S[j])); \
        float y0 = S[0] * C[6][0], y1 = S[1] * C[6][1]; y0 = fmaf(S[2], C[6][2], y0); y1 = fmaf(S[3], C[6][3], y1); y0 = fmaf(S[4], C[7][0], y0); y1 = fmaf(S[5], C[7][1], y1); y0 = fmaf(S[6], C[7][2], y0); y1 = fmaf(S[7], C[7][3], y1); \
        yred[((T) & 15) * 512 + wid * 64 + lane] = y0 + y1; } while (0)
    for (int c = 0; c < nblk; ++c) {
        for (int tt = 0; tt < BL; tt += 2) {
            const int t = c * BL + tt;
            if (tt == (BL >> 1) && c + 1 < nblk) { RW_COMMIT(c + 1); if (c + 2 < nblk) RW_STAGE(c + 2); }
            RW_STEP(ca, cb, t);
            RW_STEP(cb, ca, t + 1);
            if (((t + 1) & 15) == 15) { SC_BAR(); RW_FINAL(t - 14 + 2 * wid); RW_FINAL(t - 13 + 2 * wid); }
        }
        if ((((c + 1) << BLS) & 63) == 0 || c + 1 == nblk) {
            const float* ge = gch + (size_t)((c << BLS) >> 6) * 64;
#pragma unroll
            for (int j = 0; j < 8; ++j) S[j] *= ge[j];
        }
    }
#pragma unroll
    for (int j = 0; j < 8; ++j) st_out[lane * 64 + 8 * wid + j] = S[j];
    __syncthreads();
#undef RW_STAGE
#undef RW_COMMIT
#undef RW_LOADOPS
#undef RW_FINAL
#undef RW_STEP
}

__device__ __forceinline__ void scan_delta(KArgs A, int l, LAS unsigned char* lds, int h, int m0, int L, int BL, int BLS, const float* st_in, float* st_out, int tid) {
    unsigned char* ws = A->ws;
    const int lane = tid & 63, wid = __builtin_amdgcn_readfirstlane(tid >> 6);
    LAS float* red = (LAS float*)(lds + SC_RED); LAS float* yred = (LAS float*)(lds + SC_YP);
    LAS float* sib = (LAS float*)(lds + SC_SI) + wid * 512;
    LAS bfu* vbuf = (LAS bfu*)(lds + SC_VBUF); LAS bfu* gbuf = (LAS bfu*)(lds + SC_GBUF); LAS float* gab = (LAS float*)(lds + SC_BON);
    const bfu* va = (const bfu*)slotp(ws, l, 11); const bfu* zs = (const bfu*)slotph(ws, l, 11);
    bfu* mix = (bfu*)slotp(ws, l, 7);
    const float* P = (const float*)slotp(ws, l, 9) + ((size_t)(h * 8 + wid) * MPAD + m0) * 16;
    const float* PG = (const float*)(ws + WS_GAB) + ((size_t)h * MPAD + m0) * 2;
    float S[8];
#pragma unroll
    for (int j = 0; j < 8; ++j) S[j] = st_in ? st_in[(8 * wid + j) * 64 + lane] : 0.f;
    const int nblk = L >> BLS; const int srow = tid >> 4, sc4 = tid & 15; const bool sval = srow < BL;
    const int nsi = BL >> 4;
    f32x4 ssi[2]; v2u sv = {0, 0}, sg = {0, 0}; float sb_ = 0.f;
#define DL_STAGE(c) do { const float* ps_ = P + (size_t)(c) * BL * 16 + lane * 4; \
        _Pragma("unroll") for (int i_ = 0; i_ < 2; ++i_) if (i_ < nsi) ssi[i_] = *(const f32x4*)(ps_ + i_ * 256); \
        if (sval) { const size_t mm = (size_t)(m0 + (c) * BL + srow) * 256 + h * 64 + sc4 * 4; sv = *(const v2u*)(va + mm); sg = *(const v2u*)(zs + mm); } if (tid < 2 * BL) sb_ = PG[(size_t)(c) * BL * 2 + tid]; } while (0)
#define DL_COMMIT(c) do { LAS float* pd_ = sib + ((c) & 1) * 4096 + lane * 4; \
        _Pragma("unroll") for (int i_ = 0; i_ < 2; ++i_) if (i_ < nsi) *(LAS f32x4*)(pd_ + i_ * 256) = ssi[i_]; \
        if (sval) { *(LAS v2u*)(vbuf + ((c) & 1) * 2048 + srow * 64 + sc4 * 4) = sv; *(LAS v2u*)(gbuf + ((c) & 1) * 2048 + srow * 64 + sc4 * 4) = sg; } if (tid < 2 * BL) gab[((c) & 1) * 64 + tid] = sb_; } while (0)
    __syncthreads();
    DL_STAGE(0); DL_COMMIT(0); if (nblk > 1) DL_STAGE(1);
    f32x4 ca[4], cb[4];
#define DL_LOADOPS(D, T) do { const LAS f32x4* po_ = (const LAS f32x4*)(sib + ((((T) >> BLS) & 1) * 4096) + ((T) & (BL - 1)) * 16); \
        _Pragma("unroll") for (int i_ = 0; i_ < 4; ++i_) D[i_] = po_[i_]; } while (0)
    DL_LOADOPS(ca, 0);
#define DL_FINAL(T) do { const int tf_ = (T); const int ttf_ = tf_ & (BL - 1), bf_ = (tf_ >> BLS) & 1; \
        const LAS float* yr_ = yred + (tf_ & 15) * 512 + lane; const float o_ = ((yr_[0] + yr_[64]) + (yr_[128] + yr_[192])) + ((yr_[256] + yr_[320]) + (yr_[384] + yr_[448])); \
        const float ss_ = wave_sum(o_ * o_) * (1.f / 64.f); \
        mix[(size_t)(m0 + tf_) * 1024 + h * 64 + lane] = (bfu)f2bf(o_ * rsqrtf(ss_ + 1e-6f) * bf2f(gbuf[bf_ * 2048 + ttf_ * 64 + lane])); } while (0)
#define DL_STEP(C, N, T) do { \
        float d0 = S[0] * C[0][0], d1 = S[1] * C[0][1]; d0 = fmaf(S[2], C[0][2], d0); d1 = fmaf(S[3], C[0][3], d1); d0 = fmaf(S[4], C[1][0], d0); d1 = fmaf(S[5], C[1][1], d1); d0 = fmaf(S[6], C[1][2], d0); d1 = fmaf(S[7], C[1][3], d1); \
        red[((T) & 1) * 512 + wid * 64 + lane] = d0 + d1; \
        SC_BAR(); \
        const LAS float* rr_ = red + ((T) & 1) * 512 + lane; const float r0_ = rr_[0], r1_ = rr_[64], r2_ = rr_[128], r3_ = rr_[192], r4_ = rr_[256], r5_ = rr_[320], r6_ = rr_[384], r7_ = rr_[448]; \
        const int bo_ = (((T) >> BLS) & 1), to_ = (T) & (BL - 1); \
        const float vv = bf2f(vbuf[bo_ * 2048 + to_ * 64 + lane]); const f32x2 ab_ = *(const LAS f32x2*)(gab + bo_ * 64 + to_ * 2); \
        asm volatile("" ::: "memory"); \
        if ((T) + 1 < L) DL_LOADOPS(N, (T) + 1); \
        const float tot_ = ((r0_ + r1_) + (r2_ + r3_)) + ((r4_ + r5_) + (r6_ + r7_)); const float av = ab_[0]; const float dl = ab_[1] * (vv - av * tot_); \
        _Pragma("unroll") for (int j = 0; j < 8; ++j) S[j] = fmaf(C[j >> 2][j & 3], dl, av * S[j]); \
        float y0 = S[0] * C[2][0], y1 = S[1] * C[2][1]; y0 = fmaf(S[2], C[2][2], y0); y1 = fmaf(S[3], C[2][3], y1); y0 = fmaf(S[4], C[3][0], y0); y1 = fmaf(S[5], C[3][1], y1); y0 = fmaf(S[6], C[3][2], y0); y1 = fmaf(S[7], C[3][3], y1); \
        yred[((T) & 15) * 512 + wid * 64 + lane] = y0 + y1; } while (0)
    for (int c = 0; c < nblk; ++c) {
        for (int tt = 0; tt < BL; tt += 2) {
            const int t = c * BL + tt;
            if (tt == (BL >> 1) && c + 1 < nblk) { DL_COMMIT(c + 1); if (c + 2 < nblk) DL_STAGE(c + 2); }
            DL_STEP(ca, cb, t);
            DL_STEP(cb, ca, t + 1);
            if (((t + 1) & 15) == 15) { SC_BAR(); DL_FINAL(t - 14 + 2 * wid); DL_FINAL(t - 13 + 2 * wid); }
        }
    }
#pragma unroll
    for (int j = 0; j < 8; ++j) st_out[(8 * wid + j) * 64 + lane] = S[j];
    __syncthreads();
#undef DL_STAGE
#undef DL_COMMIT
#undef DL_LOADOPS
#undef DL_FINAL
#undef DL_STEP
}

__device__ __forceinline__ void sample_attn(KArgs A, int l, LAS unsigned char* lds, int unit, int tid) {
    unsigned char* ws = A->ws;
    const int sb = unit >> 2, h = unit & 3;
    LAS float* qs = (LAS float*)lds;
    LAS float* sc = qs + 2048;
    LAS float* scl = sc + 1024;
    LAS float* ssq = scl + 32;
    LAS float* lsum = ssq + 512;
    const bfu* qb = (const bfu*)slotp(ws, l, 4); bfu* mix = (bfu*)slotp(ws, l, 7);
    const float* ck = A->in[2] + (size_t)(l * 8 + sb) * 2048 * 512 + h * 128; const float* cv = A->in[3] + (size_t)(l * 8 + sb) * 2048 * 512 + h * 128;
    const float* nk = A->out + O_BKS + (size_t)(l * 8 + sb) * 16 * 512 + h * 128; const float* nv = A->out + O_BVS + (size_t)(l * 8 + sb) * 16 * 512 + h * 128;
    const float* lf = (const float*)(ws + WS_CTL + 1024); const float lam = lf[2 * l], omli = 1.f - lf[2 * l + 1];
    __syncthreads();
    for (int i = tid; i < 2048; i += NTHR) { const int map = i >> 10, qi = (i >> 6) & 15, p = i & 63; const int s = p >> 5, n_ = (p >> 4) & 1, r = p & 15;
        qs[(map * 16 + qi) * 64 + n_ * 32 + s * 16 + r] = bf2f(qb[(size_t)(MP + sb * 16 + qi) * 512 + h * 128 + map * 64 + p]); }
    float mrun = -1e30f, lrun = 0.f;
    const int qi = tid & 15, kj = tid >> 4, eg = tid >> 4;
    f32x4 acc0 = {0.f, 0.f, 0.f, 0.f}, acc1 = {0.f, 0.f, 0.f, 0.f};
    __syncthreads();
    for (int tile = 0; tile < 65; ++tile) {
        const int kidx = tile * 32 + kj;
        float s1 = -1e30f, s2 = -1e30f;
        if (kidx < 2064) { const float* kr = kidx < 2048 ? ck + (size_t)kidx * 512 : nk + (size_t)(kidx - 2048) * 512; s1 = 0.f; s2 = 0.f;
#pragma unroll 4
            for (int d = 0; d < 64; d += 4) { const f32x4 k1 = *(const f32x4*)(kr + d), k2 = *(const f32x4*)(kr + 64 + d); const LAS float* q1 = qs + qi * 64 + d; const LAS float* q2 = qs + (16 + qi) * 64 + d;
                s1 += q1[0] * k1[0] + q1[1] * k1[1] + q1[2] * k1[2] + q1[3] * k1[3]; s2 += q2[0] * k2[0] + q2[1] * k2[1] + q2[2] * k2[2] + q2[3] * k2[3]; } }
        sc[qi * 32 + kj] = s1; sc[(16 + qi) * 32 + kj] = s2;
        __syncthreads();
        if (tid < 32) { LAS float* r = sc + tid * 32; float mx = mrun;
#pragma unroll 8
            for (int j = 0; j < 32; ++j) mx = fmaxf(mx, r[j]);
            const float f = exp2f(mrun - mx); float su = 0.f;
#pragma unroll 8
            for (int j = 0; j < 32; ++j) { const float p = exp2f(r[j] - mx); r[j] = p; su += p; }
            lrun = lrun * f + su; mrun = mx; scl[tid] = f; }
        __syncthreads();
        { const float f0 = scl[qi], f1 = scl[16 + qi]; acc0 = acc0 * f0; acc1 = acc1 * f1;
            const int nk_ = tile < 64 ? 32 : 16;
            for (int j = 0; j < nk_; ++j) { const int kx = tile * 32 + j; const float* vr = (kx < 2048 ? cv + (size_t)kx * 512 : nv + (size_t)(kx - 2048) * 512) + eg * 4;
                const f32x4 v = *(const f32x4*)vr; acc0 = acc0 + v * sc[qi * 32 + j]; acc1 = acc1 + v * sc[(16 + qi) * 32 + j]; } }
        __syncthreads();
    }
    if (tid < 32) lsum[tid] = lrun;
    __syncthreads();
    const f32x4 o = acc0 * (1.f / lsum[qi]) - acc1 * (lam / lsum[16 + qi]);
    ssq[qi * 32 + eg] = (o[0] * o[0] + o[1] * o[1]) + (o[2] * o[2] + o[3] * o[3]);
    __syncthreads();
    float ss = 0.f;
#pragma unroll 8
    for (int j = 0; j < 32; ++j) ss += ssq[qi * 32 + j];
    const float rn = rsqrtf(ss * (1.f / 128.f) + 1e-6f) * omli; const float* bn = A->in[20] + l * 128 + eg * 4;
    v2u w; w.x = pk2(o[0] * rn * bn[0], o[1] * rn * bn[1]); w.y = pk2(o[2] * rn * bn[2], o[3] * rn * bn[3]);
    *(v2u*)(mix + (size_t)(MP + sb * 16 + qi) * 1024 + 256 + h * 128 + eg * 4) = w;
    __syncthreads();
}

#define PH_BEGIN \
        KArgs A = (KArgs)__builtin_amdgcn_kernarg_segment_ptr(); \
        int tid = wv * 64 + (int)__builtin_amdgcn_mbcnt_hi(~0u, __builtin_amdgcn_mbcnt_lo(~0u, 0u)); asm volatile("" : "+v"(tid)); tid &= 511; \
        const int bid = blockIdx.x, G = gridDim.x; \
        const int lane = tid & 63, wave = wv; \
        const int gw = bid * NWAVES + wave, NGW = G * NWAVES, gtid = bid * NTHR + tid, NT = G * NTHR; \
        unsigned char* ws = A->ws; float* rsb = (float*)(ws + WS_RS); unsigned char* wb = ws + WS_W; \
        (void)lane; (void)gw; (void)NGW; (void)gtid; (void)NT; (void)rsb; (void)wb;
#define IN(k) (lo <= (k) && (k) < hi)
__device__ __forceinline__ void grid_bar(unsigned* bar, unsigned target, bool leader) {
    asm volatile("s_waitcnt vmcnt(0) lgkmcnt(0)" ::: "memory");
    __syncthreads();
    if (leader) {
        __builtin_amdgcn_fence(__ATOMIC_RELEASE, "agent");
        asm volatile("s_waitcnt vmcnt(0)" ::: "memory");
        __hip_atomic_fetch_add(bar, 1u, __ATOMIC_RELAXED, __HIP_MEMORY_SCOPE_AGENT);
        unsigned spins = 0;
        while (__hip_atomic_load(bar, __ATOMIC_RELAXED, __HIP_MEMORY_SCOPE_AGENT) < target) { __builtin_amdgcn_s_sleep(2); if (++spins > (1u << 27)) break; }
        __builtin_amdgcn_fence(__ATOMIC_ACQUIRE, "agent");
        asm volatile("s_waitcnt vmcnt(0)" ::: "memory");
    }
    __syncthreads();
}
#define SEAM(k) do { if ((k) + 1 < hi) { grid_bar((unsigned*)(ws + WS_CTL + 4096), (unsigned)((k) + 1 - lo) * (unsigned)G, tid == 0); } } while (0)
__global__ void __launch_bounds__(NTHR, 2) hybrid_fwd(Args Aval) {
    extern __shared__ __attribute__((aligned(16))) unsigned char lds_raw[];
    LAS unsigned char* lds = (LAS unsigned char*)lds_raw;
    const int lo = Aval.ph_lo, hi = Aval.ph_hi;
    if (Aval.ph_lo < 0) cg::this_grid().sync();
    const int wv = __builtin_amdgcn_readfirstlane(threadIdx.x >> 6);
    if (IN(0)) { PH_BEGIN prologue(A, lds, gw, NGW, lane, wave, gtid, NT); SEAM(0); }
    { constexpr int l = 0;

        const int p0 = 1 + 11 * l;
        if (IN(p0 + 0)) { PH_BEGIN
            pg8::Gemm g{(const pg8::bf16_t*)slotp(ws, l, 0), (const pg8::bf16_t*)(wb + W_IN), MPAD, NIN, 1024};
            pg8::StaticOrder S; S.init(MPAD, NIN, G, bid);
            EpiG1 E{rsb + (size_t)(3 * l) * MPAD, (bfu*)slotp(ws, l, 2), (bfu*)slotp(ws, l, 4), (bfu*)slotp(ws, l, 5), (bfu*)slotp(ws, l, 6), (bfu*)slotp(ws, l, 7), (float*)(ws + WS_AB), (const float*)(ws + WS_ROPE),
                    A->out + O_BKP + (size_t)l * MP * 512, A->out + O_BVP + (size_t)l * MP * 512, A->out + O_BKS + (size_t)l * MS * 512, A->out + O_BVS + (size_t)l * MS * 512};
            pg8::gemm_phase<EpiG1, pg8::StaticOrder, true, true>((PG8_LAS unsigned char*)lds, g, S, E, wv);
            SEAM(p0 + 0); }
        if (IN(p0 + 1)) { PH_BEGIN
            prep_a(A, l, gw, NGW, lane); prep_c1(A, l, gw, NGW, lane);
            if (l == 1) conv_weights(A, 1, 2, lds, gw, NGW, lane, wave);
            SEAM(p0 + 1); }
        if (IN(p0 + 2)) { PH_BEGIN
            pg8::Gemm g{(const pg8::bf16_t*)slotp(ws, l, 12), (const pg8::bf16_t*)(wb + W_LR), MPAD, 768, 256};
            pg8::StaticOrder S; S.init(MPAD, 768, G, bid);
            EpiB<0> E{(bfu*)slotp(ws, l, 13), 768, nullptr};
            pg8::gemm_phase<EpiB<0>, pg8::StaticOrder, true, true>((PG8_LAS unsigned char*)lds, g, S, E, wv);
            SEAM(p0 + 2); }
        if (IN(p0 + 3)) { PH_BEGIN prep_c2(A, l, bid, G, tid); SEAM(p0 + 3); }
        if (IN(p0 + 4)) { PH_BEGIN
            if (bid < 32) { const int b = bid >> 2, h = bid & 3;
                scan_rwkv(A, l, lds, h, b * 8192, 8192, 32, 5, b * 128, nullptr, A->out + O_CWP + (size_t)((l * 8 + b) * 4 + h) * 4096, tid);
#ifdef PROBE_SCAN2
                scan_rwkv(A, l, lds, h, b * 8192, 8192, 32, 5, b * 128, nullptr, A->out + O_CWP + (size_t)((l * 8 + b) * 4 + h) * 4096, tid);
#endif
                scan_rwkv(A, l, lds, h, MP + b * 16, 16, 16, 4, 1024 + b, A->in[7] + (size_t)((l * 8 + b) * 4 + h) * 4096, A->out + O_CWS + (size_t)((l * 8 + b) * 4 + h) * 4096, tid);
            } else if (bid < 64) { const int b = (bid - 32) >> 2, h = bid & 3;
                scan_delta(A, l, lds, h, b * 8192, 8192, 32, 5, nullptr, A->out + O_ADP + (size_t)((l * 8 + b) * 4 + h) * 4096, tid);
#ifdef PROBE_SCAN2
                scan_delta(A, l, lds, h, b * 8192, 8192, 32, 5, nullptr, A->out + O_ADP + (size_t)((l * 8 + b) * 4 + h) * 4096, tid);
#endif
                scan_delta(A, l, lds, h, MP + b * 16, 16, 16, 4, A->in[5] + (size_t)((l * 8 + b) * 4 + h) * 4096, A->out + O_ADS + (size_t)((l * 8 + b) * 4 + h) * 4096, tid);
            } else if (bid < 96) { sample_attn(A, l, lds, bid - 64, tid); }
            __syncthreads();
            unsigned* ctr = (unsigned*)(ws + WS_CTL) + 16 * l; volatile LAS unsigned* qw = (volatile LAS unsigned*)(lds + MISC_OFF);
            const attn_body::bf16* Q = (const attn_body::bf16*)slotp(ws, l, 4); const attn_body::bf16* K = (const attn_body::bf16*)slotp(ws, l, 5); const attn_body::bf16* V = (const attn_body::bf16*)slotp(ws, l, 6);
            attn_body::bf16* O = (attn_body::bf16*)slotp(ws, l, 13);
            for (;;) {
                if (tid == 0) qw[0] = atomicAdd(ctr, 1u);
                __syncthreads();
                const unsigned u = qw[0];
                __syncthreads();
                if (u >= 4096u) break;
                const int qb = 31 - (int)(u >> 7), bh = (int)(u & 127);
                attn_body::attn_unit<8>(bh >> 4, bh & 15, qb, Q, K, V, O, (char*)lds_raw, wv);
            }
            SEAM(p0 + 4); }
        if (IN(p0 + 5)) { PH_BEGIN
            post_attn(A, l, gw, NGW, lane);
            conv_p(A, l, (bfu*)slotp(ws, l, 10), gtid, NT);
            if (l == 0) conv_weights(A, 1, 1, lds, gw, NGW, lane, wave);
            SEAM(p0 + 5); }
        if (IN(p0 + 6)) { PH_BEGIN
            pg8::Gemm g{(const pg8::bf16_t*)slotp(ws, l, 7), (const pg8::bf16_t*)(wb + W_OUT), MPAD, 1024, 1024};
            pg8::StaticOrder S; S.init(MPAD, 1024, G, bid);
            EpiH<2> E{A->out, (bfu*)slotp(ws, l, 0), rsb + (size_t)(3 * l + 1) * MPAD, nullptr, nullptr};
            pg8::gemm_phase<EpiH<2>, pg8::StaticOrder, true, true>((PG8_LAS unsigned char*)lds, g, S, E, wv);
            SEAM(p0 + 6); }
        if (IN(p0 + 7)) { PH_BEGIN
            pg8::Gemm g{(const pg8::bf16_t*)slotp(ws, l, 0), (const pg8::bf16_t*)(wb + W_FF1), MPAD, FFD, 1024};
            pg8::StaticOrder S; S.init(MPAD, FFD, G, bid);
            EpiB<1> E{(bfu*)slotp(ws, l, 2), FFD, rsb + (size_t)(3 * l + 1) * MPAD};
            pg8::gemm_phase<EpiB<1>, pg8::StaticOrder, true, true>((PG8_LAS unsigned char*)lds, g, S, E, wv);
            SEAM(p0 + 7); }
        if (IN(p0 + 8)) { PH_BEGIN
            pg8::Gemm g{(const pg8::bf16_t*)slotp(ws, l, 2), (const pg8::bf16_t*)(wb + W_FF2), MPAD, 1024, FFD};
            pg8::StaticOrder S; S.init(MPAD, 1024, G, bid);
            EpiH<2> E{A->out, (bfu*)slotp(ws, l, 0), rsb + (size_t)(3 * l + 2) * MPAD, nullptr, nullptr};
            pg8::gemm_phase<EpiH<2>, pg8::StaticOrder, true, true>((PG8_LAS unsigned char*)lds, g, S, E, wv);
            SEAM(p0 + 8); }
        if (IN(p0 + 9)) { PH_BEGIN
            pg8::Gemm g{(const pg8::bf16_t*)slotp(ws, l, 10), (const pg8::bf16_t*)(wb + W_PP), MPAD, 1024, 256};
            pg8::StaticOrder S; S.init(MPAD, 1024, G, bid);
            EpiB<0> E{(bfu*)slotp(ws, l, 11), 1024, nullptr};
            pg8::gemm_phase<EpiB<0>, pg8::StaticOrder, true, true>((PG8_LAS unsigned char*)lds, g, S, E, wv);
            SEAM(p0 + 9); }
        if (IN(p0 + 10)) { PH_BEGIN
            pg8::Gemm g{(const pg8::bf16_t*)slotp(ws, l, 0), (const pg8::bf16_t*)(wb + W_GATE), MPAD, 1024, 1024};
            pg8::StaticOrder S; S.init(MPAD, 1024, G, bid);
            EpiH<3> E{A->out, (bfu*)slotp(ws, l, 13), rsb + (size_t)(3 * l + 3) * MPAD, rsb + (size_t)(3 * l + 2) * MPAD, (const bfu*)slotp(ws, l, 11)};
            pg8::gemm_phase<EpiH<3>, pg8::StaticOrder, true, true>((PG8_LAS unsigned char*)lds, g, S, E, wv);
            SEAM(p0 + 10); }
        }
    { constexpr int l = 1;

        const int p0 = 1 + 11 * l;
        if (IN(p0 + 0)) { PH_BEGIN
            pg8::Gemm g{(const pg8::bf16_t*)slotp(ws, l, 0), (const pg8::bf16_t*)(wb + W_IN), MPAD, NIN, 1024};
            pg8::StaticOrder S; S.init(MPAD, NIN, G, bid);
            EpiG1 E{rsb + (size_t)(3 * l) * MPAD, (bfu*)slotp(ws, l, 2), (bfu*)slotp(ws, l, 4), (bfu*)slotp(ws, l, 5), (bfu*)slotp(ws, l, 6), (bfu*)slotp(ws, l, 7), (float*)(ws + WS_AB), (const float*)(ws + WS_ROPE),
                    A->out + O_BKP + (size_t)l * MP * 512, A->out + O_BVP + (size_t)l * MP * 512, A->out + O_BKS + (size_t)l * MS * 512, A->out + O_BVS + (size_t)l * MS * 512};
            pg8::gemm_phase<EpiG1, pg8::StaticOrder, true, true>((PG8_LAS unsigned char*)lds, g, S, E, wv);
            SEAM(p0 + 0); }
        if (IN(p0 + 1)) { PH_BEGIN
            prep_a(A, l, gw, NGW, lane); prep_c1(A, l, gw, NGW, lane);
            if (l == 1) conv_weights(A, 1, 2, lds, gw, NGW, lane, wave);
            SEAM(p0 + 1); }
        if (IN(p0 + 2)) { PH_BEGIN
            pg8::Gemm g{(const pg8::bf16_t*)slotp(ws, l, 12), (const pg8::bf16_t*)(wb + W_LR), MPAD, 768, 256};
            pg8::StaticOrder S; S.init(MPAD, 768, G, bid);
            EpiB<0> E{(bfu*)slotp(ws, l, 13), 768, nullptr};
            pg8::gemm_phase<EpiB<0>, pg8::StaticOrder, true, true>((PG8_LAS unsigned char*)lds, g, S, E, wv);
            SEAM(p0 + 2); }
        if (IN(p0 + 3)) { PH_BEGIN prep_c2(A, l, bid, G, tid); SEAM(p0 + 3); }
        if (IN(p0 + 4)) { PH_BEGIN
            if (bid < 32) { const int b = bid >> 2, h = bid & 3;
                scan_rwkv(A, l, lds, h, b * 8192, 8192, 32, 5, b * 128, nullptr, A->out + O_CWP + (size_t)((l * 8 + b) * 4 + h) * 4096, tid);
#ifdef PROBE_SCAN2
                scan_rwkv(A, l, lds, h, b * 8192, 8192, 32, 5, b * 128, nullptr, A->out + O_CWP + (size_t)((l * 8 + b) * 4 + h) * 4096, tid);
#endif
                scan_rwkv(A, l, lds, h, MP + b * 16, 16, 16, 4, 1024 + b, A->in[7] + (size_t)((l * 8 + b) * 4 + h) * 4096, A->out + O_CWS + (size_t)((l * 8 + b) * 4 + h) * 4096, tid);
            } else if (bid < 64) { const int b = (bid - 32) >> 2, h = bid & 3;
                scan_delta(A, l, lds, h, b * 8192, 8192, 32, 5, nullptr, A->out + O_ADP + (size_t)((l * 8 + b) * 4 + h) * 4096, tid);
#ifdef PROBE_SCAN2
                scan_delta(A, l, lds, h, b * 8192, 8192, 32, 5, nullptr, A->out + O_ADP + (size_t)((l * 8 + b) * 4 + h) * 4096, tid);
#endif
                scan_delta(A, l, lds, h, MP + b * 16, 16, 16, 4, A->in[5] + (size_t)((l * 8 + b) * 4 + h) * 4096, A->out + O_ADS + (size_t)((l * 8 + b) * 4 + h) * 4096, tid);
            } else if (bid < 96) { sample_attn(A, l, lds, bid - 64, tid); }
            __syncthreads();
            unsigned* ctr = (unsigned*)(ws + WS_CTL) + 16 * l; volatile LAS unsigned* qw = (volatile LAS unsigned*)(lds + MISC_OFF);
            const attn_body::bf16* Q = (const attn_body::bf16*)slotp(ws, l, 4); const attn_body::bf16* K = (const attn_body::bf16*)slotp(ws, l, 5); const attn_body::bf16* V = (const attn_body::bf16*)slotp(ws, l, 6);
            attn_body::bf16* O = (attn_body::bf16*)slotp(ws, l, 13);
            for (;;) {
                if (tid == 0) qw[0] = atomicAdd(ctr, 1u);
                __syncthreads();
                const unsigned u = qw[0];
                __syncthreads();
                if (u >= 4096u) break;
                const int qb = 31 - (int)(u >> 7), bh = (int)(u & 127);
                attn_body::attn_unit<8>(bh >> 4, bh & 15, qb, Q, K, V, O, (char*)lds_raw, wv);
            }
            SEAM(p0 + 4); }
        if (IN(p0 + 5)) { PH_BEGIN
            post_attn(A, l, gw, NGW, lane);
            conv_p(A, l, (bfu*)slotp(ws, l, 10), gtid, NT);
            if (l == 0) conv_weights(A, 1, 1, lds, gw, NGW, lane, wave);
            SEAM(p0 + 5); }
        if (IN(p0 + 6)) { PH_BEGIN
            pg8::Gemm g{(const pg8::bf16_t*)slotp(ws, l, 7), (const pg8::bf16_t*)(wb + W_OUT), MPAD, 1024, 1024};
            pg8::StaticOrder S; S.init(MPAD, 1024, G, bid);
            EpiH<2> E{A->out, (bfu*)slotp(ws, l, 0), rsb + (size_t)(3 * l + 1) * MPAD, nullptr, nullptr};
            pg8::gemm_phase<EpiH<2>, pg8::StaticOrder, true, true>((PG8_LAS unsigned char*)lds, g, S, E, wv);
            SEAM(p0 + 6); }
        if (IN(p0 + 7)) { PH_BEGIN
            pg8::Gemm g{(const pg8::bf16_t*)slotp(ws, l, 0), (const pg8::bf16_t*)(wb + W_FF1), MPAD, FFD, 1024};
            pg8::StaticOrder S; S.init(MPAD, FFD, G, bid);
            EpiB<1> E{(bfu*)slotp(ws, l, 2), FFD, rsb + (size_t)(3 * l + 1) * MPAD};
            pg8::gemm_phase<EpiB<1>, pg8::StaticOrder, true, true>((PG8_LAS unsigned char*)lds, g, S, E, wv);
            SEAM(p0 + 7); }
        if (IN(p0 + 8)) { PH_BEGIN
            pg8::Gemm g{(const pg8::bf16_t*)slotp(ws, l, 2), (const pg8::bf16_t*)(wb + W_FF2), MPAD, 1024, FFD};
            pg8::StaticOrder S; S.init(MPAD, 1024, G, bid);
            EpiH<2> E{A->out, (bfu*)slotp(ws, l, 0), rsb + (size_t)(3 * l + 2) * MPAD, nullptr, nullptr};
            pg8::gemm_phase<EpiH<2>, pg8::StaticOrder, true, true>((PG8_LAS unsigned char*)lds, g, S, E, wv);
            SEAM(p0 + 8); }
        if (IN(p0 + 9)) { PH_BEGIN
            pg8::Gemm g{(const pg8::bf16_t*)slotp(ws, l, 10), (const pg8::bf16_t*)(wb + W_PP), MPAD, 1024, 256};
            pg8::StaticOrder S; S.init(MPAD, 1024, G, bid);
            EpiB<0> E{(bfu*)slotp(ws, l, 11), 1024, nullptr};
            pg8::gemm_phase<EpiB<0>, pg8::StaticOrder, true, true>((PG8_LAS unsigned char*)lds, g, S, E, wv);
            SEAM(p0 + 9); }
        if (IN(p0 + 10)) { PH_BEGIN
            pg8::Gemm g{(const pg8::bf16_t*)slotp(ws, l, 0), (const pg8::bf16_t*)(wb + W_GATE), MPAD, 1024, 1024};
            pg8::StaticOrder S; S.init(MPAD, 1024, G, bid);
            EpiH<3> E{A->out, (bfu*)slotp(ws, l, 13), rsb + (size_t)(3 * l + 3) * MPAD, rsb + (size_t)(3 * l + 2) * MPAD, (const bfu*)slotp(ws, l, 11)};
            pg8::gemm_phase<EpiH<3>, pg8::StaticOrder, true, true>((PG8_LAS unsigned char*)lds, g, S, E, wv);
            SEAM(p0 + 10); }
        }
    if (IN(NPHASE - 1)) { PH_BEGIN final_norm(A, gw, NGW, lane); }
}
#undef PH_BEGIN
#undef IN
#undef SEAM

extern "C" void kernel_launch(void* const* d_in, const int* in_sizes, int n_in, void* d_out, int out_size, void* d_ws, size_t ws_size, hipStream_t stream) {
    static int grid = 0;
    if (grid == 0) {
        if (n_in != 40 || (size_t)out_size != O_END || ws_size < WS_SLOT + 15 * USLOT) { fprintf(stderr, "kernel_launch: unexpected shapes (n_in %d out %d ws %zu)\n", n_in, out_size, ws_size); grid = -1; return; }
        int dev = 0, cus = 0, per_cu = 0;
        if (hipGetDevice(&dev) != hipSuccess || hipDeviceGetAttribute(&cus, hipDeviceAttributeMultiprocessorCount, dev) != hipSuccess) { grid = -1; return; }
        if (hipFuncSetAttribute((const void*)hybrid_fwd, hipFuncAttributeMaxDynamicSharedMemorySize, LDS_BYTES) != hipSuccess) { fprintf(stderr, "kernel_launch: hipFuncSetAttribute failed\n"); grid = -1; return; }
        if (hipOccupancyMaxActiveBlocksPerMultiprocessor(&per_cu, (const void*)hybrid_fwd, NTHR, LDS_BYTES) != hipSuccess || per_cu < 1) { fprintf(stderr, "kernel_launch: occupancy query says %d\n", per_cu); per_cu = 1; }
        (void)hipGetLastError();
        grid = cus;
    }
    if (grid < 0) return;
    if (hipMemsetAsync((char*)d_ws + WS_CTL, 0, 64 * 1024, stream) != hipSuccess) { fprintf(stderr, "kernel_launch: memset failed\n"); return; }
    Args a{};
    for (int i = 0; i < 40; ++i) a.in[i] = (const float*)d_in[i];
    a.out = (float*)d_out; a.ws = (unsigned char*)d_ws;
#if MK_ONE_LAUNCH
    a.ph_lo = 0; a.ph_hi = NPHASE;
    void* args[] = {&a};
    hipError_t e = hipLaunchCooperativeKernel((const void*)hybrid_fwd, dim3(grid), dim3(NTHR), args, LDS_BYTES, stream);
    if (e != hipSuccess) fprintf(stderr, "kernel_launch: cooperative launch failed: %s (grid %d)\n", hipGetErrorString(e), grid);
#else
    for (int ph = 0; ph < NPHASE; ++ph) { a.ph_lo = ph; a.ph_hi = ph + 1; hipLaunchKernelGGL(hybrid_fwd, dim3(grid), dim3(NTHR), LDS_BYTES, stream, a); }
#endif
}
```

```cpp
#include <hip/hip_runtime.h>
#include <hip/hip_cooperative_groups.h>
#include <cstdio>
#include <cstdint>
namespace cg = cooperative_groups;
namespace pg8 {
#define PG8_LAS __attribute__((address_space(3)))
typedef unsigned short bf16_t;
typedef short bf16x8 __attribute__((ext_vector_type(8)));
typedef float f32x4 __attribute__((ext_vector_type(4)));
typedef unsigned u32x4 __attribute__((ext_vector_type(4)));
constexpr int BM = 256, BK = 64, HALF = 128, HTB = HALF * BK * 2  , STAGE_BYTES = 8 * HTB, NXCD = 8, WGM = 8;

__host__ __device__ __forceinline__ int lds_byte(int r, int c) { const int st = (r >> 4) * 2 + (c >> 5), rr = r & 15, cc = c & 31, ob = rr * 64 + cc * 2; return st * 1024 + (ob ^ (((ob >> 9) & 1) << 5)); }
__host__ __device__ __forceinline__ void stage_rc(int b, int& R, int& C) { const int st = b / 1024, sb = b % 1024, swz = sb ^ (((sb >> 9) & 1) << 5); R = (st >> 1) * 16 + swz / 64; C = (st & 1) * 32 + (swz % 64) / 2; }
__host__ __device__ __forceinline__ int perm32(int rho) { const int n = rho >> 4, i = rho & 15; return 8 * (i >> 2) + 4 * n + (i & 3); }

struct Unit { int pm, pn; };
struct Gemm { const bf16_t* A; const bf16_t* Bt; int M, N, K; };

struct StaticOrder {
    int nM, nN, nwg, G, c;
    __host__ __device__ void init(int M, int N, int G_, int c_) { nM = M / BM; nN = N / BM; nwg = nM * nN; G = G_; c = c_; }
    __host__ __device__ bool next(int i, Unit& u) const {
        const long L = (long)i * G + c; if (L >= nwg) return false;
        int wgid = (int)L; { const int q = nwg / NXCD, r = nwg % NXCD, xcd = wgid % NXCD, off = wgid / NXCD; wgid = (xcd < r ? xcd * (q + 1) : r * (q + 1) + (xcd - r) * q) + off; }
        const int nig = WGM * nN, gid = wgid / nig, fm = gid * WGM, gsz = (nM - fm) < WGM ? (nM - fm) : WGM;
        u.pm = fm + ((wgid % nig) % gsz); u.pn = (wgid % nig) / gsz; return true;
    }
    __device__ __forceinline__ void a_ready(const Unit&) const {}
    __device__ __forceinline__ void done(const Unit&) const {}
};

__device__ __forceinline__ unsigned cvt_pk_bf16(float lo, float hi) { unsigned r; asm volatile("v_cvt_pk_bf16_f32 %0, %1, %2" : "=v"(r) : "v"(lo), "v"(hi)); return r; }
typedef float f32x2 __attribute__((ext_vector_type(2)));
__device__ __forceinline__ f32x2 gelu_pk(f32x2 v) {
    const f32x2 av = __builtin_elementwise_abs(v), d = av * 0.2316418882f + 1.0f;
    f32x2 t; t.x = __builtin_amdgcn_rcpf(d.x); t.y = __builtin_amdgcn_rcpf(d.y);
    f32x2 q = t * 0.5307027145f + (-0.7265760135f); q = q * t + 0.7107068705f; q = q * t + (-0.142248368f); q = q * t + 0.127414796f; q = q * t;
    const f32x2 s = (v * v) * (-0.72134752044f);
    f32x2 e; e.x = __builtin_amdgcn_exp2f(s.x); e.y = __builtin_amdgcn_exp2f(s.y);
    const f32x2 m = v * (q * e), r = v - m;
    f32x2 o; o.x = v.x < 0.f ? m.x : r.x; o.y = v.y < 0.f ? m.y : r.y; return o;
}

template <int ACT  > struct EpiBf16 {
    static constexpr bool PERM = true, AFTER_DRAIN = false; static_assert(ACT == 0 || ACT == 1, "EpiBf16: ACT is 0 (none) or 1 (gelu_pk)");
    bf16_t* O; int ldc; const float* bias; int split_cols; size_t split_stride; float scale0;
    __device__ __forceinline__ void operator()(const f32x4 (&acc)[2][2][4][2], const Unit& u, int wr, int wc, int fr, int fq) const {
        const int row0 = u.pm * BM + wr * 64 + fr; int colt = u.pn * BM; bf16_t* base = O;
        float sc = 1.f; if (split_cols) { const int t = colt / split_cols; base += (size_t)t * split_stride; colt -= t * split_cols; if (t == 0) sc = scale0; }
        const int col0 = colt + wc * 32 + 8 * fq, bcol0 = u.pn * BM + wc * 32 + 8 * fq;
        f32x4 bv[2][2];
#pragma unroll
        for (int bj = 0; bj < 2; ++bj)
#pragma unroll
            for (int n = 0; n < 2; ++n) bv[bj][n] = bias ? *(const f32x4*)(bias + bcol0 + bj * HALF + 4 * n) : (f32x4){0.f, 0.f, 0.f, 0.f};
#pragma unroll
        for (int ai = 0; ai < 2; ++ai)
#pragma unroll
            for (int m = 0; m < 4; ++m) { bf16_t* rowp = base + (size_t)(row0 + ai * HALF + m * 16) * ldc + col0;
#pragma unroll
                for (int bj = 0; bj < 2; ++bj) { f32x4 v0 = acc[ai][bj][m][0] + bv[bj][0], v1 = acc[ai][bj][m][1] + bv[bj][1];
                    if (ACT == 1) { f32x2 a = gelu_pk((f32x2){v0[0], v0[1]}), b = gelu_pk((f32x2){v0[2], v0[3]}), c = gelu_pk((f32x2){v1[0], v1[1]}), d = gelu_pk((f32x2){v1[2], v1[3]});
                        v0 = (f32x4){a.x, a.y, b.x, b.y}; v1 = (f32x4){c.x, c.y, d.x, d.y}; }
                    v0 = v0 * sc; v1 = v1 * sc; u32x4 w; w.x = cvt_pk_bf16(v0[0], v0[1]); w.y = cvt_pk_bf16(v0[2], v0[3]); w.z = cvt_pk_bf16(v1[0], v1[1]); w.w = cvt_pk_bf16(v1[2], v1[3]);
                    *(u32x4*)(rowp + bj * HALF) = w; } }
    }
};

struct PanelStats {
    unsigned* xbuf;
    unsigned* cnt;
    unsigned* tmo;
    int ntn; float eps;
    unsigned code;
    __device__ __forceinline__ bool run(const f32x4 (&v)[2][2][4][2], const Unit& u, int wr, int wc, int fr, int fq, PG8_LAS unsigned char* lds, int wid, int lane) const {
        typedef float f32x2v __attribute__((ext_vector_type(2)));
        PG8_LAS f32x2v* P = (PG8_LAS f32x2v*)lds;
        PG8_LAS f32x2v* S = (PG8_LAS f32x2v*)(lds + 8192);
        PG8_LAS unsigned* flag = (PG8_LAS unsigned*)(lds + 8192 + 2048);
#pragma unroll
        for (int ai = 0; ai < 2; ++ai)
#pragma unroll
            for (int m = 0; m < 4; ++m) {
                float s = 0.f;
#pragma unroll
                for (int bj = 0; bj < 2; ++bj)
#pragma unroll
                    for (int n = 0; n < 2; ++n) { const f32x4 x = v[ai][bj][m][n]; s += (x[0] + x[1]) + (x[2] + x[3]); }
                s += __shfl_xor(s, 16); s += __shfl_xor(s, 32);
                const float mw = s * (1.0f / 64.0f); float q = 0.f;
#pragma unroll
                for (int bj = 0; bj < 2; ++bj)
#pragma unroll
                    for (int n = 0; n < 2; ++n) { const f32x4 d = v[ai][bj][m][n] - mw; q += (d[0] * d[0] + d[1] * d[1]) + (d[2] * d[2] + d[3] * d[3]); }
                q += __shfl_xor(q, 16); q += __shfl_xor(q, 32);
                if (fq == 0) P[(ai * HALF + wr * 64 + m * 16 + fr) * 4 + wc] = (f32x2v){mw, q};
            }
        asm volatile("s_waitcnt lgkmcnt(0)" ::: "memory"); __builtin_amdgcn_s_barrier(); asm volatile("" ::: "memory");
#if defined(BROKEN_EXCHANGE_NO_WAIT)
#warning BROKEN CONTROL BUILD: the row-statistics exchange does not wait; results are wrong by design
        if (blockIdx.x >= 64) { const long long t0_ = clock64(); while (clock64() - t0_ < 60000) __builtin_amdgcn_s_sleep(8); }
#endif
        const int row = wid * 32 + (lane & 31);
        if (lane < 32) {
            const f32x2v a = P[row * 4 + 0], b = P[row * 4 + 1], c = P[row * 4 + 2], d = P[row * 4 + 3];
            const float mt = (a.x + b.x + c.x + d.x) * 0.25f;
            const float da = a.x - mt, db = b.x - mt, dc = c.x - mt, dd = d.x - mt;
            const float m2 = (a.y + b.y) + (c.y + d.y) + 64.0f * ((da * da + db * db) + (dc * dc + dd * dd));
            unsigned long long* slot = (unsigned long long*)xbuf + ((size_t)(u.pm * BM + row) * 4 + u.pn);
            __hip_atomic_store(slot, ((unsigned long long)__float_as_uint(m2) << 32) | __float_as_uint(mt), __ATOMIC_RELAXED, __HIP_MEMORY_SCOPE_AGENT);
        }
        asm volatile("s_waitcnt vmcnt(0)" ::: "memory");
        if (lane == 0) __hip_atomic_fetch_add(cnt + 64 * u.pm, 1u, __ATOMIC_RELAXED, __HIP_MEMORY_SCOPE_AGENT);
        if (wid == 0) {
            bool dead = false; const unsigned long long t0 = __builtin_amdgcn_s_memrealtime(); const unsigned want = 8u * (unsigned)ntn;
            for (;;) {
#if defined(BROKEN_EXCHANGE_NO_WAIT)
                break;
#endif
                if ((unsigned)__builtin_amdgcn_readfirstlane(__hip_atomic_load(cnt + 64 * u.pm, __ATOMIC_RELAXED, __HIP_MEMORY_SCOPE_AGENT)) >= want) break;
                if (__builtin_amdgcn_s_memrealtime() - t0 > 2000000ull) {
                    if (lane == 0) { unsigned expect = 0u; __hip_atomic_compare_exchange_strong(tmo + 1, &expect, code | (unsigned)(u.pm & 0xff), __ATOMIC_RELAXED, __ATOMIC_RELAXED, __HIP_MEMORY_SCOPE_AGENT);
                                     __hip_atomic_store(tmo, 1u, __ATOMIC_RELAXED, __HIP_MEMORY_SCOPE_AGENT); }
                    dead = true; break; }
                __builtin_amdgcn_s_sleep(2);
            }
            __builtin_amdgcn_fence(__ATOMIC_ACQUIRE, "agent");
            if (lane == 0) flag[0] = dead ? 1u : 0u;
        }
        asm volatile("s_waitcnt vmcnt(0) lgkmcnt(0)" ::: "memory"); __builtin_amdgcn_s_barrier(); asm volatile("" ::: "memory");
        const bool bad = flag[0] != 0u;
        if (lane < 32) {
            const unsigned long long* slot = (const unsigned long long*)xbuf + (size_t)(u.pm * BM + row) * 4; float mt[4], m2[4]; float ms = 0.f;
#pragma unroll
            for (int t = 0; t < 4; ++t) { if (t < ntn) { const unsigned long long w = __hip_atomic_load(slot + t, __ATOMIC_RELAXED, __HIP_MEMORY_SCOPE_AGENT); mt[t] = __uint_as_float((unsigned)w); m2[t] = __uint_as_float((unsigned)(w >> 32)); } else { mt[t] = 0.f; m2[t] = 0.f; } ms += mt[t]; }
            const float mean = ms / (float)ntn; float q = 0.f;
#pragma unroll
            for (int t = 0; t < 4; ++t) if (t < ntn) { const float dm = mt[t] - mean; q += m2[t] + 256.0f * dm * dm; }
            S[row] = (f32x2v){mean, 1.0f / sqrtf(q / (256.0f * (float)ntn) + eps)};
        }
        asm volatile("s_waitcnt lgkmcnt(0)" ::: "memory"); __builtin_amdgcn_s_barrier(); asm volatile("" ::: "memory");
        return bad;
    }
};
struct EpiLnRes {
    static constexpr bool PERM = false, AFTER_DRAIN = true;
    const float* base; float* out; int ldc; const float* bias; PanelStats st; unsigned poison;
    __device__ __forceinline__ void fused(f32x4 (&acc)[2][2][4][2], const Unit& u, int wr, int wc, int fr, int fq, PG8_LAS unsigned char* lds, int wid, int lane) const {
        typedef float f32x2v __attribute__((ext_vector_type(2)));
        const PG8_LAS f32x2v* S = (const PG8_LAS f32x2v*)(lds + 8192);
        const int col0 = u.pn * BM + wc * 32 + 4 * fq;
#pragma unroll
        for (int bj = 0; bj < 2; ++bj)
#pragma unroll
            for (int n = 0; n < 2; ++n) { const f32x4 bv = bias ? *(const f32x4*)(bias + col0 + bj * HALF + n * 16) : (f32x4){0.f, 0.f, 0.f, 0.f};
#pragma unroll
                for (int ai = 0; ai < 2; ++ai)
#pragma unroll
                    for (int m = 0; m < 4; ++m) acc[ai][bj][m][n] += bv; }
        f32x4 pre[4][2][2];
#pragma unroll
        for (int m = 0; m < 4; ++m) { const size_t off = (size_t)(u.pm * BM + wr * 64 + m * 16 + fr) * ldc + col0;
#pragma unroll
            for (int bj = 0; bj < 2; ++bj)
#pragma unroll
                for (int n = 0; n < 2; ++n) pre[m][bj][n] = *(const f32x4*)(base + off + bj * HALF + n * 16); }
        const bool bad = st.run(acc, u, wr, wc, fr, fq, lds, wid, lane) || poison != 0u;
        const float qnan = __builtin_nanf("");
#pragma unroll
        for (int ai = 0; ai < 2; ++ai)
#pragma unroll
            for (int m = 0; m < 4; ++m) { const int r = ai * HALF + wr * 64 + m * 16 + fr; const f32x2v sr = S[r]; const size_t off = (size_t)(u.pm * BM + r) * ldc + col0;
#pragma unroll
                for (int bj = 0; bj < 2; ++bj)
#pragma unroll
                    for (int n = 0; n < 2; ++n) { const f32x4 bs = ai == 0 ? pre[m][bj][n] : *(const f32x4*)(base + off + bj * HALF + n * 16); f32x4 o = bs + (acc[ai][bj][m][n] - sr.x) * sr.y;
                        if (bad) o = (f32x4){qnan, qnan, qnan, qnan}; *(f32x4*)(out + off + bj * HALF + n * 16) = o; }
                if (m & 1) asm volatile("" ::: "memory"); }
    }
};
struct EpiLnResLn {
    static constexpr bool PERM = false, AFTER_DRAIN = true;
    const float* base; float* out; bf16_t* xn; int ldc; const float* bias; PanelStats st1, st2; unsigned poison;
    __device__ __forceinline__ void fused(f32x4 (&acc)[2][2][4][2], const Unit& u, int wr, int wc, int fr, int fq, PG8_LAS unsigned char* lds, int wid, int lane) const {
        typedef float f32x2v __attribute__((ext_vector_type(2))); typedef unsigned u32x2v __attribute__((ext_vector_type(2)));
        const PG8_LAS f32x2v* S = (const PG8_LAS f32x2v*)(lds + 8192);
        const int col0 = u.pn * BM + wc * 32 + 4 * fq;
#pragma unroll
        for (int bj = 0; bj < 2; ++bj)
#pragma unroll
            for (int n = 0; n < 2; ++n) { const f32x4 bv = bias ? *(const f32x4*)(bias + col0 + bj * HALF + n * 16) : (f32x4){0.f, 0.f, 0.f, 0.f};
#pragma unroll
                for (int ai = 0; ai < 2; ++ai)
#pragma unroll
                    for (int m = 0; m < 4; ++m) acc[ai][bj][m][n] += bv; }
        bool bad = st1.run(acc, u, wr, wc, fr, fq, lds, wid, lane) || poison != 0u;
        const float qnan = __builtin_nanf("");
#pragma unroll
        for (int ai = 0; ai < 2; ++ai)
#pragma unroll
            for (int m = 0; m < 4; ++m) { const int r = ai * HALF + wr * 64 + m * 16 + fr; const f32x2v sr = S[r]; const size_t off = (size_t)(u.pm * BM + r) * ldc + col0;
#pragma unroll
                for (int bj = 0; bj < 2; ++bj)
#pragma unroll
                    for (int n = 0; n < 2; ++n) { const f32x4 bs = *(const f32x4*)(base + off + bj * HALF + n * 16); acc[ai][bj][m][n] = bs + (acc[ai][bj][m][n] - sr.x) * sr.y; }
                asm volatile("" : "+v"(acc[ai][0][m][0]), "+v"(acc[ai][0][m][1]), "+v"(acc[ai][1][m][0]), "+v"(acc[ai][1][m][1]));
                if (m & 1) asm volatile("" ::: "memory"); }
        const bool bad1 = bad;
        bad = st2.run(acc, u, wr, wc, fr, fq, lds, wid, lane) || bad;
#pragma unroll
        for (int ai = 0; ai < 2; ++ai)
#pragma unroll
            for (int m = 0; m < 4; ++m) { const int r = ai * HALF + wr * 64 + m * 16 + fr; const f32x2v sr = S[r]; const size_t off = (size_t)(u.pm * BM + r) * ldc + col0;
#pragma unroll
                for (int bj = 0; bj < 2; ++bj)
#pragma unroll
                    for (int n = 0; n < 2; ++n) { const f32x4 x1 = acc[ai][bj][m][n]; *(f32x4*)(out + off + bj * HALF + n * 16) = bad1 ? (f32x4){qnan, qnan, qnan, qnan} : x1;
                        const f32x4 o = (x1 - sr.x) * sr.y; u32x2v w; w.x = cvt_pk_bf16(o[0], o[1]); w.y = cvt_pk_bf16(o[2], o[3]);
                        if (bad) { w.x = 0x7fc07fc0u; w.y = 0x7fc07fc0u; } *(u32x2v*)(xn + off + bj * HALF + n * 16) = w; }
                asm volatile("" ::: "memory"); }
    }
};

template <class Epi, class Sched, bool ALIGN_EPI = false, bool SP2 = false>
__device__ __forceinline__ void gemm_phase(PG8_LAS unsigned char* lds, const Gemm g, const Sched& S, const Epi& E, const int wv_) {
    int tid_o = wv_ * 64 + (int)__builtin_amdgcn_mbcnt_hi(~0u, __builtin_amdgcn_mbcnt_lo(~0u, 0u)); asm volatile("" : "+v"(tid_o)); tid_o &= 511;
    const int tid = tid_o, wid = __builtin_amdgcn_readfirstlane(tid >> 6), lane = tid & 63, wr = wid >> 2, wc = wid & 3, fr = lane & 15, fq = lane >> 4;
    const int K = g.K, nt = K / BK;
    unsigned voffA[2], voffB[2];
#pragma unroll
    for (int i = 0; i < 2; ++i) { int R, C; stage_rc(tid * 16 + i * 8192, R, C); const int Rb = Epi::PERM ? ((R & ~31) + perm32(R & 31)) : R;
        voffA[i] = (unsigned)(R * K + C) * 2u; voffB[i] = (unsigned)(Rb * K + C) * 2u; }
    const size_t kstep = (size_t)(BK * 2);
    const size_t hstep = (size_t)HALF * K * 2;
    const size_t tstep = 2 * hstep;
    const unsigned ldsw = (unsigned)wid * 1024u;
    const int aoff = lds_byte(wr * 64 + fr, fq * 8), boff = lds_byte(wc * 32 + fr, fq * 8);
#define PG8_SA(b, h) (((b) * 2 + (h)) * HTB)
#define PG8_SB(b, h) ((4 + (b) * 2 + (h)) * HTB)
#define PG8_STAGE(bufoff, gbase, voff) do { _Pragma("unroll") for (int _i = 0; _i < 2; ++_i) \
        __builtin_amdgcn_global_load_lds((const unsigned*)((const char*)(gbase) + (voff)[_i]), (PG8_LAS unsigned*)(lds + (bufoff) + ldsw + _i * 8192), 16, 0, 0); } while (0)
#define PG8_LDA(dst, b, h) do { _Pragma("unroll") for (int m = 0; m < 4; ++m) _Pragma("unroll") for (int k = 0; k < 2; ++k) dst[m][k] = *(const PG8_LAS bf16x8*)(lds + PG8_SA(b, h) + aoff + m * 2048 + k * 1024); } while (0)
#define PG8_LDB(dst, b, h) do { _Pragma("unroll") for (int n = 0; n < 2; ++n) _Pragma("unroll") for (int k = 0; k < 2; ++k) dst[n][k] = *(const PG8_LAS bf16x8*)(lds + PG8_SB(b, h) + boff + n * 2048 + k * 1024); } while (0)
#define PG8_MMA(ai, bj, At, Bt) do { __builtin_amdgcn_s_setprio(1); _Pragma("unroll") for (int m = 0; m < 4; ++m) _Pragma("unroll") for (int n = 0; n < 2; ++n) _Pragma("unroll") for (int k = 0; k < 2; ++k) \
        acc[ai][bj][m][n] = __builtin_amdgcn_mfma_f32_16x16x32_bf16(Bt[n][k], At[m][k], acc[ai][bj][m][n], 0, 0, 0); __builtin_amdgcn_s_setprio(0); } while (0)
#define PG8_WAIT_V(n) asm volatile("s_waitcnt vmcnt(" #n ")" ::: "memory")
#define PG8_WAIT_L(n) asm volatile("s_waitcnt lgkmcnt(" #n ")" ::: "memory")
#define PG8_BAR __builtin_amdgcn_s_barrier()
#define PG8_SCHED __builtin_amdgcn_sched_barrier(0)
    Unit cur, nxt; int ui = 0;
    if (!S.next(0, cur)) return;
    f32x4 acc[2][2][4][2];
#pragma unroll
    for (int a = 0; a < 2; ++a)
#pragma unroll
        for (int b = 0; b < 2; ++b)
#pragma unroll
            for (int m = 0; m < 4; ++m)
#pragma unroll
                for (int n = 0; n < 2; ++n) acc[a][b][m][n] = (f32x4){0.f, 0.f, 0.f, 0.f};
    bf16x8 At[4][2], B0[2][2], B1[2][2];
    const char* cA = (const char*)g.A + (size_t)cur.pm * tstep; const char* cB = (const char*)g.Bt + (size_t)cur.pn * tstep;
    S.a_ready(cur);
    if constexpr (SP2) {
        PG8_STAGE(PG8_SB(0, 0), cB, voffB); PG8_STAGE(PG8_SB(0, 1), cB + hstep, voffB); PG8_STAGE(PG8_SA(0, 0), cA, voffA); PG8_STAGE(PG8_SA(0, 1), cA + hstep, voffA);
        if (wr == 1) PG8_BAR;
        PG8_WAIT_V(2); PG8_BAR;
        PG8_STAGE(PG8_SB(1, 0), cB + kstep, voffB); PG8_STAGE(PG8_SA(1, 0), cA + kstep, voffA); PG8_STAGE(PG8_SB(1, 1), cB + hstep + kstep, voffB);
        PG8_WAIT_V(6); PG8_BAR;
    } else {
        PG8_STAGE(PG8_SB(0, 0), cB, voffB); PG8_STAGE(PG8_SA(0, 0), cA, voffA); PG8_STAGE(PG8_SB(0, 1), cB + hstep, voffB); PG8_STAGE(PG8_SA(0, 1), cA + hstep, voffA);
        if (wr == 1) PG8_BAR;
        PG8_WAIT_V(4); PG8_BAR;
        PG8_STAGE(PG8_SB(1, 0), cB + kstep, voffB); PG8_STAGE(PG8_SA(1, 0), cA + kstep, voffA); PG8_STAGE(PG8_SB(1, 1), cB + hstep + kstep, voffB);
        PG8_WAIT_V(6); PG8_BAR;
    }
    for (;;) {
        const bool has_next = S.next(ui + 1, nxt);
        const char* nA = has_next ? (const char*)g.A + (size_t)nxt.pm * tstep : cA; const char* nB = has_next ? (const char*)g.Bt + (size_t)nxt.pn * tstep : cB;
        for (int t = 0; t < nt; t += 2) {
            const bool last = (t == nt - 2);
            const char* a1 = cA + (size_t)(t + 1) * kstep;
            const char* a2 = last ? nA : cA + (size_t)(t + 2) * kstep; const char* b2 = last ? nB : cB + (size_t)(t + 2) * kstep;
            const char* a3 = a2 + kstep; const char* b3 = b2 + kstep;
            if (last && has_next) S.a_ready(nxt);
            if constexpr (SP2) {
            PG8_LDB(B0, 0, 0); PG8_LDB(B1, 0, 1); PG8_SCHED; PG8_LDA(At, 0, 0); PG8_STAGE(PG8_SA(1, 1), a1 + hstep, voffA);
            PG8_WAIT_V(8); PG8_WAIT_L(0); PG8_BAR; PG8_MMA(0, 0, At, B0); PG8_MMA(0, 1, At, B1); PG8_BAR; PG8_SCHED;
            PG8_LDA(At, 0, 1); PG8_STAGE(PG8_SB(0, 0), b2, voffB); PG8_STAGE(PG8_SB(0, 1), b2 + hstep, voffB); PG8_STAGE(PG8_SA(0, 0), a2, voffA);
            PG8_WAIT_V(8); PG8_WAIT_L(0); PG8_BAR; PG8_MMA(1, 0, At, B0); PG8_MMA(1, 1, At, B1); PG8_BAR; PG8_SCHED;
            PG8_LDB(B0, 1, 0); PG8_LDB(B1, 1, 1); PG8_SCHED; PG8_LDA(At, 1, 0); PG8_STAGE(PG8_SA(0, 1), a2 + hstep, voffA);
            PG8_WAIT_V(8); PG8_WAIT_L(0); PG8_BAR; PG8_MMA(0, 0, At, B0); PG8_MMA(0, 1, At, B1); PG8_BAR; PG8_SCHED;
            PG8_LDA(At, 1, 1); PG8_STAGE(PG8_SB(1, 0), b3, voffB); PG8_STAGE(PG8_SB(1, 1), b3 + hstep, voffB); PG8_STAGE(PG8_SA(1, 0), a3, voffA);
            PG8_WAIT_V(8); PG8_WAIT_L(0); PG8_BAR; PG8_MMA(1, 0, At, B0); PG8_MMA(1, 1, At, B1); PG8_BAR; PG8_SCHED;
            } else {
            PG8_LDB(B0, 0, 0); PG8_SCHED; PG8_LDA(At, 0, 0); PG8_STAGE(PG8_SA(1, 1), a1 + hstep, voffA);
            PG8_WAIT_L(8); PG8_BAR; PG8_WAIT_L(0); PG8_MMA(0, 0, At, B0); PG8_BAR; PG8_SCHED;
            PG8_LDB(B1, 0, 1); PG8_STAGE(PG8_SB(0, 0), b2, voffB);
            PG8_BAR; PG8_WAIT_L(0); PG8_MMA(0, 1, At, B1); PG8_BAR;
            PG8_LDA(At, 0, 1); PG8_STAGE(PG8_SA(0, 0), a2, voffA);
            PG8_BAR; PG8_WAIT_L(0); PG8_MMA(1, 0, At, B0); PG8_BAR; PG8_SCHED;
            PG8_STAGE(PG8_SB(0, 1), b2 + hstep, voffB);
            PG8_WAIT_V(6); PG8_BAR; PG8_MMA(1, 1, At, B1); PG8_BAR;
            PG8_LDB(B0, 1, 0); PG8_SCHED; PG8_LDA(At, 1, 0); PG8_STAGE(PG8_SA(0, 1), a2 + hstep, voffA);
            PG8_WAIT_L(8); PG8_BAR; PG8_WAIT_L(0); PG8_MMA(0, 0, At, B0); PG8_BAR; PG8_SCHED;
            PG8_LDB(B1, 1, 1); PG8_STAGE(PG8_SB(1, 0), b3, voffB);
            PG8_BAR; PG8_WAIT_L(0); PG8_MMA(0, 1, At, B1); PG8_BAR;
            PG8_LDA(At, 1, 1); PG8_STAGE(PG8_SA(1, 0), a3, voffA);
            PG8_BAR; PG8_WAIT_L(0); PG8_MMA(1, 0, At, B0); PG8_BAR; PG8_SCHED;
            PG8_STAGE(PG8_SB(1, 1), b3 + hstep, voffB);
            PG8_WAIT_V(6); PG8_BAR; PG8_MMA(1, 1, At, B1); PG8_BAR;
            }
        }
        if constexpr (ALIGN_EPI) { if (wr == 0) PG8_BAR; }
        if constexpr (!Epi::AFTER_DRAIN) { E(acc, cur, wr, wc, fr, fq); S.done(cur); }
        if (!has_next) break;
#pragma unroll
        for (int a = 0; a < 2; ++a)
#pragma unroll
            for (int b = 0; b < 2; ++b)
#pragma unroll
                for (int m = 0; m < 4; ++m)
#pragma unroll
                    for (int n = 0; n < 2; ++n) acc[a][b][m][n] = (f32x4){0.f, 0.f, 0.f, 0.f};
        cur = nxt; cA = nA; cB = nB; ++ui;
        if constexpr (ALIGN_EPI) { if (wr == 1) PG8_BAR; }
    }
    PG8_WAIT_V(0);
    if constexpr (!ALIGN_EPI) { if (wr == 0) PG8_BAR; }
    PG8_BAR;
    if constexpr (Epi::AFTER_DRAIN) { E.fused(acc, cur, wr, wc, fr, fq, lds, wid, lane); S.done(cur); }
#undef PG8_SA
#undef PG8_SB
#undef PG8_STAGE
#undef PG8_LDA
#undef PG8_LDB
#undef PG8_MMA
#undef PG8_WAIT_V
#undef PG8_WAIT_L
#undef PG8_BAR
#undef PG8_SCHED
}
}
#include <hip/hip_bf16.h>
#include <cmath>
namespace attn_body {
using bf16=__hip_bfloat16;
using bf16x8=__attribute__((ext_vector_type(8)))short;
using s16x4=__attribute__((ext_vector_type(4)))short;
using f32x16=__attribute__((ext_vector_type(16)))float;
using u32x4=__attribute__((ext_vector_type(4)))unsigned;
constexpr int BATCH=8,NHEAD=16,SEQ=8192,D=64,DM=NHEAD*D,DMI=512,DMO=1024;
constexpr int NW=8,QBLK=32,QB=QBLK*NW,KVBLK=64,NQB=SEQ/QB;
constexpr int ATTN_PITCH=DM, ATTN_UNIT_ROWS=QB;
__device__ __forceinline__ int crow(int r,int hi){return (r&3)+8*(r>>2)+4*hi;}
#define SBAR() __builtin_amdgcn_sched_barrier(0)
__device__ __forceinline__ void cmask(f32x16&p0,f32x16&p1,int jb,int qrel,int hi){
  const float NEG=-INFINITY; int kb=64*jb+4*hi;
  #pragma unroll
  for(int r=0;r<16;++r){ if(jb>(qrel>>6)){p0[r]=NEG;p1[r]=NEG;} } (void)kb;
}

constexpr int NSLOT=3, SLOTB=8192;
constexpr int LDS_K=0, LDS_V=NSLOT*SLOTB, LDS_WS=2*NSLOT*SLOTB, LDS_OST=LDS_WS+NW*64*4, LDS_BYTES=LDS_OST+NW*4096;
constexpr float C2=0.125f*1.4426950408889634f;
__device__ __forceinline__ void glds16(const void*gsrc,unsigned lds_dst){unsigned keep;
  asm volatile("s_mov_b32 %0, m0\n\ts_mov_b32 m0, %2\n\ts_nop 0\n\tglobal_load_lds_dwordx4 %1, off\n\ts_mov_b32 m0, %0":"=&s"(keep):"v"(gsrc),"s"(lds_dst):"memory");}
__device__ __forceinline__ float max3f(float a,float b,float c){float r;asm("v_max3_f32 %0, %1, %2, %3":"=v"(r):"v"(a),"v"(b),"v"(c));return r;}
__device__ __forceinline__ float max2f(float a,float b){float r;asm("v_max_f32_e32 %0, %1, %2":"=v"(r):"v"(a),"v"(b));return r;}
__device__ __forceinline__ float fadd_s(float a,float b){float r;asm("v_add_f32_e32 %0, %1, %2":"=v"(r):"v"(a),"v"(b));return r;}
__device__ __forceinline__ float fsub_s(float a,float b){float r;asm("v_sub_f32_e32 %0, %1, %2":"=v"(r):"v"(a),"v"(b));return r;}
typedef float f32x2_t __attribute__((ext_vector_type(2))); typedef __bf16 bf16x2_t __attribute__((ext_vector_type(2)));
__device__ __forceinline__ unsigned cvtpk_s(float lo,float hi){f32x2_t v={lo,hi};bf16x2_t b=__builtin_convertvector(v,bf16x2_t);return __builtin_bit_cast(unsigned,b);}
#define WAIT_BAR(N) asm volatile("s_waitcnt vmcnt(" #N ") lgkmcnt(0)\n\ts_barrier":::"memory")

__device__ __forceinline__ void qkt(f32x16&p0,f32x16&p1,const char*Kslot,const bf16x8*qr,const f32x16&negm,int r32,int hi){
  const char*kb=Kslot+hi*1024+r32*16;
  #pragma unroll
  for(int d0=0;d0<4;++d0){
    const bf16x8 b0=*reinterpret_cast<const bf16x8*>(kb+d0*2048);
    const bf16x8 b1=*reinterpret_cast<const bf16x8*>(kb+d0*2048+512);
    if(d0==0){p0=__builtin_amdgcn_mfma_f32_32x32x16_bf16(b0,qr[0],negm,0,0,0);p1=__builtin_amdgcn_mfma_f32_32x32x16_bf16(b1,qr[0],negm,0,0,0);}
    else{p0=__builtin_amdgcn_mfma_f32_32x32x16_bf16(b0,qr[d0],p0,0,0,0);p1=__builtin_amdgcn_mfma_f32_32x32x16_bf16(b1,qr[d0],p1,0,0,0);}}
}
typedef __attribute__((address_space(3))) const char* lds_cptr;
typedef short v4i16_t __attribute__((ext_vector_type(4)));
__device__ __forceinline__ void kload8(bf16x8*kf,lds_cptr kp){
  kf[0]=*(const __attribute__((address_space(3))) bf16x8*)(kp);      kf[1]=*(const __attribute__((address_space(3))) bf16x8*)(kp+512);
  kf[2]=*(const __attribute__((address_space(3))) bf16x8*)(kp+2048); kf[3]=*(const __attribute__((address_space(3))) bf16x8*)(kp+2560);
  kf[4]=*(const __attribute__((address_space(3))) bf16x8*)(kp+4096); kf[5]=*(const __attribute__((address_space(3))) bf16x8*)(kp+4608);
  kf[6]=*(const __attribute__((address_space(3))) bf16x8*)(kp+6144); kf[7]=*(const __attribute__((address_space(3))) bf16x8*)(kp+6656);
}
__device__ __forceinline__ void kload2(bf16x8*kf,lds_cptr kp,int j){ kf[2*j]=*(const __attribute__((address_space(3))) bf16x8*)(kp+j*2048); kf[2*j+1]=*(const __attribute__((address_space(3))) bf16x8*)(kp+j*2048+512); }
__device__ __forceinline__ s16x4 vtr(lds_cptr p){ return __builtin_bit_cast(s16x4,__builtin_amdgcn_ds_read_tr16_b64_v4i16((__attribute__((address_space(3))) v4i16_t*)p)); }
__device__ __forceinline__ float rowmax(const f32x16&p0,const f32x16&p1){
  float a=max3f(p0[0],p0[1],p1[0]),b=max3f(p0[2],p0[3],p1[1]);a=max3f(a,p1[2],p1[3]);
  #pragma unroll
  for(int r=4;r<16;r+=4){a=max3f(a,p0[r],p0[r+1]);b=max3f(b,p0[r+2],p0[r+3]);a=max3f(a,p1[r],p1[r+1]);b=max3f(b,p1[r+2],p1[r+3]);}
  const float m=max2f(a,b);
  auto rr=__builtin_amdgcn_permlane32_swap(__float_as_uint(m),__float_as_uint(m),false,false);
  return max2f(__uint_as_float(rr[0]),__uint_as_float(rr[1]));
}
__device__ __forceinline__ void pv(f32x16*o,int vb,bf16x8 pa0,bf16x8 pa1,bf16x8 pa2,bf16x8 pa3){
  #pragma unroll
  for(int d0=0;d0<2;++d0){s16x4 lo[4],hi[4];
    #pragma unroll
    for(int ks=0;ks<4;++ks){
      asm volatile("ds_read_b64_tr_b16 %0,%1 offset:%c2":"=&v"(lo[ks]):"v"(vb),"i"(d0*4096+ks*1024):"memory");
      asm volatile("ds_read_b64_tr_b16 %0,%1 offset:%c2":"=&v"(hi[ks]):"v"(vb),"i"(d0*4096+ks*1024+512):"memory");}
    asm volatile("s_waitcnt lgkmcnt(0)":::"memory");SBAR();
    #define PK(k) (bf16x8){lo[k][0],lo[k][1],lo[k][2],lo[k][3],hi[k][0],hi[k][1],hi[k][2],hi[k][3]}
    o[d0]=__builtin_amdgcn_mfma_f32_32x32x16_bf16(pa0,PK(0),o[d0],0,0,0);
    o[d0]=__builtin_amdgcn_mfma_f32_32x32x16_bf16(pa1,PK(1),o[d0],0,0,0);
    o[d0]=__builtin_amdgcn_mfma_f32_32x32x16_bf16(pa2,PK(2),o[d0],0,0,0);
    o[d0]=__builtin_amdgcn_mfma_f32_32x32x16_bf16(pa3,PK(3),o[d0],0,0,0);
    #undef PK
  }
}

#ifndef ATTN_STORE16
#define ATTN_STORE16(p,v) (*(u32x4*)(p)=(v))
#endif
template<int THRL> __device__ __forceinline__ void attn_unit(int b,int h,int qb,const bf16*Q,const bf16*__restrict__ K,const bf16*__restrict__ V,bf16*O,char*shm,const int wv_){
  int tid_o=wv_*64+(int)__builtin_amdgcn_mbcnt_hi(~0u,__builtin_amdgcn_mbcnt_lo(~0u,0u)); asm volatile("":"+v"(tid_o)); tid_o&=511;
  const int tid=tid_o,lane=tid&63,r32=lane&31,hi=lane>>5; const int wid=__builtin_amdgcn_readfirstlane(tid>>6);
  const long rowbase=(long)b*SEQ; const int q0=qb*QB;
  const bf16*Qw=Q+(rowbase+q0+wid*QBLK)*DMI+(h>>1)*D;
  const bf16*Kh=K+rowbase*DMI+(h>>1)*D,*Vh=V+rowbase*DMI+(h>>2)*128+(h&1)*64;
  const unsigned lds0=(unsigned)(uintptr_t)shm;
  float*wsf=(float*)(shm+LDS_WS)+wid*64;
  const bf16*ksrc=Kh+(long)lane*DMI+wid*8;
  const bf16*vsrc=Vh+(long)(16*(wid&3)+(lane>>2))*DMI+(wid>>2)*32+(lane&3)*8;
  const unsigned kdst=lds0+LDS_K+wid*1024, vdst=lds0+LDS_V+wid*1024;
  #define DMA_K(t,slot) glds16(ksrc+(long)(t)*KVBLK*DMI,(unsigned)__builtin_amdgcn_readfirstlane(kdst+(slot)))
  #define DMA_V(t,slot) glds16(vsrc+(long)(t)*KVBLK*DMI,(unsigned)__builtin_amdgcn_readfirstlane(vdst+(slot)))
  const int vb0=(int)(lds0+LDS_V)+((lane>>4)&1)*32+(lane&3)*8+(4*hi+((lane&15)>>2))*64;
  const char*Kbase=shm+LDS_K; bf16x8 kf[8];
  const lds_cptr shm3=(lds_cptr)shm; const lds_cptr kp0=shm3+LDS_K+hi*1024+r32*16; const lds_cptr vp0=shm3+LDS_V+((lane>>4)&1)*32+(lane&3)*8+(4*hi+((lane&15)>>2))*64;
  const int NT=(q0+QB)/KVBLK;
  DMA_K(0,0);DMA_V(0,0);DMA_K(1,SLOTB);
  bf16x8 qr[4];
  #pragma unroll
  for(int d0=0;d0<4;++d0)qr[d0]=*reinterpret_cast<const bf16x8*>(&Qw[(long)r32*DMI+d0*16+hi*8]);
  float mhat=0.f,l_reg=0.f;f32x16 o[2];o[0]=f32x16{};o[1]=f32x16{};f32x16 negm=f32x16{};asm volatile("":"+v"(negm));
  const int qrel=wid*QBLK+r32;
  #define CMASK(P0,P1,t) do{int jb_=(t)-(NT-4); if(jb_>=0)cmask(P0,P1,jb_,qrel,hi);}while(0)
  bool resc=false;
  #define START(P0,P1) do{ const float rm=rowmax(P0,P1); resc=false; \
    { const float dl=rm; mhat=fadd_s(mhat,dl); \
      _Pragma("unroll") for(int r=0;r<16;++r){P0[r]=fsub_s(P0[r],dl);P1[r]=fsub_s(P1[r],dl);} \
      _Pragma("unroll") for(int r=0;r<16;++r)negm[r]=-mhat; asm volatile("":"+v"(negm)); } \
    _Pragma("unroll") for(int r=0;r<16;++r)P0[r]=__builtin_amdgcn_exp2f(P0[r]); }while(0)
  #define RESC() do{ if(resc){ asm volatile("s_waitcnt lgkmcnt(0)":::"memory"); \
      _Pragma("unroll") for(int d_=0;d_<2;++d_) _Pragma("unroll") for(int r=0;r<16;++r)o[d_][r]*=wsf[crow(r,hi)]; } }while(0)
  f32x16 pA0,pA1,pB0,pB1;
  int sl_prev=0,sl_cur=0,sl_next=SLOTB;
  #define ROT() do{sl_prev=sl_cur;sl_cur=sl_next;sl_next=(sl_next==(NSLOT-1)*SLOTB)?0:sl_next+SLOTB;}while(0)
  DMA_K(2,2*SLOTB);
  WAIT_BAR(3);
  qkt(pA0,pA1,Kbase,qr,negm,r32,hi);asm volatile("s_nop 15\n\ts_nop 7":"+v"(pA0),"+v"(pA1));CMASK(pA0,pA1,0);
  START(pA0,pA1);
  _Pragma("unroll") for(int r=0;r<16;++r)pA1[r]=__builtin_amdgcn_exp2f(pA1[r]);
  WAIT_BAR(0);
  DMA_K(3,0);DMA_V(1,SLOTB);
  ROT();
  kload8(kf,kp0+sl_cur);
  WAIT_BAR(2);
  s16x4 vlo[8],vhi[8]; u32x4 pw0,pw1,pw2,pw3;
  #define PKW(P,B) cvtpk_s(P[B],P[B+1])
  #define PAF(k) __builtin_bit_cast(bf16x8,pw##k)
  #define VFR(i) (bf16x8){vlo[i][0],vlo[i][1],vlo[i][2],vlo[i][3],vhi[i][0],vhi[i][1],vhi[i][2],vhi[i][3]}
  #define PIN(x) asm volatile("":"+v"(x))
  #define MX3(a,b,c) __builtin_fmaxf(__builtin_fmaxf((a),(b)),(c))
  #define GAPA(MF,A0,A1,A2,A3,W0,W1,PW) do{ MF; sacc+=A0; sacc+=A1; sacc+=A2; sacc+=A3; PIN(sacc); W0; W1; PIN(PW); SBAR(); }while(0)
  #define EX(v) __builtin_amdgcn_exp2f(v)
  #define GAPB(MF,X,B) do{ MF; X[B]=EX(X[B]); X[B+1]=EX(X[B+1]); X[B+2]=EX(X[B+2]); X[B+3]=EX(X[B+3]); PIN(X); SBAR(); }while(0)
  #define VRD(i) do{ vlo[i]=vtr(vp_+(((i)>>2)*4096+((i)&3)*1024)); vhi[i]=vtr(vp_+(((i)>>2)*4096+((i)&3)*1024+512)); }while(0)
  #define KRD(G,j) do{ if(G){ kload2(kf,kp0+sl_next,j); SBAR(); } }while(0)
  #define STEP(C0,C1,P0,P1,t,GK,GV,GL) do{ SBAR(); \
    const lds_cptr vp_=vp0+sl_prev; \
    VRD(0); SBAR(); float sacc=(P0[0]+P0[1]); \
    GAPA(C0=__builtin_amdgcn_mfma_f32_32x32x16_bf16(kf[0],qr[0],negm,0,0,0), P0[2],P0[3],P0[4],P0[5],     pw0[0]=PKW(P0,0), pw0[1]=PKW(P0,2), pw0); \
    VRD(4); SBAR(); GAPA(C1=__builtin_amdgcn_mfma_f32_32x32x16_bf16(kf[1],qr[0],negm,0,0,0), P0[6],P0[7],P0[8],P0[9],     pw0[2]=PKW(P0,4), pw0[3]=PKW(P0,6), pw0); \
    VRD(1); SBAR(); GAPA(C0=__builtin_amdgcn_mfma_f32_32x32x16_bf16(kf[2],qr[1],C0,0,0,0),   P0[10],P0[11],P0[12],P0[13], pw1[0]=PKW(P0,8), pw1[1]=PKW(P0,10), pw1); \
    VRD(5); SBAR(); GAPA(C1=__builtin_amdgcn_mfma_f32_32x32x16_bf16(kf[3],qr[1],C1,0,0,0),   P0[14],P0[15],P1[0],P1[1],   pw1[2]=PKW(P0,12),pw1[3]=PKW(P0,14), pw1); \
    VRD(2); SBAR(); GAPA(C0=__builtin_amdgcn_mfma_f32_32x32x16_bf16(kf[4],qr[2],C0,0,0,0),   P1[2],P1[3],P1[4],P1[5],     pw2[0]=PKW(P1,0), pw2[1]=PKW(P1,2), pw2); \
    VRD(6); SBAR(); GAPA(C1=__builtin_amdgcn_mfma_f32_32x32x16_bf16(kf[5],qr[2],C1,0,0,0),   P1[6],P1[7],P1[8],P1[9],     pw2[2]=PKW(P1,4), pw2[3]=PKW(P1,6), pw2); \
    VRD(3); SBAR(); GAPA(C0=__builtin_amdgcn_mfma_f32_32x32x16_bf16(kf[6],qr[3],C0,0,0,0),   P1[10],P1[11],P1[12],P1[13], pw3[0]=PKW(P1,8), pw3[1]=PKW(P1,10), pw3); \
    VRD(7); SBAR(); GAPA(C1=__builtin_amdgcn_mfma_f32_32x32x16_bf16(kf[7],qr[3],C1,0,0,0),   P1[14],P1[15],0.f,0.f,       pw3[2]=PKW(P1,12),pw3[3]=PKW(P1,14), pw3); \
    l_reg+=sacc; \
    if(GK){DMA_K((t)+3,sl_cur);} if(GV){DMA_V((t)+1,sl_next);} \
    CMASK(C0,C1,t); \
    { float a=MX3(C0[0],C0[1],C1[0]),b=MX3(C0[2],C0[3],C1[1]); a=MX3(a,C1[2],C1[3]); \
      _Pragma("unroll") for(int r=4;r<16;r+=4){a=MX3(a,C0[r],C0[r+1]);b=MX3(b,C0[r+2],C0[r+3]);a=MX3(a,C1[r],C1[r+1]);b=MX3(b,C1[r+2],C1[r+3]);} \
      float rm=__builtin_fmaxf(a,b); { auto rr=__builtin_amdgcn_permlane32_swap(__float_as_uint(rm),__float_as_uint(rm),false,false); rm=__builtin_fmaxf(__uint_as_float(rr[0]),__uint_as_float(rr[1])); } \
      resc=false; \
      if(__builtin_expect(__any(rm>(float)THRL),0)){ const float dl=__builtin_fmaxf(rm,0.f); mhat+=dl; \
        _Pragma("unroll") for(int r=0;r<16;++r){C0[r]-=dl;C1[r]-=dl;} \
        _Pragma("unroll") for(int r=0;r<16;++r)negm[r]=-mhat; asm volatile("":"+v"(negm)); \
        const float f=__builtin_amdgcn_exp2f(-dl); l_reg*=f; if(hi==0)wsf[r32]=f; resc=true; } } \
    SBAR(); \
    GAPB(o[0]=__builtin_amdgcn_mfma_f32_32x32x16_bf16(PAF(0),VFR(0),o[0],0,0,0), C0,0); \
    GAPB(o[1]=__builtin_amdgcn_mfma_f32_32x32x16_bf16(PAF(0),VFR(4),o[1],0,0,0), C0,4); \
    KRD(GL,0); GAPB(o[0]=__builtin_amdgcn_mfma_f32_32x32x16_bf16(PAF(1),VFR(1),o[0],0,0,0), C0,8); \
    KRD(GL,1); GAPB(o[1]=__builtin_amdgcn_mfma_f32_32x32x16_bf16(PAF(1),VFR(5),o[1],0,0,0), C0,12); \
    KRD(GL,2); GAPB(o[0]=__builtin_amdgcn_mfma_f32_32x32x16_bf16(PAF(2),VFR(2),o[0],0,0,0), C1,0); \
    KRD(GL,3); GAPB(o[1]=__builtin_amdgcn_mfma_f32_32x32x16_bf16(PAF(2),VFR(6),o[1],0,0,0), C1,4); \
    GAPB(o[0]=__builtin_amdgcn_mfma_f32_32x32x16_bf16(PAF(3),VFR(3),o[0],0,0,0), C1,8); \
    GAPB(o[1]=__builtin_amdgcn_mfma_f32_32x32x16_bf16(PAF(3),VFR(7),o[1],0,0,0), C1,12); \
    }while(0)
  int t=1;
  #undef CMASK
  #define CMASK(P0,P1,t) do{}while(0)
  for(;t+5<NT;t+=2){
    STEP(pB0,pB1,pA0,pA1,t,true,true,true);     WAIT_BAR(2); RESC(); ROT();
    STEP(pA0,pA1,pB0,pB1,t+1,true,true,true);   WAIT_BAR(2); RESC(); ROT();
  }
  #undef CMASK
  #define CMASK(P0,P1,t) do{int jb_=(t)-(NT-4); if(jb_>=0)cmask(P0,P1,jb_,qrel,hi);}while(0)
  #define ENDW(tt) do{ if((tt)+3<NT){WAIT_BAR(2);} else if((tt)+2<NT){WAIT_BAR(1);} else {WAIT_BAR(0);} }while(0)
  for(;t+1<NT;t+=2){
    STEP(pB0,pB1,pA0,pA1,t,(t+3<NT),(t+1<NT),(t+1<NT));       ENDW(t);   RESC(); ROT();
    STEP(pA0,pA1,pB0,pB1,t+1,(t+4<NT),(t+2<NT),(t+2<NT));     ENDW(t+1); RESC(); ROT();
  }
  STEP(pB0,pB1,pA0,pA1,NT-1,false,false,false); RESC();
  { float sacc=pB0[0]+pB0[1]; _Pragma("unroll") for(int r=2;r<16;++r)sacc+=pB0[r]; _Pragma("unroll") for(int r=0;r<16;++r)sacc+=pB1[r]; l_reg+=sacc;
    pw0=(u32x4){PKW(pB0,0),PKW(pB0,2),PKW(pB0,4),PKW(pB0,6)};pw1=(u32x4){PKW(pB0,8),PKW(pB0,10),PKW(pB0,12),PKW(pB0,14)};pw2=(u32x4){PKW(pB1,0),PKW(pB1,2),PKW(pB1,4),PKW(pB1,6)};pw3=(u32x4){PKW(pB1,8),PKW(pB1,10),PKW(pB1,12),PKW(pB1,14)};
    SBAR(); pv(o,vb0+sl_cur,PAF(0),PAF(1),PAF(2),PAF(3)); }
  #undef PKW
  #undef PAF
  #undef VFR
  #undef PIN
  #undef MX3
  #undef GAPA
  #undef GAPB
  #undef EX
  #undef VRD
  #undef KRD
  #undef STEP
  #undef ENDW
  {auto rr=__builtin_amdgcn_permlane32_swap(__float_as_uint(l_reg),__float_as_uint(l_reg),false,false);l_reg=__uint_as_float(rr[0])+__uint_as_float(rr[1]);}
  if(hi==0)wsf[32+r32]=l_reg;asm volatile("s_waitcnt lgkmcnt(0)":::"memory");
  float rli[16];
  #pragma unroll
  for(int r=0;r<16;++r)rli[r]=__builtin_amdgcn_rcpf(wsf[32+crow(r,hi)]);
  bf16*Ow=O+(rowbase+q0+wid*QBLK)*DMO+h*D;
  { bf16*stg=(bf16*)(shm+LDS_OST)+wid*2048;
    #pragma unroll
    for(int r=0;r<16;++r){const int orow=crow(r,hi);
      #pragma unroll
      for(int d0=0;d0<2;++d0)stg[orow*64+d0*32+r32]=__float2bfloat16(o[d0][r]*rli[r]);}
    asm volatile("s_waitcnt lgkmcnt(0)":::"memory");
    #pragma unroll
    for(int i=0;i<4;++i){const int row=i*8+(lane>>3),ch=lane&7; const u32x4 v=*(const u32x4*)(stg+row*64+ch*8); ATTN_STORE16(Ow+(long)row*DMO+ch*8,v);} }
  asm volatile("s_waitcnt lgkmcnt(0)\n\ts_barrier":::"memory");
  #undef DMA_K
  #undef DMA_V
  #undef CMASK
  #undef START
  #undef RESC
  #undef ROT
}
constexpr int ATTN_LDS_BYTES=LDS_BYTES;
struct AttnTensors { const bf16* Q; const bf16* K; const bf16* V; bf16* O; };
struct AttnUnit { int bh; int qb; };
struct StaticOrder {
  int vcu;
  __device__ __forceinline__ explicit StaticOrder(int grid,int block):vcu((block%8)*(grid/8)+block/8){}
  __device__ __forceinline__ bool next(int i,AttnUnit&u)const{ if(i>=4)return false; const int s=vcu&7; u.bh=vcu>>3; u.qb=(i==0)?s:(i==1)?15-s:(i==2)?16+s:31-s; return true; }
  __device__ __forceinline__ void a_ready(const AttnUnit&)const{}
  __device__ __forceinline__ void done(const AttnUnit&)const{}
};
template<class Sched,int THRL=8> __device__ __forceinline__ void attn_phase(char*lds,const AttnTensors&T,const Sched&S){
  AttnUnit u;
  for(int i=0;S.next(i,u);++i){ S.a_ready(u); attn_unit<THRL>(u.bh/NHEAD,u.bh%NHEAD,u.qb,T.Q,T.K,T.V,T.O,lds); S.done(u); }
}
#undef SBAR
#undef WAIT_BAR
}

#define LAS __attribute__((address_space(3)))
typedef unsigned short bfu;
typedef unsigned v4u __attribute__((ext_vector_type(4)));
typedef unsigned v2u __attribute__((ext_vector_type(2)));
typedef float f32x4 __attribute__((ext_vector_type(4)));
typedef float f32x8 __attribute__((ext_vector_type(8)));
typedef float f32x16 __attribute__((ext_vector_type(16)));
typedef float f32x2 __attribute__((ext_vector_type(2)));

constexpr int NWAVES = 8, NTHR = 512;
constexpr int MP = 65536, MS = 128, MR = MP + MS, MPAD = 65792;
constexpr int NIN = 3840, FFD = 4096;
constexpr int NPHASE = 24;
#ifndef MK_ONE_LAUNCH
#define MK_ONE_LAUNCH 1
#endif

constexpr size_t O_Y = 0;
constexpr size_t O_YS = (size_t)MP * 1024;
constexpr size_t O_ACP = O_YS + 128 * 1024;
constexpr size_t O_ADP = O_ACP + 2 * 8 * 3 * 768;
constexpr size_t O_BKP = O_ADP + 2 * 8 * 4 * 64 * 64;
constexpr size_t O_BVP = O_BKP + (size_t)2 * 8 * 8192 * 512;
constexpr size_t O_CSP = O_BVP + (size_t)2 * 8 * 8192 * 512;
constexpr size_t O_CWP = O_CSP + 2 * 8 * 1024;
constexpr size_t O_ACS = O_CWP + 2 * 8 * 4 * 64 * 64;
constexpr size_t O_ADS = O_ACS + 2 * 8 * 3 * 768;
constexpr size_t O_BKS = O_ADS + 2 * 8 * 4 * 64 * 64;
constexpr size_t O_BVS = O_BKS + 2 * 8 * 16 * 512;
constexpr size_t O_CSS = O_BVS + 2 * 8 * 16 * 512;
constexpr size_t O_CWS = O_CSS + 2 * 8 * 1024;
constexpr size_t O_END = O_CWS + 2 * 8 * 4 * 64 * 64;
static_assert(O_END == 202874880, "output size");

constexpr size_t MiB = 1u << 20;
constexpr size_t WS_CTL = 0;
constexpr size_t WS_RS = 64 * 1024;
constexpr size_t WS_BONUS = 2 * MiB;
constexpr size_t WS_GAB = 3 * MiB + 512 * 1024;
constexpr size_t WS_AB = 6 * MiB;
constexpr size_t WS_ROPE = 8 * MiB + 512 * 1024;
constexpr size_t WS_GCH = 10 * MiB + 512 * 1024;
constexpr size_t WS_W = 12 * MiB;
constexpr size_t W_IN = 0, W_OUT = W_IN + (size_t)NIN * 1024 * 2, W_FF1 = W_OUT + 1024 * 1024 * 2, W_FF2 = W_FF1 + 4096 * 1024 * 2,
                 W_GATE = W_FF2 + 4096 * 1024 * 2, W_PP = W_GATE + 1024 * 1024 * 2, W_LR = W_PP + 1024 * 256 * 2, W_END = W_LR + 768 * 256 * 2;
constexpr size_t WS_SLOT = 41 * MiB;
constexpr size_t USLOT = (size_t)MPAD * 1024;
static_assert(WS_W + W_END <= WS_SLOT, "weights");
constexpr size_t WS_PAIRC = WS_SLOT + 15 * USLOT;
constexpr size_t WS_PAIRD = WS_PAIRC + 4 * (size_t)(MPAD / 2) * 16;
constexpr size_t WS_TOTAL = WS_PAIRD + 4 * (size_t)(MPAD / 2) * 8;
static_assert(WS_TOTAL <= (size_t)1024 * MiB, "ws");
static_assert(WS_RS + 7 * (size_t)MPAD * 4 <= WS_BONUS && WS_BONUS + 4 * (size_t)MPAD * 4 <= WS_GAB && WS_GAB + 8 * (size_t)MPAD * 4 <= WS_AB && WS_AB + 8 * (size_t)MPAD * 4 <= WS_ROPE && WS_ROPE + 8192 * 64 * 4 <= WS_GCH && WS_GCH + 4 * 1032 * 64 * 4 <= WS_W, "ctl map");

__device__ __forceinline__ unsigned char* slotp(unsigned char* ws, int l, int s) {
    if (l & 1) { if (s < 2) s += 13; else if (s >= 13) s -= 13; }
    return ws + WS_SLOT + (size_t)s * USLOT;
}
__device__ __forceinline__ unsigned char* slotph(unsigned char* ws, int l, int s) { return slotp(ws, l, s) + USLOT / 2; }

constexpr int RING_BYTES = 131072, MISC_OFF = RING_BYTES + 320, LDS_BYTES = 147456;

#define LDS_WAIT() asm volatile("s_waitcnt lgkmcnt(0)" ::: "memory")
__device__ __forceinline__ float bf2f(unsigned short u) { return __uint_as_float(((unsigned)u) << 16); }
__device__ __forceinline__ unsigned f2bf(float f) { unsigned u = __builtin_bit_cast(unsigned, f); return (u + 0x7fffu + ((u >> 16) & 1u)) >> 16; }
__device__ __forceinline__ unsigned pk2(float lo, float hi) { return f2bf(lo) | (f2bf(hi) << 16); }
#define DPP_ROR_ADD(v, ctrl) ((v) + __builtin_bit_cast(float, __builtin_amdgcn_update_dpp(0, __builtin_bit_cast(int, (v)), (ctrl), 0xf, 0xf, false)))
__device__ __forceinline__ float wave_sum(float v) {
    v = DPP_ROR_ADD(v, 0x128); v = DPP_ROR_ADD(v, 0x124); v = DPP_ROR_ADD(v, 0x122); v = DPP_ROR_ADD(v, 0x121);
    v += __shfl_xor(v, 16);
    const unsigned u = __float_as_uint(v); auto rr = __builtin_amdgcn_permlane32_swap(u, u, false, false);
    return __uint_as_float(rr[0]) + __uint_as_float(rr[1]);
}
__device__ __forceinline__ float sigm(float x) { return 1.f / (1.f + __expf(-x)); }
__device__ __forceinline__ float softplusf(float x) { return x > 20.f ? x : log1pf(__expf(x)); }

struct Args { const float* in[40]; float* out; unsigned char* ws; int ph_lo, ph_hi; };
typedef const __attribute__((address_space(4))) Args* KArgs;

constexpr float ATT_C2 = 0.125f * 1.4426950408889634f;
struct EpiG1 {
    static constexpr bool PERM = false, AFTER_DRAIN = false;
    const float* rs; bfu *aqkvz, *qb, *kb, *vb, *craw; float* ab; const float* rope; float *okp, *ovp, *oks, *ovs;
    __device__ __forceinline__ void operator()(const pg8::f32x4 (&acc)[2][2][4][2], const pg8::Unit& u, int wr, int wc, int fr, int fq) const {
        const int pn = u.pn; const int rowb = u.pm * 256 + wr * 64 + fr; const int cl = wc * 32 + 4 * fq;
#pragma unroll
        for (int ai = 0; ai < 2; ++ai)
#pragma unroll
            for (int m = 0; m < 4; ++m) {
                const int row = rowb + ai * 128 + m * 16;
                const float s = rsqrtf(rs[row] * (1.f / 1024.f) + 1e-6f);
                if (pn < 4 || (pn >= 10 && pn < 14)) {
                    bfu* dst = (pn < 4 ? aqkvz + pn * 256 : craw + (pn - 10) * 256) + (size_t)row * 1024 + cl;
#pragma unroll
                    for (int bj = 0; bj < 2; ++bj)
#pragma unroll
                        for (int n = 0; n < 2; ++n) { const pg8::f32x4 v = acc[ai][bj][m][n] * s; v2u w; w.x = pg8::cvt_pk_bf16(v[0], v[1]); w.y = pg8::cvt_pk_bf16(v[2], v[3]); *(v2u*)(dst + bj * 128 + n * 16) = w; }
                } else if (pn < 8) {
                    const bool isk = pn >= 6;
                    const int pos = row < MP ? (row & 8191) : 2048 + ((row - MP) & 15);
                    const int i0 = (wc & 1) * 16 + 4 * fq;
                    const pg8::f32x4 c4 = *(const pg8::f32x4*)(rope + pos * 64 + i0), s4 = *(const pg8::f32x4*)(rope + pos * 64 + 32 + i0);
#pragma unroll
                    for (int bj = 0; bj < 2; ++bj) {
                        const pg8::f32x4 x1 = acc[ai][bj][m][0] * s, x2 = acc[ai][bj][m][1] * s;
                        pg8::f32x4 o1 = x1 * c4 - x2 * s4, o2 = x2 * c4 + x1 * s4;
                        if (!isk) {
                            o1 = o1 * ATT_C2; o2 = o2 * ATT_C2;
                            bfu* d = qb + (size_t)row * 512 + (pn - 4) * 256 + bj * 128 + cl;
                            v2u w; w.x = pg8::cvt_pk_bf16(o1[0], o1[1]); w.y = pg8::cvt_pk_bf16(o1[2], o1[3]); *(v2u*)d = w;
                            w.x = pg8::cvt_pk_bf16(o2[0], o2[1]); w.y = pg8::cvt_pk_bf16(o2[2], o2[3]); *(v2u*)(d + 16) = w;
                        } else {
                            bfu* d = kb + (size_t)row * 512 + (pn - 6) * 256 + bj * 128 + cl;
                            v2u w; w.x = pg8::cvt_pk_bf16(o1[0], o1[1]); w.y = pg8::cvt_pk_bf16(o1[2], o1[3]); *(v2u*)d = w;
                            w.x = pg8::cvt_pk_bf16(o2[0], o2[1]); w.y = pg8::cvt_pk_bf16(o2[2], o2[3]); *(v2u*)(d + 16) = w;
                            if (row < MR) {
                                float* ob = (row < MP ? okp + (size_t)row * 512 : oks + (size_t)(row - MP) * 512) + (pn - 6) * 256 + bj * 128 + (wc >> 1) * 64 + (wc & 1) * 16 + 4 * fq;
                                *(pg8::f32x4*)ob = o1; *(pg8::f32x4*)(ob + 32) = o2;
                            }
                        }
                    }
                } else if (pn < 10) {
#pragma unroll
                    for (int bj = 0; bj < 2; ++bj)
#pragma unroll
                        for (int n = 0; n < 2; ++n) {
                            const pg8::f32x4 v = acc[ai][bj][m][n] * s; const int col = (pn - 8) * 256 + bj * 128 + cl + n * 16;
                            v2u w; w.x = pg8::cvt_pk_bf16(v[0], v[1]); w.y = pg8::cvt_pk_bf16(v[2], v[3]); *(v2u*)(vb + (size_t)row * 512 + col) = w;
                            if (row < MR) { float* ob = (row < MP ? ovp + (size_t)row * 512 : ovs + (size_t)(row - MP) * 512) + col; *(pg8::f32x4*)ob = v; }
                        }
                } else {
                    if (wc == 0 && fq < 2) { const pg8::f32x4 v = acc[ai][0][m][0] * s; *(pg8::f32x4*)(ab + (size_t)row * 8 + 4 * fq) = v; }
                }
            }
    }
};
template <int MODE> struct EpiB {
    static constexpr bool PERM = false, AFTER_DRAIN = false;
    bfu* O; int ldc; const float* rs;
    __device__ __forceinline__ void operator()(const pg8::f32x4 (&acc)[2][2][4][2], const pg8::Unit& u, int wr, int wc, int fr, int fq) const {
        const int rowb = u.pm * 256 + wr * 64 + fr; const int cl = u.pn * 256 + wc * 32 + 4 * fq;
#pragma unroll
        for (int ai = 0; ai < 2; ++ai)
#pragma unroll
            for (int m = 0; m < 4; ++m) {
                const int row = rowb + ai * 128 + m * 16;
                float s = 1.f; if (MODE == 1) s = rsqrtf(rs[row] * (1.f / 1024.f) + 1e-6f);
                bfu* dst = O + (size_t)row * ldc + cl;
#pragma unroll
                for (int bj = 0; bj < 2; ++bj)
#pragma unroll
                    for (int n = 0; n < 2; ++n) {
                        pg8::f32x4 v = acc[ai][bj][m][n];
                        if (MODE == 1) { v = v * s; v[0] = fmaxf(v[0], 0.f); v[1] = fmaxf(v[1], 0.f); v[2] = fmaxf(v[2], 0.f); v[3] = fmaxf(v[3], 0.f); v = v * v; }
                        v2u w; w.x = pg8::cvt_pk_bf16(v[0], v[1]); w.y = pg8::cvt_pk_bf16(v[2], v[3]); *(v2u*)(dst + bj * 128 + n * 16) = w;
                    }
            }
    }
};
template <int MODE> struct EpiH {
    static constexpr bool PERM = false, AFTER_DRAIN = false;
    float* H; bfu* xh; float* rsn; const float* rs; const bfu* pp;
    __device__ __forceinline__ void operator()(const pg8::f32x4 (&acc)[2][2][4][2], const pg8::Unit& u, int wr, int wc, int fr, int fq) const {
        const int rowb = u.pm * 256 + wr * 64 + fr; const int cl = u.pn * 256 + wc * 32 + 4 * fq;
#pragma unroll
        for (int ai = 0; ai < 2; ++ai)
#pragma unroll
            for (int m = 0; m < 4; ++m) {
                const int row = rowb + ai * 128 + m * 16; const bool valid = row < MR; float ss = 0.f;
                if (valid) {
                    float s = 1.f; if (MODE == 3) s = rsqrtf(rs[row] * (1.f / 1024.f) + 1e-6f);
#pragma unroll
                    for (int bj = 0; bj < 2; ++bj)
#pragma unroll
                        for (int n = 0; n < 2; ++n) {
                            const size_t off = (size_t)row * 1024 + cl + bj * 128 + n * 16;
                            pg8::f32x4 h = *(const pg8::f32x4*)(H + off); const pg8::f32x4 a = acc[ai][bj][m][n];
                            if (MODE == 3) { const v2u pw = *(const v2u*)(pp + off);
                                h[0] += sigm(a[0] * s) * __uint_as_float(pw.x << 16); h[1] += sigm(a[1] * s) * __uint_as_float(pw.x & 0xffff0000u);
                                h[2] += sigm(a[2] * s) * __uint_as_float(pw.y << 16); h[3] += sigm(a[3] * s) * __uint_as_float(pw.y & 0xffff0000u);
                            } else h = h + a;
                            *(pg8::f32x4*)(H + off) = h;
                            v2u w; w.x = pg8::cvt_pk_bf16(h[0], h[1]); w.y = pg8::cvt_pk_bf16(h[2], h[3]); *(v2u*)(xh + off) = w;
                            ss += (h[0] * h[0] + h[1] * h[1]) + (h[2] * h[2] + h[3] * h[3]);
                        }
                }
                ss += __shfl_xor(ss, 16); ss += __shfl_xor(ss, 32);
                if (valid && fq == 0) unsafeAtomicAdd(rsn + row, ss);
            }
    }
};

__device__ __forceinline__ int win_src(int nd) {
    if (nd < 1024) return nd;
    if (nd < 2048) { const int c = nd - 1024, p = c & 63, grp = c >> 6; const int s = p >> 5, n_ = (p >> 4) & 1, r = p & 15; return 1032 + grp * 64 + n_ * 32 + s * 16 + r; }
    if (nd < 2560) return 2056 + (nd - 2048);
    if (nd < 3584) return 2568 + (nd - 2560);
    if (nd < 3592) return 1024 + (nd - 3584);
    return -1;
}
template <bool MAP> __device__ __forceinline__ void wt_item(const float* W, int K, int Nsrc, bfu* WT, const float* gain, LAS float* scr, int item, int nblk, int lane) {
    const int kb = item / nblk, nb = item % nblk, k0 = 64 * kb, n0 = 32 * nb;
    const int nd = n0 + (lane & 31); const int src = MAP ? win_src(nd) : nd;
#pragma unroll 8
    for (int i = 0; i < 32; ++i) { const int kk = 2 * i + (lane >> 5); float v = src >= 0 ? W[(size_t)(k0 + kk) * Nsrc + src] : 0.f; if (gain) v *= gain[k0 + kk]; scr[kk * 33 + (lane & 31)] = v; }
    LDS_WAIT(); asm volatile("" ::: "memory");
    const int c = lane & 7;
#pragma unroll
    for (int j = 0; j < 4; ++j) { const int n = (lane >> 3) + 8 * j; const LAS float* s = scr + (8 * c) * 33 + n;
        v4u o; o.x = pk2(s[0 * 33], s[1 * 33]); o.y = pk2(s[2 * 33], s[3 * 33]); o.z = pk2(s[4 * 33], s[5 * 33]); o.w = pk2(s[6 * 33], s[7 * 33]);
        *(v4u*)(WT + (size_t)(n0 + n) * K + k0 + 8 * c) = o; }
    LDS_WAIT(); asm volatile("" ::: "memory");
}
__device__ __forceinline__ void conv_weights(KArgs A, int l, int mask, LAS unsigned char* lds, int gw, int NGW, int lane, int wave) {
    LAS float* scr = (LAS float*)(lds + wave * 16384);
    unsigned char* wb = A->ws + WS_W;
    if (mask & 1) {
        const float* win = A->in[11] + (size_t)l * 1024 * 3592; const float* g = A->in[10] + l * 1024;
        for (int it = gw; it < 16 * 120; it += NGW) wt_item<true>(win, 1024, 3592, (bfu*)(wb + W_IN), g, scr, it, 120, lane);
        const float* wu = A->in[23] + (size_t)l * 64 * 256; const float* au = A->in[25] + (size_t)l * 64 * 256; const float* gu = A->in[26] + (size_t)l * 128 * 256;
        bfu* lr = (bfu*)(wb + W_LR);
        for (int i = gw * 64 + lane; i < 768 * 256; i += NGW * 64) { const int n = i >> 8, k = i & 255; float v = 0.f;
            if (n < 256) { if (k < 64) v = wu[k * 256 + n]; } else if (n < 512) { if (k >= 64 && k < 128) v = au[(k - 64) * 256 + (n - 256)]; } else { if (k >= 128) v = gu[(k - 128) * 256 + (n - 512)]; }
            lr[i] = (bfu)f2bf(v); }
    }
    if (mask & 2) {
        const float* wo = A->in[32] + (size_t)l * 1024 * 1024; const float* f1 = A->in[34] + (size_t)l * 1024 * 4096; const float* f2 = A->in[35] + (size_t)l * 4096 * 1024;
        const float* wg = A->in[37] + (size_t)l * 1024 * 1024; const float* wp = A->in[38] + (size_t)l * 256 * 1024;
        const float* gf = A->in[33] + l * 1024; const float* gp = A->in[36] + l * 1024;
        constexpr int I_O = 16 * 32, I_1 = 16 * 128, I_2 = 64 * 32, I_G = 16 * 32, I_P = 4 * 32;
        for (int it = gw; it < I_O + I_1 + I_2 + I_G + I_P; it += NGW) {
            int r = it;
            if (r < I_O) { wt_item<false>(wo, 1024, 1024, (bfu*)(wb + W_OUT), nullptr, scr, r, 32, lane); continue; } r -= I_O;
            if (r < I_1) { wt_item<false>(f1, 1024, 4096, (bfu*)(wb + W_FF1), gf, scr, r, 128, lane); continue; } r -= I_1;
            if (r < I_2) { wt_item<false>(f2, 4096, 1024, (bfu*)(wb + W_FF2), nullptr, scr, r, 32, lane); continue; } r -= I_2;
            if (r < I_G) { wt_item<false>(wg, 1024, 1024, (bfu*)(wb + W_GATE), gp, scr, r, 32, lane); continue; } r -= I_G;
            wt_item<false>(wp, 256, 1024, (bfu*)(wb + W_PP), nullptr, scr, r, 32, lane);
        }
    }
}
__device__ __forceinline__ void conv_p(KArgs A, int l, bfu* pb, int gtid, int NT) {
    const float* pp = A->in[8] + (size_t)l * MP * 256; const float* ps = A->in[9] + (size_t)l * MS * 256;
    for (int i = gtid; i < MR * 64; i += NT) { const int m = i >> 6, c = (i & 63) * 4;
        const f32x4 v = *(const f32x4*)(m < MP ? pp + (size_t)m * 256 + c : ps + (size_t)(m - MP) * 256 + c);
        v2u w; w.x = pk2(v[0], v[1]); w.y = pk2(v[2], v[3]); *(v2u*)(pb + (size_t)m * 256 + c) = w; }
}
__device__ __forceinline__ void prologue(KArgs A, LAS unsigned char* lds, int gw, int NGW, int lane, int wave, int gtid, int NT) {
    conv_weights(A, 0, 3, lds, gw, NGW, lane, wave);
    unsigned char* ws = A->ws;
    float* rs = (float*)(ws + WS_RS); bfu* xh = (bfu*)slotp(ws, 0, 0); float* H = A->out;
    for (int i = gtid; i < 6 * MPAD; i += NT) rs[MPAD + i] = 0.f;
    for (int m = gw; m < MPAD; m += NGW) {
        if (m < MR) {
            const float* xr = m < MP ? A->in[0] + (size_t)m * 1024 : A->in[1] + (size_t)(m - MP) * 1024; float ss = 0.f;
#pragma unroll
            for (int j = 0; j < 4; ++j) { const f32x4 v = *(const f32x4*)(xr + j * 256 + lane * 4); *(f32x4*)(H + (size_t)m * 1024 + j * 256 + lane * 4) = v;
                v2u w; w.x = pk2(v[0], v[1]); w.y = pk2(v[2], v[3]); *(v2u*)(xh + (size_t)m * 1024 + j * 256 + lane * 4) = w; ss += (v[0] * v[0] + v[1] * v[1]) + (v[2] * v[2] + v[3] * v[3]); }
            ss = wave_sum(ss); if (lane == 0) rs[m] = ss;
        } else {
#pragma unroll
            for (int j = 0; j < 4; ++j) *(v2u*)(xh + (size_t)m * 1024 + j * 256 + lane * 4) = (v2u){0u, 0u};
            if (lane == 0) rs[m] = 1024.f;
        }
    }
    float* rope = (float*)(ws + WS_ROPE);
    for (int i = gtid; i < 8192 * 32; i += NT) { const int pos = i >> 5, k = i & 31;
        const float inv = exp2f(-(float)k * (13.287712379549449f / 32.0f)); const float ang = (float)pos * inv;
        const float nn = rintf(ang * 0.15915494309189535f); const float fr = fmaf(-nn, 1.9353071795864769e-3f, fmaf(-nn, 6.28125f, ang));
        rope[pos * 64 + k] = __cosf(fr); rope[pos * 64 + 32 + k] = __sinf(fr); }
    if (gw == 0) {
        for (int l = 0; l < 2; ++l) {
            const float a = wave_sum(A->in[16][l * 64 + lane] * A->in[17][l * 64 + lane]), b = wave_sum(A->in[18][l * 64 + lane] * A->in[19][l * 64 + lane]);
            const float li = 0.8f - 0.6f * expf(-0.3f * (float)l);
            if (lane == 0) { float* lf = (float*)(ws + WS_CTL + 1024); lf[2 * l] = expf(a) - expf(b) + li; lf[2 * l + 1] = li; }
        }
    }
}

__device__ __forceinline__ void prep_a(KArgs A, int l, int gw, int NGW, int lane) {
    unsigned char* ws = A->ws;
    const bfu* aq = (const bfu*)slotp(ws, l, 2); const float* ab = (const float*)(ws + WS_AB);
    float* sia = (float*)slotp(ws, l, 9); bfu* va = (bfu*)slotp(ws, l, 11); bfu* zs = (bfu*)slotph(ws, l, 11); float* gab = (float*)(ws + WS_GAB);
    const float* cw = A->in[12] + l * 4 * 768; const float* stc = A->in[4] + (size_t)l * 8 * 3 * 768;
    const float* anorm = A->in[15] + l * 64;
    for (int m = gw; m < MR; m += NGW) {
        int t, L, sb = 0; const bool smp = m >= MP; float* aco;
        if (!smp) { t = m & 8191; L = 8192; aco = A->out + O_ACP + ((size_t)(l * 8 + (m >> 13)) * 3) * 768; }
        else { sb = (m - MP) >> 4; t = (m - MP) & 15; L = 16; aco = A->out + O_ACS + ((size_t)(l * 8 + sb) * 3) * 768; }
#pragma unroll 1
        for (int h = 0; h < 4; ++h) {
            float val[3];
#pragma unroll
            for (int g = 0; g < 3; ++g) {
                const int c = g * 256 + h * 64 + lane; float x[4];
#pragma unroll
                for (int d = 0; d < 4; ++d) { const int tt = t - d;
                    x[d] = tt >= 0 ? bf2f(aq[(size_t)(m - d) * 1024 + c]) : (smp ? stc[((size_t)sb * 3 + (3 + tt)) * 768 + c] : 0.f); }
                const float y = x[3] * cw[c] + x[2] * cw[768 + c] + x[1] * cw[1536 + c] + x[0] * cw[2304 + c];
                val[g] = y * sigm(y);
                if (t >= L - 3) aco[(size_t)(t - (L - 3)) * 768 + c] = x[0];
            }
            const float sq = wave_sum(val[0] * val[0]), sk = wave_sum(val[1] * val[1]);
            const float qn = val[0] * rsqrtf(sq + 1e-6f) * 0.125f, kn = val[1] * rsqrtf(sk + 1e-6f);
            float* rec = sia + ((size_t)(h * 8 + (lane >> 3)) * MPAD + m) * 16 + (lane & 7);
            rec[0] = kn; rec[8] = qn;
            va[(size_t)m * 256 + h * 64 + lane] = (bfu)f2bf(val[2]);
            const float z = bf2f(aq[(size_t)m * 1024 + 768 + h * 64 + lane]);
            zs[(size_t)m * 256 + h * 64 + lane] = (bfu)f2bf(z * sigm(z) * anorm[lane]);
        }
        if (lane < 4) { const int h = lane;
            const float g = -__expf(A->in[13][l * 4 + h]) * softplusf(ab[(size_t)m * 8 + h] + A->in[14][l * 4 + h]);
            gab[((size_t)h * MPAD + m) * 2] = __expf(g); gab[((size_t)h * MPAD + m) * 2 + 1] = sigm(ab[(size_t)m * 8 + 4 + h]); }
    }
}
__device__ __forceinline__ void prep_c1(KArgs A, int l, int gw, int NGW, int lane) {
    unsigned char* ws = A->ws;
    const bfu* cr = (const bfu*)slotp(ws, l, 7); bfu* lra = (bfu*)slotp(ws, l, 12);
    const float* mu = A->in[21] + l * 1024; const float* sts = A->in[6] + (size_t)l * 8 * 1024;
    for (int m = gw; m < MR; m += NGW) {
        int t, L, sb = 0; const bool smp = m >= MP; float* cso;
        if (!smp) { t = m & 8191; L = 8192; cso = A->out + O_CSP + (size_t)(l * 8 + (m >> 13)) * 1024; }
        else { sb = (m - MP) >> 4; t = (m - MP) & 15; L = 16; cso = A->out + O_CSS + (size_t)(l * 8 + sb) * 1024; }
#pragma unroll
        for (int i = 0; i < 4; ++i) { const int j = 768 + lane + 64 * i;
            const float cur = bf2f(cr[(size_t)m * 1024 + j]);
            const float prev = t > 0 ? bf2f(cr[(size_t)(m - 1) * 1024 + j]) : (smp ? sts[(size_t)sb * 1024 + j] : 0.f);
            const float c = cur + (prev - cur) * mu[j];
            const float o = i == 0 ? tanhf(c) : (i == 1 ? c : sigm(c));
            lra[(size_t)m * 256 + lane + 64 * i] = (bfu)f2bf(o); }
        if (t == L - 1) {
#pragma unroll
            for (int i = 0; i < 16; ++i) cso[lane + 64 * i] = bf2f(cr[(size_t)m * 1024 + lane + 64 * i]);
        }
    }
}
__device__ __forceinline__ void prep_c2(KArgs A, int l, int bid, int G, int tid) {
    unsigned char* ws = A->ws;
    const bfu* cr = (const bfu*)slotp(ws, l, 7); const bfu* lro = (const bfu*)slotp(ws, l, 13);
    bfu* v2 = (bfu*)slotp(ws, l, 12); bfu* gg = (bfu*)slotph(ws, l, 12);
    float* bonus = (float*)(ws + WS_BONUS); float* gch = (float*)(ws + WS_GCH); float* pairc = (float*)(ws + WS_PAIRC);
    const float* mu = A->in[21] + l * 1024; const float* sts = A->in[6] + (size_t)l * 8 * 1024;
    const int ch = tid & 255, h = ch >> 6, lane = ch & 63, half = tid >> 8;
    float* sic = (float*)slotp(ws, l, h) + ((size_t)(lane >> 3) * MPAD) * 32 + (lane & 7);
    const float mur = mu[ch], muk = mu[256 + ch], muv = mu[512 + ch];
    const float w0 = A->in[22][l * 256 + ch], a0 = A->in[24][l * 256 + ch], kk_ = A->in[27][l * 256 + ch], ka = A->in[28][l * 256 + ch], rk = A->in[29][l * 256 + ch];
    for (int u = bid * 2 + half; u < 1032; u += G * 2) {
        int m0, n; float pr, pk, pv;
        if (u < 1024) { m0 = u * 64; n = 64;
            if ((u & 127) == 0) { pr = pk = pv = 0.f; } else { pr = bf2f(cr[(size_t)(m0 - 1) * 1024 + ch]); pk = bf2f(cr[(size_t)(m0 - 1) * 1024 + 256 + ch]); pv = bf2f(cr[(size_t)(m0 - 1) * 1024 + 512 + ch]); } }
        else { const int sb = u - 1024; m0 = MP + sb * 16; n = 16; pr = sts[(size_t)sb * 1024 + ch]; pk = sts[(size_t)sb * 1024 + 256 + ch]; pv = sts[(size_t)sb * 1024 + 512 + ch]; }
        float cum = 0.f, pkka = 0.f, pkp = 0.f;
#pragma unroll 4
        for (int tt = 0; tt < n; ++tt) { const int m = m0 + tt;
            const float c_r = bf2f(cr[(size_t)m * 1024 + ch]), c_k = bf2f(cr[(size_t)m * 1024 + 256 + ch]), c_v = bf2f(cr[(size_t)m * 1024 + 512 + ch]);
            const float r = c_r + (pr - c_r) * mur, k = c_k + (pk - c_k) * muk, v = c_v + (pv - c_v) * muv; pr = c_r; pk = c_k; pv = c_v;
            const float lw = bf2f(lro[(size_t)m * 768 + ch]), la = bf2f(lro[(size_t)m * 768 + 256 + ch]); const bfu gb = lro[(size_t)m * 768 + 512 + ch];
            const float wl = -0.6065306597126334f * sigm(w0 + lw); const float a = sigm(a0 + la);
            const float kkr = k * kk_; const float kk = kkr * rsqrtf(wave_sum(kkr * kkr) + 1e-6f);
            const float kp = k * (1.f + (a - 1.f) * ka);
            const float Gp = __expf(cum); cum += wl; const float Gc = __expf(cum), iG = __expf(-cum);
            float* rec = sic + (size_t)m * 32;
            rec[0] = kk * Gp; rec[8] = kk * a * iG; rec[16] = kp * iG; rec[24] = r * Gc;
            { const float kka = kk * a; float* pc = pairc + ((size_t)h * (MPAD / 2) + (m >> 1)) * 4;
              if (tt & 1) { const float c22 = wave_sum(pkka * kk), c32 = wave_sum(pkp * kk); if (lane == 0) { pc[0] = c22; pc[1] = c32; } }
              else { const float c24 = wave_sum(kka * r), c34 = wave_sum(kp * r); if (lane == 0) { pc[2] = c24; pc[3] = c34; } }
              pkka = kka; pkp = kp; }
            const float bo = wave_sum(r * kp * rk); if (lane == 0) bonus[(size_t)h * MPAD + m] = bo;
            v2[(size_t)m * 256 + ch] = (bfu)f2bf(v); gg[(size_t)m * 256 + ch] = gb;
        }
        gch[((size_t)h * 1032 + u) * 64 + lane] = __expf(cum);
    }
}
__device__ __forceinline__ void prep_a2(KArgs A, int l, int gw, int NGW, int lane) {
    unsigned char* ws = A->ws; const float* sia = (const float*)slotp(ws, l, 9); float* paird = (float*)(ws + WS_PAIRD);
    for (int task = gw; task < 4 * (MR / 2); task += NGW) { const int h = task & 3, pr = task >> 2, m = 2 * pr;
        const float* rec = sia + ((size_t)(h * 8 + (lane >> 3)) * MPAD + m) * 16 + (lane & 7);
        const float k1 = rec[0], q1 = rec[8], k2 = rec[16];
        const float g12 = wave_sum(k1 * k2), h11 = wave_sum(q1 * k1);
        if (lane == 0) { paird[((size_t)h * (MPAD / 2) + pr) * 2] = g12; paird[((size_t)h * (MPAD / 2) + pr) * 2 + 1] = h11; } }
}
__device__ __forceinline__ void post_attn(KArgs A, int l, int gw, int NGW, int lane) {
    unsigned char* ws = A->ws;
    const bfu* O = (const bfu*)slotp(ws, l, 13); bfu* mix = (bfu*)slotp(ws, l, 7);
    const float* lf = (const float*)(ws + WS_CTL + 1024); const float lam = lf[2 * l], omli = 1.f - lf[2 * l + 1];
    const int h = lane >> 4, e0 = (lane & 15) * 8; const float* bn = A->in[20] + l * 128 + e0;
    float bnv[8];
#pragma unroll
    for (int i = 0; i < 8; ++i) bnv[i] = bn[i] * omli;
    for (int m = gw; m < MP; m += NGW) {
        const v4u a = *(const v4u*)(O + (size_t)m * 1024 + (4 * h + (e0 >> 6)) * 64 + (e0 & 63));
        const v4u b = *(const v4u*)(O + (size_t)m * 1024 + (4 * h + 2 + (e0 >> 6)) * 64 + (e0 & 63));
        float o[8]; float ss = 0.f;
#pragma unroll
        for (int i = 0; i < 4; ++i) { const unsigned aw = a[i], bw = b[i];
            o[2 * i] = __uint_as_float(aw << 16) - lam * __uint_as_float(bw << 16); o[2 * i + 1] = __uint_as_float(aw & 0xffff0000u) - lam * __uint_as_float(bw & 0xffff0000u);
            ss += o[2 * i] * o[2 * i] + o[2 * i + 1] * o[2 * i + 1]; }
        ss += __shfl_xor(ss, 1); ss += __shfl_xor(ss, 2); ss += __shfl_xor(ss, 4); ss += __shfl_xor(ss, 8);
        const float rn = rsqrtf(ss * (1.f / 128.f) + 1e-6f);
        v4u w; w.x = pk2(o[0] * rn * bnv[0], o[1] * rn * bnv[1]); w.y = pk2(o[2] * rn * bnv[2], o[3] * rn * bnv[3]); w.z = pk2(o[4] * rn * bnv[4], o[5] * rn * bnv[5]); w.w = pk2(o[6] * rn * bnv[6], o[7] * rn * bnv[7]);
        *(v4u*)(mix + (size_t)m * 1024 + 256 + h * 128 + e0) = w;
    }
}
__device__ __forceinline__ void final_norm(KArgs A, int gw, int NGW, int lane) {
    const float* rs = (const float*)(A->ws + WS_RS) + 6 * (size_t)MPAD; const float* g = A->in[39];
    for (int m = gw; m < MR; m += NGW) { const float s = rsqrtf(rs[m] * (1.f / 1024.f) + 1e-6f);
#pragma unroll
        for (int j = 0; j < 4; ++j) { float* p = A->out + (size_t)m * 1024 + j * 256 + lane * 4; f32x4 v = *(f32x4*)p; const f32x4 gv = *(const f32x4*)(g + j * 256 + lane * 4); v = v * s * gv; *(f32x4*)p = v; } }
}

#define SC_BAR() asm volatile("s_waitcnt lgkmcnt(0)\n\ts_barrier" ::: "memory")
constexpr int SC_RED = 0, SC_SI = 16384, SC_VBUF = 81920, SC_GBUF = 90112, SC_BON = 98304, SC_PC = 98816, SC_YP = 99328;
#define FMAC_DPP(acc, op, s1, J) asm("v_fmac_f32_dpp %0, %1, %2 row_newbcast:" #J " row_mask:0xf bank_mask:0xf" : "+v"(acc) : "v"(op), "v"(s1))
#define DOT8(a0, a1, op, JB0, JB1, JB2, JB3, JB4, JB5, JB6, JB7) do { FMAC_DPP(a0, op, S[0], JB0); FMAC_DPP(a1, op, S[1], JB1); FMAC_DPP(a0, op, S[2], JB2); FMAC_DPP(a1, op, S[3], JB3); \
        FMAC_DPP(a0, op, S[4], JB4); FMAC_DPP(a1, op, S[5], JB5); FMAC_DPP(a0, op, S[6], JB6); FMAC_DPP(a1, op, S[7], JB7); } while (0)
#define DOT8_LO(a0, a1, op) DOT8(a0, a1, op, 0, 1, 2, 3, 4, 5, 6, 7)
#define DOT8_HI(a0, a1, op) DOT8(a0, a1, op, 8, 9, 10, 11, 12, 13, 14, 15)
#define AXPY8_LO(op, s) do { FMAC_DPP(S[0], op, s, 0); FMAC_DPP(S[1], op, s, 1); FMAC_DPP(S[2], op, s, 2); FMAC_DPP(S[3], op, s, 3); FMAC_DPP(S[4], op, s, 4); FMAC_DPP(S[5], op, s, 5); FMAC_DPP(S[6], op, s, 6); FMAC_DPP(S[7], op, s, 7); } while (0)
#define AXPY8_HI(op, s) do { FMAC_DPP(S[0], op, s, 8); FMAC_DPP(S[1], op, s, 9); FMAC_DPP(S[2], op, s, 10); FMAC_DPP(S[3], op, s, 11); FMAC_DPP(S[4], op, s, 12); FMAC_DPP(S[5], op, s, 13); FMAC_DPP(S[6], op, s, 14); FMAC_DPP(S[7], op, s, 15); } while (0)
#define RED8(V) do { const LAS f32x4* rr_ = (const LAS f32x4*)red + par_ * 512 + lane; const f32x4 q0_ = rr_[0], q1_ = rr_[64], q2_ = rr_[128], q3_ = rr_[192], q4_ = rr_[256], q5_ = rr_[320], q6_ = rr_[384], q7_ = rr_[448]; \
        V = ((q0_ + q1_) + (q2_ + q3_)) + ((q4_ + q5_) + (q6_ + q7_)); } while (0)

__device__ __forceinline__ void scan_rwkv(KArgs A, int l, LAS unsigned char* lds, int h, int m0, int L, int BL, int BLS, int chunk0, const float* st_in, float* st_out, int tid) {
    unsigned char* ws = A->ws;
    const int lane = tid & 63, wid = __builtin_amdgcn_readfirstlane(tid >> 6);
    LAS float* red = (LAS float*)(lds + SC_RED); LAS float* yred = (LAS float*)(lds + SC_YP);
    LAS float* sib = (LAS float*)(lds + SC_SI) + wid * 1024;
    LAS bfu* vbuf = (LAS bfu*)(lds + SC_VBUF); LAS bfu* gbuf = (LAS bfu*)(lds + SC_GBUF); LAS float* bon = (LAS float*)(lds + SC_BON); LAS float* pcs = (LAS float*)(lds + SC_PC);
    const bfu* v2 = (const bfu*)slotp(ws, l, 12); const bfu* gg = (const bfu*)slotph(ws, l, 12);
    const float* bonus = (const float*)(ws + WS_BONUS) + (size_t)h * MPAD;
    const float* pairc = (const float*)(ws + WS_PAIRC) + ((size_t)h * (MPAD / 2) + (m0 >> 1)) * 4;
    const float* gch = (const float*)(ws + WS_GCH) + ((size_t)h * 1032 + chunk0) * 64 + 8 * wid;
    bfu* mix = (bfu*)slotp(ws, l, 7);
    const float* P = (const float*)slotp(ws, l, h) + ((size_t)wid * MPAD + m0) * 32;
    const float lnw = A->in[30][l * 256 + h * 64 + lane], lnb = A->in[31][l * 256 + h * 64 + lane];
    float S[8];
#pragma unroll
    for (int j = 0; j < 8; ++j) S[j] = st_in ? st_in[lane * 64 + 8 * wid + j] : 0.f;
    const int nblk = L >> BLS; const int srow = tid >> 4, sc4 = tid & 15; const bool sval = srow < BL;
    const int nsi = BL >> 3;
    f32x4 ssi[4]; v2u sv = {0, 0}, sg = {0, 0}; float sb_ = 0.f, sp_ = 0.f;
#define RW_STAGE(c) do { const float* ps_ = P + (size_t)(c) * BL * 32 + lane * 4; \
        _Pragma("unroll") for (int i_ = 0; i_ < 4; ++i_) if (i_ < nsi) ssi[i_] = *(const f32x4*)(ps_ + i_ * 256); \
        if (sval) { const size_t mm = (size_t)(m0 + (c) * BL + srow) * 256 + h * 64 + sc4 * 4; sv = *(const v2u*)(v2 + mm); sg = *(const v2u*)(gg + mm); } \
        if (tid < BL) sb_ = bonus[m0 + (c) * BL + tid]; if (tid < 2 * BL) sp_ = pairc[(size_t)(c) * BL * 2 + tid]; } while (0)
#define RW_COMMIT(c) do { LAS float* pd_ = sib + ((c) & 1) * 8192 + lane * 4; \
        _Pragma("unroll") for (int i_ = 0; i_ < 4; ++i_) if (i_ < nsi) *(LAS f32x4*)(pd_ + i_ * 256) = ssi[i_]; \
        if (sval) { *(LAS v2u*)(vbuf + ((c) & 1) * 2048 + srow * 64 + sc4 * 4) = sv; *(LAS v2u*)(gbuf + ((c) & 1) * 2048 + srow * 64 + sc4 * 4) = sg; } \
        if (tid < BL) bon[((c) & 1) * 32 + tid] = sb_; if (tid < 2 * BL) pcs[((c) & 1) * 64 + tid] = sp_; } while (0)
    __syncthreads();
    RW_STAGE(0); RW_COMMIT(0); if (nblk > 1) RW_STAGE(1);
    float ca0, ca1, ca2, ca3, cb0 = 0.f, cb1 = 0.f, cb2 = 0.f, cb3 = 0.f;
#define RW_LOADOPS(D, T) do { const LAS float* po_ = sib + ((((T) >> BLS) & 1) * 8192) + ((T) & (BL - 1)) * 32 + (lane & 15); D##0 = po_[0]; D##1 = po_[16]; D##2 = po_[32]; D##3 = po_[48]; } while (0)
    RW_LOADOPS(ca, 0);
#define RW_FINAL(T) do { const int tf_ = (T); const int ttf_ = tf_ & (BL - 1), bf_ = (tf_ >> BLS) & 1; \
        const LAS float* yr_ = yred + (tf_ & 15) * 512 + lane; const float y_ = ((yr_[0] + yr_[64]) + (yr_[128] + yr_[192])) + ((yr_[256] + yr_[320]) + (yr_[384] + yr_[448])); \
        const float mu_ = wave_sum(y_) * (1.f / 64.f); const float d_ = y_ - mu_; const float var_ = wave_sum(d_ * d_) * (1.f / 64.f); \
        const float cy_ = d_ * rsqrtf(var_ + 64e-5f) * lnw + lnb; \
        const float vv_ = bf2f(vbuf[bf_ * 2048 + ttf_ * 64 + lane]), g_ = bf2f(gbuf[bf_ * 2048 + ttf_ * 64 + lane]); \
        mix[(size_t)(m0 + tf_) * 1024 + 768 + h * 64 + lane] = (bfu)f2bf((cy_ + bon[bf_ * 32 + ttf_] * vv_) * g_); } while (0)
#define RW_ROUND(C, N, T) do { const int par_ = ((T) >> 1) & 1; \
        float d1a = 0.f, d1b = 0.f, d2a = 0.f, d2b = 0.f, f1a = 0.f, f1b = 0.f; \
        DOT8_LO(d1a, d1b, C##0); DOT8_LO(d2a, d2b, C##2); DOT8_HI(f1a, f1b, C##1); \
        ((LAS f32x4*)red)[(par_ * 8 + wid) * 64 + lane] = (f32x4){d1a + d1b, d2a + d2b, f1a + f1b, 0.f}; \
        SC_BAR(); \
        f32x4 tot_; RED8(tot_); \
        const int bo_ = (((T) >> BLS) & 1), to_ = (T) & (BL - 1); \
        const float v1 = bf2f(vbuf[bo_ * 2048 + to_ * 64 + lane]), v2_ = bf2f(vbuf[bo_ * 2048 + to_ * 64 + 64 + lane]); const f32x4 pc_ = *(const LAS f32x4*)(pcs + bo_ * 64 + to_ * 2); \
        asm volatile("" ::: "memory"); \
        if ((T) + 2 < L) RW_LOADOPS(N, (T) + 2); \
        const float sa1 = -tot_[0]; const float sa2 = -(tot_[1] + sa1 * pc_[0] + v1 * pc_[1]); const float y1 = tot_[2] + sa1 * pc_[2] + v1 * pc_[3]; \
        AXPY8_LO(C##1, v1); AXPY8_HI(C##0, sa1); AXPY8_LO(C##3, v2_); AXPY8_HI(C##2, sa2); \
        float y2a = 0.f, y2b = 0.f; DOT8_HI(y2a, y2b, C##3); \
        yred[((T) & 15) * 512 + wid * 64 + lane] = y1 * 0.125f; yred[(((T) + 1) & 15) * 512 + wid * 64 + lane] = y2a + y2b; } while (0)
    for (int c = 0; c < nblk; ++c) {
        for (int tt = 0; tt < BL; tt += 4) {
            const int t = c * BL + tt;
            if (tt == (BL >> 1) && c + 1 < nblk) { RW_COMMIT(c + 1); if (c + 2 < nblk) RW_STAGE(c + 2); }
            RW_ROUND(ca, cb, t);
            RW_ROUND(cb, ca, t + 2);
            if (((t + 3) & 15) == 15) { SC_BAR(); RW_FINAL(t - 12 + 2 * wid); RW_FINAL(t - 11 + 2 * wid); }
        }
        if ((((c + 1) << BLS) & 63) == 0 || c + 1 == nblk) {
            const float* ge = gch + (size_t)((c << BLS) >> 6) * 64;
#pragma unroll
            for (int j = 0; j < 8; ++j) S[j] *= ge[j];
        }
    }
#pragma unroll
    for (int j = 0; j < 8; ++j) st_out[lane * 64 + 8 * wid + j] = S[j];
    __syncthreads();
#undef RW_STAGE
#undef RW_COMMIT
#undef RW_LOADOPS
#undef RW_FINAL
#undef RW_ROUND
}

__device__ __forceinline__ void scan_delta(KArgs A, int l, LAS unsigned char* lds, int h, int m0, int L, int BL, int BLS, const float* st_in, float* st_out, int tid) {
    unsigned char* ws = A->ws;
    const int lane = tid & 63, wid = __builtin_amdgcn_readfirstlane(tid >> 6);
    LAS float* red = (LAS float*)(lds + SC_RED); LAS float* yred = (LAS float*)(lds + SC_YP);
    LAS float* sib = (LAS float*)(lds + SC_SI) + wid * 512;
    LAS bfu* vbuf = (LAS bfu*)(lds + SC_VBUF); LAS bfu* gbuf = (LAS bfu*)(lds + SC_GBUF); LAS float* gab = (LAS float*)(lds + SC_BON); LAS float* pds = (LAS float*)(lds + SC_PC);
    const bfu* va = (const bfu*)slotp(ws, l, 11); const bfu* zs = (const bfu*)slotph(ws, l, 11);
    bfu* mix = (bfu*)slotp(ws, l, 7);
    const float* P = (const float*)slotp(ws, l, 9) + ((size_t)(h * 8 + wid) * MPAD + m0) * 16;
    const float* PG = (const float*)(ws + WS_GAB) + ((size_t)h * MPAD + m0) * 2;
    const float* paird = (const float*)(ws + WS_PAIRD) + ((size_t)h * (MPAD / 2) + (m0 >> 1)) * 2;
    float S[8];
#pragma unroll
    for (int j = 0; j < 8; ++j) S[j] = st_in ? st_in[(8 * wid + j) * 64 + lane] : 0.f;
    const int nblk = L >> BLS; const int srow = tid >> 4, sc4 = tid & 15; const bool sval = srow < BL;
    const int nsi = BL >> 4;
    f32x4 ssi[2]; v2u sv = {0, 0}, sg = {0, 0}; float sb_ = 0.f, sp_ = 0.f;
#define DL_STAGE(c) do { const float* ps_ = P + (size_t)(c) * BL * 16 + lane * 4; \
        _Pragma("unroll") for (int i_ = 0; i_ < 2; ++i_) if (i_ < nsi) ssi[i_] = *(const f32x4*)(ps_ + i_ * 256); \
        if (sval) { const size_t mm = (size_t)(m0 + (c) * BL + srow) * 256 + h * 64 + sc4 * 4; sv = *(const v2u*)(va + mm); sg = *(const v2u*)(zs + mm); } \
        if (tid < 2 * BL) sb_ = PG[(size_t)(c) * BL * 2 + tid]; if (tid < BL) sp_ = paird[(size_t)(c) * BL + tid]; } while (0)
#define DL_COMMIT(c) do { LAS float* pd_ = sib + ((c) & 1) * 4096 + lane * 4; \
        _Pragma("unroll") for (int i_ = 0; i_ < 2; ++i_) if (i_ < nsi) *(LAS f32x4*)(pd_ + i_ * 256) = ssi[i_]; \
        if (sval) { *(LAS v2u*)(vbuf + ((c) & 1) * 2048 + srow * 64 + sc4 * 4) = sv; *(LAS v2u*)(gbuf + ((c) & 1) * 2048 + srow * 64 + sc4 * 4) = sg; } \
        if (tid < 2 * BL) gab[((c) & 1) * 64 + tid] = sb_; if (tid < BL) pds[((c) & 1) * 32 + tid] = sp_; } while (0)
    __syncthreads();
    DL_STAGE(0); DL_COMMIT(0); if (nblk > 1) DL_STAGE(1);
    float ca0, ca1, cb0 = 0.f, cb1 = 0.f;
#define DL_LOADOPS(D, T) do { const LAS float* po_ = sib + ((((T) >> BLS) & 1) * 4096) + ((T) & (BL - 1)) * 16 + (lane & 15); D##0 = po_[0]; D##1 = po_[16]; } while (0)
    DL_LOADOPS(ca, 0);
#define DL_FINAL(T) do { const int tf_ = (T); const int ttf_ = tf_ & (BL - 1), bf_ = (tf_ >> BLS) & 1; \
        const LAS float* yr_ = yred + (tf_ & 15) * 512 + lane; const float o_ = ((yr_[0] + yr_[64]) + (yr_[128] + yr_[192])) + ((yr_[256] + yr_[320]) + (yr_[384] + yr_[448])); \
        const float ss_ = wave_sum(o_ * o_) * (1.f / 64.f); \
        mix[(size_t)(m0 + tf_) * 1024 + h * 64 + lane] = (bfu)f2bf(o_ * rsqrtf(ss_ + 1e-6f) * bf2f(gbuf[bf_ * 2048 + ttf_ * 64 + lane])); } while (0)
#define DL_ROUND(C, N, T) do { const int par_ = ((T) >> 1) & 1; \
        float d1a = 0.f, d1b = 0.f, d2a = 0.f, d2b = 0.f, f1a = 0.f, f1b = 0.f; \
        DOT8_LO(d1a, d1b, C##0); DOT8_LO(d2a, d2b, C##1); DOT8_HI(f1a, f1b, C##0); \
        ((LAS f32x4*)red)[(par_ * 8 + wid) * 64 + lane] = (f32x4){d1a + d1b, d2a + d2b, f1a + f1b, 0.f}; \
        SC_BAR(); \
        f32x4 tot_; RED8(tot_); \
        const int bo_ = (((T) >> BLS) & 1), to_ = (T) & (BL - 1); \
        const float v1 = bf2f(vbuf[bo_ * 2048 + to_ * 64 + lane]), v2_ = bf2f(vbuf[bo_ * 2048 + to_ * 64 + 64 + lane]); \
        const f32x4 ab_ = *(const LAS f32x4*)(gab + bo_ * 64 + to_ * 2); const f32x2 pd2_ = *(const LAS f32x2*)(pds + bo_ * 32 + to_); \
        asm volatile("" ::: "memory"); \
        if ((T) + 2 < L) DL_LOADOPS(N, (T) + 2); \
        const float a1 = ab_[0], a2 = ab_[2]; const float dl1 = ab_[1] * (v1 - a1 * tot_[0]); const float dl2 = ab_[3] * (v2_ - a2 * (a1 * tot_[1] + pd2_[0] * dl1)); \
        const float o1 = a1 * tot_[2] + pd2_[1] * dl1; const float a12 = a1 * a2, dl1s = a2 * dl1; \
        _Pragma("unroll") for (int j = 0; j < 8; ++j) S[j] *= a12; \
        AXPY8_LO(C##0, dl1s); AXPY8_LO(C##1, dl2); \
        float y2a = 0.f, y2b = 0.f; DOT8_HI(y2a, y2b, C##1); \
        yred[((T) & 15) * 512 + wid * 64 + lane] = o1 * 0.125f; yred[(((T) + 1) & 15) * 512 + wid * 64 + lane] = y2a + y2b; } while (0)
    for (int c = 0; c < nblk; ++c) {
        for (int tt = 0; tt < BL; tt += 4) {
            const int t = c * BL + tt;
            if (tt == (BL >> 1) && c + 1 < nblk) { DL_COMMIT(c + 1); if (c + 2 < nblk) DL_STAGE(c + 2); }
            DL_ROUND(ca, cb, t);
            DL_ROUND(cb, ca, t + 2);
            if (((t + 3) & 15) == 15) { SC_BAR(); DL_FINAL(t - 12 + 2 * wid); DL_FINAL(t - 11 + 2 * wid); }
        }
    }
#pragma unroll
    for (int j = 0; j < 8; ++j) st_out[(8 * wid + j) * 64 + lane] = S[j];
    __syncthreads();
#undef DL_STAGE
#undef DL_COMMIT
#undef DL_LOADOPS
#undef DL_FINAL
#undef DL_ROUND
}

__device__ __forceinline__ void sample_attn(KArgs A, int l, LAS unsigned char* lds, int unit, int tid) {
    unsigned char* ws = A->ws;
    const int sb = unit >> 2, h = unit & 3;
    LAS float* qs = (LAS float*)lds;
    LAS float* sc = qs + 2048;
    LAS float* scl = sc + 1024;
    LAS float* ssq = scl + 32;
    LAS float* lsum = ssq + 512;
    const bfu* qb = (const bfu*)slotp(ws, l, 4); bfu* mix = (bfu*)slotp(ws, l, 7);
    const float* ck = A->in[2] + (size_t)(l * 8 + sb) * 2048 * 512 + h * 128; const float* cv = A->in[3] + (size_t)(l * 8 + sb) * 2048 * 512 + h * 128;
    const float* nk = A->out + O_BKS + (size_t)(l * 8 + sb) * 16 * 512 + h * 128; const float* nv = A->out + O_BVS + (size_t)(l * 8 + sb) * 16 * 512 + h * 128;
    const float* lf = (const float*)(ws + WS_CTL + 1024); const float lam = lf[2 * l], omli = 1.f - lf[2 * l + 1];
    __syncthreads();
    for (int i = tid; i < 2048; i += NTHR) { const int map = i >> 10, qi = (i >> 6) & 15, p = i & 63; const int s = p >> 5, n_ = (p >> 4) & 1, r = p & 15;
        qs[(map * 16 + qi) * 64 + n_ * 32 + s * 16 + r] = bf2f(qb[(size_t)(MP + sb * 16 + qi) * 512 + h * 128 + map * 64 + p]); }
    float mrun = -1e30f, lrun = 0.f;
    const int qi = tid & 15, kj = tid >> 4, eg = tid >> 4;
    f32x4 acc0 = {0.f, 0.f, 0.f, 0.f}, acc1 = {0.f, 0.f, 0.f, 0.f};
    __syncthreads();
    for (int tile = 0; tile < 65; ++tile) {
        const int kidx = tile * 32 + kj;
        float s1 = -1e30f, s2 = -1e30f;
        if (kidx < 2064) { const float* kr = kidx < 2048 ? ck + (size_t)kidx * 512 : nk + (size_t)(kidx - 2048) * 512; s1 = 0.f; s2 = 0.f;
#pragma unroll 4
            for (int d = 0; d < 64; d += 4) { const f32x4 k1 = *(const f32x4*)(kr + d), k2 = *(const f32x4*)(kr + 64 + d); const LAS float* q1 = qs + qi * 64 + d; const LAS float* q2 = qs + (16 + qi) * 64 + d;
                s1 += q1[0] * k1[0] + q1[1] * k1[1] + q1[2] * k1[2] + q1[3] * k1[3]; s2 += q2[0] * k2[0] + q2[1] * k2[1] + q2[2] * k2[2] + q2[3] * k2[3]; } }
        sc[qi * 32 + kj] = s1; sc[(16 + qi) * 32 + kj] = s2;
        __syncthreads();
        if (tid < 32) { LAS float* r = sc + tid * 32; float mx = mrun;
#pragma unroll 8
            for (int j = 0; j < 32; ++j) mx = fmaxf(mx, r[j]);
            const float f = exp2f(mrun - mx); float su = 0.f;
#pragma unroll 8
            for (int j = 0; j < 32; ++j) { const float p = exp2f(r[j] - mx); r[j] = p; su += p; }
            lrun = lrun * f + su; mrun = mx; scl[tid] = f; }
        __syncthreads();
        { const float f0 = scl[qi], f1 = scl[16 + qi]; acc0 = acc0 * f0; acc1 = acc1 * f1;
            const int nk_ = tile < 64 ? 32 : 16;
            for (int j = 0; j < nk_; ++j) { const int kx = tile * 32 + j; const float* vr = (kx < 2048 ? cv + (size_t)kx * 512 : nv + (size_t)(kx - 2048) * 512) + eg * 4;
                const f32x4 v = *(const f32x4*)vr; acc0 = acc0 + v * sc[qi * 32 + j]; acc1 = acc1 + v * sc[(16 + qi) * 32 + j]; } }
        __syncthreads();
    }
    if (tid < 32) lsum[tid] = lrun;
    __syncthreads();
    const f32x4 o = acc0 * (1.f / lsum[qi]) - acc1 * (lam / lsum[16 + qi]);
    ssq[qi * 32 + eg] = (o[0] * o[0] + o[1] * o[1]) + (o[2] * o[2] + o[3] * o[3]);
    __syncthreads();
    float ss = 0.f;
#pragma unroll 8
    for (int j = 0; j < 32; ++j) ss += ssq[qi * 32 + j];
    const float rn = rsqrtf(ss * (1.f / 128.f) + 1e-6f) * omli; const float* bn = A->in[20] + l * 128 + eg * 4;
    v2u w; w.x = pk2(o[0] * rn * bn[0], o[1] * rn * bn[1]); w.y = pk2(o[2] * rn * bn[2], o[3] * rn * bn[3]);
    *(v2u*)(mix + (size_t)(MP + sb * 16 + qi) * 1024 + 256 + h * 128 + eg * 4) = w;
    __syncthreads();
}

#define PH_BEGIN \
        KArgs A = (KArgs)__builtin_amdgcn_kernarg_segment_ptr(); \
        int tid = wv * 64 + (int)__builtin_amdgcn_mbcnt_hi(~0u, __builtin_amdgcn_mbcnt_lo(~0u, 0u)); asm volatile("" : "+v"(tid)); tid &= 511; \
        const int bid = blockIdx.x, G = gridDim.x; \
        const int lane = tid & 63, wave = wv; \
        const int gw = bid * NWAVES + wave, NGW = G * NWAVES, gtid = bid * NTHR + tid, NT = G * NTHR; \
        unsigned char* ws = A->ws; float* rsb = (float*)(ws + WS_RS); unsigned char* wb = ws + WS_W; \
        (void)lane; (void)gw; (void)NGW; (void)gtid; (void)NT; (void)rsb; (void)wb;
#define IN(k) (lo <= (k) && (k) < hi)
__device__ __forceinline__ void grid_bar(unsigned* bar, unsigned target, bool leader) {
    asm volatile("s_waitcnt vmcnt(0) lgkmcnt(0)" ::: "memory");
    __syncthreads();
    if (leader) {
        __builtin_amdgcn_fence(__ATOMIC_RELEASE, "agent");
        asm volatile("s_waitcnt vmcnt(0)" ::: "memory");
        __hip_atomic_fetch_add(bar, 1u, __ATOMIC_RELAXED, __HIP_MEMORY_SCOPE_AGENT);
        unsigned spins = 0;
        while (__hip_atomic_load(bar, __ATOMIC_RELAXED, __HIP_MEMORY_SCOPE_AGENT) < target) { __builtin_amdgcn_s_sleep(2); if (++spins > (1u << 27)) break; }
        __builtin_amdgcn_fence(__ATOMIC_ACQUIRE, "agent");
        asm volatile("s_waitcnt vmcnt(0)" ::: "memory");
    }
    __syncthreads();
}
#define SEAM(k) do { if ((k) + 1 < hi) { grid_bar((unsigned*)(ws + WS_CTL + 4096), (unsigned)((k) + 1 - lo) * (unsigned)G, tid == 0); } } while (0)
__global__ void __launch_bounds__(NTHR, 2) hybrid_fwd(Args Aval) {
    extern __shared__ __attribute__((aligned(16))) unsigned char lds_raw[];
    LAS unsigned char* lds = (LAS unsigned char*)lds_raw;
    const int lo = Aval.ph_lo, hi = Aval.ph_hi;
    if (Aval.ph_lo < 0) cg::this_grid().sync();
    const int wv = __builtin_amdgcn_readfirstlane(threadIdx.x >> 6);
    if (IN(0)) { PH_BEGIN prologue(A, lds, gw, NGW, lane, wave, gtid, NT); SEAM(0); }
    { constexpr int l = 0;

        const int p0 = 1 + 11 * l;
        if (IN(p0 + 0)) { PH_BEGIN
            pg8::Gemm g{(const pg8::bf16_t*)slotp(ws, l, 0), (const pg8::bf16_t*)(wb + W_IN), MPAD, NIN, 1024};
            pg8::StaticOrder S; S.init(MPAD, NIN, G, bid);
            EpiG1 E{rsb + (size_t)(3 * l) * MPAD, (bfu*)slotp(ws, l, 2), (bfu*)slotp(ws, l, 4), (bfu*)slotp(ws, l, 5), (bfu*)slotp(ws, l, 6), (bfu*)slotp(ws, l, 7), (float*)(ws + WS_AB), (const float*)(ws + WS_ROPE),
                    A->out + O_BKP + (size_t)l * MP * 512, A->out + O_BVP + (size_t)l * MP * 512, A->out + O_BKS + (size_t)l * MS * 512, A->out + O_BVS + (size_t)l * MS * 512};
            pg8::gemm_phase<EpiG1, pg8::StaticOrder, true, true>((PG8_LAS unsigned char*)lds, g, S, E, wv);
            SEAM(p0 + 0); }
        if (IN(p0 + 1)) { PH_BEGIN
            prep_a(A, l, gw, NGW, lane); prep_c1(A, l, gw, NGW, lane);
#ifdef PROBE_EW2
            prep_a(A, l, gw, NGW, lane); prep_c1(A, l, gw, NGW, lane);
#endif
            if (l == 1) conv_weights(A, 1, 2, lds, gw, NGW, lane, wave);
            SEAM(p0 + 1); }
        if (IN(p0 + 2)) { PH_BEGIN
            pg8::Gemm g{(const pg8::bf16_t*)slotp(ws, l, 12), (const pg8::bf16_t*)(wb + W_LR), MPAD, 768, 256};
            pg8::StaticOrder S; S.init(MPAD, 768, G, bid);
            EpiB<0> E{(bfu*)slotp(ws, l, 13), 768, nullptr};
            pg8::gemm_phase<EpiB<0>, pg8::StaticOrder, true, true>((PG8_LAS unsigned char*)lds, g, S, E, wv);
            SEAM(p0 + 2); }
        if (IN(p0 + 3)) { PH_BEGIN prep_c2(A, l, bid, G, tid); prep_a2(A, l, gw, NGW, lane);
#ifdef PROBE_EW2
            prep_c2(A, l, bid, G, tid);
#endif
            SEAM(p0 + 3); }
        if (IN(p0 + 4)) { PH_BEGIN
            if (bid < 32) { const int b = bid >> 2, h = bid & 3;
                scan_rwkv(A, l, lds, h, b * 8192, 8192, 32, 5, b * 128, nullptr, A->out + O_CWP + (size_t)((l * 8 + b) * 4 + h) * 4096, tid);
#ifdef PROBE_SCAN2
                scan_rwkv(A, l, lds, h, b * 8192, 8192, 32, 5, b * 128, nullptr, A->out + O_CWP + (size_t)((l * 8 + b) * 4 + h) * 4096, tid);
#endif
                scan_rwkv(A, l, lds, h, MP + b * 16, 16, 16, 4, 1024 + b, A->in[7] + (size_t)((l * 8 + b) * 4 + h) * 4096, A->out + O_CWS + (size_t)((l * 8 + b) * 4 + h) * 4096, tid);
            } else if (bid < 64) { const int b = (bid - 32) >> 2, h = bid & 3;
                scan_delta(A, l, lds, h, b * 8192, 8192, 32, 5, nullptr, A->out + O_ADP + (size_t)((l * 8 + b) * 4 + h) * 4096, tid);
#ifdef PROBE_SCAN2
                scan_delta(A, l, lds, h, b * 8192, 8192, 32, 5, nullptr, A->out + O_ADP + (size_t)((l * 8 + b) * 4 + h) * 4096, tid);
#endif
                scan_delta(A, l, lds, h, MP + b * 16, 16, 16, 4, A->in[5] + (size_t)((l * 8 + b) * 4 + h) * 4096, A->out + O_ADS + (size_t)((l * 8 + b) * 4 + h) * 4096, tid);
            } else if (bid < 96) { sample_attn(A, l, lds, bid - 64, tid); }
            __syncthreads();
            unsigned* ctr = (unsigned*)(ws + WS_CTL) + 16 * l; volatile LAS unsigned* qw = (volatile LAS unsigned*)(lds + MISC_OFF);
            const attn_body::bf16* Q = (const attn_body::bf16*)slotp(ws, l, 4); const attn_body::bf16* K = (const attn_body::bf16*)slotp(ws, l, 5); const attn_body::bf16* V = (const attn_body::bf16*)slotp(ws, l, 6);
            attn_body::bf16* O = (attn_body::bf16*)slotp(ws, l, 13);
            for (;;) {
                if (tid == 0) qw[0] = atomicAdd(ctr, 1u);
                __syncthreads();
                const unsigned u = qw[0];
                __syncthreads();
                if (u >= 4096u) break;
                const int qb = 31 - (int)(u >> 7), bh = (int)(u & 127);
                attn_body::attn_unit<8>(bh >> 4, bh & 15, qb, Q, K, V, O, (char*)lds_raw, wv);
            }
            SEAM(p0 + 4); }
        if (IN(p0 + 5)) { PH_BEGIN
            post_attn(A, l, gw, NGW, lane);
            conv_p(A, l, (bfu*)slotp(ws, l, 10), gtid, NT);
#ifdef PROBE_EW2
            post_attn(A, l, gw, NGW, lane);
            conv_p(A, l, (bfu*)slotp(ws, l, 10), gtid, NT);
#endif
            if (l == 0) conv_weights(A, 1, 1, lds, gw, NGW, lane, wave);
            SEAM(p0 + 5); }
        if (IN(p0 + 6)) { PH_BEGIN
            pg8::Gemm g{(const pg8::bf16_t*)slotp(ws, l, 7), (const pg8::bf16_t*)(wb + W_OUT), MPAD, 1024, 1024};
            pg8::StaticOrder S; S.init(MPAD, 1024, G, bid);
            EpiH<2> E{A->out, (bfu*)slotp(ws, l, 0), rsb + (size_t)(3 * l + 1) * MPAD, nullptr, nullptr};
            pg8::gemm_phase<EpiH<2>, pg8::StaticOrder, true, true>((PG8_LAS unsigned char*)lds, g, S, E, wv);
            SEAM(p0 + 6); }
        if (IN(p0 + 7)) { PH_BEGIN
            pg8::Gemm g{(const pg8::bf16_t*)slotp(ws, l, 0), (const pg8::bf16_t*)(wb + W_FF1), MPAD, FFD, 1024};
            pg8::StaticOrder S; S.init(MPAD, FFD, G, bid);
            EpiB<1> E{(bfu*)slotp(ws, l, 2), FFD, rsb + (size_t)(3 * l + 1) * MPAD};
            pg8::gemm_phase<EpiB<1>, pg8::StaticOrder, true, true>((PG8_LAS unsigned char*)lds, g, S, E, wv);
            SEAM(p0 + 7); }
        if (IN(p0 + 8)) { PH_BEGIN
            pg8::Gemm g{(const pg8::bf16_t*)slotp(ws, l, 2), (const pg8::bf16_t*)(wb + W_FF2), MPAD, 1024, FFD};
            pg8::StaticOrder S; S.init(MPAD, 1024, G, bid);
            EpiH<2> E{A->out, (bfu*)slotp(ws, l, 0), rsb + (size_t)(3 * l + 2) * MPAD, nullptr, nullptr};
            pg8::gemm_phase<EpiH<2>, pg8::StaticOrder, true, true>((PG8_LAS unsigned char*)lds, g, S, E, wv);
            SEAM(p0 + 8); }
        if (IN(p0 + 9)) { PH_BEGIN
            pg8::Gemm g{(const pg8::bf16_t*)slotp(ws, l, 10), (const pg8::bf16_t*)(wb + W_PP), MPAD, 1024, 256};
            pg8::StaticOrder S; S.init(MPAD, 1024, G, bid);
            EpiB<0> E{(bfu*)slotp(ws, l, 11), 1024, nullptr};
            pg8::gemm_phase<EpiB<0>, pg8::StaticOrder, true, true>((PG8_LAS unsigned char*)lds, g, S, E, wv);
            SEAM(p0 + 9); }
        if (IN(p0 + 10)) { PH_BEGIN
            pg8::Gemm g{(const pg8::bf16_t*)slotp(ws, l, 0), (const pg8::bf16_t*)(wb + W_GATE), MPAD, 1024, 1024};
            pg8::StaticOrder S; S.init(MPAD, 1024, G, bid);
            EpiH<3> E{A->out, (bfu*)slotp(ws, l, 13), rsb + (size_t)(3 * l + 3) * MPAD, rsb + (size_t)(3 * l + 2) * MPAD, (const bfu*)slotp(ws, l, 11)};
            pg8::gemm_phase<EpiH<3>, pg8::StaticOrder, true, true>((PG8_LAS unsigned char*)lds, g, S, E, wv);
            SEAM(p0 + 10); }
        }
    { constexpr int l = 1;

        const int p0 = 1 + 11 * l;
        if (IN(p0 + 0)) { PH_BEGIN
            pg8::Gemm g{(const pg8::bf16_t*)slotp(ws, l, 0), (const pg8::bf16_t*)(wb + W_IN), MPAD, NIN, 1024};
            pg8::StaticOrder S; S.init(MPAD, NIN, G, bid);
            EpiG1 E{rsb + (size_t)(3 * l) * MPAD, (bfu*)slotp(ws, l, 2), (bfu*)slotp(ws, l, 4), (bfu*)slotp(ws, l, 5), (bfu*)slotp(ws, l, 6), (bfu*)slotp(ws, l, 7), (float*)(ws + WS_AB), (const float*)(ws + WS_ROPE),
                    A->out + O_BKP + (size_t)l * MP * 512, A->out + O_BVP + (size_t)l * MP * 512, A->out + O_BKS + (size_t)l * MS * 512, A->out + O_BVS + (size_t)l * MS * 512};
            pg8::gemm_phase<EpiG1, pg8::StaticOrder, true, true>((PG8_LAS unsigned char*)lds, g, S, E, wv);
            SEAM(p0 + 0); }
        if (IN(p0 + 1)) { PH_BEGIN
            prep_a(A, l, gw, NGW, lane); prep_c1(A, l, gw, NGW, lane);
#ifdef PROBE_EW2
            prep_a(A, l, gw, NGW, lane); prep_c1(A, l, gw, NGW, lane);
#endif
            if (l == 1) conv_weights(A, 1, 2, lds, gw, NGW, lane, wave);
            SEAM(p0 + 1); }
        if (IN(p0 + 2)) { PH_BEGIN
            pg8::Gemm g{(const pg8::bf16_t*)slotp(ws, l, 12), (const pg8::bf16_t*)(wb + W_LR), MPAD, 768, 256};
            pg8::StaticOrder S; S.init(MPAD, 768, G, bid);
            EpiB<0> E{(bfu*)slotp(ws, l, 13), 768, nullptr};
            pg8::gemm_phase<EpiB<0>, pg8::StaticOrder, true, true>((PG8_LAS unsigned char*)lds, g, S, E, wv);
            SEAM(p0 + 2); }
        if (IN(p0 + 3)) { PH_BEGIN prep_c2(A, l, bid, G, tid); prep_a2(A, l, gw, NGW, lane);
#ifdef PROBE_EW2
            prep_c2(A, l, bid, G, tid);
#endif
            SEAM(p0 + 3); }
        if (IN(p0 + 4)) { PH_BEGIN
            if (bid < 32) { const int b = bid >> 2, h = bid & 3;
                scan_rwkv(A, l, lds, h, b * 8192, 8192, 32, 5, b * 128, nullptr, A->out + O_CWP + (size_t)((l * 8 + b) * 4 + h) * 4096, tid);
#ifdef PROBE_SCAN2
                scan_rwkv(A, l, lds, h, b * 8192, 8192, 32, 5, b * 128, nullptr, A->out + O_CWP + (size_t)((l * 8 + b) * 4 + h) * 4096, tid);
#endif
                scan_rwkv(A, l, lds, h, MP + b * 16, 16, 16, 4, 1024 + b, A->in[7] + (size_t)((l * 8 + b) * 4 + h) * 4096, A->out + O_CWS + (size_t)((l * 8 + b) * 4 + h) * 4096, tid);
            } else if (bid < 64) { const int b = (bid - 32) >> 2, h = bid & 3;
                scan_delta(A, l, lds, h, b * 8192, 8192, 32, 5, nullptr, A->out + O_ADP + (size_t)((l * 8 + b) * 4 + h) * 4096, tid);
#ifdef PROBE_SCAN2
                scan_delta(A, l, lds, h, b * 8192, 8192, 32, 5, nullptr, A->out + O_ADP + (size_t)((l * 8 + b) * 4 + h) * 4096, tid);
#endif
                scan_delta(A, l, lds, h, MP + b * 16, 16, 16, 4, A->in[5] + (size_t)((l * 8 + b) * 4 + h) * 4096, A->out + O_ADS + (size_t)((l * 8 + b) * 4 + h) * 4096, tid);
            } else if (bid < 96) { sample_attn(A, l, lds, bid - 64, tid); }
            __syncthreads();
            unsigned* ctr = (unsigned*)(ws + WS_CTL) + 16 * l; volatile LAS unsigned* qw = (volatile LAS unsigned*)(lds + MISC_OFF);
            const attn_body::bf16* Q = (const attn_body::bf16*)slotp(ws, l, 4); const attn_body::bf16* K = (const attn_body::bf16*)slotp(ws, l, 5); const attn_body::bf16* V = (const attn_body::bf16*)slotp(ws, l, 6);
            attn_body::bf16* O = (attn_body::bf16*)slotp(ws, l, 13);
            for (;;) {
                if (tid == 0) qw[0] = atomicAdd(ctr, 1u);
                __syncthreads();
                const unsigned u = qw[0];
                __syncthreads();
                if (u >= 4096u) break;
                const int qb = 31 - (int)(u >> 7), bh = (int)(u & 127);
                attn_body::attn_unit<8>(bh >> 4, bh & 15, qb, Q, K, V, O, (char*)lds_raw, wv);
            }
            SEAM(p0 + 4); }
        if (IN(p0 + 5)) { PH_BEGIN
            post_attn(A, l, gw, NGW, lane);
            conv_p(A, l, (bfu*)slotp(ws, l, 10), gtid, NT);
#ifdef PROBE_EW2
            post_attn(A, l, gw, NGW, lane);
            conv_p(A, l, (bfu*)slotp(ws, l, 10), gtid, NT);
#endif
            if (l == 0) conv_weights(A, 1, 1, lds, gw, NGW, lane, wave);
            SEAM(p0 + 5); }
        if (IN(p0 + 6)) { PH_BEGIN
            pg8::Gemm g{(const pg8::bf16_t*)slotp(ws, l, 7), (const pg8::bf16_t*)(wb + W_OUT), MPAD, 1024, 1024};
            pg8::StaticOrder S; S.init(MPAD, 1024, G, bid);
            EpiH<2> E{A->out, (bfu*)slotp(ws, l, 0), rsb + (size_t)(3 * l + 1) * MPAD, nullptr, nullptr};
            pg8::gemm_phase<EpiH<2>, pg8::StaticOrder, true, true>((PG8_LAS unsigned char*)lds, g, S, E, wv);
            SEAM(p0 + 6); }
        if (IN(p0 + 7)) { PH_BEGIN
            pg8::Gemm g{(const pg8::bf16_t*)slotp(ws, l, 0), (const pg8::bf16_t*)(wb + W_FF1), MPAD, FFD, 1024};
            pg8::StaticOrder S; S.init(MPAD, FFD, G, bid);
            EpiB<1> E{(bfu*)slotp(ws, l, 2), FFD, rsb + (size_t)(3 * l + 1) * MPAD};
            pg8::gemm_phase<EpiB<1>, pg8::StaticOrder, true, true>((PG8_LAS unsigned char*)lds, g, S, E, wv);
            SEAM(p0 + 7); }
        if (IN(p0 + 8)) { PH_BEGIN
            pg8::Gemm g{(const pg8::bf16_t*)slotp(ws, l, 2), (const pg8::bf16_t*)(wb + W_FF2), MPAD, 1024, FFD};
            pg8::StaticOrder S; S.init(MPAD, 1024, G, bid);
            EpiH<2> E{A->out, (bfu*)slotp(ws, l, 0), rsb + (size_t)(3 * l + 2) * MPAD, nullptr, nullptr};
            pg8::gemm_phase<EpiH<2>, pg8::StaticOrder, true, true>((PG8_LAS unsigned char*)lds, g, S, E, wv);
            SEAM(p0 + 8); }
        if (IN(p0 + 9)) { PH_BEGIN
            pg8::Gemm g{(const pg8::bf16_t*)slotp(ws, l, 10), (const pg8::bf16_t*)(wb + W_PP), MPAD, 1024, 256};
            pg8::StaticOrder S; S.init(MPAD, 1024, G, bid);
            EpiB<0> E{(bfu*)slotp(ws, l, 11), 1024, nullptr};
            pg8::gemm_phase<EpiB<0>, pg8::StaticOrder, true, true>((PG8_LAS unsigned char*)lds, g, S, E, wv);
            SEAM(p0 + 9); }
        if (IN(p0 + 10)) { PH_BEGIN
            pg8::Gemm g{(const pg8::bf16_t*)slotp(ws, l, 0), (const pg8::bf16_t*)(wb + W_GATE), MPAD, 1024, 1024};
            pg8::StaticOrder S; S.init(MPAD, 1024, G, bid);
            EpiH<3> E{A->out, (bfu*)slotp(ws, l, 13), rsb + (size_t)(3 * l + 3) * MPAD, rsb + (size_t)(3 * l + 2) * MPAD, (const bfu*)slotp(ws, l, 11)};
            pg8::gemm_phase<EpiH<3>, pg8::StaticOrder, true, true>((PG8_LAS unsigned char*)lds, g, S, E, wv);
            SEAM(p0 + 10); }
        }
    if (IN(NPHASE - 1)) { PH_BEGIN final_norm(A, gw, NGW, lane); }
}
#undef PH_BEGIN
#undef IN
#undef SEAM

extern "C" void kernel_launch(void* const* d_in, const int* in_sizes, int n_in, void* d_out, int out_size, void* d_ws, size_t ws_size, hipStream_t stream) {
    static int grid = 0;
    if (grid == 0) {
        if (n_in != 40 || (size_t)out_size != O_END || ws_size < WS_TOTAL) { fprintf(stderr, "kernel_launch: unexpected shapes (n_in %d out %d ws %zu)\n", n_in, out_size, ws_size); grid = -1; return; }
        int dev = 0, cus = 0, per_cu = 0;
        if (hipGetDevice(&dev) != hipSuccess || hipDeviceGetAttribute(&cus, hipDeviceAttributeMultiprocessorCount, dev) != hipSuccess) { grid = -1; return; }
        if (hipFuncSetAttribute((const void*)hybrid_fwd, hipFuncAttributeMaxDynamicSharedMemorySize, LDS_BYTES) != hipSuccess) { fprintf(stderr, "kernel_launch: hipFuncSetAttribute failed\n"); grid = -1; return; }
        if (hipOccupancyMaxActiveBlocksPerMultiprocessor(&per_cu, (const void*)hybrid_fwd, NTHR, LDS_BYTES) != hipSuccess || per_cu < 1) { fprintf(stderr, "kernel_launch: occupancy query says %d\n", per_cu); per_cu = 1; }
        (void)hipGetLastError();
        grid = cus;
    }
    if (grid < 0) return;
    if (hipMemsetAsync((char*)d_ws + WS_CTL, 0, 64 * 1024, stream) != hipSuccess) { fprintf(stderr, "kernel_launch: memset failed\n"); return; }
    Args a{};
    for (int i = 0; i < 40; ++i) a.in[i] = (const float*)d_in[i];
    a.out = (float*)d_out; a.ws = (unsigned char*)d_ws;
#if MK_ONE_LAUNCH
    a.ph_lo = 0; a.ph_hi = NPHASE;
    void* args[] = {&a};
    hipError_t e = hipLaunchCooperativeKernel((const void*)hybrid_fwd, dim3(grid), dim3(NTHR), args, LDS_BYTES, stream);
    if (e != hipSuccess) fprintf(stderr, "kernel_launch: cooperative launch failed: %s (grid %d)\n", hipGetErrorString(e), grid);
#else
    for (int ph = 0; ph < NPHASE; ++ph) { a.ph_lo = ph; a.ph_hi = ph + 1; hipLaunchKernelGGL(hybrid_fwd, dim3(grid), dim3(NTHR), LDS_BYTES, stream, a); }
#endif
}
```

```cpp
#include <hip/hip_runtime.h>
#include <hip/hip_cooperative_groups.h>
#include <cstdio>
#include <cstdint>
namespace cg = cooperative_groups;
namespace pg8 {
#define PG8_LAS __attribute__((address_space(3)))
typedef unsigned short bf16_t;
typedef short bf16x8 __attribute__((ext_vector_type(8)));
typedef float f32x4 __attribute__((ext_vector_type(4)));
typedef unsigned u32x4 __attribute__((ext_vector_type(4)));
constexpr int BM = 256, BK = 64, HALF = 128, HTB = HALF * BK * 2  , STAGE_BYTES = 8 * HTB, NXCD = 8, WGM = 8;

__host__ __device__ __forceinline__ int lds_byte(int r, int c) { const int st = (r >> 4) * 2 + (c >> 5), rr = r & 15, cc = c & 31, ob = rr * 64 + cc * 2; return st * 1024 + (ob ^ (((ob >> 9) & 1) << 5)); }
__host__ __device__ __forceinline__ void stage_rc(int b, int& R, int& C) { const int st = b / 1024, sb = b % 1024, swz = sb ^ (((sb >> 9) & 1) << 5); R = (st >> 1) * 16 + swz / 64; C = (st & 1) * 32 + (swz % 64) / 2; }
__host__ __device__ __forceinline__ int perm32(int rho) { const int n = rho >> 4, i = rho & 15; return 8 * (i >> 2) + 4 * n + (i & 3); }

struct Unit { int pm, pn; };
struct Gemm { const bf16_t* A; const bf16_t* Bt; int M, N, K; };

struct StaticOrder {
    int nM, nN, nwg, G, c;
    __host__ __device__ void init(int M, int N, int G_, int c_) { nM = M / BM; nN = N / BM; nwg = nM * nN; G = G_; c = c_; }
    __host__ __device__ bool next(int i, Unit& u) const {
        const long L = (long)i * G + c; if (L >= nwg) return false;
        int wgid = (int)L; { const int q = nwg / NXCD, r = nwg % NXCD, xcd = wgid % NXCD, off = wgid / NXCD; wgid = (xcd < r ? xcd * (q + 1) : r * (q + 1) + (xcd - r) * q) + off; }
        const int nig = WGM * nN, gid = wgid / nig, fm = gid * WGM, gsz = (nM - fm) < WGM ? (nM - fm) : WGM;
        u.pm = fm + ((wgid % nig) % gsz); u.pn = (wgid % nig) / gsz; return true;
    }
    __device__ __forceinline__ void a_ready(const Unit&) const {}
    __device__ __forceinline__ void done(const Unit&) const {}
};

__device__ __forceinline__ unsigned cvt_pk_bf16(float lo, float hi) { unsigned r; asm volatile("v_cvt_pk_bf16_f32 %0, %1, %2" : "=v"(r) : "v"(lo), "v"(hi)); return r; }
typedef float f32x2 __attribute__((ext_vector_type(2)));
__device__ __forceinline__ f32x2 gelu_pk(f32x2 v) {
    const f32x2 av = __builtin_elementwise_abs(v), d = av * 0.2316418882f + 1.0f;
    f32x2 t; t.x = __builtin_amdgcn_rcpf(d.x); t.y = __builtin_amdgcn_rcpf(d.y);
    f32x2 q = t * 0.5307027145f + (-0.7265760135f); q = q * t + 0.7107068705f; q = q * t + (-0.142248368f); q = q * t + 0.127414796f; q = q * t;
    const f32x2 s = (v * v) * (-0.72134752044f);
    f32x2 e; e.x = __builtin_amdgcn_exp2f(s.x); e.y = __builtin_amdgcn_exp2f(s.y);
    const f32x2 m = v * (q * e), r = v - m;
    f32x2 o; o.x = v.x < 0.f ? m.x : r.x; o.y = v.y < 0.f ? m.y : r.y; return o;
}

template <int ACT  > struct EpiBf16 {
    static constexpr bool PERM = true, AFTER_DRAIN = false; static_assert(ACT == 0 || ACT == 1, "EpiBf16: ACT is 0 (none) or 1 (gelu_pk)");
    bf16_t* O; int ldc; const float* bias; int split_cols; size_t split_stride; float scale0;
    __device__ __forceinline__ void operator()(const f32x4 (&acc)[2][2][4][2], const Unit& u, int wr, int wc, int fr, int fq) const {
        const int row0 = u.pm * BM + wr * 64 + fr; int colt = u.pn * BM; bf16_t* base = O;
        float sc = 1.f; if (split_cols) { const int t = colt / split_cols; base += (size_t)t * split_stride; colt -= t * split_cols; if (t == 0) sc = scale0; }
        const int col0 = colt + wc * 32 + 8 * fq, bcol0 = u.pn * BM + wc * 32 + 8 * fq;
        f32x4 bv[2][2];
#pragma unroll
        for (int bj = 0; bj < 2; ++bj)
#pragma unroll
            for (int n = 0; n < 2; ++n) bv[bj][n] = bias ? *(const f32x4*)(bias + bcol0 + bj * HALF + 4 * n) : (f32x4){0.f, 0.f, 0.f, 0.f};
#pragma unroll
        for (int ai = 0; ai < 2; ++ai)
#pragma unroll
            for (int m = 0; m < 4; ++m) { bf16_t* rowp = base + (size_t)(row0 + ai * HALF + m * 16) * ldc + col0;
#pragma unroll
                for (int bj = 0; bj < 2; ++bj) { f32x4 v0 = acc[ai][bj][m][0] + bv[bj][0], v1 = acc[ai][bj][m][1] + bv[bj][1];
                    if (ACT == 1) { f32x2 a = gelu_pk((f32x2){v0[0], v0[1]}), b = gelu_pk((f32x2){v0[2], v0[3]}), c = gelu_pk((f32x2){v1[0], v1[1]}), d = gelu_pk((f32x2){v1[2], v1[3]});
                        v0 = (f32x4){a.x, a.y, b.x, b.y}; v1 = (f32x4){c.x, c.y, d.x, d.y}; }
                    v0 = v0 * sc; v1 = v1 * sc; u32x4 w; w.x = cvt_pk_bf16(v0[0], v0[1]); w.y = cvt_pk_bf16(v0[2], v0[3]); w.z = cvt_pk_bf16(v1[0], v1[1]); w.w = cvt_pk_bf16(v1[2], v1[3]);
                    *(u32x4*)(rowp + bj * HALF) = w; } }
    }
};

struct PanelStats {
    unsigned* xbuf;
    unsigned* cnt;
    unsigned* tmo;
    int ntn; float eps;
    unsigned code;
    __device__ __forceinline__ bool run(const f32x4 (&v)[2][2][4][2], const Unit& u, int wr, int wc, int fr, int fq, PG8_LAS unsigned char* lds, int wid, int lane) const {
        typedef float f32x2v __attribute__((ext_vector_type(2)));
        PG8_LAS f32x2v* P = (PG8_LAS f32x2v*)lds;
        PG8_LAS f32x2v* S = (PG8_LAS f32x2v*)(lds + 8192);
        PG8_LAS unsigned* flag = (PG8_LAS unsigned*)(lds + 8192 + 2048);
#pragma unroll
        for (int ai = 0; ai < 2; ++ai)
#pragma unroll
            for (int m = 0; m < 4; ++m) {
                float s = 0.f;
#pragma unroll
                for (int bj = 0; bj < 2; ++bj)
#pragma unroll
                    for (int n = 0; n < 2; ++n) { const f32x4 x = v[ai][bj][m][n]; s += (x[0] + x[1]) + (x[2] + x[3]); }
                s += __shfl_xor(s, 16); s += __shfl_xor(s, 32);
                const float mw = s * (1.0f / 64.0f); float q = 0.f;
#pragma unroll
                for (int bj = 0; bj < 2; ++bj)
#pragma unroll
                    for (int n = 0; n < 2; ++n) { const f32x4 d = v[ai][bj][m][n] - mw; q += (d[0] * d[0] + d[1] * d[1]) + (d[2] * d[2] + d[3] * d[3]); }
                q += __shfl_xor(q, 16); q += __shfl_xor(q, 32);
                if (fq == 0) P[(ai * HALF + wr * 64 + m * 16 + fr) * 4 + wc] = (f32x2v){mw, q};
            }
        asm volatile("s_waitcnt lgkmcnt(0)" ::: "memory"); __builtin_amdgcn_s_barrier(); asm volatile("" ::: "memory");
#if defined(BROKEN_EXCHANGE_NO_WAIT)
#warning BROKEN CONTROL BUILD: the row-statistics exchange does not wait; results are wrong by design
        if (blockIdx.x >= 64) { const long long t0_ = clock64(); while (clock64() - t0_ < 60000) __builtin_amdgcn_s_sleep(8); }
#endif
        const int row = wid * 32 + (lane & 31);
        if (lane < 32) {
            const f32x2v a = P[row * 4 + 0], b = P[row * 4 + 1], c = P[row * 4 + 2], d = P[row * 4 + 3];
            const float mt = (a.x + b.x + c.x + d.x) * 0.25f;
            const float da = a.x - mt, db = b.x - mt, dc = c.x - mt, dd = d.x - mt;
            const float m2 = (a.y + b.y) + (c.y + d.y) + 64.0f * ((da * da + db * db) + (dc * dc + dd * dd));
            unsigned long long* slot = (unsigned long long*)xbuf + ((size_t)(u.pm * BM + row) * 4 + u.pn);
            __hip_atomic_store(slot, ((unsigned long long)__float_as_uint(m2) << 32) | __float_as_uint(mt), __ATOMIC_RELAXED, __HIP_MEMORY_SCOPE_AGENT);
        }
        asm volatile("s_waitcnt vmcnt(0)" ::: "memory");
        if (lane == 0) __hip_atomic_fetch_add(cnt + 64 * u.pm, 1u, __ATOMIC_RELAXED, __HIP_MEMORY_SCOPE_AGENT);
        if (wid == 0) {
            bool dead = false; const unsigned long long t0 = __builtin_amdgcn_s_memrealtime(); const unsigned want = 8u * (unsigned)ntn;
            for (;;) {
#if defined(BROKEN_EXCHANGE_NO_WAIT)
                break;
#endif
                if ((unsigned)__builtin_amdgcn_readfirstlane(__hip_atomic_load(cnt + 64 * u.pm, __ATOMIC_RELAXED, __HIP_MEMORY_SCOPE_AGENT)) >= want) break;
                if (__builtin_amdgcn_s_memrealtime() - t0 > 2000000ull) {
                    if (lane == 0) { unsigned expect = 0u; __hip_atomic_compare_exchange_strong(tmo + 1, &expect, code | (unsigned)(u.pm & 0xff), __ATOMIC_RELAXED, __ATOMIC_RELAXED, __HIP_MEMORY_SCOPE_AGENT);
                                     __hip_atomic_store(tmo, 1u, __ATOMIC_RELAXED, __HIP_MEMORY_SCOPE_AGENT); }
                    dead = true; break; }
                __builtin_amdgcn_s_sleep(2);
            }
            __builtin_amdgcn_fence(__ATOMIC_ACQUIRE, "agent");
            if (lane == 0) flag[0] = dead ? 1u : 0u;
        }
        asm volatile("s_waitcnt vmcnt(0) lgkmcnt(0)" ::: "memory"); __builtin_amdgcn_s_barrier(); asm volatile("" ::: "memory");
        const bool bad = flag[0] != 0u;
        if (lane < 32) {
            const unsigned long long* slot = (const unsigned long long*)xbuf + (size_t)(u.pm * BM + row) * 4; float mt[4], m2[4]; float ms = 0.f;
#pragma unroll
            for (int t = 0; t < 4; ++t) { if (t < ntn) { const unsigned long long w = __hip_atomic_load(slot + t, __ATOMIC_RELAXED, __HIP_MEMORY_SCOPE_AGENT); mt[t] = __uint_as_float((unsigned)w); m2[t] = __uint_as_float((unsigned)(w >> 32)); } else { mt[t] = 0.f; m2[t] = 0.f; } ms += mt[t]; }
            const float mean = ms / (float)ntn; float q = 0.f;
#pragma unroll
            for (int t = 0; t < 4; ++t) if (t < ntn) { const float dm = mt[t] - mean; q += m2[t] + 256.0f * dm * dm; }
            S[row] = (f32x2v){mean, 1.0f / sqrtf(q / (256.0f * (float)ntn) + eps)};
        }
        asm volatile("s_waitcnt lgkmcnt(0)" ::: "memory"); __builtin_amdgcn_s_barrier(); asm volatile("" ::: "memory");
        return bad;
    }
};
struct EpiLnRes {
    static constexpr bool PERM = false, AFTER_DRAIN = true;
    const float* base; float* out; int ldc; const float* bias; PanelStats st; unsigned poison;
    __device__ __forceinline__ void fused(f32x4 (&acc)[2][2][4][2], const Unit& u, int wr, int wc, int fr, int fq, PG8_LAS unsigned char* lds, int wid, int lane) const {
        typedef float f32x2v __attribute__((ext_vector_type(2)));
        const PG8_LAS f32x2v* S = (const PG8_LAS f32x2v*)(lds + 8192);
        const int col0 = u.pn * BM + wc * 32 + 4 * fq;
#pragma unroll
        for (int bj = 0; bj < 2; ++bj)
#pragma unroll
            for (int n = 0; n < 2; ++n) { const f32x4 bv = bias ? *(const f32x4*)(bias + col0 + bj * HALF + n * 16) : (f32x4){0.f, 0.f, 0.f, 0.f};
#pragma unroll
                for (int ai = 0; ai < 2; ++ai)
#pragma unroll
                    for (int m = 0; m < 4; ++m) acc[ai][bj][m][n] += bv; }
        f32x4 pre[4][2][2];
#pragma unroll
        for (int m = 0; m < 4; ++m) { const size_t off = (size_t)(u.pm * BM + wr * 64 + m * 16 + fr) * ldc + col0;
#pragma unroll
            for (int bj = 0; bj < 2; ++bj)
#pragma unroll
                for (int n = 0; n < 2; ++n) pre[m][bj][n] = *(const f32x4*)(base + off + bj * HALF + n * 16); }
        const bool bad = st.run(acc, u, wr, wc, fr, fq, lds, wid, lane) || poison != 0u;
        const float qnan = __builtin_nanf("");
#pragma unroll
        for (int ai = 0; ai < 2; ++ai)
#pragma unroll
            for (int m = 0; m < 4; ++m) { const int r = ai * HALF + wr * 64 + m * 16 + fr; const f32x2v sr = S[r]; const size_t off = (size_t)(u.pm * BM + r) * ldc + col0;
#pragma unroll
                for (int bj = 0; bj < 2; ++bj)
#pragma unroll
                    for (int n = 0; n < 2; ++n) { const f32x4 bs = ai == 0 ? pre[m][bj][n] : *(const f32x4*)(base + off + bj * HALF + n * 16); f32x4 o = bs + (acc[ai][bj][m][n] - sr.x) * sr.y;
                        if (bad) o = (f32x4){qnan, qnan, qnan, qnan}; *(f32x4*)(out + off + bj * HALF + n * 16) = o; }
                if (m & 1) asm volatile("" ::: "memory"); }
    }
};
struct EpiLnResLn {
    static constexpr bool PERM = false, AFTER_DRAIN = true;
    const float* base; float* out; bf16_t* xn; int ldc; const float* bias; PanelStats st1, st2; unsigned poison;
    __device__ __forceinline__ void fused(f32x4 (&acc)[2][2][4][2], const Unit& u, int wr, int wc, int fr, int fq, PG8_LAS unsigned char* lds, int wid, int lane) const {
        typedef float f32x2v __attribute__((ext_vector_type(2))); typedef unsigned u32x2v __attribute__((ext_vector_type(2)));
        const PG8_LAS f32x2v* S = (const PG8_LAS f32x2v*)(lds + 8192);
        const int col0 = u.pn * BM + wc * 32 + 4 * fq;
#pragma unroll
        for (int bj = 0; bj < 2; ++bj)
#pragma unroll
            for (int n = 0; n < 2; ++n) { const f32x4 bv = bias ? *(const f32x4*)(bias + col0 + bj * HALF + n * 16) : (f32x4){0.f, 0.f, 0.f, 0.f};
#pragma unroll
                for (int ai = 0; ai < 2; ++ai)
#pragma unroll
                    for (int m = 0; m < 4; ++m) acc[ai][bj][m][n] += bv; }
        bool bad = st1.run(acc, u, wr, wc, fr, fq, lds, wid, lane) || poison != 0u;
        const float qnan = __builtin_nanf("");
#pragma unroll
        for (int ai = 0; ai < 2; ++ai)
#pragma unroll
            for (int m = 0; m < 4; ++m) { const int r = ai * HALF + wr * 64 + m * 16 + fr; const f32x2v sr = S[r]; const size_t off = (size_t)(u.pm * BM + r) * ldc + col0;
#pragma unroll
                for (int bj = 0; bj < 2; ++bj)
#pragma unroll
                    for (int n = 0; n < 2; ++n) { const f32x4 bs = *(const f32x4*)(base + off + bj * HALF + n * 16); acc[ai][bj][m][n] = bs + (acc[ai][bj][m][n] - sr.x) * sr.y; }
                asm volatile("" : "+v"(acc[ai][0][m][0]), "+v"(acc[ai][0][m][1]), "+v"(acc[ai][1][m][0]), "+v"(acc[ai][1][m][1]));
                if (m & 1) asm volatile("" ::: "memory"); }
        const bool bad1 = bad;
        bad = st2.run(acc, u, wr, wc, fr, fq, lds, wid, lane) || bad;
#pragma unroll
        for (int ai = 0; ai < 2; ++ai)
#pragma unroll
            for (int m = 0; m < 4; ++m) { const int r = ai * HALF + wr * 64 + m * 16 + fr; const f32x2v sr = S[r]; const size_t off = (size_t)(u.pm * BM + r) * ldc + col0;
#pragma unroll
                for (int bj = 0; bj < 2; ++bj)
#pragma unroll
                    for (int n = 0; n < 2; ++n) { const f32x4 x1 = acc[ai][bj][m][n]; *(f32x4*)(out + off + bj * HALF + n * 16) = bad1 ? (f32x4){qnan, qnan, qnan, qnan} : x1;
                        const f32x4 o = (x1 - sr.x) * sr.y; u32x2v w; w.x = cvt_pk_bf16(o[0], o[1]); w.y = cvt_pk_bf16(o[2], o[3]);
                        if (bad) { w.x = 0x7fc07fc0u; w.y = 0x7fc07fc0u; } *(u32x2v*)(xn + off + bj * HALF + n * 16) = w; }
                asm volatile("" ::: "memory"); }
    }
};

template <class Epi, class Sched, bool ALIGN_EPI = false, bool SP2 = false>
__device__ __forceinline__ void gemm_phase(PG8_LAS unsigned char* lds, const Gemm g, const Sched& S, const Epi& E, const int wv_) {
    int tid_o = wv_ * 64 + (int)__builtin_amdgcn_mbcnt_hi(~0u, __builtin_amdgcn_mbcnt_lo(~0u, 0u)); asm volatile("" : "+v"(tid_o)); tid_o &= 511;
    const int tid = tid_o, wid = __builtin_amdgcn_readfirstlane(tid >> 6), lane = tid & 63, wr = wid >> 2, wc = wid & 3, fr = lane & 15, fq = lane >> 4;
    const int K = g.K, nt = K / BK;
    unsigned voffA[2], voffB[2];
#pragma unroll
    for (int i = 0; i < 2; ++i) { int R, C; stage_rc(tid * 16 + i * 8192, R, C); const int Rb = Epi::PERM ? ((R & ~31) + perm32(R & 31)) : R;
        voffA[i] = (unsigned)(R * K + C) * 2u; voffB[i] = (unsigned)(Rb * K + C) * 2u; }
    const size_t kstep = (size_t)(BK * 2);
    const size_t hstep = (size_t)HALF * K * 2;
    const size_t tstep = 2 * hstep;
    const unsigned ldsw = (unsigned)wid * 1024u;
    const int aoff = lds_byte(wr * 64 + fr, fq * 8), boff = lds_byte(wc * 32 + fr, fq * 8);
#define PG8_SA(b, h) (((b) * 2 + (h)) * HTB)
#define PG8_SB(b, h) ((4 + (b) * 2 + (h)) * HTB)
#define PG8_STAGE(bufoff, gbase, voff) do { _Pragma("unroll") for (int _i = 0; _i < 2; ++_i) \
        __builtin_amdgcn_global_load_lds((const unsigned*)((const char*)(gbase) + (voff)[_i]), (PG8_LAS unsigned*)(lds + (bufoff) + ldsw + _i * 8192), 16, 0, 0); } while (0)
#define PG8_LDA(dst, b, h) do { _Pragma("unroll") for (int m = 0; m < 4; ++m) _Pragma("unroll") for (int k = 0; k < 2; ++k) dst[m][k] = *(const PG8_LAS bf16x8*)(lds + PG8_SA(b, h) + aoff + m * 2048 + k * 1024); } while (0)
#define PG8_LDB(dst, b, h) do { _Pragma("unroll") for (int n = 0; n < 2; ++n) _Pragma("unroll") for (int k = 0; k < 2; ++k) dst[n][k] = *(const PG8_LAS bf16x8*)(lds + PG8_SB(b, h) + boff + n * 2048 + k * 1024); } while (0)
#define PG8_MMA(ai, bj, At, Bt) do { __builtin_amdgcn_s_setprio(1); _Pragma("unroll") for (int m = 0; m < 4; ++m) _Pragma("unroll") for (int n = 0; n < 2; ++n) _Pragma("unroll") for (int k = 0; k < 2; ++k) \
        acc[ai][bj][m][n] = __builtin_amdgcn_mfma_f32_16x16x32_bf16(Bt[n][k], At[m][k], acc[ai][bj][m][n], 0, 0, 0); __builtin_amdgcn_s_setprio(0); } while (0)
#define PG8_WAIT_V(n) asm volatile("s_waitcnt vmcnt(" #n ")" ::: "memory")
#define PG8_WAIT_L(n) asm volatile("s_waitcnt lgkmcnt(" #n ")" ::: "memory")
#define PG8_BAR __builtin_amdgcn_s_barrier()
#define PG8_SCHED __builtin_amdgcn_sched_barrier(0)
    Unit cur, nxt; int ui = 0;
    if (!S.next(0, cur)) return;
    f32x4 acc[2][2][4][2];
#pragma unroll
    for (int a = 0; a < 2; ++a)
#pragma unroll
        for (int b = 0; b < 2; ++b)
#pragma unroll
            for (int m = 0; m < 4; ++m)
#pragma unroll
                for (int n = 0; n < 2; ++n) acc[a][b][m][n] = (f32x4){0.f, 0.f, 0.f, 0.f};
    bf16x8 At[4][2], B0[2][2], B1[2][2];
    const char* cA = (const char*)g.A + (size_t)cur.pm * tstep; const char* cB = (const char*)g.Bt + (size_t)cur.pn * tstep;
    S.a_ready(cur);
    if constexpr (SP2) {
        PG8_STAGE(PG8_SB(0, 0), cB, voffB); PG8_STAGE(PG8_SB(0, 1), cB + hstep, voffB); PG8_STAGE(PG8_SA(0, 0), cA, voffA); PG8_STAGE(PG8_SA(0, 1), cA + hstep, voffA);
        if (wr == 1) PG8_BAR;
        PG8_WAIT_V(2); PG8_BAR;
        PG8_STAGE(PG8_SB(1, 0), cB + kstep, voffB); PG8_STAGE(PG8_SA(1, 0), cA + kstep, voffA); PG8_STAGE(PG8_SB(1, 1), cB + hstep + kstep, voffB);
        PG8_WAIT_V(6); PG8_BAR;
    } else {
        PG8_STAGE(PG8_SB(0, 0), cB, voffB); PG8_STAGE(PG8_SA(0, 0), cA, voffA); PG8_STAGE(PG8_SB(0, 1), cB + hstep, voffB); PG8_STAGE(PG8_SA(0, 1), cA + hstep, voffA);
        if (wr == 1) PG8_BAR;
        PG8_WAIT_V(4); PG8_BAR;
        PG8_STAGE(PG8_SB(1, 0), cB + kstep, voffB); PG8_STAGE(PG8_SA(1, 0), cA + kstep, voffA); PG8_STAGE(PG8_SB(1, 1), cB + hstep + kstep, voffB);
        PG8_WAIT_V(6); PG8_BAR;
    }
    for (;;) {
        const bool has_next = S.next(ui + 1, nxt);
        const char* nA = has_next ? (const char*)g.A + (size_t)nxt.pm * tstep : cA; const char* nB = has_next ? (const char*)g.Bt + (size_t)nxt.pn * tstep : cB;
        for (int t = 0; t < nt; t += 2) {
            const bool last = (t == nt - 2);
            const char* a1 = cA + (size_t)(t + 1) * kstep;
            const char* a2 = last ? nA : cA + (size_t)(t + 2) * kstep; const char* b2 = last ? nB : cB + (size_t)(t + 2) * kstep;
            const char* a3 = a2 + kstep; const char* b3 = b2 + kstep;
            if (last && has_next) S.a_ready(nxt);
            if constexpr (SP2) {
            PG8_LDB(B0, 0, 0); PG8_LDB(B1, 0, 1); PG8_SCHED; PG8_LDA(At, 0, 0); PG8_STAGE(PG8_SA(1, 1), a1 + hstep, voffA);
            PG8_WAIT_V(8); PG8_WAIT_L(0); PG8_BAR; PG8_MMA(0, 0, At, B0); PG8_MMA(0, 1, At, B1); PG8_BAR; PG8_SCHED;
            PG8_LDA(At, 0, 1); PG8_STAGE(PG8_SB(0, 0), b2, voffB); PG8_STAGE(PG8_SB(0, 1), b2 + hstep, voffB); PG8_STAGE(PG8_SA(0, 0), a2, voffA);
            PG8_WAIT_V(8); PG8_WAIT_L(0); PG8_BAR; PG8_MMA(1, 0, At, B0); PG8_MMA(1, 1, At, B1); PG8_BAR; PG8_SCHED;
            PG8_LDB(B0, 1, 0); PG8_LDB(B1, 1, 1); PG8_SCHED; PG8_LDA(At, 1, 0); PG8_STAGE(PG8_SA(0, 1), a2 + hstep, voffA);
            PG8_WAIT_V(8); PG8_WAIT_L(0); PG8_BAR; PG8_MMA(0, 0, At, B0); PG8_MMA(0, 1, At, B1); PG8_BAR; PG8_SCHED;
            PG8_LDA(At, 1, 1); PG8_STAGE(PG8_SB(1, 0), b3, voffB); PG8_STAGE(PG8_SB(1, 1), b3 + hstep, voffB); PG8_STAGE(PG8_SA(1, 0), a3, voffA);
            PG8_WAIT_V(8); PG8_WAIT_L(0); PG8_BAR; PG8_MMA(1, 0, At, B0); PG8_MMA(1, 1, At, B1); PG8_BAR; PG8_SCHED;
            } else {
            PG8_LDB(B0, 0, 0); PG8_SCHED; PG8_LDA(At, 0, 0); PG8_STAGE(PG8_SA(1, 1), a1 + hstep, voffA);
            PG8_WAIT_L(8); PG8_BAR; PG8_WAIT_L(0); PG8_MMA(0, 0, At, B0); PG8_BAR; PG8_SCHED;
            PG8_LDB(B1, 0, 1); PG8_STAGE(PG8_SB(0, 0), b2, voffB);
            PG8_BAR; PG8_WAIT_L(0); PG8_MMA(0, 1, At, B1); PG8_BAR;
            PG8_LDA(At, 0, 1); PG8_STAGE(PG8_SA(0, 0), a2, voffA);
            PG8_BAR; PG8_WAIT_L(0); PG8_MMA(1, 0, At, B0); PG8_BAR; PG8_SCHED;
            PG8_STAGE(PG8_SB(0, 1), b2 + hstep, voffB);
            PG8_WAIT_V(6); PG8_BAR; PG8_MMA(1, 1, At, B1); PG8_BAR;
            PG8_LDB(B0, 1, 0); PG8_SCHED; PG8_LDA(At, 1, 0); PG8_STAGE(PG8_SA(0, 1), a2 + hstep, voffA);
            PG8_WAIT_L(8); PG8_BAR; PG8_WAIT_L(0); PG8_MMA(0, 0, At, B0); PG8_BAR; PG8_SCHED;
            PG8_LDB(B1, 1, 1); PG8_STAGE(PG8_SB(1, 0), b3, voffB);
            PG8_BAR; PG8_WAIT_L(0); PG8_MMA(0, 1, At, B1); PG8_BAR;
            PG8_LDA(At, 1, 1); PG8_STAGE(PG8_SA(1, 0), a3, voffA);
            PG8_BAR; PG8_WAIT_L(0); PG8_MMA(1, 0, At, B0); PG8_BAR; PG8_SCHED;
            PG8_STAGE(PG8_SB(1, 1), b3 + hstep, voffB);
            PG8_WAIT_V(6); PG8_BAR; PG8_MMA(1, 1, At, B1); PG8_BAR;
            }
        }
        if constexpr (ALIGN_EPI) { if (wr == 0) PG8_BAR; }
        if constexpr (!Epi::AFTER_DRAIN) { E(acc, cur, wr, wc, fr, fq); S.done(cur); }
        if (!has_next) break;
#pragma unroll
        for (int a = 0; a < 2; ++a)
#pragma unroll
            for (int b = 0; b < 2; ++b)
#pragma unroll
                for (int m = 0; m < 4; ++m)
#pragma unroll
                    for (int n = 0; n < 2; ++n) acc[a][b][m][n] = (f32x4){0.f, 0.f, 0.f, 0.f};
        cur = nxt; cA = nA; cB = nB; ++ui;
        if constexpr (ALIGN_EPI) { if (wr == 1) PG8_BAR; }
    }
    PG8_WAIT_V(0);
    if constexpr (!ALIGN_EPI) { if (wr == 0) PG8_BAR; }
    PG8_BAR;
    if constexpr (Epi::AFTER_DRAIN) { E.fused(acc, cur, wr, wc, fr, fq, lds, wid, lane); S.done(cur); }
#undef PG8_SA
#undef PG8_SB
#undef PG8_STAGE
#undef PG8_LDA
#undef PG8_LDB
#undef PG8_MMA
#undef PG8_WAIT_V
#undef PG8_WAIT_L
#undef PG8_BAR
#undef PG8_SCHED
}
}
#include <hip/hip_bf16.h>
#include <cmath>
namespace attn_body {
using bf16=__hip_bfloat16;
using bf16x8=__attribute__((ext_vector_type(8)))short;
using s16x4=__attribute__((ext_vector_type(4)))short;
using f32x16=__attribute__((ext_vector_type(16)))float;
using u32x4=__attribute__((ext_vector_type(4)))unsigned;
constexpr int BATCH=8,NHEAD=16,SEQ=8192,D=64,DM=NHEAD*D,DMI=512,DMO=1024;
constexpr int NW=8,QBLK=32,QB=QBLK*NW,KVBLK=64,NQB=SEQ/QB;
constexpr int ATTN_PITCH=DM, ATTN_UNIT_ROWS=QB;
__device__ __forceinline__ int crow(int r,int hi){return (r&3)+8*(r>>2)+4*hi;}
#define SBAR() __builtin_amdgcn_sched_barrier(0)
__device__ __forceinline__ void cmask(f32x16&p0,f32x16&p1,int jb,int qrel,int hi){
  const float NEG=-INFINITY; int kb=64*jb+4*hi;
  #pragma unroll
  for(int r=0;r<16;++r){ if(jb>(qrel>>6)){p0[r]=NEG;p1[r]=NEG;} } (void)kb;
}

constexpr int NSLOT=3, SLOTB=8192;
constexpr int LDS_K=0, LDS_V=NSLOT*SLOTB, LDS_WS=2*NSLOT*SLOTB, LDS_OST=LDS_WS+NW*64*4, LDS_BYTES=LDS_OST+NW*4096;
constexpr float C2=0.125f*1.4426950408889634f;
__device__ __forceinline__ void glds16(const void*gsrc,unsigned lds_dst){unsigned keep;
  asm volatile("s_mov_b32 %0, m0\n\ts_mov_b32 m0, %2\n\ts_nop 0\n\tglobal_load_lds_dwordx4 %1, off\n\ts_mov_b32 m0, %0":"=&s"(keep):"v"(gsrc),"s"(lds_dst):"memory");}
__device__ __forceinline__ float max3f(float a,float b,float c){float r;asm("v_max3_f32 %0, %1, %2, %3":"=v"(r):"v"(a),"v"(b),"v"(c));return r;}
__device__ __forceinline__ float max2f(float a,float b){float r;asm("v_max_f32_e32 %0, %1, %2":"=v"(r):"v"(a),"v"(b));return r;}
__device__ __forceinline__ float fadd_s(float a,float b){float r;asm("v_add_f32_e32 %0, %1, %2":"=v"(r):"v"(a),"v"(b));return r;}
__device__ __forceinline__ float fsub_s(float a,float b){float r;asm("v_sub_f32_e32 %0, %1, %2":"=v"(r):"v"(a),"v"(b));return r;}
typedef float f32x2_t __attribute__((ext_vector_type(2))); typedef __bf16 bf16x2_t __attribute__((ext_vector_type(2)));
__device__ __forceinline__ unsigned cvtpk_s(float lo,float hi){f32x2_t v={lo,hi};bf16x2_t b=__builtin_convertvector(v,bf16x2_t);return __builtin_bit_cast(unsigned,b);}
#define WAIT_BAR(N) asm volatile("s_waitcnt vmcnt(" #N ") lgkmcnt(0)\n\ts_barrier":::"memory")

__device__ __forceinline__ void qkt(f32x16&p0,f32x16&p1,const char*Kslot,const bf16x8*qr,const f32x16&negm,int r32,int hi){
  const char*kb=Kslot+hi*1024+r32*16;
  #pragma unroll
  for(int d0=0;d0<4;++d0){
    const bf16x8 b0=*reinterpret_cast<const bf16x8*>(kb+d0*2048);
    const bf16x8 b1=*reinterpret_cast<const bf16x8*>(kb+d0*2048+512);
    if(d0==0){p0=__builtin_amdgcn_mfma_f32_32x32x16_bf16(b0,qr[0],negm,0,0,0);p1=__builtin_amdgcn_mfma_f32_32x32x16_bf16(b1,qr[0],negm,0,0,0);}
    else{p0=__builtin_amdgcn_mfma_f32_32x32x16_bf16(b0,qr[d0],p0,0,0,0);p1=__builtin_amdgcn_mfma_f32_32x32x16_bf16(b1,qr[d0],p1,0,0,0);}}
}
typedef __attribute__((address_space(3))) const char* lds_cptr;
typedef short v4i16_t __attribute__((ext_vector_type(4)));
__device__ __forceinline__ void kload8(bf16x8*kf,lds_cptr kp){
  kf[0]=*(const __attribute__((address_space(3))) bf16x8*)(kp);      kf[1]=*(const __attribute__((address_space(3))) bf16x8*)(kp+512);
  kf[2]=*(const __attribute__((address_space(3))) bf16x8*)(kp+2048); kf[3]=*(const __attribute__((address_space(3))) bf16x8*)(kp+2560);
  kf[4]=*(const __attribute__((address_space(3))) bf16x8*)(kp+4096); kf[5]=*(const __attribute__((address_space(3))) bf16x8*)(kp+4608);
  kf[6]=*(const __attribute__((address_space(3))) bf16x8*)(kp+6144); kf[7]=*(const __attribute__((address_space(3))) bf16x8*)(kp+6656);
}
__device__ __forceinline__ void kload2(bf16x8*kf,lds_cptr kp,int j){ kf[2*j]=*(const __attribute__((address_space(3))) bf16x8*)(kp+j*2048); kf[2*j+1]=*(const __attribute__((address_space(3))) bf16x8*)(kp+j*2048+512); }
__device__ __forceinline__ s16x4 vtr(lds_cptr p){ return __builtin_bit_cast(s16x4,__builtin_amdgcn_ds_read_tr16_b64_v4i16((__attribute__((address_space(3))) v4i16_t*)p)); }
__device__ __forceinline__ float rowmax(const f32x16&p0,const f32x16&p1){
  float a=max3f(p0[0],p0[1],p1[0]),b=max3f(p0[2],p0[3],p1[1]);a=max3f(a,p1[2],p1[3]);
  #pragma unroll
  for(int r=4;r<16;r+=4){a=max3f(a,p0[r],p0[r+1]);b=max3f(b,p0[r+2],p0[r+3]);a=max3f(a,p1[r],p1[r+1]);b=max3f(b,p1[r+2],p1[r+3]);}
  const float m=max2f(a,b);
  auto rr=__builtin_amdgcn_permlane32_swap(__float_as_uint(m),__float_as_uint(m),false,false);
  return max2f(__uint_as_float(rr[0]),__uint_as_float(rr[1]));
}
__device__ __forceinline__ void pv(f32x16*o,int vb,bf16x8 pa0,bf16x8 pa1,bf16x8 pa2,bf16x8 pa3){
  #pragma unroll
  for(int d0=0;d0<2;++d0){s16x4 lo[4],hi[4];
    #pragma unroll
    for(int ks=0;ks<4;++ks){
      asm volatile("ds_read_b64_tr_b16 %0,%1 offset:%c2":"=&v"(lo[ks]):"v"(vb),"i"(d0*4096+ks*1024):"memory");
      asm volatile("ds_read_b64_tr_b16 %0,%1 offset:%c2":"=&v"(hi[ks]):"v"(vb),"i"(d0*4096+ks*1024+512):"memory");}
    asm volatile("s_waitcnt lgkmcnt(0)":::"memory");SBAR();
    #define PK(k) (bf16x8){lo[k][0],lo[k][1],lo[k][2],lo[k][3],hi[k][0],hi[k][1],hi[k][2],hi[k][3]}
    o[d0]=__builtin_amdgcn_mfma_f32_32x32x16_bf16(pa0,PK(0),o[d0],0,0,0);
    o[d0]=__builtin_amdgcn_mfma_f32_32x32x16_bf16(pa1,PK(1),o[d0],0,0,0);
    o[d0]=__builtin_amdgcn_mfma_f32_32x32x16_bf16(pa2,PK(2),o[d0],0,0,0);
    o[d0]=__builtin_amdgcn_mfma_f32_32x32x16_bf16(pa3,PK(3),o[d0],0,0,0);
    #undef PK
  }
}

#ifndef ATTN_STORE16
#define ATTN_STORE16(p,v) (*(u32x4*)(p)=(v))
#endif
template<int THRL> __device__ __forceinline__ void attn_unit(int b,int h,int qb,const bf16*Q,const bf16*__restrict__ K,const bf16*__restrict__ V,bf16*O,char*shm,const int wv_){
  int tid_o=wv_*64+(int)__builtin_amdgcn_mbcnt_hi(~0u,__builtin_amdgcn_mbcnt_lo(~0u,0u)); asm volatile("":"+v"(tid_o)); tid_o&=511;
  const int tid=tid_o,lane=tid&63,r32=lane&31,hi=lane>>5; const int wid=__builtin_amdgcn_readfirstlane(tid>>6);
  const long rowbase=(long)b*SEQ; const int q0=qb*QB;
  const bf16*Qw=Q+(rowbase+q0+wid*QBLK)*DMI+(h>>1)*D;
  const bf16*Kh=K+rowbase*DMI+(h>>1)*D,*Vh=V+rowbase*DMI+(h>>2)*128+(h&1)*64;
  const unsigned lds0=(unsigned)(uintptr_t)shm;
  float*wsf=(float*)(shm+LDS_WS)+wid*64;
  const bf16*ksrc=Kh+(long)lane*DMI+wid*8;
  const bf16*vsrc=Vh+(long)(16*(wid&3)+(lane>>2))*DMI+(wid>>2)*32+(lane&3)*8;
  const unsigned kdst=lds0+LDS_K+wid*1024, vdst=lds0+LDS_V+wid*1024;
  #define DMA_K(t,slot) glds16(ksrc+(long)(t)*KVBLK*DMI,(unsigned)__builtin_amdgcn_readfirstlane(kdst+(slot)))
  #define DMA_V(t,slot) glds16(vsrc+(long)(t)*KVBLK*DMI,(unsigned)__builtin_amdgcn_readfirstlane(vdst+(slot)))
  const int vb0=(int)(lds0+LDS_V)+((lane>>4)&1)*32+(lane&3)*8+(4*hi+((lane&15)>>2))*64;
  const char*Kbase=shm+LDS_K; bf16x8 kf[8];
  const lds_cptr shm3=(lds_cptr)shm; const lds_cptr kp0=shm3+LDS_K+hi*1024+r32*16; const lds_cptr vp0=shm3+LDS_V+((lane>>4)&1)*32+(lane&3)*8+(4*hi+((lane&15)>>2))*64;
  const int NT=(q0+QB)/KVBLK;
  DMA_K(0,0);DMA_V(0,0);DMA_K(1,SLOTB);
  bf16x8 qr[4];
  #pragma unroll
  for(int d0=0;d0<4;++d0)qr[d0]=*reinterpret_cast<const bf16x8*>(&Qw[(long)r32*DMI+d0*16+hi*8]);
  float mhat=0.f,l_reg=0.f;f32x16 o[2];o[0]=f32x16{};o[1]=f32x16{};f32x16 negm=f32x16{};asm volatile("":"+v"(negm));
  const int qrel=wid*QBLK+r32;
  #define CMASK(P0,P1,t) do{int jb_=(t)-(NT-4); if(jb_>=0)cmask(P0,P1,jb_,qrel,hi);}while(0)
  bool resc=false;
  #define START(P0,P1) do{ const float rm=rowmax(P0,P1); resc=false; \
    { const float dl=rm; mhat=fadd_s(mhat,dl); \
      _Pragma("unroll") for(int r=0;r<16;++r){P0[r]=fsub_s(P0[r],dl);P1[r]=fsub_s(P1[r],dl);} \
      _Pragma("unroll") for(int r=0;r<16;++r)negm[r]=-mhat; asm volatile("":"+v"(negm)); } \
    _Pragma("unroll") for(int r=0;r<16;++r)P0[r]=__builtin_amdgcn_exp2f(P0[r]); }while(0)
  #define RESC() do{ if(resc){ asm volatile("s_waitcnt lgkmcnt(0)":::"memory"); \
      _Pragma("unroll") for(int d_=0;d_<2;++d_) _Pragma("unroll") for(int r=0;r<16;++r)o[d_][r]*=wsf[crow(r,hi)]; } }while(0)
  f32x16 pA0,pA1,pB0,pB1;
  int sl_prev=0,sl_cur=0,sl_next=SLOTB;
  #define ROT() do{sl_prev=sl_cur;sl_cur=sl_next;sl_next=(sl_next==(NSLOT-1)*SLOTB)?0:sl_next+SLOTB;}while(0)
  DMA_K(2,2*SLOTB);
  WAIT_BAR(3);
  qkt(pA0,pA1,Kbase,qr,negm,r32,hi);asm volatile("s_nop 15\n\ts_nop 7":"+v"(pA0),"+v"(pA1));CMASK(pA0,pA1,0);
  START(pA0,pA1);
  _Pragma("unroll") for(int r=0;r<16;++r)pA1[r]=__builtin_amdgcn_exp2f(pA1[r]);
  WAIT_BAR(0);
  DMA_K(3,0);DMA_V(1,SLOTB);
  ROT();
  kload8(kf,kp0+sl_cur);
  WAIT_BAR(2);
  s16x4 vlo[8],vhi[8]; u32x4 pw0,pw1,pw2,pw3;
  #define PKW(P,B) cvtpk_s(P[B],P[B+1])
  #define PAF(k) __builtin_bit_cast(bf16x8,pw##k)
  #define VFR(i) (bf16x8){vlo[i][0],vlo[i][1],vlo[i][2],vlo[i][3],vhi[i][0],vhi[i][1],vhi[i][2],vhi[i][3]}
  #define PIN(x) asm volatile("":"+v"(x))
  #define MX3(a,b,c) __builtin_fmaxf(__builtin_fmaxf((a),(b)),(c))
  #define GAPA(MF,A0,A1,A2,A3,W0,W1,PW) do{ MF; sacc+=A0; sacc+=A1; sacc+=A2; sacc+=A3; PIN(sacc); W0; W1; PIN(PW); SBAR(); }while(0)
  #define EX(v) __builtin_amdgcn_exp2f(v)
  #define GAPB(MF,X,B) do{ MF; X[B]=EX(X[B]); X[B+1]=EX(X[B+1]); X[B+2]=EX(X[B+2]); X[B+3]=EX(X[B+3]); PIN(X); SBAR(); }while(0)
  #define VRD(i) do{ vlo[i]=vtr(vp_+(((i)>>2)*4096+((i)&3)*1024)); vhi[i]=vtr(vp_+(((i)>>2)*4096+((i)&3)*1024+512)); }while(0)
  #define KRD(G,j) do{ if(G){ kload2(kf,kp0+sl_next,j); SBAR(); } }while(0)
  #define STEP(C0,C1,P0,P1,t,GK,GV,GL) do{ SBAR(); \
    const lds_cptr vp_=vp0+sl_prev; \
    VRD(0); SBAR(); float sacc=(P0[0]+P0[1]); \
    GAPA(C0=__builtin_amdgcn_mfma_f32_32x32x16_bf16(kf[0],qr[0],negm,0,0,0), P0[2],P0[3],P0[4],P0[5],     pw0[0]=PKW(P0,0), pw0[1]=PKW(P0,2), pw0); \
    VRD(4); SBAR(); GAPA(C1=__builtin_amdgcn_mfma_f32_32x32x16_bf16(kf[1],qr[0],negm,0,0,0), P0[6],P0[7],P0[8],P0[9],     pw0[2]=PKW(P0,4), pw0[3]=PKW(P0,6), pw0); \
    VRD(1); SBAR(); GAPA(C0=__builtin_amdgcn_mfma_f32_32x32x16_bf16(kf[2],qr[1],C0,0,0,0),   P0[10],P0[11],P0[12],P0[13], pw1[0]=PKW(P0,8), pw1[1]=PKW(P0,10), pw1); \
    VRD(5); SBAR(); GAPA(C1=__builtin_amdgcn_mfma_f32_32x32x16_bf16(kf[3],qr[1],C1,0,0,0),   P0[14],P0[15],P1[0],P1[1],   pw1[2]=PKW(P0,12),pw1[3]=PKW(P0,14), pw1); \
    VRD(2); SBAR(); GAPA(C0=__builtin_amdgcn_mfma_f32_32x32x16_bf16(kf[4],qr[2],C0,0,0,0),   P1[2],P1[3],P1[4],P1[5],     pw2[0]=PKW(P1,0), pw2[1]=PKW(P1,2), pw2); \
    VRD(6); SBAR(); GAPA(C1=__builtin_amdgcn_mfma_f32_32x32x16_bf16(kf[5],qr[2],C1,0,0,0),   P1[6],P1[7],P1[8],P1[9],     pw2[2]=PKW(P1,4), pw2[3]=PKW(P1,6), pw2); \
    VRD(3); SBAR(); GAPA(C0=__builtin_amdgcn_mfma_f32_32x32x16_bf16(kf[6],qr[3],C0,0,0,0),   P1[10],P1[11],P1[12],P1[13], pw3[0]=PKW(P1,8), pw3[1]=PKW(P1,10), pw3); \
    VRD(7); SBAR(); GAPA(C1=__builtin_amdgcn_mfma_f32_32x32x16_bf16(kf[7],qr[3],C1,0,0,0),   P1[14],P1[15],0.f,0.f,       pw3[2]=PKW(P1,12),pw3[3]=PKW(P1,14), pw3); \
    l_reg+=sacc; \
    if(GK){DMA_K((t)+3,sl_cur);} if(GV){DMA_V((t)+1,sl_next);} \
    CMASK(C0,C1,t); \
    { float a=MX3(C0[0],C0[1],C1[0]),b=MX3(C0[2],C0[3],C1[1]); a=MX3(a,C1[2],C1[3]); \
      _Pragma("unroll") for(int r=4;r<16;r+=4){a=MX3(a,C0[r],C0[r+1]);b=MX3(b,C0[r+2],C0[r+3]);a=MX3(a,C1[r],C1[r+1]);b=MX3(b,C1[r+2],C1[r+3]);} \
      float rm=__builtin_fmaxf(a,b); { auto rr=__builtin_amdgcn_permlane32_swap(__float_as_uint(rm),__float_as_uint(rm),false,false); rm=__builtin_fmaxf(__uint_as_float(rr[0]),__uint_as_float(rr[1])); } \
      resc=false; \
      if(__builtin_expect(__any(rm>(float)THRL),0)){ const float dl=__builtin_fmaxf(rm,0.f); mhat+=dl; \
        _Pragma("unroll") for(int r=0;r<16;++r){C0[r]-=dl;C1[r]-=dl;} \
        _Pragma("unroll") for(int r=0;r<16;++r)negm[r]=-mhat; asm volatile("":"+v"(negm)); \
        const float f=__builtin_amdgcn_exp2f(-dl); l_reg*=f; if(hi==0)wsf[r32]=f; resc=true; } } \
    SBAR(); \
    GAPB(o[0]=__builtin_amdgcn_mfma_f32_32x32x16_bf16(PAF(0),VFR(0),o[0],0,0,0), C0,0); \
    GAPB(o[1]=__builtin_amdgcn_mfma_f32_32x32x16_bf16(PAF(0),VFR(4),o[1],0,0,0), C0,4); \
    KRD(GL,0); GAPB(o[0]=__builtin_amdgcn_mfma_f32_32x32x16_bf16(PAF(1),VFR(1),o[0],0,0,0), C0,8); \
    KRD(GL,1); GAPB(o[1]=__builtin_amdgcn_mfma_f32_32x32x16_bf16(PAF(1),VFR(5),o[1],0,0,0), C0,12); \
    KRD(GL,2); GAPB(o[0]=__builtin_amdgcn_mfma_f32_32x32x16_bf16(PAF(2),VFR(2),o[0],0,0,0), C1,0); \
    KRD(GL,3); GAPB(o[1]=__builtin_amdgcn_mfma_f32_32x32x16_bf16(PAF(2),VFR(6),o[1],0,0,0), C1,4); \
    GAPB(o[0]=__builtin_amdgcn_mfma_f32_32x32x16_bf16(PAF(3),VFR(3),o[0],0,0,0), C1,8); \
    GAPB(o[1]=__builtin_amdgcn_mfma_f32_32x32x16_bf16(PAF(3),VFR(7),o[1],0,0,0), C1,12); \
    }while(0)
  int t=1;
  #undef CMASK
  #define CMASK(P0,P1,t) do{}while(0)
  for(;t+5<NT;t+=2){
    STEP(pB0,pB1,pA0,pA1,t,true,true,true);     WAIT_BAR(2); RESC(); ROT();
    STEP(pA0,pA1,pB0,pB1,t+1,true,true,true);   WAIT_BAR(2); RESC(); ROT();
  }
  #undef CMASK
  #define CMASK(P0,P1,t) do{int jb_=(t)-(NT-4); if(jb_>=0)cmask(P0,P1,jb_,qrel,hi);}while(0)
  #define ENDW(tt) do{ if((tt)+3<NT){WAIT_BAR(2);} else if((tt)+2<NT){WAIT_BAR(1);} else {WAIT_BAR(0);} }while(0)
  for(;t+1<NT;t+=2){
    STEP(pB0,pB1,pA0,pA1,t,(t+3<NT),(t+1<NT),(t+1<NT));       ENDW(t);   RESC(); ROT();
    STEP(pA0,pA1,pB0,pB1,t+1,(t+4<NT),(t+2<NT),(t+2<NT));     ENDW(t+1); RESC(); ROT();
  }
  STEP(pB0,pB1,pA0,pA1,NT-1,false,false,false); RESC();
  { float sacc=pB0[0]+pB0[1]; _Pragma("unroll") for(int r=2;r<16;++r)sacc+=pB0[r]; _Pragma("unroll") for(int r=0;r<16;++r)sacc+=pB1[r]; l_reg+=sacc;
    pw0=(u32x4){PKW(pB0,0),PKW(pB0,2),PKW(pB0,4),PKW(pB0,6)};pw1=(u32x4){PKW(pB0,8),PKW(pB0,10),PKW(pB0,12),PKW(pB0,14)};pw2=(u32x4){PKW(pB1,0),PKW(pB1,2),PKW(pB1,4),PKW(pB1,6)};pw3=(u32x4){PKW(pB1,8),PKW(pB1,10),PKW(pB1,12),PKW(pB1,14)};
    SBAR(); pv(o,vb0+sl_cur,PAF(0),PAF(1),PAF(2),PAF(3)); }
  #undef PKW
  #undef PAF
  #undef VFR
  #undef PIN
  #undef MX3
  #undef GAPA
  #undef GAPB
  #undef EX
  #undef VRD
  #undef KRD
  #undef STEP
  #undef ENDW
  {auto rr=__builtin_amdgcn_permlane32_swap(__float_as_uint(l_reg),__float_as_uint(l_reg),false,false);l_reg=__uint_as_float(rr[0])+__uint_as_float(rr[1]);}
  if(hi==0)wsf[32+r32]=l_reg;asm volatile("s_waitcnt lgkmcnt(0)":::"memory");
  float rli[16];
  #pragma unroll
  for(int r=0;r<16;++r)rli[r]=__builtin_amdgcn_rcpf(wsf[32+crow(r,hi)]);
  bf16*Ow=O+(rowbase+q0+wid*QBLK)*DMO+h*D;
  { bf16*stg=(bf16*)(shm+LDS_OST)+wid*2048;
    #pragma unroll
    for(int r=0;r<16;++r){const int orow=crow(r,hi);
      #pragma unroll
      for(int d0=0;d0<2;++d0)stg[orow*64+d0*32+r32]=__float2bfloat16(o[d0][r]*rli[r]);}
    asm volatile("s_waitcnt lgkmcnt(0)":::"memory");
    #pragma unroll
    for(int i=0;i<4;++i){const int row=i*8+(lane>>3),ch=lane&7; const u32x4 v=*(const u32x4*)(stg+row*64+ch*8); ATTN_STORE16(Ow+(long)row*DMO+ch*8,v);} }
  asm volatile("s_waitcnt lgkmcnt(0)\n\ts_barrier":::"memory");
  #undef DMA_K
  #undef DMA_V
  #undef CMASK
  #undef START
  #undef RESC
  #undef ROT
}
constexpr int ATTN_LDS_BYTES=LDS_BYTES;
struct AttnTensors { const bf16* Q; const bf16* K; const bf16* V; bf16* O; };
struct AttnUnit { int bh; int qb; };
struct StaticOrder {
  int vcu;
  __device__ __forceinline__ explicit StaticOrder(int grid,int block):vcu((block%8)*(grid/8)+block/8){}
  __device__ __forceinline__ bool next(int i,AttnUnit&u)const{ if(i>=4)return false; const int s=vcu&7; u.bh=vcu>>3; u.qb=(i==0)?s:(i==1)?15-s:(i==2)?16+s:31-s; return true; }
  __device__ __forceinline__ void a_ready(const AttnUnit&)const{}
  __device__ __forceinline__ void done(const AttnUnit&)const{}
};
template<class Sched,int THRL=8> __device__ __forceinline__ void attn_phase(char*lds,const AttnTensors&T,const Sched&S){
  AttnUnit u;
  for(int i=0;S.next(i,u);++i){ S.a_ready(u); attn_unit<THRL>(u.bh/NHEAD,u.bh%NHEAD,u.qb,T.Q,T.K,T.V,T.O,lds); S.done(u); }
}
#undef SBAR
#undef WAIT_BAR
}

#define LAS __attribute__((address_space(3)))
typedef unsigned short bfu;
typedef unsigned v4u __attribute__((ext_vector_type(4)));
typedef unsigned v2u __attribute__((ext_vector_type(2)));
typedef float f32x4 __attribute__((ext_vector_type(4)));
typedef float f32x8 __attribute__((ext_vector_type(8)));
typedef float f32x16 __attribute__((ext_vector_type(16)));
typedef float f32x2 __attribute__((ext_vector_type(2)));

constexpr int NWAVES = 8, NTHR = 512;
constexpr int MP = 65536, MS = 128, MR = MP + MS, MPAD = 65792;
constexpr int NIN = 3840, FFD = 4096;
constexpr int NPHASE = 24;
#ifndef MK_ONE_LAUNCH
#define MK_ONE_LAUNCH 1
#endif

constexpr size_t O_Y = 0;
constexpr size_t O_YS = (size_t)MP * 1024;
constexpr size_t O_ACP = O_YS + 128 * 1024;
constexpr size_t O_ADP = O_ACP + 2 * 8 * 3 * 768;
constexpr size_t O_BKP = O_ADP + 2 * 8 * 4 * 64 * 64;
constexpr size_t O_BVP = O_BKP + (size_t)2 * 8 * 8192 * 512;
constexpr size_t O_CSP = O_BVP + (size_t)2 * 8 * 8192 * 512;
constexpr size_t O_CWP = O_CSP + 2 * 8 * 1024;
constexpr size_t O_ACS = O_CWP + 2 * 8 * 4 * 64 * 64;
constexpr size_t O_ADS = O_ACS + 2 * 8 * 3 * 768;
constexpr size_t O_BKS = O_ADS + 2 * 8 * 4 * 64 * 64;
constexpr size_t O_BVS = O_BKS + 2 * 8 * 16 * 512;
constexpr size_t O_CSS = O_BVS + 2 * 8 * 16 * 512;
constexpr size_t O_CWS = O_CSS + 2 * 8 * 1024;
constexpr size_t O_END = O_CWS + 2 * 8 * 4 * 64 * 64;
static_assert(O_END == 202874880, "output size");

constexpr size_t MiB = 1u << 20;
constexpr size_t WS_CTL = 0;
constexpr size_t WS_RS = 64 * 1024;
constexpr size_t WS_BONUS = 2 * MiB;
constexpr size_t WS_GAB = 3 * MiB + 512 * 1024;
constexpr size_t WS_AB = 6 * MiB;
constexpr size_t WS_ROPE = 8 * MiB + 512 * 1024;
constexpr size_t WS_GCH = 10 * MiB + 512 * 1024;
constexpr size_t WS_W = 12 * MiB;
constexpr size_t W_IN = 0, W_OUT = W_IN + (size_t)NIN * 1024 * 2, W_FF1 = W_OUT + 1024 * 1024 * 2, W_FF2 = W_FF1 + 4096 * 1024 * 2,
                 W_GATE = W_FF2 + 4096 * 1024 * 2, W_PP = W_GATE + 1024 * 1024 * 2, W_LR = W_PP + 1024 * 256 * 2, W_END = W_LR + 768 * 256 * 2;
constexpr size_t WS_SLOT = 41 * MiB;
constexpr size_t USLOT = (size_t)MPAD * 1024;
static_assert(WS_W + W_END <= WS_SLOT, "weights");
constexpr size_t WS_PAIRC = WS_SLOT + 15 * USLOT;
constexpr size_t WS_PAIRD = WS_PAIRC + 4 * (size_t)(MPAD / 2) * 16;
constexpr size_t WS_TOTAL = WS_PAIRD + 4 * (size_t)(MPAD / 2) * 8;
static_assert(WS_TOTAL <= (size_t)1024 * MiB, "ws");
static_assert(WS_RS + 7 * (size_t)MPAD * 4 <= WS_BONUS && WS_BONUS + 4 * (size_t)MPAD * 4 <= WS_GAB && WS_GAB + 8 * (size_t)MPAD * 4 <= WS_AB && WS_AB + 8 * (size_t)MPAD * 4 <= WS_ROPE && WS_ROPE + 8192 * 64 * 4 <= WS_GCH && WS_GCH + 4 * 1032 * 64 * 4 <= WS_W, "ctl map");

__device__ __forceinline__ unsigned char* slotp(unsigned char* ws, int l, int s) {
    if (l & 1) { if (s < 2) s += 13; else if (s >= 13) s -= 13; }
    return ws + WS_SLOT + (size_t)s * USLOT;
}
__device__ __forceinline__ unsigned char* slotph(unsigned char* ws, int l, int s) { return slotp(ws, l, s) + USLOT / 2; }

constexpr int RING_BYTES = 131072, MISC_OFF = RING_BYTES + 320, LDS_BYTES = 147456;

#define LDS_WAIT() asm volatile("s_waitcnt lgkmcnt(0)" ::: "memory")
__device__ __forceinline__ float bf2f(unsigned short u) { return __uint_as_float(((unsigned)u) << 16); }
__device__ __forceinline__ unsigned f2bf(float f) { unsigned u = __builtin_bit_cast(unsigned, f); return (u + 0x7fffu + ((u >> 16) & 1u)) >> 16; }
__device__ __forceinline__ unsigned pk2(float lo, float hi) { return f2bf(lo) | (f2bf(hi) << 16); }
#define DPP_ROR_ADD(v, ctrl) ((v) + __builtin_bit_cast(float, __builtin_amdgcn_update_dpp(0, __builtin_bit_cast(int, (v)), (ctrl), 0xf, 0xf, false)))
__device__ __forceinline__ float wave_sum(float v) {
    v = DPP_ROR_ADD(v, 0x128); v = DPP_ROR_ADD(v, 0x124); v = DPP_ROR_ADD(v, 0x122); v = DPP_ROR_ADD(v, 0x121);
    v += __shfl_xor(v, 16);
    const unsigned u = __float_as_uint(v); auto rr = __builtin_amdgcn_permlane32_swap(u, u, false, false);
    return __uint_as_float(rr[0]) + __uint_as_float(rr[1]);
}
__device__ __forceinline__ float sigm(float x) { return 1.f / (1.f + __expf(-x)); }
__device__ __forceinline__ float softplusf(float x) { return x > 20.f ? x : log1pf(__expf(x)); }

struct Args { const float* in[40]; float* out; unsigned char* ws; int ph_lo, ph_hi; };
typedef const __attribute__((address_space(4))) Args* KArgs;

constexpr float ATT_C2 = 0.125f * 1.4426950408889634f;
struct EpiG1 {
    static constexpr bool PERM = false, AFTER_DRAIN = false;
    const float* rs; bfu *aqkvz, *qb, *kb, *vb, *craw; float* ab; const float* rope; float *okp, *ovp, *oks, *ovs;
    __device__ __forceinline__ void operator()(const pg8::f32x4 (&acc)[2][2][4][2], const pg8::Unit& u, int wr, int wc, int fr, int fq) const {
        const int pn = u.pn; const int rowb = u.pm * 256 + wr * 64 + fr; const int cl = wc * 32 + 4 * fq;
#pragma unroll
        for (int ai = 0; ai < 2; ++ai)
#pragma unroll
            for (int m = 0; m < 4; ++m) {
                const int row = rowb + ai * 128 + m * 16;
                const float s = rsqrtf(rs[row] * (1.f / 1024.f) + 1e-6f);
                if (pn < 4 || (pn >= 10 && pn < 14)) {
                    bfu* dst = (pn < 4 ? aqkvz + pn * 256 : craw + (pn - 10) * 256) + (size_t)row * 1024 + cl;
#pragma unroll
                    for (int bj = 0; bj < 2; ++bj)
#pragma unroll
                        for (int n = 0; n < 2; ++n) { const pg8::f32x4 v = acc[ai][bj][m][n] * s; v2u w; w.x = pg8::cvt_pk_bf16(v[0], v[1]); w.y = pg8::cvt_pk_bf16(v[2], v[3]); *(v2u*)(dst + bj * 128 + n * 16) = w; }
                } else if (pn < 8) {
                    const bool isk = pn >= 6;
                    const int pos = row < MP ? (row & 8191) : 2048 + ((row - MP) & 15);
                    const int i0 = (wc & 1) * 16 + 4 * fq;
                    const pg8::f32x4 c4 = *(const pg8::f32x4*)(rope + pos * 64 + i0), s4 = *(const pg8::f32x4*)(rope + pos * 64 + 32 + i0);
#pragma unroll
                    for (int bj = 0; bj < 2; ++bj) {
                        const pg8::f32x4 x1 = acc[ai][bj][m][0] * s, x2 = acc[ai][bj][m][1] * s;
                        pg8::f32x4 o1 = x1 * c4 - x2 * s4, o2 = x2 * c4 + x1 * s4;
                        if (!isk) {
                            o1 = o1 * ATT_C2; o2 = o2 * ATT_C2;
                            bfu* d = qb + (size_t)row * 512 + (pn - 4) * 256 + bj * 128 + cl;
                            v2u w; w.x = pg8::cvt_pk_bf16(o1[0], o1[1]); w.y = pg8::cvt_pk_bf16(o1[2], o1[3]); *(v2u*)d = w;
                            w.x = pg8::cvt_pk_bf16(o2[0], o2[1]); w.y = pg8::cvt_pk_bf16(o2[2], o2[3]); *(v2u*)(d + 16) = w;
                        } else {
                            bfu* d = kb + (size_t)row * 512 + (pn - 6) * 256 + bj * 128 + cl;
                            v2u w; w.x = pg8::cvt_pk_bf16(o1[0], o1[1]); w.y = pg8::cvt_pk_bf16(o1[2], o1[3]); *(v2u*)d = w;
                            w.x = pg8::cvt_pk_bf16(o2[0], o2[1]); w.y = pg8::cvt_pk_bf16(o2[2], o2[3]); *(v2u*)(d + 16) = w;
                            if (row < MR) {
                                float* ob = (row < MP ? okp + (size_t)row * 512 : oks + (size_t)(row - MP) * 512) + (pn - 6) * 256 + bj * 128 + (wc >> 1) * 64 + (wc & 1) * 16 + 4 * fq;
                                *(pg8::f32x4*)ob = o1; *(pg8::f32x4*)(ob + 32) = o2;
                            }
                        }
                    }
                } else if (pn < 10) {
#pragma unroll
                    for (int bj = 0; bj < 2; ++bj)
#pragma unroll
                        for (int n = 0; n < 2; ++n) {
                            const pg8::f32x4 v = acc[ai][bj][m][n] * s; const int col = (pn - 8) * 256 + bj * 128 + cl + n * 16;
                            v2u w; w.x = pg8::cvt_pk_bf16(v[0], v[1]); w.y = pg8::cvt_pk_bf16(v[2], v[3]); *(v2u*)(vb + (size_t)row * 512 + col) = w;
                            if (row < MR) { float* ob = (row < MP ? ovp + (size_t)row * 512 : ovs + (size_t)(row - MP) * 512) + col; *(pg8::f32x4*)ob = v; }
                        }
                } else {
                    if (wc == 0 && fq < 2) { const pg8::f32x4 v = acc[ai][0][m][0] * s; *(pg8::f32x4*)(ab + (size_t)row * 8 + 4 * fq) = v; }
                }
            }
    }
};
template <int MODE> struct EpiB {
    static constexpr bool PERM = false, AFTER_DRAIN = false;
    bfu* O; int ldc; const float* rs;
    __device__ __forceinline__ void operator()(const pg8::f32x4 (&acc)[2][2][4][2], const pg8::Unit& u, int wr, int wc, int fr, int fq) const {
        const int rowb = u.pm * 256 + wr * 64 + fr; const int cl = u.pn * 256 + wc * 32 + 4 * fq;
#pragma unroll
        for (int ai = 0; ai < 2; ++ai)
#pragma unroll
            for (int m = 0; m < 4; ++m) {
                const int row = rowb + ai * 128 + m * 16;
                float s = 1.f; if (MODE == 1) s = rsqrtf(rs[row] * (1.f / 1024.f) + 1e-6f);
                bfu* dst = O + (size_t)row * ldc + cl;
#pragma unroll
                for (int bj = 0; bj < 2; ++bj)
#pragma unroll
                    for (int n = 0; n < 2; ++n) {
                        pg8::f32x4 v = acc[ai][bj][m][n];
                        if (MODE == 1) { v = v * s; v[0] = fmaxf(v[0], 0.f); v[1] = fmaxf(v[1], 0.f); v[2] = fmaxf(v[2], 0.f); v[3] = fmaxf(v[3], 0.f); v = v * v; }
                        v2u w; w.x = pg8::cvt_pk_bf16(v[0], v[1]); w.y = pg8::cvt_pk_bf16(v[2], v[3]); *(v2u*)(dst + bj * 128 + n * 16) = w;
                    }
            }
    }
};
template <int MODE> struct EpiH {
    static constexpr bool PERM = false, AFTER_DRAIN = false;
    float* H; bfu* xh; float* rsn; const float* rs; const bfu* pp;
    __device__ __forceinline__ void operator()(const pg8::f32x4 (&acc)[2][2][4][2], const pg8::Unit& u, int wr, int wc, int fr, int fq) const {
        const int rowb = u.pm * 256 + wr * 64 + fr; const int cl = u.pn * 256 + wc * 32 + 4 * fq;
#pragma unroll
        for (int ai = 0; ai < 2; ++ai)
#pragma unroll
            for (int m = 0; m < 4; ++m) {
                const int row = rowb + ai * 128 + m * 16; const bool valid = row < MR; float ss = 0.f;
                if (valid) {
                    float s = 1.f; if (MODE == 3) s = rsqrtf(rs[row] * (1.f / 1024.f) + 1e-6f);
#pragma unroll
                    for (int bj = 0; bj < 2; ++bj)
#pragma unroll
                        for (int n = 0; n < 2; ++n) {
                            const size_t off = (size_t)row * 1024 + cl + bj * 128 + n * 16;
                            pg8::f32x4 h = *(const pg8::f32x4*)(H + off); const pg8::f32x4 a = acc[ai][bj][m][n];
                            if (MODE == 3) { const v2u pw = *(const v2u*)(pp + off);
                                h[0] += sigm(a[0] * s) * __uint_as_float(pw.x << 16); h[1] += sigm(a[1] * s) * __uint_as_float(pw.x & 0xffff0000u);
                                h[2] += sigm(a[2] * s) * __uint_as_float(pw.y << 16); h[3] += sigm(a[3] * s) * __uint_as_float(pw.y & 0xffff0000u);
                            } else h = h + a;
                            *(pg8::f32x4*)(H + off) = h;
                            v2u w; w.x = pg8::cvt_pk_bf16(h[0], h[1]); w.y = pg8::cvt_pk_bf16(h[2], h[3]); *(v2u*)(xh + off) = w;
                            ss += (h[0] * h[0] + h[1] * h[1]) + (h[2] * h[2] + h[3] * h[3]);
                        }
                }
                ss += __shfl_xor(ss, 16); ss += __shfl_xor(ss, 32);
                if (valid && fq == 0) unsafeAtomicAdd(rsn + row, ss);
            }
    }
};

__device__ __forceinline__ int win_src(int nd) {
    if (nd < 1024) return nd;
    if (nd < 2048) { const int c = nd - 1024, p = c & 63, grp = c >> 6; const int s = p >> 5, n_ = (p >> 4) & 1, r = p & 15; return 1032 + grp * 64 + n_ * 32 + s * 16 + r; }
    if (nd < 2560) return 2056 + (nd - 2048);
    if (nd < 3584) return 2568 + (nd - 2560);
    if (nd < 3592) return 1024 + (nd - 3584);
    return -1;
}
template <bool MAP> __device__ __forceinline__ void wt_item(const float* W, int K, int Nsrc, bfu* WT, const float* gain, LAS float* scr, int item, int nblk, int lane) {
    const int kb = item / nblk, nb = item % nblk, k0 = 64 * kb, n0 = 32 * nb;
    const int nd = n0 + (lane & 31); const int src = MAP ? win_src(nd) : nd;
#pragma unroll 8
    for (int i = 0; i < 32; ++i) { const int kk = 2 * i + (lane >> 5); float v = src >= 0 ? W[(size_t)(k0 + kk) * Nsrc + src] : 0.f; if (gain) v *= gain[k0 + kk]; scr[kk * 33 + (lane & 31)] = v; }
    LDS_WAIT(); asm volatile("" ::: "memory");
    const int c = lane & 7;
#pragma unroll
    for (int j = 0; j < 4; ++j) { const int n = (lane >> 3) + 8 * j; const LAS float* s = scr + (8 * c) * 33 + n;
        v4u o; o.x = pk2(s[0 * 33], s[1 * 33]); o.y = pk2(s[2 * 33], s[3 * 33]); o.z = pk2(s[4 * 33], s[5 * 33]); o.w = pk2(s[6 * 33], s[7 * 33]);
        *(v4u*)(WT + (size_t)(n0 + n) * K + k0 + 8 * c) = o; }
    LDS_WAIT(); asm volatile("" ::: "memory");
}
__device__ __forceinline__ void conv_weights(KArgs A, int l, int mask, LAS unsigned char* lds, int gw, int NGW, int lane, int wave) {
    LAS float* scr = (LAS float*)(lds + wave * 16384);
    unsigned char* wb = A->ws + WS_W;
    if (mask & 1) {
        const float* win = A->in[11] + (size_t)l * 1024 * 3592; const float* g = A->in[10] + l * 1024;
        for (int it = gw; it < 16 * 120; it += NGW) wt_item<true>(win, 1024, 3592, (bfu*)(wb + W_IN), g, scr, it, 120, lane);
        const float* wu = A->in[23] + (size_t)l * 64 * 256; const float* au = A->in[25] + (size_t)l * 64 * 256; const float* gu = A->in[26] + (size_t)l * 128 * 256;
        bfu* lr = (bfu*)(wb + W_LR);
        for (int i = gw * 64 + lane; i < 768 * 256; i += NGW * 64) { const int n = i >> 8, k = i & 255; float v = 0.f;
            if (n < 256) { if (k < 64) v = wu[k * 256 + n]; } else if (n < 512) { if (k >= 64 && k < 128) v = au[(k - 64) * 256 + (n - 256)]; } else { if (k >= 128) v = gu[(k - 128) * 256 + (n - 512)]; }
            lr[i] = (bfu)f2bf(v); }
    }
    if (mask & 2) {
        const float* wo = A->in[32] + (size_t)l * 1024 * 1024; const float* f1 = A->in[34] + (size_t)l * 1024 * 4096; const float* f2 = A->in[35] + (size_t)l * 4096 * 1024;
        const float* wg = A->in[37] + (size_t)l * 1024 * 1024; const float* wp = A->in[38] + (size_t)l * 256 * 1024;
        const float* gf = A->in[33] + l * 1024; const float* gp = A->in[36] + l * 1024;
        constexpr int I_O = 16 * 32, I_1 = 16 * 128, I_2 = 64 * 32, I_G = 16 * 32, I_P = 4 * 32;
        for (int it = gw; it < I_O + I_1 + I_2 + I_G + I_P; it += NGW) {
            int r = it;
            if (r < I_O) { wt_item<false>(wo, 1024, 1024, (bfu*)(wb + W_OUT), nullptr, scr, r, 32, lane); continue; } r -= I_O;
            if (r < I_1) { wt_item<false>(f1, 1024, 4096, (bfu*)(wb + W_FF1), gf, scr, r, 128, lane); continue; } r -= I_1;
            if (r < I_2) { wt_item<false>(f2, 4096, 1024, (bfu*)(wb + W_FF2), nullptr, scr, r, 32, lane); continue; } r -= I_2;
            if (r < I_G) { wt_item<false>(wg, 1024, 1024, (bfu*)(wb + W_GATE), gp, scr, r, 32, lane); continue; } r -= I_G;
            wt_item<false>(wp, 256, 1024, (bfu*)(wb + W_PP), nullptr, scr, r, 32, lane);
        }
    }
}
__device__ __forceinline__ void conv_p(KArgs A, int l, bfu* pb, int gtid, int NT) {
    const float* pp = A->in[8] + (size_t)l * MP * 256; const float* ps = A->in[9] + (size_t)l * MS * 256;
    for (int i = gtid; i < MR * 64; i += NT) { const int m = i >> 6, c = (i & 63) * 4;
        const f32x4 v = *(const f32x4*)(m < MP ? pp + (size_t)m * 256 + c : ps + (size_t)(m - MP) * 256 + c);
        v2u w; w.x = pk2(v[0], v[1]); w.y = pk2(v[2], v[3]); *(v2u*)(pb + (size_t)m * 256 + c) = w; }
}
__device__ __forceinline__ void prologue(KArgs A, LAS unsigned char* lds, int gw, int NGW, int lane, int wave, int gtid, int NT) {
    conv_weights(A, 0, 3, lds, gw, NGW, lane, wave);
    unsigned char* ws = A->ws;
    float* rs = (float*)(ws + WS_RS); bfu* xh = (bfu*)slotp(ws, 0, 0); float* H = A->out;
    for (int i = gtid; i < 6 * MPAD; i += NT) rs[MPAD + i] = 0.f;
    for (int m = gw; m < MPAD; m += NGW) {
        if (m < MR) {
            const float* xr = m < MP ? A->in[0] + (size_t)m * 1024 : A->in[1] + (size_t)(m - MP) * 1024; float ss = 0.f;
#pragma unroll
            for (int j = 0; j < 4; ++j) { const f32x4 v = *(const f32x4*)(xr + j * 256 + lane * 4); *(f32x4*)(H + (size_t)m * 1024 + j * 256 + lane * 4) = v;
                v2u w; w.x = pk2(v[0], v[1]); w.y = pk2(v[2], v[3]); *(v2u*)(xh + (size_t)m * 1024 + j * 256 + lane * 4) = w; ss += (v[0] * v[0] + v[1] * v[1]) + (v[2] * v[2] + v[3] * v[3]); }
            ss = wave_sum(ss); if (lane == 0) rs[m] = ss;
        } else {
#pragma unroll
            for (int j = 0; j < 4; ++j) *(v2u*)(xh + (size_t)m * 1024 + j * 256 + lane * 4) = (v2u){0u, 0u};
            if (lane == 0) rs[m] = 1024.f;
        }
    }
    float* rope = (float*)(ws + WS_ROPE);
    for (int i = gtid; i < 8192 * 32; i += NT) { const int pos = i >> 5, k = i & 31;
        const float inv = exp2f(-(float)k * (13.287712379549449f / 32.0f)); const float ang = (float)pos * inv;
        const float nn = rintf(ang * 0.15915494309189535f); const float fr = fmaf(-nn, 1.9353071795864769e-3f, fmaf(-nn, 6.28125f, ang));
        rope[pos * 64 + k] = __cosf(fr); rope[pos * 64 + 32 + k] = __sinf(fr); }
    if (gw == 0) {
        for (int l = 0; l < 2; ++l) {
            const float a = wave_sum(A->in[16][l * 64 + lane] * A->in[17][l * 64 + lane]), b = wave_sum(A->in[18][l * 64 + lane] * A->in[19][l * 64 + lane]);
            const float li = 0.8f - 0.6f * expf(-0.3f * (float)l);
            if (lane == 0) { float* lf = (float*)(ws + WS_CTL + 1024); lf[2 * l] = expf(a) - expf(b) + li; lf[2 * l + 1] = li; }
        }
    }
}

__device__ __forceinline__ void prep_a(KArgs A, int l, int gw, int NGW, int lane) {
    unsigned char* ws = A->ws;
    const bfu* aq = (const bfu*)slotp(ws, l, 2); const float* ab = (const float*)(ws + WS_AB);
    float* sia = (float*)slotp(ws, l, 9); bfu* va = (bfu*)slotp(ws, l, 11); bfu* zs = (bfu*)slotph(ws, l, 11); float* gab = (float*)(ws + WS_GAB);
    const float* cw = A->in[12] + l * 4 * 768; const float* stc = A->in[4] + (size_t)l * 8 * 3 * 768;
    const float* anorm = A->in[15] + l * 64;
    for (int m = gw; m < MR; m += NGW) {
        int t, L, sb = 0; const bool smp = m >= MP; float* aco;
        if (!smp) { t = m & 8191; L = 8192; aco = A->out + O_ACP + ((size_t)(l * 8 + (m >> 13)) * 3) * 768; }
        else { sb = (m - MP) >> 4; t = (m - MP) & 15; L = 16; aco = A->out + O_ACS + ((size_t)(l * 8 + sb) * 3) * 768; }
#pragma unroll 1
        for (int h = 0; h < 4; ++h) {
            float val[3];
#pragma unroll
            for (int g = 0; g < 3; ++g) {
                const int c = g * 256 + h * 64 + lane; float x[4];
#pragma unroll
                for (int d = 0; d < 4; ++d) { const int tt = t - d;
                    x[d] = tt >= 0 ? bf2f(aq[(size_t)(m - d) * 1024 + c]) : (smp ? stc[((size_t)sb * 3 + (3 + tt)) * 768 + c] : 0.f); }
                const float y = x[3] * cw[c] + x[2] * cw[768 + c] + x[1] * cw[1536 + c] + x[0] * cw[2304 + c];
                val[g] = y * sigm(y);
                if (t >= L - 3) aco[(size_t)(t - (L - 3)) * 768 + c] = x[0];
            }
            const float sq = wave_sum(val[0] * val[0]), sk = wave_sum(val[1] * val[1]);
            const float qn = val[0] * rsqrtf(sq + 1e-6f) * 0.125f, kn = val[1] * rsqrtf(sk + 1e-6f);
            float* rec = sia + ((size_t)(h * 8 + (lane >> 3)) * MPAD + m) * 16 + (lane & 7);
            rec[0] = kn; rec[8] = qn;
            va[(size_t)m * 256 + h * 64 + lane] = (bfu)f2bf(val[2]);
            const float z = bf2f(aq[(size_t)m * 1024 + 768 + h * 64 + lane]);
            zs[(size_t)m * 256 + h * 64 + lane] = (bfu)f2bf(z * sigm(z) * anorm[lane]);
        }
        if (lane < 4) { const int h = lane;
            const float g = -__expf(A->in[13][l * 4 + h]) * softplusf(ab[(size_t)m * 8 + h] + A->in[14][l * 4 + h]);
            gab[((size_t)h * MPAD + m) * 2] = __expf(g); gab[((size_t)h * MPAD + m) * 2 + 1] = sigm(ab[(size_t)m * 8 + 4 + h]); }
    }
}
__device__ __forceinline__ void prep_c1(KArgs A, int l, int gw, int NGW, int lane) {
    unsigned char* ws = A->ws;
    const bfu* cr = (const bfu*)slotp(ws, l, 7); bfu* lra = (bfu*)slotp(ws, l, 12);
    const float* mu = A->in[21] + l * 1024; const float* sts = A->in[6] + (size_t)l * 8 * 1024;
    for (int m = gw; m < MR; m += NGW) {
        int t, L, sb = 0; const bool smp = m >= MP; float* cso;
        if (!smp) { t = m & 8191; L = 8192; cso = A->out + O_CSP + (size_t)(l * 8 + (m >> 13)) * 1024; }
        else { sb = (m - MP) >> 4; t = (m - MP) & 15; L = 16; cso = A->out + O_CSS + (size_t)(l * 8 + sb) * 1024; }
#pragma unroll
        for (int i = 0; i < 4; ++i) { const int j = 768 + lane + 64 * i;
            const float cur = bf2f(cr[(size_t)m * 1024 + j]);
            const float prev = t > 0 ? bf2f(cr[(size_t)(m - 1) * 1024 + j]) : (smp ? sts[(size_t)sb * 1024 + j] : 0.f);
            const float c = cur + (prev - cur) * mu[j];
            const float o = i == 0 ? tanhf(c) : (i == 1 ? c : sigm(c));
            lra[(size_t)m * 256 + lane + 64 * i] = (bfu)f2bf(o); }
        if (t == L - 1) {
#pragma unroll
            for (int i = 0; i < 16; ++i) cso[lane + 64 * i] = bf2f(cr[(size_t)m * 1024 + lane + 64 * i]);
        }
    }
}
__device__ __forceinline__ void prep_c2(KArgs A, int l, int bid, int G, int tid) {
    unsigned char* ws = A->ws;
    const bfu* cr = (const bfu*)slotp(ws, l, 7); const bfu* lro = (const bfu*)slotp(ws, l, 13);
    bfu* v2 = (bfu*)slotp(ws, l, 12); bfu* gg = (bfu*)slotph(ws, l, 12);
    float* bonus = (float*)(ws + WS_BONUS); float* gch = (float*)(ws + WS_GCH); float* pairc = (float*)(ws + WS_PAIRC);
    const float* mu = A->in[21] + l * 1024; const float* sts = A->in[6] + (size_t)l * 8 * 1024;
    const int ch = tid & 255, h = ch >> 6, lane = ch & 63, half = tid >> 8;
    float* sic = (float*)slotp(ws, l, h) + ((size_t)(lane >> 3) * MPAD) * 32 + (lane & 7);
    const float mur = mu[ch], muk = mu[256 + ch], muv = mu[512 + ch];
    const float w0 = A->in[22][l * 256 + ch], a0 = A->in[24][l * 256 + ch], kk_ = A->in[27][l * 256 + ch], ka = A->in[28][l * 256 + ch], rk = A->in[29][l * 256 + ch];
    for (int u = bid * 2 + half; u < 1032; u += G * 2) {
        int m0, n; float pr, pk, pv;
        if (u < 1024) { m0 = u * 64; n = 64;
            if ((u & 127) == 0) { pr = pk = pv = 0.f; } else { pr = bf2f(cr[(size_t)(m0 - 1) * 1024 + ch]); pk = bf2f(cr[(size_t)(m0 - 1) * 1024 + 256 + ch]); pv = bf2f(cr[(size_t)(m0 - 1) * 1024 + 512 + ch]); } }
        else { const int sb = u - 1024; m0 = MP + sb * 16; n = 16; pr = sts[(size_t)sb * 1024 + ch]; pk = sts[(size_t)sb * 1024 + 256 + ch]; pv = sts[(size_t)sb * 1024 + 512 + ch]; }
        float cum = 0.f, pkka = 0.f, pkp = 0.f;
#pragma unroll 4
        for (int tt = 0; tt < n; ++tt) { const int m = m0 + tt;
            const float c_r = bf2f(cr[(size_t)m * 1024 + ch]), c_k = bf2f(cr[(size_t)m * 1024 + 256 + ch]), c_v = bf2f(cr[(size_t)m * 1024 + 512 + ch]);
            const float r = c_r + (pr - c_r) * mur, k = c_k + (pk - c_k) * muk, v = c_v + (pv - c_v) * muv; pr = c_r; pk = c_k; pv = c_v;
            const float lw = bf2f(lro[(size_t)m * 768 + ch]), la = bf2f(lro[(size_t)m * 768 + 256 + ch]); const bfu gb = lro[(size_t)m * 768 + 512 + ch];
            const float wl = -0.6065306597126334f * sigm(w0 + lw); const float a = sigm(a0 + la);
            const float kkr = k * kk_; const float kk = kkr * rsqrtf(wave_sum(kkr * kkr) + 1e-6f);
            const float kp = k * (1.f + (a - 1.f) * ka);
            const float Gp = __expf(cum); cum += wl; const float Gc = __expf(cum), iG = __expf(-cum);
            float* rec = sic + (size_t)m * 32;
            rec[0] = kk * Gp; rec[8] = kk * a * iG; rec[16] = kp * iG; rec[24] = r * Gc;
            { const float kka = kk * a; float* pc = pairc + ((size_t)h * (MPAD / 2) + (m >> 1)) * 4;
              if (tt & 1) { const float c22 = wave_sum(pkka * kk), c32 = wave_sum(pkp * kk); if (lane == 0) { pc[0] = c22; pc[1] = c32; } }
              else { const float c24 = wave_sum(kka * r), c34 = wave_sum(kp * r); if (lane == 0) { pc[2] = c24; pc[3] = c34; } }
              pkka = kka; pkp = kp; }
            const float bo = wave_sum(r * kp * rk); if (lane == 0) bonus[(size_t)h * MPAD + m] = bo;
            v2[(size_t)m * 256 + ch] = (bfu)f2bf(v); gg[(size_t)m * 256 + ch] = gb;
        }
        gch[((size_t)h * 1032 + u) * 64 + lane] = __expf(cum);
    }
}
__device__ __forceinline__ void prep_a2(KArgs A, int l, int gw, int NGW, int lane) {
    unsigned char* ws = A->ws; const float* sia = (const float*)slotp(ws, l, 9); float* paird = (float*)(ws + WS_PAIRD);
    for (int task = gw; task < 4 * (MR / 2); task += NGW) { const int h = task & 3, pr = task >> 2, m = 2 * pr;
        const float* rec = sia + ((size_t)(h * 8 + (lane >> 3)) * MPAD + m) * 16 + (lane & 7);
        const float k1 = rec[0], q1 = rec[8], k2 = rec[16];
        const float g12 = wave_sum(k1 * k2), h11 = wave_sum(q1 * k1);
        if (lane == 0) { paird[((size_t)h * (MPAD / 2) + pr) * 2] = g12; paird[((size_t)h * (MPAD / 2) + pr) * 2 + 1] = h11; } }
}
__device__ __forceinline__ void post_attn(KArgs A, int l, int gw, int NGW, int lane) {
    unsigned char* ws = A->ws;
    const bfu* O = (const bfu*)slotp(ws, l, 13); bfu* mix = (bfu*)slotp(ws, l, 7);
    const float* lf = (const float*)(ws + WS_CTL + 1024); const float lam = lf[2 * l], omli = 1.f - lf[2 * l + 1];
    const int h = lane >> 4, e0 = (lane & 15) * 8; const float* bn = A->in[20] + l * 128 + e0;
    float bnv[8];
#pragma unroll
    for (int i = 0; i < 8; ++i) bnv[i] = bn[i] * omli;
    for (int m = gw; m < MP; m += NGW) {
        const v4u a = *(const v4u*)(O + (size_t)m * 1024 + (4 * h + (e0 >> 6)) * 64 + (e0 & 63));
        const v4u b = *(const v4u*)(O + (size_t)m * 1024 + (4 * h + 2 + (e0 >> 6)) * 64 + (e0 & 63));
        float o[8]; float ss = 0.f;
#pragma unroll
        for (int i = 0; i < 4; ++i) { const unsigned aw = a[i], bw = b[i];
            o[2 * i] = __uint_as_float(aw << 16) - lam * __uint_as_float(bw << 16); o[2 * i + 1] = __uint_as_float(aw & 0xffff0000u) - lam * __uint_as_float(bw & 0xffff0000u);
            ss += o[2 * i] * o[2 * i] + o[2 * i + 1] * o[2 * i + 1]; }
        ss += __shfl_xor(ss, 1); ss += __shfl_xor(ss, 2); ss += __shfl_xor(ss, 4); ss += __shfl_xor(ss, 8);
        const float rn = rsqrtf(ss * (1.f / 128.f) + 1e-6f);
        v4u w; w.x = pk2(o[0] * rn * bnv[0], o[1] * rn * bnv[1]); w.y = pk2(o[2] * rn * bnv[2], o[3] * rn * bnv[3]); w.z = pk2(o[4] * rn * bnv[4], o[5] * rn * bnv[5]); w.w = pk2(o[6] * rn * bnv[6], o[7] * rn * bnv[7]);
        *(v4u*)(mix + (size_t)m * 1024 + 256 + h * 128 + e0) = w;
    }
}
__device__ __forceinline__ void final_norm(KArgs A, int gw, int NGW, int lane) {
    const float* rs = (const float*)(A->ws + WS_RS) + 6 * (size_t)MPAD; const float* g = A->in[39];
    for (int m = gw; m < MR; m += NGW) { const float s = rsqrtf(rs[m] * (1.f / 1024.f) + 1e-6f);
#pragma unroll
        for (int j = 0; j < 4; ++j) { float* p = A->out + (size_t)m * 1024 + j * 256 + lane * 4; f32x4 v = *(f32x4*)p; const f32x4 gv = *(const f32x4*)(g + j * 256 + lane * 4); v = v * s * gv; *(f32x4*)p = v; } }
}

#define SC_BAR() asm volatile("s_waitcnt lgkmcnt(0)\n\ts_barrier" ::: "memory")
constexpr int SC_RED = 0, SC_SI = 16384, SC_VBUF = 81920, SC_GBUF = 90112, SC_BON = 98304, SC_PC = 98816, SC_YP = 99328;
#define FMAC_DPP(acc, op, s1, J) asm("v_fmac_f32_dpp %0, %1, %2 row_newbcast:" #J " row_mask:0xf bank_mask:0xf" : "+v"(acc) : "v"(op), "v"(s1))
#define DOT8(a0, a1, op, JB0, JB1, JB2, JB3, JB4, JB5, JB6, JB7) do { FMAC_DPP(a0, op, S[0], JB0); FMAC_DPP(a1, op, S[1], JB1); FMAC_DPP(a0, op, S[2], JB2); FMAC_DPP(a1, op, S[3], JB3); \
        FMAC_DPP(a0, op, S[4], JB4); FMAC_DPP(a1, op, S[5], JB5); FMAC_DPP(a0, op, S[6], JB6); FMAC_DPP(a1, op, S[7], JB7); } while (0)
#define DOT8_LO(a0, a1, op) DOT8(a0, a1, op, 0, 1, 2, 3, 4, 5, 6, 7)
#define DOT8_HI(a0, a1, op) DOT8(a0, a1, op, 8, 9, 10, 11, 12, 13, 14, 15)
#define AXPY8_LO(op, s) do { FMAC_DPP(S[0], op, s, 0); FMAC_DPP(S[1], op, s, 1); FMAC_DPP(S[2], op, s, 2); FMAC_DPP(S[3], op, s, 3); FMAC_DPP(S[4], op, s, 4); FMAC_DPP(S[5], op, s, 5); FMAC_DPP(S[6], op, s, 6); FMAC_DPP(S[7], op, s, 7); } while (0)
#define AXPY8_HI(op, s) do { FMAC_DPP(S[0], op, s, 8); FMAC_DPP(S[1], op, s, 9); FMAC_DPP(S[2], op, s, 10); FMAC_DPP(S[3], op, s, 11); FMAC_DPP(S[4], op, s, 12); FMAC_DPP(S[5], op, s, 13); FMAC_DPP(S[6], op, s, 14); FMAC_DPP(S[7], op, s, 15); } while (0)
#define AXPYV(X0, X1, s) do { S[0] = fmaf(X0[0], s, S[0]); S[1] = fmaf(X0[1], s, S[1]); S[2] = fmaf(X0[2], s, S[2]); S[3] = fmaf(X0[3], s, S[3]); S[4] = fmaf(X1[0], s, S[4]); S[5] = fmaf(X1[1], s, S[5]); S[6] = fmaf(X1[2], s, S[6]); S[7] = fmaf(X1[3], s, S[7]); } while (0)
#define RED8(V) do { const LAS f32x4* rr_ = (const LAS f32x4*)red + par_ * 512 + lane; const f32x4 q0_ = rr_[0], q1_ = rr_[64], q2_ = rr_[128], q3_ = rr_[192], q4_ = rr_[256], q5_ = rr_[320], q6_ = rr_[384], q7_ = rr_[448]; \
        V = ((q0_ + q1_) + (q2_ + q3_)) + ((q4_ + q5_) + (q6_ + q7_)); } while (0)

__device__ __forceinline__ void scan_rwkv(KArgs A, int l, LAS unsigned char* lds, int h, int m0, int L, int BL, int BLS, int chunk0, const float* st_in, float* st_out, int tid) {
    unsigned char* ws = A->ws;
    const int lane = tid & 63, wid = __builtin_amdgcn_readfirstlane(tid >> 6);
    LAS float* red = (LAS float*)(lds + SC_RED); LAS float* yred = (LAS float*)(lds + SC_YP);
    LAS float* sib = (LAS float*)(lds + SC_SI) + wid * 1024;
    LAS bfu* vbuf = (LAS bfu*)(lds + SC_VBUF); LAS bfu* gbuf = (LAS bfu*)(lds + SC_GBUF); LAS float* bon = (LAS float*)(lds + SC_BON); LAS float* pcs = (LAS float*)(lds + SC_PC);
    const bfu* v2 = (const bfu*)slotp(ws, l, 12); const bfu* gg = (const bfu*)slotph(ws, l, 12);
    const float* bonus = (const float*)(ws + WS_BONUS) + (size_t)h * MPAD;
    const float* pairc = (const float*)(ws + WS_PAIRC) + ((size_t)h * (MPAD / 2) + (m0 >> 1)) * 4;
    const float* gch = (const float*)(ws + WS_GCH) + ((size_t)h * 1032 + chunk0) * 64 + 8 * wid;
    bfu* mix = (bfu*)slotp(ws, l, 7);
    const float* P = (const float*)slotp(ws, l, h) + ((size_t)wid * MPAD + m0) * 32;
    const float lnw = A->in[30][l * 256 + h * 64 + lane], lnb = A->in[31][l * 256 + h * 64 + lane];
    float S[8];
#pragma unroll
    for (int j = 0; j < 8; ++j) S[j] = st_in ? st_in[lane * 64 + 8 * wid + j] : 0.f;
    const int nblk = L >> BLS; const int srow = tid >> 4, sc4 = tid & 15; const bool sval = srow < BL;
    const int nsi = BL >> 3;
    f32x4 ssi[4]; v2u sv = {0, 0}, sg = {0, 0}; float sb_ = 0.f, sp_ = 0.f;
#define RW_STAGE(c) do { const float* ps_ = P + (size_t)(c) * BL * 32 + lane * 4; \
        _Pragma("unroll") for (int i_ = 0; i_ < 4; ++i_) if (i_ < nsi) ssi[i_] = *(const f32x4*)(ps_ + i_ * 256); \
        if (sval) { const size_t mm = (size_t)(m0 + (c) * BL + srow) * 256 + h * 64 + sc4 * 4; sv = *(const v2u*)(v2 + mm); sg = *(const v2u*)(gg + mm); } \
        if (tid < BL) sb_ = bonus[m0 + (c) * BL + tid]; if (tid < 2 * BL) sp_ = pairc[(size_t)(c) * BL * 2 + tid]; } while (0)
#define RW_COMMIT(c) do { LAS float* pd_ = sib + ((c) & 1) * 8192 + lane * 4; \
        _Pragma("unroll") for (int i_ = 0; i_ < 4; ++i_) if (i_ < nsi) *(LAS f32x4*)(pd_ + i_ * 256) = ssi[i_]; \
        if (sval) { *(LAS v2u*)(vbuf + ((c) & 1) * 2048 + srow * 64 + sc4 * 4) = sv; *(LAS v2u*)(gbuf + ((c) & 1) * 2048 + srow * 64 + sc4 * 4) = sg; } \
        if (tid < BL) bon[((c) & 1) * 32 + tid] = sb_; if (tid < 2 * BL) pcs[((c) & 1) * 64 + tid] = sp_; } while (0)
    __syncthreads();
    RW_STAGE(0); RW_COMMIT(0); if (nblk > 1) RW_STAGE(1);
    float ca0, ca1, cb0 = 0.f, cb1 = 0.f;
    f32x4 cau[8], cbu[8];
#define RW_LOADOPS(D, T) do { const LAS float* pb_ = sib + ((((T) >> BLS) & 1) * 8192) + ((T) & (BL - 1)) * 32; const LAS float* po_ = pb_ + (lane & 7) + ((lane & 8) ? 24 : 0); \
        D##0 = po_[0]; D##1 = po_[32]; const LAS f32x4* pu_ = (const LAS f32x4*)pb_; \
        D##u[0] = pu_[2]; D##u[1] = pu_[3]; D##u[2] = pu_[4]; D##u[3] = pu_[5]; D##u[4] = pu_[10]; D##u[5] = pu_[11]; D##u[6] = pu_[12]; D##u[7] = pu_[13]; } while (0)
    RW_LOADOPS(ca, 0);
#define RW_FINAL(T) do { const int tf_ = (T); const int ttf_ = tf_ & (BL - 1), bf_ = (tf_ >> BLS) & 1; \
        const LAS float* yr_ = yred + (tf_ & 15) * 512 + lane; const float y_ = ((yr_[0] + yr_[64]) + (yr_[128] + yr_[192])) + ((yr_[256] + yr_[320]) + (yr_[384] + yr_[448])); \
        const float mu_ = wave_sum(y_) * (1.f / 64.f); const float d_ = y_ - mu_; const float var_ = wave_sum(d_ * d_) * (1.f / 64.f); \
        const float cy_ = d_ * rsqrtf(var_ + 64e-5f) * lnw + lnb; \
        const float vv_ = bf2f(vbuf[bf_ * 2048 + ttf_ * 64 + lane]), g_ = bf2f(gbuf[bf_ * 2048 + ttf_ * 64 + lane]); \
        mix[(size_t)(m0 + tf_) * 1024 + 768 + h * 64 + lane] = (bfu)f2bf((cy_ + bon[bf_ * 32 + ttf_] * vv_) * g_); } while (0)
#define RW_ROUND(C, N, T) do { const int par_ = ((T) >> 1) & 1; \
        float d1a = 0.f, d1b = 0.f, d2a = 0.f, d2b = 0.f, f1a = 0.f, f1b = 0.f; \
        DOT8_LO(d1a, d1b, C##0); DOT8_LO(d2a, d2b, C##1); DOT8_HI(f1a, f1b, C##0); \
        ((LAS f32x4*)red)[(par_ * 8 + wid) * 64 + lane] = (f32x4){d1a + d1b, d2a + d2b, f1a + f1b, 0.f}; \
        SC_BAR(); \
        f32x4 tot_; RED8(tot_); \
        const int bo_ = (((T) >> BLS) & 1), to_ = (T) & (BL - 1); \
        const float v1 = bf2f(vbuf[bo_ * 2048 + to_ * 64 + lane]), v2_ = bf2f(vbuf[bo_ * 2048 + to_ * 64 + 64 + lane]); const f32x4 pc_ = *(const LAS f32x4*)(pcs + bo_ * 64 + to_ * 2); \
        asm volatile("" ::: "memory"); \
        if ((T) + 2 < L) RW_LOADOPS(N, (T) + 2); \
        const float sa1 = -tot_[0]; const float sa2 = -(tot_[1] + sa1 * pc_[0] + v1 * pc_[1]); const float y1 = tot_[2] + sa1 * pc_[2] + v1 * pc_[3]; \
        AXPYV(C##u[2], C##u[3], v1); AXPYV(C##u[0], C##u[1], sa1); AXPYV(C##u[6], C##u[7], v2_); AXPYV(C##u[4], C##u[5], sa2); \
        float y2a = 0.f, y2b = 0.f; DOT8_HI(y2a, y2b, C##1); \
        yred[((T) & 15) * 512 + wid * 64 + lane] = y1 * 0.125f; yred[(((T) + 1) & 15) * 512 + wid * 64 + lane] = y2a + y2b; } while (0)
    for (int c = 0; c < nblk; ++c) {
        for (int tt = 0; tt < BL; tt += 4) {
            const int t = c * BL + tt;
            if (tt == (BL >> 1) && c + 1 < nblk) { RW_COMMIT(c + 1); if (c + 2 < nblk) RW_STAGE(c + 2); }
            RW_ROUND(ca, cb, t);
            RW_ROUND(cb, ca, t + 2);
            if (((t + 3) & 15) == 15) { SC_BAR(); RW_FINAL(t - 12 + 2 * wid); RW_FINAL(t - 11 + 2 * wid); }
        }
        if ((((c + 1) << BLS) & 63) == 0 || c + 1 == nblk) {
            const float* ge = gch + (size_t)((c << BLS) >> 6) * 64;
#pragma unroll
            for (int j = 0; j < 8; ++j) S[j] *= ge[j];
        }
    }
#pragma unroll
    for (int j = 0; j < 8; ++j) st_out[lane * 64 + 8 * wid + j] = S[j];
    __syncthreads();
#undef RW_STAGE
#undef RW_COMMIT
#undef RW_LOADOPS
#undef RW_FINAL
#undef RW_ROUND
}

__device__ __forceinline__ void scan_delta(KArgs A, int l, LAS unsigned char* lds, int h, int m0, int L, int BL, int BLS, const float* st_in, float* st_out, int tid) {
    unsigned char* ws = A->ws;
    const int lane = tid & 63, wid = __builtin_amdgcn_readfirstlane(tid >> 6);
    LAS float* red = (LAS float*)(lds + SC_RED); LAS float* yred = (LAS float*)(lds + SC_YP);
    LAS float* sib = (LAS float*)(lds + SC_SI) + wid * 512;
    LAS bfu* vbuf = (LAS bfu*)(lds + SC_VBUF); LAS bfu* gbuf = (LAS bfu*)(lds + SC_GBUF); LAS float* gab = (LAS float*)(lds + SC_BON); LAS float* pds = (LAS float*)(lds + SC_PC);
    const bfu* va = (const bfu*)slotp(ws, l, 11); const bfu* zs = (const bfu*)slotph(ws, l, 11);
    bfu* mix = (bfu*)slotp(ws, l, 7);
    const float* P = (const float*)slotp(ws, l, 9) + ((size_t)(h * 8 + wid) * MPAD + m0) * 16;
    const float* PG = (const float*)(ws + WS_GAB) + ((size_t)h * MPAD + m0) * 2;
    const float* paird = (const float*)(ws + WS_PAIRD) + ((size_t)h * (MPAD / 2) + (m0 >> 1)) * 2;
    float S[8];
#pragma unroll
    for (int j = 0; j < 8; ++j) S[j] = st_in ? st_in[(8 * wid + j) * 64 + lane] : 0.f;
    const int nblk = L >> BLS; const int srow = tid >> 4, sc4 = tid & 15; const bool sval = srow < BL;
    const int nsi = BL >> 4;
    f32x4 ssi[2]; v2u sv = {0, 0}, sg = {0, 0}; float sb_ = 0.f, sp_ = 0.f;
#define DL_STAGE(c) do { const float* ps_ = P + (size_t)(c) * BL * 16 + lane * 4; \
        _Pragma("unroll") for (int i_ = 0; i_ < 2; ++i_) if (i_ < nsi) ssi[i_] = *(const f32x4*)(ps_ + i_ * 256); \
        if (sval) { const size_t mm = (size_t)(m0 + (c) * BL + srow) * 256 + h * 64 + sc4 * 4; sv = *(const v2u*)(va + mm); sg = *(const v2u*)(zs + mm); } \
        if (tid < 2 * BL) sb_ = PG[(size_t)(c) * BL * 2 + tid]; if (tid < BL) sp_ = paird[(size_t)(c) * BL + tid]; } while (0)
#define DL_COMMIT(c) do { LAS float* pd_ = sib + ((c) & 1) * 4096 + lane * 4; \
        _Pragma("unroll") for (int i_ = 0; i_ < 2; ++i_) if (i_ < nsi) *(LAS f32x4*)(pd_ + i_ * 256) = ssi[i_]; \
        if (sval) { *(LAS v2u*)(vbuf + ((c) & 1) * 2048 + srow * 64 + sc4 * 4) = sv; *(LAS v2u*)(gbuf + ((c) & 1) * 2048 + srow * 64 + sc4 * 4) = sg; } \
        if (tid < 2 * BL) gab[((c) & 1) * 64 + tid] = sb_; if (tid < BL) pds[((c) & 1) * 32 + tid] = sp_; } while (0)
    __syncthreads();
    DL_STAGE(0); DL_COMMIT(0); if (nblk > 1) DL_STAGE(1);
    float ca0, ca1, cb0 = 0.f, cb1 = 0.f;
    f32x4 cau[4], cbu[4];
#define DL_LOADOPS(D, T) do { const LAS float* pb_ = sib + ((((T) >> BLS) & 1) * 4096) + ((T) & (BL - 1)) * 16; const LAS float* po_ = pb_ + (lane & 15); D##0 = po_[0]; D##1 = po_[16]; \
        const LAS f32x4* pu_ = (const LAS f32x4*)pb_; D##u[0] = pu_[0]; D##u[1] = pu_[1]; D##u[2] = pu_[4]; D##u[3] = pu_[5]; } while (0)
    DL_LOADOPS(ca, 0);
#define DL_FINAL(T) do { const int tf_ = (T); const int ttf_ = tf_ & (BL - 1), bf_ = (tf_ >> BLS) & 1; \
        const LAS float* yr_ = yred + (tf_ & 15) * 512 + lane; const float o_ = ((yr_[0] + yr_[64]) + (yr_[128] + yr_[192])) + ((yr_[256] + yr_[320]) + (yr_[384] + yr_[448])); \
        const float ss_ = wave_sum(o_ * o_) * (1.f / 64.f); \
        mix[(size_t)(m0 + tf_) * 1024 + h * 64 + lane] = (bfu)f2bf(o_ * rsqrtf(ss_ + 1e-6f) * bf2f(gbuf[bf_ * 2048 + ttf_ * 64 + lane])); } while (0)
#define DL_ROUND(C, N, T) do { const int par_ = ((T) >> 1) & 1; \
        float d1a = 0.f, d1b = 0.f, d2a = 0.f, d2b = 0.f, f1a = 0.f, f1b = 0.f; \
        DOT8_LO(d1a, d1b, C##0); DOT8_LO(d2a, d2b, C##1); DOT8_HI(f1a, f1b, C##0); \
        ((LAS f32x4*)red)[(par_ * 8 + wid) * 64 + lane] = (f32x4){d1a + d1b, d2a + d2b, f1a + f1b, 0.f}; \
        SC_BAR(); \
        f32x4 tot_; RED8(tot_); \
        const int bo_ = (((T) >> BLS) & 1), to_ = (T) & (BL - 1); \
        const float v1 = bf2f(vbuf[bo_ * 2048 + to_ * 64 + lane]), v2_ = bf2f(vbuf[bo_ * 2048 + to_ * 64 + 64 + lane]); \
        const f32x4 ab_ = *(const LAS f32x4*)(gab + bo_ * 64 + to_ * 2); const f32x2 pd2_ = *(const LAS f32x2*)(pds + bo_ * 32 + to_); \
        asm volatile("" ::: "memory"); \
        if ((T) + 2 < L) DL_LOADOPS(N, (T) + 2); \
        const float a1 = ab_[0], a2 = ab_[2]; const float dl1 = ab_[1] * (v1 - a1 * tot_[0]); const float dl2 = ab_[3] * (v2_ - a2 * (a1 * tot_[1] + pd2_[0] * dl1)); \
        const float o1 = a1 * tot_[2] + pd2_[1] * dl1; const float a12 = a1 * a2, dl1s = a2 * dl1; \
        _Pragma("unroll") for (int j = 0; j < 8; ++j) S[j] *= a12; \
        AXPYV(C##u[0], C##u[1], dl1s); AXPYV(C##u[2], C##u[3], dl2); \
        float y2a = 0.f, y2b = 0.f; DOT8_HI(y2a, y2b, C##1); \
        yred[((T) & 15) * 512 + wid * 64 + lane] = o1 * 0.125f; yred[(((T) + 1) & 15) * 512 + wid * 64 + lane] = y2a + y2b; } while (0)
    for (int c = 0; c < nblk; ++c) {
        for (int tt = 0; tt < BL; tt += 4) {
            const int t = c * BL + tt;
            if (tt == (BL >> 1) && c + 1 < nblk) { DL_COMMIT(c + 1); if (c + 2 < nblk) DL_STAGE(c + 2); }
            DL_ROUND(ca, cb, t);
            DL_ROUND(cb, ca, t + 2);
            if (((t + 3) & 15) == 15) { SC_BAR(); DL_FINAL(t - 12 + 2 * wid); DL_FINAL(t - 11 + 2 * wid); }
        }
    }
#pragma unroll
    for (int j = 0; j < 8; ++j) st_out[(8 * wid + j) * 64 + lane] = S[j];
    __syncthreads();
#undef DL_STAGE
#undef DL_COMMIT
#undef DL_LOADOPS
#undef DL_FINAL
#undef DL_ROUND
}

__device__ __forceinline__ void sample_attn(KArgs A, int l, LAS unsigned char* lds, int unit, int tid) {
    unsigned char* ws = A->ws;
    const int sb = unit >> 2, h = unit & 3;
    LAS float* qs = (LAS float*)lds;
    LAS float* sc = qs + 2048;
    LAS float* scl = sc + 1024;
    LAS float* ssq = scl + 32;
    LAS float* lsum = ssq + 512;
    const bfu* qb = (const bfu*)slotp(ws, l, 4); bfu* mix = (bfu*)slotp(ws, l, 7);
    const float* ck = A->in[2] + (size_t)(l * 8 + sb) * 2048 * 512 + h * 128; const float* cv = A->in[3] + (size_t)(l * 8 + sb) * 2048 * 512 + h * 128;
    const float* nk = A->out + O_BKS + (size_t)(l * 8 + sb) * 16 * 512 + h * 128; const float* nv = A->out + O_BVS + (size_t)(l * 8 + sb) * 16 * 512 + h * 128;
    const float* lf = (const float*)(ws + WS_CTL + 1024); const float lam = lf[2 * l], omli = 1.f - lf[2 * l + 1];
    __syncthreads();
    for (int i = tid; i < 2048; i += NTHR) { const int map = i >> 10, qi = (i >> 6) & 15, p = i & 63; const int s = p >> 5, n_ = (p >> 4) & 1, r = p & 15;
        qs[(map * 16 + qi) * 64 + n_ * 32 + s * 16 + r] = bf2f(qb[(size_t)(MP + sb * 16 + qi) * 512 + h * 128 + map * 64 + p]); }
    float mrun = -1e30f, lrun = 0.f;
    const int qi = tid & 15, kj = tid >> 4, eg = tid >> 4;
    f32x4 acc0 = {0.f, 0.f, 0.f, 0.f}, acc1 = {0.f, 0.f, 0.f, 0.f};
    __syncthreads();
    for (int tile = 0; tile < 65; ++tile) {
        const int kidx = tile * 32 + kj;
        float s1 = -1e30f, s2 = -1e30f;
        if (kidx < 2064) { const float* kr = kidx < 2048 ? ck + (size_t)kidx * 512 : nk + (size_t)(kidx - 2048) * 512; s1 = 0.f; s2 = 0.f;
#pragma unroll 4
            for (int d = 0; d < 64; d += 4) { const f32x4 k1 = *(const f32x4*)(kr + d), k2 = *(const f32x4*)(kr + 64 + d); const LAS float* q1 = qs + qi * 64 + d; const LAS float* q2 = qs + (16 + qi) * 64 + d;
                s1 += q1[0] * k1[0] + q1[1] * k1[1] + q1[2] * k1[2] + q1[3] * k1[3]; s2 += q2[0] * k2[0] + q2[1] * k2[1] + q2[2] * k2[2] + q2[3] * k2[3]; } }
        sc[qi * 32 + kj] = s1; sc[(16 + qi) * 32 + kj] = s2;
        __syncthreads();
        if (tid < 32) { LAS float* r = sc + tid * 32; float mx = mrun;
#pragma unroll 8
            for (int j = 0; j < 32; ++j) mx = fmaxf(mx, r[j]);
            const float f = exp2f(mrun - mx); float su = 0.f;
#pragma unroll 8
            for (int j = 0; j < 32; ++j) { const float p = exp2f(r[j] - mx); r[j] = p; su += p; }
            lrun = lrun * f + su; mrun = mx; scl[tid] = f; }
        __syncthreads();
        { const float f0 = scl[qi], f1 = scl[16 + qi]; acc0 = acc0 * f0; acc1 = acc1 * f1;
            const int nk_ = tile < 64 ? 32 : 16;
            for (int j = 0; j < nk_; ++j) { const int kx = tile * 32 + j; const float* vr = (kx < 2048 ? cv + (size_t)kx * 512 : nv + (size_t)(kx - 2048) * 512) + eg * 4;
                const f32x4 v = *(const f32x4*)vr; acc0 = acc0 + v * sc[qi * 32 + j]; acc1 = acc1 + v * sc[(16 + qi) * 32 + j]; } }
        __syncthreads();
    }
    if (tid < 32) lsum[tid] = lrun;
    __syncthreads();
    const f32x4 o = acc0 * (1.f / lsum[qi]) - acc1 * (lam / lsum[16 + qi]);
    ssq[qi * 32 + eg] = (o[0] * o[0] + o[1] * o[1]) + (o[2] * o[2] + o[3] * o[3]);
    __syncthreads();
    float ss = 0.f;
#pragma unroll 8
    for (int j = 0; j < 32; ++j) ss += ssq[qi * 32 + j];
    const float rn = rsqrtf(ss * (1.f / 128.f) + 1e-6f) * omli; const float* bn = A->in[20] + l * 128 + eg * 4;
    v2u w; w.x = pk2(o[0] * rn * bn[0], o[1] * rn * bn[1]); w.y = pk2(o[2] * rn * bn[2], o[3] * rn * bn[3]);
    *(v2u*)(mix + (size_t)(MP + sb * 16 + qi) * 1024 + 256 + h * 128 + eg * 4) = w;
    __syncthreads();
}

#define PH_BEGIN \
        KArgs A = (KArgs)__builtin_amdgcn_kernarg_segment_ptr(); \
        int tid = wv * 64 + (int)__builtin_amdgcn_mbcnt_hi(~0u, __builtin_amdgcn_mbcnt_lo(~0u, 0u)); asm volatile("" : "+v"(tid)); tid &= 511; \
        const int bid = blockIdx.x, G = gridDim.x; \
        const int lane = tid & 63, wave = wv; \
        const int gw = bid * NWAVES + wave, NGW = G * NWAVES, gtid = bid * NTHR + tid, NT = G * NTHR; \
        unsigned char* ws = A->ws; float* rsb = (float*)(ws + WS_RS); unsigned char* wb = ws + WS_W; \
        (void)lane; (void)gw; (void)NGW; (void)gtid; (void)NT; (void)rsb; (void)wb;
#define IN(k) (lo <= (k) && (k) < hi)
__device__ __forceinline__ void grid_bar(unsigned* bar, unsigned target, bool leader) {
    asm volatile("s_waitcnt vmcnt(0) lgkmcnt(0)" ::: "memory");
    __syncthreads();
    if (leader) {
        __builtin_amdgcn_fence(__ATOMIC_RELEASE, "agent");
        asm volatile("s_waitcnt vmcnt(0)" ::: "memory");
        __hip_atomic_fetch_add(bar, 1u, __ATOMIC_RELAXED, __HIP_MEMORY_SCOPE_AGENT);
        unsigned spins = 0;
        while (__hip_atomic_load(bar, __ATOMIC_RELAXED, __HIP_MEMORY_SCOPE_AGENT) < target) { __builtin_amdgcn_s_sleep(2); if (++spins > (1u << 27)) break; }
        __builtin_amdgcn_fence(__ATOMIC_ACQUIRE, "agent");
        asm volatile("s_waitcnt vmcnt(0)" ::: "memory");
    }
    __syncthreads();
}
#define SEAM(k) do { if ((k) + 1 < hi) { ++nbar; grid_bar((unsigned*)(ws + WS_CTL + 4096), nbar * (unsigned)G, tid == 0); } } while (0)
#define SEAM_SKIP(k) do { } while (0)
__global__ void __launch_bounds__(NTHR, 2) hybrid_fwd(Args Aval) {
    extern __shared__ __attribute__((aligned(16))) unsigned char lds_raw[];
    LAS unsigned char* lds = (LAS unsigned char*)lds_raw;
    const int lo = Aval.ph_lo, hi = Aval.ph_hi; unsigned nbar = 0u;
    if (Aval.ph_lo < 0) cg::this_grid().sync();
    const int wv = __builtin_amdgcn_readfirstlane(threadIdx.x >> 6);
    if (IN(0)) { PH_BEGIN prologue(A, lds, gw, NGW, lane, wave, gtid, NT); SEAM(0); }
    { constexpr int l = 0;

        const int p0 = 1 + 11 * l;
        if (IN(p0 + 0)) { PH_BEGIN
            pg8::Gemm g{(const pg8::bf16_t*)slotp(ws, l, 0), (const pg8::bf16_t*)(wb + W_IN), MPAD, NIN, 1024};
            pg8::StaticOrder S; S.init(MPAD, NIN, G, bid);
            EpiG1 E{rsb + (size_t)(3 * l) * MPAD, (bfu*)slotp(ws, l, 2), (bfu*)slotp(ws, l, 4), (bfu*)slotp(ws, l, 5), (bfu*)slotp(ws, l, 6), (bfu*)slotp(ws, l, 7), (float*)(ws + WS_AB), (const float*)(ws + WS_ROPE),
                    A->out + O_BKP + (size_t)l * MP * 512, A->out + O_BVP + (size_t)l * MP * 512, A->out + O_BKS + (size_t)l * MS * 512, A->out + O_BVS + (size_t)l * MS * 512};
            pg8::gemm_phase<EpiG1, pg8::StaticOrder, true, true>((PG8_LAS unsigned char*)lds, g, S, E, wv);
            SEAM(p0 + 0); }
        if (IN(p0 + 1)) { PH_BEGIN
            prep_a(A, l, gw, NGW, lane); prep_c1(A, l, gw, NGW, lane);
#ifdef PROBE_EW2
            prep_a(A, l, gw, NGW, lane); prep_c1(A, l, gw, NGW, lane);
#endif
            if (l == 1) conv_weights(A, 1, 2, lds, gw, NGW, lane, wave);
            SEAM(p0 + 1); }
        if (IN(p0 + 2)) { PH_BEGIN
            pg8::Gemm g{(const pg8::bf16_t*)slotp(ws, l, 12), (const pg8::bf16_t*)(wb + W_LR), MPAD, 768, 256};
            pg8::StaticOrder S; S.init(MPAD, 768, G, bid);
            EpiB<0> E{(bfu*)slotp(ws, l, 13), 768, nullptr};
            pg8::gemm_phase<EpiB<0>, pg8::StaticOrder, true, true>((PG8_LAS unsigned char*)lds, g, S, E, wv);
            SEAM(p0 + 2); }
        if (IN(p0 + 3)) { PH_BEGIN prep_c2(A, l, bid, G, tid); prep_a2(A, l, gw, NGW, lane);
#ifdef PROBE_EW2
            prep_c2(A, l, bid, G, tid);
#endif
            SEAM(p0 + 3); }
        if (IN(p0 + 4)) { PH_BEGIN
            if (bid < 32) { const int b = bid >> 2, h = bid & 3;
                scan_rwkv(A, l, lds, h, b * 8192, 8192, 32, 5, b * 128, nullptr, A->out + O_CWP + (size_t)((l * 8 + b) * 4 + h) * 4096, tid);
#ifdef PROBE_SCAN2
                scan_rwkv(A, l, lds, h, b * 8192, 8192, 32, 5, b * 128, nullptr, A->out + O_CWP + (size_t)((l * 8 + b) * 4 + h) * 4096, tid);
#endif
                scan_rwkv(A, l, lds, h, MP + b * 16, 16, 16, 4, 1024 + b, A->in[7] + (size_t)((l * 8 + b) * 4 + h) * 4096, A->out + O_CWS + (size_t)((l * 8 + b) * 4 + h) * 4096, tid);
            } else if (bid < 64) { const int b = (bid - 32) >> 2, h = bid & 3;
                scan_delta(A, l, lds, h, b * 8192, 8192, 32, 5, nullptr, A->out + O_ADP + (size_t)((l * 8 + b) * 4 + h) * 4096, tid);
#ifdef PROBE_SCAN2
                scan_delta(A, l, lds, h, b * 8192, 8192, 32, 5, nullptr, A->out + O_ADP + (size_t)((l * 8 + b) * 4 + h) * 4096, tid);
#endif
                scan_delta(A, l, lds, h, MP + b * 16, 16, 16, 4, A->in[5] + (size_t)((l * 8 + b) * 4 + h) * 4096, A->out + O_ADS + (size_t)((l * 8 + b) * 4 + h) * 4096, tid);
            } else if (bid < 96) { sample_attn(A, l, lds, bid - 64, tid); }
            __syncthreads();
            unsigned* ctr = (unsigned*)(ws + WS_CTL) + 16 * l; volatile LAS unsigned* qw = (volatile LAS unsigned*)(lds + MISC_OFF);
            const attn_body::bf16* Q = (const attn_body::bf16*)slotp(ws, l, 4); const attn_body::bf16* K = (const attn_body::bf16*)slotp(ws, l, 5); const attn_body::bf16* V = (const attn_body::bf16*)slotp(ws, l, 6);
            attn_body::bf16* O = (attn_body::bf16*)slotp(ws, l, 13);
            for (;;) {
                if (tid == 0) qw[0] = atomicAdd(ctr, 1u);
                __syncthreads();
                const unsigned u = qw[0];
                __syncthreads();
                if (u >= 4096u) break;
                const int qb = 31 - (int)(u >> 7), bh = (int)(u & 127);
                attn_body::attn_unit<8>(bh >> 4, bh & 15, qb, Q, K, V, O, (char*)lds_raw, wv);
            }
            SEAM(p0 + 4); }
        if (IN(p0 + 5)) { PH_BEGIN
            post_attn(A, l, gw, NGW, lane);
            conv_p(A, l, (bfu*)slotp(ws, l, 10), gtid, NT);
#ifdef PROBE_EW2
            post_attn(A, l, gw, NGW, lane);
            conv_p(A, l, (bfu*)slotp(ws, l, 10), gtid, NT);
#endif
            if (l == 0) conv_weights(A, 1, 1, lds, gw, NGW, lane, wave);
            SEAM(p0 + 5); }
        if (IN(p0 + 6)) { PH_BEGIN
            pg8::Gemm g{(const pg8::bf16_t*)slotp(ws, l, 7), (const pg8::bf16_t*)(wb + W_OUT), MPAD, 1024, 1024};
            pg8::StaticOrder S; S.init(MPAD, 1024, G, bid);
            EpiH<2> E{A->out, (bfu*)slotp(ws, l, 0), rsb + (size_t)(3 * l + 1) * MPAD, nullptr, nullptr};
            pg8::gemm_phase<EpiH<2>, pg8::StaticOrder, true, true>((PG8_LAS unsigned char*)lds, g, S, E, wv);
            SEAM(p0 + 6); }
        if (IN(p0 + 7)) { PH_BEGIN
            pg8::Gemm g{(const pg8::bf16_t*)slotp(ws, l, 0), (const pg8::bf16_t*)(wb + W_FF1), MPAD, FFD, 1024};
            pg8::StaticOrder S; S.init(MPAD, FFD, G, bid);
            EpiB<1> E{(bfu*)slotp(ws, l, 2), FFD, rsb + (size_t)(3 * l + 1) * MPAD};
            pg8::gemm_phase<EpiB<1>, pg8::StaticOrder, true, true>((PG8_LAS unsigned char*)lds, g, S, E, wv);
            {
                pg8::Gemm g2{(const pg8::bf16_t*)slotp(ws, l, 10), (const pg8::bf16_t*)(wb + W_PP), MPAD, 1024, 256};
                pg8::StaticOrder S2; S2.init(MPAD, 1024, G, bid);
                EpiB<0> E2{(bfu*)slotp(ws, l, 11), 1024, nullptr};
                pg8::gemm_phase<EpiB<0>, pg8::StaticOrder, true, true>((PG8_LAS unsigned char*)lds, g2, S2, E2, wv); }
            SEAM(p0 + 7); }
        if (IN(p0 + 8)) { PH_BEGIN
            pg8::Gemm g{(const pg8::bf16_t*)slotp(ws, l, 2), (const pg8::bf16_t*)(wb + W_FF2), MPAD, 1024, FFD};
            pg8::StaticOrder S; S.init(MPAD, 1024, G, bid);
            EpiH<2> E{A->out, (bfu*)slotp(ws, l, 0), rsb + (size_t)(3 * l + 2) * MPAD, nullptr, nullptr};
            pg8::gemm_phase<EpiH<2>, pg8::StaticOrder, true, true>((PG8_LAS unsigned char*)lds, g, S, E, wv);
            SEAM(p0 + 8); }
        if (IN(p0 + 9)) { PH_BEGIN SEAM_SKIP(p0 + 9); }
        if (IN(p0 + 10)) { PH_BEGIN
            pg8::Gemm g{(const pg8::bf16_t*)slotp(ws, l, 0), (const pg8::bf16_t*)(wb + W_GATE), MPAD, 1024, 1024};
            pg8::StaticOrder S; S.init(MPAD, 1024, G, bid);
            EpiH<3> E{A->out, (bfu*)slotp(ws, l, 13), rsb + (size_t)(3 * l + 3) * MPAD, rsb + (size_t)(3 * l + 2) * MPAD, (const bfu*)slotp(ws, l, 11)};
            pg8::gemm_phase<EpiH<3>, pg8::StaticOrder, true, true>((PG8_LAS unsigned char*)lds, g, S, E, wv);
            SEAM(p0 + 10); }
        }
    { constexpr int l = 1;

        const int p0 = 1 + 11 * l;
        if (IN(p0 + 0)) { PH_BEGIN
            pg8::Gemm g{(const pg8::bf16_t*)slotp(ws, l, 0), (const pg8::bf16_t*)(wb + W_IN), MPAD, NIN, 1024};
            pg8::StaticOrder S; S.init(MPAD, NIN, G, bid);
            EpiG1 E{rsb + (size_t)(3 * l) * MPAD, (bfu*)slotp(ws, l, 2), (bfu*)slotp(ws, l, 4), (bfu*)slotp(ws, l, 5), (bfu*)slotp(ws, l, 6), (bfu*)slotp(ws, l, 7), (float*)(ws + WS_AB), (const float*)(ws + WS_ROPE),
                    A->out + O_BKP + (size_t)l * MP * 512, A->out + O_BVP + (size_t)l * MP * 512, A->out + O_BKS + (size_t)l * MS * 512, A->out + O_BVS + (size_t)l * MS * 512};
            pg8::gemm_phase<EpiG1, pg8::StaticOrder, true, true>((PG8_LAS unsigned char*)lds, g, S, E, wv);
            SEAM(p0 + 0); }
        if (IN(p0 + 1)) { PH_BEGIN
            prep_a(A, l, gw, NGW, lane); prep_c1(A, l, gw, NGW, lane);
#ifdef PROBE_EW2
            prep_a(A, l, gw, NGW, lane); prep_c1(A, l, gw, NGW, lane);
#endif
            if (l == 1) conv_weights(A, 1, 2, lds, gw, NGW, lane, wave);
            SEAM(p0 + 1); }
        if (IN(p0 + 2)) { PH_BEGIN
            pg8::Gemm g{(const pg8::bf16_t*)slotp(ws, l, 12), (const pg8::bf16_t*)(wb + W_LR), MPAD, 768, 256};
            pg8::StaticOrder S; S.init(MPAD, 768, G, bid);
            EpiB<0> E{(bfu*)slotp(ws, l, 13), 768, nullptr};
            pg8::gemm_phase<EpiB<0>, pg8::StaticOrder, true, true>((PG8_LAS unsigned char*)lds, g, S, E, wv);
            SEAM(p0 + 2); }
        if (IN(p0 + 3)) { PH_BEGIN prep_c2(A, l, bid, G, tid); prep_a2(A, l, gw, NGW, lane);
#ifdef PROBE_EW2
            prep_c2(A, l, bid, G, tid);
#endif
            SEAM(p0 + 3); }
        if (IN(p0 + 4)) { PH_BEGIN
            if (bid < 32) { const int b = bid >> 2, h = bid & 3;
                scan_rwkv(A, l, lds, h, b * 8192, 8192, 32, 5, b * 128, nullptr, A->out + O_CWP + (size_t)((l * 8 + b) * 4 + h) * 4096, tid);
#ifdef PROBE_SCAN2
                scan_rwkv(A, l, lds, h, b * 8192, 8192, 32, 5, b * 128, nullptr, A->out + O_CWP + (size_t)((l * 8 + b) * 4 + h) * 4096, tid);
#endif
                scan_rwkv(A, l, lds, h, MP + b * 16, 16, 16, 4, 1024 + b, A->in[7] + (size_t)((l * 8 + b) * 4 + h) * 4096, A->out + O_CWS + (size_t)((l * 8 + b) * 4 + h) * 4096, tid);
            } else if (bid < 64) { const int b = (bid - 32) >> 2, h = bid & 3;
                scan_delta(A, l, lds, h, b * 8192, 8192, 32, 5, nullptr, A->out + O_ADP + (size_t)((l * 8 + b) * 4 + h) * 4096, tid);
#ifdef PROBE_SCAN2
                scan_delta(A, l, lds, h, b * 8192, 8192, 32, 5, nullptr, A->out + O_ADP + (size_t)((l * 8 + b) * 4 + h) * 4096, tid);
#endif
                scan_delta(A, l, lds, h, MP + b * 16, 16, 16, 4, A->in[5] + (size_t)((l * 8 + b) * 4 + h) * 4096, A->out + O_ADS + (size_t)((l * 8 + b) * 4 + h) * 4096, tid);
            } else if (bid < 96) { sample_attn(A, l, lds, bid - 64, tid); }
            __syncthreads();
            unsigned* ctr = (unsigned*)(ws + WS_CTL) + 16 * l; volatile LAS unsigned* qw = (volatile LAS unsigned*)(lds + MISC_OFF);
            const attn_body::bf16* Q = (const attn_body::bf16*)slotp(ws, l, 4); const attn_body::bf16* K = (const attn_body::bf16*)slotp(ws, l, 5); const attn_body::bf16* V = (const attn_body::bf16*)slotp(ws, l, 6);
            attn_body::bf16* O = (attn_body::bf16*)slotp(ws, l, 13);
            for (;;) {
                if (tid == 0) qw[0] = atomicAdd(ctr, 1u);
                __syncthreads();
                const unsigned u = qw[0];
                __syncthreads();
                if (u >= 4096u) break;
                const int qb = 31 - (int)(u >> 7), bh = (int)(u & 127);
                attn_body::attn_unit<8>(bh >> 4, bh & 15, qb, Q, K, V, O, (char*)lds_raw, wv);
            }
            SEAM(p0 + 4); }
        if (IN(p0 + 5)) { PH_BEGIN
            post_attn(A, l, gw, NGW, lane);
            conv_p(A, l, (bfu*)slotp(ws, l, 10), gtid, NT);
#ifdef PROBE_EW2
            post_attn(A, l, gw, NGW, lane);
            conv_p(A, l, (bfu*)slotp(ws, l, 10), gtid, NT);
#endif
            if (l == 0) conv_weights(A, 1, 1, lds, gw, NGW, lane, wave);
            SEAM(p0 + 5); }
        if (IN(p0 + 6)) { PH_BEGIN
            pg8::Gemm g{(const pg8::bf16_t*)slotp(ws, l, 7), (const pg8::bf16_t*)(wb + W_OUT), MPAD, 1024, 1024};
            pg8::StaticOrder S; S.init(MPAD, 1024, G, bid);
            EpiH<2> E{A->out, (bfu*)slotp(ws, l, 0), rsb + (size_t)(3 * l + 1) * MPAD, nullptr, nullptr};
            pg8::gemm_phase<EpiH<2>, pg8::StaticOrder, true, true>((PG8_LAS unsigned char*)lds, g, S, E, wv);
            SEAM(p0 + 6); }
        if (IN(p0 + 7)) { PH_BEGIN
            pg8::Gemm g{(const pg8::bf16_t*)slotp(ws, l, 0), (const pg8::bf16_t*)(wb + W_FF1), MPAD, FFD, 1024};
            pg8::StaticOrder S; S.init(MPAD, FFD, G, bid);
            EpiB<1> E{(bfu*)slotp(ws, l, 2), FFD, rsb + (size_t)(3 * l + 1) * MPAD};
            pg8::gemm_phase<EpiB<1>, pg8::StaticOrder, true, true>((PG8_LAS unsigned char*)lds, g, S, E, wv);
            {
                pg8::Gemm g2{(const pg8::bf16_t*)slotp(ws, l, 10), (const pg8::bf16_t*)(wb + W_PP), MPAD, 1024, 256};
                pg8::StaticOrder S2; S2.init(MPAD, 1024, G, bid);
                EpiB<0> E2{(bfu*)slotp(ws, l, 11), 1024, nullptr};
                pg8::gemm_phase<EpiB<0>, pg8::StaticOrder, true, true>((PG8_LAS unsigned char*)lds, g2, S2, E2, wv); }
            SEAM(p0 + 7); }
        if (IN(p0 + 8)) { PH_BEGIN
            pg8::Gemm g{(const pg8::bf16_t*)slotp(ws, l, 2), (const pg8::bf16_t*)(wb + W_FF2), MPAD, 1024, FFD};
            pg8::StaticOrder S; S.init(MPAD, 1024, G, bid);
            EpiH<2> E{A->out, (bfu*)slotp(ws, l, 0), rsb + (size_t)(3 * l + 2) * MPAD, nullptr, nullptr};
            pg8::gemm_phase<EpiH<2>, pg8::StaticOrder, true, true>((PG8_LAS unsigned char*)lds, g, S, E, wv);
            SEAM(p0 + 8); }
        if (IN(p0 + 9)) { PH_BEGIN SEAM_SKIP(p0 + 9); }
        if (IN(p0 + 10)) { PH_BEGIN
            pg8::Gemm g{(const pg8::bf16_t*)slotp(ws, l, 0), (const pg8::bf16_t*)(wb + W_GATE), MPAD, 1024, 1024};
            pg8::StaticOrder S; S.init(MPAD, 1024, G, bid);
            EpiH<3> E{A->out, (bfu*)slotp(ws, l, 13), rsb + (size_t)(3 * l + 3) * MPAD, rsb + (size_t)(3 * l + 2) * MPAD, (const bfu*)slotp(ws, l, 11)};
            pg8::gemm_phase<EpiH<3>, pg8::StaticOrder, true, true>((PG8_LAS unsigned char*)lds, g, S, E, wv);
            SEAM(p0 + 10); }
        }
    if (IN(NPHASE - 1)) { PH_BEGIN final_norm(A, gw, NGW, lane); }
}
#undef PH_BEGIN
#undef IN
#undef SEAM

extern "C" void kernel_launch(void* const* d_in, const int* in_sizes, int n_in, void* d_out, int out_size, void* d_ws, size_t ws_size, hipStream_t stream) {
    static int grid = 0;
    if (grid == 0) {
        if (n_in != 40 || (size_t)out_size != O_END || ws_size < WS_TOTAL) { fprintf(stderr, "kernel_launch: unexpected shapes (n_in %d out %d ws %zu)\n", n_in, out_size, ws_size); grid = -1; return; }
        int dev = 0, cus = 0, per_cu = 0;
        if (hipGetDevice(&dev) != hipSuccess || hipDeviceGetAttribute(&cus, hipDeviceAttributeMultiprocessorCount, dev) != hipSuccess) { grid = -1; return; }
        if (hipFuncSetAttribute((const void*)hybrid_fwd, hipFuncAttributeMaxDynamicSharedMemorySize, LDS_BYTES) != hipSuccess) { fprintf(stderr, "kernel_launch: hipFuncSetAttribute failed\n"); grid = -1; return; }
        if (hipOccupancyMaxActiveBlocksPerMultiprocessor(&per_cu, (const void*)hybrid_fwd, NTHR, LDS_BYTES) != hipSuccess || per_cu < 1) { fprintf(stderr, "kernel_launch: occupancy query says %d\n", per_cu); per_cu = 1; }
        (void)hipGetLastError();
        grid = cus;
    }
    if (grid < 0) return;
    if (hipMemsetAsync((char*)d_ws + WS_CTL, 0, 64 * 1024, stream) != hipSuccess) { fprintf(stderr, "kernel_launch: memset failed\n"); return; }
    Args a{};
    for (int i = 0; i < 40; ++i) a.in[i] = (const float*)d_in[i];
    a.out = (float*)d_out; a.ws = (unsigned char*)d_ws;
#if MK_ONE_LAUNCH
    a.ph_lo = 0; a.ph_hi = NPHASE;
    void* args[] = {&a};
    hipError_t e = hipLaunchCooperativeKernel((const void*)hybrid_fwd, dim3(grid), dim3(NTHR), args, LDS_BYTES, stream);
    if (e != hipSuccess) fprintf(stderr, "kernel_launch: cooperative launch failed: %s (grid %d)\n", hipGetErrorString(e), grid);
#else
    for (int ph = 0; ph < NPHASE; ++ph) { a.ph_lo = ph; a.ph_hi = ph + 1; hipLaunchKernelGGL(hybrid_fwd, dim3(grid), dim3(NTHR), LDS_BYTES, stream, a); }
#endif
}
```

```cpp
#include <hip/hip_runtime.h>
#include <hip/hip_cooperative_groups.h>
#include <cstdio>
#include <cstdint>
namespace cg = cooperative_groups;
namespace pg8 {
#define PG8_LAS __attribute__((address_space(3)))
typedef unsigned short bf16_t;
typedef short bf16x8 __attribute__((ext_vector_type(8)));
typedef float f32x4 __attribute__((ext_vector_type(4)));
typedef unsigned u32x4 __attribute__((ext_vector_type(4)));
constexpr int BM = 256, BK = 64, HALF = 128, HTB = HALF * BK * 2  , STAGE_BYTES = 8 * HTB, NXCD = 8, WGM = 8;

__host__ __device__ __forceinline__ int lds_byte(int r, int c) { const int st = (r >> 4) * 2 + (c >> 5), rr = r & 15, cc = c & 31, ob = rr * 64 + cc * 2; return st * 1024 + (ob ^ (((ob >> 9) & 1) << 5)); }
__host__ __device__ __forceinline__ void stage_rc(int b, int& R, int& C) { const int st = b / 1024, sb = b % 1024, swz = sb ^ (((sb >> 9) & 1) << 5); R = (st >> 1) * 16 + swz / 64; C = (st & 1) * 32 + (swz % 64) / 2; }
__host__ __device__ __forceinline__ int perm32(int rho) { const int n = rho >> 4, i = rho & 15; return 8 * (i >> 2) + 4 * n + (i & 3); }

struct Unit { int pm, pn; };
struct Gemm { const bf16_t* A; const bf16_t* Bt; int M, N, K; };

struct StaticOrder {
    int nM, nN, nwg, G, c;
    __host__ __device__ void init(int M, int N, int G_, int c_) { nM = M / BM; nN = N / BM; nwg = nM * nN; G = G_; c = c_; }
    __host__ __device__ bool next(int i, Unit& u) const {
        const long L = (long)i * G + c; if (L >= nwg) return false;
        int wgid = (int)L; { const int q = nwg / NXCD, r = nwg % NXCD, xcd = wgid % NXCD, off = wgid / NXCD; wgid = (xcd < r ? xcd * (q + 1) : r * (q + 1) + (xcd - r) * q) + off; }
        const int nig = WGM * nN, gid = wgid / nig, fm = gid * WGM, gsz = (nM - fm) < WGM ? (nM - fm) : WGM;
        u.pm = fm + ((wgid % nig) % gsz); u.pn = (wgid % nig) / gsz; return true;
    }
    __device__ __forceinline__ void a_ready(const Unit&) const {}
    __device__ __forceinline__ void done(const Unit&) const {}
};

__device__ __forceinline__ unsigned cvt_pk_bf16(float lo, float hi) { unsigned r; asm volatile("v_cvt_pk_bf16_f32 %0, %1, %2" : "=v"(r) : "v"(lo), "v"(hi)); return r; }
typedef float f32x2 __attribute__((ext_vector_type(2)));
__device__ __forceinline__ f32x2 gelu_pk(f32x2 v) {
    const f32x2 av = __builtin_elementwise_abs(v), d = av * 0.2316418882f + 1.0f;
    f32x2 t; t.x = __builtin_amdgcn_rcpf(d.x); t.y = __builtin_amdgcn_rcpf(d.y);
    f32x2 q = t * 0.5307027145f + (-0.7265760135f); q = q * t + 0.7107068705f; q = q * t + (-0.142248368f); q = q * t + 0.127414796f; q = q * t;
    const f32x2 s = (v * v) * (-0.72134752044f);
    f32x2 e; e.x = __builtin_amdgcn_exp2f(s.x); e.y = __builtin_amdgcn_exp2f(s.y);
    const f32x2 m = v * (q * e), r = v - m;
    f32x2 o; o.x = v.x < 0.f ? m.x : r.x; o.y = v.y < 0.f ? m.y : r.y; return o;
}

template <int ACT  > struct EpiBf16 {
    static constexpr bool PERM = true, AFTER_DRAIN = false; static_assert(ACT == 0 || ACT == 1, "EpiBf16: ACT is 0 (none) or 1 (gelu_pk)");
    bf16_t* O; int ldc; const float* bias; int split_cols; size_t split_stride; float scale0;
    __device__ __forceinline__ void operator()(const f32x4 (&acc)[2][2][4][2], const Unit& u, int wr, int wc, int fr, int fq) const {
        const int row0 = u.pm * BM + wr * 64 + fr; int colt = u.pn * BM; bf16_t* base = O;
        float sc = 1.f; if (split_cols) { const int t = colt / split_cols; base += (size_t)t * split_stride; colt -= t * split_cols; if (t == 0) sc = scale0; }
        const int col0 = colt + wc * 32 + 8 * fq, bcol0 = u.pn * BM + wc * 32 + 8 * fq;
        f32x4 bv[2][2];
#pragma unroll
        for (int bj = 0; bj < 2; ++bj)
#pragma unroll
            for (int n = 0; n < 2; ++n) bv[bj][n] = bias ? *(const f32x4*)(bias + bcol0 + bj * HALF + 4 * n) : (f32x4){0.f, 0.f, 0.f, 0.f};
#pragma unroll
        for (int ai = 0; ai < 2; ++ai)
#pragma unroll
            for (int m = 0; m < 4; ++m) { bf16_t* rowp = base + (size_t)(row0 + ai * HALF + m * 16) * ldc + col0;
#pragma unroll
                for (int bj = 0; bj < 2; ++bj) { f32x4 v0 = acc[ai][bj][m][0] + bv[bj][0], v1 = acc[ai][bj][m][1] + bv[bj][1];
                    if (ACT == 1) { f32x2 a = gelu_pk((f32x2){v0[0], v0[1]}), b = gelu_pk((f32x2){v0[2], v0[3]}), c = gelu_pk((f32x2){v1[0], v1[1]}), d = gelu_pk((f32x2){v1[2], v1[3]});
                        v0 = (f32x4){a.x, a.y, b.x, b.y}; v1 = (f32x4){c.x, c.y, d.x, d.y}; }
                    v0 = v0 * sc; v1 = v1 * sc; u32x4 w; w.x = cvt_pk_bf16(v0[0], v0[1]); w.y = cvt_pk_bf16(v0[2], v0[3]); w.z = cvt_pk_bf16(v1[0], v1[1]); w.w = cvt_pk_bf16(v1[2], v1[3]);
                    *(u32x4*)(rowp + bj * HALF) = w; } }
    }
};

struct PanelStats {
    unsigned* xbuf;
    unsigned* cnt;
    unsigned* tmo;
    int ntn; float eps;
    unsigned code;
    __device__ __forceinline__ bool run(const f32x4 (&v)[2][2][4][2], const Unit& u, int wr, int wc, int fr, int fq, PG8_LAS unsigned char* lds, int wid, int lane) const {
        typedef float f32x2v __attribute__((ext_vector_type(2)));
        PG8_LAS f32x2v* P = (PG8_LAS f32x2v*)lds;
        PG8_LAS f32x2v* S = (PG8_LAS f32x2v*)(lds + 8192);
        PG8_LAS unsigned* flag = (PG8_LAS unsigned*)(lds + 8192 + 2048);
#pragma unroll
        for (int ai = 0; ai < 2; ++ai)
#pragma unroll
            for (int m = 0; m < 4; ++m) {
                float s = 0.f;
#pragma unroll
                for (int bj = 0; bj < 2; ++bj)
#pragma unroll
                    for (int n = 0; n < 2; ++n) { const f32x4 x = v[ai][bj][m][n]; s += (x[0] + x[1]) + (x[2] + x[3]); }
                s += __shfl_xor(s, 16); s += __shfl_xor(s, 32);
                const float mw = s * (1.0f / 64.0f); float q = 0.f;
#pragma unroll
                for (int bj = 0; bj < 2; ++bj)
#pragma unroll
                    for (int n = 0; n < 2; ++n) { const f32x4 d = v[ai][bj][m][n] - mw; q += (d[0] * d[0] + d[1] * d[1]) + (d[2] * d[2] + d[3] * d[3]); }
                q += __shfl_xor(q, 16); q += __shfl_xor(q, 32);
                if (fq == 0) P[(ai * HALF + wr * 64 + m * 16 + fr) * 4 + wc] = (f32x2v){mw, q};
            }
        asm volatile("s_waitcnt lgkmcnt(0)" ::: "memory"); __builtin_amdgcn_s_barrier(); asm volatile("" ::: "memory");
#if defined(BROKEN_EXCHANGE_NO_WAIT)
#warning BROKEN CONTROL BUILD: the row-statistics exchange does not wait; results are wrong by design
        if (blockIdx.x >= 64) { const long long t0_ = clock64(); while (clock64() - t0_ < 60000) __builtin_amdgcn_s_sleep(8); }
#endif
        const int row = wid * 32 + (lane & 31);
        if (lane < 32) {
            const f32x2v a = P[row * 4 + 0], b = P[row * 4 + 1], c = P[row * 4 + 2], d = P[row * 4 + 3];
            const float mt = (a.x + b.x + c.x + d.x) * 0.25f;
            const float da = a.x - mt, db = b.x - mt, dc = c.x - mt, dd = d.x - mt;
            const float m2 = (a.y + b.y) + (c.y + d.y) + 64.0f * ((da * da + db * db) + (dc * dc + dd * dd));
            unsigned long long* slot = (unsigned long long*)xbuf + ((size_t)(u.pm * BM + row) * 4 + u.pn);
            __hip_atomic_store(slot, ((unsigned long long)__float_as_uint(m2) << 32) | __float_as_uint(mt), __ATOMIC_RELAXED, __HIP_MEMORY_SCOPE_AGENT);
        }
        asm volatile("s_waitcnt vmcnt(0)" ::: "memory");
        if (lane == 0) __hip_atomic_fetch_add(cnt + 64 * u.pm, 1u, __ATOMIC_RELAXED, __HIP_MEMORY_SCOPE_AGENT);
        if (wid == 0) {
            bool dead = false; const unsigned long long t0 = __builtin_amdgcn_s_memrealtime(); const unsigned want = 8u * (unsigned)ntn;
            for (;;) {
#if defined(BROKEN_EXCHANGE_NO_WAIT)
                break;
#endif
                if ((unsigned)__builtin_amdgcn_readfirstlane(__hip_atomic_load(cnt + 64 * u.pm, __ATOMIC_RELAXED, __HIP_MEMORY_SCOPE_AGENT)) >= want) break;
                if (__builtin_amdgcn_s_memrealtime() - t0 > 2000000ull) {
                    if (lane == 0) { unsigned expect = 0u; __hip_atomic_compare_exchange_strong(tmo + 1, &expect, code | (unsigned)(u.pm & 0xff), __ATOMIC_RELAXED, __ATOMIC_RELAXED, __HIP_MEMORY_SCOPE_AGENT);
                                     __hip_atomic_store(tmo, 1u, __ATOMIC_RELAXED, __HIP_MEMORY_SCOPE_AGENT); }
                    dead = true; break; }
                __builtin_amdgcn_s_sleep(2);
            }
            __builtin_amdgcn_fence(__ATOMIC_ACQUIRE, "agent");
            if (lane == 0) flag[0] = dead ? 1u : 0u;
        }
        asm volatile("s_waitcnt vmcnt(0) lgkmcnt(0)" ::: "memory"); __builtin_amdgcn_s_barrier(); asm volatile("" ::: "memory");
        const bool bad = flag[0] != 0u;
        if (lane < 32) {
            const unsigned long long* slot = (const unsigned long long*)xbuf + (size_t)(u.pm * BM + row) * 4; float mt[4], m2[4]; float ms = 0.f;
#pragma unroll
            for (int t = 0; t < 4; ++t) { if (t < ntn) { const unsigned long long w = __hip_atomic_load(slot + t, __ATOMIC_RELAXED, __HIP_MEMORY_SCOPE_AGENT); mt[t] = __uint_as_float((unsigned)w); m2[t] = __uint_as_float((unsigned)(w >> 32)); } else { mt[t] = 0.f; m2[t] = 0.f; } ms += mt[t]; }
            const float mean = ms / (float)ntn; float q = 0.f;
#pragma unroll
            for (int t = 0; t < 4; ++t) if (t < ntn) { const float dm = mt[t] - mean; q += m2[t] + 256.0f * dm * dm; }
            S[row] = (f32x2v){mean, 1.0f / sqrtf(q / (256.0f * (float)ntn) + eps)};
        }
        asm volatile("s_waitcnt lgkmcnt(0)" ::: "memory"); __builtin_amdgcn_s_barrier(); asm volatile("" ::: "memory");
        return bad;
    }
};
struct EpiLnRes {
    static constexpr bool PERM = false, AFTER_DRAIN = true;
    const float* base; float* out; int ldc; const float* bias; PanelStats st; unsigned poison;
    __device__ __forceinline__ void fused(f32x4 (&acc)[2][2][4][2], const Unit& u, int wr, int wc, int fr, int fq, PG8_LAS unsigned char* lds, int wid, int lane) const {
        typedef float f32x2v __attribute__((ext_vector_type(2)));
        const PG8_LAS f32x2v* S = (const PG8_LAS f32x2v*)(lds + 8192);
        const int col0 = u.pn * BM + wc * 32 + 4 * fq;
#pragma unroll
        for (int bj = 0; bj < 2; ++bj)
#pragma unroll
            for (int n = 0; n < 2; ++n) { const f32x4 bv = bias ? *(const f32x4*)(bias + col0 + bj * HALF + n * 16) : (f32x4){0.f, 0.f, 0.f, 0.f};
#pragma unroll
                for (int ai = 0; ai < 2; ++ai)
#pragma unroll
                    for (int m = 0; m < 4; ++m) acc[ai][bj][m][n] += bv; }
        f32x4 pre[4][2][2];
#pragma unroll
        for (int m = 0; m < 4; ++m) { const size_t off = (size_t)(u.pm * BM + wr * 64 + m * 16 + fr) * ldc + col0;
#pragma unroll
            for (int bj = 0; bj < 2; ++bj)
#pragma unroll
                for (int n = 0; n < 2; ++n) pre[m][bj][n] = *(const f32x4*)(base + off + bj * HALF + n * 16); }
        const bool bad = st.run(acc, u, wr, wc, fr, fq, lds, wid, lane) || poison != 0u;
        const float qnan = __builtin_nanf("");
#pragma unroll
        for (int ai = 0; ai < 2; ++ai)
#pragma unroll
            for (int m = 0; m < 4; ++m) { const int r = ai * HALF + wr * 64 + m * 16 + fr; const f32x2v sr = S[r]; const size_t off = (size_t)(u.pm * BM + r) * ldc + col0;
#pragma unroll
                for (int bj = 0; bj < 2; ++bj)
#pragma unroll
                    for (int n = 0; n < 2; ++n) { const f32x4 bs = ai == 0 ? pre[m][bj][n] : *(const f32x4*)(base + off + bj * HALF + n * 16); f32x4 o = bs + (acc[ai][bj][m][n] - sr.x) * sr.y;
                        if (bad) o = (f32x4){qnan, qnan, qnan, qnan}; *(f32x4*)(out + off + bj * HALF + n * 16) = o; }
                if (m & 1) asm volatile("" ::: "memory"); }
    }
};
struct EpiLnResLn {
    static constexpr bool PERM = false, AFTER_DRAIN = true;
    const float* base; float* out; bf16_t* xn; int ldc; const float* bias; PanelStats st1, st2; unsigned poison;
    __device__ __forceinline__ void fused(f32x4 (&acc)[2][2][4][2], const Unit& u, int wr, int wc, int fr, int fq, PG8_LAS unsigned char* lds, int wid, int lane) const {
        typedef float f32x2v __attribute__((ext_vector_type(2))); typedef unsigned u32x2v __attribute__((ext_vector_type(2)));
        const PG8_LAS f32x2v* S = (const PG8_LAS f32x2v*)(lds + 8192);
        const int col0 = u.pn * BM + wc * 32 + 4 * fq;
#pragma unroll
        for (int bj = 0; bj < 2; ++bj)
#pragma unroll
            for (int n = 0; n < 2; ++n) { const f32x4 bv = bias ? *(const f32x4*)(bias + col0 + bj * HALF + n * 16) : (f32x4){0.f, 0.f, 0.f, 0.f};
#pragma unroll
                for (int ai = 0; ai < 2; ++ai)
#pragma unroll
                    for (int m = 0; m < 4; ++m) acc[ai][bj][m][n] += bv; }
        bool bad = st1.run(acc, u, wr, wc, fr, fq, lds, wid, lane) || poison != 0u;
        const float qnan = __builtin_nanf("");
#pragma unroll
        for (int ai = 0; ai < 2; ++ai)
#pragma unroll
            for (int m = 0; m < 4; ++m) { const int r = ai * HALF + wr * 64 + m * 16 + fr; const f32x2v sr = S[r]; const size_t off = (size_t)(u.pm * BM + r) * ldc + col0;
#pragma unroll
                for (int bj = 0; bj < 2; ++bj)
#pragma unroll
                    for (int n = 0; n < 2; ++n) { const f32x4 bs = *(const f32x4*)(base + off + bj * HALF + n * 16); acc[ai][bj][m][n] = bs + (acc[ai][bj][m][n] - sr.x) * sr.y; }
                asm volatile("" : "+v"(acc[ai][0][m][0]), "+v"(acc[ai][0][m][1]), "+v"(acc[ai][1][m][0]), "+v"(acc[ai][1][m][1]));
                if (m & 1) asm volatile("" ::: "memory"); }
        const bool bad1 = bad;
        bad = st2.run(acc, u, wr, wc, fr, fq, lds, wid, lane) || bad;
#pragma unroll
        for (int ai = 0; ai < 2; ++ai)
#pragma unroll
            for (int m = 0; m < 4; ++m) { const int r = ai * HALF + wr * 64 + m * 16 + fr; const f32x2v sr = S[r]; const size_t off = (size_t)(u.pm * BM + r) * ldc + col0;
#pragma unroll
                for (int bj = 0; bj < 2; ++bj)
#pragma unroll
                    for (int n = 0; n < 2; ++n) { const f32x4 x1 = acc[ai][bj][m][n]; *(f32x4*)(out + off + bj * HALF + n * 16) = bad1 ? (f32x4){qnan, qnan, qnan, qnan} : x1;
                        const f32x4 o = (x1 - sr.x) * sr.y; u32x2v w; w.x = cvt_pk_bf16(o[0], o[1]); w.y = cvt_pk_bf16(o[2], o[3]);
                        if (bad) { w.x = 0x7fc07fc0u; w.y = 0x7fc07fc0u; } *(u32x2v*)(xn + off + bj * HALF + n * 16) = w; }
                asm volatile("" ::: "memory"); }
    }
};

template <class Epi, class Sched, bool ALIGN_EPI = false, bool SP2 = false>
__device__ __forceinline__ void gemm_phase(PG8_LAS unsigned char* lds, const Gemm g, const Sched& S, const Epi& E, const int wv_) {
    int tid_o = wv_ * 64 + (int)__builtin_amdgcn_mbcnt_hi(~0u, __builtin_amdgcn_mbcnt_lo(~0u, 0u)); asm volatile("" : "+v"(tid_o)); tid_o &= 511;
    const int tid = tid_o, wid = __builtin_amdgcn_readfirstlane(tid >> 6), lane = tid & 63, wr = wid >> 2, wc = wid & 3, fr = lane & 15, fq = lane >> 4;
    const int K = g.K, nt = K / BK;
    unsigned voffA[2], voffB[2];
#pragma unroll
    for (int i = 0; i < 2; ++i) { int R, C; stage_rc(tid * 16 + i * 8192, R, C); const int Rb = Epi::PERM ? ((R & ~31) + perm32(R & 31)) : R;
        voffA[i] = (unsigned)(R * K + C) * 2u; voffB[i] = (unsigned)(Rb * K + C) * 2u; }
    const size_t kstep = (size_t)(BK * 2);
    const size_t hstep = (size_t)HALF * K * 2;
    const size_t tstep = 2 * hstep;
    const unsigned ldsw = (unsigned)wid * 1024u;
    const int aoff = lds_byte(wr * 64 + fr, fq * 8), boff = lds_byte(wc * 32 + fr, fq * 8);
#define PG8_SA(b, h) (((b) * 2 + (h)) * HTB)
#define PG8_SB(b, h) ((4 + (b) * 2 + (h)) * HTB)
#define PG8_STAGE(bufoff, gbase, voff) do { _Pragma("unroll") for (int _i = 0; _i < 2; ++_i) \
        __builtin_amdgcn_global_load_lds((const unsigned*)((const char*)(gbase) + (voff)[_i]), (PG8_LAS unsigned*)(lds + (bufoff) + ldsw + _i * 8192), 16, 0, 0); } while (0)
#define PG8_LDA(dst, b, h) do { _Pragma("unroll") for (int m = 0; m < 4; ++m) _Pragma("unroll") for (int k = 0; k < 2; ++k) dst[m][k] = *(const PG8_LAS bf16x8*)(lds + PG8_SA(b, h) + aoff + m * 2048 + k * 1024); } while (0)
#define PG8_LDB(dst, b, h) do { _Pragma("unroll") for (int n = 0; n < 2; ++n) _Pragma("unroll") for (int k = 0; k < 2; ++k) dst[n][k] = *(const PG8_LAS bf16x8*)(lds + PG8_SB(b, h) + boff + n * 2048 + k * 1024); } while (0)
#define PG8_MMA(ai, bj, At, Bt) do { __builtin_amdgcn_s_setprio(1); _Pragma("unroll") for (int m = 0; m < 4; ++m) _Pragma("unroll") for (int n = 0; n < 2; ++n) _Pragma("unroll") for (int k = 0; k < 2; ++k) \
        acc[ai][bj][m][n] = __builtin_amdgcn_mfma_f32_16x16x32_bf16(Bt[n][k], At[m][k], acc[ai][bj][m][n], 0, 0, 0); __builtin_amdgcn_s_setprio(0); } while (0)
#define PG8_WAIT_V(n) asm volatile("s_waitcnt vmcnt(" #n ")" ::: "memory")
#define PG8_WAIT_L(n) asm volatile("s_waitcnt lgkmcnt(" #n ")" ::: "memory")
#define PG8_BAR __builtin_amdgcn_s_barrier()
#define PG8_SCHED __builtin_amdgcn_sched_barrier(0)
    Unit cur, nxt; int ui = 0;
    if (!S.next(0, cur)) return;
    f32x4 acc[2][2][4][2];
#pragma unroll
    for (int a = 0; a < 2; ++a)
#pragma unroll
        for (int b = 0; b < 2; ++b)
#pragma unroll
            for (int m = 0; m < 4; ++m)
#pragma unroll
                for (int n = 0; n < 2; ++n) acc[a][b][m][n] = (f32x4){0.f, 0.f, 0.f, 0.f};
    bf16x8 At[4][2], B0[2][2], B1[2][2];
    const char* cA = (const char*)g.A + (size_t)cur.pm * tstep; const char* cB = (const char*)g.Bt + (size_t)cur.pn * tstep;
    S.a_ready(cur);
    if constexpr (SP2) {
        PG8_STAGE(PG8_SB(0, 0), cB, voffB); PG8_STAGE(PG8_SB(0, 1), cB + hstep, voffB); PG8_STAGE(PG8_SA(0, 0), cA, voffA); PG8_STAGE(PG8_SA(0, 1), cA + hstep, voffA);
        if (wr == 1) PG8_BAR;
        PG8_WAIT_V(2); PG8_BAR;
        PG8_STAGE(PG8_SB(1, 0), cB + kstep, voffB); PG8_STAGE(PG8_SA(1, 0), cA + kstep, voffA); PG8_STAGE(PG8_SB(1, 1), cB + hstep + kstep, voffB);
        PG8_WAIT_V(6); PG8_BAR;
    } else {
        PG8_STAGE(PG8_SB(0, 0), cB, voffB); PG8_STAGE(PG8_SA(0, 0), cA, voffA); PG8_STAGE(PG8_SB(0, 1), cB + hstep, voffB); PG8_STAGE(PG8_SA(0, 1), cA + hstep, voffA);
        if (wr == 1) PG8_BAR;
        PG8_WAIT_V(4); PG8_BAR;
        PG8_STAGE(PG8_SB(1, 0), cB + kstep, voffB); PG8_STAGE(PG8_SA(1, 0), cA + kstep, voffA); PG8_STAGE(PG8_SB(1, 1), cB + hstep + kstep, voffB);
        PG8_WAIT_V(6); PG8_BAR;
    }
    for (;;) {
        const bool has_next = S.next(ui + 1, nxt);
        const char* nA = has_next ? (const char*)g.A + (size_t)nxt.pm * tstep : cA; const char* nB = has_next ? (const char*)g.Bt + (size_t)nxt.pn * tstep : cB;
        for (int t = 0; t < nt; t += 2) {
            const bool last = (t == nt - 2);
            const char* a1 = cA + (size_t)(t + 1) * kstep;
            const char* a2 = last ? nA : cA + (size_t)(t + 2) * kstep; const char* b2 = last ? nB : cB + (size_t)(t + 2) * kstep;
            const char* a3 = a2 + kstep; const char* b3 = b2 + kstep;
            if (last && has_next) S.a_ready(nxt);
            if constexpr (SP2) {
            PG8_LDB(B0, 0, 0); PG8_LDB(B1, 0, 1); PG8_SCHED; PG8_LDA(At, 0, 0); PG8_STAGE(PG8_SA(1, 1), a1 + hstep, voffA);
            PG8_WAIT_V(8); PG8_WAIT_L(0); PG8_BAR; PG8_MMA(0, 0, At, B0); PG8_MMA(0, 1, At, B1); PG8_BAR; PG8_SCHED;
            PG8_LDA(At, 0, 1); PG8_STAGE(PG8_SB(0, 0), b2, voffB); PG8_STAGE(PG8_SB(0, 1), b2 + hstep, voffB); PG8_STAGE(PG8_SA(0, 0), a2, voffA);
            PG8_WAIT_V(8); PG8_WAIT_L(0); PG8_BAR; PG8_MMA(1, 0, At, B0); PG8_MMA(1, 1, At, B1); PG8_BAR; PG8_SCHED;
            PG8_LDB(B0, 1, 0); PG8_LDB(B1, 1, 1); PG8_SCHED; PG8_LDA(At, 1, 0); PG8_STAGE(PG8_SA(0, 1), a2 + hstep, voffA);
            PG8_WAIT_V(8); PG8_WAIT_L(0); PG8_BAR; PG8_MMA(0, 0, At, B0); PG8_MMA(0, 1, At, B1); PG8_BAR; PG8_SCHED;
            PG8_LDA(At, 1, 1); PG8_STAGE(PG8_SB(1, 0), b3, voffB); PG8_STAGE(PG8_SB(1, 1), b3 + hstep, voffB); PG8_STAGE(PG8_SA(1, 0), a3, voffA);
            PG8_WAIT_V(8); PG8_WAIT_L(0); PG8_BAR; PG8_MMA(1, 0, At, B0); PG8_MMA(1, 1, At, B1); PG8_BAR; PG8_SCHED;
            } else {
            PG8_LDB(B0, 0, 0); PG8_SCHED; PG8_LDA(At, 0, 0); PG8_STAGE(PG8_SA(1, 1), a1 + hstep, voffA);
            PG8_WAIT_L(8); PG8_BAR; PG8_WAIT_L(0); PG8_MMA(0, 0, At, B0); PG8_BAR; PG8_SCHED;
            PG8_LDB(B1, 0, 1); PG8_STAGE(PG8_SB(0, 0), b2, voffB);
            PG8_BAR; PG8_WAIT_L(0); PG8_MMA(0, 1, At, B1); PG8_BAR;
            PG8_LDA(At, 0, 1); PG8_STAGE(PG8_SA(0, 0), a2, voffA);
            PG8_BAR; PG8_WAIT_L(0); PG8_MMA(1, 0, At, B0); PG8_BAR; PG8_SCHED;
            PG8_STAGE(PG8_SB(0, 1), b2 + hstep, voffB);
            PG8_WAIT_V(6); PG8_BAR; PG8_MMA(1, 1, At, B1); PG8_BAR;
            PG8_LDB(B0, 1, 0); PG8_SCHED; PG8_LDA(At, 1, 0); PG8_STAGE(PG8_SA(0, 1), a2 + hstep, voffA);
            PG8_WAIT_L(8); PG8_BAR; PG8_WAIT_L(0); PG8_MMA(0, 0, At, B0); PG8_BAR; PG8_SCHED;
            PG8_LDB(B1, 1, 1); PG8_STAGE(PG8_SB(1, 0), b3, voffB);
            PG8_BAR; PG8_WAIT_L(0); PG8_MMA(0, 1, At, B1); PG8_BAR;
            PG8_LDA(At, 1, 1); PG8_STAGE(PG8_SA(1, 0), a3, voffA);
            PG8_BAR; PG8_WAIT_L(0); PG8_MMA(1, 0, At, B0); PG8_BAR; PG8_SCHED;
            PG8_STAGE(PG8_SB(1, 1), b3 + hstep, voffB);
            PG8_WAIT_V(6); PG8_BAR; PG8_MMA(1, 1, At, B1); PG8_BAR;
            }
        }
        if constexpr (ALIGN_EPI) { if (wr == 0) PG8_BAR; }
        if constexpr (!Epi::AFTER_DRAIN) { E(acc, cur, wr, wc, fr, fq); S.done(cur); }
        if (!has_next) break;
#pragma unroll
        for (int a = 0; a < 2; ++a)
#pragma unroll
            for (int b = 0; b < 2; ++b)
#pragma unroll
                for (int m = 0; m < 4; ++m)
#pragma unroll
                    for (int n = 0; n < 2; ++n) acc[a][b][m][n] = (f32x4){0.f, 0.f, 0.f, 0.f};
        cur = nxt; cA = nA; cB = nB; ++ui;
        if constexpr (ALIGN_EPI) { if (wr == 1) PG8_BAR; }
    }
    PG8_WAIT_V(0);
    if constexpr (!ALIGN_EPI) { if (wr == 0) PG8_BAR; }
    PG8_BAR;
    if constexpr (Epi::AFTER_DRAIN) { E.fused(acc, cur, wr, wc, fr, fq, lds, wid, lane); S.done(cur); }
#undef PG8_SA
#undef PG8_SB
#undef PG8_STAGE
#undef PG8_LDA
#undef PG8_LDB
#undef PG8_MMA
#undef PG8_WAIT_V
#undef PG8_WAIT_L
#undef PG8_BAR
#undef PG8_SCHED
}
}
#include <hip/hip_bf16.h>
#include <cmath>
namespace attn_body {
using bf16=__hip_bfloat16;
using bf16x8=__attribute__((ext_vector_type(8)))short;
using s16x4=__attribute__((ext_vector_type(4)))short;
using f32x16=__attribute__((ext_vector_type(16)))float;
using u32x4=__attribute__((ext_vector_type(4)))unsigned;
constexpr int BATCH=8,NHEAD=16,SEQ=8192,D=64,DM=NHEAD*D,DMI=512,DMO=1024;
constexpr int NW=8,QBLK=32,QB=QBLK*NW,KVBLK=64,NQB=SEQ/QB;
constexpr int ATTN_PITCH=DM, ATTN_UNIT_ROWS=QB;
__device__ __forceinline__ int crow(int r,int hi){return (r&3)+8*(r>>2)+4*hi;}
#define SBAR() __builtin_amdgcn_sched_barrier(0)
__device__ __forceinline__ void cmask(f32x16&p0,f32x16&p1,int jb,int qrel,int hi){
  const float NEG=-INFINITY; int kb=64*jb+4*hi;
  #pragma unroll
  for(int r=0;r<16;++r){ if(jb>(qrel>>6)){p0[r]=NEG;p1[r]=NEG;} } (void)kb;
}

constexpr int NSLOT=3, SLOTB=8192;
constexpr int LDS_K=0, LDS_V=NSLOT*SLOTB, LDS_WS=2*NSLOT*SLOTB, LDS_OST=LDS_WS+NW*64*4, LDS_BYTES=LDS_OST+NW*4096;
constexpr float C2=0.125f*1.4426950408889634f;
__device__ __forceinline__ void glds16(const void*gsrc,unsigned lds_dst){unsigned keep;
  asm volatile("s_mov_b32 %0, m0\n\ts_mov_b32 m0, %2\n\ts_nop 0\n\tglobal_load_lds_dwordx4 %1, off\n\ts_mov_b32 m0, %0":"=&s"(keep):"v"(gsrc),"s"(lds_dst):"memory");}
__device__ __forceinline__ float max3f(float a,float b,float c){float r;asm("v_max3_f32 %0, %1, %2, %3":"=v"(r):"v"(a),"v"(b),"v"(c));return r;}
__device__ __forceinline__ float max2f(float a,float b){float r;asm("v_max_f32_e32 %0, %1, %2":"=v"(r):"v"(a),"v"(b));return r;}
__device__ __forceinline__ float fadd_s(float a,float b){float r;asm("v_add_f32_e32 %0, %1, %2":"=v"(r):"v"(a),"v"(b));return r;}
__device__ __forceinline__ float fsub_s(float a,float b){float r;asm("v_sub_f32_e32 %0, %1, %2":"=v"(r):"v"(a),"v"(b));return r;}
typedef float f32x2_t __attribute__((ext_vector_type(2))); typedef __bf16 bf16x2_t __attribute__((ext_vector_type(2)));
__device__ __forceinline__ unsigned cvtpk_s(float lo,float hi){f32x2_t v={lo,hi};bf16x2_t b=__builtin_convertvector(v,bf16x2_t);return __builtin_bit_cast(unsigned,b);}
#define WAIT_BAR(N) asm volatile("s_waitcnt vmcnt(" #N ") lgkmcnt(0)\n\ts_barrier":::"memory")

__device__ __forceinline__ void qkt(f32x16&p0,f32x16&p1,const char*Kslot,const bf16x8*qr,const f32x16&negm,int r32,int hi){
  const char*kb=Kslot+hi*1024+r32*16;
  #pragma unroll
  for(int d0=0;d0<4;++d0){
    const bf16x8 b0=*reinterpret_cast<const bf16x8*>(kb+d0*2048);
    const bf16x8 b1=*reinterpret_cast<const bf16x8*>(kb+d0*2048+512);
    if(d0==0){p0=__builtin_amdgcn_mfma_f32_32x32x16_bf16(b0,qr[0],negm,0,0,0);p1=__builtin_amdgcn_mfma_f32_32x32x16_bf16(b1,qr[0],negm,0,0,0);}
    else{p0=__builtin_amdgcn_mfma_f32_32x32x16_bf16(b0,qr[d0],p0,0,0,0);p1=__builtin_amdgcn_mfma_f32_32x32x16_bf16(b1,qr[d0],p1,0,0,0);}}
}
typedef __attribute__((address_space(3))) const char* lds_cptr;
typedef short v4i16_t __attribute__((ext_vector_type(4)));
__device__ __forceinline__ void kload8(bf16x8*kf,lds_cptr kp){
  kf[0]=*(const __attribute__((address_space(3))) bf16x8*)(kp);      kf[1]=*(const __attribute__((address_space(3))) bf16x8*)(kp+512);
  kf[2]=*(const __attribute__((address_space(3))) bf16x8*)(kp+2048); kf[3]=*(const __attribute__((address_space(3))) bf16x8*)(kp+2560);
  kf[4]=*(const __attribute__((address_space(3))) bf16x8*)(kp+4096); kf[5]=*(const __attribute__((address_space(3))) bf16x8*)(kp+4608);
  kf[6]=*(const __attribute__((address_space(3))) bf16x8*)(kp+6144); kf[7]=*(const __attribute__((address_space(3))) bf16x8*)(kp+6656);
}
__device__ __forceinline__ void kload2(bf16x8*kf,lds_cptr kp,int j){ kf[2*j]=*(const __attribute__((address_space(3))) bf16x8*)(kp+j*2048); kf[2*j+1]=*(const __attribute__((address_space(3))) bf16x8*)(kp+j*2048+512); }
__device__ __forceinline__ s16x4 vtr(lds_cptr p){ return __builtin_bit_cast(s16x4,__builtin_amdgcn_ds_read_tr16_b64_v4i16((__attribute__((address_space(3))) v4i16_t*)p)); }
__device__ __forceinline__ float rowmax(const f32x16&p0,const f32x16&p1){
  float a=max3f(p0[0],p0[1],p1[0]),b=max3f(p0[2],p0[3],p1[1]);a=max3f(a,p1[2],p1[3]);
  #pragma unroll
  for(int r=4;r<16;r+=4){a=max3f(a,p0[r],p0[r+1]);b=max3f(b,p0[r+2],p0[r+3]);a=max3f(a,p1[r],p1[r+1]);b=max3f(b,p1[r+2],p1[r+3]);}
  const float m=max2f(a,b);
  auto rr=__builtin_amdgcn_permlane32_swap(__float_as_uint(m),__float_as_uint(m),false,false);
  return max2f(__uint_as_float(rr[0]),__uint_as_float(rr[1]));
}
__device__ __forceinline__ void pv(f32x16*o,int vb,bf16x8 pa0,bf16x8 pa1,bf16x8 pa2,bf16x8 pa3){
  #pragma unroll
  for(int d0=0;d0<2;++d0){s16x4 lo[4],hi[4];
    #pragma unroll
    for(int ks=0;ks<4;++ks){
      asm volatile("ds_read_b64_tr_b16 %0,%1 offset:%c2":"=&v"(lo[ks]):"v"(vb),"i"(d0*4096+ks*1024):"memory");
      asm volatile("ds_read_b64_tr_b16 %0,%1 offset:%c2":"=&v"(hi[ks]):"v"(vb),"i"(d0*4096+ks*1024+512):"memory");}
    asm volatile("s_waitcnt lgkmcnt(0)":::"memory");SBAR();
    #define PK(k) (bf16x8){lo[k][0],lo[k][1],lo[k][2],lo[k][3],hi[k][0],hi[k][1],hi[k][2],hi[k][3]}
    o[d0]=__builtin_amdgcn_mfma_f32_32x32x16_bf16(pa0,PK(0),o[d0],0,0,0);
    o[d0]=__builtin_amdgcn_mfma_f32_32x32x16_bf16(pa1,PK(1),o[d0],0,0,0);
    o[d0]=__builtin_amdgcn_mfma_f32_32x32x16_bf16(pa2,PK(2),o[d0],0,0,0);
    o[d0]=__builtin_amdgcn_mfma_f32_32x32x16_bf16(pa3,PK(3),o[d0],0,0,0);
    #undef PK
  }
}

#ifndef ATTN_STORE16
#define ATTN_STORE16(p,v) (*(u32x4*)(p)=(v))
#endif
template<int THRL> __device__ __forceinline__ void attn_unit(int b,int h,int qb,const bf16*Q,const bf16*__restrict__ K,const bf16*__restrict__ V,bf16*O,char*shm,const int wv_){
  int tid_o=wv_*64+(int)__builtin_amdgcn_mbcnt_hi(~0u,__builtin_amdgcn_mbcnt_lo(~0u,0u)); asm volatile("":"+v"(tid_o)); tid_o&=511;
  const int tid=tid_o,lane=tid&63,r32=lane&31,hi=lane>>5; const int wid=__builtin_amdgcn_readfirstlane(tid>>6);
  const long rowbase=(long)b*SEQ; const int q0=qb*QB;
  const bf16*Qw=Q+(rowbase+q0+wid*QBLK)*DMI+(h>>1)*D;
  const bf16*Kh=K+rowbase*DMI+(h>>1)*D,*Vh=V+rowbase*DMI+(h>>2)*128+(h&1)*64;
  const unsigned lds0=(unsigned)(uintptr_t)shm;
  float*wsf=(float*)(shm+LDS_WS)+wid*64;
  const bf16*ksrc=Kh+(long)lane*DMI+wid*8;
  const bf16*vsrc=Vh+(long)(16*(wid&3)+(lane>>2))*DMI+(wid>>2)*32+(lane&3)*8;
  const unsigned kdst=lds0+LDS_K+wid*1024, vdst=lds0+LDS_V+wid*1024;
  #define DMA_K(t,slot) glds16(ksrc+(long)(t)*KVBLK*DMI,(unsigned)__builtin_amdgcn_readfirstlane(kdst+(slot)))
  #define DMA_V(t,slot) glds16(vsrc+(long)(t)*KVBLK*DMI,(unsigned)__builtin_amdgcn_readfirstlane(vdst+(slot)))
  const int vb0=(int)(lds0+LDS_V)+((lane>>4)&1)*32+(lane&3)*8+(4*hi+((lane&15)>>2))*64;
  const char*Kbase=shm+LDS_K; bf16x8 kf[8];
  const lds_cptr shm3=(lds_cptr)shm; const lds_cptr kp0=shm3+LDS_K+hi*1024+r32*16; const lds_cptr vp0=shm3+LDS_V+((lane>>4)&1)*32+(lane&3)*8+(4*hi+((lane&15)>>2))*64;
  const int NT=(q0+QB)/KVBLK;
  DMA_K(0,0);DMA_V(0,0);DMA_K(1,SLOTB);
  bf16x8 qr[4];
  #pragma unroll
  for(int d0=0;d0<4;++d0)qr[d0]=*reinterpret_cast<const bf16x8*>(&Qw[(long)r32*DMI+d0*16+hi*8]);
  float mhat=0.f,l_reg=0.f;f32x16 o[2];o[0]=f32x16{};o[1]=f32x16{};f32x16 negm=f32x16{};asm volatile("":"+v"(negm));
  const int qrel=wid*QBLK+r32;
  #define CMASK(P0,P1,t) do{int jb_=(t)-(NT-4); if(jb_>=0)cmask(P0,P1,jb_,qrel,hi);}while(0)
  bool resc=false;
  #define START(P0,P1) do{ const float rm=rowmax(P0,P1); resc=false; \
    { const float dl=rm; mhat=fadd_s(mhat,dl); \
      _Pragma("unroll") for(int r=0;r<16;++r){P0[r]=fsub_s(P0[r],dl);P1[r]=fsub_s(P1[r],dl);} \
      _Pragma("unroll") for(int r=0;r<16;++r)negm[r]=-mhat; asm volatile("":"+v"(negm)); } \
    _Pragma("unroll") for(int r=0;r<16;++r)P0[r]=__builtin_amdgcn_exp2f(P0[r]); }while(0)
  #define RESC() do{ if(resc){ asm volatile("s_waitcnt lgkmcnt(0)":::"memory"); \
      _Pragma("unroll") for(int d_=0;d_<2;++d_) _Pragma("unroll") for(int r=0;r<16;++r)o[d_][r]*=wsf[crow(r,hi)]; } }while(0)
  f32x16 pA0,pA1,pB0,pB1;
  int sl_prev=0,sl_cur=0,sl_next=SLOTB;
  #define ROT() do{sl_prev=sl_cur;sl_cur=sl_next;sl_next=(sl_next==(NSLOT-1)*SLOTB)?0:sl_next+SLOTB;}while(0)
  DMA_K(2,2*SLOTB);
  WAIT_BAR(3);
  qkt(pA0,pA1,Kbase,qr,negm,r32,hi);asm volatile("s_nop 15\n\ts_nop 7":"+v"(pA0),"+v"(pA1));CMASK(pA0,pA1,0);
  START(pA0,pA1);
  _Pragma("unroll") for(int r=0;r<16;++r)pA1[r]=__builtin_amdgcn_exp2f(pA1[r]);
  WAIT_BAR(0);
  DMA_K(3,0);DMA_V(1,SLOTB);
  ROT();
  kload8(kf,kp0+sl_cur);
  WAIT_BAR(2);
  s16x4 vlo[8],vhi[8]; u32x4 pw0,pw1,pw2,pw3;
  #define PKW(P,B) cvtpk_s(P[B],P[B+1])
  #define PAF(k) __builtin_bit_cast(bf16x8,pw##k)
  #define VFR(i) (bf16x8){vlo[i][0],vlo[i][1],vlo[i][2],vlo[i][3],vhi[i][0],vhi[i][1],vhi[i][2],vhi[i][3]}
  #define PIN(x) asm volatile("":"+v"(x))
  #define MX3(a,b,c) __builtin_fmaxf(__builtin_fmaxf((a),(b)),(c))
  #define GAPA(MF,A0,A1,A2,A3,W0,W1,PW) do{ MF; sacc+=A0; sacc+=A1; sacc+=A2; sacc+=A3; PIN(sacc); W0; W1; PIN(PW); SBAR(); }while(0)
  #define EX(v) __builtin_amdgcn_exp2f(v)
  #define GAPB(MF,X,B) do{ MF; X[B]=EX(X[B]); X[B+1]=EX(X[B+1]); X[B+2]=EX(X[B+2]); X[B+3]=EX(X[B+3]); PIN(X); SBAR(); }while(0)
  #define VRD(i) do{ vlo[i]=vtr(vp_+(((i)>>2)*4096+((i)&3)*1024)); vhi[i]=vtr(vp_+(((i)>>2)*4096+((i)&3)*1024+512)); }while(0)
  #define KRD(G,j) do{ if(G){ kload2(kf,kp0+sl_next,j); SBAR(); } }while(0)
  #define STEP(C0,C1,P0,P1,t,GK,GV,GL) do{ SBAR(); \
    const lds_cptr vp_=vp0+sl_prev; \
    VRD(0); SBAR(); float sacc=(P0[0]+P0[1]); \
    GAPA(C0=__builtin_amdgcn_mfma_f32_32x32x16_bf16(kf[0],qr[0],negm,0,0,0), P0[2],P0[3],P0[4],P0[5],     pw0[0]=PKW(P0,0), pw0[1]=PKW(P0,2), pw0); \
    VRD(4); SBAR(); GAPA(C1=__builtin_amdgcn_mfma_f32_32x32x16_bf16(kf[1],qr[0],negm,0,0,0), P0[6],P0[7],P0[8],P0[9],     pw0[2]=PKW(P0,4), pw0[3]=PKW(P0,6), pw0); \
    VRD(1); SBAR(); GAPA(C0=__builtin_amdgcn_mfma_f32_32x32x16_bf16(kf[2],qr[1],C0,0,0,0),   P0[10],P0[11],P0[12],P0[13], pw1[0]=PKW(P0,8), pw1[1]=PKW(P0,10), pw1); \
    VRD(5); SBAR(); GAPA(C1=__builtin_amdgcn_mfma_f32_32x32x16_bf16(kf[3],qr[1],C1,0,0,0),   P0[14],P0[15],P1[0],P1[1],   pw1[2]=PKW(P0,12),pw1[3]=PKW(P0,14), pw1); \
    VRD(2); SBAR(); GAPA(C0=__builtin_amdgcn_mfma_f32_32x32x16_bf16(kf[4],qr[2],C0,0,0,0),   P1[2],P1[3],P1[4],P1[5],     pw2[0]=PKW(P1,0), pw2[1]=PKW(P1,2), pw2); \
    VRD(6); SBAR(); GAPA(C1=__builtin_amdgcn_mfma_f32_32x32x16_bf16(kf[5],qr[2],C1,0,0,0),   P1[6],P1[7],P1[8],P1[9],     pw2[2]=PKW(P1,4), pw2[3]=PKW(P1,6), pw2); \
    VRD(3); SBAR(); GAPA(C0=__builtin_amdgcn_mfma_f32_32x32x16_bf16(kf[6],qr[3],C0,0,0,0),   P1[10],P1[11],P1[12],P1[13], pw3[0]=PKW(P1,8), pw3[1]=PKW(P1,10), pw3); \
    VRD(7); SBAR(); GAPA(C1=__builtin_amdgcn_mfma_f32_32x32x16_bf16(kf[7],qr[3],C1,0,0,0),   P1[14],P1[15],0.f,0.f,       pw3[2]=PKW(P1,12),pw3[3]=PKW(P1,14), pw3); \
    l_reg+=sacc; \
    if(GK){DMA_K((t)+3,sl_cur);} if(GV){DMA_V((t)+1,sl_next);} \
    CMASK(C0,C1,t); \
    { float a=MX3(C0[0],C0[1],C1[0]),b=MX3(C0[2],C0[3],C1[1]); a=MX3(a,C1[2],C1[3]); \
      _Pragma("unroll") for(int r=4;r<16;r+=4){a=MX3(a,C0[r],C0[r+1]);b=MX3(b,C0[r+2],C0[r+3]);a=MX3(a,C1[r],C1[r+1]);b=MX3(b,C1[r+2],C1[r+3]);} \
      float rm=__builtin_fmaxf(a,b); { auto rr=__builtin_amdgcn_permlane32_swap(__float_as_uint(rm),__float_as_uint(rm),false,false); rm=__builtin_fmaxf(__uint_as_float(rr[0]),__uint_as_float(rr[1])); } \
      resc=false; \
      if(__builtin_expect(__any(rm>(float)THRL),0)){ const float dl=__builtin_fmaxf(rm,0.f); mhat+=dl; \
        _Pragma("unroll") for(int r=0;r<16;++r){C0[r]-=dl;C1[r]-=dl;} \
        _Pragma("unroll") for(int r=0;r<16;++r)negm[r]=-mhat; asm volatile("":"+v"(negm)); \
        const float f=__builtin_amdgcn_exp2f(-dl); l_reg*=f; if(hi==0)wsf[r32]=f; resc=true; } } \
    SBAR(); \
    GAPB(o[0]=__builtin_amdgcn_mfma_f32_32x32x16_bf16(PAF(0),VFR(0),o[0],0,0,0), C0,0); \
    GAPB(o[1]=__builtin_amdgcn_mfma_f32_32x32x16_bf16(PAF(0),VFR(4),o[1],0,0,0), C0,4); \
    KRD(GL,0); GAPB(o[0]=__builtin_amdgcn_mfma_f32_32x32x16_bf16(PAF(1),VFR(1),o[0],0,0,0), C0,8); \
    KRD(GL,1); GAPB(o[1]=__builtin_amdgcn_mfma_f32_32x32x16_bf16(PAF(1),VFR(5),o[1],0,0,0), C0,12); \
    KRD(GL,2); GAPB(o[0]=__builtin_amdgcn_mfma_f32_32x32x16_bf16(PAF(2),VFR(2),o[0],0,0,0), C1,0); \
    KRD(GL,3); GAPB(o[1]=__builtin_amdgcn_mfma_f32_32x32x16_bf16(PAF(2),VFR(6),o[1],0,0,0), C1,4); \
    GAPB(o[0]=__builtin_amdgcn_mfma_f32_32x32x16_bf16(PAF(3),VFR(3),o[0],0,0,0), C1,8); \
    GAPB(o[1]=__builtin_amdgcn_mfma_f32_32x32x16_bf16(PAF(3),VFR(7),o[1],0,0,0), C1,12); \
    }while(0)
  int t=1;
  #undef CMASK
  #define CMASK(P0,P1,t) do{}while(0)
  for(;t+5<NT;t+=2){
    STEP(pB0,pB1,pA0,pA1,t,true,true,true);     WAIT_BAR(2); RESC(); ROT();
    STEP(pA0,pA1,pB0,pB1,t+1,true,true,true);   WAIT_BAR(2); RESC(); ROT();
  }
  #undef CMASK
  #define CMASK(P0,P1,t) do{int jb_=(t)-(NT-4); if(jb_>=0)cmask(P0,P1,jb_,qrel,hi);}while(0)
  #define ENDW(tt) do{ if((tt)+3<NT){WAIT_BAR(2);} else if((tt)+2<NT){WAIT_BAR(1);} else {WAIT_BAR(0);} }while(0)
  for(;t+1<NT;t+=2){
    STEP(pB0,pB1,pA0,pA1,t,(t+3<NT),(t+1<NT),(t+1<NT));       ENDW(t);   RESC(); ROT();
    STEP(pA0,pA1,pB0,pB1,t+1,(t+4<NT),(t+2<NT),(t+2<NT));     ENDW(t+1); RESC(); ROT();
  }
  STEP(pB0,pB1,pA0,pA1,NT-1,false,false,false); RESC();
  { float sacc=pB0[0]+pB0[1]; _Pragma("unroll") for(int r=2;r<16;++r)sacc+=pB0[r]; _Pragma("unroll") for(int r=0;r<16;++r)sacc+=pB1[r]; l_reg+=sacc;
    pw0=(u32x4){PKW(pB0,0),PKW(pB0,2),PKW(pB0,4),PKW(pB0,6)};pw1=(u32x4){PKW(pB0,8),PKW(pB0,10),PKW(pB0,12),PKW(pB0,14)};pw2=(u32x4){PKW(pB1,0),PKW(pB1,2),PKW(pB1,4),PKW(pB1,6)};pw3=(u32x4){PKW(pB1,8),PKW(pB1,10),PKW(pB1,12),PKW(pB1,14)};
    SBAR(); pv(o,vb0+sl_cur,PAF(0),PAF(1),PAF(2),PAF(3)); }
  #undef PKW
  #undef PAF
  #undef VFR
  #undef PIN
  #undef MX3
  #undef GAPA
  #undef GAPB
  #undef EX
  #undef VRD
  #undef KRD
  #undef STEP
  #undef ENDW
  {auto rr=__builtin_amdgcn_permlane32_swap(__float_as_uint(l_reg),__float_as_uint(l_reg),false,false);l_reg=__uint_as_float(rr[0])+__uint_as_float(rr[1]);}
  if(hi==0)wsf[32+r32]=l_reg;asm volatile("s_waitcnt lgkmcnt(0)":::"memory");
  float rli[16];
  #pragma unroll
  for(int r=0;r<16;++r)rli[r]=__builtin_amdgcn_rcpf(wsf[32+crow(r,hi)]);
  bf16*Ow=O+(rowbase+q0+wid*QBLK)*DMO+h*D;
  { bf16*stg=(bf16*)(shm+LDS_OST)+wid*2048;
    #pragma unroll
    for(int r=0;r<16;++r){const int orow=crow(r,hi);
      #pragma unroll
      for(int d0=0;d0<2;++d0)stg[orow*64+d0*32+r32]=__float2bfloat16(o[d0][r]*rli[r]);}
    asm volatile("s_waitcnt lgkmcnt(0)":::"memory");
    #pragma unroll
    for(int i=0;i<4;++i){const int row=i*8+(lane>>3),ch=lane&7; const u32x4 v=*(const u32x4*)(stg+row*64+ch*8); ATTN_STORE16(Ow+(long)row*DMO+ch*8,v);} }
  asm volatile("s_waitcnt lgkmcnt(0)\n\ts_barrier":::"memory");
  #undef DMA_K
  #undef DMA_V
  #undef CMASK
  #undef START
  #undef RESC
  #undef ROT
}
constexpr int ATTN_LDS_BYTES=LDS_BYTES;
struct AttnTensors { const bf16* Q; const bf16* K; const bf16* V; bf16* O; };
struct AttnUnit { int bh; int qb; };
struct StaticOrder {
  int vcu;
  __device__ __forceinline__ explicit StaticOrder(int grid,int block):vcu((block%8)*(grid/8)+block/8){}
  __device__ __forceinline__ bool next(int i,AttnUnit&u)const{ if(i>=4)return false; const int s=vcu&7; u.bh=vcu>>3; u.qb=(i==0)?s:(i==1)?15-s:(i==2)?16+s:31-s; return true; }
  __device__ __forceinline__ void a_ready(const AttnUnit&)const{}
  __device__ __forceinline__ void done(const AttnUnit&)const{}
};
template<class Sched,int THRL=8> __device__ __forceinline__ void attn_phase(char*lds,const AttnTensors&T,const Sched&S){
  AttnUnit u;
  for(int i=0;S.next(i,u);++i){ S.a_ready(u); attn_unit<THRL>(u.bh/NHEAD,u.bh%NHEAD,u.qb,T.Q,T.K,T.V,T.O,lds); S.done(u); }
}
#undef SBAR
#undef WAIT_BAR
}

#define LAS __attribute__((address_space(3)))
typedef unsigned short bfu;
typedef unsigned v4u __attribute__((ext_vector_type(4)));
typedef unsigned v2u __attribute__((ext_vector_type(2)));
typedef float f32x4 __attribute__((ext_vector_type(4)));
typedef float f32x8 __attribute__((ext_vector_type(8)));
typedef float f32x16 __attribute__((ext_vector_type(16)));
typedef float f32x2 __attribute__((ext_vector_type(2)));

constexpr int NWAVES = 8, NTHR = 512;
constexpr int MP = 65536, MS = 128, MR = MP + MS, MPAD = 65792;
constexpr int NIN = 3840, FFD = 4096;
constexpr int NPHASE = 24;
#ifndef MK_ONE_LAUNCH
#define MK_ONE_LAUNCH 1
#endif

constexpr size_t O_Y = 0;
constexpr size_t O_YS = (size_t)MP * 1024;
constexpr size_t O_ACP = O_YS + 128 * 1024;
constexpr size_t O_ADP = O_ACP + 2 * 8 * 3 * 768;
constexpr size_t O_BKP = O_ADP + 2 * 8 * 4 * 64 * 64;
constexpr size_t O_BVP = O_BKP + (size_t)2 * 8 * 8192 * 512;
constexpr size_t O_CSP = O_BVP + (size_t)2 * 8 * 8192 * 512;
constexpr size_t O_CWP = O_CSP + 2 * 8 * 1024;
constexpr size_t O_ACS = O_CWP + 2 * 8 * 4 * 64 * 64;
constexpr size_t O_ADS = O_ACS + 2 * 8 * 3 * 768;
constexpr size_t O_BKS = O_ADS + 2 * 8 * 4 * 64 * 64;
constexpr size_t O_BVS = O_BKS + 2 * 8 * 16 * 512;
constexpr size_t O_CSS = O_BVS + 2 * 8 * 16 * 512;
constexpr size_t O_CWS = O_CSS + 2 * 8 * 1024;
constexpr size_t O_END = O_CWS + 2 * 8 * 4 * 64 * 64;
static_assert(O_END == 202874880, "output size");

constexpr size_t MiB = 1u << 20;
constexpr size_t WS_CTL = 0;
constexpr size_t WS_RS = 64 * 1024;
constexpr size_t WS_BONUS = 2 * MiB;
constexpr size_t WS_GAB = 3 * MiB + 512 * 1024;
constexpr size_t WS_AB = 6 * MiB;
constexpr size_t WS_ROPE = 8 * MiB + 512 * 1024;
constexpr size_t WS_GCH = 10 * MiB + 512 * 1024;
constexpr size_t WS_W = 12 * MiB;
constexpr size_t W_IN = 0, W_OUT = W_IN + (size_t)NIN * 1024 * 2, W_FF1 = W_OUT + 1024 * 1024 * 2, W_FF2 = W_FF1 + 4096 * 1024 * 2,
                 W_GATE = W_FF2 + 4096 * 1024 * 2, W_PP = W_GATE + 1024 * 1024 * 2, W_LR = W_PP + 1024 * 256 * 2, W_END = W_LR + 768 * 256 * 2;
constexpr size_t WS_SLOT = 41 * MiB;
constexpr size_t USLOT = (size_t)MPAD * 1024;
static_assert(WS_W + W_END <= WS_SLOT, "weights");
constexpr size_t WS_PAIRC = WS_SLOT + 15 * USLOT;
constexpr size_t WS_PAIRD = WS_PAIRC + 4 * (size_t)(MPAD / 2) * 16;
constexpr size_t WS_TOTAL = WS_PAIRD + 4 * (size_t)(MPAD / 2) * 8;
static_assert(WS_TOTAL <= (size_t)1024 * MiB, "ws");
static_assert(WS_RS + 7 * (size_t)MPAD * 4 <= WS_BONUS && WS_BONUS + 4 * (size_t)MPAD * 4 <= WS_GAB && WS_GAB + 8 * (size_t)MPAD * 4 <= WS_AB && WS_AB + 8 * (size_t)MPAD * 4 <= WS_ROPE && WS_ROPE + 8192 * 64 * 4 <= WS_GCH && WS_GCH + 4 * 1032 * 64 * 4 <= WS_W, "ctl map");

__device__ __forceinline__ unsigned char* slotp(unsigned char* ws, int l, int s) {
    if (l & 1) { if (s < 2) s += 13; else if (s >= 13) s -= 13; }
    return ws + WS_SLOT + (size_t)s * USLOT;
}
__device__ __forceinline__ unsigned char* slotph(unsigned char* ws, int l, int s) { return slotp(ws, l, s) + USLOT / 2; }

constexpr int RING_BYTES = 131072, MISC_OFF = RING_BYTES + 320, LDS_BYTES = 147456;

#define LDS_WAIT() asm volatile("s_waitcnt lgkmcnt(0)" ::: "memory")
__device__ __forceinline__ float bf2f(unsigned short u) { return __uint_as_float(((unsigned)u) << 16); }
__device__ __forceinline__ unsigned f2bf(float f) { unsigned u = __builtin_bit_cast(unsigned, f); return (u + 0x7fffu + ((u >> 16) & 1u)) >> 16; }
__device__ __forceinline__ unsigned pk2(float lo, float hi) { return f2bf(lo) | (f2bf(hi) << 16); }
#define DPP_ROR_ADD(v, ctrl) ((v) + __builtin_bit_cast(float, __builtin_amdgcn_update_dpp(0, __builtin_bit_cast(int, (v)), (ctrl), 0xf, 0xf, false)))
__device__ __forceinline__ float wave_sum(float v) {
    v = DPP_ROR_ADD(v, 0x128); v = DPP_ROR_ADD(v, 0x124); v = DPP_ROR_ADD(v, 0x122); v = DPP_ROR_ADD(v, 0x121);
    v += __shfl_xor(v, 16);
    const unsigned u = __float_as_uint(v); auto rr = __builtin_amdgcn_permlane32_swap(u, u, false, false);
    return __uint_as_float(rr[0]) + __uint_as_float(rr[1]);
}
__device__ __forceinline__ float sigm(float x) { return 1.f / (1.f + __expf(-x)); }
__device__ __forceinline__ float softplusf(float x) { return x > 20.f ? x : log1pf(__expf(x)); }

struct Args { const float* in[40]; float* out; unsigned char* ws; int ph_lo, ph_hi; };
typedef const __attribute__((address_space(4))) Args* KArgs;

constexpr float ATT_C2 = 0.125f * 1.4426950408889634f;
struct EpiG1 {
    static constexpr bool PERM = false, AFTER_DRAIN = false;
    const float* rs; bfu *aqkvz, *qb, *kb, *vb, *craw; float* ab; const float* rope; float *okp, *ovp, *oks, *ovs;
    __device__ __forceinline__ void operator()(const pg8::f32x4 (&acc)[2][2][4][2], const pg8::Unit& u, int wr, int wc, int fr, int fq) const {
        const int pn = u.pn; const int rowb = u.pm * 256 + wr * 64 + fr; const int cl = wc * 32 + 4 * fq;
#pragma unroll
        for (int ai = 0; ai < 2; ++ai)
#pragma unroll
            for (int m = 0; m < 4; ++m) {
                const int row = rowb + ai * 128 + m * 16;
                const float s = rsqrtf(rs[row] * (1.f / 1024.f) + 1e-6f);
                if (pn < 4 || (pn >= 10 && pn < 14)) {
                    bfu* dst = (pn < 4 ? aqkvz + pn * 256 : craw + (pn - 10) * 256) + (size_t)row * 1024 + cl;
#pragma unroll
                    for (int bj = 0; bj < 2; ++bj)
#pragma unroll
                        for (int n = 0; n < 2; ++n) { const pg8::f32x4 v = acc[ai][bj][m][n] * s; v2u w; w.x = pg8::cvt_pk_bf16(v[0], v[1]); w.y = pg8::cvt_pk_bf16(v[2], v[3]); *(v2u*)(dst + bj * 128 + n * 16) = w; }
                } else if (pn < 8) {
                    const bool isk = pn >= 6;
                    const int pos = row < MP ? (row & 8191) : 2048 + ((row - MP) & 15);
                    const int i0 = (wc & 1) * 16 + 4 * fq;
                    const pg8::f32x4 c4 = *(const pg8::f32x4*)(rope + pos * 64 + i0), s4 = *(const pg8::f32x4*)(rope + pos * 64 + 32 + i0);
#pragma unroll
                    for (int bj = 0; bj < 2; ++bj) {
                        const pg8::f32x4 x1 = acc[ai][bj][m][0] * s, x2 = acc[ai][bj][m][1] * s;
                        pg8::f32x4 o1 = x1 * c4 - x2 * s4, o2 = x2 * c4 + x1 * s4;
                        if (!isk) {
                            o1 = o1 * ATT_C2; o2 = o2 * ATT_C2;
                            bfu* d = qb + (size_t)row * 512 + (pn - 4) * 256 + bj * 128 + cl;
                            v2u w; w.x = pg8::cvt_pk_bf16(o1[0], o1[1]); w.y = pg8::cvt_pk_bf16(o1[2], o1[3]); *(v2u*)d = w;
                            w.x = pg8::cvt_pk_bf16(o2[0], o2[1]); w.y = pg8::cvt_pk_bf16(o2[2], o2[3]); *(v2u*)(d + 16) = w;
                        } else {
                            bfu* d = kb + (size_t)row * 512 + (pn - 6) * 256 + bj * 128 + cl;
                            v2u w; w.x = pg8::cvt_pk_bf16(o1[0], o1[1]); w.y = pg8::cvt_pk_bf16(o1[2], o1[3]); *(v2u*)d = w;
                            w.x = pg8::cvt_pk_bf16(o2[0], o2[1]); w.y = pg8::cvt_pk_bf16(o2[2], o2[3]); *(v2u*)(d + 16) = w;
                            if (row < MR) {
                                float* ob = (row < MP ? okp + (size_t)row * 512 : oks + (size_t)(row - MP) * 512) + (pn - 6) * 256 + bj * 128 + (wc >> 1) * 64 + (wc & 1) * 16 + 4 * fq;
                                *(pg8::f32x4*)ob = o1; *(pg8::f32x4*)(ob + 32) = o2;
                            }
                        }
                    }
                } else if (pn < 10) {
#pragma unroll
                    for (int bj = 0; bj < 2; ++bj)
#pragma unroll
                        for (int n = 0; n < 2; ++n) {
                            const pg8::f32x4 v = acc[ai][bj][m][n] * s; const int col = (pn - 8) * 256 + bj * 128 + cl + n * 16;
                            v2u w; w.x = pg8::cvt_pk_bf16(v[0], v[1]); w.y = pg8::cvt_pk_bf16(v[2], v[3]); *(v2u*)(vb + (size_t)row * 512 + col) = w;
                            if (row < MR) { float* ob = (row < MP ? ovp + (size_t)row * 512 : ovs + (size_t)(row - MP) * 512) + col; *(pg8::f32x4*)ob = v; }
                        }
                } else {
                    if (wc == 0 && fq < 2) { const pg8::f32x4 v = acc[ai][0][m][0] * s; *(pg8::f32x4*)(ab + (size_t)row * 8 + 4 * fq) = v; }
                }
            }
    }
};
template <int MODE> struct EpiB {
    static constexpr bool PERM = false, AFTER_DRAIN = false;
    bfu* O; int ldc; const float* rs;
    __device__ __forceinline__ void operator()(const pg8::f32x4 (&acc)[2][2][4][2], const pg8::Unit& u, int wr, int wc, int fr, int fq) const {
        const int rowb = u.pm * 256 + wr * 64 + fr; const int cl = u.pn * 256 + wc * 32 + 4 * fq;
#pragma unroll
        for (int ai = 0; ai < 2; ++ai)
#pragma unroll
            for (int m = 0; m < 4; ++m) {
                const int row = rowb + ai * 128 + m * 16;
                float s = 1.f; if (MODE == 1) s = rsqrtf(rs[row] * (1.f / 1024.f) + 1e-6f);
                bfu* dst = O + (size_t)row * ldc + cl;
#pragma unroll
                for (int bj = 0; bj < 2; ++bj)
#pragma unroll
                    for (int n = 0; n < 2; ++n) {
                        pg8::f32x4 v = acc[ai][bj][m][n];
                        if (MODE == 1) { v = v * s; v[0] = fmaxf(v[0], 0.f); v[1] = fmaxf(v[1], 0.f); v[2] = fmaxf(v[2], 0.f); v[3] = fmaxf(v[3], 0.f); v = v * v; }
                        v2u w; w.x = pg8::cvt_pk_bf16(v[0], v[1]); w.y = pg8::cvt_pk_bf16(v[2], v[3]); *(v2u*)(dst + bj * 128 + n * 16) = w;
                    }
            }
    }
};
template <int MODE> struct EpiH {
    static constexpr bool PERM = false, AFTER_DRAIN = false;
    float* H; bfu* xh; float* rsn; const float* rs; const bfu* pp;
    __device__ __forceinline__ void operator()(const pg8::f32x4 (&acc)[2][2][4][2], const pg8::Unit& u, int wr, int wc, int fr, int fq) const {
        const int rowb = u.pm * 256 + wr * 64 + fr; const int cl = u.pn * 256 + wc * 32 + 4 * fq;
#pragma unroll
        for (int ai = 0; ai < 2; ++ai)
#pragma unroll
            for (int m = 0; m < 4; ++m) {
                const int row = rowb + ai * 128 + m * 16; const bool valid = row < MR; float ss = 0.f;
                if (valid) {
                    float s = 1.f; if (MODE == 3) s = rsqrtf(rs[row] * (1.f / 1024.f) + 1e-6f);
#pragma unroll
                    for (int bj = 0; bj < 2; ++bj)
#pragma unroll
                        for (int n = 0; n < 2; ++n) {
                            const size_t off = (size_t)row * 1024 + cl + bj * 128 + n * 16;
                            pg8::f32x4 h = *(const pg8::f32x4*)(H + off); const pg8::f32x4 a = acc[ai][bj][m][n];
                            if (MODE == 3) { const v2u pw = *(const v2u*)(pp + off);
                                h[0] += sigm(a[0] * s) * __uint_as_float(pw.x << 16); h[1] += sigm(a[1] * s) * __uint_as_float(pw.x & 0xffff0000u);
                                h[2] += sigm(a[2] * s) * __uint_as_float(pw.y << 16); h[3] += sigm(a[3] * s) * __uint_as_float(pw.y & 0xffff0000u);
                            } else h = h + a;
                            *(pg8::f32x4*)(H + off) = h;
                            v2u w; w.x = pg8::cvt_pk_bf16(h[0], h[1]); w.y = pg8::cvt_pk_bf16(h[2], h[3]); *(v2u*)(xh + off) = w;
                            ss += (h[0] * h[0] + h[1] * h[1]) + (h[2] * h[2] + h[3] * h[3]);
                        }
                }
                ss += __shfl_xor(ss, 16); ss += __shfl_xor(ss, 32);
                if (valid && fq == 0) unsafeAtomicAdd(rsn + row, ss);
            }
    }
};

__device__ __forceinline__ int win_src(int nd) {
    if (nd < 1024) return nd;
    if (nd < 2048) { const int c = nd - 1024, p = c & 63, grp = c >> 6; const int s = p >> 5, n_ = (p >> 4) & 1, r = p & 15; return 1032 + grp * 64 + n_ * 32 + s * 16 + r; }
    if (nd < 2560) return 2056 + (nd - 2048);
    if (nd < 3584) return 2568 + (nd - 2560);
    if (nd < 3592) return 1024 + (nd - 3584);
    return -1;
}
template <bool MAP> __device__ __forceinline__ void wt_item(const float* W, int K, int Nsrc, bfu* WT, const float* gain, LAS float* scr, int item, int nblk, int lane) {
    const int kb = item / nblk, nb = item % nblk, k0 = 64 * kb, n0 = 32 * nb;
    const int nd = n0 + (lane & 31); const int src = MAP ? win_src(nd) : nd;
#pragma unroll 8
    for (int i = 0; i < 32; ++i) { const int kk = 2 * i + (lane >> 5); float v = src >= 0 ? W[(size_t)(k0 + kk) * Nsrc + src] : 0.f; if (gain) v *= gain[k0 + kk]; scr[kk * 33 + (lane & 31)] = v; }
    LDS_WAIT(); asm volatile("" ::: "memory");
    const int c = lane & 7;
#pragma unroll
    for (int j = 0; j < 4; ++j) { const int n = (lane >> 3) + 8 * j; const LAS float* s = scr + (8 * c) * 33 + n;
        v4u o; o.x = pk2(s[0 * 33], s[1 * 33]); o.y = pk2(s[2 * 33], s[3 * 33]); o.z = pk2(s[4 * 33], s[5 * 33]); o.w = pk2(s[6 * 33], s[7 * 33]);
        *(v4u*)(WT + (size_t)(n0 + n) * K + k0 + 8 * c) = o; }
    LDS_WAIT(); asm volatile("" ::: "memory");
}
__device__ __forceinline__ void conv_weights(KArgs A, int l, int mask, LAS unsigned char* lds, int gw, int NGW, int lane, int wave) {
    LAS float* scr = (LAS float*)(lds + wave * 16384);
    unsigned char* wb = A->ws + WS_W;
    if (mask & 1) {
        const float* win = A->in[11] + (size_t)l * 1024 * 3592; const float* g = A->in[10] + l * 1024;
        for (int it = gw; it < 16 * 120; it += NGW) wt_item<true>(win, 1024, 3592, (bfu*)(wb + W_IN), g, scr, it, 120, lane);
        const float* wu = A->in[23] + (size_t)l * 64 * 256; const float* au = A->in[25] + (size_t)l * 64 * 256; const float* gu = A->in[26] + (size_t)l * 128 * 256;
        bfu* lr = (bfu*)(wb + W_LR);
        for (int i = gw * 64 + lane; i < 768 * 256; i += NGW * 64) { const int n = i >> 8, k = i & 255; float v = 0.f;
            if (n < 256) { if (k < 64) v = wu[k * 256 + n]; } else if (n < 512) { if (k >= 64 && k < 128) v = au[(k - 64) * 256 + (n - 256)]; } else { if (k >= 128) v = gu[(k - 128) * 256 + (n - 512)]; }
            lr[i] = (bfu)f2bf(v); }
    }
    if (mask & 2) {
        const float* wo = A->in[32] + (size_t)l * 1024 * 1024; const float* f1 = A->in[34] + (size_t)l * 1024 * 4096; const float* f2 = A->in[35] + (size_t)l * 4096 * 1024;
        const float* wg = A->in[37] + (size_t)l * 1024 * 1024; const float* wp = A->in[38] + (size_t)l * 256 * 1024;
        const float* gf = A->in[33] + l * 1024; const float* gp = A->in[36] + l * 1024;
        constexpr int I_O = 16 * 32, I_1 = 16 * 128, I_2 = 64 * 32, I_G = 16 * 32, I_P = 4 * 32;
        for (int it = gw; it < I_O + I_1 + I_2 + I_G + I_P; it += NGW) {
            int r = it;
            if (r < I_O) { wt_item<false>(wo, 1024, 1024, (bfu*)(wb + W_OUT), nullptr, scr, r, 32, lane); continue; } r -= I_O;
            if (r < I_1) { wt_item<false>(f1, 1024, 4096, (bfu*)(wb + W_FF1), gf, scr, r, 128, lane); continue; } r -= I_1;
            if (r < I_2) { wt_item<false>(f2, 4096, 1024, (bfu*)(wb + W_FF2), nullptr, scr, r, 32, lane); continue; } r -= I_2;
            if (r < I_G) { wt_item<false>(wg, 1024, 1024, (bfu*)(wb + W_GATE), gp, scr, r, 32, lane); continue; } r -= I_G;
            wt_item<false>(wp, 256, 1024, (bfu*)(wb + W_PP), nullptr, scr, r, 32, lane);
        }
    }
}
__device__ __forceinline__ void conv_p(KArgs A, int l, bfu* pb, int gtid, int NT) {
    const float* pp = A->in[8] + (size_t)l * MP * 256; const float* ps = A->in[9] + (size_t)l * MS * 256;
    for (int i = gtid; i < MR * 64; i += NT) { const int m = i >> 6, c = (i & 63) * 4;
        const f32x4 v = *(const f32x4*)(m < MP ? pp + (size_t)m * 256 + c : ps + (size_t)(m - MP) * 256 + c);
        v2u w; w.x = pk2(v[0], v[1]); w.y = pk2(v[2], v[3]); *(v2u*)(pb + (size_t)m * 256 + c) = w; }
}
__device__ __forceinline__ void prologue(KArgs A, LAS unsigned char* lds, int gw, int NGW, int lane, int wave, int gtid, int NT) {
    conv_weights(A, 0, 3, lds, gw, NGW, lane, wave);
    unsigned char* ws = A->ws;
    float* rs = (float*)(ws + WS_RS); bfu* xh = (bfu*)slotp(ws, 0, 0); float* H = A->out;
    for (int i = gtid; i < 6 * MPAD; i += NT) rs[MPAD + i] = 0.f;
    for (int m = gw; m < MPAD; m += NGW) {
        if (m < MR) {
            const float* xr = m < MP ? A->in[0] + (size_t)m * 1024 : A->in[1] + (size_t)(m - MP) * 1024; float ss = 0.f;
#pragma unroll
            for (int j = 0; j < 4; ++j) { const f32x4 v = *(const f32x4*)(xr + j * 256 + lane * 4); *(f32x4*)(H + (size_t)m * 1024 + j * 256 + lane * 4) = v;
                v2u w; w.x = pk2(v[0], v[1]); w.y = pk2(v[2], v[3]); *(v2u*)(xh + (size_t)m * 1024 + j * 256 + lane * 4) = w; ss += (v[0] * v[0] + v[1] * v[1]) + (v[2] * v[2] + v[3] * v[3]); }
            ss = wave_sum(ss); if (lane == 0) rs[m] = ss;
        } else {
#pragma unroll
            for (int j = 0; j < 4; ++j) *(v2u*)(xh + (size_t)m * 1024 + j * 256 + lane * 4) = (v2u){0u, 0u};
            if (lane == 0) rs[m] = 1024.f;
        }
    }
    float* rope = (float*)(ws + WS_ROPE);
    for (int i = gtid; i < 8192 * 32; i += NT) { const int pos = i >> 5, k = i & 31;
        const float inv = exp2f(-(float)k * (13.287712379549449f / 32.0f)); const float ang = (float)pos * inv;
        const float nn = rintf(ang * 0.15915494309189535f); const float fr = fmaf(-nn, 1.9353071795864769e-3f, fmaf(-nn, 6.28125f, ang));
        rope[pos * 64 + k] = __cosf(fr); rope[pos * 64 + 32 + k] = __sinf(fr); }
    if (gw == 0) {
        for (int l = 0; l < 2; ++l) {
            const float a = wave_sum(A->in[16][l * 64 + lane] * A->in[17][l * 64 + lane]), b = wave_sum(A->in[18][l * 64 + lane] * A->in[19][l * 64 + lane]);
            const float li = 0.8f - 0.6f * expf(-0.3f * (float)l);
            if (lane == 0) { float* lf = (float*)(ws + WS_CTL + 1024); lf[2 * l] = expf(a) - expf(b) + li; lf[2 * l + 1] = li; }
        }
    }
}

__device__ __forceinline__ void prep_a(KArgs A, int l, int gw, int NGW, int lane) {
    unsigned char* ws = A->ws;
    const bfu* aq = (const bfu*)slotp(ws, l, 2); const float* ab = (const float*)(ws + WS_AB);
    float* sia = (float*)slotp(ws, l, 9); bfu* va = (bfu*)slotp(ws, l, 11); bfu* zs = (bfu*)slotph(ws, l, 11); float* gab = (float*)(ws + WS_GAB);
    const float* cw = A->in[12] + l * 4 * 768; const float* stc = A->in[4] + (size_t)l * 8 * 3 * 768;
    const float* anorm = A->in[15] + l * 64;
    for (int m = gw; m < MR; m += NGW) {
        int t, L, sb = 0; const bool smp = m >= MP; float* aco;
        if (!smp) { t = m & 8191; L = 8192; aco = A->out + O_ACP + ((size_t)(l * 8 + (m >> 13)) * 3) * 768; }
        else { sb = (m - MP) >> 4; t = (m - MP) & 15; L = 16; aco = A->out + O_ACS + ((size_t)(l * 8 + sb) * 3) * 768; }
#pragma unroll 1
        for (int h = 0; h < 4; ++h) {
            float val[3];
#pragma unroll
            for (int g = 0; g < 3; ++g) {
                const int c = g * 256 + h * 64 + lane; float x[4];
#pragma unroll
                for (int d = 0; d < 4; ++d) { const int tt = t - d;
                    x[d] = tt >= 0 ? bf2f(aq[(size_t)(m - d) * 1024 + c]) : (smp ? stc[((size_t)sb * 3 + (3 + tt)) * 768 + c] : 0.f); }
                const float y = x[3] * cw[c] + x[2] * cw[768 + c] + x[1] * cw[1536 + c] + x[0] * cw[2304 + c];
                val[g] = y * sigm(y);
                if (t >= L - 3) aco[(size_t)(t - (L - 3)) * 768 + c] = x[0];
            }
            const float sq = wave_sum(val[0] * val[0]), sk = wave_sum(val[1] * val[1]);
            const float qn = val[0] * rsqrtf(sq + 1e-6f) * 0.125f, kn = val[1] * rsqrtf(sk + 1e-6f);
            float* rec = sia + ((size_t)(h * 8 + (lane >> 3)) * MPAD + m) * 16 + (lane & 7);
            rec[0] = kn; rec[8] = qn;
            va[(size_t)m * 256 + h * 64 + lane] = (bfu)f2bf(val[2]);
            const float z = bf2f(aq[(size_t)m * 1024 + 768 + h * 64 + lane]);
            zs[(size_t)m * 256 + h * 64 + lane] = (bfu)f2bf(z * sigm(z) * anorm[lane]);
        }
        if (lane < 4) { const int h = lane;
            const float g = -__expf(A->in[13][l * 4 + h]) * softplusf(ab[(size_t)m * 8 + h] + A->in[14][l * 4 + h]);
            gab[((size_t)h * MPAD + m) * 2] = __expf(g); gab[((size_t)h * MPAD + m) * 2 + 1] = sigm(ab[(size_t)m * 8 + 4 + h]); }
    }
}
__device__ __forceinline__ void prep_c1(KArgs A, int l, int gw, int NGW, int lane) {
    unsigned char* ws = A->ws;
    const bfu* cr = (const bfu*)slotp(ws, l, 7); bfu* lra = (bfu*)slotp(ws, l, 12);
    const float* mu = A->in[21] + l * 1024; const float* sts = A->in[6] + (size_t)l * 8 * 1024;
    for (int m = gw; m < MR; m += NGW) {
        int t, L, sb = 0; const bool smp = m >= MP; float* cso;
        if (!smp) { t = m & 8191; L = 8192; cso = A->out + O_CSP + (size_t)(l * 8 + (m >> 13)) * 1024; }
        else { sb = (m - MP) >> 4; t = (m - MP) & 15; L = 16; cso = A->out + O_CSS + (size_t)(l * 8 + sb) * 1024; }
#pragma unroll
        for (int i = 0; i < 4; ++i) { const int j = 768 + lane + 64 * i;
            const float cur = bf2f(cr[(size_t)m * 1024 + j]);
            const float prev = t > 0 ? bf2f(cr[(size_t)(m - 1) * 1024 + j]) : (smp ? sts[(size_t)sb * 1024 + j] : 0.f);
            const float c = cur + (prev - cur) * mu[j];
            const float o = i == 0 ? tanhf(c) : (i == 1 ? c : sigm(c));
            lra[(size_t)m * 256 + lane + 64 * i] = (bfu)f2bf(o); }
        if (t == L - 1) {
#pragma unroll
            for (int i = 0; i < 16; ++i) cso[lane + 64 * i] = bf2f(cr[(size_t)m * 1024 + lane + 64 * i]);
        }
    }
}
__device__ __forceinline__ void prep_c2(KArgs A, int l, int bid, int G, int tid) {
    unsigned char* ws = A->ws;
    const bfu* cr = (const bfu*)slotp(ws, l, 7); const bfu* lro = (const bfu*)slotp(ws, l, 13);
    bfu* v2 = (bfu*)slotp(ws, l, 12); bfu* gg = (bfu*)slotph(ws, l, 12);
    float* bonus = (float*)(ws + WS_BONUS); float* gch = (float*)(ws + WS_GCH); float* pairc = (float*)(ws + WS_PAIRC);
    const float* mu = A->in[21] + l * 1024; const float* sts = A->in[6] + (size_t)l * 8 * 1024;
    const int ch = tid & 255, h = ch >> 6, lane = ch & 63, half = tid >> 8;
    float* sic = (float*)slotp(ws, l, h) + ((size_t)(lane >> 3) * MPAD) * 32 + (lane & 7);
    const float mur = mu[ch], muk = mu[256 + ch], muv = mu[512 + ch];
    const float w0 = A->in[22][l * 256 + ch], a0 = A->in[24][l * 256 + ch], kk_ = A->in[27][l * 256 + ch], ka = A->in[28][l * 256 + ch], rk = A->in[29][l * 256 + ch];
    for (int u = bid * 2 + half; u < 1032; u += G * 2) {
        int m0, n; float pr, pk, pv;
        if (u < 1024) { m0 = u * 64; n = 64;
            if ((u & 127) == 0) { pr = pk = pv = 0.f; } else { pr = bf2f(cr[(size_t)(m0 - 1) * 1024 + ch]); pk = bf2f(cr[(size_t)(m0 - 1) * 1024 + 256 + ch]); pv = bf2f(cr[(size_t)(m0 - 1) * 1024 + 512 + ch]); } }
        else { const int sb = u - 1024; m0 = MP + sb * 16; n = 16; pr = sts[(size_t)sb * 1024 + ch]; pk = sts[(size_t)sb * 1024 + 256 + ch]; pv = sts[(size_t)sb * 1024 + 512 + ch]; }
        float cum = 0.f, pkka = 0.f, pkp = 0.f;
#pragma unroll 4
        for (int tt = 0; tt < n; ++tt) { const int m = m0 + tt;
            const float c_r = bf2f(cr[(size_t)m * 1024 + ch]), c_k = bf2f(cr[(size_t)m * 1024 + 256 + ch]), c_v = bf2f(cr[(size_t)m * 1024 + 512 + ch]);
            const float r = c_r + (pr - c_r) * mur, k = c_k + (pk - c_k) * muk, v = c_v + (pv - c_v) * muv; pr = c_r; pk = c_k; pv = c_v;
            const float lw = bf2f(lro[(size_t)m * 768 + ch]), la = bf2f(lro[(size_t)m * 768 + 256 + ch]); const bfu gb = lro[(size_t)m * 768 + 512 + ch];
            const float wl = -0.6065306597126334f * sigm(w0 + lw); const float a = sigm(a0 + la);
            const float kkr = k * kk_; const float kk = kkr * rsqrtf(wave_sum(kkr * kkr) + 1e-6f);
            const float kp = k * (1.f + (a - 1.f) * ka);
            const float Gp = __expf(cum); cum += wl; const float Gc = __expf(cum), iG = __expf(-cum);
            float* rec = sic + (size_t)m * 32;
            rec[0] = kk * Gp; rec[8] = kk * a * iG; rec[16] = kp * iG; rec[24] = r * Gc;
            { const float kka = kk * a; float* pc = pairc + ((size_t)h * (MPAD / 2) + (m >> 1)) * 4;
              if (tt & 1) { const float c22 = wave_sum(pkka * kk), c32 = wave_sum(pkp * kk); if (lane == 0) { pc[0] = c22; pc[1] = c32; } }
              else { const float c24 = wave_sum(kka * r), c34 = wave_sum(kp * r); if (lane == 0) { pc[2] = c24; pc[3] = c34; } }
              pkka = kka; pkp = kp; }
            const float bo = wave_sum(r * kp * rk); if (lane == 0) bonus[(size_t)h * MPAD + m] = bo;
            v2[(size_t)m * 256 + ch] = (bfu)f2bf(v); gg[(size_t)m * 256 + ch] = gb;
        }
        gch[((size_t)h * 1032 + u) * 64 + lane] = __expf(cum);
    }
}
__device__ __forceinline__ void prep_a2(KArgs A, int l, int gw, int NGW, int lane) {
    unsigned char* ws = A->ws; const float* sia = (const float*)slotp(ws, l, 9); float* paird = (float*)(ws + WS_PAIRD);
    for (int task = gw; task < 4 * (MR / 2); task += NGW) { const int h = task & 3, pr = task >> 2, m = 2 * pr;
        const float* rec = sia + ((size_t)(h * 8 + (lane >> 3)) * MPAD + m) * 16 + (lane & 7);
        const float k1 = rec[0], q1 = rec[8], k2 = rec[16];
        const float g12 = wave_sum(k1 * k2), h11 = wave_sum(q1 * k1);
        if (lane == 0) { paird[((size_t)h * (MPAD / 2) + pr) * 2] = g12; paird[((size_t)h * (MPAD / 2) + pr) * 2 + 1] = h11; } }
}
__device__ __forceinline__ void post_attn(KArgs A, int l, int gw, int NGW, int lane) {
    unsigned char* ws = A->ws;
    const bfu* O = (const bfu*)slotp(ws, l, 13); bfu* mix = (bfu*)slotp(ws, l, 7);
    const float* lf = (const float*)(ws + WS_CTL + 1024); const float lam = lf[2 * l], omli = 1.f - lf[2 * l + 1];
    const int h = lane >> 4, e0 = (lane & 15) * 8; const float* bn = A->in[20] + l * 128 + e0;
    float bnv[8];
#pragma unroll
    for (int i = 0; i < 8; ++i) bnv[i] = bn[i] * omli;
    for (int m = gw; m < MP; m += NGW) {
        const v4u a = *(const v4u*)(O + (size_t)m * 1024 + (4 * h + (e0 >> 6)) * 64 + (e0 & 63));
        const v4u b = *(const v4u*)(O + (size_t)m * 1024 + (4 * h + 2 + (e0 >> 6)) * 64 + (e0 & 63));
        float o[8]; float ss = 0.f;
#pragma unroll
        for (int i = 0; i < 4; ++i) { const unsigned aw = a[i], bw = b[i];
            o[2 * i] = __uint_as_float(aw << 16) - lam * __uint_as_float(bw << 16); o[2 * i + 1] = __uint_as_float(aw & 0xffff0000u) - lam * __uint_as_float(bw & 0xffff0000u);
            ss += o[2 * i] * o[2 * i] + o[2 * i + 1] * o[2 * i + 1]; }
        ss += __shfl_xor(ss, 1); ss += __shfl_xor(ss, 2); ss += __shfl_xor(ss, 4); ss += __shfl_xor(ss, 8);
        const float rn = rsqrtf(ss * (1.f / 128.f) + 1e-6f);
        v4u w; w.x = pk2(o[0] * rn * bnv[0], o[1] * rn * bnv[1]); w.y = pk2(o[2] * rn * bnv[2], o[3] * rn * bnv[3]); w.z = pk2(o[4] * rn * bnv[4], o[5] * rn * bnv[5]); w.w = pk2(o[6] * rn * bnv[6], o[7] * rn * bnv[7]);
        *(v4u*)(mix + (size_t)m * 1024 + 256 + h * 128 + e0) = w;
    }
}
__device__ __forceinline__ void post_scan(KArgs A, int l, int gw, int NGW, int lane) {
    unsigned char* ws = A->ws; bfu* mix = (bfu*)slotp(ws, l, 7);
    const bfu* zs = (const bfu*)slotph(ws, l, 11); const bfu* v2 = (const bfu*)slotp(ws, l, 12); const bfu* gg = (const bfu*)slotph(ws, l, 12);
    const float* bonus = (const float*)(ws + WS_BONUS);
    for (int m = gw; m < MR; m += NGW) {
#pragma unroll
        for (int h = 0; h < 4; ++h) {
            bfu* pa = mix + (size_t)m * 1024 + h * 64 + lane; const float o = bf2f(*pa);
            const float ss = wave_sum(o * o) * (1.f / 64.f);
            *pa = (bfu)f2bf(o * rsqrtf(ss + 1e-6f) * bf2f(zs[(size_t)m * 256 + h * 64 + lane]));
            bfu* pc = mix + (size_t)m * 1024 + 768 + h * 64 + lane; const float y = bf2f(*pc);
            const float mu = wave_sum(y) * (1.f / 64.f); const float d = y - mu; const float var = wave_sum(d * d) * (1.f / 64.f);
            const float cy = d * rsqrtf(var + 64e-5f) * A->in[30][l * 256 + h * 64 + lane] + A->in[31][l * 256 + h * 64 + lane];
            *pc = (bfu)f2bf((cy + bonus[(size_t)h * MPAD + m] * bf2f(v2[(size_t)m * 256 + h * 64 + lane])) * bf2f(gg[(size_t)m * 256 + h * 64 + lane]));
        }
    }
}
__device__ __forceinline__ void final_norm(KArgs A, int gw, int NGW, int lane) {
    const float* rs = (const float*)(A->ws + WS_RS) + 6 * (size_t)MPAD; const float* g = A->in[39];
    for (int m = gw; m < MR; m += NGW) { const float s = rsqrtf(rs[m] * (1.f / 1024.f) + 1e-6f);
#pragma unroll
        for (int j = 0; j < 4; ++j) { float* p = A->out + (size_t)m * 1024 + j * 256 + lane * 4; f32x4 v = *(f32x4*)p; const f32x4 gv = *(const f32x4*)(g + j * 256 + lane * 4); v = v * s * gv; *(f32x4*)p = v; } }
}

#define SC_BAR() asm volatile("s_waitcnt lgkmcnt(0)\n\ts_barrier" ::: "memory")
constexpr int SC_RED = 0, SC_SI = 16384, SC_VBUF = 81920, SC_GBUF = 90112, SC_BON = 98304, SC_PC = 98816, SC_YP = 99328;
#define FMAC_DPP(acc, op, s1, J) asm("v_fmac_f32_dpp %0, %1, %2 row_newbcast:" #J " row_mask:0xf bank_mask:0xf" : "+v"(acc) : "v"(op), "v"(s1))
#define DOT8(a0, a1, op, JB0, JB1, JB2, JB3, JB4, JB5, JB6, JB7) do { FMAC_DPP(a0, op, S[0], JB0); FMAC_DPP(a1, op, S[1], JB1); FMAC_DPP(a0, op, S[2], JB2); FMAC_DPP(a1, op, S[3], JB3); \
        FMAC_DPP(a0, op, S[4], JB4); FMAC_DPP(a1, op, S[5], JB5); FMAC_DPP(a0, op, S[6], JB6); FMAC_DPP(a1, op, S[7], JB7); } while (0)
#define DOT8_LO(a0, a1, op) DOT8(a0, a1, op, 0, 1, 2, 3, 4, 5, 6, 7)
#define DOT8_HI(a0, a1, op) DOT8(a0, a1, op, 8, 9, 10, 11, 12, 13, 14, 15)
#define AXPY8_LO(op, s) do { FMAC_DPP(S[0], op, s, 0); FMAC_DPP(S[1], op, s, 1); FMAC_DPP(S[2], op, s, 2); FMAC_DPP(S[3], op, s, 3); FMAC_DPP(S[4], op, s, 4); FMAC_DPP(S[5], op, s, 5); FMAC_DPP(S[6], op, s, 6); FMAC_DPP(S[7], op, s, 7); } while (0)
#define AXPY8_HI(op, s) do { FMAC_DPP(S[0], op, s, 8); FMAC_DPP(S[1], op, s, 9); FMAC_DPP(S[2], op, s, 10); FMAC_DPP(S[3], op, s, 11); FMAC_DPP(S[4], op, s, 12); FMAC_DPP(S[5], op, s, 13); FMAC_DPP(S[6], op, s, 14); FMAC_DPP(S[7], op, s, 15); } while (0)
#define PKF(a, b, c) __builtin_elementwise_fma((a), (b), (c))
#define AXPYV(X0, X1, s) do { const f32x2 s_ = (f32x2){(s), (s)}; f32x2 p0_ = (f32x2){S[0], S[1]}, p1_ = (f32x2){S[2], S[3]}, p2_ = (f32x2){S[4], S[5]}, p3_ = (f32x2){S[6], S[7]}; \
        p0_ = PKF(((f32x2){X0[0], X0[1]}), s_, p0_); p1_ = PKF(((f32x2){X0[2], X0[3]}), s_, p1_); p2_ = PKF(((f32x2){X1[0], X1[1]}), s_, p2_); p3_ = PKF(((f32x2){X1[2], X1[3]}), s_, p3_); \
        S[0] = p0_[0]; S[1] = p0_[1]; S[2] = p1_[0]; S[3] = p1_[1]; S[4] = p2_[0]; S[5] = p2_[1]; S[6] = p3_[0]; S[7] = p3_[1]; } while (0)
#define RED8(V) do { const LAS f32x4* rr_ = (const LAS f32x4*)red + par_ * 512 + lane; const f32x4 q0_ = rr_[0], q1_ = rr_[64], q2_ = rr_[128], q3_ = rr_[192], q4_ = rr_[256], q5_ = rr_[320], q6_ = rr_[384], q7_ = rr_[448]; \
        V = ((q0_ + q1_) + (q2_ + q3_)) + ((q4_ + q5_) + (q6_ + q7_)); } while (0)

#define SWAPSUM(v) do { const unsigned u_ = __float_as_uint(v); auto rr_ = __builtin_amdgcn_permlane32_swap(u_, u_, false, false); v = __uint_as_float(rr_[0]) + __uint_as_float(rr_[1]); } while (0)
#define DOT4_LO(a0, a1, op) do { FMAC_DPP(a0, op, S[0], 0); FMAC_DPP(a1, op, S[1], 1); FMAC_DPP(a0, op, S[2], 2); FMAC_DPP(a1, op, S[3], 3); } while (0)
#define DOT4_HI(a0, a1, op) do { FMAC_DPP(a0, op, S[0], 4); FMAC_DPP(a1, op, S[1], 5); FMAC_DPP(a0, op, S[2], 6); FMAC_DPP(a1, op, S[3], 7); } while (0)
#define AXPY4(X, s) do { const f32x2 s_ = (f32x2){(s), (s)}; f32x2 p0_ = (f32x2){S[0], S[1]}, p1_ = (f32x2){S[2], S[3]}; p0_ = PKF(((f32x2){X[0], X[1]}), s_, p0_); p1_ = PKF(((f32x2){X[2], X[3]}), s_, p1_); S[0] = p0_[0]; S[1] = p0_[1]; S[2] = p1_[0]; S[3] = p1_[1]; } while (0)
__device__ __forceinline__ void scan_rwkv(KArgs A, int l, LAS unsigned char* lds, int h, int half, int m0, int L, int BL, int BLS, int chunk0, const float* st_in, float* st_out, int tid) {
    unsigned char* ws = A->ws;
    const int lane = tid & 63, wid = __builtin_amdgcn_readfirstlane(tid >> 6); const int kh = lane >> 5, r = lane & 31, row = 32 * half + r;
    LAS float* red = (LAS float*)(lds + SC_RED); LAS float* yred = (LAS float*)(lds + SC_YP);
    LAS float* sib = (LAS float*)(lds + SC_SI) + wid * 1024;
    LAS bfu* vbuf = (LAS bfu*)(lds + SC_VBUF); LAS float* pcs = (LAS float*)(lds + SC_PC);
    const bfu* v2 = (const bfu*)slotp(ws, l, 12);
    const float* pairc = (const float*)(ws + WS_PAIRC) + ((size_t)h * (MPAD / 2) + (m0 >> 1)) * 4;
    const float* gch = (const float*)(ws + WS_GCH) + ((size_t)h * 1032 + chunk0) * 64 + 8 * wid + 4 * kh;
    bfu* mix = (bfu*)slotp(ws, l, 7);
    const float* P = (const float*)slotp(ws, l, h) + ((size_t)wid * MPAD + m0) * 32;
    float S[4];
#pragma unroll
    for (int j = 0; j < 4; ++j) S[j] = st_in ? st_in[row * 64 + 8 * wid + 4 * kh + j] : 0.f;
    const int nblk = L >> BLS; const int srow = tid >> 4, sc4 = tid & 15; const bool sval = srow < BL;
    const int nsi = BL >> 3;
    f32x4 ssi[4]; v2u sv = {0, 0}; float sp_ = 0.f;
#define RW_STAGE(c) do { const float* ps_ = P + (size_t)(c) * BL * 32 + lane * 4; \
        _Pragma("unroll") for (int i_ = 0; i_ < 4; ++i_) if (i_ < nsi) ssi[i_] = *(const f32x4*)(ps_ + i_ * 256); \
        if (sval) { const size_t mm = (size_t)(m0 + (c) * BL + srow) * 256 + h * 64 + sc4 * 4; sv = *(const v2u*)(v2 + mm); } \
        if (tid < 2 * BL) sp_ = pairc[(size_t)(c) * BL * 2 + tid]; } while (0)
#define RW_COMMIT(c) do { LAS float* pd_ = sib + ((c) & 1) * 8192 + lane * 4; \
        _Pragma("unroll") for (int i_ = 0; i_ < 4; ++i_) if (i_ < nsi) *(LAS f32x4*)(pd_ + i_ * 256) = ssi[i_]; \
        if (sval) { *(LAS v2u*)(vbuf + ((c) & 1) * 2048 + srow * 64 + sc4 * 4) = sv; } \
        if (tid < 2 * BL) pcs[((c) & 1) * 64 + tid] = sp_; } while (0)
    __syncthreads();
    RW_STAGE(0); RW_COMMIT(0); if (nblk > 1) RW_STAGE(1);
    const int dsel = ((lane & 4) ? 24 : 0) + 4 * kh + (lane & 3);
    float ca0, ca1, cb0 = 0.f, cb1 = 0.f; f32x4 cau[4], cbu[4];
#define RW_LOADOPS(D, T) do { const LAS float* pb_ = sib + ((((T) >> BLS) & 1) * 8192) + ((T) & (BL - 1)) * 32; \
        D##0 = pb_[dsel]; D##1 = pb_[32 + dsel]; const LAS f32x4* pu_ = (const LAS f32x4*)(pb_ + 4 * kh); \
        D##u[0] = pu_[2]; D##u[1] = pu_[4]; D##u[2] = pu_[10]; D##u[3] = pu_[12]; } while (0)
    RW_LOADOPS(ca, 0);
#define RW_FINAL(T) do { const int tf_ = (T); \
        const LAS float* yr_ = yred + (tf_ & 15) * 512 + lane; const float y_ = ((yr_[0] + yr_[64]) + (yr_[128] + yr_[192])) + ((yr_[256] + yr_[320]) + (yr_[384] + yr_[448])); \
        if (lane < 32) mix[(size_t)(m0 + tf_) * 1024 + 768 + h * 64 + row] = (bfu)f2bf(y_); } while (0)
#define RW_ROUND(C, N, T) do { const int par_ = ((T) >> 1) & 1; \
        float d1a = 0.f, d1b = 0.f, d2a = 0.f, d2b = 0.f, f1a = 0.f, f1b = 0.f; \
        DOT4_LO(d1a, d1b, C##0); DOT4_LO(d2a, d2b, C##1); DOT4_HI(f1a, f1b, C##0); \
        float d1 = d1a + d1b, d2 = d2a + d2b, f1 = f1a + f1b; SWAPSUM(d1); SWAPSUM(d2); SWAPSUM(f1); \
        ((LAS f32x4*)red)[(par_ * 8 + wid) * 64 + lane] = (f32x4){d1, d2, f1, 0.f}; \
        SC_BAR(); \
        f32x4 tot_; RED8(tot_); \
        const int bo_ = (((T) >> BLS) & 1), to_ = (T) & (BL - 1); \
        const float v1 = bf2f(vbuf[bo_ * 2048 + to_ * 64 + row]), v2_ = bf2f(vbuf[bo_ * 2048 + to_ * 64 + 64 + row]); const f32x4 pc_ = *(const LAS f32x4*)(pcs + bo_ * 64 + to_ * 2); \
        asm volatile("" ::: "memory"); \
        if ((T) + 2 < L) RW_LOADOPS(N, (T) + 2); \
        __builtin_amdgcn_sched_barrier(0); \
        const float sa1 = -tot_[0]; const float sa2 = -(tot_[1] + sa1 * pc_[0] + v1 * pc_[1]); const float y1 = tot_[2] + sa1 * pc_[2] + v1 * pc_[3]; \
        AXPY4(C##u[1], v1); AXPY4(C##u[0], sa1); AXPY4(C##u[3], v2_); AXPY4(C##u[2], sa2); \
        float y2a = 0.f, y2b = 0.f; DOT4_HI(y2a, y2b, C##1); float y2 = y2a + y2b; SWAPSUM(y2); \
        yred[((T) & 15) * 512 + wid * 64 + lane] = y1 * 0.125f; yred[(((T) + 1) & 15) * 512 + wid * 64 + lane] = y2; } while (0)
    for (int c = 0; c < nblk; ++c) {
        for (int tt = 0; tt < BL; tt += 4) {
            const int t = c * BL + tt;
            if (tt == (BL >> 1) && c + 1 < nblk) { RW_COMMIT(c + 1); if (c + 2 < nblk) RW_STAGE(c + 2); }
            RW_ROUND(ca, cb, t);
            RW_ROUND(cb, ca, t + 2);
            if (((t + 3) & 15) == 15) { SC_BAR(); RW_FINAL(t - 12 + 2 * wid); RW_FINAL(t - 11 + 2 * wid); }
        }
        if ((((c + 1) << BLS) & 63) == 0 || c + 1 == nblk) {
            const float* ge = gch + (size_t)((c << BLS) >> 6) * 64;
#pragma unroll
            for (int j = 0; j < 4; ++j) S[j] *= ge[j];
        }
    }
#pragma unroll
    for (int j = 0; j < 4; ++j) st_out[row * 64 + 8 * wid + 4 * kh + j] = S[j];
    __syncthreads();
#undef RW_STAGE
#undef RW_COMMIT
#undef RW_LOADOPS
#undef RW_FINAL
#undef RW_ROUND
}

__device__ __forceinline__ void scan_delta(KArgs A, int l, LAS unsigned char* lds, int h, int half, int m0, int L, int BL, int BLS, const float* st_in, float* st_out, int tid) {
    unsigned char* ws = A->ws;
    const int lane = tid & 63, wid = __builtin_amdgcn_readfirstlane(tid >> 6); const int kh = lane >> 5, r = lane & 31, row = 32 * half + r;
    LAS float* red = (LAS float*)(lds + SC_RED); LAS float* yred = (LAS float*)(lds + SC_YP);
    LAS float* sib = (LAS float*)(lds + SC_SI) + wid * 512;
    LAS bfu* vbuf = (LAS bfu*)(lds + SC_VBUF); LAS float* gab = (LAS float*)(lds + SC_BON); LAS float* pds = (LAS float*)(lds + SC_PC);
    const bfu* va = (const bfu*)slotp(ws, l, 11);
    bfu* mix = (bfu*)slotp(ws, l, 7);
    const float* P = (const float*)slotp(ws, l, 9) + ((size_t)(h * 8 + wid) * MPAD + m0) * 16;
    const float* PG = (const float*)(ws + WS_GAB) + ((size_t)h * MPAD + m0) * 2;
    const float* paird = (const float*)(ws + WS_PAIRD) + ((size_t)h * (MPAD / 2) + (m0 >> 1)) * 2;
    float S[4];
#pragma unroll
    for (int j = 0; j < 4; ++j) S[j] = st_in ? st_in[(8 * wid + 4 * kh + j) * 64 + row] : 0.f;
    const int nblk = L >> BLS; const int srow = tid >> 4, sc4 = tid & 15; const bool sval = srow < BL;
    const int nsi = BL >> 4;
    f32x4 ssi[2]; v2u sv = {0, 0}; float sb_ = 0.f, sp_ = 0.f;
#define DL_STAGE(c) do { const float* ps_ = P + (size_t)(c) * BL * 16 + lane * 4; \
        _Pragma("unroll") for (int i_ = 0; i_ < 2; ++i_) if (i_ < nsi) ssi[i_] = *(const f32x4*)(ps_ + i_ * 256); \
        if (sval) { const size_t mm = (size_t)(m0 + (c) * BL + srow) * 256 + h * 64 + sc4 * 4; sv = *(const v2u*)(va + mm); } \
        if (tid < 2 * BL) sb_ = PG[(size_t)(c) * BL * 2 + tid]; if (tid < BL) sp_ = paird[(size_t)(c) * BL + tid]; } while (0)
#define DL_COMMIT(c) do { LAS float* pd_ = sib + ((c) & 1) * 4096 + lane * 4; \
        _Pragma("unroll") for (int i_ = 0; i_ < 2; ++i_) if (i_ < nsi) *(LAS f32x4*)(pd_ + i_ * 256) = ssi[i_]; \
        if (sval) { *(LAS v2u*)(vbuf + ((c) & 1) * 2048 + srow * 64 + sc4 * 4) = sv; } \
        if (tid < 2 * BL) gab[((c) & 1) * 64 + tid] = sb_; if (tid < BL) pds[((c) & 1) * 32 + tid] = sp_; } while (0)
    __syncthreads();
    DL_STAGE(0); DL_COMMIT(0); if (nblk > 1) DL_STAGE(1);
    const int dsel = ((lane & 4) ? 8 : 0) + 4 * kh + (lane & 3);
    float ca0, ca1, cb0 = 0.f, cb1 = 0.f; f32x4 cau[2], cbu[2];
#define DL_LOADOPS(D, T) do { const LAS float* pb_ = sib + ((((T) >> BLS) & 1) * 4096) + ((T) & (BL - 1)) * 16; D##0 = pb_[dsel]; D##1 = pb_[16 + dsel]; \
        const LAS f32x4* pu_ = (const LAS f32x4*)(pb_ + 4 * kh); D##u[0] = pu_[0]; D##u[1] = pu_[4]; } while (0)
    DL_LOADOPS(ca, 0);
#define DL_FINAL(T) do { const int tf_ = (T); \
        const LAS float* yr_ = yred + (tf_ & 15) * 512 + lane; const float o_ = ((yr_[0] + yr_[64]) + (yr_[128] + yr_[192])) + ((yr_[256] + yr_[320]) + (yr_[384] + yr_[448])); \
        if (lane < 32) mix[(size_t)(m0 + tf_) * 1024 + h * 64 + row] = (bfu)f2bf(o_); } while (0)
#define DL_ROUND(C, N, T) do { const int par_ = ((T) >> 1) & 1; \
        float d1a = 0.f, d1b = 0.f, d2a = 0.f, d2b = 0.f, f1a = 0.f, f1b = 0.f; \
        DOT4_LO(d1a, d1b, C##0); DOT4_LO(d2a, d2b, C##1); DOT4_HI(f1a, f1b, C##0); \
        float d1 = d1a + d1b, d2 = d2a + d2b, f1 = f1a + f1b; SWAPSUM(d1); SWAPSUM(d2); SWAPSUM(f1); \
        ((LAS f32x4*)red)[(par_ * 8 + wid) * 64 + lane] = (f32x4){d1, d2, f1, 0.f}; \
        SC_BAR(); \
        f32x4 tot_; RED8(tot_); \
        const int bo_ = (((T) >> BLS) & 1), to_ = (T) & (BL - 1); \
        const float v1 = bf2f(vbuf[bo_ * 2048 + to_ * 64 + row]), v2_ = bf2f(vbuf[bo_ * 2048 + to_ * 64 + 64 + row]); \
        const f32x4 ab_ = *(const LAS f32x4*)(gab + bo_ * 64 + to_ * 2); const f32x2 pd2_ = *(const LAS f32x2*)(pds + bo_ * 32 + to_); \
        asm volatile("" ::: "memory"); \
        if ((T) + 2 < L) DL_LOADOPS(N, (T) + 2); \
        __builtin_amdgcn_sched_barrier(0); \
        const float a1 = ab_[0], a2 = ab_[2]; const float dl1 = ab_[1] * (v1 - a1 * tot_[0]); const float dl2 = ab_[3] * (v2_ - a2 * (a1 * tot_[1] + pd2_[0] * dl1)); \
        const float o1 = a1 * tot_[2] + pd2_[1] * dl1; const float a12 = a1 * a2, dl1s = a2 * dl1; \
        _Pragma("unroll") for (int j = 0; j < 4; ++j) S[j] *= a12; \
        AXPY4(C##u[0], dl1s); AXPY4(C##u[1], dl2); \
        float y2a = 0.f, y2b = 0.f; DOT4_HI(y2a, y2b, C##1); float y2 = y2a + y2b; SWAPSUM(y2); \
        yred[((T) & 15) * 512 + wid * 64 + lane] = o1 * 0.125f; yred[(((T) + 1) & 15) * 512 + wid * 64 + lane] = y2; } while (0)
    for (int c = 0; c < nblk; ++c) {
        for (int tt = 0; tt < BL; tt += 4) {
            const int t = c * BL + tt;
            if (tt == (BL >> 1) && c + 1 < nblk) { DL_COMMIT(c + 1); if (c + 2 < nblk) DL_STAGE(c + 2); }
            DL_ROUND(ca, cb, t);
            DL_ROUND(cb, ca, t + 2);
            if (((t + 3) & 15) == 15) { SC_BAR(); DL_FINAL(t - 12 + 2 * wid); DL_FINAL(t - 11 + 2 * wid); }
        }
    }
#pragma unroll
    for (int j = 0; j < 4; ++j) st_out[(8 * wid + 4 * kh + j) * 64 + row] = S[j];
    __syncthreads();
#undef DL_STAGE
#undef DL_COMMIT
#undef DL_LOADOPS
#undef DL_FINAL
#undef DL_ROUND
}

__device__ __forceinline__ void sample_attn(KArgs A, int l, LAS unsigned char* lds, int unit, int tid) {
    unsigned char* ws = A->ws;
    const int sb = unit >> 2, h = unit & 3;
    LAS float* qs = (LAS float*)lds;
    LAS float* sc = qs + 2048;
    LAS float* scl = sc + 1024;
    LAS float* ssq = scl + 32;
    LAS float* lsum = ssq + 512;
    const bfu* qb = (const bfu*)slotp(ws, l, 4); bfu* mix = (bfu*)slotp(ws, l, 7);
    const float* ck = A->in[2] + (size_t)(l * 8 + sb) * 2048 * 512 + h * 128; const float* cv = A->in[3] + (size_t)(l * 8 + sb) * 2048 * 512 + h * 128;
    const float* nk = A->out + O_BKS + (size_t)(l * 8 + sb) * 16 * 512 + h * 128; const float* nv = A->out + O_BVS + (size_t)(l * 8 + sb) * 16 * 512 + h * 128;
    const float* lf = (const float*)(ws + WS_CTL + 1024); const float lam = lf[2 * l], omli = 1.f - lf[2 * l + 1];
    __syncthreads();
    for (int i = tid; i < 2048; i += NTHR) { const int map = i >> 10, qi = (i >> 6) & 15, p = i & 63; const int s = p >> 5, n_ = (p >> 4) & 1, r = p & 15;
        qs[(map * 16 + qi) * 64 + n_ * 32 + s * 16 + r] = bf2f(qb[(size_t)(MP + sb * 16 + qi) * 512 + h * 128 + map * 64 + p]); }
    float mrun = -1e30f, lrun = 0.f;
    const int qi = tid & 15, kj = tid >> 4, eg = tid >> 4;
    f32x4 acc0 = {0.f, 0.f, 0.f, 0.f}, acc1 = {0.f, 0.f, 0.f, 0.f};
    __syncthreads();
    for (int tile = 0; tile < 65; ++tile) {
        const int kidx = tile * 32 + kj;
        float s1 = -1e30f, s2 = -1e30f;
        if (kidx < 2064) { const float* kr = kidx < 2048 ? ck + (size_t)kidx * 512 : nk + (size_t)(kidx - 2048) * 512; s1 = 0.f; s2 = 0.f;
#pragma unroll 4
            for (int d = 0; d < 64; d += 4) { const f32x4 k1 = *(const f32x4*)(kr + d), k2 = *(const f32x4*)(kr + 64 + d); const LAS float* q1 = qs + qi * 64 + d; const LAS float* q2 = qs + (16 + qi) * 64 + d;
                s1 += q1[0] * k1[0] + q1[1] * k1[1] + q1[2] * k1[2] + q1[3] * k1[3]; s2 += q2[0] * k2[0] + q2[1] * k2[1] + q2[2] * k2[2] + q2[3] * k2[3]; } }
        sc[qi * 32 + kj] = s1; sc[(16 + qi) * 32 + kj] = s2;
        __syncthreads();
        if (tid < 32) { LAS float* r = sc + tid * 32; float mx = mrun;
#pragma unroll 8
            for (int j = 0; j < 32; ++j) mx = fmaxf(mx, r[j]);
            const float f = exp2f(mrun - mx); float su = 0.f;
#pragma unroll 8
            for (int j = 0; j < 32; ++j) { const float p = exp2f(r[j] - mx); r[j] = p; su += p; }
            lrun = lrun * f + su; mrun = mx; scl[tid] = f; }
        __syncthreads();
        { const float f0 = scl[qi], f1 = scl[16 + qi]; acc0 = acc0 * f0; acc1 = acc1 * f1;
            const int nk_ = tile < 64 ? 32 : 16;
            for (int j = 0; j < nk_; ++j) { const int kx = tile * 32 + j; const float* vr = (kx < 2048 ? cv + (size_t)kx * 512 : nv + (size_t)(kx - 2048) * 512) + eg * 4;
                const f32x4 v = *(const f32x4*)vr; acc0 = acc0 + v * sc[qi * 32 + j]; acc1 = acc1 + v * sc[(16 + qi) * 32 + j]; } }
        __syncthreads();
    }
    if (tid < 32) lsum[tid] = lrun;
    __syncthreads();
    const f32x4 o = acc0 * (1.f / lsum[qi]) - acc1 * (lam / lsum[16 + qi]);
    ssq[qi * 32 + eg] = (o[0] * o[0] + o[1] * o[1]) + (o[2] * o[2] + o[3] * o[3]);
    __syncthreads();
    float ss = 0.f;
#pragma unroll 8
    for (int j = 0; j < 32; ++j) ss += ssq[qi * 32 + j];
    const float rn = rsqrtf(ss * (1.f / 128.f) + 1e-6f) * omli; const float* bn = A->in[20] + l * 128 + eg * 4;
    v2u w; w.x = pk2(o[0] * rn * bn[0], o[1] * rn * bn[1]); w.y = pk2(o[2] * rn * bn[2], o[3] * rn * bn[3]);
    *(v2u*)(mix + (size_t)(MP + sb * 16 + qi) * 1024 + 256 + h * 128 + eg * 4) = w;
    __syncthreads();
}

#define PH_BEGIN \
        KArgs A = (KArgs)__builtin_amdgcn_kernarg_segment_ptr(); \
        int tid = wv * 64 + (int)__builtin_amdgcn_mbcnt_hi(~0u, __builtin_amdgcn_mbcnt_lo(~0u, 0u)); asm volatile("" : "+v"(tid)); tid &= 511; \
        const int bid = blockIdx.x, G = gridDim.x; \
        const int lane = tid & 63, wave = wv; \
        const int gw = bid * NWAVES + wave, NGW = G * NWAVES, gtid = bid * NTHR + tid, NT = G * NTHR; \
        unsigned char* ws = A->ws; float* rsb = (float*)(ws + WS_RS); unsigned char* wb = ws + WS_W; \
        (void)lane; (void)gw; (void)NGW; (void)gtid; (void)NT; (void)rsb; (void)wb;
#define IN(k) (lo <= (k) && (k) < hi)
__device__ __forceinline__ void grid_bar(unsigned* bar, unsigned target, bool leader) {
    asm volatile("s_waitcnt vmcnt(0) lgkmcnt(0)" ::: "memory");
    __syncthreads();
    if (leader) {
        __builtin_amdgcn_fence(__ATOMIC_RELEASE, "agent");
        asm volatile("s_waitcnt vmcnt(0)" ::: "memory");
        __hip_atomic_fetch_add(bar, 1u, __ATOMIC_RELAXED, __HIP_MEMORY_SCOPE_AGENT);
        unsigned spins = 0;
        while (__hip_atomic_load(bar, __ATOMIC_RELAXED, __HIP_MEMORY_SCOPE_AGENT) < target) { __builtin_amdgcn_s_sleep(2); if (++spins > (1u << 27)) break; }
        __builtin_amdgcn_fence(__ATOMIC_ACQUIRE, "agent");
        asm volatile("s_waitcnt vmcnt(0)" ::: "memory");
    }
    __syncthreads();
}
#define SEAM(k) do { if ((k) + 1 < hi) { ++nbar; grid_bar((unsigned*)(ws + WS_CTL + 4096), nbar * (unsigned)G, tid == 0); } } while (0)
#define SEAM_SKIP(k) do { } while (0)
__global__ void __launch_bounds__(NTHR, 2) hybrid_fwd(Args Aval) {
    extern __shared__ __attribute__((aligned(16))) unsigned char lds_raw[];
    LAS unsigned char* lds = (LAS unsigned char*)lds_raw;
    const int lo = Aval.ph_lo, hi = Aval.ph_hi; unsigned nbar = 0u;
    if (Aval.ph_lo < 0) cg::this_grid().sync();
    const int wv = __builtin_amdgcn_readfirstlane(threadIdx.x >> 6);
    if (IN(0)) { PH_BEGIN prologue(A, lds, gw, NGW, lane, wave, gtid, NT); SEAM(0); }
    { constexpr int l = 0;

        const int p0 = 1 + 11 * l;
        if (IN(p0 + 0)) { PH_BEGIN
            pg8::Gemm g{(const pg8::bf16_t*)slotp(ws, l, 0), (const pg8::bf16_t*)(wb + W_IN), MPAD, NIN, 1024};
            pg8::StaticOrder S; S.init(MPAD, NIN, G, bid);
            EpiG1 E{rsb + (size_t)(3 * l) * MPAD, (bfu*)slotp(ws, l, 2), (bfu*)slotp(ws, l, 4), (bfu*)slotp(ws, l, 5), (bfu*)slotp(ws, l, 6), (bfu*)slotp(ws, l, 7), (float*)(ws + WS_AB), (const float*)(ws + WS_ROPE),
                    A->out + O_BKP + (size_t)l * MP * 512, A->out + O_BVP + (size_t)l * MP * 512, A->out + O_BKS + (size_t)l * MS * 512, A->out + O_BVS + (size_t)l * MS * 512};
            pg8::gemm_phase<EpiG1, pg8::StaticOrder, true, true>((PG8_LAS unsigned char*)lds, g, S, E, wv);
            SEAM(p0 + 0); }
        if (IN(p0 + 1)) { PH_BEGIN
            prep_a(A, l, gw, NGW, lane); prep_c1(A, l, gw, NGW, lane);
            if (l == 1) conv_weights(A, 1, 2, lds, gw, NGW, lane, wave);
            SEAM(p0 + 1); }
        if (IN(p0 + 2)) { PH_BEGIN
            pg8::Gemm g{(const pg8::bf16_t*)slotp(ws, l, 12), (const pg8::bf16_t*)(wb + W_LR), MPAD, 768, 256};
            pg8::StaticOrder S; S.init(MPAD, 768, G, bid);
            EpiB<0> E{(bfu*)slotp(ws, l, 13), 768, nullptr};
            pg8::gemm_phase<EpiB<0>, pg8::StaticOrder, true, true>((PG8_LAS unsigned char*)lds, g, S, E, wv);
            SEAM(p0 + 2); }
        if (IN(p0 + 3)) { PH_BEGIN prep_c2(A, l, bid, G, tid); prep_a2(A, l, gw, NGW, lane);
            SEAM(p0 + 3); }
        if (IN(p0 + 4)) { PH_BEGIN
            if (bid < 64) { const int st = bid >> 1, half = bid & 1, b = st >> 2, h = st & 3;
                scan_rwkv(A, l, lds, h, half, b * 8192, 8192, 32, 5, b * 128, nullptr, A->out + O_CWP + (size_t)((l * 8 + b) * 4 + h) * 4096, tid);
                scan_rwkv(A, l, lds, h, half, MP + b * 16, 16, 16, 4, 1024 + b, A->in[7] + (size_t)((l * 8 + b) * 4 + h) * 4096, A->out + O_CWS + (size_t)((l * 8 + b) * 4 + h) * 4096, tid);
            } else if (bid < 128) { const int st = (bid - 64) >> 1, half = bid & 1, b = st >> 2, h = st & 3;
                scan_delta(A, l, lds, h, half, b * 8192, 8192, 32, 5, nullptr, A->out + O_ADP + (size_t)((l * 8 + b) * 4 + h) * 4096, tid);
                scan_delta(A, l, lds, h, half, MP + b * 16, 16, 16, 4, A->in[5] + (size_t)((l * 8 + b) * 4 + h) * 4096, A->out + O_ADS + (size_t)((l * 8 + b) * 4 + h) * 4096, tid);
            } else if (bid < 160) { sample_attn(A, l, lds, bid - 128, tid); }
            __syncthreads();
            unsigned* ctr = (unsigned*)(ws + WS_CTL) + 16 * l; volatile LAS unsigned* qw = (volatile LAS unsigned*)(lds + MISC_OFF);
            const attn_body::bf16* Q = (const attn_body::bf16*)slotp(ws, l, 4); const attn_body::bf16* K = (const attn_body::bf16*)slotp(ws, l, 5); const attn_body::bf16* V = (const attn_body::bf16*)slotp(ws, l, 6);
            attn_body::bf16* O = (attn_body::bf16*)slotp(ws, l, 13);
            for (;;) {
                if (tid == 0) qw[0] = atomicAdd(ctr, 1u);
                __syncthreads();
                const unsigned u = qw[0];
                __syncthreads();
                if (u >= 4096u) break;
                const int qb = 31 - (int)(u >> 7), bh = (int)(u & 127);
                attn_body::attn_unit<8>(bh >> 4, bh & 15, qb, Q, K, V, O, (char*)lds_raw, wv);
            }
            SEAM(p0 + 4); }
        if (IN(p0 + 5)) { PH_BEGIN
            post_attn(A, l, gw, NGW, lane); post_scan(A, l, gw, NGW, lane);
            conv_p(A, l, (bfu*)slotp(ws, l, 10), gtid, NT);
            if (l == 0) conv_weights(A, 1, 1, lds, gw, NGW, lane, wave);
            SEAM(p0 + 5); }
        if (IN(p0 + 6)) { PH_BEGIN
            pg8::Gemm g{(const pg8::bf16_t*)slotp(ws, l, 7), (const pg8::bf16_t*)(wb + W_OUT), MPAD, 1024, 1024};
            pg8::StaticOrder S; S.init(MPAD, 1024, G, bid);
            EpiH<2> E{A->out, (bfu*)slotp(ws, l, 0), rsb + (size_t)(3 * l + 1) * MPAD, nullptr, nullptr};
            pg8::gemm_phase<EpiH<2>, pg8::StaticOrder, true, true>((PG8_LAS unsigned char*)lds, g, S, E, wv);
            SEAM(p0 + 6); }
        if (IN(p0 + 7)) { PH_BEGIN
            pg8::Gemm g{(const pg8::bf16_t*)slotp(ws, l, 0), (const pg8::bf16_t*)(wb + W_FF1), MPAD, FFD, 1024};
            pg8::StaticOrder S; S.init(MPAD, FFD, G, bid);
            EpiB<1> E{(bfu*)slotp(ws, l, 2), FFD, rsb + (size_t)(3 * l + 1) * MPAD};
            pg8::gemm_phase<EpiB<1>, pg8::StaticOrder, true, true>((PG8_LAS unsigned char*)lds, g, S, E, wv);
            {
                pg8::Gemm g2{(const pg8::bf16_t*)slotp(ws, l, 10), (const pg8::bf16_t*)(wb + W_PP), MPAD, 1024, 256};
                pg8::StaticOrder S2; S2.init(MPAD, 1024, G, bid);
                EpiB<0> E2{(bfu*)slotp(ws, l, 11), 1024, nullptr};
                pg8::gemm_phase<EpiB<0>, pg8::StaticOrder, true, true>((PG8_LAS unsigned char*)lds, g2, S2, E2, wv); }
            SEAM(p0 + 7); }
        if (IN(p0 + 8)) { PH_BEGIN
            pg8::Gemm g{(const pg8::bf16_t*)slotp(ws, l, 2), (const pg8::bf16_t*)(wb + W_FF2), MPAD, 1024, FFD};
            pg8::StaticOrder S; S.init(MPAD, 1024, G, bid);
            EpiH<2> E{A->out, (bfu*)slotp(ws, l, 0), rsb + (size_t)(3 * l + 2) * MPAD, nullptr, nullptr};
            pg8::gemm_phase<EpiH<2>, pg8::StaticOrder, true, true>((PG8_LAS unsigned char*)lds, g, S, E, wv);
            SEAM(p0 + 8); }
        if (IN(p0 + 9)) { PH_BEGIN SEAM_SKIP(p0 + 9); }
        if (IN(p0 + 10)) { PH_BEGIN
            pg8::Gemm g{(const pg8::bf16_t*)slotp(ws, l, 0), (const pg8::bf16_t*)(wb + W_GATE), MPAD, 1024, 1024};
            pg8::StaticOrder S; S.init(MPAD, 1024, G, bid);
            EpiH<3> E{A->out, (bfu*)slotp(ws, l, 13), rsb + (size_t)(3 * l + 3) * MPAD, rsb + (size_t)(3 * l + 2) * MPAD, (const bfu*)slotp(ws, l, 11)};
            pg8::gemm_phase<EpiH<3>, pg8::StaticOrder, true, true>((PG8_LAS unsigned char*)lds, g, S, E, wv);
            SEAM(p0 + 10); }
        }
    { constexpr int l = 1;

        const int p0 = 1 + 11 * l;
        if (IN(p0 + 0)) { PH_BEGIN
            pg8::Gemm g{(const pg8::bf16_t*)slotp(ws, l, 0), (const pg8::bf16_t*)(wb + W_IN), MPAD, NIN, 1024};
            pg8::StaticOrder S; S.init(MPAD, NIN, G, bid);
            EpiG1 E{rsb + (size_t)(3 * l) * MPAD, (bfu*)slotp(ws, l, 2), (bfu*)slotp(ws, l, 4), (bfu*)slotp(ws, l, 5), (bfu*)slotp(ws, l, 6), (bfu*)slotp(ws, l, 7), (float*)(ws + WS_AB), (const float*)(ws + WS_ROPE),
                    A->out + O_BKP + (size_t)l * MP * 512, A->out + O_BVP + (size_t)l * MP * 512, A->out + O_BKS + (size_t)l * MS * 512, A->out + O_BVS + (size_t)l * MS * 512};
            pg8::gemm_phase<EpiG1, pg8::StaticOrder, true, true>((PG8_LAS unsigned char*)lds, g, S, E, wv);
            SEAM(p0 + 0); }
        if (IN(p0 + 1)) { PH_BEGIN
            prep_a(A, l, gw, NGW, lane); prep_c1(A, l, gw, NGW, lane);
            if (l == 1) conv_weights(A, 1, 2, lds, gw, NGW, lane, wave);
            SEAM(p0 + 1); }
        if (IN(p0 + 2)) { PH_BEGIN
            pg8::Gemm g{(const pg8::bf16_t*)slotp(ws, l, 12), (const pg8::bf16_t*)(wb + W_LR), MPAD, 768, 256};
            pg8::StaticOrder S; S.init(MPAD, 768, G, bid);
            EpiB<0> E{(bfu*)slotp(ws, l, 13), 768, nullptr};
            pg8::gemm_phase<EpiB<0>, pg8::StaticOrder, true, true>((PG8_LAS unsigned char*)lds, g, S, E, wv);
            SEAM(p0 + 2); }
        if (IN(p0 + 3)) { PH_BEGIN prep_c2(A, l, bid, G, tid); prep_a2(A, l, gw, NGW, lane);
            SEAM(p0 + 3); }
        if (IN(p0 + 4)) { PH_BEGIN
            if (bid < 64) { const int st = bid >> 1, half = bid & 1, b = st >> 2, h = st & 3;
                scan_rwkv(A, l, lds, h, half, b * 8192, 8192, 32, 5, b * 128, nullptr, A->out + O_CWP + (size_t)((l * 8 + b) * 4 + h) * 4096, tid);
                scan_rwkv(A, l, lds, h, half, MP + b * 16, 16, 16, 4, 1024 + b, A->in[7] + (size_t)((l * 8 + b) * 4 + h) * 4096, A->out + O_CWS + (size_t)((l * 8 + b) * 4 + h) * 4096, tid);
            } else if (bid < 128) { const int st = (bid - 64) >> 1, half = bid & 1, b = st >> 2, h = st & 3;
                scan_delta(A, l, lds, h, half, b * 8192, 8192, 32, 5, nullptr, A->out + O_ADP + (size_t)((l * 8 + b) * 4 + h) * 4096, tid);
                scan_delta(A, l, lds, h, half, MP + b * 16, 16, 16, 4, A->in[5] + (size_t)((l * 8 + b) * 4 + h) * 4096, A->out + O_ADS + (size_t)((l * 8 + b) * 4 + h) * 4096, tid);
            } else if (bid < 160) { sample_attn(A, l, lds, bid - 128, tid); }
            __syncthreads();
            unsigned* ctr = (unsigned*)(ws + WS_CTL) + 16 * l; volatile LAS unsigned* qw = (volatile LAS unsigned*)(lds + MISC_OFF);
            const attn_body::bf16* Q = (const attn_body::bf16*)slotp(ws, l, 4); const attn_body::bf16* K = (const attn_body::bf16*)slotp(ws, l, 5); const attn_body::bf16* V = (const attn_body::bf16*)slotp(ws, l, 6);
            attn_body::bf16* O = (attn_body::bf16*)slotp(ws, l, 13);
            for (;;) {
                if (tid == 0) qw[0] = atomicAdd(ctr, 1u);
                __syncthreads();
                const unsigned u = qw[0];
                __syncthreads();
                if (u >= 4096u) break;
                const int qb = 31 - (int)(u >> 7), bh = (int)(u & 127);
                attn_body::attn_unit<8>(bh >> 4, bh & 15, qb, Q, K, V, O, (char*)lds_raw, wv);
            }
            SEAM(p0 + 4); }
        if (IN(p0 + 5)) { PH_BEGIN
            post_attn(A, l, gw, NGW, lane); post_scan(A, l, gw, NGW, lane);
            conv_p(A, l, (bfu*)slotp(ws, l, 10), gtid, NT);
            if (l == 0) conv_weights(A, 1, 1, lds, gw, NGW, lane, wave);
            SEAM(p0 + 5); }
        if (IN(p0 + 6)) { PH_BEGIN
            pg8::Gemm g{(const pg8::bf16_t*)slotp(ws, l, 7), (const pg8::bf16_t*)(wb + W_OUT), MPAD, 1024, 1024};
            pg8::StaticOrder S; S.init(MPAD, 1024, G, bid);
            EpiH<2> E{A->out, (bfu*)slotp(ws, l, 0), rsb + (size_t)(3 * l + 1) * MPAD, nullptr, nullptr};
            pg8::gemm_phase<EpiH<2>, pg8::StaticOrder, true, true>((PG8_LAS unsigned char*)lds, g, S, E, wv);
            SEAM(p0 + 6); }
        if (IN(p0 + 7)) { PH_BEGIN
            pg8::Gemm g{(const pg8::bf16_t*)slotp(ws, l, 0), (const pg8::bf16_t*)(wb + W_FF1), MPAD, FFD, 1024};
            pg8::StaticOrder S; S.init(MPAD, FFD, G, bid);
            EpiB<1> E{(bfu*)slotp(ws, l, 2), FFD, rsb + (size_t)(3 * l + 1) * MPAD};
            pg8::gemm_phase<EpiB<1>, pg8::StaticOrder, true, true>((PG8_LAS unsigned char*)lds, g, S, E, wv);
            {
                pg8::Gemm g2{(const pg8::bf16_t*)slotp(ws, l, 10), (const pg8::bf16_t*)(wb + W_PP), MPAD, 1024, 256};
                pg8::StaticOrder S2; S2.init(MPAD, 1024, G, bid);
                EpiB<0> E2{(bfu*)slotp(ws, l, 11), 1024, nullptr};
                pg8::gemm_phase<EpiB<0>, pg8::StaticOrder, true, true>((PG8_LAS unsigned char*)lds, g2, S2, E2, wv); }
            SEAM(p0 + 7); }
        if (IN(p0 + 8)) { PH_BEGIN
            pg8::Gemm g{(const pg8::bf16_t*)slotp(ws, l, 2), (const pg8::bf16_t*)(wb + W_FF2), MPAD, 1024, FFD};
            pg8::StaticOrder S; S.init(MPAD, 1024, G, bid);
            EpiH<2> E{A->out, (bfu*)slotp(ws, l, 0), rsb + (size_t)(3 * l + 2) * MPAD, nullptr, nullptr};
            pg8::gemm_phase<EpiH<2>, pg8::StaticOrder, true, true>((PG8_LAS unsigned char*)lds, g, S, E, wv);
            SEAM(p0 + 8); }
        if (IN(p0 + 9)) { PH_BEGIN SEAM_SKIP(p0 + 9); }
        if (IN(p0 + 10)) { PH_BEGIN
            pg8::Gemm g{(const pg8::bf16_t*)slotp(ws, l, 0), (const pg8::bf16_t*)(wb + W_GATE), MPAD, 1024, 1024};
            pg8::StaticOrder S; S.init(MPAD, 1024, G, bid);
            EpiH<3> E{A->out, (bfu*)slotp(ws, l, 13), rsb + (size_t)(3 * l + 3) * MPAD, rsb + (size_t)(3 * l + 2) * MPAD, (const bfu*)slotp(ws, l, 11)};
            pg8::gemm_phase<EpiH<3>, pg8::StaticOrder, true, true>((PG8_LAS unsigned char*)lds, g, S, E, wv);
            SEAM(p0 + 10); }
        }
    if (IN(NPHASE - 1)) { PH_BEGIN final_norm(A, gw, NGW, lane); }
}
#undef PH_BEGIN
#undef IN
#undef SEAM

extern "C" void kernel_launch(void* const* d_in, const int* in_sizes, int n_in, void* d_out, int out_size, void* d_ws, size_t ws_size, hipStream_t stream) {
    static int grid = 0;
    if (grid == 0) {
        if (n_in != 40 || (size_t)out_size != O_END || ws_size < WS_TOTAL) { fprintf(stderr, "kernel_launch: unexpected shapes (n_in %d out %d ws %zu)\n", n_in, out_size, ws_size); grid = -1; return; }
        int dev = 0, cus = 0, per_cu = 0;
        if (hipGetDevice(&dev) != hipSuccess || hipDeviceGetAttribute(&cus, hipDeviceAttributeMultiprocessorCount, dev) != hipSuccess) { grid = -1; return; }
        if (hipFuncSetAttribute((const void*)hybrid_fwd, hipFuncAttributeMaxDynamicSharedMemorySize, LDS_BYTES) != hipSuccess) { fprintf(stderr, "kernel_launch: hipFuncSetAttribute failed\n"); grid = -1; return; }
        if (hipOccupancyMaxActiveBlocksPerMultiprocessor(&per_cu, (const void*)hybrid_fwd, NTHR, LDS_BYTES) != hipSuccess || per_cu < 1) { fprintf(stderr, "kernel_launch: occupancy query says %d\n", per_cu); per_cu = 1; }
        (void)hipGetLastError();
        grid = cus;
    }
    if (grid < 0) return;
    if (hipMemsetAsync((char*)d_ws + WS_CTL, 0, 64 * 1024, stream) != hipSuccess) { fprintf(stderr, "kernel_launch: memset failed\n"); return; }
    Args a{};
    for (int i = 0; i < 40; ++i) a.in[i] = (const float*)d_in[i];
    a.out = (float*)d_out; a.ws = (unsigned char*)d_ws;
#if MK_ONE_LAUNCH
    a.ph_lo = 0; a.ph_hi = NPHASE;
    void* args[] = {&a};
    hipError_t e = hipLaunchCooperativeKernel((const void*)hybrid_fwd, dim3(grid), dim3(NTHR), args, LDS_BYTES, stream);
    if (e != hipSuccess) fprintf(stderr, "kernel_launch: cooperative launch failed: %s (grid %d)\n", hipGetErrorString(e), grid);
#else
    for (int ph = 0; ph < NPHASE; ++ph) { a.ph_lo = ph; a.ph_hi = ph + 1; hipLaunchKernelGGL(hybrid_fwd, dim3(grid), dim3(NTHR), LDS_BYTES, stream, a); }
#endif
}
```

```cpp
#include <hip/hip_runtime.h>
#include <hip/hip_cooperative_groups.h>
#include <cstdio>
#include <cstdint>
namespace cg = cooperative_groups;
namespace pg8 {
#define PG8_LAS __attribute__((address_space(3)))
typedef unsigned short bf16_t;
typedef short bf16x8 __attribute__((ext_vector_type(8)));
typedef float f32x4 __attribute__((ext_vector_type(4)));
typedef unsigned u32x4 __attribute__((ext_vector_type(4)));
constexpr int BM = 256, BK = 64, HALF = 128, HTB = HALF * BK * 2  , STAGE_BYTES = 8 * HTB, NXCD = 8, WGM = 8;

__host__ __device__ __forceinline__ int lds_byte(int r, int c) { const int st = (r >> 4) * 2 + (c >> 5), rr = r & 15, cc = c & 31, ob = rr * 64 + cc * 2; return st * 1024 + (ob ^ (((ob >> 9) & 1) << 5)); }
__host__ __device__ __forceinline__ void stage_rc(int b, int& R, int& C) { const int st = b / 1024, sb = b % 1024, swz = sb ^ (((sb >> 9) & 1) << 5); R = (st >> 1) * 16 + swz / 64; C = (st & 1) * 32 + (swz % 64) / 2; }
__host__ __device__ __forceinline__ int perm32(int rho) { const int n = rho >> 4, i = rho & 15; return 8 * (i >> 2) + 4 * n + (i & 3); }

struct Unit { int pm, pn; };
struct Gemm { const bf16_t* A; const bf16_t* Bt; int M, N, K; };

struct StaticOrder {
    int nM, nN, nwg, G, c;
    __host__ __device__ void init(int M, int N, int G_, int c_) { nM = M / BM; nN = N / BM; nwg = nM * nN; G = G_; c = c_; }
    __host__ __device__ bool next(int i, Unit& u) const {
        const long L = (long)i * G + c; if (L >= nwg) return false;
        int wgid = (int)L; { const int q = nwg / NXCD, r = nwg % NXCD, xcd = wgid % NXCD, off = wgid / NXCD; wgid = (xcd < r ? xcd * (q + 1) : r * (q + 1) + (xcd - r) * q) + off; }
        const int nig = WGM * nN, gid = wgid / nig, fm = gid * WGM, gsz = (nM - fm) < WGM ? (nM - fm) : WGM;
        u.pm = fm + ((wgid % nig) % gsz); u.pn = (wgid % nig) / gsz; return true;
    }
    __device__ __forceinline__ void a_ready(const Unit&) const {}
    __device__ __forceinline__ void done(const Unit&) const {}
};

__device__ __forceinline__ unsigned cvt_pk_bf16(float lo, float hi) { unsigned r; asm volatile("v_cvt_pk_bf16_f32 %0, %1, %2" : "=v"(r) : "v"(lo), "v"(hi)); return r; }
typedef float f32x2 __attribute__((ext_vector_type(2)));
__device__ __forceinline__ f32x2 gelu_pk(f32x2 v) {
    const f32x2 av = __builtin_elementwise_abs(v), d = av * 0.2316418882f + 1.0f;
    f32x2 t; t.x = __builtin_amdgcn_rcpf(d.x); t.y = __builtin_amdgcn_rcpf(d.y);
    f32x2 q = t * 0.5307027145f + (-0.7265760135f); q = q * t + 0.7107068705f; q = q * t + (-0.142248368f); q = q * t + 0.127414796f; q = q * t;
    const f32x2 s = (v * v) * (-0.72134752044f);
    f32x2 e; e.x = __builtin_amdgcn_exp2f(s.x); e.y = __builtin_amdgcn_exp2f(s.y);
    const f32x2 m = v * (q * e), r = v - m;
    f32x2 o; o.x = v.x < 0.f ? m.x : r.x; o.y = v.y < 0.f ? m.y : r.y; return o;
}

template <int ACT  > struct EpiBf16 {
    static constexpr bool PERM = true, AFTER_DRAIN = false; static_assert(ACT == 0 || ACT == 1, "EpiBf16: ACT is 0 (none) or 1 (gelu_pk)");
    bf16_t* O; int ldc; const float* bias; int split_cols; size_t split_stride; float scale0;
    __device__ __forceinline__ void operator()(const f32x4 (&acc)[2][2][4][2], const Unit& u, int wr, int wc, int fr, int fq) const {
        const int row0 = u.pm * BM + wr * 64 + fr; int colt = u.pn * BM; bf16_t* base = O;
        float sc = 1.f; if (split_cols) { const int t = colt / split_cols; base += (size_t)t * split_stride; colt -= t * split_cols; if (t == 0) sc = scale0; }
        const int col0 = colt + wc * 32 + 8 * fq, bcol0 = u.pn * BM + wc * 32 + 8 * fq;
        f32x4 bv[2][2];
#pragma unroll
        for (int bj = 0; bj < 2; ++bj)
#pragma unroll
            for (int n = 0; n < 2; ++n) bv[bj][n] = bias ? *(const f32x4*)(bias + bcol0 + bj * HALF + 4 * n) : (f32x4){0.f, 0.f, 0.f, 0.f};
#pragma unroll
        for (int ai = 0; ai < 2; ++ai)
#pragma unroll
            for (int m = 0; m < 4; ++m) { bf16_t* rowp = base + (size_t)(row0 + ai * HALF + m * 16) * ldc + col0;
#pragma unroll
                for (int bj = 0; bj < 2; ++bj) { f32x4 v0 = acc[ai][bj][m][0] + bv[bj][0], v1 = acc[ai][bj][m][1] + bv[bj][1];
                    if (ACT == 1) { f32x2 a = gelu_pk((f32x2){v0[0], v0[1]}), b = gelu_pk((f32x2){v0[2], v0[3]}), c = gelu_pk((f32x2){v1[0], v1[1]}), d = gelu_pk((f32x2){v1[2], v1[3]});
                        v0 = (f32x4){a.x, a.y, b.x, b.y}; v1 = (f32x4){c.x, c.y, d.x, d.y}; }
                    v0 = v0 * sc; v1 = v1 * sc; u32x4 w; w.x = cvt_pk_bf16(v0[0], v0[1]); w.y = cvt_pk_bf16(v0[2], v0[3]); w.z = cvt_pk_bf16(v1[0], v1[1]); w.w = cvt_pk_bf16(v1[2], v1[3]);
                    *(u32x4*)(rowp + bj * HALF) = w; } }
    }
};

struct PanelStats {
    unsigned* xbuf;
    unsigned* cnt;
    unsigned* tmo;
    int ntn; float eps;
    unsigned code;
    __device__ __forceinline__ bool run(const f32x4 (&v)[2][2][4][2], const Unit& u, int wr, int wc, int fr, int fq, PG8_LAS unsigned char* lds, int wid, int lane) const {
        typedef float f32x2v __attribute__((ext_vector_type(2)));
        PG8_LAS f32x2v* P = (PG8_LAS f32x2v*)lds;
        PG8_LAS f32x2v* S = (PG8_LAS f32x2v*)(lds + 8192);
        PG8_LAS unsigned* flag = (PG8_LAS unsigned*)(lds + 8192 + 2048);
#pragma unroll
        for (int ai = 0; ai < 2; ++ai)
#pragma unroll
            for (int m = 0; m < 4; ++m) {
                float s = 0.f;
#pragma unroll
                for (int bj = 0; bj < 2; ++bj)
#pragma unroll
                    for (int n = 0; n < 2; ++n) { const f32x4 x = v[ai][bj][m][n]; s += (x[0] + x[1]) + (x[2] + x[3]); }
                s += __shfl_xor(s, 16); s += __shfl_xor(s, 32);
                const float mw = s * (1.0f / 64.0f); float q = 0.f;
#pragma unroll
                for (int bj = 0; bj < 2; ++bj)
#pragma unroll
                    for (int n = 0; n < 2; ++n) { const f32x4 d = v[ai][bj][m][n] - mw; q += (d[0] * d[0] + d[1] * d[1]) + (d[2] * d[2] + d[3] * d[3]); }
                q += __shfl_xor(q, 16); q += __shfl_xor(q, 32);
                if (fq == 0) P[(ai * HALF + wr * 64 + m * 16 + fr) * 4 + wc] = (f32x2v){mw, q};
            }
        asm volatile("s_waitcnt lgkmcnt(0)" ::: "memory"); __builtin_amdgcn_s_barrier(); asm volatile("" ::: "memory");
#if defined(BROKEN_EXCHANGE_NO_WAIT)
#warning BROKEN CONTROL BUILD: the row-statistics exchange does not wait; results are wrong by design
        if (blockIdx.x >= 64) { const long long t0_ = clock64(); while (clock64() - t0_ < 60000) __builtin_amdgcn_s_sleep(8); }
#endif
        const int row = wid * 32 + (lane & 31);
        if (lane < 32) {
            const f32x2v a = P[row * 4 + 0], b = P[row * 4 + 1], c = P[row * 4 + 2], d = P[row * 4 + 3];
            const float mt = (a.x + b.x + c.x + d.x) * 0.25f;
            const float da = a.x - mt, db = b.x - mt, dc = c.x - mt, dd = d.x - mt;
            const float m2 = (a.y + b.y) + (c.y + d.y) + 64.0f * ((da * da + db * db) + (dc * dc + dd * dd));
            unsigned long long* slot = (unsigned long long*)xbuf + ((size_t)(u.pm * BM + row) * 4 + u.pn);
            __hip_atomic_store(slot, ((unsigned long long)__float_as_uint(m2) << 32) | __float_as_uint(mt), __ATOMIC_RELAXED, __HIP_MEMORY_SCOPE_AGENT);
        }
        asm volatile("s_waitcnt vmcnt(0)" ::: "memory");
        if (lane == 0) __hip_atomic_fetch_add(cnt + 64 * u.pm, 1u, __ATOMIC_RELAXED, __HIP_MEMORY_SCOPE_AGENT);
        if (wid == 0) {
            bool dead = false; const unsigned long long t0 = __builtin_amdgcn_s_memrealtime(); const unsigned want = 8u * (unsigned)ntn;
            for (;;) {
#if defined(BROKEN_EXCHANGE_NO_WAIT)
                break;
#endif
                if ((unsigned)__builtin_amdgcn_readfirstlane(__hip_atomic_load(cnt + 64 * u.pm, __ATOMIC_RELAXED, __HIP_MEMORY_SCOPE_AGENT)) >= want) break;
                if (__builtin_amdgcn_s_memrealtime() - t0 > 2000000ull) {
                    if (lane == 0) { unsigned expect = 0u; __hip_atomic_compare_exchange_strong(tmo + 1, &expect, code | (unsigned)(u.pm & 0xff), __ATOMIC_RELAXED, __ATOMIC_RELAXED, __HIP_MEMORY_SCOPE_AGENT);
                                     __hip_atomic_store(tmo, 1u, __ATOMIC_RELAXED, __HIP_MEMORY_SCOPE_AGENT); }
                    dead = true; break; }
                __builtin_amdgcn_s_sleep(2);
            }
            __builtin_amdgcn_fence(__ATOMIC_ACQUIRE, "agent");
            if (lane == 0) flag[0] = dead ? 1u : 0u;
        }
        asm volatile("s_waitcnt vmcnt(0) lgkmcnt(0)" ::: "memory"); __builtin_amdgcn_s_barrier(); asm volatile("" ::: "memory");
        const bool bad = flag[0] != 0u;
        if (lane < 32) {
            const unsigned long long* slot = (const unsigned long long*)xbuf + (size_t)(u.pm * BM + row) * 4; float mt[4], m2[4]; float ms = 0.f;
#pragma unroll
            for (int t = 0; t < 4; ++t) { if (t < ntn) { const unsigned long long w = __hip_atomic_load(slot + t, __ATOMIC_RELAXED, __HIP_MEMORY_SCOPE_AGENT); mt[t] = __uint_as_float((unsigned)w); m2[t] = __uint_as_float((unsigned)(w >> 32)); } else { mt[t] = 0.f; m2[t] = 0.f; } ms += mt[t]; }
            const float mean = ms / (float)ntn; float q = 0.f;
#pragma unroll
            for (int t = 0; t < 4; ++t) if (t < ntn) { const float dm = mt[t] - mean; q += m2[t] + 256.0f * dm * dm; }
            S[row] = (f32x2v){mean, 1.0f / sqrtf(q / (256.0f * (float)ntn) + eps)};
        }
        asm volatile("s_waitcnt lgkmcnt(0)" ::: "memory"); __builtin_amdgcn_s_barrier(); asm volatile("" ::: "memory");
        return bad;
    }
};
struct EpiLnRes {
    static constexpr bool PERM = false, AFTER_DRAIN = true;
    const float* base; float* out; int ldc; const float* bias; PanelStats st; unsigned poison;
    __device__ __forceinline__ void fused(f32x4 (&acc)[2][2][4][2], const Unit& u, int wr, int wc, int fr, int fq, PG8_LAS unsigned char* lds, int wid, int lane) const {
        typedef float f32x2v __attribute__((ext_vector_type(2)));
        const PG8_LAS f32x2v* S = (const PG8_LAS f32x2v*)(lds + 8192);
        const int col0 = u.pn * BM + wc * 32 + 4 * fq;
#pragma unroll
        for (int bj = 0; bj < 2; ++bj)
#pragma unroll
            for (int n = 0; n < 2; ++n) { const f32x4 bv = bias ? *(const f32x4*)(bias + col0 + bj * HALF + n * 16) : (f32x4){0.f, 0.f, 0.f, 0.f};
#pragma unroll
                for (int ai = 0; ai < 2; ++ai)
#pragma unroll
                    for (int m = 0; m < 4; ++m) acc[ai][bj][m][n] += bv; }
        f32x4 pre[4][2][2];
#pragma unroll
        for (int m = 0; m < 4; ++m) { const size_t off = (size_t)(u.pm * BM + wr * 64 + m * 16 + fr) * ldc + col0;
#pragma unroll
            for (int bj = 0; bj < 2; ++bj)
#pragma unroll
                for (int n = 0; n < 2; ++n) pre[m][bj][n] = *(const f32x4*)(base + off + bj * HALF + n * 16); }
        const bool bad = st.run(acc, u, wr, wc, fr, fq, lds, wid, lane) || poison != 0u;
        const float qnan = __builtin_nanf("");
#pragma unroll
        for (int ai = 0; ai < 2; ++ai)
#pragma unroll
            for (int m = 0; m < 4; ++m) { const int r = ai * HALF + wr * 64 + m * 16 + fr; const f32x2v sr = S[r]; const size_t off = (size_t)(u.pm * BM + r) * ldc + col0;
#pragma unroll
                for (int bj = 0; bj < 2; ++bj)
#pragma unroll
                    for (int n = 0; n < 2; ++n) { const f32x4 bs = ai == 0 ? pre[m][bj][n] : *(const f32x4*)(base + off + bj * HALF + n * 16); f32x4 o = bs + (acc[ai][bj][m][n] - sr.x) * sr.y;
                        if (bad) o = (f32x4){qnan, qnan, qnan, qnan}; *(f32x4*)(out + off + bj * HALF + n * 16) = o; }
                if (m & 1) asm volatile("" ::: "memory"); }
    }
};
struct EpiLnResLn {
    static constexpr bool PERM = false, AFTER_DRAIN = true;
    const float* base; float* out; bf16_t* xn; int ldc; const float* bias; PanelStats st1, st2; unsigned poison;
    __device__ __forceinline__ void fused(f32x4 (&acc)[2][2][4][2], const Unit& u, int wr, int wc, int fr, int fq, PG8_LAS unsigned char* lds, int wid, int lane) const {
        typedef float f32x2v __attribute__((ext_vector_type(2))); typedef unsigned u32x2v __attribute__((ext_vector_type(2)));
        const PG8_LAS f32x2v* S = (const PG8_LAS f32x2v*)(lds + 8192);
        const int col0 = u.pn * BM + wc * 32 + 4 * fq;
#pragma unroll
        for (int bj = 0; bj < 2; ++bj)
#pragma unroll
            for (int n = 0; n < 2; ++n) { const f32x4 bv = bias ? *(const f32x4*)(bias + col0 + bj * HALF + n * 16) : (f32x4){0.f, 0.f, 0.f, 0.f};
#pragma unroll
                for (int ai = 0; ai < 2; ++ai)
#pragma unroll
                    for (int m = 0; m < 4; ++m) acc[ai][bj][m][n] += bv; }
        bool bad = st1.run(acc, u, wr, wc, fr, fq, lds, wid, lane) || poison != 0u;
        const float qnan = __builtin_nanf("");
#pragma unroll
        for (int ai = 0; ai < 2; ++ai)
#pragma unroll
            for (int m = 0; m < 4; ++m) { const int r = ai * HALF + wr * 64 + m * 16 + fr; const f32x2v sr = S[r]; const size_t off = (size_t)(u.pm * BM + r) * ldc + col0;
#pragma unroll
                for (int bj = 0; bj < 2; ++bj)
#pragma unroll
                    for (int n = 0; n < 2; ++n) { const f32x4 bs = *(const f32x4*)(base + off + bj * HALF + n * 16); acc[ai][bj][m][n] = bs + (acc[ai][bj][m][n] - sr.x) * sr.y; }
                asm volatile("" : "+v"(acc[ai][0][m][0]), "+v"(acc[ai][0][m][1]), "+v"(acc[ai][1][m][0]), "+v"(acc[ai][1][m][1]));
                if (m & 1) asm volatile("" ::: "memory"); }
        const bool bad1 = bad;
        bad = st2.run(acc, u, wr, wc, fr, fq, lds, wid, lane) || bad;
#pragma unroll
        for (int ai = 0; ai < 2; ++ai)
#pragma unroll
            for (int m = 0; m < 4; ++m) { const int r = ai * HALF + wr * 64 + m * 16 + fr; const f32x2v sr = S[r]; const size_t off = (size_t)(u.pm * BM + r) * ldc + col0;
#pragma unroll
                for (int bj = 0; bj < 2; ++bj)
#pragma unroll
                    for (int n = 0; n < 2; ++n) { const f32x4 x1 = acc[ai][bj][m][n]; *(f32x4*)(out + off + bj * HALF + n * 16) = bad1 ? (f32x4){qnan, qnan, qnan, qnan} : x1;
                        const f32x4 o = (x1 - sr.x) * sr.y; u32x2v w; w.x = cvt_pk_bf16(o[0], o[1]); w.y = cvt_pk_bf16(o[2], o[3]);
                        if (bad) { w.x = 0x7fc07fc0u; w.y = 0x7fc07fc0u; } *(u32x2v*)(xn + off + bj * HALF + n * 16) = w; }
                asm volatile("" ::: "memory"); }
    }
};

template <class Epi, class Sched, bool ALIGN_EPI = false, bool SP2 = false>
__device__ __forceinline__ void gemm_phase(PG8_LAS unsigned char* lds, const Gemm g, const Sched& S, const Epi& E, const int wv_) {
    int tid_o = wv_ * 64 + (int)__builtin_amdgcn_mbcnt_hi(~0u, __builtin_amdgcn_mbcnt_lo(~0u, 0u)); asm volatile("" : "+v"(tid_o)); tid_o &= 511;
    const int tid = tid_o, wid = __builtin_amdgcn_readfirstlane(tid >> 6), lane = tid & 63, wr = wid >> 2, wc = wid & 3, fr = lane & 15, fq = lane >> 4;
    const int K = g.K, nt = K / BK;
    unsigned voffA[2], voffB[2];
#pragma unroll
    for (int i = 0; i < 2; ++i) { int R, C; stage_rc(tid * 16 + i * 8192, R, C); const int Rb = Epi::PERM ? ((R & ~31) + perm32(R & 31)) : R;
        voffA[i] = (unsigned)(R * K + C) * 2u; voffB[i] = (unsigned)(Rb * K + C) * 2u; }
    const size_t kstep = (size_t)(BK * 2);
    const size_t hstep = (size_t)HALF * K * 2;
    const size_t tstep = 2 * hstep;
    const unsigned ldsw = (unsigned)wid * 1024u;
    const int aoff = lds_byte(wr * 64 + fr, fq * 8), boff = lds_byte(wc * 32 + fr, fq * 8);
#define PG8_SA(b, h) (((b) * 2 + (h)) * HTB)
#define PG8_SB(b, h) ((4 + (b) * 2 + (h)) * HTB)
#define PG8_STAGE(bufoff, gbase, voff) do { _Pragma("unroll") for (int _i = 0; _i < 2; ++_i) \
        __builtin_amdgcn_global_load_lds((const unsigned*)((const char*)(gbase) + (voff)[_i]), (PG8_LAS unsigned*)(lds + (bufoff) + ldsw + _i * 8192), 16, 0, 0); } while (0)
#define PG8_LDA(dst, b, h) do { _Pragma("unroll") for (int m = 0; m < 4; ++m) _Pragma("unroll") for (int k = 0; k < 2; ++k) dst[m][k] = *(const PG8_LAS bf16x8*)(lds + PG8_SA(b, h) + aoff + m * 2048 + k * 1024); } while (0)
#define PG8_LDB(dst, b, h) do { _Pragma("unroll") for (int n = 0; n < 2; ++n) _Pragma("unroll") for (int k = 0; k < 2; ++k) dst[n][k] = *(const PG8_LAS bf16x8*)(lds + PG8_SB(b, h) + boff + n * 2048 + k * 1024); } while (0)
#define PG8_MMA(ai, bj, At, Bt) do { __builtin_amdgcn_s_setprio(1); _Pragma("unroll") for (int m = 0; m < 4; ++m) _Pragma("unroll") for (int n = 0; n < 2; ++n) _Pragma("unroll") for (int k = 0; k < 2; ++k) \
        acc[ai][bj][m][n] = __builtin_amdgcn_mfma_f32_16x16x32_bf16(Bt[n][k], At[m][k], acc[ai][bj][m][n], 0, 0, 0); __builtin_amdgcn_s_setprio(0); } while (0)
#define PG8_WAIT_V(n) asm volatile("s_waitcnt vmcnt(" #n ")" ::: "memory")
#define PG8_WAIT_L(n) asm volatile("s_waitcnt lgkmcnt(" #n ")" ::: "memory")
#define PG8_BAR __builtin_amdgcn_s_barrier()
#define PG8_SCHED __builtin_amdgcn_sched_barrier(0)
    Unit cur, nxt; int ui = 0;
    if (!S.next(0, cur)) return;
    f32x4 acc[2][2][4][2];
#pragma unroll
    for (int a = 0; a < 2; ++a)
#pragma unroll
        for (int b = 0; b < 2; ++b)
#pragma unroll
            for (int m = 0; m < 4; ++m)
#pragma unroll
                for (int n = 0; n < 2; ++n) acc[a][b][m][n] = (f32x4){0.f, 0.f, 0.f, 0.f};
    bf16x8 At[4][2], B0[2][2], B1[2][2];
    const char* cA = (const char*)g.A + (size_t)cur.pm * tstep; const char* cB = (const char*)g.Bt + (size_t)cur.pn * tstep;
    S.a_ready(cur);
    if constexpr (SP2) {
        PG8_STAGE(PG8_SB(0, 0), cB, voffB); PG8_STAGE(PG8_SB(0, 1), cB + hstep, voffB); PG8_STAGE(PG8_SA(0, 0), cA, voffA); PG8_STAGE(PG8_SA(0, 1), cA + hstep, voffA);
        if (wr == 1) PG8_BAR;
        PG8_WAIT_V(2); PG8_BAR;
        PG8_STAGE(PG8_SB(1, 0), cB + kstep, voffB); PG8_STAGE(PG8_SA(1, 0), cA + kstep, voffA); PG8_STAGE(PG8_SB(1, 1), cB + hstep + kstep, voffB);
        PG8_WAIT_V(6); PG8_BAR;
    } else {
        PG8_STAGE(PG8_SB(0, 0), cB, voffB); PG8_STAGE(PG8_SA(0, 0), cA, voffA); PG8_STAGE(PG8_SB(0, 1), cB + hstep, voffB); PG8_STAGE(PG8_SA(0, 1), cA + hstep, voffA);
        if (wr == 1) PG8_BAR;
        PG8_WAIT_V(4); PG8_BAR;
        PG8_STAGE(PG8_SB(1, 0), cB + kstep, voffB); PG8_STAGE(PG8_SA(1, 0), cA + kstep, voffA); PG8_STAGE(PG8_SB(1, 1), cB + hstep + kstep, voffB);
        PG8_WAIT_V(6); PG8_BAR;
    }
    for (;;) {
        const bool has_next = S.next(ui + 1, nxt);
        const char* nA = has_next ? (const char*)g.A + (size_t)nxt.pm * tstep : cA; const char* nB = has_next ? (const char*)g.Bt + (size_t)nxt.pn * tstep : cB;
        for (int t = 0; t < nt; t += 2) {
            const bool last = (t == nt - 2);
            const char* a1 = cA + (size_t)(t + 1) * kstep;
            const char* a2 = last ? nA : cA + (size_t)(t + 2) * kstep; const char* b2 = last ? nB : cB + (size_t)(t + 2) * kstep;
            const char* a3 = a2 + kstep; const char* b3 = b2 + kstep;
            if (last && has_next) S.a_ready(nxt);
            if constexpr (SP2) {
            PG8_LDB(B0, 0, 0); PG8_LDB(B1, 0, 1); PG8_SCHED; PG8_LDA(At, 0, 0); PG8_STAGE(PG8_SA(1, 1), a1 + hstep, voffA);
            PG8_WAIT_V(8); PG8_WAIT_L(0); PG8_BAR; PG8_MMA(0, 0, At, B0); PG8_MMA(0, 1, At, B1); PG8_BAR; PG8_SCHED;
            PG8_LDA(At, 0, 1); PG8_STAGE(PG8_SB(0, 0), b2, voffB); PG8_STAGE(PG8_SB(0, 1), b2 + hstep, voffB); PG8_STAGE(PG8_SA(0, 0), a2, voffA);
            PG8_WAIT_V(8); PG8_WAIT_L(0); PG8_BAR; PG8_MMA(1, 0, At, B0); PG8_MMA(1, 1, At, B1); PG8_BAR; PG8_SCHED;
            PG8_LDB(B0, 1, 0); PG8_LDB(B1, 1, 1); PG8_SCHED; PG8_LDA(At, 1, 0); PG8_STAGE(PG8_SA(0, 1), a2 + hstep, voffA);
            PG8_WAIT_V(8); PG8_WAIT_L(0); PG8_BAR; PG8_MMA(0, 0, At, B0); PG8_MMA(0, 1, At, B1); PG8_BAR; PG8_SCHED;
            PG8_LDA(At, 1, 1); PG8_STAGE(PG8_SB(1, 0), b3, voffB); PG8_STAGE(PG8_SB(1, 1), b3 + hstep, voffB); PG8_STAGE(PG8_SA(1, 0), a3, voffA);
            PG8_WAIT_V(8); PG8_WAIT_L(0); PG8_BAR; PG8_MMA(1, 0, At, B0); PG8_MMA(1, 1, At, B1); PG8_BAR; PG8_SCHED;
            } else {
            PG8_LDB(B0, 0, 0); PG8_SCHED; PG8_LDA(At, 0, 0); PG8_STAGE(PG8_SA(1, 1), a1 + hstep, voffA);
            PG8_WAIT_L(8); PG8_BAR; PG8_WAIT_L(0); PG8_MMA(0, 0, At, B0); PG8_BAR; PG8_SCHED;
            PG8_LDB(B1, 0, 1); PG8_STAGE(PG8_SB(0, 0), b2, voffB);
            PG8_BAR; PG8_WAIT_L(0); PG8_MMA(0, 1, At, B1); PG8_BAR;
            PG8_LDA(At, 0, 1); PG8_STAGE(PG8_SA(0, 0), a2, voffA);
            PG8_BAR; PG8_WAIT_L(0); PG8_MMA(1, 0, At, B0); PG8_BAR; PG8_SCHED;
            PG8_STAGE(PG8_SB(0, 1), b2 + hstep, voffB);
            PG8_WAIT_V(6); PG8_BAR; PG8_MMA(1, 1, At, B1); PG8_BAR;
            PG8_LDB(B0, 1, 0); PG8_SCHED; PG8_LDA(At, 1, 0); PG8_STAGE(PG8_SA(0, 1), a2 + hstep, voffA);
            PG8_WAIT_L(8); PG8_BAR; PG8_WAIT_L(0); PG8_MMA(0, 0, At, B0); PG8_BAR; PG8_SCHED;
            PG8_LDB(B1, 1, 1); PG8_STAGE(PG8_SB(1, 0), b3, voffB);
            PG8_BAR; PG8_WAIT_L(0); PG8_MMA(0, 1, At, B1); PG8_BAR;
            PG8_LDA(At, 1, 1); PG8_STAGE(PG8_SA(1, 0), a3, voffA);
            PG8_BAR; PG8_WAIT_L(0); PG8_MMA(1, 0, At, B0); PG8_BAR; PG8_SCHED;
            PG8_STAGE(PG8_SB(1, 1), b3 + hstep, voffB);
            PG8_WAIT_V(6); PG8_BAR; PG8_MMA(1, 1, At, B1); PG8_BAR;
            }
        }
        if constexpr (ALIGN_EPI) { if (wr == 0) PG8_BAR; }
        if constexpr (!Epi::AFTER_DRAIN) { E(acc, cur, wr, wc, fr, fq); S.done(cur); }
        if (!has_next) break;
#pragma unroll
        for (int a = 0; a < 2; ++a)
#pragma unroll
            for (int b = 0; b < 2; ++b)
#pragma unroll
                for (int m = 0; m < 4; ++m)
#pragma unroll
                    for (int n = 0; n < 2; ++n) acc[a][b][m][n] = (f32x4){0.f, 0.f, 0.f, 0.f};
        cur = nxt; cA = nA; cB = nB; ++ui;
        if constexpr (ALIGN_EPI) { if (wr == 1) PG8_BAR; }
    }
    PG8_WAIT_V(0);
    if constexpr (!ALIGN_EPI) { if (wr == 0) PG8_BAR; }
    PG8_BAR;
    if constexpr (Epi::AFTER_DRAIN) { E.fused(acc, cur, wr, wc, fr, fq, lds, wid, lane); S.done(cur); }
#undef PG8_SA
#undef PG8_SB
#undef PG8_STAGE
#undef PG8_LDA
#undef PG8_LDB
#undef PG8_MMA
#undef PG8_WAIT_V
#undef PG8_WAIT_L
#undef PG8_BAR
#undef PG8_SCHED
}
}
#include <hip/hip_bf16.h>
#include <cmath>
namespace attn_body {
using bf16=__hip_bfloat16;
using bf16x8=__attribute__((ext_vector_type(8)))short;
using s16x4=__attribute__((ext_vector_type(4)))short;
using f32x16=__attribute__((ext_vector_type(16)))float;
using u32x4=__attribute__((ext_vector_type(4)))unsigned;
constexpr int BATCH=8,NHEAD=16,SEQ=8192,D=64,DM=NHEAD*D,DMI=512,DMO=1024;
constexpr int NW=8,QBLK=32,QB=QBLK*NW,KVBLK=64,NQB=SEQ/QB;
constexpr int ATTN_PITCH=DM, ATTN_UNIT_ROWS=QB;
__device__ __forceinline__ int crow(int r,int hi){return (r&3)+8*(r>>2)+4*hi;}
#define SBAR() __builtin_amdgcn_sched_barrier(0)
__device__ __forceinline__ void cmask(f32x16&p0,f32x16&p1,int jb,int qrel,int hi){
  const float NEG=-INFINITY; int kb=64*jb+4*hi;
  #pragma unroll
  for(int r=0;r<16;++r){ if(jb>(qrel>>6)){p0[r]=NEG;p1[r]=NEG;} } (void)kb;
}

constexpr int NSLOT=3, SLOTB=8192;
constexpr int LDS_K=0, LDS_V=NSLOT*SLOTB, LDS_WS=2*NSLOT*SLOTB, LDS_OST=LDS_WS+NW*64*4, LDS_BYTES=LDS_OST+NW*4096;
constexpr float C2=0.125f*1.4426950408889634f;
__device__ __forceinline__ void glds16(const void*gsrc,unsigned lds_dst){unsigned keep;
  asm volatile("s_mov_b32 %0, m0\n\ts_mov_b32 m0, %2\n\ts_nop 0\n\tglobal_load_lds_dwordx4 %1, off\n\ts_mov_b32 m0, %0":"=&s"(keep):"v"(gsrc),"s"(lds_dst):"memory");}
__device__ __forceinline__ float max3f(float a,float b,float c){float r;asm("v_max3_f32 %0, %1, %2, %3":"=v"(r):"v"(a),"v"(b),"v"(c));return r;}
__device__ __forceinline__ float max2f(float a,float b){float r;asm("v_max_f32_e32 %0, %1, %2":"=v"(r):"v"(a),"v"(b));return r;}
__device__ __forceinline__ float fadd_s(float a,float b){float r;asm("v_add_f32_e32 %0, %1, %2":"=v"(r):"v"(a),"v"(b));return r;}
__device__ __forceinline__ float fsub_s(float a,float b){float r;asm("v_sub_f32_e32 %0, %1, %2":"=v"(r):"v"(a),"v"(b));return r;}
typedef float f32x2_t __attribute__((ext_vector_type(2))); typedef __bf16 bf16x2_t __attribute__((ext_vector_type(2)));
__device__ __forceinline__ unsigned cvtpk_s(float lo,float hi){f32x2_t v={lo,hi};bf16x2_t b=__builtin_convertvector(v,bf16x2_t);return __builtin_bit_cast(unsigned,b);}
#define WAIT_BAR(N) asm volatile("s_waitcnt vmcnt(" #N ") lgkmcnt(0)\n\ts_barrier":::"memory")

__device__ __forceinline__ void qkt(f32x16&p0,f32x16&p1,const char*Kslot,const bf16x8*qr,const f32x16&negm,int r32,int hi){
  const char*kb=Kslot+hi*1024+r32*16;
  #pragma unroll
  for(int d0=0;d0<4;++d0){
    const bf16x8 b0=*reinterpret_cast<const bf16x8*>(kb+d0*2048);
    const bf16x8 b1=*reinterpret_cast<const bf16x8*>(kb+d0*2048+512);
    if(d0==0){p0=__builtin_amdgcn_mfma_f32_32x32x16_bf16(b0,qr[0],negm,0,0,0);p1=__builtin_amdgcn_mfma_f32_32x32x16_bf16(b1,qr[0],negm,0,0,0);}
    else{p0=__builtin_amdgcn_mfma_f32_32x32x16_bf16(b0,qr[d0],p0,0,0,0);p1=__builtin_amdgcn_mfma_f32_32x32x16_bf16(b1,qr[d0],p1,0,0,0);}}
}
typedef __attribute__((address_space(3))) const char* lds_cptr;
typedef short v4i16_t __attribute__((ext_vector_type(4)));
__device__ __forceinline__ void kload8(bf16x8*kf,lds_cptr kp){
  kf[0]=*(const __attribute__((address_space(3))) bf16x8*)(kp);      kf[1]=*(const __attribute__((address_space(3))) bf16x8*)(kp+512);
  kf[2]=*(const __attribute__((address_space(3))) bf16x8*)(kp+2048); kf[3]=*(const __attribute__((address_space(3))) bf16x8*)(kp+2560);
  kf[4]=*(const __attribute__((address_space(3))) bf16x8*)(kp+4096); kf[5]=*(const __attribute__((address_space(3))) bf16x8*)(kp+4608);
  kf[6]=*(const __attribute__((address_space(3))) bf16x8*)(kp+6144); kf[7]=*(const __attribute__((address_space(3))) bf16x8*)(kp+6656);
}
__device__ __forceinline__ void kload2(bf16x8*kf,lds_cptr kp,int j){ kf[2*j]=*(const __attribute__((address_space(3))) bf16x8*)(kp+j*2048); kf[2*j+1]=*(const __attribute__((address_space(3))) bf16x8*)(kp+j*2048+512); }
__device__ __forceinline__ s16x4 vtr(lds_cptr p){ return __builtin_bit_cast(s16x4,__builtin_amdgcn_ds_read_tr16_b64_v4i16((__attribute__((address_space(3))) v4i16_t*)p)); }
__device__ __forceinline__ float rowmax(const f32x16&p0,const f32x16&p1){
  float a=max3f(p0[0],p0[1],p1[0]),b=max3f(p0[2],p0[3],p1[1]);a=max3f(a,p1[2],p1[3]);
  #pragma unroll
  for(int r=4;r<16;r+=4){a=max3f(a,p0[r],p0[r+1]);b=max3f(b,p0[r+2],p0[r+3]);a=max3f(a,p1[r],p1[r+1]);b=max3f(b,p1[r+2],p1[r+3]);}
  const float m=max2f(a,b);
  auto rr=__builtin_amdgcn_permlane32_swap(__float_as_uint(m),__float_as_uint(m),false,false);
  return max2f(__uint_as_float(rr[0]),__uint_as_float(rr[1]));
}
__device__ __forceinline__ void pv(f32x16*o,int vb,bf16x8 pa0,bf16x8 pa1,bf16x8 pa2,bf16x8 pa3){
  #pragma unroll
  for(int d0=0;d0<2;++d0){s16x4 lo[4],hi[4];
    #pragma unroll
    for(int ks=0;ks<4;++ks){
      asm volatile("ds_read_b64_tr_b16 %0,%1 offset:%c2":"=&v"(lo[ks]):"v"(vb),"i"(d0*4096+ks*1024):"memory");
      asm volatile("ds_read_b64_tr_b16 %0,%1 offset:%c2":"=&v"(hi[ks]):"v"(vb),"i"(d0*4096+ks*1024+512):"memory");}
    asm volatile("s_waitcnt lgkmcnt(0)":::"memory");SBAR();
    #define PK(k) (bf16x8){lo[k][0],lo[k][1],lo[k][2],lo[k][3],hi[k][0],hi[k][1],hi[k][2],hi[k][3]}
    o[d0]=__builtin_amdgcn_mfma_f32_32x32x16_bf16(pa0,PK(0),o[d0],0,0,0);
    o[d0]=__builtin_amdgcn_mfma_f32_32x32x16_bf16(pa1,PK(1),o[d0],0,0,0);
    o[d0]=__builtin_amdgcn_mfma_f32_32x32x16_bf16(pa2,PK(2),o[d0],0,0,0);
    o[d0]=__builtin_amdgcn_mfma_f32_32x32x16_bf16(pa3,PK(3),o[d0],0,0,0);
    #undef PK
  }
}

#ifndef ATTN_STORE16
#define ATTN_STORE16(p,v) (*(u32x4*)(p)=(v))
#endif
template<int THRL> __device__ __forceinline__ void attn_unit(int b,int h,int qb,const bf16*Q,const bf16*__restrict__ K,const bf16*__restrict__ V,bf16*O,char*shm,const int wv_){
  int tid_o=wv_*64+(int)__builtin_amdgcn_mbcnt_hi(~0u,__builtin_amdgcn_mbcnt_lo(~0u,0u)); asm volatile("":"+v"(tid_o)); tid_o&=511;
  const int tid=tid_o,lane=tid&63,r32=lane&31,hi=lane>>5; const int wid=__builtin_amdgcn_readfirstlane(tid>>6);
  const long rowbase=(long)b*SEQ; const int q0=qb*QB;
  const bf16*Qw=Q+(rowbase+q0+wid*QBLK)*DMI+(h>>1)*D;
  const bf16*Kh=K+rowbase*DMI+(h>>1)*D,*Vh=V+rowbase*DMI+(h>>2)*128+(h&1)*64;
  const unsigned lds0=(unsigned)(uintptr_t)shm;
  float*wsf=(float*)(shm+LDS_WS)+wid*64;
  const bf16*ksrc=Kh+(long)lane*DMI+wid*8;
  const bf16*vsrc=Vh+(long)(16*(wid&3)+(lane>>2))*DMI+(wid>>2)*32+(lane&3)*8;
  const unsigned kdst=lds0+LDS_K+wid*1024, vdst=lds0+LDS_V+wid*1024;
  #define DMA_K(t,slot) glds16(ksrc+(long)(t)*KVBLK*DMI,(unsigned)__builtin_amdgcn_readfirstlane(kdst+(slot)))
  #define DMA_V(t,slot) glds16(vsrc+(long)(t)*KVBLK*DMI,(unsigned)__builtin_amdgcn_readfirstlane(vdst+(slot)))
  const int vb0=(int)(lds0+LDS_V)+((lane>>4)&1)*32+(lane&3)*8+(4*hi+((lane&15)>>2))*64;
  const char*Kbase=shm+LDS_K; bf16x8 kf[8];
  const lds_cptr shm3=(lds_cptr)shm; const lds_cptr kp0=shm3+LDS_K+hi*1024+r32*16; const lds_cptr vp0=shm3+LDS_V+((lane>>4)&1)*32+(lane&3)*8+(4*hi+((lane&15)>>2))*64;
  const int NT=(q0+QB)/KVBLK;
  DMA_K(0,0);DMA_V(0,0);DMA_K(1,SLOTB);
  bf16x8 qr[4];
  #pragma unroll
  for(int d0=0;d0<4;++d0)qr[d0]=*reinterpret_cast<const bf16x8*>(&Qw[(long)r32*DMI+d0*16+hi*8]);
  float mhat=0.f,l_reg=0.f;f32x16 o[2];o[0]=f32x16{};o[1]=f32x16{};f32x16 negm=f32x16{};asm volatile("":"+v"(negm));
  const int qrel=wid*QBLK+r32;
  #define CMASK(P0,P1,t) do{int jb_=(t)-(NT-4); if(jb_>=0)cmask(P0,P1,jb_,qrel,hi);}while(0)
  bool resc=false;
  #define START(P0,P1) do{ const float rm=rowmax(P0,P1); resc=false; \
    { const float dl=rm; mhat=fadd_s(mhat,dl); \
      _Pragma("unroll") for(int r=0;r<16;++r){P0[r]=fsub_s(P0[r],dl);P1[r]=fsub_s(P1[r],dl);} \
      _Pragma("unroll") for(int r=0;r<16;++r)negm[r]=-mhat; asm volatile("":"+v"(negm)); } \
    _Pragma("unroll") for(int r=0;r<16;++r)P0[r]=__builtin_amdgcn_exp2f(P0[r]); }while(0)
  #define RESC() do{ if(resc){ asm volatile("s_waitcnt lgkmcnt(0)":::"memory"); \
      _Pragma("unroll") for(int d_=0;d_<2;++d_) _Pragma("unroll") for(int r=0;r<16;++r)o[d_][r]*=wsf[crow(r,hi)]; } }while(0)
  f32x16 pA0,pA1,pB0,pB1;
  int sl_prev=0,sl_cur=0,sl_next=SLOTB;
  #define ROT() do{sl_prev=sl_cur;sl_cur=sl_next;sl_next=(sl_next==(NSLOT-1)*SLOTB)?0:sl_next+SLOTB;}while(0)
  DMA_K(2,2*SLOTB);
  WAIT_BAR(3);
  qkt(pA0,pA1,Kbase,qr,negm,r32,hi);asm volatile("s_nop 15\n\ts_nop 7":"+v"(pA0),"+v"(pA1));CMASK(pA0,pA1,0);
  START(pA0,pA1);
  _Pragma("unroll") for(int r=0;r<16;++r)pA1[r]=__builtin_amdgcn_exp2f(pA1[r]);
  WAIT_BAR(0);
  DMA_K(3,0);DMA_V(1,SLOTB);
  ROT();
  kload8(kf,kp0+sl_cur);
  WAIT_BAR(2);
  s16x4 vlo[8],vhi[8]; u32x4 pw0,pw1,pw2,pw3;
  #define PKW(P,B) cvtpk_s(P[B],P[B+1])
  #define PAF(k) __builtin_bit_cast(bf16x8,pw##k)
  #define VFR(i) (bf16x8){vlo[i][0],vlo[i][1],vlo[i][2],vlo[i][3],vhi[i][0],vhi[i][1],vhi[i][2],vhi[i][3]}
  #define PIN(x) asm volatile("":"+v"(x))
  #define MX3(a,b,c) __builtin_fmaxf(__builtin_fmaxf((a),(b)),(c))
  #define GAPA(MF,A0,A1,A2,A3,W0,W1,PW) do{ MF; sacc+=A0; sacc+=A1; sacc+=A2; sacc+=A3; PIN(sacc); W0; W1; PIN(PW); SBAR(); }while(0)
  #define EX(v) __builtin_amdgcn_exp2f(v)
  #define GAPB(MF,X,B) do{ MF; X[B]=EX(X[B]); X[B+1]=EX(X[B+1]); X[B+2]=EX(X[B+2]); X[B+3]=EX(X[B+3]); PIN(X); SBAR(); }while(0)
  #define VRD(i) do{ vlo[i]=vtr(vp_+(((i)>>2)*4096+((i)&3)*1024)); vhi[i]=vtr(vp_+(((i)>>2)*4096+((i)&3)*1024+512)); }while(0)
  #define KRD(G,j) do{ if(G){ kload2(kf,kp0+sl_next,j); SBAR(); } }while(0)
  #define STEP(C0,C1,P0,P1,t,GK,GV,GL) do{ SBAR(); \
    const lds_cptr vp_=vp0+sl_prev; \
    VRD(0); SBAR(); float sacc=(P0[0]+P0[1]); \
    GAPA(C0=__builtin_amdgcn_mfma_f32_32x32x16_bf16(kf[0],qr[0],negm,0,0,0), P0[2],P0[3],P0[4],P0[5],     pw0[0]=PKW(P0,0), pw0[1]=PKW(P0,2), pw0); \
    VRD(4); SBAR(); GAPA(C1=__builtin_amdgcn_mfma_f32_32x32x16_bf16(kf[1],qr[0],negm,0,0,0), P0[6],P0[7],P0[8],P0[9],     pw0[2]=PKW(P0,4), pw0[3]=PKW(P0,6), pw0); \
    VRD(1); SBAR(); GAPA(C0=__builtin_amdgcn_mfma_f32_32x32x16_bf16(kf[2],qr[1],C0,0,0,0),   P0[10],P0[11],P0[12],P0[13], pw1[0]=PKW(P0,8), pw1[1]=PKW(P0,10), pw1); \
    VRD(5); SBAR(); GAPA(C1=__builtin_amdgcn_mfma_f32_32x32x16_bf16(kf[3],qr[1],C1,0,0,0),   P0[14],P0[15],P1[0],P1[1],   pw1[2]=PKW(P0,12),pw1[3]=PKW(P0,14), pw1); \
    VRD(2); SBAR(); GAPA(C0=__builtin_amdgcn_mfma_f32_32x32x16_bf16(kf[4],qr[2],C0,0,0,0),   P1[2],P1[3],P1[4],P1[5],     pw2[0]=PKW(P1,0), pw2[1]=PKW(P1,2), pw2); \
    VRD(6); SBAR(); GAPA(C1=__builtin_amdgcn_mfma_f32_32x32x16_bf16(kf[5],qr[2],C1,0,0,0),   P1[6],P1[7],P1[8],P1[9],     pw2[2]=PKW(P1,4), pw2[3]=PKW(P1,6), pw2); \
    VRD(3); SBAR(); GAPA(C0=__builtin_amdgcn_mfma_f32_32x32x16_bf16(kf[6],qr[3],C0,0,0,0),   P1[10],P1[11],P1[12],P1[13], pw3[0]=PKW(P1,8), pw3[1]=PKW(P1,10), pw3); \
    VRD(7); SBAR(); GAPA(C1=__builtin_amdgcn_mfma_f32_32x32x16_bf16(kf[7],qr[3],C1,0,0,0),   P1[14],P1[15],0.f,0.f,       pw3[2]=PKW(P1,12),pw3[3]=PKW(P1,14), pw3); \
    l_reg+=sacc; \
    if(GK){DMA_K((t)+3,sl_cur);} if(GV){DMA_V((t)+1,sl_next);} \
    CMASK(C0,C1,t); \
    { float a=MX3(C0[0],C0[1],C1[0]),b=MX3(C0[2],C0[3],C1[1]); a=MX3(a,C1[2],C1[3]); \
      _Pragma("unroll") for(int r=4;r<16;r+=4){a=MX3(a,C0[r],C0[r+1]);b=MX3(b,C0[r+2],C0[r+3]);a=MX3(a,C1[r],C1[r+1]);b=MX3(b,C1[r+2],C1[r+3]);} \
      float rm=__builtin_fmaxf(a,b); { auto rr=__builtin_amdgcn_permlane32_swap(__float_as_uint(rm),__float_as_uint(rm),false,false); rm=__builtin_fmaxf(__uint_as_float(rr[0]),__uint_as_float(rr[1])); } \
      resc=false; \
      if(__builtin_expect(__any(rm>(float)THRL),0)){ const float dl=__builtin_fmaxf(rm,0.f); mhat+=dl; \
        _Pragma("unroll") for(int r=0;r<16;++r){C0[r]-=dl;C1[r]-=dl;} \
        _Pragma("unroll") for(int r=0;r<16;++r)negm[r]=-mhat; asm volatile("":"+v"(negm)); \
        const float f=__builtin_amdgcn_exp2f(-dl); l_reg*=f; if(hi==0)wsf[r32]=f; resc=true; } } \
    SBAR(); \
    GAPB(o[0]=__builtin_amdgcn_mfma_f32_32x32x16_bf16(PAF(0),VFR(0),o[0],0,0,0), C0,0); \
    GAPB(o[1]=__builtin_amdgcn_mfma_f32_32x32x16_bf16(PAF(0),VFR(4),o[1],0,0,0), C0,4); \
    KRD(GL,0); GAPB(o[0]=__builtin_amdgcn_mfma_f32_32x32x16_bf16(PAF(1),VFR(1),o[0],0,0,0), C0,8); \
    KRD(GL,1); GAPB(o[1]=__builtin_amdgcn_mfma_f32_32x32x16_bf16(PAF(1),VFR(5),o[1],0,0,0), C0,12); \
    KRD(GL,2); GAPB(o[0]=__builtin_amdgcn_mfma_f32_32x32x16_bf16(PAF(2),VFR(2),o[0],0,0,0), C1,0); \
    KRD(GL,3); GAPB(o[1]=__builtin_amdgcn_mfma_f32_32x32x16_bf16(PAF(2),VFR(6),o[1],0,0,0), C1,4); \
    GAPB(o[0]=__builtin_amdgcn_mfma_f32_32x32x16_bf16(PAF(3),VFR(3),o[0],0,0,0), C1,8); \
    GAPB(o[1]=__builtin_amdgcn_mfma_f32_32x32x16_bf16(PAF(3),VFR(7),o[1],0,0,0), C1,12); \
    }while(0)
  int t=1;
  #undef CMASK
  #define CMASK(P0,P1,t) do{}while(0)
  for(;t+5<NT;t+=2){
    STEP(pB0,pB1,pA0,pA1,t,true,true,true);     WAIT_BAR(2); RESC(); ROT();
    STEP(pA0,pA1,pB0,pB1,t+1,true,true,true);   WAIT_BAR(2); RESC(); ROT();
  }
  #undef CMASK
  #define CMASK(P0,P1,t) do{int jb_=(t)-(NT-4); if(jb_>=0)cmask(P0,P1,jb_,qrel,hi);}while(0)
  #define ENDW(tt) do{ if((tt)+3<NT){WAIT_BAR(2);} else if((tt)+2<NT){WAIT_BAR(1);} else {WAIT_BAR(0);} }while(0)
  for(;t+1<NT;t+=2){
    STEP(pB0,pB1,pA0,pA1,t,(t+3<NT),(t+1<NT),(t+1<NT));       ENDW(t);   RESC(); ROT();
    STEP(pA0,pA1,pB0,pB1,t+1,(t+4<NT),(t+2<NT),(t+2<NT));     ENDW(t+1); RESC(); ROT();
  }
  STEP(pB0,pB1,pA0,pA1,NT-1,false,false,false); RESC();
  { float sacc=pB0[0]+pB0[1]; _Pragma("unroll") for(int r=2;r<16;++r)sacc+=pB0[r]; _Pragma("unroll") for(int r=0;r<16;++r)sacc+=pB1[r]; l_reg+=sacc;
    pw0=(u32x4){PKW(pB0,0),PKW(pB0,2),PKW(pB0,4),PKW(pB0,6)};pw1=(u32x4){PKW(pB0,8),PKW(pB0,10),PKW(pB0,12),PKW(pB0,14)};pw2=(u32x4){PKW(pB1,0),PKW(pB1,2),PKW(pB1,4),PKW(pB1,6)};pw3=(u32x4){PKW(pB1,8),PKW(pB1,10),PKW(pB1,12),PKW(pB1,14)};
    SBAR(); pv(o,vb0+sl_cur,PAF(0),PAF(1),PAF(2),PAF(3)); }
  #undef PKW
  #undef PAF
  #undef VFR
  #undef PIN
  #undef MX3
  #undef GAPA
  #undef GAPB
  #undef EX
  #undef VRD
  #undef KRD
  #undef STEP
  #undef ENDW
  {auto rr=__builtin_amdgcn_permlane32_swap(__float_as_uint(l_reg),__float_as_uint(l_reg),false,false);l_reg=__uint_as_float(rr[0])+__uint_as_float(rr[1]);}
  if(hi==0)wsf[32+r32]=l_reg;asm volatile("s_waitcnt lgkmcnt(0)":::"memory");
  float rli[16];
  #pragma unroll
  for(int r=0;r<16;++r)rli[r]=__builtin_amdgcn_rcpf(wsf[32+crow(r,hi)]);
  bf16*Ow=O+(rowbase+q0+wid*QBLK)*DMO+h*D;
  { bf16*stg=(bf16*)(shm+LDS_OST)+wid*2048;
    #pragma unroll
    for(int r=0;r<16;++r){const int orow=crow(r,hi);
      #pragma unroll
      for(int d0=0;d0<2;++d0)stg[orow*64+d0*32+r32]=__float2bfloat16(o[d0][r]*rli[r]);}
    asm volatile("s_waitcnt lgkmcnt(0)":::"memory");
    #pragma unroll
    for(int i=0;i<4;++i){const int row=i*8+(lane>>3),ch=lane&7; const u32x4 v=*(const u32x4*)(stg+row*64+ch*8); ATTN_STORE16(Ow+(long)row*DMO+ch*8,v);} }
  asm volatile("s_waitcnt lgkmcnt(0)\n\ts_barrier":::"memory");
  #undef DMA_K
  #undef DMA_V
  #undef CMASK
  #undef START
  #undef RESC
  #undef ROT
}
constexpr int ATTN_LDS_BYTES=LDS_BYTES;
struct AttnTensors { const bf16* Q; const bf16* K; const bf16* V; bf16* O; };
struct AttnUnit { int bh; int qb; };
struct StaticOrder {
  int vcu;
  __device__ __forceinline__ explicit StaticOrder(int grid,int block):vcu((block%8)*(grid/8)+block/8){}
  __device__ __forceinline__ bool next(int i,AttnUnit&u)const{ if(i>=4)return false; const int s=vcu&7; u.bh=vcu>>3; u.qb=(i==0)?s:(i==1)?15-s:(i==2)?16+s:31-s; return true; }
  __device__ __forceinline__ void a_ready(const AttnUnit&)const{}
  __device__ __forceinline__ void done(const AttnUnit&)const{}
};
template<class Sched,int THRL=8> __device__ __forceinline__ void attn_phase(char*lds,const AttnTensors&T,const Sched&S){
  AttnUnit u;
  for(int i=0;S.next(i,u);++i){ S.a_ready(u); attn_unit<THRL>(u.bh/NHEAD,u.bh%NHEAD,u.qb,T.Q,T.K,T.V,T.O,lds); S.done(u); }
}
#undef SBAR
#undef WAIT_BAR
}

#define LAS __attribute__((address_space(3)))
typedef unsigned short bfu;
typedef unsigned v4u __attribute__((ext_vector_type(4)));
typedef unsigned v2u __attribute__((ext_vector_type(2)));
typedef float f32x4 __attribute__((ext_vector_type(4)));
typedef float f32x8 __attribute__((ext_vector_type(8)));
typedef float f32x16 __attribute__((ext_vector_type(16)));
typedef float f32x2 __attribute__((ext_vector_type(2)));

constexpr int NWAVES = 8, NTHR = 512;
constexpr int MP = 65536, MS = 128, MR = MP + MS, MPAD = 65792;
constexpr int NIN = 3840, FFD = 4096;
constexpr int NPHASE = 24;
#ifndef MK_ONE_LAUNCH
#define MK_ONE_LAUNCH 1
#endif

constexpr size_t O_Y = 0;
constexpr size_t O_YS = (size_t)MP * 1024;
constexpr size_t O_ACP = O_YS + 128 * 1024;
constexpr size_t O_ADP = O_ACP + 2 * 8 * 3 * 768;
constexpr size_t O_BKP = O_ADP + 2 * 8 * 4 * 64 * 64;
constexpr size_t O_BVP = O_BKP + (size_t)2 * 8 * 8192 * 512;
constexpr size_t O_CSP = O_BVP + (size_t)2 * 8 * 8192 * 512;
constexpr size_t O_CWP = O_CSP + 2 * 8 * 1024;
constexpr size_t O_ACS = O_CWP + 2 * 8 * 4 * 64 * 64;
constexpr size_t O_ADS = O_ACS + 2 * 8 * 3 * 768;
constexpr size_t O_BKS = O_ADS + 2 * 8 * 4 * 64 * 64;
constexpr size_t O_BVS = O_BKS + 2 * 8 * 16 * 512;
constexpr size_t O_CSS = O_BVS + 2 * 8 * 16 * 512;
constexpr size_t O_CWS = O_CSS + 2 * 8 * 1024;
constexpr size_t O_END = O_CWS + 2 * 8 * 4 * 64 * 64;
static_assert(O_END == 202874880, "output size");

constexpr size_t MiB = 1u << 20;
constexpr size_t WS_CTL = 0;
constexpr size_t WS_RS = 64 * 1024;
constexpr size_t WS_BONUS = 2 * MiB;
constexpr size_t WS_GAB = 3 * MiB + 512 * 1024;
constexpr size_t WS_AB = 6 * MiB;
constexpr size_t WS_ROPE = 8 * MiB + 512 * 1024;
constexpr size_t WS_GCH = 10 * MiB + 512 * 1024;
constexpr size_t WS_W = 12 * MiB;
constexpr size_t W_IN = 0, W_OUT = W_IN + (size_t)NIN * 1024 * 2, W_FF1 = W_OUT + 1024 * 1024 * 2, W_FF2 = W_FF1 + 4096 * 1024 * 2,
                 W_GATE = W_FF2 + 4096 * 1024 * 2, W_PP = W_GATE + 1024 * 1024 * 2, W_LR = W_PP + 1024 * 256 * 2, W_END = W_LR + 768 * 256 * 2;
constexpr size_t WS_SLOT = 41 * MiB;
constexpr size_t USLOT = (size_t)MPAD * 1024;
static_assert(WS_W + W_END <= WS_SLOT, "weights");
constexpr size_t WS_PAIRC = WS_SLOT + 15 * USLOT;
constexpr size_t WS_PAIRD = WS_PAIRC + 4 * (size_t)(MPAD / 2) * 16;
constexpr size_t WS_TOTAL = WS_PAIRD + 4 * (size_t)(MPAD / 2) * 8;
static_assert(WS_TOTAL <= (size_t)1024 * MiB, "ws");
static_assert(WS_RS + 7 * (size_t)MPAD * 4 <= WS_BONUS && WS_BONUS + 4 * (size_t)MPAD * 4 <= WS_GAB && WS_GAB + 8 * (size_t)MPAD * 4 <= WS_AB && WS_AB + 8 * (size_t)MPAD * 4 <= WS_ROPE && WS_ROPE + 8192 * 64 * 4 <= WS_GCH && WS_GCH + 4 * 1032 * 64 * 4 <= WS_W, "ctl map");

__device__ __forceinline__ unsigned char* slotp(unsigned char* ws, int l, int s) {
    if (l & 1) { if (s < 2) s += 13; else if (s >= 13) s -= 13; }
    return ws + WS_SLOT + (size_t)s * USLOT;
}
__device__ __forceinline__ unsigned char* slotph(unsigned char* ws, int l, int s) { return slotp(ws, l, s) + USLOT / 2; }

constexpr int RING_BYTES = 131072, MISC_OFF = RING_BYTES + 320, LDS_BYTES = 147456;

#define LDS_WAIT() asm volatile("s_waitcnt lgkmcnt(0)" ::: "memory")
__device__ __forceinline__ float bf2f(unsigned short u) { return __uint_as_float(((unsigned)u) << 16); }
__device__ __forceinline__ unsigned f2bf(float f) { unsigned u = __builtin_bit_cast(unsigned, f); return (u + 0x7fffu + ((u >> 16) & 1u)) >> 16; }
__device__ __forceinline__ unsigned pk2(float lo, float hi) { return f2bf(lo) | (f2bf(hi) << 16); }
#define DPP_ROR_ADD(v, ctrl) ((v) + __builtin_bit_cast(float, __builtin_amdgcn_update_dpp(0, __builtin_bit_cast(int, (v)), (ctrl), 0xf, 0xf, false)))
__device__ __forceinline__ float wave_sum(float v) {
    v = DPP_ROR_ADD(v, 0x128); v = DPP_ROR_ADD(v, 0x124); v = DPP_ROR_ADD(v, 0x122); v = DPP_ROR_ADD(v, 0x121);
    v += __shfl_xor(v, 16);
    const unsigned u = __float_as_uint(v); auto rr = __builtin_amdgcn_permlane32_swap(u, u, false, false);
    return __uint_as_float(rr[0]) + __uint_as_float(rr[1]);
}
__device__ __forceinline__ float sigm(float x) { return 1.f / (1.f + __expf(-x)); }
__device__ __forceinline__ float softplusf(float x) { return x > 20.f ? x : log1pf(__expf(x)); }

struct Args { const float* in[40]; float* out; unsigned char* ws; int ph_lo, ph_hi; };
typedef const __attribute__((address_space(4))) Args* KArgs;

constexpr float ATT_C2 = 0.125f * 1.4426950408889634f;
struct EpiG1 {
    static constexpr bool PERM = false, AFTER_DRAIN = false;
    const float* rs; bfu *aqkvz, *qb, *kb, *vb, *craw; float* ab; const float* rope; float *okp, *ovp, *oks, *ovs;
    __device__ __forceinline__ void operator()(const pg8::f32x4 (&acc)[2][2][4][2], const pg8::Unit& u, int wr, int wc, int fr, int fq) const {
        const int pn = u.pn; const int rowb = u.pm * 256 + wr * 64 + fr; const int cl = wc * 32 + 4 * fq;
#pragma unroll
        for (int ai = 0; ai < 2; ++ai)
#pragma unroll
            for (int m = 0; m < 4; ++m) {
                const int row = rowb + ai * 128 + m * 16;
                const float s = rsqrtf(rs[row] * (1.f / 1024.f) + 1e-6f);
                if (pn < 4 || (pn >= 10 && pn < 14)) {
                    bfu* dst = (pn < 4 ? aqkvz + pn * 256 : craw + (pn - 10) * 256) + (size_t)row * 1024 + cl;
#pragma unroll
                    for (int bj = 0; bj < 2; ++bj)
#pragma unroll
                        for (int n = 0; n < 2; ++n) { const pg8::f32x4 v = acc[ai][bj][m][n] * s; v2u w; w.x = pg8::cvt_pk_bf16(v[0], v[1]); w.y = pg8::cvt_pk_bf16(v[2], v[3]); *(v2u*)(dst + bj * 128 + n * 16) = w; }
                } else if (pn < 8) {
                    const bool isk = pn >= 6;
                    const int pos = row < MP ? (row & 8191) : 2048 + ((row - MP) & 15);
                    const int i0 = (wc & 1) * 16 + 4 * fq;
                    const pg8::f32x4 c4 = *(const pg8::f32x4*)(rope + pos * 64 + i0), s4 = *(const pg8::f32x4*)(rope + pos * 64 + 32 + i0);
#pragma unroll
                    for (int bj = 0; bj < 2; ++bj) {
                        const pg8::f32x4 x1 = acc[ai][bj][m][0] * s, x2 = acc[ai][bj][m][1] * s;
                        pg8::f32x4 o1 = x1 * c4 - x2 * s4, o2 = x2 * c4 + x1 * s4;
                        if (!isk) {
                            o1 = o1 * ATT_C2; o2 = o2 * ATT_C2;
                            bfu* d = qb + (size_t)row * 512 + (pn - 4) * 256 + bj * 128 + cl;
                            v2u w; w.x = pg8::cvt_pk_bf16(o1[0], o1[1]); w.y = pg8::cvt_pk_bf16(o1[2], o1[3]); *(v2u*)d = w;
                            w.x = pg8::cvt_pk_bf16(o2[0], o2[1]); w.y = pg8::cvt_pk_bf16(o2[2], o2[3]); *(v2u*)(d + 16) = w;
                        } else {
                            bfu* d = kb + (size_t)row * 512 + (pn - 6) * 256 + bj * 128 + cl;
                            v2u w; w.x = pg8::cvt_pk_bf16(o1[0], o1[1]); w.y = pg8::cvt_pk_bf16(o1[2], o1[3]); *(v2u*)d = w;
                            w.x = pg8::cvt_pk_bf16(o2[0], o2[1]); w.y = pg8::cvt_pk_bf16(o2[2], o2[3]); *(v2u*)(d + 16) = w;
                            if (row < MR) {
                                float* ob = (row < MP ? okp + (size_t)row * 512 : oks + (size_t)(row - MP) * 512) + (pn - 6) * 256 + bj * 128 + (wc >> 1) * 64 + (wc & 1) * 16 + 4 * fq;
                                *(pg8::f32x4*)ob = o1; *(pg8::f32x4*)(ob + 32) = o2;
                            }
                        }
                    }
                } else if (pn < 10) {
#pragma unroll
                    for (int bj = 0; bj < 2; ++bj)
#pragma unroll
                        for (int n = 0; n < 2; ++n) {
                            const pg8::f32x4 v = acc[ai][bj][m][n] * s; const int col = (pn - 8) * 256 + bj * 128 + cl + n * 16;
                            v2u w; w.x = pg8::cvt_pk_bf16(v[0], v[1]); w.y = pg8::cvt_pk_bf16(v[2], v[3]); *(v2u*)(vb + (size_t)row * 512 + col) = w;
                            if (row < MR) { float* ob = (row < MP ? ovp + (size_t)row * 512 : ovs + (size_t)(row - MP) * 512) + col; *(pg8::f32x4*)ob = v; }
                        }
                } else {
                    if (wc == 0 && fq < 2) { const pg8::f32x4 v = acc[ai][0][m][0] * s; *(pg8::f32x4*)(ab + (size_t)row * 8 + 4 * fq) = v; }
                }
            }
    }
};
template <int MODE> struct EpiB {
    static constexpr bool PERM = true, AFTER_DRAIN = false;
    bfu* O; int ldc; const float* rs;
    __device__ __forceinline__ void operator()(const pg8::f32x4 (&acc)[2][2][4][2], const pg8::Unit& u, int wr, int wc, int fr, int fq) const {
        const int rowb = u.pm * 256 + wr * 64 + fr; const int cl = u.pn * 256 + wc * 32 + 8 * fq;
#pragma unroll
        for (int ai = 0; ai < 2; ++ai)
#pragma unroll
            for (int m = 0; m < 4; ++m) {
                const int row = rowb + ai * 128 + m * 16;
                float s = 1.f; if (MODE == 1) s = rsqrtf(rs[row] * (1.f / 1024.f) + 1e-6f);
                bfu* dst = O + (size_t)row * ldc + cl;
#pragma unroll
                for (int bj = 0; bj < 2; ++bj) {
                    pg8::f32x4 v0 = acc[ai][bj][m][0], v1 = acc[ai][bj][m][1];
                    if (MODE == 1) { v0 = v0 * s; v1 = v1 * s;
                        v0[0] = fmaxf(v0[0], 0.f); v0[1] = fmaxf(v0[1], 0.f); v0[2] = fmaxf(v0[2], 0.f); v0[3] = fmaxf(v0[3], 0.f); v1[0] = fmaxf(v1[0], 0.f); v1[1] = fmaxf(v1[1], 0.f); v1[2] = fmaxf(v1[2], 0.f); v1[3] = fmaxf(v1[3], 0.f);
                        v0 = v0 * v0; v1 = v1 * v1; }
                    v4u w; w.x = pg8::cvt_pk_bf16(v0[0], v0[1]); w.y = pg8::cvt_pk_bf16(v0[2], v0[3]); w.z = pg8::cvt_pk_bf16(v1[0], v1[1]); w.w = pg8::cvt_pk_bf16(v1[2], v1[3]);
                    *(v4u*)(dst + bj * 128) = w;
                }
            }
    }
};
template <int MODE> struct EpiH {
    static constexpr bool PERM = true, AFTER_DRAIN = false;
    float* H; bfu* xh; float* rsn; const float* rs; const bfu* pp;
    __device__ __forceinline__ void operator()(const pg8::f32x4 (&acc)[2][2][4][2], const pg8::Unit& u, int wr, int wc, int fr, int fq) const {
        const int rowb = u.pm * 256 + wr * 64 + fr; const int cl = u.pn * 256 + wc * 32 + 8 * fq;
#pragma unroll
        for (int ai = 0; ai < 2; ++ai)
#pragma unroll
            for (int m = 0; m < 4; ++m) {
                const int row = rowb + ai * 128 + m * 16; const bool valid = row < MR; float ss = 0.f;
                if (valid) {
                    float s = 1.f; if (MODE == 3) s = rsqrtf(rs[row] * (1.f / 1024.f) + 1e-6f);
#pragma unroll
                    for (int bj = 0; bj < 2; ++bj) {
                        const size_t off = (size_t)row * 1024 + cl + bj * 128;
                        pg8::f32x4 h0 = *(const pg8::f32x4*)(H + off), h1 = *(const pg8::f32x4*)(H + off + 4); const pg8::f32x4 a0 = acc[ai][bj][m][0], a1 = acc[ai][bj][m][1];
                        if (MODE == 3) { const v4u pw = *(const v4u*)(pp + off);
                            h0[0] += sigm(a0[0] * s) * __uint_as_float(pw.x << 16); h0[1] += sigm(a0[1] * s) * __uint_as_float(pw.x & 0xffff0000u);
                            h0[2] += sigm(a0[2] * s) * __uint_as_float(pw.y << 16); h0[3] += sigm(a0[3] * s) * __uint_as_float(pw.y & 0xffff0000u);
                            h1[0] += sigm(a1[0] * s) * __uint_as_float(pw.z << 16); h1[1] += sigm(a1[1] * s) * __uint_as_float(pw.z & 0xffff0000u);
                            h1[2] += sigm(a1[2] * s) * __uint_as_float(pw.w << 16); h1[3] += sigm(a1[3] * s) * __uint_as_float(pw.w & 0xffff0000u);
                        } else { h0 = h0 + a0; h1 = h1 + a1; }
                        *(pg8::f32x4*)(H + off) = h0; *(pg8::f32x4*)(H + off + 4) = h1;
                        v4u w; w.x = pg8::cvt_pk_bf16(h0[0], h0[1]); w.y = pg8::cvt_pk_bf16(h0[2], h0[3]); w.z = pg8::cvt_pk_bf16(h1[0], h1[1]); w.w = pg8::cvt_pk_bf16(h1[2], h1[3]); *(v4u*)(xh + off) = w;
                        ss += ((h0[0] * h0[0] + h0[1] * h0[1]) + (h0[2] * h0[2] + h0[3] * h0[3])) + ((h1[0] * h1[0] + h1[1] * h1[1]) + (h1[2] * h1[2] + h1[3] * h1[3]));
                    }
                }
                ss += __shfl_xor(ss, 16); ss += __shfl_xor(ss, 32);
                if (valid && fq == 0) unsafeAtomicAdd(rsn + row, ss);
            }
    }
};

__device__ __forceinline__ int win_src(int nd) {
    if (nd < 1024) return nd;
    if (nd < 2048) { const int c = nd - 1024, p = c & 63, grp = c >> 6; const int s = p >> 5, n_ = (p >> 4) & 1, r = p & 15; return 1032 + grp * 64 + n_ * 32 + s * 16 + r; }
    if (nd < 2560) return 2056 + (nd - 2048);
    if (nd < 3584) return 2568 + (nd - 2560);
    if (nd < 3592) return 1024 + (nd - 3584);
    return -1;
}
template <bool MAP> __device__ __forceinline__ void wt_item(const float* W, int K, int Nsrc, bfu* WT, const float* gain, LAS float* scr, int item, int nblk, int lane) {
    const int kb = item / nblk, nb = item % nblk, k0 = 64 * kb, n0 = 32 * nb;
    const int nd = n0 + (lane & 31); const int src = MAP ? win_src(nd) : nd;
#pragma unroll 8
    for (int i = 0; i < 32; ++i) { const int kk = 2 * i + (lane >> 5); float v = src >= 0 ? W[(size_t)(k0 + kk) * Nsrc + src] : 0.f; if (gain) v *= gain[k0 + kk]; scr[kk * 33 + (lane & 31)] = v; }
    LDS_WAIT(); asm volatile("" ::: "memory");
    const int c = lane & 7;
#pragma unroll
    for (int j = 0; j < 4; ++j) { const int n = (lane >> 3) + 8 * j; const LAS float* s = scr + (8 * c) * 33 + n;
        v4u o; o.x = pk2(s[0 * 33], s[1 * 33]); o.y = pk2(s[2 * 33], s[3 * 33]); o.z = pk2(s[4 * 33], s[5 * 33]); o.w = pk2(s[6 * 33], s[7 * 33]);
        *(v4u*)(WT + (size_t)(n0 + n) * K + k0 + 8 * c) = o; }
    LDS_WAIT(); asm volatile("" ::: "memory");
}
__device__ __forceinline__ void conv_weights(KArgs A, int l, int mask, LAS unsigned char* lds, int gw, int NGW, int lane, int wave) {
    LAS float* scr = (LAS float*)(lds + wave * 16384);
    unsigned char* wb = A->ws + WS_W;
    if (mask & 1) {
        const float* win = A->in[11] + (size_t)l * 1024 * 3592; const float* g = A->in[10] + l * 1024;
        for (int it = gw; it < 16 * 120; it += NGW) wt_item<true>(win, 1024, 3592, (bfu*)(wb + W_IN), g, scr, it, 120, lane);
        const float* wu = A->in[23] + (size_t)l * 64 * 256; const float* au = A->in[25] + (size_t)l * 64 * 256; const float* gu = A->in[26] + (size_t)l * 128 * 256;
        bfu* lr = (bfu*)(wb + W_LR);
        for (int i = gw * 64 + lane; i < 768 * 256; i += NGW * 64) { const int n = i >> 8, k = i & 255; float v = 0.f;
            if (n < 256) { if (k < 64) v = wu[k * 256 + n]; } else if (n < 512) { if (k >= 64 && k < 128) v = au[(k - 64) * 256 + (n - 256)]; } else { if (k >= 128) v = gu[(k - 128) * 256 + (n - 512)]; }
            lr[i] = (bfu)f2bf(v); }
    }
    if (mask & 2) {
        const float* wo = A->in[32] + (size_t)l * 1024 * 1024; const float* f1 = A->in[34] + (size_t)l * 1024 * 4096; const float* f2 = A->in[35] + (size_t)l * 4096 * 1024;
        const float* wg = A->in[37] + (size_t)l * 1024 * 1024; const float* wp = A->in[38] + (size_t)l * 256 * 1024;
        const float* gf = A->in[33] + l * 1024; const float* gp = A->in[36] + l * 1024;
        constexpr int I_O = 16 * 32, I_1 = 16 * 128, I_2 = 64 * 32, I_G = 16 * 32, I_P = 4 * 32;
        for (int it = gw; it < I_O + I_1 + I_2 + I_G + I_P; it += NGW) {
            int r = it;
            if (r < I_O) { wt_item<false>(wo, 1024, 1024, (bfu*)(wb + W_OUT), nullptr, scr, r, 32, lane); continue; } r -= I_O;
            if (r < I_1) { wt_item<false>(f1, 1024, 4096, (bfu*)(wb + W_FF1), gf, scr, r, 128, lane); continue; } r -= I_1;
            if (r < I_2) { wt_item<false>(f2, 4096, 1024, (bfu*)(wb + W_FF2), nullptr, scr, r, 32, lane); continue; } r -= I_2;
            if (r < I_G) { wt_item<false>(wg, 1024, 1024, (bfu*)(wb + W_GATE), gp, scr, r, 32, lane); continue; } r -= I_G;
            wt_item<false>(wp, 256, 1024, (bfu*)(wb + W_PP), nullptr, scr, r, 32, lane);
        }
    }
}
__device__ __forceinline__ void conv_p(KArgs A, int l, bfu* pb, int gtid, int NT) {
    const float* pp = A->in[8] + (size_t)l * MP * 256; const float* ps = A->in[9] + (size_t)l * MS * 256;
    for (int i = gtid; i < MR * 64; i += NT) { const int m = i >> 6, c = (i & 63) * 4;
        const f32x4 v = *(const f32x4*)(m < MP ? pp + (size_t)m * 256 + c : ps + (size_t)(m - MP) * 256 + c);
        v2u w; w.x = pk2(v[0], v[1]); w.y = pk2(v[2], v[3]); *(v2u*)(pb + (size_t)m * 256 + c) = w; }
}
__device__ __forceinline__ void prologue(KArgs A, LAS unsigned char* lds, int gw, int NGW, int lane, int wave, int gtid, int NT) {
    conv_weights(A, 0, 3, lds, gw, NGW, lane, wave);
    unsigned char* ws = A->ws;
    float* rs = (float*)(ws + WS_RS); bfu* xh = (bfu*)slotp(ws, 0, 0); float* H = A->out;
    for (int i = gtid; i < 6 * MPAD; i += NT) rs[MPAD + i] = 0.f;
    for (int m = gw; m < MPAD; m += NGW) {
        if (m < MR) {
            const float* xr = m < MP ? A->in[0] + (size_t)m * 1024 : A->in[1] + (size_t)(m - MP) * 1024; float ss = 0.f;
#pragma unroll
            for (int j = 0; j < 4; ++j) { const f32x4 v = *(const f32x4*)(xr + j * 256 + lane * 4); *(f32x4*)(H + (size_t)m * 1024 + j * 256 + lane * 4) = v;
                v2u w; w.x = pk2(v[0], v[1]); w.y = pk2(v[2], v[3]); *(v2u*)(xh + (size_t)m * 1024 + j * 256 + lane * 4) = w; ss += (v[0] * v[0] + v[1] * v[1]) + (v[2] * v[2] + v[3] * v[3]); }
            ss = wave_sum(ss); if (lane == 0) rs[m] = ss;
        } else {
#pragma unroll
            for (int j = 0; j < 4; ++j) *(v2u*)(xh + (size_t)m * 1024 + j * 256 + lane * 4) = (v2u){0u, 0u};
            if (lane == 0) rs[m] = 1024.f;
        }
    }
    float* rope = (float*)(ws + WS_ROPE);
    for (int i = gtid; i < 8192 * 32; i += NT) { const int pos = i >> 5, k = i & 31;
        const float inv = exp2f(-(float)k * (13.287712379549449f / 32.0f)); const float ang = (float)pos * inv;
        const float nn = rintf(ang * 0.15915494309189535f); const float fr = fmaf(-nn, 1.9353071795864769e-3f, fmaf(-nn, 6.28125f, ang));
        rope[pos * 64 + k] = __cosf(fr); rope[pos * 64 + 32 + k] = __sinf(fr); }
    if (gw == 0) {
        for (int l = 0; l < 2; ++l) {
            const float a = wave_sum(A->in[16][l * 64 + lane] * A->in[17][l * 64 + lane]), b = wave_sum(A->in[18][l * 64 + lane] * A->in[19][l * 64 + lane]);
            const float li = 0.8f - 0.6f * expf(-0.3f * (float)l);
            if (lane == 0) { float* lf = (float*)(ws + WS_CTL + 1024); lf[2 * l] = expf(a) - expf(b) + li; lf[2 * l + 1] = li; }
        }
    }
}

__device__ __forceinline__ void prep_a(KArgs A, int l, int gw, int NGW, int lane) {
    unsigned char* ws = A->ws;
    const bfu* aq = (const bfu*)slotp(ws, l, 2); const float* ab = (const float*)(ws + WS_AB);
    float* sia = (float*)slotp(ws, l, 9); bfu* va = (bfu*)slotp(ws, l, 11); bfu* zs = (bfu*)slotph(ws, l, 11); float* gab = (float*)(ws + WS_GAB);
    const float* cw = A->in[12] + l * 4 * 768; const float* stc = A->in[4] + (size_t)l * 8 * 3 * 768;
    const float* anorm = A->in[15] + l * 64;
    for (int m = gw; m < MR; m += NGW) {
        int t, L, sb = 0; const bool smp = m >= MP; float* aco;
        if (!smp) { t = m & 8191; L = 8192; aco = A->out + O_ACP + ((size_t)(l * 8 + (m >> 13)) * 3) * 768; }
        else { sb = (m - MP) >> 4; t = (m - MP) & 15; L = 16; aco = A->out + O_ACS + ((size_t)(l * 8 + sb) * 3) * 768; }
#pragma unroll 1
        for (int h = 0; h < 4; ++h) {
            float val[3];
#pragma unroll
            for (int g = 0; g < 3; ++g) {
                const int c = g * 256 + h * 64 + lane; float x[4];
#pragma unroll
                for (int d = 0; d < 4; ++d) { const int tt = t - d;
                    x[d] = tt >= 0 ? bf2f(aq[(size_t)(m - d) * 1024 + c]) : (smp ? stc[((size_t)sb * 3 + (3 + tt)) * 768 + c] : 0.f); }
                const float y = x[3] * cw[c] + x[2] * cw[768 + c] + x[1] * cw[1536 + c] + x[0] * cw[2304 + c];
                val[g] = y * sigm(y);
                if (t >= L - 3) aco[(size_t)(t - (L - 3)) * 768 + c] = x[0];
            }
            const float sq = wave_sum(val[0] * val[0]), sk = wave_sum(val[1] * val[1]);
            const float qn = val[0] * rsqrtf(sq + 1e-6f) * 0.125f, kn = val[1] * rsqrtf(sk + 1e-6f);
            float* rec = sia + ((size_t)(h * 8 + (lane >> 3)) * MPAD + m) * 16 + (lane & 7);
            rec[0] = kn; rec[8] = qn;
            va[(size_t)m * 256 + h * 64 + lane] = (bfu)f2bf(val[2]);
            const float z = bf2f(aq[(size_t)m * 1024 + 768 + h * 64 + lane]);
            zs[(size_t)m * 256 + h * 64 + lane] = (bfu)f2bf(z * sigm(z) * anorm[lane]);
        }
        if (lane < 4) { const int h = lane;
            const float g = -__expf(A->in[13][l * 4 + h]) * softplusf(ab[(size_t)m * 8 + h] + A->in[14][l * 4 + h]);
            gab[((size_t)h * MPAD + m) * 2] = __expf(g); gab[((size_t)h * MPAD + m) * 2 + 1] = sigm(ab[(size_t)m * 8 + 4 + h]); }
    }
}
__device__ __forceinline__ void prep_c1(KArgs A, int l, int gw, int NGW, int lane) {
    unsigned char* ws = A->ws;
    const bfu* cr = (const bfu*)slotp(ws, l, 7); bfu* lra = (bfu*)slotp(ws, l, 12);
    const float* mu = A->in[21] + l * 1024; const float* sts = A->in[6] + (size_t)l * 8 * 1024;
    for (int m = gw; m < MR; m += NGW) {
        int t, L, sb = 0; const bool smp = m >= MP; float* cso;
        if (!smp) { t = m & 8191; L = 8192; cso = A->out + O_CSP + (size_t)(l * 8 + (m >> 13)) * 1024; }
        else { sb = (m - MP) >> 4; t = (m - MP) & 15; L = 16; cso = A->out + O_CSS + (size_t)(l * 8 + sb) * 1024; }
#pragma unroll
        for (int i = 0; i < 4; ++i) { const int j = 768 + lane + 64 * i;
            const float cur = bf2f(cr[(size_t)m * 1024 + j]);
            const float prev = t > 0 ? bf2f(cr[(size_t)(m - 1) * 1024 + j]) : (smp ? sts[(size_t)sb * 1024 + j] : 0.f);
            const float c = cur + (prev - cur) * mu[j];
            const float o = i == 0 ? tanhf(c) : (i == 1 ? c : sigm(c));
            lra[(size_t)m * 256 + lane + 64 * i] = (bfu)f2bf(o); }
        if (t == L - 1) {
#pragma unroll
            for (int i = 0; i < 16; ++i) cso[lane + 64 * i] = bf2f(cr[(size_t)m * 1024 + lane + 64 * i]);
        }
    }
}
__device__ __forceinline__ void prep_c2(KArgs A, int l, int bid, int G, int tid) {
    unsigned char* ws = A->ws;
    const bfu* cr = (const bfu*)slotp(ws, l, 7); const bfu* lro = (const bfu*)slotp(ws, l, 13);
    bfu* v2 = (bfu*)slotp(ws, l, 12); bfu* gg = (bfu*)slotph(ws, l, 12);
    float* bonus = (float*)(ws + WS_BONUS); float* gch = (float*)(ws + WS_GCH); float* pairc = (float*)(ws + WS_PAIRC);
    const float* mu = A->in[21] + l * 1024; const float* sts = A->in[6] + (size_t)l * 8 * 1024;
    const int ch = tid & 255, h = ch >> 6, lane = ch & 63, half = tid >> 8;
    float* sic = (float*)slotp(ws, l, h) + ((size_t)(lane >> 3) * MPAD) * 32 + (lane & 7);
    const float mur = mu[ch], muk = mu[256 + ch], muv = mu[512 + ch];
    const float w0 = A->in[22][l * 256 + ch], a0 = A->in[24][l * 256 + ch], kk_ = A->in[27][l * 256 + ch], ka = A->in[28][l * 256 + ch], rk = A->in[29][l * 256 + ch];
    for (int u = bid * 2 + half; u < 1032; u += G * 2) {
        int m0, n; float pr, pk, pv;
        if (u < 1024) { m0 = u * 64; n = 64;
            if ((u & 127) == 0) { pr = pk = pv = 0.f; } else { pr = bf2f(cr[(size_t)(m0 - 1) * 1024 + ch]); pk = bf2f(cr[(size_t)(m0 - 1) * 1024 + 256 + ch]); pv = bf2f(cr[(size_t)(m0 - 1) * 1024 + 512 + ch]); } }
        else { const int sb = u - 1024; m0 = MP + sb * 16; n = 16; pr = sts[(size_t)sb * 1024 + ch]; pk = sts[(size_t)sb * 1024 + 256 + ch]; pv = sts[(size_t)sb * 1024 + 512 + ch]; }
        float cum = 0.f, pkka = 0.f, pkp = 0.f;
#pragma unroll 4
        for (int tt = 0; tt < n; ++tt) { const int m = m0 + tt;
            const float c_r = bf2f(cr[(size_t)m * 1024 + ch]), c_k = bf2f(cr[(size_t)m * 1024 + 256 + ch]), c_v = bf2f(cr[(size_t)m * 1024 + 512 + ch]);
            const float r = c_r + (pr - c_r) * mur, k = c_k + (pk - c_k) * muk, v = c_v + (pv - c_v) * muv; pr = c_r; pk = c_k; pv = c_v;
            const float lw = bf2f(lro[(size_t)m * 768 + ch]), la = bf2f(lro[(size_t)m * 768 + 256 + ch]); const bfu gb = lro[(size_t)m * 768 + 512 + ch];
            const float wl = -0.6065306597126334f * sigm(w0 + lw); const float a = sigm(a0 + la);
            const float kkr = k * kk_; const float kk = kkr * rsqrtf(wave_sum(kkr * kkr) + 1e-6f);
            const float kp = k * (1.f + (a - 1.f) * ka);
            const float Gp = __expf(cum); cum += wl; const float Gc = __expf(cum), iG = __expf(-cum);
            float* rec = sic + (size_t)m * 32;
            rec[0] = kk * Gp; rec[8] = kk * a * iG; rec[16] = kp * iG; rec[24] = r * Gc;
            { const float kka = kk * a; float* pc = pairc + ((size_t)h * (MPAD / 2) + (m >> 1)) * 4;
              if (tt & 1) { const float c22 = wave_sum(pkka * kk), c32 = wave_sum(pkp * kk); if (lane == 0) { pc[0] = c22; pc[1] = c32; } }
              else { const float c24 = wave_sum(kka * r), c34 = wave_sum(kp * r); if (lane == 0) { pc[2] = c24; pc[3] = c34; } }
              pkka = kka; pkp = kp; }
            const float bo = wave_sum(r * kp * rk); if (lane == 0) bonus[(size_t)h * MPAD + m] = bo;
            v2[(size_t)m * 256 + ch] = (bfu)f2bf(v); gg[(size_t)m * 256 + ch] = gb;
        }
        gch[((size_t)h * 1032 + u) * 64 + lane] = __expf(cum);
    }
}
__device__ __forceinline__ void prep_a2(KArgs A, int l, int gw, int NGW, int lane) {
    unsigned char* ws = A->ws; const float* sia = (const float*)slotp(ws, l, 9); float* paird = (float*)(ws + WS_PAIRD);
    for (int task = gw; task < 4 * (MR / 2); task += NGW) { const int h = task & 3, pr = task >> 2, m = 2 * pr;
        const float* rec = sia + ((size_t)(h * 8 + (lane >> 3)) * MPAD + m) * 16 + (lane & 7);
        const float k1 = rec[0], q1 = rec[8], k2 = rec[16];
        const float g12 = wave_sum(k1 * k2), h11 = wave_sum(q1 * k1);
        if (lane == 0) { paird[((size_t)h * (MPAD / 2) + pr) * 2] = g12; paird[((size_t)h * (MPAD / 2) + pr) * 2 + 1] = h11; } }
}
__device__ __forceinline__ void post_attn(KArgs A, int l, int gw, int NGW, int lane) {
    unsigned char* ws = A->ws;
    const bfu* O = (const bfu*)slotp(ws, l, 13); bfu* mix = (bfu*)slotp(ws, l, 7);
    const float* lf = (const float*)(ws + WS_CTL + 1024); const float lam = lf[2 * l], omli = 1.f - lf[2 * l + 1];
    const int h = lane >> 4, e0 = (lane & 15) * 8; const float* bn = A->in[20] + l * 128 + e0;
    float bnv[8];
#pragma unroll
    for (int i = 0; i < 8; ++i) bnv[i] = bn[i] * omli;
    for (int m = gw; m < MP; m += NGW) {
        const v4u a = *(const v4u*)(O + (size_t)m * 1024 + (4 * h + (e0 >> 6)) * 64 + (e0 & 63));
        const v4u b = *(const v4u*)(O + (size_t)m * 1024 + (4 * h + 2 + (e0 >> 6)) * 64 + (e0 & 63));
        float o[8]; float ss = 0.f;
#pragma unroll
        for (int i = 0; i < 4; ++i) { const unsigned aw = a[i], bw = b[i];
            o[2 * i] = __uint_as_float(aw << 16) - lam * __uint_as_float(bw << 16); o[2 * i + 1] = __uint_as_float(aw & 0xffff0000u) - lam * __uint_as_float(bw & 0xffff0000u);
            ss += o[2 * i] * o[2 * i] + o[2 * i + 1] * o[2 * i + 1]; }
        ss += __shfl_xor(ss, 1); ss += __shfl_xor(ss, 2); ss += __shfl_xor(ss, 4); ss += __shfl_xor(ss, 8);
        const float rn = rsqrtf(ss * (1.f / 128.f) + 1e-6f);
        v4u w; w.x = pk2(o[0] * rn * bnv[0], o[1] * rn * bnv[1]); w.y = pk2(o[2] * rn * bnv[2], o[3] * rn * bnv[3]); w.z = pk2(o[4] * rn * bnv[4], o[5] * rn * bnv[5]); w.w = pk2(o[6] * rn * bnv[6], o[7] * rn * bnv[7]);
        *(v4u*)(mix + (size_t)m * 1024 + 256 + h * 128 + e0) = w;
    }
}
__device__ __forceinline__ void post_scan(KArgs A, int l, int gw, int NGW, int lane) {
    unsigned char* ws = A->ws; bfu* mix = (bfu*)slotp(ws, l, 7);
    const bfu* zs = (const bfu*)slotph(ws, l, 11); const bfu* v2 = (const bfu*)slotp(ws, l, 12); const bfu* gg = (const bfu*)slotph(ws, l, 12);
    const float* bonus = (const float*)(ws + WS_BONUS);
    for (int m = gw; m < MR; m += NGW) {
#pragma unroll
        for (int h = 0; h < 4; ++h) {
            bfu* pa = mix + (size_t)m * 1024 + h * 64 + lane; const float o = bf2f(*pa);
            const float ss = wave_sum(o * o) * (1.f / 64.f);
            *pa = (bfu)f2bf(o * rsqrtf(ss + 1e-6f) * bf2f(zs[(size_t)m * 256 + h * 64 + lane]));
            bfu* pc = mix + (size_t)m * 1024 + 768 + h * 64 + lane; const float y = bf2f(*pc);
            const float mu = wave_sum(y) * (1.f / 64.f); const float d = y - mu; const float var = wave_sum(d * d) * (1.f / 64.f);
            const float cy = d * rsqrtf(var + 64e-5f) * A->in[30][l * 256 + h * 64 + lane] + A->in[31][l * 256 + h * 64 + lane];
            *pc = (bfu)f2bf((cy + bonus[(size_t)h * MPAD + m] * bf2f(v2[(size_t)m * 256 + h * 64 + lane])) * bf2f(gg[(size_t)m * 256 + h * 64 + lane]));
        }
    }
}
__device__ __forceinline__ void final_norm(KArgs A, int gw, int NGW, int lane) {
    const float* rs = (const float*)(A->ws + WS_RS) + 6 * (size_t)MPAD; const float* g = A->in[39];
    for (int m = gw; m < MR; m += NGW) { const float s = rsqrtf(rs[m] * (1.f / 1024.f) + 1e-6f);
#pragma unroll
        for (int j = 0; j < 4; ++j) { float* p = A->out + (size_t)m * 1024 + j * 256 + lane * 4; f32x4 v = *(f32x4*)p; const f32x4 gv = *(const f32x4*)(g + j * 256 + lane * 4); v = v * s * gv; *(f32x4*)p = v; } }
}

#define SC_BAR() asm volatile("s_waitcnt lgkmcnt(0)\n\ts_barrier" ::: "memory")
constexpr int SC_RED = 0, SC_SI = 16384, SC_VBUF = 81920, SC_GBUF = 90112, SC_BON = 98304, SC_PC = 98816, SC_YP = 99328;
#define FMAC_DPP(acc, op, s1, J) asm("v_fmac_f32_dpp %0, %1, %2 row_newbcast:" #J " row_mask:0xf bank_mask:0xf" : "+v"(acc) : "v"(op), "v"(s1))
#define DOT8(a0, a1, op, JB0, JB1, JB2, JB3, JB4, JB5, JB6, JB7) do { FMAC_DPP(a0, op, S[0], JB0); FMAC_DPP(a1, op, S[1], JB1); FMAC_DPP(a0, op, S[2], JB2); FMAC_DPP(a1, op, S[3], JB3); \
        FMAC_DPP(a0, op, S[4], JB4); FMAC_DPP(a1, op, S[5], JB5); FMAC_DPP(a0, op, S[6], JB6); FMAC_DPP(a1, op, S[7], JB7); } while (0)
#define DOT8_LO(a0, a1, op) DOT8(a0, a1, op, 0, 1, 2, 3, 4, 5, 6, 7)
#define DOT8_HI(a0, a1, op) DOT8(a0, a1, op, 8, 9, 10, 11, 12, 13, 14, 15)
#define AXPY8_LO(op, s) do { FMAC_DPP(S[0], op, s, 0); FMAC_DPP(S[1], op, s, 1); FMAC_DPP(S[2], op, s, 2); FMAC_DPP(S[3], op, s, 3); FMAC_DPP(S[4], op, s, 4); FMAC_DPP(S[5], op, s, 5); FMAC_DPP(S[6], op, s, 6); FMAC_DPP(S[7], op, s, 7); } while (0)
#define AXPY8_HI(op, s) do { FMAC_DPP(S[0], op, s, 8); FMAC_DPP(S[1], op, s, 9); FMAC_DPP(S[2], op, s, 10); FMAC_DPP(S[3], op, s, 11); FMAC_DPP(S[4], op, s, 12); FMAC_DPP(S[5], op, s, 13); FMAC_DPP(S[6], op, s, 14); FMAC_DPP(S[7], op, s, 15); } while (0)
#define PKF(a, b, c) __builtin_elementwise_fma((a), (b), (c))
#define AXPYV(X0, X1, s) do { const f32x2 s_ = (f32x2){(s), (s)}; f32x2 p0_ = (f32x2){S[0], S[1]}, p1_ = (f32x2){S[2], S[3]}, p2_ = (f32x2){S[4], S[5]}, p3_ = (f32x2){S[6], S[7]}; \
        p0_ = PKF(((f32x2){X0[0], X0[1]}), s_, p0_); p1_ = PKF(((f32x2){X0[2], X0[3]}), s_, p1_); p2_ = PKF(((f32x2){X1[0], X1[1]}), s_, p2_); p3_ = PKF(((f32x2){X1[2], X1[3]}), s_, p3_); \
        S[0] = p0_[0]; S[1] = p0_[1]; S[2] = p1_[0]; S[3] = p1_[1]; S[4] = p2_[0]; S[5] = p2_[1]; S[6] = p3_[0]; S[7] = p3_[1]; } while (0)
#define RED8(V) do { const LAS f32x4* rr_ = (const LAS f32x4*)red + par_ * 512 + lane; const f32x4 q0_ = rr_[0], q1_ = rr_[64], q2_ = rr_[128], q3_ = rr_[192], q4_ = rr_[256], q5_ = rr_[320], q6_ = rr_[384], q7_ = rr_[448]; \
        V = ((q0_ + q1_) + (q2_ + q3_)) + ((q4_ + q5_) + (q6_ + q7_)); } while (0)

#define SWAPSUM(v) do { const unsigned u_ = __float_as_uint(v); auto rr_ = __builtin_amdgcn_permlane32_swap(u_, u_, false, false); v = __uint_as_float(rr_[0]) + __uint_as_float(rr_[1]); } while (0)
#define DOT4_LO(a0, a1, op) do { FMAC_DPP(a0, op, S[0], 0); FMAC_DPP(a1, op, S[1], 1); FMAC_DPP(a0, op, S[2], 2); FMAC_DPP(a1, op, S[3], 3); } while (0)
#define DOT4_HI(a0, a1, op) do { FMAC_DPP(a0, op, S[0], 4); FMAC_DPP(a1, op, S[1], 5); FMAC_DPP(a0, op, S[2], 6); FMAC_DPP(a1, op, S[3], 7); } while (0)
#define AXPY4(X, s) do { const f32x2 s_ = (f32x2){(s), (s)}; f32x2 p0_ = (f32x2){S[0], S[1]}, p1_ = (f32x2){S[2], S[3]}; p0_ = PKF(((f32x2){X[0], X[1]}), s_, p0_); p1_ = PKF(((f32x2){X[2], X[3]}), s_, p1_); S[0] = p0_[0]; S[1] = p0_[1]; S[2] = p1_[0]; S[3] = p1_[1]; } while (0)
__device__ __forceinline__ void scan_rwkv(KArgs A, int l, LAS unsigned char* lds, int h, int half, int m0, int L, int BL, int BLS, int chunk0, const float* st_in, float* st_out, int tid) {
    unsigned char* ws = A->ws;
    const int lane = tid & 63, wid = __builtin_amdgcn_readfirstlane(tid >> 6); const int kh = lane >> 5, r = lane & 31, row = 32 * half + r;
    LAS float* red = (LAS float*)(lds + SC_RED); LAS float* yred = (LAS float*)(lds + SC_YP);
    LAS float* sib = (LAS float*)(lds + SC_SI) + wid * 1024;
    LAS bfu* vbuf = (LAS bfu*)(lds + SC_VBUF); LAS float* pcs = (LAS float*)(lds + SC_PC);
    const bfu* v2 = (const bfu*)slotp(ws, l, 12);
    const float* pairc = (const float*)(ws + WS_PAIRC) + ((size_t)h * (MPAD / 2) + (m0 >> 1)) * 4;
    const float* gch = (const float*)(ws + WS_GCH) + ((size_t)h * 1032 + chunk0) * 64 + 8 * wid + 4 * kh;
    bfu* mix = (bfu*)slotp(ws, l, 7);
    const float* P = (const float*)slotp(ws, l, h) + ((size_t)wid * MPAD + m0) * 32;
    float S[4];
#pragma unroll
    for (int j = 0; j < 4; ++j) S[j] = st_in ? st_in[row * 64 + 8 * wid + 4 * kh + j] : 0.f;
    const int nblk = L >> BLS; const int srow = tid >> 4, sc4 = tid & 15; const bool sval = srow < BL;
    const int nsi = BL >> 3;
    f32x4 ssi[4]; v2u sv = {0, 0}; float sp_ = 0.f;
#define RW_STAGE(c) do { const float* ps_ = P + (size_t)(c) * BL * 32 + lane * 4; \
        _Pragma("unroll") for (int i_ = 0; i_ < 4; ++i_) if (i_ < nsi) ssi[i_] = *(const f32x4*)(ps_ + i_ * 256); \
        if (sval) { const size_t mm = (size_t)(m0 + (c) * BL + srow) * 256 + h * 64 + sc4 * 4; sv = *(const v2u*)(v2 + mm); } \
        if (tid < 2 * BL) sp_ = pairc[(size_t)(c) * BL * 2 + tid]; } while (0)
#define RW_COMMIT(c) do { LAS float* pd_ = sib + ((c) & 1) * 8192 + lane * 4; \
        _Pragma("unroll") for (int i_ = 0; i_ < 4; ++i_) if (i_ < nsi) *(LAS f32x4*)(pd_ + i_ * 256) = ssi[i_]; \
        if (sval) { *(LAS v2u*)(vbuf + ((c) & 1) * 2048 + srow * 64 + sc4 * 4) = sv; } \
        if (tid < 2 * BL) pcs[((c) & 1) * 64 + tid] = sp_; } while (0)
    __syncthreads();
    RW_STAGE(0); RW_COMMIT(0); if (nblk > 1) RW_STAGE(1);
    const int dsel = ((lane & 4) ? 24 : 0) + 4 * kh + (lane & 3);
    float ca0, ca1, cb0 = 0.f, cb1 = 0.f; f32x4 cau[4], cbu[4];
#define RW_LOADOPS(D, T) do { const LAS float* pb_ = sib + ((((T) >> BLS) & 1) * 8192) + ((T) & (BL - 1)) * 32; \
        D##0 = pb_[dsel]; D##1 = pb_[32 + dsel]; const LAS f32x4* pu_ = (const LAS f32x4*)(pb_ + 4 * kh); \
        D##u[0] = pu_[2]; D##u[1] = pu_[4]; D##u[2] = pu_[10]; D##u[3] = pu_[12]; } while (0)
    RW_LOADOPS(ca, 0);
#define RW_FINAL(T) do { const int tf_ = (T); \
        const LAS float* yr_ = yred + (tf_ & 15) * 512 + lane; const float y_ = ((yr_[0] + yr_[64]) + (yr_[128] + yr_[192])) + ((yr_[256] + yr_[320]) + (yr_[384] + yr_[448])); \
        if (lane < 32) mix[(size_t)(m0 + tf_) * 1024 + 768 + h * 64 + row] = (bfu)f2bf(y_); } while (0)
#define RW_ROUND(C, N, T) do { const int par_ = ((T) >> 1) & 1; \
        float d1a = 0.f, d1b = 0.f, d2a = 0.f, d2b = 0.f, f1a = 0.f, f1b = 0.f; \
        DOT4_LO(d1a, d1b, C##0); DOT4_LO(d2a, d2b, C##1); DOT4_HI(f1a, f1b, C##0); \
        float d1 = d1a + d1b, d2 = d2a + d2b, f1 = f1a + f1b; SWAPSUM(d1); SWAPSUM(d2); SWAPSUM(f1); \
        ((LAS f32x4*)red)[(par_ * 8 + wid) * 64 + lane] = (f32x4){d1, d2, f1, 0.f}; \
        SC_BAR(); \
        f32x4 tot_; RED8(tot_); \
        const int bo_ = (((T) >> BLS) & 1), to_ = (T) & (BL - 1); \
        const float v1 = bf2f(vbuf[bo_ * 2048 + to_ * 64 + row]), v2_ = bf2f(vbuf[bo_ * 2048 + to_ * 64 + 64 + row]); const f32x4 pc_ = *(const LAS f32x4*)(pcs + bo_ * 64 + to_ * 2); \
        asm volatile("" ::: "memory"); \
        if ((T) + 2 < L) RW_LOADOPS(N, (T) + 2); \
        __builtin_amdgcn_sched_barrier(0); \
        const float sa1 = -tot_[0]; const float sa2 = -(tot_[1] + sa1 * pc_[0] + v1 * pc_[1]); const float y1 = tot_[2] + sa1 * pc_[2] + v1 * pc_[3]; \
        AXPY4(C##u[1], v1); AXPY4(C##u[0], sa1); AXPY4(C##u[3], v2_); AXPY4(C##u[2], sa2); \
        float y2a = 0.f, y2b = 0.f; DOT4_HI(y2a, y2b, C##1); float y2 = y2a + y2b; SWAPSUM(y2); \
        yred[((T) & 15) * 512 + wid * 64 + lane] = y1 * 0.125f; yred[(((T) + 1) & 15) * 512 + wid * 64 + lane] = y2; } while (0)
    for (int c = 0; c < nblk; ++c) {
        for (int tt = 0; tt < BL; tt += 4) {
            const int t = c * BL + tt;
            if (tt == (BL >> 1) && c + 1 < nblk) { RW_COMMIT(c + 1); if (c + 2 < nblk) RW_STAGE(c + 2); }
            RW_ROUND(ca, cb, t);
            RW_ROUND(cb, ca, t + 2);
            if (((t + 3) & 15) == 15) { SC_BAR(); RW_FINAL(t - 12 + 2 * wid); RW_FINAL(t - 11 + 2 * wid); }
        }
        if ((((c + 1) << BLS) & 63) == 0 || c + 1 == nblk) {
            const float* ge = gch + (size_t)((c << BLS) >> 6) * 64;
#pragma unroll
            for (int j = 0; j < 4; ++j) S[j] *= ge[j];
        }
    }
#pragma unroll
    for (int j = 0; j < 4; ++j) st_out[row * 64 + 8 * wid + 4 * kh + j] = S[j];
    __syncthreads();
#undef RW_STAGE
#undef RW_COMMIT
#undef RW_LOADOPS
#undef RW_FINAL
#undef RW_ROUND
}

__device__ __forceinline__ void scan_delta(KArgs A, int l, LAS unsigned char* lds, int h, int half, int m0, int L, int BL, int BLS, const float* st_in, float* st_out, int tid) {
    unsigned char* ws = A->ws;
    const int lane = tid & 63, wid = __builtin_amdgcn_readfirstlane(tid >> 6); const int kh = lane >> 5, r = lane & 31, row = 32 * half + r;
    LAS float* red = (LAS float*)(lds + SC_RED); LAS float* yred = (LAS float*)(lds + SC_YP);
    LAS float* sib = (LAS float*)(lds + SC_SI) + wid * 512;
    LAS bfu* vbuf = (LAS bfu*)(lds + SC_VBUF); LAS float* gab = (LAS float*)(lds + SC_BON); LAS float* pds = (LAS float*)(lds + SC_PC);
    const bfu* va = (const bfu*)slotp(ws, l, 11);
    bfu* mix = (bfu*)slotp(ws, l, 7);
    const float* P = (const float*)slotp(ws, l, 9) + ((size_t)(h * 8 + wid) * MPAD + m0) * 16;
    const float* PG = (const float*)(ws + WS_GAB) + ((size_t)h * MPAD + m0) * 2;
    const float* paird = (const float*)(ws + WS_PAIRD) + ((size_t)h * (MPAD / 2) + (m0 >> 1)) * 2;
    float S[4];
#pragma unroll
    for (int j = 0; j < 4; ++j) S[j] = st_in ? st_in[(8 * wid + 4 * kh + j) * 64 + row] : 0.f;
    const int nblk = L >> BLS; const int srow = tid >> 4, sc4 = tid & 15; const bool sval = srow < BL;
    const int nsi = BL >> 4;
    f32x4 ssi[2]; v2u sv = {0, 0}; float sb_ = 0.f, sp_ = 0.f;
#define DL_STAGE(c) do { const float* ps_ = P + (size_t)(c) * BL * 16 + lane * 4; \
        _Pragma("unroll") for (int i_ = 0; i_ < 2; ++i_) if (i_ < nsi) ssi[i_] = *(const f32x4*)(ps_ + i_ * 256); \
        if (sval) { const size_t mm = (size_t)(m0 + (c) * BL + srow) * 256 + h * 64 + sc4 * 4; sv = *(const v2u*)(va + mm); } \
        if (tid < 2 * BL) sb_ = PG[(size_t)(c) * BL * 2 + tid]; if (tid < BL) sp_ = paird[(size_t)(c) * BL + tid]; } while (0)
#define DL_COMMIT(c) do { LAS float* pd_ = sib + ((c) & 1) * 4096 + lane * 4; \
        _Pragma("unroll") for (int i_ = 0; i_ < 2; ++i_) if (i_ < nsi) *(LAS f32x4*)(pd_ + i_ * 256) = ssi[i_]; \
        if (sval) { *(LAS v2u*)(vbuf + ((c) & 1) * 2048 + srow * 64 + sc4 * 4) = sv; } \
        if (tid < 2 * BL) gab[((c) & 1) * 64 + tid] = sb_; if (tid < BL) pds[((c) & 1) * 32 + tid] = sp_; } while (0)
    __syncthreads();
    DL_STAGE(0); DL_COMMIT(0); if (nblk > 1) DL_STAGE(1);
    const int dsel = ((lane & 4) ? 8 : 0) + 4 * kh + (lane & 3);
    float ca0, ca1, cb0 = 0.f, cb1 = 0.f; f32x4 cau[2], cbu[2];
#define DL_LOADOPS(D, T) do { const LAS float* pb_ = sib + ((((T) >> BLS) & 1) * 4096) + ((T) & (BL - 1)) * 16; D##0 = pb_[dsel]; D##1 = pb_[16 + dsel]; \
        const LAS f32x4* pu_ = (const LAS f32x4*)(pb_ + 4 * kh); D##u[0] = pu_[0]; D##u[1] = pu_[4]; } while (0)
    DL_LOADOPS(ca, 0);
#define DL_FINAL(T) do { const int tf_ = (T); \
        const LAS float* yr_ = yred + (tf_ & 15) * 512 + lane; const float o_ = ((yr_[0] + yr_[64]) + (yr_[128] + yr_[192])) + ((yr_[256] + yr_[320]) + (yr_[384] + yr_[448])); \
        if (lane < 32) mix[(size_t)(m0 + tf_) * 1024 + h * 64 + row] = (bfu)f2bf(o_); } while (0)
#define DL_ROUND(C, N, T) do { const int par_ = ((T) >> 1) & 1; \
        float d1a = 0.f, d1b = 0.f, d2a = 0.f, d2b = 0.f, f1a = 0.f, f1b = 0.f; \
        DOT4_LO(d1a, d1b, C##0); DOT4_LO(d2a, d2b, C##1); DOT4_HI(f1a, f1b, C##0); \
        float d1 = d1a + d1b, d2 = d2a + d2b, f1 = f1a + f1b; SWAPSUM(d1); SWAPSUM(d2); SWAPSUM(f1); \
        ((LAS f32x4*)red)[(par_ * 8 + wid) * 64 + lane] = (f32x4){d1, d2, f1, 0.f}; \
        SC_BAR(); \
        f32x4 tot_; RED8(tot_); \
        const int bo_ = (((T) >> BLS) & 1), to_ = (T) & (BL - 1); \
        const float v1 = bf2f(vbuf[bo_ * 2048 + to_ * 64 + row]), v2_ = bf2f(vbuf[bo_ * 2048 + to_ * 64 + 64 + row]); \
        const f32x4 ab_ = *(const LAS f32x4*)(gab + bo_ * 64 + to_ * 2); const f32x2 pd2_ = *(const LAS f32x2*)(pds + bo_ * 32 + to_); \
        asm volatile("" ::: "memory"); \
        if ((T) + 2 < L) DL_LOADOPS(N, (T) + 2); \
        __builtin_amdgcn_sched_barrier(0); \
        const float a1 = ab_[0], a2 = ab_[2]; const float dl1 = ab_[1] * (v1 - a1 * tot_[0]); const float dl2 = ab_[3] * (v2_ - a2 * (a1 * tot_[1] + pd2_[0] * dl1)); \
        const float o1 = a1 * tot_[2] + pd2_[1] * dl1; const float a12 = a1 * a2, dl1s = a2 * dl1; \
        _Pragma("unroll") for (int j = 0; j < 4; ++j) S[j] *= a12; \
        AXPY4(C##u[0], dl1s); AXPY4(C##u[1], dl2); \
        float y2a = 0.f, y2b = 0.f; DOT4_HI(y2a, y2b, C##1); float y2 = y2a + y2b; SWAPSUM(y2); \
        yred[((T) & 15) * 512 + wid * 64 + lane] = o1 * 0.125f; yred[(((T) + 1) & 15) * 512 + wid * 64 + lane] = y2; } while (0)
    for (int c = 0; c < nblk; ++c) {
        for (int tt = 0; tt < BL; tt += 4) {
            const int t = c * BL + tt;
            if (tt == (BL >> 1) && c + 1 < nblk) { DL_COMMIT(c + 1); if (c + 2 < nblk) DL_STAGE(c + 2); }
            DL_ROUND(ca, cb, t);
            DL_ROUND(cb, ca, t + 2);
            if (((t + 3) & 15) == 15) { SC_BAR(); DL_FINAL(t - 12 + 2 * wid); DL_FINAL(t - 11 + 2 * wid); }
        }
    }
#pragma unroll
    for (int j = 0; j < 4; ++j) st_out[(8 * wid + 4 * kh + j) * 64 + row] = S[j];
    __syncthreads();
#undef DL_STAGE
#undef DL_COMMIT
#undef DL_LOADOPS
#undef DL_FINAL
#undef DL_ROUND
}

__device__ __forceinline__ void sample_attn(KArgs A, int l, LAS unsigned char* lds, int unit, int tid) {
    unsigned char* ws = A->ws;
    const int sb = unit >> 2, h = unit & 3;
    LAS float* qs = (LAS float*)lds;
    LAS float* sc = qs + 2048;
    LAS float* scl = sc + 1024;
    LAS float* ssq = scl + 32;
    LAS float* lsum = ssq + 512;
    const bfu* qb = (const bfu*)slotp(ws, l, 4); bfu* mix = (bfu*)slotp(ws, l, 7);
    const float* ck = A->in[2] + (size_t)(l * 8 + sb) * 2048 * 512 + h * 128; const float* cv = A->in[3] + (size_t)(l * 8 + sb) * 2048 * 512 + h * 128;
    const float* nk = A->out + O_BKS + (size_t)(l * 8 + sb) * 16 * 512 + h * 128; const float* nv = A->out + O_BVS + (size_t)(l * 8 + sb) * 16 * 512 + h * 128;
    const float* lf = (const float*)(ws + WS_CTL + 1024); const float lam = lf[2 * l], omli = 1.f - lf[2 * l + 1];
    __syncthreads();
    for (int i = tid; i < 2048; i += NTHR) { const int map = i >> 10, qi = (i >> 6) & 15, p = i & 63; const int s = p >> 5, n_ = (p >> 4) & 1, r = p & 15;
        qs[(map * 16 + qi) * 64 + n_ * 32 + s * 16 + r] = bf2f(qb[(size_t)(MP + sb * 16 + qi) * 512 + h * 128 + map * 64 + p]); }
    float mrun = -1e30f, lrun = 0.f;
    const int qi = tid & 15, kj = tid >> 4, eg = tid >> 4;
    f32x4 acc0 = {0.f, 0.f, 0.f, 0.f}, acc1 = {0.f, 0.f, 0.f, 0.f};
    __syncthreads();
    for (int tile = 0; tile < 65; ++tile) {
        const int kidx = tile * 32 + kj;
        float s1 = -1e30f, s2 = -1e30f;
        if (kidx < 2064) { const float* kr = kidx < 2048 ? ck + (size_t)kidx * 512 : nk + (size_t)(kidx - 2048) * 512; s1 = 0.f; s2 = 0.f;
#pragma unroll 4
            for (int d = 0; d < 64; d += 4) { const f32x4 k1 = *(const f32x4*)(kr + d), k2 = *(const f32x4*)(kr + 64 + d); const LAS float* q1 = qs + qi * 64 + d; const LAS float* q2 = qs + (16 + qi) * 64 + d;
                s1 += q1[0] * k1[0] + q1[1] * k1[1] + q1[2] * k1[2] + q1[3] * k1[3]; s2 += q2[0] * k2[0] + q2[1] * k2[1] + q2[2] * k2[2] + q2[3] * k2[3]; } }
        sc[qi * 32 + kj] = s1; sc[(16 + qi) * 32 + kj] = s2;
        __syncthreads();
        if (tid < 32) { LAS float* r = sc + tid * 32; float mx = mrun;
#pragma unroll 8
            for (int j = 0; j < 32; ++j) mx = fmaxf(mx, r[j]);
            const float f = exp2f(mrun - mx); float su = 0.f;
#pragma unroll 8
            for (int j = 0; j < 32; ++j) { const float p = exp2f(r[j] - mx); r[j] = p; su += p; }
            lrun = lrun * f + su; mrun = mx; scl[tid] = f; }
        __syncthreads();
        { const float f0 = scl[qi], f1 = scl[16 + qi]; acc0 = acc0 * f0; acc1 = acc1 * f1;
            const int nk_ = tile < 64 ? 32 : 16;
            for (int j = 0; j < nk_; ++j) { const int kx = tile * 32 + j; const float* vr = (kx < 2048 ? cv + (size_t)kx * 512 : nv + (size_t)(kx - 2048) * 512) + eg * 4;
                const f32x4 v = *(const f32x4*)vr; acc0 = acc0 + v * sc[qi * 32 + j]; acc1 = acc1 + v * sc[(16 + qi) * 32 + j]; } }
        __syncthreads();
    }
    if (tid < 32) lsum[tid] = lrun;
    __syncthreads();
    const f32x4 o = acc0 * (1.f / lsum[qi]) - acc1 * (lam / lsum[16 + qi]);
    ssq[qi * 32 + eg] = (o[0] * o[0] + o[1] * o[1]) + (o[2] * o[2] + o[3] * o[3]);
    __syncthreads();
    float ss = 0.f;
#pragma unroll 8
    for (int j = 0; j < 32; ++j) ss += ssq[qi * 32 + j];
    const float rn = rsqrtf(ss * (1.f / 128.f) + 1e-6f) * omli; const float* bn = A->in[20] + l * 128 + eg * 4;
    v2u w; w.x = pk2(o[0] * rn * bn[0], o[1] * rn * bn[1]); w.y = pk2(o[2] * rn * bn[2], o[3] * rn * bn[3]);
    *(v2u*)(mix + (size_t)(MP + sb * 16 + qi) * 1024 + 256 + h * 128 + eg * 4) = w;
    __syncthreads();
}

#define PH_BEGIN \
        KArgs A = (KArgs)__builtin_amdgcn_kernarg_segment_ptr(); \
        int tid = wv * 64 + (int)__builtin_amdgcn_mbcnt_hi(~0u, __builtin_amdgcn_mbcnt_lo(~0u, 0u)); asm volatile("" : "+v"(tid)); tid &= 511; \
        const int bid = blockIdx.x, G = gridDim.x; \
        const int lane = tid & 63, wave = wv; \
        const int gw = bid * NWAVES + wave, NGW = G * NWAVES, gtid = bid * NTHR + tid, NT = G * NTHR; \
        unsigned char* ws = A->ws; float* rsb = (float*)(ws + WS_RS); unsigned char* wb = ws + WS_W; \
        (void)lane; (void)gw; (void)NGW; (void)gtid; (void)NT; (void)rsb; (void)wb;
#define IN(k) (lo <= (k) && (k) < hi)
__device__ __forceinline__ void grid_bar(unsigned* bar, unsigned target, bool leader) {
    asm volatile("s_waitcnt vmcnt(0) lgkmcnt(0)" ::: "memory");
    __syncthreads();
    if (leader) {
        __builtin_amdgcn_fence(__ATOMIC_RELEASE, "agent");
        asm volatile("s_waitcnt vmcnt(0)" ::: "memory");
        __hip_atomic_fetch_add(bar, 1u, __ATOMIC_RELAXED, __HIP_MEMORY_SCOPE_AGENT);
        unsigned spins = 0;
        while (__hip_atomic_load(bar, __ATOMIC_RELAXED, __HIP_MEMORY_SCOPE_AGENT) < target) { __builtin_amdgcn_s_sleep(2); if (++spins > (1u << 27)) break; }
        __builtin_amdgcn_fence(__ATOMIC_ACQUIRE, "agent");
        asm volatile("s_waitcnt vmcnt(0)" ::: "memory");
    }
    __syncthreads();
}
#define SEAM(k) do { if ((k) + 1 < hi) { ++nbar; grid_bar((unsigned*)(ws + WS_CTL + 4096), nbar * (unsigned)G, tid == 0); } } while (0)
#define SEAM_SKIP(k) do { } while (0)
__global__ void __launch_bounds__(NTHR, 2) hybrid_fwd(Args Aval) {
    extern __shared__ __attribute__((aligned(16))) unsigned char lds_raw[];
    LAS unsigned char* lds = (LAS unsigned char*)lds_raw;
    const int lo = Aval.ph_lo, hi = Aval.ph_hi; unsigned nbar = 0u;
    if (Aval.ph_lo < 0) cg::this_grid().sync();
    const int wv = __builtin_amdgcn_readfirstlane(threadIdx.x >> 6);
    if (IN(0)) { PH_BEGIN prologue(A, lds, gw, NGW, lane, wave, gtid, NT); SEAM(0); }
    { constexpr int l = 0;

        const int p0 = 1 + 11 * l;
        if (IN(p0 + 0)) { PH_BEGIN
            pg8::Gemm g{(const pg8::bf16_t*)slotp(ws, l, 0), (const pg8::bf16_t*)(wb + W_IN), MPAD, NIN, 1024};
            pg8::StaticOrder S; S.init(MPAD, NIN, G, bid);
            EpiG1 E{rsb + (size_t)(3 * l) * MPAD, (bfu*)slotp(ws, l, 2), (bfu*)slotp(ws, l, 4), (bfu*)slotp(ws, l, 5), (bfu*)slotp(ws, l, 6), (bfu*)slotp(ws, l, 7), (float*)(ws + WS_AB), (const float*)(ws + WS_ROPE),
                    A->out + O_BKP + (size_t)l * MP * 512, A->out + O_BVP + (size_t)l * MP * 512, A->out + O_BKS + (size_t)l * MS * 512, A->out + O_BVS + (size_t)l * MS * 512};
            pg8::gemm_phase<EpiG1, pg8::StaticOrder, true, true>((PG8_LAS unsigned char*)lds, g, S, E, wv);
            SEAM(p0 + 0); }
        if (IN(p0 + 1)) { PH_BEGIN
            prep_a(A, l, gw, NGW, lane); prep_c1(A, l, gw, NGW, lane);
            if (l == 1) conv_weights(A, 1, 2, lds, gw, NGW, lane, wave);
            SEAM(p0 + 1); }
        if (IN(p0 + 2)) { PH_BEGIN
            pg8::Gemm g{(const pg8::bf16_t*)slotp(ws, l, 12), (const pg8::bf16_t*)(wb + W_LR), MPAD, 768, 256};
            pg8::StaticOrder S; S.init(MPAD, 768, G, bid);
            EpiB<0> E{(bfu*)slotp(ws, l, 13), 768, nullptr};
            pg8::gemm_phase<EpiB<0>, pg8::StaticOrder, true, true>((PG8_LAS unsigned char*)lds, g, S, E, wv);
            SEAM(p0 + 2); }
        if (IN(p0 + 3)) { PH_BEGIN prep_c2(A, l, bid, G, tid); prep_a2(A, l, gw, NGW, lane);
            SEAM(p0 + 3); }
        if (IN(p0 + 4)) { PH_BEGIN
            if (bid < 64) { const int st = bid >> 1, half = bid & 1, b = st >> 2, h = st & 3;
                scan_rwkv(A, l, lds, h, half, b * 8192, 8192, 32, 5, b * 128, nullptr, A->out + O_CWP + (size_t)((l * 8 + b) * 4 + h) * 4096, tid);
                scan_rwkv(A, l, lds, h, half, MP + b * 16, 16, 16, 4, 1024 + b, A->in[7] + (size_t)((l * 8 + b) * 4 + h) * 4096, A->out + O_CWS + (size_t)((l * 8 + b) * 4 + h) * 4096, tid);
            } else if (bid < 128) { const int st = (bid - 64) >> 1, half = bid & 1, b = st >> 2, h = st & 3;
                scan_delta(A, l, lds, h, half, b * 8192, 8192, 32, 5, nullptr, A->out + O_ADP + (size_t)((l * 8 + b) * 4 + h) * 4096, tid);
                scan_delta(A, l, lds, h, half, MP + b * 16, 16, 16, 4, A->in[5] + (size_t)((l * 8 + b) * 4 + h) * 4096, A->out + O_ADS + (size_t)((l * 8 + b) * 4 + h) * 4096, tid);
            } else if (bid < 160) { sample_attn(A, l, lds, bid - 128, tid); }
            __syncthreads();
            unsigned* ctr = (unsigned*)(ws + WS_CTL) + 16 * l; volatile LAS unsigned* qw = (volatile LAS unsigned*)(lds + MISC_OFF);
            const attn_body::bf16* Q = (const attn_body::bf16*)slotp(ws, l, 4); const attn_body::bf16* K = (const attn_body::bf16*)slotp(ws, l, 5); const attn_body::bf16* V = (const attn_body::bf16*)slotp(ws, l, 6);
            attn_body::bf16* O = (attn_body::bf16*)slotp(ws, l, 13);
            for (;;) {
                if (tid == 0) qw[0] = atomicAdd(ctr, 1u);
                __syncthreads();
                const unsigned u = qw[0];
                __syncthreads();
                if (u >= 4096u) break;
                const int qb = 31 - (int)(u >> 7), bh = (int)(u & 127);
                attn_body::attn_unit<8>(bh >> 4, bh & 15, qb, Q, K, V, O, (char*)lds_raw, wv);
            }
            SEAM(p0 + 4); }
        if (IN(p0 + 5)) { PH_BEGIN
            post_attn(A, l, gw, NGW, lane); post_scan(A, l, gw, NGW, lane);
            conv_p(A, l, (bfu*)slotp(ws, l, 10), gtid, NT);
            if (l == 0) conv_weights(A, 1, 1, lds, gw, NGW, lane, wave);
            SEAM(p0 + 5); }
        if (IN(p0 + 6)) { PH_BEGIN
            pg8::Gemm g{(const pg8::bf16_t*)slotp(ws, l, 7), (const pg8::bf16_t*)(wb + W_OUT), MPAD, 1024, 1024};
            pg8::StaticOrder S; S.init(MPAD, 1024, G, bid);
            EpiH<2> E{A->out, (bfu*)slotp(ws, l, 0), rsb + (size_t)(3 * l + 1) * MPAD, nullptr, nullptr};
            pg8::gemm_phase<EpiH<2>, pg8::StaticOrder, true, true>((PG8_LAS unsigned char*)lds, g, S, E, wv);
            SEAM(p0 + 6); }
        if (IN(p0 + 7)) { PH_BEGIN
            pg8::Gemm g{(const pg8::bf16_t*)slotp(ws, l, 0), (const pg8::bf16_t*)(wb + W_FF1), MPAD, FFD, 1024};
            pg8::StaticOrder S; S.init(MPAD, FFD, G, bid);
            EpiB<1> E{(bfu*)slotp(ws, l, 2), FFD, rsb + (size_t)(3 * l + 1) * MPAD};
            pg8::gemm_phase<EpiB<1>, pg8::StaticOrder, true, true>((PG8_LAS unsigned char*)lds, g, S, E, wv);
            {
                pg8::Gemm g2{(const pg8::bf16_t*)slotp(ws, l, 10), (const pg8::bf16_t*)(wb + W_PP), MPAD, 1024, 256};
                pg8::StaticOrder S2; S2.init(MPAD, 1024, G, bid);
                EpiB<0> E2{(bfu*)slotp(ws, l, 11), 1024, nullptr};
                pg8::gemm_phase<EpiB<0>, pg8::StaticOrder, true, true>((PG8_LAS unsigned char*)lds, g2, S2, E2, wv); }
            SEAM(p0 + 7); }
        if (IN(p0 + 8)) { PH_BEGIN
            pg8::Gemm g{(const pg8::bf16_t*)slotp(ws, l, 2), (const pg8::bf16_t*)(wb + W_FF2), MPAD, 1024, FFD};
            pg8::StaticOrder S; S.init(MPAD, 1024, G, bid);
            EpiH<2> E{A->out, (bfu*)slotp(ws, l, 0), rsb + (size_t)(3 * l + 2) * MPAD, nullptr, nullptr};
            pg8::gemm_phase<EpiH<2>, pg8::StaticOrder, true, true>((PG8_LAS unsigned char*)lds, g, S, E, wv);
            SEAM(p0 + 8); }
        if (IN(p0 + 9)) { PH_BEGIN SEAM_SKIP(p0 + 9); }
        if (IN(p0 + 10)) { PH_BEGIN
            pg8::Gemm g{(const pg8::bf16_t*)slotp(ws, l, 0), (const pg8::bf16_t*)(wb + W_GATE), MPAD, 1024, 1024};
            pg8::StaticOrder S; S.init(MPAD, 1024, G, bid);
            EpiH<3> E{A->out, (bfu*)slotp(ws, l, 13), rsb + (size_t)(3 * l + 3) * MPAD, rsb + (size_t)(3 * l + 2) * MPAD, (const bfu*)slotp(ws, l, 11)};
            pg8::gemm_phase<EpiH<3>, pg8::StaticOrder, true, true>((PG8_LAS unsigned char*)lds, g, S, E, wv);
            SEAM(p0 + 10); }
        }
    { constexpr int l = 1;

        const int p0 = 1 + 11 * l;
        if (IN(p0 + 0)) { PH_BEGIN
            pg8::Gemm g{(const pg8::bf16_t*)slotp(ws, l, 0), (const pg8::bf16_t*)(wb + W_IN), MPAD, NIN, 1024};
            pg8::StaticOrder S; S.init(MPAD, NIN, G, bid);
            EpiG1 E{rsb + (size_t)(3 * l) * MPAD, (bfu*)slotp(ws, l, 2), (bfu*)slotp(ws, l, 4), (bfu*)slotp(ws, l, 5), (bfu*)slotp(ws, l, 6), (bfu*)slotp(ws, l, 7), (float*)(ws + WS_AB), (const float*)(ws + WS_ROPE),
                    A->out + O_BKP + (size_t)l * MP * 512, A->out + O_BVP + (size_t)l * MP * 512, A->out + O_BKS + (size_t)l * MS * 512, A->out + O_BVS + (size_t)l * MS * 512};
            pg8::gemm_phase<EpiG1, pg8::StaticOrder, true, true>((PG8_LAS unsigned char*)lds, g, S, E, wv);
            SEAM(p0 + 0); }
        if (IN(p0 + 1)) { PH_BEGIN
            prep_a(A, l, gw, NGW, lane); prep_c1(A, l, gw, NGW, lane);
            if (l == 1) conv_weights(A, 1, 2, lds, gw, NGW, lane, wave);
            SEAM(p0 + 1); }
        if (IN(p0 + 2)) { PH_BEGIN
            pg8::Gemm g{(const pg8::bf16_t*)slotp(ws, l, 12), (const pg8::bf16_t*)(wb + W_LR), MPAD, 768, 256};
            pg8::StaticOrder S; S.init(MPAD, 768, G, bid);
            EpiB<0> E{(bfu*)slotp(ws, l, 13), 768, nullptr};
            pg8::gemm_phase<EpiB<0>, pg8::StaticOrder, true, true>((PG8_LAS unsigned char*)lds, g, S, E, wv);
            SEAM(p0 + 2); }
        if (IN(p0 + 3)) { PH_BEGIN prep_c2(A, l, bid, G, tid); prep_a2(A, l, gw, NGW, lane);
            SEAM(p0 + 3); }
        if (IN(p0 + 4)) { PH_BEGIN
            if (bid < 64) { const int st = bid >> 1, half = bid & 1, b = st >> 2, h = st & 3;
                scan_rwkv(A, l, lds, h, half, b * 8192, 8192, 32, 5, b * 128, nullptr, A->out + O_CWP + (size_t)((l * 8 + b) * 4 + h) * 4096, tid);
                scan_rwkv(A, l, lds, h, half, MP + b * 16, 16, 16, 4, 1024 + b, A->in[7] + (size_t)((l * 8 + b) * 4 + h) * 4096, A->out + O_CWS + (size_t)((l * 8 + b) * 4 + h) * 4096, tid);
            } else if (bid < 128) { const int st = (bid - 64) >> 1, half = bid & 1, b = st >> 2, h = st & 3;
                scan_delta(A, l, lds, h, half, b * 8192, 8192, 32, 5, nullptr, A->out + O_ADP + (size_t)((l * 8 + b) * 4 + h) * 4096, tid);
                scan_delta(A, l, lds, h, half, MP + b * 16, 16, 16, 4, A->in[5] + (size_t)((l * 8 + b) * 4 + h) * 4096, A->out + O_ADS + (size_t)((l * 8 + b) * 4 + h) * 4096, tid);
            } else if (bid < 160) { sample_attn(A, l, lds, bid - 128, tid); }
            __syncthreads();
            unsigned* ctr = (unsigned*)(ws + WS_CTL) + 16 * l; volatile LAS unsigned* qw = (volatile LAS unsigned*)(lds + MISC_OFF);
            const attn_body::bf16* Q = (const attn_body::bf16*)slotp(ws, l, 4); const attn_body::bf16* K = (const attn_body::bf16*)slotp(ws, l, 5); const attn_body::bf16* V = (const attn_body::bf16*)slotp(ws, l, 6);
            attn_body::bf16* O = (attn_body::bf16*)slotp(ws, l, 13);
            for (;;) {
                if (tid == 0) qw[0] = atomicAdd(ctr, 1u);
                __syncthreads();
                const unsigned u = qw[0];
                __syncthreads();
                if (u >= 4096u) break;
                const int qb = 31 - (int)(u >> 7), bh = (int)(u & 127);
                attn_body::attn_unit<8>(bh >> 4, bh & 15, qb, Q, K, V, O, (char*)lds_raw, wv);
            }
            SEAM(p0 + 4); }
        if (IN(p0 + 5)) { PH_BEGIN
            post_attn(A, l, gw, NGW, lane); post_scan(A, l, gw, NGW, lane);
            conv_p(A, l, (bfu*)slotp(ws, l, 10), gtid, NT);
            if (l == 0) conv_weights(A, 1, 1, lds, gw, NGW, lane, wave);
            SEAM(p0 + 5); }
        if (IN(p0 + 6)) { PH_BEGIN
            pg8::Gemm g{(const pg8::bf16_t*)slotp(ws, l, 7), (const pg8::bf16_t*)(wb + W_OUT), MPAD, 1024, 1024};
            pg8::StaticOrder S; S.init(MPAD, 1024, G, bid);
            EpiH<2> E{A->out, (bfu*)slotp(ws, l, 0), rsb + (size_t)(3 * l + 1) * MPAD, nullptr, nullptr};
            pg8::gemm_phase<EpiH<2>, pg8::StaticOrder, true, true>((PG8_LAS unsigned char*)lds, g, S, E, wv);
            SEAM(p0 + 6); }
        if (IN(p0 + 7)) { PH_BEGIN
            pg8::Gemm g{(const pg8::bf16_t*)slotp(ws, l, 0), (const pg8::bf16_t*)(wb + W_FF1), MPAD, FFD, 1024};
            pg8::StaticOrder S; S.init(MPAD, FFD, G, bid);
            EpiB<1> E{(bfu*)slotp(ws, l, 2), FFD, rsb + (size_t)(3 * l + 1) * MPAD};
            pg8::gemm_phase<EpiB<1>, pg8::StaticOrder, true, true>((PG8_LAS unsigned char*)lds, g, S, E, wv);
            {
                pg8::Gemm g2{(const pg8::bf16_t*)slotp(ws, l, 10), (const pg8::bf16_t*)(wb + W_PP), MPAD, 1024, 256};
                pg8::StaticOrder S2; S2.init(MPAD, 1024, G, bid);
                EpiB<0> E2{(bfu*)slotp(ws, l, 11), 1024, nullptr};
                pg8::gemm_phase<EpiB<0>, pg8::StaticOrder, true, true>((PG8_LAS unsigned char*)lds, g2, S2, E2, wv); }
            SEAM(p0 + 7); }
        if (IN(p0 + 8)) { PH_BEGIN
            pg8::Gemm g{(const pg8::bf16_t*)slotp(ws, l, 2), (const pg8::bf16_t*)(wb + W_FF2), MPAD, 1024, FFD};
            pg8::StaticOrder S; S.init(MPAD, 1024, G, bid);
            EpiH<2> E{A->out, (bfu*)slotp(ws, l, 0), rsb + (size_t)(3 * l + 2) * MPAD, nullptr, nullptr};
            pg8::gemm_phase<EpiH<2>, pg8::StaticOrder, true, true>((PG8_LAS unsigned char*)lds, g, S, E, wv);
            SEAM(p0 + 8); }
        if (IN(p0 + 9)) { PH_BEGIN SEAM_SKIP(p0 + 9); }
        if (IN(p0 + 10)) { PH_BEGIN
            pg8::Gemm g{(const pg8::bf16_t*)slotp(ws, l, 0), (const pg8::bf16_t*)(wb + W_GATE), MPAD, 1024, 1024};
            pg8::StaticOrder S; S.init(MPAD, 1024, G, bid);
            EpiH<3> E{A->out, (bfu*)slotp(ws, l, 13), rsb + (size_t)(3 * l + 3) * MPAD, rsb + (size_t)(3 * l + 2) * MPAD, (const bfu*)slotp(ws, l, 11)};
            pg8::gemm_phase<EpiH<3>, pg8::StaticOrder, true, true>((PG8_LAS unsigned char*)lds, g, S, E, wv);
            SEAM(p0 + 10); }
        }
    if (IN(NPHASE - 1)) { PH_BEGIN final_norm(A, gw, NGW, lane); }
}
#undef PH_BEGIN
#undef IN
#undef SEAM

extern "C" void kernel_launch(void* const* d_in, const int* in_sizes, int n_in, void* d_out, int out_size, void* d_ws, size_t ws_size, hipStream_t stream) {
    static int grid = 0;
    if (grid == 0) {
        if (n_in != 40 || (size_t)out_size != O_END || ws_size < WS_TOTAL) { fprintf(stderr, "kernel_launch: unexpected shapes (n_in %d out %d ws %zu)\n", n_in, out_size, ws_size); grid = -1; return; }
        int dev = 0, cus = 0, per_cu = 0;
        if (hipGetDevice(&dev) != hipSuccess || hipDeviceGetAttribute(&cus, hipDeviceAttributeMultiprocessorCount, dev) != hipSuccess) { grid = -1; return; }
        if (hipFuncSetAttribute((const void*)hybrid_fwd, hipFuncAttributeMaxDynamicSharedMemorySize, LDS_BYTES) != hipSuccess) { fprintf(stderr, "kernel_launch: hipFuncSetAttribute failed\n"); grid = -1; return; }
        if (hipOccupancyMaxActiveBlocksPerMultiprocessor(&per_cu, (const void*)hybrid_fwd, NTHR, LDS_BYTES) != hipSuccess || per_cu < 1) { fprintf(stderr, "kernel_launch: occupancy query says %d\n", per_cu); per_cu = 1; }
        (void)hipGetLastError();
        grid = cus;
    }
    if (grid < 0) return;
    if (hipMemsetAsync((char*)d_ws + WS_CTL, 0, 64 * 1024, stream) != hipSuccess) { fprintf(stderr, "kernel_launch: memset failed\n"); return; }
    Args a{};
    for (int i = 0; i < 40; ++i) a.in[i] = (const float*)d_in[i];
    a.out = (float*)d_out; a.ws = (unsigned char*)d_ws;
#if MK_ONE_LAUNCH
    a.ph_lo = 0; a.ph_hi = NPHASE;
    void* args[] = {&a};
    hipError_t e = hipLaunchCooperativeKernel((const void*)hybrid_fwd, dim3(grid), dim3(NTHR), args, LDS_BYTES, stream);
    if (e != hipSuccess) fprintf(stderr, "kernel_launch: cooperative launch failed: %s (grid %d)\n", hipGetErrorString(e), grid);
#else
    for (int ph = 0; ph < NPHASE; ++ph) { a.ph_lo = ph; a.ph_hi = ph + 1; hipLaunchKernelGGL(hybrid_fwd, dim3(grid), dim3(NTHR), LDS_BYTES, stream, a); }
#endif
}
```

```cpp
#include <hip/hip_runtime.h>
#include <hip/hip_cooperative_groups.h>
#include <cstdio>
#include <cstdint>
namespace cg = cooperative_groups;
namespace pg8 {
#define PG8_LAS __attribute__((address_space(3)))
typedef unsigned short bf16_t;
typedef short bf16x8 __attribute__((ext_vector_type(8)));
typedef float f32x4 __attribute__((ext_vector_type(4)));
typedef unsigned u32x4 __attribute__((ext_vector_type(4)));
constexpr int BM = 256, BK = 64, HALF = 128, HTB = HALF * BK * 2  , STAGE_BYTES = 8 * HTB, NXCD = 8, WGM = 8;

__host__ __device__ __forceinline__ int lds_byte(int r, int c) { const int st = (r >> 4) * 2 + (c >> 5), rr = r & 15, cc = c & 31, ob = rr * 64 + cc * 2; return st * 1024 + (ob ^ (((ob >> 9) & 1) << 5)); }
__host__ __device__ __forceinline__ void stage_rc(int b, int& R, int& C) { const int st = b / 1024, sb = b % 1024, swz = sb ^ (((sb >> 9) & 1) << 5); R = (st >> 1) * 16 + swz / 64; C = (st & 1) * 32 + (swz % 64) / 2; }
__host__ __device__ __forceinline__ int perm32(int rho) { const int n = rho >> 4, i = rho & 15; return 8 * (i >> 2) + 4 * n + (i & 3); }

struct Unit { int pm, pn; };
struct Gemm { const bf16_t* A; const bf16_t* Bt; int M, N, K; };

struct StaticOrder {
    int nM, nN, nwg, G, c;
    __host__ __device__ void init(int M, int N, int G_, int c_) { nM = M / BM; nN = N / BM; nwg = nM * nN; G = G_; c = c_; }
    __host__ __device__ bool next(int i, Unit& u) const {
        const long L = (long)i * G + c; if (L >= nwg) return false;
        int wgid = (int)L; { const int q = nwg / NXCD, r = nwg % NXCD, xcd = wgid % NXCD, off = wgid / NXCD; wgid = (xcd < r ? xcd * (q + 1) : r * (q + 1) + (xcd - r) * q) + off; }
        const int nig = WGM * nN, gid = wgid / nig, fm = gid * WGM, gsz = (nM - fm) < WGM ? (nM - fm) : WGM;
        u.pm = fm + ((wgid % nig) % gsz); u.pn = (wgid % nig) / gsz; return true;
    }
    __device__ __forceinline__ void a_ready(const Unit&) const {}
    __device__ __forceinline__ void done(const Unit&) const {}
};

__device__ __forceinline__ unsigned cvt_pk_bf16(float lo, float hi) { unsigned r; asm volatile("v_cvt_pk_bf16_f32 %0, %1, %2" : "=v"(r) : "v"(lo), "v"(hi)); return r; }
typedef float f32x2 __attribute__((ext_vector_type(2)));
__device__ __forceinline__ f32x2 gelu_pk(f32x2 v) {
    const f32x2 av = __builtin_elementwise_abs(v), d = av * 0.2316418882f + 1.0f;
    f32x2 t; t.x = __builtin_amdgcn_rcpf(d.x); t.y = __builtin_amdgcn_rcpf(d.y);
    f32x2 q = t * 0.5307027145f + (-0.7265760135f); q = q * t + 0.7107068705f; q = q * t + (-0.142248368f); q = q * t + 0.127414796f; q = q * t;
    const f32x2 s = (v * v) * (-0.72134752044f);
    f32x2 e; e.x = __builtin_amdgcn_exp2f(s.x); e.y = __builtin_amdgcn_exp2f(s.y);
    const f32x2 m = v * (q * e), r = v - m;
    f32x2 o; o.x = v.x < 0.f ? m.x : r.x; o.y = v.y < 0.f ? m.y : r.y; return o;
}

template <int ACT  > struct EpiBf16 {
    static constexpr bool PERM = true, AFTER_DRAIN = false; static_assert(ACT == 0 || ACT == 1, "EpiBf16: ACT is 0 (none) or 1 (gelu_pk)");
    bf16_t* O; int ldc; const float* bias; int split_cols; size_t split_stride; float scale0;
    __device__ __forceinline__ void operator()(const f32x4 (&acc)[2][2][4][2], const Unit& u, int wr, int wc, int fr, int fq) const {
        const int row0 = u.pm * BM + wr * 64 + fr; int colt = u.pn * BM; bf16_t* base = O;
        float sc = 1.f; if (split_cols) { const int t = colt / split_cols; base += (size_t)t * split_stride; colt -= t * split_cols; if (t == 0) sc = scale0; }
        const int col0 = colt + wc * 32 + 8 * fq, bcol0 = u.pn * BM + wc * 32 + 8 * fq;
        f32x4 bv[2][2];
#pragma unroll
        for (int bj = 0; bj < 2; ++bj)
#pragma unroll
            for (int n = 0; n < 2; ++n) bv[bj][n] = bias ? *(const f32x4*)(bias + bcol0 + bj * HALF + 4 * n) : (f32x4){0.f, 0.f, 0.f, 0.f};
#pragma unroll
        for (int ai = 0; ai < 2; ++ai)
#pragma unroll
            for (int m = 0; m < 4; ++m) { bf16_t* rowp = base + (size_t)(row0 + ai * HALF + m * 16) * ldc + col0;
#pragma unroll
                for (int bj = 0; bj < 2; ++bj) { f32x4 v0 = acc[ai][bj][m][0] + bv[bj][0], v1 = acc[ai][bj][m][1] + bv[bj][1];
                    if (ACT == 1) { f32x2 a = gelu_pk((f32x2){v0[0], v0[1]}), b = gelu_pk((f32x2){v0[2], v0[3]}), c = gelu_pk((f32x2){v1[0], v1[1]}), d = gelu_pk((f32x2){v1[2], v1[3]});
                        v0 = (f32x4){a.x, a.y, b.x, b.y}; v1 = (f32x4){c.x, c.y, d.x, d.y}; }
                    v0 = v0 * sc; v1 = v1 * sc; u32x4 w; w.x = cvt_pk_bf16(v0[0], v0[1]); w.y = cvt_pk_bf16(v0[2], v0[3]); w.z = cvt_pk_bf16(v1[0], v1[1]); w.w = cvt_pk_bf16(v1[2], v1[3]);
                    *(u32x4*)(rowp + bj * HALF) = w; } }
    }
};

struct PanelStats {
    unsigned* xbuf;
    unsigned* cnt;
    unsigned* tmo;
    int ntn; float eps;
    unsigned code;
    __device__ __forceinline__ bool run(const f32x4 (&v)[2][2][4][2], const Unit& u, int wr, int wc, int fr, int fq, PG8_LAS unsigned char* lds, int wid, int lane) const {
        typedef float f32x2v __attribute__((ext_vector_type(2)));
        PG8_LAS f32x2v* P = (PG8_LAS f32x2v*)lds;
        PG8_LAS f32x2v* S = (PG8_LAS f32x2v*)(lds + 8192);
        PG8_LAS unsigned* flag = (PG8_LAS unsigned*)(lds + 8192 + 2048);
#pragma unroll
        for (int ai = 0; ai < 2; ++ai)
#pragma unroll
            for (int m = 0; m < 4; ++m) {
                float s = 0.f;
#pragma unroll
                for (int bj = 0; bj < 2; ++bj)
#pragma unroll
                    for (int n = 0; n < 2; ++n) { const f32x4 x = v[ai][bj][m][n]; s += (x[0] + x[1]) + (x[2] + x[3]); }
                s += __shfl_xor(s, 16); s += __shfl_xor(s, 32);
                const float mw = s * (1.0f / 64.0f); float q = 0.f;
#pragma unroll
                for (int bj = 0; bj < 2; ++bj)
#pragma unroll
                    for (int n = 0; n < 2; ++n) { const f32x4 d = v[ai][bj][m][n] - mw; q += (d[0] * d[0] + d[1] * d[1]) + (d[2] * d[2] + d[3] * d[3]); }
                q += __shfl_xor(q, 16); q += __shfl_xor(q, 32);
                if (fq == 0) P[(ai * HALF + wr * 64 + m * 16 + fr) * 4 + wc] = (f32x2v){mw, q};
            }
        asm volatile("s_waitcnt lgkmcnt(0)" ::: "memory"); __builtin_amdgcn_s_barrier(); asm volatile("" ::: "memory");
#if defined(BROKEN_EXCHANGE_NO_WAIT)
#warning BROKEN CONTROL BUILD: the row-statistics exchange does not wait; results are wrong by design
        if (blockIdx.x >= 64) { const long long t0_ = clock64(); while (clock64() - t0_ < 60000) __builtin_amdgcn_s_sleep(8); }
#endif
        const int row = wid * 32 + (lane & 31);
        if (lane < 32) {
            const f32x2v a = P[row * 4 + 0], b = P[row * 4 + 1], c = P[row * 4 + 2], d = P[row * 4 + 3];
            const float mt = (a.x + b.x + c.x + d.x) * 0.25f;
            const float da = a.x - mt, db = b.x - mt, dc = c.x - mt, dd = d.x - mt;
            const float m2 = (a.y + b.y) + (c.y + d.y) + 64.0f * ((da * da + db * db) + (dc * dc + dd * dd));
            unsigned long long* slot = (unsigned long long*)xbuf + ((size_t)(u.pm * BM + row) * 4 + u.pn);
            __hip_atomic_store(slot, ((unsigned long long)__float_as_uint(m2) << 32) | __float_as_uint(mt), __ATOMIC_RELAXED, __HIP_MEMORY_SCOPE_AGENT);
        }
        asm volatile("s_waitcnt vmcnt(0)" ::: "memory");
        if (lane == 0) __hip_atomic_fetch_add(cnt + 64 * u.pm, 1u, __ATOMIC_RELAXED, __HIP_MEMORY_SCOPE_AGENT);
        if (wid == 0) {
            bool dead = false; const unsigned long long t0 = __builtin_amdgcn_s_memrealtime(); const unsigned want = 8u * (unsigned)ntn;
            for (;;) {
#if defined(BROKEN_EXCHANGE_NO_WAIT)
                break;
#endif
                if ((unsigned)__builtin_amdgcn_readfirstlane(__hip_atomic_load(cnt + 64 * u.pm, __ATOMIC_RELAXED, __HIP_MEMORY_SCOPE_AGENT)) >= want) break;
                if (__builtin_amdgcn_s_memrealtime() - t0 > 2000000ull) {
                    if (lane == 0) { unsigned expect = 0u; __hip_atomic_compare_exchange_strong(tmo + 1, &expect, code | (unsigned)(u.pm & 0xff), __ATOMIC_RELAXED, __ATOMIC_RELAXED, __HIP_MEMORY_SCOPE_AGENT);
                                     __hip_atomic_store(tmo, 1u, __ATOMIC_RELAXED, __HIP_MEMORY_SCOPE_AGENT); }
                    dead = true; break; }
                __builtin_amdgcn_s_sleep(2);
            }
            __builtin_amdgcn_fence(__ATOMIC_ACQUIRE, "agent");
            if (lane == 0) flag[0] = dead ? 1u : 0u;
        }
        asm volatile("s_waitcnt vmcnt(0) lgkmcnt(0)" ::: "memory"); __builtin_amdgcn_s_barrier(); asm volatile("" ::: "memory");
        const bool bad = flag[0] != 0u;
        if (lane < 32) {
            const unsigned long long* slot = (const unsigned long long*)xbuf + (size_t)(u.pm * BM + row) * 4; float mt[4], m2[4]; float ms = 0.f;
#pragma unroll
            for (int t = 0; t < 4; ++t) { if (t < ntn) { const unsigned long long w = __hip_atomic_load(slot + t, __ATOMIC_RELAXED, __HIP_MEMORY_SCOPE_AGENT); mt[t] = __uint_as_float((unsigned)w); m2[t] = __uint_as_float((unsigned)(w >> 32)); } else { mt[t] = 0.f; m2[t] = 0.f; } ms += mt[t]; }
            const float mean = ms / (float)ntn; float q = 0.f;
#pragma unroll
            for (int t = 0; t < 4; ++t) if (t < ntn) { const float dm = mt[t] - mean; q += m2[t] + 256.0f * dm * dm; }
            S[row] = (f32x2v){mean, 1.0f / sqrtf(q / (256.0f * (float)ntn) + eps)};
        }
        asm volatile("s_waitcnt lgkmcnt(0)" ::: "memory"); __builtin_amdgcn_s_barrier(); asm volatile("" ::: "memory");
        return bad;
    }
};
struct EpiLnRes {
    static constexpr bool PERM = false, AFTER_DRAIN = true;
    const float* base; float* out; int ldc; const float* bias; PanelStats st; unsigned poison;
    __device__ __forceinline__ void fused(f32x4 (&acc)[2][2][4][2], const Unit& u, int wr, int wc, int fr, int fq, PG8_LAS unsigned char* lds, int wid, int lane) const {
        typedef float f32x2v __attribute__((ext_vector_type(2)));
        const PG8_LAS f32x2v* S = (const PG8_LAS f32x2v*)(lds + 8192);
        const int col0 = u.pn * BM + wc * 32 + 4 * fq;
#pragma unroll
        for (int bj = 0; bj < 2; ++bj)
#pragma unroll
            for (int n = 0; n < 2; ++n) { const f32x4 bv = bias ? *(const f32x4*)(bias + col0 + bj * HALF + n * 16) : (f32x4){0.f, 0.f, 0.f, 0.f};
#pragma unroll
                for (int ai = 0; ai < 2; ++ai)
#pragma unroll
                    for (int m = 0; m < 4; ++m) acc[ai][bj][m][n] += bv; }
        f32x4 pre[4][2][2];
#pragma unroll
        for (int m = 0; m < 4; ++m) { const size_t off = (size_t)(u.pm * BM + wr * 64 + m * 16 + fr) * ldc + col0;
#pragma unroll
            for (int bj = 0; bj < 2; ++bj)
#pragma unroll
                for (int n = 0; n < 2; ++n) pre[m][bj][n] = *(const f32x4*)(base + off + bj * HALF + n * 16); }
        const bool bad = st.run(acc, u, wr, wc, fr, fq, lds, wid, lane) || poison != 0u;
        const float qnan = __builtin_nanf("");
#pragma unroll
        for (int ai = 0; ai < 2; ++ai)
#pragma unroll
            for (int m = 0; m < 4; ++m) { const int r = ai * HALF + wr * 64 + m * 16 + fr; const f32x2v sr = S[r]; const size_t off = (size_t)(u.pm * BM + r) * ldc + col0;
#pragma unroll
                for (int bj = 0; bj < 2; ++bj)
#pragma unroll
                    for (int n = 0; n < 2; ++n) { const f32x4 bs = ai == 0 ? pre[m][bj][n] : *(const f32x4*)(base + off + bj * HALF + n * 16); f32x4 o = bs + (acc[ai][bj][m][n] - sr.x) * sr.y;
                        if (bad) o = (f32x4){qnan, qnan, qnan, qnan}; *(f32x4*)(out + off + bj * HALF + n * 16) = o; }
                if (m & 1) asm volatile("" ::: "memory"); }
    }
};
struct EpiLnResLn {
    static constexpr bool PERM = false, AFTER_DRAIN = true;
    const float* base; float* out; bf16_t* xn; int ldc; const float* bias; PanelStats st1, st2; unsigned poison;
    __device__ __forceinline__ void fused(f32x4 (&acc)[2][2][4][2], const Unit& u, int wr, int wc, int fr, int fq, PG8_LAS unsigned char* lds, int wid, int lane) const {
        typedef float f32x2v __attribute__((ext_vector_type(2))); typedef unsigned u32x2v __attribute__((ext_vector_type(2)));
        const PG8_LAS f32x2v* S = (const PG8_LAS f32x2v*)(lds + 8192);
        const int col0 = u.pn * BM + wc * 32 + 4 * fq;
#pragma unroll
        for (int bj = 0; bj < 2; ++bj)
#pragma unroll
            for (int n = 0; n < 2; ++n) { const f32x4 bv = bias ? *(const f32x4*)(bias + col0 + bj * HALF + n * 16) : (f32x4){0.f, 0.f, 0.f, 0.f};
#pragma unroll
                for (int ai = 0; ai < 2; ++ai)
#pragma unroll
                    for (int m = 0; m < 4; ++m) acc[ai][bj][m][n] += bv; }
        bool bad = st1.run(acc, u, wr, wc, fr, fq, lds, wid, lane) || poison != 0u;
        const float qnan = __builtin_nanf("");
#pragma unroll
        for (int ai = 0; ai < 2; ++ai)
#pragma unroll
            for (int m = 0; m < 4; ++m) { const int r = ai * HALF + wr * 64 + m * 16 + fr; const f32x2v sr = S[r]; const size_t off = (size_t)(u.pm * BM + r) * ldc + col0;
#pragma unroll
                for (int bj = 0; bj < 2; ++bj)
#pragma unroll
                    for (int n = 0; n < 2; ++n) { const f32x4 bs = *(const f32x4*)(base + off + bj * HALF + n * 16); acc[ai][bj][m][n] = bs + (acc[ai][bj][m][n] - sr.x) * sr.y; }
                asm volatile("" : "+v"(acc[ai][0][m][0]), "+v"(acc[ai][0][m][1]), "+v"(acc[ai][1][m][0]), "+v"(acc[ai][1][m][1]));
                if (m & 1) asm volatile("" ::: "memory"); }
        const bool bad1 = bad;
        bad = st2.run(acc, u, wr, wc, fr, fq, lds, wid, lane) || bad;
#pragma unroll
        for (int ai = 0; ai < 2; ++ai)
#pragma unroll
            for (int m = 0; m < 4; ++m) { const int r = ai * HALF + wr * 64 + m * 16 + fr; const f32x2v sr = S[r]; const size_t off = (size_t)(u.pm * BM + r) * ldc + col0;
#pragma unroll
                for (int bj = 0; bj < 2; ++bj)
#pragma unroll
                    for (int n = 0; n < 2; ++n) { const f32x4 x1 = acc[ai][bj][m][n]; *(f32x4*)(out + off + bj * HALF + n * 16) = bad1 ? (f32x4){qnan, qnan, qnan, qnan} : x1;
                        const f32x4 o = (x1 - sr.x) * sr.y; u32x2v w; w.x = cvt_pk_bf16(o[0], o[1]); w.y = cvt_pk_bf16(o[2], o[3]);
                        if (bad) { w.x = 0x7fc07fc0u; w.y = 0x7fc07fc0u; } *(u32x2v*)(xn + off + bj * HALF + n * 16) = w; }
                asm volatile("" ::: "memory"); }
    }
};

template <class Epi, class Sched, bool ALIGN_EPI = false, bool SP2 = false>
__device__ __forceinline__ void gemm_phase(PG8_LAS unsigned char* lds, const Gemm g, const Sched& S, const Epi& E, const int wv_) {
    int tid_o = wv_ * 64 + (int)__builtin_amdgcn_mbcnt_hi(~0u, __builtin_amdgcn_mbcnt_lo(~0u, 0u)); asm volatile("" : "+v"(tid_o)); tid_o &= 511;
    const int tid = tid_o, wid = __builtin_amdgcn_readfirstlane(tid >> 6), lane = tid & 63, wr = wid >> 2, wc = wid & 3, fr = lane & 15, fq = lane >> 4;
    const int K = g.K, nt = K / BK;
    unsigned voffA[2], voffB[2];
#pragma unroll
    for (int i = 0; i < 2; ++i) { int R, C; stage_rc(tid * 16 + i * 8192, R, C); const int Rb = Epi::PERM ? ((R & ~31) + perm32(R & 31)) : R;
        voffA[i] = (unsigned)(R * K + C) * 2u; voffB[i] = (unsigned)(Rb * K + C) * 2u; }
    const size_t kstep = (size_t)(BK * 2);
    const size_t hstep = (size_t)HALF * K * 2;
    const size_t tstep = 2 * hstep;
    const unsigned ldsw = (unsigned)wid * 1024u;
    const int aoff = lds_byte(wr * 64 + fr, fq * 8), boff = lds_byte(wc * 32 + fr, fq * 8);
#define PG8_SA(b, h) (((b) * 2 + (h)) * HTB)
#define PG8_SB(b, h) ((4 + (b) * 2 + (h)) * HTB)
#define PG8_STAGE(bufoff, gbase, voff) do { _Pragma("unroll") for (int _i = 0; _i < 2; ++_i) \
        __builtin_amdgcn_global_load_lds((const unsigned*)((const char*)(gbase) + (voff)[_i]), (PG8_LAS unsigned*)(lds + (bufoff) + ldsw + _i * 8192), 16, 0, 0); } while (0)
#define PG8_LDA(dst, b, h) do { _Pragma("unroll") for (int m = 0; m < 4; ++m) _Pragma("unroll") for (int k = 0; k < 2; ++k) dst[m][k] = *(const PG8_LAS bf16x8*)(lds + PG8_SA(b, h) + aoff + m * 2048 + k * 1024); } while (0)
#define PG8_LDB(dst, b, h) do { _Pragma("unroll") for (int n = 0; n < 2; ++n) _Pragma("unroll") for (int k = 0; k < 2; ++k) dst[n][k] = *(const PG8_LAS bf16x8*)(lds + PG8_SB(b, h) + boff + n * 2048 + k * 1024); } while (0)
#define PG8_MMA(ai, bj, At, Bt) do { __builtin_amdgcn_s_setprio(1); _Pragma("unroll") for (int m = 0; m < 4; ++m) _Pragma("unroll") for (int n = 0; n < 2; ++n) _Pragma("unroll") for (int k = 0; k < 2; ++k) \
        acc[ai][bj][m][n] = __builtin_amdgcn_mfma_f32_16x16x32_bf16(Bt[n][k], At[m][k], acc[ai][bj][m][n], 0, 0, 0); __builtin_amdgcn_s_setprio(0); } while (0)
#define PG8_WAIT_V(n) asm volatile("s_waitcnt vmcnt(" #n ")" ::: "memory")
#define PG8_WAIT_L(n) asm volatile("s_waitcnt lgkmcnt(" #n ")" ::: "memory")
#define PG8_BAR __builtin_amdgcn_s_barrier()
#define PG8_SCHED __builtin_amdgcn_sched_barrier(0)
    Unit cur, nxt; int ui = 0;
    if (!S.next(0, cur)) return;
    f32x4 acc[2][2][4][2];
#pragma unroll
    for (int a = 0; a < 2; ++a)
#pragma unroll
        for (int b = 0; b < 2; ++b)
#pragma unroll
            for (int m = 0; m < 4; ++m)
#pragma unroll
                for (int n = 0; n < 2; ++n) acc[a][b][m][n] = (f32x4){0.f, 0.f, 0.f, 0.f};
    bf16x8 At[4][2], B0[2][2], B1[2][2];
    const char* cA = (const char*)g.A + (size_t)cur.pm * tstep; const char* cB = (const char*)g.Bt + (size_t)cur.pn * tstep;
    S.a_ready(cur);
    if constexpr (SP2) {
        PG8_STAGE(PG8_SB(0, 0), cB, voffB); PG8_STAGE(PG8_SB(0, 1), cB + hstep, voffB); PG8_STAGE(PG8_SA(0, 0), cA, voffA); PG8_STAGE(PG8_SA(0, 1), cA + hstep, voffA);
        if (wr == 1) PG8_BAR;
        PG8_WAIT_V(2); PG8_BAR;
        PG8_STAGE(PG8_SB(1, 0), cB + kstep, voffB); PG8_STAGE(PG8_SA(1, 0), cA + kstep, voffA); PG8_STAGE(PG8_SB(1, 1), cB + hstep + kstep, voffB);
        PG8_WAIT_V(6); PG8_BAR;
    } else {
        PG8_STAGE(PG8_SB(0, 0), cB, voffB); PG8_STAGE(PG8_SA(0, 0), cA, voffA); PG8_STAGE(PG8_SB(0, 1), cB + hstep, voffB); PG8_STAGE(PG8_SA(0, 1), cA + hstep, voffA);
        if (wr == 1) PG8_BAR;
        PG8_WAIT_V(4); PG8_BAR;
        PG8_STAGE(PG8_SB(1, 0), cB + kstep, voffB); PG8_STAGE(PG8_SA(1, 0), cA + kstep, voffA); PG8_STAGE(PG8_SB(1, 1), cB + hstep + kstep, voffB);
        PG8_WAIT_V(6); PG8_BAR;
    }
    for (;;) {
        const bool has_next = S.next(ui + 1, nxt);
        const char* nA = has_next ? (const char*)g.A + (size_t)nxt.pm * tstep : cA; const char* nB = has_next ? (const char*)g.Bt + (size_t)nxt.pn * tstep : cB;
        for (int t = 0; t < nt; t += 2) {
            const bool last = (t == nt - 2);
            const char* a1 = cA + (size_t)(t + 1) * kstep;
            const char* a2 = last ? nA : cA + (size_t)(t + 2) * kstep; const char* b2 = last ? nB : cB + (size_t)(t + 2) * kstep;
            const char* a3 = a2 + kstep; const char* b3 = b2 + kstep;
            if (last && has_next) S.a_ready(nxt);
            if constexpr (SP2) {
            PG8_LDB(B0, 0, 0); PG8_LDB(B1, 0, 1); PG8_SCHED; PG8_LDA(At, 0, 0); PG8_STAGE(PG8_SA(1, 1), a1 + hstep, voffA);
            PG8_WAIT_V(8); PG8_WAIT_L(0); PG8_BAR; PG8_MMA(0, 0, At, B0); PG8_MMA(0, 1, At, B1); PG8_BAR; PG8_SCHED;
            PG8_LDA(At, 0, 1); PG8_STAGE(PG8_SB(0, 0), b2, voffB); PG8_STAGE(PG8_SB(0, 1), b2 + hstep, voffB); PG8_STAGE(PG8_SA(0, 0), a2, voffA);
            PG8_WAIT_V(8); PG8_WAIT_L(0); PG8_BAR; PG8_MMA(1, 0, At, B0); PG8_MMA(1, 1, At, B1); PG8_BAR; PG8_SCHED;
            PG8_LDB(B0, 1, 0); PG8_LDB(B1, 1, 1); PG8_SCHED; PG8_LDA(At, 1, 0); PG8_STAGE(PG8_SA(0, 1), a2 + hstep, voffA);
            PG8_WAIT_V(8); PG8_WAIT_L(0); PG8_BAR; PG8_MMA(0, 0, At, B0); PG8_MMA(0, 1, At, B1); PG8_BAR; PG8_SCHED;
            PG8_LDA(At, 1, 1); PG8_STAGE(PG8_SB(1, 0), b3, voffB); PG8_STAGE(PG8_SB(1, 1), b3 + hstep, voffB); PG8_STAGE(PG8_SA(1, 0), a3, voffA);
            PG8_WAIT_V(8); PG8_WAIT_L(0); PG8_BAR; PG8_MMA(1, 0, At, B0); PG8_MMA(1, 1, At, B1); PG8_BAR; PG8_SCHED;
            } else {
            PG8_LDB(B0, 0, 0); PG8_SCHED; PG8_LDA(At, 0, 0); PG8_STAGE(PG8_SA(1, 1), a1 + hstep, voffA);
            PG8_WAIT_L(8); PG8_BAR; PG8_WAIT_L(0); PG8_MMA(0, 0, At, B0); PG8_BAR; PG8_SCHED;
            PG8_LDB(B1, 0, 1); PG8_STAGE(PG8_SB(0, 0), b2, voffB);
            PG8_BAR; PG8_WAIT_L(0); PG8_MMA(0, 1, At, B1); PG8_BAR;
            PG8_LDA(At, 0, 1); PG8_STAGE(PG8_SA(0, 0), a2, voffA);
            PG8_BAR; PG8_WAIT_L(0); PG8_MMA(1, 0, At, B0); PG8_BAR; PG8_SCHED;
            PG8_STAGE(PG8_SB(0, 1), b2 + hstep, voffB);
            PG8_WAIT_V(6); PG8_BAR; PG8_MMA(1, 1, At, B1); PG8_BAR;
            PG8_LDB(B0, 1, 0); PG8_SCHED; PG8_LDA(At, 1, 0); PG8_STAGE(PG8_SA(0, 1), a2 + hstep, voffA);
            PG8_WAIT_L(8); PG8_BAR; PG8_WAIT_L(0); PG8_MMA(0, 0, At, B0); PG8_BAR; PG8_SCHED;
            PG8_LDB(B1, 1, 1); PG8_STAGE(PG8_SB(1, 0), b3, voffB);
            PG8_BAR; PG8_WAIT_L(0); PG8_MMA(0, 1, At, B1); PG8_BAR;
            PG8_LDA(At, 1, 1); PG8_STAGE(PG8_SA(1, 0), a3, voffA);
            PG8_BAR; PG8_WAIT_L(0); PG8_MMA(1, 0, At, B0); PG8_BAR; PG8_SCHED;
            PG8_STAGE(PG8_SB(1, 1), b3 + hstep, voffB);
            PG8_WAIT_V(6); PG8_BAR; PG8_MMA(1, 1, At, B1); PG8_BAR;
            }
        }
        if constexpr (ALIGN_EPI) { if (wr == 0) PG8_BAR; }
        if constexpr (!Epi::AFTER_DRAIN) { E(acc, cur, wr, wc, fr, fq); S.done(cur); }
        if (!has_next) break;
#pragma unroll
        for (int a = 0; a < 2; ++a)
#pragma unroll
            for (int b = 0; b < 2; ++b)
#pragma unroll
                for (int m = 0; m < 4; ++m)
#pragma unroll
                    for (int n = 0; n < 2; ++n) acc[a][b][m][n] = (f32x4){0.f, 0.f, 0.f, 0.f};
        cur = nxt; cA = nA; cB = nB; ++ui;
        if constexpr (ALIGN_EPI) { if (wr == 1) PG8_BAR; }
    }
    PG8_WAIT_V(0);
    if constexpr (!ALIGN_EPI) { if (wr == 0) PG8_BAR; }
    PG8_BAR;
    if constexpr (Epi::AFTER_DRAIN) { E.fused(acc, cur, wr, wc, fr, fq, lds, wid, lane); S.done(cur); }
#undef PG8_SA
#undef PG8_SB
#undef PG8_STAGE
#undef PG8_LDA
#undef PG8_LDB
#undef PG8_MMA
#undef PG8_WAIT_V
#undef PG8_WAIT_L
#undef PG8_BAR
#undef PG8_SCHED
}
}
#include <hip/hip_bf16.h>
#include <cmath>
namespace attn_body {
using bf16=__hip_bfloat16;
using bf16x8=__attribute__((ext_vector_type(8)))short;
using s16x4=__attribute__((ext_vector_type(4)))short;
using f32x16=__attribute__((ext_vector_type(16)))float;
using u32x4=__attribute__((ext_vector_type(4)))unsigned;
constexpr int BATCH=8,NHEAD=16,SEQ=8192,D=64,DM=NHEAD*D,DMI=512,DMO=1024;
constexpr int NW=8,QBLK=32,QB=QBLK*NW,KVBLK=64,NQB=SEQ/QB;
constexpr int ATTN_PITCH=DM, ATTN_UNIT_ROWS=QB;
__device__ __forceinline__ int crow(int r,int hi){return (r&3)+8*(r>>2)+4*hi;}
#define SBAR() __builtin_amdgcn_sched_barrier(0)
__device__ __forceinline__ void cmask(f32x16&p0,f32x16&p1,int jb,int qrel,int hi){
  const float NEG=-INFINITY; int kb=64*jb+4*hi;
  #pragma unroll
  for(int r=0;r<16;++r){ if(jb>(qrel>>6)){p0[r]=NEG;p1[r]=NEG;} } (void)kb;
}

constexpr int NSLOT=3, SLOTB=8192;
constexpr int LDS_K=0, LDS_V=NSLOT*SLOTB, LDS_WS=2*NSLOT*SLOTB, LDS_OST=LDS_WS+NW*64*4, LDS_BYTES=LDS_OST+NW*4096;
constexpr float C2=0.125f*1.4426950408889634f;
__device__ __forceinline__ void glds16(const void*gsrc,unsigned lds_dst){unsigned keep;
  asm volatile("s_mov_b32 %0, m0\n\ts_mov_b32 m0, %2\n\ts_nop 0\n\tglobal_load_lds_dwordx4 %1, off\n\ts_mov_b32 m0, %0":"=&s"(keep):"v"(gsrc),"s"(lds_dst):"memory");}
__device__ __forceinline__ float max3f(float a,float b,float c){float r;asm("v_max3_f32 %0, %1, %2, %3":"=v"(r):"v"(a),"v"(b),"v"(c));return r;}
__device__ __forceinline__ float max2f(float a,float b){float r;asm("v_max_f32_e32 %0, %1, %2":"=v"(r):"v"(a),"v"(b));return r;}
__device__ __forceinline__ float fadd_s(float a,float b){float r;asm("v_add_f32_e32 %0, %1, %2":"=v"(r):"v"(a),"v"(b));return r;}
__device__ __forceinline__ float fsub_s(float a,float b){float r;asm("v_sub_f32_e32 %0, %1, %2":"=v"(r):"v"(a),"v"(b));return r;}
typedef float f32x2_t __attribute__((ext_vector_type(2))); typedef __bf16 bf16x2_t __attribute__((ext_vector_type(2)));
__device__ __forceinline__ unsigned cvtpk_s(float lo,float hi){f32x2_t v={lo,hi};bf16x2_t b=__builtin_convertvector(v,bf16x2_t);return __builtin_bit_cast(unsigned,b);}
#define WAIT_BAR(N) asm volatile("s_waitcnt vmcnt(" #N ") lgkmcnt(0)\n\ts_barrier":::"memory")

__device__ __forceinline__ void qkt(f32x16&p0,f32x16&p1,const char*Kslot,const bf16x8*qr,const f32x16&negm,int r32,int hi){
  const char*kb=Kslot+hi*1024+r32*16;
  #pragma unroll
  for(int d0=0;d0<4;++d0){
    const bf16x8 b0=*reinterpret_cast<const bf16x8*>(kb+d0*2048);
    const bf16x8 b1=*reinterpret_cast<const bf16x8*>(kb+d0*2048+512);
    if(d0==0){p0=__builtin_amdgcn_mfma_f32_32x32x16_bf16(b0,qr[0],negm,0,0,0);p1=__builtin_amdgcn_mfma_f32_32x32x16_bf16(b1,qr[0],negm,0,0,0);}
    else{p0=__builtin_amdgcn_mfma_f32_32x32x16_bf16(b0,qr[d0],p0,0,0,0);p1=__builtin_amdgcn_mfma_f32_32x32x16_bf16(b1,qr[d0],p1,0,0,0);}}
}
typedef __attribute__((address_space(3))) const char* lds_cptr;
typedef short v4i16_t __attribute__((ext_vector_type(4)));
__device__ __forceinline__ void kload8(bf16x8*kf,lds_cptr kp){
  kf[0]=*(const __attribute__((address_space(3))) bf16x8*)(kp);      kf[1]=*(const __attribute__((address_space(3))) bf16x8*)(kp+512);
  kf[2]=*(const __attribute__((address_space(3))) bf16x8*)(kp+2048); kf[3]=*(const __attribute__((address_space(3))) bf16x8*)(kp+2560);
  kf[4]=*(const __attribute__((address_space(3))) bf16x8*)(kp+4096); kf[5]=*(const __attribute__((address_space(3))) bf16x8*)(kp+4608);
  kf[6]=*(const __attribute__((address_space(3))) bf16x8*)(kp+6144); kf[7]=*(const __attribute__((address_space(3))) bf16x8*)(kp+6656);
}
__device__ __forceinline__ void kload2(bf16x8*kf,lds_cptr kp,int j){ kf[2*j]=*(const __attribute__((address_space(3))) bf16x8*)(kp+j*2048); kf[2*j+1]=*(const __attribute__((address_space(3))) bf16x8*)(kp+j*2048+512); }
__device__ __forceinline__ s16x4 vtr(lds_cptr p){ return __builtin_bit_cast(s16x4,__builtin_amdgcn_ds_read_tr16_b64_v4i16((__attribute__((address_space(3))) v4i16_t*)p)); }
__device__ __forceinline__ float rowmax(const f32x16&p0,const f32x16&p1){
  float a=max3f(p0[0],p0[1],p1[0]),b=max3f(p0[2],p0[3],p1[1]);a=max3f(a,p1[2],p1[3]);
  #pragma unroll
  for(int r=4;r<16;r+=4){a=max3f(a,p0[r],p0[r+1]);b=max3f(b,p0[r+2],p0[r+3]);a=max3f(a,p1[r],p1[r+1]);b=max3f(b,p1[r+2],p1[r+3]);}
  const float m=max2f(a,b);
  auto rr=__builtin_amdgcn_permlane32_swap(__float_as_uint(m),__float_as_uint(m),false,false);
  return max2f(__uint_as_float(rr[0]),__uint_as_float(rr[1]));
}
__device__ __forceinline__ void pv(f32x16*o,int vb,bf16x8 pa0,bf16x8 pa1,bf16x8 pa2,bf16x8 pa3){
  #pragma unroll
  for(int d0=0;d0<2;++d0){s16x4 lo[4],hi[4];
    #pragma unroll
    for(int ks=0;ks<4;++ks){
      asm volatile("ds_read_b64_tr_b16 %0,%1 offset:%c2":"=&v"(lo[ks]):"v"(vb),"i"(d0*4096+ks*1024):"memory");
      asm volatile("ds_read_b64_tr_b16 %0,%1 offset:%c2":"=&v"(hi[ks]):"v"(vb),"i"(d0*4096+ks*1024+512):"memory");}
    asm volatile("s_waitcnt lgkmcnt(0)":::"memory");SBAR();
    #define PK(k) (bf16x8){lo[k][0],lo[k][1],lo[k][2],lo[k][3],hi[k][0],hi[k][1],hi[k][2],hi[k][3]}
    o[d0]=__builtin_amdgcn_mfma_f32_32x32x16_bf16(pa0,PK(0),o[d0],0,0,0);
    o[d0]=__builtin_amdgcn_mfma_f32_32x32x16_bf16(pa1,PK(1),o[d0],0,0,0);
    o[d0]=__builtin_amdgcn_mfma_f32_32x32x16_bf16(pa2,PK(2),o[d0],0,0,0);
    o[d0]=__builtin_amdgcn_mfma_f32_32x32x16_bf16(pa3,PK(3),o[d0],0,0,0);
    #undef PK
  }
}

#ifndef ATTN_STORE16
#define ATTN_STORE16(p,v) (*(u32x4*)(p)=(v))
#endif
template<int THRL> __device__ __forceinline__ void attn_unit(int b,int h,int qb,const bf16*Q,const bf16*__restrict__ K,const bf16*__restrict__ V,bf16*O,char*shm,const int wv_){
  int tid_o=wv_*64+(int)__builtin_amdgcn_mbcnt_hi(~0u,__builtin_amdgcn_mbcnt_lo(~0u,0u)); asm volatile("":"+v"(tid_o)); tid_o&=511;
  const int tid=tid_o,lane=tid&63,r32=lane&31,hi=lane>>5; const int wid=__builtin_amdgcn_readfirstlane(tid>>6);
  const long rowbase=(long)b*SEQ; const int q0=qb*QB;
  const bf16*Qw=Q+(rowbase+q0+wid*QBLK)*DMI+(h>>1)*D;
  const bf16*Kh=K+rowbase*DMI+(h>>1)*D,*Vh=V+rowbase*DMI+(h>>2)*128+(h&1)*64;
  const unsigned lds0=(unsigned)(uintptr_t)shm;
  float*wsf=(float*)(shm+LDS_WS)+wid*64;
  const bf16*ksrc=Kh+(long)lane*DMI+wid*8;
  const bf16*vsrc=Vh+(long)(16*(wid&3)+(lane>>2))*DMI+(wid>>2)*32+(lane&3)*8;
  const unsigned kdst=lds0+LDS_K+wid*1024, vdst=lds0+LDS_V+wid*1024;
  #define DMA_K(t,slot) glds16(ksrc+(long)(t)*KVBLK*DMI,(unsigned)__builtin_amdgcn_readfirstlane(kdst+(slot)))
  #define DMA_V(t,slot) glds16(vsrc+(long)(t)*KVBLK*DMI,(unsigned)__builtin_amdgcn_readfirstlane(vdst+(slot)))
  const int vb0=(int)(lds0+LDS_V)+((lane>>4)&1)*32+(lane&3)*8+(4*hi+((lane&15)>>2))*64;
  const char*Kbase=shm+LDS_K; bf16x8 kf[8];
  const lds_cptr shm3=(lds_cptr)shm; const lds_cptr kp0=shm3+LDS_K+hi*1024+r32*16; const lds_cptr vp0=shm3+LDS_V+((lane>>4)&1)*32+(lane&3)*8+(4*hi+((lane&15)>>2))*64;
  const int NT=(q0+QB)/KVBLK;
  DMA_K(0,0);DMA_V(0,0);DMA_K(1,SLOTB);
  bf16x8 qr[4];
  #pragma unroll
  for(int d0=0;d0<4;++d0)qr[d0]=*reinterpret_cast<const bf16x8*>(&Qw[(long)r32*DMI+d0*16+hi*8]);
  float mhat=0.f,l_reg=0.f;f32x16 o[2];o[0]=f32x16{};o[1]=f32x16{};f32x16 negm=f32x16{};asm volatile("":"+v"(negm));
  const int qrel=wid*QBLK+r32;
  #define CMASK(P0,P1,t) do{int jb_=(t)-(NT-4); if(jb_>=0)cmask(P0,P1,jb_,qrel,hi);}while(0)
  bool resc=false;
  #define START(P0,P1) do{ const float rm=rowmax(P0,P1); resc=false; \
    { const float dl=rm; mhat=fadd_s(mhat,dl); \
      _Pragma("unroll") for(int r=0;r<16;++r){P0[r]=fsub_s(P0[r],dl);P1[r]=fsub_s(P1[r],dl);} \
      _Pragma("unroll") for(int r=0;r<16;++r)negm[r]=-mhat; asm volatile("":"+v"(negm)); } \
    _Pragma("unroll") for(int r=0;r<16;++r)P0[r]=__builtin_amdgcn_exp2f(P0[r]); }while(0)
  #define RESC() do{ if(resc){ asm volatile("s_waitcnt lgkmcnt(0)":::"memory"); \
      _Pragma("unroll") for(int d_=0;d_<2;++d_) _Pragma("unroll") for(int r=0;r<16;++r)o[d_][r]*=wsf[crow(r,hi)]; } }while(0)
  f32x16 pA0,pA1,pB0,pB1;
  int sl_prev=0,sl_cur=0,sl_next=SLOTB;
  #define ROT() do{sl_prev=sl_cur;sl_cur=sl_next;sl_next=(sl_next==(NSLOT-1)*SLOTB)?0:sl_next+SLOTB;}while(0)
  DMA_K(2,2*SLOTB);
  WAIT_BAR(3);
  qkt(pA0,pA1,Kbase,qr,negm,r32,hi);asm volatile("s_nop 15\n\ts_nop 7":"+v"(pA0),"+v"(pA1));CMASK(pA0,pA1,0);
  START(pA0,pA1);
  _Pragma("unroll") for(int r=0;r<16;++r)pA1[r]=__builtin_amdgcn_exp2f(pA1[r]);
  WAIT_BAR(0);
  DMA_K(3,0);DMA_V(1,SLOTB);
  ROT();
  kload8(kf,kp0+sl_cur);
  WAIT_BAR(2);
  s16x4 vlo[8],vhi[8]; u32x4 pw0,pw1,pw2,pw3;
  #define PKW(P,B) cvtpk_s(P[B],P[B+1])
  #define PAF(k) __builtin_bit_cast(bf16x8,pw##k)
  #define VFR(i) (bf16x8){vlo[i][0],vlo[i][1],vlo[i][2],vlo[i][3],vhi[i][0],vhi[i][1],vhi[i][2],vhi[i][3]}
  #define PIN(x) asm volatile("":"+v"(x))
  #define MX3(a,b,c) __builtin_fmaxf(__builtin_fmaxf((a),(b)),(c))
  #define GAPA(MF,A0,A1,A2,A3,W0,W1,PW) do{ MF; sacc+=A0; sacc+=A1; sacc+=A2; sacc+=A3; PIN(sacc); W0; W1; PIN(PW); SBAR(); }while(0)
  #define EX(v) __builtin_amdgcn_exp2f(v)
  #define GAPB(MF,X,B) do{ MF; X[B]=EX(X[B]); X[B+1]=EX(X[B+1]); X[B+2]=EX(X[B+2]); X[B+3]=EX(X[B+3]); PIN(X); SBAR(); }while(0)
  #define VRD(i) do{ vlo[i]=vtr(vp_+(((i)>>2)*4096+((i)&3)*1024)); vhi[i]=vtr(vp_+(((i)>>2)*4096+((i)&3)*1024+512)); }while(0)
  #define KRD(G,j) do{ if(G){ kload2(kf,kp0+sl_next,j); SBAR(); } }while(0)
  #define STEP(C0,C1,P0,P1,t,GK,GV,GL) do{ SBAR(); \
    const lds_cptr vp_=vp0+sl_prev; \
    VRD(0); SBAR(); float sacc=(P0[0]+P0[1]); \
    GAPA(C0=__builtin_amdgcn_mfma_f32_32x32x16_bf16(kf[0],qr[0],negm,0,0,0), P0[2],P0[3],P0[4],P0[5],     pw0[0]=PKW(P0,0), pw0[1]=PKW(P0,2), pw0); \
    VRD(4); SBAR(); GAPA(C1=__builtin_amdgcn_mfma_f32_32x32x16_bf16(kf[1],qr[0],negm,0,0,0), P0[6],P0[7],P0[8],P0[9],     pw0[2]=PKW(P0,4), pw0[3]=PKW(P0,6), pw0); \
    VRD(1); SBAR(); GAPA(C0=__builtin_amdgcn_mfma_f32_32x32x16_bf16(kf[2],qr[1],C0,0,0,0),   P0[10],P0[11],P0[12],P0[13], pw1[0]=PKW(P0,8), pw1[1]=PKW(P0,10), pw1); \
    VRD(5); SBAR(); GAPA(C1=__builtin_amdgcn_mfma_f32_32x32x16_bf16(kf[3],qr[1],C1,0,0,0),   P0[14],P0[15],P1[0],P1[1],   pw1[2]=PKW(P0,12),pw1[3]=PKW(P0,14), pw1); \
    VRD(2); SBAR(); GAPA(C0=__builtin_amdgcn_mfma_f32_32x32x16_bf16(kf[4],qr[2],C0,0,0,0),   P1[2],P1[3],P1[4],P1[5],     pw2[0]=PKW(P1,0), pw2[1]=PKW(P1,2), pw2); \
    VRD(6); SBAR(); GAPA(C1=__builtin_amdgcn_mfma_f32_32x32x16_bf16(kf[5],qr[2],C1,0,0,0),   P1[6],P1[7],P1[8],P1[9],     pw2[2]=PKW(P1,4), pw2[3]=PKW(P1,6), pw2); \
    VRD(3); SBAR(); GAPA(C0=__builtin_amdgcn_mfma_f32_32x32x16_bf16(kf[6],qr[3],C0,0,0,0),   P1[10],P1[11],P1[12],P1[13], pw3[0]=PKW(P1,8), pw3[1]=PKW(P1,10), pw3); \
    VRD(7); SBAR(); GAPA(C1=__builtin_amdgcn_mfma_f32_32x32x16_bf16(kf[7],qr[3],C1,0,0,0),   P1[14],P1[15],0.f,0.f,       pw3[2]=PKW(P1,12),pw3[3]=PKW(P1,14), pw3); \
    l_reg+=sacc; \
    if(GK){DMA_K((t)+3,sl_cur);} if(GV){DMA_V((t)+1,sl_next);} \
    CMASK(C0,C1,t); \
    { float a=MX3(C0[0],C0[1],C1[0]),b=MX3(C0[2],C0[3],C1[1]); a=MX3(a,C1[2],C1[3]); \
      _Pragma("unroll") for(int r=4;r<16;r+=4){a=MX3(a,C0[r],C0[r+1]);b=MX3(b,C0[r+2],C0[r+3]);a=MX3(a,C1[r],C1[r+1]);b=MX3(b,C1[r+2],C1[r+3]);} \
      float rm=__builtin_fmaxf(a,b); { auto rr=__builtin_amdgcn_permlane32_swap(__float_as_uint(rm),__float_as_uint(rm),false,false); rm=__builtin_fmaxf(__uint_as_float(rr[0]),__uint_as_float(rr[1])); } \
      resc=false; \
      if(__builtin_expect(__any(rm>(float)THRL),0)){ const float dl=__builtin_fmaxf(rm,0.f); mhat+=dl; \
        _Pragma("unroll") for(int r=0;r<16;++r){C0[r]-=dl;C1[r]-=dl;} \
        _Pragma("unroll") for(int r=0;r<16;++r)negm[r]=-mhat; asm volatile("":"+v"(negm)); \
        const float f=__builtin_amdgcn_exp2f(-dl); l_reg*=f; if(hi==0)wsf[r32]=f; resc=true; } } \
    SBAR(); \
    GAPB(o[0]=__builtin_amdgcn_mfma_f32_32x32x16_bf16(PAF(0),VFR(0),o[0],0,0,0), C0,0); \
    GAPB(o[1]=__builtin_amdgcn_mfma_f32_32x32x16_bf16(PAF(0),VFR(4),o[1],0,0,0), C0,4); \
    KRD(GL,0); GAPB(o[0]=__builtin_amdgcn_mfma_f32_32x32x16_bf16(PAF(1),VFR(1),o[0],0,0,0), C0,8); \
    KRD(GL,1); GAPB(o[1]=__builtin_amdgcn_mfma_f32_32x32x16_bf16(PAF(1),VFR(5),o[1],0,0,0), C0,12); \
    KRD(GL,2); GAPB(o[0]=__builtin_amdgcn_mfma_f32_32x32x16_bf16(PAF(2),VFR(2),o[0],0,0,0), C1,0); \
    KRD(GL,3); GAPB(o[1]=__builtin_amdgcn_mfma_f32_32x32x16_bf16(PAF(2),VFR(6),o[1],0,0,0), C1,4); \
    GAPB(o[0]=__builtin_amdgcn_mfma_f32_32x32x16_bf16(PAF(3),VFR(3),o[0],0,0,0), C1,8); \
    GAPB(o[1]=__builtin_amdgcn_mfma_f32_32x32x16_bf16(PAF(3),VFR(7),o[1],0,0,0), C1,12); \
    }while(0)
  int t=1;
  #undef CMASK
  #define CMASK(P0,P1,t) do{}while(0)
  for(;t+5<NT;t+=2){
    STEP(pB0,pB1,pA0,pA1,t,true,true,true);     WAIT_BAR(2); RESC(); ROT();
    STEP(pA0,pA1,pB0,pB1,t+1,true,true,true);   WAIT_BAR(2); RESC(); ROT();
  }
  #undef CMASK
  #define CMASK(P0,P1,t) do{int jb_=(t)-(NT-4); if(jb_>=0)cmask(P0,P1,jb_,qrel,hi);}while(0)
  #define ENDW(tt) do{ if((tt)+3<NT){WAIT_BAR(2);} else if((tt)+2<NT){WAIT_BAR(1);} else {WAIT_BAR(0);} }while(0)
  for(;t+1<NT;t+=2){
    STEP(pB0,pB1,pA0,pA1,t,(t+3<NT),(t+1<NT),(t+1<NT));       ENDW(t);   RESC(); ROT();
    STEP(pA0,pA1,pB0,pB1,t+1,(t+4<NT),(t+2<NT),(t+2<NT));     ENDW(t+1); RESC(); ROT();
  }
  STEP(pB0,pB1,pA0,pA1,NT-1,false,false,false); RESC();
  { float sacc=pB0[0]+pB0[1]; _Pragma("unroll") for(int r=2;r<16;++r)sacc+=pB0[r]; _Pragma("unroll") for(int r=0;r<16;++r)sacc+=pB1[r]; l_reg+=sacc;
    pw0=(u32x4){PKW(pB0,0),PKW(pB0,2),PKW(pB0,4),PKW(pB0,6)};pw1=(u32x4){PKW(pB0,8),PKW(pB0,10),PKW(pB0,12),PKW(pB0,14)};pw2=(u32x4){PKW(pB1,0),PKW(pB1,2),PKW(pB1,4),PKW(pB1,6)};pw3=(u32x4){PKW(pB1,8),PKW(pB1,10),PKW(pB1,12),PKW(pB1,14)};
    SBAR(); pv(o,vb0+sl_cur,PAF(0),PAF(1),PAF(2),PAF(3)); }
  #undef PKW
  #undef PAF
  #undef VFR
  #undef PIN
  #undef MX3
  #undef GAPA
  #undef GAPB
  #undef EX
  #undef VRD
  #undef KRD
  #undef STEP
  #undef ENDW
  {auto rr=__builtin_amdgcn_permlane32_swap(__float_as_uint(l_reg),__float_as_uint(l_reg),false,false);l_reg=__uint_as_float(rr[0])+__uint_as_float(rr[1]);}
  if(hi==0)wsf[32+r32]=l_reg;asm volatile("s_waitcnt lgkmcnt(0)":::"memory");
  float rli[16];
  #pragma unroll
  for(int r=0;r<16;++r)rli[r]=__builtin_amdgcn_rcpf(wsf[32+crow(r,hi)]);
  bf16*Ow=O+(rowbase+q0+wid*QBLK)*DMO+h*D;
  { bf16*stg=(bf16*)(shm+LDS_OST)+wid*2048;
    #pragma unroll
    for(int r=0;r<16;++r){const int orow=crow(r,hi);
      #pragma unroll
      for(int d0=0;d0<2;++d0)stg[orow*64+d0*32+r32]=__float2bfloat16(o[d0][r]*rli[r]);}
    asm volatile("s_waitcnt lgkmcnt(0)":::"memory");
    #pragma unroll
    for(int i=0;i<4;++i){const int row=i*8+(lane>>3),ch=lane&7; const u32x4 v=*(const u32x4*)(stg+row*64+ch*8); ATTN_STORE16(Ow+(long)row*DMO+ch*8,v);} }
  asm volatile("s_waitcnt lgkmcnt(0)\n\ts_barrier":::"memory");
  #undef DMA_K
  #undef DMA_V
  #undef CMASK
  #undef START
  #undef RESC
  #undef ROT
}
constexpr int ATTN_LDS_BYTES=LDS_BYTES;
struct AttnTensors { const bf16* Q; const bf16* K; const bf16* V; bf16* O; };
struct AttnUnit { int bh; int qb; };
struct StaticOrder {
  int vcu;
  __device__ __forceinline__ explicit StaticOrder(int grid,int block):vcu((block%8)*(grid/8)+block/8){}
  __device__ __forceinline__ bool next(int i,AttnUnit&u)const{ if(i>=4)return false; const int s=vcu&7; u.bh=vcu>>3; u.qb=(i==0)?s:(i==1)?15-s:(i==2)?16+s:31-s; return true; }
  __device__ __forceinline__ void a_ready(const AttnUnit&)const{}
  __device__ __forceinline__ void done(const AttnUnit&)const{}
};
template<class Sched,int THRL=8> __device__ __forceinline__ void attn_phase(char*lds,const AttnTensors&T,const Sched&S){
  AttnUnit u;
  for(int i=0;S.next(i,u);++i){ S.a_ready(u); attn_unit<THRL>(u.bh/NHEAD,u.bh%NHEAD,u.qb,T.Q,T.K,T.V,T.O,lds); S.done(u); }
}
#undef SBAR
#undef WAIT_BAR
}

#define LAS __attribute__((address_space(3)))
typedef unsigned short bfu;
typedef unsigned v4u __attribute__((ext_vector_type(4)));
typedef unsigned v2u __attribute__((ext_vector_type(2)));
typedef float f32x4 __attribute__((ext_vector_type(4)));
typedef float f32x8 __attribute__((ext_vector_type(8)));
typedef float f32x16 __attribute__((ext_vector_type(16)));
typedef float f32x2 __attribute__((ext_vector_type(2)));

constexpr int NWAVES = 8, NTHR = 512;
constexpr int MP = 65536, MS = 128, MR = MP + MS, MPAD = 65792;
constexpr int NIN = 3840, FFD = 4096;
constexpr int NPHASE = 24;
#ifndef MK_ONE_LAUNCH
#define MK_ONE_LAUNCH 1
#endif

constexpr size_t O_Y = 0;
constexpr size_t O_YS = (size_t)MP * 1024;
constexpr size_t O_ACP = O_YS + 128 * 1024;
constexpr size_t O_ADP = O_ACP + 2 * 8 * 3 * 768;
constexpr size_t O_BKP = O_ADP + 2 * 8 * 4 * 64 * 64;
constexpr size_t O_BVP = O_BKP + (size_t)2 * 8 * 8192 * 512;
constexpr size_t O_CSP = O_BVP + (size_t)2 * 8 * 8192 * 512;
constexpr size_t O_CWP = O_CSP + 2 * 8 * 1024;
constexpr size_t O_ACS = O_CWP + 2 * 8 * 4 * 64 * 64;
constexpr size_t O_ADS = O_ACS + 2 * 8 * 3 * 768;
constexpr size_t O_BKS = O_ADS + 2 * 8 * 4 * 64 * 64;
constexpr size_t O_BVS = O_BKS + 2 * 8 * 16 * 512;
constexpr size_t O_CSS = O_BVS + 2 * 8 * 16 * 512;
constexpr size_t O_CWS = O_CSS + 2 * 8 * 1024;
constexpr size_t O_END = O_CWS + 2 * 8 * 4 * 64 * 64;
static_assert(O_END == 202874880, "output size");

constexpr size_t MiB = 1u << 20;
constexpr size_t WS_CTL = 0;
constexpr size_t WS_RS = 64 * 1024;
constexpr size_t WS_BONUS = 2 * MiB;
constexpr size_t WS_GAB = 3 * MiB + 512 * 1024;
constexpr size_t WS_AB = 6 * MiB;
constexpr size_t WS_ROPE = 8 * MiB + 512 * 1024;
constexpr size_t WS_GCH = 10 * MiB + 512 * 1024;
constexpr size_t WS_W = 12 * MiB;
constexpr size_t W_IN = 0, W_OUT = W_IN + (size_t)NIN * 1024 * 2, W_FF1 = W_OUT + 1024 * 1024 * 2, W_FF2 = W_FF1 + 4096 * 1024 * 2,
                 W_GATE = W_FF2 + 4096 * 1024 * 2, W_PP = W_GATE + 1024 * 1024 * 2, W_LR = W_PP + 1024 * 256 * 2, W_END = W_LR + 768 * 256 * 2;
constexpr size_t WS_SLOT = 41 * MiB;
constexpr size_t USLOT = (size_t)MPAD * 1024;
static_assert(WS_W + W_END <= WS_SLOT, "weights");
constexpr size_t WS_PAIRC = WS_SLOT + 15 * USLOT;
constexpr size_t WS_PAIRD = WS_PAIRC + 4 * (size_t)(MPAD / 2) * 16;
constexpr size_t WS_TOTAL = WS_PAIRD + 4 * (size_t)(MPAD / 2) * 8;
static_assert(WS_TOTAL <= (size_t)1024 * MiB, "ws");
static_assert(WS_RS + 7 * (size_t)MPAD * 4 <= WS_BONUS && WS_BONUS + 4 * (size_t)MPAD * 4 <= WS_GAB && WS_GAB + 8 * (size_t)MPAD * 4 <= WS_AB && WS_AB + 8 * (size_t)MPAD * 4 <= WS_ROPE && WS_ROPE + 8192 * 64 * 4 <= WS_GCH && WS_GCH + 4 * 1032 * 64 * 4 <= WS_W, "ctl map");

__device__ __forceinline__ unsigned char* slotp(unsigned char* ws, int l, int s) {
    if (l & 1) { if (s < 2) s += 13; else if (s >= 13) s -= 13; }
    return ws + WS_SLOT + (size_t)s * USLOT;
}
__device__ __forceinline__ unsigned char* slotph(unsigned char* ws, int l, int s) { return slotp(ws, l, s) + USLOT / 2; }

constexpr int RING_BYTES = 131072, MISC_OFF = RING_BYTES + 320, LDS_BYTES = 147456;

#define LDS_WAIT() asm volatile("s_waitcnt lgkmcnt(0)" ::: "memory")
__device__ __forceinline__ float bf2f(unsigned short u) { return __uint_as_float(((unsigned)u) << 16); }
__device__ __forceinline__ unsigned f2bf(float f) { unsigned u = __builtin_bit_cast(unsigned, f); return (u + 0x7fffu + ((u >> 16) & 1u)) >> 16; }
__device__ __forceinline__ unsigned pk2(float lo, float hi) { return f2bf(lo) | (f2bf(hi) << 16); }
#define DPP_ROR_ADD(v, ctrl) ((v) + __builtin_bit_cast(float, __builtin_amdgcn_update_dpp(0, __builtin_bit_cast(int, (v)), (ctrl), 0xf, 0xf, false)))
__device__ __forceinline__ float wave_sum(float v) {
    v = DPP_ROR_ADD(v, 0x128); v = DPP_ROR_ADD(v, 0x124); v = DPP_ROR_ADD(v, 0x122); v = DPP_ROR_ADD(v, 0x121);
    v += __shfl_xor(v, 16);
    const unsigned u = __float_as_uint(v); auto rr = __builtin_amdgcn_permlane32_swap(u, u, false, false);
    return __uint_as_float(rr[0]) + __uint_as_float(rr[1]);
}
__device__ __forceinline__ float sigm(float x) { return 1.f / (1.f + __expf(-x)); }
__device__ __forceinline__ float softplusf(float x) { return x > 20.f ? x : log1pf(__expf(x)); }

struct Args { const float* in[40]; float* out; unsigned char* ws; int ph_lo, ph_hi; };
typedef const __attribute__((address_space(4))) Args* KArgs;

constexpr float ATT_C2 = 0.125f * 1.4426950408889634f;
struct EpiG1 {
    static constexpr bool PERM = true, AFTER_DRAIN = false;
    const float* rs; bfu *aqkvz, *qb, *kb, *vb, *craw; float* ab; const float* rope; float *okp, *ovp, *oks, *ovs;
    __device__ __forceinline__ void operator()(const pg8::f32x4 (&acc)[2][2][4][2], const pg8::Unit& u, int wr, int wc, int fr, int fq) const {
        const int pn = u.pn; const int rowb = u.pm * 256 + wr * 64 + fr; const int cl = wc * 32 + 8 * fq;
#pragma unroll
        for (int ai = 0; ai < 2; ++ai)
#pragma unroll
            for (int m = 0; m < 4; ++m) {
                const int row = rowb + ai * 128 + m * 16;
                const float s = rsqrtf(rs[row] * (1.f / 1024.f) + 1e-6f);
                if (pn < 4 || (pn >= 10 && pn < 14)) {
                    bfu* dst = (pn < 4 ? aqkvz + pn * 256 : craw + (pn - 10) * 256) + (size_t)row * 1024 + cl;
#pragma unroll
                    for (int bj = 0; bj < 2; ++bj) { const pg8::f32x4 v0 = acc[ai][bj][m][0] * s, v1 = acc[ai][bj][m][1] * s;
                        v4u w; w.x = pg8::cvt_pk_bf16(v0[0], v0[1]); w.y = pg8::cvt_pk_bf16(v0[2], v0[3]); w.z = pg8::cvt_pk_bf16(v1[0], v1[1]); w.w = pg8::cvt_pk_bf16(v1[2], v1[3]); *(v4u*)(dst + bj * 128) = w; }
                } else if (pn < 8) {
                    const bool isk = pn >= 6;
                    const int pos = row < MP ? (row & 8191) : 2048 + ((row - MP) & 15);
                    const int i0 = (wc & 1) * 16 + 4 * fq;
                    const pg8::f32x4 c4 = *(const pg8::f32x4*)(rope + pos * 64 + i0), s4 = *(const pg8::f32x4*)(rope + pos * 64 + 32 + i0);
#pragma unroll
                    for (int bj = 0; bj < 2; ++bj) {
                        const pg8::f32x4 x1 = acc[ai][bj][m][0] * s, x2 = acc[ai][bj][m][1] * s;
                        pg8::f32x4 o1 = x1 * c4 - x2 * s4, o2 = x2 * c4 + x1 * s4;
                        if (!isk) {
                            o1 = o1 * ATT_C2; o2 = o2 * ATT_C2;
                            v4u w; w.x = pg8::cvt_pk_bf16(o1[0], o1[1]); w.y = pg8::cvt_pk_bf16(o1[2], o1[3]); w.z = pg8::cvt_pk_bf16(o2[0], o2[1]); w.w = pg8::cvt_pk_bf16(o2[2], o2[3]);
                            *(v4u*)(qb + (size_t)row * 512 + (pn - 4) * 256 + bj * 128 + cl) = w;
                        } else {
                            v4u w; w.x = pg8::cvt_pk_bf16(o1[0], o1[1]); w.y = pg8::cvt_pk_bf16(o1[2], o1[3]); w.z = pg8::cvt_pk_bf16(o2[0], o2[1]); w.w = pg8::cvt_pk_bf16(o2[2], o2[3]);
                            *(v4u*)(kb + (size_t)row * 512 + (pn - 6) * 256 + bj * 128 + cl) = w;
                            if (row < MR) {
                                float* ob = (row < MP ? okp + (size_t)row * 512 : oks + (size_t)(row - MP) * 512) + (pn - 6) * 256 + bj * 128 + (wc >> 1) * 64 + (wc & 1) * 16 + 4 * fq;
                                *(pg8::f32x4*)ob = o1; *(pg8::f32x4*)(ob + 32) = o2;
                            }
                        }
                    }
                } else if (pn < 10) {
#pragma unroll
                    for (int bj = 0; bj < 2; ++bj) {
                        const pg8::f32x4 v0 = acc[ai][bj][m][0] * s, v1 = acc[ai][bj][m][1] * s; const int col = (pn - 8) * 256 + bj * 128 + cl;
                        v4u w; w.x = pg8::cvt_pk_bf16(v0[0], v0[1]); w.y = pg8::cvt_pk_bf16(v0[2], v0[3]); w.z = pg8::cvt_pk_bf16(v1[0], v1[1]); w.w = pg8::cvt_pk_bf16(v1[2], v1[3]);
                        *(v4u*)(vb + (size_t)row * 512 + col) = w;
                        if (row < MR) { float* ob = (row < MP ? ovp + (size_t)row * 512 : ovs + (size_t)(row - MP) * 512) + col; *(pg8::f32x4*)ob = v0; *(pg8::f32x4*)(ob + 4) = v1; }
                    }
                } else {
                    if (wc == 0 && fq == 0) { const pg8::f32x4 v0 = acc[ai][0][m][0] * s, v1 = acc[ai][0][m][1] * s; *(pg8::f32x4*)(ab + (size_t)row * 8) = v0; *(pg8::f32x4*)(ab + (size_t)row * 8 + 4) = v1; }
                }
            }
    }
};
template <int MODE> struct EpiB {
    static constexpr bool PERM = true, AFTER_DRAIN = false;
    bfu* O; int ldc; const float* rs;
    __device__ __forceinline__ void operator()(const pg8::f32x4 (&acc)[2][2][4][2], const pg8::Unit& u, int wr, int wc, int fr, int fq) const {
        const int rowb = u.pm * 256 + wr * 64 + fr; const int cl = u.pn * 256 + wc * 32 + 8 * fq;
#pragma unroll
        for (int ai = 0; ai < 2; ++ai)
#pragma unroll
            for (int m = 0; m < 4; ++m) {
                const int row = rowb + ai * 128 + m * 16;
                float s = 1.f; if (MODE == 1) s = rsqrtf(rs[row] * (1.f / 1024.f) + 1e-6f);
                bfu* dst = O + (size_t)row * ldc + cl;
#pragma unroll
                for (int bj = 0; bj < 2; ++bj) {
                    pg8::f32x4 v0 = acc[ai][bj][m][0], v1 = acc[ai][bj][m][1];
                    if (MODE == 1) { v0 = v0 * s; v1 = v1 * s;
                        v0[0] = fmaxf(v0[0], 0.f); v0[1] = fmaxf(v0[1], 0.f); v0[2] = fmaxf(v0[2], 0.f); v0[3] = fmaxf(v0[3], 0.f); v1[0] = fmaxf(v1[0], 0.f); v1[1] = fmaxf(v1[1], 0.f); v1[2] = fmaxf(v1[2], 0.f); v1[3] = fmaxf(v1[3], 0.f);
                        v0 = v0 * v0; v1 = v1 * v1; }
                    v4u w; w.x = pg8::cvt_pk_bf16(v0[0], v0[1]); w.y = pg8::cvt_pk_bf16(v0[2], v0[3]); w.z = pg8::cvt_pk_bf16(v1[0], v1[1]); w.w = pg8::cvt_pk_bf16(v1[2], v1[3]);
                    *(v4u*)(dst + bj * 128) = w;
                }
            }
    }
};
template <int MODE> struct EpiH {
    static constexpr bool PERM = true, AFTER_DRAIN = false;
    float* H; bfu* xh; float* rsn; const float* rs; const bfu* pp;
    __device__ __forceinline__ void operator()(const pg8::f32x4 (&acc)[2][2][4][2], const pg8::Unit& u, int wr, int wc, int fr, int fq) const {
        const int rowb = u.pm * 256 + wr * 64 + fr; const int cl = u.pn * 256 + wc * 32 + 8 * fq;
#pragma unroll
        for (int ai = 0; ai < 2; ++ai)
#pragma unroll
            for (int m = 0; m < 4; ++m) {
                const int row = rowb + ai * 128 + m * 16; const bool valid = row < MR; float ss = 0.f;
                if (valid) {
                    float s = 1.f; if (MODE == 3) s = rsqrtf(rs[row] * (1.f / 1024.f) + 1e-6f);
#pragma unroll
                    for (int bj = 0; bj < 2; ++bj) {
                        const size_t off = (size_t)row * 1024 + cl + bj * 128;
                        pg8::f32x4 h0 = *(const pg8::f32x4*)(H + off), h1 = *(const pg8::f32x4*)(H + off + 4); const pg8::f32x4 a0 = acc[ai][bj][m][0], a1 = acc[ai][bj][m][1];
                        if (MODE == 3) { const v4u pw = *(const v4u*)(pp + off);
                            h0[0] += sigm(a0[0] * s) * __uint_as_float(pw.x << 16); h0[1] += sigm(a0[1] * s) * __uint_as_float(pw.x & 0xffff0000u);
                            h0[2] += sigm(a0[2] * s) * __uint_as_float(pw.y << 16); h0[3] += sigm(a0[3] * s) * __uint_as_float(pw.y & 0xffff0000u);
                            h1[0] += sigm(a1[0] * s) * __uint_as_float(pw.z << 16); h1[1] += sigm(a1[1] * s) * __uint_as_float(pw.z & 0xffff0000u);
                            h1[2] += sigm(a1[2] * s) * __uint_as_float(pw.w << 16); h1[3] += sigm(a1[3] * s) * __uint_as_float(pw.w & 0xffff0000u);
                        } else { h0 = h0 + a0; h1 = h1 + a1; }
                        *(pg8::f32x4*)(H + off) = h0; *(pg8::f32x4*)(H + off + 4) = h1;
                        v4u w; w.x = pg8::cvt_pk_bf16(h0[0], h0[1]); w.y = pg8::cvt_pk_bf16(h0[2], h0[3]); w.z = pg8::cvt_pk_bf16(h1[0], h1[1]); w.w = pg8::cvt_pk_bf16(h1[2], h1[3]); *(v4u*)(xh + off) = w;
                        ss += ((h0[0] * h0[0] + h0[1] * h0[1]) + (h0[2] * h0[2] + h0[3] * h0[3])) + ((h1[0] * h1[0] + h1[1] * h1[1]) + (h1[2] * h1[2] + h1[3] * h1[3]));
                    }
                }
                ss += __shfl_xor(ss, 16); ss += __shfl_xor(ss, 32);
                if (valid && fq == 0) unsafeAtomicAdd(rsn + row, ss);
            }
    }
};

__device__ __forceinline__ int win_src(int nd) {
    if (nd < 1024) return nd;
    if (nd < 2048) { const int c = nd - 1024, p = c & 63, grp = c >> 6; const int s = p >> 5, fq_ = (p >> 3) & 3, n_ = (p >> 2) & 1, j_ = p & 3; return 1032 + grp * 64 + n_ * 32 + s * 16 + 4 * fq_ + j_; }
    if (nd < 2560) return 2056 + (nd - 2048);
    if (nd < 3584) return 2568 + (nd - 2560);
    if (nd < 3592) return 1024 + (nd - 3584);
    return -1;
}
template <bool MAP> __device__ __forceinline__ void wt_item(const float* W, int K, int Nsrc, bfu* WT, const float* gain, LAS float* scr, int item, int nblk, int lane) {
    const int kb = item / nblk, nb = item % nblk, k0 = 64 * kb, n0 = 32 * nb;
    const int nd = n0 + (lane & 31); const int src = MAP ? win_src(nd) : nd;
#pragma unroll 8
    for (int i = 0; i < 32; ++i) { const int kk = 2 * i + (lane >> 5); float v = src >= 0 ? W[(size_t)(k0 + kk) * Nsrc + src] : 0.f; if (gain) v *= gain[k0 + kk]; scr[kk * 33 + (lane & 31)] = v; }
    LDS_WAIT(); asm volatile("" ::: "memory");
    const int c = lane & 7;
#pragma unroll
    for (int j = 0; j < 4; ++j) { const int n = (lane >> 3) + 8 * j; const LAS float* s = scr + (8 * c) * 33 + n;
        v4u o; o.x = pk2(s[0 * 33], s[1 * 33]); o.y = pk2(s[2 * 33], s[3 * 33]); o.z = pk2(s[4 * 33], s[5 * 33]); o.w = pk2(s[6 * 33], s[7 * 33]);
        *(v4u*)(WT + (size_t)(n0 + n) * K + k0 + 8 * c) = o; }
    LDS_WAIT(); asm volatile("" ::: "memory");
}
__device__ __forceinline__ void conv_weights(KArgs A, int l, int mask, LAS unsigned char* lds, int gw, int NGW, int lane, int wave) {
    LAS float* scr = (LAS float*)(lds + wave * 16384);
    unsigned char* wb = A->ws + WS_W;
    if (mask & 1) {
        const float* win = A->in[11] + (size_t)l * 1024 * 3592; const float* g = A->in[10] + l * 1024;
        for (int it = gw; it < 16 * 120; it += NGW) wt_item<true>(win, 1024, 3592, (bfu*)(wb + W_IN), g, scr, it, 120, lane);
        const float* wu = A->in[23] + (size_t)l * 64 * 256; const float* au = A->in[25] + (size_t)l * 64 * 256; const float* gu = A->in[26] + (size_t)l * 128 * 256;
        bfu* lr = (bfu*)(wb + W_LR);
        for (int i = gw * 64 + lane; i < 768 * 256; i += NGW * 64) { const int n = i >> 8, k = i & 255; float v = 0.f;
            if (n < 256) { if (k < 64) v = wu[k * 256 + n]; } else if (n < 512) { if (k >= 64 && k < 128) v = au[(k - 64) * 256 + (n - 256)]; } else { if (k >= 128) v = gu[(k - 128) * 256 + (n - 512)]; }
            lr[i] = (bfu)f2bf(v); }
    }
    if (mask & 2) {
        const float* wo = A->in[32] + (size_t)l * 1024 * 1024; const float* f1 = A->in[34] + (size_t)l * 1024 * 4096; const float* f2 = A->in[35] + (size_t)l * 4096 * 1024;
        const float* wg = A->in[37] + (size_t)l * 1024 * 1024; const float* wp = A->in[38] + (size_t)l * 256 * 1024;
        const float* gf = A->in[33] + l * 1024; const float* gp = A->in[36] + l * 1024;
        constexpr int I_O = 16 * 32, I_1 = 16 * 128, I_2 = 64 * 32, I_G = 16 * 32, I_P = 4 * 32;
        for (int it = gw; it < I_O + I_1 + I_2 + I_G + I_P; it += NGW) {
            int r = it;
            if (r < I_O) { wt_item<false>(wo, 1024, 1024, (bfu*)(wb + W_OUT), nullptr, scr, r, 32, lane); continue; } r -= I_O;
            if (r < I_1) { wt_item<false>(f1, 1024, 4096, (bfu*)(wb + W_FF1), gf, scr, r, 128, lane); continue; } r -= I_1;
            if (r < I_2) { wt_item<false>(f2, 4096, 1024, (bfu*)(wb + W_FF2), nullptr, scr, r, 32, lane); continue; } r -= I_2;
            if (r < I_G) { wt_item<false>(wg, 1024, 1024, (bfu*)(wb + W_GATE), gp, scr, r, 32, lane); continue; } r -= I_G;
            wt_item<false>(wp, 256, 1024, (bfu*)(wb + W_PP), nullptr, scr, r, 32, lane);
        }
    }
}
__device__ __forceinline__ void conv_p(KArgs A, int l, bfu* pb, int gtid, int NT) {
    const float* pp = A->in[8] + (size_t)l * MP * 256; const float* ps = A->in[9] + (size_t)l * MS * 256;
    for (int i = gtid; i < MR * 64; i += NT) { const int m = i >> 6, c = (i & 63) * 4;
        const f32x4 v = *(const f32x4*)(m < MP ? pp + (size_t)m * 256 + c : ps + (size_t)(m - MP) * 256 + c);
        v2u w; w.x = pk2(v[0], v[1]); w.y = pk2(v[2], v[3]); *(v2u*)(pb + (size_t)m * 256 + c) = w; }
}
__device__ __forceinline__ void prologue(KArgs A, LAS unsigned char* lds, int gw, int NGW, int lane, int wave, int gtid, int NT) {
    conv_weights(A, 0, 3, lds, gw, NGW, lane, wave);
    unsigned char* ws = A->ws;
    float* rs = (float*)(ws + WS_RS); bfu* xh = (bfu*)slotp(ws, 0, 0); float* H = A->out;
    for (int i = gtid; i < 6 * MPAD; i += NT) rs[MPAD + i] = 0.f;
    for (int m = gw; m < MPAD; m += NGW) {
        if (m < MR) {
            const float* xr = m < MP ? A->in[0] + (size_t)m * 1024 : A->in[1] + (size_t)(m - MP) * 1024; float ss = 0.f;
#pragma unroll
            for (int j = 0; j < 4; ++j) { const f32x4 v = *(const f32x4*)(xr + j * 256 + lane * 4); *(f32x4*)(H + (size_t)m * 1024 + j * 256 + lane * 4) = v;
                v2u w; w.x = pk2(v[0], v[1]); w.y = pk2(v[2], v[3]); *(v2u*)(xh + (size_t)m * 1024 + j * 256 + lane * 4) = w; ss += (v[0] * v[0] + v[1] * v[1]) + (v[2] * v[2] + v[3] * v[3]); }
            ss = wave_sum(ss); if (lane == 0) rs[m] = ss;
        } else {
#pragma unroll
            for (int j = 0; j < 4; ++j) *(v2u*)(xh + (size_t)m * 1024 + j * 256 + lane * 4) = (v2u){0u, 0u};
            if (lane == 0) rs[m] = 1024.f;
        }
    }
    float* rope = (float*)(ws + WS_ROPE);
    for (int i = gtid; i < 8192 * 32; i += NT) { const int pos = i >> 5, k = i & 31;
        const float inv = exp2f(-(float)k * (13.287712379549449f / 32.0f)); const float ang = (float)pos * inv;
        const float nn = rintf(ang * 0.15915494309189535f); const float fr = fmaf(-nn, 1.9353071795864769e-3f, fmaf(-nn, 6.28125f, ang));
        rope[pos * 64 + k] = __cosf(fr); rope[pos * 64 + 32 + k] = __sinf(fr); }
    if (gw == 0) {
        for (int l = 0; l < 2; ++l) {
            const float a = wave_sum(A->in[16][l * 64 + lane] * A->in[17][l * 64 + lane]), b = wave_sum(A->in[18][l * 64 + lane] * A->in[19][l * 64 + lane]);
            const float li = 0.8f - 0.6f * expf(-0.3f * (float)l);
            if (lane == 0) { float* lf = (float*)(ws + WS_CTL + 1024); lf[2 * l] = expf(a) - expf(b) + li; lf[2 * l + 1] = li; }
        }
    }
}

__device__ __forceinline__ void prep_a(KArgs A, int l, int gw, int NGW, int lane) {
    unsigned char* ws = A->ws;
    const bfu* aq = (const bfu*)slotp(ws, l, 2); const float* ab = (const float*)(ws + WS_AB);
    float* sia = (float*)slotp(ws, l, 9); bfu* va = (bfu*)slotp(ws, l, 11); bfu* zs = (bfu*)slotph(ws, l, 11); float* gab = (float*)(ws + WS_GAB);
    const float* cw = A->in[12] + l * 4 * 768; const float* stc = A->in[4] + (size_t)l * 8 * 3 * 768;
    const float* anorm = A->in[15] + l * 64;
    for (int m = gw; m < MR; m += NGW) {
        int t, L, sb = 0; const bool smp = m >= MP; float* aco;
        if (!smp) { t = m & 8191; L = 8192; aco = A->out + O_ACP + ((size_t)(l * 8 + (m >> 13)) * 3) * 768; }
        else { sb = (m - MP) >> 4; t = (m - MP) & 15; L = 16; aco = A->out + O_ACS + ((size_t)(l * 8 + sb) * 3) * 768; }
#pragma unroll 1
        for (int h = 0; h < 4; ++h) {
            float val[3];
#pragma unroll
            for (int g = 0; g < 3; ++g) {
                const int c = g * 256 + h * 64 + lane; float x[4];
#pragma unroll
                for (int d = 0; d < 4; ++d) { const int tt = t - d;
                    x[d] = tt >= 0 ? bf2f(aq[(size_t)(m - d) * 1024 + c]) : (smp ? stc[((size_t)sb * 3 + (3 + tt)) * 768 + c] : 0.f); }
                const float y = x[3] * cw[c] + x[2] * cw[768 + c] + x[1] * cw[1536 + c] + x[0] * cw[2304 + c];
                val[g] = y * sigm(y);
                if (t >= L - 3) aco[(size_t)(t - (L - 3)) * 768 + c] = x[0];
            }
            const float sq = wave_sum(val[0] * val[0]), sk = wave_sum(val[1] * val[1]);
            const float qn = val[0] * rsqrtf(sq + 1e-6f) * 0.125f, kn = val[1] * rsqrtf(sk + 1e-6f);
            float* rec = sia + ((size_t)(h * 8 + (lane >> 3)) * MPAD + m) * 16 + (lane & 7);
            rec[0] = kn; rec[8] = qn;
            va[(size_t)m * 256 + h * 64 + lane] = (bfu)f2bf(val[2]);
            const float z = bf2f(aq[(size_t)m * 1024 + 768 + h * 64 + lane]);
            zs[(size_t)m * 256 + h * 64 + lane] = (bfu)f2bf(z * sigm(z) * anorm[lane]);
        }
        if (lane < 4) { const int h = lane;
            const float g = -__expf(A->in[13][l * 4 + h]) * softplusf(ab[(size_t)m * 8 + h] + A->in[14][l * 4 + h]);
            gab[((size_t)h * MPAD + m) * 2] = __expf(g); gab[((size_t)h * MPAD + m) * 2 + 1] = sigm(ab[(size_t)m * 8 + 4 + h]); }
    }
}
__device__ __forceinline__ void prep_c1(KArgs A, int l, int gw, int NGW, int lane) {
    unsigned char* ws = A->ws;
    const bfu* cr = (const bfu*)slotp(ws, l, 7); bfu* lra = (bfu*)slotp(ws, l, 12);
    const float* mu = A->in[21] + l * 1024; const float* sts = A->in[6] + (size_t)l * 8 * 1024;
    for (int m = gw; m < MR; m += NGW) {
        int t, L, sb = 0; const bool smp = m >= MP; float* cso;
        if (!smp) { t = m & 8191; L = 8192; cso = A->out + O_CSP + (size_t)(l * 8 + (m >> 13)) * 1024; }
        else { sb = (m - MP) >> 4; t = (m - MP) & 15; L = 16; cso = A->out + O_CSS + (size_t)(l * 8 + sb) * 1024; }
#pragma unroll
        for (int i = 0; i < 4; ++i) { const int j = 768 + lane + 64 * i;
            const float cur = bf2f(cr[(size_t)m * 1024 + j]);
            const float prev = t > 0 ? bf2f(cr[(size_t)(m - 1) * 1024 + j]) : (smp ? sts[(size_t)sb * 1024 + j] : 0.f);
            const float c = cur + (prev - cur) * mu[j];
            const float o = i == 0 ? tanhf(c) : (i == 1 ? c : sigm(c));
            lra[(size_t)m * 256 + lane + 64 * i] = (bfu)f2bf(o); }
        if (t == L - 1) {
#pragma unroll
            for (int i = 0; i < 16; ++i) cso[lane + 64 * i] = bf2f(cr[(size_t)m * 1024 + lane + 64 * i]);
        }
    }
}
__device__ __forceinline__ void prep_c2(KArgs A, int l, int bid, int G, int tid) {
    unsigned char* ws = A->ws;
    const bfu* cr = (const bfu*)slotp(ws, l, 7); const bfu* lro = (const bfu*)slotp(ws, l, 13);
    bfu* v2 = (bfu*)slotp(ws, l, 12); bfu* gg = (bfu*)slotph(ws, l, 12);
    float* bonus = (float*)(ws + WS_BONUS); float* gch = (float*)(ws + WS_GCH); float* pairc = (float*)(ws + WS_PAIRC);
    const float* mu = A->in[21] + l * 1024; const float* sts = A->in[6] + (size_t)l * 8 * 1024;
    const int ch = tid & 255, h = ch >> 6, lane = ch & 63, half = tid >> 8;
    float* sic = (float*)slotp(ws, l, h) + ((size_t)(lane >> 3) * MPAD) * 32 + (lane & 7);
    const float mur = mu[ch], muk = mu[256 + ch], muv = mu[512 + ch];
    const float w0 = A->in[22][l * 256 + ch], a0 = A->in[24][l * 256 + ch], kk_ = A->in[27][l * 256 + ch], ka = A->in[28][l * 256 + ch], rk = A->in[29][l * 256 + ch];
    for (int u = bid * 2 + half; u < 1032; u += G * 2) {
        int m0, n; float pr, pk, pv;
        if (u < 1024) { m0 = u * 64; n = 64;
            if ((u & 127) == 0) { pr = pk = pv = 0.f; } else { pr = bf2f(cr[(size_t)(m0 - 1) * 1024 + ch]); pk = bf2f(cr[(size_t)(m0 - 1) * 1024 + 256 + ch]); pv = bf2f(cr[(size_t)(m0 - 1) * 1024 + 512 + ch]); } }
        else { const int sb = u - 1024; m0 = MP + sb * 16; n = 16; pr = sts[(size_t)sb * 1024 + ch]; pk = sts[(size_t)sb * 1024 + 256 + ch]; pv = sts[(size_t)sb * 1024 + 512 + ch]; }
        float cum = 0.f, pkka = 0.f, pkp = 0.f;
#pragma unroll 4
        for (int tt = 0; tt < n; ++tt) { const int m = m0 + tt;
            const float c_r = bf2f(cr[(size_t)m * 1024 + ch]), c_k = bf2f(cr[(size_t)m * 1024 + 256 + ch]), c_v = bf2f(cr[(size_t)m * 1024 + 512 + ch]);
            const float r = c_r + (pr - c_r) * mur, k = c_k + (pk - c_k) * muk, v = c_v + (pv - c_v) * muv; pr = c_r; pk = c_k; pv = c_v;
            const float lw = bf2f(lro[(size_t)m * 768 + ch]), la = bf2f(lro[(size_t)m * 768 + 256 + ch]); const bfu gb = lro[(size_t)m * 768 + 512 + ch];
            const float wl = -0.6065306597126334f * sigm(w0 + lw); const float a = sigm(a0 + la);
            const float kkr = k * kk_; const float kk = kkr * rsqrtf(wave_sum(kkr * kkr) + 1e-6f);
            const float kp = k * (1.f + (a - 1.f) * ka);
            const float Gp = __expf(cum); cum += wl; const float Gc = __expf(cum), iG = __expf(-cum);
            float* rec = sic + (size_t)m * 32;
            rec[0] = kk * Gp; rec[8] = kk * a * iG; rec[16] = kp * iG; rec[24] = r * Gc;
            { const float kka = kk * a; float* pc = pairc + ((size_t)h * (MPAD / 2) + (m >> 1)) * 4;
              if (tt & 1) { const float c22 = wave_sum(pkka * kk), c32 = wave_sum(pkp * kk); if (lane == 0) { pc[0] = c22; pc[1] = c32; } }
              else { const float c24 = wave_sum(kka * r), c34 = wave_sum(kp * r); if (lane == 0) { pc[2] = c24; pc[3] = c34; } }
              pkka = kka; pkp = kp; }
            const float bo = wave_sum(r * kp * rk); if (lane == 0) bonus[(size_t)h * MPAD + m] = bo;
            v2[(size_t)m * 256 + ch] = (bfu)f2bf(v); gg[(size_t)m * 256 + ch] = gb;
        }
        gch[((size_t)h * 1032 + u) * 64 + lane] = __expf(cum);
    }
}
__device__ __forceinline__ void prep_a2(KArgs A, int l, int gw, int NGW, int lane) {
    unsigned char* ws = A->ws; const float* sia = (const float*)slotp(ws, l, 9); float* paird = (float*)(ws + WS_PAIRD);
    for (int task = gw; task < 4 * (MR / 2); task += NGW) { const int h = task & 3, pr = task >> 2, m = 2 * pr;
        const float* rec = sia + ((size_t)(h * 8 + (lane >> 3)) * MPAD + m) * 16 + (lane & 7);
        const float k1 = rec[0], q1 = rec[8], k2 = rec[16];
        const float g12 = wave_sum(k1 * k2), h11 = wave_sum(q1 * k1);
        if (lane == 0) { paird[((size_t)h * (MPAD / 2) + pr) * 2] = g12; paird[((size_t)h * (MPAD / 2) + pr) * 2 + 1] = h11; } }
}
__device__ __forceinline__ void post_attn(KArgs A, int l, int gw, int NGW, int lane) {
    unsigned char* ws = A->ws;
    const bfu* O = (const bfu*)slotp(ws, l, 13); bfu* mix = (bfu*)slotp(ws, l, 7);
    const float* lf = (const float*)(ws + WS_CTL + 1024); const float lam = lf[2 * l], omli = 1.f - lf[2 * l + 1];
    const int h = lane >> 4, e0 = (lane & 15) * 8; const float* bn = A->in[20] + l * 128 + e0;
    float bnv[8];
#pragma unroll
    for (int i = 0; i < 8; ++i) bnv[i] = bn[i] * omli;
    for (int m = gw; m < MP; m += NGW) {
        const v4u a = *(const v4u*)(O + (size_t)m * 1024 + (4 * h + (e0 >> 6)) * 64 + (e0 & 63));
        const v4u b = *(const v4u*)(O + (size_t)m * 1024 + (4 * h + 2 + (e0 >> 6)) * 64 + (e0 & 63));
        float o[8]; float ss = 0.f;
#pragma unroll
        for (int i = 0; i < 4; ++i) { const unsigned aw = a[i], bw = b[i];
            o[2 * i] = __uint_as_float(aw << 16) - lam * __uint_as_float(bw << 16); o[2 * i + 1] = __uint_as_float(aw & 0xffff0000u) - lam * __uint_as_float(bw & 0xffff0000u);
            ss += o[2 * i] * o[2 * i] + o[2 * i + 1] * o[2 * i + 1]; }
        ss += __shfl_xor(ss, 1); ss += __shfl_xor(ss, 2); ss += __shfl_xor(ss, 4); ss += __shfl_xor(ss, 8);
        const float rn = rsqrtf(ss * (1.f / 128.f) + 1e-6f);
        v4u w; w.x = pk2(o[0] * rn * bnv[0], o[1] * rn * bnv[1]); w.y = pk2(o[2] * rn * bnv[2], o[3] * rn * bnv[3]); w.z = pk2(o[4] * rn * bnv[4], o[5] * rn * bnv[5]); w.w = pk2(o[6] * rn * bnv[6], o[7] * rn * bnv[7]);
        *(v4u*)(mix + (size_t)m * 1024 + 256 + h * 128 + e0) = w;
    }
}
__device__ __forceinline__ void post_scan(KArgs A, int l, int gw, int NGW, int lane) {
    unsigned char* ws = A->ws; bfu* mix = (bfu*)slotp(ws, l, 7);
    const bfu* zs = (const bfu*)slotph(ws, l, 11); const bfu* v2 = (const bfu*)slotp(ws, l, 12); const bfu* gg = (const bfu*)slotph(ws, l, 12);
    const float* bonus = (const float*)(ws + WS_BONUS);
    for (int m = gw; m < MR; m += NGW) {
#pragma unroll
        for (int h = 0; h < 4; ++h) {
            bfu* pa = mix + (size_t)m * 1024 + h * 64 + lane; const float o = bf2f(*pa);
            const float ss = wave_sum(o * o) * (1.f / 64.f);
            *pa = (bfu)f2bf(o * rsqrtf(ss + 1e-6f) * bf2f(zs[(size_t)m * 256 + h * 64 + lane]));
            bfu* pc = mix + (size_t)m * 1024 + 768 + h * 64 + lane; const float y = bf2f(*pc);
            const float mu = wave_sum(y) * (1.f / 64.f); const float d = y - mu; const float var = wave_sum(d * d) * (1.f / 64.f);
            const float cy = d * rsqrtf(var + 64e-5f) * A->in[30][l * 256 + h * 64 + lane] + A->in[31][l * 256 + h * 64 + lane];
            *pc = (bfu)f2bf((cy + bonus[(size_t)h * MPAD + m] * bf2f(v2[(size_t)m * 256 + h * 64 + lane])) * bf2f(gg[(size_t)m * 256 + h * 64 + lane]));
        }
    }
}
__device__ __forceinline__ void final_norm(KArgs A, int gw, int NGW, int lane) {
    const float* rs = (const float*)(A->ws + WS_RS) + 6 * (size_t)MPAD; const float* g = A->in[39];
    for (int m = gw; m < MR; m += NGW) { const float s = rsqrtf(rs[m] * (1.f / 1024.f) + 1e-6f);
#pragma unroll
        for (int j = 0; j < 4; ++j) { float* p = A->out + (size_t)m * 1024 + j * 256 + lane * 4; f32x4 v = *(f32x4*)p; const f32x4 gv = *(const f32x4*)(g + j * 256 + lane * 4); v = v * s * gv; *(f32x4*)p = v; } }
}

#define SC_BAR() asm volatile("s_waitcnt lgkmcnt(0)\n\ts_barrier" ::: "memory")
constexpr int SC_RED = 0, SC_SI = 16384, SC_VBUF = 81920, SC_GBUF = 90112, SC_BON = 98304, SC_PC = 98816, SC_YP = 99328;
#define FMAC_DPP(acc, op, s1, J) asm("v_fmac_f32_dpp %0, %1, %2 row_newbcast:" #J " row_mask:0xf bank_mask:0xf" : "+v"(acc) : "v"(op), "v"(s1))
#define DOT8(a0, a1, op, JB0, JB1, JB2, JB3, JB4, JB5, JB6, JB7) do { FMAC_DPP(a0, op, S[0], JB0); FMAC_DPP(a1, op, S[1], JB1); FMAC_DPP(a0, op, S[2], JB2); FMAC_DPP(a1, op, S[3], JB3); \
        FMAC_DPP(a0, op, S[4], JB4); FMAC_DPP(a1, op, S[5], JB5); FMAC_DPP(a0, op, S[6], JB6); FMAC_DPP(a1, op, S[7], JB7); } while (0)
#define DOT8_LO(a0, a1, op) DOT8(a0, a1, op, 0, 1, 2, 3, 4, 5, 6, 7)
#define DOT8_HI(a0, a1, op) DOT8(a0, a1, op, 8, 9, 10, 11, 12, 13, 14, 15)
#define AXPY8_LO(op, s) do { FMAC_DPP(S[0], op, s, 0); FMAC_DPP(S[1], op, s, 1); FMAC_DPP(S[2], op, s, 2); FMAC_DPP(S[3], op, s, 3); FMAC_DPP(S[4], op, s, 4); FMAC_DPP(S[5], op, s, 5); FMAC_DPP(S[6], op, s, 6); FMAC_DPP(S[7], op, s, 7); } while (0)
#define AXPY8_HI(op, s) do { FMAC_DPP(S[0], op, s, 8); FMAC_DPP(S[1], op, s, 9); FMAC_DPP(S[2], op, s, 10); FMAC_DPP(S[3], op, s, 11); FMAC_DPP(S[4], op, s, 12); FMAC_DPP(S[5], op, s, 13); FMAC_DPP(S[6], op, s, 14); FMAC_DPP(S[7], op, s, 15); } while (0)
#define PKF(a, b, c) __builtin_elementwise_fma((a), (b), (c))
#define AXPYV(X0, X1, s) do { const f32x2 s_ = (f32x2){(s), (s)}; f32x2 p0_ = (f32x2){S[0], S[1]}, p1_ = (f32x2){S[2], S[3]}, p2_ = (f32x2){S[4], S[5]}, p3_ = (f32x2){S[6], S[7]}; \
        p0_ = PKF(((f32x2){X0[0], X0[1]}), s_, p0_); p1_ = PKF(((f32x2){X0[2], X0[3]}), s_, p1_); p2_ = PKF(((f32x2){X1[0], X1[1]}), s_, p2_); p3_ = PKF(((f32x2){X1[2], X1[3]}), s_, p3_); \
        S[0] = p0_[0]; S[1] = p0_[1]; S[2] = p1_[0]; S[3] = p1_[1]; S[4] = p2_[0]; S[5] = p2_[1]; S[6] = p3_[0]; S[7] = p3_[1]; } while (0)
#define RED8(V) do { const LAS f32x4* rr_ = (const LAS f32x4*)red + par_ * 512 + lane; const f32x4 q0_ = rr_[0], q1_ = rr_[64], q2_ = rr_[128], q3_ = rr_[192], q4_ = rr_[256], q5_ = rr_[320], q6_ = rr_[384], q7_ = rr_[448]; \
        V = ((q0_ + q1_) + (q2_ + q3_)) + ((q4_ + q5_) + (q6_ + q7_)); } while (0)

#define SWAPSUM(v) do { const unsigned u_ = __float_as_uint(v); auto rr_ = __builtin_amdgcn_permlane32_swap(u_, u_, false, false); v = __uint_as_float(rr_[0]) + __uint_as_float(rr_[1]); } while (0)
#define DOT4_LO(a0, a1, op) do { FMAC_DPP(a0, op, S[0], 0); FMAC_DPP(a1, op, S[1], 1); FMAC_DPP(a0, op, S[2], 2); FMAC_DPP(a1, op, S[3], 3); } while (0)
#define DOT4_HI(a0, a1, op) do { FMAC_DPP(a0, op, S[0], 4); FMAC_DPP(a1, op, S[1], 5); FMAC_DPP(a0, op, S[2], 6); FMAC_DPP(a1, op, S[3], 7); } while (0)
#define AXPY4(X, s) do { const f32x2 s_ = (f32x2){(s), (s)}; f32x2 p0_ = (f32x2){S[0], S[1]}, p1_ = (f32x2){S[2], S[3]}; p0_ = PKF(((f32x2){X[0], X[1]}), s_, p0_); p1_ = PKF(((f32x2){X[2], X[3]}), s_, p1_); S[0] = p0_[0]; S[1] = p0_[1]; S[2] = p1_[0]; S[3] = p1_[1]; } while (0)
__device__ __forceinline__ void scan_rwkv(KArgs A, int l, LAS unsigned char* lds, int h, int half, int m0, int L, int BL, int BLS, int chunk0, const float* st_in, float* st_out, int tid) {
    unsigned char* ws = A->ws;
    const int lane = tid & 63, wid = __builtin_amdgcn_readfirstlane(tid >> 6); const int kh = lane >> 5, r = lane & 31, row = 32 * half + r;
    LAS float* red = (LAS float*)(lds + SC_RED); LAS float* yred = (LAS float*)(lds + SC_YP);
    LAS float* sib = (LAS float*)(lds + SC_SI) + wid * 1024;
    LAS bfu* vbuf = (LAS bfu*)(lds + SC_VBUF); LAS float* pcs = (LAS float*)(lds + SC_PC);
    const bfu* v2 = (const bfu*)slotp(ws, l, 12);
    const float* pairc = (const float*)(ws + WS_PAIRC) + ((size_t)h * (MPAD / 2) + (m0 >> 1)) * 4;
    const float* gch = (const float*)(ws + WS_GCH) + ((size_t)h * 1032 + chunk0) * 64 + 8 * wid + 4 * kh;
    bfu* mix = (bfu*)slotp(ws, l, 7);
    const float* P = (const float*)slotp(ws, l, h) + ((size_t)wid * MPAD + m0) * 32;
    float S[4];
#pragma unroll
    for (int j = 0; j < 4; ++j) S[j] = st_in ? st_in[row * 64 + 8 * wid + 4 * kh + j] : 0.f;
    const int nblk = L >> BLS; const int srow = tid >> 4, sc4 = tid & 15; const bool sval = srow < BL;
    const int nsi = BL >> 3;
    f32x4 ssi[4]; v2u sv = {0, 0}; float sp_ = 0.f;
#define RW_STAGE(c) do { const float* ps_ = P + (size_t)(c) * BL * 32 + lane * 4; \
        _Pragma("unroll") for (int i_ = 0; i_ < 4; ++i_) if (i_ < nsi) ssi[i_] = *(const f32x4*)(ps_ + i_ * 256); \
        if (sval) { const size_t mm = (size_t)(m0 + (c) * BL + srow) * 256 + h * 64 + sc4 * 4; sv = *(const v2u*)(v2 + mm); } \
        if (tid < 2 * BL) sp_ = pairc[(size_t)(c) * BL * 2 + tid]; } while (0)
#define RW_COMMIT(c) do { LAS float* pd_ = sib + ((c) & 1) * 8192 + lane * 4; \
        _Pragma("unroll") for (int i_ = 0; i_ < 4; ++i_) if (i_ < nsi) *(LAS f32x4*)(pd_ + i_ * 256) = ssi[i_]; \
        if (sval) { *(LAS v2u*)(vbuf + ((c) & 1) * 2048 + srow * 64 + sc4 * 4) = sv; } \
        if (tid < 2 * BL) pcs[((c) & 1) * 64 + tid] = sp_; } while (0)
    __syncthreads();
    RW_STAGE(0); RW_COMMIT(0); if (nblk > 1) RW_STAGE(1);
    const int dsel = ((lane & 4) ? 24 : 0) + 4 * kh + (lane & 3);
    float ca0, ca1, cb0 = 0.f, cb1 = 0.f; f32x4 cau[4], cbu[4];
#define RW_LOADOPS(D, T) do { const LAS float* pb_ = sib + ((((T) >> BLS) & 1) * 8192) + ((T) & (BL - 1)) * 32; \
        D##0 = pb_[dsel]; D##1 = pb_[32 + dsel]; const LAS f32x4* pu_ = (const LAS f32x4*)(pb_ + 4 * kh); \
        D##u[0] = pu_[2]; D##u[1] = pu_[4]; D##u[2] = pu_[10]; D##u[3] = pu_[12]; } while (0)
    RW_LOADOPS(ca, 0);
#define RW_FINAL(T) do { const int tf_ = (T); \
        const LAS float* yr_ = yred + (tf_ & 15) * 512 + lane; const float y_ = ((yr_[0] + yr_[64]) + (yr_[128] + yr_[192])) + ((yr_[256] + yr_[320]) + (yr_[384] + yr_[448])); \
        if (lane < 32) mix[(size_t)(m0 + tf_) * 1024 + 768 + h * 64 + row] = (bfu)f2bf(y_); } while (0)
#define RW_ROUND(C, N, T) do { const int par_ = ((T) >> 1) & 1; \
        float d1a = 0.f, d1b = 0.f, d2a = 0.f, d2b = 0.f, f1a = 0.f, f1b = 0.f; \
        DOT4_LO(d1a, d1b, C##0); DOT4_LO(d2a, d2b, C##1); DOT4_HI(f1a, f1b, C##0); \
        float d1 = d1a + d1b, d2 = d2a + d2b, f1 = f1a + f1b; SWAPSUM(d1); SWAPSUM(d2); SWAPSUM(f1); \
        ((LAS f32x4*)red)[(par_ * 8 + wid) * 64 + lane] = (f32x4){d1, d2, f1, 0.f}; \
        SC_BAR(); \
        f32x4 tot_; RED8(tot_); \
        const int bo_ = (((T) >> BLS) & 1), to_ = (T) & (BL - 1); \
        const float v1 = bf2f(vbuf[bo_ * 2048 + to_ * 64 + row]), v2_ = bf2f(vbuf[bo_ * 2048 + to_ * 64 + 64 + row]); const f32x4 pc_ = *(const LAS f32x4*)(pcs + bo_ * 64 + to_ * 2); \
        asm volatile("" ::: "memory"); \
        if ((T) + 2 < L) RW_LOADOPS(N, (T) + 2); \
        __builtin_amdgcn_sched_barrier(0); \
        const float sa1 = -tot_[0]; const float sa2 = -(tot_[1] + sa1 * pc_[0] + v1 * pc_[1]); const float y1 = tot_[2] + sa1 * pc_[2] + v1 * pc_[3]; \
        AXPY4(C##u[1], v1); AXPY4(C##u[0], sa1); AXPY4(C##u[3], v2_); AXPY4(C##u[2], sa2); \
        float y2a = 0.f, y2b = 0.f; DOT4_HI(y2a, y2b, C##1); float y2 = y2a + y2b; SWAPSUM(y2); \
        yred[((T) & 15) * 512 + wid * 64 + lane] = y1 * 0.125f; yred[(((T) + 1) & 15) * 512 + wid * 64 + lane] = y2; } while (0)
    for (int c = 0; c < nblk; ++c) {
        for (int tt = 0; tt < BL; tt += 4) {
            const int t = c * BL + tt;
            if (tt == (BL >> 1) && c + 1 < nblk) { RW_COMMIT(c + 1); if (c + 2 < nblk) RW_STAGE(c + 2); }
            RW_ROUND(ca, cb, t);
            RW_ROUND(cb, ca, t + 2);
            if (((t + 3) & 15) == 15) { SC_BAR(); RW_FINAL(t - 12 + 2 * wid); RW_FINAL(t - 11 + 2 * wid); }
        }
        if ((((c + 1) << BLS) & 63) == 0 || c + 1 == nblk) {
            const float* ge = gch + (size_t)((c << BLS) >> 6) * 64;
#pragma unroll
            for (int j = 0; j < 4; ++j) S[j] *= ge[j];
        }
    }
#pragma unroll
    for (int j = 0; j < 4; ++j) st_out[row * 64 + 8 * wid + 4 * kh + j] = S[j];
    __syncthreads();
#undef RW_STAGE
#undef RW_COMMIT
#undef RW_LOADOPS
#undef RW_FINAL
#undef RW_ROUND
}

__device__ __forceinline__ void scan_delta(KArgs A, int l, LAS unsigned char* lds, int h, int half, int m0, int L, int BL, int BLS, const float* st_in, float* st_out, int tid) {
    unsigned char* ws = A->ws;
    const int lane = tid & 63, wid = __builtin_amdgcn_readfirstlane(tid >> 6); const int kh = lane >> 5, r = lane & 31, row = 32 * half + r;
    LAS float* red = (LAS float*)(lds + SC_RED); LAS float* yred = (LAS float*)(lds + SC_YP);
    LAS float* sib = (LAS float*)(lds + SC_SI) + wid * 512;
    LAS bfu* vbuf = (LAS bfu*)(lds + SC_VBUF); LAS float* gab = (LAS float*)(lds + SC_BON); LAS float* pds = (LAS float*)(lds + SC_PC);
    const bfu* va = (const bfu*)slotp(ws, l, 11);
    bfu* mix = (bfu*)slotp(ws, l, 7);
    const float* P = (const float*)slotp(ws, l, 9) + ((size_t)(h * 8 + wid) * MPAD + m0) * 16;
    const float* PG = (const float*)(ws + WS_GAB) + ((size_t)h * MPAD + m0) * 2;
    const float* paird = (const float*)(ws + WS_PAIRD) + ((size_t)h * (MPAD / 2) + (m0 >> 1)) * 2;
    float S[4];
#pragma unroll
    for (int j = 0; j < 4; ++j) S[j] = st_in ? st_in[(8 * wid + 4 * kh + j) * 64 + row] : 0.f;
    const int nblk = L >> BLS; const int srow = tid >> 4, sc4 = tid & 15; const bool sval = srow < BL;
    const int nsi = BL >> 4;
    f32x4 ssi[2]; v2u sv = {0, 0}; float sb_ = 0.f, sp_ = 0.f;
#define DL_STAGE(c) do { const float* ps_ = P + (size_t)(c) * BL * 16 + lane * 4; \
        _Pragma("unroll") for (int i_ = 0; i_ < 2; ++i_) if (i_ < nsi) ssi[i_] = *(const f32x4*)(ps_ + i_ * 256); \
        if (sval) { const size_t mm = (size_t)(m0 + (c) * BL + srow) * 256 + h * 64 + sc4 * 4; sv = *(const v2u*)(va + mm); } \
        if (tid < 2 * BL) sb_ = PG[(size_t)(c) * BL * 2 + tid]; if (tid < BL) sp_ = paird[(size_t)(c) * BL + tid]; } while (0)
#define DL_COMMIT(c) do { LAS float* pd_ = sib + ((c) & 1) * 4096 + lane * 4; \
        _Pragma("unroll") for (int i_ = 0; i_ < 2; ++i_) if (i_ < nsi) *(LAS f32x4*)(pd_ + i_ * 256) = ssi[i_]; \
        if (sval) { *(LAS v2u*)(vbuf + ((c) & 1) * 2048 + srow * 64 + sc4 * 4) = sv; } \
        if (tid < 2 * BL) gab[((c) & 1) * 64 + tid] = sb_; if (tid < BL) pds[((c) & 1) * 32 + tid] = sp_; } while (0)
    __syncthreads();
    DL_STAGE(0); DL_COMMIT(0); if (nblk > 1) DL_STAGE(1);
    const int dsel = ((lane & 4) ? 8 : 0) + 4 * kh + (lane & 3);
    float ca0, ca1, cb0 = 0.f, cb1 = 0.f; f32x4 cau[2], cbu[2];
#define DL_LOADOPS(D, T) do { const LAS float* pb_ = sib + ((((T) >> BLS) & 1) * 4096) + ((T) & (BL - 1)) * 16; D##0 = pb_[dsel]; D##1 = pb_[16 + dsel]; \
        const LAS f32x4* pu_ = (const LAS f32x4*)(pb_ + 4 * kh); D##u[0] = pu_[0]; D##u[1] = pu_[4]; } while (0)
    DL_LOADOPS(ca, 0);
#define DL_FINAL(T) do { const int tf_ = (T); \
        const LAS float* yr_ = yred + (tf_ & 15) * 512 + lane; const float o_ = ((yr_[0] + yr_[64]) + (yr_[128] + yr_[192])) + ((yr_[256] + yr_[320]) + (yr_[384] + yr_[448])); \
        if (lane < 32) mix[(size_t)(m0 + tf_) * 1024 + h * 64 + row] = (bfu)f2bf(o_); } while (0)
#define DL_ROUND(C, N, T) do { const int par_ = ((T) >> 1) & 1; \
        float d1a = 0.f, d1b = 0.f, d2a = 0.f, d2b = 0.f, f1a = 0.f, f1b = 0.f; \
        DOT4_LO(d1a, d1b, C##0); DOT4_LO(d2a, d2b, C##1); DOT4_HI(f1a, f1b, C##0); \
        float d1 = d1a + d1b, d2 = d2a + d2b, f1 = f1a + f1b; SWAPSUM(d1); SWAPSUM(d2); SWAPSUM(f1); \
        ((LAS f32x4*)red)[(par_ * 8 + wid) * 64 + lane] = (f32x4){d1, d2, f1, 0.f}; \
        SC_BAR(); \
        f32x4 tot_; RED8(tot_); \
        const int bo_ = (((T) >> BLS) & 1), to_ = (T) & (BL - 1); \
        const float v1 = bf2f(vbuf[bo_ * 2048 + to_ * 64 + row]), v2_ = bf2f(vbuf[bo_ * 2048 + to_ * 64 + 64 + row]); \
        const f32x4 ab_ = *(const LAS f32x4*)(gab + bo_ * 64 + to_ * 2); const f32x2 pd2_ = *(const LAS f32x2*)(pds + bo_ * 32 + to_); \
        asm volatile("" ::: "memory"); \
        if ((T) + 2 < L) DL_LOADOPS(N, (T) + 2); \
        __builtin_amdgcn_sched_barrier(0); \
        const float a1 = ab_[0], a2 = ab_[2]; const float dl1 = ab_[1] * (v1 - a1 * tot_[0]); const float dl2 = ab_[3] * (v2_ - a2 * (a1 * tot_[1] + pd2_[0] * dl1)); \
        const float o1 = a1 * tot_[2] + pd2_[1] * dl1; const float a12 = a1 * a2, dl1s = a2 * dl1; \
        _Pragma("unroll") for (int j = 0; j < 4; ++j) S[j] *= a12; \
        AXPY4(C##u[0], dl1s); AXPY4(C##u[1], dl2); \
        float y2a = 0.f, y2b = 0.f; DOT4_HI(y2a, y2b, C##1); float y2 = y2a + y2b; SWAPSUM(y2); \
        yred[((T) & 15) * 512 + wid * 64 + lane] = o1 * 0.125f; yred[(((T) + 1) & 15) * 512 + wid * 64 + lane] = y2; } while (0)
    for (int c = 0; c < nblk; ++c) {
        for (int tt = 0; tt < BL; tt += 4) {
            const int t = c * BL + tt;
            if (tt == (BL >> 1) && c + 1 < nblk) { DL_COMMIT(c + 1); if (c + 2 < nblk) DL_STAGE(c + 2); }
            DL_ROUND(ca, cb, t);
            DL_ROUND(cb, ca, t + 2);
            if (((t + 3) & 15) == 15) { SC_BAR(); DL_FINAL(t - 12 + 2 * wid); DL_FINAL(t - 11 + 2 * wid); }
        }
    }
#pragma unroll
    for (int j = 0; j < 4; ++j) st_out[(8 * wid + 4 * kh + j) * 64 + row] = S[j];
    __syncthreads();
#undef DL_STAGE
#undef DL_COMMIT
#undef DL_LOADOPS
#undef DL_FINAL
#undef DL_ROUND
}

__device__ __forceinline__ void sample_attn(KArgs A, int l, LAS unsigned char* lds, int unit, int tid) {
    unsigned char* ws = A->ws;
    const int sb = unit >> 2, h = unit & 3;
    LAS float* qs = (LAS float*)lds;
    LAS float* sc = qs + 2048;
    LAS float* scl = sc + 1024;
    LAS float* ssq = scl + 32;
    LAS float* lsum = ssq + 512;
    const bfu* qb = (const bfu*)slotp(ws, l, 4); bfu* mix = (bfu*)slotp(ws, l, 7);
    const float* ck = A->in[2] + (size_t)(l * 8 + sb) * 2048 * 512 + h * 128; const float* cv = A->in[3] + (size_t)(l * 8 + sb) * 2048 * 512 + h * 128;
    const float* nk = A->out + O_BKS + (size_t)(l * 8 + sb) * 16 * 512 + h * 128; const float* nv = A->out + O_BVS + (size_t)(l * 8 + sb) * 16 * 512 + h * 128;
    const float* lf = (const float*)(ws + WS_CTL + 1024); const float lam = lf[2 * l], omli = 1.f - lf[2 * l + 1];
    __syncthreads();
    for (int i = tid; i < 2048; i += NTHR) { const int map = i >> 10, qi = (i >> 6) & 15, p = i & 63; const int s = p >> 5, fq_ = (p >> 3) & 3, n_ = (p >> 2) & 1, j_ = p & 3;
        qs[(map * 16 + qi) * 64 + n_ * 32 + s * 16 + 4 * fq_ + j_] = bf2f(qb[(size_t)(MP + sb * 16 + qi) * 512 + h * 128 + map * 64 + p]); }
    float mrun = -1e30f, lrun = 0.f;
    const int qi = tid & 15, kj = tid >> 4, eg = tid >> 4;
    f32x4 acc0 = {0.f, 0.f, 0.f, 0.f}, acc1 = {0.f, 0.f, 0.f, 0.f};
    __syncthreads();
    for (int tile = 0; tile < 65; ++tile) {
        const int kidx = tile * 32 + kj;
        float s1 = -1e30f, s2 = -1e30f;
        if (kidx < 2064) { const float* kr = kidx < 2048 ? ck + (size_t)kidx * 512 : nk + (size_t)(kidx - 2048) * 512; s1 = 0.f; s2 = 0.f;
#pragma unroll 4
            for (int d = 0; d < 64; d += 4) { const f32x4 k1 = *(const f32x4*)(kr + d), k2 = *(const f32x4*)(kr + 64 + d); const LAS float* q1 = qs + qi * 64 + d; const LAS float* q2 = qs + (16 + qi) * 64 + d;
                s1 += q1[0] * k1[0] + q1[1] * k1[1] + q1[2] * k1[2] + q1[3] * k1[3]; s2 += q2[0] * k2[0] + q2[1] * k2[1] + q2[2] * k2[2] + q2[3] * k2[3]; } }
        sc[qi * 32 + kj] = s1; sc[(16 + qi) * 32 + kj] = s2;
        __syncthreads();
        if (tid < 32) { LAS float* r = sc + tid * 32; float mx = mrun;
#pragma unroll 8
            for (int j = 0; j < 32; ++j) mx = fmaxf(mx, r[j]);
            const float f = exp2f(mrun - mx); float su = 0.f;
#pragma unroll 8
            for (int j = 0; j < 32; ++j) { const float p = exp2f(r[j] - mx); r[j] = p; su += p; }
            lrun = lrun * f + su; mrun = mx; scl[tid] = f; }
        __syncthreads();
        { const float f0 = scl[qi], f1 = scl[16 + qi]; acc0 = acc0 * f0; acc1 = acc1 * f1;
            const int nk_ = tile < 64 ? 32 : 16;
            for (int j = 0; j < nk_; ++j) { const int kx = tile * 32 + j; const float* vr = (kx < 2048 ? cv + (size_t)kx * 512 : nv + (size_t)(kx - 2048) * 512) + eg * 4;
                const f32x4 v = *(const f32x4*)vr; acc0 = acc0 + v * sc[qi * 32 + j]; acc1 = acc1 + v * sc[(16 + qi) * 32 + j]; } }
        __syncthreads();
    }
    if (tid < 32) lsum[tid] = lrun;
    __syncthreads();
    const f32x4 o = acc0 * (1.f / lsum[qi]) - acc1 * (lam / lsum[16 + qi]);
    ssq[qi * 32 + eg] = (o[0] * o[0] + o[1] * o[1]) + (o[2] * o[2] + o[3] * o[3]);
    __syncthreads();
    float ss = 0.f;
#pragma unroll 8
    for (int j = 0; j < 32; ++j) ss += ssq[qi * 32 + j];
    const float rn = rsqrtf(ss * (1.f / 128.f) + 1e-6f) * omli; const float* bn = A->in[20] + l * 128 + eg * 4;
    v2u w; w.x = pk2(o[0] * rn * bn[0], o[1] * rn * bn[1]); w.y = pk2(o[2] * rn * bn[2], o[3] * rn * bn[3]);
    *(v2u*)(mix + (size_t)(MP + sb * 16 + qi) * 1024 + 256 + h * 128 + eg * 4) = w;
    __syncthreads();
}

#define PH_BEGIN \
        KArgs A = (KArgs)__builtin_amdgcn_kernarg_segment_ptr(); \
        int tid = wv * 64 + (int)__builtin_amdgcn_mbcnt_hi(~0u, __builtin_amdgcn_mbcnt_lo(~0u, 0u)); asm volatile("" : "+v"(tid)); tid &= 511; \
        const int bid = blockIdx.x, G = gridDim.x; \
        const int lane = tid & 63, wave = wv; \
        const int gw = bid * NWAVES + wave, NGW = G * NWAVES, gtid = bid * NTHR + tid, NT = G * NTHR; \
        unsigned char* ws = A->ws; float* rsb = (float*)(ws + WS_RS); unsigned char* wb = ws + WS_W; \
        (void)lane; (void)gw; (void)NGW; (void)gtid; (void)NT; (void)rsb; (void)wb;
#define IN(k) (lo <= (k) && (k) < hi)
__device__ __forceinline__ void grid_bar(unsigned* bar, unsigned target, bool leader) {
    asm volatile("s_waitcnt vmcnt(0) lgkmcnt(0)" ::: "memory");
    __syncthreads();
    if (leader) {
        __builtin_amdgcn_fence(__ATOMIC_RELEASE, "agent");
        asm volatile("s_waitcnt vmcnt(0)" ::: "memory");
        __hip_atomic_fetch_add(bar, 1u, __ATOMIC_RELAXED, __HIP_MEMORY_SCOPE_AGENT);
        unsigned spins = 0;
        while (__hip_atomic_load(bar, __ATOMIC_RELAXED, __HIP_MEMORY_SCOPE_AGENT) < target) { __builtin_amdgcn_s_sleep(2); if (++spins > (1u << 27)) break; }
        __builtin_amdgcn_fence(__ATOMIC_ACQUIRE, "agent");
        asm volatile("s_waitcnt vmcnt(0)" ::: "memory");
    }
    __syncthreads();
}
#define SEAM(k) do { if ((k) + 1 < hi) { ++nbar; grid_bar((unsigned*)(ws + WS_CTL + 4096), nbar * (unsigned)G, tid == 0); } } while (0)
#define SEAM_SKIP(k) do { } while (0)
__global__ void __launch_bounds__(NTHR, 2) hybrid_fwd(Args Aval) {
    extern __shared__ __attribute__((aligned(16))) unsigned char lds_raw[];
    LAS unsigned char* lds = (LAS unsigned char*)lds_raw;
    const int lo = Aval.ph_lo, hi = Aval.ph_hi; unsigned nbar = 0u;
    if (Aval.ph_lo < 0) cg::this_grid().sync();
    const int wv = __builtin_amdgcn_readfirstlane(threadIdx.x >> 6);
    if (IN(0)) { PH_BEGIN prologue(A, lds, gw, NGW, lane, wave, gtid, NT); SEAM(0); }
    { constexpr int l = 0;

        const int p0 = 1 + 11 * l;
        if (IN(p0 + 0)) { PH_BEGIN
            pg8::Gemm g{(const pg8::bf16_t*)slotp(ws, l, 0), (const pg8::bf16_t*)(wb + W_IN), MPAD, NIN, 1024};
            pg8::StaticOrder S; S.init(MPAD, NIN, G, bid);
            EpiG1 E{rsb + (size_t)(3 * l) * MPAD, (bfu*)slotp(ws, l, 2), (bfu*)slotp(ws, l, 4), (bfu*)slotp(ws, l, 5), (bfu*)slotp(ws, l, 6), (bfu*)slotp(ws, l, 7), (float*)(ws + WS_AB), (const float*)(ws + WS_ROPE),
                    A->out + O_BKP + (size_t)l * MP * 512, A->out + O_BVP + (size_t)l * MP * 512, A->out + O_BKS + (size_t)l * MS * 512, A->out + O_BVS + (size_t)l * MS * 512};
            pg8::gemm_phase<EpiG1, pg8::StaticOrder, true, true>((PG8_LAS unsigned char*)lds, g, S, E, wv);
            SEAM(p0 + 0); }
        if (IN(p0 + 1)) { PH_BEGIN
            prep_a(A, l, gw, NGW, lane); prep_c1(A, l, gw, NGW, lane);
            if (l == 1) conv_weights(A, 1, 2, lds, gw, NGW, lane, wave);
            SEAM(p0 + 1); }
        if (IN(p0 + 2)) { PH_BEGIN
            pg8::Gemm g{(const pg8::bf16_t*)slotp(ws, l, 12), (const pg8::bf16_t*)(wb + W_LR), MPAD, 768, 256};
            pg8::StaticOrder S; S.init(MPAD, 768, G, bid);
            EpiB<0> E{(bfu*)slotp(ws, l, 13), 768, nullptr};
            pg8::gemm_phase<EpiB<0>, pg8::StaticOrder, true, true>((PG8_LAS unsigned char*)lds, g, S, E, wv);
            SEAM(p0 + 2); }
        if (IN(p0 + 3)) { PH_BEGIN prep_c2(A, l, bid, G, tid); prep_a2(A, l, gw, NGW, lane);
            SEAM(p0 + 3); }
        if (IN(p0 + 4)) { PH_BEGIN
            if (bid < 64) { const int st = bid >> 1, half = bid & 1, b = st >> 2, h = st & 3;
                scan_rwkv(A, l, lds, h, half, b * 8192, 8192, 32, 5, b * 128, nullptr, A->out + O_CWP + (size_t)((l * 8 + b) * 4 + h) * 4096, tid);
                scan_rwkv(A, l, lds, h, half, MP + b * 16, 16, 16, 4, 1024 + b, A->in[7] + (size_t)((l * 8 + b) * 4 + h) * 4096, A->out + O_CWS + (size_t)((l * 8 + b) * 4 + h) * 4096, tid);
            } else if (bid < 128) { const int st = (bid - 64) >> 1, half = bid & 1, b = st >> 2, h = st & 3;
                scan_delta(A, l, lds, h, half, b * 8192, 8192, 32, 5, nullptr, A->out + O_ADP + (size_t)((l * 8 + b) * 4 + h) * 4096, tid);
                scan_delta(A, l, lds, h, half, MP + b * 16, 16, 16, 4, A->in[5] + (size_t)((l * 8 + b) * 4 + h) * 4096, A->out + O_ADS + (size_t)((l * 8 + b) * 4 + h) * 4096, tid);
            } else if (bid < 160) { sample_attn(A, l, lds, bid - 128, tid); }
            __syncthreads();
            unsigned* ctr = (unsigned*)(ws + WS_CTL) + 16 * l; volatile LAS unsigned* qw = (volatile LAS unsigned*)(lds + MISC_OFF);
            const attn_body::bf16* Q = (const attn_body::bf16*)slotp(ws, l, 4); const attn_body::bf16* K = (const attn_body::bf16*)slotp(ws, l, 5); const attn_body::bf16* V = (const attn_body::bf16*)slotp(ws, l, 6);
            attn_body::bf16* O = (attn_body::bf16*)slotp(ws, l, 13);
            for (;;) {
                if (tid == 0) qw[0] = atomicAdd(ctr, 1u);
                __syncthreads();
                const unsigned u = qw[0];
                __syncthreads();
                if (u >= 4096u) break;
                const int qb = 31 - (int)(u >> 7), bh = (int)(u & 127);
                attn_body::attn_unit<8>(bh >> 4, bh & 15, qb, Q, K, V, O, (char*)lds_raw, wv);
            }
            SEAM(p0 + 4); }
        if (IN(p0 + 5)) { PH_BEGIN
            post_attn(A, l, gw, NGW, lane); post_scan(A, l, gw, NGW, lane);
            conv_p(A, l, (bfu*)slotp(ws, l, 10), gtid, NT);
            if (l == 0) conv_weights(A, 1, 1, lds, gw, NGW, lane, wave);
            SEAM(p0 + 5); }
        if (IN(p0 + 6)) { PH_BEGIN
            pg8::Gemm g{(const pg8::bf16_t*)slotp(ws, l, 7), (const pg8::bf16_t*)(wb + W_OUT), MPAD, 1024, 1024};
            pg8::StaticOrder S; S.init(MPAD, 1024, G, bid);
            EpiH<2> E{A->out, (bfu*)slotp(ws, l, 0), rsb + (size_t)(3 * l + 1) * MPAD, nullptr, nullptr};
            pg8::gemm_phase<EpiH<2>, pg8::StaticOrder, true, true>((PG8_LAS unsigned char*)lds, g, S, E, wv);
            SEAM(p0 + 6); }
        if (IN(p0 + 7)) { PH_BEGIN
            pg8::Gemm g{(const pg8::bf16_t*)slotp(ws, l, 0), (const pg8::bf16_t*)(wb + W_FF1), MPAD, FFD, 1024};
            pg8::StaticOrder S; S.init(MPAD, FFD, G, bid);
            EpiB<1> E{(bfu*)slotp(ws, l, 2), FFD, rsb + (size_t)(3 * l + 1) * MPAD};
            pg8::gemm_phase<EpiB<1>, pg8::StaticOrder, true, true>((PG8_LAS unsigned char*)lds, g, S, E, wv);
            {
                pg8::Gemm g2{(const pg8::bf16_t*)slotp(ws, l, 10), (const pg8::bf16_t*)(wb + W_PP), MPAD, 1024, 256};
                pg8::StaticOrder S2; S2.init(MPAD, 1024, G, bid);
                EpiB<0> E2{(bfu*)slotp(ws, l, 11), 1024, nullptr};
                pg8::gemm_phase<EpiB<0>, pg8::StaticOrder, true, true>((PG8_LAS unsigned char*)lds, g2, S2, E2, wv); }
            SEAM(p0 + 7); }
        if (IN(p0 + 8)) { PH_BEGIN
            pg8::Gemm g{(const pg8::bf16_t*)slotp(ws, l, 2), (const pg8::bf16_t*)(wb + W_FF2), MPAD, 1024, FFD};
            pg8::StaticOrder S; S.init(MPAD, 1024, G, bid);
            EpiH<2> E{A->out, (bfu*)slotp(ws, l, 0), rsb + (size_t)(3 * l + 2) * MPAD, nullptr, nullptr};
            pg8::gemm_phase<EpiH<2>, pg8::StaticOrder, true, true>((PG8_LAS unsigned char*)lds, g, S, E, wv);
            SEAM(p0 + 8); }
        if (IN(p0 + 9)) { PH_BEGIN SEAM_SKIP(p0 + 9); }
        if (IN(p0 + 10)) { PH_BEGIN
            pg8::Gemm g{(const pg8::bf16_t*)slotp(ws, l, 0), (const pg8::bf16_t*)(wb + W_GATE), MPAD, 1024, 1024};
            pg8::StaticOrder S; S.init(MPAD, 1024, G, bid);
            EpiH<3> E{A->out, (bfu*)slotp(ws, l, 13), rsb + (size_t)(3 * l + 3) * MPAD, rsb + (size_t)(3 * l + 2) * MPAD, (const bfu*)slotp(ws, l, 11)};
            pg8::gemm_phase<EpiH<3>, pg8::StaticOrder, true, true>((PG8_LAS unsigned char*)lds, g, S, E, wv);
            SEAM(p0 + 10); }
        }
    { constexpr int l = 1;

        const int p0 = 1 + 11 * l;
        if (IN(p0 + 0)) { PH_BEGIN
            pg8::Gemm g{(const pg8::bf16_t*)slotp(ws, l, 0), (const pg8::bf16_t*)(wb + W_IN), MPAD, NIN, 1024};
            pg8::StaticOrder S; S.init(MPAD, NIN, G, bid);
            EpiG1 E{rsb + (size_t)(3 * l) * MPAD, (bfu*)slotp(ws, l, 2), (bfu*)slotp(ws, l, 4), (bfu*)slotp(ws, l, 5), (bfu*)slotp(ws, l, 6), (bfu*)slotp(ws, l, 7), (float*)(ws + WS_AB), (const float*)(ws + WS_ROPE),
                    A->out + O_BKP + (size_t)l * MP * 512, A->out + O_BVP + (size_t)l * MP * 512, A->out + O_BKS + (size_t)l * MS * 512, A->out + O_BVS + (size_t)l * MS * 512};
            pg8::gemm_phase<EpiG1, pg8::StaticOrder, true, true>((PG8_LAS unsigned char*)lds, g, S, E, wv);
            SEAM(p0 + 0); }
        if (IN(p0 + 1)) { PH_BEGIN
            prep_a(A, l, gw, NGW, lane); prep_c1(A, l, gw, NGW, lane);
            if (l == 1) conv_weights(A, 1, 2, lds, gw, NGW, lane, wave);
            SEAM(p0 + 1); }
        if (IN(p0 + 2)) { PH_BEGIN
            pg8::Gemm g{(const pg8::bf16_t*)slotp(ws, l, 12), (const pg8::bf16_t*)(wb + W_LR), MPAD, 768, 256};
            pg8::StaticOrder S; S.init(MPAD, 768, G, bid);
            EpiB<0> E{(bfu*)slotp(ws, l, 13), 768, nullptr};
            pg8::gemm_phase<EpiB<0>, pg8::StaticOrder, true, true>((PG8_LAS unsigned char*)lds, g, S, E, wv);
            SEAM(p0 + 2); }
        if (IN(p0 + 3)) { PH_BEGIN prep_c2(A, l, bid, G, tid); prep_a2(A, l, gw, NGW, lane);
            SEAM(p0 + 3); }
        if (IN(p0 + 4)) { PH_BEGIN
            if (bid < 64) { const int st = bid >> 1, half = bid & 1, b = st >> 2, h = st & 3;
                scan_rwkv(A, l, lds, h, half, b * 8192, 8192, 32, 5, b * 128, nullptr, A->out + O_CWP + (size_t)((l * 8 + b) * 4 + h) * 4096, tid);
                scan_rwkv(A, l, lds, h, half, MP + b * 16, 16, 16, 4, 1024 + b, A->in[7] + (size_t)((l * 8 + b) * 4 + h) * 4096, A->out + O_CWS + (size_t)((l * 8 + b) * 4 + h) * 4096, tid);
            } else if (bid < 128) { const int st = (bid - 64) >> 1, half = bid & 1, b = st >> 2, h = st & 3;
                scan_delta(A, l, lds, h, half, b * 8192, 8192, 32, 5, nullptr, A->out + O_ADP + (size_t)((l * 8 + b) * 4 + h) * 4096, tid);
                scan_delta(A, l, lds, h, half, MP + b * 16, 16, 16, 4, A->in[5] + (size_t)((l * 8 + b) * 4 + h) * 4096, A->out + O_ADS + (size_t)((l * 8 + b) * 4 + h) * 4096, tid);
            } else if (bid < 160) { sample_attn(A, l, lds, bid - 128, tid); }
            __syncthreads();
            unsigned* ctr = (unsigned*)(ws + WS_CTL) + 16 * l; volatile LAS unsigned* qw = (volatile LAS unsigned*)(lds + MISC_OFF);
            const attn_body::bf16* Q = (const attn_body::bf16*)slotp(ws, l, 4); const attn_body::bf16* K = (const attn_body::bf16*)slotp(ws, l, 5); const attn_body::bf16* V = (const attn_body::bf16*)slotp(ws, l, 6);
            attn_body::bf16* O = (attn_body::bf16*)slotp(ws, l, 13);
            for (;;) {
                if (tid == 0) qw[0] = atomicAdd(ctr, 1u);
                __syncthreads();
                const unsigned u = qw[0];
                __syncthreads();
                if (u >= 4096u) break;
                const int qb = 31 - (int)(u >> 7), bh = (int)(u & 127);
                attn_body::attn_unit<8>(bh >> 4, bh & 15, qb, Q, K, V, O, (char*)lds_raw, wv);
            }
            SEAM(p0 + 4); }
        if (IN(p0 + 5)) { PH_BEGIN
            post_attn(A, l, gw, NGW, lane); post_scan(A, l, gw, NGW, lane);
            conv_p(A, l, (bfu*)slotp(ws, l, 10), gtid, NT);
            if (l == 0) conv_weights(A, 1, 1, lds, gw, NGW, lane, wave);
            SEAM(p0 + 5); }
        if (IN(p0 + 6)) { PH_BEGIN
            pg8::Gemm g{(const pg8::bf16_t*)slotp(ws, l, 7), (const pg8::bf16_t*)(wb + W_OUT), MPAD, 1024, 1024};
            pg8::StaticOrder S; S.init(MPAD, 1024, G, bid);
            EpiH<2> E{A->out, (bfu*)slotp(ws, l, 0), rsb + (size_t)(3 * l + 1) * MPAD, nullptr, nullptr};
            pg8::gemm_phase<EpiH<2>, pg8::StaticOrder, true, true>((PG8_LAS unsigned char*)lds, g, S, E, wv);
            SEAM(p0 + 6); }
        if (IN(p0 + 7)) { PH_BEGIN
            pg8::Gemm g{(const pg8::bf16_t*)slotp(ws, l, 0), (const pg8::bf16_t*)(wb + W_FF1), MPAD, FFD, 1024};
            pg8::StaticOrder S; S.init(MPAD, FFD, G, bid);
            EpiB<1> E{(bfu*)slotp(ws, l, 2), FFD, rsb + (size_t)(3 * l + 1) * MPAD};
            pg8::gemm_phase<EpiB<1>, pg8::StaticOrder, true, true>((PG8_LAS unsigned char*)lds, g, S, E, wv);
            {
                pg8::Gemm g2{(const pg8::bf16_t*)slotp(ws, l, 10), (const pg8::bf16_t*)(wb + W_PP), MPAD, 1024, 256};
                pg8::StaticOrder S2; S2.init(MPAD, 1024, G, bid);
                EpiB<0> E2{(bfu*)slotp(ws, l, 11), 1024, nullptr};
                pg8::gemm_phase<EpiB<0>, pg8::StaticOrder, true, true>((PG8_LAS unsigned char*)lds, g2, S2, E2, wv); }
            SEAM(p0 + 7); }
        if (IN(p0 + 8)) { PH_BEGIN
            pg8::Gemm g{(const pg8::bf16_t*)slotp(ws, l, 2), (const pg8::bf16_t*)(wb + W_FF2), MPAD, 1024, FFD};
            pg8::StaticOrder S; S.init(MPAD, 1024, G, bid);
            EpiH<2> E{A->out, (bfu*)slotp(ws, l, 0), rsb + (size_t)(3 * l + 2) * MPAD, nullptr, nullptr};
            pg8::gemm_phase<EpiH<2>, pg8::StaticOrder, true, true>((PG8_LAS unsigned char*)lds, g, S, E, wv);
            SEAM(p0 + 8); }
        if (IN(p0 + 9)) { PH_BEGIN SEAM_SKIP(p0 + 9); }
        if (IN(p0 + 10)) { PH_BEGIN
            pg8::Gemm g{(const pg8::bf16_t*)slotp(ws, l, 0), (const pg8::bf16_t*)(wb + W_GATE), MPAD, 1024, 1024};
            pg8::StaticOrder S; S.init(MPAD, 1024, G, bid);
            EpiH<3> E{A->out, (bfu*)slotp(ws, l, 13), rsb + (size_t)(3 * l + 3) * MPAD, rsb + (size_t)(3 * l + 2) * MPAD, (const bfu*)slotp(ws, l, 11)};
            pg8::gemm_phase<EpiH<3>, pg8::StaticOrder, true, true>((PG8_LAS unsigned char*)lds, g, S, E, wv);
            SEAM(p0 + 10); }
        }
    if (IN(NPHASE - 1)) { PH_BEGIN final_norm(A, gw, NGW, lane); }
}
#undef PH_BEGIN
#undef IN
#undef SEAM

extern "C" void kernel_launch(void* const* d_in, const int* in_sizes, int n_in, void* d_out, int out_size, void* d_ws, size_t ws_size, hipStream_t stream) {
    static int grid = 0;
    if (grid == 0) {
        if (n_in != 40 || (size_t)out_size != O_END || ws_size < WS_TOTAL) { fprintf(stderr, "kernel_launch: unexpected shapes (n_in %d out %d ws %zu)\n", n_in, out_size, ws_size); grid = -1; return; }
        int dev = 0, cus = 0, per_cu = 0;
        if (hipGetDevice(&dev) != hipSuccess || hipDeviceGetAttribute(&cus, hipDeviceAttributeMultiprocessorCount, dev) != hipSuccess) { grid = -1; return; }
        if (hipFuncSetAttribute((const void*)hybrid_fwd, hipFuncAttributeMaxDynamicSharedMemorySize, LDS_BYTES) != hipSuccess) { fprintf(stderr, "kernel_launch: hipFuncSetAttribute failed\n"); grid = -1; return; }
        if (hipOccupancyMaxActiveBlocksPerMultiprocessor(&per_cu, (const void*)hybrid_fwd, NTHR, LDS_BYTES) != hipSuccess || per_cu < 1) { fprintf(stderr, "kernel_launch: occupancy query says %d\n", per_cu); per_cu = 1; }
        (void)hipGetLastError();
        grid = cus;
    }
    if (grid < 0) return;
    if (hipMemsetAsync((char*)d_ws + WS_CTL, 0, 64 * 1024, stream) != hipSuccess) { fprintf(stderr, "kernel_launch: memset failed\n"); return; }
    Args a{};
    for (int i = 0; i < 40; ++i) a.in[i] = (const float*)d_in[i];
    a.out = (float*)d_out; a.ws = (unsigned char*)d_ws;
#if MK_ONE_LAUNCH
    a.ph_lo = 0; a.ph_hi = NPHASE;
    void* args[] = {&a};
    hipError_t e = hipLaunchCooperativeKernel((const void*)hybrid_fwd, dim3(grid), dim3(NTHR), args, LDS_BYTES, stream);
    if (e != hipSuccess) fprintf(stderr, "kernel_launch: cooperative launch failed: %s (grid %d)\n", hipGetErrorString(e), grid);
#else
    for (int ph = 0; ph < NPHASE; ++ph) { a.ph_lo = ph; a.ph_hi = ph + 1; hipLaunchKernelGGL(hybrid_fwd, dim3(grid), dim3(NTHR), LDS_BYTES, stream, a); }
#endif
}
```

```cpp
#include <hip/hip_runtime.h>
#include <hip/hip_cooperative_groups.h>
#include <cstdio>
#include <cstdint>
namespace cg = cooperative_groups;
namespace pg8 {
#define PG8_LAS __attribute__((address_space(3)))
typedef unsigned short bf16_t;
typedef short bf16x8 __attribute__((ext_vector_type(8)));
typedef float f32x4 __attribute__((ext_vector_type(4)));
typedef unsigned u32x4 __attribute__((ext_vector_type(4)));
constexpr int BM = 256, BK = 64, HALF = 128, HTB = HALF * BK * 2  , STAGE_BYTES = 8 * HTB, NXCD = 8, WGM = 8;

__host__ __device__ __forceinline__ int lds_byte(int r, int c) { const int st = (r >> 4) * 2 + (c >> 5), rr = r & 15, cc = c & 31, ob = rr * 64 + cc * 2; return st * 1024 + (ob ^ (((ob >> 9) & 1) << 5)); }
__host__ __device__ __forceinline__ void stage_rc(int b, int& R, int& C) { const int st = b / 1024, sb = b % 1024, swz = sb ^ (((sb >> 9) & 1) << 5); R = (st >> 1) * 16 + swz / 64; C = (st & 1) * 32 + (swz % 64) / 2; }
__host__ __device__ __forceinline__ int perm32(int rho) { const int n = rho >> 4, i = rho & 15; return 8 * (i >> 2) + 4 * n + (i & 3); }

struct Unit { int pm, pn; };
struct Gemm { const bf16_t* A; const bf16_t* Bt; int M, N, K; };

struct StaticOrder {
    int nM, nN, nwg, G, c;
    __host__ __device__ void init(int M, int N, int G_, int c_) { nM = M / BM; nN = N / BM; nwg = nM * nN; G = G_; c = c_; }
    __host__ __device__ bool next(int i, Unit& u) const {
        const long L = (long)i * G + c; if (L >= nwg) return false;
        int wgid = (int)L; { const int q = nwg / NXCD, r = nwg % NXCD, xcd = wgid % NXCD, off = wgid / NXCD; wgid = (xcd < r ? xcd * (q + 1) : r * (q + 1) + (xcd - r) * q) + off; }
        const int nig = WGM * nN, gid = wgid / nig, fm = gid * WGM, gsz = (nM - fm) < WGM ? (nM - fm) : WGM;
        u.pm = fm + ((wgid % nig) % gsz); u.pn = (wgid % nig) / gsz; return true;
    }
    __device__ __forceinline__ void a_ready(const Unit&) const {}
    __device__ __forceinline__ void done(const Unit&) const {}
};

__device__ __forceinline__ unsigned cvt_pk_bf16(float lo, float hi) { unsigned r; asm volatile("v_cvt_pk_bf16_f32 %0, %1, %2" : "=v"(r) : "v"(lo), "v"(hi)); return r; }
typedef float f32x2 __attribute__((ext_vector_type(2)));
__device__ __forceinline__ f32x2 gelu_pk(f32x2 v) {
    const f32x2 av = __builtin_elementwise_abs(v), d = av * 0.2316418882f + 1.0f;
    f32x2 t; t.x = __builtin_amdgcn_rcpf(d.x); t.y = __builtin_amdgcn_rcpf(d.y);
    f32x2 q = t * 0.5307027145f + (-0.7265760135f); q = q * t + 0.7107068705f; q = q * t + (-0.142248368f); q = q * t + 0.127414796f; q = q * t;
    const f32x2 s = (v * v) * (-0.72134752044f);
    f32x2 e; e.x = __builtin_amdgcn_exp2f(s.x); e.y = __builtin_amdgcn_exp2f(s.y);
    const f32x2 m = v * (q * e), r = v - m;
    f32x2 o; o.x = v.x < 0.f ? m.x : r.x; o.y = v.y < 0.f ? m.y : r.y; return o;
}

template <int ACT  > struct EpiBf16 {
    static constexpr bool PERM = true, AFTER_DRAIN = false; static_assert(ACT == 0 || ACT == 1, "EpiBf16: ACT is 0 (none) or 1 (gelu_pk)");
    bf16_t* O; int ldc; const float* bias; int split_cols; size_t split_stride; float scale0;
    __device__ __forceinline__ void operator()(const f32x4 (&acc)[2][2][4][2], const Unit& u, int wr, int wc, int fr, int fq) const {
        const int row0 = u.pm * BM + wr * 64 + fr; int colt = u.pn * BM; bf16_t* base = O;
        float sc = 1.f; if (split_cols) { const int t = colt / split_cols; base += (size_t)t * split_stride; colt -= t * split_cols; if (t == 0) sc = scale0; }
        const int col0 = colt + wc * 32 + 8 * fq, bcol0 = u.pn * BM + wc * 32 + 8 * fq;
        f32x4 bv[2][2];
#pragma unroll
        for (int bj = 0; bj < 2; ++bj)
#pragma unroll
            for (int n = 0; n < 2; ++n) bv[bj][n] = bias ? *(const f32x4*)(bias + bcol0 + bj * HALF + 4 * n) : (f32x4){0.f, 0.f, 0.f, 0.f};
#pragma unroll
        for (int ai = 0; ai < 2; ++ai)
#pragma unroll
            for (int m = 0; m < 4; ++m) { bf16_t* rowp = base + (size_t)(row0 + ai * HALF + m * 16) * ldc + col0;
#pragma unroll
                for (int bj = 0; bj < 2; ++bj) { f32x4 v0 = acc[ai][bj][m][0] + bv[bj][0], v1 = acc[ai][bj][m][1] + bv[bj][1];
                    if (ACT == 1) { f32x2 a = gelu_pk((f32x2){v0[0], v0[1]}), b = gelu_pk((f32x2){v0[2], v0[3]}), c = gelu_pk((f32x2){v1[0], v1[1]}), d = gelu_pk((f32x2){v1[2], v1[3]});
                        v0 = (f32x4){a.x, a.y, b.x, b.y}; v1 = (f32x4){c.x, c.y, d.x, d.y}; }
                    v0 = v0 * sc; v1 = v1 * sc; u32x4 w; w.x = cvt_pk_bf16(v0[0], v0[1]); w.y = cvt_pk_bf16(v0[2], v0[3]); w.z = cvt_pk_bf16(v1[0], v1[1]); w.w = cvt_pk_bf16(v1[2], v1[3]);
                    *(u32x4*)(rowp + bj * HALF) = w; } }
    }
};

struct PanelStats {
    unsigned* xbuf;
    unsigned* cnt;
    unsigned* tmo;
    int ntn; float eps;
    unsigned code;
    __device__ __forceinline__ bool run(const f32x4 (&v)[2][2][4][2], const Unit& u, int wr, int wc, int fr, int fq, PG8_LAS unsigned char* lds, int wid, int lane) const {
        typedef float f32x2v __attribute__((ext_vector_type(2)));
        PG8_LAS f32x2v* P = (PG8_LAS f32x2v*)lds;
        PG8_LAS f32x2v* S = (PG8_LAS f32x2v*)(lds + 8192);
        PG8_LAS unsigned* flag = (PG8_LAS unsigned*)(lds + 8192 + 2048);
#pragma unroll
        for (int ai = 0; ai < 2; ++ai)
#pragma unroll
            for (int m = 0; m < 4; ++m) {
                float s = 0.f;
#pragma unroll
                for (int bj = 0; bj < 2; ++bj)
#pragma unroll
                    for (int n = 0; n < 2; ++n) { const f32x4 x = v[ai][bj][m][n]; s += (x[0] + x[1]) + (x[2] + x[3]); }
                s += __shfl_xor(s, 16); s += __shfl_xor(s, 32);
                const float mw = s * (1.0f / 64.0f); float q = 0.f;
#pragma unroll
                for (int bj = 0; bj < 2; ++bj)
#pragma unroll
                    for (int n = 0; n < 2; ++n) { const f32x4 d = v[ai][bj][m][n] - mw; q += (d[0] * d[0] + d[1] * d[1]) + (d[2] * d[2] + d[3] * d[3]); }
                q += __shfl_xor(q, 16); q += __shfl_xor(q, 32);
                if (fq == 0) P[(ai * HALF + wr * 64 + m * 16 + fr) * 4 + wc] = (f32x2v){mw, q};
            }
        asm volatile("s_waitcnt lgkmcnt(0)" ::: "memory"); __builtin_amdgcn_s_barrier(); asm volatile("" ::: "memory");
#if defined(BROKEN_EXCHANGE_NO_WAIT)
#warning BROKEN CONTROL BUILD: the row-statistics exchange does not wait; results are wrong by design
        if (blockIdx.x >= 64) { const long long t0_ = clock64(); while (clock64() - t0_ < 60000) __builtin_amdgcn_s_sleep(8); }
#endif
        const int row = wid * 32 + (lane & 31);
        if (lane < 32) {
            const f32x2v a = P[row * 4 + 0], b = P[row * 4 + 1], c = P[row * 4 + 2], d = P[row * 4 + 3];
            const float mt = (a.x + b.x + c.x + d.x) * 0.25f;
            const float da = a.x - mt, db = b.x - mt, dc = c.x - mt, dd = d.x - mt;
            const float m2 = (a.y + b.y) + (c.y + d.y) + 64.0f * ((da * da + db * db) + (dc * dc + dd * dd));
            unsigned long long* slot = (unsigned long long*)xbuf + ((size_t)(u.pm * BM + row) * 4 + u.pn);
            __hip_atomic_store(slot, ((unsigned long long)__float_as_uint(m2) << 32) | __float_as_uint(mt), __ATOMIC_RELAXED, __HIP_MEMORY_SCOPE_AGENT);
        }
        asm volatile("s_waitcnt vmcnt(0)" ::: "memory");
        if (lane == 0) __hip_atomic_fetch_add(cnt + 64 * u.pm, 1u, __ATOMIC_RELAXED, __HIP_MEMORY_SCOPE_AGENT);
        if (wid == 0) {
            bool dead = false; const unsigned long long t0 = __builtin_amdgcn_s_memrealtime(); const unsigned want = 8u * (unsigned)ntn;
            for (;;) {
#if defined(BROKEN_EXCHANGE_NO_WAIT)
                break;
#endif
                if ((unsigned)__builtin_amdgcn_readfirstlane(__hip_atomic_load(cnt + 64 * u.pm, __ATOMIC_RELAXED, __HIP_MEMORY_SCOPE_AGENT)) >= want) break;
                if (__builtin_amdgcn_s_memrealtime() - t0 > 2000000ull) {
                    if (lane == 0) { unsigned expect = 0u; __hip_atomic_compare_exchange_strong(tmo + 1, &expect, code | (unsigned)(u.pm & 0xff), __ATOMIC_RELAXED, __ATOMIC_RELAXED, __HIP_MEMORY_SCOPE_AGENT);
                                     __hip_atomic_store(tmo, 1u, __ATOMIC_RELAXED, __HIP_MEMORY_SCOPE_AGENT); }
                    dead = true; break; }
                __builtin_amdgcn_s_sleep(2);
            }
            __builtin_amdgcn_fence(__ATOMIC_ACQUIRE, "agent");
            if (lane == 0) flag[0] = dead ? 1u : 0u;
        }
        asm volatile("s_waitcnt vmcnt(0) lgkmcnt(0)" ::: "memory"); __builtin_amdgcn_s_barrier(); asm volatile("" ::: "memory");
        const bool bad = flag[0] != 0u;
        if (lane < 32) {
            const unsigned long long* slot = (const unsigned long long*)xbuf + (size_t)(u.pm * BM + row) * 4; float mt[4], m2[4]; float ms = 0.f;
#pragma unroll
            for (int t = 0; t < 4; ++t) { if (t < ntn) { const unsigned long long w = __hip_atomic_load(slot + t, __ATOMIC_RELAXED, __HIP_MEMORY_SCOPE_AGENT); mt[t] = __uint_as_float((unsigned)w); m2[t] = __uint_as_float((unsigned)(w >> 32)); } else { mt[t] = 0.f; m2[t] = 0.f; } ms += mt[t]; }
            const float mean = ms / (float)ntn; float q = 0.f;
#pragma unroll
            for (int t = 0; t < 4; ++t) if (t < ntn) { const float dm = mt[t] - mean; q += m2[t] + 256.0f * dm * dm; }
            S[row] = (f32x2v){mean, 1.0f / sqrtf(q / (256.0f * (float)ntn) + eps)};
        }
        asm volatile("s_waitcnt lgkmcnt(0)" ::: "memory"); __builtin_amdgcn_s_barrier(); asm volatile("" ::: "memory");
        return bad;
    }
};
struct EpiLnRes {
    static constexpr bool PERM = false, AFTER_DRAIN = true;
    const float* base; float* out; int ldc; const float* bias; PanelStats st; unsigned poison;
    __device__ __forceinline__ void fused(f32x4 (&acc)[2][2][4][2], const Unit& u, int wr, int wc, int fr, int fq, PG8_LAS unsigned char* lds, int wid, int lane) const {
        typedef float f32x2v __attribute__((ext_vector_type(2)));
        const PG8_LAS f32x2v* S = (const PG8_LAS f32x2v*)(lds + 8192);
        const int col0 = u.pn * BM + wc * 32 + 4 * fq;
#pragma unroll
        for (int bj = 0; bj < 2; ++bj)
#pragma unroll
            for (int n = 0; n < 2; ++n) { const f32x4 bv = bias ? *(const f32x4*)(bias + col0 + bj * HALF + n * 16) : (f32x4){0.f, 0.f, 0.f, 0.f};
#pragma unroll
                for (int ai = 0; ai < 2; ++ai)
#pragma unroll
                    for (int m = 0; m < 4; ++m) acc[ai][bj][m][n] += bv; }
        f32x4 pre[4][2][2];
#pragma unroll
        for (int m = 0; m < 4; ++m) { const size_t off = (size_t)(u.pm * BM + wr * 64 + m * 16 + fr) * ldc + col0;
#pragma unroll
            for (int bj = 0; bj < 2; ++bj)
#pragma unroll
                for (int n = 0; n < 2; ++n) pre[m][bj][n] = *(const f32x4*)(base + off + bj * HALF + n * 16); }
        const bool bad = st.run(acc, u, wr, wc, fr, fq, lds, wid, lane) || poison != 0u;
        const float qnan = __builtin_nanf("");
#pragma unroll
        for (int ai = 0; ai < 2; ++ai)
#pragma unroll
            for (int m = 0; m < 4; ++m) { const int r = ai * HALF + wr * 64 + m * 16 + fr; const f32x2v sr = S[r]; const size_t off = (size_t)(u.pm * BM + r) * ldc + col0;
#pragma unroll
                for (int bj = 0; bj < 2; ++bj)
#pragma unroll
                    for (int n = 0; n < 2; ++n) { const f32x4 bs = ai == 0 ? pre[m][bj][n] : *(const f32x4*)(base + off + bj * HALF + n * 16); f32x4 o = bs + (acc[ai][bj][m][n] - sr.x) * sr.y;
                        if (bad) o = (f32x4){qnan, qnan, qnan, qnan}; *(f32x4*)(out + off + bj * HALF + n * 16) = o; }
                if (m & 1) asm volatile("" ::: "memory"); }
    }
};
struct EpiLnResLn {
    static constexpr bool PERM = false, AFTER_DRAIN = true;
    const float* base; float* out; bf16_t* xn; int ldc; const float* bias; PanelStats st1, st2; unsigned poison;
    __device__ __forceinline__ void fused(f32x4 (&acc)[2][2][4][2], const Unit& u, int wr, int wc, int fr, int fq, PG8_LAS unsigned char* lds, int wid, int lane) const {
        typedef float f32x2v __attribute__((ext_vector_type(2))); typedef unsigned u32x2v __attribute__((ext_vector_type(2)));
        const PG8_LAS f32x2v* S = (const PG8_LAS f32x2v*)(lds + 8192);
        const int col0 = u.pn * BM + wc * 32 + 4 * fq;
#pragma unroll
        for (int bj = 0; bj < 2; ++bj)
#pragma unroll
            for (int n = 0; n < 2; ++n) { const f32x4 bv = bias ? *(const f32x4*)(bias + col0 + bj * HALF + n * 16) : (f32x4){0.f, 0.f, 0.f, 0.f};
#pragma unroll
                for (int ai = 0; ai < 2; ++ai)
#pragma unroll
                    for (int m = 0; m < 4; ++m) acc[ai][bj][m][n] += bv; }
        bool bad = st1.run(acc, u, wr, wc, fr, fq, lds, wid, lane) || poison != 0u;
        const float qnan = __builtin_nanf("");
#pragma unroll
        for (int ai = 0; ai < 2; ++ai)
#pragma unroll
            for (int m = 0; m < 4; ++m) { const int r = ai * HALF + wr * 64 + m * 16 + fr; const f32x2v sr = S[r]; const size_t off = (size_t)(u.pm * BM + r) * ldc + col0;
#pragma unroll
                for (int bj = 0; bj < 2; ++bj)
#pragma unroll
                    for (int n = 0; n < 2; ++n) { const f32x4 bs = *(const f32x4*)(base + off + bj * HALF + n * 16); acc[ai][bj][m][n] = bs + (acc[ai][bj][m][n] - sr.x) * sr.y; }
                asm volatile("" : "+v"(acc[ai][0][m][0]), "+v"(acc[ai][0][m][1]), "+v"(acc[ai][1][m][0]), "+v"(acc[ai][1][m][1]));
                if (m & 1) asm volatile("" ::: "memory"); }
        const bool bad1 = bad;
        bad = st2.run(acc, u, wr, wc, fr, fq, lds, wid, lane) || bad;
#pragma unroll
        for (int ai = 0; ai < 2; ++ai)
#pragma unroll
            for (int m = 0; m < 4; ++m) { const int r = ai * HALF + wr * 64 + m * 16 + fr; const f32x2v sr = S[r]; const size_t off = (size_t)(u.pm * BM + r) * ldc + col0;
#pragma unroll
                for (int bj = 0; bj < 2; ++bj)
#pragma unroll
                    for (int n = 0; n < 2; ++n) { const f32x4 x1 = acc[ai][bj][m][n]; *(f32x4*)(out + off + bj * HALF + n * 16) = bad1 ? (f32x4){qnan, qnan, qnan, qnan} : x1;
                        const f32x4 o = (x1 - sr.x) * sr.y; u32x2v w; w.x = cvt_pk_bf16(o[0], o[1]); w.y = cvt_pk_bf16(o[2], o[3]);
                        if (bad) { w.x = 0x7fc07fc0u; w.y = 0x7fc07fc0u; } *(u32x2v*)(xn + off + bj * HALF + n * 16) = w; }
                asm volatile("" ::: "memory"); }
    }
};

template <class Epi, class Sched, bool ALIGN_EPI = false, bool SP2 = false>
__device__ __forceinline__ void gemm_phase(PG8_LAS unsigned char* lds, const Gemm g, const Sched& S, const Epi& E, const int wv_) {
    int tid_o = wv_ * 64 + (int)__builtin_amdgcn_mbcnt_hi(~0u, __builtin_amdgcn_mbcnt_lo(~0u, 0u)); asm volatile("" : "+v"(tid_o)); tid_o &= 511;
    const int tid = tid_o, wid = __builtin_amdgcn_readfirstlane(tid >> 6), lane = tid & 63, wr = wid >> 2, wc = wid & 3, fr = lane & 15, fq = lane >> 4;
    const int K = g.K, nt = K / BK;
    unsigned voffA[2], voffB[2];
#pragma unroll
    for (int i = 0; i < 2; ++i) { int R, C; stage_rc(tid * 16 + i * 8192, R, C); const int Rb = Epi::PERM ? ((R & ~31) + perm32(R & 31)) : R;
        voffA[i] = (unsigned)(R * K + C) * 2u; voffB[i] = (unsigned)(Rb * K + C) * 2u; }
    const size_t kstep = (size_t)(BK * 2);
    const size_t hstep = (size_t)HALF * K * 2;
    const size_t tstep = 2 * hstep;
    const unsigned ldsw = (unsigned)wid * 1024u;
    const int aoff = lds_byte(wr * 64 + fr, fq * 8), boff = lds_byte(wc * 32 + fr, fq * 8);
#define PG8_SA(b, h) (((b) * 2 + (h)) * HTB)
#define PG8_SB(b, h) ((4 + (b) * 2 + (h)) * HTB)
#define PG8_STAGE(bufoff, gbase, voff) do { _Pragma("unroll") for (int _i = 0; _i < 2; ++_i) \
        __builtin_amdgcn_global_load_lds((const unsigned*)((const char*)(gbase) + (voff)[_i]), (PG8_LAS unsigned*)(lds + (bufoff) + ldsw + _i * 8192), 16, 0, 0); } while (0)
#define PG8_LDA(dst, b, h) do { _Pragma("unroll") for (int m = 0; m < 4; ++m) _Pragma("unroll") for (int k = 0; k < 2; ++k) dst[m][k] = *(const PG8_LAS bf16x8*)(lds + PG8_SA(b, h) + aoff + m * 2048 + k * 1024); } while (0)
#define PG8_LDB(dst, b, h) do { _Pragma("unroll") for (int n = 0; n < 2; ++n) _Pragma("unroll") for (int k = 0; k < 2; ++k) dst[n][k] = *(const PG8_LAS bf16x8*)(lds + PG8_SB(b, h) + boff + n * 2048 + k * 1024); } while (0)
#define PG8_MMA(ai, bj, At, Bt) do { __builtin_amdgcn_s_setprio(1); _Pragma("unroll") for (int m = 0; m < 4; ++m) _Pragma("unroll") for (int n = 0; n < 2; ++n) _Pragma("unroll") for (int k = 0; k < 2; ++k) \
        acc[ai][bj][m][n] = __builtin_amdgcn_mfma_f32_16x16x32_bf16(Bt[n][k], At[m][k], acc[ai][bj][m][n], 0, 0, 0); __builtin_amdgcn_s_setprio(0); } while (0)
#define PG8_WAIT_V(n) asm volatile("s_waitcnt vmcnt(" #n ")" ::: "memory")
#define PG8_WAIT_L(n) asm volatile("s_waitcnt lgkmcnt(" #n ")" ::: "memory")
#define PG8_BAR __builtin_amdgcn_s_barrier()
#define PG8_SCHED __builtin_amdgcn_sched_barrier(0)
    Unit cur, nxt; int ui = 0;
    if (!S.next(0, cur)) return;
    f32x4 acc[2][2][4][2];
#pragma unroll
    for (int a = 0; a < 2; ++a)
#pragma unroll
        for (int b = 0; b < 2; ++b)
#pragma unroll
            for (int m = 0; m < 4; ++m)
#pragma unroll
                for (int n = 0; n < 2; ++n) acc[a][b][m][n] = (f32x4){0.f, 0.f, 0.f, 0.f};
    bf16x8 At[4][2], B0[2][2], B1[2][2];
    const char* cA = (const char*)g.A + (size_t)cur.pm * tstep; const char* cB = (const char*)g.Bt + (size_t)cur.pn * tstep;
    S.a_ready(cur);
    if constexpr (SP2) {
        PG8_STAGE(PG8_SB(0, 0), cB, voffB); PG8_STAGE(PG8_SB(0, 1), cB + hstep, voffB); PG8_STAGE(PG8_SA(0, 0), cA, voffA); PG8_STAGE(PG8_SA(0, 1), cA + hstep, voffA);
        if (wr == 1) PG8_BAR;
        PG8_WAIT_V(2); PG8_BAR;
        PG8_STAGE(PG8_SB(1, 0), cB + kstep, voffB); PG8_STAGE(PG8_SA(1, 0), cA + kstep, voffA); PG8_STAGE(PG8_SB(1, 1), cB + hstep + kstep, voffB);
        PG8_WAIT_V(6); PG8_BAR;
    } else {
        PG8_STAGE(PG8_SB(0, 0), cB, voffB); PG8_STAGE(PG8_SA(0, 0), cA, voffA); PG8_STAGE(PG8_SB(0, 1), cB + hstep, voffB); PG8_STAGE(PG8_SA(0, 1), cA + hstep, voffA);
        if (wr == 1) PG8_BAR;
        PG8_WAIT_V(4); PG8_BAR;
        PG8_STAGE(PG8_SB(1, 0), cB + kstep, voffB); PG8_STAGE(PG8_SA(1, 0), cA + kstep, voffA); PG8_STAGE(PG8_SB(1, 1), cB + hstep + kstep, voffB);
        PG8_WAIT_V(6); PG8_BAR;
    }
    for (;;) {
        const bool has_next = S.next(ui + 1, nxt);
        const char* nA = has_next ? (const char*)g.A + (size_t)nxt.pm * tstep : cA; const char* nB = has_next ? (const char*)g.Bt + (size_t)nxt.pn * tstep : cB;
        for (int t = 0; t < nt; t += 2) {
            const bool last = (t == nt - 2);
            const char* a1 = cA + (size_t)(t + 1) * kstep;
            const char* a2 = last ? nA : cA + (size_t)(t + 2) * kstep; const char* b2 = last ? nB : cB + (size_t)(t + 2) * kstep;
            const char* a3 = a2 + kstep; const char* b3 = b2 + kstep;
            if (last && has_next) S.a_ready(nxt);
            if constexpr (SP2) {
            PG8_LDB(B0, 0, 0); PG8_LDB(B1, 0, 1); PG8_SCHED; PG8_LDA(At, 0, 0); PG8_STAGE(PG8_SA(1, 1), a1 + hstep, voffA);
            PG8_WAIT_V(8); PG8_WAIT_L(0); PG8_BAR; PG8_MMA(0, 0, At, B0); PG8_MMA(0, 1, At, B1); PG8_BAR; PG8_SCHED;
            PG8_LDA(At, 0, 1); PG8_STAGE(PG8_SB(0, 0), b2, voffB); PG8_STAGE(PG8_SB(0, 1), b2 + hstep, voffB); PG8_STAGE(PG8_SA(0, 0), a2, voffA);
            PG8_WAIT_V(8); PG8_WAIT_L(0); PG8_BAR; PG8_MMA(1, 0, At, B0); PG8_MMA(1, 1, At, B1); PG8_BAR; PG8_SCHED;
            PG8_LDB(B0, 1, 0); PG8_LDB(B1, 1, 1); PG8_SCHED; PG8_LDA(At, 1, 0); PG8_STAGE(PG8_SA(0, 1), a2 + hstep, voffA);
            PG8_WAIT_V(8); PG8_WAIT_L(0); PG8_BAR; PG8_MMA(0, 0, At, B0); PG8_MMA(0, 1, At, B1); PG8_BAR; PG8_SCHED;
            PG8_LDA(At, 1, 1); PG8_STAGE(PG8_SB(1, 0), b3, voffB); PG8_STAGE(PG8_SB(1, 1), b3 + hstep, voffB); PG8_STAGE(PG8_SA(1, 0), a3, voffA);
            PG8_WAIT_V(8); PG8_WAIT_L(0); PG8_BAR; PG8_MMA(1, 0, At, B0); PG8_MMA(1, 1, At, B1); PG8_BAR; PG8_SCHED;
            } else {
            PG8_LDB(B0, 0, 0); PG8_SCHED; PG8_LDA(At, 0, 0); PG8_STAGE(PG8_SA(1, 1), a1 + hstep, voffA);
            PG8_WAIT_L(8); PG8_BAR; PG8_WAIT_L(0); PG8_MMA(0, 0, At, B0); PG8_BAR; PG8_SCHED;
            PG8_LDB(B1, 0, 1); PG8_STAGE(PG8_SB(0, 0), b2, voffB);
            PG8_BAR; PG8_WAIT_L(0); PG8_MMA(0, 1, At, B1); PG8_BAR;
            PG8_LDA(At, 0, 1); PG8_STAGE(PG8_SA(0, 0), a2, voffA);
            PG8_BAR; PG8_WAIT_L(0); PG8_MMA(1, 0, At, B0); PG8_BAR; PG8_SCHED;
            PG8_STAGE(PG8_SB(0, 1), b2 + hstep, voffB);
            PG8_WAIT_V(6); PG8_BAR; PG8_MMA(1, 1, At, B1); PG8_BAR;
            PG8_LDB(B0, 1, 0); PG8_SCHED; PG8_LDA(At, 1, 0); PG8_STAGE(PG8_SA(0, 1), a2 + hstep, voffA);
            PG8_WAIT_L(8); PG8_BAR; PG8_WAIT_L(0); PG8_MMA(0, 0, At, B0); PG8_BAR; PG8_SCHED;
            PG8_LDB(B1, 1, 1); PG8_STAGE(PG8_SB(1, 0), b3, voffB);
            PG8_BAR; PG8_WAIT_L(0); PG8_MMA(0, 1, At, B1); PG8_BAR;
            PG8_LDA(At, 1, 1); PG8_STAGE(PG8_SA(1, 0), a3, voffA);
            PG8_BAR; PG8_WAIT_L(0); PG8_MMA(1, 0, At, B0); PG8_BAR; PG8_SCHED;
            PG8_STAGE(PG8_SB(1, 1), b3 + hstep, voffB);
            PG8_WAIT_V(6); PG8_BAR; PG8_MMA(1, 1, At, B1); PG8_BAR;
            }
        }
        if constexpr (ALIGN_EPI) { if (wr == 0) PG8_BAR; }
        if constexpr (!Epi::AFTER_DRAIN) { E(acc, cur, wr, wc, fr, fq); S.done(cur); }
        if (!has_next) break;
#pragma unroll
        for (int a = 0; a < 2; ++a)
#pragma unroll
            for (int b = 0; b < 2; ++b)
#pragma unroll
                for (int m = 0; m < 4; ++m)
#pragma unroll
                    for (int n = 0; n < 2; ++n) acc[a][b][m][n] = (f32x4){0.f, 0.f, 0.f, 0.f};
        cur = nxt; cA = nA; cB = nB; ++ui;
        if constexpr (ALIGN_EPI) { if (wr == 1) PG8_BAR; }
    }
    PG8_WAIT_V(0);
    if constexpr (!ALIGN_EPI) { if (wr == 0) PG8_BAR; }
    PG8_BAR;
    if constexpr (Epi::AFTER_DRAIN) { E.fused(acc, cur, wr, wc, fr, fq, lds, wid, lane); S.done(cur); }
#undef PG8_SA
#undef PG8_SB
#undef PG8_STAGE
#undef PG8_LDA
#undef PG8_LDB
#undef PG8_MMA
#undef PG8_WAIT_V
#undef PG8_WAIT_L
#undef PG8_BAR
#undef PG8_SCHED
}
}
#include <hip/hip_bf16.h>
#include <cmath>
namespace attn_body {
using bf16=__hip_bfloat16;
using bf16x8=__attribute__((ext_vector_type(8)))short;
using s16x4=__attribute__((ext_vector_type(4)))short;
using f32x16=__attribute__((ext_vector_type(16)))float;
using u32x4=__attribute__((ext_vector_type(4)))unsigned;
constexpr int BATCH=8,NHEAD=16,SEQ=8192,D=64,DM=NHEAD*D,DMI=512,DMO=1024;
constexpr int NW=8,QBLK=32,QB=QBLK*NW,KVBLK=64,NQB=SEQ/QB;
constexpr int ATTN_PITCH=DM, ATTN_UNIT_ROWS=QB;
__device__ __forceinline__ int crow(int r,int hi){return (r&3)+8*(r>>2)+4*hi;}
#define SBAR() __builtin_amdgcn_sched_barrier(0)
__device__ __forceinline__ void cmask(f32x16&p0,f32x16&p1,int jb,int qrel,int hi){
  const float NEG=-INFINITY; int kb=64*jb+4*hi;
  #pragma unroll
  for(int r=0;r<16;++r){ if(jb>(qrel>>6)){p0[r]=NEG;p1[r]=NEG;} } (void)kb;
}

constexpr int NSLOT=3, SLOTB=8192;
constexpr int LDS_K=0, LDS_V=NSLOT*SLOTB, LDS_WS=2*NSLOT*SLOTB, LDS_OST=LDS_WS+NW*64*4, LDS_BYTES=LDS_OST+NW*4096;
constexpr float C2=0.125f*1.4426950408889634f;
__device__ __forceinline__ void glds16(const void*gsrc,unsigned lds_dst){unsigned keep;
  asm volatile("s_mov_b32 %0, m0\n\ts_mov_b32 m0, %2\n\ts_nop 0\n\tglobal_load_lds_dwordx4 %1, off\n\ts_mov_b32 m0, %0":"=&s"(keep):"v"(gsrc),"s"(lds_dst):"memory");}
__device__ __forceinline__ float max3f(float a,float b,float c){float r;asm("v_max3_f32 %0, %1, %2, %3":"=v"(r):"v"(a),"v"(b),"v"(c));return r;}
__device__ __forceinline__ float max2f(float a,float b){float r;asm("v_max_f32_e32 %0, %1, %2":"=v"(r):"v"(a),"v"(b));return r;}
__device__ __forceinline__ float fadd_s(float a,float b){float r;asm("v_add_f32_e32 %0, %1, %2":"=v"(r):"v"(a),"v"(b));return r;}
__device__ __forceinline__ float fsub_s(float a,float b){float r;asm("v_sub_f32_e32 %0, %1, %2":"=v"(r):"v"(a),"v"(b));return r;}
typedef float f32x2_t __attribute__((ext_vector_type(2))); typedef __bf16 bf16x2_t __attribute__((ext_vector_type(2)));
__device__ __forceinline__ unsigned cvtpk_s(float lo,float hi){f32x2_t v={lo,hi};bf16x2_t b=__builtin_convertvector(v,bf16x2_t);return __builtin_bit_cast(unsigned,b);}
#define WAIT_BAR(N) asm volatile("s_waitcnt vmcnt(" #N ") lgkmcnt(0)\n\ts_barrier":::"memory")

__device__ __forceinline__ void qkt(f32x16&p0,f32x16&p1,const char*Kslot,const bf16x8*qr,const f32x16&negm,int r32,int hi){
  const char*kb=Kslot+hi*1024+r32*16;
  #pragma unroll
  for(int d0=0;d0<4;++d0){
    const bf16x8 b0=*reinterpret_cast<const bf16x8*>(kb+d0*2048);
    const bf16x8 b1=*reinterpret_cast<const bf16x8*>(kb+d0*2048+512);
    if(d0==0){p0=__builtin_amdgcn_mfma_f32_32x32x16_bf16(b0,qr[0],negm,0,0,0);p1=__builtin_amdgcn_mfma_f32_32x32x16_bf16(b1,qr[0],negm,0,0,0);}
    else{p0=__builtin_amdgcn_mfma_f32_32x32x16_bf16(b0,qr[d0],p0,0,0,0);p1=__builtin_amdgcn_mfma_f32_32x32x16_bf16(b1,qr[d0],p1,0,0,0);}}
}
typedef __attribute__((address_space(3))) const char* lds_cptr;
typedef short v4i16_t __attribute__((ext_vector_type(4)));
__device__ __forceinline__ void kload8(bf16x8*kf,lds_cptr kp){
  kf[0]=*(const __attribute__((address_space(3))) bf16x8*)(kp);      kf[1]=*(const __attribute__((address_space(3))) bf16x8*)(kp+512);
  kf[2]=*(const __attribute__((address_space(3))) bf16x8*)(kp+2048); kf[3]=*(const __attribute__((address_space(3))) bf16x8*)(kp+2560);
  kf[4]=*(const __attribute__((address_space(3))) bf16x8*)(kp+4096); kf[5]=*(const __attribute__((address_space(3))) bf16x8*)(kp+4608);
  kf[6]=*(const __attribute__((address_space(3))) bf16x8*)(kp+6144); kf[7]=*(const __attribute__((address_space(3))) bf16x8*)(kp+6656);
}
__device__ __forceinline__ void kload2(bf16x8*kf,lds_cptr kp,int j){ kf[2*j]=*(const __attribute__((address_space(3))) bf16x8*)(kp+j*2048); kf[2*j+1]=*(const __attribute__((address_space(3))) bf16x8*)(kp+j*2048+512); }
__device__ __forceinline__ s16x4 vtr(lds_cptr p){ return __builtin_bit_cast(s16x4,__builtin_amdgcn_ds_read_tr16_b64_v4i16((__attribute__((address_space(3))) v4i16_t*)p)); }
__device__ __forceinline__ float rowmax(const f32x16&p0,const f32x16&p1){
  float a=max3f(p0[0],p0[1],p1[0]),b=max3f(p0[2],p0[3],p1[1]);a=max3f(a,p1[2],p1[3]);
  #pragma unroll
  for(int r=4;r<16;r+=4){a=max3f(a,p0[r],p0[r+1]);b=max3f(b,p0[r+2],p0[r+3]);a=max3f(a,p1[r],p1[r+1]);b=max3f(b,p1[r+2],p1[r+3]);}
  const float m=max2f(a,b);
  auto rr=__builtin_amdgcn_permlane32_swap(__float_as_uint(m),__float_as_uint(m),false,false);
  return max2f(__uint_as_float(rr[0]),__uint_as_float(rr[1]));
}
__device__ __forceinline__ void pv(f32x16*o,int vb,bf16x8 pa0,bf16x8 pa1,bf16x8 pa2,bf16x8 pa3){
  #pragma unroll
  for(int d0=0;d0<2;++d0){s16x4 lo[4],hi[4];
    #pragma unroll
    for(int ks=0;ks<4;++ks){
      asm volatile("ds_read_b64_tr_b16 %0,%1 offset:%c2":"=&v"(lo[ks]):"v"(vb),"i"(d0*4096+ks*1024):"memory");
      asm volatile("ds_read_b64_tr_b16 %0,%1 offset:%c2":"=&v"(hi[ks]):"v"(vb),"i"(d0*4096+ks*1024+512):"memory");}
    asm volatile("s_waitcnt lgkmcnt(0)":::"memory");SBAR();
    #define PK(k) (bf16x8){lo[k][0],lo[k][1],lo[k][2],lo[k][3],hi[k][0],hi[k][1],hi[k][2],hi[k][3]}
    o[d0]=__builtin_amdgcn_mfma_f32_32x32x16_bf16(pa0,PK(0),o[d0],0,0,0);
    o[d0]=__builtin_amdgcn_mfma_f32_32x32x16_bf16(pa1,PK(1),o[d0],0,0,0);
    o[d0]=__builtin_amdgcn_mfma_f32_32x32x16_bf16(pa2,PK(2),o[d0],0,0,0);
    o[d0]=__builtin_amdgcn_mfma_f32_32x32x16_bf16(pa3,PK(3),o[d0],0,0,0);
    #undef PK
  }
}

#ifndef ATTN_STORE16
#define ATTN_STORE16(p,v) (*(u32x4*)(p)=(v))
#endif
template<int THRL> __device__ __forceinline__ void attn_unit(int b,int h,int qb,const bf16*Q,const bf16*__restrict__ K,const bf16*__restrict__ V,bf16*O,char*shm,const int wv_){
  int tid_o=wv_*64+(int)__builtin_amdgcn_mbcnt_hi(~0u,__builtin_amdgcn_mbcnt_lo(~0u,0u)); asm volatile("":"+v"(tid_o)); tid_o&=511;
  const int tid=tid_o,lane=tid&63,r32=lane&31,hi=lane>>5; const int wid=__builtin_amdgcn_readfirstlane(tid>>6);
  const long rowbase=(long)b*SEQ; const int q0=qb*QB;
  const bf16*Qw=Q+(rowbase+q0+wid*QBLK)*DMI+(h>>1)*D;
  const bf16*Kh=K+rowbase*DMI+(h>>1)*D,*Vh=V+rowbase*DMI+(h>>2)*128+(h&1)*64;
  const unsigned lds0=(unsigned)(uintptr_t)shm;
  float*wsf=(float*)(shm+LDS_WS)+wid*64;
  const bf16*ksrc=Kh+(long)lane*DMI+wid*8;
  const bf16*vsrc=Vh+(long)(16*(wid&3)+(lane>>2))*DMI+(wid>>2)*32+(lane&3)*8;
  const unsigned kdst=lds0+LDS_K+wid*1024, vdst=lds0+LDS_V+wid*1024;
  #define DMA_K(t,slot) glds16(ksrc+(long)(t)*KVBLK*DMI,(unsigned)__builtin_amdgcn_readfirstlane(kdst+(slot)))
  #define DMA_V(t,slot) glds16(vsrc+(long)(t)*KVBLK*DMI,(unsigned)__builtin_amdgcn_readfirstlane(vdst+(slot)))
  const int vb0=(int)(lds0+LDS_V)+((lane>>4)&1)*32+(lane&3)*8+(4*hi+((lane&15)>>2))*64;
  const char*Kbase=shm+LDS_K; bf16x8 kf[8];
  const lds_cptr shm3=(lds_cptr)shm; const lds_cptr kp0=shm3+LDS_K+hi*1024+r32*16; const lds_cptr vp0=shm3+LDS_V+((lane>>4)&1)*32+(lane&3)*8+(4*hi+((lane&15)>>2))*64;
  const int NT=(q0+QB)/KVBLK;
  DMA_K(0,0);DMA_V(0,0);DMA_K(1,SLOTB);
  bf16x8 qr[4];
  #pragma unroll
  for(int d0=0;d0<4;++d0)qr[d0]=*reinterpret_cast<const bf16x8*>(&Qw[(long)r32*DMI+d0*16+hi*8]);
  float mhat=0.f,l_reg=0.f;f32x16 o[2];o[0]=f32x16{};o[1]=f32x16{};f32x16 negm=f32x16{};asm volatile("":"+v"(negm));
  const int qrel=wid*QBLK+r32;
  #define CMASK(P0,P1,t) do{int jb_=(t)-(NT-4); if(jb_>=0)cmask(P0,P1,jb_,qrel,hi);}while(0)
  bool resc=false;
  #define START(P0,P1) do{ const float rm=rowmax(P0,P1); resc=false; \
    { const float dl=rm; mhat=fadd_s(mhat,dl); \
      _Pragma("unroll") for(int r=0;r<16;++r){P0[r]=fsub_s(P0[r],dl);P1[r]=fsub_s(P1[r],dl);} \
      _Pragma("unroll") for(int r=0;r<16;++r)negm[r]=-mhat; asm volatile("":"+v"(negm)); } \
    _Pragma("unroll") for(int r=0;r<16;++r)P0[r]=__builtin_amdgcn_exp2f(P0[r]); }while(0)
  #define RESC() do{ if(resc){ asm volatile("s_waitcnt lgkmcnt(0)":::"memory"); \
      _Pragma("unroll") for(int d_=0;d_<2;++d_) _Pragma("unroll") for(int r=0;r<16;++r)o[d_][r]*=wsf[crow(r,hi)]; } }while(0)
  f32x16 pA0,pA1,pB0,pB1;
  int sl_prev=0,sl_cur=0,sl_next=SLOTB;
  #define ROT() do{sl_prev=sl_cur;sl_cur=sl_next;sl_next=(sl_next==(NSLOT-1)*SLOTB)?0:sl_next+SLOTB;}while(0)
  DMA_K(2,2*SLOTB);
  WAIT_BAR(3);
  qkt(pA0,pA1,Kbase,qr,negm,r32,hi);asm volatile("s_nop 15\n\ts_nop 7":"+v"(pA0),"+v"(pA1));CMASK(pA0,pA1,0);
  START(pA0,pA1);
  _Pragma("unroll") for(int r=0;r<16;++r)pA1[r]=__builtin_amdgcn_exp2f(pA1[r]);
  WAIT_BAR(0);
  DMA_K(3,0);DMA_V(1,SLOTB);
  ROT();
  kload8(kf,kp0+sl_cur);
  WAIT_BAR(2);
  s16x4 vlo[8],vhi[8]; u32x4 pw0,pw1,pw2,pw3;
  #define PKW(P,B) cvtpk_s(P[B],P[B+1])
  #define PAF(k) __builtin_bit_cast(bf16x8,pw##k)
  #define VFR(i) (bf16x8){vlo[i][0],vlo[i][1],vlo[i][2],vlo[i][3],vhi[i][0],vhi[i][1],vhi[i][2],vhi[i][3]}
  #define PIN(x) asm volatile("":"+v"(x))
  #define MX3(a,b,c) __builtin_fmaxf(__builtin_fmaxf((a),(b)),(c))
  #define GAPA(MF,A0,A1,A2,A3,W0,W1,PW) do{ MF; sacc+=A0; sacc+=A1; sacc+=A2; sacc+=A3; PIN(sacc); W0; W1; PIN(PW); SBAR(); }while(0)
  #define EX(v) __builtin_amdgcn_exp2f(v)
  #define GAPB(MF,X,B) do{ MF; X[B]=EX(X[B]); X[B+1]=EX(X[B+1]); X[B+2]=EX(X[B+2]); X[B+3]=EX(X[B+3]); PIN(X); SBAR(); }while(0)
  #define VRD(i) do{ vlo[i]=vtr(vp_+(((i)>>2)*4096+((i)&3)*1024)); vhi[i]=vtr(vp_+(((i)>>2)*4096+((i)&3)*1024+512)); }while(0)
  #define KRD(G,j) do{ if(G){ kload2(kf,kp0+sl_next,j); SBAR(); } }while(0)
  #define STEP(C0,C1,P0,P1,t,GK,GV,GL) do{ SBAR(); \
    const lds_cptr vp_=vp0+sl_prev; \
    VRD(0); SBAR(); float sacc=(P0[0]+P0[1]); \
    GAPA(C0=__builtin_amdgcn_mfma_f32_32x32x16_bf16(kf[0],qr[0],negm,0,0,0), P0[2],P0[3],P0[4],P0[5],     pw0[0]=PKW(P0,0), pw0[1]=PKW(P0,2), pw0); \
    VRD(4); SBAR(); GAPA(C1=__builtin_amdgcn_mfma_f32_32x32x16_bf16(kf[1],qr[0],negm,0,0,0), P0[6],P0[7],P0[8],P0[9],     pw0[2]=PKW(P0,4), pw0[3]=PKW(P0,6), pw0); \
    VRD(1); SBAR(); GAPA(C0=__builtin_amdgcn_mfma_f32_32x32x16_bf16(kf[2],qr[1],C0,0,0,0),   P0[10],P0[11],P0[12],P0[13], pw1[0]=PKW(P0,8), pw1[1]=PKW(P0,10), pw1); \
    VRD(5); SBAR(); GAPA(C1=__builtin_amdgcn_mfma_f32_32x32x16_bf16(kf[3],qr[1],C1,0,0,0),   P0[14],P0[15],P1[0],P1[1],   pw1[2]=PKW(P0,12),pw1[3]=PKW(P0,14), pw1); \
    VRD(2); SBAR(); GAPA(C0=__builtin_amdgcn_mfma_f32_32x32x16_bf16(kf[4],qr[2],C0,0,0,0),   P1[2],P1[3],P1[4],P1[5],     pw2[0]=PKW(P1,0), pw2[1]=PKW(P1,2), pw2); \
    VRD(6); SBAR(); GAPA(C1=__builtin_amdgcn_mfma_f32_32x32x16_bf16(kf[5],qr[2],C1,0,0,0),   P1[6],P1[7],P1[8],P1[9],     pw2[2]=PKW(P1,4), pw2[3]=PKW(P1,6), pw2); \
    VRD(3); SBAR(); GAPA(C0=__builtin_amdgcn_mfma_f32_32x32x16_bf16(kf[6],qr[3],C0,0,0,0),   P1[10],P1[11],P1[12],P1[13], pw3[0]=PKW(P1,8), pw3[1]=PKW(P1,10), pw3); \
    VRD(7); SBAR(); GAPA(C1=__builtin_amdgcn_mfma_f32_32x32x16_bf16(kf[7],qr[3],C1,0,0,0),   P1[14],P1[15],0.f,0.f,       pw3[2]=PKW(P1,12),pw3[3]=PKW(P1,14), pw3); \
    l_reg+=sacc; \
    if(GK){DMA_K((t)+3,sl_cur);} if(GV){DMA_V((t)+1,sl_next);} \
    CMASK(C0,C1,t); \
    { float a=MX3(C0[0],C0[1],C1[0]),b=MX3(C0[2],C0[3],C1[1]); a=MX3(a,C1[2],C1[3]); \
      _Pragma("unroll") for(int r=4;r<16;r+=4){a=MX3(a,C0[r],C0[r+1]);b=MX3(b,C0[r+2],C0[r+3]);a=MX3(a,C1[r],C1[r+1]);b=MX3(b,C1[r+2],C1[r+3]);} \
      float rm=__builtin_fmaxf(a,b); { auto rr=__builtin_amdgcn_permlane32_swap(__float_as_uint(rm),__float_as_uint(rm),false,false); rm=__builtin_fmaxf(__uint_as_float(rr[0]),__uint_as_float(rr[1])); } \
      resc=false; \
      if(__builtin_expect(__any(rm>(float)THRL),0)){ const float dl=__builtin_fmaxf(rm,0.f); mhat+=dl; \
        _Pragma("unroll") for(int r=0;r<16;++r){C0[r]-=dl;C1[r]-=dl;} \
        _Pragma("unroll") for(int r=0;r<16;++r)negm[r]=-mhat; asm volatile("":"+v"(negm)); \
        const float f=__builtin_amdgcn_exp2f(-dl); l_reg*=f; if(hi==0)wsf[r32]=f; resc=true; } } \
    SBAR(); \
    GAPB(o[0]=__builtin_amdgcn_mfma_f32_32x32x16_bf16(PAF(0),VFR(0),o[0],0,0,0), C0,0); \
    GAPB(o[1]=__builtin_amdgcn_mfma_f32_32x32x16_bf16(PAF(0),VFR(4),o[1],0,0,0), C0,4); \
    KRD(GL,0); GAPB(o[0]=__builtin_amdgcn_mfma_f32_32x32x16_bf16(PAF(1),VFR(1),o[0],0,0,0), C0,8); \
    KRD(GL,1); GAPB(o[1]=__builtin_amdgcn_mfma_f32_32x32x16_bf16(PAF(1),VFR(5),o[1],0,0,0), C0,12); \
    KRD(GL,2); GAPB(o[0]=__builtin_amdgcn_mfma_f32_32x32x16_bf16(PAF(2),VFR(2),o[0],0,0,0), C1,0); \
    KRD(GL,3); GAPB(o[1]=__builtin_amdgcn_mfma_f32_32x32x16_bf16(PAF(2),VFR(6),o[1],0,0,0), C1,4); \
    GAPB(o[0]=__builtin_amdgcn_mfma_f32_32x32x16_bf16(PAF(3),VFR(3),o[0],0,0,0), C1,8); \
    GAPB(o[1]=__builtin_amdgcn_mfma_f32_32x32x16_bf16(PAF(3),VFR(7),o[1],0,0,0), C1,12); \
    }while(0)
  int t=1;
  #undef CMASK
  #define CMASK(P0,P1,t) do{}while(0)
  for(;t+5<NT;t+=2){
    STEP(pB0,pB1,pA0,pA1,t,true,true,true);     WAIT_BAR(2); RESC(); ROT();
    STEP(pA0,pA1,pB0,pB1,t+1,true,true,true);   WAIT_BAR(2); RESC(); ROT();
  }
  #undef CMASK
  #define CMASK(P0,P1,t) do{int jb_=(t)-(NT-4); if(jb_>=0)cmask(P0,P1,jb_,qrel,hi);}while(0)
  #define ENDW(tt) do{ if((tt)+3<NT){WAIT_BAR(2);} else if((tt)+2<NT){WAIT_BAR(1);} else {WAIT_BAR(0);} }while(0)
  for(;t+1<NT;t+=2){
    STEP(pB0,pB1,pA0,pA1,t,(t+3<NT),(t+1<NT),(t+1<NT));       ENDW(t);   RESC(); ROT();
    STEP(pA0,pA1,pB0,pB1,t+1,(t+4<NT),(t+2<NT),(t+2<NT));     ENDW(t+1); RESC(); ROT();
  }
  STEP(pB0,pB1,pA0,pA1,NT-1,false,false,false); RESC();
  { float sacc=pB0[0]+pB0[1]; _Pragma("unroll") for(int r=2;r<16;++r)sacc+=pB0[r]; _Pragma("unroll") for(int r=0;r<16;++r)sacc+=pB1[r]; l_reg+=sacc;
    pw0=(u32x4){PKW(pB0,0),PKW(pB0,2),PKW(pB0,4),PKW(pB0,6)};pw1=(u32x4){PKW(pB0,8),PKW(pB0,10),PKW(pB0,12),PKW(pB0,14)};pw2=(u32x4){PKW(pB1,0),PKW(pB1,2),PKW(pB1,4),PKW(pB1,6)};pw3=(u32x4){PKW(pB1,8),PKW(pB1,10),PKW(pB1,12),PKW(pB1,14)};
    SBAR(); pv(o,vb0+sl_cur,PAF(0),PAF(1),PAF(2),PAF(3)); }
  #undef PKW
  #undef PAF
  #undef VFR
  #undef PIN
  #undef MX3
  #undef GAPA
  #undef GAPB
  #undef EX
  #undef VRD
  #undef KRD
  #undef STEP
  #undef ENDW
  {auto rr=__builtin_amdgcn_permlane32_swap(__float_as_uint(l_reg),__float_as_uint(l_reg),false,false);l_reg=__uint_as_float(rr[0])+__uint_as_float(rr[1]);}
  if(hi==0)wsf[32+r32]=l_reg;asm volatile("s_waitcnt lgkmcnt(0)":::"memory");
  float rli[16];
  #pragma unroll
  for(int r=0;r<16;++r)rli[r]=__builtin_amdgcn_rcpf(wsf[32+crow(r,hi)]);
  bf16*Ow=O+(rowbase+q0+wid*QBLK)*DMO+h*D;
  { bf16*stg=(bf16*)(shm+LDS_OST)+wid*2048;
    #pragma unroll
    for(int r=0;r<16;++r){const int orow=crow(r,hi);
      #pragma unroll
      for(int d0=0;d0<2;++d0)stg[orow*64+d0*32+r32]=__float2bfloat16(o[d0][r]*rli[r]);}
    asm volatile("s_waitcnt lgkmcnt(0)":::"memory");
    #pragma unroll
    for(int i=0;i<4;++i){const int row=i*8+(lane>>3),ch=lane&7; const u32x4 v=*(const u32x4*)(stg+row*64+ch*8); ATTN_STORE16(Ow+(long)row*DMO+ch*8,v);} }
  asm volatile("s_waitcnt lgkmcnt(0)\n\ts_barrier":::"memory");
  #undef DMA_K
  #undef DMA_V
  #undef CMASK
  #undef START
  #undef RESC
  #undef ROT
}
constexpr int ATTN_LDS_BYTES=LDS_BYTES;
struct AttnTensors { const bf16* Q; const bf16* K; const bf16* V; bf16* O; };
struct AttnUnit { int bh; int qb; };
struct StaticOrder {
  int vcu;
  __device__ __forceinline__ explicit StaticOrder(int grid,int block):vcu((block%8)*(grid/8)+block/8){}
  __device__ __forceinline__ bool next(int i,AttnUnit&u)const{ if(i>=4)return false; const int s=vcu&7; u.bh=vcu>>3; u.qb=(i==0)?s:(i==1)?15-s:(i==2)?16+s:31-s; return true; }
  __device__ __forceinline__ void a_ready(const AttnUnit&)const{}
  __device__ __forceinline__ void done(const AttnUnit&)const{}
};
template<class Sched,int THRL=8> __device__ __forceinline__ void attn_phase(char*lds,const AttnTensors&T,const Sched&S){
  AttnUnit u;
  for(int i=0;S.next(i,u);++i){ S.a_ready(u); attn_unit<THRL>(u.bh/NHEAD,u.bh%NHEAD,u.qb,T.Q,T.K,T.V,T.O,lds); S.done(u); }
}
#undef SBAR
#undef WAIT_BAR
}

#define LAS __attribute__((address_space(3)))
typedef unsigned short bfu;
typedef unsigned v4u __attribute__((ext_vector_type(4)));
typedef unsigned v2u __attribute__((ext_vector_type(2)));
typedef float f32x4 __attribute__((ext_vector_type(4)));
typedef float f32x8 __attribute__((ext_vector_type(8)));
typedef float f32x16 __attribute__((ext_vector_type(16)));
typedef float f32x2 __attribute__((ext_vector_type(2)));

constexpr int NWAVES = 8, NTHR = 512;
constexpr int MP = 65536, MS = 128, MR = MP + MS, MPAD = 65792;
constexpr int NIN = 3840, FFD = 4096;
constexpr int NPHASE = 24;
#ifndef MK_ONE_LAUNCH
#define MK_ONE_LAUNCH 1
#endif

constexpr size_t O_Y = 0;
constexpr size_t O_YS = (size_t)MP * 1024;
constexpr size_t O_ACP = O_YS + 128 * 1024;
constexpr size_t O_ADP = O_ACP + 2 * 8 * 3 * 768;
constexpr size_t O_BKP = O_ADP + 2 * 8 * 4 * 64 * 64;
constexpr size_t O_BVP = O_BKP + (size_t)2 * 8 * 8192 * 512;
constexpr size_t O_CSP = O_BVP + (size_t)2 * 8 * 8192 * 512;
constexpr size_t O_CWP = O_CSP + 2 * 8 * 1024;
constexpr size_t O_ACS = O_CWP + 2 * 8 * 4 * 64 * 64;
constexpr size_t O_ADS = O_ACS + 2 * 8 * 3 * 768;
constexpr size_t O_BKS = O_ADS + 2 * 8 * 4 * 64 * 64;
constexpr size_t O_BVS = O_BKS + 2 * 8 * 16 * 512;
constexpr size_t O_CSS = O_BVS + 2 * 8 * 16 * 512;
constexpr size_t O_CWS = O_CSS + 2 * 8 * 1024;
constexpr size_t O_END = O_CWS + 2 * 8 * 4 * 64 * 64;
static_assert(O_END == 202874880, "output size");

constexpr size_t MiB = 1u << 20;
constexpr size_t WS_CTL = 0;
constexpr size_t WS_RS = 64 * 1024;
constexpr size_t WS_BONUS = 2 * MiB;
constexpr size_t WS_GAB = 3 * MiB + 512 * 1024;
constexpr size_t WS_AB = 6 * MiB;
constexpr size_t WS_ROPE = 8 * MiB + 512 * 1024;
constexpr size_t WS_GCH = 10 * MiB + 512 * 1024;
constexpr size_t WS_W = 12 * MiB;
constexpr size_t W_IN = 0, W_OUT = W_IN + (size_t)NIN * 1024 * 2, W_FF1 = W_OUT + 1024 * 1024 * 2, W_FF2 = W_FF1 + 4096 * 1024 * 2,
                 W_GATE = W_FF2 + 4096 * 1024 * 2, W_PP = W_GATE + 1024 * 1024 * 2, W_LR = W_PP + 1024 * 256 * 2, W_END = W_LR + 768 * 256 * 2;
constexpr size_t WS_SLOT = 41 * MiB;
constexpr size_t USLOT = (size_t)MPAD * 1024;
static_assert(WS_W + W_END <= WS_SLOT, "weights");
constexpr size_t WS_PAIRC = WS_SLOT + 15 * USLOT;
constexpr size_t WS_PAIRD = WS_PAIRC + 4 * (size_t)(MPAD / 2) * 16;
constexpr size_t WS_TOTAL = WS_PAIRD + 4 * (size_t)(MPAD / 2) * 8;
static_assert(WS_TOTAL <= (size_t)1024 * MiB, "ws");
static_assert(WS_RS + 7 * (size_t)MPAD * 4 <= WS_BONUS && WS_BONUS + 4 * (size_t)MPAD * 4 <= WS_GAB && WS_GAB + 8 * (size_t)MPAD * 4 <= WS_AB && WS_AB + 8 * (size_t)MPAD * 4 <= WS_ROPE && WS_ROPE + 8192 * 64 * 4 <= WS_GCH && WS_GCH + 4 * 1032 * 64 * 4 <= WS_W, "ctl map");

__device__ __forceinline__ unsigned char* slotp(unsigned char* ws, int l, int s) {
    if (l & 1) { if (s < 2) s += 13; else if (s >= 13) s -= 13; }
    return ws + WS_SLOT + (size_t)s * USLOT;
}
__device__ __forceinline__ unsigned char* slotph(unsigned char* ws, int l, int s) { return slotp(ws, l, s) + USLOT / 2; }

constexpr int RING_BYTES = 131072, MISC_OFF = RING_BYTES + 320, LDS_BYTES = 147456;

#define LDS_WAIT() asm volatile("s_waitcnt lgkmcnt(0)" ::: "memory")
__device__ __forceinline__ float bf2f(unsigned short u) { return __uint_as_float(((unsigned)u) << 16); }
__device__ __forceinline__ unsigned f2bf(float f) { unsigned u = __builtin_bit_cast(unsigned, f); return (u + 0x7fffu + ((u >> 16) & 1u)) >> 16; }
__device__ __forceinline__ unsigned pk2(float lo, float hi) { return f2bf(lo) | (f2bf(hi) << 16); }
#define DPP_ROR_ADD(v, ctrl) ((v) + __builtin_bit_cast(float, __builtin_amdgcn_update_dpp(0, __builtin_bit_cast(int, (v)), (ctrl), 0xf, 0xf, false)))
__device__ __forceinline__ float wave_sum(float v) {
    v = DPP_ROR_ADD(v, 0x128); v = DPP_ROR_ADD(v, 0x124); v = DPP_ROR_ADD(v, 0x122); v = DPP_ROR_ADD(v, 0x121);
    v += __shfl_xor(v, 16);
    const unsigned u = __float_as_uint(v); auto rr = __builtin_amdgcn_permlane32_swap(u, u, false, false);
    return __uint_as_float(rr[0]) + __uint_as_float(rr[1]);
}
__device__ __forceinline__ float sigm(float x) { return 1.f / (1.f + __expf(-x)); }
__device__ __forceinline__ float softplusf(float x) { return x > 20.f ? x : log1pf(__expf(x)); }

struct Args { const float* in[40]; float* out; unsigned char* ws; int ph_lo, ph_hi; };
typedef const __attribute__((address_space(4))) Args* KArgs;

constexpr float ATT_C2 = 0.125f * 1.4426950408889634f;
struct EpiG1 {
    static constexpr bool PERM = true, AFTER_DRAIN = false;
    const float* rs; bfu *aqkvz, *qb, *kb, *vb, *craw; float* ab; const float* rope; float *okp, *ovp, *oks, *ovs;
    __device__ __forceinline__ void operator()(const pg8::f32x4 (&acc)[2][2][4][2], const pg8::Unit& u, int wr, int wc, int fr, int fq) const {
        const int pn = u.pn; const int rowb = u.pm * 256 + wr * 64 + fr; const int cl = wc * 32 + 8 * fq;
#pragma unroll
        for (int ai = 0; ai < 2; ++ai)
#pragma unroll
            for (int m = 0; m < 4; ++m) {
                const int row = rowb + ai * 128 + m * 16;
                const float s = rsqrtf(rs[row] * (1.f / 1024.f) + 1e-6f);
                if (pn < 4 || (pn >= 10 && pn < 14)) {
                    bfu* dst = (pn < 4 ? aqkvz + pn * 256 : craw + (pn - 10) * 256) + (size_t)row * 1024 + cl;
#pragma unroll
                    for (int bj = 0; bj < 2; ++bj) { const pg8::f32x4 v0 = acc[ai][bj][m][0] * s, v1 = acc[ai][bj][m][1] * s;
                        v4u w; w.x = pg8::cvt_pk_bf16(v0[0], v0[1]); w.y = pg8::cvt_pk_bf16(v0[2], v0[3]); w.z = pg8::cvt_pk_bf16(v1[0], v1[1]); w.w = pg8::cvt_pk_bf16(v1[2], v1[3]); *(v4u*)(dst + bj * 128) = w; }
                } else if (pn < 8) {
                    const bool isk = pn >= 6;
                    const int pos = row < MP ? (row & 8191) : 2048 + ((row - MP) & 15);
                    const int i0 = (wc & 1) * 16 + 4 * fq;
                    const pg8::f32x4 c4 = *(const pg8::f32x4*)(rope + pos * 64 + i0), s4 = *(const pg8::f32x4*)(rope + pos * 64 + 32 + i0);
#pragma unroll
                    for (int bj = 0; bj < 2; ++bj) {
                        const pg8::f32x4 x1 = acc[ai][bj][m][0] * s, x2 = acc[ai][bj][m][1] * s;
                        pg8::f32x4 o1 = x1 * c4 - x2 * s4, o2 = x2 * c4 + x1 * s4;
                        if (!isk) {
                            o1 = o1 * ATT_C2; o2 = o2 * ATT_C2;
                            v4u w; w.x = pg8::cvt_pk_bf16(o1[0], o1[1]); w.y = pg8::cvt_pk_bf16(o1[2], o1[3]); w.z = pg8::cvt_pk_bf16(o2[0], o2[1]); w.w = pg8::cvt_pk_bf16(o2[2], o2[3]);
                            *(v4u*)(qb + (size_t)row * 512 + (pn - 4) * 256 + bj * 128 + cl) = w;
                        } else {
                            v4u w; w.x = pg8::cvt_pk_bf16(o1[0], o1[1]); w.y = pg8::cvt_pk_bf16(o1[2], o1[3]); w.z = pg8::cvt_pk_bf16(o2[0], o2[1]); w.w = pg8::cvt_pk_bf16(o2[2], o2[3]);
                            *(v4u*)(kb + (size_t)row * 512 + (pn - 6) * 256 + bj * 128 + cl) = w;
                            if (row < MR) {
                                float* ob = (row < MP ? okp + (size_t)row * 512 : oks + (size_t)(row - MP) * 512) + (pn - 6) * 256 + bj * 128 + (wc >> 1) * 64 + (wc & 1) * 16 + 4 * fq;
                                *(pg8::f32x4*)ob = o1; *(pg8::f32x4*)(ob + 32) = o2;
                            }
                        }
                    }
                } else if (pn < 10) {
#pragma unroll
                    for (int bj = 0; bj < 2; ++bj) {
                        const pg8::f32x4 v0 = acc[ai][bj][m][0] * s, v1 = acc[ai][bj][m][1] * s; const int col = (pn - 8) * 256 + bj * 128 + cl;
                        v4u w; w.x = pg8::cvt_pk_bf16(v0[0], v0[1]); w.y = pg8::cvt_pk_bf16(v0[2], v0[3]); w.z = pg8::cvt_pk_bf16(v1[0], v1[1]); w.w = pg8::cvt_pk_bf16(v1[2], v1[3]);
                        *(v4u*)(vb + (size_t)row * 512 + col) = w;
                        if (row < MR) { float* ob = (row < MP ? ovp + (size_t)row * 512 : ovs + (size_t)(row - MP) * 512) + col; *(pg8::f32x4*)ob = v0; *(pg8::f32x4*)(ob + 4) = v1; }
                    }
                } else {
                    if (wc == 0 && fq == 0) { const pg8::f32x4 v0 = acc[ai][0][m][0] * s, v1 = acc[ai][0][m][1] * s; *(pg8::f32x4*)(ab + (size_t)row * 8) = v0; *(pg8::f32x4*)(ab + (size_t)row * 8 + 4) = v1; }
                }
            }
    }
};
template <int MODE> struct EpiB {
    static constexpr bool PERM = true, AFTER_DRAIN = false;
    bfu* O; int ldc; const float* rs;
    __device__ __forceinline__ void operator()(const pg8::f32x4 (&acc)[2][2][4][2], const pg8::Unit& u, int wr, int wc, int fr, int fq) const {
        const int rowb = u.pm * 256 + wr * 64 + fr; const int cl = u.pn * 256 + wc * 32 + 8 * fq;
#pragma unroll
        for (int ai = 0; ai < 2; ++ai)
#pragma unroll
            for (int m = 0; m < 4; ++m) {
                const int row = rowb + ai * 128 + m * 16;
                float s = 1.f; if (MODE == 1) s = rsqrtf(rs[row] * (1.f / 1024.f) + 1e-6f);
                bfu* dst = O + (size_t)row * ldc + cl;
#pragma unroll
                for (int bj = 0; bj < 2; ++bj) {
                    pg8::f32x4 v0 = acc[ai][bj][m][0], v1 = acc[ai][bj][m][1];
                    if (MODE == 1) { v0 = v0 * s; v1 = v1 * s;
                        v0[0] = fmaxf(v0[0], 0.f); v0[1] = fmaxf(v0[1], 0.f); v0[2] = fmaxf(v0[2], 0.f); v0[3] = fmaxf(v0[3], 0.f); v1[0] = fmaxf(v1[0], 0.f); v1[1] = fmaxf(v1[1], 0.f); v1[2] = fmaxf(v1[2], 0.f); v1[3] = fmaxf(v1[3], 0.f);
                        v0 = v0 * v0; v1 = v1 * v1; }
                    v4u w; w.x = pg8::cvt_pk_bf16(v0[0], v0[1]); w.y = pg8::cvt_pk_bf16(v0[2], v0[3]); w.z = pg8::cvt_pk_bf16(v1[0], v1[1]); w.w = pg8::cvt_pk_bf16(v1[2], v1[3]);
                    *(v4u*)(dst + bj * 128) = w;
                }
            }
    }
};
template <int MODE> struct EpiH {
    static constexpr bool PERM = true, AFTER_DRAIN = false;
    float* H; bfu* xh; float* rsn; const float* rs; const bfu* pp;
    __device__ __forceinline__ void operator()(const pg8::f32x4 (&acc)[2][2][4][2], const pg8::Unit& u, int wr, int wc, int fr, int fq) const {
        const int rowb = u.pm * 256 + wr * 64 + fr; const int cl = u.pn * 256 + wc * 32 + 8 * fq;
#pragma unroll
        for (int ai = 0; ai < 2; ++ai)
#pragma unroll
            for (int m = 0; m < 4; ++m) {
                const int row = rowb + ai * 128 + m * 16; const bool valid = row < MR; float ss = 0.f;
                if (valid) {
                    float s = 1.f; if (MODE == 3) s = rsqrtf(rs[row] * (1.f / 1024.f) + 1e-6f);
#pragma unroll
                    for (int bj = 0; bj < 2; ++bj) {
                        const size_t off = (size_t)row * 1024 + cl + bj * 128;
                        pg8::f32x4 h0 = *(const pg8::f32x4*)(H + off), h1 = *(const pg8::f32x4*)(H + off + 4); const pg8::f32x4 a0 = acc[ai][bj][m][0], a1 = acc[ai][bj][m][1];
                        if (MODE == 3) { const v4u pw = *(const v4u*)(pp + off);
                            h0[0] += sigm(a0[0] * s) * __uint_as_float(pw.x << 16); h0[1] += sigm(a0[1] * s) * __uint_as_float(pw.x & 0xffff0000u);
                            h0[2] += sigm(a0[2] * s) * __uint_as_float(pw.y << 16); h0[3] += sigm(a0[3] * s) * __uint_as_float(pw.y & 0xffff0000u);
                            h1[0] += sigm(a1[0] * s) * __uint_as_float(pw.z << 16); h1[1] += sigm(a1[1] * s) * __uint_as_float(pw.z & 0xffff0000u);
                            h1[2] += sigm(a1[2] * s) * __uint_as_float(pw.w << 16); h1[3] += sigm(a1[3] * s) * __uint_as_float(pw.w & 0xffff0000u);
                        } else { h0 = h0 + a0; h1 = h1 + a1; }
                        *(pg8::f32x4*)(H + off) = h0; *(pg8::f32x4*)(H + off + 4) = h1;
                        v4u w; w.x = pg8::cvt_pk_bf16(h0[0], h0[1]); w.y = pg8::cvt_pk_bf16(h0[2], h0[3]); w.z = pg8::cvt_pk_bf16(h1[0], h1[1]); w.w = pg8::cvt_pk_bf16(h1[2], h1[3]); *(v4u*)(xh + off) = w;
                        ss += ((h0[0] * h0[0] + h0[1] * h0[1]) + (h0[2] * h0[2] + h0[3] * h0[3])) + ((h1[0] * h1[0] + h1[1] * h1[1]) + (h1[2] * h1[2] + h1[3] * h1[3]));
                    }
                }
                ss += __shfl_xor(ss, 16); ss += __shfl_xor(ss, 32);
                if (valid && fq == 0) unsafeAtomicAdd(rsn + row, ss);
            }
    }
};

__device__ __forceinline__ int win_src(int nd) {
    if (nd < 1024) return nd;
    if (nd < 2048) { const int c = nd - 1024, p = c & 63, grp = c >> 6; const int s = p >> 5, fq_ = (p >> 3) & 3, n_ = (p >> 2) & 1, j_ = p & 3; return 1032 + grp * 64 + n_ * 32 + s * 16 + 4 * fq_ + j_; }
    if (nd < 2560) return 2056 + (nd - 2048);
    if (nd < 3584) return 2568 + (nd - 2560);
    if (nd < 3592) return 1024 + (nd - 3584);
    return -1;
}
template <bool MAP> __device__ __forceinline__ void wt_item(const float* W, int K, int Nsrc, bfu* WT, const float* gain, LAS float* scr, int item, int nblk, int lane) {
    const int kb = item / nblk, nb = item % nblk, k0 = 64 * kb, n0 = 32 * nb;
    const int nd = n0 + (lane & 31); const int src = MAP ? win_src(nd) : nd;
#pragma unroll 8
    for (int i = 0; i < 32; ++i) { const int kk = 2 * i + (lane >> 5); float v = src >= 0 ? W[(size_t)(k0 + kk) * Nsrc + src] : 0.f; if (gain) v *= gain[k0 + kk]; scr[kk * 33 + (lane & 31)] = v; }
    LDS_WAIT(); asm volatile("" ::: "memory");
    const int c = lane & 7;
#pragma unroll
    for (int j = 0; j < 4; ++j) { const int n = (lane >> 3) + 8 * j; const LAS float* s = scr + (8 * c) * 33 + n;
        v4u o; o.x = pk2(s[0 * 33], s[1 * 33]); o.y = pk2(s[2 * 33], s[3 * 33]); o.z = pk2(s[4 * 33], s[5 * 33]); o.w = pk2(s[6 * 33], s[7 * 33]);
        *(v4u*)(WT + (size_t)(n0 + n) * K + k0 + 8 * c) = o; }
    LDS_WAIT(); asm volatile("" ::: "memory");
}
__device__ __forceinline__ void conv_weights(KArgs A, int l, int mask, LAS unsigned char* lds, int gw, int NGW, int lane, int wave) {
    LAS float* scr = (LAS float*)(lds + wave * 16384);
    unsigned char* wb = A->ws + WS_W;
    if (mask & 1) {
        const float* win = A->in[11] + (size_t)l * 1024 * 3592; const float* g = A->in[10] + l * 1024;
        for (int it = gw; it < 16 * 120; it += NGW) wt_item<true>(win, 1024, 3592, (bfu*)(wb + W_IN), g, scr, it, 120, lane);
        const float* wu = A->in[23] + (size_t)l * 64 * 256; const float* au = A->in[25] + (size_t)l * 64 * 256; const float* gu = A->in[26] + (size_t)l * 128 * 256;
        bfu* lr = (bfu*)(wb + W_LR);
        for (int i = gw * 64 + lane; i < 768 * 256; i += NGW * 64) { const int n = i >> 8, k = i & 255; float v = 0.f;
            if (n < 256) { if (k < 64) v = wu[k * 256 + n]; } else if (n < 512) { if (k >= 64 && k < 128) v = au[(k - 64) * 256 + (n - 256)]; } else { if (k >= 128) v = gu[(k - 128) * 256 + (n - 512)]; }
            lr[i] = (bfu)f2bf(v); }
    }
    if (mask & 2) {
        const float* wo = A->in[32] + (size_t)l * 1024 * 1024; const float* f1 = A->in[34] + (size_t)l * 1024 * 4096; const float* f2 = A->in[35] + (size_t)l * 4096 * 1024;
        const float* wg = A->in[37] + (size_t)l * 1024 * 1024; const float* wp = A->in[38] + (size_t)l * 256 * 1024;
        const float* gf = A->in[33] + l * 1024; const float* gp = A->in[36] + l * 1024;
        constexpr int I_O = 16 * 32, I_1 = 16 * 128, I_2 = 64 * 32, I_G = 16 * 32, I_P = 4 * 32;
        for (int it = gw; it < I_O + I_1 + I_2 + I_G + I_P; it += NGW) {
            int r = it;
            if (r < I_O) { wt_item<false>(wo, 1024, 1024, (bfu*)(wb + W_OUT), nullptr, scr, r, 32, lane); continue; } r -= I_O;
            if (r < I_1) { wt_item<false>(f1, 1024, 4096, (bfu*)(wb + W_FF1), gf, scr, r, 128, lane); continue; } r -= I_1;
            if (r < I_2) { wt_item<false>(f2, 4096, 1024, (bfu*)(wb + W_FF2), nullptr, scr, r, 32, lane); continue; } r -= I_2;
            if (r < I_G) { wt_item<false>(wg, 1024, 1024, (bfu*)(wb + W_GATE), gp, scr, r, 32, lane); continue; } r -= I_G;
            wt_item<false>(wp, 256, 1024, (bfu*)(wb + W_PP), nullptr, scr, r, 32, lane);
        }
    }
}
__device__ __forceinline__ void conv_p(KArgs A, int l, bfu* pb, int gtid, int NT) {
    const float* pp = A->in[8] + (size_t)l * MP * 256; const float* ps = A->in[9] + (size_t)l * MS * 256;
    for (int i = gtid; i < MR * 64; i += NT) { const int m = i >> 6, c = (i & 63) * 4;
        const f32x4 v = *(const f32x4*)(m < MP ? pp + (size_t)m * 256 + c : ps + (size_t)(m - MP) * 256 + c);
        v2u w; w.x = pk2(v[0], v[1]); w.y = pk2(v[2], v[3]); *(v2u*)(pb + (size_t)m * 256 + c) = w; }
}
__device__ __forceinline__ void prologue(KArgs A, LAS unsigned char* lds, int gw, int NGW, int lane, int wave, int gtid, int NT) {
    conv_weights(A, 0, 3, lds, gw, NGW, lane, wave);
    unsigned char* ws = A->ws;
    float* rs = (float*)(ws + WS_RS); bfu* xh = (bfu*)slotp(ws, 0, 0); float* H = A->out;
    for (int i = gtid; i < 6 * MPAD; i += NT) rs[MPAD + i] = 0.f;
    for (int m = gw; m < MPAD; m += NGW) {
        if (m < MR) {
            const float* xr = m < MP ? A->in[0] + (size_t)m * 1024 : A->in[1] + (size_t)(m - MP) * 1024; float ss = 0.f;
#pragma unroll
            for (int j = 0; j < 4; ++j) { const f32x4 v = *(const f32x4*)(xr + j * 256 + lane * 4); *(f32x4*)(H + (size_t)m * 1024 + j * 256 + lane * 4) = v;
                v2u w; w.x = pk2(v[0], v[1]); w.y = pk2(v[2], v[3]); *(v2u*)(xh + (size_t)m * 1024 + j * 256 + lane * 4) = w; ss += (v[0] * v[0] + v[1] * v[1]) + (v[2] * v[2] + v[3] * v[3]); }
            ss = wave_sum(ss); if (lane == 0) rs[m] = ss;
        } else {
#pragma unroll
            for (int j = 0; j < 4; ++j) *(v2u*)(xh + (size_t)m * 1024 + j * 256 + lane * 4) = (v2u){0u, 0u};
            if (lane == 0) rs[m] = 1024.f;
        }
    }
    float* rope = (float*)(ws + WS_ROPE);
    for (int i = gtid; i < 8192 * 32; i += NT) { const int pos = i >> 5, k = i & 31;
        const float inv = exp2f(-(float)k * (13.287712379549449f / 32.0f)); const float ang = (float)pos * inv;
        const float nn = rintf(ang * 0.15915494309189535f); const float fr = fmaf(-nn, 1.9353071795864769e-3f, fmaf(-nn, 6.28125f, ang));
        rope[pos * 64 + k] = __cosf(fr); rope[pos * 64 + 32 + k] = __sinf(fr); }
    if (gw == 0) {
        for (int l = 0; l < 2; ++l) {
            const float a = wave_sum(A->in[16][l * 64 + lane] * A->in[17][l * 64 + lane]), b = wave_sum(A->in[18][l * 64 + lane] * A->in[19][l * 64 + lane]);
            const float li = 0.8f - 0.6f * expf(-0.3f * (float)l);
            if (lane == 0) { float* lf = (float*)(ws + WS_CTL + 1024); lf[2 * l] = expf(a) - expf(b) + li; lf[2 * l + 1] = li; }
        }
    }
}

__device__ __forceinline__ void prep_a(KArgs A, int l, int gw, int NGW, int lane) {
    unsigned char* ws = A->ws;
    const bfu* aq = (const bfu*)slotp(ws, l, 2); const float* ab = (const float*)(ws + WS_AB);
    float* sia = (float*)slotp(ws, l, 9); bfu* va = (bfu*)slotp(ws, l, 11); bfu* zs = (bfu*)slotph(ws, l, 11); float* gab = (float*)(ws + WS_GAB);
    const float* cw = A->in[12] + l * 4 * 768; const float* stc = A->in[4] + (size_t)l * 8 * 3 * 768;
    const float* anorm = A->in[15] + l * 64;
    for (int g = gw; g < MR / 4; g += NGW) {
        const int m0 = 4 * g; int t0, L, sb = 0; const bool smp = m0 >= MP; float* aco;
        if (!smp) { t0 = m0 & 8191; L = 8192; aco = A->out + O_ACP + ((size_t)(l * 8 + (m0 >> 13)) * 3) * 768; }
        else { sb = (m0 - MP) >> 4; t0 = (m0 - MP) & 15; L = 16; aco = A->out + O_ACS + ((size_t)(l * 8 + sb) * 3) * 768; }
#pragma unroll 1
        for (int h = 0; h < 4; ++h) {
            float rows[3][7];
#pragma unroll
            for (int gi = 0; gi < 3; ++gi) { const int c = gi * 256 + h * 64 + lane;
#pragma unroll
                for (int r = 0; r < 7; ++r) { const int tt = t0 - 3 + r;
                    rows[gi][r] = tt >= 0 ? bf2f(aq[(size_t)(m0 - 3 + r) * 1024 + c]) : (smp ? stc[((size_t)sb * 3 + (3 + tt)) * 768 + c] : 0.f); } }
            float zv[4];
#pragma unroll
            for (int i = 0; i < 4; ++i) zv[i] = bf2f(aq[(size_t)(m0 + i) * 1024 + 768 + h * 64 + lane]);
            float val[4][3];
#pragma unroll
            for (int gi = 0; gi < 3; ++gi) { const int c = gi * 256 + h * 64 + lane; const float w0 = cw[c], w1 = cw[768 + c], w2 = cw[1536 + c], w3 = cw[2304 + c];
#pragma unroll
                for (int i = 0; i < 4; ++i) { const float y = rows[gi][i] * w0 + rows[gi][i + 1] * w1 + rows[gi][i + 2] * w2 + rows[gi][i + 3] * w3; val[i][gi] = y * sigm(y);
                    if (t0 + i >= L - 3) aco[(size_t)(t0 + i - (L - 3)) * 768 + c] = rows[gi][i + 3]; } }
#pragma unroll
            for (int i = 0; i < 4; ++i) { const int m = m0 + i;
                const float sq = wave_sum(val[i][0] * val[i][0]), sk = wave_sum(val[i][1] * val[i][1]);
                const float qn = val[i][0] * rsqrtf(sq + 1e-6f) * 0.125f, kn = val[i][1] * rsqrtf(sk + 1e-6f);
                float* rec = sia + ((size_t)(h * 8 + (lane >> 3)) * MPAD + m) * 16 + (lane & 7);
                rec[0] = kn; rec[8] = qn;
                va[(size_t)m * 256 + h * 64 + lane] = (bfu)f2bf(val[i][2]);
                zs[(size_t)m * 256 + h * 64 + lane] = (bfu)f2bf(zv[i] * sigm(zv[i]) * anorm[lane]); }
        }
        if (lane < 16) { const int m = m0 + (lane >> 2), hh = lane & 3;
            const float gl = -__expf(A->in[13][l * 4 + hh]) * softplusf(ab[(size_t)m * 8 + hh] + A->in[14][l * 4 + hh]);
            gab[((size_t)hh * MPAD + m) * 2] = __expf(gl); gab[((size_t)hh * MPAD + m) * 2 + 1] = sigm(ab[(size_t)m * 8 + 4 + hh]); }
    }
}
__device__ __forceinline__ void prep_c1(KArgs A, int l, int gw, int NGW, int lane) {
    unsigned char* ws = A->ws;
    const bfu* cr = (const bfu*)slotp(ws, l, 7); bfu* lra = (bfu*)slotp(ws, l, 12);
    const float* mu = A->in[21] + l * 1024; const float* sts = A->in[6] + (size_t)l * 8 * 1024;
    for (int m = gw; m < MR; m += NGW) {
        int t, L, sb = 0; const bool smp = m >= MP; float* cso;
        if (!smp) { t = m & 8191; L = 8192; cso = A->out + O_CSP + (size_t)(l * 8 + (m >> 13)) * 1024; }
        else { sb = (m - MP) >> 4; t = (m - MP) & 15; L = 16; cso = A->out + O_CSS + (size_t)(l * 8 + sb) * 1024; }
#pragma unroll
        for (int i = 0; i < 4; ++i) { const int j = 768 + lane + 64 * i;
            const float cur = bf2f(cr[(size_t)m * 1024 + j]);
            const float prev = t > 0 ? bf2f(cr[(size_t)(m - 1) * 1024 + j]) : (smp ? sts[(size_t)sb * 1024 + j] : 0.f);
            const float c = cur + (prev - cur) * mu[j];
            const float o = i == 0 ? tanhf(c) : (i == 1 ? c : sigm(c));
            lra[(size_t)m * 256 + lane + 64 * i] = (bfu)f2bf(o); }
        if (t == L - 1) {
#pragma unroll
            for (int i = 0; i < 16; ++i) cso[lane + 64 * i] = bf2f(cr[(size_t)m * 1024 + lane + 64 * i]);
        }
    }
}
__device__ __forceinline__ void prep_c2(KArgs A, int l, int bid, int G, int tid) {
    unsigned char* ws = A->ws;
    const bfu* cr = (const bfu*)slotp(ws, l, 7); const bfu* lro = (const bfu*)slotp(ws, l, 13);
    bfu* v2 = (bfu*)slotp(ws, l, 12); bfu* gg = (bfu*)slotph(ws, l, 12);
    float* bonus = (float*)(ws + WS_BONUS); float* gch = (float*)(ws + WS_GCH); float* pairc = (float*)(ws + WS_PAIRC);
    const float* mu = A->in[21] + l * 1024; const float* sts = A->in[6] + (size_t)l * 8 * 1024;
    const int ch = tid & 255, h = ch >> 6, lane = ch & 63, half = tid >> 8;
    float* sic = (float*)slotp(ws, l, h) + ((size_t)(lane >> 3) * MPAD) * 32 + (lane & 7);
    const float mur = mu[ch], muk = mu[256 + ch], muv = mu[512 + ch];
    const float w0 = A->in[22][l * 256 + ch], a0 = A->in[24][l * 256 + ch], kk_ = A->in[27][l * 256 + ch], ka = A->in[28][l * 256 + ch], rk = A->in[29][l * 256 + ch];
    for (int u = bid * 2 + half; u < 1032; u += G * 2) {
        int m0, n; float pr, pk, pv;
        if (u < 1024) { m0 = u * 64; n = 64;
            if ((u & 127) == 0) { pr = pk = pv = 0.f; } else { pr = bf2f(cr[(size_t)(m0 - 1) * 1024 + ch]); pk = bf2f(cr[(size_t)(m0 - 1) * 1024 + 256 + ch]); pv = bf2f(cr[(size_t)(m0 - 1) * 1024 + 512 + ch]); } }
        else { const int sb = u - 1024; m0 = MP + sb * 16; n = 16; pr = sts[(size_t)sb * 1024 + ch]; pk = sts[(size_t)sb * 1024 + 256 + ch]; pv = sts[(size_t)sb * 1024 + 512 + ch]; }
        float cum = 0.f, pkka = 0.f, pkp = 0.f;
#pragma unroll 4
        for (int tt = 0; tt < n; ++tt) { const int m = m0 + tt;
            const float c_r = bf2f(cr[(size_t)m * 1024 + ch]), c_k = bf2f(cr[(size_t)m * 1024 + 256 + ch]), c_v = bf2f(cr[(size_t)m * 1024 + 512 + ch]);
            const float r = c_r + (pr - c_r) * mur, k = c_k + (pk - c_k) * muk, v = c_v + (pv - c_v) * muv; pr = c_r; pk = c_k; pv = c_v;
            const float lw = bf2f(lro[(size_t)m * 768 + ch]), la = bf2f(lro[(size_t)m * 768 + 256 + ch]); const bfu gb = lro[(size_t)m * 768 + 512 + ch];
            const float wl = -0.6065306597126334f * sigm(w0 + lw); const float a = sigm(a0 + la);
            const float kkr = k * kk_; const float kk = kkr * rsqrtf(wave_sum(kkr * kkr) + 1e-6f);
            const float kp = k * (1.f + (a - 1.f) * ka);
            const float Gp = __expf(cum); cum += wl; const float Gc = __expf(cum), iG = __expf(-cum);
            float* rec = sic + (size_t)m * 32;
            rec[0] = kk * Gp; rec[8] = kk * a * iG; rec[16] = kp * iG; rec[24] = r * Gc;
            { const float kka = kk * a; float* pc = pairc + ((size_t)h * (MPAD / 2) + (m >> 1)) * 4;
              if (tt & 1) { const float c22 = wave_sum(pkka * kk), c32 = wave_sum(pkp * kk); if (lane == 0) { pc[0] = c22; pc[1] = c32; } }
              else { const float c24 = wave_sum(kka * r), c34 = wave_sum(kp * r); if (lane == 0) { pc[2] = c24; pc[3] = c34; } }
              pkka = kka; pkp = kp; }
            const float bo = wave_sum(r * kp * rk); if (lane == 0) bonus[(size_t)h * MPAD + m] = bo;
            v2[(size_t)m * 256 + ch] = (bfu)f2bf(v); gg[(size_t)m * 256 + ch] = gb;
        }
        gch[((size_t)h * 1032 + u) * 64 + lane] = __expf(cum);
    }
}
__device__ __forceinline__ void prep_a2(KArgs A, int l, int gw, int NGW, int lane) {
    unsigned char* ws = A->ws; const float* sia = (const float*)slotp(ws, l, 9); float* paird = (float*)(ws + WS_PAIRD);
    for (int task = gw; task < 4 * (MR / 2); task += NGW) { const int h = task & 3, pr = task >> 2, m = 2 * pr;
        const float* rec = sia + ((size_t)(h * 8 + (lane >> 3)) * MPAD + m) * 16 + (lane & 7);
        const float k1 = rec[0], q1 = rec[8], k2 = rec[16];
        const float g12 = wave_sum(k1 * k2), h11 = wave_sum(q1 * k1);
        if (lane == 0) { paird[((size_t)h * (MPAD / 2) + pr) * 2] = g12; paird[((size_t)h * (MPAD / 2) + pr) * 2 + 1] = h11; } }
}
__device__ __forceinline__ void post_attn(KArgs A, int l, int gw, int NGW, int lane) {
    unsigned char* ws = A->ws;
    const bfu* O = (const bfu*)slotp(ws, l, 13); bfu* mix = (bfu*)slotp(ws, l, 7);
    const float* lf = (const float*)(ws + WS_CTL + 1024); const float lam = lf[2 * l], omli = 1.f - lf[2 * l + 1];
    const int h = lane >> 4, e0 = (lane & 15) * 8; const float* bn = A->in[20] + l * 128 + e0;
    float bnv[8];
#pragma unroll
    for (int i = 0; i < 8; ++i) bnv[i] = bn[i] * omli;
    for (int m = gw; m < MP; m += NGW) {
        const v4u a = *(const v4u*)(O + (size_t)m * 1024 + (4 * h + (e0 >> 6)) * 64 + (e0 & 63));
        const v4u b = *(const v4u*)(O + (size_t)m * 1024 + (4 * h + 2 + (e0 >> 6)) * 64 + (e0 & 63));
        float o[8]; float ss = 0.f;
#pragma unroll
        for (int i = 0; i < 4; ++i) { const unsigned aw = a[i], bw = b[i];
            o[2 * i] = __uint_as_float(aw << 16) - lam * __uint_as_float(bw << 16); o[2 * i + 1] = __uint_as_float(aw & 0xffff0000u) - lam * __uint_as_float(bw & 0xffff0000u);
            ss += o[2 * i] * o[2 * i] + o[2 * i + 1] * o[2 * i + 1]; }
        ss += __shfl_xor(ss, 1); ss += __shfl_xor(ss, 2); ss += __shfl_xor(ss, 4); ss += __shfl_xor(ss, 8);
        const float rn = rsqrtf(ss * (1.f / 128.f) + 1e-6f);
        v4u w; w.x = pk2(o[0] * rn * bnv[0], o[1] * rn * bnv[1]); w.y = pk2(o[2] * rn * bnv[2], o[3] * rn * bnv[3]); w.z = pk2(o[4] * rn * bnv[4], o[5] * rn * bnv[5]); w.w = pk2(o[6] * rn * bnv[6], o[7] * rn * bnv[7]);
        *(v4u*)(mix + (size_t)m * 1024 + 256 + h * 128 + e0) = w;
    }
}
__device__ __forceinline__ void post_scan(KArgs A, int l, int gw, int NGW, int lane) {
    unsigned char* ws = A->ws; bfu* mix = (bfu*)slotp(ws, l, 7);
    const bfu* zs = (const bfu*)slotph(ws, l, 11); const bfu* v2 = (const bfu*)slotp(ws, l, 12); const bfu* gg = (const bfu*)slotph(ws, l, 12);
    const float* bonus = (const float*)(ws + WS_BONUS);
    for (int m = gw; m < MR; m += NGW) {
#pragma unroll
        for (int h = 0; h < 4; ++h) {
            bfu* pa = mix + (size_t)m * 1024 + h * 64 + lane; const float o = bf2f(*pa);
            const float ss = wave_sum(o * o) * (1.f / 64.f);
            *pa = (bfu)f2bf(o * rsqrtf(ss + 1e-6f) * bf2f(zs[(size_t)m * 256 + h * 64 + lane]));
            bfu* pc = mix + (size_t)m * 1024 + 768 + h * 64 + lane; const float y = bf2f(*pc);
            const float mu = wave_sum(y) * (1.f / 64.f); const float d = y - mu; const float var = wave_sum(d * d) * (1.f / 64.f);
            const float cy = d * rsqrtf(var + 64e-5f) * A->in[30][l * 256 + h * 64 + lane] + A->in[31][l * 256 + h * 64 + lane];
            *pc = (bfu)f2bf((cy + bonus[(size_t)h * MPAD + m] * bf2f(v2[(size_t)m * 256 + h * 64 + lane])) * bf2f(gg[(size_t)m * 256 + h * 64 + lane]));
        }
    }
}
__device__ __forceinline__ void final_norm(KArgs A, int gw, int NGW, int lane) {
    const float* rs = (const float*)(A->ws + WS_RS) + 6 * (size_t)MPAD; const float* g = A->in[39];
    for (int m = gw; m < MR; m += NGW) { const float s = rsqrtf(rs[m] * (1.f / 1024.f) + 1e-6f);
#pragma unroll
        for (int j = 0; j < 4; ++j) { float* p = A->out + (size_t)m * 1024 + j * 256 + lane * 4; f32x4 v = *(f32x4*)p; const f32x4 gv = *(const f32x4*)(g + j * 256 + lane * 4); v = v * s * gv; *(f32x4*)p = v; } }
}

#define SC_BAR() asm volatile("s_waitcnt lgkmcnt(0)\n\ts_barrier" ::: "memory")
constexpr int SC_RED = 0, SC_SI = 16384, SC_VBUF = 81920, SC_GBUF = 90112, SC_BON = 98304, SC_PC = 98816, SC_YP = 99328;
#define FMAC_DPP(acc, op, s1, J) asm("v_fmac_f32_dpp %0, %1, %2 row_newbcast:" #J " row_mask:0xf bank_mask:0xf" : "+v"(acc) : "v"(op), "v"(s1))
#define DOT8(a0, a1, op, JB0, JB1, JB2, JB3, JB4, JB5, JB6, JB7) do { FMAC_DPP(a0, op, S[0], JB0); FMAC_DPP(a1, op, S[1], JB1); FMAC_DPP(a0, op, S[2], JB2); FMAC_DPP(a1, op, S[3], JB3); \
        FMAC_DPP(a0, op, S[4], JB4); FMAC_DPP(a1, op, S[5], JB5); FMAC_DPP(a0, op, S[6], JB6); FMAC_DPP(a1, op, S[7], JB7); } while (0)
#define DOT8_LO(a0, a1, op) DOT8(a0, a1, op, 0, 1, 2, 3, 4, 5, 6, 7)
#define DOT8_HI(a0, a1, op) DOT8(a0, a1, op, 8, 9, 10, 11, 12, 13, 14, 15)
#define AXPY8_LO(op, s) do { FMAC_DPP(S[0], op, s, 0); FMAC_DPP(S[1], op, s, 1); FMAC_DPP(S[2], op, s, 2); FMAC_DPP(S[3], op, s, 3); FMAC_DPP(S[4], op, s, 4); FMAC_DPP(S[5], op, s, 5); FMAC_DPP(S[6], op, s, 6); FMAC_DPP(S[7], op, s, 7); } while (0)
#define AXPY8_HI(op, s) do { FMAC_DPP(S[0], op, s, 8); FMAC_DPP(S[1], op, s, 9); FMAC_DPP(S[2], op, s, 10); FMAC_DPP(S[3], op, s, 11); FMAC_DPP(S[4], op, s, 12); FMAC_DPP(S[5], op, s, 13); FMAC_DPP(S[6], op, s, 14); FMAC_DPP(S[7], op, s, 15); } while (0)
#define PKF(a, b, c) __builtin_elementwise_fma((a), (b), (c))
#define AXPYV(X0, X1, s) do { const f32x2 s_ = (f32x2){(s), (s)}; f32x2 p0_ = (f32x2){S[0], S[1]}, p1_ = (f32x2){S[2], S[3]}, p2_ = (f32x2){S[4], S[5]}, p3_ = (f32x2){S[6], S[7]}; \
        p0_ = PKF(((f32x2){X0[0], X0[1]}), s_, p0_); p1_ = PKF(((f32x2){X0[2], X0[3]}), s_, p1_); p2_ = PKF(((f32x2){X1[0], X1[1]}), s_, p2_); p3_ = PKF(((f32x2){X1[2], X1[3]}), s_, p3_); \
        S[0] = p0_[0]; S[1] = p0_[1]; S[2] = p1_[0]; S[3] = p1_[1]; S[4] = p2_[0]; S[5] = p2_[1]; S[6] = p3_[0]; S[7] = p3_[1]; } while (0)
#define RED8(V) do { const LAS f32x4* rr_ = (const LAS f32x4*)red + par_ * 512 + lane; const f32x4 q0_ = rr_[0], q1_ = rr_[64], q2_ = rr_[128], q3_ = rr_[192], q4_ = rr_[256], q5_ = rr_[320], q6_ = rr_[384], q7_ = rr_[448]; \
        V = ((q0_ + q1_) + (q2_ + q3_)) + ((q4_ + q5_) + (q6_ + q7_)); } while (0)

#define SWAPSUM(v) do { const unsigned u_ = __float_as_uint(v); auto rr_ = __builtin_amdgcn_permlane32_swap(u_, u_, false, false); v = __uint_as_float(rr_[0]) + __uint_as_float(rr_[1]); } while (0)
#define DOT4_LO(a0, a1, op) do { FMAC_DPP(a0, op, S[0], 0); FMAC_DPP(a1, op, S[1], 1); FMAC_DPP(a0, op, S[2], 2); FMAC_DPP(a1, op, S[3], 3); } while (0)
#define DOT4_HI(a0, a1, op) do { FMAC_DPP(a0, op, S[0], 4); FMAC_DPP(a1, op, S[1], 5); FMAC_DPP(a0, op, S[2], 6); FMAC_DPP(a1, op, S[3], 7); } while (0)
#define AXPY4(X, s) do { const f32x2 s_ = (f32x2){(s), (s)}; f32x2 p0_ = (f32x2){S[0], S[1]}, p1_ = (f32x2){S[2], S[3]}; p0_ = PKF(((f32x2){X[0], X[1]}), s_, p0_); p1_ = PKF(((f32x2){X[2], X[3]}), s_, p1_); S[0] = p0_[0]; S[1] = p0_[1]; S[2] = p1_[0]; S[3] = p1_[1]; } while (0)
__device__ __forceinline__ void scan_rwkv(KArgs A, int l, LAS unsigned char* lds, int h, int half, int m0, int L, int BL, int BLS, int chunk0, const float* st_in, float* st_out, int tid) {
    unsigned char* ws = A->ws;
    const int lane = tid & 63, wid = __builtin_amdgcn_readfirstlane(tid >> 6); const int kh = lane >> 5, r = lane & 31, row = 32 * half + r;
    LAS float* red = (LAS float*)(lds + SC_RED); LAS float* yred = (LAS float*)(lds + SC_YP);
    LAS float* sib = (LAS float*)(lds + SC_SI) + wid * 1024;
    LAS bfu* vbuf = (LAS bfu*)(lds + SC_VBUF); LAS float* pcs = (LAS float*)(lds + SC_PC);
    const bfu* v2 = (const bfu*)slotp(ws, l, 12);
    const float* pairc = (const float*)(ws + WS_PAIRC) + ((size_t)h * (MPAD / 2) + (m0 >> 1)) * 4;
    const float* gch = (const float*)(ws + WS_GCH) + ((size_t)h * 1032 + chunk0) * 64 + 8 * wid + 4 * kh;
    bfu* mix = (bfu*)slotp(ws, l, 7);
    const float* P = (const float*)slotp(ws, l, h) + ((size_t)wid * MPAD + m0) * 32;
    float S[4];
#pragma unroll
    for (int j = 0; j < 4; ++j) S[j] = st_in ? st_in[row * 64 + 8 * wid + 4 * kh + j] : 0.f;
    const int nblk = L >> BLS; const int srow = tid >> 4, sc4 = tid & 15; const bool sval = srow < BL;
    const int nsi = BL >> 3;
    f32x4 ssi[4]; v2u sv = {0, 0}; float sp_ = 0.f;
#define RW_STAGE(c) do { const float* ps_ = P + (size_t)(c) * BL * 32 + lane * 4; \
        _Pragma("unroll") for (int i_ = 0; i_ < 4; ++i_) if (i_ < nsi) ssi[i_] = *(const f32x4*)(ps_ + i_ * 256); \
        if (sval) { const size_t mm = (size_t)(m0 + (c) * BL + srow) * 256 + h * 64 + sc4 * 4; sv = *(const v2u*)(v2 + mm); } \
        if (tid < 2 * BL) sp_ = pairc[(size_t)(c) * BL * 2 + tid]; } while (0)
#define RW_COMMIT(c) do { LAS float* pd_ = sib + ((c) & 1) * 8192 + lane * 4; \
        _Pragma("unroll") for (int i_ = 0; i_ < 4; ++i_) if (i_ < nsi) *(LAS f32x4*)(pd_ + i_ * 256) = ssi[i_]; \
        if (sval) { *(LAS v2u*)(vbuf + ((c) & 1) * 2048 + srow * 64 + sc4 * 4) = sv; } \
        if (tid < 2 * BL) pcs[((c) & 1) * 64 + tid] = sp_; } while (0)
    __syncthreads();
    RW_STAGE(0); RW_COMMIT(0); if (nblk > 1) RW_STAGE(1);
    const int dsel = ((lane & 4) ? 24 : 0) + 4 * kh + (lane & 3);
    float ca0, ca1, cb0 = 0.f, cb1 = 0.f; f32x4 cau[4], cbu[4];
#define RW_LOADOPS(D, T) do { const LAS float* pb_ = sib + ((((T) >> BLS) & 1) * 8192) + ((T) & (BL - 1)) * 32; \
        D##0 = pb_[dsel]; D##1 = pb_[32 + dsel]; const LAS f32x4* pu_ = (const LAS f32x4*)(pb_ + 4 * kh); \
        D##u[0] = pu_[2]; D##u[1] = pu_[4]; D##u[2] = pu_[10]; D##u[3] = pu_[12]; } while (0)
    RW_LOADOPS(ca, 0);
#define RW_FINAL(T) do { const int tf_ = (T); \
        const LAS float* yr_ = yred + (tf_ & 15) * 512 + lane; const float y_ = ((yr_[0] + yr_[64]) + (yr_[128] + yr_[192])) + ((yr_[256] + yr_[320]) + (yr_[384] + yr_[448])); \
        if (lane < 32) mix[(size_t)(m0 + tf_) * 1024 + 768 + h * 64 + row] = (bfu)f2bf(y_); } while (0)
#define RW_ROUND(C, N, T) do { const int par_ = ((T) >> 1) & 1; \
        float d1a = 0.f, d1b = 0.f, d2a = 0.f, d2b = 0.f, f1a = 0.f, f1b = 0.f; \
        DOT4_LO(d1a, d1b, C##0); DOT4_LO(d2a, d2b, C##1); DOT4_HI(f1a, f1b, C##0); \
        float d1 = d1a + d1b, d2 = d2a + d2b, f1 = f1a + f1b; SWAPSUM(d1); SWAPSUM(d2); SWAPSUM(f1); \
        ((LAS f32x4*)red)[(par_ * 8 + wid) * 64 + lane] = (f32x4){d1, d2, f1, 0.f}; \
        SC_BAR(); \
        f32x4 tot_; RED8(tot_); \
        const int bo_ = (((T) >> BLS) & 1), to_ = (T) & (BL - 1); \
        const float v1 = bf2f(vbuf[bo_ * 2048 + to_ * 64 + row]), v2_ = bf2f(vbuf[bo_ * 2048 + to_ * 64 + 64 + row]); const f32x4 pc_ = *(const LAS f32x4*)(pcs + bo_ * 64 + to_ * 2); \
        asm volatile("" ::: "memory"); \
        if ((T) + 2 < L) RW_LOADOPS(N, (T) + 2); \
        __builtin_amdgcn_sched_barrier(0); \
        const float sa1 = -tot_[0]; const float sa2 = -(tot_[1] + sa1 * pc_[0] + v1 * pc_[1]); const float y1 = tot_[2] + sa1 * pc_[2] + v1 * pc_[3]; \
        AXPY4(C##u[1], v1); AXPY4(C##u[0], sa1); AXPY4(C##u[3], v2_); AXPY4(C##u[2], sa2); \
        float y2a = 0.f, y2b = 0.f; DOT4_HI(y2a, y2b, C##1); float y2 = y2a + y2b; SWAPSUM(y2); \
        yred[((T) & 15) * 512 + wid * 64 + lane] = y1 * 0.125f; yred[(((T) + 1) & 15) * 512 + wid * 64 + lane] = y2; } while (0)
    for (int c = 0; c < nblk; ++c) {
        for (int tt = 0; tt < BL; tt += 4) {
            const int t = c * BL + tt;
            if (tt == (BL >> 1) && c + 1 < nblk) { RW_COMMIT(c + 1); if (c + 2 < nblk) RW_STAGE(c + 2); }
            RW_ROUND(ca, cb, t);
            RW_ROUND(cb, ca, t + 2);
            if (((t + 3) & 15) == 15) { SC_BAR(); RW_FINAL(t - 12 + 2 * wid); RW_FINAL(t - 11 + 2 * wid); }
        }
        if ((((c + 1) << BLS) & 63) == 0 || c + 1 == nblk) {
            const float* ge = gch + (size_t)((c << BLS) >> 6) * 64;
#pragma unroll
            for (int j = 0; j < 4; ++j) S[j] *= ge[j];
        }
    }
#pragma unroll
    for (int j = 0; j < 4; ++j) st_out[row * 64 + 8 * wid + 4 * kh + j] = S[j];
    __syncthreads();
#undef RW_STAGE
#undef RW_COMMIT
#undef RW_LOADOPS
#undef RW_FINAL
#undef RW_ROUND
}

__device__ __forceinline__ void scan_delta(KArgs A, int l, LAS unsigned char* lds, int h, int half, int m0, int L, int BL, int BLS, const float* st_in, float* st_out, int tid) {
    unsigned char* ws = A->ws;
    const int lane = tid & 63, wid = __builtin_amdgcn_readfirstlane(tid >> 6); const int kh = lane >> 5, r = lane & 31, row = 32 * half + r;
    LAS float* red = (LAS float*)(lds + SC_RED); LAS float* yred = (LAS float*)(lds + SC_YP);
    LAS float* sib = (LAS float*)(lds + SC_SI) + wid * 512;
    LAS bfu* vbuf = (LAS bfu*)(lds + SC_VBUF); LAS float* gab = (LAS float*)(lds + SC_BON); LAS float* pds = (LAS float*)(lds + SC_PC);
    const bfu* va = (const bfu*)slotp(ws, l, 11);
    bfu* mix = (bfu*)slotp(ws, l, 7);
    const float* P = (const float*)slotp(ws, l, 9) + ((size_t)(h * 8 + wid) * MPAD + m0) * 16;
    const float* PG = (const float*)(ws + WS_GAB) + ((size_t)h * MPAD + m0) * 2;
    const float* paird = (const float*)(ws + WS_PAIRD) + ((size_t)h * (MPAD / 2) + (m0 >> 1)) * 2;
    float S[4];
#pragma unroll
    for (int j = 0; j < 4; ++j) S[j] = st_in ? st_in[(8 * wid + 4 * kh + j) * 64 + row] : 0.f;
    const int nblk = L >> BLS; const int srow = tid >> 4, sc4 = tid & 15; const bool sval = srow < BL;
    const int nsi = BL >> 4;
    f32x4 ssi[2]; v2u sv = {0, 0}; float sb_ = 0.f, sp_ = 0.f;
#define DL_STAGE(c) do { const float* ps_ = P + (size_t)(c) * BL * 16 + lane * 4; \
        _Pragma("unroll") for (int i_ = 0; i_ < 2; ++i_) if (i_ < nsi) ssi[i_] = *(const f32x4*)(ps_ + i_ * 256); \
        if (sval) { const size_t mm = (size_t)(m0 + (c) * BL + srow) * 256 + h * 64 + sc4 * 4; sv = *(const v2u*)(va + mm); } \
        if (tid < 2 * BL) sb_ = PG[(size_t)(c) * BL * 2 + tid]; if (tid < BL) sp_ = paird[(size_t)(c) * BL + tid]; } while (0)
#define DL_COMMIT(c) do { LAS float* pd_ = sib + ((c) & 1) * 4096 + lane * 4; \
        _Pragma("unroll") for (int i_ = 0; i_ < 2; ++i_) if (i_ < nsi) *(LAS f32x4*)(pd_ + i_ * 256) = ssi[i_]; \
        if (sval) { *(LAS v2u*)(vbuf + ((c) & 1) * 2048 + srow * 64 + sc4 * 4) = sv; } \
        if (tid < 2 * BL) gab[((c) & 1) * 64 + tid] = sb_; if (tid < BL) pds[((c) & 1) * 32 + tid] = sp_; } while (0)
    __syncthreads();
    DL_STAGE(0); DL_COMMIT(0); if (nblk > 1) DL_STAGE(1);
    const int dsel = ((lane & 4) ? 8 : 0) + 4 * kh + (lane & 3);
    float ca0, ca1, cb0 = 0.f, cb1 = 0.f; f32x4 cau[2], cbu[2];
#define DL_LOADOPS(D, T) do { const LAS float* pb_ = sib + ((((T) >> BLS) & 1) * 4096) + ((T) & (BL - 1)) * 16; D##0 = pb_[dsel]; D##1 = pb_[16 + dsel]; \
        const LAS f32x4* pu_ = (const LAS f32x4*)(pb_ + 4 * kh); D##u[0] = pu_[0]; D##u[1] = pu_[4]; } while (0)
    DL_LOADOPS(ca, 0);
#define DL_FINAL(T) do { const int tf_ = (T); \
        const LAS float* yr_ = yred + (tf_ & 15) * 512 + lane; const float o_ = ((yr_[0] + yr_[64]) + (yr_[128] + yr_[192])) + ((yr_[256] + yr_[320]) + (yr_[384] + yr_[448])); \
        if (lane < 32) mix[(size_t)(m0 + tf_) * 1024 + h * 64 + row] = (bfu)f2bf(o_); } while (0)
#define DL_ROUND(C, N, T) do { const int par_ = ((T) >> 1) & 1; \
        float d1a = 0.f, d1b = 0.f, d2a = 0.f, d2b = 0.f, f1a = 0.f, f1b = 0.f; \
        DOT4_LO(d1a, d1b, C##0); DOT4_LO(d2a, d2b, C##1); DOT4_HI(f1a, f1b, C##0); \
        float d1 = d1a + d1b, d2 = d2a + d2b, f1 = f1a + f1b; SWAPSUM(d1); SWAPSUM(d2); SWAPSUM(f1); \
        ((LAS f32x4*)red)[(par_ * 8 + wid) * 64 + lane] = (f32x4){d1, d2, f1, 0.f}; \
        SC_BAR(); \
        f32x4 tot_; RED8(tot_); \
        const int bo_ = (((T) >> BLS) & 1), to_ = (T) & (BL - 1); \
        const float v1 = bf2f(vbuf[bo_ * 2048 + to_ * 64 + row]), v2_ = bf2f(vbuf[bo_ * 2048 + to_ * 64 + 64 + row]); \
        const f32x4 ab_ = *(const LAS f32x4*)(gab + bo_ * 64 + to_ * 2); const f32x2 pd2_ = *(const LAS f32x2*)(pds + bo_ * 32 + to_); \
        asm volatile("" ::: "memory"); \
        if ((T) + 2 < L) DL_LOADOPS(N, (T) + 2); \
        __builtin_amdgcn_sched_barrier(0); \
        const float a1 = ab_[0], a2 = ab_[2]; const float dl1 = ab_[1] * (v1 - a1 * tot_[0]); const float dl2 = ab_[3] * (v2_ - a2 * (a1 * tot_[1] + pd2_[0] * dl1)); \
        const float o1 = a1 * tot_[2] + pd2_[1] * dl1; const float a12 = a1 * a2, dl1s = a2 * dl1; \
        _Pragma("unroll") for (int j = 0; j < 4; ++j) S[j] *= a12; \
        AXPY4(C##u[0], dl1s); AXPY4(C##u[1], dl2); \
        float y2a = 0.f, y2b = 0.f; DOT4_HI(y2a, y2b, C##1); float y2 = y2a + y2b; SWAPSUM(y2); \
        yred[((T) & 15) * 512 + wid * 64 + lane] = o1 * 0.125f; yred[(((T) + 1) & 15) * 512 + wid * 64 + lane] = y2; } while (0)
    for (int c = 0; c < nblk; ++c) {
        for (int tt = 0; tt < BL; tt += 4) {
            const int t = c * BL + tt;
            if (tt == (BL >> 1) && c + 1 < nblk) { DL_COMMIT(c + 1); if (c + 2 < nblk) DL_STAGE(c + 2); }
            DL_ROUND(ca, cb, t);
            DL_ROUND(cb, ca, t + 2);
            if (((t + 3) & 15) == 15) { SC_BAR(); DL_FINAL(t - 12 + 2 * wid); DL_FINAL(t - 11 + 2 * wid); }
        }
    }
#pragma unroll
    for (int j = 0; j < 4; ++j) st_out[(8 * wid + 4 * kh + j) * 64 + row] = S[j];
    __syncthreads();
#undef DL_STAGE
#undef DL_COMMIT
#undef DL_LOADOPS
#undef DL_FINAL
#undef DL_ROUND
}

__device__ __forceinline__ void sample_attn(KArgs A, int l, LAS unsigned char* lds, int unit, int tid) {
    unsigned char* ws = A->ws;
    const int sb = unit >> 2, h = unit & 3;
    LAS float* qs = (LAS float*)lds;
    LAS float* sc = qs + 2048;
    LAS float* scl = sc + 1024;
    LAS float* ssq = scl + 32;
    LAS float* lsum = ssq + 512;
    const bfu* qb = (const bfu*)slotp(ws, l, 4); bfu* mix = (bfu*)slotp(ws, l, 7);
    const float* ck = A->in[2] + (size_t)(l * 8 + sb) * 2048 * 512 + h * 128; const float* cv = A->in[3] + (size_t)(l * 8 + sb) * 2048 * 512 + h * 128;
    const float* nk = A->out + O_BKS + (size_t)(l * 8 + sb) * 16 * 512 + h * 128; const float* nv = A->out + O_BVS + (size_t)(l * 8 + sb) * 16 * 512 + h * 128;
    const float* lf = (const float*)(ws + WS_CTL + 1024); const float lam = lf[2 * l], omli = 1.f - lf[2 * l + 1];
    __syncthreads();
    for (int i = tid; i < 2048; i += NTHR) { const int map = i >> 10, qi = (i >> 6) & 15, p = i & 63; const int s = p >> 5, fq_ = (p >> 3) & 3, n_ = (p >> 2) & 1, j_ = p & 3;
        qs[(map * 16 + qi) * 64 + n_ * 32 + s * 16 + 4 * fq_ + j_] = bf2f(qb[(size_t)(MP + sb * 16 + qi) * 512 + h * 128 + map * 64 + p]); }
    float mrun = -1e30f, lrun = 0.f;
    const int qi = tid & 15, kj = tid >> 4, eg = tid >> 4;
    f32x4 acc0 = {0.f, 0.f, 0.f, 0.f}, acc1 = {0.f, 0.f, 0.f, 0.f};
    __syncthreads();
    for (int tile = 0; tile < 65; ++tile) {
        const int kidx = tile * 32 + kj;
        float s1 = -1e30f, s2 = -1e30f;
        if (kidx < 2064) { const float* kr = kidx < 2048 ? ck + (size_t)kidx * 512 : nk + (size_t)(kidx - 2048) * 512; s1 = 0.f; s2 = 0.f;
#pragma unroll 4
            for (int d = 0; d < 64; d += 4) { const f32x4 k1 = *(const f32x4*)(kr + d), k2 = *(const f32x4*)(kr + 64 + d); const LAS float* q1 = qs + qi * 64 + d; const LAS float* q2 = qs + (16 + qi) * 64 + d;
                s1 += q1[0] * k1[0] + q1[1] * k1[1] + q1[2] * k1[2] + q1[3] * k1[3]; s2 += q2[0] * k2[0] + q2[1] * k2[1] + q2[2] * k2[2] + q2[3] * k2[3]; } }
        sc[qi * 32 + kj] = s1; sc[(16 + qi) * 32 + kj] = s2;
        __syncthreads();
        if (tid < 32) { LAS float* r = sc + tid * 32; float mx = mrun;
#pragma unroll 8
            for (int j = 0; j < 32; ++j) mx = fmaxf(mx, r[j]);
            const float f = exp2f(mrun - mx); float su = 0.f;
#pragma unroll 8
            for (int j = 0; j < 32; ++j) { const float p = exp2f(r[j] - mx); r[j] = p; su += p; }
            lrun = lrun * f + su; mrun = mx; scl[tid] = f; }
        __syncthreads();
        { const float f0 = scl[qi], f1 = scl[16 + qi]; acc0 = acc0 * f0; acc1 = acc1 * f1;
            const int nk_ = tile < 64 ? 32 : 16;
            for (int j = 0; j < nk_; ++j) { const int kx = tile * 32 + j; const float* vr = (kx < 2048 ? cv + (size_t)kx * 512 : nv + (size_t)(kx - 2048) * 512) + eg * 4;
                const f32x4 v = *(const f32x4*)vr; acc0 = acc0 + v * sc[qi * 32 + j]; acc1 = acc1 + v * sc[(16 + qi) * 32 + j]; } }
        __syncthreads();
    }
    if (tid < 32) lsum[tid] = lrun;
    __syncthreads();
    const f32x4 o = acc0 * (1.f / lsum[qi]) - acc1 * (lam / lsum[16 + qi]);
    ssq[qi * 32 + eg] = (o[0] * o[0] + o[1] * o[1]) + (o[2] * o[2] + o[3] * o[3]);
    __syncthreads();
    float ss = 0.f;
#pragma unroll 8
    for (int j = 0; j < 32; ++j) ss += ssq[qi * 32 + j];
    const float rn = rsqrtf(ss * (1.f / 128.f) + 1e-6f) * omli; const float* bn = A->in[20] + l * 128 + eg * 4;
    v2u w; w.x = pk2(o[0] * rn * bn[0], o[1] * rn * bn[1]); w.y = pk2(o[2] * rn * bn[2], o[3] * rn * bn[3]);
    *(v2u*)(mix + (size_t)(MP + sb * 16 + qi) * 1024 + 256 + h * 128 + eg * 4) = w;
    __syncthreads();
}

#define PH_BEGIN \
        KArgs A = (KArgs)__builtin_amdgcn_kernarg_segment_ptr(); \
        int tid = wv * 64 + (int)__builtin_amdgcn_mbcnt_hi(~0u, __builtin_amdgcn_mbcnt_lo(~0u, 0u)); asm volatile("" : "+v"(tid)); tid &= 511; \
        const int bid = blockIdx.x, G = gridDim.x; \
        const int lane = tid & 63, wave = wv; \
        const int gw = bid * NWAVES + wave, NGW = G * NWAVES, gtid = bid * NTHR + tid, NT = G * NTHR; \
        unsigned char* ws = A->ws; float* rsb = (float*)(ws + WS_RS); unsigned char* wb = ws + WS_W; \
        (void)lane; (void)gw; (void)NGW; (void)gtid; (void)NT; (void)rsb; (void)wb;
#define IN(k) (lo <= (k) && (k) < hi)
__device__ __forceinline__ void grid_bar(unsigned* bar, unsigned target, bool leader) {
    asm volatile("s_waitcnt vmcnt(0) lgkmcnt(0)" ::: "memory");
    __syncthreads();
    if (leader) {
        __builtin_amdgcn_fence(__ATOMIC_RELEASE, "agent");
        asm volatile("s_waitcnt vmcnt(0)" ::: "memory");
        __hip_atomic_fetch_add(bar, 1u, __ATOMIC_RELAXED, __HIP_MEMORY_SCOPE_AGENT);
        unsigned spins = 0;
        while (__hip_atomic_load(bar, __ATOMIC_RELAXED, __HIP_MEMORY_SCOPE_AGENT) < target) { __builtin_amdgcn_s_sleep(2); if (++spins > (1u << 27)) break; }
        __builtin_amdgcn_fence(__ATOMIC_ACQUIRE, "agent");
        asm volatile("s_waitcnt vmcnt(0)" ::: "memory");
    }
    __syncthreads();
}
#define SEAM(k) do { if ((k) + 1 < hi) { ++nbar; grid_bar((unsigned*)(ws + WS_CTL + 4096), nbar * (unsigned)G, tid == 0); } } while (0)
#define SEAM_SKIP(k) do { } while (0)
__global__ void __launch_bounds__(NTHR, 2) hybrid_fwd(Args Aval) {
    extern __shared__ __attribute__((aligned(16))) unsigned char lds_raw[];
    LAS unsigned char* lds = (LAS unsigned char*)lds_raw;
    const int lo = Aval.ph_lo, hi = Aval.ph_hi; unsigned nbar = 0u;
    if (Aval.ph_lo < 0) cg::this_grid().sync();
    const int wv = __builtin_amdgcn_readfirstlane(threadIdx.x >> 6);
    if (IN(0)) { PH_BEGIN prologue(A, lds, gw, NGW, lane, wave, gtid, NT); SEAM(0); }
    { constexpr int l = 0;

        const int p0 = 1 + 11 * l;
        if (IN(p0 + 0)) { PH_BEGIN
            pg8::Gemm g{(const pg8::bf16_t*)slotp(ws, l, 0), (const pg8::bf16_t*)(wb + W_IN), MPAD, NIN, 1024};
            pg8::StaticOrder S; S.init(MPAD, NIN, G, bid);
            EpiG1 E{rsb + (size_t)(3 * l) * MPAD, (bfu*)slotp(ws, l, 2), (bfu*)slotp(ws, l, 4), (bfu*)slotp(ws, l, 5), (bfu*)slotp(ws, l, 6), (bfu*)slotp(ws, l, 7), (float*)(ws + WS_AB), (const float*)(ws + WS_ROPE),
                    A->out + O_BKP + (size_t)l * MP * 512, A->out + O_BVP + (size_t)l * MP * 512, A->out + O_BKS + (size_t)l * MS * 512, A->out + O_BVS + (size_t)l * MS * 512};
            pg8::gemm_phase<EpiG1, pg8::StaticOrder, true, true>((PG8_LAS unsigned char*)lds, g, S, E, wv);
            SEAM(p0 + 0); }
        if (IN(p0 + 1)) { PH_BEGIN
            prep_a(A, l, gw, NGW, lane); prep_c1(A, l, gw, NGW, lane);
            if (l == 1) conv_weights(A, 1, 2, lds, gw, NGW, lane, wave);
            SEAM(p0 + 1); }
        if (IN(p0 + 2)) { PH_BEGIN
            pg8::Gemm g{(const pg8::bf16_t*)slotp(ws, l, 12), (const pg8::bf16_t*)(wb + W_LR), MPAD, 768, 256};
            pg8::StaticOrder S; S.init(MPAD, 768, G, bid);
            EpiB<0> E{(bfu*)slotp(ws, l, 13), 768, nullptr};
            pg8::gemm_phase<EpiB<0>, pg8::StaticOrder, true, true>((PG8_LAS unsigned char*)lds, g, S, E, wv);
            SEAM(p0 + 2); }
        if (IN(p0 + 3)) { PH_BEGIN prep_c2(A, l, bid, G, tid); prep_a2(A, l, gw, NGW, lane);
            SEAM(p0 + 3); }
        if (IN(p0 + 4)) { PH_BEGIN
            if (bid < 64) { const int st = bid >> 1, half = bid & 1, b = st >> 2, h = st & 3;
                scan_rwkv(A, l, lds, h, half, b * 8192, 8192, 32, 5, b * 128, nullptr, A->out + O_CWP + (size_t)((l * 8 + b) * 4 + h) * 4096, tid);
                scan_rwkv(A, l, lds, h, half, MP + b * 16, 16, 16, 4, 1024 + b, A->in[7] + (size_t)((l * 8 + b) * 4 + h) * 4096, A->out + O_CWS + (size_t)((l * 8 + b) * 4 + h) * 4096, tid);
            } else if (bid < 128) { const int st = (bid - 64) >> 1, half = bid & 1, b = st >> 2, h = st & 3;
                scan_delta(A, l, lds, h, half, b * 8192, 8192, 32, 5, nullptr, A->out + O_ADP + (size_t)((l * 8 + b) * 4 + h) * 4096, tid);
                scan_delta(A, l, lds, h, half, MP + b * 16, 16, 16, 4, A->in[5] + (size_t)((l * 8 + b) * 4 + h) * 4096, A->out + O_ADS + (size_t)((l * 8 + b) * 4 + h) * 4096, tid);
            } else if (bid < 160) { sample_attn(A, l, lds, bid - 128, tid); }
            __syncthreads();
            unsigned* ctr = (unsigned*)(ws + WS_CTL) + 16 * l; volatile LAS unsigned* qw = (volatile LAS unsigned*)(lds + MISC_OFF);
            const attn_body::bf16* Q = (const attn_body::bf16*)slotp(ws, l, 4); const attn_body::bf16* K = (const attn_body::bf16*)slotp(ws, l, 5); const attn_body::bf16* V = (const attn_body::bf16*)slotp(ws, l, 6);
            attn_body::bf16* O = (attn_body::bf16*)slotp(ws, l, 13);
            for (;;) {
                if (tid == 0) qw[0] = atomicAdd(ctr, 1u);
                __syncthreads();
                const unsigned u = qw[0];
                __syncthreads();
                if (u >= 4096u) break;
                const int qb = 31 - (int)(u >> 7), bh = (int)(u & 127);
                attn_body::attn_unit<8>(bh >> 4, bh & 15, qb, Q, K, V, O, (char*)lds_raw, wv);
            }
            SEAM(p0 + 4); }
        if (IN(p0 + 5)) { PH_BEGIN
            post_attn(A, l, gw, NGW, lane); post_scan(A, l, gw, NGW, lane);
            conv_p(A, l, (bfu*)slotp(ws, l, 10), gtid, NT);
            if (l == 0) conv_weights(A, 1, 1, lds, gw, NGW, lane, wave);
            SEAM(p0 + 5); }
        if (IN(p0 + 6)) { PH_BEGIN
            pg8::Gemm g{(const pg8::bf16_t*)slotp(ws, l, 7), (const pg8::bf16_t*)(wb + W_OUT), MPAD, 1024, 1024};
            pg8::StaticOrder S; S.init(MPAD, 1024, G, bid);
            EpiH<2> E{A->out, (bfu*)slotp(ws, l, 0), rsb + (size_t)(3 * l + 1) * MPAD, nullptr, nullptr};
            pg8::gemm_phase<EpiH<2>, pg8::StaticOrder, true, true>((PG8_LAS unsigned char*)lds, g, S, E, wv);
            SEAM(p0 + 6); }
        if (IN(p0 + 7)) { PH_BEGIN
            pg8::Gemm g{(const pg8::bf16_t*)slotp(ws, l, 0), (const pg8::bf16_t*)(wb + W_FF1), MPAD, FFD, 1024};
            pg8::StaticOrder S; S.init(MPAD, FFD, G, bid);
            EpiB<1> E{(bfu*)slotp(ws, l, 2), FFD, rsb + (size_t)(3 * l + 1) * MPAD};
            pg8::gemm_phase<EpiB<1>, pg8::StaticOrder, true, true>((PG8_LAS unsigned char*)lds, g, S, E, wv);
            {
                pg8::Gemm g2{(const pg8::bf16_t*)slotp(ws, l, 10), (const pg8::bf16_t*)(wb + W_PP), MPAD, 1024, 256};
                pg8::StaticOrder S2; S2.init(MPAD, 1024, G, bid);
                EpiB<0> E2{(bfu*)slotp(ws, l, 11), 1024, nullptr};
                pg8::gemm_phase<EpiB<0>, pg8::StaticOrder, true, true>((PG8_LAS unsigned char*)lds, g2, S2, E2, wv); }
            SEAM(p0 + 7); }
        if (IN(p0 + 8)) { PH_BEGIN
            pg8::Gemm g{(const pg8::bf16_t*)slotp(ws, l, 2), (const pg8::bf16_t*)(wb + W_FF2), MPAD, 1024, FFD};
            pg8::StaticOrder S; S.init(MPAD, 1024, G, bid);
            EpiH<2> E{A->out, (bfu*)slotp(ws, l, 0), rsb + (size_t)(3 * l + 2) * MPAD, nullptr, nullptr};
            pg8::gemm_phase<EpiH<2>, pg8::StaticOrder, true, true>((PG8_LAS unsigned char*)lds, g, S, E, wv);
            SEAM(p0 + 8); }
        if (IN(p0 + 9)) { PH_BEGIN SEAM_SKIP(p0 + 9); }
        if (IN(p0 + 10)) { PH_BEGIN
            pg8::Gemm g{(const pg8::bf16_t*)slotp(ws, l, 0), (const pg8::bf16_t*)(wb + W_GATE), MPAD, 1024, 1024};
            pg8::StaticOrder S; S.init(MPAD, 1024, G, bid);
            EpiH<3> E{A->out, (bfu*)slotp(ws, l, 13), rsb + (size_t)(3 * l + 3) * MPAD, rsb + (size_t)(3 * l + 2) * MPAD, (const bfu*)slotp(ws, l, 11)};
            pg8::gemm_phase<EpiH<3>, pg8::StaticOrder, true, true>((PG8_LAS unsigned char*)lds, g, S, E, wv);
            SEAM(p0 + 10); }
        }
    { constexpr int l = 1;

        const int p0 = 1 + 11 * l;
        if (IN(p0 + 0)) { PH_BEGIN
            pg8::Gemm g{(const pg8::bf16_t*)slotp(ws, l, 0), (const pg8::bf16_t*)(wb + W_IN), MPAD, NIN, 1024};
            pg8::StaticOrder S; S.init(MPAD, NIN, G, bid);
            EpiG1 E{rsb + (size_t)(3 * l) * MPAD, (bfu*)slotp(ws, l, 2), (bfu*)slotp(ws, l, 4), (bfu*)slotp(ws, l, 5), (bfu*)slotp(ws, l, 6), (bfu*)slotp(ws, l, 7), (float*)(ws + WS_AB), (const float*)(ws + WS_ROPE),
                    A->out + O_BKP + (size_t)l * MP * 512, A->out + O_BVP + (size_t)l * MP * 512, A->out + O_BKS + (size_t)l * MS * 512, A->out + O_BVS + (size_t)l * MS * 512};
            pg8::gemm_phase<EpiG1, pg8::StaticOrder, true, true>((PG8_LAS unsigned char*)lds, g, S, E, wv);
            SEAM(p0 + 0); }
        if (IN(p0 + 1)) { PH_BEGIN
            prep_a(A, l, gw, NGW, lane); prep_c1(A, l, gw, NGW, lane);
            if (l == 1) conv_weights(A, 1, 2, lds, gw, NGW, lane, wave);
            SEAM(p0 + 1); }
        if (IN(p0 + 2)) { PH_BEGIN
            pg8::Gemm g{(const pg8::bf16_t*)slotp(ws, l, 12), (const pg8::bf16_t*)(wb + W_LR), MPAD, 768, 256};
            pg8::StaticOrder S; S.init(MPAD, 768, G, bid);
            EpiB<0> E{(bfu*)slotp(ws, l, 13), 768, nullptr};
            pg8::gemm_phase<EpiB<0>, pg8::StaticOrder, true, true>((PG8_LAS unsigned char*)lds, g, S, E, wv);
            SEAM(p0 + 2); }
        if (IN(p0 + 3)) { PH_BEGIN prep_c2(A, l, bid, G, tid); prep_a2(A, l, gw, NGW, lane);
            SEAM(p0 + 3); }
        if (IN(p0 + 4)) { PH_BEGIN
            if (bid < 64) { const int st = bid >> 1, half = bid & 1, b = st >> 2, h = st & 3;
                scan_rwkv(A, l, lds, h, half, b * 8192, 8192, 32, 5, b * 128, nullptr, A->out + O_CWP + (size_t)((l * 8 + b) * 4 + h) * 4096, tid);
                scan_rwkv(A, l, lds, h, half, MP + b * 16, 16, 16, 4, 1024 + b, A->in[7] + (size_t)((l * 8 + b) * 4 + h) * 4096, A->out + O_CWS + (size_t)((l * 8 + b) * 4 + h) * 4096, tid);
            } else if (bid < 128) { const int st = (bid - 64) >> 1, half = bid & 1, b = st >> 2, h = st & 3;
                scan_delta(A, l, lds, h, half, b * 8192, 8192, 32, 5, nullptr, A->out + O_ADP + (size_t)((l * 8 + b) * 4 + h) * 4096, tid);
                scan_delta(A, l, lds, h, half, MP + b * 16, 16, 16, 4, A->in[5] + (size_t)((l * 8 + b) * 4 + h) * 4096, A->out + O_ADS + (size_t)((l * 8 + b) * 4 + h) * 4096, tid);
            } else if (bid < 160) { sample_attn(A, l, lds, bid - 128, tid); }
            __syncthreads();
            unsigned* ctr = (unsigned*)(ws + WS_CTL) + 16 * l; volatile LAS unsigned* qw = (volatile LAS unsigned*)(lds + MISC_OFF);
            const attn_body::bf16* Q = (const attn_body::bf16*)slotp(ws, l, 4); const attn_body::bf16* K = (const attn_body::bf16*)slotp(ws, l, 5); const attn_body::bf16* V = (const attn_body::bf16*)slotp(ws, l, 6);
            attn_body::bf16* O = (attn_body::bf16*)slotp(ws, l, 13);
            for (;;) {
                if (tid == 0) qw[0] = atomicAdd(ctr, 1u);
                __syncthreads();
                const unsigned u = qw[0];
                __syncthreads();
                if (u >= 4096u) break;
                const int qb = 31 - (int)(u >> 7), bh = (int)(u & 127);
                attn_body::attn_unit<8>(bh >> 4, bh & 15, qb, Q, K, V, O, (char*)lds_raw, wv);
            }
            SEAM(p0 + 4); }
        if (IN(p0 + 5)) { PH_BEGIN
            post_attn(A, l, gw, NGW, lane); post_scan(A, l, gw, NGW, lane);
            conv_p(A, l, (bfu*)slotp(ws, l, 10), gtid, NT);
            if (l == 0) conv_weights(A, 1, 1, lds, gw, NGW, lane, wave);
            SEAM(p0 + 5); }
        if (IN(p0 + 6)) { PH_BEGIN
            pg8::Gemm g{(const pg8::bf16_t*)slotp(ws, l, 7), (const pg8::bf16_t*)(wb + W_OUT), MPAD, 1024, 1024};
            pg8::StaticOrder S; S.init(MPAD, 1024, G, bid);
            EpiH<2> E{A->out, (bfu*)slotp(ws, l, 0), rsb + (size_t)(3 * l + 1) * MPAD, nullptr, nullptr};
            pg8::gemm_phase<EpiH<2>, pg8::StaticOrder, true, true>((PG8_LAS unsigned char*)lds, g, S, E, wv);
            SEAM(p0 + 6); }
        if (IN(p0 + 7)) { PH_BEGIN
            pg8::Gemm g{(const pg8::bf16_t*)slotp(ws, l, 0), (const pg8::bf16_t*)(wb + W_FF1), MPAD, FFD, 1024};
            pg8::StaticOrder S; S.init(MPAD, FFD, G, bid);
            EpiB<1> E{(bfu*)slotp(ws, l, 2), FFD, rsb + (size_t)(3 * l + 1) * MPAD};
            pg8::gemm_phase<EpiB<1>, pg8::StaticOrder, true, true>((PG8_LAS unsigned char*)lds, g, S, E, wv);
            {
                pg8::Gemm g2{(const pg8::bf16_t*)slotp(ws, l, 10), (const pg8::bf16_t*)(wb + W_PP), MPAD, 1024, 256};
                pg8::StaticOrder S2; S2.init(MPAD, 1024, G, bid);
                EpiB<0> E2{(bfu*)slotp(ws, l, 11), 1024, nullptr};
                pg8::gemm_phase<EpiB<0>, pg8::StaticOrder, true, true>((PG8_LAS unsigned char*)lds, g2, S2, E2, wv); }
            SEAM(p0 + 7); }
        if (IN(p0 + 8)) { PH_BEGIN
            pg8::Gemm g{(const pg8::bf16_t*)slotp(ws, l, 2), (const pg8::bf16_t*)(wb + W_FF2), MPAD, 1024, FFD};
            pg8::StaticOrder S; S.init(MPAD, 1024, G, bid);
            EpiH<2> E{A->out, (bfu*)slotp(ws, l, 0), rsb + (size_t)(3 * l + 2) * MPAD, nullptr, nullptr};
            pg8::gemm_phase<EpiH<2>, pg8::StaticOrder, true, true>((PG8_LAS unsigned char*)lds, g, S, E, wv);
            SEAM(p0 + 8); }
        if (IN(p0 + 9)) { PH_BEGIN SEAM_SKIP(p0 + 9); }
        if (IN(p0 + 10)) { PH_BEGIN
            pg8::Gemm g{(const pg8::bf16_t*)slotp(ws, l, 0), (const pg8::bf16_t*)(wb + W_GATE), MPAD, 1024, 1024};
            pg8::StaticOrder S; S.init(MPAD, 1024, G, bid);
            EpiH<3> E{A->out, (bfu*)slotp(ws, l, 13), rsb + (size_t)(3 * l + 3) * MPAD, rsb + (size_t)(3 * l + 2) * MPAD, (const bfu*)slotp(ws, l, 11)};
            pg8::gemm_phase<EpiH<3>, pg8::StaticOrder, true, true>((PG8_LAS unsigned char*)lds, g, S, E, wv);
            SEAM(p0 + 10); }
        }
    if (IN(NPHASE - 1)) { PH_BEGIN final_norm(A, gw, NGW, lane); }
}
#undef PH_BEGIN
#undef IN
#undef SEAM

extern "C" void kernel_launch(void* const* d_in, const int* in_sizes, int n_in, void* d_out, int out_size, void* d_ws, size_t ws_size, hipStream_t stream) {
    static int grid = 0;
    if (grid == 0) {
        if (n_in != 40 || (size_t)out_size != O_END || ws_size < WS_TOTAL) { fprintf(stderr, "kernel_launch: unexpected shapes (n_in %d out %d ws %zu)\n", n_in, out_size, ws_size); grid = -1; return; }
        int dev = 0, cus = 0, per_cu = 0;
        if (hipGetDevice(&dev) != hipSuccess || hipDeviceGetAttribute(&cus, hipDeviceAttributeMultiprocessorCount, dev) != hipSuccess) { grid = -1; return; }
        if (hipFuncSetAttribute((const void*)hybrid_fwd, hipFuncAttributeMaxDynamicSharedMemorySize, LDS_BYTES) != hipSuccess) { fprintf(stderr, "kernel_launch: hipFuncSetAttribute failed\n"); grid = -1; return; }
        if (hipOccupancyMaxActiveBlocksPerMultiprocessor(&per_cu, (const void*)hybrid_fwd, NTHR, LDS_BYTES) != hipSuccess || per_cu < 1) { fprintf(stderr, "kernel_launch: occupancy query says %d\n", per_cu); per_cu = 1; }
        (void)hipGetLastError();
        grid = cus;
    }
    if (grid < 0) return;
    if (hipMemsetAsync((char*)d_ws + WS_CTL, 0, 64 * 1024, stream) != hipSuccess) { fprintf(stderr, "kernel_launch: memset failed\n"); return; }
    Args a{};
    for (int i = 0; i < 40; ++i) a.in[i] = (const float*)d_in[i];
    a.out = (float*)d_out; a.ws = (unsigned char*)d_ws;
#if MK_ONE_LAUNCH
    a.ph_lo = 0; a.ph_hi = NPHASE;
    void* args[] = {&a};
    hipError_t e = hipLaunchCooperativeKernel((const void*)hybrid_fwd, dim3(grid), dim3(NTHR), args, LDS_BYTES, stream);
    if (e != hipSuccess) fprintf(stderr, "kernel_launch: cooperative launch failed: %s (grid %d)\n", hipGetErrorString(e), grid);
#else
    for (int ph = 0; ph < NPHASE; ++ph) { a.ph_lo = ph; a.ph_hi = ph + 1; hipLaunchKernelGGL(hybrid_fwd, dim3(grid), dim3(NTHR), LDS_BYTES, stream, a); }
#endif
}
```

```cpp
#include <hip/hip_runtime.h>
#include <hip/hip_cooperative_groups.h>
#include <cstdio>
#include <cstdint>
namespace cg = cooperative_groups;
namespace pg8 {
#define PG8_LAS __attribute__((address_space(3)))
typedef unsigned short bf16_t;
typedef short bf16x8 __attribute__((ext_vector_type(8)));
typedef float f32x4 __attribute__((ext_vector_type(4)));
typedef unsigned u32x4 __attribute__((ext_vector_type(4)));
constexpr int BM = 256, BK = 64, HALF = 128, HTB = HALF * BK * 2  , STAGE_BYTES = 8 * HTB, NXCD = 8, WGM = 8;

__host__ __device__ __forceinline__ int lds_byte(int r, int c) { const int st = (r >> 4) * 2 + (c >> 5), rr = r & 15, cc = c & 31, ob = rr * 64 + cc * 2; return st * 1024 + (ob ^ (((ob >> 9) & 1) << 5)); }
__host__ __device__ __forceinline__ void stage_rc(int b, int& R, int& C) { const int st = b / 1024, sb = b % 1024, swz = sb ^ (((sb >> 9) & 1) << 5); R = (st >> 1) * 16 + swz / 64; C = (st & 1) * 32 + (swz % 64) / 2; }
__host__ __device__ __forceinline__ int perm32(int rho) { const int n = rho >> 4, i = rho & 15; return 8 * (i >> 2) + 4 * n + (i & 3); }

struct Unit { int pm, pn; };
struct Gemm { const bf16_t* A; const bf16_t* Bt; int M, N, K; };

struct StaticOrder {
    int nM, nN, nwg, G, c;
    __host__ __device__ void init(int M, int N, int G_, int c_) { nM = M / BM; nN = N / BM; nwg = nM * nN; G = G_; c = c_; }
    __host__ __device__ bool next(int i, Unit& u) const {
        const long L = (long)i * G + c; if (L >= nwg) return false;
        int wgid = (int)L; { const int q = nwg / NXCD, r = nwg % NXCD, xcd = wgid % NXCD, off = wgid / NXCD; wgid = (xcd < r ? xcd * (q + 1) : r * (q + 1) + (xcd - r) * q) + off; }
        const int nig = WGM * nN, gid = wgid / nig, fm = gid * WGM, gsz = (nM - fm) < WGM ? (nM - fm) : WGM;
        u.pm = fm + ((wgid % nig) % gsz); u.pn = (wgid % nig) / gsz; return true;
    }
    __device__ __forceinline__ void a_ready(const Unit&) const {}
    __device__ __forceinline__ void done(const Unit&) const {}
};

__device__ __forceinline__ unsigned cvt_pk_bf16(float lo, float hi) { unsigned r; asm volatile("v_cvt_pk_bf16_f32 %0, %1, %2" : "=v"(r) : "v"(lo), "v"(hi)); return r; }
typedef float f32x2 __attribute__((ext_vector_type(2)));
__device__ __forceinline__ f32x2 gelu_pk(f32x2 v) {
    const f32x2 av = __builtin_elementwise_abs(v), d = av * 0.2316418882f + 1.0f;
    f32x2 t; t.x = __builtin_amdgcn_rcpf(d.x); t.y = __builtin_amdgcn_rcpf(d.y);
    f32x2 q = t * 0.5307027145f + (-0.7265760135f); q = q * t + 0.7107068705f; q = q * t + (-0.142248368f); q = q * t + 0.127414796f; q = q * t;
    const f32x2 s = (v * v) * (-0.72134752044f);
    f32x2 e; e.x = __builtin_amdgcn_exp2f(s.x); e.y = __builtin_amdgcn_exp2f(s.y);
    const f32x2 m = v * (q * e), r = v - m;
    f32x2 o; o.x = v.x < 0.f ? m.x : r.x; o.y = v.y < 0.f ? m.y : r.y; return o;
}

template <int ACT  > struct EpiBf16 {
    static constexpr bool PERM = true, AFTER_DRAIN = false; static_assert(ACT == 0 || ACT == 1, "EpiBf16: ACT is 0 (none) or 1 (gelu_pk)");
    bf16_t* O; int ldc; const float* bias; int split_cols; size_t split_stride; float scale0;
    __device__ __forceinline__ void operator()(const f32x4 (&acc)[2][2][4][2], const Unit& u, int wr, int wc, int fr, int fq) const {
        const int row0 = u.pm * BM + wr * 64 + fr; int colt = u.pn * BM; bf16_t* base = O;
        float sc = 1.f; if (split_cols) { const int t = colt / split_cols; base += (size_t)t * split_stride; colt -= t * split_cols; if (t == 0) sc = scale0; }
        const int col0 = colt + wc * 32 + 8 * fq, bcol0 = u.pn * BM + wc * 32 + 8 * fq;
        f32x4 bv[2][2];
#pragma unroll
        for (int bj = 0; bj < 2; ++bj)
#pragma unroll
            for (int n = 0; n < 2; ++n) bv[bj][n] = bias ? *(const f32x4*)(bias + bcol0 + bj * HALF + 4 * n) : (f32x4){0.f, 0.f, 0.f, 0.f};
#pragma unroll
        for (int ai = 0; ai < 2; ++ai)
#pragma unroll
            for (int m = 0; m < 4; ++m) { bf16_t* rowp = base + (size_t)(row0 + ai * HALF + m * 16) * ldc + col0;
#pragma unroll
                for (int bj = 0; bj < 2; ++bj) { f32x4 v0 = acc[ai][bj][m][0] + bv[bj][0], v1 = acc[ai][bj][m][1] + bv[bj][1];
                    if (ACT == 1) { f32x2 a = gelu_pk((f32x2){v0[0], v0[1]}), b = gelu_pk((f32x2){v0[2], v0[3]}), c = gelu_pk((f32x2){v1[0], v1[1]}), d = gelu_pk((f32x2){v1[2], v1[3]});
                        v0 = (f32x4){a.x, a.y, b.x, b.y}; v1 = (f32x4){c.x, c.y, d.x, d.y}; }
                    v0 = v0 * sc; v1 = v1 * sc; u32x4 w; w.x = cvt_pk_bf16(v0[0], v0[1]); w.y = cvt_pk_bf16(v0[2], v0[3]); w.z = cvt_pk_bf16(v1[0], v1[1]); w.w = cvt_pk_bf16(v1[2], v1[3]);
                    *(u32x4*)(rowp + bj * HALF) = w; } }
    }
};

struct PanelStats {
    unsigned* xbuf;
    unsigned* cnt;
    unsigned* tmo;
    int ntn; float eps;
    unsigned code;
    __device__ __forceinline__ bool run(const f32x4 (&v)[2][2][4][2], const Unit& u, int wr, int wc, int fr, int fq, PG8_LAS unsigned char* lds, int wid, int lane) const {
        typedef float f32x2v __attribute__((ext_vector_type(2)));
        PG8_LAS f32x2v* P = (PG8_LAS f32x2v*)lds;
        PG8_LAS f32x2v* S = (PG8_LAS f32x2v*)(lds + 8192);
        PG8_LAS unsigned* flag = (PG8_LAS unsigned*)(lds + 8192 + 2048);
#pragma unroll
        for (int ai = 0; ai < 2; ++ai)
#pragma unroll
            for (int m = 0; m < 4; ++m) {
                float s = 0.f;
#pragma unroll
                for (int bj = 0; bj < 2; ++bj)
#pragma unroll
                    for (int n = 0; n < 2; ++n) { const f32x4 x = v[ai][bj][m][n]; s += (x[0] + x[1]) + (x[2] + x[3]); }
                s += __shfl_xor(s, 16); s += __shfl_xor(s, 32);
                const float mw = s * (1.0f / 64.0f); float q = 0.f;
#pragma unroll
                for (int bj = 0; bj < 2; ++bj)
#pragma unroll
                    for (int n = 0; n < 2; ++n) { const f32x4 d = v[ai][bj][m][n] - mw; q += (d[0] * d[0] + d[1] * d[1]) + (d[2] * d[2] + d[3] * d[3]); }
                q += __shfl_xor(q, 16); q += __shfl_xor(q, 32);
                if (fq == 0) P[(ai * HALF + wr * 64 + m * 16 + fr) * 4 + wc] = (f32x2v){mw, q};
            }
        asm volatile("s_waitcnt lgkmcnt(0)" ::: "memory"); __builtin_amdgcn_s_barrier(); asm volatile("" ::: "memory");
#if defined(BROKEN_EXCHANGE_NO_WAIT)
#warning BROKEN CONTROL BUILD: the row-statistics exchange does not wait; results are wrong by design
        if (blockIdx.x >= 64) { const long long t0_ = clock64(); while (clock64() - t0_ < 60000) __builtin_amdgcn_s_sleep(8); }
#endif
        const int row = wid * 32 + (lane & 31);
        if (lane < 32) {
            const f32x2v a = P[row * 4 + 0], b = P[row * 4 + 1], c = P[row * 4 + 2], d = P[row * 4 + 3];
            const float mt = (a.x + b.x + c.x + d.x) * 0.25f;
            const float da = a.x - mt, db = b.x - mt, dc = c.x - mt, dd = d.x - mt;
            const float m2 = (a.y + b.y) + (c.y + d.y) + 64.0f * ((da * da + db * db) + (dc * dc + dd * dd));
            unsigned long long* slot = (unsigned long long*)xbuf + ((size_t)(u.pm * BM + row) * 4 + u.pn);
            __hip_atomic_store(slot, ((unsigned long long)__float_as_uint(m2) << 32) | __float_as_uint(mt), __ATOMIC_RELAXED, __HIP_MEMORY_SCOPE_AGENT);
        }
        asm volatile("s_waitcnt vmcnt(0)" ::: "memory");
        if (lane == 0) __hip_atomic_fetch_add(cnt + 64 * u.pm, 1u, __ATOMIC_RELAXED, __HIP_MEMORY_SCOPE_AGENT);
        if (wid == 0) {
            bool dead = false; const unsigned long long t0 = __builtin_amdgcn_s_memrealtime(); const unsigned want = 8u * (unsigned)ntn;
            for (;;) {
#if defined(BROKEN_EXCHANGE_NO_WAIT)
                break;
#endif
                if ((unsigned)__builtin_amdgcn_readfirstlane(__hip_atomic_load(cnt + 64 * u.pm, __ATOMIC_RELAXED, __HIP_MEMORY_SCOPE_AGENT)) >= want) break;
                if (__builtin_amdgcn_s_memrealtime() - t0 > 2000000ull) {
                    if (lane == 0) { unsigned expect = 0u; __hip_atomic_compare_exchange_strong(tmo + 1, &expect, code | (unsigned)(u.pm & 0xff), __ATOMIC_RELAXED, __ATOMIC_RELAXED, __HIP_MEMORY_SCOPE_AGENT);
                                     __hip_atomic_store(tmo, 1u, __ATOMIC_RELAXED, __HIP_MEMORY_SCOPE_AGENT); }
                    dead = true; break; }
                __builtin_amdgcn_s_sleep(2);
            }
            __builtin_amdgcn_fence(__ATOMIC_ACQUIRE, "agent");
            if (lane == 0) flag[0] = dead ? 1u : 0u;
        }
        asm volatile("s_waitcnt vmcnt(0) lgkmcnt(0)" ::: "memory"); __builtin_amdgcn_s_barrier(); asm volatile("" ::: "memory");
        const bool bad = flag[0] != 0u;
        if (lane < 32) {
            const unsigned long long* slot = (const unsigned long long*)xbuf + (size_t)(u.pm * BM + row) * 4; float mt[4], m2[4]; float ms = 0.f;
#pragma unroll
            for (int t = 0; t < 4; ++t) { if (t < ntn) { const unsigned long long w = __hip_atomic_load(slot + t, __ATOMIC_RELAXED, __HIP_MEMORY_SCOPE_AGENT); mt[t] = __uint_as_float((unsigned)w); m2[t] = __uint_as_float((unsigned)(w >> 32)); } else { mt[t] = 0.f; m2[t] = 0.f; } ms += mt[t]; }
            const float mean = ms / (float)ntn; float q = 0.f;
#pragma unroll
            for (int t = 0; t < 4; ++t) if (t < ntn) { const float dm = mt[t] - mean; q += m2[t] + 256.0f * dm * dm; }
            S[row] = (f32x2v){mean, 1.0f / sqrtf(q / (256.0f * (float)ntn) + eps)};
        }
        asm volatile("s_waitcnt lgkmcnt(0)" ::: "memory"); __builtin_amdgcn_s_barrier(); asm volatile("" ::: "memory");
        return bad;
    }
};
struct EpiLnRes {
    static constexpr bool PERM = false, AFTER_DRAIN = true;
    const float* base; float* out; int ldc; const float* bias; PanelStats st; unsigned poison;
    __device__ __forceinline__ void fused(f32x4 (&acc)[2][2][4][2], const Unit& u, int wr, int wc, int fr, int fq, PG8_LAS unsigned char* lds, int wid, int lane) const {
        typedef float f32x2v __attribute__((ext_vector_type(2)));
        const PG8_LAS f32x2v* S = (const PG8_LAS f32x2v*)(lds + 8192);
        const int col0 = u.pn * BM + wc * 32 + 4 * fq;
#pragma unroll
        for (int bj = 0; bj < 2; ++bj)
#pragma unroll
            for (int n = 0; n < 2; ++n) { const f32x4 bv = bias ? *(const f32x4*)(bias + col0 + bj * HALF + n * 16) : (f32x4){0.f, 0.f, 0.f, 0.f};
#pragma unroll
                for (int ai = 0; ai < 2; ++ai)
#pragma unroll
                    for (int m = 0; m < 4; ++m) acc[ai][bj][m][n] += bv; }
        f32x4 pre[4][2][2];
#pragma unroll
        for (int m = 0; m < 4; ++m) { const size_t off = (size_t)(u.pm * BM + wr * 64 + m * 16 + fr) * ldc + col0;
#pragma unroll
            for (int bj = 0; bj < 2; ++bj)
#pragma unroll
                for (int n = 0; n < 2; ++n) pre[m][bj][n] = *(const f32x4*)(base + off + bj * HALF + n * 16); }
        const bool bad = st.run(acc, u, wr, wc, fr, fq, lds, wid, lane) || poison != 0u;
        const float qnan = __builtin_nanf("");
#pragma unroll
        for (int ai = 0; ai < 2; ++ai)
#pragma unroll
            for (int m = 0; m < 4; ++m) { const int r = ai * HALF + wr * 64 + m * 16 + fr; const f32x2v sr = S[r]; const size_t off = (size_t)(u.pm * BM + r) * ldc + col0;
#pragma unroll
                for (int bj = 0; bj < 2; ++bj)
#pragma unroll
                    for (int n = 0; n < 2; ++n) { const f32x4 bs = ai == 0 ? pre[m][bj][n] : *(const f32x4*)(base + off + bj * HALF + n * 16); f32x4 o = bs + (acc[ai][bj][m][n] - sr.x) * sr.y;
                        if (bad) o = (f32x4){qnan, qnan, qnan, qnan}; *(f32x4*)(out + off + bj * HALF + n * 16) = o; }
                if (m & 1) asm volatile("" ::: "memory"); }
    }
};
struct EpiLnResLn {
    static constexpr bool PERM = false, AFTER_DRAIN = true;
    const float* base; float* out; bf16_t* xn; int ldc; const float* bias; PanelStats st1, st2; unsigned poison;
    __device__ __forceinline__ void fused(f32x4 (&acc)[2][2][4][2], const Unit& u, int wr, int wc, int fr, int fq, PG8_LAS unsigned char* lds, int wid, int lane) const {
        typedef float f32x2v __attribute__((ext_vector_type(2))); typedef unsigned u32x2v __attribute__((ext_vector_type(2)));
        const PG8_LAS f32x2v* S = (const PG8_LAS f32x2v*)(lds + 8192);
        const int col0 = u.pn * BM + wc * 32 + 4 * fq;
#pragma unroll
        for (int bj = 0; bj < 2; ++bj)
#pragma unroll
            for (int n = 0; n < 2; ++n) { const f32x4 bv = bias ? *(const f32x4*)(bias + col0 + bj * HALF + n * 16) : (f32x4){0.f, 0.f, 0.f, 0.f};
#pragma unroll
                for (int ai = 0; ai < 2; ++ai)
#pragma unroll
                    for (int m = 0; m < 4; ++m) acc[ai][bj][m][n] += bv; }
        bool bad = st1.run(acc, u, wr, wc, fr, fq, lds, wid, lane) || poison != 0u;
        const float qnan = __builtin_nanf("");
#pragma unroll
        for (int ai = 0; ai < 2; ++ai)
#pragma unroll
            for (int m = 0; m < 4; ++m) { const int r = ai * HALF + wr * 64 + m * 16 + fr; const f32x2v sr = S[r]; const size_t off = (size_t)(u.pm * BM + r) * ldc + col0;
#pragma unroll
                for (int bj = 0; bj < 2; ++bj)
#pragma unroll
                    for (int n = 0; n < 2; ++n) { const f32x4 bs = *(const f32x4*)(base + off + bj * HALF + n * 16); acc[ai][bj][m][n] = bs + (acc[ai][bj][m][n] - sr.x) * sr.y; }
                asm volatile("" : "+v"(acc[ai][0][m][0]), "+v"(acc[ai][0][m][1]), "+v"(acc[ai][1][m][0]), "+v"(acc[ai][1][m][1]));
                if (m & 1) asm volatile("" ::: "memory"); }
        const bool bad1 = bad;
        bad = st2.run(acc, u, wr, wc, fr, fq, lds, wid, lane) || bad;
#pragma unroll
        for (int ai = 0; ai < 2; ++ai)
#pragma unroll
            for (int m = 0; m < 4; ++m) { const int r = ai * HALF + wr * 64 + m * 16 + fr; const f32x2v sr = S[r]; const size_t off = (size_t)(u.pm * BM + r) * ldc + col0;
#pragma unroll
                for (int bj = 0; bj < 2; ++bj)
#pragma unroll
                    for (int n = 0; n < 2; ++n) { const f32x4 x1 = acc[ai][bj][m][n]; *(f32x4*)(out + off + bj * HALF + n * 16) = bad1 ? (f32x4){qnan, qnan, qnan, qnan} : x1;
                        const f32x4 o = (x1 - sr.x) * sr.y; u32x2v w; w.x = cvt_pk_bf16(o[0], o[1]); w.y = cvt_pk_bf16(o[2], o[3]);
                        if (bad) { w.x = 0x7fc07fc0u; w.y = 0x7fc07fc0u; } *(u32x2v*)(xn + off + bj * HALF + n * 16) = w; }
                asm volatile("" ::: "memory"); }
    }
};

template <class Epi, class Sched, bool ALIGN_EPI = false, bool SP2 = false>
__device__ __forceinline__ void gemm_phase(PG8_LAS unsigned char* lds, const Gemm g, const Sched& S, const Epi& E, const int wv_) {
    int tid_o = wv_ * 64 + (int)__builtin_amdgcn_mbcnt_hi(~0u, __builtin_amdgcn_mbcnt_lo(~0u, 0u)); asm volatile("" : "+v"(tid_o)); tid_o &= 511;
    const int tid = tid_o, wid = __builtin_amdgcn_readfirstlane(tid >> 6), lane = tid & 63, wr = wid >> 2, wc = wid & 3, fr = lane & 15, fq = lane >> 4;
    const int K = g.K, nt = K / BK;
    unsigned voffA[2], voffB[2];
#pragma unroll
    for (int i = 0; i < 2; ++i) { int R, C; stage_rc(tid * 16 + i * 8192, R, C); const int Rb = Epi::PERM ? ((R & ~31) + perm32(R & 31)) : R;
        voffA[i] = (unsigned)(R * K + C) * 2u; voffB[i] = (unsigned)(Rb * K + C) * 2u; }
    const size_t kstep = (size_t)(BK * 2);
    const size_t hstep = (size_t)HALF * K * 2;
    const size_t tstep = 2 * hstep;
    const unsigned ldsw = (unsigned)wid * 1024u;
    const int aoff = lds_byte(wr * 64 + fr, fq * 8), boff = lds_byte(wc * 32 + fr, fq * 8);
#define PG8_SA(b, h) (((b) * 2 + (h)) * HTB)
#define PG8_SB(b, h) ((4 + (b) * 2 + (h)) * HTB)
#define PG8_STAGE(bufoff, gbase, voff) do { _Pragma("unroll") for (int _i = 0; _i < 2; ++_i) \
        __builtin_amdgcn_global_load_lds((const unsigned*)((const char*)(gbase) + (voff)[_i]), (PG8_LAS unsigned*)(lds + (bufoff) + ldsw + _i * 8192), 16, 0, 0); } while (0)
#define PG8_LDA(dst, b, h) do { _Pragma("unroll") for (int m = 0; m < 4; ++m) _Pragma("unroll") for (int k = 0; k < 2; ++k) dst[m][k] = *(const PG8_LAS bf16x8*)(lds + PG8_SA(b, h) + aoff + m * 2048 + k * 1024); } while (0)
#define PG8_LDB(dst, b, h) do { _Pragma("unroll") for (int n = 0; n < 2; ++n) _Pragma("unroll") for (int k = 0; k < 2; ++k) dst[n][k] = *(const PG8_LAS bf16x8*)(lds + PG8_SB(b, h) + boff + n * 2048 + k * 1024); } while (0)
#define PG8_MMA(ai, bj, At, Bt) do { __builtin_amdgcn_s_setprio(1); _Pragma("unroll") for (int m = 0; m < 4; ++m) _Pragma("unroll") for (int n = 0; n < 2; ++n) _Pragma("unroll") for (int k = 0; k < 2; ++k) \
        acc[ai][bj][m][n] = __builtin_amdgcn_mfma_f32_16x16x32_bf16(Bt[n][k], At[m][k], acc[ai][bj][m][n], 0, 0, 0); __builtin_amdgcn_s_setprio(0); } while (0)
#define PG8_WAIT_V(n) asm volatile("s_waitcnt vmcnt(" #n ")" ::: "memory")
#define PG8_WAIT_L(n) asm volatile("s_waitcnt lgkmcnt(" #n ")" ::: "memory")
#define PG8_BAR __builtin_amdgcn_s_barrier()
#define PG8_SCHED __builtin_amdgcn_sched_barrier(0)
    Unit cur, nxt; int ui = 0;
    if (!S.next(0, cur)) return;
    f32x4 acc[2][2][4][2];
#pragma unroll
    for (int a = 0; a < 2; ++a)
#pragma unroll
        for (int b = 0; b < 2; ++b)
#pragma unroll
            for (int m = 0; m < 4; ++m)
#pragma unroll
                for (int n = 0; n < 2; ++n) acc[a][b][m][n] = (f32x4){0.f, 0.f, 0.f, 0.f};
    bf16x8 At[4][2], B0[2][2], B1[2][2];
    const char* cA = (const char*)g.A + (size_t)cur.pm * tstep; const char* cB = (const char*)g.Bt + (size_t)cur.pn * tstep;
    S.a_ready(cur);
    if constexpr (SP2) {
        PG8_STAGE(PG8_SB(0, 0), cB, voffB); PG8_STAGE(PG8_SB(0, 1), cB + hstep, voffB); PG8_STAGE(PG8_SA(0, 0), cA, voffA); PG8_STAGE(PG8_SA(0, 1), cA + hstep, voffA);
        if (wr == 1) PG8_BAR;
        PG8_WAIT_V(2); PG8_BAR;
        PG8_STAGE(PG8_SB(1, 0), cB + kstep, voffB); PG8_STAGE(PG8_SA(1, 0), cA + kstep, voffA); PG8_STAGE(PG8_SB(1, 1), cB + hstep + kstep, voffB);
        PG8_WAIT_V(6); PG8_BAR;
    } else {
        PG8_STAGE(PG8_SB(0, 0), cB, voffB); PG8_STAGE(PG8_SA(0, 0), cA, voffA); PG8_STAGE(PG8_SB(0, 1), cB + hstep, voffB); PG8_STAGE(PG8_SA(0, 1), cA + hstep, voffA);
        if (wr == 1) PG8_BAR;
        PG8_WAIT_V(4); PG8_BAR;
        PG8_STAGE(PG8_SB(1, 0), cB + kstep, voffB); PG8_STAGE(PG8_SA(1, 0), cA + kstep, voffA); PG8_STAGE(PG8_SB(1, 1), cB + hstep + kstep, voffB);
        PG8_WAIT_V(6); PG8_BAR;
    }
    for (;;) {
        const bool has_next = S.next(ui + 1, nxt);
        const char* nA = has_next ? (const char*)g.A + (size_t)nxt.pm * tstep : cA; const char* nB = has_next ? (const char*)g.Bt + (size_t)nxt.pn * tstep : cB;
        for (int t = 0; t < nt; t += 2) {
            const bool last = (t == nt - 2);
            const char* a1 = cA + (size_t)(t + 1) * kstep;
            const char* a2 = last ? nA : cA + (size_t)(t + 2) * kstep; const char* b2 = last ? nB : cB + (size_t)(t + 2) * kstep;
            const char* a3 = a2 + kstep; const char* b3 = b2 + kstep;
            if (last && has_next) S.a_ready(nxt);
            if constexpr (SP2) {
            PG8_LDB(B0, 0, 0); PG8_LDB(B1, 0, 1); PG8_SCHED; PG8_LDA(At, 0, 0); PG8_STAGE(PG8_SA(1, 1), a1 + hstep, voffA);
            PG8_WAIT_V(8); PG8_WAIT_L(0); PG8_BAR; PG8_MMA(0, 0, At, B0); PG8_MMA(0, 1, At, B1); PG8_BAR; PG8_SCHED;
            PG8_LDA(At, 0, 1); PG8_STAGE(PG8_SB(0, 0), b2, voffB); PG8_STAGE(PG8_SB(0, 1), b2 + hstep, voffB); PG8_STAGE(PG8_SA(0, 0), a2, voffA);
            PG8_WAIT_V(8); PG8_WAIT_L(0); PG8_BAR; PG8_MMA(1, 0, At, B0); PG8_MMA(1, 1, At, B1); PG8_BAR; PG8_SCHED;
            PG8_LDB(B0, 1, 0); PG8_LDB(B1, 1, 1); PG8_SCHED; PG8_LDA(At, 1, 0); PG8_STAGE(PG8_SA(0, 1), a2 + hstep, voffA);
            PG8_WAIT_V(8); PG8_WAIT_L(0); PG8_BAR; PG8_MMA(0, 0, At, B0); PG8_MMA(0, 1, At, B1); PG8_BAR; PG8_SCHED;
            PG8_LDA(At, 1, 1); PG8_STAGE(PG8_SB(1, 0), b3, voffB); PG8_STAGE(PG8_SB(1, 1), b3 + hstep, voffB); PG8_STAGE(PG8_SA(1, 0), a3, voffA);
            PG8_WAIT_V(8); PG8_WAIT_L(0); PG8_BAR; PG8_MMA(1, 0, At, B0); PG8_MMA(1, 1, At, B1); PG8_BAR; PG8_SCHED;
            } else {
            PG8_LDB(B0, 0, 0); PG8_SCHED; PG8_LDA(At, 0, 0); PG8_STAGE(PG8_SA(1, 1), a1 + hstep, voffA);
            PG8_WAIT_L(8); PG8_BAR; PG8_WAIT_L(0); PG8_MMA(0, 0, At, B0); PG8_BAR; PG8_SCHED;
            PG8_LDB(B1, 0, 1); PG8_STAGE(PG8_SB(0, 0), b2, voffB);
            PG8_BAR; PG8_WAIT_L(0); PG8_MMA(0, 1, At, B1); PG8_BAR;
            PG8_LDA(At, 0, 1); PG8_STAGE(PG8_SA(0, 0), a2, voffA);
            PG8_BAR; PG8_WAIT_L(0); PG8_MMA(1, 0, At, B0); PG8_BAR; PG8_SCHED;
            PG8_STAGE(PG8_SB(0, 1), b2 + hstep, voffB);
            PG8_WAIT_V(6); PG8_BAR; PG8_MMA(1, 1, At, B1); PG8_BAR;
            PG8_LDB(B0, 1, 0); PG8_SCHED; PG8_LDA(At, 1, 0); PG8_STAGE(PG8_SA(0, 1), a2 + hstep, voffA);
            PG8_WAIT_L(8); PG8_BAR; PG8_WAIT_L(0); PG8_MMA(0, 0, At, B0); PG8_BAR; PG8_SCHED;
            PG8_LDB(B1, 1, 1); PG8_STAGE(PG8_SB(1, 0), b3, voffB);
            PG8_BAR; PG8_WAIT_L(0); PG8_MMA(0, 1, At, B1); PG8_BAR;
            PG8_LDA(At, 1, 1); PG8_STAGE(PG8_SA(1, 0), a3, voffA);
            PG8_BAR; PG8_WAIT_L(0); PG8_MMA(1, 0, At, B0); PG8_BAR; PG8_SCHED;
            PG8_STAGE(PG8_SB(1, 1), b3 + hstep, voffB);
            PG8_WAIT_V(6); PG8_BAR; PG8_MMA(1, 1, At, B1); PG8_BAR;
            }
        }
        if constexpr (ALIGN_EPI) { if (wr == 0) PG8_BAR; }
        if constexpr (!Epi::AFTER_DRAIN) { E(acc, cur, wr, wc, fr, fq); S.done(cur); }
        if (!has_next) break;
#pragma unroll
        for (int a = 0; a < 2; ++a)
#pragma unroll
            for (int b = 0; b < 2; ++b)
#pragma unroll
                for (int m = 0; m < 4; ++m)
#pragma unroll
                    for (int n = 0; n < 2; ++n) acc[a][b][m][n] = (f32x4){0.f, 0.f, 0.f, 0.f};
        cur = nxt; cA = nA; cB = nB; ++ui;
        if constexpr (ALIGN_EPI) { if (wr == 1) PG8_BAR; }
    }
    PG8_WAIT_V(0);
    if constexpr (!ALIGN_EPI) { if (wr == 0) PG8_BAR; }
    PG8_BAR;
    if constexpr (Epi::AFTER_DRAIN) { E.fused(acc, cur, wr, wc, fr, fq, lds, wid, lane); S.done(cur); }
#undef PG8_SA
#undef PG8_SB
#undef PG8_STAGE
#undef PG8_LDA
#undef PG8_LDB
#undef PG8_MMA
#undef PG8_WAIT_V
#undef PG8_WAIT_L
#undef PG8_BAR
#undef PG8_SCHED
}
}
#include <hip/hip_bf16.h>
#include <cmath>
namespace attn_body {
using bf16=__hip_bfloat16;
using bf16x8=__attribute__((ext_vector_type(8)))short;
using s16x4=__attribute__((ext_vector_type(4)))short;
using f32x16=__attribute__((ext_vector_type(16)))float;
using u32x4=__attribute__((ext_vector_type(4)))unsigned;
constexpr int BATCH=8,NHEAD=16,SEQ=8192,D=64,DM=NHEAD*D,DMI=512,DMO=1024;
constexpr int NW=8,QBLK=32,QB=QBLK*NW,KVBLK=64,NQB=SEQ/QB;
constexpr int ATTN_PITCH=DM, ATTN_UNIT_ROWS=QB;
__device__ __forceinline__ int crow(int r,int hi){return (r&3)+8*(r>>2)+4*hi;}
#define SBAR() __builtin_amdgcn_sched_barrier(0)
__device__ __forceinline__ void cmask(f32x16&p0,f32x16&p1,int jb,int qrel,int hi){
  const float NEG=-INFINITY; int kb=64*jb+4*hi;
  #pragma unroll
  for(int r=0;r<16;++r){ if(jb>(qrel>>6)){p0[r]=NEG;p1[r]=NEG;} } (void)kb;
}

constexpr int NSLOT=3, SLOTB=8192;
constexpr int LDS_K=0, LDS_V=NSLOT*SLOTB, LDS_WS=2*NSLOT*SLOTB, LDS_OST=LDS_WS+NW*64*4, LDS_BYTES=LDS_OST+NW*4096;
constexpr float C2=0.125f*1.4426950408889634f;
__device__ __forceinline__ void glds16(const void*gsrc,unsigned lds_dst){unsigned keep;
  asm volatile("s_mov_b32 %0, m0\n\ts_mov_b32 m0, %2\n\ts_nop 0\n\tglobal_load_lds_dwordx4 %1, off\n\ts_mov_b32 m0, %0":"=&s"(keep):"v"(gsrc),"s"(lds_dst):"memory");}
__device__ __forceinline__ float max3f(float a,float b,float c){float r;asm("v_max3_f32 %0, %1, %2, %3":"=v"(r):"v"(a),"v"(b),"v"(c));return r;}
__device__ __forceinline__ float max2f(float a,float b){float r;asm("v_max_f32_e32 %0, %1, %2":"=v"(r):"v"(a),"v"(b));return r;}
__device__ __forceinline__ float fadd_s(float a,float b){float r;asm("v_add_f32_e32 %0, %1, %2":"=v"(r):"v"(a),"v"(b));return r;}
__device__ __forceinline__ float fsub_s(float a,float b){float r;asm("v_sub_f32_e32 %0, %1, %2":"=v"(r):"v"(a),"v"(b));return r;}
typedef float f32x2_t __attribute__((ext_vector_type(2))); typedef __bf16 bf16x2_t __attribute__((ext_vector_type(2)));
__device__ __forceinline__ unsigned cvtpk_s(float lo,float hi){f32x2_t v={lo,hi};bf16x2_t b=__builtin_convertvector(v,bf16x2_t);return __builtin_bit_cast(unsigned,b);}
#define WAIT_BAR(N) asm volatile("s_waitcnt vmcnt(" #N ") lgkmcnt(0)\n\ts_barrier":::"memory")

__device__ __forceinline__ void qkt(f32x16&p0,f32x16&p1,const char*Kslot,const bf16x8*qr,const f32x16&negm,int r32,int hi){
  const char*kb=Kslot+hi*1024+r32*16;
  #pragma unroll
  for(int d0=0;d0<4;++d0){
    const bf16x8 b0=*reinterpret_cast<const bf16x8*>(kb+d0*2048);
    const bf16x8 b1=*reinterpret_cast<const bf16x8*>(kb+d0*2048+512);
    if(d0==0){p0=__builtin_amdgcn_mfma_f32_32x32x16_bf16(b0,qr[0],negm,0,0,0);p1=__builtin_amdgcn_mfma_f32_32x32x16_bf16(b1,qr[0],negm,0,0,0);}
    else{p0=__builtin_amdgcn_mfma_f32_32x32x16_bf16(b0,qr[d0],p0,0,0,0);p1=__builtin_amdgcn_mfma_f32_32x32x16_bf16(b1,qr[d0],p1,0,0,0);}}
}
typedef __attribute__((address_space(3))) const char* lds_cptr;
typedef short v4i16_t __attribute__((ext_vector_type(4)));
__device__ __forceinline__ void kload8(bf16x8*kf,lds_cptr kp){
  kf[0]=*(const __attribute__((address_space(3))) bf16x8*)(kp);      kf[1]=*(const __attribute__((address_space(3))) bf16x8*)(kp+512);
  kf[2]=*(const __attribute__((address_space(3))) bf16x8*)(kp+2048); kf[3]=*(const __attribute__((address_space(3))) bf16x8*)(kp+2560);
  kf[4]=*(const __attribute__((address_space(3))) bf16x8*)(kp+4096); kf[5]=*(const __attribute__((address_space(3))) bf16x8*)(kp+4608);
  kf[6]=*(const __attribute__((address_space(3))) bf16x8*)(kp+6144); kf[7]=*(const __attribute__((address_space(3))) bf16x8*)(kp+6656);
}
__device__ __forceinline__ void kload2(bf16x8*kf,lds_cptr kp,int j){ kf[2*j]=*(const __attribute__((address_space(3))) bf16x8*)(kp+j*2048); kf[2*j+1]=*(const __attribute__((address_space(3))) bf16x8*)(kp+j*2048+512); }
__device__ __forceinline__ s16x4 vtr(lds_cptr p){ return __builtin_bit_cast(s16x4,__builtin_amdgcn_ds_read_tr16_b64_v4i16((__attribute__((address_space(3))) v4i16_t*)p)); }
__device__ __forceinline__ float rowmax(const f32x16&p0,const f32x16&p1){
  float a=max3f(p0[0],p0[1],p1[0]),b=max3f(p0[2],p0[3],p1[1]);a=max3f(a,p1[2],p1[3]);
  #pragma unroll
  for(int r=4;r<16;r+=4){a=max3f(a,p0[r],p0[r+1]);b=max3f(b,p0[r+2],p0[r+3]);a=max3f(a,p1[r],p1[r+1]);b=max3f(b,p1[r+2],p1[r+3]);}
  const float m=max2f(a,b);
  auto rr=__builtin_amdgcn_permlane32_swap(__float_as_uint(m),__float_as_uint(m),false,false);
  return max2f(__uint_as_float(rr[0]),__uint_as_float(rr[1]));
}
__device__ __forceinline__ void pv(f32x16*o,int vb,bf16x8 pa0,bf16x8 pa1,bf16x8 pa2,bf16x8 pa3){
  #pragma unroll
  for(int d0=0;d0<2;++d0){s16x4 lo[4],hi[4];
    #pragma unroll
    for(int ks=0;ks<4;++ks){
      asm volatile("ds_read_b64_tr_b16 %0,%1 offset:%c2":"=&v"(lo[ks]):"v"(vb),"i"(d0*4096+ks*1024):"memory");
      asm volatile("ds_read_b64_tr_b16 %0,%1 offset:%c2":"=&v"(hi[ks]):"v"(vb),"i"(d0*4096+ks*1024+512):"memory");}
    asm volatile("s_waitcnt lgkmcnt(0)":::"memory");SBAR();
    #define PK(k) (bf16x8){lo[k][0],lo[k][1],lo[k][2],lo[k][3],hi[k][0],hi[k][1],hi[k][2],hi[k][3]}
    o[d0]=__builtin_amdgcn_mfma_f32_32x32x16_bf16(pa0,PK(0),o[d0],0,0,0);
    o[d0]=__builtin_amdgcn_mfma_f32_32x32x16_bf16(pa1,PK(1),o[d0],0,0,0);
    o[d0]=__builtin_amdgcn_mfma_f32_32x32x16_bf16(pa2,PK(2),o[d0],0,0,0);
    o[d0]=__builtin_amdgcn_mfma_f32_32x32x16_bf16(pa3,PK(3),o[d0],0,0,0);
    #undef PK
  }
}

#ifndef ATTN_STORE16
#define ATTN_STORE16(p,v) (*(u32x4*)(p)=(v))
#endif
template<int THRL> __device__ __forceinline__ void attn_unit(int b,int h,int qb,const bf16*Q,const bf16*__restrict__ K,const bf16*__restrict__ V,bf16*O,char*shm,const int wv_){
  int tid_o=wv_*64+(int)__builtin_amdgcn_mbcnt_hi(~0u,__builtin_amdgcn_mbcnt_lo(~0u,0u)); asm volatile("":"+v"(tid_o)); tid_o&=511;
  const int tid=tid_o,lane=tid&63,r32=lane&31,hi=lane>>5; const int wid=__builtin_amdgcn_readfirstlane(tid>>6);
  const long rowbase=(long)b*SEQ; const int q0=qb*QB;
  const bf16*Qw=Q+(rowbase+q0+wid*QBLK)*DMI+(h>>1)*D;
  const bf16*Kh=K+rowbase*DMI+(h>>1)*D,*Vh=V+rowbase*DMI+(h>>2)*128+(h&1)*64;
  const unsigned lds0=(unsigned)(uintptr_t)shm;
  float*wsf=(float*)(shm+LDS_WS)+wid*64;
  const bf16*ksrc=Kh+(long)lane*DMI+wid*8;
  const bf16*vsrc=Vh+(long)(16*(wid&3)+(lane>>2))*DMI+(wid>>2)*32+(lane&3)*8;
  const unsigned kdst=lds0+LDS_K+wid*1024, vdst=lds0+LDS_V+wid*1024;
  #define DMA_K(t,slot) glds16(ksrc+(long)(t)*KVBLK*DMI,(unsigned)__builtin_amdgcn_readfirstlane(kdst+(slot)))
  #define DMA_V(t,slot) glds16(vsrc+(long)(t)*KVBLK*DMI,(unsigned)__builtin_amdgcn_readfirstlane(vdst+(slot)))
  const int vb0=(int)(lds0+LDS_V)+((lane>>4)&1)*32+(lane&3)*8+(4*hi+((lane&15)>>2))*64;
  const char*Kbase=shm+LDS_K; bf16x8 kf[8];
  const lds_cptr shm3=(lds_cptr)shm; const lds_cptr kp0=shm3+LDS_K+hi*1024+r32*16; const lds_cptr vp0=shm3+LDS_V+((lane>>4)&1)*32+(lane&3)*8+(4*hi+((lane&15)>>2))*64;
  const int NT=(q0+QB)/KVBLK;
  DMA_K(0,0);DMA_V(0,0);DMA_K(1,SLOTB);
  bf16x8 qr[4];
  #pragma unroll
  for(int d0=0;d0<4;++d0)qr[d0]=*reinterpret_cast<const bf16x8*>(&Qw[(long)r32*DMI+d0*16+hi*8]);
  float mhat=0.f,l_reg=0.f;f32x16 o[2];o[0]=f32x16{};o[1]=f32x16{};f32x16 negm=f32x16{};asm volatile("":"+v"(negm));
  const int qrel=wid*QBLK+r32;
  #define CMASK(P0,P1,t) do{int jb_=(t)-(NT-4); if(jb_>=0)cmask(P0,P1,jb_,qrel,hi);}while(0)
  bool resc=false;
  #define START(P0,P1) do{ const float rm=rowmax(P0,P1); resc=false; \
    { const float dl=rm; mhat=fadd_s(mhat,dl); \
      _Pragma("unroll") for(int r=0;r<16;++r){P0[r]=fsub_s(P0[r],dl);P1[r]=fsub_s(P1[r],dl);} \
      _Pragma("unroll") for(int r=0;r<16;++r)negm[r]=-mhat; asm volatile("":"+v"(negm)); } \
    _Pragma("unroll") for(int r=0;r<16;++r)P0[r]=__builtin_amdgcn_exp2f(P0[r]); }while(0)
  #define RESC() do{ if(resc){ asm volatile("s_waitcnt lgkmcnt(0)":::"memory"); \
      _Pragma("unroll") for(int d_=0;d_<2;++d_) _Pragma("unroll") for(int r=0;r<16;++r)o[d_][r]*=wsf[crow(r,hi)]; } }while(0)
  f32x16 pA0,pA1,pB0,pB1;
  int sl_prev=0,sl_cur=0,sl_next=SLOTB;
  #define ROT() do{sl_prev=sl_cur;sl_cur=sl_next;sl_next=(sl_next==(NSLOT-1)*SLOTB)?0:sl_next+SLOTB;}while(0)
  DMA_K(2,2*SLOTB);
  WAIT_BAR(3);
  qkt(pA0,pA1,Kbase,qr,negm,r32,hi);asm volatile("s_nop 15\n\ts_nop 7":"+v"(pA0),"+v"(pA1));CMASK(pA0,pA1,0);
  START(pA0,pA1);
  _Pragma("unroll") for(int r=0;r<16;++r)pA1[r]=__builtin_amdgcn_exp2f(pA1[r]);
  WAIT_BAR(0);
  DMA_K(3,0);DMA_V(1,SLOTB);
  ROT();
  kload8(kf,kp0+sl_cur);
  WAIT_BAR(2);
  s16x4 vlo[8],vhi[8]; u32x4 pw0,pw1,pw2,pw3;
  #define PKW(P,B) cvtpk_s(P[B],P[B+1])
  #define PAF(k) __builtin_bit_cast(bf16x8,pw##k)
  #define VFR(i) (bf16x8){vlo[i][0],vlo[i][1],vlo[i][2],vlo[i][3],vhi[i][0],vhi[i][1],vhi[i][2],vhi[i][3]}
  #define PIN(x) asm volatile("":"+v"(x))
  #define MX3(a,b,c) __builtin_fmaxf(__builtin_fmaxf((a),(b)),(c))
  #define GAPA(MF,A0,A1,A2,A3,W0,W1,PW) do{ MF; sacc+=A0; sacc+=A1; sacc+=A2; sacc+=A3; PIN(sacc); W0; W1; PIN(PW); SBAR(); }while(0)
  #define EX(v) __builtin_amdgcn_exp2f(v)
  #define GAPB(MF,X,B) do{ MF; X[B]=EX(X[B]); X[B+1]=EX(X[B+1]); X[B+2]=EX(X[B+2]); X[B+3]=EX(X[B+3]); PIN(X); SBAR(); }while(0)
  #define VRD(i) do{ vlo[i]=vtr(vp_+(((i)>>2)*4096+((i)&3)*1024)); vhi[i]=vtr(vp_+(((i)>>2)*4096+((i)&3)*1024+512)); }while(0)
  #define KRD(G,j) do{ if(G){ kload2(kf,kp0+sl_next,j); SBAR(); } }while(0)
  #define STEP(C0,C1,P0,P1,t,GK,GV,GL) do{ SBAR(); \
    const lds_cptr vp_=vp0+sl_prev; \
    VRD(0); SBAR(); float sacc=(P0[0]+P0[1]); \
    GAPA(C0=__builtin_amdgcn_mfma_f32_32x32x16_bf16(kf[0],qr[0],negm,0,0,0), P0[2],P0[3],P0[4],P0[5],     pw0[0]=PKW(P0,0), pw0[1]=PKW(P0,2), pw0); \
    VRD(4); SBAR(); GAPA(C1=__builtin_amdgcn_mfma_f32_32x32x16_bf16(kf[1],qr[0],negm,0,0,0), P0[6],P0[7],P0[8],P0[9],     pw0[2]=PKW(P0,4), pw0[3]=PKW(P0,6), pw0); \
    VRD(1); SBAR(); GAPA(C0=__builtin_amdgcn_mfma_f32_32x32x16_bf16(kf[2],qr[1],C0,0,0,0),   P0[10],P0[11],P0[12],P0[13], pw1[0]=PKW(P0,8), pw1[1]=PKW(P0,10), pw1); \
    VRD(5); SBAR(); GAPA(C1=__builtin_amdgcn_mfma_f32_32x32x16_bf16(kf[3],qr[1],C1,0,0,0),   P0[14],P0[15],P1[0],P1[1],   pw1[2]=PKW(P0,12),pw1[3]=PKW(P0,14), pw1); \
    VRD(2); SBAR(); GAPA(C0=__builtin_amdgcn_mfma_f32_32x32x16_bf16(kf[4],qr[2],C0,0,0,0),   P1[2],P1[3],P1[4],P1[5],     pw2[0]=PKW(P1,0), pw2[1]=PKW(P1,2), pw2); \
    VRD(6); SBAR(); GAPA(C1=__builtin_amdgcn_mfma_f32_32x32x16_bf16(kf[5],qr[2],C1,0,0,0),   P1[6],P1[7],P1[8],P1[9],     pw2[2]=PKW(P1,4), pw2[3]=PKW(P1,6), pw2); \
    VRD(3); SBAR(); GAPA(C0=__builtin_amdgcn_mfma_f32_32x32x16_bf16(kf[6],qr[3],C0,0,0,0),   P1[10],P1[11],P1[12],P1[13], pw3[0]=PKW(P1,8), pw3[1]=PKW(P1,10), pw3); \
    VRD(7); SBAR(); GAPA(C1=__builtin_amdgcn_mfma_f32_32x32x16_bf16(kf[7],qr[3],C1,0,0,0),   P1[14],P1[15],0.f,0.f,       pw3[2]=PKW(P1,12),pw3[3]=PKW(P1,14), pw3); \
    l_reg+=sacc; \
    if(GK){DMA_K((t)+3,sl_cur);} if(GV){DMA_V((t)+1,sl_next);} \
    CMASK(C0,C1,t); \
    { float a=MX3(C0[0],C0[1],C1[0]),b=MX3(C0[2],C0[3],C1[1]); a=MX3(a,C1[2],C1[3]); \
      _Pragma("unroll") for(int r=4;r<16;r+=4){a=MX3(a,C0[r],C0[r+1]);b=MX3(b,C0[r+2],C0[r+3]);a=MX3(a,C1[r],C1[r+1]);b=MX3(b,C1[r+2],C1[r+3]);} \
      float rm=__builtin_fmaxf(a,b); { auto rr=__builtin_amdgcn_permlane32_swap(__float_as_uint(rm),__float_as_uint(rm),false,false); rm=__builtin_fmaxf(__uint_as_float(rr[0]),__uint_as_float(rr[1])); } \
      resc=false; \
      if(__builtin_expect(__any(rm>(float)THRL),0)){ const float dl=__builtin_fmaxf(rm,0.f); mhat+=dl; \
        _Pragma("unroll") for(int r=0;r<16;++r){C0[r]-=dl;C1[r]-=dl;} \
        _Pragma("unroll") for(int r=0;r<16;++r)negm[r]=-mhat; asm volatile("":"+v"(negm)); \
        const float f=__builtin_amdgcn_exp2f(-dl); l_reg*=f; if(hi==0)wsf[r32]=f; resc=true; } } \
    SBAR(); \
    GAPB(o[0]=__builtin_amdgcn_mfma_f32_32x32x16_bf16(PAF(0),VFR(0),o[0],0,0,0), C0,0); \
    GAPB(o[1]=__builtin_amdgcn_mfma_f32_32x32x16_bf16(PAF(0),VFR(4),o[1],0,0,0), C0,4); \
    KRD(GL,0); GAPB(o[0]=__builtin_amdgcn_mfma_f32_32x32x16_bf16(PAF(1),VFR(1),o[0],0,0,0), C0,8); \
    KRD(GL,1); GAPB(o[1]=__builtin_amdgcn_mfma_f32_32x32x16_bf16(PAF(1),VFR(5),o[1],0,0,0), C0,12); \
    KRD(GL,2); GAPB(o[0]=__builtin_amdgcn_mfma_f32_32x32x16_bf16(PAF(2),VFR(2),o[0],0,0,0), C1,0); \
    KRD(GL,3); GAPB(o[1]=__builtin_amdgcn_mfma_f32_32x32x16_bf16(PAF(2),VFR(6),o[1],0,0,0), C1,4); \
    GAPB(o[0]=__builtin_amdgcn_mfma_f32_32x32x16_bf16(PAF(3),VFR(3),o[0],0,0,0), C1,8); \
    GAPB(o[1]=__builtin_amdgcn_mfma_f32_32x32x16_bf16(PAF(3),VFR(7),o[1],0,0,0), C1,12); \
    }while(0)
  int t=1;
  #undef CMASK
  #define CMASK(P0,P1,t) do{}while(0)
  for(;t+5<NT;t+=2){
    STEP(pB0,pB1,pA0,pA1,t,true,true,true);     WAIT_BAR(2); RESC(); ROT();
    STEP(pA0,pA1,pB0,pB1,t+1,true,true,true);   WAIT_BAR(2); RESC(); ROT();
  }
  #undef CMASK
  #define CMASK(P0,P1,t) do{int jb_=(t)-(NT-4); if(jb_>=0)cmask(P0,P1,jb_,qrel,hi);}while(0)
  #define ENDW(tt) do{ if((tt)+3<NT){WAIT_BAR(2);} else if((tt)+2<NT){WAIT_BAR(1);} else {WAIT_BAR(0);} }while(0)
  for(;t+1<NT;t+=2){
    STEP(pB0,pB1,pA0,pA1,t,(t+3<NT),(t+1<NT),(t+1<NT));       ENDW(t);   RESC(); ROT();
    STEP(pA0,pA1,pB0,pB1,t+1,(t+4<NT),(t+2<NT),(t+2<NT));     ENDW(t+1); RESC(); ROT();
  }
  STEP(pB0,pB1,pA0,pA1,NT-1,false,false,false); RESC();
  { float sacc=pB0[0]+pB0[1]; _Pragma("unroll") for(int r=2;r<16;++r)sacc+=pB0[r]; _Pragma("unroll") for(int r=0;r<16;++r)sacc+=pB1[r]; l_reg+=sacc;
    pw0=(u32x4){PKW(pB0,0),PKW(pB0,2),PKW(pB0,4),PKW(pB0,6)};pw1=(u32x4){PKW(pB0,8),PKW(pB0,10),PKW(pB0,12),PKW(pB0,14)};pw2=(u32x4){PKW(pB1,0),PKW(pB1,2),PKW(pB1,4),PKW(pB1,6)};pw3=(u32x4){PKW(pB1,8),PKW(pB1,10),PKW(pB1,12),PKW(pB1,14)};
    SBAR(); pv(o,vb0+sl_cur,PAF(0),PAF(1),PAF(2),PAF(3)); }
  #undef PKW
  #undef PAF
  #undef VFR
  #undef PIN
  #undef MX3
  #undef GAPA
  #undef GAPB
  #undef EX
  #undef VRD
  #undef KRD
  #undef STEP
  #undef ENDW
  {auto rr=__builtin_amdgcn_permlane32_swap(__float_as_uint(l_reg),__float_as_uint(l_reg),false,false);l_reg=__uint_as_float(rr[0])+__uint_as_float(rr[1]);}
  if(hi==0)wsf[32+r32]=l_reg;asm volatile("s_waitcnt lgkmcnt(0)":::"memory");
  float rli[16];
  #pragma unroll
  for(int r=0;r<16;++r)rli[r]=__builtin_amdgcn_rcpf(wsf[32+crow(r,hi)]);
  bf16*Ow=O+(rowbase+q0+wid*QBLK)*DMO+h*D;
  { bf16*stg=(bf16*)(shm+LDS_OST)+wid*2048;
    #pragma unroll
    for(int r=0;r<16;++r){const int orow=crow(r,hi);
      #pragma unroll
      for(int d0=0;d0<2;++d0)stg[orow*64+d0*32+r32]=__float2bfloat16(o[d0][r]*rli[r]);}
    asm volatile("s_waitcnt lgkmcnt(0)":::"memory");
    #pragma unroll
    for(int i=0;i<4;++i){const int row=i*8+(lane>>3),ch=lane&7; const u32x4 v=*(const u32x4*)(stg+row*64+ch*8); ATTN_STORE16(Ow+(long)row*DMO+ch*8,v);} }
  asm volatile("s_waitcnt lgkmcnt(0)\n\ts_barrier":::"memory");
  #undef DMA_K
  #undef DMA_V
  #undef CMASK
  #undef START
  #undef RESC
  #undef ROT
}
constexpr int ATTN_LDS_BYTES=LDS_BYTES;
struct AttnTensors { const bf16* Q; const bf16* K; const bf16* V; bf16* O; };
struct AttnUnit { int bh; int qb; };
struct StaticOrder {
  int vcu;
  __device__ __forceinline__ explicit StaticOrder(int grid,int block):vcu((block%8)*(grid/8)+block/8){}
  __device__ __forceinline__ bool next(int i,AttnUnit&u)const{ if(i>=4)return false; const int s=vcu&7; u.bh=vcu>>3; u.qb=(i==0)?s:(i==1)?15-s:(i==2)?16+s:31-s; return true; }
  __device__ __forceinline__ void a_ready(const AttnUnit&)const{}
  __device__ __forceinline__ void done(const AttnUnit&)const{}
};
template<class Sched,int THRL=8> __device__ __forceinline__ void attn_phase(char*lds,const AttnTensors&T,const Sched&S){
  AttnUnit u;
  for(int i=0;S.next(i,u);++i){ S.a_ready(u); attn_unit<THRL>(u.bh/NHEAD,u.bh%NHEAD,u.qb,T.Q,T.K,T.V,T.O,lds); S.done(u); }
}
#undef SBAR
#undef WAIT_BAR
}

#define LAS __attribute__((address_space(3)))
typedef unsigned short bfu;
typedef unsigned v4u __attribute__((ext_vector_type(4)));
typedef unsigned v2u __attribute__((ext_vector_type(2)));
typedef float f32x4 __attribute__((ext_vector_type(4)));
typedef float f32x8 __attribute__((ext_vector_type(8)));
typedef float f32x16 __attribute__((ext_vector_type(16)));
typedef float f32x2 __attribute__((ext_vector_type(2)));

constexpr int NWAVES = 8, NTHR = 512;
constexpr int MP = 65536, MS = 128, MR = MP + MS, MPAD = 65792;
constexpr int NIN = 3840, FFD = 4096;
constexpr int NPHASE = 24;
#ifndef MK_ONE_LAUNCH
#define MK_ONE_LAUNCH 1
#endif

constexpr size_t O_Y = 0;
constexpr size_t O_YS = (size_t)MP * 1024;
constexpr size_t O_ACP = O_YS + 128 * 1024;
constexpr size_t O_ADP = O_ACP + 2 * 8 * 3 * 768;
constexpr size_t O_BKP = O_ADP + 2 * 8 * 4 * 64 * 64;
constexpr size_t O_BVP = O_BKP + (size_t)2 * 8 * 8192 * 512;
constexpr size_t O_CSP = O_BVP + (size_t)2 * 8 * 8192 * 512;
constexpr size_t O_CWP = O_CSP + 2 * 8 * 1024;
constexpr size_t O_ACS = O_CWP + 2 * 8 * 4 * 64 * 64;
constexpr size_t O_ADS = O_ACS + 2 * 8 * 3 * 768;
constexpr size_t O_BKS = O_ADS + 2 * 8 * 4 * 64 * 64;
constexpr size_t O_BVS = O_BKS + 2 * 8 * 16 * 512;
constexpr size_t O_CSS = O_BVS + 2 * 8 * 16 * 512;
constexpr size_t O_CWS = O_CSS + 2 * 8 * 1024;
constexpr size_t O_END = O_CWS + 2 * 8 * 4 * 64 * 64;
static_assert(O_END == 202874880, "output size");

constexpr size_t MiB = 1u << 20;
constexpr size_t WS_CTL = 0;
constexpr size_t WS_RS = 64 * 1024;
constexpr size_t WS_BONUS = 2 * MiB;
constexpr size_t WS_GAB = 3 * MiB + 512 * 1024;
constexpr size_t WS_AB = 6 * MiB;
constexpr size_t WS_ROPE = 8 * MiB + 512 * 1024;
constexpr size_t WS_GCH = 10 * MiB + 512 * 1024;
constexpr size_t WS_W = 12 * MiB;
constexpr size_t W_IN = 0, W_OUT = W_IN + (size_t)NIN * 1024 * 2, W_FF1 = W_OUT + 1024 * 1024 * 2, W_FF2 = W_FF1 + 4096 * 1024 * 2,
                 W_GATE = W_FF2 + 4096 * 1024 * 2, W_PP = W_GATE + 1024 * 1024 * 2, W_LR = W_PP + 1024 * 256 * 2, W_END = W_LR + 768 * 256 * 2;
constexpr size_t WS_SLOT = 41 * MiB;
constexpr size_t USLOT = (size_t)MPAD * 1024;
static_assert(WS_W + W_END <= WS_SLOT, "weights");
constexpr size_t WS_PAIRC = WS_SLOT + 15 * USLOT;
constexpr size_t WS_PAIRD = WS_PAIRC + 4 * (size_t)(MPAD / 2) * 16;
constexpr size_t WS_TOTAL = WS_PAIRD + 4 * (size_t)(MPAD / 2) * 8;
static_assert(WS_TOTAL <= (size_t)1024 * MiB, "ws");
static_assert(WS_RS + 7 * (size_t)MPAD * 4 <= WS_BONUS && WS_BONUS + 4 * (size_t)MPAD * 4 <= WS_GAB && WS_GAB + 8 * (size_t)MPAD * 4 <= WS_AB && WS_AB + 8 * (size_t)MPAD * 4 <= WS_ROPE && WS_ROPE + 8192 * 64 * 4 <= WS_GCH && WS_GCH + 4 * 1032 * 64 * 4 <= WS_W, "ctl map");

__device__ __forceinline__ unsigned char* slotp(unsigned char* ws, int l, int s) {
    if (l & 1) { if (s < 2) s += 13; else if (s >= 13) s -= 13; }
    return ws + WS_SLOT + (size_t)s * USLOT;
}
__device__ __forceinline__ unsigned char* slotph(unsigned char* ws, int l, int s) { return slotp(ws, l, s) + USLOT / 2; }

constexpr int RING_BYTES = 131072, MISC_OFF = RING_BYTES + 320, LDS_BYTES = 147456;

#define LDS_WAIT() asm volatile("s_waitcnt lgkmcnt(0)" ::: "memory")
__device__ __forceinline__ float bf2f(unsigned short u) { return __uint_as_float(((unsigned)u) << 16); }
__device__ __forceinline__ unsigned f2bf(float f) { unsigned u = __builtin_bit_cast(unsigned, f); return (u + 0x7fffu + ((u >> 16) & 1u)) >> 16; }
__device__ __forceinline__ unsigned pk2(float lo, float hi) { return f2bf(lo) | (f2bf(hi) << 16); }
#define DPP_ROR_ADD(v, ctrl) ((v) + __builtin_bit_cast(float, __builtin_amdgcn_update_dpp(0, __builtin_bit_cast(int, (v)), (ctrl), 0xf, 0xf, false)))
__device__ __forceinline__ float wave_sum(float v) {
    v = DPP_ROR_ADD(v, 0x128); v = DPP_ROR_ADD(v, 0x124); v = DPP_ROR_ADD(v, 0x122); v = DPP_ROR_ADD(v, 0x121);
    v += __shfl_xor(v, 16);
    const unsigned u = __float_as_uint(v); auto rr = __builtin_amdgcn_permlane32_swap(u, u, false, false);
    return __uint_as_float(rr[0]) + __uint_as_float(rr[1]);
}
__device__ __forceinline__ float sigm(float x) { return 1.f / (1.f + __expf(-x)); }
__device__ __forceinline__ float softplusf(float x) { return x > 20.f ? x : log1pf(__expf(x)); }

struct Args { const float* in[40]; float* out; unsigned char* ws; int ph_lo, ph_hi; };
typedef const __attribute__((address_space(4))) Args* KArgs;

constexpr float ATT_C2 = 0.125f * 1.4426950408889634f;
struct EpiG1 {
    static constexpr bool PERM = true, AFTER_DRAIN = false;
    const float* rs; bfu *aqkvz, *qb, *kb, *vb, *craw; float* ab; const float* rope; float *okp, *ovp, *oks, *ovs;
    __device__ __forceinline__ void operator()(const pg8::f32x4 (&acc)[2][2][4][2], const pg8::Unit& u, int wr, int wc, int fr, int fq) const {
        const int pn = u.pn; const int rowb = u.pm * 256 + wr * 64 + fr; const int cl = wc * 32 + 8 * fq;
#pragma unroll
        for (int ai = 0; ai < 2; ++ai)
#pragma unroll
            for (int m = 0; m < 4; ++m) {
                const int row = rowb + ai * 128 + m * 16;
                const float s = rsqrtf(rs[row] * (1.f / 1024.f) + 1e-6f);
                if (pn < 4 || (pn >= 10 && pn < 14)) {
                    bfu* dst = (pn < 4 ? aqkvz + pn * 256 : craw + (pn - 10) * 256) + (size_t)row * 1024 + cl;
#pragma unroll
                    for (int bj = 0; bj < 2; ++bj) { const pg8::f32x4 v0 = acc[ai][bj][m][0] * s, v1 = acc[ai][bj][m][1] * s;
                        v4u w; w.x = pg8::cvt_pk_bf16(v0[0], v0[1]); w.y = pg8::cvt_pk_bf16(v0[2], v0[3]); w.z = pg8::cvt_pk_bf16(v1[0], v1[1]); w.w = pg8::cvt_pk_bf16(v1[2], v1[3]); *(v4u*)(dst + bj * 128) = w; }
                } else if (pn < 8) {
                    const bool isk = pn >= 6;
                    const int pos = row < MP ? (row & 8191) : 2048 + ((row - MP) & 15);
                    const int i0 = (wc & 1) * 16 + 4 * fq;
                    const pg8::f32x4 c4 = *(const pg8::f32x4*)(rope + pos * 64 + i0), s4 = *(const pg8::f32x4*)(rope + pos * 64 + 32 + i0);
#pragma unroll
                    for (int bj = 0; bj < 2; ++bj) {
                        const pg8::f32x4 x1 = acc[ai][bj][m][0] * s, x2 = acc[ai][bj][m][1] * s;
                        pg8::f32x4 o1 = x1 * c4 - x2 * s4, o2 = x2 * c4 + x1 * s4;
                        if (!isk) {
                            o1 = o1 * ATT_C2; o2 = o2 * ATT_C2;
                            v4u w; w.x = pg8::cvt_pk_bf16(o1[0], o1[1]); w.y = pg8::cvt_pk_bf16(o1[2], o1[3]); w.z = pg8::cvt_pk_bf16(o2[0], o2[1]); w.w = pg8::cvt_pk_bf16(o2[2], o2[3]);
                            *(v4u*)(qb + (size_t)row * 512 + (pn - 4) * 256 + bj * 128 + cl) = w;
                        } else {
                            v4u w; w.x = pg8::cvt_pk_bf16(o1[0], o1[1]); w.y = pg8::cvt_pk_bf16(o1[2], o1[3]); w.z = pg8::cvt_pk_bf16(o2[0], o2[1]); w.w = pg8::cvt_pk_bf16(o2[2], o2[3]);
                            *(v4u*)(kb + (size_t)row * 512 + (pn - 6) * 256 + bj * 128 + cl) = w;
                            if (row < MR) {
                                float* ob = (row < MP ? okp + (size_t)row * 512 : oks + (size_t)(row - MP) * 512) + (pn - 6) * 256 + bj * 128 + (wc >> 1) * 64 + (wc & 1) * 16 + 4 * fq;
                                *(pg8::f32x4*)ob = o1; *(pg8::f32x4*)(ob + 32) = o2;
                            }
                        }
                    }
                } else if (pn < 10) {
#pragma unroll
                    for (int bj = 0; bj < 2; ++bj) {
                        const pg8::f32x4 v0 = acc[ai][bj][m][0] * s, v1 = acc[ai][bj][m][1] * s; const int col = (pn - 8) * 256 + bj * 128 + cl;
                        v4u w; w.x = pg8::cvt_pk_bf16(v0[0], v0[1]); w.y = pg8::cvt_pk_bf16(v0[2], v0[3]); w.z = pg8::cvt_pk_bf16(v1[0], v1[1]); w.w = pg8::cvt_pk_bf16(v1[2], v1[3]);
                        *(v4u*)(vb + (size_t)row * 512 + col) = w;
                        if (row < MR) { float* ob = (row < MP ? ovp + (size_t)row * 512 : ovs + (size_t)(row - MP) * 512) + col; *(pg8::f32x4*)ob = v0; *(pg8::f32x4*)(ob + 4) = v1; }
                    }
                } else {
                    if (wc == 0 && fq == 0) { const pg8::f32x4 v0 = acc[ai][0][m][0] * s, v1 = acc[ai][0][m][1] * s; *(pg8::f32x4*)(ab + (size_t)row * 8) = v0; *(pg8::f32x4*)(ab + (size_t)row * 8 + 4) = v1; }
                }
            }
    }
};
template <int MODE> struct EpiB {
    static constexpr bool PERM = true, AFTER_DRAIN = false;
    bfu* O; int ldc; const float* rs;
    __device__ __forceinline__ void operator()(const pg8::f32x4 (&acc)[2][2][4][2], const pg8::Unit& u, int wr, int wc, int fr, int fq) const {
        const int rowb = u.pm * 256 + wr * 64 + fr; const int cl = u.pn * 256 + wc * 32 + 8 * fq;
#pragma unroll
        for (int ai = 0; ai < 2; ++ai)
#pragma unroll
            for (int m = 0; m < 4; ++m) {
                const int row = rowb + ai * 128 + m * 16;
                float s = 1.f; if (MODE == 1) s = rsqrtf(rs[row] * (1.f / 1024.f) + 1e-6f);
                bfu* dst = O + (size_t)row * ldc + cl;
#pragma unroll
                for (int bj = 0; bj < 2; ++bj) {
                    pg8::f32x4 v0 = acc[ai][bj][m][0], v1 = acc[ai][bj][m][1];
                    if (MODE == 1) { v0 = v0 * s; v1 = v1 * s;
                        v0[0] = fmaxf(v0[0], 0.f); v0[1] = fmaxf(v0[1], 0.f); v0[2] = fmaxf(v0[2], 0.f); v0[3] = fmaxf(v0[3], 0.f); v1[0] = fmaxf(v1[0], 0.f); v1[1] = fmaxf(v1[1], 0.f); v1[2] = fmaxf(v1[2], 0.f); v1[3] = fmaxf(v1[3], 0.f);
                        v0 = v0 * v0; v1 = v1 * v1; }
                    v4u w; w.x = pg8::cvt_pk_bf16(v0[0], v0[1]); w.y = pg8::cvt_pk_bf16(v0[2], v0[3]); w.z = pg8::cvt_pk_bf16(v1[0], v1[1]); w.w = pg8::cvt_pk_bf16(v1[2], v1[3]);
                    *(v4u*)(dst + bj * 128) = w;
                }
            }
    }
};
template <int MODE> struct EpiH {
    static constexpr bool PERM = true, AFTER_DRAIN = false;
    float* H; bfu* xh; float* rsn; const float* rs; const bfu* pp;
    __device__ __forceinline__ void operator()(const pg8::f32x4 (&acc)[2][2][4][2], const pg8::Unit& u, int wr, int wc, int fr, int fq) const {
        const int rowb = u.pm * 256 + wr * 64 + fr; const int cl = u.pn * 256 + wc * 32 + 8 * fq;
#pragma unroll
        for (int ai = 0; ai < 2; ++ai)
#pragma unroll
            for (int m = 0; m < 4; ++m) {
                const int row = rowb + ai * 128 + m * 16; const bool valid = row < MR; float ss = 0.f;
                if (valid) {
                    float s = 1.f; if (MODE == 3) s = rsqrtf(rs[row] * (1.f / 1024.f) + 1e-6f);
#pragma unroll
                    for (int bj = 0; bj < 2; ++bj) {
                        const size_t off = (size_t)row * 1024 + cl + bj * 128;
                        pg8::f32x4 h0 = *(const pg8::f32x4*)(H + off), h1 = *(const pg8::f32x4*)(H + off + 4); const pg8::f32x4 a0 = acc[ai][bj][m][0], a1 = acc[ai][bj][m][1];
                        if (MODE == 3) { const v4u pw = *(const v4u*)(pp + off);
                            h0[0] += sigm(a0[0] * s) * __uint_as_float(pw.x << 16); h0[1] += sigm(a0[1] * s) * __uint_as_float(pw.x & 0xffff0000u);
                            h0[2] += sigm(a0[2] * s) * __uint_as_float(pw.y << 16); h0[3] += sigm(a0[3] * s) * __uint_as_float(pw.y & 0xffff0000u);
                            h1[0] += sigm(a1[0] * s) * __uint_as_float(pw.z << 16); h1[1] += sigm(a1[1] * s) * __uint_as_float(pw.z & 0xffff0000u);
                            h1[2] += sigm(a1[2] * s) * __uint_as_float(pw.w << 16); h1[3] += sigm(a1[3] * s) * __uint_as_float(pw.w & 0xffff0000u);
                        } else { h0 = h0 + a0; h1 = h1 + a1; }
                        *(pg8::f32x4*)(H + off) = h0; *(pg8::f32x4*)(H + off + 4) = h1;
                        v4u w; w.x = pg8::cvt_pk_bf16(h0[0], h0[1]); w.y = pg8::cvt_pk_bf16(h0[2], h0[3]); w.z = pg8::cvt_pk_bf16(h1[0], h1[1]); w.w = pg8::cvt_pk_bf16(h1[2], h1[3]); *(v4u*)(xh + off) = w;
                        ss += ((h0[0] * h0[0] + h0[1] * h0[1]) + (h0[2] * h0[2] + h0[3] * h0[3])) + ((h1[0] * h1[0] + h1[1] * h1[1]) + (h1[2] * h1[2] + h1[3] * h1[3]));
                    }
                }
                ss += __shfl_xor(ss, 16); ss += __shfl_xor(ss, 32);
                if (valid && fq == 0) unsafeAtomicAdd(rsn + row, ss);
            }
    }
};

__device__ __forceinline__ int win_src(int nd) {
    if (nd < 1024) return nd;
    if (nd < 2048) { const int c = nd - 1024, p = c & 63, grp = c >> 6; const int s = p >> 5, fq_ = (p >> 3) & 3, n_ = (p >> 2) & 1, j_ = p & 3; return 1032 + grp * 64 + n_ * 32 + s * 16 + 4 * fq_ + j_; }
    if (nd < 2560) return 2056 + (nd - 2048);
    if (nd < 3584) return 2568 + (nd - 2560);
    if (nd < 3592) return 1024 + (nd - 3584);
    return -1;
}
template <bool MAP> __device__ __forceinline__ void wt_item(const float* W, int K, int Nsrc, bfu* WT, const float* gain, LAS float* scr, int item, int nblk, int lane) {
    const int kb = item / nblk, nb = item % nblk, k0 = 64 * kb, n0 = 32 * nb;
    const int nd = n0 + (lane & 31); const int src = MAP ? win_src(nd) : nd;
#pragma unroll 8
    for (int i = 0; i < 32; ++i) { const int kk = 2 * i + (lane >> 5); float v = src >= 0 ? W[(size_t)(k0 + kk) * Nsrc + src] : 0.f; if (gain) v *= gain[k0 + kk]; scr[kk * 33 + (lane & 31)] = v; }
    LDS_WAIT(); asm volatile("" ::: "memory");
    const int c = lane & 7;
#pragma unroll
    for (int j = 0; j < 4; ++j) { const int n = (lane >> 3) + 8 * j; const LAS float* s = scr + (8 * c) * 33 + n;
        v4u o; o.x = pk2(s[0 * 33], s[1 * 33]); o.y = pk2(s[2 * 33], s[3 * 33]); o.z = pk2(s[4 * 33], s[5 * 33]); o.w = pk2(s[6 * 33], s[7 * 33]);
        *(v4u*)(WT + (size_t)(n0 + n) * K + k0 + 8 * c) = o; }
    LDS_WAIT(); asm volatile("" ::: "memory");
}
__device__ __forceinline__ void conv_weights(KArgs A, int l, int mask, LAS unsigned char* lds, int gw, int NGW, int lane, int wave) {
    LAS float* scr = (LAS float*)(lds + wave * 16384);
    unsigned char* wb = A->ws + WS_W;
    if (mask & 1) {
        const float* win = A->in[11] + (size_t)l * 1024 * 3592; const float* g = A->in[10] + l * 1024;
        for (int it = gw; it < 16 * 120; it += NGW) wt_item<true>(win, 1024, 3592, (bfu*)(wb + W_IN), g, scr, it, 120, lane);
        const float* wu = A->in[23] + (size_t)l * 64 * 256; const float* au = A->in[25] + (size_t)l * 64 * 256; const float* gu = A->in[26] + (size_t)l * 128 * 256;
        bfu* lr = (bfu*)(wb + W_LR);
        for (int i = gw * 64 + lane; i < 768 * 256; i += NGW * 64) { const int n = i >> 8, k = i & 255; float v = 0.f;
            if (n < 256) { if (k < 64) v = wu[k * 256 + n]; } else if (n < 512) { if (k >= 64 && k < 128) v = au[(k - 64) * 256 + (n - 256)]; } else { if (k >= 128) v = gu[(k - 128) * 256 + (n - 512)]; }
            lr[i] = (bfu)f2bf(v); }
    }
    if (mask & 2) {
        const float* wo = A->in[32] + (size_t)l * 1024 * 1024; const float* f1 = A->in[34] + (size_t)l * 1024 * 4096; const float* f2 = A->in[35] + (size_t)l * 4096 * 1024;
        const float* wg = A->in[37] + (size_t)l * 1024 * 1024; const float* wp = A->in[38] + (size_t)l * 256 * 1024;
        const float* gf = A->in[33] + l * 1024; const float* gp = A->in[36] + l * 1024;
        constexpr int I_O = 16 * 32, I_1 = 16 * 128, I_2 = 64 * 32, I_G = 16 * 32, I_P = 4 * 32;
        for (int it = gw; it < I_O + I_1 + I_2 + I_G + I_P; it += NGW) {
            int r = it;
            if (r < I_O) { wt_item<false>(wo, 1024, 1024, (bfu*)(wb + W_OUT), nullptr, scr, r, 32, lane); continue; } r -= I_O;
            if (r < I_1) { wt_item<false>(f1, 1024, 4096, (bfu*)(wb + W_FF1), gf, scr, r, 128, lane); continue; } r -= I_1;
            if (r < I_2) { wt_item<false>(f2, 4096, 1024, (bfu*)(wb + W_FF2), nullptr, scr, r, 32, lane); continue; } r -= I_2;
            if (r < I_G) { wt_item<false>(wg, 1024, 1024, (bfu*)(wb + W_GATE), gp, scr, r, 32, lane); continue; } r -= I_G;
            wt_item<false>(wp, 256, 1024, (bfu*)(wb + W_PP), nullptr, scr, r, 32, lane);
        }
    }
}
__device__ __forceinline__ void conv_p(KArgs A, int l, bfu* pb, int gtid, int NT) {
    const float* pp = A->in[8] + (size_t)l * MP * 256; const float* ps = A->in[9] + (size_t)l * MS * 256;
    for (int i = gtid; i < MR * 64; i += NT) { const int m = i >> 6, c = (i & 63) * 4;
        const f32x4 v = *(const f32x4*)(m < MP ? pp + (size_t)m * 256 + c : ps + (size_t)(m - MP) * 256 + c);
        v2u w; w.x = pk2(v[0], v[1]); w.y = pk2(v[2], v[3]); *(v2u*)(pb + (size_t)m * 256 + c) = w; }
}
__device__ __forceinline__ void prologue(KArgs A, LAS unsigned char* lds, int gw, int NGW, int lane, int wave, int gtid, int NT) {
    conv_weights(A, 0, 3, lds, gw, NGW, lane, wave);
    unsigned char* ws = A->ws;
    float* rs = (float*)(ws + WS_RS); bfu* xh = (bfu*)slotp(ws, 0, 0); float* H = A->out;
    for (int i = gtid; i < 6 * MPAD; i += NT) rs[MPAD + i] = 0.f;
    for (int m = gw; m < MPAD; m += NGW) {
        if (m < MR) {
            const float* xr = m < MP ? A->in[0] + (size_t)m * 1024 : A->in[1] + (size_t)(m - MP) * 1024; float ss = 0.f;
#pragma unroll
            for (int j = 0; j < 4; ++j) { const f32x4 v = *(const f32x4*)(xr + j * 256 + lane * 4); *(f32x4*)(H + (size_t)m * 1024 + j * 256 + lane * 4) = v;
                v2u w; w.x = pk2(v[0], v[1]); w.y = pk2(v[2], v[3]); *(v2u*)(xh + (size_t)m * 1024 + j * 256 + lane * 4) = w; ss += (v[0] * v[0] + v[1] * v[1]) + (v[2] * v[2] + v[3] * v[3]); }
            ss = wave_sum(ss); if (lane == 0) rs[m] = ss;
        } else {
#pragma unroll
            for (int j = 0; j < 4; ++j) *(v2u*)(xh + (size_t)m * 1024 + j * 256 + lane * 4) = (v2u){0u, 0u};
            if (lane == 0) rs[m] = 1024.f;
        }
    }
    float* rope = (float*)(ws + WS_ROPE);
    for (int i = gtid; i < 8192 * 32; i += NT) { const int pos = i >> 5, k = i & 31;
        const float inv = exp2f(-(float)k * (13.287712379549449f / 32.0f)); const float ang = (float)pos * inv;
        const float nn = rintf(ang * 0.15915494309189535f); const float fr = fmaf(-nn, 1.9353071795864769e-3f, fmaf(-nn, 6.28125f, ang));
        rope[pos * 64 + k] = __cosf(fr); rope[pos * 64 + 32 + k] = __sinf(fr); }
    if (gw == 0) {
        for (int l = 0; l < 2; ++l) {
            const float a = wave_sum(A->in[16][l * 64 + lane] * A->in[17][l * 64 + lane]), b = wave_sum(A->in[18][l * 64 + lane] * A->in[19][l * 64 + lane]);
            const float li = 0.8f - 0.6f * expf(-0.3f * (float)l);
            if (lane == 0) { float* lf = (float*)(ws + WS_CTL + 1024); lf[2 * l] = expf(a) - expf(b) + li; lf[2 * l + 1] = li; }
        }
    }
}

__device__ __forceinline__ void prep_a(KArgs A, int l, int gw, int NGW, int lane) {
    unsigned char* ws = A->ws;
    const bfu* aq = (const bfu*)slotp(ws, l, 2); const float* ab = (const float*)(ws + WS_AB);
    float* sia = (float*)slotp(ws, l, 9); bfu* va = (bfu*)slotp(ws, l, 11); bfu* zs = (bfu*)slotph(ws, l, 11); float* gab = (float*)(ws + WS_GAB);
    const float* cw = A->in[12] + l * 4 * 768; const float* stc = A->in[4] + (size_t)l * 8 * 3 * 768;
    const float* anorm = A->in[15] + l * 64;
    for (int g = gw; g < MR / 4; g += NGW) {
        const int m0 = 4 * g; int t0, L, sb = 0; const bool smp = m0 >= MP; float* aco;
        if (!smp) { t0 = m0 & 8191; L = 8192; aco = A->out + O_ACP + ((size_t)(l * 8 + (m0 >> 13)) * 3) * 768; }
        else { sb = (m0 - MP) >> 4; t0 = (m0 - MP) & 15; L = 16; aco = A->out + O_ACS + ((size_t)(l * 8 + sb) * 3) * 768; }
#pragma unroll 1
        for (int h = 0; h < 4; ++h) {
            float rows[3][7];
#pragma unroll
            for (int gi = 0; gi < 3; ++gi) { const int c = gi * 256 + h * 64 + lane;
#pragma unroll
                for (int r = 0; r < 7; ++r) { const int tt = t0 - 3 + r;
                    rows[gi][r] = tt >= 0 ? bf2f(aq[(size_t)(m0 - 3 + r) * 1024 + c]) : (smp ? stc[((size_t)sb * 3 + (3 + tt)) * 768 + c] : 0.f); } }
            float zv[4];
#pragma unroll
            for (int i = 0; i < 4; ++i) zv[i] = bf2f(aq[(size_t)(m0 + i) * 1024 + 768 + h * 64 + lane]);
            float val[4][3];
#pragma unroll
            for (int gi = 0; gi < 3; ++gi) { const int c = gi * 256 + h * 64 + lane; const float w0 = cw[c], w1 = cw[768 + c], w2 = cw[1536 + c], w3 = cw[2304 + c];
#pragma unroll
                for (int i = 0; i < 4; ++i) { const float y = rows[gi][i] * w0 + rows[gi][i + 1] * w1 + rows[gi][i + 2] * w2 + rows[gi][i + 3] * w3; val[i][gi] = y * sigm(y);
                    if (t0 + i >= L - 3) aco[(size_t)(t0 + i - (L - 3)) * 768 + c] = rows[gi][i + 3]; } }
#pragma unroll
            for (int i = 0; i < 4; ++i) { const int m = m0 + i;
                const float sq = wave_sum(val[i][0] * val[i][0]), sk = wave_sum(val[i][1] * val[i][1]);
                const float qn = val[i][0] * rsqrtf(sq + 1e-6f) * 0.125f, kn = val[i][1] * rsqrtf(sk + 1e-6f);
                float* rec = sia + ((size_t)(h * 8 + (lane >> 3)) * MPAD + m) * 16 + (lane & 7);
                rec[0] = kn; rec[8] = qn;
                va[(size_t)m * 256 + h * 64 + lane] = (bfu)f2bf(val[i][2]);
                zs[(size_t)m * 256 + h * 64 + lane] = (bfu)f2bf(zv[i] * sigm(zv[i]) * anorm[lane]); }
        }
        if (lane < 16) { const int m = m0 + (lane >> 2), hh = lane & 3;
            const float gl = -__expf(A->in[13][l * 4 + hh]) * softplusf(ab[(size_t)m * 8 + hh] + A->in[14][l * 4 + hh]);
            gab[((size_t)hh * MPAD + m) * 2] = __expf(gl); gab[((size_t)hh * MPAD + m) * 2 + 1] = sigm(ab[(size_t)m * 8 + 4 + hh]); }
    }
}
__device__ __forceinline__ void prep_c1(KArgs A, int l, int gw, int NGW, int lane) {
    unsigned char* ws = A->ws;
    const bfu* cr = (const bfu*)slotp(ws, l, 7); bfu* lra = (bfu*)slotp(ws, l, 12);
    const float* mu = A->in[21] + l * 1024; const float* sts = A->in[6] + (size_t)l * 8 * 1024;
    for (int g = gw; g < MR / 4; g += NGW) {
        const int m0 = 4 * g; int t0, L, sb = 0; const bool smp = m0 >= MP; float* cso;
        if (!smp) { t0 = m0 & 8191; L = 8192; cso = A->out + O_CSP + (size_t)(l * 8 + (m0 >> 13)) * 1024; }
        else { sb = (m0 - MP) >> 4; t0 = (m0 - MP) & 15; L = 16; cso = A->out + O_CSS + (size_t)(l * 8 + sb) * 1024; }
        float rows[4][5];
#pragma unroll
        for (int i = 0; i < 4; ++i) { const int j = 768 + lane + 64 * i;
            rows[i][0] = t0 > 0 ? bf2f(cr[(size_t)(m0 - 1) * 1024 + j]) : (smp ? sts[(size_t)sb * 1024 + j] : 0.f);
#pragma unroll
            for (int r = 0; r < 4; ++r) rows[i][r + 1] = bf2f(cr[(size_t)(m0 + r) * 1024 + j]); }
#pragma unroll
        for (int i = 0; i < 4; ++i) { const float muj = mu[768 + lane + 64 * i];
#pragma unroll
            for (int r = 0; r < 4; ++r) { const float cur = rows[i][r + 1], prev = rows[i][r]; const float c = cur + (prev - cur) * muj;
                const float o = i == 0 ? tanhf(c) : (i == 1 ? c : sigm(c));
                lra[(size_t)(m0 + r) * 256 + lane + 64 * i] = (bfu)f2bf(o); } }
        if (t0 + 3 == L - 1) {
#pragma unroll
            for (int i = 0; i < 16; ++i) cso[lane + 64 * i] = bf2f(cr[(size_t)(m0 + 3) * 1024 + lane + 64 * i]);
        }
    }
}
__device__ __forceinline__ void prep_c2(KArgs A, int l, int bid, int G, int tid) {
    unsigned char* ws = A->ws;
    const bfu* cr = (const bfu*)slotp(ws, l, 7); const bfu* lro = (const bfu*)slotp(ws, l, 13);
    bfu* v2 = (bfu*)slotp(ws, l, 12); bfu* gg = (bfu*)slotph(ws, l, 12);
    float* bonus = (float*)(ws + WS_BONUS); float* gch = (float*)(ws + WS_GCH); float* pairc = (float*)(ws + WS_PAIRC);
    const float* mu = A->in[21] + l * 1024; const float* sts = A->in[6] + (size_t)l * 8 * 1024;
    const int ch = tid & 255, h = ch >> 6, lane = ch & 63, half = tid >> 8;
    float* sic = (float*)slotp(ws, l, h) + ((size_t)(lane >> 3) * MPAD) * 32 + (lane & 7);
    const float mur = mu[ch], muk = mu[256 + ch], muv = mu[512 + ch];
    const float w0 = A->in[22][l * 256 + ch], a0 = A->in[24][l * 256 + ch], kk_ = A->in[27][l * 256 + ch], ka = A->in[28][l * 256 + ch], rk = A->in[29][l * 256 + ch];
    for (int u = bid * 2 + half; u < 1032; u += G * 2) {
        int m0, n; float pr, pk, pv;
        if (u < 1024) { m0 = u * 64; n = 64;
            if ((u & 127) == 0) { pr = pk = pv = 0.f; } else { pr = bf2f(cr[(size_t)(m0 - 1) * 1024 + ch]); pk = bf2f(cr[(size_t)(m0 - 1) * 1024 + 256 + ch]); pv = bf2f(cr[(size_t)(m0 - 1) * 1024 + 512 + ch]); } }
        else { const int sb = u - 1024; m0 = MP + sb * 16; n = 16; pr = sts[(size_t)sb * 1024 + ch]; pk = sts[(size_t)sb * 1024 + 256 + ch]; pv = sts[(size_t)sb * 1024 + 512 + ch]; }
        float cum = 0.f, pkka = 0.f, pkp = 0.f;
#pragma unroll 4
        for (int tt = 0; tt < n; ++tt) { const int m = m0 + tt;
            const float c_r = bf2f(cr[(size_t)m * 1024 + ch]), c_k = bf2f(cr[(size_t)m * 1024 + 256 + ch]), c_v = bf2f(cr[(size_t)m * 1024 + 512 + ch]);
            const float r = c_r + (pr - c_r) * mur, k = c_k + (pk - c_k) * muk, v = c_v + (pv - c_v) * muv; pr = c_r; pk = c_k; pv = c_v;
            const float lw = bf2f(lro[(size_t)m * 768 + ch]), la = bf2f(lro[(size_t)m * 768 + 256 + ch]); const bfu gb = lro[(size_t)m * 768 + 512 + ch];
            const float wl = -0.6065306597126334f * sigm(w0 + lw); const float a = sigm(a0 + la);
            const float kkr = k * kk_; const float kk = kkr * rsqrtf(wave_sum(kkr * kkr) + 1e-6f);
            const float kp = k * (1.f + (a - 1.f) * ka);
            const float Gp = __expf(cum); cum += wl; const float Gc = __expf(cum), iG = __expf(-cum);
            float* rec = sic + (size_t)m * 32;
            rec[0] = kk * Gp; rec[8] = kk * a * iG; rec[16] = kp * iG; rec[24] = r * Gc;
            { const float kka = kk * a; float* pc = pairc + ((size_t)h * (MPAD / 2) + (m >> 1)) * 4;
              if (tt & 1) { const float c22 = wave_sum(pkka * kk), c32 = wave_sum(pkp * kk); if (lane == 0) { pc[0] = c22; pc[1] = c32; } }
              else { const float c24 = wave_sum(kka * r), c34 = wave_sum(kp * r); if (lane == 0) { pc[2] = c24; pc[3] = c34; } }
              pkka = kka; pkp = kp; }
            const float bo = wave_sum(r * kp * rk); if (lane == 0) bonus[(size_t)h * MPAD + m] = bo;
            v2[(size_t)m * 256 + ch] = (bfu)f2bf(v); gg[(size_t)m * 256 + ch] = gb;
        }
        gch[((size_t)h * 1032 + u) * 64 + lane] = __expf(cum);
    }
}
__device__ __forceinline__ void prep_a2(KArgs A, int l, int gw, int NGW, int lane) {
    unsigned char* ws = A->ws; const float* sia = (const float*)slotp(ws, l, 9); float* paird = (float*)(ws + WS_PAIRD);
    for (int task = gw; task < 4 * (MR / 2); task += NGW) { const int h = task & 3, pr = task >> 2, m = 2 * pr;
        const float* rec = sia + ((size_t)(h * 8 + (lane >> 3)) * MPAD + m) * 16 + (lane & 7);
        const float k1 = rec[0], q1 = rec[8], k2 = rec[16];
        const float g12 = wave_sum(k1 * k2), h11 = wave_sum(q1 * k1);
        if (lane == 0) { paird[((size_t)h * (MPAD / 2) + pr) * 2] = g12; paird[((size_t)h * (MPAD / 2) + pr) * 2 + 1] = h11; } }
}
__device__ __forceinline__ void post_attn(KArgs A, int l, int gw, int NGW, int lane) {
    unsigned char* ws = A->ws;
    const bfu* O = (const bfu*)slotp(ws, l, 13); bfu* mix = (bfu*)slotp(ws, l, 7);
    const float* lf = (const float*)(ws + WS_CTL + 1024); const float lam = lf[2 * l], omli = 1.f - lf[2 * l + 1];
    const int h = lane >> 4, e0 = (lane & 15) * 8; const float* bn = A->in[20] + l * 128 + e0;
    float bnv[8];
#pragma unroll
    for (int i = 0; i < 8; ++i) bnv[i] = bn[i] * omli;
    for (int g = gw; g < MP / 4; g += NGW) {
        v4u av[4], bv[4];
#pragma unroll
        for (int i = 0; i < 4; ++i) { const size_t m = (size_t)(4 * g + i);
            av[i] = *(const v4u*)(O + m * 1024 + (4 * h + (e0 >> 6)) * 64 + (e0 & 63)); bv[i] = *(const v4u*)(O + m * 1024 + (4 * h + 2 + (e0 >> 6)) * 64 + (e0 & 63)); }
#pragma unroll
        for (int i = 0; i < 4; ++i) { const size_t m = (size_t)(4 * g + i);
            float o[8]; float ss = 0.f;
#pragma unroll
            for (int q = 0; q < 4; ++q) { const unsigned aw = av[i][q], bw = bv[i][q];
                o[2 * q] = __uint_as_float(aw << 16) - lam * __uint_as_float(bw << 16); o[2 * q + 1] = __uint_as_float(aw & 0xffff0000u) - lam * __uint_as_float(bw & 0xffff0000u);
                ss += o[2 * q] * o[2 * q] + o[2 * q + 1] * o[2 * q + 1]; }
            ss += __shfl_xor(ss, 1); ss += __shfl_xor(ss, 2); ss += __shfl_xor(ss, 4); ss += __shfl_xor(ss, 8);
            const float rn = rsqrtf(ss * (1.f / 128.f) + 1e-6f);
            v4u w; w.x = pk2(o[0] * rn * bnv[0], o[1] * rn * bnv[1]); w.y = pk2(o[2] * rn * bnv[2], o[3] * rn * bnv[3]); w.z = pk2(o[4] * rn * bnv[4], o[5] * rn * bnv[5]); w.w = pk2(o[6] * rn * bnv[6], o[7] * rn * bnv[7]);
            *(v4u*)(mix + m * 1024 + 256 + h * 128 + e0) = w; }
    }
}
__device__ __forceinline__ void post_scan(KArgs A, int l, int gw, int NGW, int lane) {
    unsigned char* ws = A->ws; bfu* mix = (bfu*)slotp(ws, l, 7);
    const bfu* zs = (const bfu*)slotph(ws, l, 11); const bfu* v2 = (const bfu*)slotp(ws, l, 12); const bfu* gg = (const bfu*)slotph(ws, l, 12);
    const float* bonus = (const float*)(ws + WS_BONUS);
    for (int m = gw; m < MR; m += NGW) {
#pragma unroll
        for (int h = 0; h < 4; ++h) {
            bfu* pa = mix + (size_t)m * 1024 + h * 64 + lane; const float o = bf2f(*pa);
            const float ss = wave_sum(o * o) * (1.f / 64.f);
            *pa = (bfu)f2bf(o * rsqrtf(ss + 1e-6f) * bf2f(zs[(size_t)m * 256 + h * 64 + lane]));
            bfu* pc = mix + (size_t)m * 1024 + 768 + h * 64 + lane; const float y = bf2f(*pc);
            const float mu = wave_sum(y) * (1.f / 64.f); const float d = y - mu; const float var = wave_sum(d * d) * (1.f / 64.f);
            const float cy = d * rsqrtf(var + 64e-5f) * A->in[30][l * 256 + h * 64 + lane] + A->in[31][l * 256 + h * 64 + lane];
            *pc = (bfu)f2bf((cy + bonus[(size_t)h * MPAD + m] * bf2f(v2[(size_t)m * 256 + h * 64 + lane])) * bf2f(gg[(size_t)m * 256 + h * 64 + lane]));
        }
    }
}
__device__ __forceinline__ void final_norm(KArgs A, int gw, int NGW, int lane) {
    const float* rs = (const float*)(A->ws + WS_RS) + 6 * (size_t)MPAD; const float* g = A->in[39];
    f32x4 gv[4];
#pragma unroll
    for (int j = 0; j < 4; ++j) gv[j] = *(const f32x4*)(g + j * 256 + lane * 4);
    for (int q = gw; q < MR / 4; q += NGW) {
        f32x4 v[4][4]; float s[4];
#pragma unroll
        for (int i = 0; i < 4; ++i) { const size_t mm = (size_t)(4 * q + i); s[i] = rsqrtf(rs[mm] * (1.f / 1024.f) + 1e-6f);
#pragma unroll
            for (int j = 0; j < 4; ++j) v[i][j] = *(const f32x4*)(A->out + mm * 1024 + j * 256 + lane * 4); }
#pragma unroll
        for (int i = 0; i < 4; ++i) { const size_t mm = (size_t)(4 * q + i);
#pragma unroll
            for (int j = 0; j < 4; ++j) *(f32x4*)(A->out + mm * 1024 + j * 256 + lane * 4) = v[i][j] * s[i] * gv[j]; }
    }
}

#define SC_BAR() asm volatile("s_waitcnt lgkmcnt(0)\n\ts_barrier" ::: "memory")
constexpr int SC_RED = 0, SC_SI = 16384, SC_VBUF = 81920, SC_GBUF = 90112, SC_BON = 98304, SC_PC = 98816, SC_YP = 99328;
#define FMAC_DPP(acc, op, s1, J) asm("v_fmac_f32_dpp %0, %1, %2 row_newbcast:" #J " row_mask:0xf bank_mask:0xf" : "+v"(acc) : "v"(op), "v"(s1))
#define DOT8(a0, a1, op, JB0, JB1, JB2, JB3, JB4, JB5, JB6, JB7) do { FMAC_DPP(a0, op, S[0], JB0); FMAC_DPP(a1, op, S[1], JB1); FMAC_DPP(a0, op, S[2], JB2); FMAC_DPP(a1, op, S[3], JB3); \
        FMAC_DPP(a0, op, S[4], JB4); FMAC_DPP(a1, op, S[5], JB5); FMAC_DPP(a0, op, S[6], JB6); FMAC_DPP(a1, op, S[7], JB7); } while (0)
#define DOT8_LO(a0, a1, op) DOT8(a0, a1, op, 0, 1, 2, 3, 4, 5, 6, 7)
#define DOT8_HI(a0, a1, op) DOT8(a0, a1, op, 8, 9, 10, 11, 12, 13, 14, 15)
#define AXPY8_LO(op, s) do { FMAC_DPP(S[0], op, s, 0); FMAC_DPP(S[1], op, s, 1); FMAC_DPP(S[2], op, s, 2); FMAC_DPP(S[3], op, s, 3); FMAC_DPP(S[4], op, s, 4); FMAC_DPP(S[5], op, s, 5); FMAC_DPP(S[6], op, s, 6); FMAC_DPP(S[7], op, s, 7); } while (0)
#define AXPY8_HI(op, s) do { FMAC_DPP(S[0], op, s, 8); FMAC_DPP(S[1], op, s, 9); FMAC_DPP(S[2], op, s, 10); FMAC_DPP(S[3], op, s, 11); FMAC_DPP(S[4], op, s, 12); FMAC_DPP(S[5], op, s, 13); FMAC_DPP(S[6], op, s, 14); FMAC_DPP(S[7], op, s, 15); } while (0)
#define PKF(a, b, c) __builtin_elementwise_fma((a), (b), (c))
#define AXPYV(X0, X1, s) do { const f32x2 s_ = (f32x2){(s), (s)}; f32x2 p0_ = (f32x2){S[0], S[1]}, p1_ = (f32x2){S[2], S[3]}, p2_ = (f32x2){S[4], S[5]}, p3_ = (f32x2){S[6], S[7]}; \
        p0_ = PKF(((f32x2){X0[0], X0[1]}), s_, p0_); p1_ = PKF(((f32x2){X0[2], X0[3]}), s_, p1_); p2_ = PKF(((f32x2){X1[0], X1[1]}), s_, p2_); p3_ = PKF(((f32x2){X1[2], X1[3]}), s_, p3_); \
        S[0] = p0_[0]; S[1] = p0_[1]; S[2] = p1_[0]; S[3] = p1_[1]; S[4] = p2_[0]; S[5] = p2_[1]; S[6] = p3_[0]; S[7] = p3_[1]; } while (0)
#define RED8(V) do { const LAS f32x4* rr_ = (const LAS f32x4*)red + par_ * 512 + lane; const f32x4 q0_ = rr_[0], q1_ = rr_[64], q2_ = rr_[128], q3_ = rr_[192], q4_ = rr_[256], q5_ = rr_[320], q6_ = rr_[384], q7_ = rr_[448]; \
        V = ((q0_ + q1_) + (q2_ + q3_)) + ((q4_ + q5_) + (q6_ + q7_)); } while (0)

#define SWAPSUM(v) do { const unsigned u_ = __float_as_uint(v); auto rr_ = __builtin_amdgcn_permlane32_swap(u_, u_, false, false); v = __uint_as_float(rr_[0]) + __uint_as_float(rr_[1]); } while (0)
#define DOT4_LO(a0, a1, op) do { FMAC_DPP(a0, op, S[0], 0); FMAC_DPP(a1, op, S[1], 1); FMAC_DPP(a0, op, S[2], 2); FMAC_DPP(a1, op, S[3], 3); } while (0)
#define DOT4_HI(a0, a1, op) do { FMAC_DPP(a0, op, S[0], 4); FMAC_DPP(a1, op, S[1], 5); FMAC_DPP(a0, op, S[2], 6); FMAC_DPP(a1, op, S[3], 7); } while (0)
#define AXPY4(X, s) do { const f32x2 s_ = (f32x2){(s), (s)}; f32x2 p0_ = (f32x2){S[0], S[1]}, p1_ = (f32x2){S[2], S[3]}; p0_ = PKF(((f32x2){X[0], X[1]}), s_, p0_); p1_ = PKF(((f32x2){X[2], X[3]}), s_, p1_); S[0] = p0_[0]; S[1] = p0_[1]; S[2] = p1_[0]; S[3] = p1_[1]; } while (0)
__device__ __forceinline__ void scan_rwkv(KArgs A, int l, LAS unsigned char* lds, int h, int half, int m0, int L, int BL, int BLS, int chunk0, const float* st_in, float* st_out, int tid) {
    unsigned char* ws = A->ws;
    const int lane = tid & 63, wid = __builtin_amdgcn_readfirstlane(tid >> 6); const int kh = lane >> 5, r = lane & 31, row = 32 * half + r;
    LAS float* red = (LAS float*)(lds + SC_RED); LAS float* yred = (LAS float*)(lds + SC_YP);
    LAS float* sib = (LAS float*)(lds + SC_SI) + wid * 1024;
    LAS bfu* vbuf = (LAS bfu*)(lds + SC_VBUF); LAS float* pcs = (LAS float*)(lds + SC_PC);
    const bfu* v2 = (const bfu*)slotp(ws, l, 12);
    const float* pairc = (const float*)(ws + WS_PAIRC) + ((size_t)h * (MPAD / 2) + (m0 >> 1)) * 4;
    const float* gch = (const float*)(ws + WS_GCH) + ((size_t)h * 1032 + chunk0) * 64 + 8 * wid + 4 * kh;
    bfu* mix = (bfu*)slotp(ws, l, 7);
    const float* P = (const float*)slotp(ws, l, h) + ((size_t)wid * MPAD + m0) * 32;
    float S[4];
#pragma unroll
    for (int j = 0; j < 4; ++j) S[j] = st_in ? st_in[row * 64 + 8 * wid + 4 * kh + j] : 0.f;
    const int nblk = L >> BLS; const int srow = tid >> 4, sc4 = tid & 15; const bool sval = srow < BL;
    const int nsi = BL >> 3;
    f32x4 ssi[4]; v2u sv = {0, 0}; float sp_ = 0.f;
#define RW_STAGE(c) do { const float* ps_ = P + (size_t)(c) * BL * 32 + lane * 4; \
        _Pragma("unroll") for (int i_ = 0; i_ < 4; ++i_) if (i_ < nsi) ssi[i_] = *(const f32x4*)(ps_ + i_ * 256); \
        if (sval) { const size_t mm = (size_t)(m0 + (c) * BL + srow) * 256 + h * 64 + sc4 * 4; sv = *(const v2u*)(v2 + mm); } \
        if (tid < 2 * BL) sp_ = pairc[(size_t)(c) * BL * 2 + tid]; } while (0)
#define RW_COMMIT(c) do { LAS float* pd_ = sib + ((c) & 1) * 8192 + lane * 4; \
        _Pragma("unroll") for (int i_ = 0; i_ < 4; ++i_) if (i_ < nsi) *(LAS f32x4*)(pd_ + i_ * 256) = ssi[i_]; \
        if (sval) { *(LAS v2u*)(vbuf + ((c) & 1) * 2048 + srow * 64 + sc4 * 4) = sv; } \
        if (tid < 2 * BL) pcs[((c) & 1) * 64 + tid] = sp_; } while (0)
    __syncthreads();
    RW_STAGE(0); RW_COMMIT(0); if (nblk > 1) RW_STAGE(1);
    const int dsel = ((lane & 4) ? 24 : 0) + 4 * kh + (lane & 3);
    float ca0, ca1, cb0 = 0.f, cb1 = 0.f; f32x4 cau[4], cbu[4];
#define RW_LOADOPS(D, T) do { const LAS float* pb_ = sib + ((((T) >> BLS) & 1) * 8192) + ((T) & (BL - 1)) * 32; \
        D##0 = pb_[dsel]; D##1 = pb_[32 + dsel]; const LAS f32x4* pu_ = (const LAS f32x4*)(pb_ + 4 * kh); \
        D##u[0] = pu_[2]; D##u[1] = pu_[4]; D##u[2] = pu_[10]; D##u[3] = pu_[12]; } while (0)
    RW_LOADOPS(ca, 0);
#define RW_FINAL(T) do { const int tf_ = (T); \
        const LAS float* yr_ = yred + (tf_ & 15) * 512 + lane; const float y_ = ((yr_[0] + yr_[64]) + (yr_[128] + yr_[192])) + ((yr_[256] + yr_[320]) + (yr_[384] + yr_[448])); \
        if (lane < 32) mix[(size_t)(m0 + tf_) * 1024 + 768 + h * 64 + row] = (bfu)f2bf(y_); } while (0)
#define RW_ROUND(C, N, T) do { const int par_ = ((T) >> 1) & 1; \
        float d1a = 0.f, d1b = 0.f, d2a = 0.f, d2b = 0.f, f1a = 0.f, f1b = 0.f; \
        DOT4_LO(d1a, d1b, C##0); DOT4_LO(d2a, d2b, C##1); DOT4_HI(f1a, f1b, C##0); \
        float d1 = d1a + d1b, d2 = d2a + d2b, f1 = f1a + f1b; SWAPSUM(d1); SWAPSUM(d2); SWAPSUM(f1); \
        ((LAS f32x4*)red)[(par_ * 8 + wid) * 64 + lane] = (f32x4){d1, d2, f1, 0.f}; \
        SC_BAR(); \
        f32x4 tot_; RED8(tot_); \
        const int bo_ = (((T) >> BLS) & 1), to_ = (T) & (BL - 1); \
        const float v1 = bf2f(vbuf[bo_ * 2048 + to_ * 64 + row]), v2_ = bf2f(vbuf[bo_ * 2048 + to_ * 64 + 64 + row]); const f32x4 pc_ = *(const LAS f32x4*)(pcs + bo_ * 64 + to_ * 2); \
        asm volatile("" ::: "memory"); \
        if ((T) + 2 < L) RW_LOADOPS(N, (T) + 2); \
        __builtin_amdgcn_sched_barrier(0); \
        const float sa1 = -tot_[0]; const float sa2 = -(tot_[1] + sa1 * pc_[0] + v1 * pc_[1]); const float y1 = tot_[2] + sa1 * pc_[2] + v1 * pc_[3]; \
        AXPY4(C##u[1], v1); AXPY4(C##u[0], sa1); AXPY4(C##u[3], v2_); AXPY4(C##u[2], sa2); \
        float y2a = 0.f, y2b = 0.f; DOT4_HI(y2a, y2b, C##1); float y2 = y2a + y2b; SWAPSUM(y2); \
        yred[((T) & 15) * 512 + wid * 64 + lane] = y1 * 0.125f; yred[(((T) + 1) & 15) * 512 + wid * 64 + lane] = y2; } while (0)
    for (int c = 0; c < nblk; ++c) {
        for (int tt = 0; tt < BL; tt += 4) {
            const int t = c * BL + tt;
            if (tt == (BL >> 1) && c + 1 < nblk) { RW_COMMIT(c + 1); if (c + 2 < nblk) RW_STAGE(c + 2); }
            RW_ROUND(ca, cb, t);
            RW_ROUND(cb, ca, t + 2);
            if (((t + 3) & 15) == 15) { SC_BAR(); RW_FINAL(t - 12 + 2 * wid); RW_FINAL(t - 11 + 2 * wid); }
        }
        if ((((c + 1) << BLS) & 63) == 0 || c + 1 == nblk) {
            const float* ge = gch + (size_t)((c << BLS) >> 6) * 64;
#pragma unroll
            for (int j = 0; j < 4; ++j) S[j] *= ge[j];
        }
    }
#pragma unroll
    for (int j = 0; j < 4; ++j) st_out[row * 64 + 8 * wid + 4 * kh + j] = S[j];
    __syncthreads();
#undef RW_STAGE
#undef RW_COMMIT
#undef RW_LOADOPS
#undef RW_FINAL
#undef RW_ROUND
}

__device__ __forceinline__ void scan_delta(KArgs A, int l, LAS unsigned char* lds, int h, int half, int m0, int L, int BL, int BLS, const float* st_in, float* st_out, int tid) {
    unsigned char* ws = A->ws;
    const int lane = tid & 63, wid = __builtin_amdgcn_readfirstlane(tid >> 6); const int kh = lane >> 5, r = lane & 31, row = 32 * half + r;
    LAS float* red = (LAS float*)(lds + SC_RED); LAS float* yred = (LAS float*)(lds + SC_YP);
    LAS float* sib = (LAS float*)(lds + SC_SI) + wid * 512;
    LAS bfu* vbuf = (LAS bfu*)(lds + SC_VBUF); LAS float* gab = (LAS float*)(lds + SC_BON); LAS float* pds = (LAS float*)(lds + SC_PC);
    const bfu* va = (const bfu*)slotp(ws, l, 11);
    bfu* mix = (bfu*)slotp(ws, l, 7);
    const float* P = (const float*)slotp(ws, l, 9) + ((size_t)(h * 8 + wid) * MPAD + m0) * 16;
    const float* PG = (const float*)(ws + WS_GAB) + ((size_t)h * MPAD + m0) * 2;
    const float* paird = (const float*)(ws + WS_PAIRD) + ((size_t)h * (MPAD / 2) + (m0 >> 1)) * 2;
    float S[4];
#pragma unroll
    for (int j = 0; j < 4; ++j) S[j] = st_in ? st_in[(8 * wid + 4 * kh + j) * 64 + row] : 0.f;
    const int nblk = L >> BLS; const int srow = tid >> 4, sc4 = tid & 15; const bool sval = srow < BL;
    const int nsi = BL >> 4;
    f32x4 ssi[2]; v2u sv = {0, 0}; float sb_ = 0.f, sp_ = 0.f;
#define DL_STAGE(c) do { const float* ps_ = P + (size_t)(c) * BL * 16 + lane * 4; \
        _Pragma("unroll") for (int i_ = 0; i_ < 2; ++i_) if (i_ < nsi) ssi[i_] = *(const f32x4*)(ps_ + i_ * 256); \
        if (sval) { const size_t mm = (size_t)(m0 + (c) * BL + srow) * 256 + h * 64 + sc4 * 4; sv = *(const v2u*)(va + mm); } \
        if (tid < 2 * BL) sb_ = PG[(size_t)(c) * BL * 2 + tid]; if (tid < BL) sp_ = paird[(size_t)(c) * BL + tid]; } while (0)
#define DL_COMMIT(c) do { LAS float* pd_ = sib + ((c) & 1) * 4096 + lane * 4; \
        _Pragma("unroll") for (int i_ = 0; i_ < 2; ++i_) if (i_ < nsi) *(LAS f32x4*)(pd_ + i_ * 256) = ssi[i_]; \
        if (sval) { *(LAS v2u*)(vbuf + ((c) & 1) * 2048 + srow * 64 + sc4 * 4) = sv; } \
        if (tid < 2 * BL) gab[((c) & 1) * 64 + tid] = sb_; if (tid < BL) pds[((c) & 1) * 32 + tid] = sp_; } while (0)
    __syncthreads();
    DL_STAGE(0); DL_COMMIT(0); if (nblk > 1) DL_STAGE(1);
    const int dsel = ((lane & 4) ? 8 : 0) + 4 * kh + (lane & 3);
    float ca0, ca1, cb0 = 0.f, cb1 = 0.f; f32x4 cau[2], cbu[2];
#define DL_LOADOPS(D, T) do { const LAS float* pb_ = sib + ((((T) >> BLS) & 1) * 4096) + ((T) & (BL - 1)) * 16; D##0 = pb_[dsel]; D##1 = pb_[16 + dsel]; \
        const LAS f32x4* pu_ = (const LAS f32x4*)(pb_ + 4 * kh); D##u[0] = pu_[0]; D##u[1] = pu_[4]; } while (0)
    DL_LOADOPS(ca, 0);
#define DL_FINAL(T) do { const int tf_ = (T); \
        const LAS float* yr_ = yred + (tf_ & 15) * 512 + lane; const float o_ = ((yr_[0] + yr_[64]) + (yr_[128] + yr_[192])) + ((yr_[256] + yr_[320]) + (yr_[384] + yr_[448])); \
        if (lane < 32) mix[(size_t)(m0 + tf_) * 1024 + h * 64 + row] = (bfu)f2bf(o_); } while (0)
#define DL_ROUND(C, N, T) do { const int par_ = ((T) >> 1) & 1; \
        float d1a = 0.f, d1b = 0.f, d2a = 0.f, d2b = 0.f, f1a = 0.f, f1b = 0.f; \
        DOT4_LO(d1a, d1b, C##0); DOT4_LO(d2a, d2b, C##1); DOT4_HI(f1a, f1b, C##0); \
        float d1 = d1a + d1b, d2 = d2a + d2b, f1 = f1a + f1b; SWAPSUM(d1); SWAPSUM(d2); SWAPSUM(f1); \
        ((LAS f32x4*)red)[(par_ * 8 + wid) * 64 + lane] = (f32x4){d1, d2, f1, 0.f}; \
        SC_BAR(); \
        f32x4 tot_; RED8(tot_); \
        const int bo_ = (((T) >> BLS) & 1), to_ = (T) & (BL - 1); \
        const float v1 = bf2f(vbuf[bo_ * 2048 + to_ * 64 + row]), v2_ = bf2f(vbuf[bo_ * 2048 + to_ * 64 + 64 + row]); \
        const f32x4 ab_ = *(const LAS f32x4*)(gab + bo_ * 64 + to_ * 2); const f32x2 pd2_ = *(const LAS f32x2*)(pds + bo_ * 32 + to_); \
        asm volatile("" ::: "memory"); \
        if ((T) + 2 < L) DL_LOADOPS(N, (T) + 2); \
        __builtin_amdgcn_sched_barrier(0); \
        const float a1 = ab_[0], a2 = ab_[2]; const float dl1 = ab_[1] * (v1 - a1 * tot_[0]); const float dl2 = ab_[3] * (v2_ - a2 * (a1 * tot_[1] + pd2_[0] * dl1)); \
        const float o1 = a1 * tot_[2] + pd2_[1] * dl1; const float a12 = a1 * a2, dl1s = a2 * dl1; \
        _Pragma("unroll") for (int j = 0; j < 4; ++j) S[j] *= a12; \
        AXPY4(C##u[0], dl1s); AXPY4(C##u[1], dl2); \
        float y2a = 0.f, y2b = 0.f; DOT4_HI(y2a, y2b, C##1); float y2 = y2a + y2b; SWAPSUM(y2); \
        yred[((T) & 15) * 512 + wid * 64 + lane] = o1 * 0.125f; yred[(((T) + 1) & 15) * 512 + wid * 64 + lane] = y2; } while (0)
    for (int c = 0; c < nblk; ++c) {
        for (int tt = 0; tt < BL; tt += 4) {
            const int t = c * BL + tt;
            if (tt == (BL >> 1) && c + 1 < nblk) { DL_COMMIT(c + 1); if (c + 2 < nblk) DL_STAGE(c + 2); }
            DL_ROUND(ca, cb, t);
            DL_ROUND(cb, ca, t + 2);
            if (((t + 3) & 15) == 15) { SC_BAR(); DL_FINAL(t - 12 + 2 * wid); DL_FINAL(t - 11 + 2 * wid); }
        }
    }
#pragma unroll
    for (int j = 0; j < 4; ++j) st_out[(8 * wid + 4 * kh + j) * 64 + row] = S[j];
    __syncthreads();
#undef DL_STAGE
#undef DL_COMMIT
#undef DL_LOADOPS
#undef DL_FINAL
#undef DL_ROUND
}

__device__ __forceinline__ void sample_attn(KArgs A, int l, LAS unsigned char* lds, int unit, int tid) {
    unsigned char* ws = A->ws;
    const int sb = unit >> 2, h = unit & 3;
    LAS float* qs = (LAS float*)lds;
    LAS float* sc = qs + 2048;
    LAS float* scl = sc + 1024;
    LAS float* ssq = scl + 32;
    LAS float* lsum = ssq + 512;
    const bfu* qb = (const bfu*)slotp(ws, l, 4); bfu* mix = (bfu*)slotp(ws, l, 7);
    const float* ck = A->in[2] + (size_t)(l * 8 + sb) * 2048 * 512 + h * 128; const float* cv = A->in[3] + (size_t)(l * 8 + sb) * 2048 * 512 + h * 128;
    const float* nk = A->out + O_BKS + (size_t)(l * 8 + sb) * 16 * 512 + h * 128; const float* nv = A->out + O_BVS + (size_t)(l * 8 + sb) * 16 * 512 + h * 128;
    const float* lf = (const float*)(ws + WS_CTL + 1024); const float lam = lf[2 * l], omli = 1.f - lf[2 * l + 1];
    __syncthreads();
    for (int i = tid; i < 2048; i += NTHR) { const int map = i >> 10, qi = (i >> 6) & 15, p = i & 63; const int s = p >> 5, fq_ = (p >> 3) & 3, n_ = (p >> 2) & 1, j_ = p & 3;
        qs[(map * 16 + qi) * 64 + n_ * 32 + s * 16 + 4 * fq_ + j_] = bf2f(qb[(size_t)(MP + sb * 16 + qi) * 512 + h * 128 + map * 64 + p]); }
    float mrun = -1e30f, lrun = 0.f;
    const int qi = tid & 15, kj = tid >> 4, eg = tid >> 4;
    f32x4 acc0 = {0.f, 0.f, 0.f, 0.f}, acc1 = {0.f, 0.f, 0.f, 0.f};
    __syncthreads();
    for (int tile = 0; tile < 65; ++tile) {
        const int kidx = tile * 32 + kj;
        float s1 = -1e30f, s2 = -1e30f;
        if (kidx < 2064) { const float* kr = kidx < 2048 ? ck + (size_t)kidx * 512 : nk + (size_t)(kidx - 2048) * 512; s1 = 0.f; s2 = 0.f;
#pragma unroll 4
            for (int d = 0; d < 64; d += 4) { const f32x4 k1 = *(const f32x4*)(kr + d), k2 = *(const f32x4*)(kr + 64 + d); const LAS float* q1 = qs + qi * 64 + d; const LAS float* q2 = qs + (16 + qi) * 64 + d;
                s1 += q1[0] * k1[0] + q1[1] * k1[1] + q1[2] * k1[2] + q1[3] * k1[3]; s2 += q2[0] * k2[0] + q2[1] * k2[1] + q2[2] * k2[2] + q2[3] * k2[3]; } }
        sc[qi * 32 + kj] = s1; sc[(16 + qi) * 32 + kj] = s2;
        __syncthreads();
        if (tid < 32) { LAS float* r = sc + tid * 32; float mx = mrun;
#pragma unroll 8
            for (int j = 0; j < 32; ++j) mx = fmaxf(mx, r[j]);
            const float f = exp2f(mrun - mx); float su = 0.f;
#pragma unroll 8
            for (int j = 0; j < 32; ++j) { const float p = exp2f(r[j] - mx); r[j] = p; su += p; }
            lrun = lrun * f + su; mrun = mx; scl[tid] = f; }
        __syncthreads();
        { const float f0 = scl[qi], f1 = scl[16 + qi]; acc0 = acc0 * f0; acc1 = acc1 * f1;
            const int nk_ = tile < 64 ? 32 : 16;
            for (int j = 0; j < nk_; ++j) { const int kx = tile * 32 + j; const float* vr = (kx < 2048 ? cv + (size_t)kx * 512 : nv + (size_t)(kx - 2048) * 512) + eg * 4;
                const f32x4 v = *(const f32x4*)vr; acc0 = acc0 + v * sc[qi * 32 + j]; acc1 = acc1 + v * sc[(16 + qi) * 32 + j]; } }
        __syncthreads();
    }
    if (tid < 32) lsum[tid] = lrun;
    __syncthreads();
    const f32x4 o = acc0 * (1.f / lsum[qi]) - acc1 * (lam / lsum[16 + qi]);
    ssq[qi * 32 + eg] = (o[0] * o[0] + o[1] * o[1]) + (o[2] * o[2] + o[3] * o[3]);
    __syncthreads();
    float ss = 0.f;
#pragma unroll 8
    for (int j = 0; j < 32; ++j) ss += ssq[qi * 32 + j];
    const float rn = rsqrtf(ss * (1.f / 128.f) + 1e-6f) * omli; const float* bn = A->in[20] + l * 128 + eg * 4;
    v2u w; w.x = pk2(o[0] * rn * bn[0], o[1] * rn * bn[1]); w.y = pk2(o[2] * rn * bn[2], o[3] * rn * bn[3]);
    *(v2u*)(mix + (size_t)(MP + sb * 16 + qi) * 1024 + 256 + h * 128 + eg * 4) = w;
    __syncthreads();
}

#define PH_BEGIN \
        KArgs A = (KArgs)__builtin_amdgcn_kernarg_segment_ptr(); \
        int tid = wv * 64 + (int)__builtin_amdgcn_mbcnt_hi(~0u, __builtin_amdgcn_mbcnt_lo(~0u, 0u)); asm volatile("" : "+v"(tid)); tid &= 511; \
        const int bid = blockIdx.x, G = gridDim.x; \
        const int lane = tid & 63, wave = wv; \
        const int gw = bid * NWAVES + wave, NGW = G * NWAVES, gtid = bid * NTHR + tid, NT = G * NTHR; \
        unsigned char* ws = A->ws; float* rsb = (float*)(ws + WS_RS); unsigned char* wb = ws + WS_W; \
        (void)lane; (void)gw; (void)NGW; (void)gtid; (void)NT; (void)rsb; (void)wb;
#define IN(k) (lo <= (k) && (k) < hi)
__device__ __forceinline__ void grid_bar(unsigned* bar, unsigned target, bool leader) {
    asm volatile("s_waitcnt vmcnt(0) lgkmcnt(0)" ::: "memory");
    __syncthreads();
    if (leader) {
        __builtin_amdgcn_fence(__ATOMIC_RELEASE, "agent");
        asm volatile("s_waitcnt vmcnt(0)" ::: "memory");
        __hip_atomic_fetch_add(bar, 1u, __ATOMIC_RELAXED, __HIP_MEMORY_SCOPE_AGENT);
        unsigned spins = 0;
        while (__hip_atomic_load(bar, __ATOMIC_RELAXED, __HIP_MEMORY_SCOPE_AGENT) < target) { __builtin_amdgcn_s_sleep(2); if (++spins > (1u << 27)) break; }
        __builtin_amdgcn_fence(__ATOMIC_ACQUIRE, "agent");
        asm volatile("s_waitcnt vmcnt(0)" ::: "memory");
    }
    __syncthreads();
}
#define SEAM(k) do { if ((k) + 1 < hi) { ++nbar; grid_bar((unsigned*)(ws + WS_CTL + 4096), nbar * (unsigned)G, tid == 0); } } while (0)
#define SEAM_SKIP(k) do { } while (0)
__global__ void __launch_bounds__(NTHR, 2) hybrid_fwd(Args Aval) {
    extern __shared__ __attribute__((aligned(16))) unsigned char lds_raw[];
    LAS unsigned char* lds = (LAS unsigned char*)lds_raw;
    const int lo = Aval.ph_lo, hi = Aval.ph_hi; unsigned nbar = 0u;
    if (Aval.ph_lo < 0) cg::this_grid().sync();
    const int wv = __builtin_amdgcn_readfirstlane(threadIdx.x >> 6);
    if (IN(0)) { PH_BEGIN prologue(A, lds, gw, NGW, lane, wave, gtid, NT); SEAM(0); }
    { constexpr int l = 0;

        const int p0 = 1 + 11 * l;
        if (IN(p0 + 0)) { PH_BEGIN
            pg8::Gemm g{(const pg8::bf16_t*)slotp(ws, l, 0), (const pg8::bf16_t*)(wb + W_IN), MPAD, NIN, 1024};
            pg8::StaticOrder S; S.init(MPAD, NIN, G, bid);
            EpiG1 E{rsb + (size_t)(3 * l) * MPAD, (bfu*)slotp(ws, l, 2), (bfu*)slotp(ws, l, 4), (bfu*)slotp(ws, l, 5), (bfu*)slotp(ws, l, 6), (bfu*)slotp(ws, l, 7), (float*)(ws + WS_AB), (const float*)(ws + WS_ROPE),
                    A->out + O_BKP + (size_t)l * MP * 512, A->out + O_BVP + (size_t)l * MP * 512, A->out + O_BKS + (size_t)l * MS * 512, A->out + O_BVS + (size_t)l * MS * 512};
            pg8::gemm_phase<EpiG1, pg8::StaticOrder, true, true>((PG8_LAS unsigned char*)lds, g, S, E, wv);
            SEAM(p0 + 0); }
        if (IN(p0 + 1)) { PH_BEGIN
            prep_a(A, l, gw, NGW, lane); prep_c1(A, l, gw, NGW, lane);
            if (l == 1) conv_weights(A, 1, 2, lds, gw, NGW, lane, wave);
            SEAM(p0 + 1); }
        if (IN(p0 + 2)) { PH_BEGIN
            pg8::Gemm g{(const pg8::bf16_t*)slotp(ws, l, 12), (const pg8::bf16_t*)(wb + W_LR), MPAD, 768, 256};
            pg8::StaticOrder S; S.init(MPAD, 768, G, bid);
            EpiB<0> E{(bfu*)slotp(ws, l, 13), 768, nullptr};
            pg8::gemm_phase<EpiB<0>, pg8::StaticOrder, true, true>((PG8_LAS unsigned char*)lds, g, S, E, wv);
            SEAM(p0 + 2); }
        if (IN(p0 + 3)) { PH_BEGIN prep_c2(A, l, bid, G, tid); prep_a2(A, l, gw, NGW, lane);
            SEAM(p0 + 3); }
        if (IN(p0 + 4)) { PH_BEGIN
            if (bid < 64) { const int st = bid >> 1, half = bid & 1, b = st >> 2, h = st & 3;
                scan_rwkv(A, l, lds, h, half, b * 8192, 8192, 32, 5, b * 128, nullptr, A->out + O_CWP + (size_t)((l * 8 + b) * 4 + h) * 4096, tid);
                scan_rwkv(A, l, lds, h, half, MP + b * 16, 16, 16, 4, 1024 + b, A->in[7] + (size_t)((l * 8 + b) * 4 + h) * 4096, A->out + O_CWS + (size_t)((l * 8 + b) * 4 + h) * 4096, tid);
            } else if (bid < 128) { const int st = (bid - 64) >> 1, half = bid & 1, b = st >> 2, h = st & 3;
                scan_delta(A, l, lds, h, half, b * 8192, 8192, 32, 5, nullptr, A->out + O_ADP + (size_t)((l * 8 + b) * 4 + h) * 4096, tid);
                scan_delta(A, l, lds, h, half, MP + b * 16, 16, 16, 4, A->in[5] + (size_t)((l * 8 + b) * 4 + h) * 4096, A->out + O_ADS + (size_t)((l * 8 + b) * 4 + h) * 4096, tid);
            } else if (bid < 160) { sample_attn(A, l, lds, bid - 128, tid); }
            __syncthreads();
            unsigned* ctr = (unsigned*)(ws + WS_CTL) + 16 * l; volatile LAS unsigned* qw = (volatile LAS unsigned*)(lds + MISC_OFF);
            const attn_body::bf16* Q = (const attn_body::bf16*)slotp(ws, l, 4); const attn_body::bf16* K = (const attn_body::bf16*)slotp(ws, l, 5); const attn_body::bf16* V = (const attn_body::bf16*)slotp(ws, l, 6);
            attn_body::bf16* O = (attn_body::bf16*)slotp(ws, l, 13);
            for (;;) {
                if (tid == 0) qw[0] = atomicAdd(ctr, 1u);
                __syncthreads();
                const unsigned u = qw[0];
                __syncthreads();
                if (u >= 4096u) break;
                const int qb = 31 - (int)(u >> 7), bh = (int)(u & 127);
                attn_body::attn_unit<8>(bh >> 4, bh & 15, qb, Q, K, V, O, (char*)lds_raw, wv);
            }
            SEAM(p0 + 4); }
        if (IN(p0 + 5)) { PH_BEGIN
            post_attn(A, l, gw, NGW, lane); post_scan(A, l, gw, NGW, lane);
            conv_p(A, l, (bfu*)slotp(ws, l, 10), gtid, NT);
            if (l == 0) conv_weights(A, 1, 1, lds, gw, NGW, lane, wave);
            SEAM(p0 + 5); }
        if (IN(p0 + 6)) { PH_BEGIN
            pg8::Gemm g{(const pg8::bf16_t*)slotp(ws, l, 7), (const pg8::bf16_t*)(wb + W_OUT), MPAD, 1024, 1024};
            pg8::StaticOrder S; S.init(MPAD, 1024, G, bid);
            EpiH<2> E{A->out, (bfu*)slotp(ws, l, 0), rsb + (size_t)(3 * l + 1) * MPAD, nullptr, nullptr};
            pg8::gemm_phase<EpiH<2>, pg8::StaticOrder, true, true>((PG8_LAS unsigned char*)lds, g, S, E, wv);
            SEAM(p0 + 6); }
        if (IN(p0 + 7)) { PH_BEGIN
            pg8::Gemm g{(const pg8::bf16_t*)slotp(ws, l, 0), (const pg8::bf16_t*)(wb + W_FF1), MPAD, FFD, 1024};
            pg8::StaticOrder S; S.init(MPAD, FFD, G, bid);
            EpiB<1> E{(bfu*)slotp(ws, l, 2), FFD, rsb + (size_t)(3 * l + 1) * MPAD};
            pg8::gemm_phase<EpiB<1>, pg8::StaticOrder, true, true>((PG8_LAS unsigned char*)lds, g, S, E, wv);
            {
                pg8::Gemm g2{(const pg8::bf16_t*)slotp(ws, l, 10), (const pg8::bf16_t*)(wb + W_PP), MPAD, 1024, 256};
                pg8::StaticOrder S2; S2.init(MPAD, 1024, G, bid);
                EpiB<0> E2{(bfu*)slotp(ws, l, 11), 1024, nullptr};
                pg8::gemm_phase<EpiB<0>, pg8::StaticOrder, true, true>((PG8_LAS unsigned char*)lds, g2, S2, E2, wv); }
            SEAM(p0 + 7); }
        if (IN(p0 + 8)) { PH_BEGIN
            pg8::Gemm g{(const pg8::bf16_t*)slotp(ws, l, 2), (const pg8::bf16_t*)(wb + W_FF2), MPAD, 1024, FFD};
            pg8::StaticOrder S; S.init(MPAD, 1024, G, bid);
            EpiH<2> E{A->out, (bfu*)slotp(ws, l, 0), rsb + (size_t)(3 * l + 2) * MPAD, nullptr, nullptr};
            pg8::gemm_phase<EpiH<2>, pg8::StaticOrder, true, true>((PG8_LAS unsigned char*)lds, g, S, E, wv);
            SEAM(p0 + 8); }
        if (IN(p0 + 9)) { PH_BEGIN SEAM_SKIP(p0 + 9); }
        if (IN(p0 + 10)) { PH_BEGIN
            pg8::Gemm g{(const pg8::bf16_t*)slotp(ws, l, 0), (const pg8::bf16_t*)(wb + W_GATE), MPAD, 1024, 1024};
            pg8::StaticOrder S; S.init(MPAD, 1024, G, bid);
            EpiH<3> E{A->out, (bfu*)slotp(ws, l, 13), rsb + (size_t)(3 * l + 3) * MPAD, rsb + (size_t)(3 * l + 2) * MPAD, (const bfu*)slotp(ws, l, 11)};
            pg8::gemm_phase<EpiH<3>, pg8::StaticOrder, true, true>((PG8_LAS unsigned char*)lds, g, S, E, wv);
            SEAM(p0 + 10); }
        }
    { constexpr int l = 1;

        const int p0 = 1 + 11 * l;
        if (IN(p0 + 0)) { PH_BEGIN
            pg8::Gemm g{(const pg8::bf16_t*)slotp(ws, l, 0), (const pg8::bf16_t*)(wb + W_IN), MPAD, NIN, 1024};
            pg8::StaticOrder S; S.init(MPAD, NIN, G, bid);
            EpiG1 E{rsb + (size_t)(3 * l) * MPAD, (bfu*)slotp(ws, l, 2), (bfu*)slotp(ws, l, 4), (bfu*)slotp(ws, l, 5), (bfu*)slotp(ws, l, 6), (bfu*)slotp(ws, l, 7), (float*)(ws + WS_AB), (const float*)(ws + WS_ROPE),
                    A->out + O_BKP + (size_t)l * MP * 512, A->out + O_BVP + (size_t)l * MP * 512, A->out + O_BKS + (size_t)l * MS * 512, A->out + O_BVS + (size_t)l * MS * 512};
            pg8::gemm_phase<EpiG1, pg8::StaticOrder, true, true>((PG8_LAS unsigned char*)lds, g, S, E, wv);
            SEAM(p0 + 0); }
        if (IN(p0 + 1)) { PH_BEGIN
            prep_a(A, l, gw, NGW, lane); prep_c1(A, l, gw, NGW, lane);
            if (l == 1) conv_weights(A, 1, 2, lds, gw, NGW, lane, wave);
            SEAM(p0 + 1); }
        if (IN(p0 + 2)) { PH_BEGIN
            pg8::Gemm g{(const pg8::bf16_t*)slotp(ws, l, 12), (const pg8::bf16_t*)(wb + W_LR), MPAD, 768, 256};
            pg8::StaticOrder S; S.init(MPAD, 768, G, bid);
            EpiB<0> E{(bfu*)slotp(ws, l, 13), 768, nullptr};
            pg8::gemm_phase<EpiB<0>, pg8::StaticOrder, true, true>((PG8_LAS unsigned char*)lds, g, S, E, wv);
            SEAM(p0 + 2); }
        if (IN(p0 + 3)) { PH_BEGIN prep_c2(A, l, bid, G, tid); prep_a2(A, l, gw, NGW, lane);
            SEAM(p0 + 3); }
        if (IN(p0 + 4)) { PH_BEGIN
            if (bid < 64) { const int st = bid >> 1, half = bid & 1, b = st >> 2, h = st & 3;
                scan_rwkv(A, l, lds, h, half, b * 8192, 8192, 32, 5, b * 128, nullptr, A->out + O_CWP + (size_t)((l * 8 + b) * 4 + h) * 4096, tid);
                scan_rwkv(A, l, lds, h, half, MP + b * 16, 16, 16, 4, 1024 + b, A->in[7] + (size_t)((l * 8 + b) * 4 + h) * 4096, A->out + O_CWS + (size_t)((l * 8 + b) * 4 + h) * 4096, tid);
            } else if (bid < 128) { const int st = (bid - 64) >> 1, half = bid & 1, b = st >> 2, h = st & 3;
                scan_delta(A, l, lds, h, half, b * 8192, 8192, 32, 5, nullptr, A->out + O_ADP + (size_t)((l * 8 + b) * 4 + h) * 4096, tid);
                scan_delta(A, l, lds, h, half, MP + b * 16, 16, 16, 4, A->in[5] + (size_t)((l * 8 + b) * 4 + h) * 4096, A->out + O_ADS + (size_t)((l * 8 + b) * 4 + h) * 4096, tid);
            } else if (bid < 160) { sample_attn(A, l, lds, bid - 128, tid); }
            __syncthreads();
            unsigned* ctr = (unsigned*)(ws + WS_CTL) + 16 * l; volatile LAS unsigned* qw = (volatile LAS unsigned*)(lds + MISC_OFF);
            const attn_body::bf16* Q = (const attn_body::bf16*)slotp(ws, l, 4); const attn_body::bf16* K = (const attn_body::bf16*)slotp(ws, l, 5); const attn_body::bf16* V = (const attn_body::bf16*)slotp(ws, l, 6);
            attn_body::bf16* O = (attn_body::bf16*)slotp(ws, l, 13);
            for (;;) {
                if (tid == 0) qw[0] = atomicAdd(ctr, 1u);
                __syncthreads();
                const unsigned u = qw[0];
                __syncthreads();
                if (u >= 4096u) break;
                const int qb = 31 - (int)(u >> 7), bh = (int)(u & 127);
                attn_body::attn_unit<8>(bh >> 4, bh & 15, qb, Q, K, V, O, (char*)lds_raw, wv);
            }
            SEAM(p0 + 4); }
        if (IN(p0 + 5)) { PH_BEGIN
            post_attn(A, l, gw, NGW, lane); post_scan(A, l, gw, NGW, lane);
            conv_p(A, l, (bfu*)slotp(ws, l, 10), gtid, NT);
            if (l == 0) conv_weights(A, 1, 1, lds, gw, NGW, lane, wave);
            SEAM(p0 + 5); }
        if (IN(p0 + 6)) { PH_BEGIN
            pg8::Gemm g{(const pg8::bf16_t*)slotp(ws, l, 7), (const pg8::bf16_t*)(wb + W_OUT), MPAD, 1024, 1024};
            pg8::StaticOrder S; S.init(MPAD, 1024, G, bid);
            EpiH<2> E{A->out, (bfu*)slotp(ws, l, 0), rsb + (size_t)(3 * l + 1) * MPAD, nullptr, nullptr};
            pg8::gemm_phase<EpiH<2>, pg8::StaticOrder, true, true>((PG8_LAS unsigned char*)lds, g, S, E, wv);
            SEAM(p0 + 6); }
        if (IN(p0 + 7)) { PH_BEGIN
            pg8::Gemm g{(const pg8::bf16_t*)slotp(ws, l, 0), (const pg8::bf16_t*)(wb + W_FF1), MPAD, FFD, 1024};
            pg8::StaticOrder S; S.init(MPAD, FFD, G, bid);
            EpiB<1> E{(bfu*)slotp(ws, l, 2), FFD, rsb + (size_t)(3 * l + 1) * MPAD};
            pg8::gemm_phase<EpiB<1>, pg8::StaticOrder, true, true>((PG8_LAS unsigned char*)lds, g, S, E, wv);
            {
                pg8::Gemm g2{(const pg8::bf16_t*)slotp(ws, l, 10), (const pg8::bf16_t*)(wb + W_PP), MPAD, 1024, 256};
                pg8::StaticOrder S2; S2.init(MPAD, 1024, G, bid);
                EpiB<0> E2{(bfu*)slotp(ws, l, 11), 1024, nullptr};
                pg8::gemm_phase<EpiB<0>, pg8::StaticOrder, true, true>((PG8_LAS unsigned char*)lds, g2, S2, E2, wv); }
            SEAM(p0 + 7); }
        if (IN(p0 + 8)) { PH_BEGIN
            pg8::Gemm g{(const pg8::bf16_t*)slotp(ws, l, 2), (const pg8::bf16_t*)(wb + W_FF2), MPAD, 1024, FFD};
            pg8::StaticOrder S; S.init(MPAD, 1024, G, bid);
            EpiH<2> E{A->out, (bfu*)slotp(ws, l, 0), rsb + (size_t)(3 * l + 2) * MPAD, nullptr, nullptr};
            pg8::gemm_phase<EpiH<2>, pg8::StaticOrder, true, true>((PG8_LAS unsigned char*)lds, g, S, E, wv);
            SEAM(p0 + 8); }
        if (IN(p0 + 9)) { PH_BEGIN SEAM_SKIP(p0 + 9); }
        if (IN(p0 + 10)) { PH_BEGIN
            pg8::Gemm g{(const pg8::bf16_t*)slotp(ws, l, 0), (const pg8::bf16_t*)(wb + W_GATE), MPAD, 1024, 1024};
            pg8::StaticOrder S; S.init(MPAD, 1024, G, bid);
            EpiH<3> E{A->out, (bfu*)slotp(ws, l, 13), rsb + (size_t)(3 * l + 3) * MPAD, rsb + (size_t)(3 * l + 2) * MPAD, (const bfu*)slotp(ws, l, 11)};
            pg8::gemm_phase<EpiH<3>, pg8::StaticOrder, true, true>((PG8_LAS unsigned char*)lds, g, S, E, wv);
            SEAM(p0 + 10); }
        }
    if (IN(NPHASE - 1)) { PH_BEGIN final_norm(A, gw, NGW, lane); }
}
#undef PH_BEGIN
#undef IN
#undef SEAM

extern "C" void kernel_launch(void* const* d_in, const int* in_sizes, int n_in, void* d_out, int out_size, void* d_ws, size_t ws_size, hipStream_t stream) {
    static int grid = 0;
    if (grid == 0) {
        if (n_in != 40 || (size_t)out_size != O_END || ws_size < WS_TOTAL) { fprintf(stderr, "kernel_launch: unexpected shapes (n_in %d out %d ws %zu)\n", n_in, out_size, ws_size); grid = -1; return; }
        int dev = 0, cus = 0, per_cu = 0;
        if (hipGetDevice(&dev) != hipSuccess || hipDeviceGetAttribute(&cus, hipDeviceAttributeMultiprocessorCount, dev) != hipSuccess) { grid = -1; return; }
        if (hipFuncSetAttribute((const void*)hybrid_fwd, hipFuncAttributeMaxDynamicSharedMemorySize, LDS_BYTES) != hipSuccess) { fprintf(stderr, "kernel_launch: hipFuncSetAttribute failed\n"); grid = -1; return; }
        if (hipOccupancyMaxActiveBlocksPerMultiprocessor(&per_cu, (const void*)hybrid_fwd, NTHR, LDS_BYTES) != hipSuccess || per_cu < 1) { fprintf(stderr, "kernel_launch: occupancy query says %d\n", per_cu); per_cu = 1; }
        (void)hipGetLastError();
        grid = cus;
    }
    if (grid < 0) return;
    if (hipMemsetAsync((char*)d_ws + WS_CTL, 0, 64 * 1024, stream) != hipSuccess) { fprintf(stderr, "kernel_launch: memset failed\n"); return; }
    Args a{};
    for (int i = 0; i < 40; ++i) a.in[i] = (const float*)d_in[i];
    a.out = (float*)d_out; a.ws = (unsigned char*)d_ws;
#if MK_ONE_LAUNCH
    a.ph_lo = 0; a.ph_hi = NPHASE;
    void* args[] = {&a};
    hipError_t e = hipLaunchCooperativeKernel((const void*)hybrid_fwd, dim3(grid), dim3(NTHR), args, LDS_BYTES, stream);
    if (e != hipSuccess) fprintf(stderr, "kernel_launch: cooperative launch failed: %s (grid %d)\n", hipGetErrorString(e), grid);
#else
    for (int ph = 0; ph < NPHASE; ++ph) { a.ph_lo = ph; a.ph_hi = ph + 1; hipLaunchKernelGGL(hybrid_fwd, dim3(grid), dim3(NTHR), LDS_BYTES, stream, a); }
#endif
}
```

```cpp
#include <hip/hip_runtime.h>
#include <hip/hip_cooperative_groups.h>
#include <cstdio>
#include <cstdint>
namespace cg = cooperative_groups;
namespace pg8 {
#define PG8_LAS __attribute__((address_space(3)))
typedef unsigned short bf16_t;
typedef short bf16x8 __attribute__((ext_vector_type(8)));
typedef float f32x4 __attribute__((ext_vector_type(4)));
typedef unsigned u32x4 __attribute__((ext_vector_type(4)));
constexpr int BM = 256, BK = 64, HALF = 128, HTB = HALF * BK * 2  , STAGE_BYTES = 8 * HTB, NXCD = 8, WGM = 8;

__host__ __device__ __forceinline__ int lds_byte(int r, int c) { const int st = (r >> 4) * 2 + (c >> 5), rr = r & 15, cc = c & 31, ob = rr * 64 + cc * 2; return st * 1024 + (ob ^ (((ob >> 9) & 1) << 5)); }
__host__ __device__ __forceinline__ void stage_rc(int b, int& R, int& C) { const int st = b / 1024, sb = b % 1024, swz = sb ^ (((sb >> 9) & 1) << 5); R = (st >> 1) * 16 + swz / 64; C = (st & 1) * 32 + (swz % 64) / 2; }
__host__ __device__ __forceinline__ int perm32(int rho) { const int n = rho >> 4, i = rho & 15; return 8 * (i >> 2) + 4 * n + (i & 3); }

struct Unit { int pm, pn; };
struct Gemm { const bf16_t* A; const bf16_t* Bt; int M, N, K; };

struct StaticOrder {
    int nM, nN, nwg, G, c;
    __host__ __device__ void init(int M, int N, int G_, int c_) { nM = M / BM; nN = N / BM; nwg = nM * nN; G = G_; c = c_; }
    __host__ __device__ bool next(int i, Unit& u) const {
        const long L = (long)i * G + c; if (L >= nwg) return false;
        int wgid = (int)L; { const int q = nwg / NXCD, r = nwg % NXCD, xcd = wgid % NXCD, off = wgid / NXCD; wgid = (xcd < r ? xcd * (q + 1) : r * (q + 1) + (xcd - r) * q) + off; }
        const int nig = WGM * nN, gid = wgid / nig, fm = gid * WGM, gsz = (nM - fm) < WGM ? (nM - fm) : WGM;
        u.pm = fm + ((wgid % nig) % gsz); u.pn = (wgid % nig) / gsz; return true;
    }
    __device__ __forceinline__ void a_ready(const Unit&) const {}
    __device__ __forceinline__ void done(const Unit&) const {}
};

__device__ __forceinline__ unsigned cvt_pk_bf16(float lo, float hi) { unsigned r; asm volatile("v_cvt_pk_bf16_f32 %0, %1, %2" : "=v"(r) : "v"(lo), "v"(hi)); return r; }
typedef float f32x2 __attribute__((ext_vector_type(2)));
__device__ __forceinline__ f32x2 gelu_pk(f32x2 v) {
    const f32x2 av = __builtin_elementwise_abs(v), d = av * 0.2316418882f + 1.0f;
    f32x2 t; t.x = __builtin_amdgcn_rcpf(d.x); t.y = __builtin_amdgcn_rcpf(d.y);
    f32x2 q = t * 0.5307027145f + (-0.7265760135f); q = q * t + 0.7107068705f; q = q * t + (-0.142248368f); q = q * t + 0.127414796f; q = q * t;
    const f32x2 s = (v * v) * (-0.72134752044f);
    f32x2 e; e.x = __builtin_amdgcn_exp2f(s.x); e.y = __builtin_amdgcn_exp2f(s.y);
    const f32x2 m = v * (q * e), r = v - m;
    f32x2 o; o.x = v.x < 0.f ? m.x : r.x; o.y = v.y < 0.f ? m.y : r.y; return o;
}

template <int ACT  > struct EpiBf16 {
    static constexpr bool PERM = true, AFTER_DRAIN = false; static_assert(ACT == 0 || ACT == 1, "EpiBf16: ACT is 0 (none) or 1 (gelu_pk)");
    bf16_t* O; int ldc; const float* bias; int split_cols; size_t split_stride; float scale0;
    __device__ __forceinline__ void operator()(const f32x4 (&acc)[2][2][4][2], const Unit& u, int wr, int wc, int fr, int fq) const {
        const int row0 = u.pm * BM + wr * 64 + fr; int colt = u.pn * BM; bf16_t* base = O;
        float sc = 1.f; if (split_cols) { const int t = colt / split_cols; base += (size_t)t * split_stride; colt -= t * split_cols; if (t == 0) sc = scale0; }
        const int col0 = colt + wc * 32 + 8 * fq, bcol0 = u.pn * BM + wc * 32 + 8 * fq;
        f32x4 bv[2][2];
#pragma unroll
        for (int bj = 0; bj < 2; ++bj)
#pragma unroll
            for (int n = 0; n < 2; ++n) bv[bj][n] = bias ? *(const f32x4*)(bias + bcol0 + bj * HALF + 4 * n) : (f32x4){0.f, 0.f, 0.f, 0.f};
#pragma unroll
        for (int ai = 0; ai < 2; ++ai)
#pragma unroll
            for (int m = 0; m < 4; ++m) { bf16_t* rowp = base + (size_t)(row0 + ai * HALF + m * 16) * ldc + col0;
#pragma unroll
                for (int bj = 0; bj < 2; ++bj) { f32x4 v0 = acc[ai][bj][m][0] + bv[bj][0], v1 = acc[ai][bj][m][1] + bv[bj][1];
                    if (ACT == 1) { f32x2 a = gelu_pk((f32x2){v0[0], v0[1]}), b = gelu_pk((f32x2){v0[2], v0[3]}), c = gelu_pk((f32x2){v1[0], v1[1]}), d = gelu_pk((f32x2){v1[2], v1[3]});
                        v0 = (f32x4){a.x, a.y, b.x, b.y}; v1 = (f32x4){c.x, c.y, d.x, d.y}; }
                    v0 = v0 * sc; v1 = v1 * sc; u32x4 w; w.x = cvt_pk_bf16(v0[0], v0[1]); w.y = cvt_pk_bf16(v0[2], v0[3]); w.z = cvt_pk_bf16(v1[0], v1[1]); w.w = cvt_pk_bf16(v1[2], v1[3]);
                    *(u32x4*)(rowp + bj * HALF) = w; } }
    }
};

struct PanelStats {
    unsigned* xbuf;
    unsigned* cnt;
    unsigned* tmo;
    int ntn; float eps;
    unsigned code;
    __device__ __forceinline__ bool run(const f32x4 (&v)[2][2][4][2], const Unit& u, int wr, int wc, int fr, int fq, PG8_LAS unsigned char* lds, int wid, int lane) const {
        typedef float f32x2v __attribute__((ext_vector_type(2)));
        PG8_LAS f32x2v* P = (PG8_LAS f32x2v*)lds;
        PG8_LAS f32x2v* S = (PG8_LAS f32x2v*)(lds + 8192);
        PG8_LAS unsigned* flag = (PG8_LAS unsigned*)(lds + 8192 + 2048);
#pragma unroll
        for (int ai = 0; ai < 2; ++ai)
#pragma unroll
            for (int m = 0; m < 4; ++m) {
                float s = 0.f;
#pragma unroll
                for (int bj = 0; bj < 2; ++bj)
#pragma unroll
                    for (int n = 0; n < 2; ++n) { const f32x4 x = v[ai][bj][m][n]; s += (x[0] + x[1]) + (x[2] + x[3]); }
                s += __shfl_xor(s, 16); s += __shfl_xor(s, 32);
                const float mw = s * (1.0f / 64.0f); float q = 0.f;
#pragma unroll
                for (int bj = 0; bj < 2; ++bj)
#pragma unroll
                    for (int n = 0; n < 2; ++n) { const f32x4 d = v[ai][bj][m][n] - mw; q += (d[0] * d[0] + d[1] * d[1]) + (d[2] * d[2] + d[3] * d[3]); }
                q += __shfl_xor(q, 16); q += __shfl_xor(q, 32);
                if (fq == 0) P[(ai * HALF + wr * 64 + m * 16 + fr) * 4 + wc] = (f32x2v){mw, q};
            }
        asm volatile("s_waitcnt lgkmcnt(0)" ::: "memory"); __builtin_amdgcn_s_barrier(); asm volatile("" ::: "memory");
#if defined(BROKEN_EXCHANGE_NO_WAIT)
#warning BROKEN CONTROL BUILD: the row-statistics exchange does not wait; results are wrong by design
        if (blockIdx.x >= 64) { const long long t0_ = clock64(); while (clock64() - t0_ < 60000) __builtin_amdgcn_s_sleep(8); }
#endif
        const int row = wid * 32 + (lane & 31);
        if (lane < 32) {
            const f32x2v a = P[row * 4 + 0], b = P[row * 4 + 1], c = P[row * 4 + 2], d = P[row * 4 + 3];
            const float mt = (a.x + b.x + c.x + d.x) * 0.25f;
            const float da = a.x - mt, db = b.x - mt, dc = c.x - mt, dd = d.x - mt;
            const float m2 = (a.y + b.y) + (c.y + d.y) + 64.0f * ((da * da + db * db) + (dc * dc + dd * dd));
            unsigned long long* slot = (unsigned long long*)xbuf + ((size_t)(u.pm * BM + row) * 4 + u.pn);
            __hip_atomic_store(slot, ((unsigned long long)__float_as_uint(m2) << 32) | __float_as_uint(mt), __ATOMIC_RELAXED, __HIP_MEMORY_SCOPE_AGENT);
        }
        asm volatile("s_waitcnt vmcnt(0)" ::: "memory");
        if (lane == 0) __hip_atomic_fetch_add(cnt + 64 * u.pm, 1u, __ATOMIC_RELAXED, __HIP_MEMORY_SCOPE_AGENT);
        if (wid == 0) {
            bool dead = false; const unsigned long long t0 = __builtin_amdgcn_s_memrealtime(); const unsigned want = 8u * (unsigned)ntn;
            for (;;) {
#if defined(BROKEN_EXCHANGE_NO_WAIT)
                break;
#endif
                if ((unsigned)__builtin_amdgcn_readfirstlane(__hip_atomic_load(cnt + 64 * u.pm, __ATOMIC_RELAXED, __HIP_MEMORY_SCOPE_AGENT)) >= want) break;
                if (__builtin_amdgcn_s_memrealtime() - t0 > 2000000ull) {
                    if (lane == 0) { unsigned expect = 0u; __hip_atomic_compare_exchange_strong(tmo + 1, &expect, code | (unsigned)(u.pm & 0xff), __ATOMIC_RELAXED, __ATOMIC_RELAXED, __HIP_MEMORY_SCOPE_AGENT);
                                     __hip_atomic_store(tmo, 1u, __ATOMIC_RELAXED, __HIP_MEMORY_SCOPE_AGENT); }
                    dead = true; break; }
                __builtin_amdgcn_s_sleep(2);
            }
            __builtin_amdgcn_fence(__ATOMIC_ACQUIRE, "agent");
            if (lane == 0) flag[0] = dead ? 1u : 0u;
        }
        asm volatile("s_waitcnt vmcnt(0) lgkmcnt(0)" ::: "memory"); __builtin_amdgcn_s_barrier(); asm volatile("" ::: "memory");
        const bool bad = flag[0] != 0u;
        if (lane < 32) {
            const unsigned long long* slot = (const unsigned long long*)xbuf + (size_t)(u.pm * BM + row) * 4; float mt[4], m2[4]; float ms = 0.f;
#pragma unroll
            for (int t = 0; t < 4; ++t) { if (t < ntn) { const unsigned long long w = __hip_atomic_load(slot + t, __ATOMIC_RELAXED, __HIP_MEMORY_SCOPE_AGENT); mt[t] = __uint_as_float((unsigned)w); m2[t] = __uint_as_float((unsigned)(w >> 32)); } else { mt[t] = 0.f; m2[t] = 0.f; } ms += mt[t]; }
            const float mean = ms / (float)ntn; float q = 0.f;
#pragma unroll
            for (int t = 0; t < 4; ++t) if (t < ntn) { const float dm = mt[t] - mean; q += m2[t] + 256.0f * dm * dm; }
            S[row] = (f32x2v){mean, 1.0f / sqrtf(q / (256.0f * (float)ntn) + eps)};
        }
        asm volatile("s_waitcnt lgkmcnt(0)" ::: "memory"); __builtin_amdgcn_s_barrier(); asm volatile("" ::: "memory");
        return bad;
    }
};
struct EpiLnRes {
    static constexpr bool PERM = false, AFTER_DRAIN = true;
    const float* base; float* out; int ldc; const float* bias; PanelStats st; unsigned poison;
    __device__ __forceinline__ void fused(f32x4 (&acc)[2][2][4][2], const Unit& u, int wr, int wc, int fr, int fq, PG8_LAS unsigned char* lds, int wid, int lane) const {
        typedef float f32x2v __attribute__((ext_vector_type(2)));
        const PG8_LAS f32x2v* S = (const PG8_LAS f32x2v*)(lds + 8192);
        const int col0 = u.pn * BM + wc * 32 + 4 * fq;
#pragma unroll
        for (int bj = 0; bj < 2; ++bj)
#pragma unroll
            for (int n = 0; n < 2; ++n) { const f32x4 bv = bias ? *(const f32x4*)(bias + col0 + bj * HALF + n * 16) : (f32x4){0.f, 0.f, 0.f, 0.f};
#pragma unroll
                for (int ai = 0; ai < 2; ++ai)
#pragma unroll
                    for (int m = 0; m < 4; ++m) acc[ai][bj][m][n] += bv; }
        f32x4 pre[4][2][2];
#pragma unroll
        for (int m = 0; m < 4; ++m) { const size_t off = (size_t)(u.pm * BM + wr * 64 + m * 16 + fr) * ldc + col0;
#pragma unroll
            for (int bj = 0; bj < 2; ++bj)
#pragma unroll
                for (int n = 0; n < 2; ++n) pre[m][bj][n] = *(const f32x4*)(base + off + bj * HALF + n * 16); }
        const bool bad = st.run(acc, u, wr, wc, fr, fq, lds, wid, lane) || poison != 0u;
        const float qnan = __builtin_nanf("");
#pragma unroll
        for (int ai = 0; ai < 2; ++ai)
#pragma unroll
            for (int m = 0; m < 4; ++m) { const int r = ai * HALF + wr * 64 + m * 16 + fr; const f32x2v sr = S[r]; const size_t off = (size_t)(u.pm * BM + r) * ldc + col0;
#pragma unroll
                for (int bj = 0; bj < 2; ++bj)
#pragma unroll
                    for (int n = 0; n < 2; ++n) { const f32x4 bs = ai == 0 ? pre[m][bj][n] : *(const f32x4*)(base + off + bj * HALF + n * 16); f32x4 o = bs + (acc[ai][bj][m][n] - sr.x) * sr.y;
                        if (bad) o = (f32x4){qnan, qnan, qnan, qnan}; *(f32x4*)(out + off + bj * HALF + n * 16) = o; }
                if (m & 1) asm volatile("" ::: "memory"); }
    }
};
struct EpiLnResLn {
    static constexpr bool PERM = false, AFTER_DRAIN = true;
    const float* base; float* out; bf16_t* xn; int ldc; const float* bias; PanelStats st1, st2; unsigned poison;
    __device__ __forceinline__ void fused(f32x4 (&acc)[2][2][4][2], const Unit& u, int wr, int wc, int fr, int fq, PG8_LAS unsigned char* lds, int wid, int lane) const {
        typedef float f32x2v __attribute__((ext_vector_type(2))); typedef unsigned u32x2v __attribute__((ext_vector_type(2)));
        const PG8_LAS f32x2v* S = (const PG8_LAS f32x2v*)(lds + 8192);
        const int col0 = u.pn * BM + wc * 32 + 4 * fq;
#pragma unroll
        for (int bj = 0; bj < 2; ++bj)
#pragma unroll
            for (int n = 0; n < 2; ++n) { const f32x4 bv = bias ? *(const f32x4*)(bias + col0 + bj * HALF + n * 16) : (f32x4){0.f, 0.f, 0.f, 0.f};
#pragma unroll
                for (int ai = 0; ai < 2; ++ai)
#pragma unroll
                    for (int m = 0; m < 4; ++m) acc[ai][bj][m][n] += bv; }
        bool bad = st1.run(acc, u, wr, wc, fr, fq, lds, wid, lane) || poison != 0u;
        const float qnan = __builtin_nanf("");
#pragma unroll
        for (int ai = 0; ai < 2; ++ai)
#pragma unroll
            for (int m = 0; m < 4; ++m) { const int r = ai * HALF + wr * 64 + m * 16 + fr; const f32x2v sr = S[r]; const size_t off = (size_t)(u.pm * BM + r) * ldc + col0;
#pragma unroll
                for (int bj = 0; bj < 2; ++bj)
#pragma unroll
                    for (int n = 0; n < 2; ++n) { const f32x4 bs = *(const f32x4*)(base + off + bj * HALF + n * 16); acc[ai][bj][m][n] = bs + (acc[ai][bj][m][n] - sr.x) * sr.y; }
                asm volatile("" : "+v"(acc[ai][0][m][0]), "+v"(acc[ai][0][m][1]), "+v"(acc[ai][1][m][0]), "+v"(acc[ai][1][m][1]));
                if (m & 1) asm volatile("" ::: "memory"); }
        const bool bad1 = bad;
        bad = st2.run(acc, u, wr, wc, fr, fq, lds, wid, lane) || bad;
#pragma unroll
        for (int ai = 0; ai < 2; ++ai)
#pragma unroll
            for (int m = 0; m < 4; ++m) { const int r = ai * HALF + wr * 64 + m * 16 + fr; const f32x2v sr = S[r]; const size_t off = (size_t)(u.pm * BM + r) * ldc + col0;
#pragma unroll
                for (int bj = 0; bj < 2; ++bj)
#pragma unroll
                    for (int n = 0; n < 2; ++n) { const f32x4 x1 = acc[ai][bj][m][n]; *(f32x4*)(out + off + bj * HALF + n * 16) = bad1 ? (f32x4){qnan, qnan, qnan, qnan} : x1;
                        const f32x4 o = (x1 - sr.x) * sr.y; u32x2v w; w.x = cvt_pk_bf16(o[0], o[1]); w.y = cvt_pk_bf16(o[2], o[3]);
                        if (bad) { w.x = 0x7fc07fc0u; w.y = 0x7fc07fc0u; } *(u32x2v*)(xn + off + bj * HALF + n * 16) = w; }
                asm volatile("" ::: "memory"); }
    }
};

template <class Epi, class Sched, bool ALIGN_EPI = false, bool SP2 = false>
__device__ __forceinline__ void gemm_phase(PG8_LAS unsigned char* lds, const Gemm g, const Sched& S, const Epi& E, const int wv_) {
    int tid_o = wv_ * 64 + (int)__builtin_amdgcn_mbcnt_hi(~0u, __builtin_amdgcn_mbcnt_lo(~0u, 0u)); asm volatile("" : "+v"(tid_o)); tid_o &= 511;
    const int tid = tid_o, wid = __builtin_amdgcn_readfirstlane(tid >> 6), lane = tid & 63, wr = wid >> 2, wc = wid & 3, fr = lane & 15, fq = lane >> 4;
    const int K = g.K, nt = K / BK;
    unsigned voffA[2], voffB[2];
#pragma unroll
    for (int i = 0; i < 2; ++i) { int R, C; stage_rc(tid * 16 + i * 8192, R, C); const int Rb = Epi::PERM ? ((R & ~31) + perm32(R & 31)) : R;
        voffA[i] = (unsigned)(R * K + C) * 2u; voffB[i] = (unsigned)(Rb * K + C) * 2u; }
    const size_t kstep = (size_t)(BK * 2);
    const size_t hstep = (size_t)HALF * K * 2;
    const size_t tstep = 2 * hstep;
    const unsigned ldsw = (unsigned)wid * 1024u;
    const int aoff = lds_byte(wr * 64 + fr, fq * 8), boff = lds_byte(wc * 32 + fr, fq * 8);
#define PG8_SA(b, h) (((b) * 2 + (h)) * HTB)
#define PG8_SB(b, h) ((4 + (b) * 2 + (h)) * HTB)
#define PG8_STAGE(bufoff, gbase, voff) do { _Pragma("unroll") for (int _i = 0; _i < 2; ++_i) \
        __builtin_amdgcn_global_load_lds((const unsigned*)((const char*)(gbase) + (voff)[_i]), (PG8_LAS unsigned*)(lds + (bufoff) + ldsw + _i * 8192), 16, 0, 0); } while (0)
#define PG8_LDA(dst, b, h) do { _Pragma("unroll") for (int m = 0; m < 4; ++m) _Pragma("unroll") for (int k = 0; k < 2; ++k) dst[m][k] = *(const PG8_LAS bf16x8*)(lds + PG8_SA(b, h) + aoff + m * 2048 + k * 1024); } while (0)
#define PG8_LDB(dst, b, h) do { _Pragma("unroll") for (int n = 0; n < 2; ++n) _Pragma("unroll") for (int k = 0; k < 2; ++k) dst[n][k] = *(const PG8_LAS bf16x8*)(lds + PG8_SB(b, h) + boff + n * 2048 + k * 1024); } while (0)
#define PG8_MMA(ai, bj, At, Bt) do { __builtin_amdgcn_s_setprio(1); _Pragma("unroll") for (int m = 0; m < 4; ++m) _Pragma("unroll") for (int n = 0; n < 2; ++n) _Pragma("unroll") for (int k = 0; k < 2; ++k) \
        acc[ai][bj][m][n] = __builtin_amdgcn_mfma_f32_16x16x32_bf16(Bt[n][k], At[m][k], acc[ai][bj][m][n], 0, 0, 0); __builtin_amdgcn_s_setprio(0); } while (0)
#define PG8_WAIT_V(n) asm volatile("s_waitcnt vmcnt(" #n ")" ::: "memory")
#define PG8_WAIT_L(n) asm volatile("s_waitcnt lgkmcnt(" #n ")" ::: "memory")
#define PG8_BAR __builtin_amdgcn_s_barrier()
#define PG8_SCHED __builtin_amdgcn_sched_barrier(0)
    Unit cur, nxt; int ui = 0;
    if (!S.next(0, cur)) return;
    f32x4 acc[2][2][4][2];
#pragma unroll
    for (int a = 0; a < 2; ++a)
#pragma unroll
        for (int b = 0; b < 2; ++b)
#pragma unroll
            for (int m = 0; m < 4; ++m)
#pragma unroll
                for (int n = 0; n < 2; ++n) acc[a][b][m][n] = (f32x4){0.f, 0.f, 0.f, 0.f};
    bf16x8 At[4][2], B0[2][2], B1[2][2];
    const char* cA = (const char*)g.A + (size_t)cur.pm * tstep; const char* cB = (const char*)g.Bt + (size_t)cur.pn * tstep;
    S.a_ready(cur);
    if constexpr (SP2) {
        PG8_STAGE(PG8_SB(0, 0), cB, voffB); PG8_STAGE(PG8_SB(0, 1), cB + hstep, voffB); PG8_STAGE(PG8_SA(0, 0), cA, voffA); PG8_STAGE(PG8_SA(0, 1), cA + hstep, voffA);
        if (wr == 1) PG8_BAR;
        PG8_WAIT_V(2); PG8_BAR;
        PG8_STAGE(PG8_SB(1, 0), cB + kstep, voffB); PG8_STAGE(PG8_SA(1, 0), cA + kstep, voffA); PG8_STAGE(PG8_SB(1, 1), cB + hstep + kstep, voffB);
        PG8_WAIT_V(6); PG8_BAR;
    } else {
        PG8_STAGE(PG8_SB(0, 0), cB, voffB); PG8_STAGE(PG8_SA(0, 0), cA, voffA); PG8_STAGE(PG8_SB(0, 1), cB + hstep, voffB); PG8_STAGE(PG8_SA(0, 1), cA + hstep, voffA);
        if (wr == 1) PG8_BAR;
        PG8_WAIT_V(4); PG8_BAR;
        PG8_STAGE(PG8_SB(1, 0), cB + kstep, voffB); PG8_STAGE(PG8_SA(1, 0), cA + kstep, voffA); PG8_STAGE(PG8_SB(1, 1), cB + hstep + kstep, voffB);
        PG8_WAIT_V(6); PG8_BAR;
    }
    for (;;) {
        const bool has_next = S.next(ui + 1, nxt);
        const char* nA = has_next ? (const char*)g.A + (size_t)nxt.pm * tstep : cA; const char* nB = has_next ? (const char*)g.Bt + (size_t)nxt.pn * tstep : cB;
        for (int t = 0; t < nt; t += 2) {
            const bool last = (t == nt - 2);
            const char* a1 = cA + (size_t)(t + 1) * kstep;
            const char* a2 = last ? nA : cA + (size_t)(t + 2) * kstep; const char* b2 = last ? nB : cB + (size_t)(t + 2) * kstep;
            const char* a3 = a2 + kstep; const char* b3 = b2 + kstep;
            if (last && has_next) S.a_ready(nxt);
            if constexpr (SP2) {
            PG8_LDB(B0, 0, 0); PG8_LDB(B1, 0, 1); PG8_SCHED; PG8_LDA(At, 0, 0); PG8_STAGE(PG8_SA(1, 1), a1 + hstep, voffA);
            PG8_WAIT_V(8); PG8_WAIT_L(0); PG8_BAR; PG8_MMA(0, 0, At, B0); PG8_MMA(0, 1, At, B1); PG8_BAR; PG8_SCHED;
            PG8_LDA(At, 0, 1); PG8_STAGE(PG8_SB(0, 0), b2, voffB); PG8_STAGE(PG8_SB(0, 1), b2 + hstep, voffB); PG8_STAGE(PG8_SA(0, 0), a2, voffA);
            PG8_WAIT_V(8); PG8_WAIT_L(0); PG8_BAR; PG8_MMA(1, 0, At, B0); PG8_MMA(1, 1, At, B1); PG8_BAR; PG8_SCHED;
            PG8_LDB(B0, 1, 0); PG8_LDB(B1, 1, 1); PG8_SCHED; PG8_LDA(At, 1, 0); PG8_STAGE(PG8_SA(0, 1), a2 + hstep, voffA);
            PG8_WAIT_V(8); PG8_WAIT_L(0); PG8_BAR; PG8_MMA(0, 0, At, B0); PG8_MMA(0, 1, At, B1); PG8_BAR; PG8_SCHED;
            PG8_LDA(At, 1, 1); PG8_STAGE(PG8_SB(1, 0), b3, voffB); PG8_STAGE(PG8_SB(1, 1), b3 + hstep, voffB); PG8_STAGE(PG8_SA(1, 0), a3, voffA);
            PG8_WAIT_V(8); PG8_WAIT_L(0); PG8_BAR; PG8_MMA(1, 0, At, B0); PG8_MMA(1, 1, At, B1); PG8_BAR; PG8_SCHED;
            } else {
            PG8_LDB(B0, 0, 0); PG8_SCHED; PG8_LDA(At, 0, 0); PG8_STAGE(PG8_SA(1, 1), a1 + hstep, voffA);
            PG8_WAIT_L(8); PG8_BAR; PG8_WAIT_L(0); PG8_MMA(0, 0, At, B0); PG8_BAR; PG8_SCHED;
            PG8_LDB(B1, 0, 1); PG8_STAGE(PG8_SB(0, 0), b2, voffB);
            PG8_BAR; PG8_WAIT_L(0); PG8_MMA(0, 1, At, B1); PG8_BAR;
            PG8_LDA(At, 0, 1); PG8_STAGE(PG8_SA(0, 0), a2, voffA);
            PG8_BAR; PG8_WAIT_L(0); PG8_MMA(1, 0, At, B0); PG8_BAR; PG8_SCHED;
            PG8_STAGE(PG8_SB(0, 1), b2 + hstep, voffB);
            PG8_WAIT_V(6); PG8_BAR; PG8_MMA(1, 1, At, B1); PG8_BAR;
            PG8_LDB(B0, 1, 0); PG8_SCHED; PG8_LDA(At, 1, 0); PG8_STAGE(PG8_SA(0, 1), a2 + hstep, voffA);
            PG8_WAIT_L(8); PG8_BAR; PG8_WAIT_L(0); PG8_MMA(0, 0, At, B0); PG8_BAR; PG8_SCHED;
            PG8_LDB(B1, 1, 1); PG8_STAGE(PG8_SB(1, 0), b3, voffB);
            PG8_BAR; PG8_WAIT_L(0); PG8_MMA(0, 1, At, B1); PG8_BAR;
            PG8_LDA(At, 1, 1); PG8_STAGE(PG8_SA(1, 0), a3, voffA);
            PG8_BAR; PG8_WAIT_L(0); PG8_MMA(1, 0, At, B0); PG8_BAR; PG8_SCHED;
            PG8_STAGE(PG8_SB(1, 1), b3 + hstep, voffB);
            PG8_WAIT_V(6); PG8_BAR; PG8_MMA(1, 1, At, B1); PG8_BAR;
            }
        }
        if constexpr (ALIGN_EPI) { if (wr == 0) PG8_BAR; }
        if constexpr (!Epi::AFTER_DRAIN) { E(acc, cur, wr, wc, fr, fq); S.done(cur); }
        if (!has_next) break;
#pragma unroll
        for (int a = 0; a < 2; ++a)
#pragma unroll
            for (int b = 0; b < 2; ++b)
#pragma unroll
                for (int m = 0; m < 4; ++m)
#pragma unroll
                    for (int n = 0; n < 2; ++n) acc[a][b][m][n] = (f32x4){0.f, 0.f, 0.f, 0.f};
        cur = nxt; cA = nA; cB = nB; ++ui;
        if constexpr (ALIGN_EPI) { if (wr == 1) PG8_BAR; }
    }
    PG8_WAIT_V(0);
    if constexpr (!ALIGN_EPI) { if (wr == 0) PG8_BAR; }
    PG8_BAR;
    if constexpr (Epi::AFTER_DRAIN) { E.fused(acc, cur, wr, wc, fr, fq, lds, wid, lane); S.done(cur); }
#undef PG8_SA
#undef PG8_SB
#undef PG8_STAGE
#undef PG8_LDA
#undef PG8_LDB
#undef PG8_MMA
#undef PG8_WAIT_V
#undef PG8_WAIT_L
#undef PG8_BAR
#undef PG8_SCHED
}
}
#include <hip/hip_bf16.h>
#include <cmath>
namespace attn_body {
using bf16=__hip_bfloat16;
using bf16x8=__attribute__((ext_vector_type(8)))short;
using s16x4=__attribute__((ext_vector_type(4)))short;
using f32x16=__attribute__((ext_vector_type(16)))float;
using u32x4=__attribute__((ext_vector_type(4)))unsigned;
constexpr int BATCH=8,NHEAD=16,SEQ=8192,D=64,DM=NHEAD*D,DMI=512,DMO=1024;
constexpr int NW=8,QBLK=32,QB=QBLK*NW,KVBLK=64,NQB=SEQ/QB;
constexpr int ATTN_PITCH=DM, ATTN_UNIT_ROWS=QB;
__device__ __forceinline__ int crow(int r,int hi){return (r&3)+8*(r>>2)+4*hi;}
#define SBAR() __builtin_amdgcn_sched_barrier(0)
__device__ __forceinline__ void cmask(f32x16&p0,f32x16&p1,int jb,int qrel,int hi){
  const float NEG=-INFINITY; int kb=64*jb+4*hi;
  #pragma unroll
  for(int r=0;r<16;++r){ if(jb>(qrel>>6)){p0[r]=NEG;p1[r]=NEG;} } (void)kb;
}

constexpr int NSLOT=3, SLOTB=8192;
constexpr int LDS_K=0, LDS_V=NSLOT*SLOTB, LDS_WS=2*NSLOT*SLOTB, LDS_OST=LDS_WS+NW*64*4, LDS_BYTES=LDS_OST+NW*4096;
constexpr float C2=0.125f*1.4426950408889634f;
__device__ __forceinline__ void glds16(const void*gsrc,unsigned lds_dst){unsigned keep;
  asm volatile("s_mov_b32 %0, m0\n\ts_mov_b32 m0, %2\n\ts_nop 0\n\tglobal_load_lds_dwordx4 %1, off\n\ts_mov_b32 m0, %0":"=&s"(keep):"v"(gsrc),"s"(lds_dst):"memory");}
__device__ __forceinline__ float max3f(float a,float b,float c){float r;asm("v_max3_f32 %0, %1, %2, %3":"=v"(r):"v"(a),"v"(b),"v"(c));return r;}
__device__ __forceinline__ float max2f(float a,float b){float r;asm("v_max_f32_e32 %0, %1, %2":"=v"(r):"v"(a),"v"(b));return r;}
__device__ __forceinline__ float fadd_s(float a,float b){float r;asm("v_add_f32_e32 %0, %1, %2":"=v"(r):"v"(a),"v"(b));return r;}
__device__ __forceinline__ float fsub_s(float a,float b){float r;asm("v_sub_f32_e32 %0, %1, %2":"=v"(r):"v"(a),"v"(b));return r;}
typedef float f32x2_t __attribute__((ext_vector_type(2))); typedef __bf16 bf16x2_t __attribute__((ext_vector_type(2)));
__device__ __forceinline__ unsigned cvtpk_s(float lo,float hi){f32x2_t v={lo,hi};bf16x2_t b=__builtin_convertvector(v,bf16x2_t);return __builtin_bit_cast(unsigned,b);}
#define WAIT_BAR(N) asm volatile("s_waitcnt vmcnt(" #N ") lgkmcnt(0)\n\ts_barrier":::"memory")

__device__ __forceinline__ void qkt(f32x16&p0,f32x16&p1,const char*Kslot,const bf16x8*qr,const f32x16&negm,int r32,int hi){
  const char*kb=Kslot+hi*1024+r32*16;
  #pragma unroll
  for(int d0=0;d0<4;++d0){
    const bf16x8 b0=*reinterpret_cast<const bf16x8*>(kb+d0*2048);
    const bf16x8 b1=*reinterpret_cast<const bf16x8*>(kb+d0*2048+512);
    if(d0==0){p0=__builtin_amdgcn_mfma_f32_32x32x16_bf16(b0,qr[0],negm,0,0,0);p1=__builtin_amdgcn_mfma_f32_32x32x16_bf16(b1,qr[0],negm,0,0,0);}
    else{p0=__builtin_amdgcn_mfma_f32_32x32x16_bf16(b0,qr[d0],p0,0,0,0);p1=__builtin_amdgcn_mfma_f32_32x32x16_bf16(b1,qr[d0],p1,0,0,0);}}
}
typedef __attribute__((address_space(3))) const char* lds_cptr;
typedef short v4i16_t __attribute__((ext_vector_type(4)));
__device__ __forceinline__ void kload8(bf16x8*kf,lds_cptr kp){
  kf[0]=*(const __attribute__((address_space(3))) bf16x8*)(kp);      kf[1]=*(const __attribute__((address_space(3))) bf16x8*)(kp+512);
  kf[2]=*(const __attribute__((address_space(3))) bf16x8*)(kp+2048); kf[3]=*(const __attribute__((address_space(3))) bf16x8*)(kp+2560);
  kf[4]=*(const __attribute__((address_space(3))) bf16x8*)(kp+4096); kf[5]=*(const __attribute__((address_space(3))) bf16x8*)(kp+4608);
  kf[6]=*(const __attribute__((address_space(3))) bf16x8*)(kp+6144); kf[7]=*(const __attribute__((address_space(3))) bf16x8*)(kp+6656);
}
__device__ __forceinline__ void kload2(bf16x8*kf,lds_cptr kp,int j){ kf[2*j]=*(const __attribute__((address_space(3))) bf16x8*)(kp+j*2048); kf[2*j+1]=*(const __attribute__((address_space(3))) bf16x8*)(kp+j*2048+512); }
__device__ __forceinline__ s16x4 vtr(lds_cptr p){ return __builtin_bit_cast(s16x4,__builtin_amdgcn_ds_read_tr16_b64_v4i16((__attribute__((address_space(3))) v4i16_t*)p)); }
__device__ __forceinline__ float rowmax(const f32x16&p0,const f32x16&p1){
  float a=max3f(p0[0],p0[1],p1[0]),b=max3f(p0[2],p0[3],p1[1]);a=max3f(a,p1[2],p1[3]);
  #pragma unroll
  for(int r=4;r<16;r+=4){a=max3f(a,p0[r],p0[r+1]);b=max3f(b,p0[r+2],p0[r+3]);a=max3f(a,p1[r],p1[r+1]);b=max3f(b,p1[r+2],p1[r+3]);}
  const float m=max2f(a,b);
  auto rr=__builtin_amdgcn_permlane32_swap(__float_as_uint(m),__float_as_uint(m),false,false);
  return max2f(__uint_as_float(rr[0]),__uint_as_float(rr[1]));
}
__device__ __forceinline__ void pv(f32x16*o,int vb,bf16x8 pa0,bf16x8 pa1,bf16x8 pa2,bf16x8 pa3){
  #pragma unroll
  for(int d0=0;d0<2;++d0){s16x4 lo[4],hi[4];
    #pragma unroll
    for(int ks=0;ks<4;++ks){
      asm volatile("ds_read_b64_tr_b16 %0,%1 offset:%c2":"=&v"(lo[ks]):"v"(vb),"i"(d0*4096+ks*1024):"memory");
      asm volatile("ds_read_b64_tr_b16 %0,%1 offset:%c2":"=&v"(hi[ks]):"v"(vb),"i"(d0*4096+ks*1024+512):"memory");}
    asm volatile("s_waitcnt lgkmcnt(0)":::"memory");SBAR();
    #define PK(k) (bf16x8){lo[k][0],lo[k][1],lo[k][2],lo[k][3],hi[k][0],hi[k][1],hi[k][2],hi[k][3]}
    o[d0]=__builtin_amdgcn_mfma_f32_32x32x16_bf16(pa0,PK(0),o[d0],0,0,0);
    o[d0]=__builtin_amdgcn_mfma_f32_32x32x16_bf16(pa1,PK(1),o[d0],0,0,0);
    o[d0]=__builtin_amdgcn_mfma_f32_32x32x16_bf16(pa2,PK(2),o[d0],0,0,0);
    o[d0]=__builtin_amdgcn_mfma_f32_32x32x16_bf16(pa3,PK(3),o[d0],0,0,0);
    #undef PK
  }
}

#ifndef ATTN_STORE16
#define ATTN_STORE16(p,v) (*(u32x4*)(p)=(v))
#endif
template<int THRL> __device__ __forceinline__ void attn_unit(int b,int h,int qb,const bf16*Q,const bf16*__restrict__ K,const bf16*__restrict__ V,bf16*O,char*shm,const int wv_){
  int tid_o=wv_*64+(int)__builtin_amdgcn_mbcnt_hi(~0u,__builtin_amdgcn_mbcnt_lo(~0u,0u)); asm volatile("":"+v"(tid_o)); tid_o&=511;
  const int tid=tid_o,lane=tid&63,r32=lane&31,hi=lane>>5; const int wid=__builtin_amdgcn_readfirstlane(tid>>6);
  const long rowbase=(long)b*SEQ; const int q0=qb*QB;
  const bf16*Qw=Q+(rowbase+q0+wid*QBLK)*DMI+(h>>1)*D;
  const bf16*Kh=K+rowbase*DMI+(h>>1)*D,*Vh=V+rowbase*DMI+(h>>2)*128+(h&1)*64;
  const unsigned lds0=(unsigned)(uintptr_t)shm;
  float*wsf=(float*)(shm+LDS_WS)+wid*64;
  const bf16*ksrc=Kh+(long)lane*DMI+wid*8;
  const bf16*vsrc=Vh+(long)(16*(wid&3)+(lane>>2))*DMI+(wid>>2)*32+(lane&3)*8;
  const unsigned kdst=lds0+LDS_K+wid*1024, vdst=lds0+LDS_V+wid*1024;
  #define DMA_K(t,slot) glds16(ksrc+(long)(t)*KVBLK*DMI,(unsigned)__builtin_amdgcn_readfirstlane(kdst+(slot)))
  #define DMA_V(t,slot) glds16(vsrc+(long)(t)*KVBLK*DMI,(unsigned)__builtin_amdgcn_readfirstlane(vdst+(slot)))
  const int vb0=(int)(lds0+LDS_V)+((lane>>4)&1)*32+(lane&3)*8+(4*hi+((lane&15)>>2))*64;
  const char*Kbase=shm+LDS_K; bf16x8 kf[8];
  const lds_cptr shm3=(lds_cptr)shm; const lds_cptr kp0=shm3+LDS_K+hi*1024+r32*16; const lds_cptr vp0=shm3+LDS_V+((lane>>4)&1)*32+(lane&3)*8+(4*hi+((lane&15)>>2))*64;
  const int NT=(q0+QB)/KVBLK;
  DMA_K(0,0);DMA_V(0,0);DMA_K(1,SLOTB);
  bf16x8 qr[4];
  #pragma unroll
  for(int d0=0;d0<4;++d0)qr[d0]=*reinterpret_cast<const bf16x8*>(&Qw[(long)r32*DMI+d0*16+hi*8]);
  float mhat=0.f,l_reg=0.f;f32x16 o[2];o[0]=f32x16{};o[1]=f32x16{};f32x16 negm=f32x16{};asm volatile("":"+v"(negm));
  const int qrel=wid*QBLK+r32;
  #define CMASK(P0,P1,t) do{int jb_=(t)-(NT-4); if(jb_>=0)cmask(P0,P1,jb_,qrel,hi);}while(0)
  bool resc=false;
  #define START(P0,P1) do{ const float rm=rowmax(P0,P1); resc=false; \
    { const float dl=rm; mhat=fadd_s(mhat,dl); \
      _Pragma("unroll") for(int r=0;r<16;++r){P0[r]=fsub_s(P0[r],dl);P1[r]=fsub_s(P1[r],dl);} \
      _Pragma("unroll") for(int r=0;r<16;++r)negm[r]=-mhat; asm volatile("":"+v"(negm)); } \
    _Pragma("unroll") for(int r=0;r<16;++r)P0[r]=__builtin_amdgcn_exp2f(P0[r]); }while(0)
  #define RESC() do{ if(resc){ asm volatile("s_waitcnt lgkmcnt(0)":::"memory"); \
      _Pragma("unroll") for(int d_=0;d_<2;++d_) _Pragma("unroll") for(int r=0;r<16;++r)o[d_][r]*=wsf[crow(r,hi)]; } }while(0)
  f32x16 pA0,pA1,pB0,pB1;
  int sl_prev=0,sl_cur=0,sl_next=SLOTB;
  #define ROT() do{sl_prev=sl_cur;sl_cur=sl_next;sl_next=(sl_next==(NSLOT-1)*SLOTB)?0:sl_next+SLOTB;}while(0)
  DMA_K(2,2*SLOTB);
  WAIT_BAR(3);
  qkt(pA0,pA1,Kbase,qr,negm,r32,hi);asm volatile("s_nop 15\n\ts_nop 7":"+v"(pA0),"+v"(pA1));CMASK(pA0,pA1,0);
  START(pA0,pA1);
  _Pragma("unroll") for(int r=0;r<16;++r)pA1[r]=__builtin_amdgcn_exp2f(pA1[r]);
  WAIT_BAR(0);
  DMA_K(3,0);DMA_V(1,SLOTB);
  ROT();
  kload8(kf,kp0+sl_cur);
  WAIT_BAR(2);
  s16x4 vlo[8],vhi[8]; u32x4 pw0,pw1,pw2,pw3;
  #define PKW(P,B) cvtpk_s(P[B],P[B+1])
  #define PAF(k) __builtin_bit_cast(bf16x8,pw##k)
  #define VFR(i) (bf16x8){vlo[i][0],vlo[i][1],vlo[i][2],vlo[i][3],vhi[i][0],vhi[i][1],vhi[i][2],vhi[i][3]}
  #define PIN(x) asm volatile("":"+v"(x))
  #define MX3(a,b,c) __builtin_fmaxf(__builtin_fmaxf((a),(b)),(c))
  #define GAPA(MF,A0,A1,A2,A3,W0,W1,PW) do{ MF; sacc+=A0; sacc+=A1; sacc+=A2; sacc+=A3; PIN(sacc); W0; W1; PIN(PW); SBAR(); }while(0)
  #define EX(v) __builtin_amdgcn_exp2f(v)
  #define GAPB(MF,X,B) do{ MF; X[B]=EX(X[B]); X[B+1]=EX(X[B+1]); X[B+2]=EX(X[B+2]); X[B+3]=EX(X[B+3]); PIN(X); SBAR(); }while(0)
  #define VRD(i) do{ vlo[i]=vtr(vp_+(((i)>>2)*4096+((i)&3)*1024)); vhi[i]=vtr(vp_+(((i)>>2)*4096+((i)&3)*1024+512)); }while(0)
  #define KRD(G,j) do{ if(G){ kload2(kf,kp0+sl_next,j); SBAR(); } }while(0)
  #define STEP(C0,C1,P0,P1,t,GK,GV,GL) do{ SBAR(); \
    const lds_cptr vp_=vp0+sl_prev; \
    VRD(0); SBAR(); float sacc=(P0[0]+P0[1]); \
    GAPA(C0=__builtin_amdgcn_mfma_f32_32x32x16_bf16(kf[0],qr[0],negm,0,0,0), P0[2],P0[3],P0[4],P0[5],     pw0[0]=PKW(P0,0), pw0[1]=PKW(P0,2), pw0); \
    VRD(4); SBAR(); GAPA(C1=__builtin_amdgcn_mfma_f32_32x32x16_bf16(kf[1],qr[0],negm,0,0,0), P0[6],P0[7],P0[8],P0[9],     pw0[2]=PKW(P0,4), pw0[3]=PKW(P0,6), pw0); \
    VRD(1); SBAR(); GAPA(C0=__builtin_amdgcn_mfma_f32_32x32x16_bf16(kf[2],qr[1],C0,0,0,0),   P0[10],P0[11],P0[12],P0[13], pw1[0]=PKW(P0,8), pw1[1]=PKW(P0,10), pw1); \
    VRD(5); SBAR(); GAPA(C1=__builtin_amdgcn_mfma_f32_32x32x16_bf16(kf[3],qr[1],C1,0,0,0),   P0[14],P0[15],P1[0],P1[1],   pw1[2]=PKW(P0,12),pw1[3]=PKW(P0,14), pw1); \
    VRD(2); SBAR(); GAPA(C0=__builtin_amdgcn_mfma_f32_32x32x16_bf16(kf[4],qr[2],C0,0,0,0),   P1[2],P1[3],P1[4],P1[5],     pw2[0]=PKW(P1,0), pw2[1]=PKW(P1,2), pw2); \
    VRD(6); SBAR(); GAPA(C1=__builtin_amdgcn_mfma_f32_32x32x16_bf16(kf[5],qr[2],C1,0,0,0),   P1[6],P1[7],P1[8],P1[9],     pw2[2]=PKW(P1,4), pw2[3]=PKW(P1,6), pw2); \
    VRD(3); SBAR(); GAPA(C0=__builtin_amdgcn_mfma_f32_32x32x16_bf16(kf[6],qr[3],C0,0,0,0),   P1[10],P1[11],P1[12],P1[13], pw3[0]=PKW(P1,8), pw3[1]=PKW(P1,10), pw3); \
    VRD(7); SBAR(); GAPA(C1=__builtin_amdgcn_mfma_f32_32x32x16_bf16(kf[7],qr[3],C1,0,0,0),   P1[14],P1[15],0.f,0.f,       pw3[2]=PKW(P1,12),pw3[3]=PKW(P1,14), pw3); \
    l_reg+=sacc; \
    if(GK){DMA_K((t)+3,sl_cur);} if(GV){DMA_V((t)+1,sl_next);} \
    CMASK(C0,C1,t); \
    { float a=MX3(C0[0],C0[1],C1[0]),b=MX3(C0[2],C0[3],C1[1]); a=MX3(a,C1[2],C1[3]); \
      _Pragma("unroll") for(int r=4;r<16;r+=4){a=MX3(a,C0[r],C0[r+1]);b=MX3(b,C0[r+2],C0[r+3]);a=MX3(a,C1[r],C1[r+1]);b=MX3(b,C1[r+2],C1[r+3]);} \
      float rm=__builtin_fmaxf(a,b); { auto rr=__builtin_amdgcn_permlane32_swap(__float_as_uint(rm),__float_as_uint(rm),false,false); rm=__builtin_fmaxf(__uint_as_float(rr[0]),__uint_as_float(rr[1])); } \
      resc=false; \
      if(__builtin_expect(__any(rm>(float)THRL),0)){ const float dl=__builtin_fmaxf(rm,0.f); mhat+=dl; \
        _Pragma("unroll") for(int r=0;r<16;++r){C0[r]-=dl;C1[r]-=dl;} \
        _Pragma("unroll") for(int r=0;r<16;++r)negm[r]=-mhat; asm volatile("":"+v"(negm)); \
        const float f=__builtin_amdgcn_exp2f(-dl); l_reg*=f; if(hi==0)wsf[r32]=f; resc=true; } } \
    SBAR(); \
    GAPB(o[0]=__builtin_amdgcn_mfma_f32_32x32x16_bf16(PAF(0),VFR(0),o[0],0,0,0), C0,0); \
    GAPB(o[1]=__builtin_amdgcn_mfma_f32_32x32x16_bf16(PAF(0),VFR(4),o[1],0,0,0), C0,4); \
    KRD(GL,0); GAPB(o[0]=__builtin_amdgcn_mfma_f32_32x32x16_bf16(PAF(1),VFR(1),o[0],0,0,0), C0,8); \
    KRD(GL,1); GAPB(o[1]=__builtin_amdgcn_mfma_f32_32x32x16_bf16(PAF(1),VFR(5),o[1],0,0,0), C0,12); \
    KRD(GL,2); GAPB(o[0]=__builtin_amdgcn_mfma_f32_32x32x16_bf16(PAF(2),VFR(2),o[0],0,0,0), C1,0); \
    KRD(GL,3); GAPB(o[1]=__builtin_amdgcn_mfma_f32_32x32x16_bf16(PAF(2),VFR(6),o[1],0,0,0), C1,4); \
    GAPB(o[0]=__builtin_amdgcn_mfma_f32_32x32x16_bf16(PAF(3),VFR(3),o[0],0,0,0), C1,8); \
    GAPB(o[1]=__builtin_amdgcn_mfma_f32_32x32x16_bf16(PAF(3),VFR(7),o[1],0,0,0), C1,12); \
    }while(0)
  int t=1;
  #undef CMASK
  #define CMASK(P0,P1,t) do{}while(0)
  for(;t+5<NT;t+=2){
    STEP(pB0,pB1,pA0,pA1,t,true,true,true);     WAIT_BAR(2); RESC(); ROT();
    STEP(pA0,pA1,pB0,pB1,t+1,true,true,true);   WAIT_BAR(2); RESC(); ROT();
  }
  #undef CMASK
  #define CMASK(P0,P1,t) do{int jb_=(t)-(NT-4); if(jb_>=0)cmask(P0,P1,jb_,qrel,hi);}while(0)
  #define ENDW(tt) do{ if((tt)+3<NT){WAIT_BAR(2);} else if((tt)+2<NT){WAIT_BAR(1);} else {WAIT_BAR(0);} }while(0)
  for(;t+1<NT;t+=2){
    STEP(pB0,pB1,pA0,pA1,t,(t+3<NT),(t+1<NT),(t+1<NT));       ENDW(t);   RESC(); ROT();
    STEP(pA0,pA1,pB0,pB1,t+1,(t+4<NT),(t+2<NT),(t+2<NT));     ENDW(t+1); RESC(); ROT();
  }
  STEP(pB0,pB1,pA0,pA1,NT-1,false,false,false); RESC();
  { float sacc=pB0[0]+pB0[1]; _Pragma("unroll") for(int r=2;r<16;++r)sacc+=pB0[r]; _Pragma("unroll") for(int r=0;r<16;++r)sacc+=pB1[r]; l_reg+=sacc;
    pw0=(u32x4){PKW(pB0,0),PKW(pB0,2),PKW(pB0,4),PKW(pB0,6)};pw1=(u32x4){PKW(pB0,8),PKW(pB0,10),PKW(pB0,12),PKW(pB0,14)};pw2=(u32x4){PKW(pB1,0),PKW(pB1,2),PKW(pB1,4),PKW(pB1,6)};pw3=(u32x4){PKW(pB1,8),PKW(pB1,10),PKW(pB1,12),PKW(pB1,14)};
    SBAR(); pv(o,vb0+sl_cur,PAF(0),PAF(1),PAF(2),PAF(3)); }
  #undef PKW
  #undef PAF
  #undef VFR
  #undef PIN
  #undef MX3
  #undef GAPA
  #undef GAPB
  #undef EX
  #undef VRD
  #undef KRD
  #undef STEP
  #undef ENDW
  {auto rr=__builtin_amdgcn_permlane32_swap(__float_as_uint(l_reg),__float_as_uint(l_reg),false,false);l_reg=__uint_as_float(rr[0])+__uint_as_float(rr[1]);}
  if(hi==0)wsf[32+r32]=l_reg;asm volatile("s_waitcnt lgkmcnt(0)":::"memory");
  float rli[16];
  #pragma unroll
  for(int r=0;r<16;++r)rli[r]=__builtin_amdgcn_rcpf(wsf[32+crow(r,hi)]);
  bf16*Ow=O+(rowbase+q0+wid*QBLK)*DMO+h*D;
  { bf16*stg=(bf16*)(shm+LDS_OST)+wid*2048;
    #pragma unroll
    for(int r=0;r<16;++r){const int orow=crow(r,hi);
      #pragma unroll
      for(int d0=0;d0<2;++d0)stg[orow*64+d0*32+r32]=__float2bfloat16(o[d0][r]*rli[r]);}
    asm volatile("s_waitcnt lgkmcnt(0)":::"memory");
    #pragma unroll
    for(int i=0;i<4;++i){const int row=i*8+(lane>>3),ch=lane&7; const u32x4 v=*(const u32x4*)(stg+row*64+ch*8); ATTN_STORE16(Ow+(long)row*DMO+ch*8,v);} }
  asm volatile("s_waitcnt lgkmcnt(0)\n\ts_barrier":::"memory");
  #undef DMA_K
  #undef DMA_V
  #undef CMASK
  #undef START
  #undef RESC
  #undef ROT
}
constexpr int ATTN_LDS_BYTES=LDS_BYTES;
struct AttnTensors { const bf16* Q; const bf16* K; const bf16* V; bf16* O; };
struct AttnUnit { int bh; int qb; };
struct StaticOrder {
  int vcu;
  __device__ __forceinline__ explicit StaticOrder(int grid,int block):vcu((block%8)*(grid/8)+block/8){}
  __device__ __forceinline__ bool next(int i,AttnUnit&u)const{ if(i>=4)return false; const int s=vcu&7; u.bh=vcu>>3; u.qb=(i==0)?s:(i==1)?15-s:(i==2)?16+s:31-s; return true; }
  __device__ __forceinline__ void a_ready(const AttnUnit&)const{}
  __device__ __forceinline__ void done(const AttnUnit&)const{}
};
template<class Sched,int THRL=8> __device__ __forceinline__ void attn_phase(char*lds,const AttnTensors&T,const Sched&S){
  AttnUnit u;
  for(int i=0;S.next(i,u);++i){ S.a_ready(u); attn_unit<THRL>(u.bh/NHEAD,u.bh%NHEAD,u.qb,T.Q,T.K,T.V,T.O,lds); S.done(u); }
}
#undef SBAR
#undef WAIT_BAR
}

#define LAS __attribute__((address_space(3)))
typedef unsigned short bfu;
typedef unsigned v4u __attribute__((ext_vector_type(4)));
typedef unsigned v2u __attribute__((ext_vector_type(2)));
typedef float f32x4 __attribute__((ext_vector_type(4)));
typedef float f32x8 __attribute__((ext_vector_type(8)));
typedef float f32x16 __attribute__((ext_vector_type(16)));
typedef float f32x2 __attribute__((ext_vector_type(2)));

constexpr int NWAVES = 8, NTHR = 512;
constexpr int MP = 65536, MS = 128, MR = MP + MS, MPAD = 65792;
constexpr int NIN = 3840, FFD = 4096;
constexpr int NPHASE = 24;
#ifndef MK_ONE_LAUNCH
#define MK_ONE_LAUNCH 1
#endif

constexpr size_t O_Y = 0;
constexpr size_t O_YS = (size_t)MP * 1024;
constexpr size_t O_ACP = O_YS + 128 * 1024;
constexpr size_t O_ADP = O_ACP + 2 * 8 * 3 * 768;
constexpr size_t O_BKP = O_ADP + 2 * 8 * 4 * 64 * 64;
constexpr size_t O_BVP = O_BKP + (size_t)2 * 8 * 8192 * 512;
constexpr size_t O_CSP = O_BVP + (size_t)2 * 8 * 8192 * 512;
constexpr size_t O_CWP = O_CSP + 2 * 8 * 1024;
constexpr size_t O_ACS = O_CWP + 2 * 8 * 4 * 64 * 64;
constexpr size_t O_ADS = O_ACS + 2 * 8 * 3 * 768;
constexpr size_t O_BKS = O_ADS + 2 * 8 * 4 * 64 * 64;
constexpr size_t O_BVS = O_BKS + 2 * 8 * 16 * 512;
constexpr size_t O_CSS = O_BVS + 2 * 8 * 16 * 512;
constexpr size_t O_CWS = O_CSS + 2 * 8 * 1024;
constexpr size_t O_END = O_CWS + 2 * 8 * 4 * 64 * 64;
static_assert(O_END == 202874880, "output size");

constexpr size_t MiB = 1u << 20;
constexpr size_t WS_CTL = 0;
constexpr size_t WS_RS = 64 * 1024;
constexpr size_t WS_BONUS = 2 * MiB;
constexpr size_t WS_GAB = 3 * MiB + 512 * 1024;
constexpr size_t WS_AB = 6 * MiB;
constexpr size_t WS_ROPE = 8 * MiB + 512 * 1024;
constexpr size_t WS_GCH = 10 * MiB + 512 * 1024;
constexpr size_t WS_W = 12 * MiB;
constexpr size_t W_IN = 0, W_OUT = W_IN + (size_t)NIN * 1024 * 2, W_FF1 = W_OUT + 1024 * 1024 * 2, W_FF2 = W_FF1 + 4096 * 1024 * 2,
                 W_GATE = W_FF2 + 4096 * 1024 * 2, W_PP = W_GATE + 1024 * 1024 * 2, W_LR = W_PP + 1024 * 256 * 2, W_END = W_LR + 768 * 256 * 2;
constexpr size_t WS_SLOT = 41 * MiB;
constexpr size_t USLOT = (size_t)MPAD * 1024;
static_assert(WS_W + W_END <= WS_SLOT, "weights");
constexpr size_t WS_PAIRC = WS_SLOT + 15 * USLOT;
constexpr size_t WS_PAIRD = WS_PAIRC + 4 * (size_t)(MPAD / 2) * 16;
constexpr size_t WS_TOTAL = WS_PAIRD + 4 * (size_t)(MPAD / 2) * 8;
static_assert(WS_TOTAL <= (size_t)1024 * MiB, "ws");
static_assert(WS_RS + 7 * (size_t)MPAD * 4 <= WS_BONUS && WS_BONUS + 4 * (size_t)MPAD * 4 <= WS_GAB && WS_GAB + 8 * (size_t)MPAD * 4 <= WS_AB && WS_AB + 8 * (size_t)MPAD * 4 <= WS_ROPE && WS_ROPE + 8192 * 64 * 4 <= WS_GCH && WS_GCH + 4 * 1032 * 64 * 4 <= WS_W, "ctl map");

__device__ __forceinline__ unsigned char* slotp(unsigned char* ws, int l, int s) {
    if (l & 1) { if (s < 2) s += 13; else if (s >= 13) s -= 13; }
    return ws + WS_SLOT + (size_t)s * USLOT;
}
__device__ __forceinline__ unsigned char* slotph(unsigned char* ws, int l, int s) { return slotp(ws, l, s) + USLOT / 2; }

constexpr int RING_BYTES = 131072, MISC_OFF = RING_BYTES + 320, LDS_BYTES = 147456;

#define LDS_WAIT() asm volatile("s_waitcnt lgkmcnt(0)" ::: "memory")
__device__ __forceinline__ float bf2f(unsigned short u) { return __uint_as_float(((unsigned)u) << 16); }
__device__ __forceinline__ unsigned f2bf(float f) { unsigned u = __builtin_bit_cast(unsigned, f); return (u + 0x7fffu + ((u >> 16) & 1u)) >> 16; }
__device__ __forceinline__ unsigned pk2(float lo, float hi) { return f2bf(lo) | (f2bf(hi) << 16); }
#define DPP_ROR_ADD(v, ctrl) ((v) + __builtin_bit_cast(float, __builtin_amdgcn_update_dpp(0, __builtin_bit_cast(int, (v)), (ctrl), 0xf, 0xf, false)))
__device__ __forceinline__ float wave_sum(float v) {
    v = DPP_ROR_ADD(v, 0x128); v = DPP_ROR_ADD(v, 0x124); v = DPP_ROR_ADD(v, 0x122); v = DPP_ROR_ADD(v, 0x121);
    v += __shfl_xor(v, 16);
    const unsigned u = __float_as_uint(v); auto rr = __builtin_amdgcn_permlane32_swap(u, u, false, false);
    return __uint_as_float(rr[0]) + __uint_as_float(rr[1]);
}
__device__ __forceinline__ float sigm(float x) { return 1.f / (1.f + __expf(-x)); }
__device__ __forceinline__ float softplusf(float x) { return x > 20.f ? x : log1pf(__expf(x)); }

struct Args { const float* in[40]; float* out; unsigned char* ws; int ph_lo, ph_hi; };
typedef const __attribute__((address_space(4))) Args* KArgs;

constexpr float ATT_C2 = 0.125f * 1.4426950408889634f;
struct EpiG1 {
    static constexpr bool PERM = true, AFTER_DRAIN = false;
    const float* rs; bfu *aqkvz, *qb, *kb, *vb, *craw; float* ab; const float* rope; float *okp, *ovp, *oks, *ovs;
    __device__ __forceinline__ void operator()(const pg8::f32x4 (&acc)[2][2][4][2], const pg8::Unit& u, int wr, int wc, int fr, int fq) const {
        const int pn = u.pn; const int rowb = u.pm * 256 + wr * 64 + fr; const int cl = wc * 32 + 8 * fq;
#pragma unroll
        for (int ai = 0; ai < 2; ++ai)
#pragma unroll
            for (int m = 0; m < 4; ++m) {
                const int row = rowb + ai * 128 + m * 16;
                const float s = rsqrtf(rs[row] * (1.f / 1024.f) + 1e-6f);
                if (pn < 4 || (pn >= 10 && pn < 14)) {
                    bfu* dst = (pn < 4 ? aqkvz + pn * 256 : craw + (pn - 10) * 256) + (size_t)row * 1024 + cl;
#pragma unroll
                    for (int bj = 0; bj < 2; ++bj) { const pg8::f32x4 v0 = acc[ai][bj][m][0] * s, v1 = acc[ai][bj][m][1] * s;
                        v4u w; w.x = pg8::cvt_pk_bf16(v0[0], v0[1]); w.y = pg8::cvt_pk_bf16(v0[2], v0[3]); w.z = pg8::cvt_pk_bf16(v1[0], v1[1]); w.w = pg8::cvt_pk_bf16(v1[2], v1[3]); *(v4u*)(dst + bj * 128) = w; }
                } else if (pn < 8) {
                    const bool isk = pn >= 6;
                    const int pos = row < MP ? (row & 8191) : 2048 + ((row - MP) & 15);
                    const int i0 = (wc & 1) * 16 + 4 * fq;
                    const pg8::f32x4 c4 = *(const pg8::f32x4*)(rope + pos * 64 + i0), s4 = *(const pg8::f32x4*)(rope + pos * 64 + 32 + i0);
#pragma unroll
                    for (int bj = 0; bj < 2; ++bj) {
                        const pg8::f32x4 x1 = acc[ai][bj][m][0] * s, x2 = acc[ai][bj][m][1] * s;
                        pg8::f32x4 o1 = x1 * c4 - x2 * s4, o2 = x2 * c4 + x1 * s4;
                        if (!isk) {
                            o1 = o1 * ATT_C2; o2 = o2 * ATT_C2;
                            v4u w; w.x = pg8::cvt_pk_bf16(o1[0], o1[1]); w.y = pg8::cvt_pk_bf16(o1[2], o1[3]); w.z = pg8::cvt_pk_bf16(o2[0], o2[1]); w.w = pg8::cvt_pk_bf16(o2[2], o2[3]);
                            *(v4u*)(qb + (size_t)row * 512 + (pn - 4) * 256 + bj * 128 + cl) = w;
                        } else {
                            v4u w; w.x = pg8::cvt_pk_bf16(o1[0], o1[1]); w.y = pg8::cvt_pk_bf16(o1[2], o1[3]); w.z = pg8::cvt_pk_bf16(o2[0], o2[1]); w.w = pg8::cvt_pk_bf16(o2[2], o2[3]);
                            *(v4u*)(kb + (size_t)row * 512 + (pn - 6) * 256 + bj * 128 + cl) = w;
                            if (row < MR) {
                                float* ob = (row < MP ? okp + (size_t)row * 512 : oks + (size_t)(row - MP) * 512) + (pn - 6) * 256 + bj * 128 + (wc >> 1) * 64 + (wc & 1) * 16 + 4 * fq;
                                *(pg8::f32x4*)ob = o1; *(pg8::f32x4*)(ob + 32) = o2;
                            }
                        }
                    }
                } else if (pn < 10) {
#pragma unroll
                    for (int bj = 0; bj < 2; ++bj) {
                        const pg8::f32x4 v0 = acc[ai][bj][m][0] * s, v1 = acc[ai][bj][m][1] * s; const int col = (pn - 8) * 256 + bj * 128 + cl;
                        v4u w; w.x = pg8::cvt_pk_bf16(v0[0], v0[1]); w.y = pg8::cvt_pk_bf16(v0[2], v0[3]); w.z = pg8::cvt_pk_bf16(v1[0], v1[1]); w.w = pg8::cvt_pk_bf16(v1[2], v1[3]);
                        *(v4u*)(vb + (size_t)row * 512 + col) = w;
                        if (row < MR) { float* ob = (row < MP ? ovp + (size_t)row * 512 : ovs + (size_t)(row - MP) * 512) + col; *(pg8::f32x4*)ob = v0; *(pg8::f32x4*)(ob + 4) = v1; }
                    }
                } else {
                    if (wc == 0 && fq == 0) { const pg8::f32x4 v0 = acc[ai][0][m][0] * s, v1 = acc[ai][0][m][1] * s; *(pg8::f32x4*)(ab + (size_t)row * 8) = v0; *(pg8::f32x4*)(ab + (size_t)row * 8 + 4) = v1; }
                }
            }
    }
};
template <int MODE> struct EpiB {
    static constexpr bool PERM = true, AFTER_DRAIN = false;
    bfu* O; int ldc; const float* rs;
    __device__ __forceinline__ void operator()(const pg8::f32x4 (&acc)[2][2][4][2], const pg8::Unit& u, int wr, int wc, int fr, int fq) const {
        const int rowb = u.pm * 256 + wr * 64 + fr; const int cl = u.pn * 256 + wc * 32 + 8 * fq;
#pragma unroll
        for (int ai = 0; ai < 2; ++ai)
#pragma unroll
            for (int m = 0; m < 4; ++m) {
                const int row = rowb + ai * 128 + m * 16;
                float s = 1.f; if (MODE == 1) s = rsqrtf(rs[row] * (1.f / 1024.f) + 1e-6f);
                bfu* dst = O + (size_t)row * ldc + cl;
#pragma unroll
                for (int bj = 0; bj < 2; ++bj) {
                    pg8::f32x4 v0 = acc[ai][bj][m][0], v1 = acc[ai][bj][m][1];
                    if (MODE == 1) { v0 = v0 * s; v1 = v1 * s;
                        v0[0] = fmaxf(v0[0], 0.f); v0[1] = fmaxf(v0[1], 0.f); v0[2] = fmaxf(v0[2], 0.f); v0[3] = fmaxf(v0[3], 0.f); v1[0] = fmaxf(v1[0], 0.f); v1[1] = fmaxf(v1[1], 0.f); v1[2] = fmaxf(v1[2], 0.f); v1[3] = fmaxf(v1[3], 0.f);
                        v0 = v0 * v0; v1 = v1 * v1; }
                    v4u w; w.x = pg8::cvt_pk_bf16(v0[0], v0[1]); w.y = pg8::cvt_pk_bf16(v0[2], v0[3]); w.z = pg8::cvt_pk_bf16(v1[0], v1[1]); w.w = pg8::cvt_pk_bf16(v1[2], v1[3]);
                    *(v4u*)(dst + bj * 128) = w;
                }
            }
    }
};
template <int MODE> struct EpiH {
    static constexpr bool PERM = true, AFTER_DRAIN = false;
    float* H; bfu* xh; float* rsn; const float* rs; const bfu* pp;
    __device__ __forceinline__ void operator()(const pg8::f32x4 (&acc)[2][2][4][2], const pg8::Unit& u, int wr, int wc, int fr, int fq) const {
        const int rowb = u.pm * 256 + wr * 64 + fr; const int cl = u.pn * 256 + wc * 32 + 8 * fq;
#pragma unroll
        for (int ai = 0; ai < 2; ++ai)
#pragma unroll
            for (int m = 0; m < 4; ++m) {
                const int row = rowb + ai * 128 + m * 16; const bool valid = row < MR; float ss = 0.f;
                if (valid) {
                    float s = 1.f; if (MODE == 3) s = rsqrtf(rs[row] * (1.f / 1024.f) + 1e-6f);
#pragma unroll
                    for (int bj = 0; bj < 2; ++bj) {
                        const size_t off = (size_t)row * 1024 + cl + bj * 128;
                        pg8::f32x4 h0 = *(const pg8::f32x4*)(H + off), h1 = *(const pg8::f32x4*)(H + off + 4); const pg8::f32x4 a0 = acc[ai][bj][m][0], a1 = acc[ai][bj][m][1];
                        if (MODE == 3) { const v4u pw = *(const v4u*)(pp + off);
                            h0[0] += sigm(a0[0] * s) * __uint_as_float(pw.x << 16); h0[1] += sigm(a0[1] * s) * __uint_as_float(pw.x & 0xffff0000u);
                            h0[2] += sigm(a0[2] * s) * __uint_as_float(pw.y << 16); h0[3] += sigm(a0[3] * s) * __uint_as_float(pw.y & 0xffff0000u);
                            h1[0] += sigm(a1[0] * s) * __uint_as_float(pw.z << 16); h1[1] += sigm(a1[1] * s) * __uint_as_float(pw.z & 0xffff0000u);
                            h1[2] += sigm(a1[2] * s) * __uint_as_float(pw.w << 16); h1[3] += sigm(a1[3] * s) * __uint_as_float(pw.w & 0xffff0000u);
                        } else { h0 = h0 + a0; h1 = h1 + a1; }
                        *(pg8::f32x4*)(H + off) = h0; *(pg8::f32x4*)(H + off + 4) = h1;
                        v4u w; w.x = pg8::cvt_pk_bf16(h0[0], h0[1]); w.y = pg8::cvt_pk_bf16(h0[2], h0[3]); w.z = pg8::cvt_pk_bf16(h1[0], h1[1]); w.w = pg8::cvt_pk_bf16(h1[2], h1[3]); *(v4u*)(xh + off) = w;
                        ss += ((h0[0] * h0[0] + h0[1] * h0[1]) + (h0[2] * h0[2] + h0[3] * h0[3])) + ((h1[0] * h1[0] + h1[1] * h1[1]) + (h1[2] * h1[2] + h1[3] * h1[3]));
                    }
                }
                ss += __shfl_xor(ss, 16); ss += __shfl_xor(ss, 32);
                if (valid && fq == 0) unsafeAtomicAdd(rsn + row, ss);
            }
    }
};

__device__ __forceinline__ int win_src(int nd) {
    if (nd < 1024) return nd;
    if (nd < 2048) { const int c = nd - 1024, p = c & 63, grp = c >> 6; const int s = p >> 5, fq_ = (p >> 3) & 3, n_ = (p >> 2) & 1, j_ = p & 3; return 1032 + grp * 64 + n_ * 32 + s * 16 + 4 * fq_ + j_; }
    if (nd < 2560) return 2056 + (nd - 2048);
    if (nd < 3584) return 2568 + (nd - 2560);
    if (nd < 3592) return 1024 + (nd - 3584);
    return -1;
}
template <bool MAP> __device__ __forceinline__ void wt_item(const float* W, int K, int Nsrc, bfu* WT, const float* gain, LAS float* scr, int item, int nblk, int lane) {
    const int kb = item / nblk, nb = item % nblk, k0 = 64 * kb, n0 = 32 * nb;
    const int nd = n0 + (lane & 31); const int src = MAP ? win_src(nd) : nd;
#pragma unroll 8
    for (int i = 0; i < 32; ++i) { const int kk = 2 * i + (lane >> 5); float v = src >= 0 ? W[(size_t)(k0 + kk) * Nsrc + src] : 0.f; if (gain) v *= gain[k0 + kk]; scr[kk * 33 + (lane & 31)] = v; }
    LDS_WAIT(); asm volatile("" ::: "memory");
    const int c = lane & 7;
#pragma unroll
    for (int j = 0; j < 4; ++j) { const int n = (lane >> 3) + 8 * j; const LAS float* s = scr + (8 * c) * 33 + n;
        v4u o; o.x = pk2(s[0 * 33], s[1 * 33]); o.y = pk2(s[2 * 33], s[3 * 33]); o.z = pk2(s[4 * 33], s[5 * 33]); o.w = pk2(s[6 * 33], s[7 * 33]);
        *(v4u*)(WT + (size_t)(n0 + n) * K + k0 + 8 * c) = o; }
    LDS_WAIT(); asm volatile("" ::: "memory");
}
__device__ __forceinline__ void conv_weights(KArgs A, int l, int mask, LAS unsigned char* lds, int gw, int NGW, int lane, int wave) {
    LAS float* scr = (LAS float*)(lds + wave * 16384);
    unsigned char* wb = A->ws + WS_W;
    if (mask & 1) {
        const float* win = A->in[11] + (size_t)l * 1024 * 3592; const float* g = A->in[10] + l * 1024;
        for (int it = gw; it < 16 * 120; it += NGW) wt_item<true>(win, 1024, 3592, (bfu*)(wb + W_IN), g, scr, it, 120, lane);
        const float* wu = A->in[23] + (size_t)l * 64 * 256; const float* au = A->in[25] + (size_t)l * 64 * 256; const float* gu = A->in[26] + (size_t)l * 128 * 256;
        bfu* lr = (bfu*)(wb + W_LR);
        for (int i = gw * 64 + lane; i < 768 * 256; i += NGW * 64) { const int n = i >> 8, k = i & 255; float v = 0.f;
            if (n < 256) { if (k < 64) v = wu[k * 256 + n]; } else if (n < 512) { if (k >= 64 && k < 128) v = au[(k - 64) * 256 + (n - 256)]; } else { if (k >= 128) v = gu[(k - 128) * 256 + (n - 512)]; }
            lr[i] = (bfu)f2bf(v); }
    }
    if (mask & 2) {
        const float* wo = A->in[32] + (size_t)l * 1024 * 1024; const float* f1 = A->in[34] + (size_t)l * 1024 * 4096; const float* f2 = A->in[35] + (size_t)l * 4096 * 1024;
        const float* wg = A->in[37] + (size_t)l * 1024 * 1024; const float* wp = A->in[38] + (size_t)l * 256 * 1024;
        const float* gf = A->in[33] + l * 1024; const float* gp = A->in[36] + l * 1024;
        constexpr int I_O = 16 * 32, I_1 = 16 * 128, I_2 = 64 * 32, I_G = 16 * 32, I_P = 4 * 32;
        for (int it = gw; it < I_O + I_1 + I_2 + I_G + I_P; it += NGW) {
            int r = it;
            if (r < I_O) { wt_item<false>(wo, 1024, 1024, (bfu*)(wb + W_OUT), nullptr, scr, r, 32, lane); continue; } r -= I_O;
            if (r < I_1) { wt_item<false>(f1, 1024, 4096, (bfu*)(wb + W_FF1), gf, scr, r, 128, lane); continue; } r -= I_1;
            if (r < I_2) { wt_item<false>(f2, 4096, 1024, (bfu*)(wb + W_FF2), nullptr, scr, r, 32, lane); continue; } r -= I_2;
            if (r < I_G) { wt_item<false>(wg, 1024, 1024, (bfu*)(wb + W_GATE), gp, scr, r, 32, lane); continue; } r -= I_G;
            wt_item<false>(wp, 256, 1024, (bfu*)(wb + W_PP), nullptr, scr, r, 32, lane);
        }
    }
}
__device__ __forceinline__ void conv_p(KArgs A, int l, bfu* pb, int gtid, int NT) {
    const float* pp = A->in[8] + (size_t)l * MP * 256; const float* ps = A->in[9] + (size_t)l * MS * 256;
    for (int i = gtid; i < MR * 64; i += NT) { const int m = i >> 6, c = (i & 63) * 4;
        const f32x4 v = *(const f32x4*)(m < MP ? pp + (size_t)m * 256 + c : ps + (size_t)(m - MP) * 256 + c);
        v2u w; w.x = pk2(v[0], v[1]); w.y = pk2(v[2], v[3]); *(v2u*)(pb + (size_t)m * 256 + c) = w; }
}
__device__ __forceinline__ void prologue(KArgs A, LAS unsigned char* lds, int gw, int NGW, int lane, int wave, int gtid, int NT) {
    conv_weights(A, 0, 3, lds, gw, NGW, lane, wave);
    unsigned char* ws = A->ws;
    float* rs = (float*)(ws + WS_RS); bfu* xh = (bfu*)slotp(ws, 0, 0); float* H = A->out;
    for (int i = gtid; i < 6 * MPAD; i += NT) rs[MPAD + i] = 0.f;
    for (int g = gw; g < MPAD / 4; g += NGW) {
        const int m0 = 4 * g;
        if (m0 < MR) {
            f32x4 v[4][4];
#pragma unroll
            for (int i = 0; i < 4; ++i) { const int m = m0 + i; const float* xr = m < MP ? A->in[0] + (size_t)m * 1024 : A->in[1] + (size_t)(m - MP) * 1024;
#pragma unroll
                for (int j = 0; j < 4; ++j) v[i][j] = *(const f32x4*)(xr + j * 256 + lane * 4); }
#pragma unroll
            for (int i = 0; i < 4; ++i) { const int m = m0 + i; float ss = 0.f;
#pragma unroll
                for (int j = 0; j < 4; ++j) { const f32x4 w4 = v[i][j]; *(f32x4*)(H + (size_t)m * 1024 + j * 256 + lane * 4) = w4;
                    v2u w; w.x = pk2(w4[0], w4[1]); w.y = pk2(w4[2], w4[3]); *(v2u*)(xh + (size_t)m * 1024 + j * 256 + lane * 4) = w; ss += (w4[0] * w4[0] + w4[1] * w4[1]) + (w4[2] * w4[2] + w4[3] * w4[3]); }
                ss = wave_sum(ss); if (lane == 0) rs[m] = ss; }
        } else {
#pragma unroll
            for (int i = 0; i < 4; ++i) { const int m = m0 + i;
#pragma unroll
                for (int j = 0; j < 4; ++j) *(v2u*)(xh + (size_t)m * 1024 + j * 256 + lane * 4) = (v2u){0u, 0u};
                if (lane == 0) rs[m] = 1024.f; }
        }
    }
    float* rope = (float*)(ws + WS_ROPE);
    for (int i = gtid; i < 8192 * 32; i += NT) { const int pos = i >> 5, k = i & 31;
        const float inv = exp2f(-(float)k * (13.287712379549449f / 32.0f)); const float ang = (float)pos * inv;
        const float nn = rintf(ang * 0.15915494309189535f); const float fr = fmaf(-nn, 1.9353071795864769e-3f, fmaf(-nn, 6.28125f, ang));
        rope[pos * 64 + k] = __cosf(fr); rope[pos * 64 + 32 + k] = __sinf(fr); }
    if (gw == 0) {
        for (int l = 0; l < 2; ++l) {
            const float a = wave_sum(A->in[16][l * 64 + lane] * A->in[17][l * 64 + lane]), b = wave_sum(A->in[18][l * 64 + lane] * A->in[19][l * 64 + lane]);
            const float li = 0.8f - 0.6f * expf(-0.3f * (float)l);
            if (lane == 0) { float* lf = (float*)(ws + WS_CTL + 1024); lf[2 * l] = expf(a) - expf(b) + li; lf[2 * l + 1] = li; }
        }
    }
}

__device__ __forceinline__ void prep_a(KArgs A, int l, int gw, int NGW, int lane) {
    unsigned char* ws = A->ws;
    const bfu* aq = (const bfu*)slotp(ws, l, 2); const float* ab = (const float*)(ws + WS_AB);
    float* sia = (float*)slotp(ws, l, 9); bfu* va = (bfu*)slotp(ws, l, 11); bfu* zs = (bfu*)slotph(ws, l, 11); float* gab = (float*)(ws + WS_GAB);
    const float* cw = A->in[12] + l * 4 * 768; const float* stc = A->in[4] + (size_t)l * 8 * 3 * 768;
    const float* anorm = A->in[15] + l * 64;
    for (int g = gw; g < MR / 4; g += NGW) {
        const int m0 = 4 * g; int t0, L, sb = 0; const bool smp = m0 >= MP; float* aco;
        if (!smp) { t0 = m0 & 8191; L = 8192; aco = A->out + O_ACP + ((size_t)(l * 8 + (m0 >> 13)) * 3) * 768; }
        else { sb = (m0 - MP) >> 4; t0 = (m0 - MP) & 15; L = 16; aco = A->out + O_ACS + ((size_t)(l * 8 + sb) * 3) * 768; }
#pragma unroll 1
        for (int h = 0; h < 4; ++h) {
            float rows[3][7];
#pragma unroll
            for (int gi = 0; gi < 3; ++gi) { const int c = gi * 256 + h * 64 + lane;
#pragma unroll
                for (int r = 0; r < 7; ++r) { const int tt = t0 - 3 + r;
                    rows[gi][r] = tt >= 0 ? bf2f(aq[(size_t)(m0 - 3 + r) * 1024 + c]) : (smp ? stc[((size_t)sb * 3 + (3 + tt)) * 768 + c] : 0.f); } }
            float zv[4];
#pragma unroll
            for (int i = 0; i < 4; ++i) zv[i] = bf2f(aq[(size_t)(m0 + i) * 1024 + 768 + h * 64 + lane]);
            float val[4][3];
#pragma unroll
            for (int gi = 0; gi < 3; ++gi) { const int c = gi * 256 + h * 64 + lane; const float w0 = cw[c], w1 = cw[768 + c], w2 = cw[1536 + c], w3 = cw[2304 + c];
#pragma unroll
                for (int i = 0; i < 4; ++i) { const float y = rows[gi][i] * w0 + rows[gi][i + 1] * w1 + rows[gi][i + 2] * w2 + rows[gi][i + 3] * w3; val[i][gi] = y * sigm(y);
                    if (t0 + i >= L - 3) aco[(size_t)(t0 + i - (L - 3)) * 768 + c] = rows[gi][i + 3]; } }
#pragma unroll
            for (int i = 0; i < 4; ++i) { const int m = m0 + i;
                const float sq = wave_sum(val[i][0] * val[i][0]), sk = wave_sum(val[i][1] * val[i][1]);
                const float qn = val[i][0] * rsqrtf(sq + 1e-6f) * 0.125f, kn = val[i][1] * rsqrtf(sk + 1e-6f);
                float* rec = sia + ((size_t)(h * 8 + (lane >> 3)) * MPAD + m) * 16 + (lane & 7);
                rec[0] = kn; rec[8] = qn;
                va[(size_t)m * 256 + h * 64 + lane] = (bfu)f2bf(val[i][2]);
                zs[(size_t)m * 256 + h * 64 + lane] = (bfu)f2bf(zv[i] * sigm(zv[i]) * anorm[lane]); }
        }
        if (lane < 16) { const int m = m0 + (lane >> 2), hh = lane & 3;
            const float gl = -__expf(A->in[13][l * 4 + hh]) * softplusf(ab[(size_t)m * 8 + hh] + A->in[14][l * 4 + hh]);
            gab[((size_t)hh * MPAD + m) * 2] = __expf(gl); gab[((size_t)hh * MPAD + m) * 2 + 1] = sigm(ab[(size_t)m * 8 + 4 + hh]); }
    }
}
__device__ __forceinline__ void prep_c1(KArgs A, int l, int gw, int NGW, int lane) {
    unsigned char* ws = A->ws;
    const bfu* cr = (const bfu*)slotp(ws, l, 7); bfu* lra = (bfu*)slotp(ws, l, 12);
    const float* mu = A->in[21] + l * 1024; const float* sts = A->in[6] + (size_t)l * 8 * 1024;
    for (int g = gw; g < MR / 4; g += NGW) {
        const int m0 = 4 * g; int t0, L, sb = 0; const bool smp = m0 >= MP; float* cso;
        if (!smp) { t0 = m0 & 8191; L = 8192; cso = A->out + O_CSP + (size_t)(l * 8 + (m0 >> 13)) * 1024; }
        else { sb = (m0 - MP) >> 4; t0 = (m0 - MP) & 15; L = 16; cso = A->out + O_CSS + (size_t)(l * 8 + sb) * 1024; }
        float rows[4][5];
#pragma unroll
        for (int i = 0; i < 4; ++i) { const int j = 768 + lane + 64 * i;
            rows[i][0] = t0 > 0 ? bf2f(cr[(size_t)(m0 - 1) * 1024 + j]) : (smp ? sts[(size_t)sb * 1024 + j] : 0.f);
#pragma unroll
            for (int r = 0; r < 4; ++r) rows[i][r + 1] = bf2f(cr[(size_t)(m0 + r) * 1024 + j]); }
#pragma unroll
        for (int i = 0; i < 4; ++i) { const float muj = mu[768 + lane + 64 * i];
#pragma unroll
            for (int r = 0; r < 4; ++r) { const float cur = rows[i][r + 1], prev = rows[i][r]; const float c = cur + (prev - cur) * muj;
                const float o = i == 0 ? tanhf(c) : (i == 1 ? c : sigm(c));
                lra[(size_t)(m0 + r) * 256 + lane + 64 * i] = (bfu)f2bf(o); } }
        if (t0 + 3 == L - 1) {
#pragma unroll
            for (int i = 0; i < 16; ++i) cso[lane + 64 * i] = bf2f(cr[(size_t)(m0 + 3) * 1024 + lane + 64 * i]);
        }
    }
}
__device__ __forceinline__ void prep_c2(KArgs A, int l, int bid, int G, int tid) {
    unsigned char* ws = A->ws;
    const bfu* cr = (const bfu*)slotp(ws, l, 7); const bfu* lro = (const bfu*)slotp(ws, l, 13);
    bfu* v2 = (bfu*)slotp(ws, l, 12); bfu* gg = (bfu*)slotph(ws, l, 12);
    float* bonus = (float*)(ws + WS_BONUS); float* gch = (float*)(ws + WS_GCH); float* pairc = (float*)(ws + WS_PAIRC);
    const float* mu = A->in[21] + l * 1024; const float* sts = A->in[6] + (size_t)l * 8 * 1024;
    const int ch = tid & 255, h = ch >> 6, lane = ch & 63, half = tid >> 8;
    float* sic = (float*)slotp(ws, l, h) + ((size_t)(lane >> 3) * MPAD) * 32 + (lane & 7);
    const float mur = mu[ch], muk = mu[256 + ch], muv = mu[512 + ch];
    const float w0 = A->in[22][l * 256 + ch], a0 = A->in[24][l * 256 + ch], kk_ = A->in[27][l * 256 + ch], ka = A->in[28][l * 256 + ch], rk = A->in[29][l * 256 + ch];
    for (int u = bid * 2 + half; u < 1032; u += G * 2) {
        int m0, n; float pr, pk, pv;
        if (u < 1024) { m0 = u * 64; n = 64;
            if ((u & 127) == 0) { pr = pk = pv = 0.f; } else { pr = bf2f(cr[(size_t)(m0 - 1) * 1024 + ch]); pk = bf2f(cr[(size_t)(m0 - 1) * 1024 + 256 + ch]); pv = bf2f(cr[(size_t)(m0 - 1) * 1024 + 512 + ch]); } }
        else { const int sb = u - 1024; m0 = MP + sb * 16; n = 16; pr = sts[(size_t)sb * 1024 + ch]; pk = sts[(size_t)sb * 1024 + 256 + ch]; pv = sts[(size_t)sb * 1024 + 512 + ch]; }
        float cum = 0.f, pkka = 0.f, pkp = 0.f;
#pragma unroll 4
        for (int tt = 0; tt < n; ++tt) { const int m = m0 + tt;
            const float c_r = bf2f(cr[(size_t)m * 1024 + ch]), c_k = bf2f(cr[(size_t)m * 1024 + 256 + ch]), c_v = bf2f(cr[(size_t)m * 1024 + 512 + ch]);
            const float r = c_r + (pr - c_r) * mur, k = c_k + (pk - c_k) * muk, v = c_v + (pv - c_v) * muv; pr = c_r; pk = c_k; pv = c_v;
            const float lw = bf2f(lro[(size_t)m * 768 + ch]), la = bf2f(lro[(size_t)m * 768 + 256 + ch]); const bfu gb = lro[(size_t)m * 768 + 512 + ch];
            const float wl = -0.6065306597126334f * sigm(w0 + lw); const float a = sigm(a0 + la);
            const float kkr = k * kk_; const float kk = kkr * rsqrtf(wave_sum(kkr * kkr) + 1e-6f);
            const float kp = k * (1.f + (a - 1.f) * ka);
            const float Gp = __expf(cum); cum += wl; const float Gc = __expf(cum), iG = __expf(-cum);
            float* rec = sic + (size_t)m * 32;
            rec[0] = kk * Gp; rec[8] = kk * a * iG; rec[16] = kp * iG; rec[24] = r * Gc;
            { const float kka = kk * a; float* pc = pairc + ((size_t)h * (MPAD / 2) + (m >> 1)) * 4;
              if (tt & 1) { const float c22 = wave_sum(pkka * kk), c32 = wave_sum(pkp * kk); if (lane == 0) { pc[0] = c22; pc[1] = c32; } }
              else { const float c24 = wave_sum(kka * r), c34 = wave_sum(kp * r); if (lane == 0) { pc[2] = c24; pc[3] = c34; } }
              pkka = kka; pkp = kp; }
            const float bo = wave_sum(r * kp * rk); if (lane == 0) bonus[(size_t)h * MPAD + m] = bo;
            v2[(size_t)m * 256 + ch] = (bfu)f2bf(v); gg[(size_t)m * 256 + ch] = gb;
        }
        gch[((size_t)h * 1032 + u) * 64 + lane] = __expf(cum);
    }
}
__device__ __forceinline__ void prep_a2(KArgs A, int l, int gw, int NGW, int lane) {
    unsigned char* ws = A->ws; const float* sia = (const float*)slotp(ws, l, 9); float* paird = (float*)(ws + WS_PAIRD);
    for (int pr = gw; pr < MR / 2; pr += NGW) { const int m = 2 * pr;
        float k1[4], q1[4], k2[4];
#pragma unroll
        for (int h = 0; h < 4; ++h) { const float* rec = sia + ((size_t)(h * 8 + (lane >> 3)) * MPAD + m) * 16 + (lane & 7); k1[h] = rec[0]; q1[h] = rec[8]; k2[h] = rec[16]; }
#pragma unroll
        for (int h = 0; h < 4; ++h) { const float g12 = wave_sum(k1[h] * k2[h]), h11 = wave_sum(q1[h] * k1[h]);
            if (lane == 0) { paird[((size_t)h * (MPAD / 2) + pr) * 2] = g12; paird[((size_t)h * (MPAD / 2) + pr) * 2 + 1] = h11; } } }
}
__device__ __forceinline__ void post_attn(KArgs A, int l, int gw, int NGW, int lane) {
    unsigned char* ws = A->ws;
    const bfu* O = (const bfu*)slotp(ws, l, 13); bfu* mix = (bfu*)slotp(ws, l, 7);
    const float* lf = (const float*)(ws + WS_CTL + 1024); const float lam = lf[2 * l], omli = 1.f - lf[2 * l + 1];
    const int h = lane >> 4, e0 = (lane & 15) * 8; const float* bn = A->in[20] + l * 128 + e0;
    float bnv[8];
#pragma unroll
    for (int i = 0; i < 8; ++i) bnv[i] = bn[i] * omli;
    for (int g = gw; g < MP / 4; g += NGW) {
        v4u av[4], bv[4];
#pragma unroll
        for (int i = 0; i < 4; ++i) { const size_t m = (size_t)(4 * g + i);
            av[i] = *(const v4u*)(O + m * 1024 + (4 * h + (e0 >> 6)) * 64 + (e0 & 63)); bv[i] = *(const v4u*)(O + m * 1024 + (4 * h + 2 + (e0 >> 6)) * 64 + (e0 & 63)); }
#pragma unroll
        for (int i = 0; i < 4; ++i) { const size_t m = (size_t)(4 * g + i);
            float o[8]; float ss = 0.f;
#pragma unroll
            for (int q = 0; q < 4; ++q) { const unsigned aw = av[i][q], bw = bv[i][q];
                o[2 * q] = __uint_as_float(aw << 16) - lam * __uint_as_float(bw << 16); o[2 * q + 1] = __uint_as_float(aw & 0xffff0000u) - lam * __uint_as_float(bw & 0xffff0000u);
                ss += o[2 * q] * o[2 * q] + o[2 * q + 1] * o[2 * q + 1]; }
            ss += __shfl_xor(ss, 1); ss += __shfl_xor(ss, 2); ss += __shfl_xor(ss, 4); ss += __shfl_xor(ss, 8);
            const float rn = rsqrtf(ss * (1.f / 128.f) + 1e-6f);
            v4u w; w.x = pk2(o[0] * rn * bnv[0], o[1] * rn * bnv[1]); w.y = pk2(o[2] * rn * bnv[2], o[3] * rn * bnv[3]); w.z = pk2(o[4] * rn * bnv[4], o[5] * rn * bnv[5]); w.w = pk2(o[6] * rn * bnv[6], o[7] * rn * bnv[7]);
            *(v4u*)(mix + m * 1024 + 256 + h * 128 + e0) = w; }
    }
}
__device__ __forceinline__ void post_scan(KArgs A, int l, int gw, int NGW, int lane) {
    unsigned char* ws = A->ws; bfu* mix = (bfu*)slotp(ws, l, 7);
    const bfu* zs = (const bfu*)slotph(ws, l, 11); const bfu* v2 = (const bfu*)slotp(ws, l, 12); const bfu* gg = (const bfu*)slotph(ws, l, 12);
    const float* bonus = (const float*)(ws + WS_BONUS);
    float lw[4], lb[4];
#pragma unroll
    for (int h = 0; h < 4; ++h) { lw[h] = A->in[30][l * 256 + h * 64 + lane]; lb[h] = A->in[31][l * 256 + h * 64 + lane]; }
    for (int g = gw; g < MR / 2; g += NGW) {
        float o[2][4], y[2][4], z[2][4], vv[2][4], gv[2][4], bo[2][4];
#pragma unroll
        for (int i = 0; i < 2; ++i)
#pragma unroll
            for (int h = 0; h < 4; ++h) { const size_t m = (size_t)(2 * g + i);
                o[i][h] = bf2f(mix[m * 1024 + h * 64 + lane]); y[i][h] = bf2f(mix[m * 1024 + 768 + h * 64 + lane]);
                z[i][h] = bf2f(zs[m * 256 + h * 64 + lane]); vv[i][h] = bf2f(v2[m * 256 + h * 64 + lane]); gv[i][h] = bf2f(gg[m * 256 + h * 64 + lane]); bo[i][h] = bonus[(size_t)h * MPAD + m]; }
#pragma unroll
        for (int i = 0; i < 2; ++i)
#pragma unroll
            for (int h = 0; h < 4; ++h) { const size_t m = (size_t)(2 * g + i);
                const float ss = wave_sum(o[i][h] * o[i][h]) * (1.f / 64.f);
                mix[m * 1024 + h * 64 + lane] = (bfu)f2bf(o[i][h] * rsqrtf(ss + 1e-6f) * z[i][h]);
                const float mu = wave_sum(y[i][h]) * (1.f / 64.f); const float d = y[i][h] - mu; const float var = wave_sum(d * d) * (1.f / 64.f);
                const float cy = d * rsqrtf(var + 64e-5f) * lw[h] + lb[h];
                mix[m * 1024 + 768 + h * 64 + lane] = (bfu)f2bf((cy + bo[i][h] * vv[i][h]) * gv[i][h]); }
    }
}
__device__ __forceinline__ void final_norm(KArgs A, int gw, int NGW, int lane) {
    const float* rs = (const float*)(A->ws + WS_RS) + 6 * (size_t)MPAD; const float* g = A->in[39];
    f32x4 gv[4];
#pragma unroll
    for (int j = 0; j < 4; ++j) gv[j] = *(const f32x4*)(g + j * 256 + lane * 4);
    for (int q = gw; q < MR / 4; q += NGW) {
        f32x4 v[4][4]; float s[4];
#pragma unroll
        for (int i = 0; i < 4; ++i) { const size_t mm = (size_t)(4 * q + i); s[i] = rsqrtf(rs[mm] * (1.f / 1024.f) + 1e-6f);
#pragma unroll
            for (int j = 0; j < 4; ++j) v[i][j] = *(const f32x4*)(A->out + mm * 1024 + j * 256 + lane * 4); }
#pragma unroll
        for (int i = 0; i < 4; ++i) { const size_t mm = (size_t)(4 * q + i);
#pragma unroll
            for (int j = 0; j < 4; ++j) *(f32x4*)(A->out + mm * 1024 + j * 256 + lane * 4) = v[i][j] * s[i] * gv[j]; }
    }
}

#define SC_BAR() asm volatile("s_waitcnt lgkmcnt(0)\n\ts_barrier" ::: "memory")
constexpr int SC_RED = 0, SC_SI = 16384, SC_VBUF = 81920, SC_GBUF = 90112, SC_BON = 98304, SC_PC = 98816, SC_YP = 99328;
#define FMAC_DPP(acc, op, s1, J) asm("v_fmac_f32_dpp %0, %1, %2 row_newbcast:" #J " row_mask:0xf bank_mask:0xf" : "+v"(acc) : "v"(op), "v"(s1))
#define DOT8(a0, a1, op, JB0, JB1, JB2, JB3, JB4, JB5, JB6, JB7) do { FMAC_DPP(a0, op, S[0], JB0); FMAC_DPP(a1, op, S[1], JB1); FMAC_DPP(a0, op, S[2], JB2); FMAC_DPP(a1, op, S[3], JB3); \
        FMAC_DPP(a0, op, S[4], JB4); FMAC_DPP(a1, op, S[5], JB5); FMAC_DPP(a0, op, S[6], JB6); FMAC_DPP(a1, op, S[7], JB7); } while (0)
#define DOT8_LO(a0, a1, op) DOT8(a0, a1, op, 0, 1, 2, 3, 4, 5, 6, 7)
#define DOT8_HI(a0, a1, op) DOT8(a0, a1, op, 8, 9, 10, 11, 12, 13, 14, 15)
#define AXPY8_LO(op, s) do { FMAC_DPP(S[0], op, s, 0); FMAC_DPP(S[1], op, s, 1); FMAC_DPP(S[2], op, s, 2); FMAC_DPP(S[3], op, s, 3); FMAC_DPP(S[4], op, s, 4); FMAC_DPP(S[5], op, s, 5); FMAC_DPP(S[6], op, s, 6); FMAC_DPP(S[7], op, s, 7); } while (0)
#define AXPY8_HI(op, s) do { FMAC_DPP(S[0], op, s, 8); FMAC_DPP(S[1], op, s, 9); FMAC_DPP(S[2], op, s, 10); FMAC_DPP(S[3], op, s, 11); FMAC_DPP(S[4], op, s, 12); FMAC_DPP(S[5], op, s, 13); FMAC_DPP(S[6], op, s, 14); FMAC_DPP(S[7], op, s, 15); } while (0)
#define PKF(a, b, c) __builtin_elementwise_fma((a), (b), (c))
#define AXPYV(X0, X1, s) do { const f32x2 s_ = (f32x2){(s), (s)}; f32x2 p0_ = (f32x2){S[0], S[1]}, p1_ = (f32x2){S[2], S[3]}, p2_ = (f32x2){S[4], S[5]}, p3_ = (f32x2){S[6], S[7]}; \
        p0_ = PKF(((f32x2){X0[0], X0[1]}), s_, p0_); p1_ = PKF(((f32x2){X0[2], X0[3]}), s_, p1_); p2_ = PKF(((f32x2){X1[0], X1[1]}), s_, p2_); p3_ = PKF(((f32x2){X1[2], X1[3]}), s_, p3_); \
        S[0] = p0_[0]; S[1] = p0_[1]; S[2] = p1_[0]; S[3] = p1_[1]; S[4] = p2_[0]; S[5] = p2_[1]; S[6] = p3_[0]; S[7] = p3_[1]; } while (0)
#define RED8(V) do { const LAS f32x4* rr_ = (const LAS f32x4*)red + par_ * 512 + lane; const f32x4 q0_ = rr_[0], q1_ = rr_[64], q2_ = rr_[128], q3_ = rr_[192], q4_ = rr_[256], q5_ = rr_[320], q6_ = rr_[384], q7_ = rr_[448]; \
        V = ((q0_ + q1_) + (q2_ + q3_)) + ((q4_ + q5_) + (q6_ + q7_)); } while (0)

#define SWAPSUM(v) do { const unsigned u_ = __float_as_uint(v); auto rr_ = __builtin_amdgcn_permlane32_swap(u_, u_, false, false); v = __uint_as_float(rr_[0]) + __uint_as_float(rr_[1]); } while (0)
#define DOT4_LO(a0, a1, op) do { FMAC_DPP(a0, op, S[0], 0); FMAC_DPP(a1, op, S[1], 1); FMAC_DPP(a0, op, S[2], 2); FMAC_DPP(a1, op, S[3], 3); } while (0)
#define DOT4_HI(a0, a1, op) do { FMAC_DPP(a0, op, S[0], 4); FMAC_DPP(a1, op, S[1], 5); FMAC_DPP(a0, op, S[2], 6); FMAC_DPP(a1, op, S[3], 7); } while (0)
#define AXPY4(X, s) do { const f32x2 s_ = (f32x2){(s), (s)}; f32x2 p0_ = (f32x2){S[0], S[1]}, p1_ = (f32x2){S[2], S[3]}; p0_ = PKF(((f32x2){X[0], X[1]}), s_, p0_); p1_ = PKF(((f32x2){X[2], X[3]}), s_, p1_); S[0] = p0_[0]; S[1] = p0_[1]; S[2] = p1_[0]; S[3] = p1_[1]; } while (0)
__device__ __forceinline__ void scan_rwkv(KArgs A, int l, LAS unsigned char* lds, int h, int half, int m0, int L, int BL, int BLS, int chunk0, const float* st_in, float* st_out, int tid) {
    unsigned char* ws = A->ws;
    const int lane = tid & 63, wid = __builtin_amdgcn_readfirstlane(tid >> 6); const int kh = lane >> 5, r = lane & 31, row = 32 * half + r;
    LAS float* red = (LAS float*)(lds + SC_RED); LAS float* yred = (LAS float*)(lds + SC_YP);
    LAS float* sib = (LAS float*)(lds + SC_SI) + wid * 1024;
    LAS bfu* vbuf = (LAS bfu*)(lds + SC_VBUF); LAS float* pcs = (LAS float*)(lds + SC_PC);
    const bfu* v2 = (const bfu*)slotp(ws, l, 12);
    const float* pairc = (const float*)(ws + WS_PAIRC) + ((size_t)h * (MPAD / 2) + (m0 >> 1)) * 4;
    const float* gch = (const float*)(ws + WS_GCH) + ((size_t)h * 1032 + chunk0) * 64 + 8 * wid + 4 * kh;
    bfu* mix = (bfu*)slotp(ws, l, 7);
    const float* P = (const float*)slotp(ws, l, h) + ((size_t)wid * MPAD + m0) * 32;
    float S[4];
#pragma unroll
    for (int j = 0; j < 4; ++j) S[j] = st_in ? st_in[row * 64 + 8 * wid + 4 * kh + j] : 0.f;
    const int nblk = L >> BLS; const int srow = tid >> 4, sc4 = tid & 15; const bool sval = srow < BL;
    const int nsi = BL >> 3;
    f32x4 ssi[4]; v2u sv = {0, 0}; float sp_ = 0.f;
#define RW_STAGE(c) do { const float* ps_ = P + (size_t)(c) * BL * 32 + lane * 4; \
        _Pragma("unroll") for (int i_ = 0; i_ < 4; ++i_) if (i_ < nsi) ssi[i_] = *(const f32x4*)(ps_ + i_ * 256); \
        if (sval) { const size_t mm = (size_t)(m0 + (c) * BL + srow) * 256 + h * 64 + sc4 * 4; sv = *(const v2u*)(v2 + mm); } \
        if (tid < 2 * BL) sp_ = pairc[(size_t)(c) * BL * 2 + tid]; } while (0)
#define RW_COMMIT(c) do { LAS float* pd_ = sib + ((c) & 1) * 8192 + lane * 4; \
        _Pragma("unroll") for (int i_ = 0; i_ < 4; ++i_) if (i_ < nsi) *(LAS f32x4*)(pd_ + i_ * 256) = ssi[i_]; \
        if (sval) { *(LAS v2u*)(vbuf + ((c) & 1) * 2048 + srow * 64 + sc4 * 4) = sv; } \
        if (tid < 2 * BL) pcs[((c) & 1) * 64 + tid] = sp_; } while (0)
    __syncthreads();
    RW_STAGE(0); RW_COMMIT(0); if (nblk > 1) RW_STAGE(1);
    const int dsel = ((lane & 4) ? 24 : 0) + 4 * kh + (lane & 3);
    float ca0, ca1, cb0 = 0.f, cb1 = 0.f; f32x4 cau[4], cbu[4];
#define RW_LOADOPS(D, T) do { const LAS float* pb_ = sib + ((((T) >> BLS) & 1) * 8192) + ((T) & (BL - 1)) * 32; \
        D##0 = pb_[dsel]; D##1 = pb_[32 + dsel]; const LAS f32x4* pu_ = (const LAS f32x4*)(pb_ + 4 * kh); \
        D##u[0] = pu_[2]; D##u[1] = pu_[4]; D##u[2] = pu_[10]; D##u[3] = pu_[12]; } while (0)
    RW_LOADOPS(ca, 0);
#define RW_FINAL(T) do { const int tf_ = (T); \
        const LAS float* yr_ = yred + (tf_ & 15) * 512 + lane; const float y_ = ((yr_[0] + yr_[64]) + (yr_[128] + yr_[192])) + ((yr_[256] + yr_[320]) + (yr_[384] + yr_[448])); \
        if (lane < 32) mix[(size_t)(m0 + tf_) * 1024 + 768 + h * 64 + row] = (bfu)f2bf(y_); } while (0)
#define RW_ROUND(C, N, T) do { const int par_ = ((T) >> 1) & 1; \
        float d1a = 0.f, d1b = 0.f, d2a = 0.f, d2b = 0.f, f1a = 0.f, f1b = 0.f; \
        DOT4_LO(d1a, d1b, C##0); DOT4_LO(d2a, d2b, C##1); DOT4_HI(f1a, f1b, C##0); \
        float d1 = d1a + d1b, d2 = d2a + d2b, f1 = f1a + f1b; SWAPSUM(d1); SWAPSUM(d2); SWAPSUM(f1); \
        ((LAS f32x4*)red)[(par_ * 8 + wid) * 64 + lane] = (f32x4){d1, d2, f1, 0.f}; \
        SC_BAR(); \
        f32x4 tot_; RED8(tot_); \
        const int bo_ = (((T) >> BLS) & 1), to_ = (T) & (BL - 1); \
        const float v1 = bf2f(vbuf[bo_ * 2048 + to_ * 64 + row]), v2_ = bf2f(vbuf[bo_ * 2048 + to_ * 64 + 64 + row]); const f32x4 pc_ = *(const LAS f32x4*)(pcs + bo_ * 64 + to_ * 2); \
        asm volatile("" ::: "memory"); \
        if ((T) + 2 < L) RW_LOADOPS(N, (T) + 2); \
        __builtin_amdgcn_sched_barrier(0); \
        const float sa1 = -tot_[0]; const float sa2 = -(tot_[1] + sa1 * pc_[0] + v1 * pc_[1]); const float y1 = tot_[2] + sa1 * pc_[2] + v1 * pc_[3]; \
        AXPY4(C##u[1], v1); AXPY4(C##u[0], sa1); AXPY4(C##u[3], v2_); AXPY4(C##u[2], sa2); \
        float y2a = 0.f, y2b = 0.f; DOT4_HI(y2a, y2b, C##1); float y2 = y2a + y2b; SWAPSUM(y2); \
        yred[((T) & 15) * 512 + wid * 64 + lane] = y1 * 0.125f; yred[(((T) + 1) & 15) * 512 + wid * 64 + lane] = y2; } while (0)
    for (int c = 0; c < nblk; ++c) {
        for (int tt = 0; tt < BL; tt += 4) {
            const int t = c * BL + tt;
            if (tt == (BL >> 1) && c + 1 < nblk) { RW_COMMIT(c + 1); if (c + 2 < nblk) RW_STAGE(c + 2); }
            RW_ROUND(ca, cb, t);
            RW_ROUND(cb, ca, t + 2);
            if (((t + 3) & 15) == 15) { SC_BAR(); RW_FINAL(t - 12 + 2 * wid); RW_FINAL(t - 11 + 2 * wid); }
        }
        if ((((c + 1) << BLS) & 63) == 0 || c + 1 == nblk) {
            const float* ge = gch + (size_t)((c << BLS) >> 6) * 64;
#pragma unroll
            for (int j = 0; j < 4; ++j) S[j] *= ge[j];
        }
    }
#pragma unroll
    for (int j = 0; j < 4; ++j) st_out[row * 64 + 8 * wid + 4 * kh + j] = S[j];
    __syncthreads();
#undef RW_STAGE
#undef RW_COMMIT
#undef RW_LOADOPS
#undef RW_FINAL
#undef RW_ROUND
}

__device__ __forceinline__ void scan_delta(KArgs A, int l, LAS unsigned char* lds, int h, int half, int m0, int L, int BL, int BLS, const float* st_in, float* st_out, int tid) {
    unsigned char* ws = A->ws;
    const int lane = tid & 63, wid = __builtin_amdgcn_readfirstlane(tid >> 6); const int kh = lane >> 5, r = lane & 31, row = 32 * half + r;
    LAS float* red = (LAS float*)(lds + SC_RED); LAS float* yred = (LAS float*)(lds + SC_YP);
    LAS float* sib = (LAS float*)(lds + SC_SI) + wid * 512;
    LAS bfu* vbuf = (LAS bfu*)(lds + SC_VBUF); LAS float* gab = (LAS float*)(lds + SC_BON); LAS float* pds = (LAS float*)(lds + SC_PC);
    const bfu* va = (const bfu*)slotp(ws, l, 11);
    bfu* mix = (bfu*)slotp(ws, l, 7);
    const float* P = (const float*)slotp(ws, l, 9) + ((size_t)(h * 8 + wid) * MPAD + m0) * 16;
    const float* PG = (const float*)(ws + WS_GAB) + ((size_t)h * MPAD + m0) * 2;
    const float* paird = (const float*)(ws + WS_PAIRD) + ((size_t)h * (MPAD / 2) + (m0 >> 1)) * 2;
    float S[4];
#pragma unroll
    for (int j = 0; j < 4; ++j) S[j] = st_in ? st_in[(8 * wid + 4 * kh + j) * 64 + row] : 0.f;
    const int nblk = L >> BLS; const int srow = tid >> 4, sc4 = tid & 15; const bool sval = srow < BL;
    const int nsi = BL >> 4;
    f32x4 ssi[2]; v2u sv = {0, 0}; float sb_ = 0.f, sp_ = 0.f;
#define DL_STAGE(c) do { const float* ps_ = P + (size_t)(c) * BL * 16 + lane * 4; \
        _Pragma("unroll") for (int i_ = 0; i_ < 2; ++i_) if (i_ < nsi) ssi[i_] = *(const f32x4*)(ps_ + i_ * 256); \
        if (sval) { const size_t mm = (size_t)(m0 + (c) * BL + srow) * 256 + h * 64 + sc4 * 4; sv = *(const v2u*)(va + mm); } \
        if (tid < 2 * BL) sb_ = PG[(size_t)(c) * BL * 2 + tid]; if (tid < BL) sp_ = paird[(size_t)(c) * BL + tid]; } while (0)
#define DL_COMMIT(c) do { LAS float* pd_ = sib + ((c) & 1) * 4096 + lane * 4; \
        _Pragma("unroll") for (int i_ = 0; i_ < 2; ++i_) if (i_ < nsi) *(LAS f32x4*)(pd_ + i_ * 256) = ssi[i_]; \
        if (sval) { *(LAS v2u*)(vbuf + ((c) & 1) * 2048 + srow * 64 + sc4 * 4) = sv; } \
        if (tid < 2 * BL) gab[((c) & 1) * 64 + tid] = sb_; if (tid < BL) pds[((c) & 1) * 32 + tid] = sp_; } while (0)
    __syncthreads();
    DL_STAGE(0); DL_COMMIT(0); if (nblk > 1) DL_STAGE(1);
    const int dsel = ((lane & 4) ? 8 : 0) + 4 * kh + (lane & 3);
    float ca0, ca1, cb0 = 0.f, cb1 = 0.f; f32x4 cau[2], cbu[2];
#define DL_LOADOPS(D, T) do { const LAS float* pb_ = sib + ((((T) >> BLS) & 1) * 4096) + ((T) & (BL - 1)) * 16; D##0 = pb_[dsel]; D##1 = pb_[16 + dsel]; \
        const LAS f32x4* pu_ = (const LAS f32x4*)(pb_ + 4 * kh); D##u[0] = pu_[0]; D##u[1] = pu_[4]; } while (0)
    DL_LOADOPS(ca, 0);
#define DL_FINAL(T) do { const int tf_ = (T); \
        const LAS float* yr_ = yred + (tf_ & 15) * 512 + lane; const float o_ = ((yr_[0] + yr_[64]) + (yr_[128] + yr_[192])) + ((yr_[256] + yr_[320]) + (yr_[384] + yr_[448])); \
        if (lane < 32) mix[(size_t)(m0 + tf_) * 1024 + h * 64 + row] = (bfu)f2bf(o_); } while (0)
#define DL_ROUND(C, N, T) do { const int par_ = ((T) >> 1) & 1; \
        float d1a = 0.f, d1b = 0.f, d2a = 0.f, d2b = 0.f, f1a = 0.f, f1b = 0.f; \
        DOT4_LO(d1a, d1b, C##0); DOT4_LO(d2a, d2b, C##1); DOT4_HI(f1a, f1b, C##0); \
        float d1 = d1a + d1b, d2 = d2a + d2b, f1 = f1a + f1b; SWAPSUM(d1); SWAPSUM(d2); SWAPSUM(f1); \
        ((LAS f32x4*)red)[(par_ * 8 + wid) * 64 + lane] = (f32x4){d1, d2, f1, 0.f}; \
        SC_BAR(); \
        f32x4 tot_; RED8(tot_); \
        const int bo_ = (((T) >> BLS) & 1), to_ = (T) & (BL - 1); \
        const float v1 = bf2f(vbuf[bo_ * 2048 + to_ * 64 + row]), v2_ = bf2f(vbuf[bo_ * 2048 + to_ * 64 + 64 + row]); \
        const f32x4 ab_ = *(const LAS f32x4*)(gab + bo_ * 64 + to_ * 2); const f32x2 pd2_ = *(const LAS f32x2*)(pds + bo_ * 32 + to_); \
        asm volatile("" ::: "memory"); \
        if ((T) + 2 < L) DL_LOADOPS(N, (T) + 2); \
        __builtin_amdgcn_sched_barrier(0); \
        const float a1 = ab_[0], a2 = ab_[2]; const float dl1 = ab_[1] * (v1 - a1 * tot_[0]); const float dl2 = ab_[3] * (v2_ - a2 * (a1 * tot_[1] + pd2_[0] * dl1)); \
        const float o1 = a1 * tot_[2] + pd2_[1] * dl1; const float a12 = a1 * a2, dl1s = a2 * dl1; \
        _Pragma("unroll") for (int j = 0; j < 4; ++j) S[j] *= a12; \
        AXPY4(C##u[0], dl1s); AXPY4(C##u[1], dl2); \
        float y2a = 0.f, y2b = 0.f; DOT4_HI(y2a, y2b, C##1); float y2 = y2a + y2b; SWAPSUM(y2); \
        yred[((T) & 15) * 512 + wid * 64 + lane] = o1 * 0.125f; yred[(((T) + 1) & 15) * 512 + wid * 64 + lane] = y2; } while (0)
    for (int c = 0; c < nblk; ++c) {
        for (int tt = 0; tt < BL; tt += 4) {
            const int t = c * BL + tt;
            if (tt == (BL >> 1) && c + 1 < nblk) { DL_COMMIT(c + 1); if (c + 2 < nblk) DL_STAGE(c + 2); }
            DL_ROUND(ca, cb, t);
            DL_ROUND(cb, ca, t + 2);
            if (((t + 3) & 15) == 15) { SC_BAR(); DL_FINAL(t - 12 + 2 * wid); DL_FINAL(t - 11 + 2 * wid); }
        }
    }
#pragma unroll
    for (int j = 0; j < 4; ++j) st_out[(8 * wid + 4 * kh + j) * 64 + row] = S[j];
    __syncthreads();
#undef DL_STAGE
#undef DL_COMMIT
#undef DL_LOADOPS
#undef DL_FINAL
#undef DL_ROUND
}

__device__ __forceinline__ void sample_attn(KArgs A, int l, LAS unsigned char* lds, int unit, int tid) {
    unsigned char* ws = A->ws;
    const int sb = unit >> 2, h = unit & 3;
    LAS float* qs = (LAS float*)lds;
    LAS float* sc = qs + 2048;
    LAS float* scl = sc + 1024;
    LAS float* ssq = scl + 32;
    LAS float* lsum = ssq + 512;
    const bfu* qb = (const bfu*)slotp(ws, l, 4); bfu* mix = (bfu*)slotp(ws, l, 7);
    const float* ck = A->in[2] + (size_t)(l * 8 + sb) * 2048 * 512 + h * 128; const float* cv = A->in[3] + (size_t)(l * 8 + sb) * 2048 * 512 + h * 128;
    const float* nk = A->out + O_BKS + (size_t)(l * 8 + sb) * 16 * 512 + h * 128; const float* nv = A->out + O_BVS + (size_t)(l * 8 + sb) * 16 * 512 + h * 128;
    const float* lf = (const float*)(ws + WS_CTL + 1024); const float lam = lf[2 * l], omli = 1.f - lf[2 * l + 1];
    __syncthreads();
    for (int i = tid; i < 2048; i += NTHR) { const int map = i >> 10, qi = (i >> 6) & 15, p = i & 63; const int s = p >> 5, fq_ = (p >> 3) & 3, n_ = (p >> 2) & 1, j_ = p & 3;
        qs[(map * 16 + qi) * 64 + n_ * 32 + s * 16 + 4 * fq_ + j_] = bf2f(qb[(size_t)(MP + sb * 16 + qi) * 512 + h * 128 + map * 64 + p]); }
    float mrun = -1e30f, lrun = 0.f;
    const int qi = tid & 15, kj = tid >> 4, eg = tid >> 4;
    f32x4 acc0 = {0.f, 0.f, 0.f, 0.f}, acc1 = {0.f, 0.f, 0.f, 0.f};
    __syncthreads();
    for (int tile = 0; tile < 65; ++tile) {
        const int kidx = tile * 32 + kj;
        float s1 = -1e30f, s2 = -1e30f;
        if (kidx < 2064) { const float* kr = kidx < 2048 ? ck + (size_t)kidx * 512 : nk + (size_t)(kidx - 2048) * 512; s1 = 0.f; s2 = 0.f;
#pragma unroll 4
            for (int d = 0; d < 64; d += 4) { const f32x4 k1 = *(const f32x4*)(kr + d), k2 = *(const f32x4*)(kr + 64 + d); const LAS float* q1 = qs + qi * 64 + d; const LAS float* q2 = qs + (16 + qi) * 64 + d;
                s1 += q1[0] * k1[0] + q1[1] * k1[1] + q1[2] * k1[2] + q1[3] * k1[3]; s2 += q2[0] * k2[0] + q2[1] * k2[1] + q2[2] * k2[2] + q2[3] * k2[3]; } }
        sc[qi * 32 + kj] = s1; sc[(16 + qi) * 32 + kj] = s2;
        __syncthreads();
        if (tid < 32) { LAS float* r = sc + tid * 32; float mx = mrun;
#pragma unroll 8
            for (int j = 0; j < 32; ++j) mx = fmaxf(mx, r[j]);
            const float f = exp2f(mrun - mx); float su = 0.f;
#pragma unroll 8
            for (int j = 0; j < 32; ++j) { const float p = exp2f(r[j] - mx); r[j] = p; su += p; }
            lrun = lrun * f + su; mrun = mx; scl[tid] = f; }
        __syncthreads();
        { const float f0 = scl[qi], f1 = scl[16 + qi]; acc0 = acc0 * f0; acc1 = acc1 * f1;
            const int nk_ = tile < 64 ? 32 : 16;
            for (int j = 0; j < nk_; ++j) { const int kx = tile * 32 + j; const float* vr = (kx < 2048 ? cv + (size_t)kx * 512 : nv + (size_t)(kx - 2048) * 512) + eg * 4;
                const f32x4 v = *(const f32x4*)vr; acc0 = acc0 + v * sc[qi * 32 + j]; acc1 = acc1 + v * sc[(16 + qi) * 32 + j]; } }
        __syncthreads();
    }
    if (tid < 32) lsum[tid] = lrun;
    __syncthreads();
    const f32x4 o = acc0 * (1.f / lsum[qi]) - acc1 * (lam / lsum[16 + qi]);
    ssq[qi * 32 + eg] = (o[0] * o[0] + o[1] * o[1]) + (o[2] * o[2] + o[3] * o[3]);
    __syncthreads();
    float ss = 0.f;
#pragma unroll 8
    for (int j = 0; j < 32; ++j) ss += ssq[qi * 32 + j];
    const float rn = rsqrtf(ss * (1.f / 128.f) + 1e-6f) * omli; const float* bn = A->in[20] + l * 128 + eg * 4;
    v2u w; w.x = pk2(o[0] * rn * bn[0], o[1] * rn * bn[1]); w.y = pk2(o[2] * rn * bn[2], o[3] * rn * bn[3]);
    *(v2u*)(mix + (size_t)(MP + sb * 16 + qi) * 1024 + 256 + h * 128 + eg * 4) = w;
    __syncthreads();
}

#define PH_BEGIN \
        KArgs A = (KArgs)__builtin_amdgcn_kernarg_segment_ptr(); \
        int tid = wv * 64 + (int)__builtin_amdgcn_mbcnt_hi(~0u, __builtin_amdgcn_mbcnt_lo(~0u, 0u)); asm volatile("" : "+v"(tid)); tid &= 511; \
        const int bid = blockIdx.x, G = gridDim.x; \
        const int lane = tid & 63, wave = wv; \
        const int gw = bid * NWAVES + wave, NGW = G * NWAVES, gtid = bid * NTHR + tid, NT = G * NTHR; \
        unsigned char* ws = A->ws; float* rsb = (float*)(ws + WS_RS); unsigned char* wb = ws + WS_W; \
        (void)lane; (void)gw; (void)NGW; (void)gtid; (void)NT; (void)rsb; (void)wb;
#define IN(k) (lo <= (k) && (k) < hi)
__device__ __forceinline__ void grid_bar(unsigned* bar, unsigned target, bool leader) {
    asm volatile("s_waitcnt vmcnt(0) lgkmcnt(0)" ::: "memory");
    __syncthreads();
    if (leader) {
        __builtin_amdgcn_fence(__ATOMIC_RELEASE, "agent");
        asm volatile("s_waitcnt vmcnt(0)" ::: "memory");
        __hip_atomic_fetch_add(bar, 1u, __ATOMIC_RELAXED, __HIP_MEMORY_SCOPE_AGENT);
        unsigned spins = 0;
        while (__hip_atomic_load(bar, __ATOMIC_RELAXED, __HIP_MEMORY_SCOPE_AGENT) < target) { __builtin_amdgcn_s_sleep(2); if (++spins > (1u << 27)) break; }
        __builtin_amdgcn_fence(__ATOMIC_ACQUIRE, "agent");
        asm volatile("s_waitcnt vmcnt(0)" ::: "memory");
    }
    __syncthreads();
}
#define SEAM(k) do { if ((k) + 1 < hi) { ++nbar; grid_bar((unsigned*)(ws + WS_CTL + 4096), nbar * (unsigned)G, tid == 0); } } while (0)
#define SEAM_SKIP(k) do { } while (0)
__global__ void __launch_bounds__(NTHR, 2) hybrid_fwd(Args Aval) {
    extern __shared__ __attribute__((aligned(16))) unsigned char lds_raw[];
    LAS unsigned char* lds = (LAS unsigned char*)lds_raw;
    const int lo = Aval.ph_lo, hi = Aval.ph_hi; unsigned nbar = 0u;
    if (Aval.ph_lo < 0) cg::this_grid().sync();
    const int wv = __builtin_amdgcn_readfirstlane(threadIdx.x >> 6);
    if (IN(0)) { PH_BEGIN prologue(A, lds, gw, NGW, lane, wave, gtid, NT); SEAM(0); }
    { constexpr int l = 0;

        const int p0 = 1 + 11 * l;
        if (IN(p0 + 0)) { PH_BEGIN
            pg8::Gemm g{(const pg8::bf16_t*)slotp(ws, l, 0), (const pg8::bf16_t*)(wb + W_IN), MPAD, NIN, 1024};
            pg8::StaticOrder S; S.init(MPAD, NIN, G, bid);
            EpiG1 E{rsb + (size_t)(3 * l) * MPAD, (bfu*)slotp(ws, l, 2), (bfu*)slotp(ws, l, 4), (bfu*)slotp(ws, l, 5), (bfu*)slotp(ws, l, 6), (bfu*)slotp(ws, l, 7), (float*)(ws + WS_AB), (const float*)(ws + WS_ROPE),
                    A->out + O_BKP + (size_t)l * MP * 512, A->out + O_BVP + (size_t)l * MP * 512, A->out + O_BKS + (size_t)l * MS * 512, A->out + O_BVS + (size_t)l * MS * 512};
            pg8::gemm_phase<EpiG1, pg8::StaticOrder, true, true>((PG8_LAS unsigned char*)lds, g, S, E, wv);
            SEAM(p0 + 0); }
        if (IN(p0 + 1)) { PH_BEGIN
            prep_a(A, l, gw, NGW, lane); prep_c1(A, l, gw, NGW, lane);
            if (l == 1) conv_weights(A, 1, 2, lds, gw, NGW, lane, wave);
            SEAM(p0 + 1); }
        if (IN(p0 + 2)) { PH_BEGIN
            pg8::Gemm g{(const pg8::bf16_t*)slotp(ws, l, 12), (const pg8::bf16_t*)(wb + W_LR), MPAD, 768, 256};
            pg8::StaticOrder S; S.init(MPAD, 768, G, bid);
            EpiB<0> E{(bfu*)slotp(ws, l, 13), 768, nullptr};
            pg8::gemm_phase<EpiB<0>, pg8::StaticOrder, true, true>((PG8_LAS unsigned char*)lds, g, S, E, wv);
            SEAM(p0 + 2); }
        if (IN(p0 + 3)) { PH_BEGIN prep_c2(A, l, bid, G, tid); prep_a2(A, l, gw, NGW, lane);
            SEAM(p0 + 3); }
        if (IN(p0 + 4)) { PH_BEGIN
            if (bid < 64) { const int st = bid >> 1, half = bid & 1, b = st >> 2, h = st & 3;
                scan_rwkv(A, l, lds, h, half, b * 8192, 8192, 32, 5, b * 128, nullptr, A->out + O_CWP + (size_t)((l * 8 + b) * 4 + h) * 4096, tid);
                scan_rwkv(A, l, lds, h, half, MP + b * 16, 16, 16, 4, 1024 + b, A->in[7] + (size_t)((l * 8 + b) * 4 + h) * 4096, A->out + O_CWS + (size_t)((l * 8 + b) * 4 + h) * 4096, tid);
            } else if (bid < 128) { const int st = (bid - 64) >> 1, half = bid & 1, b = st >> 2, h = st & 3;
                scan_delta(A, l, lds, h, half, b * 8192, 8192, 32, 5, nullptr, A->out + O_ADP + (size_t)((l * 8 + b) * 4 + h) * 4096, tid);
                scan_delta(A, l, lds, h, half, MP + b * 16, 16, 16, 4, A->in[5] + (size_t)((l * 8 + b) * 4 + h) * 4096, A->out + O_ADS + (size_t)((l * 8 + b) * 4 + h) * 4096, tid);
            } else if (bid < 160) { sample_attn(A, l, lds, bid - 128, tid); }
            __syncthreads();
            unsigned* ctr = (unsigned*)(ws + WS_CTL) + 16 * l; volatile LAS unsigned* qw = (volatile LAS unsigned*)(lds + MISC_OFF);
            const attn_body::bf16* Q = (const attn_body::bf16*)slotp(ws, l, 4); const attn_body::bf16* K = (const attn_body::bf16*)slotp(ws, l, 5); const attn_body::bf16* V = (const attn_body::bf16*)slotp(ws, l, 6);
            attn_body::bf16* O = (attn_body::bf16*)slotp(ws, l, 13);
            for (;;) {
                if (tid == 0) qw[0] = atomicAdd(ctr, 1u);
                __syncthreads();
                const unsigned u = qw[0];
                __syncthreads();
                if (u >= 4096u) break;
                const int qb = 31 - (int)(u >> 7), bh = (int)(u & 127);
                attn_body::attn_unit<8>(bh >> 4, bh & 15, qb, Q, K, V, O, (char*)lds_raw, wv);
            }
            SEAM(p0 + 4); }
        if (IN(p0 + 5)) { PH_BEGIN
            post_attn(A, l, gw, NGW, lane); post_scan(A, l, gw, NGW, lane);
            conv_p(A, l, (bfu*)slotp(ws, l, 10), gtid, NT);
            if (l == 0) conv_weights(A, 1, 1, lds, gw, NGW, lane, wave);
            SEAM(p0 + 5); }
        if (IN(p0 + 6)) { PH_BEGIN
            pg8::Gemm g{(const pg8::bf16_t*)slotp(ws, l, 7), (const pg8::bf16_t*)(wb + W_OUT), MPAD, 1024, 1024};
            pg8::StaticOrder S; S.init(MPAD, 1024, G, bid);
            EpiH<2> E{A->out, (bfu*)slotp(ws, l, 0), rsb + (size_t)(3 * l + 1) * MPAD, nullptr, nullptr};
            pg8::gemm_phase<EpiH<2>, pg8::StaticOrder, true, true>((PG8_LAS unsigned char*)lds, g, S, E, wv);
            SEAM(p0 + 6); }
        if (IN(p0 + 7)) { PH_BEGIN
            pg8::Gemm g{(const pg8::bf16_t*)slotp(ws, l, 0), (const pg8::bf16_t*)(wb + W_FF1), MPAD, FFD, 1024};
            pg8::StaticOrder S; S.init(MPAD, FFD, G, bid);
            EpiB<1> E{(bfu*)slotp(ws, l, 2), FFD, rsb + (size_t)(3 * l + 1) * MPAD};
            pg8::gemm_phase<EpiB<1>, pg8::StaticOrder, true, true>((PG8_LAS unsigned char*)lds, g, S, E, wv);
            {
                pg8::Gemm g2{(const pg8::bf16_t*)slotp(ws, l, 10), (const pg8::bf16_t*)(wb + W_PP), MPAD, 1024, 256};
                pg8::StaticOrder S2; S2.init(MPAD, 1024, G, bid);
                EpiB<0> E2{(bfu*)slotp(ws, l, 11), 1024, nullptr};
                pg8::gemm_phase<EpiB<0>, pg8::StaticOrder, true, true>((PG8_LAS unsigned char*)lds, g2, S2, E2, wv); }
            SEAM(p0 + 7); }
        if (IN(p0 + 8)) { PH_BEGIN
            pg8::Gemm g{(const pg8::bf16_t*)slotp(ws, l, 2), (const pg8::bf16_t*)(wb + W_FF2), MPAD, 1024, FFD};
            pg8::StaticOrder S; S.init(MPAD, 1024, G, bid);
            EpiH<2> E{A->out, (bfu*)slotp(ws, l, 0), rsb + (size_t)(3 * l + 2) * MPAD, nullptr, nullptr};
            pg8::gemm_phase<EpiH<2>, pg8::StaticOrder, true, true>((PG8_LAS unsigned char*)lds, g, S, E, wv);
            SEAM(p0 + 8); }
        if (IN(p0 + 9)) { PH_BEGIN SEAM_SKIP(p0 + 9); }
        if (IN(p0 + 10)) { PH_BEGIN
            pg8::Gemm g{(const pg8::bf16_t*)slotp(ws, l, 0), (const pg8::bf16_t*)(wb + W_GATE), MPAD, 1024, 1024};
            pg8::StaticOrder S; S.init(MPAD, 1024, G, bid);
            EpiH<3> E{A->out, (bfu*)slotp(ws, l, 13), rsb + (size_t)(3 * l + 3) * MPAD, rsb + (size_t)(3 * l + 2) * MPAD, (const bfu*)slotp(ws, l, 11)};
            pg8::gemm_phase<EpiH<3>, pg8::StaticOrder, true, true>((PG8_LAS unsigned char*)lds, g, S, E, wv);
            SEAM(p0 + 10); }
        }
    { constexpr int l = 1;

        const int p0 = 1 + 11 * l;
        if (IN(p0 + 0)) { PH_BEGIN
            pg8::Gemm g{(const pg8::bf16_t*)slotp(ws, l, 0), (const pg8::bf16_t*)(wb + W_IN), MPAD, NIN, 1024};
            pg8::StaticOrder S; S.init(MPAD, NIN, G, bid);
            EpiG1 E{rsb + (size_t)(3 * l) * MPAD, (bfu*)slotp(ws, l, 2), (bfu*)slotp(ws, l, 4), (bfu*)slotp(ws, l, 5), (bfu*)slotp(ws, l, 6), (bfu*)slotp(ws, l, 7), (float*)(ws + WS_AB), (const float*)(ws + WS_ROPE),
                    A->out + O_BKP + (size_t)l * MP * 512, A->out + O_BVP + (size_t)l * MP * 512, A->out + O_BKS + (size_t)l * MS * 512, A->out + O_BVS + (size_t)l * MS * 512};
            pg8::gemm_phase<EpiG1, pg8::StaticOrder, true, true>((PG8_LAS unsigned char*)lds, g, S, E, wv);
            SEAM(p0 + 0); }
        if (IN(p0 + 1)) { PH_BEGIN
            prep_a(A, l, gw, NGW, lane); prep_c1(A, l, gw, NGW, lane);
            if (l == 1) conv_weights(A, 1, 2, lds, gw, NGW, lane, wave);
            SEAM(p0 + 1); }
        if (IN(p0 + 2)) { PH_BEGIN
            pg8::Gemm g{(const pg8::bf16_t*)slotp(ws, l, 12), (const pg8::bf16_t*)(wb + W_LR), MPAD, 768, 256};
            pg8::StaticOrder S; S.init(MPAD, 768, G, bid);
            EpiB<0> E{(bfu*)slotp(ws, l, 13), 768, nullptr};
            pg8::gemm_phase<EpiB<0>, pg8::StaticOrder, true, true>((PG8_LAS unsigned char*)lds, g, S, E, wv);
            SEAM(p0 + 2); }
        if (IN(p0 + 3)) { PH_BEGIN prep_c2(A, l, bid, G, tid); prep_a2(A, l, gw, NGW, lane);
            SEAM(p0 + 3); }
        if (IN(p0 + 4)) { PH_BEGIN
            if (bid < 64) { const int st = bid >> 1, half = bid & 1, b = st >> 2, h = st & 3;
                scan_rwkv(A, l, lds, h, half, b * 8192, 8192, 32, 5, b * 128, nullptr, A->out + O_CWP + (size_t)((l * 8 + b) * 4 + h) * 4096, tid);
                scan_rwkv(A, l, lds, h, half, MP + b * 16, 16, 16, 4, 1024 + b, A->in[7] + (size_t)((l * 8 + b) * 4 + h) * 4096, A->out + O_CWS + (size_t)((l * 8 + b) * 4 + h) * 4096, tid);
            } else if (bid < 128) { const int st = (bid - 64) >> 1, half = bid & 1, b = st >> 2, h = st & 3;
                scan_delta(A, l, lds, h, half, b * 8192, 8192, 32, 5, nullptr, A->out + O_ADP + (size_t)((l * 8 + b) * 4 + h) * 4096, tid);
                scan_delta(A, l, lds, h, half, MP + b * 16, 16, 16, 4, A->in[5] + (size_t)((l * 8 + b) * 4 + h) * 4096, A->out + O_ADS + (size_t)((l * 8 + b) * 4 + h) * 4096, tid);
            } else if (bid < 160) { sample_attn(A, l, lds, bid - 128, tid); }
            __syncthreads();
            unsigned* ctr = (unsigned*)(ws + WS_CTL) + 16 * l; volatile LAS unsigned* qw = (volatile LAS unsigned*)(lds + MISC_OFF);
            const attn_body::bf16* Q = (const attn_body::bf16*)slotp(ws, l, 4); const attn_body::bf16* K = (const attn_body::bf16*)slotp(ws, l, 5); const attn_body::bf16* V = (const attn_body::bf16*)slotp(ws, l, 6);
            attn_body::bf16* O = (attn_body::bf16*)slotp(ws, l, 13);
            for (;;) {
                if (tid == 0) qw[0] = atomicAdd(ctr, 1u);
                __syncthreads();
                const unsigned u = qw[0];
                __syncthreads();
                if (u >= 4096u) break;
                const int qb = 31 - (int)(u >> 7), bh = (int)(u & 127);
                attn_body::attn_unit<8>(bh >> 4, bh & 15, qb, Q, K, V, O, (char*)lds_raw, wv);
            }
            SEAM(p0 + 4); }
        if (IN(p0 + 5)) { PH_BEGIN
            post_attn(A, l, gw, NGW, lane); post_scan(A, l, gw, NGW, lane);
            conv_p(A, l, (bfu*)slotp(ws, l, 10), gtid, NT);
            if (l == 0) conv_weights(A, 1, 1, lds, gw, NGW, lane, wave);
            SEAM(p0 + 5); }
        if (IN(p0 + 6)) { PH_BEGIN
            pg8::Gemm g{(const pg8::bf16_t*)slotp(ws, l, 7), (const pg8::bf16_t*)(wb + W_OUT), MPAD, 1024, 1024};
            pg8::StaticOrder S; S.init(MPAD, 1024, G, bid);
            EpiH<2> E{A->out, (bfu*)slotp(ws, l, 0), rsb + (size_t)(3 * l + 1) * MPAD, nullptr, nullptr};
            pg8::gemm_phase<EpiH<2>, pg8::StaticOrder, true, true>((PG8_LAS unsigned char*)lds, g, S, E, wv);
            SEAM(p0 + 6); }
        if (IN(p0 + 7)) { PH_BEGIN
            pg8::Gemm g{(const pg8::bf16_t*)slotp(ws, l, 0), (const pg8::bf16_t*)(wb + W_FF1), MPAD, FFD, 1024};
            pg8::StaticOrder S; S.init(MPAD, FFD, G, bid);
            EpiB<1> E{(bfu*)slotp(ws, l, 2), FFD, rsb + (size_t)(3 * l + 1) * MPAD};
            pg8::gemm_phase<EpiB<1>, pg8::StaticOrder, true, true>((PG8_LAS unsigned char*)lds, g, S, E, wv);
            {
                pg8::Gemm g2{(const pg8::bf16_t*)slotp(ws, l, 10), (const pg8::bf16_t*)(wb + W_PP), MPAD, 1024, 256};
                pg8::StaticOrder S2; S2.init(MPAD, 1024, G, bid);
                EpiB<0> E2{(bfu*)slotp(ws, l, 11), 1024, nullptr};
                pg8::gemm_phase<EpiB<0>, pg8::StaticOrder, true, true>((PG8_LAS unsigned char*)lds, g2, S2, E2, wv); }
            SEAM(p0 + 7); }
        if (IN(p0 + 8)) { PH_BEGIN
            pg8::Gemm g{(const pg8::bf16_t*)slotp(ws, l, 2), (const pg8::bf16_t*)(wb + W_FF2), MPAD, 1024, FFD};
            pg8::StaticOrder S; S.init(MPAD, 1024, G, bid);
            EpiH<2> E{A->out, (bfu*)slotp(ws, l, 0), rsb + (size_t)(3 * l + 2) * MPAD, nullptr, nullptr};
            pg8::gemm_phase<EpiH<2>, pg8::StaticOrder, true, true>((PG8_LAS unsigned char*)lds, g, S, E, wv);
            SEAM(p0 + 8); }
        if (IN(p0 + 9)) { PH_BEGIN SEAM_SKIP(p0 + 9); }
        if (IN(p0 + 10)) { PH_BEGIN
            pg8::Gemm g{(const pg8::bf16_t*)slotp(ws, l, 0), (const pg8::bf16_t*)(wb + W_GATE), MPAD, 1024, 1024};
            pg8::StaticOrder S; S.init(MPAD, 1024, G, bid);
            EpiH<3> E{A->out, (bfu*)slotp(ws, l, 13), rsb + (size_t)(3 * l + 3) * MPAD, rsb + (size_t)(3 * l + 2) * MPAD, (const bfu*)slotp(ws, l, 11)};
            pg8::gemm_phase<EpiH<3>, pg8::StaticOrder, true, true>((PG8_LAS unsigned char*)lds, g, S, E, wv);
            SEAM(p0 + 10); }
        }
    if (IN(NPHASE - 1)) { PH_BEGIN final_norm(A, gw, NGW, lane); }
}
#undef PH_BEGIN
#undef IN
#undef SEAM

extern "C" void kernel_launch(void* const* d_in, const int* in_sizes, int n_in, void* d_out, int out_size, void* d_ws, size_t ws_size, hipStream_t stream) {
    static int grid = 0;
    if (grid == 0) {
        if (n_in != 40 || (size_t)out_size != O_END || ws_size < WS_TOTAL) { fprintf(stderr, "kernel_launch: unexpected shapes (n_in %d out %d ws %zu)\n", n_in, out_size, ws_size); grid = -1; return; }
        int dev = 0, cus = 0, per_cu = 0;
        if (hipGetDevice(&dev) != hipSuccess || hipDeviceGetAttribute(&cus, hipDeviceAttributeMultiprocessorCount, dev) != hipSuccess) { grid = -1; return; }
        if (hipFuncSetAttribute((const void*)hybrid_fwd, hipFuncAttributeMaxDynamicSharedMemorySize, LDS_BYTES) != hipSuccess) { fprintf(stderr, "kernel_launch: hipFuncSetAttribute failed\n"); grid = -1; return; }
        if (hipOccupancyMaxActiveBlocksPerMultiprocessor(&per_cu, (const void*)hybrid_fwd, NTHR, LDS_BYTES) != hipSuccess || per_cu < 1) { fprintf(stderr, "kernel_launch: occupancy query says %d\n", per_cu); per_cu = 1; }
        (void)hipGetLastError();
        grid = cus;
    }
    if (grid < 0) return;
    if (hipMemsetAsync((char*)d_ws + WS_CTL, 0, 64 * 1024, stream) != hipSuccess) { fprintf(stderr, "kernel_launch: memset failed\n"); return; }
    Args a{};
    for (int i = 0; i < 40; ++i) a.in[i] = (const float*)d_in[i];
    a.out = (float*)d_out; a.ws = (unsigned char*)d_ws;
#if MK_ONE_LAUNCH
    a.ph_lo = 0; a.ph_hi = NPHASE;
    void* args[] = {&a};
    hipError_t e = hipLaunchCooperativeKernel((const void*)hybrid_fwd, dim3(grid), dim3(NTHR), args, LDS_BYTES, stream);
    if (e != hipSuccess) fprintf(stderr, "kernel_launch: cooperative launch failed: %s (grid %d)\n", hipGetErrorString(e), grid);
#else
    for (int ph = 0; ph < NPHASE; ++ph) { a.ph_lo = ph; a.ph_hi = ph + 1; hipLaunchKernelGGL(hybrid_fwd, dim3(grid), dim3(NTHR), LDS_BYTES, stream, a); }
#endif
}
```

```cpp
#include <hip/hip_runtime.h>
#include <hip/hip_cooperative_groups.h>
#include <cstdio>
#include <cstdint>
namespace cg = cooperative_groups;
namespace pg8 {
#define PG8_LAS __attribute__((address_space(3)))
typedef unsigned short bf16_t;
typedef short bf16x8 __attribute__((ext_vector_type(8)));
typedef float f32x4 __attribute__((ext_vector_type(4)));
typedef unsigned u32x4 __attribute__((ext_vector_type(4)));
constexpr int BM = 256, BK = 64, HALF = 128, HTB = HALF * BK * 2  , STAGE_BYTES = 8 * HTB, NXCD = 8, WGM = 8;

__host__ __device__ __forceinline__ int lds_byte(int r, int c) { const int st = (r >> 4) * 2 + (c >> 5), rr = r & 15, cc = c & 31, ob = rr * 64 + cc * 2; return st * 1024 + (ob ^ (((ob >> 9) & 1) << 5)); }
__host__ __device__ __forceinline__ void stage_rc(int b, int& R, int& C) { const int st = b / 1024, sb = b % 1024, swz = sb ^ (((sb >> 9) & 1) << 5); R = (st >> 1) * 16 + swz / 64; C = (st & 1) * 32 + (swz % 64) / 2; }
__host__ __device__ __forceinline__ int perm32(int rho) { const int n = rho >> 4, i = rho & 15; return 8 * (i >> 2) + 4 * n + (i & 3); }

struct Unit { int pm, pn; };
struct Gemm { const bf16_t* A; const bf16_t* Bt; int M, N, K; };

struct StaticOrder {
    int nM, nN, nwg, G, c;
    __host__ __device__ void init(int M, int N, int G_, int c_) { nM = M / BM; nN = N / BM; nwg = nM * nN; G = G_; c = c_; }
    __host__ __device__ bool next(int i, Unit& u) const {
        const long L = (long)i * G + c; if (L >= nwg) return false;
        int wgid = (int)L; { const int q = nwg / NXCD, r = nwg % NXCD, xcd = wgid % NXCD, off = wgid / NXCD; wgid = (xcd < r ? xcd * (q + 1) : r * (q + 1) + (xcd - r) * q) + off; }
        const int nig = WGM * nN, gid = wgid / nig, fm = gid * WGM, gsz = (nM - fm) < WGM ? (nM - fm) : WGM;
        u.pm = fm + ((wgid % nig) % gsz); u.pn = (wgid % nig) / gsz; return true;
    }
    __device__ __forceinline__ void a_ready(const Unit&) const {}
    __device__ __forceinline__ void done(const Unit&) const {}
};

__device__ __forceinline__ unsigned cvt_pk_bf16(float lo, float hi) { unsigned r; asm volatile("v_cvt_pk_bf16_f32 %0, %1, %2" : "=v"(r) : "v"(lo), "v"(hi)); return r; }
typedef float f32x2 __attribute__((ext_vector_type(2)));
__device__ __forceinline__ f32x2 gelu_pk(f32x2 v) {
    const f32x2 av = __builtin_elementwise_abs(v), d = av * 0.2316418882f + 1.0f;
    f32x2 t; t.x = __builtin_amdgcn_rcpf(d.x); t.y = __builtin_amdgcn_rcpf(d.y);
    f32x2 q = t * 0.5307027145f + (-0.7265760135f); q = q * t + 0.7107068705f; q = q * t + (-0.142248368f); q = q * t + 0.127414796f; q = q * t;
    const f32x2 s = (v * v) * (-0.72134752044f);
    f32x2 e; e.x = __builtin_amdgcn_exp2f(s.x); e.y = __builtin_amdgcn_exp2f(s.y);
    const f32x2 m = v * (q * e), r = v - m;
    f32x2 o; o.x = v.x < 0.f ? m.x : r.x; o.y = v.y < 0.f ? m.y : r.y; return o;
}

template <int ACT  > struct EpiBf16 {
    static constexpr bool PERM = true, AFTER_DRAIN = false; static_assert(ACT == 0 || ACT == 1, "EpiBf16: ACT is 0 (none) or 1 (gelu_pk)");
    bf16_t* O; int ldc; const float* bias; int split_cols; size_t split_stride; float scale0;
    __device__ __forceinline__ void operator()(const f32x4 (&acc)[2][2][4][2], const Unit& u, int wr, int wc, int fr, int fq) const {
        const int row0 = u.pm * BM + wr * 64 + fr; int colt = u.pn * BM; bf16_t* base = O;
        float sc = 1.f; if (split_cols) { const int t = colt / split_cols; base += (size_t)t * split_stride; colt -= t * split_cols; if (t == 0) sc = scale0; }
        const int col0 = colt + wc * 32 + 8 * fq, bcol0 = u.pn * BM + wc * 32 + 8 * fq;
        f32x4 bv[2][2];
#pragma unroll
        for (int bj = 0; bj < 2; ++bj)
#pragma unroll
            for (int n = 0; n < 2; ++n) bv[bj][n] = bias ? *(const f32x4*)(bias + bcol0 + bj * HALF + 4 * n) : (f32x4){0.f, 0.f, 0.f, 0.f};
#pragma unroll
        for (int ai = 0; ai < 2; ++ai)
#pragma unroll
            for (int m = 0; m < 4; ++m) { bf16_t* rowp = base + (size_t)(row0 + ai * HALF + m * 16) * ldc + col0;
#pragma unroll
                for (int bj = 0; bj < 2; ++bj) { f32x4 v0 = acc[ai][bj][m][0] + bv[bj][0], v1 = acc[ai][bj][m][1] + bv[bj][1];
                    if (ACT == 1) { f32x2 a = gelu_pk((f32x2){v0[0], v0[1]}), b = gelu_pk((f32x2){v0[2], v0[3]}), c = gelu_pk((f32x2){v1[0], v1[1]}), d = gelu_pk((f32x2){v1[2], v1[3]});
                        v0 = (f32x4){a.x, a.y, b.x, b.y}; v1 = (f32x4){c.x, c.y, d.x, d.y}; }
                    v0 = v0 * sc; v1 = v1 * sc; u32x4 w; w.x = cvt_pk_bf16(v0[0], v0[1]); w.y = cvt_pk_bf16(v0[2], v0[3]); w.z = cvt_pk_bf16(v1[0], v1[1]); w.w = cvt_pk_bf16(v1[2], v1[3]);
                    *(u32x4*)(rowp + bj * HALF) = w; } }
    }
};

struct PanelStats {
    unsigned* xbuf;
    unsigned* cnt;
    unsigned* tmo;
    int ntn; float eps;
    unsigned code;
    __device__ __forceinline__ bool run(const f32x4 (&v)[2][2][4][2], const Unit& u, int wr, int wc, int fr, int fq, PG8_LAS unsigned char* lds, int wid, int lane) const {
        typedef float f32x2v __attribute__((ext_vector_type(2)));
        PG8_LAS f32x2v* P = (PG8_LAS f32x2v*)lds;
        PG8_LAS f32x2v* S = (PG8_LAS f32x2v*)(lds + 8192);
        PG8_LAS unsigned* flag = (PG8_LAS unsigned*)(lds + 8192 + 2048);
#pragma unroll
        for (int ai = 0; ai < 2; ++ai)
#pragma unroll
            for (int m = 0; m < 4; ++m) {
                float s = 0.f;
#pragma unroll
                for (int bj = 0; bj < 2; ++bj)
#pragma unroll
                    for (int n = 0; n < 2; ++n) { const f32x4 x = v[ai][bj][m][n]; s += (x[0] + x[1]) + (x[2] + x[3]); }
                s += __shfl_xor(s, 16); s += __shfl_xor(s, 32);
                const float mw = s * (1.0f / 64.0f); float q = 0.f;
#pragma unroll
                for (int bj = 0; bj < 2; ++bj)
#pragma unroll
                    for (int n = 0; n < 2; ++n) { const f32x4 d = v[ai][bj][m][n] - mw; q += (d[0] * d[0] + d[1] * d[1]) + (d[2] * d[2] + d[3] * d[3]); }
                q += __shfl_xor(q, 16); q += __shfl_xor(q, 32);
                if (fq == 0) P[(ai * HALF + wr * 64 + m * 16 + fr) * 4 + wc] = (f32x2v){mw, q};
            }
        asm volatile("s_waitcnt lgkmcnt(0)" ::: "memory"); __builtin_amdgcn_s_barrier(); asm volatile("" ::: "memory");
#if defined(BROKEN_EXCHANGE_NO_WAIT)
#warning BROKEN CONTROL BUILD: the row-statistics exchange does not wait; results are wrong by design
        if (blockIdx.x >= 64) { const long long t0_ = clock64(); while (clock64() - t0_ < 60000) __builtin_amdgcn_s_sleep(8); }
#endif
        const int row = wid * 32 + (lane & 31);
        if (lane < 32) {
            const f32x2v a = P[row * 4 + 0], b = P[row * 4 + 1], c = P[row * 4 + 2], d = P[row * 4 + 3];
            const float mt = (a.x + b.x + c.x + d.x) * 0.25f;
            const float da = a.x - mt, db = b.x - mt, dc = c.x - mt, dd = d.x - mt;
            const float m2 = (a.y + b.y) + (c.y + d.y) + 64.0f * ((da * da + db * db) + (dc * dc + dd * dd));
            unsigned long long* slot = (unsigned long long*)xbuf + ((size_t)(u.pm * BM + row) * 4 + u.pn);
            __hip_atomic_store(slot, ((unsigned long long)__float_as_uint(m2) << 32) | __float_as_uint(mt), __ATOMIC_RELAXED, __HIP_MEMORY_SCOPE_AGENT);
        }
        asm volatile("s_waitcnt vmcnt(0)" ::: "memory");
        if (lane == 0) __hip_atomic_fetch_add(cnt + 64 * u.pm, 1u, __ATOMIC_RELAXED, __HIP_MEMORY_SCOPE_AGENT);
        if (wid == 0) {
            bool dead = false; const unsigned long long t0 = __builtin_amdgcn_s_memrealtime(); const unsigned want = 8u * (unsigned)ntn;
            for (;;) {
#if defined(BROKEN_EXCHANGE_NO_WAIT)
                break;
#endif
                if ((unsigned)__builtin_amdgcn_readfirstlane(__hip_atomic_load(cnt + 64 * u.pm, __ATOMIC_RELAXED, __HIP_MEMORY_SCOPE_AGENT)) >= want) break;
                if (__builtin_amdgcn_s_memrealtime() - t0 > 2000000ull) {
                    if (lane == 0) { unsigned expect = 0u; __hip_atomic_compare_exchange_strong(tmo + 1, &expect, code | (unsigned)(u.pm & 0xff), __ATOMIC_RELAXED, __ATOMIC_RELAXED, __HIP_MEMORY_SCOPE_AGENT);
                                     __hip_atomic_store(tmo, 1u, __ATOMIC_RELAXED, __HIP_MEMORY_SCOPE_AGENT); }
                    dead = true; break; }
                __builtin_amdgcn_s_sleep(2);
            }
            __builtin_amdgcn_fence(__ATOMIC_ACQUIRE, "agent");
            if (lane == 0) flag[0] = dead ? 1u : 0u;
        }
        asm volatile("s_waitcnt vmcnt(0) lgkmcnt(0)" ::: "memory"); __builtin_amdgcn_s_barrier(); asm volatile("" ::: "memory");
        const bool bad = flag[0] != 0u;
        if (lane < 32) {
            const unsigned long long* slot = (const unsigned long long*)xbuf + (size_t)(u.pm * BM + row) * 4; float mt[4], m2[4]; float ms = 0.f;
#pragma unroll
            for (int t = 0; t < 4; ++t) { if (t < ntn) { const unsigned long long w = __hip_atomic_load(slot + t, __ATOMIC_RELAXED, __HIP_MEMORY_SCOPE_AGENT); mt[t] = __uint_as_float((unsigned)w); m2[t] = __uint_as_float((unsigned)(w >> 32)); } else { mt[t] = 0.f; m2[t] = 0.f; } ms += mt[t]; }
            const float mean = ms / (float)ntn; float q = 0.f;
#pragma unroll
            for (int t = 0; t < 4; ++t) if (t < ntn) { const float dm = mt[t] - mean; q += m2[t] + 256.0f * dm * dm; }
            S[row] = (f32x2v){mean, 1.0f / sqrtf(q / (256.0f * (float)ntn) + eps)};
        }
        asm volatile("s_waitcnt lgkmcnt(0)" ::: "memory"); __builtin_amdgcn_s_barrier(); asm volatile("" ::: "memory");
        return bad;
    }
};
struct EpiLnRes {
    static constexpr bool PERM = false, AFTER_DRAIN = true;
    const float* base; float* out; int ldc; const float* bias; PanelStats st; unsigned poison;
    __device__ __forceinline__ void fused(f32x4 (&acc)[2][2][4][2], const Unit& u, int wr, int wc, int fr, int fq, PG8_LAS unsigned char* lds, int wid, int lane) const {
        typedef float f32x2v __attribute__((ext_vector_type(2)));
        const PG8_LAS f32x2v* S = (const PG8_LAS f32x2v*)(lds + 8192);
        const int col0 = u.pn * BM + wc * 32 + 4 * fq;
#pragma unroll
        for (int bj = 0; bj < 2; ++bj)
#pragma unroll
            for (int n = 0; n < 2; ++n) { const f32x4 bv = bias ? *(const f32x4*)(bias + col0 + bj * HALF + n * 16) : (f32x4){0.f, 0.f, 0.f, 0.f};
#pragma unroll
                for (int ai = 0; ai < 2; ++ai)
#pragma unroll
                    for (int m = 0; m < 4; ++m) acc[ai][bj][m][n] += bv; }
        f32x4 pre[4][2][2];
#pragma unroll
        for (int m = 0; m < 4; ++m) { const size_t off = (size_t)(u.pm * BM + wr * 64 + m * 16 + fr) * ldc + col0;
#pragma unroll
            for (int bj = 0; bj < 2; ++bj)
#pragma unroll
                for (int n = 0; n < 2; ++n) pre[m][bj][n] = *(const f32x4*)(base + off + bj * HALF + n * 16); }
        const bool bad = st.run(acc, u, wr, wc, fr, fq, lds, wid, lane) || poison != 0u;
        const float qnan = __builtin_nanf("");
#pragma unroll
        for (int ai = 0; ai < 2; ++ai)
#pragma unroll
            for (int m = 0; m < 4; ++m) { const int r = ai * HALF + wr * 64 + m * 16 + fr; const f32x2v sr = S[r]; const size_t off = (size_t)(u.pm * BM + r) * ldc + col0;
#pragma unroll
                for (int bj = 0; bj < 2; ++bj)
#pragma unroll
                    for (int n = 0; n < 2; ++n) { const f32x4 bs = ai == 0 ? pre[m][bj][n] : *(const f32x4*)(base + off + bj * HALF + n * 16); f32x4 o = bs + (acc[ai][bj][m][n] - sr.x) * sr.y;
                        if (bad) o = (f32x4){qnan, qnan, qnan, qnan}; *(f32x4*)(out + off + bj * HALF + n * 16) = o; }
                if (m & 1) asm volatile("" ::: "memory"); }
    }
};
struct EpiLnResLn {
    static constexpr bool PERM = false, AFTER_DRAIN = true;
    const float* base; float* out; bf16_t* xn; int ldc; const float* bias; PanelStats st1, st2; unsigned poison;
    __device__ __forceinline__ void fused(f32x4 (&acc)[2][2][4][2], const Unit& u, int wr, int wc, int fr, int fq, PG8_LAS unsigned char* lds, int wid, int lane) const {
        typedef float f32x2v __attribute__((ext_vector_type(2))); typedef unsigned u32x2v __attribute__((ext_vector_type(2)));
        const PG8_LAS f32x2v* S = (const PG8_LAS f32x2v*)(lds + 8192);
        const int col0 = u.pn * BM + wc * 32 + 4 * fq;
#pragma unroll
        for (int bj = 0; bj < 2; ++bj)
#pragma unroll
            for (int n = 0; n < 2; ++n) { const f32x4 bv = bias ? *(const f32x4*)(bias + col0 + bj * HALF + n * 16) : (f32x4){0.f, 0.f, 0.f, 0.f};
#pragma unroll
                for (int ai = 0; ai < 2; ++ai)
#pragma unroll
                    for (int m = 0; m < 4; ++m) acc[ai][bj][m][n] += bv; }
        bool bad = st1.run(acc, u, wr, wc, fr, fq, lds, wid, lane) || poison != 0u;
        const float qnan = __builtin_nanf("");
#pragma unroll
        for (int ai = 0; ai < 2; ++ai)
#pragma unroll
            for (int m = 0; m < 4; ++m) { const int r = ai * HALF + wr * 64 + m * 16 + fr; const f32x2v sr = S[r]; const size_t off = (size_t)(u.pm * BM + r) * ldc + col0;
#pragma unroll
                for (int bj = 0; bj < 2; ++bj)
#pragma unroll
                    for (int n = 0; n < 2; ++n) { const f32x4 bs = *(const f32x4*)(base + off + bj * HALF + n * 16); acc[ai][bj][m][n] = bs + (acc[ai][bj][m][n] - sr.x) * sr.y; }
                asm volatile("" : "+v"(acc[ai][0][m][0]), "+v"(acc[ai][0][m][1]), "+v"(acc[ai][1][m][0]), "+v"(acc[ai][1][m][1]));
                if (m & 1) asm volatile("" ::: "memory"); }
        const bool bad1 = bad;
        bad = st2.run(acc, u, wr, wc, fr, fq, lds, wid, lane) || bad;
#pragma unroll
        for (int ai = 0; ai < 2; ++ai)
#pragma unroll
            for (int m = 0; m < 4; ++m) { const int r = ai * HALF + wr * 64 + m * 16 + fr; const f32x2v sr = S[r]; const size_t off = (size_t)(u.pm * BM + r) * ldc + col0;
#pragma unroll
                for (int bj = 0; bj < 2; ++bj)
#pragma unroll
                    for (int n = 0; n < 2; ++n) { const f32x4 x1 = acc[ai][bj][m][n]; *(f32x4*)(out + off + bj * HALF + n * 16) = bad1 ? (f32x4){qnan, qnan, qnan, qnan} : x1;
                        const f32x4 o = (x1 - sr.x) * sr.y; u32x2v w; w.x = cvt_pk_bf16(o[0], o[1]); w.y = cvt_pk_bf16(o[2], o[3]);
                        if (bad) { w.x = 0x7fc07fc0u; w.y = 0x7fc07fc0u; } *(u32x2v*)(xn + off + bj * HALF + n * 16) = w; }
                asm volatile("" ::: "memory"); }
    }
};

template <class Epi, class Sched, bool ALIGN_EPI = false, bool SP2 = false>
__device__ __forceinline__ void gemm_phase(PG8_LAS unsigned char* lds, const Gemm g, const Sched& S, const Epi& E, const int wv_) {
    int tid_o = wv_ * 64 + (int)__builtin_amdgcn_mbcnt_hi(~0u, __builtin_amdgcn_mbcnt_lo(~0u, 0u)); asm volatile("" : "+v"(tid_o)); tid_o &= 511;
    const int tid = tid_o, wid = __builtin_amdgcn_readfirstlane(tid >> 6), lane = tid & 63, wr = wid >> 2, wc = wid & 3, fr = lane & 15, fq = lane >> 4;
    const int K = g.K, nt = K / BK;
    unsigned voffA[2], voffB[2];
#pragma unroll
    for (int i = 0; i < 2; ++i) { int R, C; stage_rc(tid * 16 + i * 8192, R, C); const int Rb = Epi::PERM ? ((R & ~31) + perm32(R & 31)) : R;
        voffA[i] = (unsigned)(R * K + C) * 2u; voffB[i] = (unsigned)(Rb * K + C) * 2u; }
    const size_t kstep = (size_t)(BK * 2);
    const size_t hstep = (size_t)HALF * K * 2;
    const size_t tstep = 2 * hstep;
    const unsigned ldsw = (unsigned)wid * 1024u;
    const int aoff = lds_byte(wr * 64 + fr, fq * 8), boff = lds_byte(wc * 32 + fr, fq * 8);
#define PG8_SA(b, h) (((b) * 2 + (h)) * HTB)
#define PG8_SB(b, h) ((4 + (b) * 2 + (h)) * HTB)
#define PG8_STAGE(bufoff, gbase, voff) do { _Pragma("unroll") for (int _i = 0; _i < 2; ++_i) \
        __builtin_amdgcn_global_load_lds((const unsigned*)((const char*)(gbase) + (voff)[_i]), (PG8_LAS unsigned*)(lds + (bufoff) + ldsw + _i * 8192), 16, 0, 0); } while (0)
#define PG8_LDA(dst, b, h) do { _Pragma("unroll") for (int m = 0; m < 4; ++m) _Pragma("unroll") for (int k = 0; k < 2; ++k) dst[m][k] = *(const PG8_LAS bf16x8*)(lds + PG8_SA(b, h) + aoff + m * 2048 + k * 1024); } while (0)
#define PG8_LDB(dst, b, h) do { _Pragma("unroll") for (int n = 0; n < 2; ++n) _Pragma("unroll") for (int k = 0; k < 2; ++k) dst[n][k] = *(const PG8_LAS bf16x8*)(lds + PG8_SB(b, h) + boff + n * 2048 + k * 1024); } while (0)
#define PG8_MMA(ai, bj, At, Bt) do { __builtin_amdgcn_s_setprio(1); _Pragma("unroll") for (int m = 0; m < 4; ++m) _Pragma("unroll") for (int n = 0; n < 2; ++n) _Pragma("unroll") for (int k = 0; k < 2; ++k) \
        acc[ai][bj][m][n] = __builtin_amdgcn_mfma_f32_16x16x32_bf16(Bt[n][k], At[m][k], acc[ai][bj][m][n], 0, 0, 0); __builtin_amdgcn_s_setprio(0); } while (0)
#define PG8_WAIT_V(n) asm volatile("s_waitcnt vmcnt(" #n ")" ::: "memory")
#define PG8_WAIT_L(n) asm volatile("s_waitcnt lgkmcnt(" #n ")" ::: "memory")
#define PG8_BAR __builtin_amdgcn_s_barrier()
#define PG8_SCHED __builtin_amdgcn_sched_barrier(0)
    Unit cur, nxt; int ui = 0;
    if (!S.next(0, cur)) return;
    f32x4 acc[2][2][4][2];
#pragma unroll
    for (int a = 0; a < 2; ++a)
#pragma unroll
        for (int b = 0; b < 2; ++b)
#pragma unroll
            for (int m = 0; m < 4; ++m)
#pragma unroll
                for (int n = 0; n < 2; ++n) acc[a][b][m][n] = (f32x4){0.f, 0.f, 0.f, 0.f};
    bf16x8 At[4][2], B0[2][2], B1[2][2];
    const char* cA = (const char*)g.A + (size_t)cur.pm * tstep; const char* cB = (const char*)g.Bt + (size_t)cur.pn * tstep;
    S.a_ready(cur);
    if constexpr (SP2) {
        PG8_STAGE(PG8_SB(0, 0), cB, voffB); PG8_STAGE(PG8_SB(0, 1), cB + hstep, voffB); PG8_STAGE(PG8_SA(0, 0), cA, voffA); PG8_STAGE(PG8_SA(0, 1), cA + hstep, voffA);
        if (wr == 1) PG8_BAR;
        PG8_WAIT_V(2); PG8_BAR;
        PG8_STAGE(PG8_SB(1, 0), cB + kstep, voffB); PG8_STAGE(PG8_SA(1, 0), cA + kstep, voffA); PG8_STAGE(PG8_SB(1, 1), cB + hstep + kstep, voffB);
        PG8_WAIT_V(6); PG8_BAR;
    } else {
        PG8_STAGE(PG8_SB(0, 0), cB, voffB); PG8_STAGE(PG8_SA(0, 0), cA, voffA); PG8_STAGE(PG8_SB(0, 1), cB + hstep, voffB); PG8_STAGE(PG8_SA(0, 1), cA + hstep, voffA);
        if (wr == 1) PG8_BAR;
        PG8_WAIT_V(4); PG8_BAR;
        PG8_STAGE(PG8_SB(1, 0), cB + kstep, voffB); PG8_STAGE(PG8_SA(1, 0), cA + kstep, voffA); PG8_STAGE(PG8_SB(1, 1), cB + hstep + kstep, voffB);
        PG8_WAIT_V(6); PG8_BAR;
    }
    for (;;) {
        const bool has_next = S.next(ui + 1, nxt);
        const char* nA = has_next ? (const char*)g.A + (size_t)nxt.pm * tstep : cA; const char* nB = has_next ? (const char*)g.Bt + (size_t)nxt.pn * tstep : cB;
        for (int t = 0; t < nt; t += 2) {
            const bool last = (t == nt - 2);
            const char* a1 = cA + (size_t)(t + 1) * kstep;
            const char* a2 = last ? nA : cA + (size_t)(t + 2) * kstep; const char* b2 = last ? nB : cB + (size_t)(t + 2) * kstep;
            const char* a3 = a2 + kstep; const char* b3 = b2 + kstep;
            if (last && has_next) S.a_ready(nxt);
            if constexpr (SP2) {
            PG8_LDB(B0, 0, 0); PG8_LDB(B1, 0, 1); PG8_SCHED; PG8_LDA(At, 0, 0); PG8_STAGE(PG8_SA(1, 1), a1 + hstep, voffA);
            PG8_WAIT_V(8); PG8_WAIT_L(0); PG8_BAR; PG8_MMA(0, 0, At, B0); PG8_MMA(0, 1, At, B1); PG8_BAR; PG8_SCHED;
            PG8_LDA(At, 0, 1); PG8_STAGE(PG8_SB(0, 0), b2, voffB); PG8_STAGE(PG8_SB(0, 1), b2 + hstep, voffB); PG8_STAGE(PG8_SA(0, 0), a2, voffA);
            PG8_WAIT_V(8); PG8_WAIT_L(0); PG8_BAR; PG8_MMA(1, 0, At, B0); PG8_MMA(1, 1, At, B1); PG8_BAR; PG8_SCHED;
            PG8_LDB(B0, 1, 0); PG8_LDB(B1, 1, 1); PG8_SCHED; PG8_LDA(At, 1, 0); PG8_STAGE(PG8_SA(0, 1), a2 + hstep, voffA);
            PG8_WAIT_V(8); PG8_WAIT_L(0); PG8_BAR; PG8_MMA(0, 0, At, B0); PG8_MMA(0, 1, At, B1); PG8_BAR; PG8_SCHED;
            PG8_LDA(At, 1, 1); PG8_STAGE(PG8_SB(1, 0), b3, voffB); PG8_STAGE(PG8_SB(1, 1), b3 + hstep, voffB); PG8_STAGE(PG8_SA(1, 0), a3, voffA);
            PG8_WAIT_V(8); PG8_WAIT_L(0); PG8_BAR; PG8_MMA(1, 0, At, B0); PG8_MMA(1, 1, At, B1); PG8_BAR; PG8_SCHED;
            } else {
            PG8_LDB(B0, 0, 0); PG8_SCHED; PG8_LDA(At, 0, 0); PG8_STAGE(PG8_SA(1, 1), a1 + hstep, voffA);
            PG8_WAIT_L(8); PG8_BAR; PG8_WAIT_L(0); PG8_MMA(0, 0, At, B0); PG8_BAR; PG8_SCHED;
            PG8_LDB(B1, 0, 1); PG8_STAGE(PG8_SB(0, 0), b2, voffB);
            PG8_BAR; PG8_WAIT_L(0); PG8_MMA(0, 1, At, B1); PG8_BAR;
            PG8_LDA(At, 0, 1); PG8_STAGE(PG8_SA(0, 0), a2, voffA);
            PG8_BAR; PG8_WAIT_L(0); PG8_MMA(1, 0, At, B0); PG8_BAR; PG8_SCHED;
            PG8_STAGE(PG8_SB(0, 1), b2 + hstep, voffB);
            PG8_WAIT_V(6); PG8_BAR; PG8_MMA(1, 1, At, B1); PG8_BAR;
            PG8_LDB(B0, 1, 0); PG8_SCHED; PG8_LDA(At, 1, 0); PG8_STAGE(PG8_SA(0, 1), a2 + hstep, voffA);
            PG8_WAIT_L(8); PG8_BAR; PG8_WAIT_L(0); PG8_MMA(0, 0, At, B0); PG8_BAR; PG8_SCHED;
            PG8_LDB(B1, 1, 1); PG8_STAGE(PG8_SB(1, 0), b3, voffB);
            PG8_BAR; PG8_WAIT_L(0); PG8_MMA(0, 1, At, B1); PG8_BAR;
            PG8_LDA(At, 1, 1); PG8_STAGE(PG8_SA(1, 0), a3, voffA);
            PG8_BAR; PG8_WAIT_L(0); PG8_MMA(1, 0, At, B0); PG8_BAR; PG8_SCHED;
            PG8_STAGE(PG8_SB(1, 1), b3 + hstep, voffB);
            PG8_WAIT_V(6); PG8_BAR; PG8_MMA(1, 1, At, B1); PG8_BAR;
            }
        }
        if constexpr (ALIGN_EPI) { if (wr == 0) PG8_BAR; }
        if constexpr (!Epi::AFTER_DRAIN) { E(acc, cur, wr, wc, fr, fq); S.done(cur); }
        if (!has_next) break;
#pragma unroll
        for (int a = 0; a < 2; ++a)
#pragma unroll
            for (int b = 0; b < 2; ++b)
#pragma unroll
                for (int m = 0; m < 4; ++m)
#pragma unroll
                    for (int n = 0; n < 2; ++n) acc[a][b][m][n] = (f32x4){0.f, 0.f, 0.f, 0.f};
        cur = nxt; cA = nA; cB = nB; ++ui;
        if constexpr (ALIGN_EPI) { if (wr == 1) PG8_BAR; }
    }
    PG8_WAIT_V(0);
    if constexpr (!ALIGN_EPI) { if (wr == 0) PG8_BAR; }
    PG8_BAR;
    if constexpr (Epi::AFTER_DRAIN) { E.fused(acc, cur, wr, wc, fr, fq, lds, wid, lane); S.done(cur); }
#undef PG8_SA
#undef PG8_SB
#undef PG8_STAGE
#undef PG8_LDA
#undef PG8_LDB
#undef PG8_MMA
#undef PG8_WAIT_V
#undef PG8_WAIT_L
#undef PG8_BAR
#undef PG8_SCHED
}
}
#include <hip/hip_bf16.h>
#include <cmath>
namespace attn_body {
using bf16=__hip_bfloat16;
using bf16x8=__attribute__((ext_vector_type(8)))short;
using s16x4=__attribute__((ext_vector_type(4)))short;
using f32x16=__attribute__((ext_vector_type(16)))float;
using u32x4=__attribute__((ext_vector_type(4)))unsigned;
constexpr int BATCH=8,NHEAD=16,SEQ=8192,D=64,DM=NHEAD*D,DMI=512,DMO=1024;
constexpr int NW=8,QBLK=32,QB=QBLK*NW,KVBLK=64,NQB=SEQ/QB;
constexpr int ATTN_PITCH=DM, ATTN_UNIT_ROWS=QB;
__device__ __forceinline__ int crow(int r,int hi){return (r&3)+8*(r>>2)+4*hi;}
#define SBAR() __builtin_amdgcn_sched_barrier(0)
__device__ __forceinline__ void cmask(f32x16&p0,f32x16&p1,int jb,int qrel,int hi){
  const float NEG=-INFINITY; int kb=64*jb+4*hi;
  #pragma unroll
  for(int r=0;r<16;++r){ if(jb>(qrel>>6)){p0[r]=NEG;p1[r]=NEG;} } (void)kb;
}

constexpr int NSLOT=3, SLOTB=8192;
constexpr int LDS_K=0, LDS_V=NSLOT*SLOTB, LDS_WS=2*NSLOT*SLOTB, LDS_OST=LDS_WS+NW*64*4, LDS_BYTES=LDS_OST+NW*4096;
constexpr float C2=0.125f*1.4426950408889634f;
__device__ __forceinline__ void glds16(const void*gsrc,unsigned lds_dst){unsigned keep;
  asm volatile("s_mov_b32 %0, m0\n\ts_mov_b32 m0, %2\n\ts_nop 0\n\tglobal_load_lds_dwordx4 %1, off\n\ts_mov_b32 m0, %0":"=&s"(keep):"v"(gsrc),"s"(lds_dst):"memory");}
__device__ __forceinline__ float max3f(float a,float b,float c){float r;asm("v_max3_f32 %0, %1, %2, %3":"=v"(r):"v"(a),"v"(b),"v"(c));return r;}
__device__ __forceinline__ float max2f(float a,float b){float r;asm("v_max_f32_e32 %0, %1, %2":"=v"(r):"v"(a),"v"(b));return r;}
__device__ __forceinline__ float fadd_s(float a,float b){float r;asm("v_add_f32_e32 %0, %1, %2":"=v"(r):"v"(a),"v"(b));return r;}
__device__ __forceinline__ float fsub_s(float a,float b){float r;asm("v_sub_f32_e32 %0, %1, %2":"=v"(r):"v"(a),"v"(b));return r;}
typedef float f32x2_t __attribute__((ext_vector_type(2))); typedef __bf16 bf16x2_t __attribute__((ext_vector_type(2)));
__device__ __forceinline__ unsigned cvtpk_s(float lo,float hi){f32x2_t v={lo,hi};bf16x2_t b=__builtin_convertvector(v,bf16x2_t);return __builtin_bit_cast(unsigned,b);}
#define WAIT_BAR(N) asm volatile("s_waitcnt vmcnt(" #N ") lgkmcnt(0)\n\ts_barrier":::"memory")

__device__ __forceinline__ void qkt(f32x16&p0,f32x16&p1,const char*Kslot,const bf16x8*qr,const f32x16&negm,int r32,int hi){
  const char*kb=Kslot+hi*1024+r32*16;
  #pragma unroll
  for(int d0=0;d0<4;++d0){
    const bf16x8 b0=*reinterpret_cast<const bf16x8*>(kb+d0*2048);
    const bf16x8 b1=*reinterpret_cast<const bf16x8*>(kb+d0*2048+512);
    if(d0==0){p0=__builtin_amdgcn_mfma_f32_32x32x16_bf16(b0,qr[0],negm,0,0,0);p1=__builtin_amdgcn_mfma_f32_32x32x16_bf16(b1,qr[0],negm,0,0,0);}
    else{p0=__builtin_amdgcn_mfma_f32_32x32x16_bf16(b0,qr[d0],p0,0,0,0);p1=__builtin_amdgcn_mfma_f32_32x32x16_bf16(b1,qr[d0],p1,0,0,0);}}
}
typedef __attribute__((address_space(3))) const char* lds_cptr;
typedef short v4i16_t __attribute__((ext_vector_type(4)));
__device__ __forceinline__ void kload8(bf16x8*kf,lds_cptr kp){
  kf[0]=*(const __attribute__((address_space(3))) bf16x8*)(kp);      kf[1]=*(const __attribute__((address_space(3))) bf16x8*)(kp+512);
  kf[2]=*(const __attribute__((address_space(3))) bf16x8*)(kp+2048); kf[3]=*(const __attribute__((address_space(3))) bf16x8*)(kp+2560);
  kf[4]=*(const __attribute__((address_space(3))) bf16x8*)(kp+4096); kf[5]=*(const __attribute__((address_space(3))) bf16x8*)(kp+4608);
  kf[6]=*(const __attribute__((address_space(3))) bf16x8*)(kp+6144); kf[7]=*(const __attribute__((address_space(3))) bf16x8*)(kp+6656);
}
__device__ __forceinline__ void kload2(bf16x8*kf,lds_cptr kp,int j){ kf[2*j]=*(const __attribute__((address_space(3))) bf16x8*)(kp+j*2048); kf[2*j+1]=*(const __attribute__((address_space(3))) bf16x8*)(kp+j*2048+512); }
__device__ __forceinline__ s16x4 vtr(lds_cptr p){ return __builtin_bit_cast(s16x4,__builtin_amdgcn_ds_read_tr16_b64_v4i16((__attribute__((address_space(3))) v4i16_t*)p)); }
__device__ __forceinline__ float rowmax(const f32x16&p0,const f32x16&p1){
  float a=max3f(p0[0],p0[1],p1[0]),b=max3f(p0[2],p0[3],p1[1]);a=max3f(a,p1[2],p1[3]);
  #pragma unroll
  for(int r=4;r<16;r+=4){a=max3f(a,p0[r],p0[r+1]);b=max3f(b,p0[r+2],p0[r+3]);a=max3f(a,p1[r],p1[r+1]);b=max3f(b,p1[r+2],p1[r+3]);}
  const float m=max2f(a,b);
  auto rr=__builtin_amdgcn_permlane32_swap(__float_as_uint(m),__float_as_uint(m),false,false);
  return max2f(__uint_as_float(rr[0]),__uint_as_float(rr[1]));
}
__device__ __forceinline__ void pv(f32x16*o,int vb,bf16x8 pa0,bf16x8 pa1,bf16x8 pa2,bf16x8 pa3){
  #pragma unroll
  for(int d0=0;d0<2;++d0){s16x4 lo[4],hi[4];
    #pragma unroll
    for(int ks=0;ks<4;++ks){
      asm volatile("ds_read_b64_tr_b16 %0,%1 offset:%c2":"=&v"(lo[ks]):"v"(vb),"i"(d0*4096+ks*1024):"memory");
      asm volatile("ds_read_b64_tr_b16 %0,%1 offset:%c2":"=&v"(hi[ks]):"v"(vb),"i"(d0*4096+ks*1024+512):"memory");}
    asm volatile("s_waitcnt lgkmcnt(0)":::"memory");SBAR();
    #define PK(k) (bf16x8){lo[k][0],lo[k][1],lo[k][2],lo[k][3],hi[k][0],hi[k][1],hi[k][2],hi[k][3]}
    o[d0]=__builtin_amdgcn_mfma_f32_32x32x16_bf16(pa0,PK(0),o[d0],0,0,0);
    o[d0]=__builtin_amdgcn_mfma_f32_32x32x16_bf16(pa1,PK(1),o[d0],0,0,0);
    o[d0]=__builtin_amdgcn_mfma_f32_32x32x16_bf16(pa2,PK(2),o[d0],0,0,0);
    o[d0]=__builtin_amdgcn_mfma_f32_32x32x16_bf16(pa3,PK(3),o[d0],0,0,0);
    #undef PK
  }
}

#ifndef ATTN_STORE16
#define ATTN_STORE16(p,v) (*(u32x4*)(p)=(v))
#endif
template<int THRL> __device__ __forceinline__ void attn_unit(int b,int h,int qb,const bf16*Q,const bf16*__restrict__ K,const bf16*__restrict__ V,bf16*O,char*shm,const int wv_){
  int tid_o=wv_*64+(int)__builtin_amdgcn_mbcnt_hi(~0u,__builtin_amdgcn_mbcnt_lo(~0u,0u)); asm volatile("":"+v"(tid_o)); tid_o&=511;
  const int tid=tid_o,lane=tid&63,r32=lane&31,hi=lane>>5; const int wid=__builtin_amdgcn_readfirstlane(tid>>6);
  const long rowbase=(long)b*SEQ; const int q0=qb*QB;
  const bf16*Qw=Q+(rowbase+q0+wid*QBLK)*DMI+(h>>1)*D;
  const bf16*Kh=K+rowbase*DMI+(h>>1)*D,*Vh=V+rowbase*DMI+(h>>2)*128+(h&1)*64;
  const unsigned lds0=(unsigned)(uintptr_t)shm;
  float*wsf=(float*)(shm+LDS_WS)+wid*64;
  const bf16*ksrc=Kh+(long)lane*DMI+wid*8;
  const bf16*vsrc=Vh+(long)(16*(wid&3)+(lane>>2))*DMI+(wid>>2)*32+(lane&3)*8;
  const unsigned kdst=lds0+LDS_K+wid*1024, vdst=lds0+LDS_V+wid*1024;
  #define DMA_K(t,slot) glds16(ksrc+(long)(t)*KVBLK*DMI,(unsigned)__builtin_amdgcn_readfirstlane(kdst+(slot)))
  #define DMA_V(t,slot) glds16(vsrc+(long)(t)*KVBLK*DMI,(unsigned)__builtin_amdgcn_readfirstlane(vdst+(slot)))
  const int vb0=(int)(lds0+LDS_V)+((lane>>4)&1)*32+(lane&3)*8+(4*hi+((lane&15)>>2))*64;
  const char*Kbase=shm+LDS_K; bf16x8 kf[8];
  const lds_cptr shm3=(lds_cptr)shm; const lds_cptr kp0=shm3+LDS_K+hi*1024+r32*16; const lds_cptr vp0=shm3+LDS_V+((lane>>4)&1)*32+(lane&3)*8+(4*hi+((lane&15)>>2))*64;
  const int NT=(q0+QB)/KVBLK;
  DMA_K(0,0);DMA_V(0,0);DMA_K(1,SLOTB);
  bf16x8 qr[4];
  #pragma unroll
  for(int d0=0;d0<4;++d0)qr[d0]=*reinterpret_cast<const bf16x8*>(&Qw[(long)r32*DMI+d0*16+hi*8]);
  float mhat=0.f,l_reg=0.f;f32x16 o[2];o[0]=f32x16{};o[1]=f32x16{};f32x16 negm=f32x16{};asm volatile("":"+v"(negm));
  const int qrel=wid*QBLK+r32;
  #define CMASK(P0,P1,t) do{int jb_=(t)-(NT-4); if(jb_>=0)cmask(P0,P1,jb_,qrel,hi);}while(0)
  bool resc=false;
  #define START(P0,P1) do{ const float rm=rowmax(P0,P1); resc=false; \
    { const float dl=rm; mhat=fadd_s(mhat,dl); \
      _Pragma("unroll") for(int r=0;r<16;++r){P0[r]=fsub_s(P0[r],dl);P1[r]=fsub_s(P1[r],dl);} \
      _Pragma("unroll") for(int r=0;r<16;++r)negm[r]=-mhat; asm volatile("":"+v"(negm)); } \
    _Pragma("unroll") for(int r=0;r<16;++r)P0[r]=__builtin_amdgcn_exp2f(P0[r]); }while(0)
  #define RESC() do{ if(resc){ asm volatile("s_waitcnt lgkmcnt(0)":::"memory"); \
      _Pragma("unroll") for(int d_=0;d_<2;++d_) _Pragma("unroll") for(int r=0;r<16;++r)o[d_][r]*=wsf[crow(r,hi)]; } }while(0)
  f32x16 pA0,pA1,pB0,pB1;
  int sl_prev=0,sl_cur=0,sl_next=SLOTB;
  #define ROT() do{sl_prev=sl_cur;sl_cur=sl_next;sl_next=(sl_next==(NSLOT-1)*SLOTB)?0:sl_next+SLOTB;}while(0)
  DMA_K(2,2*SLOTB);
  WAIT_BAR(3);
  qkt(pA0,pA1,Kbase,qr,negm,r32,hi);asm volatile("s_nop 15\n\ts_nop 7":"+v"(pA0),"+v"(pA1));CMASK(pA0,pA1,0);
  START(pA0,pA1);
  _Pragma("unroll") for(int r=0;r<16;++r)pA1[r]=__builtin_amdgcn_exp2f(pA1[r]);
  WAIT_BAR(0);
  DMA_K(3,0);DMA_V(1,SLOTB);
  ROT();
  kload8(kf,kp0+sl_cur);
  WAIT_BAR(2);
  s16x4 vlo[8],vhi[8]; u32x4 pw0,pw1,pw2,pw3;
  #define PKW(P,B) cvtpk_s(P[B],P[B+1])
  #define PAF(k) __builtin_bit_cast(bf16x8,pw##k)
  #define VFR(i) (bf16x8){vlo[i][0],vlo[i][1],vlo[i][2],vlo[i][3],vhi[i][0],vhi[i][1],vhi[i][2],vhi[i][3]}
  #define PIN(x) asm volatile("":"+v"(x))
  #define MX3(a,b,c) __builtin_fmaxf(__builtin_fmaxf((a),(b)),(c))
  #define GAPA(MF,A0,A1,A2,A3,W0,W1,PW) do{ MF; sacc+=A0; sacc+=A1; sacc+=A2; sacc+=A3; PIN(sacc); W0; W1; PIN(PW); SBAR(); }while(0)
  #define EX(v) __builtin_amdgcn_exp2f(v)
  #define GAPB(MF,X,B) do{ MF; X[B]=EX(X[B]); X[B+1]=EX(X[B+1]); X[B+2]=EX(X[B+2]); X[B+3]=EX(X[B+3]); PIN(X); SBAR(); }while(0)
  #define VRD(i) do{ vlo[i]=vtr(vp_+(((i)>>2)*4096+((i)&3)*1024)); vhi[i]=vtr(vp_+(((i)>>2)*4096+((i)&3)*1024+512)); }while(0)
  #define KRD(G,j) do{ if(G){ kload2(kf,kp0+sl_next,j); SBAR(); } }while(0)
  #define STEP(C0,C1,P0,P1,t,GK,GV,GL) do{ SBAR(); \
    const lds_cptr vp_=vp0+sl_prev; \
    VRD(0); SBAR(); float sacc=(P0[0]+P0[1]); \
    GAPA(C0=__builtin_amdgcn_mfma_f32_32x32x16_bf16(kf[0],qr[0],negm,0,0,0), P0[2],P0[3],P0[4],P0[5],     pw0[0]=PKW(P0,0), pw0[1]=PKW(P0,2), pw0); \
    VRD(4); SBAR(); GAPA(C1=__builtin_amdgcn_mfma_f32_32x32x16_bf16(kf[1],qr[0],negm,0,0,0), P0[6],P0[7],P0[8],P0[9],     pw0[2]=PKW(P0,4), pw0[3]=PKW(P0,6), pw0); \
    VRD(1); SBAR(); GAPA(C0=__builtin_amdgcn_mfma_f32_32x32x16_bf16(kf[2],qr[1],C0,0,0,0),   P0[10],P0[11],P0[12],P0[13], pw1[0]=PKW(P0,8), pw1[1]=PKW(P0,10), pw1); \
    VRD(5); SBAR(); GAPA(C1=__builtin_amdgcn_mfma_f32_32x32x16_bf16(kf[3],qr[1],C1,0,0,0),   P0[14],P0[15],P1[0],P1[1],   pw1[2]=PKW(P0,12),pw1[3]=PKW(P0,14), pw1); \
    VRD(2); SBAR(); GAPA(C0=__builtin_amdgcn_mfma_f32_32x32x16_bf16(kf[4],qr[2],C0,0,0,0),   P1[2],P1[3],P1[4],P1[5],     pw2[0]=PKW(P1,0), pw2[1]=PKW(P1,2), pw2); \
    VRD(6); SBAR(); GAPA(C1=__builtin_amdgcn_mfma_f32_32x32x16_bf16(kf[5],qr[2],C1,0,0,0),   P1[6],P1[7],P1[8],P1[9],     pw2[2]=PKW(P1,4), pw2[3]=PKW(P1,6), pw2); \
    VRD(3); SBAR(); GAPA(C0=__builtin_amdgcn_mfma_f32_32x32x16_bf16(kf[6],qr[3],C0,0,0,0),   P1[10],P1[11],P1[12],P1[13], pw3[0]=PKW(P1,8), pw3[1]=PKW(P1,10), pw3); \
    VRD(7); SBAR(); GAPA(C1=__builtin_amdgcn_mfma_f32_32x32x16_bf16(kf[7],qr[3],C1,0,0,0),   P1[14],P1[15],0.f,0.f,       pw3[2]=PKW(P1,12),pw3[3]=PKW(P1,14), pw3); \
    l_reg+=sacc; \
    if(GK){DMA_K((t)+3,sl_cur);} if(GV){DMA_V((t)+1,sl_next);} \
    CMASK(C0,C1,t); \
    { float a=MX3(C0[0],C0[1],C1[0]),b=MX3(C0[2],C0[3],C1[1]); a=MX3(a,C1[2],C1[3]); \
      _Pragma("unroll") for(int r=4;r<16;r+=4){a=MX3(a,C0[r],C0[r+1]);b=MX3(b,C0[r+2],C0[r+3]);a=MX3(a,C1[r],C1[r+1]);b=MX3(b,C1[r+2],C1[r+3]);} \
      float rm=__builtin_fmaxf(a,b); { auto rr=__builtin_amdgcn_permlane32_swap(__float_as_uint(rm),__float_as_uint(rm),false,false); rm=__builtin_fmaxf(__uint_as_float(rr[0]),__uint_as_float(rr[1])); } \
      resc=false; \
      if(__builtin_expect(__any(rm>(float)THRL),0)){ const float dl=__builtin_fmaxf(rm,0.f); mhat+=dl; \
        _Pragma("unroll") for(int r=0;r<16;++r){C0[r]-=dl;C1[r]-=dl;} \
        _Pragma("unroll") for(int r=0;r<16;++r)negm[r]=-mhat; asm volatile("":"+v"(negm)); \
        const float f=__builtin_amdgcn_exp2f(-dl); l_reg*=f; if(hi==0)wsf[r32]=f; resc=true; } } \
    SBAR(); \
    GAPB(o[0]=__builtin_amdgcn_mfma_f32_32x32x16_bf16(PAF(0),VFR(0),o[0],0,0,0), C0,0); \
    GAPB(o[1]=__builtin_amdgcn_mfma_f32_32x32x16_bf16(PAF(0),VFR(4),o[1],0,0,0), C0,4); \
    KRD(GL,0); GAPB(o[0]=__builtin_amdgcn_mfma_f32_32x32x16_bf16(PAF(1),VFR(1),o[0],0,0,0), C0,8); \
    KRD(GL,1); GAPB(o[1]=__builtin_amdgcn_mfma_f32_32x32x16_bf16(PAF(1),VFR(5),o[1],0,0,0), C0,12); \
    KRD(GL,2); GAPB(o[0]=__builtin_amdgcn_mfma_f32_32x32x16_bf16(PAF(2),VFR(2),o[0],0,0,0), C1,0); \
    KRD(GL,3); GAPB(o[1]=__builtin_amdgcn_mfma_f32_32x32x16_bf16(PAF(2),VFR(6),o[1],0,0,0), C1,4); \
    GAPB(o[0]=__builtin_amdgcn_mfma_f32_32x32x16_bf16(PAF(3),VFR(3),o[0],0,0,0), C1,8); \
    GAPB(o[1]=__builtin_amdgcn_mfma_f32_32x32x16_bf16(PAF(3),VFR(7),o[1],0,0,0), C1,12); \
    }while(0)
  int t=1;
  #undef CMASK
  #define CMASK(P0,P1,t) do{}while(0)
  for(;t+5<NT;t+=2){
    STEP(pB0,pB1,pA0,pA1,t,true,true,true);     WAIT_BAR(2); RESC(); ROT();
    STEP(pA0,pA1,pB0,pB1,t+1,true,true,true);   WAIT_BAR(2); RESC(); ROT();
  }
  #undef CMASK
  #define CMASK(P0,P1,t) do{int jb_=(t)-(NT-4); if(jb_>=0)cmask(P0,P1,jb_,qrel,hi);}while(0)
  #define ENDW(tt) do{ if((tt)+3<NT){WAIT_BAR(2);} else if((tt)+2<NT){WAIT_BAR(1);} else {WAIT_BAR(0);} }while(0)
  for(;t+1<NT;t+=2){
    STEP(pB0,pB1,pA0,pA1,t,(t+3<NT),(t+1<NT),(t+1<NT));       ENDW(t);   RESC(); ROT();
    STEP(pA0,pA1,pB0,pB1,t+1,(t+4<NT),(t+2<NT),(t+2<NT));     ENDW(t+1); RESC(); ROT();
  }
  STEP(pB0,pB1,pA0,pA1,NT-1,false,false,false); RESC();
  { float sacc=pB0[0]+pB0[1]; _Pragma("unroll") for(int r=2;r<16;++r)sacc+=pB0[r]; _Pragma("unroll") for(int r=0;r<16;++r)sacc+=pB1[r]; l_reg+=sacc;
    pw0=(u32x4){PKW(pB0,0),PKW(pB0,2),PKW(pB0,4),PKW(pB0,6)};pw1=(u32x4){PKW(pB0,8),PKW(pB0,10),PKW(pB0,12),PKW(pB0,14)};pw2=(u32x4){PKW(pB1,0),PKW(pB1,2),PKW(pB1,4),PKW(pB1,6)};pw3=(u32x4){PKW(pB1,8),PKW(pB1,10),PKW(pB1,12),PKW(pB1,14)};
    SBAR(); pv(o,vb0+sl_cur,PAF(0),PAF(1),PAF(2),PAF(3)); }
  #undef PKW
  #undef PAF
  #undef VFR
  #undef PIN
  #undef MX3
  #undef GAPA
  #undef GAPB
  #undef EX
  #undef VRD
  #undef KRD
  #undef STEP
  #undef ENDW
  {auto rr=__builtin_amdgcn_permlane32_swap(__float_as_uint(l_reg),__float_as_uint(l_reg),false,false);l_reg=__uint_as_float(rr[0])+__uint_as_float(rr[1]);}
  if(hi==0)wsf[32+r32]=l_reg;asm volatile("s_waitcnt lgkmcnt(0)":::"memory");
  float rli[16];
  #pragma unroll
  for(int r=0;r<16;++r)rli[r]=__builtin_amdgcn_rcpf(wsf[32+crow(r,hi)]);
  bf16*Ow=O+(rowbase+q0+wid*QBLK)*DMO+h*D;
  { bf16*stg=(bf16*)(shm+LDS_OST)+wid*2048;
    #pragma unroll
    for(int r=0;r<16;++r){const int orow=crow(r,hi);
      #pragma unroll
      for(int d0=0;d0<2;++d0)stg[orow*64+d0*32+r32]=__float2bfloat16(o[d0][r]*rli[r]);}
    asm volatile("s_waitcnt lgkmcnt(0)":::"memory");
    #pragma unroll
    for(int i=0;i<4;++i){const int row=i*8+(lane>>3),ch=lane&7; const u32x4 v=*(const u32x4*)(stg+row*64+ch*8); ATTN_STORE16(Ow+(long)row*DMO+ch*8,v);} }
  asm volatile("s_waitcnt lgkmcnt(0)\n\ts_barrier":::"memory");
  #undef DMA_K
  #undef DMA_V
  #undef CMASK
  #undef START
  #undef RESC
  #undef ROT
}
constexpr int ATTN_LDS_BYTES=LDS_BYTES;
struct AttnTensors { const bf16* Q; const bf16* K; const bf16* V; bf16* O; };
struct AttnUnit { int bh; int qb; };
struct StaticOrder {
  int vcu;
  __device__ __forceinline__ explicit StaticOrder(int grid,int block):vcu((block%8)*(grid/8)+block/8){}
  __device__ __forceinline__ bool next(int i,AttnUnit&u)const{ if(i>=4)return false; const int s=vcu&7; u.bh=vcu>>3; u.qb=(i==0)?s:(i==1)?15-s:(i==2)?16+s:31-s; return true; }
  __device__ __forceinline__ void a_ready(const AttnUnit&)const{}
  __device__ __forceinline__ void done(const AttnUnit&)const{}
};
template<class Sched,int THRL=8> __device__ __forceinline__ void attn_phase(char*lds,const AttnTensors&T,const Sched&S){
  AttnUnit u;
  for(int i=0;S.next(i,u);++i){ S.a_ready(u); attn_unit<THRL>(u.bh/NHEAD,u.bh%NHEAD,u.qb,T.Q,T.K,T.V,T.O,lds); S.done(u); }
}
#undef SBAR
#undef WAIT_BAR
}

#define LAS __attribute__((address_space(3)))
typedef unsigned short bfu;
typedef unsigned v4u __attribute__((ext_vector_type(4)));
typedef unsigned v2u __attribute__((ext_vector_type(2)));
typedef float f32x4 __attribute__((ext_vector_type(4)));
typedef float f32x8 __attribute__((ext_vector_type(8)));
typedef float f32x16 __attribute__((ext_vector_type(16)));
typedef float f32x2 __attribute__((ext_vector_type(2)));

constexpr int NWAVES = 8, NTHR = 512;
constexpr int MP = 65536, MS = 128, MR = MP + MS, MPAD = 65792;
constexpr int NIN = 3840, FFD = 4096;
constexpr int NPHASE = 24;
#ifndef MK_ONE_LAUNCH
#define MK_ONE_LAUNCH 1
#endif

constexpr size_t O_Y = 0;
constexpr size_t O_YS = (size_t)MP * 1024;
constexpr size_t O_ACP = O_YS + 128 * 1024;
constexpr size_t O_ADP = O_ACP + 2 * 8 * 3 * 768;
constexpr size_t O_BKP = O_ADP + 2 * 8 * 4 * 64 * 64;
constexpr size_t O_BVP = O_BKP + (size_t)2 * 8 * 8192 * 512;
constexpr size_t O_CSP = O_BVP + (size_t)2 * 8 * 8192 * 512;
constexpr size_t O_CWP = O_CSP + 2 * 8 * 1024;
constexpr size_t O_ACS = O_CWP + 2 * 8 * 4 * 64 * 64;
constexpr size_t O_ADS = O_ACS + 2 * 8 * 3 * 768;
constexpr size_t O_BKS = O_ADS + 2 * 8 * 4 * 64 * 64;
constexpr size_t O_BVS = O_BKS + 2 * 8 * 16 * 512;
constexpr size_t O_CSS = O_BVS + 2 * 8 * 16 * 512;
constexpr size_t O_CWS = O_CSS + 2 * 8 * 1024;
constexpr size_t O_END = O_CWS + 2 * 8 * 4 * 64 * 64;
static_assert(O_END == 202874880, "output size");

constexpr size_t MiB = 1u << 20;
constexpr size_t WS_CTL = 0;
constexpr size_t WS_RS = 64 * 1024;
constexpr size_t WS_BONUS = 2 * MiB;
constexpr size_t WS_GAB = 3 * MiB + 512 * 1024;
constexpr size_t WS_AB = 6 * MiB;
constexpr size_t WS_ROPE = 8 * MiB + 512 * 1024;
constexpr size_t WS_GCH = 10 * MiB + 512 * 1024;
constexpr size_t WS_W = 12 * MiB;
constexpr size_t W_IN = 0, W_OUT = W_IN + (size_t)NIN * 1024 * 2, W_FF1 = W_OUT + 1024 * 1024 * 2, W_FF2 = W_FF1 + 4096 * 1024 * 2,
                 W_GATE = W_FF2 + 4096 * 1024 * 2, W_PP = W_GATE + 1024 * 1024 * 2, W_LR = W_PP + 1024 * 256 * 2, W_END = W_LR + 768 * 256 * 2;
constexpr size_t WS_SLOT = 41 * MiB;
constexpr size_t USLOT = (size_t)MPAD * 1024;
static_assert(WS_W + W_END <= WS_SLOT, "weights");
constexpr size_t WS_PAIRC = WS_SLOT + 15 * USLOT;
constexpr size_t WS_PAIRD = WS_PAIRC + 4 * (size_t)(MPAD / 2) * 16;
constexpr size_t WS_TOTAL = WS_PAIRD + 4 * (size_t)(MPAD / 2) * 8;
static_assert(WS_TOTAL <= (size_t)1024 * MiB, "ws");
static_assert(WS_RS + 7 * (size_t)MPAD * 4 <= WS_BONUS && WS_BONUS + 4 * (size_t)MPAD * 4 <= WS_GAB && WS_GAB + 8 * (size_t)MPAD * 4 <= WS_AB && WS_AB + 8 * (size_t)MPAD * 4 <= WS_ROPE && WS_ROPE + 8192 * 64 * 4 <= WS_GCH && WS_GCH + 4 * 1032 * 64 * 4 <= WS_W, "ctl map");

__device__ __forceinline__ unsigned char* slotp(unsigned char* ws, int l, int s) {
    if (l & 1) { if (s < 2) s += 13; else if (s >= 13) s -= 13; }
    return ws + WS_SLOT + (size_t)s * USLOT;
}
__device__ __forceinline__ unsigned char* slotph(unsigned char* ws, int l, int s) { return slotp(ws, l, s) + USLOT / 2; }

constexpr int RING_BYTES = 131072, MISC_OFF = RING_BYTES + 320, LDS_BYTES = 147456;

#define LDS_WAIT() asm volatile("s_waitcnt lgkmcnt(0)" ::: "memory")
__device__ __forceinline__ float bf2f(unsigned short u) { return __uint_as_float(((unsigned)u) << 16); }
__device__ __forceinline__ unsigned f2bf(float f) { unsigned u = __builtin_bit_cast(unsigned, f); return (u + 0x7fffu + ((u >> 16) & 1u)) >> 16; }
__device__ __forceinline__ unsigned pk2(float lo, float hi) { return f2bf(lo) | (f2bf(hi) << 16); }
#define DPP_ROR_ADD(v, ctrl) ((v) + __builtin_bit_cast(float, __builtin_amdgcn_update_dpp(0, __builtin_bit_cast(int, (v)), (ctrl), 0xf, 0xf, false)))
__device__ __forceinline__ float wave_sum(float v) {
    v = DPP_ROR_ADD(v, 0x128); v = DPP_ROR_ADD(v, 0x124); v = DPP_ROR_ADD(v, 0x122); v = DPP_ROR_ADD(v, 0x121);
    v += __shfl_xor(v, 16);
    const unsigned u = __float_as_uint(v); auto rr = __builtin_amdgcn_permlane32_swap(u, u, false, false);
    return __uint_as_float(rr[0]) + __uint_as_float(rr[1]);
}
__device__ __forceinline__ float sigm(float x) { return 1.f / (1.f + __expf(-x)); }
__device__ __forceinline__ float softplusf(float x) { return x > 20.f ? x : log1pf(__expf(x)); }

struct Args { const float* in[40]; float* out; unsigned char* ws; int ph_lo, ph_hi; };
typedef const __attribute__((address_space(4))) Args* KArgs;

constexpr float ATT_C2 = 0.125f * 1.4426950408889634f;
struct EpiG1 {
    static constexpr bool PERM = true, AFTER_DRAIN = false;
    const float* rs; bfu *aqkvz, *qb, *kb, *vb, *craw; float* ab; const float* rope; float *okp, *ovp, *oks, *ovs;
    __device__ __forceinline__ void operator()(const pg8::f32x4 (&acc)[2][2][4][2], const pg8::Unit& u, int wr, int wc, int fr, int fq) const {
        const int pn = u.pn; const int rowb = u.pm * 256 + wr * 64 + fr; const int cl = wc * 32 + 8 * fq;
#pragma unroll
        for (int ai = 0; ai < 2; ++ai)
#pragma unroll
            for (int m = 0; m < 4; ++m) {
                const int row = rowb + ai * 128 + m * 16;
                const float s = rsqrtf(rs[row] * (1.f / 1024.f) + 1e-6f);
                if (pn < 4 || (pn >= 10 && pn < 14)) {
                    bfu* dst = (pn < 4 ? aqkvz + pn * 256 : craw + (pn - 10) * 256) + (size_t)row * 1024 + cl;
#pragma unroll
                    for (int bj = 0; bj < 2; ++bj) { const pg8::f32x4 v0 = acc[ai][bj][m][0] * s, v1 = acc[ai][bj][m][1] * s;
                        v4u w; w.x = pg8::cvt_pk_bf16(v0[0], v0[1]); w.y = pg8::cvt_pk_bf16(v0[2], v0[3]); w.z = pg8::cvt_pk_bf16(v1[0], v1[1]); w.w = pg8::cvt_pk_bf16(v1[2], v1[3]); *(v4u*)(dst + bj * 128) = w; }
                } else if (pn < 8) {
                    const bool isk = pn >= 6;
                    const int pos = row < MP ? (row & 8191) : 2048 + ((row - MP) & 15);
                    const int i0 = (wc & 1) * 16 + 4 * fq;
                    const pg8::f32x4 c4 = *(const pg8::f32x4*)(rope + pos * 64 + i0), s4 = *(const pg8::f32x4*)(rope + pos * 64 + 32 + i0);
#pragma unroll
                    for (int bj = 0; bj < 2; ++bj) {
                        const pg8::f32x4 x1 = acc[ai][bj][m][0] * s, x2 = acc[ai][bj][m][1] * s;
                        pg8::f32x4 o1 = x1 * c4 - x2 * s4, o2 = x2 * c4 + x1 * s4;
                        if (!isk) {
                            o1 = o1 * ATT_C2; o2 = o2 * ATT_C2;
                            v4u w; w.x = pg8::cvt_pk_bf16(o1[0], o1[1]); w.y = pg8::cvt_pk_bf16(o1[2], o1[3]); w.z = pg8::cvt_pk_bf16(o2[0], o2[1]); w.w = pg8::cvt_pk_bf16(o2[2], o2[3]);
                            *(v4u*)(qb + (size_t)row * 512 + (pn - 4) * 256 + bj * 128 + cl) = w;
                        } else {
                            v4u w; w.x = pg8::cvt_pk_bf16(o1[0], o1[1]); w.y = pg8::cvt_pk_bf16(o1[2], o1[3]); w.z = pg8::cvt_pk_bf16(o2[0], o2[1]); w.w = pg8::cvt_pk_bf16(o2[2], o2[3]);
                            *(v4u*)(kb + (size_t)row * 512 + (pn - 6) * 256 + bj * 128 + cl) = w;
                            if (row < MR) {
                                float* ob = (row < MP ? okp + (size_t)row * 512 : oks + (size_t)(row - MP) * 512) + (pn - 6) * 256 + bj * 128 + (wc >> 1) * 64 + (wc & 1) * 16 + 4 * fq;
                                *(pg8::f32x4*)ob = o1; *(pg8::f32x4*)(ob + 32) = o2;
                            }
                        }
                    }
                } else if (pn < 10) {
#pragma unroll
                    for (int bj = 0; bj < 2; ++bj) {
                        const pg8::f32x4 v0 = acc[ai][bj][m][0] * s, v1 = acc[ai][bj][m][1] * s; const int col = (pn - 8) * 256 + bj * 128 + cl;
                        v4u w; w.x = pg8::cvt_pk_bf16(v0[0], v0[1]); w.y = pg8::cvt_pk_bf16(v0[2], v0[3]); w.z = pg8::cvt_pk_bf16(v1[0], v1[1]); w.w = pg8::cvt_pk_bf16(v1[2], v1[3]);
                        *(v4u*)(vb + (size_t)row * 512 + col) = w;
                        if (row < MR) { float* ob = (row < MP ? ovp + (size_t)row * 512 : ovs + (size_t)(row - MP) * 512) + col; *(pg8::f32x4*)ob = v0; *(pg8::f32x4*)(ob + 4) = v1; }
                    }
                } else {
                    if (wc == 0 && fq == 0) { const pg8::f32x4 v0 = acc[ai][0][m][0] * s, v1 = acc[ai][0][m][1] * s; *(pg8::f32x4*)(ab + (size_t)row * 8) = v0; *(pg8::f32x4*)(ab + (size_t)row * 8 + 4) = v1; }
                }
            }
    }
};
template <int MODE> struct EpiB {
    static constexpr bool PERM = true, AFTER_DRAIN = false;
    bfu* O; int ldc; const float* rs;
    __device__ __forceinline__ void operator()(const pg8::f32x4 (&acc)[2][2][4][2], const pg8::Unit& u, int wr, int wc, int fr, int fq) const {
        const int rowb = u.pm * 256 + wr * 64 + fr; const int cl = u.pn * 256 + wc * 32 + 8 * fq;
#pragma unroll
        for (int ai = 0; ai < 2; ++ai)
#pragma unroll
            for (int m = 0; m < 4; ++m) {
                const int row = rowb + ai * 128 + m * 16;
                float s = 1.f; if (MODE == 1) s = rsqrtf(rs[row] * (1.f / 1024.f) + 1e-6f);
                bfu* dst = O + (size_t)row * ldc + cl;
#pragma unroll
                for (int bj = 0; bj < 2; ++bj) {
                    pg8::f32x4 v0 = acc[ai][bj][m][0], v1 = acc[ai][bj][m][1];
                    if (MODE == 1) { v0 = v0 * s; v1 = v1 * s;
                        v0[0] = fmaxf(v0[0], 0.f); v0[1] = fmaxf(v0[1], 0.f); v0[2] = fmaxf(v0[2], 0.f); v0[3] = fmaxf(v0[3], 0.f); v1[0] = fmaxf(v1[0], 0.f); v1[1] = fmaxf(v1[1], 0.f); v1[2] = fmaxf(v1[2], 0.f); v1[3] = fmaxf(v1[3], 0.f);
                        v0 = v0 * v0; v1 = v1 * v1; }
                    v4u w; w.x = pg8::cvt_pk_bf16(v0[0], v0[1]); w.y = pg8::cvt_pk_bf16(v0[2], v0[3]); w.z = pg8::cvt_pk_bf16(v1[0], v1[1]); w.w = pg8::cvt_pk_bf16(v1[2], v1[3]);
                    *(v4u*)(dst + bj * 128) = w;
                }
            }
    }
};
template <int MODE> struct EpiH {
    static constexpr bool PERM = true, AFTER_DRAIN = false;
    float* H; bfu* xh; float* rsn; const float* rs; const bfu* pp;
    __device__ __forceinline__ void operator()(const pg8::f32x4 (&acc)[2][2][4][2], const pg8::Unit& u, int wr, int wc, int fr, int fq) const {
        const int rowb = u.pm * 256 + wr * 64 + fr; const int cl = u.pn * 256 + wc * 32 + 8 * fq;
#pragma unroll
        for (int ai = 0; ai < 2; ++ai)
#pragma unroll
            for (int m = 0; m < 4; ++m) {
                const int row = rowb + ai * 128 + m * 16; const bool valid = row < MR; float ss = 0.f;
                if (valid) {
                    float s = 1.f; if (MODE == 3) s = rsqrtf(rs[row] * (1.f / 1024.f) + 1e-6f);
#pragma unroll
                    for (int bj = 0; bj < 2; ++bj) {
                        const size_t off = (size_t)row * 1024 + cl + bj * 128;
                        pg8::f32x4 h0 = *(const pg8::f32x4*)(H + off), h1 = *(const pg8::f32x4*)(H + off + 4); const pg8::f32x4 a0 = acc[ai][bj][m][0], a1 = acc[ai][bj][m][1];
                        if (MODE == 3) { const v4u pw = *(const v4u*)(pp + off);
                            h0[0] += sigm(a0[0] * s) * __uint_as_float(pw.x << 16); h0[1] += sigm(a0[1] * s) * __uint_as_float(pw.x & 0xffff0000u);
                            h0[2] += sigm(a0[2] * s) * __uint_as_float(pw.y << 16); h0[3] += sigm(a0[3] * s) * __uint_as_float(pw.y & 0xffff0000u);
                            h1[0] += sigm(a1[0] * s) * __uint_as_float(pw.z << 16); h1[1] += sigm(a1[1] * s) * __uint_as_float(pw.z & 0xffff0000u);
                            h1[2] += sigm(a1[2] * s) * __uint_as_float(pw.w << 16); h1[3] += sigm(a1[3] * s) * __uint_as_float(pw.w & 0xffff0000u);
                        } else { h0 = h0 + a0; h1 = h1 + a1; }
                        *(pg8::f32x4*)(H + off) = h0; *(pg8::f32x4*)(H + off + 4) = h1;
                        v4u w; w.x = pg8::cvt_pk_bf16(h0[0], h0[1]); w.y = pg8::cvt_pk_bf16(h0[2], h0[3]); w.z = pg8::cvt_pk_bf16(h1[0], h1[1]); w.w = pg8::cvt_pk_bf16(h1[2], h1[3]); *(v4u*)(xh + off) = w;
                        ss += ((h0[0] * h0[0] + h0[1] * h0[1]) + (h0[2] * h0[2] + h0[3] * h0[3])) + ((h1[0] * h1[0] + h1[1] * h1[1]) + (h1[2] * h1[2] + h1[3] * h1[3]));
                    }
                }
                ss += __shfl_xor(ss, 16); ss += __shfl_xor(ss, 32);
                if (valid && fq == 0) unsafeAtomicAdd(rsn + row, ss);
            }
    }
};

__device__ __forceinline__ int win_src(int nd) {
    if (nd < 1024) return nd;
    if (nd < 2048) { const int c = nd - 1024, p = c & 63, grp = c >> 6; const int s = p >> 5, fq_ = (p >> 3) & 3, n_ = (p >> 2) & 1, j_ = p & 3; return 1032 + grp * 64 + n_ * 32 + s * 16 + 4 * fq_ + j_; }
    if (nd < 2560) return 2056 + (nd - 2048);
    if (nd < 3584) return 2568 + (nd - 2560);
    if (nd < 3592) return 1024 + (nd - 3584);
    return -1;
}
template <bool MAP> __device__ __forceinline__ void wt_item(const float* W, int K, int Nsrc, bfu* WT, const float* gain, LAS float* scr, int item, int nblk, int lane) {
    const int kb = item / nblk, nb = item % nblk, k0 = 64 * kb, n0 = 32 * nb;
    const int nd = n0 + (lane & 31); const int src = MAP ? win_src(nd) : nd;
#pragma unroll 8
    for (int i = 0; i < 32; ++i) { const int kk = 2 * i + (lane >> 5); float v = src >= 0 ? W[(size_t)(k0 + kk) * Nsrc + src] : 0.f; if (gain) v *= gain[k0 + kk]; scr[kk * 33 + (lane & 31)] = v; }
    LDS_WAIT(); asm volatile("" ::: "memory");
    const int c = lane & 7;
#pragma unroll
    for (int j = 0; j < 4; ++j) { const int n = (lane >> 3) + 8 * j; const LAS float* s = scr + (8 * c) * 33 + n;
        v4u o; o.x = pk2(s[0 * 33], s[1 * 33]); o.y = pk2(s[2 * 33], s[3 * 33]); o.z = pk2(s[4 * 33], s[5 * 33]); o.w = pk2(s[6 * 33], s[7 * 33]);
        *(v4u*)(WT + (size_t)(n0 + n) * K + k0 + 8 * c) = o; }
    LDS_WAIT(); asm volatile("" ::: "memory");
}
__device__ __forceinline__ void conv_weights(KArgs A, int l, int mask, LAS unsigned char* lds, int gw, int NGW, int lane, int wave) {
    LAS float* scr = (LAS float*)(lds + wave * 16384);
    unsigned char* wb = A->ws + WS_W;
    if (mask & 1) {
        const float* win = A->in[11] + (size_t)l * 1024 * 3592; const float* g = A->in[10] + l * 1024;
        for (int it = gw; it < 16 * 120; it += NGW) wt_item<true>(win, 1024, 3592, (bfu*)(wb + W_IN), g, scr, it, 120, lane);
        const float* wu = A->in[23] + (size_t)l * 64 * 256; const float* au = A->in[25] + (size_t)l * 64 * 256; const float* gu = A->in[26] + (size_t)l * 128 * 256;
        bfu* lr = (bfu*)(wb + W_LR);
        for (int i = gw * 64 + lane; i < 768 * 256; i += NGW * 64) { const int n = i >> 8, k = i & 255; float v = 0.f;
            if (n < 256) { if (k < 64) v = wu[k * 256 + n]; } else if (n < 512) { if (k >= 64 && k < 128) v = au[(k - 64) * 256 + (n - 256)]; } else { if (k >= 128) v = gu[(k - 128) * 256 + (n - 512)]; }
            lr[i] = (bfu)f2bf(v); }
    }
    if (mask & 2) {
        const float* wo = A->in[32] + (size_t)l * 1024 * 1024; const float* f1 = A->in[34] + (size_t)l * 1024 * 4096; const float* f2 = A->in[35] + (size_t)l * 4096 * 1024;
        const float* wg = A->in[37] + (size_t)l * 1024 * 1024; const float* wp = A->in[38] + (size_t)l * 256 * 1024;
        const float* gf = A->in[33] + l * 1024; const float* gp = A->in[36] + l * 1024;
        constexpr int I_O = 16 * 32, I_1 = 16 * 128, I_2 = 64 * 32, I_G = 16 * 32, I_P = 4 * 32;
        for (int it = gw; it < I_O + I_1 + I_2 + I_G + I_P; it += NGW) {
            int r = it;
            if (r < I_O) { wt_item<false>(wo, 1024, 1024, (bfu*)(wb + W_OUT), nullptr, scr, r, 32, lane); continue; } r -= I_O;
            if (r < I_1) { wt_item<false>(f1, 1024, 4096, (bfu*)(wb + W_FF1), gf, scr, r, 128, lane); continue; } r -= I_1;
            if (r < I_2) { wt_item<false>(f2, 4096, 1024, (bfu*)(wb + W_FF2), nullptr, scr, r, 32, lane); continue; } r -= I_2;
            if (r < I_G) { wt_item<false>(wg, 1024, 1024, (bfu*)(wb + W_GATE), gp, scr, r, 32, lane); continue; } r -= I_G;
            wt_item<false>(wp, 256, 1024, (bfu*)(wb + W_PP), nullptr, scr, r, 32, lane);
        }
    }
}
__device__ __forceinline__ void conv_p(KArgs A, int l, bfu* pb, int gtid, int NT) {
    const float* pp = A->in[8] + (size_t)l * MP * 256; const float* ps = A->in[9] + (size_t)l * MS * 256;
    for (int i = gtid; i < MR * 64; i += NT) { const int m = i >> 6, c = (i & 63) * 4;
        const f32x4 v = *(const f32x4*)(m < MP ? pp + (size_t)m * 256 + c : ps + (size_t)(m - MP) * 256 + c);
        v2u w; w.x = pk2(v[0], v[1]); w.y = pk2(v[2], v[3]); *(v2u*)(pb + (size_t)m * 256 + c) = w; }
}
__device__ __forceinline__ void prologue(KArgs A, LAS unsigned char* lds, int gw, int NGW, int lane, int wave, int gtid, int NT) {
    conv_weights(A, 0, 3, lds, gw, NGW, lane, wave);
    unsigned char* ws = A->ws;
    float* rs = (float*)(ws + WS_RS); bfu* xh = (bfu*)slotp(ws, 0, 0); float* H = A->out;
    for (int i = gtid; i < 6 * MPAD; i += NT) rs[MPAD + i] = 0.f;
    for (int g = gw; g < MPAD / 4; g += NGW) {
        const int m0 = 4 * g;
        if (m0 < MR) {
            f32x4 v[4][4];
#pragma unroll
            for (int i = 0; i < 4; ++i) { const int m = m0 + i; const float* xr = m < MP ? A->in[0] + (size_t)m * 1024 : A->in[1] + (size_t)(m - MP) * 1024;
#pragma unroll
                for (int j = 0; j < 4; ++j) v[i][j] = *(const f32x4*)(xr + j * 256 + lane * 4); }
#pragma unroll
            for (int i = 0; i < 4; ++i) { const int m = m0 + i; float ss = 0.f;
#pragma unroll
                for (int j = 0; j < 4; ++j) { const f32x4 w4 = v[i][j]; *(f32x4*)(H + (size_t)m * 1024 + j * 256 + lane * 4) = w4;
                    v2u w; w.x = pk2(w4[0], w4[1]); w.y = pk2(w4[2], w4[3]); *(v2u*)(xh + (size_t)m * 1024 + j * 256 + lane * 4) = w; ss += (w4[0] * w4[0] + w4[1] * w4[1]) + (w4[2] * w4[2] + w4[3] * w4[3]); }
                ss = wave_sum(ss); if (lane == 0) rs[m] = ss; }
        } else {
#pragma unroll
            for (int i = 0; i < 4; ++i) { const int m = m0 + i;
#pragma unroll
                for (int j = 0; j < 4; ++j) *(v2u*)(xh + (size_t)m * 1024 + j * 256 + lane * 4) = (v2u){0u, 0u};
                if (lane == 0) rs[m] = 1024.f; }
        }
    }
    float* rope = (float*)(ws + WS_ROPE);
    for (int i = gtid; i < 8192 * 32; i += NT) { const int pos = i >> 5, k = i & 31;
        const float inv = exp2f(-(float)k * (13.287712379549449f / 32.0f)); const float ang = (float)pos * inv;
        const float nn = rintf(ang * 0.15915494309189535f); const float fr = fmaf(-nn, 1.9353071795864769e-3f, fmaf(-nn, 6.28125f, ang));
        rope[pos * 64 + k] = __cosf(fr); rope[pos * 64 + 32 + k] = __sinf(fr); }
    if (gw == 0) {
        for (int l = 0; l < 2; ++l) {
            const float a = wave_sum(A->in[16][l * 64 + lane] * A->in[17][l * 64 + lane]), b = wave_sum(A->in[18][l * 64 + lane] * A->in[19][l * 64 + lane]);
            const float li = 0.8f - 0.6f * expf(-0.3f * (float)l);
            if (lane == 0) { float* lf = (float*)(ws + WS_CTL + 1024); lf[2 * l] = expf(a) - expf(b) + li; lf[2 * l + 1] = li; }
        }
    }
}

__device__ __forceinline__ void prep_a(KArgs A, int l, int gw, int NGW, int lane) {
    unsigned char* ws = A->ws;
    const bfu* aq = (const bfu*)slotp(ws, l, 2); const float* ab = (const float*)(ws + WS_AB);
    float* sia = (float*)slotp(ws, l, 9); bfu* va = (bfu*)slotp(ws, l, 11); bfu* zs = (bfu*)slotph(ws, l, 11); float* gab = (float*)(ws + WS_GAB);
    const float* cw = A->in[12] + l * 4 * 768; const float* stc = A->in[4] + (size_t)l * 8 * 3 * 768;
    const float* anorm = A->in[15] + l * 64;
    for (int g = gw; g < MR / 4; g += NGW) {
        const int m0 = 4 * g; int t0, L, sb = 0; const bool smp = m0 >= MP; float* aco;
        if (!smp) { t0 = m0 & 8191; L = 8192; aco = A->out + O_ACP + ((size_t)(l * 8 + (m0 >> 13)) * 3) * 768; }
        else { sb = (m0 - MP) >> 4; t0 = (m0 - MP) & 15; L = 16; aco = A->out + O_ACS + ((size_t)(l * 8 + sb) * 3) * 768; }
#pragma unroll 1
        for (int h = 0; h < 4; ++h) {
            float rows[3][7];
#pragma unroll
            for (int gi = 0; gi < 3; ++gi) { const int c = gi * 256 + h * 64 + lane;
#pragma unroll
                for (int r = 0; r < 7; ++r) { const int tt = t0 - 3 + r;
                    rows[gi][r] = tt >= 0 ? bf2f(aq[(size_t)(m0 - 3 + r) * 1024 + c]) : (smp ? stc[((size_t)sb * 3 + (3 + tt)) * 768 + c] : 0.f); } }
            float zv[4];
#pragma unroll
            for (int i = 0; i < 4; ++i) zv[i] = bf2f(aq[(size_t)(m0 + i) * 1024 + 768 + h * 64 + lane]);
            float val[4][3];
#pragma unroll
            for (int gi = 0; gi < 3; ++gi) { const int c = gi * 256 + h * 64 + lane; const float w0 = cw[c], w1 = cw[768 + c], w2 = cw[1536 + c], w3 = cw[2304 + c];
#pragma unroll
                for (int i = 0; i < 4; ++i) { const float y = rows[gi][i] * w0 + rows[gi][i + 1] * w1 + rows[gi][i + 2] * w2 + rows[gi][i + 3] * w3; val[i][gi] = y * sigm(y);
                    if (t0 + i >= L - 3) aco[(size_t)(t0 + i - (L - 3)) * 768 + c] = rows[gi][i + 3]; } }
#pragma unroll
            for (int i = 0; i < 4; ++i) { const int m = m0 + i;
                const float sq = wave_sum(val[i][0] * val[i][0]), sk = wave_sum(val[i][1] * val[i][1]);
                const float qn = val[i][0] * rsqrtf(sq + 1e-6f) * 0.125f, kn = val[i][1] * rsqrtf(sk + 1e-6f);
                float* rec = sia + ((size_t)(h * 8 + (lane >> 3)) * MPAD + m) * 16 + (lane & 7);
                rec[0] = kn; rec[8] = qn;
                va[(size_t)m * 256 + h * 64 + lane] = (bfu)f2bf(val[i][2]);
                zs[(size_t)m * 256 + h * 64 + lane] = (bfu)f2bf(zv[i] * sigm(zv[i]) * anorm[lane]); }
        }
        if (lane < 16) { const int m = m0 + (lane >> 2), hh = lane & 3;
            const float gl = -__expf(A->in[13][l * 4 + hh]) * softplusf(ab[(size_t)m * 8 + hh] + A->in[14][l * 4 + hh]);
            gab[((size_t)hh * MPAD + m) * 2] = __expf(gl); gab[((size_t)hh * MPAD + m) * 2 + 1] = sigm(ab[(size_t)m * 8 + 4 + hh]); }
    }
}
__device__ __forceinline__ void prep_c1(KArgs A, int l, int gw, int NGW, int lane) {
    unsigned char* ws = A->ws;
    const bfu* cr = (const bfu*)slotp(ws, l, 7); bfu* lra = (bfu*)slotp(ws, l, 12);
    const float* mu = A->in[21] + l * 1024; const float* sts = A->in[6] + (size_t)l * 8 * 1024;
    for (int g = gw; g < MR / 4; g += NGW) {
        const int m0 = 4 * g; int t0, L, sb = 0; const bool smp = m0 >= MP; float* cso;
        if (!smp) { t0 = m0 & 8191; L = 8192; cso = A->out + O_CSP + (size_t)(l * 8 + (m0 >> 13)) * 1024; }
        else { sb = (m0 - MP) >> 4; t0 = (m0 - MP) & 15; L = 16; cso = A->out + O_CSS + (size_t)(l * 8 + sb) * 1024; }
        float rows[4][5];
#pragma unroll
        for (int i = 0; i < 4; ++i) { const int j = 768 + lane + 64 * i;
            rows[i][0] = t0 > 0 ? bf2f(cr[(size_t)(m0 - 1) * 1024 + j]) : (smp ? sts[(size_t)sb * 1024 + j] : 0.f);
#pragma unroll
            for (int r = 0; r < 4; ++r) rows[i][r + 1] = bf2f(cr[(size_t)(m0 + r) * 1024 + j]); }
#pragma unroll
        for (int i = 0; i < 4; ++i) { const float muj = mu[768 + lane + 64 * i];
#pragma unroll
            for (int r = 0; r < 4; ++r) { const float cur = rows[i][r + 1], prev = rows[i][r]; const float c = cur + (prev - cur) * muj;
                const float o = i == 0 ? tanhf(c) : (i == 1 ? c : sigm(c));
                lra[(size_t)(m0 + r) * 256 + lane + 64 * i] = (bfu)f2bf(o); } }
        if (t0 + 3 == L - 1) {
#pragma unroll
            for (int i = 0; i < 16; ++i) cso[lane + 64 * i] = bf2f(cr[(size_t)(m0 + 3) * 1024 + lane + 64 * i]);
        }
    }
}
__device__ __forceinline__ void prep_c2(KArgs A, int l, int bid, int G, int tid) {
    unsigned char* ws = A->ws;
    const bfu* cr = (const bfu*)slotp(ws, l, 7); const bfu* lro = (const bfu*)slotp(ws, l, 13);
    bfu* v2 = (bfu*)slotp(ws, l, 12); bfu* gg = (bfu*)slotph(ws, l, 12);
    float* bonus = (float*)(ws + WS_BONUS); float* gch = (float*)(ws + WS_GCH); float* pairc = (float*)(ws + WS_PAIRC);
    const float* mu = A->in[21] + l * 1024; const float* sts = A->in[6] + (size_t)l * 8 * 1024;
    const int ch = tid & 255, h = ch >> 6, lane = ch & 63, half = tid >> 8;
    float* sic = (float*)slotp(ws, l, h) + ((size_t)(lane >> 3) * MPAD) * 32 + (lane & 7);
    const float mur = mu[ch], muk = mu[256 + ch], muv = mu[512 + ch];
    const float w0 = A->in[22][l * 256 + ch], a0 = A->in[24][l * 256 + ch], kk_ = A->in[27][l * 256 + ch], ka = A->in[28][l * 256 + ch], rk = A->in[29][l * 256 + ch];
    for (int u = bid * 2 + half; u < 1032; u += G * 2) {
        int m0, n; float pr, pk, pv;
        if (u < 1024) { m0 = u * 64; n = 64;
            if ((u & 127) == 0) { pr = pk = pv = 0.f; } else { pr = bf2f(cr[(size_t)(m0 - 1) * 1024 + ch]); pk = bf2f(cr[(size_t)(m0 - 1) * 1024 + 256 + ch]); pv = bf2f(cr[(size_t)(m0 - 1) * 1024 + 512 + ch]); } }
        else { const int sb = u - 1024; m0 = MP + sb * 16; n = 16; pr = sts[(size_t)sb * 1024 + ch]; pk = sts[(size_t)sb * 1024 + 256 + ch]; pv = sts[(size_t)sb * 1024 + 512 + ch]; }
        float cum = 0.f, pkka = 0.f, pkp = 0.f;
        for (int t4 = 0; t4 < n; t4 += 4) {
            float lr_[4], lk_[4], lv_[4], lw_[4], la_[4]; bfu lg_[4];
#pragma unroll
            for (int i = 0; i < 4; ++i) { const size_t mm = (size_t)(m0 + t4 + i);
                lr_[i] = bf2f(cr[mm * 1024 + ch]); lk_[i] = bf2f(cr[mm * 1024 + 256 + ch]); lv_[i] = bf2f(cr[mm * 1024 + 512 + ch]);
                lw_[i] = bf2f(lro[mm * 768 + ch]); la_[i] = bf2f(lro[mm * 768 + 256 + ch]); lg_[i] = lro[mm * 768 + 512 + ch]; }
#pragma unroll
        for (int i4 = 0; i4 < 4; ++i4) { const int tt = t4 + i4; const int m = m0 + tt;
            const float c_r = lr_[i4], c_k = lk_[i4], c_v = lv_[i4]; const float lw = lw_[i4], la = la_[i4]; const bfu gb = lg_[i4];
            const float r = c_r + (pr - c_r) * mur, k = c_k + (pk - c_k) * muk, v = c_v + (pv - c_v) * muv; pr = c_r; pk = c_k; pv = c_v;
            const float wl = -0.6065306597126334f * sigm(w0 + lw); const float a = sigm(a0 + la);
            const float kkr = k * kk_; const float kk = kkr * rsqrtf(wave_sum(kkr * kkr) + 1e-6f);
            const float kp = k * (1.f + (a - 1.f) * ka);
            const float Gp = __expf(cum); cum += wl; const float Gc = __expf(cum), iG = __expf(-cum);
            float* rec = sic + (size_t)m * 32;
            rec[0] = kk * Gp; rec[8] = kk * a * iG; rec[16] = kp * iG; rec[24] = r * Gc;
            { const float kka = kk * a; float* pc = pairc + ((size_t)h * (MPAD / 2) + (m >> 1)) * 4;
              if (tt & 1) { const float c22 = wave_sum(pkka * kk), c32 = wave_sum(pkp * kk); if (lane == 0) { pc[0] = c22; pc[1] = c32; } }
              else { const float c24 = wave_sum(kka * r), c34 = wave_sum(kp * r); if (lane == 0) { pc[2] = c24; pc[3] = c34; } }
              pkka = kka; pkp = kp; }
            const float bo = wave_sum(r * kp * rk); if (lane == 0) bonus[(size_t)h * MPAD + m] = bo;
            v2[(size_t)m * 256 + ch] = (bfu)f2bf(v); gg[(size_t)m * 256 + ch] = gb;
        }
        }
        gch[((size_t)h * 1032 + u) * 64 + lane] = __expf(cum);
    }
}
__device__ __forceinline__ void prep_a2(KArgs A, int l, int gw, int NGW, int lane) {
    unsigned char* ws = A->ws; const float* sia = (const float*)slotp(ws, l, 9); float* paird = (float*)(ws + WS_PAIRD);
    for (int pr = gw; pr < MR / 2; pr += NGW) { const int m = 2 * pr;
        float k1[4], q1[4], k2[4];
#pragma unroll
        for (int h = 0; h < 4; ++h) { const float* rec = sia + ((size_t)(h * 8 + (lane >> 3)) * MPAD + m) * 16 + (lane & 7); k1[h] = rec[0]; q1[h] = rec[8]; k2[h] = rec[16]; }
#pragma unroll
        for (int h = 0; h < 4; ++h) { const float g12 = wave_sum(k1[h] * k2[h]), h11 = wave_sum(q1[h] * k1[h]);
            if (lane == 0) { paird[((size_t)h * (MPAD / 2) + pr) * 2] = g12; paird[((size_t)h * (MPAD / 2) + pr) * 2 + 1] = h11; } } }
}
__device__ __forceinline__ void post_attn(KArgs A, int l, int gw, int NGW, int lane) {
    unsigned char* ws = A->ws;
    const bfu* O = (const bfu*)slotp(ws, l, 13); bfu* mix = (bfu*)slotp(ws, l, 7);
    const float* lf = (const float*)(ws + WS_CTL + 1024); const float lam = lf[2 * l], omli = 1.f - lf[2 * l + 1];
    const int h = lane >> 4, e0 = (lane & 15) * 8; const float* bn = A->in[20] + l * 128 + e0;
    float bnv[8];
#pragma unroll
    for (int i = 0; i < 8; ++i) bnv[i] = bn[i] * omli;
    for (int g = gw; g < MP / 4; g += NGW) {
        v4u av[4], bv[4];
#pragma unroll
        for (int i = 0; i < 4; ++i) { const size_t m = (size_t)(4 * g + i);
            av[i] = *(const v4u*)(O + m * 1024 + (4 * h + (e0 >> 6)) * 64 + (e0 & 63)); bv[i] = *(const v4u*)(O + m * 1024 + (4 * h + 2 + (e0 >> 6)) * 64 + (e0 & 63)); }
#pragma unroll
        for (int i = 0; i < 4; ++i) { const size_t m = (size_t)(4 * g + i);
            float o[8]; float ss = 0.f;
#pragma unroll
            for (int q = 0; q < 4; ++q) { const unsigned aw = av[i][q], bw = bv[i][q];
                o[2 * q] = __uint_as_float(aw << 16) - lam * __uint_as_float(bw << 16); o[2 * q + 1] = __uint_as_float(aw & 0xffff0000u) - lam * __uint_as_float(bw & 0xffff0000u);
                ss += o[2 * q] * o[2 * q] + o[2 * q + 1] * o[2 * q + 1]; }
            ss += __shfl_xor(ss, 1); ss += __shfl_xor(ss, 2); ss += __shfl_xor(ss, 4); ss += __shfl_xor(ss, 8);
            const float rn = rsqrtf(ss * (1.f / 128.f) + 1e-6f);
            v4u w; w.x = pk2(o[0] * rn * bnv[0], o[1] * rn * bnv[1]); w.y = pk2(o[2] * rn * bnv[2], o[3] * rn * bnv[3]); w.z = pk2(o[4] * rn * bnv[4], o[5] * rn * bnv[5]); w.w = pk2(o[6] * rn * bnv[6], o[7] * rn * bnv[7]);
            *(v4u*)(mix + m * 1024 + 256 + h * 128 + e0) = w; }
    }
}
__device__ __forceinline__ void post_scan(KArgs A, int l, int gw, int NGW, int lane) {
    unsigned char* ws = A->ws; bfu* mix = (bfu*)slotp(ws, l, 7);
    const bfu* zs = (const bfu*)slotph(ws, l, 11); const bfu* v2 = (const bfu*)slotp(ws, l, 12); const bfu* gg = (const bfu*)slotph(ws, l, 12);
    const float* bonus = (const float*)(ws + WS_BONUS);
    float lw[4], lb[4];
#pragma unroll
    for (int h = 0; h < 4; ++h) { lw[h] = A->in[30][l * 256 + h * 64 + lane]; lb[h] = A->in[31][l * 256 + h * 64 + lane]; }
    for (int g = gw; g < MR / 2; g += NGW) {
        float o[2][4], y[2][4], z[2][4], vv[2][4], gv[2][4], bo[2][4];
#pragma unroll
        for (int i = 0; i < 2; ++i)
#pragma unroll
            for (int h = 0; h < 4; ++h) { const size_t m = (size_t)(2 * g + i);
                o[i][h] = bf2f(mix[m * 1024 + h * 64 + lane]); y[i][h] = bf2f(mix[m * 1024 + 768 + h * 64 + lane]);
                z[i][h] = bf2f(zs[m * 256 + h * 64 + lane]); vv[i][h] = bf2f(v2[m * 256 + h * 64 + lane]); gv[i][h] = bf2f(gg[m * 256 + h * 64 + lane]); bo[i][h] = bonus[(size_t)h * MPAD + m]; }
#pragma unroll
        for (int i = 0; i < 2; ++i)
#pragma unroll
            for (int h = 0; h < 4; ++h) { const size_t m = (size_t)(2 * g + i);
                const float ss = wave_sum(o[i][h] * o[i][h]) * (1.f / 64.f);
                mix[m * 1024 + h * 64 + lane] = (bfu)f2bf(o[i][h] * rsqrtf(ss + 1e-6f) * z[i][h]);
                const float mu = wave_sum(y[i][h]) * (1.f / 64.f); const float d = y[i][h] - mu; const float var = wave_sum(d * d) * (1.f / 64.f);
                const float cy = d * rsqrtf(var + 64e-5f) * lw[h] + lb[h];
                mix[m * 1024 + 768 + h * 64 + lane] = (bfu)f2bf((cy + bo[i][h] * vv[i][h]) * gv[i][h]); }
    }
}
__device__ __forceinline__ void final_norm(KArgs A, int gw, int NGW, int lane) {
    const float* rs = (const float*)(A->ws + WS_RS) + 6 * (size_t)MPAD; const float* g = A->in[39];
    f32x4 gv[4];
#pragma unroll
    for (int j = 0; j < 4; ++j) gv[j] = *(const f32x4*)(g + j * 256 + lane * 4);
    for (int q = gw; q < MR / 4; q += NGW) {
        f32x4 v[4][4]; float s[4];
#pragma unroll
        for (int i = 0; i < 4; ++i) { const size_t mm = (size_t)(4 * q + i); s[i] = rsqrtf(rs[mm] * (1.f / 1024.f) + 1e-6f);
#pragma unroll
            for (int j = 0; j < 4; ++j) v[i][j] = *(const f32x4*)(A->out + mm * 1024 + j * 256 + lane * 4); }
#pragma unroll
        for (int i = 0; i < 4; ++i) { const size_t mm = (size_t)(4 * q + i);
#pragma unroll
            for (int j = 0; j < 4; ++j) *(f32x4*)(A->out + mm * 1024 + j * 256 + lane * 4) = v[i][j] * s[i] * gv[j]; }
    }
}

#define SC_BAR() asm volatile("s_waitcnt lgkmcnt(0)\n\ts_barrier" ::: "memory")
constexpr int SC_RED = 0, SC_SI = 16384, SC_VBUF = 81920, SC_GBUF = 90112, SC_BON = 98304, SC_PC = 98816, SC_YP = 99328;
#define FMAC_DPP(acc, op, s1, J) asm("v_fmac_f32_dpp %0, %1, %2 row_newbcast:" #J " row_mask:0xf bank_mask:0xf" : "+v"(acc) : "v"(op), "v"(s1))
#define DOT8(a0, a1, op, JB0, JB1, JB2, JB3, JB4, JB5, JB6, JB7) do { FMAC_DPP(a0, op, S[0], JB0); FMAC_DPP(a1, op, S[1], JB1); FMAC_DPP(a0, op, S[2], JB2); FMAC_DPP(a1, op, S[3], JB3); \
        FMAC_DPP(a0, op, S[4], JB4); FMAC_DPP(a1, op, S[5], JB5); FMAC_DPP(a0, op, S[6], JB6); FMAC_DPP(a1, op, S[7], JB7); } while (0)
#define DOT8_LO(a0, a1, op) DOT8(a0, a1, op, 0, 1, 2, 3, 4, 5, 6, 7)
#define DOT8_HI(a0, a1, op) DOT8(a0, a1, op, 8, 9, 10, 11, 12, 13, 14, 15)
#define AXPY8_LO(op, s) do { FMAC_DPP(S[0], op, s, 0); FMAC_DPP(S[1], op, s, 1); FMAC_DPP(S[2], op, s, 2); FMAC_DPP(S[3], op, s, 3); FMAC_DPP(S[4], op, s, 4); FMAC_DPP(S[5], op, s, 5); FMAC_DPP(S[6], op, s, 6); FMAC_DPP(S[7], op, s, 7); } while (0)
#define AXPY8_HI(op, s) do { FMAC_DPP(S[0], op, s, 8); FMAC_DPP(S[1], op, s, 9); FMAC_DPP(S[2], op, s, 10); FMAC_DPP(S[3], op, s, 11); FMAC_DPP(S[4], op, s, 12); FMAC_DPP(S[5], op, s, 13); FMAC_DPP(S[6], op, s, 14); FMAC_DPP(S[7], op, s, 15); } while (0)
#define PKF(a, b, c) __builtin_elementwise_fma((a), (b), (c))
#define AXPYV(X0, X1, s) do { const f32x2 s_ = (f32x2){(s), (s)}; f32x2 p0_ = (f32x2){S[0], S[1]}, p1_ = (f32x2){S[2], S[3]}, p2_ = (f32x2){S[4], S[5]}, p3_ = (f32x2){S[6], S[7]}; \
        p0_ = PKF(((f32x2){X0[0], X0[1]}), s_, p0_); p1_ = PKF(((f32x2){X0[2], X0[3]}), s_, p1_); p2_ = PKF(((f32x2){X1[0], X1[1]}), s_, p2_); p3_ = PKF(((f32x2){X1[2], X1[3]}), s_, p3_); \
        S[0] = p0_[0]; S[1] = p0_[1]; S[2] = p1_[0]; S[3] = p1_[1]; S[4] = p2_[0]; S[5] = p2_[1]; S[6] = p3_[0]; S[7] = p3_[1]; } while (0)
#define RED8(V) do { const LAS f32x4* rr_ = (const LAS f32x4*)red + par_ * 512 + lane; const f32x4 q0_ = rr_[0], q1_ = rr_[64], q2_ = rr_[128], q3_ = rr_[192], q4_ = rr_[256], q5_ = rr_[320], q6_ = rr_[384], q7_ = rr_[448]; \
        V = ((q0_ + q1_) + (q2_ + q3_)) + ((q4_ + q5_) + (q6_ + q7_)); } while (0)

#define SWAPSUM(v) do { const unsigned u_ = __float_as_uint(v); auto rr_ = __builtin_amdgcn_permlane32_swap(u_, u_, false, false); v = __uint_as_float(rr_[0]) + __uint_as_float(rr_[1]); } while (0)
#define DOT4_LO(a0, a1, op) do { FMAC_DPP(a0, op, S[0], 0); FMAC_DPP(a1, op, S[1], 1); FMAC_DPP(a0, op, S[2], 2); FMAC_DPP(a1, op, S[3], 3); } while (0)
#define DOT4_HI(a0, a1, op) do { FMAC_DPP(a0, op, S[0], 4); FMAC_DPP(a1, op, S[1], 5); FMAC_DPP(a0, op, S[2], 6); FMAC_DPP(a1, op, S[3], 7); } while (0)
#define AXPY4(X, s) do { const f32x2 s_ = (f32x2){(s), (s)}; f32x2 p0_ = (f32x2){S[0], S[1]}, p1_ = (f32x2){S[2], S[3]}; p0_ = PKF(((f32x2){X[0], X[1]}), s_, p0_); p1_ = PKF(((f32x2){X[2], X[3]}), s_, p1_); S[0] = p0_[0]; S[1] = p0_[1]; S[2] = p1_[0]; S[3] = p1_[1]; } while (0)
__device__ __forceinline__ void scan_rwkv(KArgs A, int l, LAS unsigned char* lds, int h, int half, int m0, int L, int BL, int BLS, int chunk0, const float* st_in, float* st_out, int tid) {
    unsigned char* ws = A->ws;
    const int lane = tid & 63, wid = __builtin_amdgcn_readfirstlane(tid >> 6); const int kh = lane >> 5, r = lane & 31, row = 32 * half + r;
    LAS float* red = (LAS float*)(lds + SC_RED); LAS float* yred = (LAS float*)(lds + SC_YP);
    LAS float* sib = (LAS float*)(lds + SC_SI) + wid * 1024;
    LAS bfu* vbuf = (LAS bfu*)(lds + SC_VBUF); LAS float* pcs = (LAS float*)(lds + SC_PC);
    const bfu* v2 = (const bfu*)slotp(ws, l, 12);
    const float* pairc = (const float*)(ws + WS_PAIRC) + ((size_t)h * (MPAD / 2) + (m0 >> 1)) * 4;
    const float* gch = (const float*)(ws + WS_GCH) + ((size_t)h * 1032 + chunk0) * 64 + 8 * wid + 4 * kh;
    bfu* mix = (bfu*)slotp(ws, l, 7);
    const float* P = (const float*)slotp(ws, l, h) + ((size_t)wid * MPAD + m0) * 32;
    float S[4];
#pragma unroll
    for (int j = 0; j < 4; ++j) S[j] = st_in ? st_in[row * 64 + 8 * wid + 4 * kh + j] : 0.f;
    const int nblk = L >> BLS; const int srow = tid >> 4, sc4 = tid & 15; const bool sval = srow < BL;
    const int nsi = BL >> 3;
    f32x4 ssi[4]; v2u sv = {0, 0}; float sp_ = 0.f;
#define RW_STAGE(c) do { const float* ps_ = P + (size_t)(c) * BL * 32 + lane * 4; \
        _Pragma("unroll") for (int i_ = 0; i_ < 4; ++i_) if (i_ < nsi) ssi[i_] = *(const f32x4*)(ps_ + i_ * 256); \
        if (sval) { const size_t mm = (size_t)(m0 + (c) * BL + srow) * 256 + h * 64 + sc4 * 4; sv = *(const v2u*)(v2 + mm); } \
        if (tid < 2 * BL) sp_ = pairc[(size_t)(c) * BL * 2 + tid]; } while (0)
#define RW_COMMIT(c) do { LAS float* pd_ = sib + ((c) & 1) * 8192 + lane * 4; \
        _Pragma("unroll") for (int i_ = 0; i_ < 4; ++i_) if (i_ < nsi) *(LAS f32x4*)(pd_ + i_ * 256) = ssi[i_]; \
        if (sval) { *(LAS v2u*)(vbuf + ((c) & 1) * 2048 + srow * 64 + sc4 * 4) = sv; } \
        if (tid < 2 * BL) pcs[((c) & 1) * 64 + tid] = sp_; } while (0)
    __syncthreads();
    RW_STAGE(0); RW_COMMIT(0); if (nblk > 1) RW_STAGE(1);
    const int dsel = ((lane & 4) ? 24 : 0) + 4 * kh + (lane & 3);
    float ca0, ca1, cb0 = 0.f, cb1 = 0.f; f32x4 cau[4], cbu[4];
#define RW_LOADOPS(D, T) do { const LAS float* pb_ = sib + ((((T) >> BLS) & 1) * 8192) + ((T) & (BL - 1)) * 32; \
        D##0 = pb_[dsel]; D##1 = pb_[32 + dsel]; const LAS f32x4* pu_ = (const LAS f32x4*)(pb_ + 4 * kh); \
        D##u[0] = pu_[2]; D##u[1] = pu_[4]; D##u[2] = pu_[10]; D##u[3] = pu_[12]; } while (0)
    RW_LOADOPS(ca, 0);
#define RW_FINAL(T) do { const int tf_ = (T); \
        const LAS float* yr_ = yred + (tf_ & 15) * 512 + lane; const float y_ = ((yr_[0] + yr_[64]) + (yr_[128] + yr_[192])) + ((yr_[256] + yr_[320]) + (yr_[384] + yr_[448])); \
        if (lane < 32) mix[(size_t)(m0 + tf_) * 1024 + 768 + h * 64 + row] = (bfu)f2bf(y_); } while (0)
#define RW_ROUND(C, N, T) do { const int par_ = ((T) >> 1) & 1; \
        float d1a = 0.f, d1b = 0.f, d2a = 0.f, d2b = 0.f, f1a = 0.f, f1b = 0.f; \
        DOT4_LO(d1a, d1b, C##0); DOT4_LO(d2a, d2b, C##1); DOT4_HI(f1a, f1b, C##0); \
        float d1 = d1a + d1b, d2 = d2a + d2b, f1 = f1a + f1b; SWAPSUM(d1); SWAPSUM(d2); SWAPSUM(f1); \
        ((LAS f32x4*)red)[(par_ * 8 + wid) * 64 + lane] = (f32x4){d1, d2, f1, 0.f}; \
        SC_BAR(); \
        f32x4 tot_; RED8(tot_); \
        const int bo_ = (((T) >> BLS) & 1), to_ = (T) & (BL - 1); \
        const float v1 = bf2f(vbuf[bo_ * 2048 + to_ * 64 + row]), v2_ = bf2f(vbuf[bo_ * 2048 + to_ * 64 + 64 + row]); const f32x4 pc_ = *(const LAS f32x4*)(pcs + bo_ * 64 + to_ * 2); \
        asm volatile("" ::: "memory"); \
        if ((T) + 2 < L) RW_LOADOPS(N, (T) + 2); \
        __builtin_amdgcn_sched_barrier(0); \
        const float sa1 = -tot_[0]; const float sa2 = -(tot_[1] + sa1 * pc_[0] + v1 * pc_[1]); const float y1 = tot_[2] + sa1 * pc_[2] + v1 * pc_[3]; \
        AXPY4(C##u[1], v1); AXPY4(C##u[0], sa1); AXPY4(C##u[3], v2_); AXPY4(C##u[2], sa2); \
        float y2a = 0.f, y2b = 0.f; DOT4_HI(y2a, y2b, C##1); float y2 = y2a + y2b; SWAPSUM(y2); \
        yred[((T) & 15) * 512 + wid * 64 + lane] = y1 * 0.125f; yred[(((T) + 1) & 15) * 512 + wid * 64 + lane] = y2; } while (0)
    for (int c = 0; c < nblk; ++c) {
        for (int tt = 0; tt < BL; tt += 4) {
            const int t = c * BL + tt;
            if (tt == (BL >> 1) && c + 1 < nblk) { RW_COMMIT(c + 1); if (c + 2 < nblk) RW_STAGE(c + 2); }
            RW_ROUND(ca, cb, t);
            RW_ROUND(cb, ca, t + 2);
            if (((t + 3) & 15) == 15) { SC_BAR(); RW_FINAL(t - 12 + 2 * wid); RW_FINAL(t - 11 + 2 * wid); }
        }
        if ((((c + 1) << BLS) & 63) == 0 || c + 1 == nblk) {
            const float* ge = gch + (size_t)((c << BLS) >> 6) * 64;
#pragma unroll
            for (int j = 0; j < 4; ++j) S[j] *= ge[j];
        }
    }
#pragma unroll
    for (int j = 0; j < 4; ++j) st_out[row * 64 + 8 * wid + 4 * kh + j] = S[j];
    __syncthreads();
#undef RW_STAGE
#undef RW_COMMIT
#undef RW_LOADOPS
#undef RW_FINAL
#undef RW_ROUND
}

__device__ __forceinline__ void scan_delta(KArgs A, int l, LAS unsigned char* lds, int h, int half, int m0, int L, int BL, int BLS, const float* st_in, float* st_out, int tid) {
    unsigned char* ws = A->ws;
    const int lane = tid & 63, wid = __builtin_amdgcn_readfirstlane(tid >> 6); const int kh = lane >> 5, r = lane & 31, row = 32 * half + r;
    LAS float* red = (LAS float*)(lds + SC_RED); LAS float* yred = (LAS float*)(lds + SC_YP);
    LAS float* sib = (LAS float*)(lds + SC_SI) + wid * 512;
    LAS bfu* vbuf = (LAS bfu*)(lds + SC_VBUF); LAS float* gab = (LAS float*)(lds + SC_BON); LAS float* pds = (LAS float*)(lds + SC_PC);
    const bfu* va = (const bfu*)slotp(ws, l, 11);
    bfu* mix = (bfu*)slotp(ws, l, 7);
    const float* P = (const float*)slotp(ws, l, 9) + ((size_t)(h * 8 + wid) * MPAD + m0) * 16;
    const float* PG = (const float*)(ws + WS_GAB) + ((size_t)h * MPAD + m0) * 2;
    const float* paird = (const float*)(ws + WS_PAIRD) + ((size_t)h * (MPAD / 2) + (m0 >> 1)) * 2;
    float S[4];
#pragma unroll
    for (int j = 0; j < 4; ++j) S[j] = st_in ? st_in[(8 * wid + 4 * kh + j) * 64 + row] : 0.f;
    const int nblk = L >> BLS; const int srow = tid >> 4, sc4 = tid & 15; const bool sval = srow < BL;
    const int nsi = BL >> 4;
    f32x4 ssi[2]; v2u sv = {0, 0}; float sb_ = 0.f, sp_ = 0.f;
#define DL_STAGE(c) do { const float* ps_ = P + (size_t)(c) * BL * 16 + lane * 4; \
        _Pragma("unroll") for (int i_ = 0; i_ < 2; ++i_) if (i_ < nsi) ssi[i_] = *(const f32x4*)(ps_ + i_ * 256); \
        if (sval) { const size_t mm = (size_t)(m0 + (c) * BL + srow) * 256 + h * 64 + sc4 * 4; sv = *(const v2u*)(va + mm); } \
        if (tid < 2 * BL) sb_ = PG[(size_t)(c) * BL * 2 + tid]; if (tid < BL) sp_ = paird[(size_t)(c) * BL + tid]; } while (0)
#define DL_COMMIT(c) do { LAS float* pd_ = sib + ((c) & 1) * 4096 + lane * 4; \
        _Pragma("unroll") for (int i_ = 0; i_ < 2; ++i_) if (i_ < nsi) *(LAS f32x4*)(pd_ + i_ * 256) = ssi[i_]; \
        if (sval) { *(LAS v2u*)(vbuf + ((c) & 1) * 2048 + srow * 64 + sc4 * 4) = sv; } \
        if (tid < 2 * BL) gab[((c) & 1) * 64 + tid] = sb_; if (tid < BL) pds[((c) & 1) * 32 + tid] = sp_; } while (0)
    __syncthreads();
    DL_STAGE(0); DL_COMMIT(0); if (nblk > 1) DL_STAGE(1);
    const int dsel = ((lane & 4) ? 8 : 0) + 4 * kh + (lane & 3);
    float ca0, ca1, cb0 = 0.f, cb1 = 0.f; f32x4 cau[2], cbu[2];
#define DL_LOADOPS(D, T) do { const LAS float* pb_ = sib + ((((T) >> BLS) & 1) * 4096) + ((T) & (BL - 1)) * 16; D##0 = pb_[dsel]; D##1 = pb_[16 + dsel]; \
        const LAS f32x4* pu_ = (const LAS f32x4*)(pb_ + 4 * kh); D##u[0] = pu_[0]; D##u[1] = pu_[4]; } while (0)
    DL_LOADOPS(ca, 0);
#define DL_FINAL(T) do { const int tf_ = (T); \
        const LAS float* yr_ = yred + (tf_ & 15) * 512 + lane; const float o_ = ((yr_[0] + yr_[64]) + (yr_[128] + yr_[192])) + ((yr_[256] + yr_[320]) + (yr_[384] + yr_[448])); \
        if (lane < 32) mix[(size_t)(m0 + tf_) * 1024 + h * 64 + row] = (bfu)f2bf(o_); } while (0)
#define DL_ROUND(C, N, T) do { const int par_ = ((T) >> 1) & 1; \
        float d1a = 0.f, d1b = 0.f, d2a = 0.f, d2b = 0.f, f1a = 0.f, f1b = 0.f; \
        DOT4_LO(d1a, d1b, C##0); DOT4_LO(d2a, d2b, C##1); DOT4_HI(f1a, f1b, C##0); \
        float d1 = d1a + d1b, d2 = d2a + d2b, f1 = f1a + f1b; SWAPSUM(d1); SWAPSUM(d2); SWAPSUM(f1); \
        ((LAS f32x4*)red)[(par_ * 8 + wid) * 64 + lane] = (f32x4){d1, d2, f1, 0.f}; \
        SC_BAR(); \
        f32x4 tot_; RED8(tot_); \
        const int bo_ = (((T) >> BLS) & 1), to_ = (T) & (BL - 1); \
        const float v1 = bf2f(vbuf[bo_ * 2048 + to_ * 64 + row]), v2_ = bf2f(vbuf[bo_ * 2048 + to_ * 64 + 64 + row]); \
        const f32x4 ab_ = *(const LAS f32x4*)(gab + bo_ * 64 + to_ * 2); const f32x2 pd2_ = *(const LAS f32x2*)(pds + bo_ * 32 + to_); \
        asm volatile("" ::: "memory"); \
        if ((T) + 2 < L) DL_LOADOPS(N, (T) + 2); \
        __builtin_amdgcn_sched_barrier(0); \
        const float a1 = ab_[0], a2 = ab_[2]; const float dl1 = ab_[1] * (v1 - a1 * tot_[0]); const float dl2 = ab_[3] * (v2_ - a2 * (a1 * tot_[1] + pd2_[0] * dl1)); \
        const float o1 = a1 * tot_[2] + pd2_[1] * dl1; const float a12 = a1 * a2, dl1s = a2 * dl1; \
        _Pragma("unroll") for (int j = 0; j < 4; ++j) S[j] *= a12; \
        AXPY4(C##u[0], dl1s); AXPY4(C##u[1], dl2); \
        float y2a = 0.f, y2b = 0.f; DOT4_HI(y2a, y2b, C##1); float y2 = y2a + y2b; SWAPSUM(y2); \
        yred[((T) & 15) * 512 + wid * 64 + lane] = o1 * 0.125f; yred[(((T) + 1) & 15) * 512 + wid * 64 + lane] = y2; } while (0)
    for (int c = 0; c < nblk; ++c) {
        for (int tt = 0; tt < BL; tt += 4) {
            const int t = c * BL + tt;
            if (tt == (BL >> 1) && c + 1 < nblk) { DL_COMMIT(c + 1); if (c + 2 < nblk) DL_STAGE(c + 2); }
            DL_ROUND(ca, cb, t);
            DL_ROUND(cb, ca, t + 2);
            if (((t + 3) & 15) == 15) { SC_BAR(); DL_FINAL(t - 12 + 2 * wid); DL_FINAL(t - 11 + 2 * wid); }
        }
    }
#pragma unroll
    for (int j = 0; j < 4; ++j) st_out[(8 * wid + 4 * kh + j) * 64 + row] = S[j];
    __syncthreads();
#undef DL_STAGE
#undef DL_COMMIT
#undef DL_LOADOPS
#undef DL_FINAL
#undef DL_ROUND
}

__device__ __forceinline__ void sample_attn(KArgs A, int l, LAS unsigned char* lds, int unit, int tid) {
    unsigned char* ws = A->ws;
    const int sb = unit >> 2, h = unit & 3;
    LAS float* qs = (LAS float*)lds;
    LAS float* sc = qs + 2048;
    LAS float* scl = sc + 1024;
    LAS float* ssq = scl + 32;
    LAS float* lsum = ssq + 512;
    const bfu* qb = (const bfu*)slotp(ws, l, 4); bfu* mix = (bfu*)slotp(ws, l, 7);
    const float* ck = A->in[2] + (size_t)(l * 8 + sb) * 2048 * 512 + h * 128; const float* cv = A->in[3] + (size_t)(l * 8 + sb) * 2048 * 512 + h * 128;
    const float* nk = A->out + O_BKS + (size_t)(l * 8 + sb) * 16 * 512 + h * 128; const float* nv = A->out + O_BVS + (size_t)(l * 8 + sb) * 16 * 512 + h * 128;
    const float* lf = (const float*)(ws + WS_CTL + 1024); const float lam = lf[2 * l], omli = 1.f - lf[2 * l + 1];
    __syncthreads();
    for (int i = tid; i < 2048; i += NTHR) { const int map = i >> 10, qi = (i >> 6) & 15, p = i & 63; const int s = p >> 5, fq_ = (p >> 3) & 3, n_ = (p >> 2) & 1, j_ = p & 3;
        qs[(map * 16 + qi) * 64 + n_ * 32 + s * 16 + 4 * fq_ + j_] = bf2f(qb[(size_t)(MP + sb * 16 + qi) * 512 + h * 128 + map * 64 + p]); }
    float mrun = -1e30f, lrun = 0.f;
    const int qi = tid & 15, kj = tid >> 4, eg = tid >> 4;
    f32x4 acc0 = {0.f, 0.f, 0.f, 0.f}, acc1 = {0.f, 0.f, 0.f, 0.f};
    __syncthreads();
    for (int tile = 0; tile < 65; ++tile) {
        const int kidx = tile * 32 + kj;
        float s1 = -1e30f, s2 = -1e30f;
        if (kidx < 2064) { const float* kr = kidx < 2048 ? ck + (size_t)kidx * 512 : nk + (size_t)(kidx - 2048) * 512; s1 = 0.f; s2 = 0.f;
#pragma unroll 4
            for (int d = 0; d < 64; d += 4) { const f32x4 k1 = *(const f32x4*)(kr + d), k2 = *(const f32x4*)(kr + 64 + d); const LAS float* q1 = qs + qi * 64 + d; const LAS float* q2 = qs + (16 + qi) * 64 + d;
                s1 += q1[0] * k1[0] + q1[1] * k1[1] + q1[2] * k1[2] + q1[3] * k1[3]; s2 += q2[0] * k2[0] + q2[1] * k2[1] + q2[2] * k2[2] + q2[3] * k2[3]; } }
        sc[qi * 32 + kj] = s1; sc[(16 + qi) * 32 + kj] = s2;
        __syncthreads();
        if (tid < 32) { LAS float* r = sc + tid * 32; float mx = mrun;
#pragma unroll 8
            for (int j = 0; j < 32; ++j) mx = fmaxf(mx, r[j]);
            const float f = exp2f(mrun - mx); float su = 0.f;
#pragma unroll 8
            for (int j = 0; j < 32; ++j) { const float p = exp2f(r[j] - mx); r[j] = p; su += p; }
            lrun = lrun * f + su; mrun = mx; scl[tid] = f; }
        __syncthreads();
        { const float f0 = scl[qi], f1 = scl[16 + qi]; acc0 = acc0 * f0; acc1 = acc1 * f1;
            const int nk_ = tile < 64 ? 32 : 16;
            for (int j = 0; j < nk_; ++j) { const int kx = tile * 32 + j; const float* vr = (kx < 2048 ? cv + (size_t)kx * 512 : nv + (size_t)(kx - 2048) * 512) + eg * 4;
                const f32x4 v = *(const f32x4*)vr; acc0 = acc0 + v * sc[qi * 32 + j]; acc1 = acc1 + v * sc[(16 + qi) * 32 + j]; } }
        __syncthreads();
    }
    if (tid < 32) lsum[tid] = lrun;
    __syncthreads();
    const f32x4 o = acc0 * (1.f / lsum[qi]) - acc1 * (lam / lsum[16 + qi]);
    ssq[qi * 32 + eg] = (o[0] * o[0] + o[1] * o[1]) + (o[2] * o[2] + o[3] * o[3]);
    __syncthreads();
    float ss = 0.f;
#pragma unroll 8
    for (int j = 0; j < 32; ++j) ss += ssq[qi * 32 + j];
    const float rn = rsqrtf(ss * (1.f / 128.f) + 1e-6f) * omli; const float* bn = A->in[20] + l * 128 + eg * 4;
    v2u w; w.x = pk2(o[0] * rn * bn[0], o[1] * rn * bn[1]); w.y = pk2(o[2] * rn * bn[2], o[3] * rn * bn[3]);
    *(v2u*)(mix + (size_t)(MP + sb * 16 + qi) * 1024 + 256 + h * 128 + eg * 4) = w;
    __syncthreads();
}

#define PH_BEGIN \
        KArgs A = (KArgs)__builtin_amdgcn_kernarg_segment_ptr(); \
        int tid = wv * 64 + (int)__builtin_amdgcn_mbcnt_hi(~0u, __builtin_amdgcn_mbcnt_lo(~0u, 0u)); asm volatile("" : "+v"(tid)); tid &= 511; \
        const int bid = blockIdx.x, G = gridDim.x; \
        const int lane = tid & 63, wave = wv; \
        const int gw = bid * NWAVES + wave, NGW = G * NWAVES, gtid = bid * NTHR + tid, NT = G * NTHR; \
        unsigned char* ws = A->ws; float* rsb = (float*)(ws + WS_RS); unsigned char* wb = ws + WS_W; \
        (void)lane; (void)gw; (void)NGW; (void)gtid; (void)NT; (void)rsb; (void)wb;
#define IN(k) (lo <= (k) && (k) < hi)
__device__ __forceinline__ void grid_bar(unsigned* bar, unsigned target, bool leader) {
    asm volatile("s_waitcnt vmcnt(0) lgkmcnt(0)" ::: "memory");
    __syncthreads();
    if (leader) {
        __builtin_amdgcn_fence(__ATOMIC_RELEASE, "agent");
        asm volatile("s_waitcnt vmcnt(0)" ::: "memory");
        __hip_atomic_fetch_add(bar, 1u, __ATOMIC_RELAXED, __HIP_MEMORY_SCOPE_AGENT);
        unsigned spins = 0;
        while (__hip_atomic_load(bar, __ATOMIC_RELAXED, __HIP_MEMORY_SCOPE_AGENT) < target) { __builtin_amdgcn_s_sleep(2); if (++spins > (1u << 27)) break; }
        __builtin_amdgcn_fence(__ATOMIC_ACQUIRE, "agent");
        asm volatile("s_waitcnt vmcnt(0)" ::: "memory");
    }
    __syncthreads();
}
#define SEAM(k) do { if ((k) + 1 < hi) { ++nbar; grid_bar((unsigned*)(ws + WS_CTL + 4096), nbar * (unsigned)G, tid == 0); } } while (0)
#define SEAM_SKIP(k) do { } while (0)
__global__ void __launch_bounds__(NTHR, 2) hybrid_fwd(Args Aval) {
    extern __shared__ __attribute__((aligned(16))) unsigned char lds_raw[];
    LAS unsigned char* lds = (LAS unsigned char*)lds_raw;
    const int lo = Aval.ph_lo, hi = Aval.ph_hi; unsigned nbar = 0u;
    if (Aval.ph_lo < 0) cg::this_grid().sync();
    const int wv = __builtin_amdgcn_readfirstlane(threadIdx.x >> 6);
    if (IN(0)) { PH_BEGIN prologue(A, lds, gw, NGW, lane, wave, gtid, NT); SEAM(0); }
    { constexpr int l = 0;

        const int p0 = 1 + 11 * l;
        if (IN(p0 + 0)) { PH_BEGIN
            pg8::Gemm g{(const pg8::bf16_t*)slotp(ws, l, 0), (const pg8::bf16_t*)(wb + W_IN), MPAD, NIN, 1024};
            pg8::StaticOrder S; S.init(MPAD, NIN, G, bid);
            EpiG1 E{rsb + (size_t)(3 * l) * MPAD, (bfu*)slotp(ws, l, 2), (bfu*)slotp(ws, l, 4), (bfu*)slotp(ws, l, 5), (bfu*)slotp(ws, l, 6), (bfu*)slotp(ws, l, 7), (float*)(ws + WS_AB), (const float*)(ws + WS_ROPE),
                    A->out + O_BKP + (size_t)l * MP * 512, A->out + O_BVP + (size_t)l * MP * 512, A->out + O_BKS + (size_t)l * MS * 512, A->out + O_BVS + (size_t)l * MS * 512};
            pg8::gemm_phase<EpiG1, pg8::StaticOrder, true, true>((PG8_LAS unsigned char*)lds, g, S, E, wv);
            SEAM(p0 + 0); }
        if (IN(p0 + 1)) { PH_BEGIN
            prep_a(A, l, gw, NGW, lane); prep_c1(A, l, gw, NGW, lane);
            if (l == 1) conv_weights(A, 1, 2, lds, gw, NGW, lane, wave);
            SEAM(p0 + 1); }
        if (IN(p0 + 2)) { PH_BEGIN
            pg8::Gemm g{(const pg8::bf16_t*)slotp(ws, l, 12), (const pg8::bf16_t*)(wb + W_LR), MPAD, 768, 256};
            pg8::StaticOrder S; S.init(MPAD, 768, G, bid);
            EpiB<0> E{(bfu*)slotp(ws, l, 13), 768, nullptr};
            pg8::gemm_phase<EpiB<0>, pg8::StaticOrder, true, true>((PG8_LAS unsigned char*)lds, g, S, E, wv);
            SEAM(p0 + 2); }
        if (IN(p0 + 3)) { PH_BEGIN prep_c2(A, l, bid, G, tid); prep_a2(A, l, gw, NGW, lane);
            SEAM(p0 + 3); }
        if (IN(p0 + 4)) { PH_BEGIN
            if (bid < 64) { const int st = bid >> 1, half = bid & 1, b = st >> 2, h = st & 3;
                scan_rwkv(A, l, lds, h, half, b * 8192, 8192, 32, 5, b * 128, nullptr, A->out + O_CWP + (size_t)((l * 8 + b) * 4 + h) * 4096, tid);
                scan_rwkv(A, l, lds, h, half, MP + b * 16, 16, 16, 4, 1024 + b, A->in[7] + (size_t)((l * 8 + b) * 4 + h) * 4096, A->out + O_CWS + (size_t)((l * 8 + b) * 4 + h) * 4096, tid);
            } else if (bid < 128) { const int st = (bid - 64) >> 1, half = bid & 1, b = st >> 2, h = st & 3;
                scan_delta(A, l, lds, h, half, b * 8192, 8192, 32, 5, nullptr, A->out + O_ADP + (size_t)((l * 8 + b) * 4 + h) * 4096, tid);
                scan_delta(A, l, lds, h, half, MP + b * 16, 16, 16, 4, A->in[5] + (size_t)((l * 8 + b) * 4 + h) * 4096, A->out + O_ADS + (size_t)((l * 8 + b) * 4 + h) * 4096, tid);
            } else if (bid < 160) { sample_attn(A, l, lds, bid - 128, tid); }
            __syncthreads();
            unsigned* ctr = (unsigned*)(ws + WS_CTL) + 16 * l; volatile LAS unsigned* qw = (volatile LAS unsigned*)(lds + MISC_OFF);
            const attn_body::bf16* Q = (const attn_body::bf16*)slotp(ws, l, 4); const attn_body::bf16* K = (const attn_body::bf16*)slotp(ws, l, 5); const attn_body::bf16* V = (const attn_body::bf16*)slotp(ws, l, 6);
            attn_body::bf16* O = (attn_body::bf16*)slotp(ws, l, 13);
            for (;;) {
                if (tid == 0) qw[0] = atomicAdd(ctr, 1u);
                __syncthreads();
                const unsigned u = qw[0];
                __syncthreads();
                if (u >= 4096u) break;
                const int qb = 31 - (int)(u >> 7), bh = (int)(u & 127);
                attn_body::attn_unit<8>(bh >> 4, bh & 15, qb, Q, K, V, O, (char*)lds_raw, wv);
            }
            SEAM(p0 + 4); }
        if (IN(p0 + 5)) { PH_BEGIN
            post_attn(A, l, gw, NGW, lane); post_scan(A, l, gw, NGW, lane);
            conv_p(A, l, (bfu*)slotp(ws, l, 10), gtid, NT);
            if (l == 0) conv_weights(A, 1, 1, lds, gw, NGW, lane, wave);
            SEAM(p0 + 5); }
        if (IN(p0 + 6)) { PH_BEGIN
            pg8::Gemm g{(const pg8::bf16_t*)slotp(ws, l, 7), (const pg8::bf16_t*)(wb + W_OUT), MPAD, 1024, 1024};
            pg8::StaticOrder S; S.init(MPAD, 1024, G, bid);
            EpiH<2> E{A->out, (bfu*)slotp(ws, l, 0), rsb + (size_t)(3 * l + 1) * MPAD, nullptr, nullptr};
            pg8::gemm_phase<EpiH<2>, pg8::StaticOrder, true, true>((PG8_LAS unsigned char*)lds, g, S, E, wv);
            SEAM(p0 + 6); }
        if (IN(p0 + 7)) { PH_BEGIN
            pg8::Gemm g{(const pg8::bf16_t*)slotp(ws, l, 0), (const pg8::bf16_t*)(wb + W_FF1), MPAD, FFD, 1024};
            pg8::StaticOrder S; S.init(MPAD, FFD, G, bid);
            EpiB<1> E{(bfu*)slotp(ws, l, 2), FFD, rsb + (size_t)(3 * l + 1) * MPAD};
            pg8::gemm_phase<EpiB<1>, pg8::StaticOrder, true, true>((PG8_LAS unsigned char*)lds, g, S, E, wv);
            {
                pg8::Gemm g2{(const pg8::bf16_t*)slotp(ws, l, 10), (const pg8::bf16_t*)(wb + W_PP), MPAD, 1024, 256};
                pg8::StaticOrder S2; S2.init(MPAD, 1024, G, bid);
                EpiB<0> E2{(bfu*)slotp(ws, l, 11), 1024, nullptr};
                pg8::gemm_phase<EpiB<0>, pg8::StaticOrder, true, true>((PG8_LAS unsigned char*)lds, g2, S2, E2, wv); }
            SEAM(p0 + 7); }
        if (IN(p0 + 8)) { PH_BEGIN
            pg8::Gemm g{(const pg8::bf16_t*)slotp(ws, l, 2), (const pg8::bf16_t*)(wb + W_FF2), MPAD, 1024, FFD};
            pg8::StaticOrder S; S.init(MPAD, 1024, G, bid);
            EpiH<2> E{A->out, (bfu*)slotp(ws, l, 0), rsb + (size_t)(3 * l + 2) * MPAD, nullptr, nullptr};
            pg8::gemm_phase<EpiH<2>, pg8::StaticOrder, true, true>((PG8_LAS unsigned char*)lds, g, S, E, wv);
            SEAM(p0 + 8); }
        if (IN(p0 + 9)) { PH_BEGIN SEAM_SKIP(p0 + 9); }
        if (IN(p0 + 10)) { PH_BEGIN
            pg8::Gemm g{(const pg8::bf16_t*)slotp(ws, l, 0), (const pg8::bf16_t*)(wb + W_GATE), MPAD, 1024, 1024};
            pg8::StaticOrder S; S.init(MPAD, 1024, G, bid);
            EpiH<3> E{A->out, (bfu*)slotp(ws, l, 13), rsb + (size_t)(3 * l + 3) * MPAD, rsb + (size_t)(3 * l + 2) * MPAD, (const bfu*)slotp(ws, l, 11)};
            pg8::gemm_phase<EpiH<3>, pg8::StaticOrder, true, true>((PG8_LAS unsigned char*)lds, g, S, E, wv);
            SEAM(p0 + 10); }
        }
    { constexpr int l = 1;

        const int p0 = 1 + 11 * l;
        if (IN(p0 + 0)) { PH_BEGIN
            pg8::Gemm g{(const pg8::bf16_t*)slotp(ws, l, 0), (const pg8::bf16_t*)(wb + W_IN), MPAD, NIN, 1024};
            pg8::StaticOrder S; S.init(MPAD, NIN, G, bid);
            EpiG1 E{rsb + (size_t)(3 * l) * MPAD, (bfu*)slotp(ws, l, 2), (bfu*)slotp(ws, l, 4), (bfu*)slotp(ws, l, 5), (bfu*)slotp(ws, l, 6), (bfu*)slotp(ws, l, 7), (float*)(ws + WS_AB), (const float*)(ws + WS_ROPE),
                    A->out + O_BKP + (size_t)l * MP * 512, A->out + O_BVP + (size_t)l * MP * 512, A->out + O_BKS + (size_t)l * MS * 512, A->out + O_BVS + (size_t)l * MS * 512};
            pg8::gemm_phase<EpiG1, pg8::StaticOrder, true, true>((PG8_LAS unsigned char*)lds, g, S, E, wv);
            SEAM(p0 + 0); }
        if (IN(p0 + 1)) { PH_BEGIN
            prep_a(A, l, gw, NGW, lane); prep_c1(A, l, gw, NGW, lane);
            if (l == 1) conv_weights(A, 1, 2, lds, gw, NGW, lane, wave);
            SEAM(p0 + 1); }
        if (IN(p0 + 2)) { PH_BEGIN
            pg8::Gemm g{(const pg8::bf16_t*)slotp(ws, l, 12), (const pg8::bf16_t*)(wb + W_LR), MPAD, 768, 256};
            pg8::StaticOrder S; S.init(MPAD, 768, G, bid);
            EpiB<0> E{(bfu*)slotp(ws, l, 13), 768, nullptr};
            pg8::gemm_phase<EpiB<0>, pg8::StaticOrder, true, true>((PG8_LAS unsigned char*)lds, g, S, E, wv);
            SEAM(p0 + 2); }
        if (IN(p0 + 3)) { PH_BEGIN prep_c2(A, l, bid, G, tid); prep_a2(A, l, gw, NGW, lane);
            SEAM(p0 + 3); }
        if (IN(p0 + 4)) { PH_BEGIN
            if (bid < 64) { const int st = bid >> 1, half = bid & 1, b = st >> 2, h = st & 3;
                scan_rwkv(A, l, lds, h, half, b * 8192, 8192, 32, 5, b * 128, nullptr, A->out + O_CWP + (size_t)((l * 8 + b) * 4 + h) * 4096, tid);
                scan_rwkv(A, l, lds, h, half, MP + b * 16, 16, 16, 4, 1024 + b, A->in[7] + (size_t)((l * 8 + b) * 4 + h) * 4096, A->out + O_CWS + (size_t)((l * 8 + b) * 4 + h) * 4096, tid);
            } else if (bid < 128) { const int st = (bid - 64) >> 1, half = bid & 1, b = st >> 2, h = st & 3;
                scan_delta(A, l, lds, h, half, b * 8192, 8192, 32, 5, nullptr, A->out + O_ADP + (size_t)((l * 8 + b) * 4 + h) * 4096, tid);
                scan_delta(A, l, lds, h, half, MP + b * 16, 16, 16, 4, A->in[5] + (size_t)((l * 8 + b) * 4 + h) * 4096, A->out + O_ADS + (size_t)((l * 8 + b) * 4 + h) * 4096, tid);
            } else if (bid < 160) { sample_attn(A, l, lds, bid - 128, tid); }
            __syncthreads();
            unsigned* ctr = (unsigned*)(ws + WS_CTL) + 16 * l; volatile LAS unsigned* qw = (volatile LAS unsigned*)(lds + MISC_OFF);
            const attn_body::bf16* Q = (const attn_body::bf16*)slotp(ws, l, 4); const attn_body::bf16* K = (const attn_body::bf16*)slotp(ws, l, 5); const attn_body::bf16* V = (const attn_body::bf16*)slotp(ws, l, 6);
            attn_body::bf16* O = (attn_body::bf16*)slotp(ws, l, 13);
            for (;;) {
                if (tid == 0) qw[0] = atomicAdd(ctr, 1u);
                __syncthreads();
                const unsigned u = qw[0];
                __syncthreads();
                if (u >= 4096u) break;
                const int qb = 31 - (int)(u >> 7), bh = (int)(u & 127);
                attn_body::attn_unit<8>(bh >> 4, bh & 15, qb, Q, K, V, O, (char*)lds_raw, wv);
            }
            SEAM(p0 + 4); }
        if (IN(p0 + 5)) { PH_BEGIN
            post_attn(A, l, gw, NGW, lane); post_scan(A, l, gw, NGW, lane);
            conv_p(A, l, (bfu*)slotp(ws, l, 10), gtid, NT);
            if (l == 0) conv_weights(A, 1, 1, lds, gw, NGW, lane, wave);
            SEAM(p0 + 5); }
        if (IN(p0 + 6)) { PH_BEGIN
            pg8::Gemm g{(const pg8::bf16_t*)slotp(ws, l, 7), (const pg8::bf16_t*)(wb + W_OUT), MPAD, 1024, 1024};
            pg8::StaticOrder S; S.init(MPAD, 1024, G, bid);
            EpiH<2> E{A->out, (bfu*)slotp(ws, l, 0), rsb + (size_t)(3 * l + 1) * MPAD, nullptr, nullptr};
            pg8::gemm_phase<EpiH<2>, pg8::StaticOrder, true, true>((PG8_LAS unsigned char*)lds, g, S, E, wv);
            SEAM(p0 + 6); }
        if (IN(p0 + 7)) { PH_BEGIN
            pg8::Gemm g{(const pg8::bf16_t*)slotp(ws, l, 0), (const pg8::bf16_t*)(wb + W_FF1), MPAD, FFD, 1024};
            pg8::StaticOrder S; S.init(MPAD, FFD, G, bid);
            EpiB<1> E{(bfu*)slotp(ws, l, 2), FFD, rsb + (size_t)(3 * l + 1) * MPAD};
            pg8::gemm_phase<EpiB<1>, pg8::StaticOrder, true, true>((PG8_LAS unsigned char*)lds, g, S, E, wv);
            {
                pg8::Gemm g2{(const pg8::bf16_t*)slotp(ws, l, 10), (const pg8::bf16_t*)(wb + W_PP), MPAD, 1024, 256};
                pg8::StaticOrder S2; S2.init(MPAD, 1024, G, bid);
                EpiB<0> E2{(bfu*)slotp(ws, l, 11), 1024, nullptr};
                pg8::gemm_phase<EpiB<0>, pg8::StaticOrder, true, true>((PG8_LAS unsigned char*)lds, g2, S2, E2, wv); }
            SEAM(p0 + 7); }
        if (IN(p0 + 8)) { PH_BEGIN
            pg8::Gemm g{(const pg8::bf16_t*)slotp(ws, l, 2), (const pg8::bf16_t*)(wb + W_FF2), MPAD, 1024, FFD};
            pg8::StaticOrder S; S.init(MPAD, 1024, G, bid);
            EpiH<2> E{A->out, (bfu*)slotp(ws, l, 0), rsb + (size_t)(3 * l + 2) * MPAD, nullptr, nullptr};
            pg8::gemm_phase<EpiH<2>, pg8::StaticOrder, true, true>((PG8_LAS unsigned char*)lds, g, S, E, wv);
            SEAM(p0 + 8); }
        if (IN(p0 + 9)) { PH_BEGIN SEAM_SKIP(p0 + 9); }
        if (IN(p0 + 10)) { PH_BEGIN
            pg8::Gemm g{(const pg8::bf16_t*)slotp(ws, l, 0), (const pg8::bf16_t*)(wb + W_GATE), MPAD, 1024, 1024};
            pg8::StaticOrder S; S.init(MPAD, 1024, G, bid);
            EpiH<3> E{A->out, (bfu*)slotp(ws, l, 13), rsb + (size_t)(3 * l + 3) * MPAD, rsb + (size_t)(3 * l + 2) * MPAD, (const bfu*)slotp(ws, l, 11)};
            pg8::gemm_phase<EpiH<3>, pg8::StaticOrder, true, true>((PG8_LAS unsigned char*)lds, g, S, E, wv);
            SEAM(p0 + 10); }
        }
    if (IN(NPHASE - 1)) { PH_BEGIN final_norm(A, gw, NGW, lane); }
}
#undef PH_BEGIN
#undef IN
#undef SEAM

extern "C" void kernel_launch(void* const* d_in, const int* in_sizes, int n_in, void* d_out, int out_size, void* d_ws, size_t ws_size, hipStream_t stream) {
    static int grid = 0;
    if (grid == 0) {
        if (n_in != 40 || (size_t)out_size != O_END || ws_size < WS_TOTAL) { fprintf(stderr, "kernel_launch: unexpected shapes (n_in %d out %d ws %zu)\n", n_in, out_size, ws_size); grid = -1; return; }
        int dev = 0, cus = 0, per_cu = 0;
        if (hipGetDevice(&dev) != hipSuccess || hipDeviceGetAttribute(&cus, hipDeviceAttributeMultiprocessorCount, dev) != hipSuccess) { grid = -1; return; }
        if (hipFuncSetAttribute((const void*)hybrid_fwd, hipFuncAttributeMaxDynamicSharedMemorySize, LDS_BYTES) != hipSuccess) { fprintf(stderr, "kernel_launch: hipFuncSetAttribute failed\n"); grid = -1; return; }
        if (hipOccupancyMaxActiveBlocksPerMultiprocessor(&per_cu, (const void*)hybrid_fwd, NTHR, LDS_BYTES) != hipSuccess || per_cu < 1) { fprintf(stderr, "kernel_launch: occupancy query says %d\n", per_cu); per_cu = 1; }
        (void)hipGetLastError();
        grid = cus;
    }
    if (grid < 0) return;
    if (hipMemsetAsync((char*)d_ws + WS_CTL, 0, 64 * 1024, stream) != hipSuccess) { fprintf(stderr, "kernel_launch: memset failed\n"); return; }
    Args a{};
    for (int i = 0; i < 40; ++i) a.in[i] = (const float*)d_in[i];
    a.out = (float*)d_out; a.ws = (unsigned char*)d_ws;
#if MK_ONE_LAUNCH
    a.ph_lo = 0; a.ph_hi = NPHASE;
    void* args[] = {&a};
    hipError_t e = hipLaunchCooperativeKernel((const void*)hybrid_fwd, dim3(grid), dim3(NTHR), args, LDS_BYTES, stream);
    if (e != hipSuccess) fprintf(stderr, "kernel_launch: cooperative launch failed: %s (grid %d)\n", hipGetErrorString(e), grid);
#else
    for (int ph = 0; ph < NPHASE; ++ph) { a.ph_lo = ph; a.ph_hi = ph + 1; hipLaunchKernelGGL(hybrid_fwd, dim3(grid), dim3(NTHR), LDS_BYTES, stream, a); }
#endif
}
```

```cpp
#include <hip/hip_runtime.h>
#include <hip/hip_cooperative_groups.h>
#include <cstdio>
#include <cstdint>
namespace cg = cooperative_groups;
namespace pg8 {
#define PG8_LAS __attribute__((address_space(3)))
typedef unsigned short bf16_t;
typedef short bf16x8 __attribute__((ext_vector_type(8)));
typedef float f32x4 __attribute__((ext_vector_type(4)));
typedef unsigned u32x4 __attribute__((ext_vector_type(4)));
constexpr int BM = 256, BK = 64, HALF = 128, HTB = HALF * BK * 2  , STAGE_BYTES = 8 * HTB, NXCD = 8, WGM = 8;

__host__ __device__ __forceinline__ int lds_byte(int r, int c) { const int st = (r >> 4) * 2 + (c >> 5), rr = r & 15, cc = c & 31, ob = rr * 64 + cc * 2; return st * 1024 + (ob ^ (((ob >> 9) & 1) << 5)); }
__host__ __device__ __forceinline__ void stage_rc(int b, int& R, int& C) { const int st = b / 1024, sb = b % 1024, swz = sb ^ (((sb >> 9) & 1) << 5); R = (st >> 1) * 16 + swz / 64; C = (st & 1) * 32 + (swz % 64) / 2; }
__host__ __device__ __forceinline__ int perm32(int rho) { const int n = rho >> 4, i = rho & 15; return 8 * (i >> 2) + 4 * n + (i & 3); }

struct Unit { int pm, pn; };
struct Gemm { const bf16_t* A; const bf16_t* Bt; int M, N, K; };

struct StaticOrder {
    int nM, nN, nwg, G, c;
    __host__ __device__ void init(int M, int N, int G_, int c_) { nM = M / BM; nN = N / BM; nwg = nM * nN; G = G_; c = c_; }
    __host__ __device__ bool next(int i, Unit& u) const {
        const long L = (long)i * G + c; if (L >= nwg) return false;
        int wgid = (int)L; { const int q = nwg / NXCD, r = nwg % NXCD, xcd = wgid % NXCD, off = wgid / NXCD; wgid = (xcd < r ? xcd * (q + 1) : r * (q + 1) + (xcd - r) * q) + off; }
        const int nig = WGM * nN, gid = wgid / nig, fm = gid * WGM, gsz = (nM - fm) < WGM ? (nM - fm) : WGM;
        u.pm = fm + ((wgid % nig) % gsz); u.pn = (wgid % nig) / gsz; return true;
    }
    __device__ __forceinline__ void a_ready(const Unit&) const {}
    __device__ __forceinline__ void done(const Unit&) const {}
};

__device__ __forceinline__ unsigned cvt_pk_bf16(float lo, float hi) { unsigned r; asm volatile("v_cvt_pk_bf16_f32 %0, %1, %2" : "=v"(r) : "v"(lo), "v"(hi)); return r; }
typedef float f32x2 __attribute__((ext_vector_type(2)));
__device__ __forceinline__ f32x2 gelu_pk(f32x2 v) {
    const f32x2 av = __builtin_elementwise_abs(v), d = av * 0.2316418882f + 1.0f;
    f32x2 t; t.x = __builtin_amdgcn_rcpf(d.x); t.y = __builtin_amdgcn_rcpf(d.y);
    f32x2 q = t * 0.5307027145f + (-0.7265760135f); q = q * t + 0.7107068705f; q = q * t + (-0.142248368f); q = q * t + 0.127414796f; q = q * t;
    const f32x2 s = (v * v) * (-0.72134752044f);
    f32x2 e; e.x = __builtin_amdgcn_exp2f(s.x); e.y = __builtin_amdgcn_exp2f(s.y);
    const f32x2 m = v * (q * e), r = v - m;
    f32x2 o; o.x = v.x < 0.f ? m.x : r.x; o.y = v.y < 0.f ? m.y : r.y; return o;
}

template <int ACT  > struct EpiBf16 {
    static constexpr bool PERM = true, AFTER_DRAIN = false; static_assert(ACT == 0 || ACT == 1, "EpiBf16: ACT is 0 (none) or 1 (gelu_pk)");
    bf16_t* O; int ldc; const float* bias; int split_cols; size_t split_stride; float scale0;
    __device__ __forceinline__ void operator()(const f32x4 (&acc)[2][2][4][2], const Unit& u, int wr, int wc, int fr, int fq) const {
        const int row0 = u.pm * BM + wr * 64 + fr; int colt = u.pn * BM; bf16_t* base = O;
        float sc = 1.f; if (split_cols) { const int t = colt / split_cols; base += (size_t)t * split_stride; colt -= t * split_cols; if (t == 0) sc = scale0; }
        const int col0 = colt + wc * 32 + 8 * fq, bcol0 = u.pn * BM + wc * 32 + 8 * fq;
        f32x4 bv[2][2];
#pragma unroll
        for (int bj = 0; bj < 2; ++bj)
#pragma unroll
            for (int n = 0; n < 2; ++n) bv[bj][n] = bias ? *(const f32x4*)(bias + bcol0 + bj * HALF + 4 * n) : (f32x4){0.f, 0.f, 0.f, 0.f};
#pragma unroll
        for (int ai = 0; ai < 2; ++ai)
#pragma unroll
            for (int m = 0; m < 4; ++m) { bf16_t* rowp = base + (size_t)(row0 + ai * HALF + m * 16) * ldc + col0;
#pragma unroll
                for (int bj = 0; bj < 2; ++bj) { f32x4 v0 = acc[ai][bj][m][0] + bv[bj][0], v1 = acc[ai][bj][m][1] + bv[bj][1];
                    if (ACT == 1) { f32x2 a = gelu_pk((f32x2){v0[0], v0[1]}), b = gelu_pk((f32x2){v0[2], v0[3]}), c = gelu_pk((f32x2){v1[0], v1[1]}), d = gelu_pk((f32x2){v1[2], v1[3]});
                        v0 = (f32x4){a.x, a.y, b.x, b.y}; v1 = (f32x4){c.x, c.y, d.x, d.y}; }
                    v0 = v0 * sc; v1 = v1 * sc; u32x4 w; w.x = cvt_pk_bf16(v0[0], v0[1]); w.y = cvt_pk_bf16(v0[2], v0[3]); w.z = cvt_pk_bf16(v1[0], v1[1]); w.w = cvt_pk_bf16(v1[2], v1[3]);
                    *(u32x4*)(rowp + bj * HALF) = w; } }
    }
};

struct PanelStats {
    unsigned* xbuf;
    unsigned* cnt;
    unsigned* tmo;
    int ntn; float eps;
    unsigned code;
    __device__ __forceinline__ bool run(const f32x4 (&v)[2][2][4][2], const Unit& u, int wr, int wc, int fr, int fq, PG8_LAS unsigned char* lds, int wid, int lane) const {
        typedef float f32x2v __attribute__((ext_vector_type(2)));
        PG8_LAS f32x2v* P = (PG8_LAS f32x2v*)lds;
        PG8_LAS f32x2v* S = (PG8_LAS f32x2v*)(lds + 8192);
        PG8_LAS unsigned* flag = (PG8_LAS unsigned*)(lds + 8192 + 2048);
#pragma unroll
        for (int ai = 0; ai < 2; ++ai)
#pragma unroll
            for (int m = 0; m < 4; ++m) {
                float s = 0.f;
#pragma unroll
                for (int bj = 0; bj < 2; ++bj)
#pragma unroll
                    for (int n = 0; n < 2; ++n) { const f32x4 x = v[ai][bj][m][n]; s += (x[0] + x[1]) + (x[2] + x[3]); }
                s += __shfl_xor(s, 16); s += __shfl_xor(s, 32);
                const float mw = s * (1.0f / 64.0f); float q = 0.f;
#pragma unroll
                for (int bj = 0; bj < 2; ++bj)
#pragma unroll
                    for (int n = 0; n < 2; ++n) { const f32x4 d = v[ai][bj][m][n] - mw; q += (d[0] * d[0] + d[1] * d[1]) + (d[2] * d[2] + d[3] * d[3]); }
                q += __shfl_xor(q, 16); q += __shfl_xor(q, 32);
                if (fq == 0) P[(ai * HALF + wr * 64 + m * 16 + fr) * 4 + wc] = (f32x2v){mw, q};
            }
        asm volatile("s_waitcnt lgkmcnt(0)" ::: "memory"); __builtin_amdgcn_s_barrier(); asm volatile("" ::: "memory");
#if defined(BROKEN_EXCHANGE_NO_WAIT)
#warning BROKEN CONTROL BUILD: the row-statistics exchange does not wait; results are wrong by design
        if (blockIdx.x >= 64) { const long long t0_ = clock64(); while (clock64() - t0_ < 60000) __builtin_amdgcn_s_sleep(8); }
#endif
        const int row = wid * 32 + (lane & 31);
        if (lane < 32) {
            const f32x2v a = P[row * 4 + 0], b = P[row * 4 + 1], c = P[row * 4 + 2], d = P[row * 4 + 3];
            const float mt = (a.x + b.x + c.x + d.x) * 0.25f;
            const float da = a.x - mt, db = b.x - mt, dc = c.x - mt, dd = d.x - mt;
            const float m2 = (a.y + b.y) + (c.y + d.y) + 64.0f * ((da * da + db * db) + (dc * dc + dd * dd));
            unsigned long long* slot = (unsigned long long*)xbuf + ((size_t)(u.pm * BM + row) * 4 + u.pn);
            __hip_atomic_store(slot, ((unsigned long long)__float_as_uint(m2) << 32) | __float_as_uint(mt), __ATOMIC_RELAXED, __HIP_MEMORY_SCOPE_AGENT);
        }
        asm volatile("s_waitcnt vmcnt(0)" ::: "memory");
        if (lane == 0) __hip_atomic_fetch_add(cnt + 64 * u.pm, 1u, __ATOMIC_RELAXED, __HIP_MEMORY_SCOPE_AGENT);
        if (wid == 0) {
            bool dead = false; const unsigned long long t0 = __builtin_amdgcn_s_memrealtime(); const unsigned want = 8u * (unsigned)ntn;
            for (;;) {
#if defined(BROKEN_EXCHANGE_NO_WAIT)
                break;
#endif
                if ((unsigned)__builtin_amdgcn_readfirstlane(__hip_atomic_load(cnt + 64 * u.pm, __ATOMIC_RELAXED, __HIP_MEMORY_SCOPE_AGENT)) >= want) break;
                if (__builtin_amdgcn_s_memrealtime() - t0 > 2000000ull) {
                    if (lane == 0) { unsigned expect = 0u; __hip_atomic_compare_exchange_strong(tmo + 1, &expect, code | (unsigned)(u.pm & 0xff), __ATOMIC_RELAXED, __ATOMIC_RELAXED, __HIP_MEMORY_SCOPE_AGENT);
                                     __hip_atomic_store(tmo, 1u, __ATOMIC_RELAXED, __HIP_MEMORY_SCOPE_AGENT); }
                    dead = true; break; }
                __builtin_amdgcn_s_sleep(2);
            }
            __builtin_amdgcn_fence(__ATOMIC_ACQUIRE, "agent");
            if (lane == 0) flag[0] = dead ? 1u : 0u;
        }
        asm volatile("s_waitcnt vmcnt(0) lgkmcnt(0)" ::: "memory"); __builtin_amdgcn_s_barrier(); asm volatile("" ::: "memory");
        const bool bad = flag[0] != 0u;
        if (lane < 32) {
            const unsigned long long* slot = (const unsigned long long*)xbuf + (size_t)(u.pm * BM + row) * 4; float mt[4], m2[4]; float ms = 0.f;
#pragma unroll
            for (int t = 0; t < 4; ++t) { if (t < ntn) { const unsigned long long w = __hip_atomic_load(slot + t, __ATOMIC_RELAXED, __HIP_MEMORY_SCOPE_AGENT); mt[t] = __uint_as_float((unsigned)w); m2[t] = __uint_as_float((unsigned)(w >> 32)); } else { mt[t] = 0.f; m2[t] = 0.f; } ms += mt[t]; }
            const float mean = ms / (float)ntn; float q = 0.f;
#pragma unroll
            for (int t = 0; t < 4; ++t) if (t < ntn) { const float dm = mt[t] - mean; q += m2[t] + 256.0f * dm * dm; }
            S[row] = (f32x2v){mean, 1.0f / sqrtf(q / (256.0f * (float)ntn) + eps)};
        }
        asm volatile("s_waitcnt lgkmcnt(0)" ::: "memory"); __builtin_amdgcn_s_barrier(); asm volatile("" ::: "memory");
        return bad;
    }
};
struct EpiLnRes {
    static constexpr bool PERM = false, AFTER_DRAIN = true;
    const float* base; float* out; int ldc; const float* bias; PanelStats st; unsigned poison;
    __device__ __forceinline__ void fused(f32x4 (&acc)[2][2][4][2], const Unit& u, int wr, int wc, int fr, int fq, PG8_LAS unsigned char* lds, int wid, int lane) const {
        typedef float f32x2v __attribute__((ext_vector_type(2)));
        const PG8_LAS f32x2v* S = (const PG8_LAS f32x2v*)(lds + 8192);
        const int col0 = u.pn * BM + wc * 32 + 4 * fq;
#pragma unroll
        for (int bj = 0; bj < 2; ++bj)
#pragma unroll
            for (int n = 0; n < 2; ++n) { const f32x4 bv = bias ? *(const f32x4*)(bias + col0 + bj * HALF + n * 16) : (f32x4){0.f, 0.f, 0.f, 0.f};
#pragma unroll
                for (int ai = 0; ai < 2; ++ai)
#pragma unroll
                    for (int m = 0; m < 4; ++m) acc[ai][bj][m][n] += bv; }
        f32x4 pre[4][2][2];
#pragma unroll
        for (int m = 0; m < 4; ++m) { const size_t off = (size_t)(u.pm * BM + wr * 64 + m * 16 + fr) * ldc + col0;
#pragma unroll
            for (int bj = 0; bj < 2; ++bj)
#pragma unroll
                for (int n = 0; n < 2; ++n) pre[m][bj][n] = *(const f32x4*)(base + off + bj * HALF + n * 16); }
        const bool bad = st.run(acc, u, wr, wc, fr, fq, lds, wid, lane) || poison != 0u;
        const float qnan = __builtin_nanf("");
#pragma unroll
        for (int ai = 0; ai < 2; ++ai)
#pragma unroll
            for (int m = 0; m < 4; ++m) { const int r = ai * HALF + wr * 64 + m * 16 + fr; const f32x2v sr = S[r]; const size_t off = (size_t)(u.pm * BM + r) * ldc + col0;
#pragma unroll
                for (int bj = 0; bj < 2; ++bj)
#pragma unroll
                    for (int n = 0; n < 2; ++n) { const f32x4 bs = ai == 0 ? pre[m][bj][n] : *(const f32x4*)(base + off + bj * HALF + n * 16); f32x4 o = bs + (acc[ai][bj][m][n] - sr.x) * sr.y;
                        if (bad) o = (f32x4){qnan, qnan, qnan, qnan}; *(f32x4*)(out + off + bj * HALF + n * 16) = o; }
                if (m & 1) asm volatile("" ::: "memory"); }
    }
};
struct EpiLnResLn {
    static constexpr bool PERM = false, AFTER_DRAIN = true;
    const float* base; float* out; bf16_t* xn; int ldc; const float* bias; PanelStats st1, st2; unsigned poison;
    __device__ __forceinline__ void fused(f32x4 (&acc)[2][2][4][2], const Unit& u, int wr, int wc, int fr, int fq, PG8_LAS unsigned char* lds, int wid, int lane) const {
        typedef float f32x2v __attribute__((ext_vector_type(2))); typedef unsigned u32x2v __attribute__((ext_vector_type(2)));
        const PG8_LAS f32x2v* S = (const PG8_LAS f32x2v*)(lds + 8192);
        const int col0 = u.pn * BM + wc * 32 + 4 * fq;
#pragma unroll
        for (int bj = 0; bj < 2; ++bj)
#pragma unroll
            for (int n = 0; n < 2; ++n) { const f32x4 bv = bias ? *(const f32x4*)(bias + col0 + bj * HALF + n * 16) : (f32x4){0.f, 0.f, 0.f, 0.f};
#pragma unroll
                for (int ai = 0; ai < 2; ++ai)
#pragma unroll
                    for (int m = 0; m < 4; ++m) acc[ai][bj][m][n] += bv; }
        bool bad = st1.run(acc, u, wr, wc, fr, fq, lds, wid, lane) || poison != 0u;
        const float qnan = __builtin_nanf("");
#pragma unroll
        for (int ai = 0; ai < 2; ++ai)
#pragma unroll
            for (int m = 0; m < 4; ++m) { const int r = ai * HALF + wr * 64 + m * 16 + fr; const f32x2v sr = S[r]; const size_t off = (size_t)(u.pm * BM + r) * ldc + col0;
#pragma unroll
                for (int bj = 0; bj < 2; ++bj)
#pragma unroll
                    for (int n = 0; n < 2; ++n) { const f32x4 bs = *(const f32x4*)(base + off + bj * HALF + n * 16); acc[ai][bj][m][n] = bs + (acc[ai][bj][m][n] - sr.x) * sr.y; }
                asm volatile("" : "+v"(acc[ai][0][m][0]), "+v"(acc[ai][0][m][1]), "+v"(acc[ai][1][m][0]), "+v"(acc[ai][1][m][1]));
                if (m & 1) asm volatile("" ::: "memory"); }
        const bool bad1 = bad;
        bad = st2.run(acc, u, wr, wc, fr, fq, lds, wid, lane) || bad;
#pragma unroll
        for (int ai = 0; ai < 2; ++ai)
#pragma unroll
            for (int m = 0; m < 4; ++m) { const int r = ai * HALF + wr * 64 + m * 16 + fr; const f32x2v sr = S[r]; const size_t off = (size_t)(u.pm * BM + r) * ldc + col0;
#pragma unroll
                for (int bj = 0; bj < 2; ++bj)
#pragma unroll
                    for (int n = 0; n < 2; ++n) { const f32x4 x1 = acc[ai][bj][m][n]; *(f32x4*)(out + off + bj * HALF + n * 16) = bad1 ? (f32x4){qnan, qnan, qnan, qnan} : x1;
                        const f32x4 o = (x1 - sr.x) * sr.y; u32x2v w; w.x = cvt_pk_bf16(o[0], o[1]); w.y = cvt_pk_bf16(o[2], o[3]);
                        if (bad) { w.x = 0x7fc07fc0u; w.y = 0x7fc07fc0u; } *(u32x2v*)(xn + off + bj * HALF + n * 16) = w; }
                asm volatile("" ::: "memory"); }
    }
};

template <class Epi, class Sched, bool ALIGN_EPI = false, bool SP2 = false>
__device__ __forceinline__ void gemm_phase(PG8_LAS unsigned char* lds, const Gemm g, const Sched& S, const Epi& E, const int wv_) {
    int tid_o = wv_ * 64 + (int)__builtin_amdgcn_mbcnt_hi(~0u, __builtin_amdgcn_mbcnt_lo(~0u, 0u)); asm volatile("" : "+v"(tid_o)); tid_o &= 511;
    const int tid = tid_o, wid = __builtin_amdgcn_readfirstlane(tid >> 6), lane = tid & 63, wr = wid >> 2, wc = wid & 3, fr = lane & 15, fq = lane >> 4;
    const int K = g.K, nt = K / BK;
    unsigned voffA[2], voffB[2];
#pragma unroll
    for (int i = 0; i < 2; ++i) { int R, C; stage_rc(tid * 16 + i * 8192, R, C); const int Rb = Epi::PERM ? ((R & ~31) + perm32(R & 31)) : R;
        voffA[i] = (unsigned)(R * K + C) * 2u; voffB[i] = (unsigned)(Rb * K + C) * 2u; }
    const size_t kstep = (size_t)(BK * 2);
    const size_t hstep = (size_t)HALF * K * 2;
    const size_t tstep = 2 * hstep;
    const unsigned ldsw = (unsigned)wid * 1024u;
    const int aoff = lds_byte(wr * 64 + fr, fq * 8), boff = lds_byte(wc * 32 + fr, fq * 8);
#define PG8_SA(b, h) (((b) * 2 + (h)) * HTB)
#define PG8_SB(b, h) ((4 + (b) * 2 + (h)) * HTB)
#define PG8_STAGE(bufoff, gbase, voff) do { _Pragma("unroll") for (int _i = 0; _i < 2; ++_i) \
        __builtin_amdgcn_global_load_lds((const unsigned*)((const char*)(gbase) + (voff)[_i]), (PG8_LAS unsigned*)(lds + (bufoff) + ldsw + _i * 8192), 16, 0, 0); } while (0)
#define PG8_LDA(dst, b, h) do { _Pragma("unroll") for (int m = 0; m < 4; ++m) _Pragma("unroll") for (int k = 0; k < 2; ++k) dst[m][k] = *(const PG8_LAS bf16x8*)(lds + PG8_SA(b, h) + aoff + m * 2048 + k * 1024); } while (0)
#define PG8_LDB(dst, b, h) do { _Pragma("unroll") for (int n = 0; n < 2; ++n) _Pragma("unroll") for (int k = 0; k < 2; ++k) dst[n][k] = *(const PG8_LAS bf16x8*)(lds + PG8_SB(b, h) + boff + n * 2048 + k * 1024); } while (0)
#define PG8_MMA(ai, bj, At, Bt) do { __builtin_amdgcn_s_setprio(1); _Pragma("unroll") for (int m = 0; m < 4; ++m) _Pragma("unroll") for (int n = 0; n < 2; ++n) _Pragma("unroll") for (int k = 0; k < 2; ++k) \
        acc[ai][bj][m][n] = __builtin_amdgcn_mfma_f32_16x16x32_bf16(Bt[n][k], At[m][k], acc[ai][bj][m][n], 0, 0, 0); __builtin_amdgcn_s_setprio(0); } while (0)
#define PG8_WAIT_V(n) asm volatile("s_waitcnt vmcnt(" #n ")" ::: "memory")
#define PG8_WAIT_L(n) asm volatile("s_waitcnt lgkmcnt(" #n ")" ::: "memory")
#define PG8_BAR __builtin_amdgcn_s_barrier()
#define PG8_SCHED __builtin_amdgcn_sched_barrier(0)
    Unit cur, nxt; int ui = 0;
    if (!S.next(0, cur)) return;
    f32x4 acc[2][2][4][2];
#pragma unroll
    for (int a = 0; a < 2; ++a)
#pragma unroll
        for (int b = 0; b < 2; ++b)
#pragma unroll
            for (int m = 0; m < 4; ++m)
#pragma unroll
                for (int n = 0; n < 2; ++n) acc[a][b][m][n] = (f32x4){0.f, 0.f, 0.f, 0.f};
    bf16x8 At[4][2], B0[2][2], B1[2][2];
    const char* cA = (const char*)g.A + (size_t)cur.pm * tstep; const char* cB = (const char*)g.Bt + (size_t)cur.pn * tstep;
    S.a_ready(cur);
    if constexpr (SP2) {
        PG8_STAGE(PG8_SB(0, 0), cB, voffB); PG8_STAGE(PG8_SB(0, 1), cB + hstep, voffB); PG8_STAGE(PG8_SA(0, 0), cA, voffA); PG8_STAGE(PG8_SA(0, 1), cA + hstep, voffA);
        if (wr == 1) PG8_BAR;
        PG8_WAIT_V(2); PG8_BAR;
        PG8_STAGE(PG8_SB(1, 0), cB + kstep, voffB); PG8_STAGE(PG8_SA(1, 0), cA + kstep, voffA); PG8_STAGE(PG8_SB(1, 1), cB + hstep + kstep, voffB);
        PG8_WAIT_V(6); PG8_BAR;
    } else {
        PG8_STAGE(PG8_SB(0, 0), cB, voffB); PG8_STAGE(PG8_SA(0, 0), cA, voffA); PG8_STAGE(PG8_SB(0, 1), cB + hstep, voffB); PG8_STAGE(PG8_SA(0, 1), cA + hstep, voffA);
        if (wr == 1) PG8_BAR;
        PG8_WAIT_V(4); PG8_BAR;
        PG8_STAGE(PG8_SB(1, 0), cB + kstep, voffB); PG8_STAGE(PG8_SA(1, 0), cA + kstep, voffA); PG8_STAGE(PG8_SB(1, 1), cB + hstep + kstep, voffB);
        PG8_WAIT_V(6); PG8_BAR;
    }
    for (;;) {
        const bool has_next = S.next(ui + 1, nxt);
        const char* nA = has_next ? (const char*)g.A + (size_t)nxt.pm * tstep : cA; const char* nB = has_next ? (const char*)g.Bt + (size_t)nxt.pn * tstep : cB;
        for (int t = 0; t < nt; t += 2) {
            const bool last = (t == nt - 2);
            const char* a1 = cA + (size_t)(t + 1) * kstep;
            const char* a2 = last ? nA : cA + (size_t)(t + 2) * kstep; const char* b2 = last ? nB : cB + (size_t)(t + 2) * kstep;
            const char* a3 = a2 + kstep; const char* b3 = b2 + kstep;
            if (last && has_next) S.a_ready(nxt);
            if constexpr (SP2) {
            PG8_LDB(B0, 0, 0); PG8_LDB(B1, 0, 1); PG8_SCHED; PG8_LDA(At, 0, 0); PG8_STAGE(PG8_SA(1, 1), a1 + hstep, voffA);
            PG8_WAIT_V(8); PG8_WAIT_L(0); PG8_BAR; PG8_MMA(0, 0, At, B0); PG8_MMA(0, 1, At, B1); PG8_BAR; PG8_SCHED;
            PG8_LDA(At, 0, 1); PG8_STAGE(PG8_SB(0, 0), b2, voffB); PG8_STAGE(PG8_SB(0, 1), b2 + hstep, voffB); PG8_STAGE(PG8_SA(0, 0), a2, voffA);
            PG8_WAIT_V(8); PG8_WAIT_L(0); PG8_BAR; PG8_MMA(1, 0, At, B0); PG8_MMA(1, 1, At, B1); PG8_BAR; PG8_SCHED;
            PG8_LDB(B0, 1, 0); PG8_LDB(B1, 1, 1); PG8_SCHED; PG8_LDA(At, 1, 0); PG8_STAGE(PG8_SA(0, 1), a2 + hstep, voffA);
            PG8_WAIT_V(8); PG8_WAIT_L(0); PG8_BAR; PG8_MMA(0, 0, At, B0); PG8_MMA(0, 1, At, B1); PG8_BAR; PG8_SCHED;
            PG8_LDA(At, 1, 1); PG8_STAGE(PG8_SB(1, 0), b3, voffB); PG8_STAGE(PG8_SB(1, 1), b3 + hstep, voffB); PG8_STAGE(PG8_SA(1, 0), a3, voffA);
            PG8_WAIT_V(8); PG8_WAIT_L(0); PG8_BAR; PG8_MMA(1, 0, At, B0); PG8_MMA(1, 1, At, B1); PG8_BAR; PG8_SCHED;
            } else {
            PG8_LDB(B0, 0, 0); PG8_SCHED; PG8_LDA(At, 0, 0); PG8_STAGE(PG8_SA(1, 1), a1 + hstep, voffA);
            PG8_WAIT_L(8); PG8_BAR; PG8_WAIT_L(0); PG8_MMA(0, 0, At, B0); PG8_BAR; PG8_SCHED;
            PG8_LDB(B1, 0, 1); PG8_STAGE(PG8_SB(0, 0), b2, voffB);
            PG8_BAR; PG8_WAIT_L(0); PG8_MMA(0, 1, At, B1); PG8_BAR;
            PG8_LDA(At, 0, 1); PG8_STAGE(PG8_SA(0, 0), a2, voffA);
            PG8_BAR; PG8_WAIT_L(0); PG8_MMA(1, 0, At, B0); PG8_BAR; PG8_SCHED;
            PG8_STAGE(PG8_SB(0, 1), b2 + hstep, voffB);
            PG8_WAIT_V(6); PG8_BAR; PG8_MMA(1, 1, At, B1); PG8_BAR;
            PG8_LDB(B0, 1, 0); PG8_SCHED; PG8_LDA(At, 1, 0); PG8_STAGE(PG8_SA(0, 1), a2 + hstep, voffA);
            PG8_WAIT_L(8); PG8_BAR; PG8_WAIT_L(0); PG8_MMA(0, 0, At, B0); PG8_BAR; PG8_SCHED;
            PG8_LDB(B1, 1, 1); PG8_STAGE(PG8_SB(1, 0), b3, voffB);
            PG8_BAR; PG8_WAIT_L(0); PG8_MMA(0, 1, At, B1); PG8_BAR;
            PG8_LDA(At, 1, 1); PG8_STAGE(PG8_SA(1, 0), a3, voffA);
            PG8_BAR; PG8_WAIT_L(0); PG8_MMA(1, 0, At, B0); PG8_BAR; PG8_SCHED;
            PG8_STAGE(PG8_SB(1, 1), b3 + hstep, voffB);
            PG8_WAIT_V(6); PG8_BAR; PG8_MMA(1, 1, At, B1); PG8_BAR;
            }
        }
        if constexpr (ALIGN_EPI) { if (wr == 0) PG8_BAR; }
        if constexpr (!Epi::AFTER_DRAIN) { E(acc, cur, wr, wc, fr, fq); S.done(cur); }
        if (!has_next) break;
#pragma unroll
        for (int a = 0; a < 2; ++a)
#pragma unroll
            for (int b = 0; b < 2; ++b)
#pragma unroll
                for (int m = 0; m < 4; ++m)
#pragma unroll
                    for (int n = 0; n < 2; ++n) acc[a][b][m][n] = (f32x4){0.f, 0.f, 0.f, 0.f};
        cur = nxt; cA = nA; cB = nB; ++ui;
        if constexpr (ALIGN_EPI) { if (wr == 1) PG8_BAR; }
    }
    PG8_WAIT_V(0);
    if constexpr (!ALIGN_EPI) { if (wr == 0) PG8_BAR; }
    PG8_BAR;
    if constexpr (Epi::AFTER_DRAIN) { E.fused(acc, cur, wr, wc, fr, fq, lds, wid, lane); S.done(cur); }
#undef PG8_SA
#undef PG8_SB
#undef PG8_STAGE
#undef PG8_LDA
#undef PG8_LDB
#undef PG8_MMA
#undef PG8_WAIT_V
#undef PG8_WAIT_L
#undef PG8_BAR
#undef PG8_SCHED
}
}
#include <hip/hip_bf16.h>
#include <cmath>
namespace attn_body {
using bf16=__hip_bfloat16;
using bf16x8=__attribute__((ext_vector_type(8)))short;
using s16x4=__attribute__((ext_vector_type(4)))short;
using f32x16=__attribute__((ext_vector_type(16)))float;
using u32x4=__attribute__((ext_vector_type(4)))unsigned;
constexpr int BATCH=8,NHEAD=16,SEQ=8192,D=64,DM=NHEAD*D,DMI=512,DMO=1024;
constexpr int NW=8,QBLK=32,QB=QBLK*NW,KVBLK=64,NQB=SEQ/QB;
constexpr int ATTN_PITCH=DM, ATTN_UNIT_ROWS=QB;
__device__ __forceinline__ int crow(int r,int hi){return (r&3)+8*(r>>2)+4*hi;}
#define SBAR() __builtin_amdgcn_sched_barrier(0)
__device__ __forceinline__ void cmask(f32x16&p0,f32x16&p1,int jb,int qrel,int hi){
  const float NEG=-INFINITY; int kb=64*jb+4*hi;
  #pragma unroll
  for(int r=0;r<16;++r){ if(jb>(qrel>>6)){p0[r]=NEG;p1[r]=NEG;} } (void)kb;
}

constexpr int NSLOT=3, SLOTB=8192;
constexpr int LDS_K=0, LDS_V=NSLOT*SLOTB, LDS_WS=2*NSLOT*SLOTB, LDS_OST=LDS_WS+NW*64*4, LDS_BYTES=LDS_OST+NW*4096;
constexpr float C2=0.125f*1.4426950408889634f;
__device__ __forceinline__ void glds16(const void*gsrc,unsigned lds_dst){unsigned keep;
  asm volatile("s_mov_b32 %0, m0\n\ts_mov_b32 m0, %2\n\ts_nop 0\n\tglobal_load_lds_dwordx4 %1, off\n\ts_mov_b32 m0, %0":"=&s"(keep):"v"(gsrc),"s"(lds_dst):"memory");}
__device__ __forceinline__ float max3f(float a,float b,float c){float r;asm("v_max3_f32 %0, %1, %2, %3":"=v"(r):"v"(a),"v"(b),"v"(c));return r;}
__device__ __forceinline__ float max2f(float a,float b){float r;asm("v_max_f32_e32 %0, %1, %2":"=v"(r):"v"(a),"v"(b));return r;}
__device__ __forceinline__ float fadd_s(float a,float b){float r;asm("v_add_f32_e32 %0, %1, %2":"=v"(r):"v"(a),"v"(b));return r;}
__device__ __forceinline__ float fsub_s(float a,float b){float r;asm("v_sub_f32_e32 %0, %1, %2":"=v"(r):"v"(a),"v"(b));return r;}
typedef float f32x2_t __attribute__((ext_vector_type(2))); typedef __bf16 bf16x2_t __attribute__((ext_vector_type(2)));
__device__ __forceinline__ unsigned cvtpk_s(float lo,float hi){f32x2_t v={lo,hi};bf16x2_t b=__builtin_convertvector(v,bf16x2_t);return __builtin_bit_cast(unsigned,b);}
#define WAIT_BAR(N) asm volatile("s_waitcnt vmcnt(" #N ") lgkmcnt(0)\n\ts_barrier":::"memory")

__device__ __forceinline__ void qkt(f32x16&p0,f32x16&p1,const char*Kslot,const bf16x8*qr,const f32x16&negm,int r32,int hi){
  const char*kb=Kslot+hi*1024+r32*16;
  #pragma unroll
  for(int d0=0;d0<4;++d0){
    const bf16x8 b0=*reinterpret_cast<const bf16x8*>(kb+d0*2048);
    const bf16x8 b1=*reinterpret_cast<const bf16x8*>(kb+d0*2048+512);
    if(d0==0){p0=__builtin_amdgcn_mfma_f32_32x32x16_bf16(b0,qr[0],negm,0,0,0);p1=__builtin_amdgcn_mfma_f32_32x32x16_bf16(b1,qr[0],negm,0,0,0);}
    else{p0=__builtin_amdgcn_mfma_f32_32x32x16_bf16(b0,qr[d0],p0,0,0,0);p1=__builtin_amdgcn_mfma_f32_32x32x16_bf16(b1,qr[d0],p1,0,0,0);}}
}
typedef __attribute__((address_space(3))) const char* lds_cptr;
typedef short v4i16_t __attribute__((ext_vector_type(4)));
__device__ __forceinline__ void kload8(bf16x8*kf,lds_cptr kp){
  kf[0]=*(const __attribute__((address_space(3))) bf16x8*)(kp);      kf[1]=*(const __attribute__((address_space(3))) bf16x8*)(kp+512);
  kf[2]=*(const __attribute__((address_space(3))) bf16x8*)(kp+2048); kf[3]=*(const __attribute__((address_space(3))) bf16x8*)(kp+2560);
  kf[4]=*(const __attribute__((address_space(3))) bf16x8*)(kp+4096); kf[5]=*(const __attribute__((address_space(3))) bf16x8*)(kp+4608);
  kf[6]=*(const __attribute__((address_space(3))) bf16x8*)(kp+6144); kf[7]=*(const __attribute__((address_space(3))) bf16x8*)(kp+6656);
}
__device__ __forceinline__ void kload2(bf16x8*kf,lds_cptr kp,int j){ kf[2*j]=*(const __attribute__((address_space(3))) bf16x8*)(kp+j*2048); kf[2*j+1]=*(const __attribute__((address_space(3))) bf16x8*)(kp+j*2048+512); }
__device__ __forceinline__ s16x4 vtr(lds_cptr p){ return __builtin_bit_cast(s16x4,__builtin_amdgcn_ds_read_tr16_b64_v4i16((__attribute__((address_space(3))) v4i16_t*)p)); }
__device__ __forceinline__ float rowmax(const f32x16&p0,const f32x16&p1){
  float a=max3f(p0[0],p0[1],p1[0]),b=max3f(p0[2],p0[3],p1[1]);a=max3f(a,p1[2],p1[3]);
  #pragma unroll
  for(int r=4;r<16;r+=4){a=max3f(a,p0[r],p0[r+1]);b=max3f(b,p0[r+2],p0[r+3]);a=max3f(a,p1[r],p1[r+1]);b=max3f(b,p1[r+2],p1[r+3]);}
  const float m=max2f(a,b);
  auto rr=__builtin_amdgcn_permlane32_swap(__float_as_uint(m),__float_as_uint(m),false,false);
  return max2f(__uint_as_float(rr[0]),__uint_as_float(rr[1]));
}
__device__ __forceinline__ void pv(f32x16*o,int vb,bf16x8 pa0,bf16x8 pa1,bf16x8 pa2,bf16x8 pa3){
  #pragma unroll
  for(int d0=0;d0<2;++d0){s16x4 lo[4],hi[4];
    #pragma unroll
    for(int ks=0;ks<4;++ks){
      asm volatile("ds_read_b64_tr_b16 %0,%1 offset:%c2":"=&v"(lo[ks]):"v"(vb),"i"(d0*4096+ks*1024):"memory");
      asm volatile("ds_read_b64_tr_b16 %0,%1 offset:%c2":"=&v"(hi[ks]):"v"(vb),"i"(d0*4096+ks*1024+512):"memory");}
    asm volatile("s_waitcnt lgkmcnt(0)":::"memory");SBAR();
    #define PK(k) (bf16x8){lo[k][0],lo[k][1],lo[k][2],lo[k][3],hi[k][0],hi[k][1],hi[k][2],hi[k][3]}
    o[d0]=__builtin_amdgcn_mfma_f32_32x32x16_bf16(pa0,PK(0),o[d0],0,0,0);
    o[d0]=__builtin_amdgcn_mfma_f32_32x32x16_bf16(pa1,PK(1),o[d0],0,0,0);
    o[d0]=__builtin_amdgcn_mfma_f32_32x32x16_bf16(pa2,PK(2),o[d0],0,0,0);
    o[d0]=__builtin_amdgcn_mfma_f32_32x32x16_bf16(pa3,PK(3),o[d0],0,0,0);
    #undef PK
  }
}

#ifndef ATTN_STORE16
#define ATTN_STORE16(p,v) (*(u32x4*)(p)=(v))
#endif
template<int THRL> __device__ __forceinline__ void attn_unit(int b,int h,int qb,const bf16*Q,const bf16*__restrict__ K,const bf16*__restrict__ V,bf16*O,char*shm,const int wv_){
  int tid_o=wv_*64+(int)__builtin_amdgcn_mbcnt_hi(~0u,__builtin_amdgcn_mbcnt_lo(~0u,0u)); asm volatile("":"+v"(tid_o)); tid_o&=511;
  const int tid=tid_o,lane=tid&63,r32=lane&31,hi=lane>>5; const int wid=__builtin_amdgcn_readfirstlane(tid>>6);
  const long rowbase=(long)b*SEQ; const int q0=qb*QB;
  const bf16*Qw=Q+(rowbase+q0+wid*QBLK)*DMI+(h>>1)*D;
  const bf16*Kh=K+rowbase*DMI+(h>>1)*D,*Vh=V+rowbase*DMI+(h>>2)*128+(h&1)*64;
  const unsigned lds0=(unsigned)(uintptr_t)shm;
  float*wsf=(float*)(shm+LDS_WS)+wid*64;
  const bf16*ksrc=Kh+(long)lane*DMI+wid*8;
  const bf16*vsrc=Vh+(long)(16*(wid&3)+(lane>>2))*DMI+(wid>>2)*32+(lane&3)*8;
  const unsigned kdst=lds0+LDS_K+wid*1024, vdst=lds0+LDS_V+wid*1024;
  #define DMA_K(t,slot) glds16(ksrc+(long)(t)*KVBLK*DMI,(unsigned)__builtin_amdgcn_readfirstlane(kdst+(slot)))
  #define DMA_V(t,slot) glds16(vsrc+(long)(t)*KVBLK*DMI,(unsigned)__builtin_amdgcn_readfirstlane(vdst+(slot)))
  const int vb0=(int)(lds0+LDS_V)+((lane>>4)&1)*32+(lane&3)*8+(4*hi+((lane&15)>>2))*64;
  const char*Kbase=shm+LDS_K; bf16x8 kf[8];
  const lds_cptr shm3=(lds_cptr)shm; const lds_cptr kp0=shm3+LDS_K+hi*1024+r32*16; const lds_cptr vp0=shm3+LDS_V+((lane>>4)&1)*32+(lane&3)*8+(4*hi+((lane&15)>>2))*64;
  const int NT=(q0+QB)/KVBLK;
  DMA_K(0,0);DMA_V(0,0);DMA_K(1,SLOTB);
  bf16x8 qr[4];
  #pragma unroll
  for(int d0=0;d0<4;++d0)qr[d0]=*reinterpret_cast<const bf16x8*>(&Qw[(long)r32*DMI+d0*16+hi*8]);
  float mhat=0.f,l_reg=0.f;f32x16 o[2];o[0]=f32x16{};o[1]=f32x16{};f32x16 negm=f32x16{};asm volatile("":"+v"(negm));
  const int qrel=wid*QBLK+r32;
  #define CMASK(P0,P1,t) do{int jb_=(t)-(NT-4); if(jb_>=0)cmask(P0,P1,jb_,qrel,hi);}while(0)
  bool resc=false;
  #define START(P0,P1) do{ const float rm=rowmax(P0,P1); resc=false; \
    { const float dl=rm; mhat=fadd_s(mhat,dl); \
      _Pragma("unroll") for(int r=0;r<16;++r){P0[r]=fsub_s(P0[r],dl);P1[r]=fsub_s(P1[r],dl);} \
      _Pragma("unroll") for(int r=0;r<16;++r)negm[r]=-mhat; asm volatile("":"+v"(negm)); } \
    _Pragma("unroll") for(int r=0;r<16;++r)P0[r]=__builtin_amdgcn_exp2f(P0[r]); }while(0)
  #define RESC() do{ if(resc){ asm volatile("s_waitcnt lgkmcnt(0)":::"memory"); \
      _Pragma("unroll") for(int d_=0;d_<2;++d_) _Pragma("unroll") for(int r=0;r<16;++r)o[d_][r]*=wsf[crow(r,hi)]; } }while(0)
  f32x16 pA0,pA1,pB0,pB1;
  int sl_prev=0,sl_cur=0,sl_next=SLOTB;
  #define ROT() do{sl_prev=sl_cur;sl_cur=sl_next;sl_next=(sl_next==(NSLOT-1)*SLOTB)?0:sl_next+SLOTB;}while(0)
  DMA_K(2,2*SLOTB);
  WAIT_BAR(3);
  qkt(pA0,pA1,Kbase,qr,negm,r32,hi);asm volatile("s_nop 15\n\ts_nop 7":"+v"(pA0),"+v"(pA1));CMASK(pA0,pA1,0);
  START(pA0,pA1);
  _Pragma("unroll") for(int r=0;r<16;++r)pA1[r]=__builtin_amdgcn_exp2f(pA1[r]);
  WAIT_BAR(0);
  DMA_K(3,0);DMA_V(1,SLOTB);
  ROT();
  kload8(kf,kp0+sl_cur);
  WAIT_BAR(2);
  s16x4 vlo[8],vhi[8]; u32x4 pw0,pw1,pw2,pw3;
  #define PKW(P,B) cvtpk_s(P[B],P[B+1])
  #define PAF(k) __builtin_bit_cast(bf16x8,pw##k)
  #define VFR(i) (bf16x8){vlo[i][0],vlo[i][1],vlo[i][2],vlo[i][3],vhi[i][0],vhi[i][1],vhi[i][2],vhi[i][3]}
  #define PIN(x) asm volatile("":"+v"(x))
  #define MX3(a,b,c) __builtin_fmaxf(__builtin_fmaxf((a),(b)),(c))
  #define GAPA(MF,A0,A1,A2,A3,W0,W1,PW) do{ MF; sacc+=A0; sacc+=A1; sacc+=A2; sacc+=A3; PIN(sacc); W0; W1; PIN(PW); SBAR(); }while(0)
  #define EX(v) __builtin_amdgcn_exp2f(v)
  #define GAPB(MF,X,B) do{ MF; X[B]=EX(X[B]); X[B+1]=EX(X[B+1]); X[B+2]=EX(X[B+2]); X[B+3]=EX(X[B+3]); PIN(X); SBAR(); }while(0)
  #define VRD(i) do{ vlo[i]=vtr(vp_+(((i)>>2)*4096+((i)&3)*1024)); vhi[i]=vtr(vp_+(((i)>>2)*4096+((i)&3)*1024+512)); }while(0)
  #define KRD(G,j) do{ if(G){ kload2(kf,kp0+sl_next,j); SBAR(); } }while(0)
  #define STEP(C0,C1,P0,P1,t,GK,GV,GL) do{ SBAR(); \
    const lds_cptr vp_=vp0+sl_prev; \
    VRD(0); SBAR(); float sacc=(P0[0]+P0[1]); \
    GAPA(C0=__builtin_amdgcn_mfma_f32_32x32x16_bf16(kf[0],qr[0],negm,0,0,0), P0[2],P0[3],P0[4],P0[5],     pw0[0]=PKW(P0,0), pw0[1]=PKW(P0,2), pw0); \
    VRD(4); SBAR(); GAPA(C1=__builtin_amdgcn_mfma_f32_32x32x16_bf16(kf[1],qr[0],negm,0,0,0), P0[6],P0[7],P0[8],P0[9],     pw0[2]=PKW(P0,4), pw0[3]=PKW(P0,6), pw0); \
    VRD(1); SBAR(); GAPA(C0=__builtin_amdgcn_mfma_f32_32x32x16_bf16(kf[2],qr[1],C0,0,0,0),   P0[10],P0[11],P0[12],P0[13], pw1[0]=PKW(P0,8), pw1[1]=PKW(P0,10), pw1); \
    VRD(5); SBAR(); GAPA(C1=__builtin_amdgcn_mfma_f32_32x32x16_bf16(kf[3],qr[1],C1,0,0,0),   P0[14],P0[15],P1[0],P1[1],   pw1[2]=PKW(P0,12),pw1[3]=PKW(P0,14), pw1); \
    VRD(2); SBAR(); GAPA(C0=__builtin_amdgcn_mfma_f32_32x32x16_bf16(kf[4],qr[2],C0,0,0,0),   P1[2],P1[3],P1[4],P1[5],     pw2[0]=PKW(P1,0), pw2[1]=PKW(P1,2), pw2); \
    VRD(6); SBAR(); GAPA(C1=__builtin_amdgcn_mfma_f32_32x32x16_bf16(kf[5],qr[2],C1,0,0,0),   P1[6],P1[7],P1[8],P1[9],     pw2[2]=PKW(P1,4), pw2[3]=PKW(P1,6), pw2); \
    VRD(3); SBAR(); GAPA(C0=__builtin_amdgcn_mfma_f32_32x32x16_bf16(kf[6],qr[3],C0,0,0,0),   P1[10],P1[11],P1[12],P1[13], pw3[0]=PKW(P1,8), pw3[1]=PKW(P1,10), pw3); \
    VRD(7); SBAR(); GAPA(C1=__builtin_amdgcn_mfma_f32_32x32x16_bf16(kf[7],qr[3],C1,0,0,0),   P1[14],P1[15],0.f,0.f,       pw3[2]=PKW(P1,12),pw3[3]=PKW(P1,14), pw3); \
    l_reg+=sacc; \
    if(GK){DMA_K((t)+3,sl_cur);} if(GV){DMA_V((t)+1,sl_next);} \
    CMASK(C0,C1,t); \
    { float a=MX3(C0[0],C0[1],C1[0]),b=MX3(C0[2],C0[3],C1[1]); a=MX3(a,C1[2],C1[3]); \
      _Pragma("unroll") for(int r=4;r<16;r+=4){a=MX3(a,C0[r],C0[r+1]);b=MX3(b,C0[r+2],C0[r+3]);a=MX3(a,C1[r],C1[r+1]);b=MX3(b,C1[r+2],C1[r+3]);} \
      float rm=__builtin_fmaxf(a,b); { auto rr=__builtin_amdgcn_permlane32_swap(__float_as_uint(rm),__float_as_uint(rm),false,false); rm=__builtin_fmaxf(__uint_as_float(rr[0]),__uint_as_float(rr[1])); } \
      resc=false; \
      if(__builtin_expect(__any(rm>(float)THRL),0)){ const float dl=__builtin_fmaxf(rm,0.f); mhat+=dl; \
        _Pragma("unroll") for(int r=0;r<16;++r){C0[r]-=dl;C1[r]-=dl;} \
        _Pragma("unroll") for(int r=0;r<16;++r)negm[r]=-mhat; asm volatile("":"+v"(negm)); \
        const float f=__builtin_amdgcn_exp2f(-dl); l_reg*=f; if(hi==0)wsf[r32]=f; resc=true; } } \
    SBAR(); \
    GAPB(o[0]=__builtin_amdgcn_mfma_f32_32x32x16_bf16(PAF(0),VFR(0),o[0],0,0,0), C0,0); \
    GAPB(o[1]=__builtin_amdgcn_mfma_f32_32x32x16_bf16(PAF(0),VFR(4),o[1],0,0,0), C0,4); \
    KRD(GL,0); GAPB(o[0]=__builtin_amdgcn_mfma_f32_32x32x16_bf16(PAF(1),VFR(1),o[0],0,0,0), C0,8); \
    KRD(GL,1); GAPB(o[1]=__builtin_amdgcn_mfma_f32_32x32x16_bf16(PAF(1),VFR(5),o[1],0,0,0), C0,12); \
    KRD(GL,2); GAPB(o[0]=__builtin_amdgcn_mfma_f32_32x32x16_bf16(PAF(2),VFR(2),o[0],0,0,0), C1,0); \
    KRD(GL,3); GAPB(o[1]=__builtin_amdgcn_mfma_f32_32x32x16_bf16(PAF(2),VFR(6),o[1],0,0,0), C1,4); \
    GAPB(o[0]=__builtin_amdgcn_mfma_f32_32x32x16_bf16(PAF(3),VFR(3),o[0],0,0,0), C1,8); \
    GAPB(o[1]=__builtin_amdgcn_mfma_f32_32x32x16_bf16(PAF(3),VFR(7),o[1],0,0,0), C1,12); \
    }while(0)
  int t=1;
  #undef CMASK
  #define CMASK(P0,P1,t) do{}while(0)
  for(;t+5<NT;t+=2){
    STEP(pB0,pB1,pA0,pA1,t,true,true,true);     WAIT_BAR(2); RESC(); ROT();
    STEP(pA0,pA1,pB0,pB1,t+1,true,true,true);   WAIT_BAR(2); RESC(); ROT();
  }
  #undef CMASK
  #define CMASK(P0,P1,t) do{int jb_=(t)-(NT-4); if(jb_>=0)cmask(P0,P1,jb_,qrel,hi);}while(0)
  #define ENDW(tt) do{ if((tt)+3<NT){WAIT_BAR(2);} else if((tt)+2<NT){WAIT_BAR(1);} else {WAIT_BAR(0);} }while(0)
  for(;t+1<NT;t+=2){
    STEP(pB0,pB1,pA0,pA1,t,(t+3<NT),(t+1<NT),(t+1<NT));       ENDW(t);   RESC(); ROT();
    STEP(pA0,pA1,pB0,pB1,t+1,(t+4<NT),(t+2<NT),(t+2<NT));     ENDW(t+1); RESC(); ROT();
  }
  STEP(pB0,pB1,pA0,pA1,NT-1,false,false,false); RESC();
  { float sacc=pB0[0]+pB0[1]; _Pragma("unroll") for(int r=2;r<16;++r)sacc+=pB0[r]; _Pragma("unroll") for(int r=0;r<16;++r)sacc+=pB1[r]; l_reg+=sacc;
    pw0=(u32x4){PKW(pB0,0),PKW(pB0,2),PKW(pB0,4),PKW(pB0,6)};pw1=(u32x4){PKW(pB0,8),PKW(pB0,10),PKW(pB0,12),PKW(pB0,14)};pw2=(u32x4){PKW(pB1,0),PKW(pB1,2),PKW(pB1,4),PKW(pB1,6)};pw3=(u32x4){PKW(pB1,8),PKW(pB1,10),PKW(pB1,12),PKW(pB1,14)};
    SBAR(); pv(o,vb0+sl_cur,PAF(0),PAF(1),PAF(2),PAF(3)); }
  #undef PKW
  #undef PAF
  #undef VFR
  #undef PIN
  #undef MX3
  #undef GAPA
  #undef GAPB
  #undef EX
  #undef VRD
  #undef KRD
  #undef STEP
  #undef ENDW
  {auto rr=__builtin_amdgcn_permlane32_swap(__float_as_uint(l_reg),__float_as_uint(l_reg),false,false);l_reg=__uint_as_float(rr[0])+__uint_as_float(rr[1]);}
  if(hi==0)wsf[32+r32]=l_reg;asm volatile("s_waitcnt lgkmcnt(0)":::"memory");
  float rli[16];
  #pragma unroll
  for(int r=0;r<16;++r)rli[r]=__builtin_amdgcn_rcpf(wsf[32+crow(r,hi)]);
  bf16*Ow=O+(rowbase+q0+wid*QBLK)*DMO+h*D;
  { bf16*stg=(bf16*)(shm+LDS_OST)+wid*2048;
    #pragma unroll
    for(int r=0;r<16;++r){const int orow=crow(r,hi);
      #pragma unroll
      for(int d0=0;d0<2;++d0)stg[orow*64+d0*32+r32]=__float2bfloat16(o[d0][r]*rli[r]);}
    asm volatile("s_waitcnt lgkmcnt(0)":::"memory");
    #pragma unroll
    for(int i=0;i<4;++i){const int row=i*8+(lane>>3),ch=lane&7; const u32x4 v=*(const u32x4*)(stg+row*64+ch*8); ATTN_STORE16(Ow+(long)row*DMO+ch*8,v);} }
  asm volatile("s_waitcnt lgkmcnt(0)\n\ts_barrier":::"memory");
  #undef DMA_K
  #undef DMA_V
  #undef CMASK
  #undef START
  #undef RESC
  #undef ROT
}
constexpr int ATTN_LDS_BYTES=LDS_BYTES;
struct AttnTensors { const bf16* Q; const bf16* K; const bf16* V; bf16* O; };
struct AttnUnit { int bh; int qb; };
struct StaticOrder {
  int vcu;
  __device__ __forceinline__ explicit StaticOrder(int grid,int block):vcu((block%8)*(grid/8)+block/8){}
  __device__ __forceinline__ bool next(int i,AttnUnit&u)const{ if(i>=4)return false; const int s=vcu&7; u.bh=vcu>>3; u.qb=(i==0)?s:(i==1)?15-s:(i==2)?16+s:31-s; return true; }
  __device__ __forceinline__ void a_ready(const AttnUnit&)const{}
  __device__ __forceinline__ void done(const AttnUnit&)const{}
};
template<class Sched,int THRL=8> __device__ __forceinline__ void attn_phase(char*lds,const AttnTensors&T,const Sched&S){
  AttnUnit u;
  for(int i=0;S.next(i,u);++i){ S.a_ready(u); attn_unit<THRL>(u.bh/NHEAD,u.bh%NHEAD,u.qb,T.Q,T.K,T.V,T.O,lds); S.done(u); }
}
#undef SBAR
#undef WAIT_BAR
}

#define LAS __attribute__((address_space(3)))
typedef unsigned short bfu;
typedef unsigned v4u __attribute__((ext_vector_type(4)));
typedef unsigned v2u __attribute__((ext_vector_type(2)));
typedef float f32x4 __attribute__((ext_vector_type(4)));
typedef float f32x8 __attribute__((ext_vector_type(8)));
typedef float f32x16 __attribute__((ext_vector_type(16)));
typedef float f32x2 __attribute__((ext_vector_type(2)));

constexpr int NWAVES = 8, NTHR = 512;
constexpr int MP = 65536, MS = 128, MR = MP + MS, MPAD = 65792;
constexpr int NIN = 3840, FFD = 4096;
constexpr int NPHASE = 24;
#ifndef MK_ONE_LAUNCH
#define MK_ONE_LAUNCH 1
#endif

constexpr size_t O_Y = 0;
constexpr size_t O_YS = (size_t)MP * 1024;
constexpr size_t O_ACP = O_YS + 128 * 1024;
constexpr size_t O_ADP = O_ACP + 2 * 8 * 3 * 768;
constexpr size_t O_BKP = O_ADP + 2 * 8 * 4 * 64 * 64;
constexpr size_t O_BVP = O_BKP + (size_t)2 * 8 * 8192 * 512;
constexpr size_t O_CSP = O_BVP + (size_t)2 * 8 * 8192 * 512;
constexpr size_t O_CWP = O_CSP + 2 * 8 * 1024;
constexpr size_t O_ACS = O_CWP + 2 * 8 * 4 * 64 * 64;
constexpr size_t O_ADS = O_ACS + 2 * 8 * 3 * 768;
constexpr size_t O_BKS = O_ADS + 2 * 8 * 4 * 64 * 64;
constexpr size_t O_BVS = O_BKS + 2 * 8 * 16 * 512;
constexpr size_t O_CSS = O_BVS + 2 * 8 * 16 * 512;
constexpr size_t O_CWS = O_CSS + 2 * 8 * 1024;
constexpr size_t O_END = O_CWS + 2 * 8 * 4 * 64 * 64;
static_assert(O_END == 202874880, "output size");

constexpr size_t MiB = 1u << 20;
constexpr size_t WS_CTL = 0;
constexpr size_t WS_RS = 64 * 1024;
constexpr size_t WS_BONUS = 2 * MiB;
constexpr size_t WS_GAB = 3 * MiB + 512 * 1024;
constexpr size_t WS_AB = 6 * MiB;
constexpr size_t WS_ROPE = 8 * MiB + 512 * 1024;
constexpr size_t WS_GCH = 10 * MiB + 512 * 1024;
constexpr size_t WS_W = 12 * MiB;
constexpr size_t W_IN = 0, W_OUT = W_IN + (size_t)NIN * 1024 * 2, W_FF1 = W_OUT + 1024 * 1024 * 2, W_FF2 = W_FF1 + 4096 * 1024 * 2,
                 W_GATE = W_FF2 + 4096 * 1024 * 2, W_PP = W_GATE + 1024 * 1024 * 2, W_LR = W_PP + 1024 * 256 * 2, W_END = W_LR + 768 * 256 * 2;
constexpr size_t WS_SLOT = 41 * MiB;
constexpr size_t USLOT = (size_t)MPAD * 1024;
static_assert(WS_W + W_END <= WS_SLOT, "weights");
constexpr size_t WS_PAIRC = WS_SLOT + 15 * USLOT;
constexpr size_t WS_PAIRD = WS_PAIRC + 4 * (size_t)(MPAD / 2) * 16;
constexpr size_t WS_TOTAL = WS_PAIRD + 4 * (size_t)(MPAD / 2) * 8;
static_assert(WS_TOTAL <= (size_t)1024 * MiB, "ws");
static_assert(WS_RS + 7 * (size_t)MPAD * 4 <= WS_BONUS && WS_BONUS + 4 * (size_t)MPAD * 4 <= WS_GAB && WS_GAB + 8 * (size_t)MPAD * 4 <= WS_AB && WS_AB + 8 * (size_t)MPAD * 4 <= WS_ROPE && WS_ROPE + 8192 * 64 * 4 <= WS_GCH && WS_GCH + 4 * 1032 * 64 * 4 <= WS_W, "ctl map");

__device__ __forceinline__ unsigned char* slotp(unsigned char* ws, int l, int s) {
    if (l & 1) { if (s < 2) s += 13; else if (s >= 13) s -= 13; }
    return ws + WS_SLOT + (size_t)s * USLOT;
}
__device__ __forceinline__ unsigned char* slotph(unsigned char* ws, int l, int s) { return slotp(ws, l, s) + USLOT / 2; }

constexpr int RING_BYTES = 131072, MISC_OFF = RING_BYTES + 320, LDS_BYTES = 147456;

#define LDS_WAIT() asm volatile("s_waitcnt lgkmcnt(0)" ::: "memory")
__device__ __forceinline__ float bf2f(unsigned short u) { return __uint_as_float(((unsigned)u) << 16); }
__device__ __forceinline__ unsigned f2bf(float f) { unsigned u = __builtin_bit_cast(unsigned, f); return (u + 0x7fffu + ((u >> 16) & 1u)) >> 16; }
__device__ __forceinline__ unsigned pk2(float lo, float hi) { return f2bf(lo) | (f2bf(hi) << 16); }
#define DPP_ROR_ADD(v, ctrl) ((v) + __builtin_bit_cast(float, __builtin_amdgcn_update_dpp(0, __builtin_bit_cast(int, (v)), (ctrl), 0xf, 0xf, false)))
__device__ __forceinline__ float wave_sum(float v) {
    v = DPP_ROR_ADD(v, 0x128); v = DPP_ROR_ADD(v, 0x124); v = DPP_ROR_ADD(v, 0x122); v = DPP_ROR_ADD(v, 0x121);
    v += __shfl_xor(v, 16);
    const unsigned u = __float_as_uint(v); auto rr = __builtin_amdgcn_permlane32_swap(u, u, false, false);
    return __uint_as_float(rr[0]) + __uint_as_float(rr[1]);
}
__device__ __forceinline__ float sigm(float x) { return 1.f / (1.f + __expf(-x)); }
__device__ __forceinline__ float softplusf(float x) { return x > 20.f ? x : log1pf(__expf(x)); }

struct Args { const float* in[40]; float* out; unsigned char* ws; int ph_lo, ph_hi; };
typedef const __attribute__((address_space(4))) Args* KArgs;

constexpr float ATT_C2 = 0.125f * 1.4426950408889634f;
struct EpiG1 {
    static constexpr bool PERM = true, AFTER_DRAIN = false;
    const float* rs; bfu *aqkvz, *qb, *kb, *vb, *craw; float* ab; const float* rope; float *okp, *ovp, *oks, *ovs;
    __device__ __forceinline__ void operator()(const pg8::f32x4 (&acc)[2][2][4][2], const pg8::Unit& u, int wr, int wc, int fr, int fq) const {
        const int pn = u.pn; const int rowb = u.pm * 256 + wr * 64 + fr; const int cl = wc * 32 + 8 * fq;
#pragma unroll
        for (int ai = 0; ai < 2; ++ai)
#pragma unroll
            for (int m = 0; m < 4; ++m) {
                const int row = rowb + ai * 128 + m * 16;
                const float s = rsqrtf(rs[row] * (1.f / 1024.f) + 1e-6f);
                if (pn < 4 || (pn >= 10 && pn < 14)) {
                    bfu* dst = (pn < 4 ? aqkvz + pn * 256 : craw + (pn - 10) * 256) + (size_t)row * 1024 + cl;
#pragma unroll
                    for (int bj = 0; bj < 2; ++bj) { const pg8::f32x4 v0 = acc[ai][bj][m][0] * s, v1 = acc[ai][bj][m][1] * s;
                        v4u w; w.x = pg8::cvt_pk_bf16(v0[0], v0[1]); w.y = pg8::cvt_pk_bf16(v0[2], v0[3]); w.z = pg8::cvt_pk_bf16(v1[0], v1[1]); w.w = pg8::cvt_pk_bf16(v1[2], v1[3]); *(v4u*)(dst + bj * 128) = w; }
                } else if (pn < 8) {
                    const bool isk = pn >= 6;
                    const int pos = row < MP ? (row & 8191) : 2048 + ((row - MP) & 15);
                    const int i0 = (wc & 1) * 16 + 4 * fq;
                    const pg8::f32x4 c4 = *(const pg8::f32x4*)(rope + pos * 64 + i0), s4 = *(const pg8::f32x4*)(rope + pos * 64 + 32 + i0);
#pragma unroll
                    for (int bj = 0; bj < 2; ++bj) {
                        const pg8::f32x4 x1 = acc[ai][bj][m][0] * s, x2 = acc[ai][bj][m][1] * s;
                        pg8::f32x4 o1 = x1 * c4 - x2 * s4, o2 = x2 * c4 + x1 * s4;
                        if (!isk) {
                            o1 = o1 * ATT_C2; o2 = o2 * ATT_C2;
                            v4u w; w.x = pg8::cvt_pk_bf16(o1[0], o1[1]); w.y = pg8::cvt_pk_bf16(o1[2], o1[3]); w.z = pg8::cvt_pk_bf16(o2[0], o2[1]); w.w = pg8::cvt_pk_bf16(o2[2], o2[3]);
                            *(v4u*)(qb + (size_t)row * 512 + (pn - 4) * 256 + bj * 128 + cl) = w;
                        } else {
                            v4u w; w.x = pg8::cvt_pk_bf16(o1[0], o1[1]); w.y = pg8::cvt_pk_bf16(o1[2], o1[3]); w.z = pg8::cvt_pk_bf16(o2[0], o2[1]); w.w = pg8::cvt_pk_bf16(o2[2], o2[3]);
                            *(v4u*)(kb + (size_t)row * 512 + (pn - 6) * 256 + bj * 128 + cl) = w;
                            if (row < MR) {
                                float* ob = (row < MP ? okp + (size_t)row * 512 : oks + (size_t)(row - MP) * 512) + (pn - 6) * 256 + bj * 128 + (wc >> 1) * 64 + (wc & 1) * 16 + 4 * fq;
                                __builtin_nontemporal_store(o1, (pg8::f32x4*)ob); __builtin_nontemporal_store(o2, (pg8::f32x4*)(ob + 32));
                            }
                        }
                    }
                } else if (pn < 10) {
#pragma unroll
                    for (int bj = 0; bj < 2; ++bj) {
                        const pg8::f32x4 v0 = acc[ai][bj][m][0] * s, v1 = acc[ai][bj][m][1] * s; const int col = (pn - 8) * 256 + bj * 128 + cl;
                        v4u w; w.x = pg8::cvt_pk_bf16(v0[0], v0[1]); w.y = pg8::cvt_pk_bf16(v0[2], v0[3]); w.z = pg8::cvt_pk_bf16(v1[0], v1[1]); w.w = pg8::cvt_pk_bf16(v1[2], v1[3]);
                        *(v4u*)(vb + (size_t)row * 512 + col) = w;
                        if (row < MR) { float* ob = (row < MP ? ovp + (size_t)row * 512 : ovs + (size_t)(row - MP) * 512) + col; __builtin_nontemporal_store(v0, (pg8::f32x4*)ob); __builtin_nontemporal_store(v1, (pg8::f32x4*)(ob + 4)); }
                    }
                } else {
                    if (wc == 0 && fq == 0) { const pg8::f32x4 v0 = acc[ai][0][m][0] * s, v1 = acc[ai][0][m][1] * s; *(pg8::f32x4*)(ab + (size_t)row * 8) = v0; *(pg8::f32x4*)(ab + (size_t)row * 8 + 4) = v1; }
                }
            }
    }
};
template <int MODE> struct EpiB {
    static constexpr bool PERM = true, AFTER_DRAIN = false;
    bfu* O; int ldc; const float* rs;
    __device__ __forceinline__ void operator()(const pg8::f32x4 (&acc)[2][2][4][2], const pg8::Unit& u, int wr, int wc, int fr, int fq) const {
        const int rowb = u.pm * 256 + wr * 64 + fr; const int cl = u.pn * 256 + wc * 32 + 8 * fq;
#pragma unroll
        for (int ai = 0; ai < 2; ++ai)
#pragma unroll
            for (int m = 0; m < 4; ++m) {
                const int row = rowb + ai * 128 + m * 16;
                float s = 1.f; if (MODE == 1) s = rsqrtf(rs[row] * (1.f / 1024.f) + 1e-6f);
                bfu* dst = O + (size_t)row * ldc + cl;
#pragma unroll
                for (int bj = 0; bj < 2; ++bj) {
                    pg8::f32x4 v0 = acc[ai][bj][m][0], v1 = acc[ai][bj][m][1];
                    if (MODE == 1) { v0 = v0 * s; v1 = v1 * s;
                        v0[0] = fmaxf(v0[0], 0.f); v0[1] = fmaxf(v0[1], 0.f); v0[2] = fmaxf(v0[2], 0.f); v0[3] = fmaxf(v0[3], 0.f); v1[0] = fmaxf(v1[0], 0.f); v1[1] = fmaxf(v1[1], 0.f); v1[2] = fmaxf(v1[2], 0.f); v1[3] = fmaxf(v1[3], 0.f);
                        v0 = v0 * v0; v1 = v1 * v1; }
                    v4u w; w.x = pg8::cvt_pk_bf16(v0[0], v0[1]); w.y = pg8::cvt_pk_bf16(v0[2], v0[3]); w.z = pg8::cvt_pk_bf16(v1[0], v1[1]); w.w = pg8::cvt_pk_bf16(v1[2], v1[3]);
                    *(v4u*)(dst + bj * 128) = w;
                }
            }
    }
};
template <int MODE> struct EpiH {
    static constexpr bool PERM = true, AFTER_DRAIN = false;
    float* H; bfu* xh; float* rsn; const float* rs; const bfu* pp;
    __device__ __forceinline__ void operator()(const pg8::f32x4 (&acc)[2][2][4][2], const pg8::Unit& u, int wr, int wc, int fr, int fq) const {
        const int rowb = u.pm * 256 + wr * 64 + fr; const int cl = u.pn * 256 + wc * 32 + 8 * fq;
#pragma unroll
        for (int ai = 0; ai < 2; ++ai)
#pragma unroll
            for (int m = 0; m < 4; ++m) {
                const int row = rowb + ai * 128 + m * 16; const bool valid = row < MR; float ss = 0.f;
                if (valid) {
                    float s = 1.f; if (MODE == 3) s = rsqrtf(rs[row] * (1.f / 1024.f) + 1e-6f);
#pragma unroll
                    for (int bj = 0; bj < 2; ++bj) {
                        const size_t off = (size_t)row * 1024 + cl + bj * 128;
                        pg8::f32x4 h0 = *(const pg8::f32x4*)(H + off), h1 = *(const pg8::f32x4*)(H + off + 4); const pg8::f32x4 a0 = acc[ai][bj][m][0], a1 = acc[ai][bj][m][1];
                        if (MODE == 3) { const v4u pw = *(const v4u*)(pp + off);
                            h0[0] += sigm(a0[0] * s) * __uint_as_float(pw.x << 16); h0[1] += sigm(a0[1] * s) * __uint_as_float(pw.x & 0xffff0000u);
                            h0[2] += sigm(a0[2] * s) * __uint_as_float(pw.y << 16); h0[3] += sigm(a0[3] * s) * __uint_as_float(pw.y & 0xffff0000u);
                            h1[0] += sigm(a1[0] * s) * __uint_as_float(pw.z << 16); h1[1] += sigm(a1[1] * s) * __uint_as_float(pw.z & 0xffff0000u);
                            h1[2] += sigm(a1[2] * s) * __uint_as_float(pw.w << 16); h1[3] += sigm(a1[3] * s) * __uint_as_float(pw.w & 0xffff0000u);
                        } else { h0 = h0 + a0; h1 = h1 + a1; }
                        *(pg8::f32x4*)(H + off) = h0; *(pg8::f32x4*)(H + off + 4) = h1;
                        v4u w; w.x = pg8::cvt_pk_bf16(h0[0], h0[1]); w.y = pg8::cvt_pk_bf16(h0[2], h0[3]); w.z = pg8::cvt_pk_bf16(h1[0], h1[1]); w.w = pg8::cvt_pk_bf16(h1[2], h1[3]); *(v4u*)(xh + off) = w;
                        ss += ((h0[0] * h0[0] + h0[1] * h0[1]) + (h0[2] * h0[2] + h0[3] * h0[3])) + ((h1[0] * h1[0] + h1[1] * h1[1]) + (h1[2] * h1[2] + h1[3] * h1[3]));
                    }
                }
                ss += __shfl_xor(ss, 16); ss += __shfl_xor(ss, 32);
                if (valid && fq == 0) unsafeAtomicAdd(rsn + row, ss);
            }
    }
};

__device__ __forceinline__ int win_src(int nd) {
    if (nd < 1024) return nd;
    if (nd < 2048) { const int c = nd - 1024, p = c & 63, grp = c >> 6; const int s = p >> 5, fq_ = (p >> 3) & 3, n_ = (p >> 2) & 1, j_ = p & 3; return 1032 + grp * 64 + n_ * 32 + s * 16 + 4 * fq_ + j_; }
    if (nd < 2560) return 2056 + (nd - 2048);
    if (nd < 3584) return 2568 + (nd - 2560);
    if (nd < 3592) return 1024 + (nd - 3584);
    return -1;
}
template <bool MAP> __device__ __forceinline__ void wt_item(const float* W, int K, int Nsrc, bfu* WT, const float* gain, LAS float* scr, int item, int nblk, int lane) {
    const int kb = item / nblk, nb = item % nblk, k0 = 64 * kb, n0 = 32 * nb;
    const int nd = n0 + (lane & 31); const int src = MAP ? win_src(nd) : nd;
#pragma unroll 8
    for (int i = 0; i < 32; ++i) { const int kk = 2 * i + (lane >> 5); float v = src >= 0 ? W[(size_t)(k0 + kk) * Nsrc + src] : 0.f; if (gain) v *= gain[k0 + kk]; scr[kk * 33 + (lane & 31)] = v; }
    LDS_WAIT(); asm volatile("" ::: "memory");
    const int c = lane & 7;
#pragma unroll
    for (int j = 0; j < 4; ++j) { const int n = (lane >> 3) + 8 * j; const LAS float* s = scr + (8 * c) * 33 + n;
        v4u o; o.x = pk2(s[0 * 33], s[1 * 33]); o.y = pk2(s[2 * 33], s[3 * 33]); o.z = pk2(s[4 * 33], s[5 * 33]); o.w = pk2(s[6 * 33], s[7 * 33]);
        *(v4u*)(WT + (size_t)(n0 + n) * K + k0 + 8 * c) = o; }
    LDS_WAIT(); asm volatile("" ::: "memory");
}
__device__ __forceinline__ void conv_weights(KArgs A, int l, int mask, LAS unsigned char* lds, int gw, int NGW, int lane, int wave) {
    LAS float* scr = (LAS float*)(lds + wave * 16384);
    unsigned char* wb = A->ws + WS_W;
    if (mask & 1) {
        const float* win = A->in[11] + (size_t)l * 1024 * 3592; const float* g = A->in[10] + l * 1024;
        for (int it = gw; it < 16 * 120; it += NGW) wt_item<true>(win, 1024, 3592, (bfu*)(wb + W_IN), g, scr, it, 120, lane);
        const float* wu = A->in[23] + (size_t)l * 64 * 256; const float* au = A->in[25] + (size_t)l * 64 * 256; const float* gu = A->in[26] + (size_t)l * 128 * 256;
        bfu* lr = (bfu*)(wb + W_LR);
        for (int i = gw * 64 + lane; i < 768 * 256; i += NGW * 64) { const int n = i >> 8, k = i & 255; float v = 0.f;
            if (n < 256) { if (k < 64) v = wu[k * 256 + n]; } else if (n < 512) { if (k >= 64 && k < 128) v = au[(k - 64) * 256 + (n - 256)]; } else { if (k >= 128) v = gu[(k - 128) * 256 + (n - 512)]; }
            lr[i] = (bfu)f2bf(v); }
    }
    if (mask & 2) {
        const float* wo = A->in[32] + (size_t)l * 1024 * 1024; const float* f1 = A->in[34] + (size_t)l * 1024 * 4096; const float* f2 = A->in[35] + (size_t)l * 4096 * 1024;
        const float* wg = A->in[37] + (size_t)l * 1024 * 1024; const float* wp = A->in[38] + (size_t)l * 256 * 1024;
        const float* gf = A->in[33] + l * 1024; const float* gp = A->in[36] + l * 1024;
        constexpr int I_O = 16 * 32, I_1 = 16 * 128, I_2 = 64 * 32, I_G = 16 * 32, I_P = 4 * 32;
        for (int it = gw; it < I_O + I_1 + I_2 + I_G + I_P; it += NGW) {
            int r = it;
            if (r < I_O) { wt_item<false>(wo, 1024, 1024, (bfu*)(wb + W_OUT), nullptr, scr, r, 32, lane); continue; } r -= I_O;
            if (r < I_1) { wt_item<false>(f1, 1024, 4096, (bfu*)(wb + W_FF1), gf, scr, r, 128, lane); continue; } r -= I_1;
            if (r < I_2) { wt_item<false>(f2, 4096, 1024, (bfu*)(wb + W_FF2), nullptr, scr, r, 32, lane); continue; } r -= I_2;
            if (r < I_G) { wt_item<false>(wg, 1024, 1024, (bfu*)(wb + W_GATE), gp, scr, r, 32, lane); continue; } r -= I_G;
            wt_item<false>(wp, 256, 1024, (bfu*)(wb + W_PP), nullptr, scr, r, 32, lane);
        }
    }
}
__device__ __forceinline__ void conv_p(KArgs A, int l, bfu* pb, int gtid, int NT) {
    const float* pp = A->in[8] + (size_t)l * MP * 256; const float* ps = A->in[9] + (size_t)l * MS * 256;
    for (int i = gtid; i < MR * 64; i += NT) { const int m = i >> 6, c = (i & 63) * 4;
        const f32x4 v = *(const f32x4*)(m < MP ? pp + (size_t)m * 256 + c : ps + (size_t)(m - MP) * 256 + c);
        v2u w; w.x = pk2(v[0], v[1]); w.y = pk2(v[2], v[3]); *(v2u*)(pb + (size_t)m * 256 + c) = w; }
}
__device__ __forceinline__ void prologue(KArgs A, LAS unsigned char* lds, int gw, int NGW, int lane, int wave, int gtid, int NT) {
    conv_weights(A, 0, 3, lds, gw, NGW, lane, wave);
    unsigned char* ws = A->ws;
    float* rs = (float*)(ws + WS_RS); bfu* xh = (bfu*)slotp(ws, 0, 0); float* H = A->out;
    for (int i = gtid; i < 6 * MPAD; i += NT) rs[MPAD + i] = 0.f;
    for (int g = gw; g < MPAD / 4; g += NGW) {
        const int m0 = 4 * g;
        if (m0 < MR) {
            f32x4 v[4][4];
#pragma unroll
            for (int i = 0; i < 4; ++i) { const int m = m0 + i; const float* xr = m < MP ? A->in[0] + (size_t)m * 1024 : A->in[1] + (size_t)(m - MP) * 1024;
#pragma unroll
                for (int j = 0; j < 4; ++j) v[i][j] = *(const f32x4*)(xr + j * 256 + lane * 4); }
#pragma unroll
            for (int i = 0; i < 4; ++i) { const int m = m0 + i; float ss = 0.f;
#pragma unroll
                for (int j = 0; j < 4; ++j) { const f32x4 w4 = v[i][j]; *(f32x4*)(H + (size_t)m * 1024 + j * 256 + lane * 4) = w4;
                    v2u w; w.x = pk2(w4[0], w4[1]); w.y = pk2(w4[2], w4[3]); *(v2u*)(xh + (size_t)m * 1024 + j * 256 + lane * 4) = w; ss += (w4[0] * w4[0] + w4[1] * w4[1]) + (w4[2] * w4[2] + w4[3] * w4[3]); }
                ss = wave_sum(ss); if (lane == 0) rs[m] = ss; }
        } else {
#pragma unroll
            for (int i = 0; i < 4; ++i) { const int m = m0 + i;
#pragma unroll
                for (int j = 0; j < 4; ++j) *(v2u*)(xh + (size_t)m * 1024 + j * 256 + lane * 4) = (v2u){0u, 0u};
                if (lane == 0) rs[m] = 1024.f; }
        }
    }
    float* rope = (float*)(ws + WS_ROPE);
    for (int i = gtid; i < 8192 * 32; i += NT) { const int pos = i >> 5, k = i & 31;
        const float inv = exp2f(-(float)k * (13.287712379549449f / 32.0f)); const float ang = (float)pos * inv;
        const float nn = rintf(ang * 0.15915494309189535f); const float fr = fmaf(-nn, 1.9353071795864769e-3f, fmaf(-nn, 6.28125f, ang));
        rope[pos * 64 + k] = __cosf(fr); rope[pos * 64 + 32 + k] = __sinf(fr); }
    if (gw == 0) {
        for (int l = 0; l < 2; ++l) {
            const float a = wave_sum(A->in[16][l * 64 + lane] * A->in[17][l * 64 + lane]), b = wave_sum(A->in[18][l * 64 + lane] * A->in[19][l * 64 + lane]);
            const float li = 0.8f - 0.6f * expf(-0.3f * (float)l);
            if (lane == 0) { float* lf = (float*)(ws + WS_CTL + 1024); lf[2 * l] = expf(a) - expf(b) + li; lf[2 * l + 1] = li; }
        }
    }
}

__device__ __forceinline__ void prep_a(KArgs A, int l, int gw, int NGW, int lane) {
    unsigned char* ws = A->ws;
    const bfu* aq = (const bfu*)slotp(ws, l, 2); const float* ab = (const float*)(ws + WS_AB);
    float* sia = (float*)slotp(ws, l, 9); bfu* va = (bfu*)slotp(ws, l, 11); bfu* zs = (bfu*)slotph(ws, l, 11); float* gab = (float*)(ws + WS_GAB);
    const float* cw = A->in[12] + l * 4 * 768; const float* stc = A->in[4] + (size_t)l * 8 * 3 * 768;
    const float* anorm = A->in[15] + l * 64;
    for (int g = gw; g < MR / 4; g += NGW) {
        const int m0 = 4 * g; int t0, L, sb = 0; const bool smp = m0 >= MP; float* aco;
        if (!smp) { t0 = m0 & 8191; L = 8192; aco = A->out + O_ACP + ((size_t)(l * 8 + (m0 >> 13)) * 3) * 768; }
        else { sb = (m0 - MP) >> 4; t0 = (m0 - MP) & 15; L = 16; aco = A->out + O_ACS + ((size_t)(l * 8 + sb) * 3) * 768; }
#pragma unroll 1
        for (int h = 0; h < 4; ++h) {
            float rows[3][7];
#pragma unroll
            for (int gi = 0; gi < 3; ++gi) { const int c = gi * 256 + h * 64 + lane;
#pragma unroll
                for (int r = 0; r < 7; ++r) { const int tt = t0 - 3 + r;
                    rows[gi][r] = tt >= 0 ? bf2f(aq[(size_t)(m0 - 3 + r) * 1024 + c]) : (smp ? stc[((size_t)sb * 3 + (3 + tt)) * 768 + c] : 0.f); } }
            float zv[4];
#pragma unroll
            for (int i = 0; i < 4; ++i) zv[i] = bf2f(aq[(size_t)(m0 + i) * 1024 + 768 + h * 64 + lane]);
            float val[4][3];
#pragma unroll
            for (int gi = 0; gi < 3; ++gi) { const int c = gi * 256 + h * 64 + lane; const float w0 = cw[c], w1 = cw[768 + c], w2 = cw[1536 + c], w3 = cw[2304 + c];
#pragma unroll
                for (int i = 0; i < 4; ++i) { const float y = rows[gi][i] * w0 + rows[gi][i + 1] * w1 + rows[gi][i + 2] * w2 + rows[gi][i + 3] * w3; val[i][gi] = y * sigm(y);
                    if (t0 + i >= L - 3) aco[(size_t)(t0 + i - (L - 3)) * 768 + c] = rows[gi][i + 3]; } }
#pragma unroll
            for (int i = 0; i < 4; ++i) { const int m = m0 + i;
                const float sq = wave_sum(val[i][0] * val[i][0]), sk = wave_sum(val[i][1] * val[i][1]);
                const float qn = val[i][0] * rsqrtf(sq + 1e-6f) * 0.125f, kn = val[i][1] * rsqrtf(sk + 1e-6f);
                float* rec = sia + ((size_t)(h * 8 + (lane >> 3)) * MPAD + m) * 16 + (lane & 7);
                rec[0] = kn; rec[8] = qn;
                va[(size_t)m * 256 + h * 64 + lane] = (bfu)f2bf(val[i][2]);
                zs[(size_t)m * 256 + h * 64 + lane] = (bfu)f2bf(zv[i] * sigm(zv[i]) * anorm[lane]); }
        }
        if (lane < 16) { const int m = m0 + (lane >> 2), hh = lane & 3;
            const float gl = -__expf(A->in[13][l * 4 + hh]) * softplusf(ab[(size_t)m * 8 + hh] + A->in[14][l * 4 + hh]);
            gab[((size_t)hh * MPAD + m) * 2] = __expf(gl); gab[((size_t)hh * MPAD + m) * 2 + 1] = sigm(ab[(size_t)m * 8 + 4 + hh]); }
    }
}
__device__ __forceinline__ void prep_c1(KArgs A, int l, int gw, int NGW, int lane) {
    unsigned char* ws = A->ws;
    const bfu* cr = (const bfu*)slotp(ws, l, 7); bfu* lra = (bfu*)slotp(ws, l, 12);
    const float* mu = A->in[21] + l * 1024; const float* sts = A->in[6] + (size_t)l * 8 * 1024;
    for (int g = gw; g < MR / 4; g += NGW) {
        const int m0 = 4 * g; int t0, L, sb = 0; const bool smp = m0 >= MP; float* cso;
        if (!smp) { t0 = m0 & 8191; L = 8192; cso = A->out + O_CSP + (size_t)(l * 8 + (m0 >> 13)) * 1024; }
        else { sb = (m0 - MP) >> 4; t0 = (m0 - MP) & 15; L = 16; cso = A->out + O_CSS + (size_t)(l * 8 + sb) * 1024; }
        float rows[4][5];
#pragma unroll
        for (int i = 0; i < 4; ++i) { const int j = 768 + lane + 64 * i;
            rows[i][0] = t0 > 0 ? bf2f(cr[(size_t)(m0 - 1) * 1024 + j]) : (smp ? sts[(size_t)sb * 1024 + j] : 0.f);
#pragma unroll
            for (int r = 0; r < 4; ++r) rows[i][r + 1] = bf2f(cr[(size_t)(m0 + r) * 1024 + j]); }
#pragma unroll
        for (int i = 0; i < 4; ++i) { const float muj = mu[768 + lane + 64 * i];
#pragma unroll
            for (int r = 0; r < 4; ++r) { const float cur = rows[i][r + 1], prev = rows[i][r]; const float c = cur + (prev - cur) * muj;
                const float o = i == 0 ? tanhf(c) : (i == 1 ? c : sigm(c));
                lra[(size_t)(m0 + r) * 256 + lane + 64 * i] = (bfu)f2bf(o); } }
        if (t0 + 3 == L - 1) {
#pragma unroll
            for (int i = 0; i < 16; ++i) cso[lane + 64 * i] = bf2f(cr[(size_t)(m0 + 3) * 1024 + lane + 64 * i]);
        }
    }
}
__device__ __forceinline__ void prep_c2(KArgs A, int l, int bid, int G, int tid) {
    unsigned char* ws = A->ws;
    const bfu* cr = (const bfu*)slotp(ws, l, 7); const bfu* lro = (const bfu*)slotp(ws, l, 13);
    bfu* v2 = (bfu*)slotp(ws, l, 12); bfu* gg = (bfu*)slotph(ws, l, 12);
    float* bonus = (float*)(ws + WS_BONUS); float* gch = (float*)(ws + WS_GCH); float* pairc = (float*)(ws + WS_PAIRC);
    const float* mu = A->in[21] + l * 1024; const float* sts = A->in[6] + (size_t)l * 8 * 1024;
    const int ch = tid & 255, h = ch >> 6, lane = ch & 63, half = tid >> 8;
    float* sic = (float*)slotp(ws, l, h) + ((size_t)(lane >> 3) * MPAD) * 32 + (lane & 7);
    const float mur = mu[ch], muk = mu[256 + ch], muv = mu[512 + ch];
    const float w0 = A->in[22][l * 256 + ch], a0 = A->in[24][l * 256 + ch], kk_ = A->in[27][l * 256 + ch], ka = A->in[28][l * 256 + ch], rk = A->in[29][l * 256 + ch];
    for (int u = bid * 2 + half; u < 1032; u += G * 2) {
        int m0, n; float pr, pk, pv;
        if (u < 1024) { m0 = u * 64; n = 64;
            if ((u & 127) == 0) { pr = pk = pv = 0.f; } else { pr = bf2f(cr[(size_t)(m0 - 1) * 1024 + ch]); pk = bf2f(cr[(size_t)(m0 - 1) * 1024 + 256 + ch]); pv = bf2f(cr[(size_t)(m0 - 1) * 1024 + 512 + ch]); } }
        else { const int sb = u - 1024; m0 = MP + sb * 16; n = 16; pr = sts[(size_t)sb * 1024 + ch]; pk = sts[(size_t)sb * 1024 + 256 + ch]; pv = sts[(size_t)sb * 1024 + 512 + ch]; }
        float cum = 0.f, pkka = 0.f, pkp = 0.f;
        for (int t4 = 0; t4 < n; t4 += 4) {
            float lr_[4], lk_[4], lv_[4], lw_[4], la_[4]; bfu lg_[4];
#pragma unroll
            for (int i = 0; i < 4; ++i) { const size_t mm = (size_t)(m0 + t4 + i);
                lr_[i] = bf2f(cr[mm * 1024 + ch]); lk_[i] = bf2f(cr[mm * 1024 + 256 + ch]); lv_[i] = bf2f(cr[mm * 1024 + 512 + ch]);
                lw_[i] = bf2f(lro[mm * 768 + ch]); la_[i] = bf2f(lro[mm * 768 + 256 + ch]); lg_[i] = lro[mm * 768 + 512 + ch]; }
#pragma unroll
        for (int i4 = 0; i4 < 4; ++i4) { const int tt = t4 + i4; const int m = m0 + tt;
            const float c_r = lr_[i4], c_k = lk_[i4], c_v = lv_[i4]; const float lw = lw_[i4], la = la_[i4]; const bfu gb = lg_[i4];
            const float r = c_r + (pr - c_r) * mur, k = c_k + (pk - c_k) * muk, v = c_v + (pv - c_v) * muv; pr = c_r; pk = c_k; pv = c_v;
            const float wl = -0.6065306597126334f * sigm(w0 + lw); const float a = sigm(a0 + la);
            const float kkr = k * kk_; const float kk = kkr * rsqrtf(wave_sum(kkr * kkr) + 1e-6f);
            const float kp = k * (1.f + (a - 1.f) * ka);
            const float Gp = __expf(cum); cum += wl; const float Gc = __expf(cum), iG = __expf(-cum);
            float* rec = sic + (size_t)m * 32;
            rec[0] = kk * Gp; rec[8] = kk * a * iG; rec[16] = kp * iG; rec[24] = r * Gc;
            { const float kka = kk * a; float* pc = pairc + ((size_t)h * (MPAD / 2) + (m >> 1)) * 4;
              if (tt & 1) { const float c22 = wave_sum(pkka * kk), c32 = wave_sum(pkp * kk); if (lane == 0) { pc[0] = c22; pc[1] = c32; } }
              else { const float c24 = wave_sum(kka * r), c34 = wave_sum(kp * r); if (lane == 0) { pc[2] = c24; pc[3] = c34; } }
              pkka = kka; pkp = kp; }
            const float bo = wave_sum(r * kp * rk); if (lane == 0) bonus[(size_t)h * MPAD + m] = bo;
            v2[(size_t)m * 256 + ch] = (bfu)f2bf(v); gg[(size_t)m * 256 + ch] = gb;
        }
        }
        gch[((size_t)h * 1032 + u) * 64 + lane] = __expf(cum);
    }
}
__device__ __forceinline__ void prep_a2(KArgs A, int l, int gw, int NGW, int lane) {
    unsigned char* ws = A->ws; const float* sia = (const float*)slotp(ws, l, 9); float* paird = (float*)(ws + WS_PAIRD);
    for (int pr = gw; pr < MR / 2; pr += NGW) { const int m = 2 * pr;
        float k1[4], q1[4], k2[4];
#pragma unroll
        for (int h = 0; h < 4; ++h) { const float* rec = sia + ((size_t)(h * 8 + (lane >> 3)) * MPAD + m) * 16 + (lane & 7); k1[h] = rec[0]; q1[h] = rec[8]; k2[h] = rec[16]; }
#pragma unroll
        for (int h = 0; h < 4; ++h) { const float g12 = wave_sum(k1[h] * k2[h]), h11 = wave_sum(q1[h] * k1[h]);
            if (lane == 0) { paird[((size_t)h * (MPAD / 2) + pr) * 2] = g12; paird[((size_t)h * (MPAD / 2) + pr) * 2 + 1] = h11; } } }
}
__device__ __forceinline__ void post_attn(KArgs A, int l, int gw, int NGW, int lane) {
    unsigned char* ws = A->ws;
    const bfu* O = (const bfu*)slotp(ws, l, 13); bfu* mix = (bfu*)slotp(ws, l, 7);
    const float* lf = (const float*)(ws + WS_CTL + 1024); const float lam = lf[2 * l], omli = 1.f - lf[2 * l + 1];
    const int h = lane >> 4, e0 = (lane & 15) * 8; const float* bn = A->in[20] + l * 128 + e0;
    float bnv[8];
#pragma unroll
    for (int i = 0; i < 8; ++i) bnv[i] = bn[i] * omli;
    for (int g = gw; g < MP / 4; g += NGW) {
        v4u av[4], bv[4];
#pragma unroll
        for (int i = 0; i < 4; ++i) { const size_t m = (size_t)(4 * g + i);
            av[i] = *(const v4u*)(O + m * 1024 + (4 * h + (e0 >> 6)) * 64 + (e0 & 63)); bv[i] = *(const v4u*)(O + m * 1024 + (4 * h + 2 + (e0 >> 6)) * 64 + (e0 & 63)); }
#pragma unroll
        for (int i = 0; i < 4; ++i) { const size_t m = (size_t)(4 * g + i);
            float o[8]; float ss = 0.f;
#pragma unroll
            for (int q = 0; q < 4; ++q) { const unsigned aw = av[i][q], bw = bv[i][q];
                o[2 * q] = __uint_as_float(aw << 16) - lam * __uint_as_float(bw << 16); o[2 * q + 1] = __uint_as_float(aw & 0xffff0000u) - lam * __uint_as_float(bw & 0xffff0000u);
                ss += o[2 * q] * o[2 * q] + o[2 * q + 1] * o[2 * q + 1]; }
            ss += __shfl_xor(ss, 1); ss += __shfl_xor(ss, 2); ss += __shfl_xor(ss, 4); ss += __shfl_xor(ss, 8);
            const float rn = rsqrtf(ss * (1.f / 128.f) + 1e-6f);
            v4u w; w.x = pk2(o[0] * rn * bnv[0], o[1] * rn * bnv[1]); w.y = pk2(o[2] * rn * bnv[2], o[3] * rn * bnv[3]); w.z = pk2(o[4] * rn * bnv[4], o[5] * rn * bnv[5]); w.w = pk2(o[6] * rn * bnv[6], o[7] * rn * bnv[7]);
            *(v4u*)(mix + m * 1024 + 256 + h * 128 + e0) = w; }
    }
}
__device__ __forceinline__ void post_scan(KArgs A, int l, int gw, int NGW, int lane) {
    unsigned char* ws = A->ws; bfu* mix = (bfu*)slotp(ws, l, 7);
    const bfu* zs = (const bfu*)slotph(ws, l, 11); const bfu* v2 = (const bfu*)slotp(ws, l, 12); const bfu* gg = (const bfu*)slotph(ws, l, 12);
    const float* bonus = (const float*)(ws + WS_BONUS);
    float lw[4], lb[4];
#pragma unroll
    for (int h = 0; h < 4; ++h) { lw[h] = A->in[30][l * 256 + h * 64 + lane]; lb[h] = A->in[31][l * 256 + h * 64 + lane]; }
    for (int g = gw; g < MR / 2; g += NGW) {
        float o[2][4], y[2][4], z[2][4], vv[2][4], gv[2][4], bo[2][4];
#pragma unroll
        for (int i = 0; i < 2; ++i)
#pragma unroll
            for (int h = 0; h < 4; ++h) { const size_t m = (size_t)(2 * g + i);
                o[i][h] = bf2f(mix[m * 1024 + h * 64 + lane]); y[i][h] = bf2f(mix[m * 1024 + 768 + h * 64 + lane]);
                z[i][h] = bf2f(zs[m * 256 + h * 64 + lane]); vv[i][h] = bf2f(v2[m * 256 + h * 64 + lane]); gv[i][h] = bf2f(gg[m * 256 + h * 64 + lane]); bo[i][h] = bonus[(size_t)h * MPAD + m]; }
#pragma unroll
        for (int i = 0; i < 2; ++i)
#pragma unroll
            for (int h = 0; h < 4; ++h) { const size_t m = (size_t)(2 * g + i);
                const float ss = wave_sum(o[i][h] * o[i][h]) * (1.f / 64.f);
                mix[m * 1024 + h * 64 + lane] = (bfu)f2bf(o[i][h] * rsqrtf(ss + 1e-6f) * z[i][h]);
                const float mu = wave_sum(y[i][h]) * (1.f / 64.f); const float d = y[i][h] - mu; const float var = wave_sum(d * d) * (1.f / 64.f);
                const float cy = d * rsqrtf(var + 64e-5f) * lw[h] + lb[h];
                mix[m * 1024 + 768 + h * 64 + lane] = (bfu)f2bf((cy + bo[i][h] * vv[i][h]) * gv[i][h]); }
    }
}
__device__ __forceinline__ void final_norm(KArgs A, int gw, int NGW, int lane) {
    const float* rs = (const float*)(A->ws + WS_RS) + 6 * (size_t)MPAD; const float* g = A->in[39];
    f32x4 gv[4];
#pragma unroll
    for (int j = 0; j < 4; ++j) gv[j] = *(const f32x4*)(g + j * 256 + lane * 4);
    for (int q = gw; q < MR / 4; q += NGW) {
        f32x4 v[4][4]; float s[4];
#pragma unroll
        for (int i = 0; i < 4; ++i) { const size_t mm = (size_t)(4 * q + i); s[i] = rsqrtf(rs[mm] * (1.f / 1024.f) + 1e-6f);
#pragma unroll
            for (int j = 0; j < 4; ++j) v[i][j] = *(const f32x4*)(A->out + mm * 1024 + j * 256 + lane * 4); }
#pragma unroll
        for (int i = 0; i < 4; ++i) { const size_t mm = (size_t)(4 * q + i);
#pragma unroll
            for (int j = 0; j < 4; ++j) __builtin_nontemporal_store(v[i][j] * s[i] * gv[j], (f32x4*)(A->out + mm * 1024 + j * 256 + lane * 4)); }
    }
}

#define SC_BAR() asm volatile("s_waitcnt lgkmcnt(0)\n\ts_barrier" ::: "memory")
constexpr int SC_RED = 0, SC_SI = 16384, SC_VBUF = 81920, SC_GBUF = 90112, SC_BON = 98304, SC_PC = 98816, SC_YP = 99328;
#define FMAC_DPP(acc, op, s1, J) asm("v_fmac_f32_dpp %0, %1, %2 row_newbcast:" #J " row_mask:0xf bank_mask:0xf" : "+v"(acc) : "v"(op), "v"(s1))
#define DOT8(a0, a1, op, JB0, JB1, JB2, JB3, JB4, JB5, JB6, JB7) do { FMAC_DPP(a0, op, S[0], JB0); FMAC_DPP(a1, op, S[1], JB1); FMAC_DPP(a0, op, S[2], JB2); FMAC_DPP(a1, op, S[3], JB3); \
        FMAC_DPP(a0, op, S[4], JB4); FMAC_DPP(a1, op, S[5], JB5); FMAC_DPP(a0, op, S[6], JB6); FMAC_DPP(a1, op, S[7], JB7); } while (0)
#define DOT8_LO(a0, a1, op) DOT8(a0, a1, op, 0, 1, 2, 3, 4, 5, 6, 7)
#define DOT8_HI(a0, a1, op) DOT8(a0, a1, op, 8, 9, 10, 11, 12, 13, 14, 15)
#define AXPY8_LO(op, s) do { FMAC_DPP(S[0], op, s, 0); FMAC_DPP(S[1], op, s, 1); FMAC_DPP(S[2], op, s, 2); FMAC_DPP(S[3], op, s, 3); FMAC_DPP(S[4], op, s, 4); FMAC_DPP(S[5], op, s, 5); FMAC_DPP(S[6], op, s, 6); FMAC_DPP(S[7], op, s, 7); } while (0)
#define AXPY8_HI(op, s) do { FMAC_DPP(S[0], op, s, 8); FMAC_DPP(S[1], op, s, 9); FMAC_DPP(S[2], op, s, 10); FMAC_DPP(S[3], op, s, 11); FMAC_DPP(S[4], op, s, 12); FMAC_DPP(S[5], op, s, 13); FMAC_DPP(S[6], op, s, 14); FMAC_DPP(S[7], op, s, 15); } while (0)
#define PKF(a, b, c) __builtin_elementwise_fma((a), (b), (c))
#define AXPYV(X0, X1, s) do { const f32x2 s_ = (f32x2){(s), (s)}; f32x2 p0_ = (f32x2){S[0], S[1]}, p1_ = (f32x2){S[2], S[3]}, p2_ = (f32x2){S[4], S[5]}, p3_ = (f32x2){S[6], S[7]}; \
        p0_ = PKF(((f32x2){X0[0], X0[1]}), s_, p0_); p1_ = PKF(((f32x2){X0[2], X0[3]}), s_, p1_); p2_ = PKF(((f32x2){X1[0], X1[1]}), s_, p2_); p3_ = PKF(((f32x2){X1[2], X1[3]}), s_, p3_); \
        S[0] = p0_[0]; S[1] = p0_[1]; S[2] = p1_[0]; S[3] = p1_[1]; S[4] = p2_[0]; S[5] = p2_[1]; S[6] = p3_[0]; S[7] = p3_[1]; } while (0)
#define RED8(V) do { const LAS f32x4* rr_ = (const LAS f32x4*)red + par_ * 512 + lane; const f32x4 q0_ = rr_[0], q1_ = rr_[64], q2_ = rr_[128], q3_ = rr_[192], q4_ = rr_[256], q5_ = rr_[320], q6_ = rr_[384], q7_ = rr_[448]; \
        V = ((q0_ + q1_) + (q2_ + q3_)) + ((q4_ + q5_) + (q6_ + q7_)); } while (0)

#define SWAPSUM(v) do { const unsigned u_ = __float_as_uint(v); auto rr_ = __builtin_amdgcn_permlane32_swap(u_, u_, false, false); v = __uint_as_float(rr_[0]) + __uint_as_float(rr_[1]); } while (0)
#define DOT4_LO(a0, a1, op) do { FMAC_DPP(a0, op, S[0], 0); FMAC_DPP(a1, op, S[1], 1); FMAC_DPP(a0, op, S[2], 2); FMAC_DPP(a1, op, S[3], 3); } while (0)
#define DOT4_HI(a0, a1, op) do { FMAC_DPP(a0, op, S[0], 4); FMAC_DPP(a1, op, S[1], 5); FMAC_DPP(a0, op, S[2], 6); FMAC_DPP(a1, op, S[3], 7); } while (0)
#define AXPY4(X, s) do { const f32x2 s_ = (f32x2){(s), (s)}; f32x2 p0_ = (f32x2){S[0], S[1]}, p1_ = (f32x2){S[2], S[3]}; p0_ = PKF(((f32x2){X[0], X[1]}), s_, p0_); p1_ = PKF(((f32x2){X[2], X[3]}), s_, p1_); S[0] = p0_[0]; S[1] = p0_[1]; S[2] = p1_[0]; S[3] = p1_[1]; } while (0)
__device__ __forceinline__ void scan_rwkv(KArgs A, int l, LAS unsigned char* lds, int h, int half, int m0, int L, int BL, int BLS, int chunk0, const float* st_in, float* st_out, int tid) {
    unsigned char* ws = A->ws;
    const int lane = tid & 63, wid = __builtin_amdgcn_readfirstlane(tid >> 6); const int kh = lane >> 5, r = lane & 31, row = 32 * half + r;
    LAS float* red = (LAS float*)(lds + SC_RED); LAS float* yred = (LAS float*)(lds + SC_YP);
    LAS float* sib = (LAS float*)(lds + SC_SI) + wid * 1024;
    LAS bfu* vbuf = (LAS bfu*)(lds + SC_VBUF); LAS float* pcs = (LAS float*)(lds + SC_PC);
    const bfu* v2 = (const bfu*)slotp(ws, l, 12);
    const float* pairc = (const float*)(ws + WS_PAIRC) + ((size_t)h * (MPAD / 2) + (m0 >> 1)) * 4;
    const float* gch = (const float*)(ws + WS_GCH) + ((size_t)h * 1032 + chunk0) * 64 + 8 * wid + 4 * kh;
    bfu* mix = (bfu*)slotp(ws, l, 7);
    const float* P = (const float*)slotp(ws, l, h) + ((size_t)wid * MPAD + m0) * 32;
    float S[4];
#pragma unroll
    for (int j = 0; j < 4; ++j) S[j] = st_in ? st_in[row * 64 + 8 * wid + 4 * kh + j] : 0.f;
    const int nblk = L >> BLS; const int srow = tid >> 4, sc4 = tid & 15; const bool sval = srow < BL;
    const int nsi = BL >> 3;
    f32x4 ssi[4]; v2u sv = {0, 0}; float sp_ = 0.f;
#define RW_STAGE(c) do { const float* ps_ = P + (size_t)(c) * BL * 32 + lane * 4; \
        _Pragma("unroll") for (int i_ = 0; i_ < 4; ++i_) if (i_ < nsi) ssi[i_] = *(const f32x4*)(ps_ + i_ * 256); \
        if (sval) { const size_t mm = (size_t)(m0 + (c) * BL + srow) * 256 + h * 64 + sc4 * 4; sv = *(const v2u*)(v2 + mm); } \
        if (tid < 2 * BL) sp_ = pairc[(size_t)(c) * BL * 2 + tid]; } while (0)
#define RW_COMMIT(c) do { LAS float* pd_ = sib + ((c) & 1) * 8192 + lane * 4; \
        _Pragma("unroll") for (int i_ = 0; i_ < 4; ++i_) if (i_ < nsi) *(LAS f32x4*)(pd_ + i_ * 256) = ssi[i_]; \
        if (sval) { *(LAS v2u*)(vbuf + ((c) & 1) * 2048 + srow * 64 + sc4 * 4) = sv; } \
        if (tid < 2 * BL) pcs[((c) & 1) * 64 + tid] = sp_; } while (0)
    __syncthreads();
    RW_STAGE(0); RW_COMMIT(0); if (nblk > 1) RW_STAGE(1);
    const int dsel = ((lane & 4) ? 24 : 0) + 4 * kh + (lane & 3);
    float ca0, ca1, cb0 = 0.f, cb1 = 0.f; f32x4 cau[4], cbu[4];
#define RW_LOADOPS(D, T) do { const LAS float* pb_ = sib + ((((T) >> BLS) & 1) * 8192) + ((T) & (BL - 1)) * 32; \
        D##0 = pb_[dsel]; D##1 = pb_[32 + dsel]; const LAS f32x4* pu_ = (const LAS f32x4*)(pb_ + 4 * kh); \
        D##u[0] = pu_[2]; D##u[1] = pu_[4]; D##u[2] = pu_[10]; D##u[3] = pu_[12]; } while (0)
    RW_LOADOPS(ca, 0);
#define RW_FINAL(T) do { const int tf_ = (T); \
        const LAS float* yr_ = yred + (tf_ & 15) * 512 + lane; const float y_ = ((yr_[0] + yr_[64]) + (yr_[128] + yr_[192])) + ((yr_[256] + yr_[320]) + (yr_[384] + yr_[448])); \
        if (lane < 32) mix[(size_t)(m0 + tf_) * 1024 + 768 + h * 64 + row] = (bfu)f2bf(y_); } while (0)
#define RW_ROUND(C, N, T) do { const int par_ = ((T) >> 1) & 1; \
        float d1a = 0.f, d1b = 0.f, d2a = 0.f, d2b = 0.f, f1a = 0.f, f1b = 0.f; \
        DOT4_LO(d1a, d1b, C##0); DOT4_LO(d2a, d2b, C##1); DOT4_HI(f1a, f1b, C##0); \
        float d1 = d1a + d1b, d2 = d2a + d2b, f1 = f1a + f1b; SWAPSUM(d1); SWAPSUM(d2); SWAPSUM(f1); \
        ((LAS f32x4*)red)[(par_ * 8 + wid) * 64 + lane] = (f32x4){d1, d2, f1, 0.f}; \
        SC_BAR(); \
        f32x4 tot_; RED8(tot_); \
        const int bo_ = (((T) >> BLS) & 1), to_ = (T) & (BL - 1); \
        const float v1 = bf2f(vbuf[bo_ * 2048 + to_ * 64 + row]), v2_ = bf2f(vbuf[bo_ * 2048 + to_ * 64 + 64 + row]); const f32x4 pc_ = *(const LAS f32x4*)(pcs + bo_ * 64 + to_ * 2); \
        asm volatile("" ::: "memory"); \
        if ((T) + 2 < L) RW_LOADOPS(N, (T) + 2); \
        __builtin_amdgcn_sched_barrier(0); \
        const float sa1 = -tot_[0]; const float sa2 = -(tot_[1] + sa1 * pc_[0] + v1 * pc_[1]); const float y1 = tot_[2] + sa1 * pc_[2] + v1 * pc_[3]; \
        AXPY4(C##u[1], v1); AXPY4(C##u[0], sa1); AXPY4(C##u[3], v2_); AXPY4(C##u[2], sa2); \
        float y2a = 0.f, y2b = 0.f; DOT4_HI(y2a, y2b, C##1); float y2 = y2a + y2b; SWAPSUM(y2); \
        yred[((T) & 15) * 512 + wid * 64 + lane] = y1 * 0.125f; yred[(((T) + 1) & 15) * 512 + wid * 64 + lane] = y2; } while (0)
    for (int c = 0; c < nblk; ++c) {
        for (int tt = 0; tt < BL; tt += 4) {
            const int t = c * BL + tt;
            if (tt == (BL >> 1) && c + 1 < nblk) { RW_COMMIT(c + 1); if (c + 2 < nblk) RW_STAGE(c + 2); }
            RW_ROUND(ca, cb, t);
            RW_ROUND(cb, ca, t + 2);
            if (((t + 3) & 15) == 15) { SC_BAR(); RW_FINAL(t - 12 + 2 * wid); RW_FINAL(t - 11 + 2 * wid); }
        }
        if ((((c + 1) << BLS) & 63) == 0 || c + 1 == nblk) {
            const float* ge = gch + (size_t)((c << BLS) >> 6) * 64;
#pragma unroll
            for (int j = 0; j < 4; ++j) S[j] *= ge[j];
        }
    }
#pragma unroll
    for (int j = 0; j < 4; ++j) st_out[row * 64 + 8 * wid + 4 * kh + j] = S[j];
    __syncthreads();
#undef RW_STAGE
#undef RW_COMMIT
#undef RW_LOADOPS
#undef RW_FINAL
#undef RW_ROUND
}

__device__ __forceinline__ void scan_delta(KArgs A, int l, LAS unsigned char* lds, int h, int half, int m0, int L, int BL, int BLS, const float* st_in, float* st_out, int tid) {
    unsigned char* ws = A->ws;
    const int lane = tid & 63, wid = __builtin_amdgcn_readfirstlane(tid >> 6); const int kh = lane >> 5, r = lane & 31, row = 32 * half + r;
    LAS float* red = (LAS float*)(lds + SC_RED); LAS float* yred = (LAS float*)(lds + SC_YP);
    LAS float* sib = (LAS float*)(lds + SC_SI) + wid * 512;
    LAS bfu* vbuf = (LAS bfu*)(lds + SC_VBUF); LAS float* gab = (LAS float*)(lds + SC_BON); LAS float* pds = (LAS float*)(lds + SC_PC);
    const bfu* va = (const bfu*)slotp(ws, l, 11);
    bfu* mix = (bfu*)slotp(ws, l, 7);
    const float* P = (const float*)slotp(ws, l, 9) + ((size_t)(h * 8 + wid) * MPAD + m0) * 16;
    const float* PG = (const float*)(ws + WS_GAB) + ((size_t)h * MPAD + m0) * 2;
    const float* paird = (const float*)(ws + WS_PAIRD) + ((size_t)h * (MPAD / 2) + (m0 >> 1)) * 2;
    float S[4];
#pragma unroll
    for (int j = 0; j < 4; ++j) S[j] = st_in ? st_in[(8 * wid + 4 * kh + j) * 64 + row] : 0.f;
    const int nblk = L >> BLS; const int srow = tid >> 4, sc4 = tid & 15; const bool sval = srow < BL;
    const int nsi = BL >> 4;
    f32x4 ssi[2]; v2u sv = {0, 0}; float sb_ = 0.f, sp_ = 0.f;
#define DL_STAGE(c) do { const float* ps_ = P + (size_t)(c) * BL * 16 + lane * 4; \
        _Pragma("unroll") for (int i_ = 0; i_ < 2; ++i_) if (i_ < nsi) ssi[i_] = *(const f32x4*)(ps_ + i_ * 256); \
        if (sval) { const size_t mm = (size_t)(m0 + (c) * BL + srow) * 256 + h * 64 + sc4 * 4; sv = *(const v2u*)(va + mm); } \
        if (tid < 2 * BL) sb_ = PG[(size_t)(c) * BL * 2 + tid]; if (tid < BL) sp_ = paird[(size_t)(c) * BL + tid]; } while (0)
#define DL_COMMIT(c) do { LAS float* pd_ = sib + ((c) & 1) * 4096 + lane * 4; \
        _Pragma("unroll") for (int i_ = 0; i_ < 2; ++i_) if (i_ < nsi) *(LAS f32x4*)(pd_ + i_ * 256) = ssi[i_]; \
        if (sval) { *(LAS v2u*)(vbuf + ((c) & 1) * 2048 + srow * 64 + sc4 * 4) = sv; } \
        if (tid < 2 * BL) gab[((c) & 1) * 64 + tid] = sb_; if (tid < BL) pds[((c) & 1) * 32 + tid] = sp_; } while (0)
    __syncthreads();
    DL_STAGE(0); DL_COMMIT(0); if (nblk > 1) DL_STAGE(1);
    const int dsel = ((lane & 4) ? 8 : 0) + 4 * kh + (lane & 3);
    float ca0, ca1, cb0 = 0.f, cb1 = 0.f; f32x4 cau[2], cbu[2];
#define DL_LOADOPS(D, T) do { const LAS float* pb_ = sib + ((((T) >> BLS) & 1) * 4096) + ((T) & (BL - 1)) * 16; D##0 = pb_[dsel]; D##1 = pb_[16 + dsel]; \
        const LAS f32x4* pu_ = (const LAS f32x4*)(pb_ + 4 * kh); D##u[0] = pu_[0]; D##u[1] = pu_[4]; } while (0)
    DL_LOADOPS(ca, 0);
#define DL_FINAL(T) do { const int tf_ = (T); \
        const LAS float* yr_ = yred + (tf_ & 15) * 512 + lane; const float o_ = ((yr_[0] + yr_[64]) + (yr_[128] + yr_[192])) + ((yr_[256] + yr_[320]) + (yr_[384] + yr_[448])); \
        if (lane < 32) mix[(size_t)(m0 + tf_) * 1024 + h * 64 + row] = (bfu)f2bf(o_); } while (0)
#define DL_ROUND(C, N, T) do { const int par_ = ((T) >> 1) & 1; \
        float d1a = 0.f, d1b = 0.f, d2a = 0.f, d2b = 0.f, f1a = 0.f, f1b = 0.f; \
        DOT4_LO(d1a, d1b, C##0); DOT4_LO(d2a, d2b, C##1); DOT4_HI(f1a, f1b, C##0); \
        float d1 = d1a + d1b, d2 = d2a + d2b, f1 = f1a + f1b; SWAPSUM(d1); SWAPSUM(d2); SWAPSUM(f1); \
        ((LAS f32x4*)red)[(par_ * 8 + wid) * 64 + lane] = (f32x4){d1, d2, f1, 0.f}; \
        SC_BAR(); \
        f32x4 tot_; RED8(tot_); \
        const int bo_ = (((T) >> BLS) & 1), to_ = (T) & (BL - 1); \
        const float v1 = bf2f(vbuf[bo_ * 2048 + to_ * 64 + row]), v2_ = bf2f(vbuf[bo_ * 2048 + to_ * 64 + 64 + row]); \
        const f32x4 ab_ = *(const LAS f32x4*)(gab + bo_ * 64 + to_ * 2); const f32x2 pd2_ = *(const LAS f32x2*)(pds + bo_ * 32 + to_); \
        asm volatile("" ::: "memory"); \
        if ((T) + 2 < L) DL_LOADOPS(N, (T) + 2); \
        __builtin_amdgcn_sched_barrier(0); \
        const float a1 = ab_[0], a2 = ab_[2]; const float dl1 = ab_[1] * (v1 - a1 * tot_[0]); const float dl2 = ab_[3] * (v2_ - a2 * (a1 * tot_[1] + pd2_[0] * dl1)); \
        const float o1 = a1 * tot_[2] + pd2_[1] * dl1; const float a12 = a1 * a2, dl1s = a2 * dl1; \
        _Pragma("unroll") for (int j = 0; j < 4; ++j) S[j] *= a12; \
        AXPY4(C##u[0], dl1s); AXPY4(C##u[1], dl2); \
        float y2a = 0.f, y2b = 0.f; DOT4_HI(y2a, y2b, C##1); float y2 = y2a + y2b; SWAPSUM(y2); \
        yred[((T) & 15) * 512 + wid * 64 + lane] = o1 * 0.125f; yred[(((T) + 1) & 15) * 512 + wid * 64 + lane] = y2; } while (0)
    for (int c = 0; c < nblk; ++c) {
        for (int tt = 0; tt < BL; tt += 4) {
            const int t = c * BL + tt;
            if (tt == (BL >> 1) && c + 1 < nblk) { DL_COMMIT(c + 1); if (c + 2 < nblk) DL_STAGE(c + 2); }
            DL_ROUND(ca, cb, t);
            DL_ROUND(cb, ca, t + 2);
            if (((t + 3) & 15) == 15) { SC_BAR(); DL_FINAL(t - 12 + 2 * wid); DL_FINAL(t - 11 + 2 * wid); }
        }
    }
#pragma unroll
    for (int j = 0; j < 4; ++j) st_out[(8 * wid + 4 * kh + j) * 64 + row] = S[j];
    __syncthreads();
#undef DL_STAGE
#undef DL_COMMIT
#undef DL_LOADOPS
#undef DL_FINAL
#undef DL_ROUND
}

__device__ __forceinline__ void sample_attn(KArgs A, int l, LAS unsigned char* lds, int unit, int tid) {
    unsigned char* ws = A->ws;
    const int sb = unit >> 2, h = unit & 3;
    LAS float* qs = (LAS float*)lds;
    LAS float* sc = qs + 2048;
    LAS float* scl = sc + 1024;
    LAS float* ssq = scl + 32;
    LAS float* lsum = ssq + 512;
    const bfu* qb = (const bfu*)slotp(ws, l, 4); bfu* mix = (bfu*)slotp(ws, l, 7);
    const float* ck = A->in[2] + (size_t)(l * 8 + sb) * 2048 * 512 + h * 128; const float* cv = A->in[3] + (size_t)(l * 8 + sb) * 2048 * 512 + h * 128;
    const float* nk = A->out + O_BKS + (size_t)(l * 8 + sb) * 16 * 512 + h * 128; const float* nv = A->out + O_BVS + (size_t)(l * 8 + sb) * 16 * 512 + h * 128;
    const float* lf = (const float*)(ws + WS_CTL + 1024); const float lam = lf[2 * l], omli = 1.f - lf[2 * l + 1];
    __syncthreads();
    for (int i = tid; i < 2048; i += NTHR) { const int map = i >> 10, qi = (i >> 6) & 15, p = i & 63; const int s = p >> 5, fq_ = (p >> 3) & 3, n_ = (p >> 2) & 1, j_ = p & 3;
        qs[(map * 16 + qi) * 64 + n_ * 32 + s * 16 + 4 * fq_ + j_] = bf2f(qb[(size_t)(MP + sb * 16 + qi) * 512 + h * 128 + map * 64 + p]); }
    float mrun = -1e30f, lrun = 0.f;
    const int qi = tid & 15, kj = tid >> 4, eg = tid >> 4;
    f32x4 acc0 = {0.f, 0.f, 0.f, 0.f}, acc1 = {0.f, 0.f, 0.f, 0.f};
    __syncthreads();
    for (int tile = 0; tile < 65; ++tile) {
        const int kidx = tile * 32 + kj;
        float s1 = -1e30f, s2 = -1e30f;
        if (kidx < 2064) { const float* kr = kidx < 2048 ? ck + (size_t)kidx * 512 : nk + (size_t)(kidx - 2048) * 512; s1 = 0.f; s2 = 0.f;
#pragma unroll 4
            for (int d = 0; d < 64; d += 4) { const f32x4 k1 = *(const f32x4*)(kr + d), k2 = *(const f32x4*)(kr + 64 + d); const LAS float* q1 = qs + qi * 64 + d; const LAS float* q2 = qs + (16 + qi) * 64 + d;
                s1 += q1[0] * k1[0] + q1[1] * k1[1] + q1[2] * k1[2] + q1[3] * k1[3]; s2 += q2[0] * k2[0] + q2[1] * k2[1] + q2[2] * k2[2] + q2[3] * k2[3]; } }
        sc[qi * 32 + kj] = s1; sc[(16 + qi) * 32 + kj] = s2;
        __syncthreads();
        if (tid < 32) { LAS float* r = sc + tid * 32; float mx = mrun;
#pragma unroll 8
            for (int j = 0; j < 32; ++j) mx = fmaxf(mx, r[j]);
            const float f = exp2f(mrun - mx); float su = 0.f;
#pragma unroll 8
            for (int j = 0; j < 32; ++j) { const float p = exp2f(r[j] - mx); r[j] = p; su += p; }
            lrun = lrun * f + su; mrun = mx; scl[tid] = f; }
        __syncthreads();
        { const float f0 = scl[qi], f1 = scl[16 + qi]; acc0 = acc0 * f0; acc1 = acc1 * f1;
            const int nk_ = tile < 64 ? 32 : 16;
            for (int j = 0; j < nk_; ++j) { const int kx = tile * 32 + j; const float* vr = (kx < 2048 ? cv + (size_t)kx * 512 : nv + (size_t)(kx - 2048) * 512) + eg * 4;
                const f32x4 v = *(const f32x4*)vr; acc0 = acc0 + v * sc[qi * 32 + j]; acc1 = acc1 + v * sc[(16 + qi) * 32 + j]; } }
        __syncthreads();
    }
    if (tid < 32) lsum[tid] = lrun;
    __syncthreads();
    const f32x4 o = acc0 * (1.f / lsum[qi]) - acc1 * (lam / lsum[16 + qi]);
    ssq[qi * 32 + eg] = (o[0] * o[0] + o[1] * o[1]) + (o[2] * o[2] + o[3] * o[3]);
    __syncthreads();
    float ss = 0.f;
#pragma unroll 8
    for (int j = 0; j < 32; ++j) ss += ssq[qi * 32 + j];
    const float rn = rsqrtf(ss * (1.f / 128.f) + 1e-6f) * omli; const float* bn = A->in[20] + l * 128 + eg * 4;
    v2u w; w.x = pk2(o[0] * rn * bn[0], o[1] * rn * bn[1]); w.y = pk2(o[2] * rn * bn[2], o[3] * rn * bn[3]);
    *(v2u*)(mix + (size_t)(MP + sb * 16 + qi) * 1024 + 256 + h * 128 + eg * 4) = w;
    __syncthreads();
}

#define PH_BEGIN \
        KArgs A = (KArgs)__builtin_amdgcn_kernarg_segment_ptr(); \
        int tid = wv * 64 + (int)__builtin_amdgcn_mbcnt_hi(~0u, __builtin_amdgcn_mbcnt_lo(~0u, 0u)); asm volatile("" : "+v"(tid)); tid &= 511; \
        const int bid = blockIdx.x, G = gridDim.x; \
        const int lane = tid & 63, wave = wv; \
        const int gw = bid * NWAVES + wave, NGW = G * NWAVES, gtid = bid * NTHR + tid, NT = G * NTHR; \
        unsigned char* ws = A->ws; float* rsb = (float*)(ws + WS_RS); unsigned char* wb = ws + WS_W; \
        (void)lane; (void)gw; (void)NGW; (void)gtid; (void)NT; (void)rsb; (void)wb;
#define IN(k) (lo <= (k) && (k) < hi)
__device__ __forceinline__ void grid_bar(unsigned* bar, unsigned target, bool leader) {
    asm volatile("s_waitcnt vmcnt(0) lgkmcnt(0)" ::: "memory");
    __syncthreads();
    if (leader) {
        __builtin_amdgcn_fence(__ATOMIC_RELEASE, "agent");
        asm volatile("s_waitcnt vmcnt(0)" ::: "memory");
        __hip_atomic_fetch_add(bar, 1u, __ATOMIC_RELAXED, __HIP_MEMORY_SCOPE_AGENT);
        unsigned spins = 0;
        while (__hip_atomic_load(bar, __ATOMIC_RELAXED, __HIP_MEMORY_SCOPE_AGENT) < target) { __builtin_amdgcn_s_sleep(2); if (++spins > (1u << 27)) break; }
        __builtin_amdgcn_fence(__ATOMIC_ACQUIRE, "agent");
        asm volatile("s_waitcnt vmcnt(0)" ::: "memory");
    }
    __syncthreads();
}
#define SEAM(k) do { if ((k) + 1 < hi) { ++nbar; grid_bar((unsigned*)(ws + WS_CTL + 4096), nbar * (unsigned)G, tid == 0); } } while (0)
#define SEAM_SKIP(k) do { } while (0)
__global__ void __launch_bounds__(NTHR, 2) hybrid_fwd(Args Aval) {
    extern __shared__ __attribute__((aligned(16))) unsigned char lds_raw[];
    LAS unsigned char* lds = (LAS unsigned char*)lds_raw;
    const int lo = Aval.ph_lo, hi = Aval.ph_hi; unsigned nbar = 0u;
    if (Aval.ph_lo < 0) cg::this_grid().sync();
    const int wv = __builtin_amdgcn_readfirstlane(threadIdx.x >> 6);
    if (IN(0)) { PH_BEGIN prologue(A, lds, gw, NGW, lane, wave, gtid, NT); SEAM(0); }
    { constexpr int l = 0;

        const int p0 = 1 + 11 * l;
        if (IN(p0 + 0)) { PH_BEGIN
            pg8::Gemm g{(const pg8::bf16_t*)slotp(ws, l, 0), (const pg8::bf16_t*)(wb + W_IN), MPAD, NIN, 1024};
            pg8::StaticOrder S; S.init(MPAD, NIN, G, bid);
            EpiG1 E{rsb + (size_t)(3 * l) * MPAD, (bfu*)slotp(ws, l, 2), (bfu*)slotp(ws, l, 4), (bfu*)slotp(ws, l, 5), (bfu*)slotp(ws, l, 6), (bfu*)slotp(ws, l, 7), (float*)(ws + WS_AB), (const float*)(ws + WS_ROPE),
                    A->out + O_BKP + (size_t)l * MP * 512, A->out + O_BVP + (size_t)l * MP * 512, A->out + O_BKS + (size_t)l * MS * 512, A->out + O_BVS + (size_t)l * MS * 512};
            pg8::gemm_phase<EpiG1, pg8::StaticOrder, true, true>((PG8_LAS unsigned char*)lds, g, S, E, wv);
            SEAM(p0 + 0); }
        if (IN(p0 + 1)) { PH_BEGIN
            prep_a(A, l, gw, NGW, lane); prep_c1(A, l, gw, NGW, lane);
            if (l == 1) conv_weights(A, 1, 2, lds, gw, NGW, lane, wave);
            SEAM(p0 + 1); }
        if (IN(p0 + 2)) { PH_BEGIN
            pg8::Gemm g{(const pg8::bf16_t*)slotp(ws, l, 12), (const pg8::bf16_t*)(wb + W_LR), MPAD, 768, 256};
            pg8::StaticOrder S; S.init(MPAD, 768, G, bid);
            EpiB<0> E{(bfu*)slotp(ws, l, 13), 768, nullptr};
            pg8::gemm_phase<EpiB<0>, pg8::StaticOrder, true, true>((PG8_LAS unsigned char*)lds, g, S, E, wv);
            SEAM(p0 + 2); }
        if (IN(p0 + 3)) { PH_BEGIN prep_c2(A, l, bid, G, tid); prep_a2(A, l, gw, NGW, lane);
            SEAM(p0 + 3); }
        if (IN(p0 + 4)) { PH_BEGIN
            if (bid < 64) { const int st = bid >> 1, half = bid & 1, b = st >> 2, h = st & 3;
                scan_rwkv(A, l, lds, h, half, b * 8192, 8192, 32, 5, b * 128, nullptr, A->out + O_CWP + (size_t)((l * 8 + b) * 4 + h) * 4096, tid);
                scan_rwkv(A, l, lds, h, half, MP + b * 16, 16, 16, 4, 1024 + b, A->in[7] + (size_t)((l * 8 + b) * 4 + h) * 4096, A->out + O_CWS + (size_t)((l * 8 + b) * 4 + h) * 4096, tid);
            } else if (bid < 128) { const int st = (bid - 64) >> 1, half = bid & 1, b = st >> 2, h = st & 3;
                scan_delta(A, l, lds, h, half, b * 8192, 8192, 32, 5, nullptr, A->out + O_ADP + (size_t)((l * 8 + b) * 4 + h) * 4096, tid);
                scan_delta(A, l, lds, h, half, MP + b * 16, 16, 16, 4, A->in[5] + (size_t)((l * 8 + b) * 4 + h) * 4096, A->out + O_ADS + (size_t)((l * 8 + b) * 4 + h) * 4096, tid);
            } else if (bid < 160) { sample_attn(A, l, lds, bid - 128, tid); }
            __syncthreads();
            unsigned* ctr = (unsigned*)(ws + WS_CTL) + 16 * l; volatile LAS unsigned* qw = (volatile LAS unsigned*)(lds + MISC_OFF);
            const attn_body::bf16* Q = (const attn_body::bf16*)slotp(ws, l, 4); const attn_body::bf16* K = (const attn_body::bf16*)slotp(ws, l, 5); const attn_body::bf16* V = (const attn_body::bf16*)slotp(ws, l, 6);
            attn_body::bf16* O = (attn_body::bf16*)slotp(ws, l, 13);
            for (;;) {
                if (tid == 0) qw[0] = atomicAdd(ctr, 1u);
                __syncthreads();
                const unsigned u = qw[0];
                __syncthreads();
                if (u >= 4096u) break;
                const int qb = 31 - (int)(u >> 7), bh = (int)(u & 127);
                attn_body::attn_unit<8>(bh >> 4, bh & 15, qb, Q, K, V, O, (char*)lds_raw, wv);
            }
            SEAM(p0 + 4); }
        if (IN(p0 + 5)) { PH_BEGIN
            post_attn(A, l, gw, NGW, lane); post_scan(A, l, gw, NGW, lane);
            conv_p(A, l, (bfu*)slotp(ws, l, 10), gtid, NT);
            if (l == 0) conv_weights(A, 1, 1, lds, gw, NGW, lane, wave);
            SEAM(p0 + 5); }
        if (IN(p0 + 6)) { PH_BEGIN
            pg8::Gemm g{(const pg8::bf16_t*)slotp(ws, l, 7), (const pg8::bf16_t*)(wb + W_OUT), MPAD, 1024, 1024};
            pg8::StaticOrder S; S.init(MPAD, 1024, G, bid);
            EpiH<2> E{A->out, (bfu*)slotp(ws, l, 0), rsb + (size_t)(3 * l + 1) * MPAD, nullptr, nullptr};
            pg8::gemm_phase<EpiH<2>, pg8::StaticOrder, true, true>((PG8_LAS unsigned char*)lds, g, S, E, wv);
            SEAM(p0 + 6); }
        if (IN(p0 + 7)) { PH_BEGIN
            pg8::Gemm g{(const pg8::bf16_t*)slotp(ws, l, 0), (const pg8::bf16_t*)(wb + W_FF1), MPAD, FFD, 1024};
            pg8::StaticOrder S; S.init(MPAD, FFD, G, bid);
            EpiB<1> E{(bfu*)slotp(ws, l, 2), FFD, rsb + (size_t)(3 * l + 1) * MPAD};
            pg8::gemm_phase<EpiB<1>, pg8::StaticOrder, true, true>((PG8_LAS unsigned char*)lds, g, S, E, wv);
            {
                pg8::Gemm g2{(const pg8::bf16_t*)slotp(ws, l, 10), (const pg8::bf16_t*)(wb + W_PP), MPAD, 1024, 256};
                pg8::StaticOrder S2; S2.init(MPAD, 1024, G, bid);
                EpiB<0> E2{(bfu*)slotp(ws, l, 11), 1024, nullptr};
                pg8::gemm_phase<EpiB<0>, pg8::StaticOrder, true, true>((PG8_LAS unsigned char*)lds, g2, S2, E2, wv); }
            SEAM(p0 + 7); }
        if (IN(p0 + 8)) { PH_BEGIN
            pg8::Gemm g{(const pg8::bf16_t*)slotp(ws, l, 2), (const pg8::bf16_t*)(wb + W_FF2), MPAD, 1024, FFD};
            pg8::StaticOrder S; S.init(MPAD, 1024, G, bid);
            EpiH<2> E{A->out, (bfu*)slotp(ws, l, 0), rsb + (size_t)(3 * l + 2) * MPAD, nullptr, nullptr};
            pg8::gemm_phase<EpiH<2>, pg8::StaticOrder, true, true>((PG8_LAS unsigned char*)lds, g, S, E, wv);
            SEAM(p0 + 8); }
        if (IN(p0 + 9)) { PH_BEGIN SEAM_SKIP(p0 + 9); }
        if (IN(p0 + 10)) { PH_BEGIN
            pg8::Gemm g{(const pg8::bf16_t*)slotp(ws, l, 0), (const pg8::bf16_t*)(wb + W_GATE), MPAD, 1024, 1024};
            pg8::StaticOrder S; S.init(MPAD, 1024, G, bid);
            EpiH<3> E{A->out, (bfu*)slotp(ws, l, 13), rsb + (size_t)(3 * l + 3) * MPAD, rsb + (size_t)(3 * l + 2) * MPAD, (const bfu*)slotp(ws, l, 11)};
            pg8::gemm_phase<EpiH<3>, pg8::StaticOrder, true, true>((PG8_LAS unsigned char*)lds, g, S, E, wv);
            SEAM(p0 + 10); }
        }
    { constexpr int l = 1;

        const int p0 = 1 + 11 * l;
        if (IN(p0 + 0)) { PH_BEGIN
            pg8::Gemm g{(const pg8::bf16_t*)slotp(ws, l, 0), (const pg8::bf16_t*)(wb + W_IN), MPAD, NIN, 1024};
            pg8::StaticOrder S; S.init(MPAD, NIN, G, bid);
            EpiG1 E{rsb + (size_t)(3 * l) * MPAD, (bfu*)slotp(ws, l, 2), (bfu*)slotp(ws, l, 4), (bfu*)slotp(ws, l, 5), (bfu*)slotp(ws, l, 6), (bfu*)slotp(ws, l, 7), (float*)(ws + WS_AB), (const float*)(ws + WS_ROPE),
                    A->out + O_BKP + (size_t)l * MP * 512, A->out + O_BVP + (size_t)l * MP * 512, A->out + O_BKS + (size_t)l * MS * 512, A->out + O_BVS + (size_t)l * MS * 512};
            pg8::gemm_phase<EpiG1, pg8::StaticOrder, true, true>((PG8_LAS unsigned char*)lds, g, S, E, wv);
            SEAM(p0 + 0); }
        if (IN(p0 + 1)) { PH_BEGIN
            prep_a(A, l, gw, NGW, lane); prep_c1(A, l, gw, NGW, lane);
            if (l == 1) conv_weights(A, 1, 2, lds, gw, NGW, lane, wave);
            SEAM(p0 + 1); }
        if (IN(p0 + 2)) { PH_BEGIN
            pg8::Gemm g{(const pg8::bf16_t*)slotp(ws, l, 12), (const pg8::bf16_t*)(wb + W_LR), MPAD, 768, 256};
            pg8::StaticOrder S; S.init(MPAD, 768, G, bid);
            EpiB<0> E{(bfu*)slotp(ws, l, 13), 768, nullptr};
            pg8::gemm_phase<EpiB<0>, pg8::StaticOrder, true, true>((PG8_LAS unsigned char*)lds, g, S, E, wv);
            SEAM(p0 + 2); }
        if (IN(p0 + 3)) { PH_BEGIN prep_c2(A, l, bid, G, tid); prep_a2(A, l, gw, NGW, lane);
            SEAM(p0 + 3); }
        if (IN(p0 + 4)) { PH_BEGIN
            if (bid < 64) { const int st = bid >> 1, half = bid & 1, b = st >> 2, h = st & 3;
                scan_rwkv(A, l, lds, h, half, b * 8192, 8192, 32, 5, b * 128, nullptr, A->out + O_CWP + (size_t)((l * 8 + b) * 4 + h) * 4096, tid);
                scan_rwkv(A, l, lds, h, half, MP + b * 16, 16, 16, 4, 1024 + b, A->in[7] + (size_t)((l * 8 + b) * 4 + h) * 4096, A->out + O_CWS + (size_t)((l * 8 + b) * 4 + h) * 4096, tid);
            } else if (bid < 128) { const int st = (bid - 64) >> 1, half = bid & 1, b = st >> 2, h = st & 3;
                scan_delta(A, l, lds, h, half, b * 8192, 8192, 32, 5, nullptr, A->out + O_ADP + (size_t)((l * 8 + b) * 4 + h) * 4096, tid);
                scan_delta(A, l, lds, h, half, MP + b * 16, 16, 16, 4, A->in[5] + (size_t)((l * 8 + b) * 4 + h) * 4096, A->out + O_ADS + (size_t)((l * 8 + b) * 4 + h) * 4096, tid);
            } else if (bid < 160) { sample_attn(A, l, lds, bid - 128, tid); }
            __syncthreads();
            unsigned* ctr = (unsigned*)(ws + WS_CTL) + 16 * l; volatile LAS unsigned* qw = (volatile LAS unsigned*)(lds + MISC_OFF);
            const attn_body::bf16* Q = (const attn_body::bf16*)slotp(ws, l, 4); const attn_body::bf16* K = (const attn_body::bf16*)slotp(ws, l, 5); const attn_body::bf16* V = (const attn_body::bf16*)slotp(ws, l, 6);
            attn_body::bf16* O = (attn_body::bf16*)slotp(ws, l, 13);
            for (;;) {
                if (tid == 0) qw[0] = atomicAdd(ctr, 1u);
                __syncthreads();
                const unsigned u = qw[0];
                __syncthreads();
                if (u >= 4096u) break;
                const int qb = 31 - (int)(u >> 7), bh = (int)(u & 127);
                attn_body::attn_unit<8>(bh >> 4, bh & 15, qb, Q, K, V, O, (char*)lds_raw, wv);
            }
            SEAM(p0 + 4); }
        if (IN(p0 + 5)) { PH_BEGIN
            post_attn(A, l, gw, NGW, lane); post_scan(A, l, gw, NGW, lane);
            conv_p(A, l, (bfu*)slotp(ws, l, 10), gtid, NT);
            if (l == 0) conv_weights(A, 1, 1, lds, gw, NGW, lane, wave);
            SEAM(p0 + 5); }
        if (IN(p0 + 6)) { PH_BEGIN
            pg8::Gemm g{(const pg8::bf16_t*)slotp(ws, l, 7), (const pg8::bf16_t*)(wb + W_OUT), MPAD, 1024, 1024};
            pg8::StaticOrder S; S.init(MPAD, 1024, G, bid);
            EpiH<2> E{A->out, (bfu*)slotp(ws, l, 0), rsb + (size_t)(3 * l + 1) * MPAD, nullptr, nullptr};
            pg8::gemm_phase<EpiH<2>, pg8::StaticOrder, true, true>((PG8_LAS unsigned char*)lds, g, S, E, wv);
            SEAM(p0 + 6); }
        if (IN(p0 + 7)) { PH_BEGIN
            pg8::Gemm g{(const pg8::bf16_t*)slotp(ws, l, 0), (const pg8::bf16_t*)(wb + W_FF1), MPAD, FFD, 1024};
            pg8::StaticOrder S; S.init(MPAD, FFD, G, bid);
            EpiB<1> E{(bfu*)slotp(ws, l, 2), FFD, rsb + (size_t)(3 * l + 1) * MPAD};
            pg8::gemm_phase<EpiB<1>, pg8::StaticOrder, true, true>((PG8_LAS unsigned char*)lds, g, S, E, wv);
            {
                pg8::Gemm g2{(const pg8::bf16_t*)slotp(ws, l, 10), (const pg8::bf16_t*)(wb + W_PP), MPAD, 1024, 256};
                pg8::StaticOrder S2; S2.init(MPAD, 1024, G, bid);
                EpiB<0> E2{(bfu*)slotp(ws, l, 11), 1024, nullptr};
                pg8::gemm_phase<EpiB<0>, pg8::StaticOrder, true, true>((PG8_LAS unsigned char*)lds, g2, S2, E2, wv); }
            SEAM(p0 + 7); }
        if (IN(p0 + 8)) { PH_BEGIN
            pg8::Gemm g{(const pg8::bf16_t*)slotp(ws, l, 2), (const pg8::bf16_t*)(wb + W_FF2), MPAD, 1024, FFD};
            pg8::StaticOrder S; S.init(MPAD, 1024, G, bid);
            EpiH<2> E{A->out, (bfu*)slotp(ws, l, 0), rsb + (size_t)(3 * l + 2) * MPAD, nullptr, nullptr};
            pg8::gemm_phase<EpiH<2>, pg8::StaticOrder, true, true>((PG8_LAS unsigned char*)lds, g, S, E, wv);
            SEAM(p0 + 8); }
        if (IN(p0 + 9)) { PH_BEGIN SEAM_SKIP(p0 + 9); }
        if (IN(p0 + 10)) { PH_BEGIN
            pg8::Gemm g{(const pg8::bf16_t*)slotp(ws, l, 0), (const pg8::bf16_t*)(wb + W_GATE), MPAD, 1024, 1024};
            pg8::StaticOrder S; S.init(MPAD, 1024, G, bid);
            EpiH<3> E{A->out, (bfu*)slotp(ws, l, 13), rsb + (size_t)(3 * l + 3) * MPAD, rsb + (size_t)(3 * l + 2) * MPAD, (const bfu*)slotp(ws, l, 11)};
            pg8::gemm_phase<EpiH<3>, pg8::StaticOrder, true, true>((PG8_LAS unsigned char*)lds, g, S, E, wv);
            SEAM(p0 + 10); }
        }
    if (IN(NPHASE - 1)) { PH_BEGIN final_norm(A, gw, NGW, lane); }
}
#undef PH_BEGIN
#undef IN
#undef SEAM

extern "C" void kernel_launch(void* const* d_in, const int* in_sizes, int n_in, void* d_out, int out_size, void* d_ws, size_t ws_size, hipStream_t stream) {
    static int grid = 0;
    if (grid == 0) {
        if (n_in != 40 || (size_t)out_size != O_END || ws_size < WS_TOTAL) { fprintf(stderr, "kernel_launch: unexpected shapes (n_in %d out %d ws %zu)\n", n_in, out_size, ws_size); grid = -1; return; }
        int dev = 0, cus = 0, per_cu = 0;
        if (hipGetDevice(&dev) != hipSuccess || hipDeviceGetAttribute(&cus, hipDeviceAttributeMultiprocessorCount, dev) != hipSuccess) { grid = -1; return; }
        if (hipFuncSetAttribute((const void*)hybrid_fwd, hipFuncAttributeMaxDynamicSharedMemorySize, LDS_BYTES) != hipSuccess) { fprintf(stderr, "kernel_launch: hipFuncSetAttribute failed\n"); grid = -1; return; }
        if (hipOccupancyMaxActiveBlocksPerMultiprocessor(&per_cu, (const void*)hybrid_fwd, NTHR, LDS_BYTES) != hipSuccess || per_cu < 1) { fprintf(stderr, "kernel_launch: occupancy query says %d\n", per_cu); per_cu = 1; }
        (void)hipGetLastError();
        grid = cus;
    }
    if (grid < 0) return;
    if (hipMemsetAsync((char*)d_ws + WS_CTL, 0, 64 * 1024, stream) != hipSuccess) { fprintf(stderr, "kernel_launch: memset failed\n"); return; }
    Args a{};
    for (int i = 0; i < 40; ++i) a.in[i] = (const float*)d_in[i];
    a.out = (float*)d_out; a.ws = (unsigned char*)d_ws;
#if MK_ONE_LAUNCH
    a.ph_lo = 0; a.ph_hi = NPHASE;
    void* args[] = {&a};
    hipError_t e = hipLaunchCooperativeKernel((const void*)hybrid_fwd, dim3(grid), dim3(NTHR), args, LDS_BYTES, stream);
    if (e != hipSuccess) fprintf(stderr, "kernel_launch: cooperative launch failed: %s (grid %d)\n", hipGetErrorString(e), grid);
#else
    for (int ph = 0; ph < NPHASE; ++ph) { a.ph_lo = ph; a.ph_hi = ph + 1; hipLaunchKernelGGL(hybrid_fwd, dim3(grid), dim3(NTHR), LDS_BYTES, stream, a); }
#endif
}
```
